# Optimizing an MI355X kernel written in HIP

```python
import math
import jax, jax.numpy as jnp
from jax import lax
import numpy as np

D_MODEL = 1024
BATCH = 32
SEQ = 2048
DEPTH = 1

RW_HEADS = 8
RW_HEAD = 64
RW_WIDTH = RW_HEADS * RW_HEAD
DECAY_LORA = 64
ICLR_LORA = 64
GATE_LORA = 128
DA_HEADS = 4
DA_HEAD = 64
DA_VDIM = 2 * DA_HEAD
DA_QK_WIDTH = DA_HEADS * 2 * DA_HEAD
DA_WIDTH = DA_HEADS * DA_VDIM
Q_BLOCK = 128
PK_HEADS = 8
PK_NKEYS = 128
PK_QDIM = 256
PK_TOPK = 16
PK_EXPERTS = PK_NKEYS * PK_NKEYS
PK_CHUNK = 128
NORM_EPS = 1e-6
GN_EPS = 64e-5
SUBLN_EPS = 1e-5
SHIFT_COLS = 3 * RW_WIDTH + DECAY_LORA + ICLR_LORA + GATE_LORA
GATE_COLS = 2 * D_MODEL
IN_COLS = SHIFT_COLS + 2 * DA_QK_WIDTH + DA_WIDTH + GATE_COLS

kernel_name = 'hybrid_rwkv7_diffattn_peer_block'


def rmsnorm(x, w, eps=NORM_EPS):
    xf = x.astype(jnp.float32)
    y = xf * lax.rsqrt(jnp.mean(xf * xf, axis=-1, keepdims=True) + eps)
    return (y * w.astype(jnp.float32)).astype(x.dtype)


def token_shift(z, mu):
    z_prev = jnp.pad(z, ((0, 0), (1, 0), (0, 0)))[:, :-1]
    return z + (z_prev - z) * mu


def rwkv7_time_mix(p, w0, w2, a0, a2, g2, k_k, k_a, r_k, lnx_w, lnx_b):
    B, S, _ = p.shape
    f32 = jnp.float32
    c = [RW_WIDTH, 2 * RW_WIDTH, 3 * RW_WIDTH, 3 * RW_WIDTH + DECAY_LORA, 3 * RW_WIDTH + DECAY_LORA + ICLR_LORA]
    r, k, v, wl, al, gl = jnp.split(p.astype(f32), c, axis=-1)
    w = -jax.nn.softplus(-(w0 + jnp.tanh(wl) @ w2)) - 0.5
    decay = jnp.exp(-jnp.exp(w))
    a = jax.nn.sigmoid(a0 + al @ a2)
    g = jax.nn.sigmoid(gl) @ g2
    heads = lambda t: t.reshape(B, S, RW_HEADS, RW_HEAD)
    kk = heads(k * k_k)
    kk = kk / jnp.maximum(jnp.sqrt(jnp.sum(kk * kk, axis=-1, keepdims=True)), 1e-12)
    k = k * (1.0 + (a - 1.0) * k_a)
    r, k, v, a, decay = heads(r), heads(k), heads(v), heads(a), heads(decay)

    def step(state, inp):
        r_t, w_t, k_t, v_t, kk_t, a_t = inp
        sa = jnp.einsum('bhvk,bhk->bhv', state, -kk_t)
        state = (state * w_t[:, :, None, :]
                 + sa[..., None] * (kk_t * a_t)[:, :, None, :]
                 + v_t[..., None] * k_t[:, :, None, :])
        return state, jnp.einsum('bhvk,bhk->bhv', state, r_t)

    tm = lambda t: jnp.moveaxis(t, 1, 0)
    state0 = jnp.zeros((B, RW_HEADS, RW_HEAD, RW_HEAD), f32)
    _, y = lax.scan(step, state0, (tm(r), tm(decay), tm(k), tm(v), tm(kk), tm(a)))
    y = jnp.moveaxis(y, 0, 1)
    mu = jnp.mean(y, axis=-1, keepdims=True)
    var = jnp.mean(jnp.square(y - mu), axis=-1, keepdims=True)
    y = ((y - mu) * lax.rsqrt(var + GN_EPS)).reshape(B, S, RW_WIDTH) * lnx_w + lnx_b
    bonus = jnp.sum(r * k * r_k, axis=-1, keepdims=True) * v
    return (y + bonus.reshape(B, S, RW_WIDTH)) * g


def diff_attention(q, k, v, lam_q1, lam_k1, lam_q2, lam_k2, subln_w, lam_init):
    B, S, _ = q.shape
    f32 = jnp.float32
    q = q.reshape(B, S, DA_HEADS, 2, DA_HEAD).astype(f32)
    k = k.reshape(B, S, DA_HEADS, 2, DA_HEAD).astype(f32)
    v = v.reshape(B, S, DA_HEADS, DA_VDIM).astype(f32)
    lam = (jnp.exp(jnp.sum(lam_q1.astype(f32) * lam_k1.astype(f32)))
           - jnp.exp(jnp.sum(lam_q2.astype(f32) * lam_k2.astype(f32))) + lam_init)
    slopes = jnp.asarray(2.0 ** (-8.0 * np.arange(1, DA_HEADS + 1) / DA_HEADS), dtype=f32)
    scale = 1.0 / math.sqrt(DA_HEAD)
    nb = S // Q_BLOCK
    qb = jnp.moveaxis(q.reshape(B, nb, Q_BLOCK, DA_HEADS, 2, DA_HEAD), 1, 0)
    kpos = jnp.arange(S)

    def block(args):
        qi, bi = args
        scores = jnp.einsum('bqhcd,bkhcd->bhcqk', qi, k) * scale
        qpos = bi * Q_BLOCK + jnp.arange(Q_BLOCK)
        dist = (qpos[:, None] - kpos[None, :]).astype(f32)
        scores = scores - (slopes[:, None, None] * dist)[None, :, None]
        scores = jnp.where((dist >= 0)[None, None, None], scores, -jnp.inf)
        pr = jax.nn.softmax(scores, axis=-1)
        attn = pr[:, :, 0] - lam * pr[:, :, 1]
        return jnp.einsum('bhqk,bkhe->bqhe', attn, v)

    o = lax.map(block, (qb, jnp.arange(nb)))
    o = jnp.moveaxis(o, 0, 1).reshape(B, S, DA_HEADS, DA_VDIM)
    o = rmsnorm(o, subln_w, SUBLN_EPS) * (1.0 - lam_init)
    return o.reshape(B, S, DA_WIDTH)


def peer_ffn(h, w_q, sub_keys, u_tab, v_tab):
    B, S, D = h.shape
    T = B * S
    hf = h.reshape(T, D)
    q = (hf @ w_q).reshape(T, PK_HEADS, 2, PK_QDIM // 2).astype(jnp.float32)
    s = jnp.einsum('thcd,hcnd->thcn', q, sub_keys.astype(jnp.float32))
    v1, i1 = lax.top_k(s[:, :, 0], PK_TOPK)
    v2, i2 = lax.top_k(s[:, :, 1], PK_TOPK)
    cand = (v1[..., :, None] + v2[..., None, :]).reshape(T, PK_HEADS, PK_TOPK * PK_TOPK)
    vals, ci = lax.top_k(cand, PK_TOPK)
    e1 = jnp.take_along_axis(i1, ci // PK_TOPK, axis=-1)
    e2 = jnp.take_along_axis(i2, ci % PK_TOPK, axis=-1)
    ids = (e1 * PK_NKEYS + e2).reshape(T, PK_HEADS * PK_TOPK)
    gates = jax.nn.softmax(vals, axis=-1).reshape(T, PK_HEADS * PK_TOPK).astype(h.dtype)
    nc = T // PK_CHUNK

    def chunk(args):
        xc, idc, gc = args
        act = jnp.einsum('ced,cd->ce', u_tab[idc], xc)
        act = jax.nn.gelu(act, approximate=False) * gc
        return jnp.einsum('ce,ced->cd', act, v_tab[idc])

    y = lax.map(chunk, (hf.reshape(nc, PK_CHUNK, D),
                        ids.reshape(nc, PK_CHUNK, PK_HEADS * PK_TOPK),
                        gates.reshape(nc, PK_CHUNK, PK_HEADS * PK_TOPK)))
    return y.reshape(B, S, D)


def setup_inputs(seed: int = 0) -> dict:
    key = jax.random.key(seed)
    ks = jax.random.split(key, 32)
    L = DEPTH
    f32 = jnp.float32
    nrm = lambda k, shape, sc: jax.random.normal(k, shape, f32) * sc
    return {
        'x': nrm(ks[0], (BATCH, SEQ, D_MODEL), 1.0),
        'norm_mix_w': 1.0 + nrm(ks[1], (L, D_MODEL), 0.1),
        'w_in': nrm(ks[2], (L, D_MODEL, IN_COLS), D_MODEL ** -0.5),
        'shift_mu': jax.random.uniform(ks[3], (L, SHIFT_COLS), f32, 0.1, 0.9),
        'w0': -1.0 + nrm(ks[4], (L, RW_WIDTH), 1.0),
        'w2': nrm(ks[5], (L, DECAY_LORA, RW_WIDTH), 0.1),
        'a0': nrm(ks[6], (L, RW_WIDTH), 0.1),
        'a2': nrm(ks[7], (L, ICLR_LORA, RW_WIDTH), 0.1),
        'g2': nrm(ks[8], (L, GATE_LORA, RW_WIDTH), GATE_LORA ** -0.5),
        'k_k': 0.85 + nrm(ks[9], (L, RW_WIDTH), 0.05),
        'k_a': 1.0 + nrm(ks[10], (L, RW_WIDTH), 0.05),
        'r_k': nrm(ks[11], (L, RW_HEADS, RW_HEAD), 0.1),
        'lnx_w': 1.0 + nrm(ks[12], (L, RW_WIDTH), 0.1),
        'lnx_b': nrm(ks[13], (L, RW_WIDTH), 0.02),
        'lam_q1': nrm(ks[14], (L, DA_HEAD), 0.1),
        'lam_k1': nrm(ks[15], (L, DA_HEAD), 0.1),
        'lam_q2': nrm(ks[16], (L, DA_HEAD), 0.1),
        'lam_k2': nrm(ks[17], (L, DA_HEAD), 0.1),
        'subln_w': 1.0 + nrm(ks[18], (L, DA_VDIM), 0.1),
        'proj_a': nrm(ks[19], (L, RW_WIDTH, D_MODEL), RW_WIDTH ** -0.5),
        'proj_b': nrm(ks[20], (L, DA_WIDTH, D_MODEL), DA_WIDTH ** -0.5),
        'w_out': nrm(ks[21], (L, D_MODEL, D_MODEL), D_MODEL ** -0.5),
        'norm_ffn_w': 1.0 + nrm(ks[22], (L, D_MODEL), 0.1),
        'peer_wq': nrm(ks[23], (L, D_MODEL, PK_HEADS * PK_QDIM), D_MODEL ** -0.5),
        'peer_keys': nrm(ks[24], (L, PK_HEADS, 2, PK_NKEYS, PK_QDIM // 2), (PK_QDIM // 2) ** -0.5),
        'peer_u': nrm(ks[25], (L, PK_EXPERTS, D_MODEL), D_MODEL ** -0.5),
        'peer_v': nrm(ks[26], (L, PK_EXPERTS, D_MODEL), 0.3),
        'final_norm_w': 1.0 + nrm(ks[27], (D_MODEL,), 0.1),
    }


def reference(x, norm_mix_w, w_in, shift_mu, w0, w2, a0, a2, g2, k_k, k_a, r_k, lnx_w, lnx_b,
              lam_q1, lam_k1, lam_q2, lam_k2, subln_w, proj_a, proj_b, w_out,
              norm_ffn_w, peer_wq, peer_keys, peer_u, peer_v, final_norm_w):
    c1 = SHIFT_COLS
    c2 = c1 + DA_QK_WIDTH
    c3 = c2 + DA_QK_WIDTH
    c4 = c3 + DA_WIDTH
    for l in range(DEPTH):
        lam_init = 0.8 - 0.6 * math.exp(-0.3 * l)
        h = rmsnorm(x, norm_mix_w[l])
        z = h @ w_in[l]
        zs, zq, zk, zv, zg = jnp.split(z, [c1, c2, c3, c4], axis=-1)
        zs = token_shift(zs, shift_mu[l])
        ya = rwkv7_time_mix(zs, w0[l], w2[l], a0[l], a2[l], g2[l], k_k[l], k_a[l], r_k[l],
                            lnx_w[l], lnx_b[l]).astype(x.dtype)
        yb = diff_attention(zq, zk, zv, lam_q1[l], lam_k1[l], lam_q2[l], lam_k2[l], subln_w[l],
                            lam_init).astype(x.dtype)
        ga, gb = jnp.split(zg, 2, axis=-1)
        merged = jax.nn.sigmoid(ga) * (ya @ proj_a[l]) + jax.nn.sigmoid(gb) * (yb @ proj_b[l])
        x = x + merged @ w_out[l]
        x = x + peer_ffn(rmsnorm(x, norm_ffn_w[l]), peer_wq[l], peer_keys[l], peer_u[l], peer_v[l])
    return rmsnorm(x, final_norm_w)
```

```cpp
#include <hip/hip_runtime.h>
#include <stdint.h>
#include <cstdio>

typedef unsigned short bf16_t;
typedef unsigned int u32;

constexpr int T_TOK = 65536, DM = 1024, SEQ = 2048, NB = 32;
constexpr int NZ = 5376;
constexpr int C_R = 0, C_K = 512, C_V = 1024, C_WL = 1536, C_AL = 1600, C_GL = 1664, C_Q = 1792, C_ZK = 2304, C_ZV = 2816, C_GA = 3328, C_GB = 4352;
constexpr int NEXP = 16384;
constexpr float NORM_EPS = 1e-6f, GN_EPS = 64e-5f, SUBLN_EPS = 1e-5f;
constexpr float LAM_INIT = 0.2f;

constexpr size_t MiB = 1u << 20;
constexpr size_t WS_CTL = 0;
constexpr size_t WS_WIN = 1 * MiB;
constexpr size_t WS_PA = 12 * MiB;
constexpr size_t WS_PB = 13 * MiB;
constexpr size_t WS_WO = 14 * MiB;
constexpr size_t WS_WQ = 16 * MiB;
constexpr size_t WS_KEYS = 20 * MiB;
constexpr size_t WS_RSTD1 = 21 * MiB;
constexpr size_t WS_RSTD2 = 22 * MiB;
constexpr size_t WS_SCAL = 23 * MiB;
constexpr size_t WS_U = 24 * MiB;
constexpr size_t WS_V = 56 * MiB;
constexpr size_t WS_XB = 88 * MiB;
constexpr size_t WS_YA = WS_XB;
constexpr size_t WS_YB = WS_XB + 64 * MiB;
constexpr size_t WS_X2B = WS_XB;
constexpr size_t WS_Z = 216 * MiB;
constexpr size_t WS_Q = WS_Z;
constexpr size_t WS_IDS = WS_Z + 256 * MiB;
constexpr size_t WS_GATES = WS_Z + 288 * MiB;
constexpr size_t WS_MERGED = 888 * MiB;
constexpr size_t WS_END = 1016 * MiB;

__device__ __forceinline__ float bf2f(bf16_t h) { return __uint_as_float(((u32)h) << 16); }
__device__ __forceinline__ bf16_t f2bf(float f) { u32 u = __float_as_uint(f); u += 0x7fffu + ((u >> 16) & 1u); return (bf16_t)(u >> 16); }
__device__ __forceinline__ float wave_sum(float v) {
#pragma unroll
    for (int o = 1; o < 64; o <<= 1) v += __shfl_xor(v, o);
    return v;
}
__device__ __forceinline__ float sigmoidf_(float x) { return 1.f / (1.f + __expf(-x)); }

namespace pg8 {
#define PG8_LAS __attribute__((address_space(3)))
typedef short bf16x8 __attribute__((ext_vector_type(8)));
typedef float f32x4 __attribute__((ext_vector_type(4)));
typedef unsigned u32x4 __attribute__((ext_vector_type(4)));
constexpr int BM = 256, BK = 64, HALF = 128, HTB = HALF * BK * 2  , STAGE_BYTES = 8 * HTB, NXCD = 8, WGM = 8;

__host__ __device__ __forceinline__ int lds_byte(int r, int c) { const int st = (r >> 4) * 2 + (c >> 5), rr = r & 15, cc = c & 31, ob = rr * 64 + cc * 2; return st * 1024 + (ob ^ (((ob >> 9) & 1) << 5)); }
__host__ __device__ __forceinline__ void stage_rc(int b, int& R, int& C) { const int st = b / 1024, sb = b % 1024, swz = sb ^ (((sb >> 9) & 1) << 5); R = (st >> 1) * 16 + swz / 64; C = (st & 1) * 32 + (swz % 64) / 2; }
__host__ __device__ __forceinline__ int perm32(int rho) { const int n = rho >> 4, i = rho & 15; return 8 * (i >> 2) + 4 * n + (i & 3); }

struct Unit { int pm, pn; };
struct Gemm { const bf16_t* A; const bf16_t* Bt; int lda, ldb, K; };

struct StaticOrder {
    int nM, nN, nwg, G, c;
    __host__ __device__ void init(int M, int N, int G_, int c_) { nM = M / BM; nN = N / BM; nwg = nM * nN; G = G_; c = c_; }
    __host__ __device__ bool next(int i, Unit& u) const {
        const long L = (long)i * G + c; if (L >= nwg) return false;
        int wgid = (int)L; { const int q = nwg / NXCD, r = nwg % NXCD, xcd = wgid % NXCD, off = wgid / NXCD; wgid = (xcd < r ? xcd * (q + 1) : r * (q + 1) + (xcd - r) * q) + off; }
        const int nig = WGM * nN, gid = wgid / nig, fm = gid * WGM, gsz = (nM - fm) < WGM ? (nM - fm) : WGM;
        u.pm = fm + ((wgid % nig) % gsz); u.pn = (wgid % nig) / gsz; return true;
    }
};
__device__ __forceinline__ unsigned cvt_pk_bf16(float lo, float hi) { unsigned r; asm volatile("v_cvt_pk_bf16_f32 %0, %1, %2" : "=v"(r) : "v"(lo), "v"(hi)); return r; }
__device__ __forceinline__ float bflo(unsigned w) { return __uint_as_float(w << 16); }
__device__ __forceinline__ float bfhi(unsigned w) { return __uint_as_float(w & 0xffff0000u); }

template <bool SSQ> struct EpiRowScale {
    static constexpr bool PERM = true;
    bf16_t* O; int ldc; const float* rs;
    __device__ __forceinline__ void operator()(const f32x4 (&acc)[2][2][4][2], const Unit& u, int wr, int wc, int fr, int fq) const {
        const int row0 = u.pm * BM + wr * 64 + fr, col0 = u.pn * BM + wc * 32 + 8 * fq;
#pragma unroll
        for (int ai = 0; ai < 2; ++ai)
#pragma unroll
            for (int m = 0; m < 4; ++m) {
                const int row = row0 + ai * HALF + m * 16;
                float s = rs[row]; if (SSQ) s = rsqrtf(s * (1.f / 1024.f) + NORM_EPS);
                bf16_t* rowp = O + (size_t)row * ldc + col0;
#pragma unroll
                for (int bj = 0; bj < 2; ++bj) {
                    const f32x4 v0 = acc[ai][bj][m][0] * s, v1 = acc[ai][bj][m][1] * s;
                    u32x4 w; w.x = cvt_pk_bf16(v0[0], v0[1]); w.y = cvt_pk_bf16(v0[2], v0[3]); w.z = cvt_pk_bf16(v1[0], v1[1]); w.w = cvt_pk_bf16(v1[2], v1[3]);
                    *(u32x4*)(rowp + bj * HALF) = w;
                }
            }
    }
};
template <bool ACCUM> struct EpiGate {
    static constexpr bool PERM = true;
    bf16_t* mg; const bf16_t* z; int gcol;
    __device__ __forceinline__ void operator()(const f32x4 (&acc)[2][2][4][2], const Unit& u, int wr, int wc, int fr, int fq) const {
        const int row0 = u.pm * BM + wr * 64 + fr, col0 = u.pn * BM + wc * 32 + 8 * fq;
#pragma unroll
        for (int ai = 0; ai < 2; ++ai)
#pragma unroll
            for (int m = 0; m < 4; ++m) {
                const int row = row0 + ai * HALF + m * 16;
                const bf16_t* gp = z + (size_t)row * NZ + gcol + col0;
                bf16_t* rowp = mg + (size_t)row * DM + col0;
#pragma unroll
                for (int bj = 0; bj < 2; ++bj) {
                    const u32x4 g = *(const u32x4*)(gp + bj * HALF);
                    const f32x4 a0 = acc[ai][bj][m][0], a1 = acc[ai][bj][m][1];
                    float r[8];
                    r[0] = sigmoidf_(bflo(g.x)) * a0[0]; r[1] = sigmoidf_(bfhi(g.x)) * a0[1]; r[2] = sigmoidf_(bflo(g.y)) * a0[2]; r[3] = sigmoidf_(bfhi(g.y)) * a0[3];
                    r[4] = sigmoidf_(bflo(g.z)) * a1[0]; r[5] = sigmoidf_(bfhi(g.z)) * a1[1]; r[6] = sigmoidf_(bflo(g.w)) * a1[2]; r[7] = sigmoidf_(bfhi(g.w)) * a1[3];
                    if (ACCUM) { const u32x4 o = *(const u32x4*)(rowp + bj * HALF);
                        r[0] += bflo(o.x); r[1] += bfhi(o.x); r[2] += bflo(o.y); r[3] += bfhi(o.y); r[4] += bflo(o.z); r[5] += bfhi(o.z); r[6] += bflo(o.w); r[7] += bfhi(o.w); }
                    u32x4 w; w.x = cvt_pk_bf16(r[0], r[1]); w.y = cvt_pk_bf16(r[2], r[3]); w.z = cvt_pk_bf16(r[4], r[5]); w.w = cvt_pk_bf16(r[6], r[7]);
                    *(u32x4*)(rowp + bj * HALF) = w;
                }
            }
    }
};
struct EpiX2 {
    static constexpr bool PERM = true;
    const float* x; float* x2; bf16_t* x2b; float* ssq;
    __device__ __forceinline__ void operator()(const f32x4 (&acc)[2][2][4][2], const Unit& u, int wr, int wc, int fr, int fq) const {
        const int row0 = u.pm * BM + wr * 64 + fr, col0 = u.pn * BM + wc * 32 + 8 * fq;
#pragma unroll
        for (int ai = 0; ai < 2; ++ai)
#pragma unroll
            for (int m = 0; m < 4; ++m) {
                const int row = row0 + ai * HALF + m * 16;
                const size_t off = (size_t)row * DM + col0;
                float ss = 0.f;
#pragma unroll
                for (int bj = 0; bj < 2; ++bj) {
                    const f32x4 x0 = *(const f32x4*)(x + off + bj * HALF), x1 = *(const f32x4*)(x + off + bj * HALF + 4);
                    const f32x4 o0 = x0 + acc[ai][bj][m][0], o1 = x1 + acc[ai][bj][m][1];
                    *(f32x4*)(x2 + off + bj * HALF) = o0; *(f32x4*)(x2 + off + bj * HALF + 4) = o1;
                    u32x4 w; w.x = cvt_pk_bf16(o0[0], o0[1]); w.y = cvt_pk_bf16(o0[2], o0[3]); w.z = cvt_pk_bf16(o1[0], o1[1]); w.w = cvt_pk_bf16(o1[2], o1[3]);
                    *(u32x4*)(x2b + off + bj * HALF) = w;
                    ss += (o0[0] * o0[0] + o0[1] * o0[1]) + (o0[2] * o0[2] + o0[3] * o0[3]) + (o1[0] * o1[0] + o1[1] * o1[1]) + (o1[2] * o1[2] + o1[3] * o1[3]);
                }
                ss += __shfl_xor(ss, 16); ss += __shfl_xor(ss, 32);
                if (fq == 0) atomicAdd(ssq + row, ss);
            }
    }
};

template <class Epi, class Sched>
__device__ __forceinline__ void gemm_phase(PG8_LAS unsigned char* lds, const Gemm g, const Sched& S, const Epi& E) {
    const int tid = threadIdx.x, wid = __builtin_amdgcn_readfirstlane(tid >> 6), lane = tid & 63, wr = wid >> 2, wc = wid & 3, fr = lane & 15, fq = lane >> 4;
    const int K = g.K, nt = K / BK;
    unsigned voffA[2], voffB[2];
#pragma unroll
    for (int i = 0; i < 2; ++i) { int R, C; stage_rc(tid * 16 + i * 8192, R, C); const int Rb = Epi::PERM ? ((R & ~31) + perm32(R & 31)) : R;
        voffA[i] = (unsigned)(R * g.lda + C) * 2u; voffB[i] = (unsigned)(Rb * g.ldb + C) * 2u; }
    const size_t kstep = (size_t)(BK * 2);
    const size_t hstepA = (size_t)HALF * g.lda * 2, hstepB = (size_t)HALF * g.ldb * 2;
    const size_t tstepA = 2 * hstepA, tstepB = 2 * hstepB;
    const unsigned ldsw = (unsigned)wid * 1024u;
    const int aoff = lds_byte(wr * 64 + fr, fq * 8), boff = lds_byte(wc * 32 + fr, fq * 8);
#define PG8_SA(b, h) (((b) * 2 + (h)) * HTB)
#define PG8_SB(b, h) ((4 + (b) * 2 + (h)) * HTB)
#define PG8_STAGE(bufoff, gbase, voff) do { _Pragma("unroll") for (int _i = 0; _i < 2; ++_i) \
        __builtin_amdgcn_global_load_lds((const unsigned*)((const char*)(gbase) + (voff)[_i]), (PG8_LAS unsigned*)(lds + (bufoff) + ldsw + _i * 8192), 16, 0, 0); } while (0)
#define PG8_LDA(dst, b, h) do { _Pragma("unroll") for (int m = 0; m < 4; ++m) _Pragma("unroll") for (int k = 0; k < 2; ++k) dst[m][k] = *(const PG8_LAS bf16x8*)(lds + PG8_SA(b, h) + aoff + m * 2048 + k * 1024); } while (0)
#define PG8_LDB(dst, b, h) do { _Pragma("unroll") for (int n = 0; n < 2; ++n) _Pragma("unroll") for (int k = 0; k < 2; ++k) dst[n][k] = *(const PG8_LAS bf16x8*)(lds + PG8_SB(b, h) + boff + n * 2048 + k * 1024); } while (0)
#define PG8_MMA(ai, bj, At, Bt) do { __builtin_amdgcn_s_setprio(1); _Pragma("unroll") for (int m = 0; m < 4; ++m) _Pragma("unroll") for (int n = 0; n < 2; ++n) _Pragma("unroll") for (int k = 0; k < 2; ++k) \
        acc[ai][bj][m][n] = __builtin_amdgcn_mfma_f32_16x16x32_bf16(Bt[n][k], At[m][k], acc[ai][bj][m][n], 0, 0, 0); __builtin_amdgcn_s_setprio(0); } while (0)
#define PG8_WAIT_V(n) asm volatile("s_waitcnt vmcnt(" #n ")" ::: "memory")
#define PG8_WAIT_L(n) asm volatile("s_waitcnt lgkmcnt(" #n ")" ::: "memory")
#define PG8_BAR __builtin_amdgcn_s_barrier()
#define PG8_SCHED __builtin_amdgcn_sched_barrier(0)
    Unit cur, nxt; int ui = 0;
    if (!S.next(0, cur)) return;
    f32x4 acc[2][2][4][2];
#pragma unroll
    for (int a = 0; a < 2; ++a)
#pragma unroll
        for (int b = 0; b < 2; ++b)
#pragma unroll
            for (int m = 0; m < 4; ++m)
#pragma unroll
                for (int n = 0; n < 2; ++n) acc[a][b][m][n] = (f32x4){0.f, 0.f, 0.f, 0.f};
    bf16x8 At[4][2], B0[2][2], B1[2][2];
    const char* cA = (const char*)g.A + (size_t)cur.pm * tstepA; const char* cB = (const char*)g.Bt + (size_t)cur.pn * tstepB;
    PG8_STAGE(PG8_SB(0, 0), cB, voffB); PG8_STAGE(PG8_SB(0, 1), cB + hstepB, voffB); PG8_STAGE(PG8_SA(0, 0), cA, voffA); PG8_STAGE(PG8_SA(0, 1), cA + hstepA, voffA);
    if (wr == 1) PG8_BAR;
    PG8_WAIT_V(2); PG8_BAR;
    PG8_STAGE(PG8_SB(1, 0), cB + kstep, voffB); PG8_STAGE(PG8_SA(1, 0), cA + kstep, voffA); PG8_STAGE(PG8_SB(1, 1), cB + hstepB + kstep, voffB);
    PG8_WAIT_V(6); PG8_BAR;
    for (;;) {
        const bool has_next = S.next(ui + 1, nxt);
        const char* nA = has_next ? (const char*)g.A + (size_t)nxt.pm * tstepA : cA; const char* nB = has_next ? (const char*)g.Bt + (size_t)nxt.pn * tstepB : cB;
        for (int t = 0; t < nt; t += 2) {
            const bool last = (t == nt - 2);
            const char* a1 = cA + (size_t)(t + 1) * kstep;
            const char* a2 = last ? nA : cA + (size_t)(t + 2) * kstep; const char* b2 = last ? nB : cB + (size_t)(t + 2) * kstep;
            const char* a3 = a2 + kstep; const char* b3 = b2 + kstep;
            PG8_LDB(B0, 0, 0); PG8_LDB(B1, 0, 1); PG8_SCHED; PG8_LDA(At, 0, 0); PG8_STAGE(PG8_SA(1, 1), a1 + hstepA, voffA);
            PG8_WAIT_V(8); PG8_WAIT_L(0); PG8_BAR; PG8_MMA(0, 0, At, B0); PG8_MMA(0, 1, At, B1); PG8_BAR; PG8_SCHED;
            PG8_LDA(At, 0, 1); PG8_STAGE(PG8_SB(0, 0), b2, voffB); PG8_STAGE(PG8_SB(0, 1), b2 + hstepB, voffB); PG8_STAGE(PG8_SA(0, 0), a2, voffA);
            PG8_WAIT_V(8); PG8_WAIT_L(0); PG8_BAR; PG8_MMA(1, 0, At, B0); PG8_MMA(1, 1, At, B1); PG8_BAR; PG8_SCHED;
            PG8_LDB(B0, 1, 0); PG8_LDB(B1, 1, 1); PG8_SCHED; PG8_LDA(At, 1, 0); PG8_STAGE(PG8_SA(0, 1), a2 + hstepA, voffA);
            PG8_WAIT_V(8); PG8_WAIT_L(0); PG8_BAR; PG8_MMA(0, 0, At, B0); PG8_MMA(0, 1, At, B1); PG8_BAR; PG8_SCHED;
            PG8_LDA(At, 1, 1); PG8_STAGE(PG8_SB(1, 0), b3, voffB); PG8_STAGE(PG8_SB(1, 1), b3 + hstepB, voffB); PG8_STAGE(PG8_SA(1, 0), a3, voffA);
            PG8_WAIT_V(8); PG8_WAIT_L(0); PG8_BAR; PG8_MMA(1, 0, At, B0); PG8_MMA(1, 1, At, B1); PG8_BAR; PG8_SCHED;
        }
        if (wr == 0) PG8_BAR;
        E(acc, cur, wr, wc, fr, fq);
        if (!has_next) break;
#pragma unroll
        for (int a = 0; a < 2; ++a)
#pragma unroll
            for (int b = 0; b < 2; ++b)
#pragma unroll
                for (int m = 0; m < 4; ++m)
#pragma unroll
                    for (int n = 0; n < 2; ++n) acc[a][b][m][n] = (f32x4){0.f, 0.f, 0.f, 0.f};
        cur = nxt; cA = nA; cB = nB; ++ui;
        if (wr == 1) PG8_BAR;
    }
    PG8_WAIT_V(0);
    PG8_BAR;
#undef PG8_SA
#undef PG8_SB
#undef PG8_STAGE
#undef PG8_LDA
#undef PG8_LDB
#undef PG8_MMA
#undef PG8_WAIT_V
#undef PG8_WAIT_L
#undef PG8_BAR
#undef PG8_SCHED
}
}

constexpr int NWAVES = 8;
constexpr int LDS_RING_BYTES = 131072, LDSCTL_OFF = 143360, MISC_OFF = LDSCTL_OFF + 320, LDS_BYTES = 147456;
#define LAS __attribute__((address_space(3)))
#define GAS __attribute__((address_space(1)))
typedef float f32x4 __attribute__((ext_vector_type(4)));
typedef unsigned v4u __attribute__((ext_vector_type(4)));
typedef unsigned v2u __attribute__((ext_vector_type(2)));
#define LDS_WAIT() asm volatile("s_waitcnt lgkmcnt(0)" ::: "memory")

constexpr int CW_BAR = 4096;
#define XB_TMO      128
#define XB_XCNT(j)  (256  + 64 * (j))
#define XB_XSUB(j)  (1280 + 64 * (j))
#define XB_XGEN(j)  (2304 + 64 * (j))
#define XB_TOP      3328
#define XB_TOPGEN   3392
#define XCD_BAR_WORDS 3456
#define XB_SPIN_CAP (1u << 20)
__device__ __forceinline__ unsigned xb_ld(unsigned* p)              { return __hip_atomic_load(p, __ATOMIC_RELAXED, __HIP_MEMORY_SCOPE_AGENT); }
__device__ __forceinline__ unsigned xb_add(unsigned* p, unsigned v) { return __hip_atomic_fetch_add(p, v, __ATOMIC_RELAXED, __HIP_MEMORY_SCOPE_AGENT); }
__device__ __forceinline__ unsigned xb_xcc_id() { return (unsigned)__builtin_amdgcn_s_getreg((3 << 11) | 20) & 0xFu; }
#define XB_SPIN(cond, bar) do { unsigned _sp = 0; while (cond) { __builtin_amdgcn_s_sleep(1); \
    if ((++_sp & 255u) == 0u) { if (xb_ld(&(bar)[XB_TMO])) break; if (_sp > XB_SPIN_CAP) { atomicAdd(&(bar)[XB_TMO], 1u); break; } } } } while (0)
struct XcdBarrier { unsigned* bar; unsigned x; volatile LAS unsigned* st; };
__device__ __forceinline__ XcdBarrier xcd_barrier_post(unsigned* bar, volatile LAS unsigned* st) {
    XcdBarrier b; b.bar = bar; b.x = xb_xcc_id(); b.st = st;
    if (threadIdx.x == 0) (void)xb_add(&bar[XB_XCNT(b.x)], 1u);
    return b;
}
__device__ __forceinline__ void xcd_barrier_complete(unsigned* bar, unsigned x, unsigned& nloc, unsigned& nx) {
    const unsigned G = gridDim.x * gridDim.y * gridDim.z;
    unsigned sum, cnt, mine, sp = 0u;
    for (;;) {
        sum = 0u; cnt = 0u; mine = 0u;
#pragma unroll
        for (unsigned j = 0; j < 16; ++j) { const unsigned c = xb_ld(&bar[XB_XCNT(j)]); sum += c; cnt += (c > 0u) ? 1u : 0u; mine = (j == x) ? c : mine; }
        if (sum == G) break;
        __builtin_amdgcn_s_sleep(1);
        if ((++sp & 255u) == 0u) { if (xb_ld(&bar[XB_TMO])) break; if (sp > XB_SPIN_CAP) { atomicAdd(&bar[XB_TMO], 1u); break; } }
    }
    nloc = mine > 0u ? mine : 1u; nx = cnt > 0u ? cnt : 1u;
}
__device__ __forceinline__ void xcd_barrier(const XcdBarrier& b) {
    asm volatile("s_waitcnt vmcnt(0)" ::: "memory");
    __syncthreads();
    if (threadIdx.x == 0) {
        unsigned* bar = b.bar;
        __builtin_amdgcn_s_waitcnt(0);
        unsigned nloc = b.st[0], nx = b.st[1];
        if (nloc == 0u) { xcd_barrier_complete(bar, b.x, nloc, nx); b.st[0] = nloc; b.st[1] = nx; }
        const unsigned old = xb_add(&bar[XB_XSUB(b.x)], 1u);
        const unsigned gen = old / nloc;
        if (old + 1u == (gen + 1u) * nloc) {
            __builtin_amdgcn_fence(__ATOMIC_RELEASE, "agent");
            asm volatile("s_waitcnt vmcnt(0)" ::: "memory");
            const unsigned og = xb_add(&bar[XB_TOP], 1u);
            const unsigned tg = og / nx;
            if (og + 1u == (tg + 1u) * nx) xb_add(&bar[XB_TOPGEN], 1u);
            else XB_SPIN(xb_ld(&bar[XB_TOPGEN]) == tg, bar);
            __builtin_amdgcn_fence(__ATOMIC_ACQUIRE, "agent");
            xb_add(&bar[XB_XGEN(b.x)], 1u);
            asm volatile("s_waitcnt vmcnt(0)" ::: "memory");
        } else {
            XB_SPIN(xb_ld(&bar[XB_XGEN(b.x)]) == gen, bar);
            __builtin_amdgcn_fence(__ATOMIC_ACQUIRE, "agent");
            asm volatile("s_waitcnt vmcnt(0)" ::: "memory");
        }
    }
    __syncthreads();
}

struct Args { const float* in[28]; float* out; unsigned char* ws; int ph_lo, ph_hi, li, pad; };

__device__ __forceinline__ void p0_transpose_item(const float* W, const float* sc, int K, int N, bf16_t* WT, LAS float* scr, int item, int lane) {
    const int nblk = N / 32, kb = item / nblk, nb = item % nblk, k0 = 64 * kb, n0 = 32 * nb;
#pragma unroll 8
    for (int i = 0; i < 32; ++i) { const int kk = 2 * i + (lane >> 5); const float s = sc ? sc[k0 + kk] : 1.f; scr[kk * 33 + (lane & 31)] = W[(size_t)(k0 + kk) * N + n0 + (lane & 31)] * s; }
    LDS_WAIT(); asm volatile("" ::: "memory");
    const int c = lane & 7;
#pragma unroll
    for (int j = 0; j < 4; ++j) { const int n = (lane >> 3) + 8 * j; const LAS float* s = scr + (8 * c) * 33 + n;
        v4u o; o.x = pg8::cvt_pk_bf16(s[0 * 33], s[1 * 33]); o.y = pg8::cvt_pk_bf16(s[2 * 33], s[3 * 33]); o.z = pg8::cvt_pk_bf16(s[4 * 33], s[5 * 33]); o.w = pg8::cvt_pk_bf16(s[6 * 33], s[7 * 33]);
        *(v4u*)(WT + (size_t)(n0 + n) * K + k0 + 8 * c) = o; }
    LDS_WAIT(); asm volatile("" ::: "memory");
}
__device__ __forceinline__ void p0_convert(const float* in, const float* cs, bf16_t* out, size_t n, int gw, int NGW, int lane) {
    for (size_t i = ((size_t)gw * 64 + lane) * 8; i < n; i += (size_t)NGW * 512) {
        f32x4 a = *(const f32x4*)(in + i), b = *(const f32x4*)(in + i + 4);
        if (cs) { const int c = (int)(i & 1023); a = a * *(const f32x4*)(cs + c); b = b * *(const f32x4*)(cs + c + 4); }
        v4u o; o.x = pg8::cvt_pk_bf16(a[0], a[1]); o.y = pg8::cvt_pk_bf16(a[2], a[3]); o.z = pg8::cvt_pk_bf16(b[0], b[1]); o.w = pg8::cvt_pk_bf16(b[2], b[3]);
        *(v4u*)(out + i) = o;
    }
}

namespace da {
typedef short bf16x8 __attribute__((ext_vector_type(8)));
typedef short s16x4 __attribute__((ext_vector_type(4)));
typedef float f32x16 __attribute__((ext_vector_type(16)));
constexpr float LOG2E = 1.4426950408889634f;
constexpr int SLOT = 32768, SCR_OFF = 65536, COMB_OFF = 69632;
__device__ __forceinline__ int crow(int r, int hi) { return (r & 3) + 8 * (r >> 2) + 4 * hi; }
__device__ __forceinline__ s16x4 vtr(const LAS unsigned char* p) { return __builtin_bit_cast(s16x4, __builtin_amdgcn_ds_read_tr16_b64_v4i16((LAS s16x4*)p)); }

__device__ __forceinline__ void attn_unit(LAS unsigned char* lds, const bf16_t* __restrict__ z, bf16_t* __restrict__ yb, const float* __restrict__ subln_w, float lam,
                                          int b, int h, int qblk, int wave, int lane) {
    const int r32 = lane & 31, hi = lane >> 5, map = wave >> 2, qs = wave & 3;
    const int q0 = qblk * 128 + qs * 32;
    const size_t rowb = (size_t)b * SEQ;
    const float slope2 = exp2f(-2.f * (float)(h + 1)) * LOG2E;
    bf16x8 qr[4];
    {
        const bf16_t* qp = z + (rowb + q0 + r32) * NZ + C_Q + h * 128 + map * 64 + hi * 8;
        constexpr float c2 = 0.125f * LOG2E;
#pragma unroll
        for (int d0 = 0; d0 < 4; ++d0) {
            const v4u w = *(const v4u*)(qp + d0 * 16);
            v4u o; o.x = pg8::cvt_pk_bf16(pg8::bflo(w.x) * c2, pg8::bfhi(w.x) * c2); o.y = pg8::cvt_pk_bf16(pg8::bflo(w.y) * c2, pg8::bfhi(w.y) * c2);
            o.z = pg8::cvt_pk_bf16(pg8::bflo(w.z) * c2, pg8::bfhi(w.z) * c2); o.w = pg8::cvt_pk_bf16(pg8::bflo(w.w) * c2, pg8::bfhi(w.w) * c2);
            qr[d0] = __builtin_bit_cast(bf16x8, o);
        }
    }
    const int qpos = q0 + r32;
    const float qterm = slope2 * (float)(4 * hi - qpos);
    LAS float* wsf = (LAS float*)(lds + SCR_OFF) + wave * 64;
    f32x16 o[4];
#pragma unroll
    for (int d = 0; d < 4; ++d) o[d] = (f32x16){};
    float m = -1e30f, lsum = 0.f;
    const int NT = 2 * qblk + 2;
    const bf16_t* ksrc0 = z + (rowb + lane) * NZ + C_ZK + h * 128 + wave * 8;
    const int pc0 = 2 * wave, pc1 = 2 * wave + 1;
    const bf16_t* vsrc0 = z + (rowb + 16 * (pc0 & 3) + (lane >> 2)) * NZ + C_ZV + h * 128 + 32 * (pc0 >> 2) + (lane & 3) * 8;
    const bf16_t* vsrc1 = z + (rowb + 16 * (pc1 & 3) + (lane >> 2)) * NZ + C_ZV + h * 128 + 32 * (pc1 >> 2) + (lane & 3) * 8;
#define DA_STAGE(j, slot) do { const size_t _o = (size_t)(j) * 64 * NZ; LAS unsigned char* _s = lds + (slot) * SLOT; \
        __builtin_amdgcn_global_load_lds((const unsigned*)(ksrc0 + _o), (LAS unsigned*)(_s + wave * 1024), 16, 0, 0); \
        __builtin_amdgcn_global_load_lds((const unsigned*)(ksrc0 + _o + 64), (LAS unsigned*)(_s + 8192 + wave * 1024), 16, 0, 0); \
        __builtin_amdgcn_global_load_lds((const unsigned*)(vsrc0 + _o), (LAS unsigned*)(_s + 16384 + pc0 * 1024), 16, 0, 0); \
        __builtin_amdgcn_global_load_lds((const unsigned*)(vsrc1 + _o), (LAS unsigned*)(_s + 16384 + pc1 * 1024), 16, 0, 0); } while (0)
    DA_STAGE(0, 0);
    for (int j = 0; j < NT; ++j) {
        asm volatile("s_waitcnt vmcnt(0)" ::: "memory");
        __syncthreads();
        if (j + 1 < NT) DA_STAGE(j + 1, (j + 1) & 1);
        if (64 * j > q0 + 31) continue;
        const LAS unsigned char* slot = lds + (j & 1) * SLOT;
        f32x16 c0, c1;
        {
            const float tb = slope2 * (float)(64 * j) + qterm;
#pragma unroll
            for (int r = 0; r < 16; ++r) { c0[r] = tb + slope2 * (float)((r & 3) + 8 * (r >> 2)); c1[r] = c0[r] + 32.f * slope2; }
        }
        const LAS unsigned char* kb = slot + map * 8192 + hi * 1024 + r32 * 16;
#pragma unroll
        for (int d0 = 0; d0 < 4; ++d0) {
            const bf16x8 k0 = *(const LAS bf16x8*)(kb + d0 * 2048), k1 = *(const LAS bf16x8*)(kb + d0 * 2048 + 512);
            c0 = __builtin_amdgcn_mfma_f32_32x32x16_bf16(k0, qr[d0], c0, 0, 0, 0);
            c1 = __builtin_amdgcn_mfma_f32_32x32x16_bf16(k1, qr[d0], c1, 0, 0, 0);
        }
        if (64 * j + 63 > q0) {
            const int kb0 = 64 * j + 4 * hi;
#pragma unroll
            for (int r = 0; r < 16; ++r) { const int kv = kb0 + (r & 3) + 8 * (r >> 2); if (kv > qpos) c0[r] = -INFINITY; if (kv + 32 > qpos) c1[r] = -INFINITY; }
        }
        float mt = fmaxf(c0[0], c1[0]);
#pragma unroll
        for (int r = 1; r < 16; ++r) mt = fmaxf(mt, fmaxf(c0[r], c1[r]));
        mt = fmaxf(mt, __shfl_xor(mt, 32));
        const float mnew = fmaxf(m, mt);
        if (__any(mnew > m)) {
            const float alpha = __builtin_amdgcn_exp2f(m - mnew);
            lsum *= alpha;
            if (hi == 0) wsf[r32] = alpha;
            float a[16];
#pragma unroll
            for (int g = 0; g < 4; ++g) { const f32x4 t = *(const LAS f32x4*)(wsf + 8 * g + 4 * hi); a[4 * g] = t[0]; a[4 * g + 1] = t[1]; a[4 * g + 2] = t[2]; a[4 * g + 3] = t[3]; }
#pragma unroll
            for (int d = 0; d < 4; ++d)
#pragma unroll
                for (int r = 0; r < 16; ++r) o[d][r] *= a[r];
        }
        m = mnew;
        float ps = 0.f;
#pragma unroll
        for (int r = 0; r < 16; ++r) { c0[r] = __builtin_amdgcn_exp2f(c0[r] - m); c1[r] = __builtin_amdgcn_exp2f(c1[r] - m); ps += c0[r] + c1[r]; }
        lsum += ps;
        v4u pw[4];
#pragma unroll
        for (int g = 0; g < 2; ++g) {
            pw[g].x = pg8::cvt_pk_bf16(c0[8 * g], c0[8 * g + 1]); pw[g].y = pg8::cvt_pk_bf16(c0[8 * g + 2], c0[8 * g + 3]); pw[g].z = pg8::cvt_pk_bf16(c0[8 * g + 4], c0[8 * g + 5]); pw[g].w = pg8::cvt_pk_bf16(c0[8 * g + 6], c0[8 * g + 7]);
            pw[2 + g].x = pg8::cvt_pk_bf16(c1[8 * g], c1[8 * g + 1]); pw[2 + g].y = pg8::cvt_pk_bf16(c1[8 * g + 2], c1[8 * g + 3]); pw[2 + g].z = pg8::cvt_pk_bf16(c1[8 * g + 4], c1[8 * g + 5]); pw[2 + g].w = pg8::cvt_pk_bf16(c1[8 * g + 6], c1[8 * g + 7]);
        }
        const LAS unsigned char* vb = slot + 16384 + ((lane >> 4) & 1) * 32 + (lane & 3) * 8 + (4 * hi + ((lane & 15) >> 2)) * 64;
#pragma unroll
        for (int d = 0; d < 4; ++d)
#pragma unroll
            for (int kg = 0; kg < 4; ++kg) {
                const s16x4 lo = vtr(vb + (d * 4 + kg) * 1024), hh = vtr(vb + (d * 4 + kg) * 1024 + 512);
                const bf16x8 vf = (bf16x8){lo[0], lo[1], lo[2], lo[3], hh[0], hh[1], hh[2], hh[3]};
                o[d] = __builtin_amdgcn_mfma_f32_32x32x16_bf16(__builtin_bit_cast(bf16x8, pw[kg]), vf, o[d], 0, 0, 0);
            }
    }
#undef DA_STAGE
    lsum += __shfl_xor(lsum, 32);
    if (hi == 0) wsf[r32] = 1.f / lsum;
    float il[16];
#pragma unroll
    for (int g = 0; g < 4; ++g) { const f32x4 t = *(const LAS f32x4*)(wsf + 8 * g + 4 * hi); il[4 * g] = t[0]; il[4 * g + 1] = t[1]; il[4 * g + 2] = t[2]; il[4 * g + 3] = t[3]; }
    LAS float* comb = (LAS float*)(lds + COMB_OFF) + qs * 4096;
    if (map == 1) {
#pragma unroll
        for (int d = 0; d < 4; ++d)
#pragma unroll
            for (int r = 0; r < 16; ++r) comb[crow(r, hi) * 128 + 32 * d + r32] = o[d][r] * il[r];
    }
    __syncthreads();
    if (map == 0) {
        float sw[4];
#pragma unroll
        for (int d = 0; d < 4; ++d) sw[d] = subln_w[32 * d + r32] * (1.f - LAM_INIT);
#pragma unroll
        for (int r = 0; r < 16; ++r) {
            float v[4], ss = 0.f;
#pragma unroll
            for (int d = 0; d < 4; ++d) { v[d] = o[d][r] * il[r] - lam * comb[crow(r, hi) * 128 + 32 * d + r32]; ss += v[d] * v[d]; }
            ss += __shfl_xor(ss, 1); ss += __shfl_xor(ss, 2); ss += __shfl_xor(ss, 4); ss += __shfl_xor(ss, 8); ss += __shfl_xor(ss, 16);
            const float rs = rsqrtf(ss * (1.f / 128.f) + SUBLN_EPS);
            bf16_t* op = yb + (rowb + q0 + crow(r, hi)) * 512 + h * 128 + r32;
#pragma unroll
            for (int d = 0; d < 4; ++d) op[32 * d] = f2bf(v[d] * rs * sw[d]);
        }
    }
    __syncthreads();
}
}

namespace rw {
typedef short bf16x8 __attribute__((ext_vector_type(8)));
typedef float f32x2 __attribute__((ext_vector_type(2)));
constexpr int CH = 32, ACT_PITCH = 528;
constexpr int OFF_ACT = 0, OFF_RKV = 16896, OFF_VEC = 41472, OFF_G = 82432, OFF_Y = 90624, OFF_NRM = 98816, OFF_SCL = 99328;
__device__ __forceinline__ float row_allsum(float v) {
    v += __uint_as_float((unsigned)__builtin_amdgcn_update_dpp(0, (int)__float_as_uint(v), 0x128, 0xf, 0xf, false));
    v += __uint_as_float((unsigned)__builtin_amdgcn_update_dpp(0, (int)__float_as_uint(v), 0x124, 0xf, 0xf, false));
    v += __uint_as_float((unsigned)__builtin_amdgcn_update_dpp(0, (int)__float_as_uint(v), 0x122, 0xf, 0xf, false));
    v += __uint_as_float((unsigned)__builtin_amdgcn_update_dpp(0, (int)__float_as_uint(v), 0x121, 0xf, 0xf, false));
    return v;
}
__device__ __forceinline__ f32x4 ld4bf(const bf16_t* p) { const v2u w = *(const v2u*)p; return (f32x4){pg8::bflo(w.x), pg8::bfhi(w.x), pg8::bflo(w.y), pg8::bfhi(w.y)}; }

struct ScanP { const float *mu, *w0, *w2, *a0, *a2, *g2, *k_k, *k_a, *r_k, *lnx_w, *lnx_b; };
__device__ __forceinline__ void scan_unit(LAS unsigned char* lds, const bf16_t* __restrict__ z, bf16_t* __restrict__ ya, const ScanP P, int b, int h, int tid, int wave, int lane) {
    const float* mu = P.mu; const float* w0 = P.w0; const float* w2 = P.w2; const float* a0 = P.a0; const float* a2 = P.a2; const float* g2 = P.g2;
    const float* k_k = P.k_k; const float* k_a = P.k_a; const float* r_k = P.r_k; const float* lnx_w = P.lnx_w; const float* lnx_b = P.lnx_b;
    const size_t rowb = (size_t)b * SEQ;
    const int tl = tid >> 4, cg = tid & 15;
    const int nt = wave & 3, rl = lane & 15, rg = lane >> 4;
    LAS float* rkv = (LAS float*)(lds + OFF_RKV); LAS float* vec = (LAS float*)(lds + OFF_VEC); LAS float* gbuf = (LAS float*)(lds + OFF_G);
    LAS float* ybuf = (LAS float*)(lds + OFF_Y); LAS float* nrm = (LAS float*)(lds + OFF_NRM); LAS float* scl = (LAS float*)(lds + OFF_SCL);
    bf16x8 bfr[4];
    {
        const int col = h * 64 + 16 * nt + rl;
#pragma unroll
        for (int f = 0; f < 4; ++f) {
            const float* src = (wave < 4) ? ((f < 2) ? w2 : a2) : g2;
            const int kb = ((wave < 4) ? 32 * (f & 1) : 32 * f) + 8 * rg;
            float e[8];
#pragma unroll
            for (int j = 0; j < 8; ++j) e[j] = src[(size_t)(kb + j) * 512 + col];
            v4u p; p.x = pg8::cvt_pk_bf16(e[0], e[1]); p.y = pg8::cvt_pk_bf16(e[2], e[3]); p.z = pg8::cvt_pk_bf16(e[4], e[5]); p.w = pg8::cvt_pk_bf16(e[6], e[7]);
            bfr[f] = __builtin_bit_cast(bf16x8, p);
        }
    }
    const int hc = h * 64 + 16 * nt + rl;
    const float w0c = w0[hc], a0c = a0[hc], kkc = k_k[hc], kac = k_a[hc], rkc = r_k[hc];
    f32x4 Sa = (f32x4){0.f, 0.f, 0.f, 0.f}, Sb = (f32x4){0.f, 0.f, 0.f, 0.f};
    const int ra = 8 * wave + 2 * rg;
    for (int t0 = 0; t0 < SEQ; t0 += CH) {
        {
            const bf16_t* zc = z + (rowb + t0 + tl) * NZ; const bf16_t* zp = zc - NZ;
            const bool hp = (t0 + tl) > 0;
            const int c4 = h * 64 + 4 * cg;
            const f32x4 zero4 = (f32x4){0.f, 0.f, 0.f, 0.f};
            f32x4 cr = ld4bf(zc + C_R + c4), ck = ld4bf(zc + C_K + c4), cv = ld4bf(zc + C_V + c4), cw = ld4bf(zc + C_WL + 4 * cg), ca = ld4bf(zc + C_AL + 4 * cg);
            f32x4 cg0 = ld4bf(zc + C_GL + 8 * cg), cg1 = ld4bf(zc + C_GL + 8 * cg + 4);
            f32x4 pr = zero4, pk = zero4, pv = zero4, pw = zero4, pa = zero4, pg0 = zero4, pg1 = zero4;
            if (hp) { pr = ld4bf(zp + C_R + c4); pk = ld4bf(zp + C_K + c4); pv = ld4bf(zp + C_V + c4); pw = ld4bf(zp + C_WL + 4 * cg); pa = ld4bf(zp + C_AL + 4 * cg); pg0 = ld4bf(zp + C_GL + 8 * cg); pg1 = ld4bf(zp + C_GL + 8 * cg + 4); }
            const f32x4 rs_ = cr + (pr - cr) * *(const f32x4*)(mu + C_R + c4), ks_ = ck + (pk - ck) * *(const f32x4*)(mu + C_K + c4), vs_ = cv + (pv - cv) * *(const f32x4*)(mu + C_V + c4);
            const f32x4 ws_ = cw + (pw - cw) * *(const f32x4*)(mu + C_WL + 4 * cg), as_ = ca + (pa - ca) * *(const f32x4*)(mu + C_AL + 4 * cg);
            const f32x4 g0_ = cg0 + (pg0 - cg0) * *(const f32x4*)(mu + C_GL + 8 * cg), g1_ = cg1 + (pg1 - cg1) * *(const f32x4*)(mu + C_GL + 8 * cg + 4);
            *(LAS f32x4*)(rkv + 0 * 2048 + tl * 64 + 4 * cg) = rs_; *(LAS f32x4*)(rkv + 1 * 2048 + tl * 64 + 4 * cg) = ks_; *(LAS f32x4*)(rkv + 2 * 2048 + tl * 64 + 4 * cg) = vs_;
            LAS unsigned char* ar = lds + OFF_ACT + tl * ACT_PITCH;
            v2u tw; tw.x = pg8::cvt_pk_bf16(tanhf(ws_[0]), tanhf(ws_[1])); tw.y = pg8::cvt_pk_bf16(tanhf(ws_[2]), tanhf(ws_[3]));
            *(LAS v2u*)(ar + 8 * cg) = tw;
            v2u aw; aw.x = pg8::cvt_pk_bf16(as_[0], as_[1]); aw.y = pg8::cvt_pk_bf16(as_[2], as_[3]);
            *(LAS v2u*)(ar + 128 + 8 * cg) = aw;
            v4u gw; gw.x = pg8::cvt_pk_bf16(sigmoidf_(g0_[0]), sigmoidf_(g0_[1])); gw.y = pg8::cvt_pk_bf16(sigmoidf_(g0_[2]), sigmoidf_(g0_[3]));
            gw.z = pg8::cvt_pk_bf16(sigmoidf_(g1_[0]), sigmoidf_(g1_[1])); gw.w = pg8::cvt_pk_bf16(sigmoidf_(g1_[2]), sigmoidf_(g1_[3]));
            *(LAS v4u*)(ar + 256 + 16 * cg) = gw;
            if (cg == 0) *(LAS f32x4*)(scl + 4 * tl) = zero4;
        }
        __syncthreads();
        f32x4 acc0[2], acc1[2];
        {
            const LAS unsigned char* ap = lds + OFF_ACT + rl * ACT_PITCH + (((wave < 4) ? 0 : 128) + 8 * rg) * 2;
#pragma unroll
            for (int mt = 0; mt < 2; ++mt) {
                acc0[mt] = (f32x4){0.f, 0.f, 0.f, 0.f}; acc1[mt] = (f32x4){0.f, 0.f, 0.f, 0.f};
#pragma unroll
                for (int f = 0; f < 4; ++f) {
                    const bf16x8 a = *(const LAS bf16x8*)(ap + mt * 16 * ACT_PITCH + f * 64);
                    if (f < 2) acc0[mt] = __builtin_amdgcn_mfma_f32_16x16x32_bf16(a, bfr[f], acc0[mt], 0, 0, 0);
                    else acc1[mt] = __builtin_amdgcn_mfma_f32_16x16x32_bf16(a, bfr[f], acc1[mt], 0, 0, 0);
                }
            }
        }
        float dec[8], av[8], kk[8], ksv[8], rsv[8];
        if (wave >= 4) {
#pragma unroll
            for (int mt = 0; mt < 2; ++mt)
#pragma unroll
                for (int r = 0; r < 4; ++r) gbuf[(16 * mt + 4 * rg + r) * 64 + 16 * nt + rl] = acc0[mt][r] + acc1[mt][r];
        } else {
#pragma unroll
            for (int mt = 0; mt < 2; ++mt)
#pragma unroll
                for (int r = 0; r < 4; ++r) {
                    const int i = mt * 4 + r, tok = 16 * mt + 4 * rg + r, c = 16 * nt + rl;
                    const float nx = -(w0c + acc0[mt][r]);
                    const float sp = nx > 20.f ? nx : log1pf(__expf(nx));
                    dec[i] = __expf(-__expf(-sp - 0.5f));
                    av[i] = sigmoidf_(a0c + acc1[mt][r]);
                    ksv[i] = rkv[1 * 2048 + tok * 64 + c]; rsv[i] = rkv[0 * 2048 + tok * 64 + c];
                    kk[i] = ksv[i] * kkc;
                    const float n2 = row_allsum(kk[i] * kk[i]);
                    if (rl == 0) nrm[tok * 4 + nt] = n2;
                }
        }
        __syncthreads();
        if (wave < 4) {
#pragma unroll
            for (int mt = 0; mt < 2; ++mt)
#pragma unroll
                for (int r = 0; r < 4; ++r) {
                    const int i = mt * 4 + r, tok = 16 * mt + 4 * rg + r, c = 16 * nt + rl;
                    const f32x4 n4 = *(const LAS f32x4*)(nrm + tok * 4);
                    const float inv = 1.f / fmaxf(sqrtf((n4[0] + n4[1]) + (n4[2] + n4[3])), 1e-12f);
                    const float kkn = kk[i] * inv, beta = kkn * av[i], kmod = ksv[i] * (1.f + (av[i] - 1.f) * kac);
                    LAS float* vp = vec + tok * 320 + c;
                    vp[0] = dec[i]; vp[64] = beta; vp[128] = -kkn; vp[192] = kmod; vp[256] = dec[i] * rsv[i];
                    const float pbr = row_allsum(beta * rsv[i]), pkr = row_allsum(kmod * rsv[i]), pbo = row_allsum(rsv[i] * kmod * rkc);
                    if (rl == 0) { __hip_atomic_fetch_add(scl + tok * 4 + 0, pbr, __ATOMIC_RELAXED, __HIP_MEMORY_SCOPE_WORKGROUP); __hip_atomic_fetch_add(scl + tok * 4 + 1, pkr, __ATOMIC_RELAXED, __HIP_MEMORY_SCOPE_WORKGROUP); __hip_atomic_fetch_add(scl + tok * 4 + 2, pbo, __ATOMIC_RELAXED, __HIP_MEMORY_SCOPE_WORKGROUP); }
                }
        }
        __syncthreads();
        for (int tk = 0; tk < CH; ++tk) {
            const LAS float* vb = vec + tk * 320 + 4 * rl;
            const f32x4 d4 = *(const LAS f32x4*)(vb), b4 = *(const LAS f32x4*)(vb + 64), n4 = *(const LAS f32x4*)(vb + 128), k4 = *(const LAS f32x4*)(vb + 192), q4 = *(const LAS f32x4*)(vb + 256);
            const f32x2 v2 = *(const LAS f32x2*)(rkv + 2 * 2048 + tk * 64 + ra);
            const f32x2 s2 = *(const LAS f32x2*)(scl + tk * 4);
            float sa_a = (Sa[0] * n4[0] + Sa[1] * n4[1]) + (Sa[2] * n4[2] + Sa[3] * n4[3]);
            float sa_b = (Sb[0] * n4[0] + Sb[1] * n4[1]) + (Sb[2] * n4[2] + Sb[3] * n4[3]);
            float ya_a = (Sa[0] * q4[0] + Sa[1] * q4[1]) + (Sa[2] * q4[2] + Sa[3] * q4[3]);
            float ya_b = (Sb[0] * q4[0] + Sb[1] * q4[1]) + (Sb[2] * q4[2] + Sb[3] * q4[3]);
            sa_a = row_allsum(sa_a); sa_b = row_allsum(sa_b); ya_a = row_allsum(ya_a); ya_b = row_allsum(ya_b);
            const float y_a = ya_a + sa_a * s2[0] + v2[0] * s2[1], y_b = ya_b + sa_b * s2[0] + v2[1] * s2[1];
            Sa = Sa * d4 + b4 * sa_a + k4 * v2[0];
            Sb = Sb * d4 + b4 * sa_b + k4 * v2[1];
            if (rl == 0) *(LAS f32x2*)(ybuf + tk * 64 + ra) = (f32x2){y_a, y_b};
        }
        __syncthreads();
        {
            const f32x4 y4 = *(const LAS f32x4*)(ybuf + tl * 64 + 4 * cg);
            const float mean = row_allsum((y4[0] + y4[1]) + (y4[2] + y4[3])) * (1.f / 64.f);
            const f32x4 dv = y4 - mean;
            const float var = row_allsum((dv[0] * dv[0] + dv[1] * dv[1]) + (dv[2] * dv[2] + dv[3] * dv[3])) * (1.f / 64.f);
            const float rs_ = rsqrtf(var + GN_EPS);
            const int c4 = h * 64 + 4 * cg;
            const f32x4 yn = dv * rs_ * *(const f32x4*)(lnx_w + c4) + *(const f32x4*)(lnx_b + c4);
            const float bonus = scl[tl * 4 + 2];
            const f32x4 vs_ = *(const LAS f32x4*)(rkv + 2 * 2048 + tl * 64 + 4 * cg), g4 = *(const LAS f32x4*)(gbuf + tl * 64 + 4 * cg);
            const f32x4 o = (yn + vs_ * bonus) * g4;
            v2u w; w.x = pg8::cvt_pk_bf16(o[0], o[1]); w.y = pg8::cvt_pk_bf16(o[2], o[3]);
            *(v2u*)(ya + (rowb + t0 + tl) * 512 + c4) = w;
        }
        __syncthreads();
    }
}
}

typedef __bf16 bf16x2_t __attribute__((ext_vector_type(2)));
__device__ __forceinline__ float dot2bf(unsigned a, unsigned b, float c) { return __builtin_amdgcn_fdot2_f32_bf16(__builtin_bit_cast(bf16x2_t, a), __builtin_bit_cast(bf16x2_t, b), c, false); }
__device__ __forceinline__ unsigned f2ord(float f) { const unsigned u = __float_as_uint(f); return (u & 0x80000000u) ? ~u : (u | 0x80000000u); }
__device__ __forceinline__ float ord2f(unsigned o) { return __uint_as_float((o & 0x80000000u) ? (o ^ 0x80000000u) : ~o); }
__device__ __forceinline__ unsigned row_allmax_u32(unsigned v) {
    v = max(v, (unsigned)__builtin_amdgcn_update_dpp(0, (int)v, 0x128, 0xf, 0xf, false));
    v = max(v, (unsigned)__builtin_amdgcn_update_dpp(0, (int)v, 0x124, 0xf, 0xf, false));
    v = max(v, (unsigned)__builtin_amdgcn_update_dpp(0, (int)v, 0x122, 0xf, 0xf, false));
    v = max(v, (unsigned)__builtin_amdgcn_update_dpp(0, (int)v, 0x121, 0xf, 0xf, false));
    return v;
}

__device__ __forceinline__ void topk_item(const bf16_t* __restrict__ qb, const bf16_t* __restrict__ KeysB, int* __restrict__ ids, float* __restrict__ gates, int t0, int h, int lane) {
    typedef short bf16x8 __attribute__((ext_vector_type(8)));
    const int rl = lane & 15, rg = lane >> 4;
    unsigned top[2][4];
#pragma unroll
    for (int c = 0; c < 2; ++c) {
        f32x4 acc[8];
#pragma unroll
        for (int nt = 0; nt < 8; ++nt) acc[nt] = (f32x4){0.f, 0.f, 0.f, 0.f};
        const bf16_t* qp = qb + (size_t)(t0 + rl) * 2048 + h * 256 + c * 128 + 8 * rg;
        const bf16_t* kp = KeysB + ((size_t)(h * 2 + c) * 128 + rl) * 128 + 8 * rg;
#pragma unroll
        for (int ks = 0; ks < 4; ++ks) {
            const bf16x8 a = *(const bf16x8*)(qp + ks * 32);
#pragma unroll
            for (int nt = 0; nt < 8; ++nt) { const bf16x8 b = *(const bf16x8*)(kp + nt * 16 * 128 + ks * 32); acc[nt] = __builtin_amdgcn_mfma_f32_16x16x32_bf16(a, b, acc[nt], 0, 0, 0); }
        }
        unsigned key[4][8];
#pragma unroll
        for (int r = 0; r < 4; ++r)
#pragma unroll
            for (int nt = 0; nt < 8; ++nt) key[r][nt] = (f2ord(acc[nt][r]) & ~127u) | (unsigned)(127 - (nt * 16 + rl));
#pragma unroll
        for (int r = 0; r < 4; ++r) top[c][r] = 0u;
        for (int round = 0; round < 16; ++round) {
#pragma unroll
            for (int r = 0; r < 4; ++r) {
                unsigned lm = max(max(max(key[r][0], key[r][1]), max(key[r][2], key[r][3])), max(max(key[r][4], key[r][5]), max(key[r][6], key[r][7])));
                const unsigned m = row_allmax_u32(lm);
                top[c][r] = (rl == round) ? m : top[c][r];
#pragma unroll
                for (int nt = 0; nt < 8; ++nt) key[r][nt] = (key[r][nt] == m) ? 0u : key[r][nt];
            }
        }
    }
    const int rowbase = lane & 48;
#pragma unroll
    for (int r = 0; r < 4; ++r) {
        const int t = t0 + 4 * rg + r;
        const float v1 = ord2f(top[0][r] & ~127u); const int n1 = 127 - (int)(top[0][r] & 127u);
        int ptr = 0; unsigned k2 = (unsigned)__builtin_amdgcn_ds_bpermute((rowbase + 0) * 4, (int)top[1][r]);
        float v0 = 0.f, sum = 0.f, mye = 0.f;
        for (int round = 0; round < 16; ++round) {
            const float head = v1 + ord2f(k2 & ~127u);
            const unsigned key = (ptr < 16) ? ((f2ord(head) & ~15u) | (unsigned)(15 - rl)) : 0u;
            const unsigned m = row_allmax_u32(key);
            const float val = ord2f(m & ~15u);
            if (round == 0) v0 = val;
            const float e = __expf(val - v0); sum += e;
            mye = (rl == round) ? e : mye;
            const bool win = (key == m);
            if (win) ids[(size_t)t * 128 + h * 16 + round] = n1 * 128 + (127 - (int)(k2 & 127u));
            ptr += win ? 1 : 0;
            k2 = (unsigned)__builtin_amdgcn_ds_bpermute((rowbase + (ptr & 15)) * 4, (int)top[1][r]);
        }
        gates[(size_t)t * 128 + h * 16 + rl] = mye / sum;
    }
}

__device__ __forceinline__ void peer_token(const bf16_t* __restrict__ x2b, const float* __restrict__ ssq2, const int* __restrict__ ids, const float* __restrict__ gates,
                                           const bf16_t* __restrict__ Ub, const bf16_t* __restrict__ Vb, const float* __restrict__ fw, float* __restrict__ out, int t, int lane) {
    const int l8 = lane * 8;
    const v4u h0 = *(const v4u*)(x2b + (size_t)t * DM + l8), h1 = *(const v4u*)(x2b + (size_t)t * DM + 512 + l8);
    const int idA = ids[(size_t)t * 128 + lane], idB = ids[(size_t)t * 128 + 64 + lane];
    const float gA = gates[(size_t)t * 128 + lane], gB = gates[(size_t)t * 128 + 64 + lane];
    const float rs = rsqrtf(ssq2[t] * (1.f / DM) + NORM_EPS);
    float y[16];
#pragma unroll
    for (int i = 0; i < 16; ++i) y[i] = 0.f;
    const int bit0 = lane & 1, bit1 = (lane >> 1) & 1, bit2 = (lane >> 2) & 1;
    const int myk = 4 * bit0 + 2 * bit1 + bit2;
    for (int g = 0; g < 16; ++g) {
        const int idsel = (g < 8) ? idA : idB; const float gsel = (g < 8) ? gA : gB; const int lb = (g * 8) & 63;
        v4u u0[8], u1[8], w0[8], w1[8];
#pragma unroll
        for (int k = 0; k < 8; ++k) { const int e = __builtin_amdgcn_readlane(idsel, lb + k); const bf16_t* up = Ub + (size_t)e * DM + l8; u0[k] = *(const v4u*)up; u1[k] = *(const v4u*)(up + 512);
            const bf16_t* vp = Vb + (size_t)e * DM + l8; w0[k] = *(const v4u*)vp; w1[k] = *(const v4u*)(vp + 512); }
        float d[8];
#pragma unroll
        for (int k = 0; k < 8; ++k) {
            float a = dot2bf(u0[k].x, h0.x, 0.f), b = dot2bf(u0[k].y, h0.y, 0.f);
            a = dot2bf(u0[k].z, h0.z, a); b = dot2bf(u0[k].w, h0.w, b);
            a = dot2bf(u1[k].x, h1.x, a); b = dot2bf(u1[k].y, h1.y, b);
            a = dot2bf(u1[k].z, h1.z, a); b = dot2bf(u1[k].w, h1.w, b);
            d[k] = a + b;
        }
        float r4[4];
#pragma unroll
        for (int k = 0; k < 4; ++k) { const float send = bit0 ? d[k] : d[k + 4], keep = bit0 ? d[k + 4] : d[k]; r4[k] = keep + __shfl_xor(send, 1); }
        float r2[2];
#pragma unroll
        for (int k = 0; k < 2; ++k) { const float send = bit1 ? r4[k] : r4[k + 2], keep = bit1 ? r4[k + 2] : r4[k]; r2[k] = keep + __shfl_xor(send, 2); }
        float r1;
        { const float send = bit2 ? r2[0] : r2[1], keep = bit2 ? r2[1] : r2[0]; r1 = keep + __shfl_xor(send, 4); }
        r1 += __shfl_xor(r1, 8); r1 += __shfl_xor(r1, 16); r1 += __shfl_xor(r1, 32);
        const float dd = r1 * rs;
        const float gt = __shfl(gsel, lb + myk);
        const float act = 0.5f * dd * (1.f + erff(dd * 0.70710678118654752f)) * gt;
#pragma unroll
        for (int k = 0; k < 8; ++k) {
            const float a = __uint_as_float((unsigned)__builtin_amdgcn_readlane((int)__float_as_uint(act), ((k & 1) << 2) | (k & 2) | ((k >> 2) & 1)));
            const unsigned ww[8] = {w0[k].x, w0[k].y, w0[k].z, w0[k].w, w1[k].x, w1[k].y, w1[k].z, w1[k].w};
#pragma unroll
            for (int i = 0; i < 8; ++i) { y[2 * i] += a * __uint_as_float(ww[i] << 16); y[2 * i + 1] += a * __uint_as_float(ww[i] & 0xffff0000u); }
        }
    }
    float* orow = out + (size_t)t * DM + l8;
    const f32x4 xa = *(const f32x4*)orow, xb_ = *(const f32x4*)(orow + 4), xc = *(const f32x4*)(orow + 512), xd = *(const f32x4*)(orow + 516);
#pragma unroll
    for (int i = 0; i < 4; ++i) { y[i] += xa[i]; y[4 + i] += xb_[i]; y[8 + i] += xc[i]; y[12 + i] += xd[i]; }
    float ss = 0.f;
#pragma unroll
    for (int i = 0; i < 16; ++i) ss += y[i] * y[i];
    ss = wave_sum(ss);
    const float r = rsqrtf(ss * (1.f / DM) + NORM_EPS);
    const f32x4 fa = *(const f32x4*)(fw + l8), fb = *(const f32x4*)(fw + l8 + 4), fc = *(const f32x4*)(fw + 512 + l8), fd = *(const f32x4*)(fw + 516 + l8);
    f32x4 oa, ob, oc, od;
#pragma unroll
    for (int i = 0; i < 4; ++i) { oa[i] = y[i] * r * fa[i]; ob[i] = y[4 + i] * r * fb[i]; oc[i] = y[8 + i] * r * fc[i]; od[i] = y[12 + i] * r * fd[i]; }
    *(f32x4*)orow = oa; *(f32x4*)(orow + 4) = ob; *(f32x4*)(orow + 512) = oc; *(f32x4*)(orow + 516) = od;
}

__global__ void __launch_bounds__(NWAVES * 64, 2) mk_fwd(Args args) {
    extern __shared__ __attribute__((aligned(16))) unsigned char lds_raw[];
    LAS unsigned char* lds = (LAS unsigned char*)lds_raw;
    volatile LAS unsigned* MISC = (volatile LAS unsigned*)(lds + MISC_OFF);
    const int tid = threadIdx.x, lane = tid & 63, wave = __builtin_amdgcn_readfirstlane(tid >> 6);
    const int G = gridDim.x; const int bx = blockIdx.x; const int vcu = (G % 8 == 0) ? (bx % 8) * (G / 8) + bx / 8 : bx;
    unsigned char* ws = args.ws;
    unsigned* ctl = (unsigned*)(ws + WS_CTL);
    for (int u = tid; u < (LDS_BYTES - LDSCTL_OFF) / 4; u += NWAVES * 64) ((LAS unsigned*)(lds + LDSCTL_OFF))[u] = 0u;
    __syncthreads();
    XcdBarrier bar = xcd_barrier_post(ctl + CW_BAR + args.li * XCD_BAR_WORDS, MISC + 8);
    const int lo = args.ph_lo, hi = args.ph_hi;
#define IN(k) (lo <= (k) && (k) < hi)
#define BOTH(k) (IN(k) && IN((k) + 1))
    bf16_t* WinT = (bf16_t*)(ws + WS_WIN); bf16_t* PaT = (bf16_t*)(ws + WS_PA); bf16_t* PbT = (bf16_t*)(ws + WS_PB); bf16_t* WoT = (bf16_t*)(ws + WS_WO);
    bf16_t* WqT = (bf16_t*)(ws + WS_WQ); bf16_t* KeysB = (bf16_t*)(ws + WS_KEYS);
    float* rstd1 = (float*)(ws + WS_RSTD1); float* ssq2 = (float*)(ws + WS_RSTD2); float* scal = (float*)(ws + WS_SCAL);
    bf16_t* Ub = (bf16_t*)(ws + WS_U); bf16_t* Vb = (bf16_t*)(ws + WS_V);
    bf16_t* xb = (bf16_t*)(ws + WS_XB); bf16_t* ya = (bf16_t*)(ws + WS_YA); bf16_t* yb = (bf16_t*)(ws + WS_YB); bf16_t* x2b = (bf16_t*)(ws + WS_X2B);
    bf16_t* z = (bf16_t*)(ws + WS_Z); bf16_t* qb = (bf16_t*)(ws + WS_Q);
    bf16_t* merged = (bf16_t*)(ws + WS_MERGED);
    const int gw = vcu * NWAVES + wave, NGW = G * NWAVES;

    if (IN(0)) {
        LAS float* scr = (LAS float*)(lds + wave * 16384);
        constexpr int I_IN = (DM / 64) * (NZ / 32), I_PA = (512 / 64) * (DM / 32), I_WO = (DM / 64) * (DM / 32), I_WQ = (DM / 64) * (2048 / 32);
        constexpr int NITEMS = I_IN + 2 * I_PA + I_WO + I_WQ;
        for (int it = gw; it < NITEMS; it += NGW) {
            int r = it;
            if (r < I_IN) { p0_transpose_item(args.in[2], args.in[1], DM, NZ, WinT, scr, r, lane); continue; } r -= I_IN;
            if (r < I_PA) { p0_transpose_item(args.in[19], nullptr, 512, DM, PaT, scr, r, lane); continue; } r -= I_PA;
            if (r < I_PA) { p0_transpose_item(args.in[20], nullptr, 512, DM, PbT, scr, r, lane); continue; } r -= I_PA;
            if (r < I_WO) { p0_transpose_item(args.in[21], nullptr, DM, DM, WoT, scr, r, lane); continue; } r -= I_WO;
            p0_transpose_item(args.in[23], args.in[22], DM, 2048, WqT, scr, r, lane);
        }
        p0_convert(args.in[24], nullptr, KeysB, (size_t)16 * 128 * 128, gw, NGW, lane);
        p0_convert(args.in[25], args.in[22], Ub, (size_t)NEXP * DM, gw, NGW, lane);
        p0_convert(args.in[26], nullptr, Vb, (size_t)NEXP * DM, gw, NGW, lane);
        for (int m = gw; m < T_TOK; m += NGW) {
            const f32x4* xr = (const f32x4*)(args.in[0] + (size_t)m * DM) + lane;
            f32x4 v[4]; float s = 0.f;
#pragma unroll
            for (int j = 0; j < 4; ++j) { v[j] = xr[64 * j]; s += (v[j][0] * v[j][0] + v[j][1] * v[j][1]) + (v[j][2] * v[j][2] + v[j][3] * v[j][3]); }
            s = wave_sum(s);
            v2u* o8 = (v2u*)(xb + (size_t)m * DM) + lane;
#pragma unroll
            for (int j = 0; j < 4; ++j) { v2u w; w.x = pg8::cvt_pk_bf16(v[j][0], v[j][1]); w.y = pg8::cvt_pk_bf16(v[j][2], v[j][3]); o8[64 * j] = w; }
            if (lane == 0) { rstd1[m] = rsqrtf(s * (1.f / DM) + NORM_EPS); ssq2[m] = 0.f; }
        }
        if (gw == 0) {
            const float a = wave_sum(args.in[14][lane] * args.in[15][lane]), b = wave_sum(args.in[16][lane] * args.in[17][lane]);
            if (lane == 0) scal[0] = __expf(a) - __expf(b) + LAM_INIT;
        }
        if (BOTH(0)) xcd_barrier(bar);
    }
    if (IN(1)) {
        pg8::Gemm g{xb, WinT, DM, DM, DM}; pg8::StaticOrder S; S.init(T_TOK, NZ, G, bx);
        pg8::EpiRowScale<false> E{z, NZ, rstd1};
        pg8::gemm_phase(lds, g, S, E);
        if (BOTH(1)) xcd_barrier(bar);
    }
    if (IN(2)) {
        {
            const rw::ScanP P{args.in[3], args.in[4], args.in[5], args.in[6], args.in[7], args.in[8], args.in[9], args.in[10], args.in[11], args.in[12], args.in[13]};
            for (int u = vcu; u < NB * 8; u += G) rw::scan_unit(lds, z, ya, P, u >> 3, u & 7, tid, wave, lane);
        }
        const float lam = scal[0];
        for (int i = 0;; ++i) {
            const int idx = vcu + i * G; if (idx >= 2048) break;
            const int slot = idx >> 8, v = idx & 255, bh = v >> 1, a = (v & 1) * 4 + (slot >> 1), qblk = (slot & 1) ? 15 - a : a;
            da::attn_unit(lds, z, yb, args.in[18], lam, bh >> 2, bh & 3, qblk, wave, lane);
        }
        if (BOTH(2)) xcd_barrier(bar);
    }
    if (IN(3)) {
        pg8::Gemm g{ya, PaT, 512, 512, 512}; pg8::StaticOrder S; S.init(T_TOK, DM, G, bx);
        pg8::EpiGate<false> E{merged, z, C_GA};
        pg8::gemm_phase(lds, g, S, E);
        if (BOTH(3)) xcd_barrier(bar);
    }
    if (IN(4)) {
        pg8::Gemm g{yb, PbT, 512, 512, 512}; pg8::StaticOrder S; S.init(T_TOK, DM, G, bx);
        pg8::EpiGate<true> E{merged, z, C_GB};
        pg8::gemm_phase(lds, g, S, E);
        if (BOTH(4)) xcd_barrier(bar);
    }
    if (IN(5)) {
        pg8::Gemm g{merged, WoT, DM, DM, DM}; pg8::StaticOrder S; S.init(T_TOK, DM, G, bx);
        pg8::EpiX2 E{args.in[0], args.out, x2b, ssq2};
        pg8::gemm_phase(lds, g, S, E);
        if (BOTH(5)) xcd_barrier(bar);
    }
    if (IN(6)) {
        pg8::Gemm g{x2b, WqT, DM, DM, DM}; pg8::StaticOrder S; S.init(T_TOK, 2048, G, bx);
        pg8::EpiRowScale<true> E{qb, 2048, ssq2};
        pg8::gemm_phase(lds, g, S, E);
        if (BOTH(6)) xcd_barrier(bar);
    }
    if (IN(7)) {
        int* ids = (int*)(ws + WS_IDS); float* gates = (float*)(ws + WS_GATES);
        for (int it = gw; it < (T_TOK / 16) * 8; it += NGW) topk_item(qb, KeysB, ids, gates, (it & 4095) * 16, it >> 12, lane);
        if (BOTH(7)) xcd_barrier(bar);
    }
    if (IN(8)) {
        const int* ids = (const int*)(ws + WS_IDS); const float* gates = (const float*)(ws + WS_GATES);
        for (int t = gw; t < T_TOK; t += NGW) peer_token(x2b, ssq2, ids, gates, Ub, Vb, args.in[27], args.out, t, lane);
    }
#undef IN
#undef BOTH
}

extern "C" void kernel_launch(void* const* d_in, const int* in_sizes, int n_in, void* d_out, int out_size, void* d_ws, size_t ws_size, hipStream_t stream) {
    static int grid = 0;
    if (grid == 0) {
        if (n_in != 28 || in_sizes[0] != T_TOK * DM || out_size != T_TOK * DM || ws_size < WS_END) {
            fprintf(stderr, "kernel_launch: unexpected shapes / workspace (n_in %d, ws %zu < %zu)\n", n_in, ws_size, (size_t)WS_END); grid = -1; return; }
        int dev = 0, cus = 0;
        if (hipGetDevice(&dev) != hipSuccess || hipDeviceGetAttribute(&cus, hipDeviceAttributeMultiprocessorCount, dev) != hipSuccess) { grid = -1; return; }
        if (hipFuncSetAttribute((const void*)mk_fwd, hipFuncAttributeMaxDynamicSharedMemorySize, LDS_BYTES) != hipSuccess) { fprintf(stderr, "kernel_launch: hipFuncSetAttribute failed\n"); grid = -1; return; }
        grid = cus;
    }
    if (grid < 0) return;
    unsigned char* ws = (unsigned char*)d_ws;
    float* out = (float*)d_out;
    (void)hipMemsetAsync(ws + WS_CTL, 0, 1 * MiB, stream);
    Args a{};
    for (int i = 0; i < 28; ++i) a.in[i] = (const float*)d_in[i];
    a.out = out; a.ws = ws;
    a.ph_lo = 0; a.ph_hi = 9; a.li = 0;
    hipLaunchKernelGGL(mk_fwd, dim3(grid), dim3(NWAVES * 64), LDS_BYTES, stream, a);
}
```

```cpp
#include <hip/hip_runtime.h>
#include <stdint.h>
#include <cstdio>

typedef unsigned short bf16_t;
typedef unsigned int u32;

#ifndef PROBE_REP
#define PROBE_REP 0
#endif
#define REPS(k) (((PROBE_REP >> (k)) & 1) ? 2 : 1)
constexpr int T_TOK = 65536, DM = 1024, SEQ = 2048, NB = 32;
constexpr int NZ = 5376;
constexpr int C_R = 0, C_K = 512, C_V = 1024, C_WL = 1536, C_AL = 1600, C_GL = 1664, C_Q = 1792, C_ZK = 2304, C_ZV = 2816, C_GA = 3328, C_GB = 4352;
constexpr int NEXP = 16384;
constexpr float NORM_EPS = 1e-6f, GN_EPS = 64e-5f, SUBLN_EPS = 1e-5f;
constexpr float LAM_INIT = 0.2f;

constexpr size_t MiB = 1u << 20;
constexpr size_t WS_CTL = 0;
constexpr size_t WS_WIN = 1 * MiB;
constexpr size_t WS_PA = 12 * MiB;
constexpr size_t WS_PB = 13 * MiB;
constexpr size_t WS_WO = 14 * MiB;
constexpr size_t WS_WQ = 16 * MiB;
constexpr size_t WS_KEYS = 20 * MiB;
constexpr size_t WS_RSTD1 = 21 * MiB;
constexpr size_t WS_RSTD2 = 22 * MiB;
constexpr size_t WS_SCAL = 23 * MiB;
constexpr size_t WS_U = 24 * MiB;
constexpr size_t WS_V = 40 * MiB;
constexpr size_t WS_USC = 56 * MiB;
constexpr size_t WS_VSC = 57 * MiB;
constexpr size_t WS_XB = 88 * MiB;
constexpr size_t WS_YA = WS_XB;
constexpr size_t WS_YB = WS_XB + 64 * MiB;
constexpr size_t WS_X2B = WS_XB;
constexpr size_t WS_Z = 216 * MiB;
constexpr size_t WS_Q = WS_Z;
constexpr size_t WS_IDS = WS_Z + 256 * MiB;
constexpr size_t WS_GATES = WS_Z + 288 * MiB;
constexpr size_t WS_MERGED = 888 * MiB;
constexpr size_t WS_END = 1016 * MiB;

__device__ __forceinline__ float bf2f(bf16_t h) { return __uint_as_float(((u32)h) << 16); }
__device__ __forceinline__ bf16_t f2bf(float f) { u32 u = __float_as_uint(f); u += 0x7fffu + ((u >> 16) & 1u); return (bf16_t)(u >> 16); }
__device__ __forceinline__ float wave_sum(float v) {
#pragma unroll
    for (int o = 1; o < 64; o <<= 1) v += __shfl_xor(v, o);
    return v;
}
__device__ __forceinline__ float sigmoidf_(float x) { return 1.f / (1.f + __expf(-x)); }

namespace pg8 {
#define PG8_LAS __attribute__((address_space(3)))
typedef short bf16x8 __attribute__((ext_vector_type(8)));
typedef float f32x4 __attribute__((ext_vector_type(4)));
typedef unsigned u32x4 __attribute__((ext_vector_type(4)));
constexpr int BM = 256, BK = 64, HALF = 128, HTB = HALF * BK * 2  , STAGE_BYTES = 8 * HTB, NXCD = 8, WGM = 8;

__host__ __device__ __forceinline__ int lds_byte(int r, int c) { const int st = (r >> 4) * 2 + (c >> 5), rr = r & 15, cc = c & 31, ob = rr * 64 + cc * 2; return st * 1024 + (ob ^ (((ob >> 9) & 1) << 5)); }
__host__ __device__ __forceinline__ void stage_rc(int b, int& R, int& C) { const int st = b / 1024, sb = b % 1024, swz = sb ^ (((sb >> 9) & 1) << 5); R = (st >> 1) * 16 + swz / 64; C = (st & 1) * 32 + (swz % 64) / 2; }
__host__ __device__ __forceinline__ int perm32(int rho) { const int n = rho >> 4, i = rho & 15; return 8 * (i >> 2) + 4 * n + (i & 3); }

struct Unit { int pm, pn; };
struct Gemm { const bf16_t* A; const bf16_t* Bt; int lda, ldb, K; };

struct StaticOrder {
    int nM, nN, nwg, G, c;
    __host__ __device__ void init(int M, int N, int G_, int c_) { nM = M / BM; nN = N / BM; nwg = nM * nN; G = G_; c = c_; }
    __host__ __device__ bool next(int i, Unit& u) const {
        const long L = (long)i * G + c; if (L >= nwg) return false;
        int wgid = (int)L; { const int q = nwg / NXCD, r = nwg % NXCD, xcd = wgid % NXCD, off = wgid / NXCD; wgid = (xcd < r ? xcd * (q + 1) : r * (q + 1) + (xcd - r) * q) + off; }
        const int nig = WGM * nN, gid = wgid / nig, fm = gid * WGM, gsz = (nM - fm) < WGM ? (nM - fm) : WGM;
        u.pm = fm + ((wgid % nig) % gsz); u.pn = (wgid % nig) / gsz; return true;
    }
};
__device__ __forceinline__ unsigned cvt_pk_bf16(float lo, float hi) { unsigned r; asm volatile("v_cvt_pk_bf16_f32 %0, %1, %2" : "=v"(r) : "v"(lo), "v"(hi)); return r; }
__device__ __forceinline__ float bflo(unsigned w) { return __uint_as_float(w << 16); }
__device__ __forceinline__ float bfhi(unsigned w) { return __uint_as_float(w & 0xffff0000u); }

template <bool SSQ> struct EpiRowScale {
    static constexpr bool PERM = true;
    bf16_t* O; int ldc; const float* rs;
    __device__ __forceinline__ void operator()(const f32x4 (&acc)[2][2][4][2], const Unit& u, int wr, int wc, int fr, int fq) const {
        const int row0 = u.pm * BM + wr * 64 + fr, col0 = u.pn * BM + wc * 32 + 8 * fq;
#pragma unroll
        for (int ai = 0; ai < 2; ++ai)
#pragma unroll
            for (int m = 0; m < 4; ++m) {
                const int row = row0 + ai * HALF + m * 16;
                float s = rs[row]; if (SSQ) s = rsqrtf(s * (1.f / 1024.f) + NORM_EPS);
                bf16_t* rowp = O + (size_t)row * ldc + col0;
#pragma unroll
                for (int bj = 0; bj < 2; ++bj) {
                    const f32x4 v0 = acc[ai][bj][m][0] * s, v1 = acc[ai][bj][m][1] * s;
                    u32x4 w; w.x = cvt_pk_bf16(v0[0], v0[1]); w.y = cvt_pk_bf16(v0[2], v0[3]); w.z = cvt_pk_bf16(v1[0], v1[1]); w.w = cvt_pk_bf16(v1[2], v1[3]);
                    *(u32x4*)(rowp + bj * HALF) = w;
                }
            }
    }
};
template <bool ACCUM> struct EpiGate {
    static constexpr bool PERM = true;
    bf16_t* mg; const bf16_t* z; int gcol;
    __device__ __forceinline__ void operator()(const f32x4 (&acc)[2][2][4][2], const Unit& u, int wr, int wc, int fr, int fq) const {
        const int row0 = u.pm * BM + wr * 64 + fr, col0 = u.pn * BM + wc * 32 + 8 * fq;
#pragma unroll
        for (int ai = 0; ai < 2; ++ai)
#pragma unroll
            for (int m = 0; m < 4; ++m) {
                const int row = row0 + ai * HALF + m * 16;
                const bf16_t* gp = z + (size_t)row * NZ + gcol + col0;
                bf16_t* rowp = mg + (size_t)row * DM + col0;
#pragma unroll
                for (int bj = 0; bj < 2; ++bj) {
                    const u32x4 g = *(const u32x4*)(gp + bj * HALF);
                    const f32x4 a0 = acc[ai][bj][m][0], a1 = acc[ai][bj][m][1];
                    float r[8];
                    r[0] = sigmoidf_(bflo(g.x)) * a0[0]; r[1] = sigmoidf_(bfhi(g.x)) * a0[1]; r[2] = sigmoidf_(bflo(g.y)) * a0[2]; r[3] = sigmoidf_(bfhi(g.y)) * a0[3];
                    r[4] = sigmoidf_(bflo(g.z)) * a1[0]; r[5] = sigmoidf_(bfhi(g.z)) * a1[1]; r[6] = sigmoidf_(bflo(g.w)) * a1[2]; r[7] = sigmoidf_(bfhi(g.w)) * a1[3];
                    if (ACCUM) { const u32x4 o = *(const u32x4*)(rowp + bj * HALF);
                        r[0] += bflo(o.x); r[1] += bfhi(o.x); r[2] += bflo(o.y); r[3] += bfhi(o.y); r[4] += bflo(o.z); r[5] += bfhi(o.z); r[6] += bflo(o.w); r[7] += bfhi(o.w); }
                    u32x4 w; w.x = cvt_pk_bf16(r[0], r[1]); w.y = cvt_pk_bf16(r[2], r[3]); w.z = cvt_pk_bf16(r[4], r[5]); w.w = cvt_pk_bf16(r[6], r[7]);
                    *(u32x4*)(rowp + bj * HALF) = w;
                }
            }
    }
};
struct EpiX2 {
    static constexpr bool PERM = true;
    const float* x; float* x2; bf16_t* x2b; float* ssq;
    __device__ __forceinline__ void operator()(const f32x4 (&acc)[2][2][4][2], const Unit& u, int wr, int wc, int fr, int fq) const {
        const int row0 = u.pm * BM + wr * 64 + fr, col0 = u.pn * BM + wc * 32 + 8 * fq;
#pragma unroll
        for (int ai = 0; ai < 2; ++ai)
#pragma unroll
            for (int m = 0; m < 4; ++m) {
                const int row = row0 + ai * HALF + m * 16;
                const size_t off = (size_t)row * DM + col0;
                float ss = 0.f;
#pragma unroll
                for (int bj = 0; bj < 2; ++bj) {
                    const f32x4 x0 = *(const f32x4*)(x + off + bj * HALF), x1 = *(const f32x4*)(x + off + bj * HALF + 4);
                    const f32x4 o0 = x0 + acc[ai][bj][m][0], o1 = x1 + acc[ai][bj][m][1];
                    *(f32x4*)(x2 + off + bj * HALF) = o0; *(f32x4*)(x2 + off + bj * HALF + 4) = o1;
                    u32x4 w; w.x = cvt_pk_bf16(o0[0], o0[1]); w.y = cvt_pk_bf16(o0[2], o0[3]); w.z = cvt_pk_bf16(o1[0], o1[1]); w.w = cvt_pk_bf16(o1[2], o1[3]);
                    *(u32x4*)(x2b + off + bj * HALF) = w;
                    ss += (o0[0] * o0[0] + o0[1] * o0[1]) + (o0[2] * o0[2] + o0[3] * o0[3]) + (o1[0] * o1[0] + o1[1] * o1[1]) + (o1[2] * o1[2] + o1[3] * o1[3]);
                }
                ss += __shfl_xor(ss, 16); ss += __shfl_xor(ss, 32);
                if (fq == 0) atomicAdd(ssq + row, ss);
            }
    }
};

template <class Epi, class Sched>
__device__ __forceinline__ void gemm_phase(PG8_LAS unsigned char* lds, const Gemm g, const Sched& S, const Epi& E) {
    const int tid = threadIdx.x, wid = __builtin_amdgcn_readfirstlane(tid >> 6), lane = tid & 63, wr = wid >> 2, wc = wid & 3, fr = lane & 15, fq = lane >> 4;
    const int K = g.K, nt = K / BK;
    unsigned voffA[2], voffB[2];
#pragma unroll
    for (int i = 0; i < 2; ++i) { int R, C; stage_rc(tid * 16 + i * 8192, R, C); const int Rb = Epi::PERM ? ((R & ~31) + perm32(R & 31)) : R;
        voffA[i] = (unsigned)(R * g.lda + C) * 2u; voffB[i] = (unsigned)(Rb * g.ldb + C) * 2u; }
    const size_t kstep = (size_t)(BK * 2);
    const size_t hstepA = (size_t)HALF * g.lda * 2, hstepB = (size_t)HALF * g.ldb * 2;
    const size_t tstepA = 2 * hstepA, tstepB = 2 * hstepB;
    const unsigned ldsw = (unsigned)wid * 1024u;
    const int aoff = lds_byte(wr * 64 + fr, fq * 8), boff = lds_byte(wc * 32 + fr, fq * 8);
#define PG8_SA(b, h) (((b) * 2 + (h)) * HTB)
#define PG8_SB(b, h) ((4 + (b) * 2 + (h)) * HTB)
#define PG8_STAGE(bufoff, gbase, voff) do { _Pragma("unroll") for (int _i = 0; _i < 2; ++_i) \
        __builtin_amdgcn_global_load_lds((const unsigned*)((const char*)(gbase) + (voff)[_i]), (PG8_LAS unsigned*)(lds + (bufoff) + ldsw + _i * 8192), 16, 0, 0); } while (0)
#define PG8_LDA(dst, b, h) do { _Pragma("unroll") for (int m = 0; m < 4; ++m) _Pragma("unroll") for (int k = 0; k < 2; ++k) dst[m][k] = *(const PG8_LAS bf16x8*)(lds + PG8_SA(b, h) + aoff + m * 2048 + k * 1024); } while (0)
#define PG8_LDB(dst, b, h) do { _Pragma("unroll") for (int n = 0; n < 2; ++n) _Pragma("unroll") for (int k = 0; k < 2; ++k) dst[n][k] = *(const PG8_LAS bf16x8*)(lds + PG8_SB(b, h) + boff + n * 2048 + k * 1024); } while (0)
#define PG8_MMA(ai, bj, At, Bt) do { __builtin_amdgcn_s_setprio(1); _Pragma("unroll") for (int m = 0; m < 4; ++m) _Pragma("unroll") for (int n = 0; n < 2; ++n) _Pragma("unroll") for (int k = 0; k < 2; ++k) \
        acc[ai][bj][m][n] = __builtin_amdgcn_mfma_f32_16x16x32_bf16(Bt[n][k], At[m][k], acc[ai][bj][m][n], 0, 0, 0); __builtin_amdgcn_s_setprio(0); } while (0)
#define PG8_WAIT_V(n) asm volatile("s_waitcnt vmcnt(" #n ")" ::: "memory")
#define PG8_WAIT_L(n) asm volatile("s_waitcnt lgkmcnt(" #n ")" ::: "memory")
#define PG8_BAR __builtin_amdgcn_s_barrier()
#define PG8_SCHED __builtin_amdgcn_sched_barrier(0)
    Unit cur, nxt; int ui = 0;
    if (!S.next(0, cur)) return;
    f32x4 acc[2][2][4][2];
#pragma unroll
    for (int a = 0; a < 2; ++a)
#pragma unroll
        for (int b = 0; b < 2; ++b)
#pragma unroll
            for (int m = 0; m < 4; ++m)
#pragma unroll
                for (int n = 0; n < 2; ++n) acc[a][b][m][n] = (f32x4){0.f, 0.f, 0.f, 0.f};
    bf16x8 At[4][2], B0[2][2], B1[2][2];
    const char* cA = (const char*)g.A + (size_t)cur.pm * tstepA; const char* cB = (const char*)g.Bt + (size_t)cur.pn * tstepB;
    PG8_STAGE(PG8_SB(0, 0), cB, voffB); PG8_STAGE(PG8_SB(0, 1), cB + hstepB, voffB); PG8_STAGE(PG8_SA(0, 0), cA, voffA); PG8_STAGE(PG8_SA(0, 1), cA + hstepA, voffA);
    if (wr == 1) PG8_BAR;
    PG8_WAIT_V(2); PG8_BAR;
    PG8_STAGE(PG8_SB(1, 0), cB + kstep, voffB); PG8_STAGE(PG8_SA(1, 0), cA + kstep, voffA); PG8_STAGE(PG8_SB(1, 1), cB + hstepB + kstep, voffB);
    PG8_WAIT_V(6); PG8_BAR;
    for (;;) {
        const bool has_next = S.next(ui + 1, nxt);
        const char* nA = has_next ? (const char*)g.A + (size_t)nxt.pm * tstepA : cA; const char* nB = has_next ? (const char*)g.Bt + (size_t)nxt.pn * tstepB : cB;
        for (int t = 0; t < nt; t += 2) {
            const bool last = (t == nt - 2);
            const char* a1 = cA + (size_t)(t + 1) * kstep;
            const char* a2 = last ? nA : cA + (size_t)(t + 2) * kstep; const char* b2 = last ? nB : cB + (size_t)(t + 2) * kstep;
            const char* a3 = a2 + kstep; const char* b3 = b2 + kstep;
            PG8_LDB(B0, 0, 0); PG8_LDB(B1, 0, 1); PG8_SCHED; PG8_LDA(At, 0, 0); PG8_STAGE(PG8_SA(1, 1), a1 + hstepA, voffA);
            PG8_WAIT_V(8); PG8_WAIT_L(0); PG8_BAR; PG8_MMA(0, 0, At, B0); PG8_MMA(0, 1, At, B1); PG8_BAR; PG8_SCHED;
            PG8_LDA(At, 0, 1); PG8_STAGE(PG8_SB(0, 0), b2, voffB); PG8_STAGE(PG8_SB(0, 1), b2 + hstepB, voffB); PG8_STAGE(PG8_SA(0, 0), a2, voffA);
            PG8_WAIT_V(8); PG8_WAIT_L(0); PG8_BAR; PG8_MMA(1, 0, At, B0); PG8_MMA(1, 1, At, B1); PG8_BAR; PG8_SCHED;
            PG8_LDB(B0, 1, 0); PG8_LDB(B1, 1, 1); PG8_SCHED; PG8_LDA(At, 1, 0); PG8_STAGE(PG8_SA(0, 1), a2 + hstepA, voffA);
            PG8_WAIT_V(8); PG8_WAIT_L(0); PG8_BAR; PG8_MMA(0, 0, At, B0); PG8_MMA(0, 1, At, B1); PG8_BAR; PG8_SCHED;
            PG8_LDA(At, 1, 1); PG8_STAGE(PG8_SB(1, 0), b3, voffB); PG8_STAGE(PG8_SB(1, 1), b3 + hstepB, voffB); PG8_STAGE(PG8_SA(1, 0), a3, voffA);
            PG8_WAIT_V(8); PG8_WAIT_L(0); PG8_BAR; PG8_MMA(1, 0, At, B0); PG8_MMA(1, 1, At, B1); PG8_BAR; PG8_SCHED;
        }
        if (wr == 0) PG8_BAR;
        E(acc, cur, wr, wc, fr, fq);
        if (!has_next) break;
#pragma unroll
        for (int a = 0; a < 2; ++a)
#pragma unroll
            for (int b = 0; b < 2; ++b)
#pragma unroll
                for (int m = 0; m < 4; ++m)
#pragma unroll
                    for (int n = 0; n < 2; ++n) acc[a][b][m][n] = (f32x4){0.f, 0.f, 0.f, 0.f};
        cur = nxt; cA = nA; cB = nB; ++ui;
        if (wr == 1) PG8_BAR;
    }
    PG8_WAIT_V(0);
    PG8_BAR;
#undef PG8_SA
#undef PG8_SB
#undef PG8_STAGE
#undef PG8_LDA
#undef PG8_LDB
#undef PG8_MMA
#undef PG8_WAIT_V
#undef PG8_WAIT_L
#undef PG8_BAR
#undef PG8_SCHED
}
}

constexpr int NWAVES = 8;
constexpr int LDS_RING_BYTES = 131072, LDSCTL_OFF = 143360, MISC_OFF = LDSCTL_OFF + 320, LDS_BYTES = 147456;
#define LAS __attribute__((address_space(3)))
#define GAS __attribute__((address_space(1)))
typedef float f32x4 __attribute__((ext_vector_type(4)));
typedef unsigned v4u __attribute__((ext_vector_type(4)));
typedef unsigned v2u __attribute__((ext_vector_type(2)));
#define LDS_WAIT() asm volatile("s_waitcnt lgkmcnt(0)" ::: "memory")

constexpr int CW_BAR = 4096;
#define XB_TMO      128
#define XB_XCNT(j)  (256  + 64 * (j))
#define XB_XSUB(j)  (1280 + 64 * (j))
#define XB_XGEN(j)  (2304 + 64 * (j))
#define XB_TOP      3328
#define XB_TOPGEN   3392
#define XCD_BAR_WORDS 3456
#define XB_SPIN_CAP (1u << 20)
__device__ __forceinline__ unsigned xb_ld(unsigned* p)              { return __hip_atomic_load(p, __ATOMIC_RELAXED, __HIP_MEMORY_SCOPE_AGENT); }
__device__ __forceinline__ unsigned xb_add(unsigned* p, unsigned v) { return __hip_atomic_fetch_add(p, v, __ATOMIC_RELAXED, __HIP_MEMORY_SCOPE_AGENT); }
__device__ __forceinline__ unsigned xb_xcc_id() { return (unsigned)__builtin_amdgcn_s_getreg((3 << 11) | 20) & 0xFu; }
#define XB_SPIN(cond, bar) do { unsigned _sp = 0; while (cond) { __builtin_amdgcn_s_sleep(1); \
    if ((++_sp & 255u) == 0u) { if (xb_ld(&(bar)[XB_TMO])) break; if (_sp > XB_SPIN_CAP) { atomicAdd(&(bar)[XB_TMO], 1u); break; } } } } while (0)
struct XcdBarrier { unsigned* bar; unsigned x; volatile LAS unsigned* st; };
__device__ __forceinline__ XcdBarrier xcd_barrier_post(unsigned* bar, volatile LAS unsigned* st) {
    XcdBarrier b; b.bar = bar; b.x = xb_xcc_id(); b.st = st;
    if (threadIdx.x == 0) (void)xb_add(&bar[XB_XCNT(b.x)], 1u);
    return b;
}
__device__ __forceinline__ void xcd_barrier_complete(unsigned* bar, unsigned x, unsigned& nloc, unsigned& nx) {
    const unsigned G = gridDim.x * gridDim.y * gridDim.z;
    unsigned sum, cnt, mine, sp = 0u;
    for (;;) {
        sum = 0u; cnt = 0u; mine = 0u;
#pragma unroll
        for (unsigned j = 0; j < 16; ++j) { const unsigned c = xb_ld(&bar[XB_XCNT(j)]); sum += c; cnt += (c > 0u) ? 1u : 0u; mine = (j == x) ? c : mine; }
        if (sum == G) break;
        __builtin_amdgcn_s_sleep(1);
        if ((++sp & 255u) == 0u) { if (xb_ld(&bar[XB_TMO])) break; if (sp > XB_SPIN_CAP) { atomicAdd(&bar[XB_TMO], 1u); break; } }
    }
    nloc = mine > 0u ? mine : 1u; nx = cnt > 0u ? cnt : 1u;
}
__device__ __forceinline__ void xcd_barrier(const XcdBarrier& b) {
    asm volatile("s_waitcnt vmcnt(0)" ::: "memory");
    __syncthreads();
    if (threadIdx.x == 0) {
        unsigned* bar = b.bar;
        __builtin_amdgcn_s_waitcnt(0);
        unsigned nloc = b.st[0], nx = b.st[1];
        if (nloc == 0u) { xcd_barrier_complete(bar, b.x, nloc, nx); b.st[0] = nloc; b.st[1] = nx; }
        const unsigned old = xb_add(&bar[XB_XSUB(b.x)], 1u);
        const unsigned gen = old / nloc;
        if (old + 1u == (gen + 1u) * nloc) {
            __builtin_amdgcn_fence(__ATOMIC_RELEASE, "agent");
            asm volatile("s_waitcnt vmcnt(0)" ::: "memory");
            const unsigned og = xb_add(&bar[XB_TOP], 1u);
            const unsigned tg = og / nx;
            if (og + 1u == (tg + 1u) * nx) xb_add(&bar[XB_TOPGEN], 1u);
            else XB_SPIN(xb_ld(&bar[XB_TOPGEN]) == tg, bar);
            __builtin_amdgcn_fence(__ATOMIC_ACQUIRE, "agent");
            xb_add(&bar[XB_XGEN(b.x)], 1u);
            asm volatile("s_waitcnt vmcnt(0)" ::: "memory");
        } else {
            XB_SPIN(xb_ld(&bar[XB_XGEN(b.x)]) == gen, bar);
            __builtin_amdgcn_fence(__ATOMIC_ACQUIRE, "agent");
            asm volatile("s_waitcnt vmcnt(0)" ::: "memory");
        }
    }
    __syncthreads();
}

struct Args { const float* in[28]; float* out; unsigned char* ws; int ph_lo, ph_hi, li, pad; };

__device__ __forceinline__ void p0_transpose_item(const float* W, const float* sc, int K, int N, bf16_t* WT, LAS float* scr, int item, int lane) {
    const int nblk = N / 32, kb = item / nblk, nb = item % nblk, k0 = 64 * kb, n0 = 32 * nb;
#pragma unroll 8
    for (int i = 0; i < 32; ++i) { const int kk = 2 * i + (lane >> 5); const float s = sc ? sc[k0 + kk] : 1.f; scr[kk * 33 + (lane & 31)] = W[(size_t)(k0 + kk) * N + n0 + (lane & 31)] * s; }
    LDS_WAIT(); asm volatile("" ::: "memory");
    const int c = lane & 7;
#pragma unroll
    for (int j = 0; j < 4; ++j) { const int n = (lane >> 3) + 8 * j; const LAS float* s = scr + (8 * c) * 33 + n;
        v4u o; o.x = pg8::cvt_pk_bf16(s[0 * 33], s[1 * 33]); o.y = pg8::cvt_pk_bf16(s[2 * 33], s[3 * 33]); o.z = pg8::cvt_pk_bf16(s[4 * 33], s[5 * 33]); o.w = pg8::cvt_pk_bf16(s[6 * 33], s[7 * 33]);
        *(v4u*)(WT + (size_t)(n0 + n) * K + k0 + 8 * c) = o; }
    LDS_WAIT(); asm volatile("" ::: "memory");
}
__device__ __forceinline__ void p0_row_fp8(const float* in, const float* cs, unsigned char* out, float* sc, int lane) {
    f32x4 v[4]; float mx = 0.f;
#pragma unroll
    for (int i = 0; i < 4; ++i) { v[i] = *(const f32x4*)(in + lane * 16 + 4 * i); if (cs) v[i] = v[i] * *(const f32x4*)(cs + lane * 16 + 4 * i);
        mx = fmaxf(mx, fmaxf(fmaxf(fabsf(v[i][0]), fabsf(v[i][1])), fmaxf(fabsf(v[i][2]), fabsf(v[i][3])))); }
#pragma unroll
    for (int o = 1; o < 64; o <<= 1) mx = fmaxf(mx, __shfl_xor(mx, o));
    mx = fmaxf(mx, 1e-30f);
    const float q = 448.f / mx;
    v4u w;
#pragma unroll
    for (int i = 0; i < 4; ++i) { int p = 0; p = __builtin_amdgcn_cvt_pk_fp8_f32(v[i][0] * q, v[i][1] * q, p, false); p = __builtin_amdgcn_cvt_pk_fp8_f32(v[i][2] * q, v[i][3] * q, p, true); w[i] = (unsigned)p; }
    *(v4u*)(out + lane * 16) = w;
    if (lane == 0) *sc = mx * (1.f / 448.f);
}
__device__ __forceinline__ void p0_convert(const float* in, const float* cs, bf16_t* out, size_t n, int gw, int NGW, int lane) {
    for (size_t i = ((size_t)gw * 64 + lane) * 8; i < n; i += (size_t)NGW * 512) {
        f32x4 a = *(const f32x4*)(in + i), b = *(const f32x4*)(in + i + 4);
        if (cs) { const int c = (int)(i & 1023); a = a * *(const f32x4*)(cs + c); b = b * *(const f32x4*)(cs + c + 4); }
        v4u o; o.x = pg8::cvt_pk_bf16(a[0], a[1]); o.y = pg8::cvt_pk_bf16(a[2], a[3]); o.z = pg8::cvt_pk_bf16(b[0], b[1]); o.w = pg8::cvt_pk_bf16(b[2], b[3]);
        *(v4u*)(out + i) = o;
    }
}

namespace da {
typedef short bf16x8 __attribute__((ext_vector_type(8)));
typedef short s16x4 __attribute__((ext_vector_type(4)));
typedef float f32x16 __attribute__((ext_vector_type(16)));
constexpr float LOG2E = 1.4426950408889634f;
constexpr int SLOT = 32768, SCR_OFF = 65536, COMB_OFF = 69632;
__device__ __forceinline__ int crow(int r, int hi) { return (r & 3) + 8 * (r >> 2) + 4 * hi; }
__device__ __forceinline__ s16x4 vtr(const LAS unsigned char* p) { return __builtin_bit_cast(s16x4, __builtin_amdgcn_ds_read_tr16_b64_v4i16((LAS s16x4*)p)); }

__device__ __forceinline__ void attn_unit(LAS unsigned char* lds, const bf16_t* __restrict__ z, bf16_t* __restrict__ yb, const float* __restrict__ subln_w, float lam,
                                          int b, int h, int qblk, int wave, int lane) {
    const int r32 = lane & 31, hi = lane >> 5, map = wave >> 2, qs = wave & 3;
    const int q0 = qblk * 128 + qs * 32;
    const size_t rowb = (size_t)b * SEQ;
    const float slope2 = exp2f(-2.f * (float)(h + 1)) * LOG2E;
    bf16x8 qr[4];
    {
        const bf16_t* qp = z + (rowb + q0 + r32) * NZ + C_Q + h * 128 + map * 64 + hi * 8;
        constexpr float c2 = 0.125f * LOG2E;
#pragma unroll
        for (int d0 = 0; d0 < 4; ++d0) {
            const v4u w = *(const v4u*)(qp + d0 * 16);
            v4u o; o.x = pg8::cvt_pk_bf16(pg8::bflo(w.x) * c2, pg8::bfhi(w.x) * c2); o.y = pg8::cvt_pk_bf16(pg8::bflo(w.y) * c2, pg8::bfhi(w.y) * c2);
            o.z = pg8::cvt_pk_bf16(pg8::bflo(w.z) * c2, pg8::bfhi(w.z) * c2); o.w = pg8::cvt_pk_bf16(pg8::bflo(w.w) * c2, pg8::bfhi(w.w) * c2);
            qr[d0] = __builtin_bit_cast(bf16x8, o);
        }
    }
    const int qpos = q0 + r32;
    const float qterm = slope2 * (float)(4 * hi - qpos);
    LAS float* wsf = (LAS float*)(lds + SCR_OFF) + wave * 64;
    f32x16 o[4];
#pragma unroll
    for (int d = 0; d < 4; ++d) o[d] = (f32x16){};
    float m = -1e30f, lsum = 0.f;
    const int NT = 2 * qblk + 2;
    const bf16_t* ksrc0 = z + (rowb + lane) * NZ + C_ZK + h * 128 + wave * 8;
    const int pc0 = 2 * wave, pc1 = 2 * wave + 1;
    const bf16_t* vsrc0 = z + (rowb + 16 * (pc0 & 3) + (lane >> 2)) * NZ + C_ZV + h * 128 + 32 * (pc0 >> 2) + (lane & 3) * 8;
    const bf16_t* vsrc1 = z + (rowb + 16 * (pc1 & 3) + (lane >> 2)) * NZ + C_ZV + h * 128 + 32 * (pc1 >> 2) + (lane & 3) * 8;
#define DA_STAGE(j, slot) do { const size_t _o = (size_t)(j) * 64 * NZ; LAS unsigned char* _s = lds + (slot) * SLOT; \
        __builtin_amdgcn_global_load_lds((const unsigned*)(ksrc0 + _o), (LAS unsigned*)(_s + wave * 1024), 16, 0, 0); \
        __builtin_amdgcn_global_load_lds((const unsigned*)(ksrc0 + _o + 64), (LAS unsigned*)(_s + 8192 + wave * 1024), 16, 0, 0); \
        __builtin_amdgcn_global_load_lds((const unsigned*)(vsrc0 + _o), (LAS unsigned*)(_s + 16384 + pc0 * 1024), 16, 0, 0); \
        __builtin_amdgcn_global_load_lds((const unsigned*)(vsrc1 + _o), (LAS unsigned*)(_s + 16384 + pc1 * 1024), 16, 0, 0); } while (0)
    DA_STAGE(0, 0);
    for (int j = 0; j < NT; ++j) {
        asm volatile("s_waitcnt vmcnt(0)" ::: "memory");
        __syncthreads();
        if (j + 1 < NT) DA_STAGE(j + 1, (j + 1) & 1);
        if (64 * j > q0 + 31) continue;
        const LAS unsigned char* slot = lds + (j & 1) * SLOT;
        f32x16 c0, c1;
        {
            const float tb = slope2 * (float)(64 * j) + qterm;
#pragma unroll
            for (int r = 0; r < 16; ++r) { c0[r] = tb + slope2 * (float)((r & 3) + 8 * (r >> 2)); c1[r] = c0[r] + 32.f * slope2; }
        }
        const LAS unsigned char* kb = slot + map * 8192 + hi * 1024 + r32 * 16;
#pragma unroll
        for (int d0 = 0; d0 < 4; ++d0) {
            const bf16x8 k0 = *(const LAS bf16x8*)(kb + d0 * 2048), k1 = *(const LAS bf16x8*)(kb + d0 * 2048 + 512);
            c0 = __builtin_amdgcn_mfma_f32_32x32x16_bf16(k0, qr[d0], c0, 0, 0, 0);
            c1 = __builtin_amdgcn_mfma_f32_32x32x16_bf16(k1, qr[d0], c1, 0, 0, 0);
        }
        if (64 * j + 63 > q0) {
            const int kb0 = 64 * j + 4 * hi;
#pragma unroll
            for (int r = 0; r < 16; ++r) { const int kv = kb0 + (r & 3) + 8 * (r >> 2); if (kv > qpos) c0[r] = -INFINITY; if (kv + 32 > qpos) c1[r] = -INFINITY; }
        }
        float mt = fmaxf(c0[0], c1[0]);
#pragma unroll
        for (int r = 1; r < 16; ++r) mt = fmaxf(mt, fmaxf(c0[r], c1[r]));
        mt = fmaxf(mt, __shfl_xor(mt, 32));
        const float mnew = fmaxf(m, mt);
        if (__any(mnew > m)) {
            const float alpha = __builtin_amdgcn_exp2f(m - mnew);
            lsum *= alpha;
            if (hi == 0) wsf[r32] = alpha;
            float a[16];
#pragma unroll
            for (int g = 0; g < 4; ++g) { const f32x4 t = *(const LAS f32x4*)(wsf + 8 * g + 4 * hi); a[4 * g] = t[0]; a[4 * g + 1] = t[1]; a[4 * g + 2] = t[2]; a[4 * g + 3] = t[3]; }
#pragma unroll
            for (int d = 0; d < 4; ++d)
#pragma unroll
                for (int r = 0; r < 16; ++r) o[d][r] *= a[r];
        }
        m = mnew;
        float ps = 0.f;
#pragma unroll
        for (int r = 0; r < 16; ++r) { c0[r] = __builtin_amdgcn_exp2f(c0[r] - m); c1[r] = __builtin_amdgcn_exp2f(c1[r] - m); ps += c0[r] + c1[r]; }
        lsum += ps;
        v4u pw[4];
#pragma unroll
        for (int g = 0; g < 2; ++g) {
            pw[g].x = pg8::cvt_pk_bf16(c0[8 * g], c0[8 * g + 1]); pw[g].y = pg8::cvt_pk_bf16(c0[8 * g + 2], c0[8 * g + 3]); pw[g].z = pg8::cvt_pk_bf16(c0[8 * g + 4], c0[8 * g + 5]); pw[g].w = pg8::cvt_pk_bf16(c0[8 * g + 6], c0[8 * g + 7]);
            pw[2 + g].x = pg8::cvt_pk_bf16(c1[8 * g], c1[8 * g + 1]); pw[2 + g].y = pg8::cvt_pk_bf16(c1[8 * g + 2], c1[8 * g + 3]); pw[2 + g].z = pg8::cvt_pk_bf16(c1[8 * g + 4], c1[8 * g + 5]); pw[2 + g].w = pg8::cvt_pk_bf16(c1[8 * g + 6], c1[8 * g + 7]);
        }
        const LAS unsigned char* vb = slot + 16384 + ((lane >> 4) & 1) * 32 + (lane & 3) * 8 + (4 * hi + ((lane & 15) >> 2)) * 64;
#pragma unroll
        for (int d = 0; d < 4; ++d)
#pragma unroll
            for (int kg = 0; kg < 4; ++kg) {
                const s16x4 lo = vtr(vb + (d * 4 + kg) * 1024), hh = vtr(vb + (d * 4 + kg) * 1024 + 512);
                const bf16x8 vf = (bf16x8){lo[0], lo[1], lo[2], lo[3], hh[0], hh[1], hh[2], hh[3]};
                o[d] = __builtin_amdgcn_mfma_f32_32x32x16_bf16(__builtin_bit_cast(bf16x8, pw[kg]), vf, o[d], 0, 0, 0);
            }
    }
#undef DA_STAGE
    lsum += __shfl_xor(lsum, 32);
    if (hi == 0) wsf[r32] = 1.f / lsum;
    float il[16];
#pragma unroll
    for (int g = 0; g < 4; ++g) { const f32x4 t = *(const LAS f32x4*)(wsf + 8 * g + 4 * hi); il[4 * g] = t[0]; il[4 * g + 1] = t[1]; il[4 * g + 2] = t[2]; il[4 * g + 3] = t[3]; }
    LAS float* comb = (LAS float*)(lds + COMB_OFF) + qs * 4096;
    if (map == 1) {
#pragma unroll
        for (int d = 0; d < 4; ++d)
#pragma unroll
            for (int r = 0; r < 16; ++r) comb[crow(r, hi) * 128 + 32 * d + r32] = o[d][r] * il[r];
    }
    __syncthreads();
    if (map == 0) {
        float sw[4];
#pragma unroll
        for (int d = 0; d < 4; ++d) sw[d] = subln_w[32 * d + r32] * (1.f - LAM_INIT);
#pragma unroll
        for (int r = 0; r < 16; ++r) {
            float v[4], ss = 0.f;
#pragma unroll
            for (int d = 0; d < 4; ++d) { v[d] = o[d][r] * il[r] - lam * comb[crow(r, hi) * 128 + 32 * d + r32]; ss += v[d] * v[d]; }
            ss += __shfl_xor(ss, 1); ss += __shfl_xor(ss, 2); ss += __shfl_xor(ss, 4); ss += __shfl_xor(ss, 8); ss += __shfl_xor(ss, 16);
            const float rs = rsqrtf(ss * (1.f / 128.f) + SUBLN_EPS);
            bf16_t* op = yb + (rowb + q0 + crow(r, hi)) * 512 + h * 128 + r32;
#pragma unroll
            for (int d = 0; d < 4; ++d) op[32 * d] = f2bf(v[d] * rs * sw[d]);
        }
    }
    __syncthreads();
}
}

namespace rw {
typedef short bf16x8 __attribute__((ext_vector_type(8)));
typedef float f32x2 __attribute__((ext_vector_type(2)));
constexpr int CH = 32, ACT_PITCH = 528;
constexpr int OFF_ACT = 0, OFF_RKV = 16896, OFF_VEC = 41472, OFF_G = 82432, OFF_Y = 90624, OFF_NRM = 98816, OFF_SCL = 99328;
__device__ __forceinline__ float row_allsum(float v) {
    v += __uint_as_float((unsigned)__builtin_amdgcn_update_dpp(0, (int)__float_as_uint(v), 0x128, 0xf, 0xf, false));
    v += __uint_as_float((unsigned)__builtin_amdgcn_update_dpp(0, (int)__float_as_uint(v), 0x124, 0xf, 0xf, false));
    v += __uint_as_float((unsigned)__builtin_amdgcn_update_dpp(0, (int)__float_as_uint(v), 0x122, 0xf, 0xf, false));
    v += __uint_as_float((unsigned)__builtin_amdgcn_update_dpp(0, (int)__float_as_uint(v), 0x121, 0xf, 0xf, false));
    return v;
}
__device__ __forceinline__ f32x4 ld4bf(const bf16_t* p) { const v2u w = *(const v2u*)p; return (f32x4){pg8::bflo(w.x), pg8::bfhi(w.x), pg8::bflo(w.y), pg8::bfhi(w.y)}; }

struct ScanP { const float *mu, *w0, *w2, *a0, *a2, *g2, *k_k, *k_a, *r_k, *lnx_w, *lnx_b; };
__device__ __forceinline__ void scan_unit(LAS unsigned char* lds, const bf16_t* __restrict__ z, bf16_t* __restrict__ ya, const ScanP P, int b, int h, int tid, int wave, int lane) {
    const float* mu = P.mu; const float* w0 = P.w0; const float* w2 = P.w2; const float* a0 = P.a0; const float* a2 = P.a2; const float* g2 = P.g2;
    const float* k_k = P.k_k; const float* k_a = P.k_a; const float* r_k = P.r_k; const float* lnx_w = P.lnx_w; const float* lnx_b = P.lnx_b;
    const size_t rowb = (size_t)b * SEQ;
    const int tl = tid >> 4, cg = tid & 15;
    const int nt = wave & 3, rl = lane & 15, rg = lane >> 4;
    LAS float* rkv = (LAS float*)(lds + OFF_RKV); LAS float* vec = (LAS float*)(lds + OFF_VEC); LAS float* gbuf = (LAS float*)(lds + OFF_G);
    LAS float* ybuf = (LAS float*)(lds + OFF_Y); LAS float* nrm = (LAS float*)(lds + OFF_NRM); LAS float* scl = (LAS float*)(lds + OFF_SCL);
    bf16x8 bfr[4];
    {
        const int col = h * 64 + 16 * nt + rl;
#pragma unroll
        for (int f = 0; f < 4; ++f) {
            const float* src = (wave < 4) ? ((f < 2) ? w2 : a2) : g2;
            const int kb = ((wave < 4) ? 32 * (f & 1) : 32 * f) + 8 * rg;
            float e[8];
#pragma unroll
            for (int j = 0; j < 8; ++j) e[j] = src[(size_t)(kb + j) * 512 + col];
            v4u p; p.x = pg8::cvt_pk_bf16(e[0], e[1]); p.y = pg8::cvt_pk_bf16(e[2], e[3]); p.z = pg8::cvt_pk_bf16(e[4], e[5]); p.w = pg8::cvt_pk_bf16(e[6], e[7]);
            bfr[f] = __builtin_bit_cast(bf16x8, p);
        }
    }
    const int hc = h * 64 + 16 * nt + rl;
    const float w0c = w0[hc], a0c = a0[hc], kkc = k_k[hc], kac = k_a[hc], rkc = r_k[hc];
    f32x4 Sa = (f32x4){0.f, 0.f, 0.f, 0.f}, Sb = (f32x4){0.f, 0.f, 0.f, 0.f};
    const int ra = 8 * wave + 2 * rg;
    for (int t0 = 0; t0 < SEQ; t0 += CH) {
        {
            const bf16_t* zc = z + (rowb + t0 + tl) * NZ; const bf16_t* zp = zc - NZ;
            const bool hp = (t0 + tl) > 0;
            const int c4 = h * 64 + 4 * cg;
            const f32x4 zero4 = (f32x4){0.f, 0.f, 0.f, 0.f};
            f32x4 cr = ld4bf(zc + C_R + c4), ck = ld4bf(zc + C_K + c4), cv = ld4bf(zc + C_V + c4), cw = ld4bf(zc + C_WL + 4 * cg), ca = ld4bf(zc + C_AL + 4 * cg);
            f32x4 cg0 = ld4bf(zc + C_GL + 8 * cg), cg1 = ld4bf(zc + C_GL + 8 * cg + 4);
            f32x4 pr = zero4, pk = zero4, pv = zero4, pw = zero4, pa = zero4, pg0 = zero4, pg1 = zero4;
            if (hp) { pr = ld4bf(zp + C_R + c4); pk = ld4bf(zp + C_K + c4); pv = ld4bf(zp + C_V + c4); pw = ld4bf(zp + C_WL + 4 * cg); pa = ld4bf(zp + C_AL + 4 * cg); pg0 = ld4bf(zp + C_GL + 8 * cg); pg1 = ld4bf(zp + C_GL + 8 * cg + 4); }
            const f32x4 rs_ = cr + (pr - cr) * *(const f32x4*)(mu + C_R + c4), ks_ = ck + (pk - ck) * *(const f32x4*)(mu + C_K + c4), vs_ = cv + (pv - cv) * *(const f32x4*)(mu + C_V + c4);
            const f32x4 ws_ = cw + (pw - cw) * *(const f32x4*)(mu + C_WL + 4 * cg), as_ = ca + (pa - ca) * *(const f32x4*)(mu + C_AL + 4 * cg);
            const f32x4 g0_ = cg0 + (pg0 - cg0) * *(const f32x4*)(mu + C_GL + 8 * cg), g1_ = cg1 + (pg1 - cg1) * *(const f32x4*)(mu + C_GL + 8 * cg + 4);
            *(LAS f32x4*)(rkv + 0 * 2048 + tl * 64 + 4 * cg) = rs_; *(LAS f32x4*)(rkv + 1 * 2048 + tl * 64 + 4 * cg) = ks_; *(LAS f32x4*)(rkv + 2 * 2048 + tl * 64 + 4 * cg) = vs_;
            LAS unsigned char* ar = lds + OFF_ACT + tl * ACT_PITCH;
            v2u tw; tw.x = pg8::cvt_pk_bf16(tanhf(ws_[0]), tanhf(ws_[1])); tw.y = pg8::cvt_pk_bf16(tanhf(ws_[2]), tanhf(ws_[3]));
            *(LAS v2u*)(ar + 8 * cg) = tw;
            v2u aw; aw.x = pg8::cvt_pk_bf16(as_[0], as_[1]); aw.y = pg8::cvt_pk_bf16(as_[2], as_[3]);
            *(LAS v2u*)(ar + 128 + 8 * cg) = aw;
            v4u gw; gw.x = pg8::cvt_pk_bf16(sigmoidf_(g0_[0]), sigmoidf_(g0_[1])); gw.y = pg8::cvt_pk_bf16(sigmoidf_(g0_[2]), sigmoidf_(g0_[3]));
            gw.z = pg8::cvt_pk_bf16(sigmoidf_(g1_[0]), sigmoidf_(g1_[1])); gw.w = pg8::cvt_pk_bf16(sigmoidf_(g1_[2]), sigmoidf_(g1_[3]));
            *(LAS v4u*)(ar + 256 + 16 * cg) = gw;
            if (cg == 0) *(LAS f32x4*)(scl + 4 * tl) = zero4;
        }
        __syncthreads();
        f32x4 acc0[2], acc1[2];
        {
            const LAS unsigned char* ap = lds + OFF_ACT + rl * ACT_PITCH + (((wave < 4) ? 0 : 128) + 8 * rg) * 2;
#pragma unroll
            for (int mt = 0; mt < 2; ++mt) {
                acc0[mt] = (f32x4){0.f, 0.f, 0.f, 0.f}; acc1[mt] = (f32x4){0.f, 0.f, 0.f, 0.f};
#pragma unroll
                for (int f = 0; f < 4; ++f) {
                    const bf16x8 a = *(const LAS bf16x8*)(ap + mt * 16 * ACT_PITCH + f * 64);
                    if (f < 2) acc0[mt] = __builtin_amdgcn_mfma_f32_16x16x32_bf16(a, bfr[f], acc0[mt], 0, 0, 0);
                    else acc1[mt] = __builtin_amdgcn_mfma_f32_16x16x32_bf16(a, bfr[f], acc1[mt], 0, 0, 0);
                }
            }
        }
        float dec[8], av[8], kk[8], ksv[8], rsv[8];
        if (wave >= 4) {
#pragma unroll
            for (int mt = 0; mt < 2; ++mt)
#pragma unroll
                for (int r = 0; r < 4; ++r) gbuf[(16 * mt + 4 * rg + r) * 64 + 16 * nt + rl] = acc0[mt][r] + acc1[mt][r];
        } else {
#pragma unroll
            for (int mt = 0; mt < 2; ++mt)
#pragma unroll
                for (int r = 0; r < 4; ++r) {
                    const int i = mt * 4 + r, tok = 16 * mt + 4 * rg + r, c = 16 * nt + rl;
                    const float nx = -(w0c + acc0[mt][r]);
                    const float sp = nx > 20.f ? nx : log1pf(__expf(nx));
                    dec[i] = __expf(-__expf(-sp - 0.5f));
                    av[i] = sigmoidf_(a0c + acc1[mt][r]);
                    ksv[i] = rkv[1 * 2048 + tok * 64 + c]; rsv[i] = rkv[0 * 2048 + tok * 64 + c];
                    kk[i] = ksv[i] * kkc;
                    const float n2 = row_allsum(kk[i] * kk[i]);
                    if (rl == 0) nrm[tok * 4 + nt] = n2;
                }
        }
        __syncthreads();
        if (wave < 4) {
#pragma unroll
            for (int mt = 0; mt < 2; ++mt)
#pragma unroll
                for (int r = 0; r < 4; ++r) {
                    const int i = mt * 4 + r, tok = 16 * mt + 4 * rg + r, c = 16 * nt + rl;
                    const f32x4 n4 = *(const LAS f32x4*)(nrm + tok * 4);
                    const float inv = 1.f / fmaxf(sqrtf((n4[0] + n4[1]) + (n4[2] + n4[3])), 1e-12f);
                    const float kkn = kk[i] * inv, beta = kkn * av[i], kmod = ksv[i] * (1.f + (av[i] - 1.f) * kac);
                    LAS float* vp = vec + tok * 320 + c;
                    vp[0] = dec[i]; vp[64] = beta; vp[128] = -kkn; vp[192] = kmod; vp[256] = dec[i] * rsv[i];
                    const float pbr = row_allsum(beta * rsv[i]), pkr = row_allsum(kmod * rsv[i]), pbo = row_allsum(rsv[i] * kmod * rkc);
                    if (rl == 0) { __hip_atomic_fetch_add(scl + tok * 4 + 0, pbr, __ATOMIC_RELAXED, __HIP_MEMORY_SCOPE_WORKGROUP); __hip_atomic_fetch_add(scl + tok * 4 + 1, pkr, __ATOMIC_RELAXED, __HIP_MEMORY_SCOPE_WORKGROUP); __hip_atomic_fetch_add(scl + tok * 4 + 2, pbo, __ATOMIC_RELAXED, __HIP_MEMORY_SCOPE_WORKGROUP); }
                }
        }
        __syncthreads();
        for (int tk = 0; tk < CH; ++tk) {
            const LAS float* vb = vec + tk * 320 + 4 * rl;
            const f32x4 d4 = *(const LAS f32x4*)(vb), b4 = *(const LAS f32x4*)(vb + 64), n4 = *(const LAS f32x4*)(vb + 128), k4 = *(const LAS f32x4*)(vb + 192), q4 = *(const LAS f32x4*)(vb + 256);
            const f32x2 v2 = *(const LAS f32x2*)(rkv + 2 * 2048 + tk * 64 + ra);
            const f32x2 s2 = *(const LAS f32x2*)(scl + tk * 4);
            float sa_a = (Sa[0] * n4[0] + Sa[1] * n4[1]) + (Sa[2] * n4[2] + Sa[3] * n4[3]);
            float sa_b = (Sb[0] * n4[0] + Sb[1] * n4[1]) + (Sb[2] * n4[2] + Sb[3] * n4[3]);
            float ya_a = (Sa[0] * q4[0] + Sa[1] * q4[1]) + (Sa[2] * q4[2] + Sa[3] * q4[3]);
            float ya_b = (Sb[0] * q4[0] + Sb[1] * q4[1]) + (Sb[2] * q4[2] + Sb[3] * q4[3]);
            sa_a = row_allsum(sa_a); sa_b = row_allsum(sa_b); ya_a = row_allsum(ya_a); ya_b = row_allsum(ya_b);
            const float y_a = ya_a + sa_a * s2[0] + v2[0] * s2[1], y_b = ya_b + sa_b * s2[0] + v2[1] * s2[1];
            Sa = Sa * d4 + b4 * sa_a + k4 * v2[0];
            Sb = Sb * d4 + b4 * sa_b + k4 * v2[1];
            if (rl == 0) *(LAS f32x2*)(ybuf + tk * 64 + ra) = (f32x2){y_a, y_b};
        }
        __syncthreads();
        {
            const f32x4 y4 = *(const LAS f32x4*)(ybuf + tl * 64 + 4 * cg);
            const float mean = row_allsum((y4[0] + y4[1]) + (y4[2] + y4[3])) * (1.f / 64.f);
            const f32x4 dv = y4 - mean;
            const float var = row_allsum((dv[0] * dv[0] + dv[1] * dv[1]) + (dv[2] * dv[2] + dv[3] * dv[3])) * (1.f / 64.f);
            const float rs_ = rsqrtf(var + GN_EPS);
            const int c4 = h * 64 + 4 * cg;
            const f32x4 yn = dv * rs_ * *(const f32x4*)(lnx_w + c4) + *(const f32x4*)(lnx_b + c4);
            const float bonus = scl[tl * 4 + 2];
            const f32x4 vs_ = *(const LAS f32x4*)(rkv + 2 * 2048 + tl * 64 + 4 * cg), g4 = *(const LAS f32x4*)(gbuf + tl * 64 + 4 * cg);
            const f32x4 o = (yn + vs_ * bonus) * g4;
            v2u w; w.x = pg8::cvt_pk_bf16(o[0], o[1]); w.y = pg8::cvt_pk_bf16(o[2], o[3]);
            *(v2u*)(ya + (rowb + t0 + tl) * 512 + c4) = w;
        }
        __syncthreads();
    }
}
}

typedef __bf16 bf16x2_t __attribute__((ext_vector_type(2)));
__device__ __forceinline__ float dot2bf(unsigned a, unsigned b, float c) { return __builtin_amdgcn_fdot2_f32_bf16(__builtin_bit_cast(bf16x2_t, a), __builtin_bit_cast(bf16x2_t, b), c, false); }
__device__ __forceinline__ unsigned f2ord(float f) { const unsigned u = __float_as_uint(f); return (u & 0x80000000u) ? ~u : (u | 0x80000000u); }
__device__ __forceinline__ float ord2f(unsigned o) { return __uint_as_float((o & 0x80000000u) ? (o ^ 0x80000000u) : ~o); }
__device__ __forceinline__ unsigned row_allmax_u32(unsigned v) {
    v = max(v, (unsigned)__builtin_amdgcn_update_dpp(0, (int)v, 0x128, 0xf, 0xf, false));
    v = max(v, (unsigned)__builtin_amdgcn_update_dpp(0, (int)v, 0x124, 0xf, 0xf, false));
    v = max(v, (unsigned)__builtin_amdgcn_update_dpp(0, (int)v, 0x122, 0xf, 0xf, false));
    v = max(v, (unsigned)__builtin_amdgcn_update_dpp(0, (int)v, 0x121, 0xf, 0xf, false));
    return v;
}

__device__ __forceinline__ void topk_item(const bf16_t* __restrict__ qb, const bf16_t* __restrict__ KeysB, int* __restrict__ ids, float* __restrict__ gates, int t0, int h, int lane) {
    typedef short bf16x8 __attribute__((ext_vector_type(8)));
    const int rl = lane & 15, rg = lane >> 4;
    unsigned top[2][4];
#pragma unroll
    for (int c = 0; c < 2; ++c) {
        f32x4 acc[8];
#pragma unroll
        for (int nt = 0; nt < 8; ++nt) acc[nt] = (f32x4){0.f, 0.f, 0.f, 0.f};
        const bf16_t* qp = qb + (size_t)(t0 + rl) * 2048 + h * 256 + c * 128 + 8 * rg;
        const bf16_t* kp = KeysB + ((size_t)(h * 2 + c) * 128 + rl) * 128 + 8 * rg;
#pragma unroll
        for (int ks = 0; ks < 4; ++ks) {
            const bf16x8 a = *(const bf16x8*)(qp + ks * 32);
#pragma unroll
            for (int nt = 0; nt < 8; ++nt) { const bf16x8 b = *(const bf16x8*)(kp + nt * 16 * 128 + ks * 32); acc[nt] = __builtin_amdgcn_mfma_f32_16x16x32_bf16(a, b, acc[nt], 0, 0, 0); }
        }
        unsigned key[4][8];
#pragma unroll
        for (int r = 0; r < 4; ++r)
#pragma unroll
            for (int nt = 0; nt < 8; ++nt) key[r][nt] = (f2ord(acc[nt][r]) & ~127u) | (unsigned)(127 - (nt * 16 + rl));
#pragma unroll
        for (int r = 0; r < 4; ++r) top[c][r] = 0u;
        for (int round = 0; round < 16; ++round) {
#pragma unroll
            for (int r = 0; r < 4; ++r) {
                unsigned lm = max(max(max(key[r][0], key[r][1]), max(key[r][2], key[r][3])), max(max(key[r][4], key[r][5]), max(key[r][6], key[r][7])));
                const unsigned m = row_allmax_u32(lm);
                top[c][r] = (rl == round) ? m : top[c][r];
#pragma unroll
                for (int nt = 0; nt < 8; ++nt) key[r][nt] = (key[r][nt] == m) ? 0u : key[r][nt];
            }
        }
    }
    const int rowbase = lane & 48;
#pragma unroll
    for (int r = 0; r < 4; ++r) {
        const int t = t0 + 4 * rg + r;
        const float v1 = ord2f(top[0][r] & ~127u); const int n1 = 127 - (int)(top[0][r] & 127u);
        int ptr = 0; unsigned k2 = (unsigned)__builtin_amdgcn_ds_bpermute((rowbase + 0) * 4, (int)top[1][r]);
        float v0 = 0.f, sum = 0.f, mye = 0.f;
        for (int round = 0; round < 16; ++round) {
            const float head = v1 + ord2f(k2 & ~127u);
            const unsigned key = (ptr < 16) ? ((f2ord(head) & ~15u) | (unsigned)(15 - rl)) : 0u;
            const unsigned m = row_allmax_u32(key);
            const float val = ord2f(m & ~15u);
            if (round == 0) v0 = val;
            const float e = __expf(val - v0); sum += e;
            mye = (rl == round) ? e : mye;
            const bool win = (key == m);
            if (win) ids[(size_t)t * 128 + h * 16 + round] = n1 * 128 + (127 - (int)(k2 & 127u));
            ptr += win ? 1 : 0;
            k2 = (unsigned)__builtin_amdgcn_ds_bpermute((rowbase + (ptr & 15)) * 4, (int)top[1][r]);
        }
        gates[(size_t)t * 128 + h * 16 + rl] = mye / sum;
    }
}

typedef float f32x2 __attribute__((ext_vector_type(2)));
__device__ __forceinline__ void peer_token(const bf16_t* __restrict__ x2b, const float* __restrict__ ssq2, const int* __restrict__ ids, const float* __restrict__ gates,
                                           const unsigned char* __restrict__ U8, const unsigned char* __restrict__ V8, const float* __restrict__ usc, const float* __restrict__ vsc,
                                           const float* __restrict__ fw, float* __restrict__ out, int t, int lane) {
    const int l16 = lane * 16;
    f32x2 hx[8];
    {
        const v4u h0 = *(const v4u*)(x2b + (size_t)t * DM + l16), h1 = *(const v4u*)(x2b + (size_t)t * DM + l16 + 8);
        const unsigned hw[8] = {h0.x, h0.y, h0.z, h0.w, h1.x, h1.y, h1.z, h1.w};
#pragma unroll
        for (int i = 0; i < 8; ++i) hx[i] = (f32x2){pg8::bflo(hw[i]), pg8::bfhi(hw[i])};
    }
    const int idA = ids[(size_t)t * 128 + lane], idB = ids[(size_t)t * 128 + 64 + lane];
    const float rs = rsqrtf(ssq2[t] * (1.f / DM) + NORM_EPS);
    const float suA = rs * usc[idA], suB = rs * usc[idB];
    const float svA = gates[(size_t)t * 128 + lane] * vsc[idA], svB = gates[(size_t)t * 128 + 64 + lane] * vsc[idB];
    f32x2 y[8];
#pragma unroll
    for (int i = 0; i < 8; ++i) y[i] = (f32x2){0.f, 0.f};
    const int bit0 = lane & 1, bit1 = (lane >> 1) & 1, bit2 = (lane >> 2) & 1;
    const int myk = 4 * bit0 + 2 * bit1 + bit2;
    for (int g = 0; g < 16; ++g) {
        const int idsel = (g < 8) ? idA : idB; const float susel = (g < 8) ? suA : suB, svsel = (g < 8) ? svA : svB; const int lb = (g * 8) & 63;
        v4u uw[8], vw[8];
#pragma unroll
        for (int k = 0; k < 8; ++k) { const int e = __builtin_amdgcn_readlane(idsel, lb + k); uw[k] = *(const v4u*)(U8 + (size_t)e * DM + l16); vw[k] = *(const v4u*)(V8 + (size_t)e * DM + l16); }
        float d[8];
#pragma unroll
        for (int k = 0; k < 8; ++k) {
            f32x2 a = (f32x2){0.f, 0.f};
#pragma unroll
            for (int i = 0; i < 4; ++i) { a += __builtin_amdgcn_cvt_pk_f32_fp8((int)uw[k][i], false) * hx[2 * i]; a += __builtin_amdgcn_cvt_pk_f32_fp8((int)uw[k][i], true) * hx[2 * i + 1]; }
            d[k] = a[0] + a[1];
        }
        float r4[4];
#pragma unroll
        for (int k = 0; k < 4; ++k) { const float send = bit0 ? d[k] : d[k + 4], keep = bit0 ? d[k + 4] : d[k]; r4[k] = keep + __shfl_xor(send, 1); }
        float r2[2];
#pragma unroll
        for (int k = 0; k < 2; ++k) { const float send = bit1 ? r4[k] : r4[k + 2], keep = bit1 ? r4[k + 2] : r4[k]; r2[k] = keep + __shfl_xor(send, 2); }
        float r1;
        { const float send = bit2 ? r2[0] : r2[1], keep = bit2 ? r2[1] : r2[0]; r1 = keep + __shfl_xor(send, 4); }
        r1 += __shfl_xor(r1, 8); r1 += __shfl_xor(r1, 16); r1 += __shfl_xor(r1, 32);
        const float dd = r1 * __shfl(susel, lb + myk);
        const float act = 0.5f * dd * (1.f + erff(dd * 0.70710678118654752f)) * __shfl(svsel, lb + myk);
#pragma unroll
        for (int k = 0; k < 8; ++k) {
            const float a = __uint_as_float((unsigned)__builtin_amdgcn_readlane((int)__float_as_uint(act), ((k & 1) << 2) | (k & 2) | ((k >> 2) & 1)));
            const f32x2 a2 = (f32x2){a, a};
#pragma unroll
            for (int i = 0; i < 4; ++i) { y[2 * i] += __builtin_amdgcn_cvt_pk_f32_fp8((int)vw[k][i], false) * a2; y[2 * i + 1] += __builtin_amdgcn_cvt_pk_f32_fp8((int)vw[k][i], true) * a2; }
        }
    }
    float* orow = out + (size_t)t * DM + l16;
    float ss = 0.f;
    f32x4 o4[4];
#pragma unroll
    for (int i = 0; i < 4; ++i) { const f32x4 xv = *(const f32x4*)(orow + 4 * i); o4[i] = (f32x4){xv[0] + y[2 * i][0], xv[1] + y[2 * i][1], xv[2] + y[2 * i + 1][0], xv[3] + y[2 * i + 1][1]};
        ss += (o4[i][0] * o4[i][0] + o4[i][1] * o4[i][1]) + (o4[i][2] * o4[i][2] + o4[i][3] * o4[i][3]); }
    ss = wave_sum(ss);
    const float r = rsqrtf(ss * (1.f / DM) + NORM_EPS);
#pragma unroll
    for (int i = 0; i < 4; ++i) *(f32x4*)(orow + 4 * i) = o4[i] * r * *(const f32x4*)(fw + l16 + 4 * i);
}

__global__ void __launch_bounds__(NWAVES * 64, 2) mk_fwd(Args args) {
    extern __shared__ __attribute__((aligned(16))) unsigned char lds_raw[];
    LAS unsigned char* lds = (LAS unsigned char*)lds_raw;
    volatile LAS unsigned* MISC = (volatile LAS unsigned*)(lds + MISC_OFF);
    const int tid = threadIdx.x, lane = tid & 63, wave = __builtin_amdgcn_readfirstlane(tid >> 6);
    const int G = gridDim.x; const int bx = blockIdx.x; const int vcu = (G % 8 == 0) ? (bx % 8) * (G / 8) + bx / 8 : bx;
    unsigned char* ws = args.ws;
    unsigned* ctl = (unsigned*)(ws + WS_CTL);
    for (int u = tid; u < (LDS_BYTES - LDSCTL_OFF) / 4; u += NWAVES * 64) ((LAS unsigned*)(lds + LDSCTL_OFF))[u] = 0u;
    __syncthreads();
    XcdBarrier bar = xcd_barrier_post(ctl + CW_BAR + args.li * XCD_BAR_WORDS, MISC + 8);
    const int lo = args.ph_lo, hi = args.ph_hi;
#define IN(k) (lo <= (k) && (k) < hi)
#define BOTH(k) (IN(k) && IN((k) + 1))
    bf16_t* WinT = (bf16_t*)(ws + WS_WIN); bf16_t* PaT = (bf16_t*)(ws + WS_PA); bf16_t* PbT = (bf16_t*)(ws + WS_PB); bf16_t* WoT = (bf16_t*)(ws + WS_WO);
    bf16_t* WqT = (bf16_t*)(ws + WS_WQ); bf16_t* KeysB = (bf16_t*)(ws + WS_KEYS);
    float* rstd1 = (float*)(ws + WS_RSTD1); float* ssq2 = (float*)(ws + WS_RSTD2); float* scal = (float*)(ws + WS_SCAL);
    unsigned char* U8 = ws + WS_U; unsigned char* V8 = ws + WS_V; float* usc = (float*)(ws + WS_USC); float* vsc = (float*)(ws + WS_VSC);
    bf16_t* xb = (bf16_t*)(ws + WS_XB); bf16_t* ya = (bf16_t*)(ws + WS_YA); bf16_t* yb = (bf16_t*)(ws + WS_YB); bf16_t* x2b = (bf16_t*)(ws + WS_X2B);
    bf16_t* z = (bf16_t*)(ws + WS_Z); bf16_t* qb = (bf16_t*)(ws + WS_Q);
    bf16_t* merged = (bf16_t*)(ws + WS_MERGED);
    const int gw = vcu * NWAVES + wave, NGW = G * NWAVES;

    if (IN(0)) {
        LAS float* scr = (LAS float*)(lds + wave * 16384);
        constexpr int I_IN = (DM / 64) * (NZ / 32), I_PA = (512 / 64) * (DM / 32), I_WO = (DM / 64) * (DM / 32), I_WQ = (DM / 64) * (2048 / 32);
        constexpr int NITEMS = I_IN + 2 * I_PA + I_WO + I_WQ;
        for (int it = gw; it < NITEMS; it += NGW) {
            int r = it;
            if (r < I_IN) { p0_transpose_item(args.in[2], args.in[1], DM, NZ, WinT, scr, r, lane); continue; } r -= I_IN;
            if (r < I_PA) { p0_transpose_item(args.in[19], nullptr, 512, DM, PaT, scr, r, lane); continue; } r -= I_PA;
            if (r < I_PA) { p0_transpose_item(args.in[20], nullptr, 512, DM, PbT, scr, r, lane); continue; } r -= I_PA;
            if (r < I_WO) { p0_transpose_item(args.in[21], nullptr, DM, DM, WoT, scr, r, lane); continue; } r -= I_WO;
            p0_transpose_item(args.in[23], args.in[22], DM, 2048, WqT, scr, r, lane);
        }
        p0_convert(args.in[24], nullptr, KeysB, (size_t)16 * 128 * 128, gw, NGW, lane);
        for (int e = gw; e < 2 * NEXP; e += NGW) {
            const bool isu = e < NEXP; const int row = isu ? e : e - NEXP;
            p0_row_fp8((isu ? args.in[25] : args.in[26]) + (size_t)row * DM, isu ? args.in[22] : nullptr, (isu ? U8 : V8) + (size_t)row * DM, (isu ? usc : vsc) + row, lane);
        }
        for (int m = gw; m < T_TOK; m += NGW) {
            const f32x4* xr = (const f32x4*)(args.in[0] + (size_t)m * DM) + lane;
            f32x4 v[4]; float s = 0.f;
#pragma unroll
            for (int j = 0; j < 4; ++j) { v[j] = xr[64 * j]; s += (v[j][0] * v[j][0] + v[j][1] * v[j][1]) + (v[j][2] * v[j][2] + v[j][3] * v[j][3]); }
            s = wave_sum(s);
            v2u* o8 = (v2u*)(xb + (size_t)m * DM) + lane;
#pragma unroll
            for (int j = 0; j < 4; ++j) { v2u w; w.x = pg8::cvt_pk_bf16(v[j][0], v[j][1]); w.y = pg8::cvt_pk_bf16(v[j][2], v[j][3]); o8[64 * j] = w; }
            if (lane == 0) { rstd1[m] = rsqrtf(s * (1.f / DM) + NORM_EPS); ssq2[m] = 0.f; }
        }
        if (gw == 0) {
            const float a = wave_sum(args.in[14][lane] * args.in[15][lane]), b = wave_sum(args.in[16][lane] * args.in[17][lane]);
            if (lane == 0) scal[0] = __expf(a) - __expf(b) + LAM_INIT;
        }
        if (BOTH(0)) xcd_barrier(bar);
    }
    if (IN(1)) {
        pg8::Gemm g{xb, WinT, DM, DM, DM}; pg8::StaticOrder S; S.init(T_TOK, NZ, G, bx);
        pg8::EpiRowScale<false> E{z, NZ, rstd1};
        for (int rep = 0; rep < REPS(1); ++rep) pg8::gemm_phase(lds, g, S, E);
        if (BOTH(1)) xcd_barrier(bar);
    }
    if (IN(2)) {
        {
            const rw::ScanP P{args.in[3], args.in[4], args.in[5], args.in[6], args.in[7], args.in[8], args.in[9], args.in[10], args.in[11], args.in[12], args.in[13]};
            for (int rep = 0; rep < REPS(2); ++rep) for (int u = vcu; u < NB * 8; u += G) rw::scan_unit(lds, z, ya, P, u >> 3, u & 7, tid, wave, lane);
        }
        const float lam = scal[0];
        for (int rep = 0; rep < REPS(10); ++rep) for (int i = 0;; ++i) {
            const int idx = vcu + i * G; if (idx >= 2048) break;
            const int slot = idx >> 8, v = idx & 255, bh = v >> 1, a = (v & 1) * 4 + (slot >> 1), qblk = (slot & 1) ? 15 - a : a;
            da::attn_unit(lds, z, yb, args.in[18], lam, bh >> 2, bh & 3, qblk, wave, lane);
        }
        if (BOTH(2)) xcd_barrier(bar);
    }
    if (IN(3)) {
        pg8::Gemm g{ya, PaT, 512, 512, 512}; pg8::StaticOrder S; S.init(T_TOK, DM, G, bx);
        pg8::EpiGate<false> E{merged, z, C_GA};
        pg8::gemm_phase(lds, g, S, E);
        if (BOTH(3)) xcd_barrier(bar);
    }
    if (IN(4)) {
        pg8::Gemm g{yb, PbT, 512, 512, 512}; pg8::StaticOrder S; S.init(T_TOK, DM, G, bx);
        pg8::EpiGate<true> E{merged, z, C_GB};
        pg8::gemm_phase(lds, g, S, E);
        if (BOTH(4)) xcd_barrier(bar);
    }
    if (IN(5)) {
        pg8::Gemm g{merged, WoT, DM, DM, DM}; pg8::StaticOrder S; S.init(T_TOK, DM, G, bx);
        pg8::EpiX2 E{args.in[0], args.out, x2b, ssq2};
        pg8::gemm_phase(lds, g, S, E);
        if (BOTH(5)) xcd_barrier(bar);
    }
    if (IN(6)) {
        pg8::Gemm g{x2b, WqT, DM, DM, DM}; pg8::StaticOrder S; S.init(T_TOK, 2048, G, bx);
        pg8::EpiRowScale<true> E{qb, 2048, ssq2};
        for (int rep = 0; rep < REPS(6); ++rep) pg8::gemm_phase(lds, g, S, E);
        if (BOTH(6)) xcd_barrier(bar);
    }
    if (IN(7)) {
        int* ids = (int*)(ws + WS_IDS); float* gates = (float*)(ws + WS_GATES);
        for (int rep = 0; rep < REPS(7); ++rep) for (int it = gw; it < (T_TOK / 16) * 8; it += NGW) topk_item(qb, KeysB, ids, gates, (it & 4095) * 16, it >> 12, lane);
        if (BOTH(7)) xcd_barrier(bar);
    }
    if (IN(8)) {
        const int* ids = (const int*)(ws + WS_IDS); const float* gates = (const float*)(ws + WS_GATES);
        for (int t = gw; t < T_TOK; t += NGW) peer_token(x2b, ssq2, ids, gates, U8, V8, usc, vsc, args.in[27], args.out, t, lane);
    }
#undef IN
#undef BOTH
}

extern "C" void kernel_launch(void* const* d_in, const int* in_sizes, int n_in, void* d_out, int out_size, void* d_ws, size_t ws_size, hipStream_t stream) {
    static int grid = 0;
    if (grid == 0) {
        if (n_in != 28 || in_sizes[0] != T_TOK * DM || out_size != T_TOK * DM || ws_size < WS_END) {
            fprintf(stderr, "kernel_launch: unexpected shapes / workspace (n_in %d, ws %zu < %zu)\n", n_in, ws_size, (size_t)WS_END); grid = -1; return; }
        int dev = 0, cus = 0;
        if (hipGetDevice(&dev) != hipSuccess || hipDeviceGetAttribute(&cus, hipDeviceAttributeMultiprocessorCount, dev) != hipSuccess) { grid = -1; return; }
        if (hipFuncSetAttribute((const void*)mk_fwd, hipFuncAttributeMaxDynamicSharedMemorySize, LDS_BYTES) != hipSuccess) { fprintf(stderr, "kernel_launch: hipFuncSetAttribute failed\n"); grid = -1; return; }
        grid = cus;
    }
    if (grid < 0) return;
    unsigned char* ws = (unsigned char*)d_ws;
    float* out = (float*)d_out;
    (void)hipMemsetAsync(ws + WS_CTL, 0, 1 * MiB, stream);
    Args a{};
    for (int i = 0; i < 28; ++i) a.in[i] = (const float*)d_in[i];
    a.out = out; a.ws = ws;
    a.ph_lo = 0; a.ph_hi = 9; a.li = 0;
    hipLaunchKernelGGL(mk_fwd, dim3(grid), dim3(NWAVES * 64), LDS_BYTES, stream, a);
}
```

```cpp
#include <hip/hip_runtime.h>
#include <stdint.h>
#include <cstdio>

typedef unsigned short bf16_t;
typedef unsigned int u32;

#ifndef PROBE_REP
#define PROBE_REP 0
#endif
#define REPS(k) (((PROBE_REP >> (k)) & 1) ? 2 : 1)
constexpr int T_TOK = 65536, DM = 1024, SEQ = 2048, NB = 32;
constexpr int NZ = 5376;
constexpr int C_R = 0, C_K = 512, C_V = 1024, C_WL = 1536, C_AL = 1600, C_GL = 1664, C_Q = 1792, C_ZK = 2304, C_ZV = 2816, C_GA = 3328, C_GB = 4352;
constexpr int NEXP = 16384;
constexpr float NORM_EPS = 1e-6f, GN_EPS = 64e-5f, SUBLN_EPS = 1e-5f;
constexpr float LAM_INIT = 0.2f;

constexpr size_t MiB = 1u << 20;
constexpr size_t WS_CTL = 0;
constexpr size_t WS_WIN = 1 * MiB;
constexpr size_t WS_PA = 12 * MiB;
constexpr size_t WS_PB = 13 * MiB;
constexpr size_t WS_WO = 14 * MiB;
constexpr size_t WS_WQ = 16 * MiB;
constexpr size_t WS_KEYS = 20 * MiB;
constexpr size_t WS_RSTD1 = 21 * MiB;
constexpr size_t WS_RSTD2 = 22 * MiB;
constexpr size_t WS_SCAL = 23 * MiB;
constexpr size_t WS_U = 24 * MiB;
constexpr size_t WS_V = 40 * MiB;
constexpr size_t WS_USC = 56 * MiB;
constexpr size_t WS_VSC = 57 * MiB;
constexpr size_t WS_XB = 88 * MiB;
constexpr size_t WS_YA = WS_XB;
constexpr size_t WS_YB = WS_XB + 64 * MiB;
constexpr size_t WS_X2B = WS_XB;
constexpr size_t WS_Z = 216 * MiB;
constexpr size_t WS_Q = WS_Z;
constexpr size_t WS_IDS = WS_Z + 256 * MiB;
constexpr size_t WS_GATES = WS_Z + 288 * MiB;
constexpr size_t WS_MERGED = 888 * MiB;
constexpr size_t WS_END = 1016 * MiB;

__device__ __forceinline__ float bf2f(bf16_t h) { return __uint_as_float(((u32)h) << 16); }
__device__ __forceinline__ bf16_t f2bf(float f) { u32 u = __float_as_uint(f); u += 0x7fffu + ((u >> 16) & 1u); return (bf16_t)(u >> 16); }
__device__ __forceinline__ float wave_sum(float v) {
#pragma unroll
    for (int o = 1; o < 64; o <<= 1) v += __shfl_xor(v, o);
    return v;
}
__device__ __forceinline__ float sigmoidf_(float x) { return 1.f / (1.f + __expf(-x)); }

namespace pg8 {
#define PG8_LAS __attribute__((address_space(3)))
typedef short bf16x8 __attribute__((ext_vector_type(8)));
typedef float f32x4 __attribute__((ext_vector_type(4)));
typedef unsigned u32x4 __attribute__((ext_vector_type(4)));
constexpr int BM = 256, BK = 64, HALF = 128, HTB = HALF * BK * 2  , STAGE_BYTES = 8 * HTB, NXCD = 8, WGM = 8;

__host__ __device__ __forceinline__ int lds_byte(int r, int c) { const int st = (r >> 4) * 2 + (c >> 5), rr = r & 15, cc = c & 31, ob = rr * 64 + cc * 2; return st * 1024 + (ob ^ (((ob >> 9) & 1) << 5)); }
__host__ __device__ __forceinline__ void stage_rc(int b, int& R, int& C) { const int st = b / 1024, sb = b % 1024, swz = sb ^ (((sb >> 9) & 1) << 5); R = (st >> 1) * 16 + swz / 64; C = (st & 1) * 32 + (swz % 64) / 2; }
__host__ __device__ __forceinline__ int perm32(int rho) { const int n = rho >> 4, i = rho & 15; return 8 * (i >> 2) + 4 * n + (i & 3); }

struct Unit { int pm, pn; };
struct Gemm { const bf16_t* A; const bf16_t* Bt; int lda, ldb, K; };

struct StaticOrder {
    int nM, nN, nwg, G, c;
    __host__ __device__ void init(int M, int N, int G_, int c_) { nM = M / BM; nN = N / BM; nwg = nM * nN; G = G_; c = c_; }
    __host__ __device__ bool next(int i, Unit& u) const {
        const long L = (long)i * G + c; if (L >= nwg) return false;
        int wgid = (int)L; { const int q = nwg / NXCD, r = nwg % NXCD, xcd = wgid % NXCD, off = wgid / NXCD; wgid = (xcd < r ? xcd * (q + 1) : r * (q + 1) + (xcd - r) * q) + off; }
        const int nig = WGM * nN, gid = wgid / nig, fm = gid * WGM, gsz = (nM - fm) < WGM ? (nM - fm) : WGM;
        u.pm = fm + ((wgid % nig) % gsz); u.pn = (wgid % nig) / gsz; return true;
    }
};
typedef float f32x2_c __attribute__((ext_vector_type(2))); typedef __bf16 bf16x2_c __attribute__((ext_vector_type(2)));
__device__ __forceinline__ unsigned cvt_pk_bf16(float lo, float hi) { const f32x2_c v = {lo, hi}; const bf16x2_c b = __builtin_convertvector(v, bf16x2_c); return __builtin_bit_cast(unsigned, b); }
__device__ __forceinline__ float bflo(unsigned w) { return __uint_as_float(w << 16); }
__device__ __forceinline__ float bfhi(unsigned w) { return __uint_as_float(w & 0xffff0000u); }

template <bool SSQ> struct EpiRowScale {
    static constexpr bool PERM = true;
    bf16_t* O; int ldc; const float* rs;
    __device__ __forceinline__ void operator()(const f32x4 (&acc)[2][2][4][2], const Unit& u, int wr, int wc, int fr, int fq) const {
        const int row0 = u.pm * BM + wr * 64 + fr, col0 = u.pn * BM + wc * 32 + 8 * fq;
#pragma unroll
        for (int ai = 0; ai < 2; ++ai)
#pragma unroll
            for (int m = 0; m < 4; ++m) {
                const int row = row0 + ai * HALF + m * 16;
                float s = rs[row]; if (SSQ) s = rsqrtf(s * (1.f / 1024.f) + NORM_EPS);
                bf16_t* rowp = O + (size_t)row * ldc + col0;
#pragma unroll
                for (int bj = 0; bj < 2; ++bj) {
                    const f32x4 v0 = acc[ai][bj][m][0] * s, v1 = acc[ai][bj][m][1] * s;
                    u32x4 w; w.x = cvt_pk_bf16(v0[0], v0[1]); w.y = cvt_pk_bf16(v0[2], v0[3]); w.z = cvt_pk_bf16(v1[0], v1[1]); w.w = cvt_pk_bf16(v1[2], v1[3]);
                    *(u32x4*)(rowp + bj * HALF) = w;
                }
            }
    }
};
template <bool ACCUM> struct EpiGate {
    static constexpr bool PERM = true;
    bf16_t* mg; const bf16_t* z; int gcol;
    __device__ __forceinline__ void operator()(const f32x4 (&acc)[2][2][4][2], const Unit& u, int wr, int wc, int fr, int fq) const {
        const int row0 = u.pm * BM + wr * 64 + fr, col0 = u.pn * BM + wc * 32 + 8 * fq;
#pragma unroll
        for (int ai = 0; ai < 2; ++ai)
#pragma unroll
            for (int m = 0; m < 4; ++m) {
                const int row = row0 + ai * HALF + m * 16;
                const bf16_t* gp = z + (size_t)row * NZ + gcol + col0;
                bf16_t* rowp = mg + (size_t)row * DM + col0;
#pragma unroll
                for (int bj = 0; bj < 2; ++bj) {
                    const u32x4 g = *(const u32x4*)(gp + bj * HALF);
                    const f32x4 a0 = acc[ai][bj][m][0], a1 = acc[ai][bj][m][1];
                    float r[8];
                    r[0] = sigmoidf_(bflo(g.x)) * a0[0]; r[1] = sigmoidf_(bfhi(g.x)) * a0[1]; r[2] = sigmoidf_(bflo(g.y)) * a0[2]; r[3] = sigmoidf_(bfhi(g.y)) * a0[3];
                    r[4] = sigmoidf_(bflo(g.z)) * a1[0]; r[5] = sigmoidf_(bfhi(g.z)) * a1[1]; r[6] = sigmoidf_(bflo(g.w)) * a1[2]; r[7] = sigmoidf_(bfhi(g.w)) * a1[3];
                    if (ACCUM) { const u32x4 o = *(const u32x4*)(rowp + bj * HALF);
                        r[0] += bflo(o.x); r[1] += bfhi(o.x); r[2] += bflo(o.y); r[3] += bfhi(o.y); r[4] += bflo(o.z); r[5] += bfhi(o.z); r[6] += bflo(o.w); r[7] += bfhi(o.w); }
                    u32x4 w; w.x = cvt_pk_bf16(r[0], r[1]); w.y = cvt_pk_bf16(r[2], r[3]); w.z = cvt_pk_bf16(r[4], r[5]); w.w = cvt_pk_bf16(r[6], r[7]);
                    *(u32x4*)(rowp + bj * HALF) = w;
                }
            }
    }
};
struct EpiX2 {
    static constexpr bool PERM = true;
    const float* x; float* x2; bf16_t* x2b; float* ssq;
    __device__ __forceinline__ void operator()(const f32x4 (&acc)[2][2][4][2], const Unit& u, int wr, int wc, int fr, int fq) const {
        const int row0 = u.pm * BM + wr * 64 + fr, col0 = u.pn * BM + wc * 32 + 8 * fq;
#pragma unroll
        for (int ai = 0; ai < 2; ++ai)
#pragma unroll
            for (int m = 0; m < 4; ++m) {
                const int row = row0 + ai * HALF + m * 16;
                const size_t off = (size_t)row * DM + col0;
                float ss = 0.f;
#pragma unroll
                for (int bj = 0; bj < 2; ++bj) {
                    const f32x4 x0 = *(const f32x4*)(x + off + bj * HALF), x1 = *(const f32x4*)(x + off + bj * HALF + 4);
                    const f32x4 o0 = x0 + acc[ai][bj][m][0], o1 = x1 + acc[ai][bj][m][1];
                    *(f32x4*)(x2 + off + bj * HALF) = o0; *(f32x4*)(x2 + off + bj * HALF + 4) = o1;
                    u32x4 w; w.x = cvt_pk_bf16(o0[0], o0[1]); w.y = cvt_pk_bf16(o0[2], o0[3]); w.z = cvt_pk_bf16(o1[0], o1[1]); w.w = cvt_pk_bf16(o1[2], o1[3]);
                    *(u32x4*)(x2b + off + bj * HALF) = w;
                    ss += (o0[0] * o0[0] + o0[1] * o0[1]) + (o0[2] * o0[2] + o0[3] * o0[3]) + (o1[0] * o1[0] + o1[1] * o1[1]) + (o1[2] * o1[2] + o1[3] * o1[3]);
                }
                ss += __shfl_xor(ss, 16); ss += __shfl_xor(ss, 32);
                if (fq == 0) atomicAdd(ssq + row, ss);
            }
    }
};

template <class Epi, class Sched>
__device__ __forceinline__ void gemm_phase(PG8_LAS unsigned char* lds, const Gemm g, const Sched& S, const Epi& E) {
    const int tid = threadIdx.x, wid = __builtin_amdgcn_readfirstlane(tid >> 6), lane = tid & 63, wr = wid >> 2, wc = wid & 3, fr = lane & 15, fq = lane >> 4;
    const int K = g.K, nt = K / BK;
    unsigned voffA[2], voffB[2];
#pragma unroll
    for (int i = 0; i < 2; ++i) { int R, C; stage_rc(tid * 16 + i * 8192, R, C); const int Rb = Epi::PERM ? ((R & ~31) + perm32(R & 31)) : R;
        voffA[i] = (unsigned)(R * g.lda + C) * 2u; voffB[i] = (unsigned)(Rb * g.ldb + C) * 2u; }
    const size_t kstep = (size_t)(BK * 2);
    const size_t hstepA = (size_t)HALF * g.lda * 2, hstepB = (size_t)HALF * g.ldb * 2;
    const size_t tstepA = 2 * hstepA, tstepB = 2 * hstepB;
    const unsigned ldsw = (unsigned)wid * 1024u;
    const int aoff = lds_byte(wr * 64 + fr, fq * 8), boff = lds_byte(wc * 32 + fr, fq * 8);
#define PG8_SA(b, h) (((b) * 2 + (h)) * HTB)
#define PG8_SB(b, h) ((4 + (b) * 2 + (h)) * HTB)
#define PG8_STAGE(bufoff, gbase, voff) do { _Pragma("unroll") for (int _i = 0; _i < 2; ++_i) \
        __builtin_amdgcn_global_load_lds((const unsigned*)((const char*)(gbase) + (voff)[_i]), (PG8_LAS unsigned*)(lds + (bufoff) + ldsw + _i * 8192), 16, 0, 0); } while (0)
#define PG8_LDA(dst, b, h) do { _Pragma("unroll") for (int m = 0; m < 4; ++m) _Pragma("unroll") for (int k = 0; k < 2; ++k) dst[m][k] = *(const PG8_LAS bf16x8*)(lds + PG8_SA(b, h) + aoff + m * 2048 + k * 1024); } while (0)
#define PG8_LDB(dst, b, h) do { _Pragma("unroll") for (int n = 0; n < 2; ++n) _Pragma("unroll") for (int k = 0; k < 2; ++k) dst[n][k] = *(const PG8_LAS bf16x8*)(lds + PG8_SB(b, h) + boff + n * 2048 + k * 1024); } while (0)
#define PG8_MMA(ai, bj, At, Bt) do { __builtin_amdgcn_s_setprio(1); _Pragma("unroll") for (int m = 0; m < 4; ++m) _Pragma("unroll") for (int n = 0; n < 2; ++n) _Pragma("unroll") for (int k = 0; k < 2; ++k) \
        acc[ai][bj][m][n] = __builtin_amdgcn_mfma_f32_16x16x32_bf16(Bt[n][k], At[m][k], acc[ai][bj][m][n], 0, 0, 0); __builtin_amdgcn_s_setprio(0); } while (0)
#define PG8_WAIT_V(n) asm volatile("s_waitcnt vmcnt(" #n ")" ::: "memory")
#define PG8_WAIT_L(n) asm volatile("s_waitcnt lgkmcnt(" #n ")" ::: "memory")
#define PG8_BAR __builtin_amdgcn_s_barrier()
#define PG8_SCHED __builtin_amdgcn_sched_barrier(0)
    Unit cur, nxt; int ui = 0;
    if (!S.next(0, cur)) return;
    f32x4 acc[2][2][4][2];
#pragma unroll
    for (int a = 0; a < 2; ++a)
#pragma unroll
        for (int b = 0; b < 2; ++b)
#pragma unroll
            for (int m = 0; m < 4; ++m)
#pragma unroll
                for (int n = 0; n < 2; ++n) acc[a][b][m][n] = (f32x4){0.f, 0.f, 0.f, 0.f};
    bf16x8 At[4][2], B0[2][2], B1[2][2];
    const char* cA = (const char*)g.A + (size_t)cur.pm * tstepA; const char* cB = (const char*)g.Bt + (size_t)cur.pn * tstepB;
    PG8_STAGE(PG8_SB(0, 0), cB, voffB); PG8_STAGE(PG8_SB(0, 1), cB + hstepB, voffB); PG8_STAGE(PG8_SA(0, 0), cA, voffA); PG8_STAGE(PG8_SA(0, 1), cA + hstepA, voffA);
    if (wr == 1) PG8_BAR;
    PG8_WAIT_V(2); PG8_BAR;
    PG8_STAGE(PG8_SB(1, 0), cB + kstep, voffB); PG8_STAGE(PG8_SA(1, 0), cA + kstep, voffA); PG8_STAGE(PG8_SB(1, 1), cB + hstepB + kstep, voffB);
    PG8_WAIT_V(6); PG8_BAR;
    for (;;) {
        const bool has_next = S.next(ui + 1, nxt);
        const char* nA = has_next ? (const char*)g.A + (size_t)nxt.pm * tstepA : cA; const char* nB = has_next ? (const char*)g.Bt + (size_t)nxt.pn * tstepB : cB;
        for (int t = 0; t < nt; t += 2) {
            const bool last = (t == nt - 2);
            const char* a1 = cA + (size_t)(t + 1) * kstep;
            const char* a2 = last ? nA : cA + (size_t)(t + 2) * kstep; const char* b2 = last ? nB : cB + (size_t)(t + 2) * kstep;
            const char* a3 = a2 + kstep; const char* b3 = b2 + kstep;
            PG8_LDB(B0, 0, 0); PG8_LDB(B1, 0, 1); PG8_SCHED; PG8_LDA(At, 0, 0); PG8_STAGE(PG8_SA(1, 1), a1 + hstepA, voffA);
            PG8_WAIT_V(8); PG8_WAIT_L(0); PG8_BAR; PG8_MMA(0, 0, At, B0); PG8_MMA(0, 1, At, B1); PG8_BAR; PG8_SCHED;
            PG8_LDA(At, 0, 1); PG8_STAGE(PG8_SB(0, 0), b2, voffB); PG8_STAGE(PG8_SB(0, 1), b2 + hstepB, voffB); PG8_STAGE(PG8_SA(0, 0), a2, voffA);
            PG8_WAIT_V(8); PG8_WAIT_L(0); PG8_BAR; PG8_MMA(1, 0, At, B0); PG8_MMA(1, 1, At, B1); PG8_BAR; PG8_SCHED;
            PG8_LDB(B0, 1, 0); PG8_LDB(B1, 1, 1); PG8_SCHED; PG8_LDA(At, 1, 0); PG8_STAGE(PG8_SA(0, 1), a2 + hstepA, voffA);
            PG8_WAIT_V(8); PG8_WAIT_L(0); PG8_BAR; PG8_MMA(0, 0, At, B0); PG8_MMA(0, 1, At, B1); PG8_BAR; PG8_SCHED;
            PG8_LDA(At, 1, 1); PG8_STAGE(PG8_SB(1, 0), b3, voffB); PG8_STAGE(PG8_SB(1, 1), b3 + hstepB, voffB); PG8_STAGE(PG8_SA(1, 0), a3, voffA);
            PG8_WAIT_V(8); PG8_WAIT_L(0); PG8_BAR; PG8_MMA(1, 0, At, B0); PG8_MMA(1, 1, At, B1); PG8_BAR; PG8_SCHED;
        }
        if (wr == 0) PG8_BAR;
        E(acc, cur, wr, wc, fr, fq);
        if (!has_next) break;
#pragma unroll
        for (int a = 0; a < 2; ++a)
#pragma unroll
            for (int b = 0; b < 2; ++b)
#pragma unroll
                for (int m = 0; m < 4; ++m)
#pragma unroll
                    for (int n = 0; n < 2; ++n) acc[a][b][m][n] = (f32x4){0.f, 0.f, 0.f, 0.f};
        cur = nxt; cA = nA; cB = nB; ++ui;
        if (wr == 1) PG8_BAR;
    }
    PG8_WAIT_V(0);
    PG8_BAR;
#undef PG8_SA
#undef PG8_SB
#undef PG8_STAGE
#undef PG8_LDA
#undef PG8_LDB
#undef PG8_MMA
#undef PG8_WAIT_V
#undef PG8_WAIT_L
#undef PG8_BAR
#undef PG8_SCHED
}
}

constexpr int NWAVES = 8;
constexpr int LDS_RING_BYTES = 131072, LDSCTL_OFF = 143360, MISC_OFF = LDSCTL_OFF + 320, LDS_BYTES = 147456;
#define LAS __attribute__((address_space(3)))
#define GAS __attribute__((address_space(1)))
typedef float f32x4 __attribute__((ext_vector_type(4)));
typedef unsigned v4u __attribute__((ext_vector_type(4)));
typedef unsigned v2u __attribute__((ext_vector_type(2)));
#define LDS_WAIT() asm volatile("s_waitcnt lgkmcnt(0)" ::: "memory")

constexpr int CW_BAR = 4096;
#define XB_TMO      128
#define XB_XCNT(j)  (256  + 64 * (j))
#define XB_XSUB(j)  (1280 + 64 * (j))
#define XB_XGEN(j)  (2304 + 64 * (j))
#define XB_TOP      3328
#define XB_TOPGEN   3392
#define XCD_BAR_WORDS 3456
#define XB_SPIN_CAP (1u << 20)
__device__ __forceinline__ unsigned xb_ld(unsigned* p)              { return __hip_atomic_load(p, __ATOMIC_RELAXED, __HIP_MEMORY_SCOPE_AGENT); }
__device__ __forceinline__ unsigned xb_add(unsigned* p, unsigned v) { return __hip_atomic_fetch_add(p, v, __ATOMIC_RELAXED, __HIP_MEMORY_SCOPE_AGENT); }
__device__ __forceinline__ unsigned xb_xcc_id() { return (unsigned)__builtin_amdgcn_s_getreg((3 << 11) | 20) & 0xFu; }
#define XB_SPIN(cond, bar) do { unsigned _sp = 0; while (cond) { __builtin_amdgcn_s_sleep(1); \
    if ((++_sp & 255u) == 0u) { if (xb_ld(&(bar)[XB_TMO])) break; if (_sp > XB_SPIN_CAP) { atomicAdd(&(bar)[XB_TMO], 1u); break; } } } } while (0)
struct XcdBarrier { unsigned* bar; unsigned x; volatile LAS unsigned* st; };
__device__ __forceinline__ XcdBarrier xcd_barrier_post(unsigned* bar, volatile LAS unsigned* st) {
    XcdBarrier b; b.bar = bar; b.x = xb_xcc_id(); b.st = st;
    if (threadIdx.x == 0) (void)xb_add(&bar[XB_XCNT(b.x)], 1u);
    return b;
}
__device__ __forceinline__ void xcd_barrier_complete(unsigned* bar, unsigned x, unsigned& nloc, unsigned& nx) {
    const unsigned G = gridDim.x * gridDim.y * gridDim.z;
    unsigned sum, cnt, mine, sp = 0u;
    for (;;) {
        sum = 0u; cnt = 0u; mine = 0u;
#pragma unroll
        for (unsigned j = 0; j < 16; ++j) { const unsigned c = xb_ld(&bar[XB_XCNT(j)]); sum += c; cnt += (c > 0u) ? 1u : 0u; mine = (j == x) ? c : mine; }
        if (sum == G) break;
        __builtin_amdgcn_s_sleep(1);
        if ((++sp & 255u) == 0u) { if (xb_ld(&bar[XB_TMO])) break; if (sp > XB_SPIN_CAP) { atomicAdd(&bar[XB_TMO], 1u); break; } }
    }
    nloc = mine > 0u ? mine : 1u; nx = cnt > 0u ? cnt : 1u;
}
__device__ __forceinline__ void xcd_barrier(const XcdBarrier& b) {
    asm volatile("s_waitcnt vmcnt(0)" ::: "memory");
    __syncthreads();
    if (threadIdx.x == 0) {
        unsigned* bar = b.bar;
        __builtin_amdgcn_s_waitcnt(0);
        unsigned nloc = b.st[0], nx = b.st[1];
        if (nloc == 0u) { xcd_barrier_complete(bar, b.x, nloc, nx); b.st[0] = nloc; b.st[1] = nx; }
        const unsigned old = xb_add(&bar[XB_XSUB(b.x)], 1u);
        const unsigned gen = old / nloc;
        if (old + 1u == (gen + 1u) * nloc) {
            __builtin_amdgcn_fence(__ATOMIC_RELEASE, "agent");
            asm volatile("s_waitcnt vmcnt(0)" ::: "memory");
            const unsigned og = xb_add(&bar[XB_TOP], 1u);
            const unsigned tg = og / nx;
            if (og + 1u == (tg + 1u) * nx) xb_add(&bar[XB_TOPGEN], 1u);
            else XB_SPIN(xb_ld(&bar[XB_TOPGEN]) == tg, bar);
            __builtin_amdgcn_fence(__ATOMIC_ACQUIRE, "agent");
            xb_add(&bar[XB_XGEN(b.x)], 1u);
            asm volatile("s_waitcnt vmcnt(0)" ::: "memory");
        } else {
            XB_SPIN(xb_ld(&bar[XB_XGEN(b.x)]) == gen, bar);
            __builtin_amdgcn_fence(__ATOMIC_ACQUIRE, "agent");
            asm volatile("s_waitcnt vmcnt(0)" ::: "memory");
        }
    }
    __syncthreads();
}

struct Args { const float* in[28]; float* out; unsigned char* ws; int ph_lo, ph_hi, li, pad; };

__device__ __forceinline__ void p0_transpose_item(const float* W, const float* sc, int K, int N, bf16_t* WT, LAS float* scr, int item, int lane) {
    const int nblk = N / 32, kb = item / nblk, nb = item % nblk, k0 = 64 * kb, n0 = 32 * nb;
#pragma unroll 8
    for (int i = 0; i < 32; ++i) { const int kk = 2 * i + (lane >> 5); const float s = sc ? sc[k0 + kk] : 1.f; scr[kk * 33 + (lane & 31)] = W[(size_t)(k0 + kk) * N + n0 + (lane & 31)] * s; }
    LDS_WAIT(); asm volatile("" ::: "memory");
    const int c = lane & 7;
#pragma unroll
    for (int j = 0; j < 4; ++j) { const int n = (lane >> 3) + 8 * j; const LAS float* s = scr + (8 * c) * 33 + n;
        v4u o; o.x = pg8::cvt_pk_bf16(s[0 * 33], s[1 * 33]); o.y = pg8::cvt_pk_bf16(s[2 * 33], s[3 * 33]); o.z = pg8::cvt_pk_bf16(s[4 * 33], s[5 * 33]); o.w = pg8::cvt_pk_bf16(s[6 * 33], s[7 * 33]);
        *(v4u*)(WT + (size_t)(n0 + n) * K + k0 + 8 * c) = o; }
    LDS_WAIT(); asm volatile("" ::: "memory");
}
__device__ __forceinline__ void p0_row_fp8(const float* in, const float* cs, unsigned char* out, float* sc, int lane) {
    f32x4 v[4]; float mx = 0.f;
#pragma unroll
    for (int i = 0; i < 4; ++i) { v[i] = *(const f32x4*)(in + lane * 16 + 4 * i); if (cs) v[i] = v[i] * *(const f32x4*)(cs + lane * 16 + 4 * i);
        mx = fmaxf(mx, fmaxf(fmaxf(fabsf(v[i][0]), fabsf(v[i][1])), fmaxf(fabsf(v[i][2]), fabsf(v[i][3])))); }
#pragma unroll
    for (int o = 1; o < 64; o <<= 1) mx = fmaxf(mx, __shfl_xor(mx, o));
    mx = fmaxf(mx, 1e-30f);
    const float q = 448.f / mx;
    v4u w;
#pragma unroll
    for (int i = 0; i < 4; ++i) { int p = 0; p = __builtin_amdgcn_cvt_pk_fp8_f32(v[i][0] * q, v[i][1] * q, p, false); p = __builtin_amdgcn_cvt_pk_fp8_f32(v[i][2] * q, v[i][3] * q, p, true); w[i] = (unsigned)p; }
    *(v4u*)(out + lane * 16) = w;
    if (lane == 0) *sc = mx * (1.f / 448.f);
}
__device__ __forceinline__ void p0_convert(const float* in, const float* cs, bf16_t* out, size_t n, int gw, int NGW, int lane) {
    for (size_t i = ((size_t)gw * 64 + lane) * 8; i < n; i += (size_t)NGW * 512) {
        f32x4 a = *(const f32x4*)(in + i), b = *(const f32x4*)(in + i + 4);
        if (cs) { const int c = (int)(i & 1023); a = a * *(const f32x4*)(cs + c); b = b * *(const f32x4*)(cs + c + 4); }
        v4u o; o.x = pg8::cvt_pk_bf16(a[0], a[1]); o.y = pg8::cvt_pk_bf16(a[2], a[3]); o.z = pg8::cvt_pk_bf16(b[0], b[1]); o.w = pg8::cvt_pk_bf16(b[2], b[3]);
        *(v4u*)(out + i) = o;
    }
}

namespace da {
typedef short bf16x8 __attribute__((ext_vector_type(8)));
typedef short s16x4 __attribute__((ext_vector_type(4)));
typedef float f32x16 __attribute__((ext_vector_type(16)));
constexpr float LOG2E = 1.4426950408889634f;
constexpr int SLOT = 32768, SCR_OFF = 65536, COMB_OFF = 69632;
__device__ __forceinline__ int crow(int r, int hi) { return (r & 3) + 8 * (r >> 2) + 4 * hi; }
__device__ __forceinline__ s16x4 vtr(const LAS unsigned char* p) { return __builtin_bit_cast(s16x4, __builtin_amdgcn_ds_read_tr16_b64_v4i16((LAS s16x4*)p)); }

__device__ __forceinline__ void attn_unit(LAS unsigned char* lds, const bf16_t* __restrict__ z, bf16_t* __restrict__ yb, const float* __restrict__ subln_w, float lam,
                                          int b, int h, int qblk, int wave, int lane) {
    const int r32 = lane & 31, hi = lane >> 5, map = wave >> 2, qs = wave & 3;
    const int q0 = qblk * 128 + qs * 32;
    const size_t rowb = (size_t)b * SEQ;
    const float slope2 = exp2f(-2.f * (float)(h + 1)) * LOG2E;
    bf16x8 qr[4];
    {
        const bf16_t* qp = z + (rowb + q0 + r32) * NZ + C_Q + h * 128 + map * 64 + hi * 8;
        constexpr float c2 = 0.125f * LOG2E;
#pragma unroll
        for (int d0 = 0; d0 < 4; ++d0) {
            const v4u w = *(const v4u*)(qp + d0 * 16);
            v4u o; o.x = pg8::cvt_pk_bf16(pg8::bflo(w.x) * c2, pg8::bfhi(w.x) * c2); o.y = pg8::cvt_pk_bf16(pg8::bflo(w.y) * c2, pg8::bfhi(w.y) * c2);
            o.z = pg8::cvt_pk_bf16(pg8::bflo(w.z) * c2, pg8::bfhi(w.z) * c2); o.w = pg8::cvt_pk_bf16(pg8::bflo(w.w) * c2, pg8::bfhi(w.w) * c2);
            qr[d0] = __builtin_bit_cast(bf16x8, o);
        }
    }
    const int qpos = q0 + r32;
    const float qterm = slope2 * (float)(4 * hi - qpos);
    LAS float* wsf = (LAS float*)(lds + SCR_OFF) + wave * 64;
    f32x16 o[4];
#pragma unroll
    for (int d = 0; d < 4; ++d) o[d] = (f32x16){};
    float m = -1e30f, lsum = 0.f;
    const int NT = 2 * qblk + 2;
    const bf16_t* ksrc0 = z + (rowb + lane) * NZ + C_ZK + h * 128 + wave * 8;
    const int pc0 = 2 * wave, pc1 = 2 * wave + 1;
    const bf16_t* vsrc0 = z + (rowb + 16 * (pc0 & 3) + (lane >> 2)) * NZ + C_ZV + h * 128 + 32 * (pc0 >> 2) + (lane & 3) * 8;
    const bf16_t* vsrc1 = z + (rowb + 16 * (pc1 & 3) + (lane >> 2)) * NZ + C_ZV + h * 128 + 32 * (pc1 >> 2) + (lane & 3) * 8;
#define DA_STAGE(j, slot) do { const size_t _o = (size_t)(j) * 64 * NZ; LAS unsigned char* _s = lds + (slot) * SLOT; \
        __builtin_amdgcn_global_load_lds((const unsigned*)(ksrc0 + _o), (LAS unsigned*)(_s + wave * 1024), 16, 0, 0); \
        __builtin_amdgcn_global_load_lds((const unsigned*)(ksrc0 + _o + 64), (LAS unsigned*)(_s + 8192 + wave * 1024), 16, 0, 0); \
        __builtin_amdgcn_global_load_lds((const unsigned*)(vsrc0 + _o), (LAS unsigned*)(_s + 16384 + pc0 * 1024), 16, 0, 0); \
        __builtin_amdgcn_global_load_lds((const unsigned*)(vsrc1 + _o), (LAS unsigned*)(_s + 16384 + pc1 * 1024), 16, 0, 0); } while (0)
    DA_STAGE(0, 0);
    for (int j = 0; j < NT; ++j) {
        asm volatile("s_waitcnt vmcnt(0)" ::: "memory");
        __syncthreads();
        if (j + 1 < NT) DA_STAGE(j + 1, (j + 1) & 1);
        if (64 * j > q0 + 31) continue;
        const LAS unsigned char* slot = lds + (j & 1) * SLOT;
        f32x16 c0, c1;
        {
            const float tb = slope2 * (float)(64 * j) + qterm;
#pragma unroll
            for (int r = 0; r < 16; ++r) { c0[r] = tb + slope2 * (float)((r & 3) + 8 * (r >> 2)); c1[r] = c0[r] + 32.f * slope2; }
        }
        const LAS unsigned char* kb = slot + map * 8192 + hi * 1024 + r32 * 16;
#pragma unroll
        for (int d0 = 0; d0 < 4; ++d0) {
            const bf16x8 k0 = *(const LAS bf16x8*)(kb + d0 * 2048), k1 = *(const LAS bf16x8*)(kb + d0 * 2048 + 512);
            c0 = __builtin_amdgcn_mfma_f32_32x32x16_bf16(k0, qr[d0], c0, 0, 0, 0);
            c1 = __builtin_amdgcn_mfma_f32_32x32x16_bf16(k1, qr[d0], c1, 0, 0, 0);
        }
        if (64 * j + 63 > q0) {
            const int kb0 = 64 * j + 4 * hi;
#pragma unroll
            for (int r = 0; r < 16; ++r) { const int kv = kb0 + (r & 3) + 8 * (r >> 2); if (kv > qpos) c0[r] = -INFINITY; if (kv + 32 > qpos) c1[r] = -INFINITY; }
        }
        float mt = fmaxf(c0[0], c1[0]);
#pragma unroll
        for (int r = 1; r < 16; ++r) mt = fmaxf(mt, fmaxf(c0[r], c1[r]));
        mt = fmaxf(mt, __shfl_xor(mt, 32));
        const float mnew = fmaxf(m, mt);
        if (__any(mnew > m)) {
            const float alpha = __builtin_amdgcn_exp2f(m - mnew);
            lsum *= alpha;
            if (hi == 0) wsf[r32] = alpha;
            float a[16];
#pragma unroll
            for (int g = 0; g < 4; ++g) { const f32x4 t = *(const LAS f32x4*)(wsf + 8 * g + 4 * hi); a[4 * g] = t[0]; a[4 * g + 1] = t[1]; a[4 * g + 2] = t[2]; a[4 * g + 3] = t[3]; }
#pragma unroll
            for (int d = 0; d < 4; ++d)
#pragma unroll
                for (int r = 0; r < 16; ++r) o[d][r] *= a[r];
        }
        m = mnew;
        float ps = 0.f;
#pragma unroll
        for (int r = 0; r < 16; ++r) { c0[r] = __builtin_amdgcn_exp2f(c0[r] - m); c1[r] = __builtin_amdgcn_exp2f(c1[r] - m); ps += c0[r] + c1[r]; }
        lsum += ps;
        v4u pw[4];
#pragma unroll
        for (int g = 0; g < 2; ++g) {
            pw[g].x = pg8::cvt_pk_bf16(c0[8 * g], c0[8 * g + 1]); pw[g].y = pg8::cvt_pk_bf16(c0[8 * g + 2], c0[8 * g + 3]); pw[g].z = pg8::cvt_pk_bf16(c0[8 * g + 4], c0[8 * g + 5]); pw[g].w = pg8::cvt_pk_bf16(c0[8 * g + 6], c0[8 * g + 7]);
            pw[2 + g].x = pg8::cvt_pk_bf16(c1[8 * g], c1[8 * g + 1]); pw[2 + g].y = pg8::cvt_pk_bf16(c1[8 * g + 2], c1[8 * g + 3]); pw[2 + g].z = pg8::cvt_pk_bf16(c1[8 * g + 4], c1[8 * g + 5]); pw[2 + g].w = pg8::cvt_pk_bf16(c1[8 * g + 6], c1[8 * g + 7]);
        }
        const LAS unsigned char* vb = slot + 16384 + ((lane >> 4) & 1) * 32 + (lane & 3) * 8 + (4 * hi + ((lane & 15) >> 2)) * 64;
#pragma unroll
        for (int d = 0; d < 4; ++d)
#pragma unroll
            for (int kg = 0; kg < 4; ++kg) {
                const s16x4 lo = vtr(vb + (d * 4 + kg) * 1024), hh = vtr(vb + (d * 4 + kg) * 1024 + 512);
                const bf16x8 vf = (bf16x8){lo[0], lo[1], lo[2], lo[3], hh[0], hh[1], hh[2], hh[3]};
                o[d] = __builtin_amdgcn_mfma_f32_32x32x16_bf16(__builtin_bit_cast(bf16x8, pw[kg]), vf, o[d], 0, 0, 0);
            }
    }
#undef DA_STAGE
    lsum += __shfl_xor(lsum, 32);
    if (hi == 0) wsf[r32] = 1.f / lsum;
    float il[16];
#pragma unroll
    for (int g = 0; g < 4; ++g) { const f32x4 t = *(const LAS f32x4*)(wsf + 8 * g + 4 * hi); il[4 * g] = t[0]; il[4 * g + 1] = t[1]; il[4 * g + 2] = t[2]; il[4 * g + 3] = t[3]; }
    LAS float* comb = (LAS float*)(lds + COMB_OFF) + qs * 4096;
    if (map == 1) {
#pragma unroll
        for (int d = 0; d < 4; ++d)
#pragma unroll
            for (int r = 0; r < 16; ++r) comb[crow(r, hi) * 128 + 32 * d + r32] = o[d][r] * il[r];
    }
    __syncthreads();
    if (map == 0) {
        float sw[4];
#pragma unroll
        for (int d = 0; d < 4; ++d) sw[d] = subln_w[32 * d + r32] * (1.f - LAM_INIT);
#pragma unroll
        for (int r = 0; r < 16; ++r) {
            float v[4], ss = 0.f;
#pragma unroll
            for (int d = 0; d < 4; ++d) { v[d] = o[d][r] * il[r] - lam * comb[crow(r, hi) * 128 + 32 * d + r32]; ss += v[d] * v[d]; }
            ss += __shfl_xor(ss, 1); ss += __shfl_xor(ss, 2); ss += __shfl_xor(ss, 4); ss += __shfl_xor(ss, 8); ss += __shfl_xor(ss, 16);
            const float rs = rsqrtf(ss * (1.f / 128.f) + SUBLN_EPS);
            bf16_t* op = yb + (rowb + q0 + crow(r, hi)) * 512 + h * 128 + r32;
#pragma unroll
            for (int d = 0; d < 4; ++d) op[32 * d] = f2bf(v[d] * rs * sw[d]);
        }
    }
    __syncthreads();
}
}

namespace rw {
typedef short bf16x8 __attribute__((ext_vector_type(8)));
typedef float f32x2 __attribute__((ext_vector_type(2)));
constexpr int CH = 32, ACT_PITCH = 528;
constexpr int OFF_ACT = 0, OFF_RKV = 16896, OFF_VEC = 41472, OFF_G = 82432, OFF_Y = 90624, OFF_NRM = 98816, OFF_SCL = 99328, OFF_CT = 99840;
template <int CTRL> __device__ __forceinline__ float dppf(float x) { return __builtin_bit_cast(float, __builtin_amdgcn_mov_dpp(__builtin_bit_cast(int, x), CTRL, 0xf, 0xf, true)); }
__device__ __forceinline__ float row_allsum(float v) { v += dppf<0x128>(v); v += dppf<0x124>(v); v += dppf<0x122>(v); v += dppf<0x121>(v); return v; }
__device__ __forceinline__ void row_allsum4(float& a, float& b, float& c, float& d) {
#define RW_DPP4(n) "v_add_f32_dpp %0, %0, %0 row_ror:" #n " row_mask:0xf bank_mask:0xf\n\tv_add_f32_dpp %1, %1, %1 row_ror:" #n " row_mask:0xf bank_mask:0xf\n\t" \
                   "v_add_f32_dpp %2, %2, %2 row_ror:" #n " row_mask:0xf bank_mask:0xf\n\tv_add_f32_dpp %3, %3, %3 row_ror:" #n " row_mask:0xf bank_mask:0xf\n\t"
    asm volatile("s_nop 1\n\t" RW_DPP4(8) RW_DPP4(4) RW_DPP4(2) RW_DPP4(1) "s_nop 1" : "+v"(a), "+v"(b), "+v"(c), "+v"(d));
#undef RW_DPP4
}
__device__ __forceinline__ f32x4 ld4bf(const bf16_t* p) { const v2u w = *(const v2u*)p; return (f32x4){pg8::bflo(w.x), pg8::bfhi(w.x), pg8::bflo(w.y), pg8::bfhi(w.y)}; }
__device__ __forceinline__ float fsig(float x) { return __builtin_amdgcn_rcpf(1.f + __expf(-x)); }
__device__ __forceinline__ float ftanh(float x) { return 1.f - 2.f * __builtin_amdgcn_rcpf(1.f + __expf(2.f * x)); }
struct ZRow { v2u r, k, v, w, a; v4u g; };
__device__ __forceinline__ ZRow ldrow(const bf16_t* zr, int c4, int cg) {
    ZRow o; o.r = *(const v2u*)(zr + C_R + c4); o.k = *(const v2u*)(zr + C_K + c4); o.v = *(const v2u*)(zr + C_V + c4); o.w = *(const v2u*)(zr + C_WL + 4 * cg); o.a = *(const v2u*)(zr + C_AL + 4 * cg);
    o.g = *(const v4u*)(zr + C_GL + 8 * cg); return o;
}
__device__ __forceinline__ f32x4 up4(v2u w) { return (f32x4){pg8::bflo(w.x), pg8::bfhi(w.x), pg8::bflo(w.y), pg8::bfhi(w.y)}; }

struct ScanP { const float *mu, *w0, *w2, *a0, *a2, *g2, *k_k, *k_a, *r_k, *lnx_w, *lnx_b; };
__device__ __forceinline__ void scan_unit(LAS unsigned char* lds, const bf16_t* __restrict__ z, bf16_t* __restrict__ ya, const ScanP P, int b, int h, int tid, int wave, int lane) {
    const float* mu = P.mu; const float* w0 = P.w0; const float* w2 = P.w2; const float* a0 = P.a0; const float* a2 = P.a2; const float* g2 = P.g2;
    const float* k_k = P.k_k; const float* k_a = P.k_a; const float* r_k = P.r_k; const float* lnx_w = P.lnx_w; const float* lnx_b = P.lnx_b;
    const size_t rowb = (size_t)b * SEQ;
    const int tl = tid >> 4, cg = tid & 15;
    const int nt = wave & 3, rl = lane & 15, rg = lane >> 4;
    LAS float* rkv = (LAS float*)(lds + OFF_RKV); LAS float* vec = (LAS float*)(lds + OFF_VEC); LAS float* gbuf = (LAS float*)(lds + OFF_G);
    LAS float* ybuf = (LAS float*)(lds + OFF_Y); LAS float* nrm = (LAS float*)(lds + OFF_NRM); LAS float* scl = (LAS float*)(lds + OFF_SCL);
    bf16x8 bfr[8];
    {
        const int col = h * 64 + 16 * nt + rl;
#pragma unroll
        for (int f = 0; f < 8; ++f) {
            const float* src = (f < 2) ? w2 : (f < 4) ? a2 : g2;
            const int kb = ((f < 4) ? 32 * (f & 1) : 32 * (f - 4)) + 8 * rg;
            float e[8];
#pragma unroll
            for (int j = 0; j < 8; ++j) e[j] = src[(size_t)(kb + j) * 512 + col];
            v4u p; p.x = pg8::cvt_pk_bf16(e[0], e[1]); p.y = pg8::cvt_pk_bf16(e[2], e[3]); p.z = pg8::cvt_pk_bf16(e[4], e[5]); p.w = pg8::cvt_pk_bf16(e[6], e[7]);
            bfr[f] = __builtin_bit_cast(bf16x8, p);
        }
    }
    const int mt = wave >> 2;
    const int hc = h * 64 + 16 * nt + rl;
    const float w0c = w0[hc], a0c = a0[hc], kkc = k_k[hc], kac = k_a[hc], rkc = r_k[hc];
    const int c4 = h * 64 + 4 * cg;
    f32x2 St[4];
#pragma unroll
    for (int i = 0; i < 4; ++i) St[i] = (f32x2){0.f, 0.f};
    const int ra = 8 * wave + 2 * rg;
    LAS float* ctab = (LAS float*)(lds + OFF_CT);
    if (tl == 0) {
        LAS float* ct = ctab + cg * 36;
        *(LAS f32x4*)(ct + 0) = *(const f32x4*)(mu + C_R + c4); *(LAS f32x4*)(ct + 4) = *(const f32x4*)(mu + C_K + c4); *(LAS f32x4*)(ct + 8) = *(const f32x4*)(mu + C_V + c4);
        *(LAS f32x4*)(ct + 12) = *(const f32x4*)(mu + C_WL + 4 * cg); *(LAS f32x4*)(ct + 16) = *(const f32x4*)(mu + C_AL + 4 * cg);
        *(LAS f32x4*)(ct + 20) = *(const f32x4*)(mu + C_GL + 8 * cg); *(LAS f32x4*)(ct + 24) = *(const f32x4*)(mu + C_GL + 8 * cg + 4);
        *(LAS f32x4*)(ct + 28) = *(const f32x4*)(lnx_w + c4); *(LAS f32x4*)(ct + 32) = *(const f32x4*)(lnx_b + c4);
    }
    __syncthreads();
    const LAS float* myct = ctab + cg * 36;
    ZRow zc = ldrow(z + (rowb + tl) * NZ, c4, cg), zp;
    if (tl > 0) zp = ldrow(z + (rowb + tl - 1) * NZ, c4, cg); else { zp.r = zp.k = zp.v = zp.w = zp.a = (v2u){0u, 0u}; zp.g = (v4u){0u, 0u, 0u, 0u}; }
    for (int t0 = 0; t0 < SEQ; t0 += CH) {
        {
            const f32x4 cr = up4(zc.r), ck = up4(zc.k), cv = up4(zc.v), cw = up4(zc.w), ca = up4(zc.a);
            const f32x4 cg0 = (f32x4){pg8::bflo(zc.g.x), pg8::bfhi(zc.g.x), pg8::bflo(zc.g.y), pg8::bfhi(zc.g.y)}, cg1 = (f32x4){pg8::bflo(zc.g.z), pg8::bfhi(zc.g.z), pg8::bflo(zc.g.w), pg8::bfhi(zc.g.w)};
            const f32x4 pr = up4(zp.r), pk = up4(zp.k), pv = up4(zp.v), pw = up4(zp.w), pa = up4(zp.a);
            const f32x4 pg0 = (f32x4){pg8::bflo(zp.g.x), pg8::bfhi(zp.g.x), pg8::bflo(zp.g.y), pg8::bfhi(zp.g.y)}, pg1 = (f32x4){pg8::bflo(zp.g.z), pg8::bfhi(zp.g.z), pg8::bflo(zp.g.w), pg8::bfhi(zp.g.w)};
            if (t0 + CH < SEQ) { zc = ldrow(z + (rowb + t0 + CH + tl) * NZ, c4, cg); zp = ldrow(z + (rowb + t0 + CH + tl - 1) * NZ, c4, cg); }
            const f32x4 rs_ = cr + (pr - cr) * *(const LAS f32x4*)(myct + 0), ks_ = ck + (pk - ck) * *(const LAS f32x4*)(myct + 4), vs_ = cv + (pv - cv) * *(const LAS f32x4*)(myct + 8);
            const f32x4 ws_ = cw + (pw - cw) * *(const LAS f32x4*)(myct + 12), as_ = ca + (pa - ca) * *(const LAS f32x4*)(myct + 16);
            const f32x4 g0_ = cg0 + (pg0 - cg0) * *(const LAS f32x4*)(myct + 20), g1_ = cg1 + (pg1 - cg1) * *(const LAS f32x4*)(myct + 24);
            *(LAS f32x4*)(rkv + 0 * 2048 + tl * 64 + 4 * cg) = rs_; *(LAS f32x4*)(rkv + 1 * 2048 + tl * 64 + 4 * cg) = ks_; *(LAS f32x4*)(rkv + 2 * 2048 + tl * 64 + 4 * cg) = vs_;
            LAS unsigned char* ar = lds + OFF_ACT + tl * ACT_PITCH;
            v2u tw; tw.x = pg8::cvt_pk_bf16(ftanh(ws_[0]), ftanh(ws_[1])); tw.y = pg8::cvt_pk_bf16(ftanh(ws_[2]), ftanh(ws_[3]));
            *(LAS v2u*)(ar + 8 * cg) = tw;
            v2u aw; aw.x = pg8::cvt_pk_bf16(as_[0], as_[1]); aw.y = pg8::cvt_pk_bf16(as_[2], as_[3]);
            *(LAS v2u*)(ar + 128 + 8 * cg) = aw;
            v4u gw; gw.x = pg8::cvt_pk_bf16(fsig(g0_[0]), fsig(g0_[1])); gw.y = pg8::cvt_pk_bf16(fsig(g0_[2]), fsig(g0_[3]));
            gw.z = pg8::cvt_pk_bf16(fsig(g1_[0]), fsig(g1_[1])); gw.w = pg8::cvt_pk_bf16(fsig(g1_[2]), fsig(g1_[3]));
            *(LAS v4u*)(ar + 256 + 16 * cg) = gw;
            if (cg == 0) *(LAS f32x4*)(scl + 4 * tl) = (f32x4){0.f, 0.f, 0.f, 0.f};
        }
        __syncthreads();
        f32x4 accw = (f32x4){0.f, 0.f, 0.f, 0.f}, acca = accw, accg = accw;
        {
            const LAS unsigned char* ap = lds + OFF_ACT + (16 * mt + rl) * ACT_PITCH + 8 * rg * 2;
#pragma unroll
            for (int f = 0; f < 8; ++f) {
                const bf16x8 a = *(const LAS bf16x8*)(ap + f * 64);
                if (f < 2) accw = __builtin_amdgcn_mfma_f32_16x16x32_bf16(a, bfr[f], accw, 0, 0, 0);
                else if (f < 4) acca = __builtin_amdgcn_mfma_f32_16x16x32_bf16(a, bfr[f], acca, 0, 0, 0);
                else accg = __builtin_amdgcn_mfma_f32_16x16x32_bf16(a, bfr[f], accg, 0, 0, 0);
            }
        }
        float dec[4], av[4], kk[4];
        {
            const int c = 16 * nt + rl;
            float n2[4];
#pragma unroll
            for (int r = 0; r < 4; ++r) {
                const int tok = 16 * mt + 4 * rg + r;
                gbuf[tok * 64 + c] = accg[r];
                const float nx = -(w0c + accw[r]);
                const float sp = nx > 20.f ? nx : __logf(1.f + __expf(nx));
                dec[r] = __expf(-__expf(-sp - 0.5f));
                av[r] = fsig(a0c + acca[r]);
                kk[r] = rkv[1 * 2048 + tok * 64 + c] * kkc;
                n2[r] = kk[r] * kk[r];
            }
            row_allsum4(n2[0], n2[1], n2[2], n2[3]);
            if (rl == 0) {
#pragma unroll
                for (int r = 0; r < 4; ++r) nrm[(16 * mt + 4 * rg + r) * 4 + nt] = n2[r];
            }
        }
        __syncthreads();
        {
            const int c = 16 * nt + rl;
#pragma unroll
            for (int r = 0; r < 4; ++r) {
                const int tok = 16 * mt + 4 * rg + r;
                const f32x4 n4 = *(const LAS f32x4*)(nrm + tok * 4);
                const float ksv = rkv[1 * 2048 + tok * 64 + c], rsv = rkv[0 * 2048 + tok * 64 + c];
                const float inv = __builtin_amdgcn_rcpf(fmaxf(sqrtf((n4[0] + n4[1]) + (n4[2] + n4[3])), 1e-12f));
                const float kkn = kk[r] * inv, beta = kkn * av[r], kmod = ksv * (1.f + (av[r] - 1.f) * kac);
                LAS float* vp = vec + tok * 320 + c;
                vp[0] = dec[r]; vp[64] = beta; vp[128] = -kkn; vp[192] = kmod; vp[256] = dec[r] * rsv;
                float pbr = beta * rsv, pkr = kmod * rsv, pbo = rsv * kmod * rkc, dum = 0.f;
                row_allsum4(pbr, pkr, pbo, dum);
                if (rl == 0) { __hip_atomic_fetch_add(scl + tok * 4 + 0, pbr, __ATOMIC_RELAXED, __HIP_MEMORY_SCOPE_WORKGROUP); __hip_atomic_fetch_add(scl + tok * 4 + 1, pkr, __ATOMIC_RELAXED, __HIP_MEMORY_SCOPE_WORKGROUP); __hip_atomic_fetch_add(scl + tok * 4 + 2, pbo, __ATOMIC_RELAXED, __HIP_MEMORY_SCOPE_WORKGROUP); }
            }
        }
        __syncthreads();
        {
            const LAS float* vb0 = vec + 4 * rl; const LAS float* rv0 = rkv + 2 * 2048 + ra;
#define RW_DECL(P) f32x4 d4##P, b4##P, n4##P, k4##P, q4##P; f32x2 v2##P, s2##P
#define RW_LOAD(P, tk_) do { d4##P = *(const LAS f32x4*)(vb0 + (tk_) * 320); b4##P = *(const LAS f32x4*)(vb0 + (tk_) * 320 + 64); n4##P = *(const LAS f32x4*)(vb0 + (tk_) * 320 + 128); \
                k4##P = *(const LAS f32x4*)(vb0 + (tk_) * 320 + 192); q4##P = *(const LAS f32x4*)(vb0 + (tk_) * 320 + 256); \
                v2##P = *(const LAS f32x2*)(rv0 + (tk_) * 64); s2##P = *(const LAS f32x2*)(scl + (tk_) * 4); } while (0)
#define RW_STEP(P, tk_) do { \
                f32x2 sa = St[0] * n4##P[0] + St[1] * n4##P[1] + St[2] * n4##P[2] + St[3] * n4##P[3]; \
                f32x2 yy = St[0] * q4##P[0] + St[1] * q4##P[1] + St[2] * q4##P[2] + St[3] * q4##P[3]; \
                float sa0 = sa[0], sa1 = sa[1], yy0 = yy[0], yy1 = yy[1]; \
                row_allsum4(sa0, sa1, yy0, yy1); \
                sa = (f32x2){sa0, sa1}; \
                _Pragma("unroll") for (int i = 0; i < 4; ++i) St[i] = St[i] * d4##P[i] + sa * b4##P[i] + v2##P * k4##P[i]; \
                const f32x2 yo = (f32x2){yy0, yy1} + sa * s2##P[0] + v2##P * s2##P[1]; \
                if (rl == 0) *(LAS f32x2*)(ybuf + (tk_) * 64 + ra) = yo; } while (0)
            RW_DECL(A); RW_DECL(B);
            RW_LOAD(A, 0);
            for (int tk = 0; tk < CH; tk += 2) {
                RW_LOAD(B, tk + 1);
                RW_STEP(A, tk);
                if (tk + 2 < CH) RW_LOAD(A, tk + 2);
                RW_STEP(B, tk + 1);
            }
#undef RW_DECL
#undef RW_LOAD
#undef RW_STEP
        }
        __syncthreads();
        {
            const f32x4 y4 = *(const LAS f32x4*)(ybuf + tl * 64 + 4 * cg);
            const float mean = row_allsum((y4[0] + y4[1]) + (y4[2] + y4[3])) * (1.f / 64.f);
            const f32x4 dv = y4 - mean;
            const float var = row_allsum((dv[0] * dv[0] + dv[1] * dv[1]) + (dv[2] * dv[2] + dv[3] * dv[3])) * (1.f / 64.f);
            const float rs_ = rsqrtf(var + GN_EPS);
            const f32x4 yn = dv * rs_ * *(const LAS f32x4*)(myct + 28) + *(const LAS f32x4*)(myct + 32);
            const float bonus = scl[tl * 4 + 2];
            const f32x4 vs_ = *(const LAS f32x4*)(rkv + 2 * 2048 + tl * 64 + 4 * cg), g4 = *(const LAS f32x4*)(gbuf + tl * 64 + 4 * cg);
            const f32x4 o = (yn + vs_ * bonus) * g4;
            v2u w; w.x = pg8::cvt_pk_bf16(o[0], o[1]); w.y = pg8::cvt_pk_bf16(o[2], o[3]);
            *(v2u*)(ya + (rowb + t0 + tl) * 512 + c4) = w;
        }
        __syncthreads();
    }
}
}

typedef __bf16 bf16x2_t __attribute__((ext_vector_type(2)));
__device__ __forceinline__ float dot2bf(unsigned a, unsigned b, float c) { return __builtin_amdgcn_fdot2_f32_bf16(__builtin_bit_cast(bf16x2_t, a), __builtin_bit_cast(bf16x2_t, b), c, false); }
__device__ __forceinline__ unsigned f2ord(float f) { const unsigned u = __float_as_uint(f); return (u & 0x80000000u) ? ~u : (u | 0x80000000u); }
__device__ __forceinline__ float ord2f(unsigned o) { return __uint_as_float((o & 0x80000000u) ? (o ^ 0x80000000u) : ~o); }
__device__ __forceinline__ unsigned row_allmax_u32(unsigned v) {
    v = max(v, (unsigned)__builtin_amdgcn_update_dpp(0, (int)v, 0x128, 0xf, 0xf, false));
    v = max(v, (unsigned)__builtin_amdgcn_update_dpp(0, (int)v, 0x124, 0xf, 0xf, false));
    v = max(v, (unsigned)__builtin_amdgcn_update_dpp(0, (int)v, 0x122, 0xf, 0xf, false));
    v = max(v, (unsigned)__builtin_amdgcn_update_dpp(0, (int)v, 0x121, 0xf, 0xf, false));
    return v;
}

constexpr int TK_PITCH = 272, TK_HALF = 128 * TK_PITCH;
typedef short tk_bf16x8 __attribute__((ext_vector_type(8)));
__device__ __forceinline__ void topk_loadq(tk_bf16x8 (&qa)[8], const bf16_t* __restrict__ qb, int t0, int h, int lane) {
    const bf16_t* qp = qb + (size_t)(t0 + (lane & 15)) * 2048 + h * 256 + 8 * (lane >> 4);
#pragma unroll
    for (int i = 0; i < 8; ++i) qa[i] = *(const tk_bf16x8*)(qp + i * 32);
}
__device__ __forceinline__ void topk_item(const tk_bf16x8 (&qa)[8], const LAS unsigned char* klds, int* __restrict__ ids, float* __restrict__ gates, int t0, int h, int lane) {
    const int rl = lane & 15, rg = lane >> 4;
    unsigned top[2][4];
#pragma unroll
    for (int c = 0; c < 2; ++c) {
        f32x4 acc[8];
#pragma unroll
        for (int nt = 0; nt < 8; ++nt) acc[nt] = (f32x4){0.f, 0.f, 0.f, 0.f};
        const LAS unsigned char* kp = klds + c * TK_HALF + rl * TK_PITCH + 16 * rg;
#pragma unroll
        for (int ks = 0; ks < 4; ++ks) {
#pragma unroll
            for (int nt = 0; nt < 8; ++nt) { const tk_bf16x8 b = *(const LAS tk_bf16x8*)(kp + nt * 16 * TK_PITCH + ks * 64); acc[nt] = __builtin_amdgcn_mfma_f32_16x16x32_bf16(qa[c * 4 + ks], b, acc[nt], 0, 0, 0); }
            __builtin_amdgcn_sched_barrier(0);
        }
        unsigned key[4][8];
#pragma unroll
        for (int r = 0; r < 4; ++r)
#pragma unroll
            for (int nt = 0; nt < 8; ++nt) key[r][nt] = (f2ord(acc[nt][r]) & ~127u) | (unsigned)(127 - (nt * 16 + rl));
#pragma unroll
        for (int r = 0; r < 4; ++r) top[c][r] = 0u;
        for (int round = 0; round < 16; ++round) {
#pragma unroll
            for (int r = 0; r < 4; ++r) {
                unsigned lm = max(max(max(key[r][0], key[r][1]), max(key[r][2], key[r][3])), max(max(key[r][4], key[r][5]), max(key[r][6], key[r][7])));
                const unsigned m = row_allmax_u32(lm);
                top[c][r] = (rl == round) ? m : top[c][r];
#pragma unroll
                for (int nt = 0; nt < 8; ++nt) key[r][nt] = (key[r][nt] == m) ? 0u : key[r][nt];
            }
        }
    }
    const int rowbase = lane & 48;
    float v1[4], v0[4], sum[4], mye[4]; int n1[4], ptr[4], myid[4]; unsigned k2[4];
#pragma unroll
    for (int r = 0; r < 4; ++r) { v1[r] = ord2f(top[0][r] & ~127u); n1[r] = 127 - (int)(top[0][r] & 127u); ptr[r] = 0; k2[r] = (unsigned)__builtin_amdgcn_ds_bpermute(rowbase * 4, (int)top[1][r]); v0[r] = 0.f; sum[r] = 0.f; mye[r] = 0.f; myid[r] = 0; }
    for (int round = 0; round < 16; ++round) {
#pragma unroll
        for (int r = 0; r < 4; ++r) {
            const float head = v1[r] + ord2f(k2[r] & ~127u);
            const unsigned key = (ptr[r] < 16) ? ((f2ord(head) & ~15u) | (unsigned)(15 - rl)) : 0u;
            const unsigned m = row_allmax_u32(key);
            const float val = ord2f(m & ~15u);
            if (round == 0) v0[r] = val;
            const float e = __expf(val - v0[r]); sum[r] += e;
            mye[r] = (rl == round) ? e : mye[r];
            const bool win = (key == m);
            const unsigned wid = row_allmax_u32(win ? (unsigned)(n1[r] * 128 + (127 - (int)(k2[r] & 127u))) + 1u : 0u);
            myid[r] = (rl == round) ? (int)wid - 1 : myid[r];
            ptr[r] += win ? 1 : 0;
            k2[r] = (unsigned)__builtin_amdgcn_ds_bpermute((rowbase + (ptr[r] & 15)) * 4, (int)top[1][r]);
        }
    }
#pragma unroll
    for (int r = 0; r < 4; ++r) { gates[(size_t)(t0 + 4 * rg + r) * 128 + h * 16 + rl] = mye[r] / sum[r]; ids[(size_t)(t0 + 4 * rg + r) * 128 + h * 16 + rl] = myid[r]; }
}

typedef float f32x2 __attribute__((ext_vector_type(2)));
__device__ __forceinline__ void peer_token(const bf16_t* __restrict__ x2b, const float* __restrict__ ssq2, const int* __restrict__ ids, const float* __restrict__ gates,
                                           const unsigned char* __restrict__ U8, const unsigned char* __restrict__ V8, const float* __restrict__ usc, const float* __restrict__ vsc,
                                           const float* __restrict__ fw, float* __restrict__ out, int t, int lane) {
    const int l16 = lane * 16;
    f32x2 hx[8];
    {
        const v4u h0 = *(const v4u*)(x2b + (size_t)t * DM + l16), h1 = *(const v4u*)(x2b + (size_t)t * DM + l16 + 8);
        const unsigned hw[8] = {h0.x, h0.y, h0.z, h0.w, h1.x, h1.y, h1.z, h1.w};
#pragma unroll
        for (int i = 0; i < 8; ++i) hx[i] = (f32x2){pg8::bflo(hw[i]), pg8::bfhi(hw[i])};
    }
    const int idA = ids[(size_t)t * 128 + lane], idB = ids[(size_t)t * 128 + 64 + lane];
    const float rs = rsqrtf(ssq2[t] * (1.f / DM) + NORM_EPS);
    const float suA = rs * usc[idA], suB = rs * usc[idB];
    const float svA = gates[(size_t)t * 128 + lane] * vsc[idA], svB = gates[(size_t)t * 128 + 64 + lane] * vsc[idB];
    f32x2 y[8];
#pragma unroll
    for (int i = 0; i < 8; ++i) y[i] = (f32x2){0.f, 0.f};
    const int bit0 = lane & 1, bit1 = (lane >> 1) & 1, bit2 = (lane >> 2) & 1;
    const int myk = 4 * bit0 + 2 * bit1 + bit2;
    for (int g = 0; g < 16; ++g) {
        const int idsel = (g < 8) ? idA : idB; const float susel = (g < 8) ? suA : suB, svsel = (g < 8) ? svA : svB; const int lb = (g * 8) & 63;
        v4u uw[8], vw[8];
#pragma unroll
        for (int k = 0; k < 8; ++k) { const int e = __builtin_amdgcn_readlane(idsel, lb + k); uw[k] = *(const v4u*)(U8 + (size_t)e * DM + l16); vw[k] = *(const v4u*)(V8 + (size_t)e * DM + l16); }
        float d[8];
#pragma unroll
        for (int k = 0; k < 8; ++k) {
            f32x2 a = (f32x2){0.f, 0.f};
#pragma unroll
            for (int i = 0; i < 4; ++i) { a += __builtin_amdgcn_cvt_pk_f32_fp8((int)uw[k][i], false) * hx[2 * i]; a += __builtin_amdgcn_cvt_pk_f32_fp8((int)uw[k][i], true) * hx[2 * i + 1]; }
            d[k] = a[0] + a[1];
        }
        float r4[4];
#pragma unroll
        for (int k = 0; k < 4; ++k) { const float send = bit0 ? d[k] : d[k + 4], keep = bit0 ? d[k + 4] : d[k]; r4[k] = keep + __shfl_xor(send, 1); }
        float r2[2];
#pragma unroll
        for (int k = 0; k < 2; ++k) { const float send = bit1 ? r4[k] : r4[k + 2], keep = bit1 ? r4[k + 2] : r4[k]; r2[k] = keep + __shfl_xor(send, 2); }
        float r1;
        { const float send = bit2 ? r2[0] : r2[1], keep = bit2 ? r2[1] : r2[0]; r1 = keep + __shfl_xor(send, 4); }
        r1 += __shfl_xor(r1, 8); r1 += __shfl_xor(r1, 16); r1 += __shfl_xor(r1, 32);
        const float dd = r1 * __shfl(susel, lb + myk);
        const float act = 0.5f * dd * (1.f + erff(dd * 0.70710678118654752f)) * __shfl(svsel, lb + myk);
#pragma unroll
        for (int k = 0; k < 8; ++k) {
            const float a = __uint_as_float((unsigned)__builtin_amdgcn_readlane((int)__float_as_uint(act), ((k & 1) << 2) | (k & 2) | ((k >> 2) & 1)));
            const f32x2 a2 = (f32x2){a, a};
#pragma unroll
            for (int i = 0; i < 4; ++i) { y[2 * i] += __builtin_amdgcn_cvt_pk_f32_fp8((int)vw[k][i], false) * a2; y[2 * i + 1] += __builtin_amdgcn_cvt_pk_f32_fp8((int)vw[k][i], true) * a2; }
        }
    }
    float* orow = out + (size_t)t * DM + l16;
    float ss = 0.f;
    f32x4 o4[4];
#pragma unroll
    for (int i = 0; i < 4; ++i) { const f32x4 xv = *(const f32x4*)(orow + 4 * i); o4[i] = (f32x4){xv[0] + y[2 * i][0], xv[1] + y[2 * i][1], xv[2] + y[2 * i + 1][0], xv[3] + y[2 * i + 1][1]};
        ss += (o4[i][0] * o4[i][0] + o4[i][1] * o4[i][1]) + (o4[i][2] * o4[i][2] + o4[i][3] * o4[i][3]); }
    ss = wave_sum(ss);
    const float r = rsqrtf(ss * (1.f / DM) + NORM_EPS);
#pragma unroll
    for (int i = 0; i < 4; ++i) *(f32x4*)(orow + 4 * i) = o4[i] * r * *(const f32x4*)(fw + l16 + 4 * i);
}

__global__ void __launch_bounds__(NWAVES * 64, 2) mk_fwd(Args args) {
    extern __shared__ __attribute__((aligned(16))) unsigned char lds_raw[];
    LAS unsigned char* lds = (LAS unsigned char*)lds_raw;
    volatile LAS unsigned* MISC = (volatile LAS unsigned*)(lds + MISC_OFF);
    const int tid = threadIdx.x, lane = tid & 63, wave = __builtin_amdgcn_readfirstlane(tid >> 6);
    const int G = gridDim.x; const int bx = blockIdx.x; const int vcu = (G % 8 == 0) ? (bx % 8) * (G / 8) + bx / 8 : bx;
    unsigned char* ws = args.ws;
    unsigned* ctl = (unsigned*)(ws + WS_CTL);
    for (int u = tid; u < (LDS_BYTES - LDSCTL_OFF) / 4; u += NWAVES * 64) ((LAS unsigned*)(lds + LDSCTL_OFF))[u] = 0u;
    __syncthreads();
    XcdBarrier bar = xcd_barrier_post(ctl + CW_BAR + args.li * XCD_BAR_WORDS, MISC + 8);
    const int lo = args.ph_lo, hi = args.ph_hi;
#define IN(k) (lo <= (k) && (k) < hi)
#define BOTH(k) (IN(k) && IN((k) + 1))
    bf16_t* WinT = (bf16_t*)(ws + WS_WIN); bf16_t* PaT = (bf16_t*)(ws + WS_PA); bf16_t* PbT = (bf16_t*)(ws + WS_PB); bf16_t* WoT = (bf16_t*)(ws + WS_WO);
    bf16_t* WqT = (bf16_t*)(ws + WS_WQ); bf16_t* KeysB = (bf16_t*)(ws + WS_KEYS);
    float* rstd1 = (float*)(ws + WS_RSTD1); float* ssq2 = (float*)(ws + WS_RSTD2); float* scal = (float*)(ws + WS_SCAL);
    unsigned char* U8 = ws + WS_U; unsigned char* V8 = ws + WS_V; float* usc = (float*)(ws + WS_USC); float* vsc = (float*)(ws + WS_VSC);
    bf16_t* xb = (bf16_t*)(ws + WS_XB); bf16_t* ya = (bf16_t*)(ws + WS_YA); bf16_t* yb = (bf16_t*)(ws + WS_YB); bf16_t* x2b = (bf16_t*)(ws + WS_X2B);
    bf16_t* z = (bf16_t*)(ws + WS_Z); bf16_t* qb = (bf16_t*)(ws + WS_Q);
    bf16_t* merged = (bf16_t*)(ws + WS_MERGED);
    const int gw = vcu * NWAVES + wave, NGW = G * NWAVES;

    if (IN(0)) {
        LAS float* scr = (LAS float*)(lds + wave * 16384);
        constexpr int I_IN = (DM / 64) * (NZ / 32), I_PA = (512 / 64) * (DM / 32), I_WO = (DM / 64) * (DM / 32), I_WQ = (DM / 64) * (2048 / 32);
        constexpr int NITEMS = I_IN + 2 * I_PA + I_WO + I_WQ;
        for (int it = gw; it < NITEMS; it += NGW) {
            int r = it;
            if (r < I_IN) { p0_transpose_item(args.in[2], args.in[1], DM, NZ, WinT, scr, r, lane); continue; } r -= I_IN;
            if (r < I_PA) { p0_transpose_item(args.in[19], nullptr, 512, DM, PaT, scr, r, lane); continue; } r -= I_PA;
            if (r < I_PA) { p0_transpose_item(args.in[20], nullptr, 512, DM, PbT, scr, r, lane); continue; } r -= I_PA;
            if (r < I_WO) { p0_transpose_item(args.in[21], nullptr, DM, DM, WoT, scr, r, lane); continue; } r -= I_WO;
            p0_transpose_item(args.in[23], args.in[22], DM, 2048, WqT, scr, r, lane);
        }
        p0_convert(args.in[24], nullptr, KeysB, (size_t)16 * 128 * 128, gw, NGW, lane);
        for (int e = gw; e < 2 * NEXP; e += NGW) {
            const bool isu = e < NEXP; const int row = isu ? e : e - NEXP;
            p0_row_fp8((isu ? args.in[25] : args.in[26]) + (size_t)row * DM, isu ? args.in[22] : nullptr, (isu ? U8 : V8) + (size_t)row * DM, (isu ? usc : vsc) + row, lane);
        }
        for (int m = gw; m < T_TOK; m += NGW) {
            const f32x4* xr = (const f32x4*)(args.in[0] + (size_t)m * DM) + lane;
            f32x4 v[4]; float s = 0.f;
#pragma unroll
            for (int j = 0; j < 4; ++j) { v[j] = xr[64 * j]; s += (v[j][0] * v[j][0] + v[j][1] * v[j][1]) + (v[j][2] * v[j][2] + v[j][3] * v[j][3]); }
            s = wave_sum(s);
            v2u* o8 = (v2u*)(xb + (size_t)m * DM) + lane;
#pragma unroll
            for (int j = 0; j < 4; ++j) { v2u w; w.x = pg8::cvt_pk_bf16(v[j][0], v[j][1]); w.y = pg8::cvt_pk_bf16(v[j][2], v[j][3]); o8[64 * j] = w; }
            if (lane == 0) { rstd1[m] = rsqrtf(s * (1.f / DM) + NORM_EPS); ssq2[m] = 0.f; }
        }
        if (gw == 0) {
            const float a = wave_sum(args.in[14][lane] * args.in[15][lane]), b = wave_sum(args.in[16][lane] * args.in[17][lane]);
            if (lane == 0) scal[0] = __expf(a) - __expf(b) + LAM_INIT;
        }
        if (BOTH(0)) xcd_barrier(bar);
    }
    if (IN(1)) {
        pg8::Gemm g{xb, WinT, DM, DM, DM}; pg8::StaticOrder S; S.init(T_TOK, NZ, G, bx);
        pg8::EpiRowScale<false> E{z, NZ, rstd1};
        for (int rep = 0; rep < REPS(1); ++rep) pg8::gemm_phase(lds, g, S, E);
        if (BOTH(1)) xcd_barrier(bar);
    }
    if (IN(2)) {
        {
            const rw::ScanP P{args.in[3], args.in[4], args.in[5], args.in[6], args.in[7], args.in[8], args.in[9], args.in[10], args.in[11], args.in[12], args.in[13]};
            for (int rep = 0; rep < REPS(2); ++rep) for (int u = vcu; u < NB * 8; u += G) rw::scan_unit(lds, z, ya, P, u >> 3, u & 7, tid, wave, lane);
        }
        const float lam = scal[0];
        for (int rep = 0; rep < REPS(10); ++rep) for (int i = 0;; ++i) {
            const int idx = vcu + i * G; if (idx >= 2048) break;
            const int slot = idx >> 8, v = idx & 255, bh = v >> 1, a = (v & 1) * 4 + (slot >> 1), qblk = (slot & 1) ? 15 - a : a;
            da::attn_unit(lds, z, yb, args.in[18], lam, bh >> 2, bh & 3, qblk, wave, lane);
        }
        if (BOTH(2)) xcd_barrier(bar);
    }
    if (IN(3)) {
        pg8::Gemm g{ya, PaT, 512, 512, 512}; pg8::StaticOrder S; S.init(T_TOK, DM, G, bx);
        pg8::EpiGate<false> E{merged, z, C_GA};
        pg8::gemm_phase(lds, g, S, E);
        if (BOTH(3)) xcd_barrier(bar);
    }
    if (IN(4)) {
        pg8::Gemm g{yb, PbT, 512, 512, 512}; pg8::StaticOrder S; S.init(T_TOK, DM, G, bx);
        pg8::EpiGate<true> E{merged, z, C_GB};
        pg8::gemm_phase(lds, g, S, E);
        if (BOTH(4)) xcd_barrier(bar);
    }
    if (IN(5)) {
        pg8::Gemm g{merged, WoT, DM, DM, DM}; pg8::StaticOrder S; S.init(T_TOK, DM, G, bx);
        pg8::EpiX2 E{args.in[0], args.out, x2b, ssq2};
        pg8::gemm_phase(lds, g, S, E);
        if (BOTH(5)) xcd_barrier(bar);
    }
    if (IN(6)) {
        pg8::Gemm g{x2b, WqT, DM, DM, DM}; pg8::StaticOrder S; S.init(T_TOK, 2048, G, bx);
        pg8::EpiRowScale<true> E{qb, 2048, ssq2};
        for (int rep = 0; rep < REPS(6); ++rep) pg8::gemm_phase(lds, g, S, E);
        if (BOTH(6)) xcd_barrier(bar);
    }
    if (IN(7)) {
        int* ids = (int*)(ws + WS_IDS); float* gates = (float*)(ws + WS_GATES);
        for (int rep = 0; rep < REPS(7); ++rep)
        for (int h = 0; h < 8; ++h) {
            __syncthreads();
            {
                const bf16_t* ksrc = KeysB + (size_t)h * 2 * 128 * 128;
#pragma unroll
                for (int i = 0; i < 8; ++i) { const int chunk = tid + i * 512, row = chunk >> 4, cc = chunk & 15;
                    *(LAS v4u*)(lds + (row >> 7) * TK_HALF + (row & 127) * TK_PITCH + cc * 16) = *(const v4u*)(ksrc + (size_t)row * 128 + cc * 8); }
            }
            __syncthreads();
            for (int tile = gw; tile < 4096; tile += NGW) {
                tk_bf16x8 qa[8];
                topk_loadq(qa, qb, tile * 16, h, lane);
                topk_item(qa, lds, ids, gates, tile * 16, h, lane);
            }
        }
        if (BOTH(7)) xcd_barrier(bar);
    }
    if (IN(8)) {
        const int* ids = (const int*)(ws + WS_IDS); const float* gates = (const float*)(ws + WS_GATES);
        for (int t = gw; t < T_TOK; t += NGW) peer_token(x2b, ssq2, ids, gates, U8, V8, usc, vsc, args.in[27], args.out, t, lane);
    }
#undef IN
#undef BOTH
}

extern "C" void kernel_launch(void* const* d_in, const int* in_sizes, int n_in, void* d_out, int out_size, void* d_ws, size_t ws_size, hipStream_t stream) {
    static int grid = 0;
    if (grid == 0) {
        if (n_in != 28 || in_sizes[0] != T_TOK * DM || out_size != T_TOK * DM || ws_size < WS_END) {
            fprintf(stderr, "kernel_launch: unexpected shapes / workspace (n_in %d, ws %zu < %zu)\n", n_in, ws_size, (size_t)WS_END); grid = -1; return; }
        int dev = 0, cus = 0;
        if (hipGetDevice(&dev) != hipSuccess || hipDeviceGetAttribute(&cus, hipDeviceAttributeMultiprocessorCount, dev) != hipSuccess) { grid = -1; return; }
        if (hipFuncSetAttribute((const void*)mk_fwd, hipFuncAttributeMaxDynamicSharedMemorySize, LDS_BYTES) != hipSuccess) { fprintf(stderr, "kernel_launch: hipFuncSetAttribute failed\n"); grid = -1; return; }
        grid = cus;
    }
    if (grid < 0) return;
    unsigned char* ws = (unsigned char*)d_ws;
    float* out = (float*)d_out;
    (void)hipMemsetAsync(ws + WS_CTL, 0, 1 * MiB, stream);
    Args a{};
    for (int i = 0; i < 28; ++i) a.in[i] = (const float*)d_in[i];
    a.out = out; a.ws = ws;
    a.ph_lo = 0; a.ph_hi = 9; a.li = 0;
    hipLaunchKernelGGL(mk_fwd, dim3(grid), dim3(NWAVES * 64), LDS_BYTES, stream, a);
}
```

```cpp
#include <hip/hip_runtime.h>
#include <stdint.h>
#include <cstdio>

typedef unsigned short bf16_t;
typedef unsigned int u32;

#ifndef PROBE_REP
#define PROBE_REP 0
#endif
#define REPS(k) (((PROBE_REP >> (k)) & 1) ? 2 : 1)
constexpr int T_TOK = 65536, DM = 1024, SEQ = 2048, NB = 32;
constexpr int NZ = 5376;
constexpr int C_R = 0, C_K = 512, C_V = 1024, C_WL = 1536, C_AL = 1600, C_GL = 1664, C_Q = 1792, C_ZK = 2304, C_ZV = 2816, C_GA = 3328, C_GB = 4352;
constexpr int NEXP = 16384;
constexpr float NORM_EPS = 1e-6f, GN_EPS = 64e-5f, SUBLN_EPS = 1e-5f;
constexpr float LAM_INIT = 0.2f;

constexpr size_t MiB = 1u << 20;
constexpr size_t WS_CTL = 0;
constexpr size_t WS_WIN = 1 * MiB;
constexpr size_t WS_PA = 12 * MiB;
constexpr size_t WS_PB = 13 * MiB;
constexpr size_t WS_WO = 14 * MiB;
constexpr size_t WS_WQ = 16 * MiB;
constexpr size_t WS_KEYS = 20 * MiB;
constexpr size_t WS_RSTD1 = 21 * MiB;
constexpr size_t WS_RSTD2 = 22 * MiB;
constexpr size_t WS_SCAL = 23 * MiB;
constexpr size_t WS_U = 24 * MiB;
constexpr size_t WS_V = 40 * MiB;
constexpr size_t WS_USC = 56 * MiB;
constexpr size_t WS_VSC = 57 * MiB;
constexpr size_t WS_XB = 88 * MiB;
constexpr size_t WS_YA = WS_XB;
constexpr size_t WS_YB = WS_XB + 64 * MiB;
constexpr size_t WS_X2B = WS_XB;
constexpr size_t WS_Z = 216 * MiB;
constexpr size_t WS_Q = WS_Z;
constexpr size_t WS_IDS = WS_Z + 256 * MiB;
constexpr size_t WS_GATES = WS_Z + 288 * MiB;
constexpr size_t WS_MERGED = 888 * MiB;
constexpr size_t WS_END = 1016 * MiB;

__device__ __forceinline__ float bf2f(bf16_t h) { return __uint_as_float(((u32)h) << 16); }
__device__ __forceinline__ bf16_t f2bf(float f) { u32 u = __float_as_uint(f); u += 0x7fffu + ((u >> 16) & 1u); return (bf16_t)(u >> 16); }
__device__ __forceinline__ float wave_sum(float v) {
#pragma unroll
    for (int o = 1; o < 64; o <<= 1) v += __shfl_xor(v, o);
    return v;
}
__device__ __forceinline__ float sigmoidf_(float x) { return 1.f / (1.f + __expf(-x)); }

namespace pg8 {
#define PG8_LAS __attribute__((address_space(3)))
typedef short bf16x8 __attribute__((ext_vector_type(8)));
typedef float f32x4 __attribute__((ext_vector_type(4)));
typedef unsigned u32x4 __attribute__((ext_vector_type(4)));
constexpr int BM = 256, BK = 64, HALF = 128, HTB = HALF * BK * 2  , STAGE_BYTES = 8 * HTB, NXCD = 8, WGM = 8;

__host__ __device__ __forceinline__ int lds_byte(int r, int c) { const int st = (r >> 4) * 2 + (c >> 5), rr = r & 15, cc = c & 31, ob = rr * 64 + cc * 2; return st * 1024 + (ob ^ (((ob >> 9) & 1) << 5)); }
__host__ __device__ __forceinline__ void stage_rc(int b, int& R, int& C) { const int st = b / 1024, sb = b % 1024, swz = sb ^ (((sb >> 9) & 1) << 5); R = (st >> 1) * 16 + swz / 64; C = (st & 1) * 32 + (swz % 64) / 2; }
__host__ __device__ __forceinline__ int perm32(int rho) { const int n = rho >> 4, i = rho & 15; return 8 * (i >> 2) + 4 * n + (i & 3); }

struct Unit { int pm, pn; };
struct Gemm { const bf16_t* A; const bf16_t* Bt; int lda, ldb, K; };

struct StaticOrder {
    int nM, nN, nwg, G, c;
    __host__ __device__ void init(int M, int N, int G_, int c_) { nM = M / BM; nN = N / BM; nwg = nM * nN; G = G_; c = c_; }
    __host__ __device__ bool next(int i, Unit& u) const {
        const long L = (long)i * G + c; if (L >= nwg) return false;
        int wgid = (int)L; { const int q = nwg / NXCD, r = nwg % NXCD, xcd = wgid % NXCD, off = wgid / NXCD; wgid = (xcd < r ? xcd * (q + 1) : r * (q + 1) + (xcd - r) * q) + off; }
        const int nig = WGM * nN, gid = wgid / nig, fm = gid * WGM, gsz = (nM - fm) < WGM ? (nM - fm) : WGM;
        u.pm = fm + ((wgid % nig) % gsz); u.pn = (wgid % nig) / gsz; return true;
    }
};
typedef float f32x2_c __attribute__((ext_vector_type(2))); typedef __bf16 bf16x2_c __attribute__((ext_vector_type(2)));
__device__ __forceinline__ unsigned cvt_pk_bf16(float lo, float hi) { const f32x2_c v = {lo, hi}; const bf16x2_c b = __builtin_convertvector(v, bf16x2_c); return __builtin_bit_cast(unsigned, b); }
__device__ __forceinline__ float bflo(unsigned w) { return __uint_as_float(w << 16); }
__device__ __forceinline__ float bfhi(unsigned w) { return __uint_as_float(w & 0xffff0000u); }

template <bool SSQ> struct EpiRowScale {
    static constexpr bool PERM = true;
    bf16_t* O; int ldc; const float* rs;
    __device__ __forceinline__ void operator()(const f32x4 (&acc)[2][2][4][2], const Unit& u, int wr, int wc, int fr, int fq) const {
        const int row0 = u.pm * BM + wr * 64 + fr, col0 = u.pn * BM + wc * 32 + 8 * fq;
#pragma unroll
        for (int ai = 0; ai < 2; ++ai)
#pragma unroll
            for (int m = 0; m < 4; ++m) {
                const int row = row0 + ai * HALF + m * 16;
                float s = rs[row]; if (SSQ) s = rsqrtf(s * (1.f / 1024.f) + NORM_EPS);
                bf16_t* rowp = O + (size_t)row * ldc + col0;
#pragma unroll
                for (int bj = 0; bj < 2; ++bj) {
                    const f32x4 v0 = acc[ai][bj][m][0] * s, v1 = acc[ai][bj][m][1] * s;
                    u32x4 w; w.x = cvt_pk_bf16(v0[0], v0[1]); w.y = cvt_pk_bf16(v0[2], v0[3]); w.z = cvt_pk_bf16(v1[0], v1[1]); w.w = cvt_pk_bf16(v1[2], v1[3]);
                    *(u32x4*)(rowp + bj * HALF) = w;
                }
            }
    }
};
template <bool ACCUM> struct EpiGate {
    static constexpr bool PERM = true;
    bf16_t* mg; const bf16_t* z; int gcol;
    __device__ __forceinline__ void operator()(const f32x4 (&acc)[2][2][4][2], const Unit& u, int wr, int wc, int fr, int fq) const {
        const int row0 = u.pm * BM + wr * 64 + fr, col0 = u.pn * BM + wc * 32 + 8 * fq;
#pragma unroll
        for (int ai = 0; ai < 2; ++ai)
#pragma unroll
            for (int m = 0; m < 4; ++m) {
                const int row = row0 + ai * HALF + m * 16;
                const bf16_t* gp = z + (size_t)row * NZ + gcol + col0;
                bf16_t* rowp = mg + (size_t)row * DM + col0;
#pragma unroll
                for (int bj = 0; bj < 2; ++bj) {
                    const u32x4 g = *(const u32x4*)(gp + bj * HALF);
                    const f32x4 a0 = acc[ai][bj][m][0], a1 = acc[ai][bj][m][1];
                    float r[8];
                    r[0] = sigmoidf_(bflo(g.x)) * a0[0]; r[1] = sigmoidf_(bfhi(g.x)) * a0[1]; r[2] = sigmoidf_(bflo(g.y)) * a0[2]; r[3] = sigmoidf_(bfhi(g.y)) * a0[3];
                    r[4] = sigmoidf_(bflo(g.z)) * a1[0]; r[5] = sigmoidf_(bfhi(g.z)) * a1[1]; r[6] = sigmoidf_(bflo(g.w)) * a1[2]; r[7] = sigmoidf_(bfhi(g.w)) * a1[3];
                    if (ACCUM) { const u32x4 o = *(const u32x4*)(rowp + bj * HALF);
                        r[0] += bflo(o.x); r[1] += bfhi(o.x); r[2] += bflo(o.y); r[3] += bfhi(o.y); r[4] += bflo(o.z); r[5] += bfhi(o.z); r[6] += bflo(o.w); r[7] += bfhi(o.w); }
                    u32x4 w; w.x = cvt_pk_bf16(r[0], r[1]); w.y = cvt_pk_bf16(r[2], r[3]); w.z = cvt_pk_bf16(r[4], r[5]); w.w = cvt_pk_bf16(r[6], r[7]);
                    *(u32x4*)(rowp + bj * HALF) = w;
                }
            }
    }
};
struct EpiX2 {
    static constexpr bool PERM = true;
    const float* x; float* x2; bf16_t* x2b; float* ssq;
    __device__ __forceinline__ void operator()(const f32x4 (&acc)[2][2][4][2], const Unit& u, int wr, int wc, int fr, int fq) const {
        const int row0 = u.pm * BM + wr * 64 + fr, col0 = u.pn * BM + wc * 32 + 8 * fq;
#pragma unroll
        for (int ai = 0; ai < 2; ++ai)
#pragma unroll
            for (int m = 0; m < 4; ++m) {
                const int row = row0 + ai * HALF + m * 16;
                const size_t off = (size_t)row * DM + col0;
                float ss = 0.f;
#pragma unroll
                for (int bj = 0; bj < 2; ++bj) {
                    const f32x4 x0 = *(const f32x4*)(x + off + bj * HALF), x1 = *(const f32x4*)(x + off + bj * HALF + 4);
                    const f32x4 o0 = x0 + acc[ai][bj][m][0], o1 = x1 + acc[ai][bj][m][1];
                    u32x4 w; w.x = cvt_pk_bf16(o0[0], o0[1]); w.y = cvt_pk_bf16(o0[2], o0[3]); w.z = cvt_pk_bf16(o1[0], o1[1]); w.w = cvt_pk_bf16(o1[2], o1[3]);
                    *(u32x4*)(x2b + off + bj * HALF) = w;
                    ss += (o0[0] * o0[0] + o0[1] * o0[1]) + (o0[2] * o0[2] + o0[3] * o0[3]) + (o1[0] * o1[0] + o1[1] * o1[1]) + (o1[2] * o1[2] + o1[3] * o1[3]);
                }
                ss += __shfl_xor(ss, 16); ss += __shfl_xor(ss, 32);
                if (fq == 0) atomicAdd(ssq + row, ss);
            }
    }
};

template <class Epi, class Sched>
__device__ __forceinline__ void gemm_phase(PG8_LAS unsigned char* lds, const Gemm g, const Sched& S, const Epi& E) {
    const int tid = threadIdx.x, wid = __builtin_amdgcn_readfirstlane(tid >> 6), lane = tid & 63, wr = wid >> 2, wc = wid & 3, fr = lane & 15, fq = lane >> 4;
    const int K = g.K, nt = K / BK;
    unsigned voffA[2], voffB[2];
#pragma unroll
    for (int i = 0; i < 2; ++i) { int R, C; stage_rc(tid * 16 + i * 8192, R, C); const int Rb = Epi::PERM ? ((R & ~31) + perm32(R & 31)) : R;
        voffA[i] = (unsigned)(R * g.lda + C) * 2u; voffB[i] = (unsigned)(Rb * g.ldb + C) * 2u; }
    const size_t kstep = (size_t)(BK * 2);
    const size_t hstepA = (size_t)HALF * g.lda * 2, hstepB = (size_t)HALF * g.ldb * 2;
    const size_t tstepA = 2 * hstepA, tstepB = 2 * hstepB;
    const unsigned ldsw = (unsigned)wid * 1024u;
    const int aoff = lds_byte(wr * 64 + fr, fq * 8), boff = lds_byte(wc * 32 + fr, fq * 8);
#define PG8_SA(b, h) (((b) * 2 + (h)) * HTB)
#define PG8_SB(b, h) ((4 + (b) * 2 + (h)) * HTB)
#define PG8_STAGE(bufoff, gbase, voff) do { _Pragma("unroll") for (int _i = 0; _i < 2; ++_i) \
        __builtin_amdgcn_global_load_lds((const unsigned*)((const char*)(gbase) + (voff)[_i]), (PG8_LAS unsigned*)(lds + (bufoff) + ldsw + _i * 8192), 16, 0, 0); } while (0)
#define PG8_LDA(dst, b, h) do { _Pragma("unroll") for (int m = 0; m < 4; ++m) _Pragma("unroll") for (int k = 0; k < 2; ++k) dst[m][k] = *(const PG8_LAS bf16x8*)(lds + PG8_SA(b, h) + aoff + m * 2048 + k * 1024); } while (0)
#define PG8_LDB(dst, b, h) do { _Pragma("unroll") for (int n = 0; n < 2; ++n) _Pragma("unroll") for (int k = 0; k < 2; ++k) dst[n][k] = *(const PG8_LAS bf16x8*)(lds + PG8_SB(b, h) + boff + n * 2048 + k * 1024); } while (0)
#define PG8_MMA(ai, bj, At, Bt) do { __builtin_amdgcn_s_setprio(1); _Pragma("unroll") for (int m = 0; m < 4; ++m) _Pragma("unroll") for (int n = 0; n < 2; ++n) _Pragma("unroll") for (int k = 0; k < 2; ++k) \
        acc[ai][bj][m][n] = __builtin_amdgcn_mfma_f32_16x16x32_bf16(Bt[n][k], At[m][k], acc[ai][bj][m][n], 0, 0, 0); __builtin_amdgcn_s_setprio(0); } while (0)
#define PG8_WAIT_V(n) asm volatile("s_waitcnt vmcnt(" #n ")" ::: "memory")
#define PG8_WAIT_L(n) asm volatile("s_waitcnt lgkmcnt(" #n ")" ::: "memory")
#define PG8_BAR __builtin_amdgcn_s_barrier()
#define PG8_SCHED __builtin_amdgcn_sched_barrier(0)
    Unit cur, nxt; int ui = 0;
    if (!S.next(0, cur)) return;
    f32x4 acc[2][2][4][2];
#pragma unroll
    for (int a = 0; a < 2; ++a)
#pragma unroll
        for (int b = 0; b < 2; ++b)
#pragma unroll
            for (int m = 0; m < 4; ++m)
#pragma unroll
                for (int n = 0; n < 2; ++n) acc[a][b][m][n] = (f32x4){0.f, 0.f, 0.f, 0.f};
    bf16x8 At[4][2], B0[2][2], B1[2][2];
    const char* cA = (const char*)g.A + (size_t)cur.pm * tstepA; const char* cB = (const char*)g.Bt + (size_t)cur.pn * tstepB;
    PG8_STAGE(PG8_SB(0, 0), cB, voffB); PG8_STAGE(PG8_SB(0, 1), cB + hstepB, voffB); PG8_STAGE(PG8_SA(0, 0), cA, voffA); PG8_STAGE(PG8_SA(0, 1), cA + hstepA, voffA);
    if (wr == 1) PG8_BAR;
    PG8_WAIT_V(2); PG8_BAR;
    PG8_STAGE(PG8_SB(1, 0), cB + kstep, voffB); PG8_STAGE(PG8_SA(1, 0), cA + kstep, voffA); PG8_STAGE(PG8_SB(1, 1), cB + hstepB + kstep, voffB);
    PG8_WAIT_V(6); PG8_BAR;
    for (;;) {
        const bool has_next = S.next(ui + 1, nxt);
        const char* nA = has_next ? (const char*)g.A + (size_t)nxt.pm * tstepA : cA; const char* nB = has_next ? (const char*)g.Bt + (size_t)nxt.pn * tstepB : cB;
        for (int t = 0; t < nt; t += 2) {
            const bool last = (t == nt - 2);
            const char* a1 = cA + (size_t)(t + 1) * kstep;
            const char* a2 = last ? nA : cA + (size_t)(t + 2) * kstep; const char* b2 = last ? nB : cB + (size_t)(t + 2) * kstep;
            const char* a3 = a2 + kstep; const char* b3 = b2 + kstep;
            PG8_LDB(B0, 0, 0); PG8_LDB(B1, 0, 1); PG8_SCHED; PG8_LDA(At, 0, 0); PG8_STAGE(PG8_SA(1, 1), a1 + hstepA, voffA);
            PG8_WAIT_V(8); PG8_WAIT_L(0); PG8_BAR; PG8_MMA(0, 0, At, B0); PG8_MMA(0, 1, At, B1); PG8_BAR; PG8_SCHED;
            PG8_LDA(At, 0, 1); PG8_STAGE(PG8_SB(0, 0), b2, voffB); PG8_STAGE(PG8_SB(0, 1), b2 + hstepB, voffB); PG8_STAGE(PG8_SA(0, 0), a2, voffA);
            PG8_WAIT_V(8); PG8_WAIT_L(0); PG8_BAR; PG8_MMA(1, 0, At, B0); PG8_MMA(1, 1, At, B1); PG8_BAR; PG8_SCHED;
            PG8_LDB(B0, 1, 0); PG8_LDB(B1, 1, 1); PG8_SCHED; PG8_LDA(At, 1, 0); PG8_STAGE(PG8_SA(0, 1), a2 + hstepA, voffA);
            PG8_WAIT_V(8); PG8_WAIT_L(0); PG8_BAR; PG8_MMA(0, 0, At, B0); PG8_MMA(0, 1, At, B1); PG8_BAR; PG8_SCHED;
            PG8_LDA(At, 1, 1); PG8_STAGE(PG8_SB(1, 0), b3, voffB); PG8_STAGE(PG8_SB(1, 1), b3 + hstepB, voffB); PG8_STAGE(PG8_SA(1, 0), a3, voffA);
            PG8_WAIT_V(8); PG8_WAIT_L(0); PG8_BAR; PG8_MMA(1, 0, At, B0); PG8_MMA(1, 1, At, B1); PG8_BAR; PG8_SCHED;
        }
        if (wr == 0) PG8_BAR;
        E(acc, cur, wr, wc, fr, fq);
        if (!has_next) break;
#pragma unroll
        for (int a = 0; a < 2; ++a)
#pragma unroll
            for (int b = 0; b < 2; ++b)
#pragma unroll
                for (int m = 0; m < 4; ++m)
#pragma unroll
                    for (int n = 0; n < 2; ++n) acc[a][b][m][n] = (f32x4){0.f, 0.f, 0.f, 0.f};
        cur = nxt; cA = nA; cB = nB; ++ui;
        if (wr == 1) PG8_BAR;
    }
    PG8_WAIT_V(0);
    PG8_BAR;
#undef PG8_SA
#undef PG8_SB
#undef PG8_STAGE
#undef PG8_LDA
#undef PG8_LDB
#undef PG8_MMA
#undef PG8_WAIT_V
#undef PG8_WAIT_L
#undef PG8_BAR
#undef PG8_SCHED
}
}

constexpr int NWAVES = 8;
constexpr int LDS_RING_BYTES = 131072, LDSCTL_OFF = 143360, MISC_OFF = LDSCTL_OFF + 320, LDS_BYTES = 147456;
#define LAS __attribute__((address_space(3)))
#define GAS __attribute__((address_space(1)))
typedef float f32x4 __attribute__((ext_vector_type(4)));
typedef unsigned v4u __attribute__((ext_vector_type(4)));
typedef unsigned v2u __attribute__((ext_vector_type(2)));
#define LDS_WAIT() asm volatile("s_waitcnt lgkmcnt(0)" ::: "memory")

constexpr int CW_BAR = 4096;
#define XB_TMO      128
#define XB_XCNT(j)  (256  + 64 * (j))
#define XB_XSUB(j)  (1280 + 64 * (j))
#define XB_XGEN(j)  (2304 + 64 * (j))
#define XB_TOP      3328
#define XB_TOPGEN   3392
#define XCD_BAR_WORDS 3456
#define XB_SPIN_CAP (1u << 20)
__device__ __forceinline__ unsigned xb_ld(unsigned* p)              { return __hip_atomic_load(p, __ATOMIC_RELAXED, __HIP_MEMORY_SCOPE_AGENT); }
__device__ __forceinline__ unsigned xb_add(unsigned* p, unsigned v) { return __hip_atomic_fetch_add(p, v, __ATOMIC_RELAXED, __HIP_MEMORY_SCOPE_AGENT); }
__device__ __forceinline__ unsigned xb_xcc_id() { return (unsigned)__builtin_amdgcn_s_getreg((3 << 11) | 20) & 0xFu; }
#define XB_SPIN(cond, bar) do { unsigned _sp = 0; while (cond) { __builtin_amdgcn_s_sleep(1); \
    if ((++_sp & 255u) == 0u) { if (xb_ld(&(bar)[XB_TMO])) break; if (_sp > XB_SPIN_CAP) { atomicAdd(&(bar)[XB_TMO], 1u); break; } } } } while (0)
struct XcdBarrier { unsigned* bar; unsigned x; volatile LAS unsigned* st; };
__device__ __forceinline__ XcdBarrier xcd_barrier_post(unsigned* bar, volatile LAS unsigned* st) {
    XcdBarrier b; b.bar = bar; b.x = xb_xcc_id(); b.st = st;
    if (threadIdx.x == 0) (void)xb_add(&bar[XB_XCNT(b.x)], 1u);
    return b;
}
__device__ __forceinline__ void xcd_barrier_complete(unsigned* bar, unsigned x, unsigned& nloc, unsigned& nx) {
    const unsigned G = gridDim.x * gridDim.y * gridDim.z;
    unsigned sum, cnt, mine, sp = 0u;
    for (;;) {
        sum = 0u; cnt = 0u; mine = 0u;
#pragma unroll
        for (unsigned j = 0; j < 16; ++j) { const unsigned c = xb_ld(&bar[XB_XCNT(j)]); sum += c; cnt += (c > 0u) ? 1u : 0u; mine = (j == x) ? c : mine; }
        if (sum == G) break;
        __builtin_amdgcn_s_sleep(1);
        if ((++sp & 255u) == 0u) { if (xb_ld(&bar[XB_TMO])) break; if (sp > XB_SPIN_CAP) { atomicAdd(&bar[XB_TMO], 1u); break; } }
    }
    nloc = mine > 0u ? mine : 1u; nx = cnt > 0u ? cnt : 1u;
}
__device__ __forceinline__ void xcd_barrier(const XcdBarrier& b) {
    asm volatile("s_waitcnt vmcnt(0)" ::: "memory");
    __syncthreads();
    if (threadIdx.x == 0) {
        unsigned* bar = b.bar;
        __builtin_amdgcn_s_waitcnt(0);
        unsigned nloc = b.st[0], nx = b.st[1];
        if (nloc == 0u) { xcd_barrier_complete(bar, b.x, nloc, nx); b.st[0] = nloc; b.st[1] = nx; }
        const unsigned old = xb_add(&bar[XB_XSUB(b.x)], 1u);
        const unsigned gen = old / nloc;
        if (old + 1u == (gen + 1u) * nloc) {
            __builtin_amdgcn_fence(__ATOMIC_RELEASE, "agent");
            asm volatile("s_waitcnt vmcnt(0)" ::: "memory");
            const unsigned og = xb_add(&bar[XB_TOP], 1u);
            const unsigned tg = og / nx;
            if (og + 1u == (tg + 1u) * nx) xb_add(&bar[XB_TOPGEN], 1u);
            else XB_SPIN(xb_ld(&bar[XB_TOPGEN]) == tg, bar);
            __builtin_amdgcn_fence(__ATOMIC_ACQUIRE, "agent");
            xb_add(&bar[XB_XGEN(b.x)], 1u);
            asm volatile("s_waitcnt vmcnt(0)" ::: "memory");
        } else {
            XB_SPIN(xb_ld(&bar[XB_XGEN(b.x)]) == gen, bar);
            __builtin_amdgcn_fence(__ATOMIC_ACQUIRE, "agent");
            asm volatile("s_waitcnt vmcnt(0)" ::: "memory");
        }
    }
    __syncthreads();
}

struct Args { const float* in[28]; float* out; unsigned char* ws; int ph_lo, ph_hi, li, pad; };

__device__ __forceinline__ void p0_transpose_item(const float* W, const float* sc, int K, int N, bf16_t* WT, LAS float* scr, int item, int lane) {
    const int nblk = N / 32, kb = item / nblk, nb = item % nblk, k0 = 64 * kb, n0 = 32 * nb;
#pragma unroll 8
    for (int i = 0; i < 32; ++i) { const int kk = 2 * i + (lane >> 5); const float s = sc ? sc[k0 + kk] : 1.f; scr[kk * 33 + (lane & 31)] = W[(size_t)(k0 + kk) * N + n0 + (lane & 31)] * s; }
    LDS_WAIT(); asm volatile("" ::: "memory");
    const int c = lane & 7;
#pragma unroll
    for (int j = 0; j < 4; ++j) { const int n = (lane >> 3) + 8 * j; const LAS float* s = scr + (8 * c) * 33 + n;
        v4u o; o.x = pg8::cvt_pk_bf16(s[0 * 33], s[1 * 33]); o.y = pg8::cvt_pk_bf16(s[2 * 33], s[3 * 33]); o.z = pg8::cvt_pk_bf16(s[4 * 33], s[5 * 33]); o.w = pg8::cvt_pk_bf16(s[6 * 33], s[7 * 33]);
        *(v4u*)(WT + (size_t)(n0 + n) * K + k0 + 8 * c) = o; }
    LDS_WAIT(); asm volatile("" ::: "memory");
}
__device__ __forceinline__ void p0_row_fp8(const float* in, const float* cs, unsigned char* out, float* sc, int lane) {
    f32x4 v[4]; float mx = 0.f;
#pragma unroll
    for (int i = 0; i < 4; ++i) { v[i] = *(const f32x4*)(in + lane * 16 + 4 * i); if (cs) v[i] = v[i] * *(const f32x4*)(cs + lane * 16 + 4 * i);
        mx = fmaxf(mx, fmaxf(fmaxf(fabsf(v[i][0]), fabsf(v[i][1])), fmaxf(fabsf(v[i][2]), fabsf(v[i][3])))); }
#pragma unroll
    for (int o = 1; o < 64; o <<= 1) mx = fmaxf(mx, __shfl_xor(mx, o));
    mx = fmaxf(mx, 1e-30f);
    const float q = 448.f / mx;
    v4u w;
#pragma unroll
    for (int i = 0; i < 4; ++i) { int p = 0; p = __builtin_amdgcn_cvt_pk_fp8_f32(v[i][0] * q, v[i][1] * q, p, false); p = __builtin_amdgcn_cvt_pk_fp8_f32(v[i][2] * q, v[i][3] * q, p, true); w[i] = (unsigned)p; }
    *(v4u*)(out + lane * 16) = w;
    if (lane == 0) *sc = mx * (1.f / 448.f);
}
__device__ __forceinline__ void p0_convert(const float* in, const float* cs, bf16_t* out, size_t n, int gw, int NGW, int lane) {
    for (size_t i = ((size_t)gw * 64 + lane) * 8; i < n; i += (size_t)NGW * 512) {
        f32x4 a = *(const f32x4*)(in + i), b = *(const f32x4*)(in + i + 4);
        if (cs) { const int c = (int)(i & 1023); a = a * *(const f32x4*)(cs + c); b = b * *(const f32x4*)(cs + c + 4); }
        v4u o; o.x = pg8::cvt_pk_bf16(a[0], a[1]); o.y = pg8::cvt_pk_bf16(a[2], a[3]); o.z = pg8::cvt_pk_bf16(b[0], b[1]); o.w = pg8::cvt_pk_bf16(b[2], b[3]);
        *(v4u*)(out + i) = o;
    }
}

namespace da {
typedef short bf16x8 __attribute__((ext_vector_type(8)));
typedef short s16x4 __attribute__((ext_vector_type(4)));
typedef float f32x16 __attribute__((ext_vector_type(16)));
constexpr float LOG2E = 1.4426950408889634f;
constexpr int SLOT = 32768, SCR_OFF = 65536, COMB_OFF = 69632;
__device__ __forceinline__ int crow(int r, int hi) { return (r & 3) + 8 * (r >> 2) + 4 * hi; }
__device__ __forceinline__ s16x4 vtr(const LAS unsigned char* p) { return __builtin_bit_cast(s16x4, __builtin_amdgcn_ds_read_tr16_b64_v4i16((LAS s16x4*)p)); }

__device__ __forceinline__ void attn_unit(LAS unsigned char* lds, const bf16_t* __restrict__ z, bf16_t* __restrict__ yb, const float* __restrict__ subln_w, float lam,
                                          int b, int h, int qblk, int wave, int lane) {
    const int r32 = lane & 31, hi = lane >> 5, map = wave >> 2, qs = wave & 3;
    const int q0 = qblk * 128 + qs * 32;
    const size_t rowb = (size_t)b * SEQ;
    const float slope2 = exp2f(-2.f * (float)(h + 1)) * LOG2E;
    bf16x8 qr[4];
    {
        const bf16_t* qp = z + (rowb + q0 + r32) * NZ + C_Q + h * 128 + map * 64 + hi * 8;
        constexpr float c2 = 0.125f * LOG2E;
#pragma unroll
        for (int d0 = 0; d0 < 4; ++d0) {
            const v4u w = *(const v4u*)(qp + d0 * 16);
            v4u o; o.x = pg8::cvt_pk_bf16(pg8::bflo(w.x) * c2, pg8::bfhi(w.x) * c2); o.y = pg8::cvt_pk_bf16(pg8::bflo(w.y) * c2, pg8::bfhi(w.y) * c2);
            o.z = pg8::cvt_pk_bf16(pg8::bflo(w.z) * c2, pg8::bfhi(w.z) * c2); o.w = pg8::cvt_pk_bf16(pg8::bflo(w.w) * c2, pg8::bfhi(w.w) * c2);
            qr[d0] = __builtin_bit_cast(bf16x8, o);
        }
    }
    const int qpos = q0 + r32;
    const float qterm = slope2 * (float)(4 * hi - qpos);
    LAS float* wsf = (LAS float*)(lds + SCR_OFF) + wave * 64;
    f32x16 o[4];
#pragma unroll
    for (int d = 0; d < 4; ++d) o[d] = (f32x16){};
    float m = -1e30f, lsum = 0.f;
    const int NT = 2 * qblk + 2;
    const bf16_t* ksrc0 = z + (rowb + lane) * NZ + C_ZK + h * 128 + wave * 8;
    const int pc0 = 2 * wave, pc1 = 2 * wave + 1;
    const bf16_t* vsrc0 = z + (rowb + 16 * (pc0 & 3) + (lane >> 2)) * NZ + C_ZV + h * 128 + 32 * (pc0 >> 2) + (lane & 3) * 8;
    const bf16_t* vsrc1 = z + (rowb + 16 * (pc1 & 3) + (lane >> 2)) * NZ + C_ZV + h * 128 + 32 * (pc1 >> 2) + (lane & 3) * 8;
#define DA_STAGE(j, slot) do { const size_t _o = (size_t)(j) * 64 * NZ; LAS unsigned char* _s = lds + (slot) * SLOT; \
        __builtin_amdgcn_global_load_lds((const unsigned*)(ksrc0 + _o), (LAS unsigned*)(_s + wave * 1024), 16, 0, 0); \
        __builtin_amdgcn_global_load_lds((const unsigned*)(ksrc0 + _o + 64), (LAS unsigned*)(_s + 8192 + wave * 1024), 16, 0, 0); \
        __builtin_amdgcn_global_load_lds((const unsigned*)(vsrc0 + _o), (LAS unsigned*)(_s + 16384 + pc0 * 1024), 16, 0, 0); \
        __builtin_amdgcn_global_load_lds((const unsigned*)(vsrc1 + _o), (LAS unsigned*)(_s + 16384 + pc1 * 1024), 16, 0, 0); } while (0)
    DA_STAGE(0, 0);
    for (int j = 0; j < NT; ++j) {
        asm volatile("s_waitcnt vmcnt(0)" ::: "memory");
        __syncthreads();
        if (j + 1 < NT) DA_STAGE(j + 1, (j + 1) & 1);
        if (64 * j > q0 + 31) continue;
        const LAS unsigned char* slot = lds + (j & 1) * SLOT;
        f32x16 c0, c1;
        {
            const float tb = slope2 * (float)(64 * j) + qterm;
#pragma unroll
            for (int r = 0; r < 16; ++r) { c0[r] = tb + slope2 * (float)((r & 3) + 8 * (r >> 2)); c1[r] = c0[r] + 32.f * slope2; }
        }
        const LAS unsigned char* kb = slot + map * 8192 + hi * 1024 + r32 * 16;
#pragma unroll
        for (int d0 = 0; d0 < 4; ++d0) {
            const bf16x8 k0 = *(const LAS bf16x8*)(kb + d0 * 2048), k1 = *(const LAS bf16x8*)(kb + d0 * 2048 + 512);
            c0 = __builtin_amdgcn_mfma_f32_32x32x16_bf16(k0, qr[d0], c0, 0, 0, 0);
            c1 = __builtin_amdgcn_mfma_f32_32x32x16_bf16(k1, qr[d0], c1, 0, 0, 0);
        }
        if (64 * j + 63 > q0) {
            const int kb0 = 64 * j + 4 * hi;
#pragma unroll
            for (int r = 0; r < 16; ++r) { const int kv = kb0 + (r & 3) + 8 * (r >> 2); if (kv > qpos) c0[r] = -INFINITY; if (kv + 32 > qpos) c1[r] = -INFINITY; }
        }
        float mt = fmaxf(c0[0], c1[0]);
#pragma unroll
        for (int r = 1; r < 16; ++r) mt = fmaxf(mt, fmaxf(c0[r], c1[r]));
        mt = fmaxf(mt, __shfl_xor(mt, 32));
        float mnew = m;
        if (__any(mt > m + 8.f)) {
            mnew = fmaxf(m, mt);
            const float alpha = __builtin_amdgcn_exp2f(m - mnew);
            lsum *= alpha;
            if (hi == 0) wsf[r32] = alpha;
            float a[16];
#pragma unroll
            for (int g = 0; g < 4; ++g) { const f32x4 t = *(const LAS f32x4*)(wsf + 8 * g + 4 * hi); a[4 * g] = t[0]; a[4 * g + 1] = t[1]; a[4 * g + 2] = t[2]; a[4 * g + 3] = t[3]; }
#pragma unroll
            for (int d = 0; d < 4; ++d)
#pragma unroll
                for (int r = 0; r < 16; ++r) o[d][r] *= a[r];
        }
        m = mnew;
        float ps = 0.f;
#pragma unroll
        for (int r = 0; r < 16; ++r) { c0[r] = __builtin_amdgcn_exp2f(c0[r] - m); c1[r] = __builtin_amdgcn_exp2f(c1[r] - m); ps += c0[r] + c1[r]; }
        lsum += ps;
        v4u pw[4];
#pragma unroll
        for (int g = 0; g < 2; ++g) {
            pw[g].x = pg8::cvt_pk_bf16(c0[8 * g], c0[8 * g + 1]); pw[g].y = pg8::cvt_pk_bf16(c0[8 * g + 2], c0[8 * g + 3]); pw[g].z = pg8::cvt_pk_bf16(c0[8 * g + 4], c0[8 * g + 5]); pw[g].w = pg8::cvt_pk_bf16(c0[8 * g + 6], c0[8 * g + 7]);
            pw[2 + g].x = pg8::cvt_pk_bf16(c1[8 * g], c1[8 * g + 1]); pw[2 + g].y = pg8::cvt_pk_bf16(c1[8 * g + 2], c1[8 * g + 3]); pw[2 + g].z = pg8::cvt_pk_bf16(c1[8 * g + 4], c1[8 * g + 5]); pw[2 + g].w = pg8::cvt_pk_bf16(c1[8 * g + 6], c1[8 * g + 7]);
        }
        const LAS unsigned char* vb = slot + 16384 + ((lane >> 4) & 1) * 32 + (lane & 3) * 8 + (4 * hi + ((lane & 15) >> 2)) * 64;
#pragma unroll
        for (int d = 0; d < 4; ++d)
#pragma unroll
            for (int kg = 0; kg < 4; ++kg) {
                const s16x4 lo = vtr(vb + (d * 4 + kg) * 1024), hh = vtr(vb + (d * 4 + kg) * 1024 + 512);
                const bf16x8 vf = (bf16x8){lo[0], lo[1], lo[2], lo[3], hh[0], hh[1], hh[2], hh[3]};
                o[d] = __builtin_amdgcn_mfma_f32_32x32x16_bf16(__builtin_bit_cast(bf16x8, pw[kg]), vf, o[d], 0, 0, 0);
            }
    }
#undef DA_STAGE
    lsum += __shfl_xor(lsum, 32);
    if (hi == 0) wsf[r32] = 1.f / lsum;
    float il[16];
#pragma unroll
    for (int g = 0; g < 4; ++g) { const f32x4 t = *(const LAS f32x4*)(wsf + 8 * g + 4 * hi); il[4 * g] = t[0]; il[4 * g + 1] = t[1]; il[4 * g + 2] = t[2]; il[4 * g + 3] = t[3]; }
    LAS float* comb = (LAS float*)(lds + COMB_OFF) + qs * 4096;
    if (map == 1) {
#pragma unroll
        for (int d = 0; d < 4; ++d)
#pragma unroll
            for (int r = 0; r < 16; ++r) comb[crow(r, hi) * 128 + 32 * d + r32] = o[d][r] * il[r];
    }
    __syncthreads();
    if (map == 0) {
        float sw[4];
#pragma unroll
        for (int d = 0; d < 4; ++d) sw[d] = subln_w[32 * d + r32] * (1.f - LAM_INIT);
#pragma unroll
        for (int r = 0; r < 16; ++r) {
            float v[4], ss = 0.f;
#pragma unroll
            for (int d = 0; d < 4; ++d) { v[d] = o[d][r] * il[r] - lam * comb[crow(r, hi) * 128 + 32 * d + r32]; ss += v[d] * v[d]; }
            ss += __shfl_xor(ss, 1); ss += __shfl_xor(ss, 2); ss += __shfl_xor(ss, 4); ss += __shfl_xor(ss, 8); ss += __shfl_xor(ss, 16);
            const float rs = rsqrtf(ss * (1.f / 128.f) + SUBLN_EPS);
            bf16_t* op = yb + (rowb + q0 + crow(r, hi)) * 512 + h * 128 + r32;
#pragma unroll
            for (int d = 0; d < 4; ++d) op[32 * d] = f2bf(v[d] * rs * sw[d]);
        }
    }
    __syncthreads();
}
}

namespace rw {
typedef short bf16x8 __attribute__((ext_vector_type(8)));
typedef float f32x2 __attribute__((ext_vector_type(2)));
constexpr int CH = 32, ACT_PITCH = 528;
constexpr int OFF_ACT = 0, OFF_RKV = 16896, OFF_VEC = 41472, OFF_G = 82432, OFF_Y = 90624, OFF_NRM = 98816, OFF_SCL = 99328, OFF_CT = 99840;
template <int CTRL> __device__ __forceinline__ float dppf(float x) { return __builtin_bit_cast(float, __builtin_amdgcn_mov_dpp(__builtin_bit_cast(int, x), CTRL, 0xf, 0xf, true)); }
__device__ __forceinline__ float row_allsum(float v) { v += dppf<0x128>(v); v += dppf<0x124>(v); v += dppf<0x122>(v); v += dppf<0x121>(v); return v; }
__device__ __forceinline__ void row_allsum4(float& a, float& b, float& c, float& d) {
#define RW_DPP4(n) "v_add_f32_dpp %0, %0, %0 row_ror:" #n " row_mask:0xf bank_mask:0xf\n\tv_add_f32_dpp %1, %1, %1 row_ror:" #n " row_mask:0xf bank_mask:0xf\n\t" \
                   "v_add_f32_dpp %2, %2, %2 row_ror:" #n " row_mask:0xf bank_mask:0xf\n\tv_add_f32_dpp %3, %3, %3 row_ror:" #n " row_mask:0xf bank_mask:0xf\n\t"
    asm volatile("s_nop 1\n\t" RW_DPP4(8) RW_DPP4(4) RW_DPP4(2) RW_DPP4(1) "s_nop 1" : "+v"(a), "+v"(b), "+v"(c), "+v"(d));
#undef RW_DPP4
}
__device__ __forceinline__ f32x4 ld4bf(const bf16_t* p) { const v2u w = *(const v2u*)p; return (f32x4){pg8::bflo(w.x), pg8::bfhi(w.x), pg8::bflo(w.y), pg8::bfhi(w.y)}; }
__device__ __forceinline__ float fsig(float x) { return __builtin_amdgcn_rcpf(1.f + __expf(-x)); }
__device__ __forceinline__ float ftanh(float x) { return 1.f - 2.f * __builtin_amdgcn_rcpf(1.f + __expf(2.f * x)); }
struct ZRow { v2u r, k, v, w, a; v4u g; };
__device__ __forceinline__ ZRow ldrow(const bf16_t* zr, int c4, int cg) {
    ZRow o; o.r = *(const v2u*)(zr + C_R + c4); o.k = *(const v2u*)(zr + C_K + c4); o.v = *(const v2u*)(zr + C_V + c4); o.w = *(const v2u*)(zr + C_WL + 4 * cg); o.a = *(const v2u*)(zr + C_AL + 4 * cg);
    o.g = *(const v4u*)(zr + C_GL + 8 * cg); return o;
}
__device__ __forceinline__ f32x4 up4(v2u w) { return (f32x4){pg8::bflo(w.x), pg8::bfhi(w.x), pg8::bflo(w.y), pg8::bfhi(w.y)}; }

struct ScanP { const float *mu, *w0, *w2, *a0, *a2, *g2, *k_k, *k_a, *r_k, *lnx_w, *lnx_b; };
__device__ __forceinline__ void scan_unit(LAS unsigned char* lds, const bf16_t* __restrict__ z, bf16_t* __restrict__ ya, const ScanP P, int b, int h, int tid, int wave, int lane) {
    const float* mu = P.mu; const float* w0 = P.w0; const float* w2 = P.w2; const float* a0 = P.a0; const float* a2 = P.a2; const float* g2 = P.g2;
    const float* k_k = P.k_k; const float* k_a = P.k_a; const float* r_k = P.r_k; const float* lnx_w = P.lnx_w; const float* lnx_b = P.lnx_b;
    const size_t rowb = (size_t)b * SEQ;
    const int tl = tid >> 4, cg = tid & 15;
    const int nt = wave & 3, rl = lane & 15, rg = lane >> 4;
    LAS float* rkv = (LAS float*)(lds + OFF_RKV); LAS float* vec = (LAS float*)(lds + OFF_VEC); LAS float* gbuf = (LAS float*)(lds + OFF_G);
    LAS float* ybuf = (LAS float*)(lds + OFF_Y); LAS float* nrm = (LAS float*)(lds + OFF_NRM); LAS float* scl = (LAS float*)(lds + OFF_SCL);
    bf16x8 bfr[8];
    {
        const int col = h * 64 + 16 * nt + rl;
#pragma unroll
        for (int f = 0; f < 8; ++f) {
            const float* src = (f < 2) ? w2 : (f < 4) ? a2 : g2;
            const int kb = ((f < 4) ? 32 * (f & 1) : 32 * (f - 4)) + 8 * rg;
            float e[8];
#pragma unroll
            for (int j = 0; j < 8; ++j) e[j] = src[(size_t)(kb + j) * 512 + col];
            v4u p; p.x = pg8::cvt_pk_bf16(e[0], e[1]); p.y = pg8::cvt_pk_bf16(e[2], e[3]); p.z = pg8::cvt_pk_bf16(e[4], e[5]); p.w = pg8::cvt_pk_bf16(e[6], e[7]);
            bfr[f] = __builtin_bit_cast(bf16x8, p);
        }
    }
    const int mt = wave >> 2;
    const int hc = h * 64 + 16 * nt + rl;
    const float w0c = w0[hc], a0c = a0[hc], kkc = k_k[hc], kac = k_a[hc], rkc = r_k[hc];
    const int c4 = h * 64 + 4 * cg;
    f32x2 St[4];
#pragma unroll
    for (int i = 0; i < 4; ++i) St[i] = (f32x2){0.f, 0.f};
    const int ra = 8 * wave + 2 * rg;
    LAS float* ctab = (LAS float*)(lds + OFF_CT);
    if (tl == 0) {
        LAS float* ct = ctab + cg * 36;
        *(LAS f32x4*)(ct + 0) = *(const f32x4*)(mu + C_R + c4); *(LAS f32x4*)(ct + 4) = *(const f32x4*)(mu + C_K + c4); *(LAS f32x4*)(ct + 8) = *(const f32x4*)(mu + C_V + c4);
        *(LAS f32x4*)(ct + 12) = *(const f32x4*)(mu + C_WL + 4 * cg); *(LAS f32x4*)(ct + 16) = *(const f32x4*)(mu + C_AL + 4 * cg);
        *(LAS f32x4*)(ct + 20) = *(const f32x4*)(mu + C_GL + 8 * cg); *(LAS f32x4*)(ct + 24) = *(const f32x4*)(mu + C_GL + 8 * cg + 4);
        *(LAS f32x4*)(ct + 28) = *(const f32x4*)(lnx_w + c4); *(LAS f32x4*)(ct + 32) = *(const f32x4*)(lnx_b + c4);
    }
    __syncthreads();
    const LAS float* myct = ctab + cg * 36;
    ZRow zc = ldrow(z + (rowb + tl) * NZ, c4, cg), zp;
    if (tl > 0) zp = ldrow(z + (rowb + tl - 1) * NZ, c4, cg); else { zp.r = zp.k = zp.v = zp.w = zp.a = (v2u){0u, 0u}; zp.g = (v4u){0u, 0u, 0u, 0u}; }
    for (int t0 = 0; t0 < SEQ; t0 += CH) {
        {
            const f32x4 cr = up4(zc.r), ck = up4(zc.k), cv = up4(zc.v), cw = up4(zc.w), ca = up4(zc.a);
            const f32x4 cg0 = (f32x4){pg8::bflo(zc.g.x), pg8::bfhi(zc.g.x), pg8::bflo(zc.g.y), pg8::bfhi(zc.g.y)}, cg1 = (f32x4){pg8::bflo(zc.g.z), pg8::bfhi(zc.g.z), pg8::bflo(zc.g.w), pg8::bfhi(zc.g.w)};
            const f32x4 pr = up4(zp.r), pk = up4(zp.k), pv = up4(zp.v), pw = up4(zp.w), pa = up4(zp.a);
            const f32x4 pg0 = (f32x4){pg8::bflo(zp.g.x), pg8::bfhi(zp.g.x), pg8::bflo(zp.g.y), pg8::bfhi(zp.g.y)}, pg1 = (f32x4){pg8::bflo(zp.g.z), pg8::bfhi(zp.g.z), pg8::bflo(zp.g.w), pg8::bfhi(zp.g.w)};
            if (t0 + CH < SEQ) { zc = ldrow(z + (rowb + t0 + CH + tl) * NZ, c4, cg); zp = ldrow(z + (rowb + t0 + CH + tl - 1) * NZ, c4, cg); }
            const f32x4 rs_ = cr + (pr - cr) * *(const LAS f32x4*)(myct + 0), ks_ = ck + (pk - ck) * *(const LAS f32x4*)(myct + 4), vs_ = cv + (pv - cv) * *(const LAS f32x4*)(myct + 8);
            const f32x4 ws_ = cw + (pw - cw) * *(const LAS f32x4*)(myct + 12), as_ = ca + (pa - ca) * *(const LAS f32x4*)(myct + 16);
            const f32x4 g0_ = cg0 + (pg0 - cg0) * *(const LAS f32x4*)(myct + 20), g1_ = cg1 + (pg1 - cg1) * *(const LAS f32x4*)(myct + 24);
            *(LAS f32x4*)(rkv + 0 * 2048 + tl * 64 + 4 * cg) = rs_; *(LAS f32x4*)(rkv + 1 * 2048 + tl * 64 + 4 * cg) = ks_; *(LAS f32x4*)(rkv + 2 * 2048 + tl * 64 + 4 * cg) = vs_;
            LAS unsigned char* ar = lds + OFF_ACT + tl * ACT_PITCH;
            v2u tw; tw.x = pg8::cvt_pk_bf16(ftanh(ws_[0]), ftanh(ws_[1])); tw.y = pg8::cvt_pk_bf16(ftanh(ws_[2]), ftanh(ws_[3]));
            *(LAS v2u*)(ar + 8 * cg) = tw;
            v2u aw; aw.x = pg8::cvt_pk_bf16(as_[0], as_[1]); aw.y = pg8::cvt_pk_bf16(as_[2], as_[3]);
            *(LAS v2u*)(ar + 128 + 8 * cg) = aw;
            v4u gw; gw.x = pg8::cvt_pk_bf16(fsig(g0_[0]), fsig(g0_[1])); gw.y = pg8::cvt_pk_bf16(fsig(g0_[2]), fsig(g0_[3]));
            gw.z = pg8::cvt_pk_bf16(fsig(g1_[0]), fsig(g1_[1])); gw.w = pg8::cvt_pk_bf16(fsig(g1_[2]), fsig(g1_[3]));
            *(LAS v4u*)(ar + 256 + 16 * cg) = gw;
            if (cg == 0) *(LAS f32x4*)(scl + 4 * tl) = (f32x4){0.f, 0.f, 0.f, 0.f};
        }
        __syncthreads();
        f32x4 accw = (f32x4){0.f, 0.f, 0.f, 0.f}, acca = accw, accg = accw;
        {
            const LAS unsigned char* ap = lds + OFF_ACT + (16 * mt + rl) * ACT_PITCH + 8 * rg * 2;
#pragma unroll
            for (int f = 0; f < 8; ++f) {
                const bf16x8 a = *(const LAS bf16x8*)(ap + f * 64);
                if (f < 2) accw = __builtin_amdgcn_mfma_f32_16x16x32_bf16(a, bfr[f], accw, 0, 0, 0);
                else if (f < 4) acca = __builtin_amdgcn_mfma_f32_16x16x32_bf16(a, bfr[f], acca, 0, 0, 0);
                else accg = __builtin_amdgcn_mfma_f32_16x16x32_bf16(a, bfr[f], accg, 0, 0, 0);
            }
        }
        float dec[4], av[4], kk[4];
        {
            const int c = 16 * nt + rl;
            float n2[4];
#pragma unroll
            for (int r = 0; r < 4; ++r) {
                const int tok = 16 * mt + 4 * rg + r;
                gbuf[tok * 64 + c] = accg[r];
                const float nx = -(w0c + accw[r]);
                const float sp = nx > 20.f ? nx : __logf(1.f + __expf(nx));
                dec[r] = __expf(-__expf(-sp - 0.5f));
                av[r] = fsig(a0c + acca[r]);
                kk[r] = rkv[1 * 2048 + tok * 64 + c] * kkc;
                n2[r] = kk[r] * kk[r];
            }
            row_allsum4(n2[0], n2[1], n2[2], n2[3]);
            if (rl == 0) {
#pragma unroll
                for (int r = 0; r < 4; ++r) nrm[(16 * mt + 4 * rg + r) * 4 + nt] = n2[r];
            }
        }
        __syncthreads();
        {
            const int c = 16 * nt + rl;
#pragma unroll
            for (int r = 0; r < 4; ++r) {
                const int tok = 16 * mt + 4 * rg + r;
                const f32x4 n4 = *(const LAS f32x4*)(nrm + tok * 4);
                const float ksv = rkv[1 * 2048 + tok * 64 + c], rsv = rkv[0 * 2048 + tok * 64 + c];
                const float inv = __builtin_amdgcn_rcpf(fmaxf(sqrtf((n4[0] + n4[1]) + (n4[2] + n4[3])), 1e-12f));
                const float kkn = kk[r] * inv, beta = kkn * av[r], kmod = ksv * (1.f + (av[r] - 1.f) * kac);
                LAS float* vp = vec + tok * 320 + c;
                vp[0] = dec[r]; vp[64] = beta; vp[128] = -kkn; vp[192] = kmod; vp[256] = dec[r] * rsv;
                float pbr = beta * rsv, pkr = kmod * rsv, pbo = rsv * kmod * rkc, dum = 0.f;
                row_allsum4(pbr, pkr, pbo, dum);
                if (rl == 0) { __hip_atomic_fetch_add(scl + tok * 4 + 0, pbr, __ATOMIC_RELAXED, __HIP_MEMORY_SCOPE_WORKGROUP); __hip_atomic_fetch_add(scl + tok * 4 + 1, pkr, __ATOMIC_RELAXED, __HIP_MEMORY_SCOPE_WORKGROUP); __hip_atomic_fetch_add(scl + tok * 4 + 2, pbo, __ATOMIC_RELAXED, __HIP_MEMORY_SCOPE_WORKGROUP); }
            }
        }
        __syncthreads();
        {
            const LAS float* vb0 = vec + 4 * rl; const LAS float* rv0 = rkv + 2 * 2048 + ra;
#define RW_DECL(P) f32x4 d4##P, b4##P, n4##P, k4##P, q4##P; f32x2 v2##P, s2##P
#define RW_LOAD(P, tk_) do { d4##P = *(const LAS f32x4*)(vb0 + (tk_) * 320); b4##P = *(const LAS f32x4*)(vb0 + (tk_) * 320 + 64); n4##P = *(const LAS f32x4*)(vb0 + (tk_) * 320 + 128); \
                k4##P = *(const LAS f32x4*)(vb0 + (tk_) * 320 + 192); q4##P = *(const LAS f32x4*)(vb0 + (tk_) * 320 + 256); \
                v2##P = *(const LAS f32x2*)(rv0 + (tk_) * 64); s2##P = *(const LAS f32x2*)(scl + (tk_) * 4); } while (0)
#define RW_STEP(P, tk_) do { \
                f32x2 sa = St[0] * n4##P[0] + St[1] * n4##P[1] + St[2] * n4##P[2] + St[3] * n4##P[3]; \
                f32x2 yy = St[0] * q4##P[0] + St[1] * q4##P[1] + St[2] * q4##P[2] + St[3] * q4##P[3]; \
                float sa0 = sa[0], sa1 = sa[1], yy0 = yy[0], yy1 = yy[1]; \
                row_allsum4(sa0, sa1, yy0, yy1); \
                sa = (f32x2){sa0, sa1}; \
                _Pragma("unroll") for (int i = 0; i < 4; ++i) St[i] = St[i] * d4##P[i] + sa * b4##P[i] + v2##P * k4##P[i]; \
                const f32x2 yo = (f32x2){yy0, yy1} + sa * s2##P[0] + v2##P * s2##P[1]; \
                if (rl == 0) *(LAS f32x2*)(ybuf + (tk_) * 64 + ra) = yo; } while (0)
            RW_DECL(A); RW_DECL(B);
            RW_LOAD(A, 0);
            for (int tk = 0; tk < CH; tk += 2) {
                RW_LOAD(B, tk + 1);
                RW_STEP(A, tk);
                if (tk + 2 < CH) RW_LOAD(A, tk + 2);
                RW_STEP(B, tk + 1);
            }
#undef RW_DECL
#undef RW_LOAD
#undef RW_STEP
        }
        __syncthreads();
        {
            const f32x4 y4 = *(const LAS f32x4*)(ybuf + tl * 64 + 4 * cg);
            const float mean = row_allsum((y4[0] + y4[1]) + (y4[2] + y4[3])) * (1.f / 64.f);
            const f32x4 dv = y4 - mean;
            const float var = row_allsum((dv[0] * dv[0] + dv[1] * dv[1]) + (dv[2] * dv[2] + dv[3] * dv[3])) * (1.f / 64.f);
            const float rs_ = rsqrtf(var + GN_EPS);
            const f32x4 yn = dv * rs_ * *(const LAS f32x4*)(myct + 28) + *(const LAS f32x4*)(myct + 32);
            const float bonus = scl[tl * 4 + 2];
            const f32x4 vs_ = *(const LAS f32x4*)(rkv + 2 * 2048 + tl * 64 + 4 * cg), g4 = *(const LAS f32x4*)(gbuf + tl * 64 + 4 * cg);
            const f32x4 o = (yn + vs_ * bonus) * g4;
            v2u w; w.x = pg8::cvt_pk_bf16(o[0], o[1]); w.y = pg8::cvt_pk_bf16(o[2], o[3]);
            *(v2u*)(ya + (rowb + t0 + tl) * 512 + c4) = w;
        }
        __syncthreads();
    }
}
}

typedef __bf16 bf16x2_t __attribute__((ext_vector_type(2)));
__device__ __forceinline__ float dot2bf(unsigned a, unsigned b, float c) { return __builtin_amdgcn_fdot2_f32_bf16(__builtin_bit_cast(bf16x2_t, a), __builtin_bit_cast(bf16x2_t, b), c, false); }
__device__ __forceinline__ unsigned f2ord(float f) { const unsigned u = __float_as_uint(f); return (u & 0x80000000u) ? ~u : (u | 0x80000000u); }
__device__ __forceinline__ float ord2f(unsigned o) { return __uint_as_float((o & 0x80000000u) ? (o ^ 0x80000000u) : ~o); }
__device__ __forceinline__ unsigned row_allmax_u32(unsigned v) {
    v = max(v, (unsigned)__builtin_amdgcn_update_dpp(0, (int)v, 0x128, 0xf, 0xf, false));
    v = max(v, (unsigned)__builtin_amdgcn_update_dpp(0, (int)v, 0x124, 0xf, 0xf, false));
    v = max(v, (unsigned)__builtin_amdgcn_update_dpp(0, (int)v, 0x122, 0xf, 0xf, false));
    v = max(v, (unsigned)__builtin_amdgcn_update_dpp(0, (int)v, 0x121, 0xf, 0xf, false));
    return v;
}

constexpr int TK_PITCH = 272, TK_HALF = 128 * TK_PITCH;
typedef short tk_bf16x8 __attribute__((ext_vector_type(8)));
__device__ __forceinline__ void topk_loadq(tk_bf16x8 (&qa)[8], const bf16_t* __restrict__ qb, int t0, int h, int lane) {
    const bf16_t* qp = qb + (size_t)(t0 + (lane & 15)) * 2048 + h * 256 + 8 * (lane >> 4);
#pragma unroll
    for (int i = 0; i < 8; ++i) qa[i] = *(const tk_bf16x8*)(qp + i * 32);
}
__device__ __forceinline__ void topk_item(const tk_bf16x8 (&qa)[8], const LAS unsigned char* klds, int* __restrict__ ids, float* __restrict__ gates, int t0, int h, int lane) {
    const int rl = lane & 15, rg = lane >> 4;
    unsigned top[2][4];
#pragma unroll
    for (int c = 0; c < 2; ++c) {
        f32x4 acc[8];
#pragma unroll
        for (int nt = 0; nt < 8; ++nt) acc[nt] = (f32x4){64.f, 64.f, 64.f, 64.f};
        const LAS unsigned char* kp = klds + c * TK_HALF + rl * TK_PITCH + 16 * rg;
#pragma unroll
        for (int ks = 0; ks < 4; ++ks) {
#pragma unroll
            for (int nt = 0; nt < 8; ++nt) { const tk_bf16x8 b = *(const LAS tk_bf16x8*)(kp + nt * 16 * TK_PITCH + ks * 64); acc[nt] = __builtin_amdgcn_mfma_f32_16x16x32_bf16(qa[c * 4 + ks], b, acc[nt], 0, 0, 0); }
            __builtin_amdgcn_sched_barrier(0);
        }
#pragma unroll
        for (int r = 0; r < 4; ++r) {
            unsigned k[8];
#pragma unroll
            for (int nt = 0; nt < 8; ++nt) k[nt] = (__float_as_uint(fmaxf(acc[nt][r], 1.f)) & ~127u) | (unsigned)(127 - (nt * 16 + rl));
#define TK_CE(i, j) do { const unsigned a_ = max(k[i], k[j]), b_ = min(k[i], k[j]); k[i] = a_; k[j] = b_; } while (0)
            TK_CE(0, 1); TK_CE(2, 3); TK_CE(4, 5); TK_CE(6, 7); TK_CE(0, 2); TK_CE(1, 3); TK_CE(4, 6); TK_CE(5, 7); TK_CE(1, 2); TK_CE(5, 6);
            TK_CE(0, 4); TK_CE(1, 5); TK_CE(2, 6); TK_CE(3, 7); TK_CE(2, 4); TK_CE(3, 5); TK_CE(1, 2); TK_CE(3, 4); TK_CE(5, 6);
#undef TK_CE
            unsigned tp = 0u;
            for (int round = 0; round < 16; ++round) {
                const unsigned m = row_allmax_u32(k[0]);
                tp = (rl == round) ? m : tp;
                const bool win = (k[0] == m);
                k[0] = win ? k[1] : k[0]; k[1] = win ? k[2] : k[1]; k[2] = win ? k[3] : k[2]; k[3] = win ? k[4] : k[3];
                k[4] = win ? k[5] : k[4]; k[5] = win ? k[6] : k[5]; k[6] = win ? k[7] : k[6]; k[7] = win ? 0u : k[7];
            }
            top[c][r] = tp;
        }
    }
    const int rowbase = lane & 48;
    float v1[4]; int n1[4], ptr[4], myid[4]; unsigned k2[4], myv[4];
#pragma unroll
    for (int r = 0; r < 4; ++r) { v1[r] = __uint_as_float(top[0][r] & ~127u); n1[r] = 127 - (int)(top[0][r] & 127u); ptr[r] = 0; k2[r] = (unsigned)__builtin_amdgcn_ds_bpermute(rowbase * 4, (int)top[1][r]); myid[r] = 0; myv[r] = 0u; }
    for (int round = 0; round < 16; ++round) {
#pragma unroll
        for (int r = 0; r < 4; ++r) {
            const float head = v1[r] + __uint_as_float(k2[r] & ~127u);
            const unsigned key = (ptr[r] < 16) ? ((__float_as_uint(head) & ~15u) | (unsigned)(15 - rl)) : 0u;
            const unsigned m = row_allmax_u32(key);
            const bool win = (key == m);
            const unsigned wid = row_allmax_u32(win ? (unsigned)(n1[r] * 128 + (127 - (int)(k2[r] & 127u))) + 1u : 0u);
            myid[r] = (rl == round) ? (int)wid - 1 : myid[r];
            myv[r] = (rl == round) ? m : myv[r];
            ptr[r] += win ? 1 : 0;
            k2[r] = (unsigned)__builtin_amdgcn_ds_bpermute((rowbase + (ptr[r] & 15)) * 4, (int)top[1][r]);
        }
    }
#pragma unroll
    for (int r = 0; r < 4; ++r) {
        const float val = __uint_as_float(myv[r] & ~15u);
        const float vmax = __uint_as_float((unsigned)__builtin_amdgcn_ds_bpermute(rowbase * 4, (int)__float_as_uint(val)));
        const float e = __expf(val - vmax);
        const float sum = rw::row_allsum(e);
        gates[(size_t)(t0 + 4 * rg + r) * 128 + h * 16 + rl] = e / sum; ids[(size_t)(t0 + 4 * rg + r) * 128 + h * 16 + rl] = myid[r];
    }
}

typedef float f32x2 __attribute__((ext_vector_type(2)));
__device__ __forceinline__ void peer_token(const bf16_t* __restrict__ x2b, const float* __restrict__ ssq2, const int* __restrict__ ids, const float* __restrict__ gates,
                                           const unsigned char* __restrict__ U8, const unsigned char* __restrict__ V8, const float* __restrict__ usc, const float* __restrict__ vsc,
                                           const float* __restrict__ fw, float* __restrict__ out, int t, int lane) {
    const int l16 = lane * 16;
    f32x2 hx[8];
    {
        const v4u h0 = *(const v4u*)(x2b + (size_t)t * DM + l16), h1 = *(const v4u*)(x2b + (size_t)t * DM + l16 + 8);
        const unsigned hw[8] = {h0.x, h0.y, h0.z, h0.w, h1.x, h1.y, h1.z, h1.w};
#pragma unroll
        for (int i = 0; i < 8; ++i) hx[i] = (f32x2){pg8::bflo(hw[i]), pg8::bfhi(hw[i])};
    }
    const int idA = ids[(size_t)t * 128 + lane], idB = ids[(size_t)t * 128 + 64 + lane];
    const float rs = rsqrtf(ssq2[t] * (1.f / DM) + NORM_EPS);
    const float suA = rs * usc[idA], suB = rs * usc[idB];
    const float svA = gates[(size_t)t * 128 + lane] * vsc[idA], svB = gates[(size_t)t * 128 + 64 + lane] * vsc[idB];
    f32x2 y[8];
#pragma unroll
    for (int i = 0; i < 8; ++i) y[i] = (f32x2){0.f, 0.f};
    const int bit0 = lane & 1, bit1 = (lane >> 1) & 1, bit2 = (lane >> 2) & 1;
    const int myk = 4 * bit0 + 2 * bit1 + bit2;
    for (int g = 0; g < 16; ++g) {
        const int idsel = (g < 8) ? idA : idB; const float susel = (g < 8) ? suA : suB, svsel = (g < 8) ? svA : svB; const int lb = (g * 8) & 63;
        v4u uw[8], vw[8];
#pragma unroll
        for (int k = 0; k < 8; ++k) { const int e = __builtin_amdgcn_readlane(idsel, lb + k); uw[k] = *(const v4u*)(U8 + (size_t)e * DM + l16); vw[k] = *(const v4u*)(V8 + (size_t)e * DM + l16); }
        float d[8];
#pragma unroll
        for (int k = 0; k < 8; ++k) {
            f32x2 a = (f32x2){0.f, 0.f};
#pragma unroll
            for (int i = 0; i < 4; ++i) { a += __builtin_amdgcn_cvt_pk_f32_fp8((int)uw[k][i], false) * hx[2 * i]; a += __builtin_amdgcn_cvt_pk_f32_fp8((int)uw[k][i], true) * hx[2 * i + 1]; }
            d[k] = a[0] + a[1];
        }
        float r4[4];
#pragma unroll
        for (int k = 0; k < 4; ++k) { const float send = bit0 ? d[k] : d[k + 4], keep = bit0 ? d[k + 4] : d[k]; r4[k] = keep + __shfl_xor(send, 1); }
        float r2[2];
#pragma unroll
        for (int k = 0; k < 2; ++k) { const float send = bit1 ? r4[k] : r4[k + 2], keep = bit1 ? r4[k + 2] : r4[k]; r2[k] = keep + __shfl_xor(send, 2); }
        float r1;
        { const float send = bit2 ? r2[0] : r2[1], keep = bit2 ? r2[1] : r2[0]; r1 = keep + __shfl_xor(send, 4); }
        r1 += __shfl_xor(r1, 8); r1 += __shfl_xor(r1, 16); r1 += __shfl_xor(r1, 32);
        const float dd = r1 * __shfl(susel, lb + myk);
        const float act = 0.5f * dd * (1.f + erff(dd * 0.70710678118654752f)) * __shfl(svsel, lb + myk);
#pragma unroll
        for (int k = 0; k < 8; ++k) {
            const float a = __uint_as_float((unsigned)__builtin_amdgcn_readlane((int)__float_as_uint(act), ((k & 1) << 2) | (k & 2) | ((k >> 2) & 1)));
            const f32x2 a2 = (f32x2){a, a};
#pragma unroll
            for (int i = 0; i < 4; ++i) { y[2 * i] += __builtin_amdgcn_cvt_pk_f32_fp8((int)vw[k][i], false) * a2; y[2 * i + 1] += __builtin_amdgcn_cvt_pk_f32_fp8((int)vw[k][i], true) * a2; }
        }
    }
    float* orow = out + (size_t)t * DM + l16;
    float ss = 0.f;
    f32x4 o4[4];
#pragma unroll
    for (int i = 0; i < 4; ++i) { o4[i] = (f32x4){hx[2 * i][0] + y[2 * i][0], hx[2 * i][1] + y[2 * i][1], hx[2 * i + 1][0] + y[2 * i + 1][0], hx[2 * i + 1][1] + y[2 * i + 1][1]};
        ss += (o4[i][0] * o4[i][0] + o4[i][1] * o4[i][1]) + (o4[i][2] * o4[i][2] + o4[i][3] * o4[i][3]); }
    ss = wave_sum(ss);
    const float r = rsqrtf(ss * (1.f / DM) + NORM_EPS);
#pragma unroll
    for (int i = 0; i < 4; ++i) *(f32x4*)(orow + 4 * i) = o4[i] * r * *(const f32x4*)(fw + l16 + 4 * i);
}

__global__ void __launch_bounds__(NWAVES * 64, 2) mk_fwd(Args args) {
    extern __shared__ __attribute__((aligned(16))) unsigned char lds_raw[];
    LAS unsigned char* lds = (LAS unsigned char*)lds_raw;
    volatile LAS unsigned* MISC = (volatile LAS unsigned*)(lds + MISC_OFF);
    const int tid = threadIdx.x, lane = tid & 63, wave = __builtin_amdgcn_readfirstlane(tid >> 6);
    const int G = gridDim.x; const int bx = blockIdx.x; const int vcu = (G % 8 == 0) ? (bx % 8) * (G / 8) + bx / 8 : bx;
    unsigned char* ws = args.ws;
    unsigned* ctl = (unsigned*)(ws + WS_CTL);
    for (int u = tid; u < (LDS_BYTES - LDSCTL_OFF) / 4; u += NWAVES * 64) ((LAS unsigned*)(lds + LDSCTL_OFF))[u] = 0u;
    __syncthreads();
    XcdBarrier bar = xcd_barrier_post(ctl + CW_BAR + args.li * XCD_BAR_WORDS, MISC + 8);
    const int lo = args.ph_lo, hi = args.ph_hi;
#define IN(k) (lo <= (k) && (k) < hi)
#define BOTH(k) (IN(k) && IN((k) + 1))
    bf16_t* WinT = (bf16_t*)(ws + WS_WIN); bf16_t* PaT = (bf16_t*)(ws + WS_PA); bf16_t* PbT = (bf16_t*)(ws + WS_PB); bf16_t* WoT = (bf16_t*)(ws + WS_WO);
    bf16_t* WqT = (bf16_t*)(ws + WS_WQ); bf16_t* KeysB = (bf16_t*)(ws + WS_KEYS);
    float* rstd1 = (float*)(ws + WS_RSTD1); float* ssq2 = (float*)(ws + WS_RSTD2); float* scal = (float*)(ws + WS_SCAL);
    unsigned char* U8 = ws + WS_U; unsigned char* V8 = ws + WS_V; float* usc = (float*)(ws + WS_USC); float* vsc = (float*)(ws + WS_VSC);
    bf16_t* xb = (bf16_t*)(ws + WS_XB); bf16_t* ya = (bf16_t*)(ws + WS_YA); bf16_t* yb = (bf16_t*)(ws + WS_YB); bf16_t* x2b = (bf16_t*)(ws + WS_X2B);
    bf16_t* z = (bf16_t*)(ws + WS_Z); bf16_t* qb = (bf16_t*)(ws + WS_Q);
    bf16_t* merged = (bf16_t*)(ws + WS_MERGED);
    const int gw = vcu * NWAVES + wave, NGW = G * NWAVES;

    if (IN(0)) {
        LAS float* scr = (LAS float*)(lds + wave * 16384);
        constexpr int I_IN = (DM / 64) * (NZ / 32), I_PA = (512 / 64) * (DM / 32), I_WO = (DM / 64) * (DM / 32), I_WQ = (DM / 64) * (2048 / 32);
        constexpr int NITEMS = I_IN + 2 * I_PA + I_WO + I_WQ;
        for (int it = gw; it < NITEMS; it += NGW) {
            int r = it;
            if (r < I_IN) { p0_transpose_item(args.in[2], args.in[1], DM, NZ, WinT, scr, r, lane); continue; } r -= I_IN;
            if (r < I_PA) { p0_transpose_item(args.in[19], nullptr, 512, DM, PaT, scr, r, lane); continue; } r -= I_PA;
            if (r < I_PA) { p0_transpose_item(args.in[20], nullptr, 512, DM, PbT, scr, r, lane); continue; } r -= I_PA;
            if (r < I_WO) { p0_transpose_item(args.in[21], nullptr, DM, DM, WoT, scr, r, lane); continue; } r -= I_WO;
            p0_transpose_item(args.in[23], args.in[22], DM, 2048, WqT, scr, r, lane);
        }
        p0_convert(args.in[24], nullptr, KeysB, (size_t)16 * 128 * 128, gw, NGW, lane);
        for (int e = gw; e < 2 * NEXP; e += NGW) {
            const bool isu = e < NEXP; const int row = isu ? e : e - NEXP;
            p0_row_fp8((isu ? args.in[25] : args.in[26]) + (size_t)row * DM, isu ? args.in[22] : nullptr, (isu ? U8 : V8) + (size_t)row * DM, (isu ? usc : vsc) + row, lane);
        }
        for (int m = gw; m < T_TOK; m += NGW) {
            const f32x4* xr = (const f32x4*)(args.in[0] + (size_t)m * DM) + lane;
            f32x4 v[4]; float s = 0.f;
#pragma unroll
            for (int j = 0; j < 4; ++j) { v[j] = xr[64 * j]; s += (v[j][0] * v[j][0] + v[j][1] * v[j][1]) + (v[j][2] * v[j][2] + v[j][3] * v[j][3]); }
            s = wave_sum(s);
            v2u* o8 = (v2u*)(xb + (size_t)m * DM) + lane;
#pragma unroll
            for (int j = 0; j < 4; ++j) { v2u w; w.x = pg8::cvt_pk_bf16(v[j][0], v[j][1]); w.y = pg8::cvt_pk_bf16(v[j][2], v[j][3]); o8[64 * j] = w; }
            if (lane == 0) { rstd1[m] = rsqrtf(s * (1.f / DM) + NORM_EPS); ssq2[m] = 0.f; }
        }
        if (gw == 0) {
            const float a = wave_sum(args.in[14][lane] * args.in[15][lane]), b = wave_sum(args.in[16][lane] * args.in[17][lane]);
            if (lane == 0) scal[0] = __expf(a) - __expf(b) + LAM_INIT;
        }
        if (BOTH(0)) xcd_barrier(bar);
    }
    if (IN(1)) {
        pg8::Gemm g{xb, WinT, DM, DM, DM}; pg8::StaticOrder S; S.init(T_TOK, NZ, G, bx);
        pg8::EpiRowScale<false> E{z, NZ, rstd1};
        for (int rep = 0; rep < REPS(1); ++rep) pg8::gemm_phase(lds, g, S, E);
        if (BOTH(1)) xcd_barrier(bar);
    }
    if (IN(2)) {
        {
            const rw::ScanP P{args.in[3], args.in[4], args.in[5], args.in[6], args.in[7], args.in[8], args.in[9], args.in[10], args.in[11], args.in[12], args.in[13]};
            for (int rep = 0; rep < REPS(2); ++rep) for (int u = vcu; u < NB * 8; u += G) rw::scan_unit(lds, z, ya, P, u >> 3, u & 7, tid, wave, lane);
        }
        const float lam = scal[0];
        for (int rep = 0; rep < REPS(10); ++rep) for (int i = 0;; ++i) {
            const int idx = vcu + i * G; if (idx >= 2048) break;
            const int slot = idx >> 8, v = idx & 255, bh = v >> 1, a = (v & 1) * 4 + (slot >> 1), qblk = (slot & 1) ? 15 - a : a;
            da::attn_unit(lds, z, yb, args.in[18], lam, bh >> 2, bh & 3, qblk, wave, lane);
        }
        if (BOTH(2)) xcd_barrier(bar);
    }
    if (IN(3)) {
        pg8::Gemm g{ya, PaT, 512, 512, 512}; pg8::StaticOrder S; S.init(T_TOK, DM, G, bx);
        pg8::EpiGate<false> E{merged, z, C_GA};
        pg8::gemm_phase(lds, g, S, E);
        if (BOTH(3)) xcd_barrier(bar);
    }
    if (IN(4)) {
        pg8::Gemm g{yb, PbT, 512, 512, 512}; pg8::StaticOrder S; S.init(T_TOK, DM, G, bx);
        pg8::EpiGate<true> E{merged, z, C_GB};
        pg8::gemm_phase(lds, g, S, E);
        if (BOTH(4)) xcd_barrier(bar);
    }
    if (IN(5)) {
        pg8::Gemm g{merged, WoT, DM, DM, DM}; pg8::StaticOrder S; S.init(T_TOK, DM, G, bx);
        pg8::EpiX2 E{args.in[0], args.out, x2b, ssq2};
        pg8::gemm_phase(lds, g, S, E);
        if (BOTH(5)) xcd_barrier(bar);
    }
    if (IN(6)) {
        pg8::Gemm g{x2b, WqT, DM, DM, DM}; pg8::StaticOrder S; S.init(T_TOK, 2048, G, bx);
        pg8::EpiRowScale<true> E{qb, 2048, ssq2};
        for (int rep = 0; rep < REPS(6); ++rep) pg8::gemm_phase(lds, g, S, E);
        if (BOTH(6)) xcd_barrier(bar);
    }
    if (IN(7)) {
        int* ids = (int*)(ws + WS_IDS); float* gates = (float*)(ws + WS_GATES);
        for (int rep = 0; rep < REPS(7); ++rep)
        for (int h = 0; h < 8; ++h) {
            __syncthreads();
            {
                const bf16_t* ksrc = KeysB + (size_t)h * 2 * 128 * 128;
#pragma unroll
                for (int i = 0; i < 8; ++i) { const int chunk = tid + i * 512, row = chunk >> 4, cc = chunk & 15;
                    *(LAS v4u*)(lds + (row >> 7) * TK_HALF + (row & 127) * TK_PITCH + cc * 16) = *(const v4u*)(ksrc + (size_t)row * 128 + cc * 8); }
            }
            __syncthreads();
            for (int tile = gw; tile < 4096; tile += NGW) {
                tk_bf16x8 qa[8];
                topk_loadq(qa, qb, tile * 16, h, lane);
                topk_item(qa, lds, ids, gates, tile * 16, h, lane);
            }
        }
        if (BOTH(7)) xcd_barrier(bar);
    }
    if (IN(8)) {
        const int* ids = (const int*)(ws + WS_IDS); const float* gates = (const float*)(ws + WS_GATES);
        for (int t = gw; t < T_TOK; t += NGW) peer_token(x2b, ssq2, ids, gates, U8, V8, usc, vsc, args.in[27], args.out, t, lane);
    }
#undef IN
#undef BOTH
}

extern "C" void kernel_launch(void* const* d_in, const int* in_sizes, int n_in, void* d_out, int out_size, void* d_ws, size_t ws_size, hipStream_t stream) {
    static int grid = 0;
    if (grid == 0) {
        if (n_in != 28 || in_sizes[0] != T_TOK * DM || out_size != T_TOK * DM || ws_size < WS_END) {
            fprintf(stderr, "kernel_launch: unexpected shapes / workspace (n_in %d, ws %zu < %zu)\n", n_in, ws_size, (size_t)WS_END); grid = -1; return; }
        int dev = 0, cus = 0;
        if (hipGetDevice(&dev) != hipSuccess || hipDeviceGetAttribute(&cus, hipDeviceAttributeMultiprocessorCount, dev) != hipSuccess) { grid = -1; return; }
        if (hipFuncSetAttribute((const void*)mk_fwd, hipFuncAttributeMaxDynamicSharedMemorySize, LDS_BYTES) != hipSuccess) { fprintf(stderr, "kernel_launch: hipFuncSetAttribute failed\n"); grid = -1; return; }
        grid = cus;
    }
    if (grid < 0) return;
    unsigned char* ws = (unsigned char*)d_ws;
    float* out = (float*)d_out;
    (void)hipMemsetAsync(ws + WS_CTL, 0, 1 * MiB, stream);
    Args a{};
    for (int i = 0; i < 28; ++i) a.in[i] = (const float*)d_in[i];
    a.out = out; a.ws = ws;
    a.ph_lo = 0; a.ph_hi = 9; a.li = 0;
    hipLaunchKernelGGL(mk_fwd, dim3(grid), dim3(NWAVES * 64), LDS_BYTES, stream, a);
}
```

```cpp
#include <hip/hip_runtime.h>
#include <stdint.h>
#include <cstdio>

typedef unsigned short bf16_t;
typedef unsigned int u32;

#ifndef PROBE_REP
#define PROBE_REP 0
#endif
#define REPS(k) (((PROBE_REP >> (k)) & 1) ? 2 : 1)
constexpr int T_TOK = 65536, DM = 1024, SEQ = 2048, NB = 32;
constexpr int NZ = 5376;
constexpr int C_R = 0, C_K = 512, C_V = 1024, C_WL = 1536, C_AL = 1600, C_GL = 1664, C_Q = 1792, C_ZK = 2304, C_ZV = 2816, C_GA = 3328, C_GB = 4352;
constexpr int NEXP = 16384;
constexpr float NORM_EPS = 1e-6f, GN_EPS = 64e-5f, SUBLN_EPS = 1e-5f;
constexpr float LAM_INIT = 0.2f;

constexpr size_t MiB = 1u << 20;
constexpr size_t WS_CTL = 0;
constexpr size_t WS_WIN = 1 * MiB;
constexpr size_t WS_PA = 12 * MiB;
constexpr size_t WS_PB = 13 * MiB;
constexpr size_t WS_WO = 14 * MiB;
constexpr size_t WS_WQ = 16 * MiB;
constexpr size_t WS_KEYS = 20 * MiB;
constexpr size_t WS_RSTD1 = 21 * MiB;
constexpr size_t WS_RSTD2 = 22 * MiB;
constexpr size_t WS_SCAL = 23 * MiB;
constexpr size_t WS_U = 24 * MiB;
constexpr size_t WS_V = 40 * MiB;
constexpr size_t WS_USC = 56 * MiB;
constexpr size_t WS_VSC = 57 * MiB;
constexpr size_t WS_XB = 88 * MiB;
constexpr size_t WS_YA = WS_XB;
constexpr size_t WS_YB = WS_XB + 64 * MiB;
constexpr size_t WS_X2B = WS_XB;
constexpr size_t WS_Z = 216 * MiB;
constexpr size_t WS_Q = WS_Z;
constexpr size_t WS_IDS = WS_Z + 256 * MiB;
constexpr size_t WS_GATES = WS_Z + 288 * MiB;
constexpr size_t WS_MERGED = 888 * MiB;
constexpr size_t WS_END = 1016 * MiB;

__device__ __forceinline__ float bf2f(bf16_t h) { return __uint_as_float(((u32)h) << 16); }
__device__ __forceinline__ bf16_t f2bf(float f) { u32 u = __float_as_uint(f); u += 0x7fffu + ((u >> 16) & 1u); return (bf16_t)(u >> 16); }
__device__ __forceinline__ float wave_sum(float v) {
#pragma unroll
    for (int o = 1; o < 64; o <<= 1) v += __shfl_xor(v, o);
    return v;
}
__device__ __forceinline__ float sigmoidf_(float x) { return 1.f / (1.f + __expf(-x)); }

namespace pg8 {
#define PG8_LAS __attribute__((address_space(3)))
typedef short bf16x8 __attribute__((ext_vector_type(8)));
typedef float f32x4 __attribute__((ext_vector_type(4)));
typedef unsigned u32x4 __attribute__((ext_vector_type(4)));
constexpr int BM = 256, BK = 64, HALF = 128, HTB = HALF * BK * 2  , STAGE_BYTES = 8 * HTB, NXCD = 8, WGM = 8;

__host__ __device__ __forceinline__ int lds_byte(int r, int c) { const int st = (r >> 4) * 2 + (c >> 5), rr = r & 15, cc = c & 31, ob = rr * 64 + cc * 2; return st * 1024 + (ob ^ (((ob >> 9) & 1) << 5)); }
__host__ __device__ __forceinline__ void stage_rc(int b, int& R, int& C) { const int st = b / 1024, sb = b % 1024, swz = sb ^ (((sb >> 9) & 1) << 5); R = (st >> 1) * 16 + swz / 64; C = (st & 1) * 32 + (swz % 64) / 2; }
__host__ __device__ __forceinline__ int perm32(int rho) { const int n = rho >> 4, i = rho & 15; return 8 * (i >> 2) + 4 * n + (i & 3); }

struct Unit { int pm, pn; };
struct Gemm { const bf16_t* A; const bf16_t* Bt; int lda, ldb, K; };

struct StaticOrder {
    int nM, nN, nwg, G, c;
    __host__ __device__ void init(int M, int N, int G_, int c_) { nM = M / BM; nN = N / BM; nwg = nM * nN; G = G_; c = c_; }
    __host__ __device__ bool next(int i, Unit& u) const {
        const long L = (long)i * G + c; if (L >= nwg) return false;
        int wgid = (int)L; { const int q = nwg / NXCD, r = nwg % NXCD, xcd = wgid % NXCD, off = wgid / NXCD; wgid = (xcd < r ? xcd * (q + 1) : r * (q + 1) + (xcd - r) * q) + off; }
        const int nig = WGM * nN, gid = wgid / nig, fm = gid * WGM, gsz = (nM - fm) < WGM ? (nM - fm) : WGM;
        u.pm = fm + ((wgid % nig) % gsz); u.pn = (wgid % nig) / gsz; return true;
    }
};
typedef float f32x2_c __attribute__((ext_vector_type(2))); typedef __bf16 bf16x2_c __attribute__((ext_vector_type(2)));
__device__ __forceinline__ unsigned cvt_pk_bf16(float lo, float hi) { const f32x2_c v = {lo, hi}; const bf16x2_c b = __builtin_convertvector(v, bf16x2_c); return __builtin_bit_cast(unsigned, b); }
__device__ __forceinline__ float bflo(unsigned w) { return __uint_as_float(w << 16); }
__device__ __forceinline__ float bfhi(unsigned w) { return __uint_as_float(w & 0xffff0000u); }

template <bool SSQ> struct EpiRowScale {
    static constexpr bool PERM = true;
    bf16_t* O; int ldc; const float* rs;
    __device__ __forceinline__ void operator()(const f32x4 (&acc)[2][2][4][2], const Unit& u, int wr, int wc, int fr, int fq) const {
        const int row0 = u.pm * BM + wr * 64 + fr, col0 = u.pn * BM + wc * 32 + 8 * fq;
#pragma unroll
        for (int ai = 0; ai < 2; ++ai)
#pragma unroll
            for (int m = 0; m < 4; ++m) {
                const int row = row0 + ai * HALF + m * 16;
                float s = rs[row]; if (SSQ) s = rsqrtf(s * (1.f / 1024.f) + NORM_EPS);
                bf16_t* rowp = O + (size_t)row * ldc + col0;
#pragma unroll
                for (int bj = 0; bj < 2; ++bj) {
                    const f32x4 v0 = acc[ai][bj][m][0] * s, v1 = acc[ai][bj][m][1] * s;
                    u32x4 w; w.x = cvt_pk_bf16(v0[0], v0[1]); w.y = cvt_pk_bf16(v0[2], v0[3]); w.z = cvt_pk_bf16(v1[0], v1[1]); w.w = cvt_pk_bf16(v1[2], v1[3]);
                    *(u32x4*)(rowp + bj * HALF) = w;
                }
            }
    }
};
template <bool ACCUM> struct EpiGate {
    static constexpr bool PERM = true;
    bf16_t* mg; const bf16_t* z; int gcol;
    __device__ __forceinline__ void operator()(const f32x4 (&acc)[2][2][4][2], const Unit& u, int wr, int wc, int fr, int fq) const {
        const int row0 = u.pm * BM + wr * 64 + fr, col0 = u.pn * BM + wc * 32 + 8 * fq;
#pragma unroll
        for (int ai = 0; ai < 2; ++ai)
#pragma unroll
            for (int m = 0; m < 4; ++m) {
                const int row = row0 + ai * HALF + m * 16;
                const bf16_t* gp = z + (size_t)row * NZ + gcol + col0;
                bf16_t* rowp = mg + (size_t)row * DM + col0;
#pragma unroll
                for (int bj = 0; bj < 2; ++bj) {
                    const u32x4 g = *(const u32x4*)(gp + bj * HALF);
                    const f32x4 a0 = acc[ai][bj][m][0], a1 = acc[ai][bj][m][1];
                    float r[8];
                    r[0] = sigmoidf_(bflo(g.x)) * a0[0]; r[1] = sigmoidf_(bfhi(g.x)) * a0[1]; r[2] = sigmoidf_(bflo(g.y)) * a0[2]; r[3] = sigmoidf_(bfhi(g.y)) * a0[3];
                    r[4] = sigmoidf_(bflo(g.z)) * a1[0]; r[5] = sigmoidf_(bfhi(g.z)) * a1[1]; r[6] = sigmoidf_(bflo(g.w)) * a1[2]; r[7] = sigmoidf_(bfhi(g.w)) * a1[3];
                    if (ACCUM) { const u32x4 o = *(const u32x4*)(rowp + bj * HALF);
                        r[0] += bflo(o.x); r[1] += bfhi(o.x); r[2] += bflo(o.y); r[3] += bfhi(o.y); r[4] += bflo(o.z); r[5] += bfhi(o.z); r[6] += bflo(o.w); r[7] += bfhi(o.w); }
                    u32x4 w; w.x = cvt_pk_bf16(r[0], r[1]); w.y = cvt_pk_bf16(r[2], r[3]); w.z = cvt_pk_bf16(r[4], r[5]); w.w = cvt_pk_bf16(r[6], r[7]);
                    *(u32x4*)(rowp + bj * HALF) = w;
                }
            }
    }
};
struct EpiX2 {
    static constexpr bool PERM = true;
    const float* x; float* x2; bf16_t* x2b; float* ssq;
    __device__ __forceinline__ void operator()(const f32x4 (&acc)[2][2][4][2], const Unit& u, int wr, int wc, int fr, int fq) const {
        const int row0 = u.pm * BM + wr * 64 + fr, col0 = u.pn * BM + wc * 32 + 8 * fq;
#pragma unroll
        for (int ai = 0; ai < 2; ++ai)
#pragma unroll
            for (int m = 0; m < 4; ++m) {
                const int row = row0 + ai * HALF + m * 16;
                const size_t off = (size_t)row * DM + col0;
                float ss = 0.f;
#pragma unroll
                for (int bj = 0; bj < 2; ++bj) {
                    const f32x4 x0 = *(const f32x4*)(x + off + bj * HALF), x1 = *(const f32x4*)(x + off + bj * HALF + 4);
                    const f32x4 o0 = x0 + acc[ai][bj][m][0], o1 = x1 + acc[ai][bj][m][1];
                    u32x4 w; w.x = cvt_pk_bf16(o0[0], o0[1]); w.y = cvt_pk_bf16(o0[2], o0[3]); w.z = cvt_pk_bf16(o1[0], o1[1]); w.w = cvt_pk_bf16(o1[2], o1[3]);
                    *(u32x4*)(x2b + off + bj * HALF) = w;
                    ss += (o0[0] * o0[0] + o0[1] * o0[1]) + (o0[2] * o0[2] + o0[3] * o0[3]) + (o1[0] * o1[0] + o1[1] * o1[1]) + (o1[2] * o1[2] + o1[3] * o1[3]);
                }
                ss += __shfl_xor(ss, 16); ss += __shfl_xor(ss, 32);
                if (fq == 0) atomicAdd(ssq + row, ss);
            }
    }
};

template <class Epi, class Sched>
__device__ __forceinline__ void gemm_phase(PG8_LAS unsigned char* lds, const Gemm g, const Sched& S, const Epi& E) {
    const int tid = threadIdx.x, wid = __builtin_amdgcn_readfirstlane(tid >> 6), lane = tid & 63, wr = wid >> 2, wc = wid & 3, fr = lane & 15, fq = lane >> 4;
    const int K = g.K, nt = K / BK;
    unsigned voffA[2], voffB[2];
#pragma unroll
    for (int i = 0; i < 2; ++i) { int R, C; stage_rc(tid * 16 + i * 8192, R, C); const int Rb = Epi::PERM ? ((R & ~31) + perm32(R & 31)) : R;
        voffA[i] = (unsigned)(R * g.lda + C) * 2u; voffB[i] = (unsigned)(Rb * g.ldb + C) * 2u; }
    const size_t kstep = (size_t)(BK * 2);
    const size_t hstepA = (size_t)HALF * g.lda * 2, hstepB = (size_t)HALF * g.ldb * 2;
    const size_t tstepA = 2 * hstepA, tstepB = 2 * hstepB;
    const unsigned ldsw = (unsigned)wid * 1024u;
    const int aoff = lds_byte(wr * 64 + fr, fq * 8), boff = lds_byte(wc * 32 + fr, fq * 8);
#define PG8_SA(b, h) (((b) * 2 + (h)) * HTB)
#define PG8_SB(b, h) ((4 + (b) * 2 + (h)) * HTB)
#define PG8_STAGE(bufoff, gbase, voff) do { _Pragma("unroll") for (int _i = 0; _i < 2; ++_i) \
        __builtin_amdgcn_global_load_lds((const unsigned*)((const char*)(gbase) + (voff)[_i]), (PG8_LAS unsigned*)(lds + (bufoff) + ldsw + _i * 8192), 16, 0, 0); } while (0)
#define PG8_LDA(dst, b, h) do { _Pragma("unroll") for (int m = 0; m < 4; ++m) _Pragma("unroll") for (int k = 0; k < 2; ++k) dst[m][k] = *(const PG8_LAS bf16x8*)(lds + PG8_SA(b, h) + aoff + m * 2048 + k * 1024); } while (0)
#define PG8_LDB(dst, b, h) do { _Pragma("unroll") for (int n = 0; n < 2; ++n) _Pragma("unroll") for (int k = 0; k < 2; ++k) dst[n][k] = *(const PG8_LAS bf16x8*)(lds + PG8_SB(b, h) + boff + n * 2048 + k * 1024); } while (0)
#define PG8_MMA(ai, bj, At, Bt) do { __builtin_amdgcn_s_setprio(1); _Pragma("unroll") for (int m = 0; m < 4; ++m) _Pragma("unroll") for (int n = 0; n < 2; ++n) _Pragma("unroll") for (int k = 0; k < 2; ++k) \
        acc[ai][bj][m][n] = __builtin_amdgcn_mfma_f32_16x16x32_bf16(Bt[n][k], At[m][k], acc[ai][bj][m][n], 0, 0, 0); __builtin_amdgcn_s_setprio(0); } while (0)
#define PG8_WAIT_V(n) asm volatile("s_waitcnt vmcnt(" #n ")" ::: "memory")
#define PG8_WAIT_L(n) asm volatile("s_waitcnt lgkmcnt(" #n ")" ::: "memory")
#define PG8_BAR __builtin_amdgcn_s_barrier()
#define PG8_SCHED __builtin_amdgcn_sched_barrier(0)
    Unit cur, nxt; int ui = 0;
    if (!S.next(0, cur)) return;
    f32x4 acc[2][2][4][2];
#pragma unroll
    for (int a = 0; a < 2; ++a)
#pragma unroll
        for (int b = 0; b < 2; ++b)
#pragma unroll
            for (int m = 0; m < 4; ++m)
#pragma unroll
                for (int n = 0; n < 2; ++n) acc[a][b][m][n] = (f32x4){0.f, 0.f, 0.f, 0.f};
    bf16x8 At[4][2], B0[2][2], B1[2][2];
    const char* cA = (const char*)g.A + (size_t)cur.pm * tstepA; const char* cB = (const char*)g.Bt + (size_t)cur.pn * tstepB;
    PG8_STAGE(PG8_SB(0, 0), cB, voffB); PG8_STAGE(PG8_SB(0, 1), cB + hstepB, voffB); PG8_STAGE(PG8_SA(0, 0), cA, voffA); PG8_STAGE(PG8_SA(0, 1), cA + hstepA, voffA);
    if (wr == 1) PG8_BAR;
    PG8_WAIT_V(2); PG8_BAR;
    PG8_STAGE(PG8_SB(1, 0), cB + kstep, voffB); PG8_STAGE(PG8_SA(1, 0), cA + kstep, voffA); PG8_STAGE(PG8_SB(1, 1), cB + hstepB + kstep, voffB);
    PG8_WAIT_V(6); PG8_BAR;
    for (;;) {
        const bool has_next = S.next(ui + 1, nxt);
        const char* nA = has_next ? (const char*)g.A + (size_t)nxt.pm * tstepA : cA; const char* nB = has_next ? (const char*)g.Bt + (size_t)nxt.pn * tstepB : cB;
        for (int t = 0; t < nt; t += 2) {
            const bool last = (t == nt - 2);
            const char* a1 = cA + (size_t)(t + 1) * kstep;
            const char* a2 = last ? nA : cA + (size_t)(t + 2) * kstep; const char* b2 = last ? nB : cB + (size_t)(t + 2) * kstep;
            const char* a3 = a2 + kstep; const char* b3 = b2 + kstep;
            PG8_LDB(B0, 0, 0); PG8_LDB(B1, 0, 1); PG8_SCHED; PG8_LDA(At, 0, 0); PG8_STAGE(PG8_SA(1, 1), a1 + hstepA, voffA);
            PG8_WAIT_V(8); PG8_WAIT_L(0); PG8_BAR; PG8_MMA(0, 0, At, B0); PG8_MMA(0, 1, At, B1); PG8_BAR; PG8_SCHED;
            PG8_LDA(At, 0, 1); PG8_STAGE(PG8_SB(0, 0), b2, voffB); PG8_STAGE(PG8_SB(0, 1), b2 + hstepB, voffB); PG8_STAGE(PG8_SA(0, 0), a2, voffA);
            PG8_WAIT_V(8); PG8_WAIT_L(0); PG8_BAR; PG8_MMA(1, 0, At, B0); PG8_MMA(1, 1, At, B1); PG8_BAR; PG8_SCHED;
            PG8_LDB(B0, 1, 0); PG8_LDB(B1, 1, 1); PG8_SCHED; PG8_LDA(At, 1, 0); PG8_STAGE(PG8_SA(0, 1), a2 + hstepA, voffA);
            PG8_WAIT_V(8); PG8_WAIT_L(0); PG8_BAR; PG8_MMA(0, 0, At, B0); PG8_MMA(0, 1, At, B1); PG8_BAR; PG8_SCHED;
            PG8_LDA(At, 1, 1); PG8_STAGE(PG8_SB(1, 0), b3, voffB); PG8_STAGE(PG8_SB(1, 1), b3 + hstepB, voffB); PG8_STAGE(PG8_SA(1, 0), a3, voffA);
            PG8_WAIT_V(8); PG8_WAIT_L(0); PG8_BAR; PG8_MMA(1, 0, At, B0); PG8_MMA(1, 1, At, B1); PG8_BAR; PG8_SCHED;
        }
        if (wr == 0) PG8_BAR;
        E(acc, cur, wr, wc, fr, fq);
        if (!has_next) break;
#pragma unroll
        for (int a = 0; a < 2; ++a)
#pragma unroll
            for (int b = 0; b < 2; ++b)
#pragma unroll
                for (int m = 0; m < 4; ++m)
#pragma unroll
                    for (int n = 0; n < 2; ++n) acc[a][b][m][n] = (f32x4){0.f, 0.f, 0.f, 0.f};
        cur = nxt; cA = nA; cB = nB; ++ui;
        if (wr == 1) PG8_BAR;
    }
    PG8_WAIT_V(0);
    PG8_BAR;
#undef PG8_SA
#undef PG8_SB
#undef PG8_STAGE
#undef PG8_LDA
#undef PG8_LDB
#undef PG8_MMA
#undef PG8_WAIT_V
#undef PG8_WAIT_L
#undef PG8_BAR
#undef PG8_SCHED
}
}

constexpr int NWAVES = 8;
constexpr int LDS_RING_BYTES = 131072, LDSCTL_OFF = 143360, MISC_OFF = LDSCTL_OFF + 320, LDS_BYTES = 147456;
#define LAS __attribute__((address_space(3)))
#define GAS __attribute__((address_space(1)))
typedef float f32x4 __attribute__((ext_vector_type(4)));
typedef unsigned v4u __attribute__((ext_vector_type(4)));
typedef unsigned v2u __attribute__((ext_vector_type(2)));
#define LDS_WAIT() asm volatile("s_waitcnt lgkmcnt(0)" ::: "memory")

constexpr int CW_BAR = 4096;
#define XB_TMO      128
#define XB_XCNT(j)  (256  + 64 * (j))
#define XB_XSUB(j)  (1280 + 64 * (j))
#define XB_XGEN(j)  (2304 + 64 * (j))
#define XB_TOP      3328
#define XB_TOPGEN   3392
#define XCD_BAR_WORDS 3456
#define XB_SPIN_CAP (1u << 20)
__device__ __forceinline__ unsigned xb_ld(unsigned* p)              { return __hip_atomic_load(p, __ATOMIC_RELAXED, __HIP_MEMORY_SCOPE_AGENT); }
__device__ __forceinline__ unsigned xb_add(unsigned* p, unsigned v) { return __hip_atomic_fetch_add(p, v, __ATOMIC_RELAXED, __HIP_MEMORY_SCOPE_AGENT); }
__device__ __forceinline__ unsigned xb_xcc_id() { return (unsigned)__builtin_amdgcn_s_getreg((3 << 11) | 20) & 0xFu; }
#define XB_SPIN(cond, bar) do { unsigned _sp = 0; while (cond) { __builtin_amdgcn_s_sleep(1); \
    if ((++_sp & 255u) == 0u) { if (xb_ld(&(bar)[XB_TMO])) break; if (_sp > XB_SPIN_CAP) { atomicAdd(&(bar)[XB_TMO], 1u); break; } } } } while (0)
struct XcdBarrier { unsigned* bar; unsigned x; volatile LAS unsigned* st; };
__device__ __forceinline__ XcdBarrier xcd_barrier_post(unsigned* bar, volatile LAS unsigned* st) {
    XcdBarrier b; b.bar = bar; b.x = xb_xcc_id(); b.st = st;
    if (threadIdx.x == 0) (void)xb_add(&bar[XB_XCNT(b.x)], 1u);
    return b;
}
__device__ __forceinline__ void xcd_barrier_complete(unsigned* bar, unsigned x, unsigned& nloc, unsigned& nx) {
    const unsigned G = gridDim.x * gridDim.y * gridDim.z;
    unsigned sum, cnt, mine, sp = 0u;
    for (;;) {
        sum = 0u; cnt = 0u; mine = 0u;
#pragma unroll
        for (unsigned j = 0; j < 16; ++j) { const unsigned c = xb_ld(&bar[XB_XCNT(j)]); sum += c; cnt += (c > 0u) ? 1u : 0u; mine = (j == x) ? c : mine; }
        if (sum == G) break;
        __builtin_amdgcn_s_sleep(1);
        if ((++sp & 255u) == 0u) { if (xb_ld(&bar[XB_TMO])) break; if (sp > XB_SPIN_CAP) { atomicAdd(&bar[XB_TMO], 1u); break; } }
    }
    nloc = mine > 0u ? mine : 1u; nx = cnt > 0u ? cnt : 1u;
}
__device__ __forceinline__ void xcd_barrier(const XcdBarrier& b) {
    asm volatile("s_waitcnt vmcnt(0)" ::: "memory");
    __syncthreads();
    if (threadIdx.x == 0) {
        unsigned* bar = b.bar;
        __builtin_amdgcn_s_waitcnt(0);
        unsigned nloc = b.st[0], nx = b.st[1];
        if (nloc == 0u) { xcd_barrier_complete(bar, b.x, nloc, nx); b.st[0] = nloc; b.st[1] = nx; }
        const unsigned old = xb_add(&bar[XB_XSUB(b.x)], 1u);
        const unsigned gen = old / nloc;
        if (old + 1u == (gen + 1u) * nloc) {
            __builtin_amdgcn_fence(__ATOMIC_RELEASE, "agent");
            asm volatile("s_waitcnt vmcnt(0)" ::: "memory");
            const unsigned og = xb_add(&bar[XB_TOP], 1u);
            const unsigned tg = og / nx;
            if (og + 1u == (tg + 1u) * nx) xb_add(&bar[XB_TOPGEN], 1u);
            else XB_SPIN(xb_ld(&bar[XB_TOPGEN]) == tg, bar);
            __builtin_amdgcn_fence(__ATOMIC_ACQUIRE, "agent");
            xb_add(&bar[XB_XGEN(b.x)], 1u);
            asm volatile("s_waitcnt vmcnt(0)" ::: "memory");
        } else {
            XB_SPIN(xb_ld(&bar[XB_XGEN(b.x)]) == gen, bar);
            __builtin_amdgcn_fence(__ATOMIC_ACQUIRE, "agent");
            asm volatile("s_waitcnt vmcnt(0)" ::: "memory");
        }
    }
    __syncthreads();
}

struct Args { const float* in[28]; float* out; unsigned char* ws; int ph_lo, ph_hi, li, pad; };

__device__ __forceinline__ void p0_transpose_item(const float* W, const float* sc, int K, int N, bf16_t* WT, LAS float* scr, int item, int lane) {
    const int nblk = N / 32, kb = item / nblk, nb = item % nblk, k0 = 64 * kb, n0 = 32 * nb;
#pragma unroll 8
    for (int i = 0; i < 32; ++i) { const int kk = 2 * i + (lane >> 5); const float s = sc ? sc[k0 + kk] : 1.f; scr[kk * 33 + (lane & 31)] = W[(size_t)(k0 + kk) * N + n0 + (lane & 31)] * s; }
    LDS_WAIT(); asm volatile("" ::: "memory");
    const int c = lane & 7;
#pragma unroll
    for (int j = 0; j < 4; ++j) { const int n = (lane >> 3) + 8 * j; const LAS float* s = scr + (8 * c) * 33 + n;
        v4u o; o.x = pg8::cvt_pk_bf16(s[0 * 33], s[1 * 33]); o.y = pg8::cvt_pk_bf16(s[2 * 33], s[3 * 33]); o.z = pg8::cvt_pk_bf16(s[4 * 33], s[5 * 33]); o.w = pg8::cvt_pk_bf16(s[6 * 33], s[7 * 33]);
        *(v4u*)(WT + (size_t)(n0 + n) * K + k0 + 8 * c) = o; }
    LDS_WAIT(); asm volatile("" ::: "memory");
}
typedef unsigned v6u_t __attribute__((ext_vector_type(6)));
typedef unsigned v3u_t __attribute__((ext_vector_type(3)));
typedef float v16f_t __attribute__((ext_vector_type(16)));
typedef float v32f_t __attribute__((ext_vector_type(32)));
__device__ __forceinline__ void p0_row_fp6(const float* in, const float* cs, unsigned char* out, float* sc, int lane) {
    f32x4 v[4]; float mx = 0.f;
#pragma unroll
    for (int i = 0; i < 4; ++i) { v[i] = *(const f32x4*)(in + lane * 16 + 4 * i); if (cs) v[i] = v[i] * *(const f32x4*)(cs + lane * 16 + 4 * i);
        mx = fmaxf(mx, fmaxf(fmaxf(fabsf(v[i][0]), fabsf(v[i][1])), fmaxf(fabsf(v[i][2]), fabsf(v[i][3])))); }
#pragma unroll
    for (int o = 1; o < 64; o <<= 1) mx = fmaxf(mx, __shfl_xor(mx, o));
    mx = fmaxf(mx, 1e-30f);
    const float q = 7.5f / mx;
    v16f_t a, b;
#pragma unroll
    for (int i = 0; i < 16; ++i) { a[i] = 0.f; b[i] = 0.f; }
#pragma unroll
    for (int i = 0; i < 8; ++i) { a[i] = v[(2 * i) >> 2][(2 * i) & 3] * q; b[i] = v[(2 * i + 1) >> 2][(2 * i + 1) & 3] * q; }
    const v6u_t p = __builtin_amdgcn_cvt_scalef32_2xpk16_fp6_f32(a, b, 1.0f);
    *(v3u_t*)(out + lane * 12) = (v3u_t){p[0], p[1], p[2]};
    if (lane == 0) *sc = mx * (1.f / 7.5f);
}
__device__ __forceinline__ void p0_convert(const float* in, const float* cs, bf16_t* out, size_t n, int gw, int NGW, int lane) {
    for (size_t i = ((size_t)gw * 64 + lane) * 8; i < n; i += (size_t)NGW * 512) {
        f32x4 a = *(const f32x4*)(in + i), b = *(const f32x4*)(in + i + 4);
        if (cs) { const int c = (int)(i & 1023); a = a * *(const f32x4*)(cs + c); b = b * *(const f32x4*)(cs + c + 4); }
        v4u o; o.x = pg8::cvt_pk_bf16(a[0], a[1]); o.y = pg8::cvt_pk_bf16(a[2], a[3]); o.z = pg8::cvt_pk_bf16(b[0], b[1]); o.w = pg8::cvt_pk_bf16(b[2], b[3]);
        *(v4u*)(out + i) = o;
    }
}

namespace da {
typedef short bf16x8 __attribute__((ext_vector_type(8)));
typedef short s16x4 __attribute__((ext_vector_type(4)));
typedef float f32x16 __attribute__((ext_vector_type(16)));
constexpr float LOG2E = 1.4426950408889634f;
constexpr int SLOT = 32768, SCR_OFF = 65536, COMB_OFF = 69632;
__device__ __forceinline__ int crow(int r, int hi) { return (r & 3) + 8 * (r >> 2) + 4 * hi; }
__device__ __forceinline__ s16x4 vtr(const LAS unsigned char* p) { return __builtin_bit_cast(s16x4, __builtin_amdgcn_ds_read_tr16_b64_v4i16((LAS s16x4*)p)); }

__device__ __forceinline__ void attn_unit(LAS unsigned char* lds, const bf16_t* __restrict__ z, bf16_t* __restrict__ yb, const float* __restrict__ subln_w, float lam,
                                          int b, int h, int qblk, int wave, int lane) {
    const int r32 = lane & 31, hi = lane >> 5, map = wave >> 2, qs = wave & 3;
    const int q0 = qblk * 128 + qs * 32;
    const size_t rowb = (size_t)b * SEQ;
    const float slope2 = exp2f(-2.f * (float)(h + 1)) * LOG2E;
    bf16x8 qr[4];
    {
        const bf16_t* qp = z + (rowb + q0 + r32) * NZ + C_Q + h * 128 + map * 64 + hi * 8;
        constexpr float c2 = 0.125f * LOG2E;
#pragma unroll
        for (int d0 = 0; d0 < 4; ++d0) {
            const v4u w = *(const v4u*)(qp + d0 * 16);
            v4u o; o.x = pg8::cvt_pk_bf16(pg8::bflo(w.x) * c2, pg8::bfhi(w.x) * c2); o.y = pg8::cvt_pk_bf16(pg8::bflo(w.y) * c2, pg8::bfhi(w.y) * c2);
            o.z = pg8::cvt_pk_bf16(pg8::bflo(w.z) * c2, pg8::bfhi(w.z) * c2); o.w = pg8::cvt_pk_bf16(pg8::bflo(w.w) * c2, pg8::bfhi(w.w) * c2);
            qr[d0] = __builtin_bit_cast(bf16x8, o);
        }
    }
    const int qpos = q0 + r32;
    const float qterm = slope2 * (float)(4 * hi - qpos);
    LAS float* wsf = (LAS float*)(lds + SCR_OFF) + wave * 64;
    f32x16 o[4];
#pragma unroll
    for (int d = 0; d < 4; ++d) o[d] = (f32x16){};
    float m = -1e30f, lsum = 0.f;
    const int NT = 2 * qblk + 2;
    const bf16_t* ksrc0 = z + (rowb + lane) * NZ + C_ZK + h * 128 + wave * 8;
    const int pc0 = 2 * wave, pc1 = 2 * wave + 1;
    const bf16_t* vsrc0 = z + (rowb + 16 * (pc0 & 3) + (lane >> 2)) * NZ + C_ZV + h * 128 + 32 * (pc0 >> 2) + (lane & 3) * 8;
    const bf16_t* vsrc1 = z + (rowb + 16 * (pc1 & 3) + (lane >> 2)) * NZ + C_ZV + h * 128 + 32 * (pc1 >> 2) + (lane & 3) * 8;
#define DA_STAGE(j, slot) do { const size_t _o = (size_t)(j) * 64 * NZ; LAS unsigned char* _s = lds + (slot) * SLOT; \
        __builtin_amdgcn_global_load_lds((const unsigned*)(ksrc0 + _o), (LAS unsigned*)(_s + wave * 1024), 16, 0, 0); \
        __builtin_amdgcn_global_load_lds((const unsigned*)(ksrc0 + _o + 64), (LAS unsigned*)(_s + 8192 + wave * 1024), 16, 0, 0); \
        __builtin_amdgcn_global_load_lds((const unsigned*)(vsrc0 + _o), (LAS unsigned*)(_s + 16384 + pc0 * 1024), 16, 0, 0); \
        __builtin_amdgcn_global_load_lds((const unsigned*)(vsrc1 + _o), (LAS unsigned*)(_s + 16384 + pc1 * 1024), 16, 0, 0); } while (0)
    DA_STAGE(0, 0);
    for (int j = 0; j < NT; ++j) {
        asm volatile("s_waitcnt vmcnt(0)" ::: "memory");
        __syncthreads();
        if (j + 1 < NT) DA_STAGE(j + 1, (j + 1) & 1);
        if (64 * j > q0 + 31) continue;
        const LAS unsigned char* slot = lds + (j & 1) * SLOT;
        f32x16 c0, c1;
        {
            const float tb = slope2 * (float)(64 * j) + qterm;
#pragma unroll
            for (int r = 0; r < 16; ++r) { c0[r] = tb + slope2 * (float)((r & 3) + 8 * (r >> 2)); c1[r] = c0[r] + 32.f * slope2; }
        }
        const LAS unsigned char* kb = slot + map * 8192 + hi * 1024 + r32 * 16;
#pragma unroll
        for (int d0 = 0; d0 < 4; ++d0) {
            const bf16x8 k0 = *(const LAS bf16x8*)(kb + d0 * 2048), k1 = *(const LAS bf16x8*)(kb + d0 * 2048 + 512);
            c0 = __builtin_amdgcn_mfma_f32_32x32x16_bf16(k0, qr[d0], c0, 0, 0, 0);
            c1 = __builtin_amdgcn_mfma_f32_32x32x16_bf16(k1, qr[d0], c1, 0, 0, 0);
        }
        if (64 * j + 63 > q0) {
            const int kb0 = 64 * j + 4 * hi;
#pragma unroll
            for (int r = 0; r < 16; ++r) { const int kv = kb0 + (r & 3) + 8 * (r >> 2); if (kv > qpos) c0[r] = -INFINITY; if (kv + 32 > qpos) c1[r] = -INFINITY; }
        }
        float mt = fmaxf(c0[0], c1[0]);
#pragma unroll
        for (int r = 1; r < 16; ++r) mt = fmaxf(mt, fmaxf(c0[r], c1[r]));
        mt = fmaxf(mt, __shfl_xor(mt, 32));
        float mnew = m;
        if (__any(mt > m + 8.f)) {
            mnew = fmaxf(m, mt);
            const float alpha = __builtin_amdgcn_exp2f(m - mnew);
            lsum *= alpha;
            if (hi == 0) wsf[r32] = alpha;
            float a[16];
#pragma unroll
            for (int g = 0; g < 4; ++g) { const f32x4 t = *(const LAS f32x4*)(wsf + 8 * g + 4 * hi); a[4 * g] = t[0]; a[4 * g + 1] = t[1]; a[4 * g + 2] = t[2]; a[4 * g + 3] = t[3]; }
#pragma unroll
            for (int d = 0; d < 4; ++d)
#pragma unroll
                for (int r = 0; r < 16; ++r) o[d][r] *= a[r];
        }
        m = mnew;
        float ps = 0.f;
#pragma unroll
        for (int r = 0; r < 16; ++r) { c0[r] = __builtin_amdgcn_exp2f(c0[r] - m); c1[r] = __builtin_amdgcn_exp2f(c1[r] - m); ps += c0[r] + c1[r]; }
        lsum += ps;
        v4u pw[4];
#pragma unroll
        for (int g = 0; g < 2; ++g) {
            pw[g].x = pg8::cvt_pk_bf16(c0[8 * g], c0[8 * g + 1]); pw[g].y = pg8::cvt_pk_bf16(c0[8 * g + 2], c0[8 * g + 3]); pw[g].z = pg8::cvt_pk_bf16(c0[8 * g + 4], c0[8 * g + 5]); pw[g].w = pg8::cvt_pk_bf16(c0[8 * g + 6], c0[8 * g + 7]);
            pw[2 + g].x = pg8::cvt_pk_bf16(c1[8 * g], c1[8 * g + 1]); pw[2 + g].y = pg8::cvt_pk_bf16(c1[8 * g + 2], c1[8 * g + 3]); pw[2 + g].z = pg8::cvt_pk_bf16(c1[8 * g + 4], c1[8 * g + 5]); pw[2 + g].w = pg8::cvt_pk_bf16(c1[8 * g + 6], c1[8 * g + 7]);
        }
        const LAS unsigned char* vb = slot + 16384 + ((lane >> 4) & 1) * 32 + (lane & 3) * 8 + (4 * hi + ((lane & 15) >> 2)) * 64;
#pragma unroll
        for (int d = 0; d < 4; ++d)
#pragma unroll
            for (int kg = 0; kg < 4; ++kg) {
                const s16x4 lo = vtr(vb + (d * 4 + kg) * 1024), hh = vtr(vb + (d * 4 + kg) * 1024 + 512);
                const bf16x8 vf = (bf16x8){lo[0], lo[1], lo[2], lo[3], hh[0], hh[1], hh[2], hh[3]};
                o[d] = __builtin_amdgcn_mfma_f32_32x32x16_bf16(__builtin_bit_cast(bf16x8, pw[kg]), vf, o[d], 0, 0, 0);
            }
    }
#undef DA_STAGE
    lsum += __shfl_xor(lsum, 32);
    if (hi == 0) wsf[r32] = 1.f / lsum;
    float il[16];
#pragma unroll
    for (int g = 0; g < 4; ++g) { const f32x4 t = *(const LAS f32x4*)(wsf + 8 * g + 4 * hi); il[4 * g] = t[0]; il[4 * g + 1] = t[1]; il[4 * g + 2] = t[2]; il[4 * g + 3] = t[3]; }
    LAS float* comb = (LAS float*)(lds + COMB_OFF) + qs * 4096;
    if (map == 1) {
#pragma unroll
        for (int d = 0; d < 4; ++d)
#pragma unroll
            for (int r = 0; r < 16; ++r) comb[crow(r, hi) * 128 + 32 * d + r32] = o[d][r] * il[r];
    }
    __syncthreads();
    if (map == 0) {
        float sw[4];
#pragma unroll
        for (int d = 0; d < 4; ++d) sw[d] = subln_w[32 * d + r32] * (1.f - LAM_INIT);
#pragma unroll
        for (int r = 0; r < 16; ++r) {
            float v[4], ss = 0.f;
#pragma unroll
            for (int d = 0; d < 4; ++d) { v[d] = o[d][r] * il[r] - lam * comb[crow(r, hi) * 128 + 32 * d + r32]; ss += v[d] * v[d]; }
            ss += __shfl_xor(ss, 1); ss += __shfl_xor(ss, 2); ss += __shfl_xor(ss, 4); ss += __shfl_xor(ss, 8); ss += __shfl_xor(ss, 16);
            const float rs = rsqrtf(ss * (1.f / 128.f) + SUBLN_EPS);
            bf16_t* op = yb + (rowb + q0 + crow(r, hi)) * 512 + h * 128 + r32;
#pragma unroll
            for (int d = 0; d < 4; ++d) op[32 * d] = f2bf(v[d] * rs * sw[d]);
        }
    }
    __syncthreads();
}
}

namespace rw {
typedef short bf16x8 __attribute__((ext_vector_type(8)));
typedef float f32x2 __attribute__((ext_vector_type(2)));
constexpr int CH = 32, ACT_PITCH = 528;
constexpr int OFF_ACT = 0, OFF_RKV = 16896, OFF_VEC = 41472, OFF_G = 82432, OFF_Y = 90624, OFF_NRM = 98816, OFF_SCL = 99328, OFF_CT = 99840;
template <int CTRL> __device__ __forceinline__ float dppf(float x) { return __builtin_bit_cast(float, __builtin_amdgcn_mov_dpp(__builtin_bit_cast(int, x), CTRL, 0xf, 0xf, true)); }
__device__ __forceinline__ float row_allsum(float v) { v += dppf<0x128>(v); v += dppf<0x124>(v); v += dppf<0x122>(v); v += dppf<0x121>(v); return v; }
__device__ __forceinline__ void row_allsum4(float& a, float& b, float& c, float& d) {
#define RW_DPP4(n) "v_add_f32_dpp %0, %0, %0 row_ror:" #n " row_mask:0xf bank_mask:0xf\n\tv_add_f32_dpp %1, %1, %1 row_ror:" #n " row_mask:0xf bank_mask:0xf\n\t" \
                   "v_add_f32_dpp %2, %2, %2 row_ror:" #n " row_mask:0xf bank_mask:0xf\n\tv_add_f32_dpp %3, %3, %3 row_ror:" #n " row_mask:0xf bank_mask:0xf\n\t"
    asm volatile("s_nop 1\n\t" RW_DPP4(8) RW_DPP4(4) RW_DPP4(2) RW_DPP4(1) "s_nop 1" : "+v"(a), "+v"(b), "+v"(c), "+v"(d));
#undef RW_DPP4
}
__device__ __forceinline__ f32x4 ld4bf(const bf16_t* p) { const v2u w = *(const v2u*)p; return (f32x4){pg8::bflo(w.x), pg8::bfhi(w.x), pg8::bflo(w.y), pg8::bfhi(w.y)}; }
__device__ __forceinline__ float fsig(float x) { return __builtin_amdgcn_rcpf(1.f + __expf(-x)); }
__device__ __forceinline__ float ftanh(float x) { return 1.f - 2.f * __builtin_amdgcn_rcpf(1.f + __expf(2.f * x)); }
struct ZRow { v2u r, k, v, w, a; v4u g; };
__device__ __forceinline__ ZRow ldrow(const bf16_t* zr, int c4, int cg) {
    ZRow o; o.r = *(const v2u*)(zr + C_R + c4); o.k = *(const v2u*)(zr + C_K + c4); o.v = *(const v2u*)(zr + C_V + c4); o.w = *(const v2u*)(zr + C_WL + 4 * cg); o.a = *(const v2u*)(zr + C_AL + 4 * cg);
    o.g = *(const v4u*)(zr + C_GL + 8 * cg); return o;
}
__device__ __forceinline__ f32x4 up4(v2u w) { return (f32x4){pg8::bflo(w.x), pg8::bfhi(w.x), pg8::bflo(w.y), pg8::bfhi(w.y)}; }

struct ScanP { const float *mu, *w0, *w2, *a0, *a2, *g2, *k_k, *k_a, *r_k, *lnx_w, *lnx_b; };
__device__ __forceinline__ void scan_unit(LAS unsigned char* lds, const bf16_t* __restrict__ z, bf16_t* __restrict__ ya, const ScanP P, int b, int h, int tid, int wave, int lane) {
    const float* mu = P.mu; const float* w0 = P.w0; const float* w2 = P.w2; const float* a0 = P.a0; const float* a2 = P.a2; const float* g2 = P.g2;
    const float* k_k = P.k_k; const float* k_a = P.k_a; const float* r_k = P.r_k; const float* lnx_w = P.lnx_w; const float* lnx_b = P.lnx_b;
    const size_t rowb = (size_t)b * SEQ;
    const int tl = tid >> 4, cg = tid & 15;
    const int nt = wave & 3, rl = lane & 15, rg = lane >> 4;
    LAS float* rkv = (LAS float*)(lds + OFF_RKV); LAS float* vec = (LAS float*)(lds + OFF_VEC); LAS float* gbuf = (LAS float*)(lds + OFF_G);
    LAS float* ybuf = (LAS float*)(lds + OFF_Y); LAS float* nrm = (LAS float*)(lds + OFF_NRM); LAS float* scl = (LAS float*)(lds + OFF_SCL);
    bf16x8 bfr[8];
    {
        const int col = h * 64 + 16 * nt + rl;
#pragma unroll
        for (int f = 0; f < 8; ++f) {
            const float* src = (f < 2) ? w2 : (f < 4) ? a2 : g2;
            const int kb = ((f < 4) ? 32 * (f & 1) : 32 * (f - 4)) + 8 * rg;
            float e[8];
#pragma unroll
            for (int j = 0; j < 8; ++j) e[j] = src[(size_t)(kb + j) * 512 + col];
            v4u p; p.x = pg8::cvt_pk_bf16(e[0], e[1]); p.y = pg8::cvt_pk_bf16(e[2], e[3]); p.z = pg8::cvt_pk_bf16(e[4], e[5]); p.w = pg8::cvt_pk_bf16(e[6], e[7]);
            bfr[f] = __builtin_bit_cast(bf16x8, p);
        }
    }
    const int mt = wave >> 2;
    const int hc = h * 64 + 16 * nt + rl;
    const float w0c = w0[hc], a0c = a0[hc], kkc = k_k[hc], kac = k_a[hc], rkc = r_k[hc];
    const int c4 = h * 64 + 4 * cg;
    f32x2 St[4];
#pragma unroll
    for (int i = 0; i < 4; ++i) St[i] = (f32x2){0.f, 0.f};
    const int ra = 8 * wave + 2 * rg;
    LAS float* ctab = (LAS float*)(lds + OFF_CT);
    if (tl == 0) {
        LAS float* ct = ctab + cg * 36;
        *(LAS f32x4*)(ct + 0) = *(const f32x4*)(mu + C_R + c4); *(LAS f32x4*)(ct + 4) = *(const f32x4*)(mu + C_K + c4); *(LAS f32x4*)(ct + 8) = *(const f32x4*)(mu + C_V + c4);
        *(LAS f32x4*)(ct + 12) = *(const f32x4*)(mu + C_WL + 4 * cg); *(LAS f32x4*)(ct + 16) = *(const f32x4*)(mu + C_AL + 4 * cg);
        *(LAS f32x4*)(ct + 20) = *(const f32x4*)(mu + C_GL + 8 * cg); *(LAS f32x4*)(ct + 24) = *(const f32x4*)(mu + C_GL + 8 * cg + 4);
        *(LAS f32x4*)(ct + 28) = *(const f32x4*)(lnx_w + c4); *(LAS f32x4*)(ct + 32) = *(const f32x4*)(lnx_b + c4);
    }
    __syncthreads();
    const LAS float* myct = ctab + cg * 36;
    ZRow zc = ldrow(z + (rowb + tl) * NZ, c4, cg), zp;
    if (tl > 0) zp = ldrow(z + (rowb + tl - 1) * NZ, c4, cg); else { zp.r = zp.k = zp.v = zp.w = zp.a = (v2u){0u, 0u}; zp.g = (v4u){0u, 0u, 0u, 0u}; }
    for (int t0 = 0; t0 < SEQ; t0 += CH) {
        {
            const f32x4 cr = up4(zc.r), ck = up4(zc.k), cv = up4(zc.v), cw = up4(zc.w), ca = up4(zc.a);
            const f32x4 cg0 = (f32x4){pg8::bflo(zc.g.x), pg8::bfhi(zc.g.x), pg8::bflo(zc.g.y), pg8::bfhi(zc.g.y)}, cg1 = (f32x4){pg8::bflo(zc.g.z), pg8::bfhi(zc.g.z), pg8::bflo(zc.g.w), pg8::bfhi(zc.g.w)};
            const f32x4 pr = up4(zp.r), pk = up4(zp.k), pv = up4(zp.v), pw = up4(zp.w), pa = up4(zp.a);
            const f32x4 pg0 = (f32x4){pg8::bflo(zp.g.x), pg8::bfhi(zp.g.x), pg8::bflo(zp.g.y), pg8::bfhi(zp.g.y)}, pg1 = (f32x4){pg8::bflo(zp.g.z), pg8::bfhi(zp.g.z), pg8::bflo(zp.g.w), pg8::bfhi(zp.g.w)};
            if (t0 + CH < SEQ) { zc = ldrow(z + (rowb + t0 + CH + tl) * NZ, c4, cg); zp = ldrow(z + (rowb + t0 + CH + tl - 1) * NZ, c4, cg); }
            const f32x4 rs_ = cr + (pr - cr) * *(const LAS f32x4*)(myct + 0), ks_ = ck + (pk - ck) * *(const LAS f32x4*)(myct + 4), vs_ = cv + (pv - cv) * *(const LAS f32x4*)(myct + 8);
            const f32x4 ws_ = cw + (pw - cw) * *(const LAS f32x4*)(myct + 12), as_ = ca + (pa - ca) * *(const LAS f32x4*)(myct + 16);
            const f32x4 g0_ = cg0 + (pg0 - cg0) * *(const LAS f32x4*)(myct + 20), g1_ = cg1 + (pg1 - cg1) * *(const LAS f32x4*)(myct + 24);
            *(LAS f32x4*)(rkv + 0 * 2048 + tl * 64 + 4 * cg) = rs_; *(LAS f32x4*)(rkv + 1 * 2048 + tl * 64 + 4 * cg) = ks_; *(LAS f32x4*)(rkv + 2 * 2048 + tl * 64 + 4 * cg) = vs_;
            LAS unsigned char* ar = lds + OFF_ACT + tl * ACT_PITCH;
            v2u tw; tw.x = pg8::cvt_pk_bf16(ftanh(ws_[0]), ftanh(ws_[1])); tw.y = pg8::cvt_pk_bf16(ftanh(ws_[2]), ftanh(ws_[3]));
            *(LAS v2u*)(ar + 8 * cg) = tw;
            v2u aw; aw.x = pg8::cvt_pk_bf16(as_[0], as_[1]); aw.y = pg8::cvt_pk_bf16(as_[2], as_[3]);
            *(LAS v2u*)(ar + 128 + 8 * cg) = aw;
            v4u gw; gw.x = pg8::cvt_pk_bf16(fsig(g0_[0]), fsig(g0_[1])); gw.y = pg8::cvt_pk_bf16(fsig(g0_[2]), fsig(g0_[3]));
            gw.z = pg8::cvt_pk_bf16(fsig(g1_[0]), fsig(g1_[1])); gw.w = pg8::cvt_pk_bf16(fsig(g1_[2]), fsig(g1_[3]));
            *(LAS v4u*)(ar + 256 + 16 * cg) = gw;
            if (cg == 0) *(LAS f32x4*)(scl + 4 * tl) = (f32x4){0.f, 0.f, 0.f, 0.f};
        }
        __syncthreads();
        f32x4 accw = (f32x4){0.f, 0.f, 0.f, 0.f}, acca = accw, accg = accw;
        {
            const LAS unsigned char* ap = lds + OFF_ACT + (16 * mt + rl) * ACT_PITCH + 8 * rg * 2;
#pragma unroll
            for (int f = 0; f < 8; ++f) {
                const bf16x8 a = *(const LAS bf16x8*)(ap + f * 64);
                if (f < 2) accw = __builtin_amdgcn_mfma_f32_16x16x32_bf16(a, bfr[f], accw, 0, 0, 0);
                else if (f < 4) acca = __builtin_amdgcn_mfma_f32_16x16x32_bf16(a, bfr[f], acca, 0, 0, 0);
                else accg = __builtin_amdgcn_mfma_f32_16x16x32_bf16(a, bfr[f], accg, 0, 0, 0);
            }
        }
        float dec[4], av[4], kk[4];
        {
            const int c = 16 * nt + rl;
            float n2[4];
#pragma unroll
            for (int r = 0; r < 4; ++r) {
                const int tok = 16 * mt + 4 * rg + r;
                gbuf[tok * 64 + c] = accg[r];
                const float nx = -(w0c + accw[r]);
                const float sp = nx > 20.f ? nx : __logf(1.f + __expf(nx));
                dec[r] = __expf(-__expf(-sp - 0.5f));
                av[r] = fsig(a0c + acca[r]);
                kk[r] = rkv[1 * 2048 + tok * 64 + c] * kkc;
                n2[r] = kk[r] * kk[r];
            }
            row_allsum4(n2[0], n2[1], n2[2], n2[3]);
            if (rl == 0) {
#pragma unroll
                for (int r = 0; r < 4; ++r) nrm[(16 * mt + 4 * rg + r) * 4 + nt] = n2[r];
            }
        }
        __syncthreads();
        {
            const int c = 16 * nt + rl;
#pragma unroll
            for (int r = 0; r < 4; ++r) {
                const int tok = 16 * mt + 4 * rg + r;
                const f32x4 n4 = *(const LAS f32x4*)(nrm + tok * 4);
                const float ksv = rkv[1 * 2048 + tok * 64 + c], rsv = rkv[0 * 2048 + tok * 64 + c];
                const float inv = __builtin_amdgcn_rcpf(fmaxf(sqrtf((n4[0] + n4[1]) + (n4[2] + n4[3])), 1e-12f));
                const float kkn = kk[r] * inv, beta = kkn * av[r], kmod = ksv * (1.f + (av[r] - 1.f) * kac);
                LAS float* vp = vec + tok * 320 + c;
                vp[0] = dec[r]; vp[64] = beta; vp[128] = -kkn; vp[192] = kmod; vp[256] = dec[r] * rsv;
                float pbr = beta * rsv, pkr = kmod * rsv, pbo = rsv * kmod * rkc, dum = 0.f;
                row_allsum4(pbr, pkr, pbo, dum);
                if (rl == 0) { __hip_atomic_fetch_add(scl + tok * 4 + 0, pbr, __ATOMIC_RELAXED, __HIP_MEMORY_SCOPE_WORKGROUP); __hip_atomic_fetch_add(scl + tok * 4 + 1, pkr, __ATOMIC_RELAXED, __HIP_MEMORY_SCOPE_WORKGROUP); __hip_atomic_fetch_add(scl + tok * 4 + 2, pbo, __ATOMIC_RELAXED, __HIP_MEMORY_SCOPE_WORKGROUP); }
            }
        }
        __syncthreads();
        {
            const LAS float* vb0 = vec + 4 * rl; const LAS float* rv0 = rkv + 2 * 2048 + ra;
#define RW_DECL(P) f32x4 d4##P, b4##P, n4##P, k4##P, q4##P; f32x2 v2##P, s2##P
#define RW_LOAD(P, tk_) do { d4##P = *(const LAS f32x4*)(vb0 + (tk_) * 320); b4##P = *(const LAS f32x4*)(vb0 + (tk_) * 320 + 64); n4##P = *(const LAS f32x4*)(vb0 + (tk_) * 320 + 128); \
                k4##P = *(const LAS f32x4*)(vb0 + (tk_) * 320 + 192); q4##P = *(const LAS f32x4*)(vb0 + (tk_) * 320 + 256); \
                v2##P = *(const LAS f32x2*)(rv0 + (tk_) * 64); s2##P = *(const LAS f32x2*)(scl + (tk_) * 4); } while (0)
#define RW_STEP(P, tk_) do { \
                f32x2 sa = St[0] * n4##P[0] + St[1] * n4##P[1] + St[2] * n4##P[2] + St[3] * n4##P[3]; \
                f32x2 yy = St[0] * q4##P[0] + St[1] * q4##P[1] + St[2] * q4##P[2] + St[3] * q4##P[3]; \
                float sa0 = sa[0], sa1 = sa[1], yy0 = yy[0], yy1 = yy[1]; \
                row_allsum4(sa0, sa1, yy0, yy1); \
                sa = (f32x2){sa0, sa1}; \
                _Pragma("unroll") for (int i = 0; i < 4; ++i) St[i] = St[i] * d4##P[i] + sa * b4##P[i] + v2##P * k4##P[i]; \
                const f32x2 yo = (f32x2){yy0, yy1} + sa * s2##P[0] + v2##P * s2##P[1]; \
                if (rl == 0) *(LAS f32x2*)(ybuf + (tk_) * 64 + ra) = yo; } while (0)
            RW_DECL(A); RW_DECL(B);
            RW_LOAD(A, 0);
            for (int tk = 0; tk < CH; tk += 2) {
                RW_LOAD(B, tk + 1);
                RW_STEP(A, tk);
                if (tk + 2 < CH) RW_LOAD(A, tk + 2);
                RW_STEP(B, tk + 1);
            }
#undef RW_DECL
#undef RW_LOAD
#undef RW_STEP
        }
        __syncthreads();
        {
            const f32x4 y4 = *(const LAS f32x4*)(ybuf + tl * 64 + 4 * cg);
            const float mean = row_allsum((y4[0] + y4[1]) + (y4[2] + y4[3])) * (1.f / 64.f);
            const f32x4 dv = y4 - mean;
            const float var = row_allsum((dv[0] * dv[0] + dv[1] * dv[1]) + (dv[2] * dv[2] + dv[3] * dv[3])) * (1.f / 64.f);
            const float rs_ = rsqrtf(var + GN_EPS);
            const f32x4 yn = dv * rs_ * *(const LAS f32x4*)(myct + 28) + *(const LAS f32x4*)(myct + 32);
            const float bonus = scl[tl * 4 + 2];
            const f32x4 vs_ = *(const LAS f32x4*)(rkv + 2 * 2048 + tl * 64 + 4 * cg), g4 = *(const LAS f32x4*)(gbuf + tl * 64 + 4 * cg);
            const f32x4 o = (yn + vs_ * bonus) * g4;
            v2u w; w.x = pg8::cvt_pk_bf16(o[0], o[1]); w.y = pg8::cvt_pk_bf16(o[2], o[3]);
            *(v2u*)(ya + (rowb + t0 + tl) * 512 + c4) = w;
        }
        __syncthreads();
    }
}
}

typedef __bf16 bf16x2_t __attribute__((ext_vector_type(2)));
__device__ __forceinline__ float dot2bf(unsigned a, unsigned b, float c) { return __builtin_amdgcn_fdot2_f32_bf16(__builtin_bit_cast(bf16x2_t, a), __builtin_bit_cast(bf16x2_t, b), c, false); }
__device__ __forceinline__ unsigned f2ord(float f) { const unsigned u = __float_as_uint(f); return (u & 0x80000000u) ? ~u : (u | 0x80000000u); }
__device__ __forceinline__ float ord2f(unsigned o) { return __uint_as_float((o & 0x80000000u) ? (o ^ 0x80000000u) : ~o); }
__device__ __forceinline__ unsigned row_allmax_u32(unsigned v) {
    v = max(v, (unsigned)__builtin_amdgcn_update_dpp(0, (int)v, 0x128, 0xf, 0xf, false));
    v = max(v, (unsigned)__builtin_amdgcn_update_dpp(0, (int)v, 0x124, 0xf, 0xf, false));
    v = max(v, (unsigned)__builtin_amdgcn_update_dpp(0, (int)v, 0x122, 0xf, 0xf, false));
    v = max(v, (unsigned)__builtin_amdgcn_update_dpp(0, (int)v, 0x121, 0xf, 0xf, false));
    return v;
}

constexpr int TK_PITCH = 272, TK_HALF = 128 * TK_PITCH;
typedef short tk_bf16x8 __attribute__((ext_vector_type(8)));
__device__ __forceinline__ void topk_loadq(tk_bf16x8 (&qa)[8], const bf16_t* __restrict__ qb, int t0, int h, int lane) {
    const bf16_t* qp = qb + (size_t)(t0 + (lane & 15)) * 2048 + h * 256 + 8 * (lane >> 4);
#pragma unroll
    for (int i = 0; i < 8; ++i) qa[i] = *(const tk_bf16x8*)(qp + i * 32);
}
__device__ __forceinline__ void topk_item(const tk_bf16x8 (&qa)[8], const LAS unsigned char* klds, int* __restrict__ ids, float* __restrict__ gates, int t0, int h, int lane) {
    const int rl = lane & 15, rg = lane >> 4;
    unsigned top[2][4];
#pragma unroll
    for (int c = 0; c < 2; ++c) {
        f32x4 acc[8];
#pragma unroll
        for (int nt = 0; nt < 8; ++nt) acc[nt] = (f32x4){64.f, 64.f, 64.f, 64.f};
        const LAS unsigned char* kp = klds + c * TK_HALF + rl * TK_PITCH + 16 * rg;
#pragma unroll
        for (int ks = 0; ks < 4; ++ks) {
#pragma unroll
            for (int nt = 0; nt < 8; ++nt) { const tk_bf16x8 b = *(const LAS tk_bf16x8*)(kp + nt * 16 * TK_PITCH + ks * 64); acc[nt] = __builtin_amdgcn_mfma_f32_16x16x32_bf16(qa[c * 4 + ks], b, acc[nt], 0, 0, 0); }
            __builtin_amdgcn_sched_barrier(0);
        }
#pragma unroll
        for (int r = 0; r < 4; ++r) {
            unsigned k[8];
#pragma unroll
            for (int nt = 0; nt < 8; ++nt) k[nt] = (__float_as_uint(fmaxf(acc[nt][r], 1.f)) & ~127u) | (unsigned)(127 - (nt * 16 + rl));
#define TK_CE(i, j) do { const unsigned a_ = max(k[i], k[j]), b_ = min(k[i], k[j]); k[i] = a_; k[j] = b_; } while (0)
            TK_CE(0, 1); TK_CE(2, 3); TK_CE(4, 5); TK_CE(6, 7); TK_CE(0, 2); TK_CE(1, 3); TK_CE(4, 6); TK_CE(5, 7); TK_CE(1, 2); TK_CE(5, 6);
            TK_CE(0, 4); TK_CE(1, 5); TK_CE(2, 6); TK_CE(3, 7); TK_CE(2, 4); TK_CE(3, 5); TK_CE(1, 2); TK_CE(3, 4); TK_CE(5, 6);
#undef TK_CE
            unsigned tp = 0u;
            for (int round = 0; round < 16; ++round) {
                const unsigned m = row_allmax_u32(k[0]);
                tp = (rl == round) ? m : tp;
                const bool win = (k[0] == m);
                k[0] = win ? k[1] : k[0]; k[1] = win ? k[2] : k[1]; k[2] = win ? k[3] : k[2]; k[3] = win ? k[4] : k[3];
                k[4] = win ? k[5] : k[4]; k[5] = win ? k[6] : k[5]; k[6] = win ? k[7] : k[6]; k[7] = win ? 0u : k[7];
            }
            top[c][r] = tp;
        }
    }
    const int rowbase = lane & 48;
    float v1[4]; int n1[4], ptr[4], myid[4]; unsigned k2[4], myv[4];
#pragma unroll
    for (int r = 0; r < 4; ++r) { v1[r] = __uint_as_float(top[0][r] & ~127u); n1[r] = 127 - (int)(top[0][r] & 127u); ptr[r] = 0; k2[r] = (unsigned)__builtin_amdgcn_ds_bpermute(rowbase * 4, (int)top[1][r]); myid[r] = 0; myv[r] = 0u; }
    for (int round = 0; round < 16; ++round) {
#pragma unroll
        for (int r = 0; r < 4; ++r) {
            const float head = v1[r] + __uint_as_float(k2[r] & ~127u);
            const unsigned key = (ptr[r] < 16) ? ((__float_as_uint(head) & ~15u) | (unsigned)(15 - rl)) : 0u;
            const unsigned m = row_allmax_u32(key);
            const bool win = (key == m);
            const unsigned wid = row_allmax_u32(win ? (unsigned)(n1[r] * 128 + (127 - (int)(k2[r] & 127u))) + 1u : 0u);
            myid[r] = (rl == round) ? (int)wid - 1 : myid[r];
            myv[r] = (rl == round) ? m : myv[r];
            ptr[r] += win ? 1 : 0;
            k2[r] = (unsigned)__builtin_amdgcn_ds_bpermute((rowbase + (ptr[r] & 15)) * 4, (int)top[1][r]);
        }
    }
#pragma unroll
    for (int r = 0; r < 4; ++r) {
        const float val = __uint_as_float(myv[r] & ~15u);
        const float vmax = __uint_as_float((unsigned)__builtin_amdgcn_ds_bpermute(rowbase * 4, (int)__float_as_uint(val)));
        const float e = __expf(val - vmax);
        const float sum = rw::row_allsum(e);
        gates[(size_t)(t0 + 4 * rg + r) * 128 + h * 16 + rl] = e / sum; ids[(size_t)(t0 + 4 * rg + r) * 128 + h * 16 + rl] = myid[r];
    }
}

typedef float f32x2 __attribute__((ext_vector_type(2)));
__device__ __forceinline__ void peer_token(const bf16_t* __restrict__ x2b, const float* __restrict__ ssq2, const int* __restrict__ ids, const float* __restrict__ gates,
                                           const unsigned char* __restrict__ U8, const unsigned char* __restrict__ V8, const float* __restrict__ usc, const float* __restrict__ vsc,
                                           const float* __restrict__ fw, float* __restrict__ out, int t, int lane) {
    const int l16 = lane * 16;
    f32x2 hx[8];
    {
        const v4u h0 = *(const v4u*)(x2b + (size_t)t * DM + l16), h1 = *(const v4u*)(x2b + (size_t)t * DM + l16 + 8);
        const unsigned hw[8] = {h0.x, h0.y, h0.z, h0.w, h1.x, h1.y, h1.z, h1.w};
#pragma unroll
        for (int i = 0; i < 8; ++i) hx[i] = (f32x2){pg8::bflo(hw[i]), pg8::bfhi(hw[i])};
    }
    const int idA = ids[(size_t)t * 128 + lane], idB = ids[(size_t)t * 128 + 64 + lane];
    const float rs = rsqrtf(ssq2[t] * (1.f / DM) + NORM_EPS);
    const float suA = rs * usc[idA], suB = rs * usc[idB];
    const float svA = gates[(size_t)t * 128 + lane] * vsc[idA], svB = gates[(size_t)t * 128 + 64 + lane] * vsc[idB];
    f32x2 y[8];
#pragma unroll
    for (int i = 0; i < 8; ++i) y[i] = (f32x2){0.f, 0.f};
    const int bit0 = lane & 1, bit1 = (lane >> 1) & 1, bit2 = (lane >> 2) & 1;
    const int myk = 4 * bit0 + 2 * bit1 + bit2;
    for (int g = 0; g < 16; ++g) {
        const int idsel = (g < 8) ? idA : idB; const float susel = (g < 8) ? suA : suB, svsel = (g < 8) ? svA : svB; const int lb = (g * 8) & 63;
        v3u_t uw[8], vw[8];
#pragma unroll
        for (int k = 0; k < 8; ++k) { const int e = __builtin_amdgcn_readlane(idsel, lb + k); uw[k] = *(const v3u_t*)(U8 + (size_t)e * 768 + lane * 12); vw[k] = *(const v3u_t*)(V8 + (size_t)e * 768 + lane * 12); }
        float d[8];
#pragma unroll
        for (int k = 0; k < 8; ++k) {
            const v32f_t f = __builtin_amdgcn_cvt_scalef32_pk32_f32_fp6((v6u_t){uw[k][0], uw[k][1], uw[k][2], 0u, 0u, 0u}, 1.0f);
            f32x2 a = (f32x2){0.f, 0.f};
#pragma unroll
            for (int i = 0; i < 8; ++i) a += (f32x2){f[2 * i], f[2 * i + 1]} * hx[i];
            d[k] = a[0] + a[1];
            __builtin_amdgcn_sched_barrier(0);
        }
        float r4[4];
#pragma unroll
        for (int k = 0; k < 4; ++k) { const float send = bit0 ? d[k] : d[k + 4], keep = bit0 ? d[k + 4] : d[k]; r4[k] = keep + __shfl_xor(send, 1); }
        float r2[2];
#pragma unroll
        for (int k = 0; k < 2; ++k) { const float send = bit1 ? r4[k] : r4[k + 2], keep = bit1 ? r4[k + 2] : r4[k]; r2[k] = keep + __shfl_xor(send, 2); }
        float r1;
        { const float send = bit2 ? r2[0] : r2[1], keep = bit2 ? r2[1] : r2[0]; r1 = keep + __shfl_xor(send, 4); }
        r1 += __shfl_xor(r1, 8); r1 += __shfl_xor(r1, 16); r1 += __shfl_xor(r1, 32);
        const float dd = r1 * __shfl(susel, lb + myk);
        const float act = 0.5f * dd * (1.f + erff(dd * 0.70710678118654752f)) * __shfl(svsel, lb + myk);
#pragma unroll
        for (int k = 0; k < 8; ++k) {
            const float a = __uint_as_float((unsigned)__builtin_amdgcn_readlane((int)__float_as_uint(act), ((k & 1) << 2) | (k & 2) | ((k >> 2) & 1)));
            const f32x2 a2 = (f32x2){a, a};
            const v32f_t f = __builtin_amdgcn_cvt_scalef32_pk32_f32_fp6((v6u_t){vw[k][0], vw[k][1], vw[k][2], 0u, 0u, 0u}, 1.0f);
#pragma unroll
            for (int i = 0; i < 8; ++i) y[i] += (f32x2){f[2 * i], f[2 * i + 1]} * a2;
            __builtin_amdgcn_sched_barrier(0);
        }
    }
    float* orow = out + (size_t)t * DM + l16;
    float ss = 0.f;
    f32x4 o4[4];
#pragma unroll
    for (int i = 0; i < 4; ++i) { o4[i] = (f32x4){hx[2 * i][0] + y[2 * i][0], hx[2 * i][1] + y[2 * i][1], hx[2 * i + 1][0] + y[2 * i + 1][0], hx[2 * i + 1][1] + y[2 * i + 1][1]};
        ss += (o4[i][0] * o4[i][0] + o4[i][1] * o4[i][1]) + (o4[i][2] * o4[i][2] + o4[i][3] * o4[i][3]); }
    ss = wave_sum(ss);
    const float r = rsqrtf(ss * (1.f / DM) + NORM_EPS);
#pragma unroll
    for (int i = 0; i < 4; ++i) *(f32x4*)(orow + 4 * i) = o4[i] * r * *(const f32x4*)(fw + l16 + 4 * i);
}

__global__ void __launch_bounds__(NWAVES * 64, 2) mk_fwd(Args args) {
    extern __shared__ __attribute__((aligned(16))) unsigned char lds_raw[];
    LAS unsigned char* lds = (LAS unsigned char*)lds_raw;
    volatile LAS unsigned* MISC = (volatile LAS unsigned*)(lds + MISC_OFF);
    const int tid = threadIdx.x, lane = tid & 63, wave = __builtin_amdgcn_readfirstlane(tid >> 6);
    const int G = gridDim.x; const int bx = blockIdx.x; const int vcu = (G % 8 == 0) ? (bx % 8) * (G / 8) + bx / 8 : bx;
    unsigned char* ws = args.ws;
    unsigned* ctl = (unsigned*)(ws + WS_CTL);
    for (int u = tid; u < (LDS_BYTES - LDSCTL_OFF) / 4; u += NWAVES * 64) ((LAS unsigned*)(lds + LDSCTL_OFF))[u] = 0u;
    __syncthreads();
    XcdBarrier bar = xcd_barrier_post(ctl + CW_BAR + args.li * XCD_BAR_WORDS, MISC + 8);
    const int lo = args.ph_lo, hi = args.ph_hi;
#define IN(k) (lo <= (k) && (k) < hi)
#define BOTH(k) (IN(k) && IN((k) + 1))
    bf16_t* WinT = (bf16_t*)(ws + WS_WIN); bf16_t* PaT = (bf16_t*)(ws + WS_PA); bf16_t* PbT = (bf16_t*)(ws + WS_PB); bf16_t* WoT = (bf16_t*)(ws + WS_WO);
    bf16_t* WqT = (bf16_t*)(ws + WS_WQ); bf16_t* KeysB = (bf16_t*)(ws + WS_KEYS);
    float* rstd1 = (float*)(ws + WS_RSTD1); float* ssq2 = (float*)(ws + WS_RSTD2); float* scal = (float*)(ws + WS_SCAL);
    unsigned char* U8 = ws + WS_U; unsigned char* V8 = ws + WS_V; float* usc = (float*)(ws + WS_USC); float* vsc = (float*)(ws + WS_VSC);
    bf16_t* xb = (bf16_t*)(ws + WS_XB); bf16_t* ya = (bf16_t*)(ws + WS_YA); bf16_t* yb = (bf16_t*)(ws + WS_YB); bf16_t* x2b = (bf16_t*)(ws + WS_X2B);
    bf16_t* z = (bf16_t*)(ws + WS_Z); bf16_t* qb = (bf16_t*)(ws + WS_Q);
    bf16_t* merged = (bf16_t*)(ws + WS_MERGED);
    const int gw = vcu * NWAVES + wave, NGW = G * NWAVES;

    if (IN(0)) {
        LAS float* scr = (LAS float*)(lds + wave * 16384);
        constexpr int I_IN = (DM / 64) * (NZ / 32), I_PA = (512 / 64) * (DM / 32), I_WO = (DM / 64) * (DM / 32), I_WQ = (DM / 64) * (2048 / 32);
        constexpr int NITEMS = I_IN + 2 * I_PA + I_WO + I_WQ;
        for (int it = gw; it < NITEMS; it += NGW) {
            int r = it;
            if (r < I_IN) { p0_transpose_item(args.in[2], args.in[1], DM, NZ, WinT, scr, r, lane); continue; } r -= I_IN;
            if (r < I_PA) { p0_transpose_item(args.in[19], nullptr, 512, DM, PaT, scr, r, lane); continue; } r -= I_PA;
            if (r < I_PA) { p0_transpose_item(args.in[20], nullptr, 512, DM, PbT, scr, r, lane); continue; } r -= I_PA;
            if (r < I_WO) { p0_transpose_item(args.in[21], nullptr, DM, DM, WoT, scr, r, lane); continue; } r -= I_WO;
            p0_transpose_item(args.in[23], args.in[22], DM, 2048, WqT, scr, r, lane);
        }
        p0_convert(args.in[24], nullptr, KeysB, (size_t)16 * 128 * 128, gw, NGW, lane);
        for (int e = gw; e < 2 * NEXP; e += NGW) {
            const bool isu = e < NEXP; const int row = isu ? e : e - NEXP;
            p0_row_fp6((isu ? args.in[25] : args.in[26]) + (size_t)row * DM, isu ? args.in[22] : nullptr, (isu ? U8 : V8) + (size_t)row * 768, (isu ? usc : vsc) + row, lane);
        }
        for (int m = gw; m < T_TOK; m += NGW) {
            const f32x4* xr = (const f32x4*)(args.in[0] + (size_t)m * DM) + lane;
            f32x4 v[4]; float s = 0.f;
#pragma unroll
            for (int j = 0; j < 4; ++j) { v[j] = xr[64 * j]; s += (v[j][0] * v[j][0] + v[j][1] * v[j][1]) + (v[j][2] * v[j][2] + v[j][3] * v[j][3]); }
            s = wave_sum(s);
            v2u* o8 = (v2u*)(xb + (size_t)m * DM) + lane;
#pragma unroll
            for (int j = 0; j < 4; ++j) { v2u w; w.x = pg8::cvt_pk_bf16(v[j][0], v[j][1]); w.y = pg8::cvt_pk_bf16(v[j][2], v[j][3]); o8[64 * j] = w; }
            if (lane == 0) { rstd1[m] = rsqrtf(s * (1.f / DM) + NORM_EPS); ssq2[m] = 0.f; }
        }
        if (gw == 0) {
            const float a = wave_sum(args.in[14][lane] * args.in[15][lane]), b = wave_sum(args.in[16][lane] * args.in[17][lane]);
            if (lane == 0) scal[0] = __expf(a) - __expf(b) + LAM_INIT;
        }
        if (BOTH(0)) xcd_barrier(bar);
    }
    if (IN(1)) {
        pg8::Gemm g{xb, WinT, DM, DM, DM}; pg8::StaticOrder S; S.init(T_TOK, NZ, G, bx);
        pg8::EpiRowScale<false> E{z, NZ, rstd1};
        for (int rep = 0; rep < REPS(1); ++rep) pg8::gemm_phase(lds, g, S, E);
        if (BOTH(1)) xcd_barrier(bar);
    }
    if (IN(2)) {
        {
            const rw::ScanP P{args.in[3], args.in[4], args.in[5], args.in[6], args.in[7], args.in[8], args.in[9], args.in[10], args.in[11], args.in[12], args.in[13]};
            for (int rep = 0; rep < REPS(2); ++rep) for (int u = vcu; u < NB * 8; u += G) rw::scan_unit(lds, z, ya, P, u >> 3, u & 7, tid, wave, lane);
        }
        const float lam = scal[0];
        for (int rep = 0; rep < REPS(10); ++rep) for (int i = 0;; ++i) {
            const int idx = vcu + i * G; if (idx >= 2048) break;
            const int slot = idx >> 8, v = idx & 255, bh = v >> 1, a = (v & 1) * 4 + (slot >> 1), qblk = (slot & 1) ? 15 - a : a;
            da::attn_unit(lds, z, yb, args.in[18], lam, bh >> 2, bh & 3, qblk, wave, lane);
        }
        if (BOTH(2)) xcd_barrier(bar);
    }
    if (IN(3)) {
        pg8::Gemm g{ya, PaT, 512, 512, 512}; pg8::StaticOrder S; S.init(T_TOK, DM, G, bx);
        pg8::EpiGate<false> E{merged, z, C_GA};
        pg8::gemm_phase(lds, g, S, E);
        if (BOTH(3)) xcd_barrier(bar);
    }
    if (IN(4)) {
        pg8::Gemm g{yb, PbT, 512, 512, 512}; pg8::StaticOrder S; S.init(T_TOK, DM, G, bx);
        pg8::EpiGate<true> E{merged, z, C_GB};
        pg8::gemm_phase(lds, g, S, E);
        if (BOTH(4)) xcd_barrier(bar);
    }
    if (IN(5)) {
        pg8::Gemm g{merged, WoT, DM, DM, DM}; pg8::StaticOrder S; S.init(T_TOK, DM, G, bx);
        pg8::EpiX2 E{args.in[0], args.out, x2b, ssq2};
        pg8::gemm_phase(lds, g, S, E);
        if (BOTH(5)) xcd_barrier(bar);
    }
    if (IN(6)) {
        pg8::Gemm g{x2b, WqT, DM, DM, DM}; pg8::StaticOrder S; S.init(T_TOK, 2048, G, bx);
        pg8::EpiRowScale<true> E{qb, 2048, ssq2};
        for (int rep = 0; rep < REPS(6); ++rep) pg8::gemm_phase(lds, g, S, E);
        if (BOTH(6)) xcd_barrier(bar);
    }
    if (IN(7)) {
        int* ids = (int*)(ws + WS_IDS); float* gates = (float*)(ws + WS_GATES);
        for (int rep = 0; rep < REPS(7); ++rep)
        for (int h = 0; h < 8; ++h) {
            __syncthreads();
            {
                const bf16_t* ksrc = KeysB + (size_t)h * 2 * 128 * 128;
#pragma unroll
                for (int i = 0; i < 8; ++i) { const int chunk = tid + i * 512, row = chunk >> 4, cc = chunk & 15;
                    *(LAS v4u*)(lds + (row >> 7) * TK_HALF + (row & 127) * TK_PITCH + cc * 16) = *(const v4u*)(ksrc + (size_t)row * 128 + cc * 8); }
            }
            __syncthreads();
            for (int tile = gw; tile < 4096; tile += NGW) {
                tk_bf16x8 qa[8];
                topk_loadq(qa, qb, tile * 16, h, lane);
                topk_item(qa, lds, ids, gates, tile * 16, h, lane);
            }
        }
        if (BOTH(7)) xcd_barrier(bar);
    }
    if (IN(8)) {
        const int* ids = (const int*)(ws + WS_IDS); const float* gates = (const float*)(ws + WS_GATES);
        for (int t = gw; t < T_TOK; t += NGW) peer_token(x2b, ssq2, ids, gates, U8, V8, usc, vsc, args.in[27], args.out, t, lane);
    }
#undef IN
#undef BOTH
}

extern "C" void kernel_launch(void* const* d_in, const int* in_sizes, int n_in, void* d_out, int out_size, void* d_ws, size_t ws_size, hipStream_t stream) {
    static int grid = 0;
    if (grid == 0) {
        if (n_in != 28 || in_sizes[0] != T_TOK * DM || out_size != T_TOK * DM || ws_size < WS_END) {
            fprintf(stderr, "kernel_launch: unexpected shapes / workspace (n_in %d, ws %zu < %zu)\n", n_in, ws_size, (size_t)WS_END); grid = -1; return; }
        int dev = 0, cus = 0;
        if (hipGetDevice(&dev) != hipSuccess || hipDeviceGetAttribute(&cus, hipDeviceAttributeMultiprocessorCount, dev) != hipSuccess) { grid = -1; return; }
        if (hipFuncSetAttribute((const void*)mk_fwd, hipFuncAttributeMaxDynamicSharedMemorySize, LDS_BYTES) != hipSuccess) { fprintf(stderr, "kernel_launch: hipFuncSetAttribute failed\n"); grid = -1; return; }
        grid = cus;
    }
    if (grid < 0) return;
    unsigned char* ws = (unsigned char*)d_ws;
    float* out = (float*)d_out;
    (void)hipMemsetAsync(ws + WS_CTL, 0, 1 * MiB, stream);
    Args a{};
    for (int i = 0; i < 28; ++i) a.in[i] = (const float*)d_in[i];
    a.out = out; a.ws = ws;
    a.ph_lo = 0; a.ph_hi = 9; a.li = 0;
    hipLaunchKernelGGL(mk_fwd, dim3(grid), dim3(NWAVES * 64), LDS_BYTES, stream, a);
}
```

```cpp
#include <hip/hip_runtime.h>
#include <stdint.h>
#include <cstdio>

typedef unsigned short bf16_t;
typedef unsigned int u32;

#ifndef PROBE_REP
#define PROBE_REP 0
#endif
#define REPS(k) (((PROBE_REP >> (k)) & 1) ? 2 : 1)
constexpr int T_TOK = 65536, DM = 1024, SEQ = 2048, NB = 32;
constexpr int NZ = 5376;
constexpr int C_R = 0, C_K = 512, C_V = 1024, C_WL = 1536, C_AL = 1600, C_GL = 1664, C_Q = 1792, C_ZK = 2304, C_ZV = 2816, C_GA = 3328, C_GB = 4352;
constexpr int NEXP = 16384;
constexpr float NORM_EPS = 1e-6f, GN_EPS = 64e-5f, SUBLN_EPS = 1e-5f;
constexpr float LAM_INIT = 0.2f;

constexpr size_t MiB = 1u << 20;
constexpr size_t WS_CTL = 0;
constexpr size_t WS_WIN = 1 * MiB;
constexpr size_t WS_PA = 12 * MiB;
constexpr size_t WS_PB = 13 * MiB;
constexpr size_t WS_WO = 14 * MiB;
constexpr size_t WS_WQ = 16 * MiB;
constexpr size_t WS_KEYS = 20 * MiB;
constexpr size_t WS_RSTD1 = 21 * MiB;
constexpr size_t WS_RSTD2 = 58 * MiB;
constexpr size_t WS_SCAL = 23 * MiB;
constexpr size_t WS_U = 24 * MiB;
constexpr size_t WS_V = 40 * MiB;
constexpr size_t WS_USC = 56 * MiB;
constexpr size_t WS_VSC = 57 * MiB;
constexpr size_t WS_XB = 88 * MiB;
constexpr size_t WS_YA = WS_XB;
constexpr size_t WS_YB = WS_XB + 64 * MiB;
constexpr size_t WS_X2B = WS_XB;
constexpr size_t WS_Z = 216 * MiB;
constexpr size_t WS_Q = WS_Z;
constexpr size_t WS_IDS = WS_Z + 256 * MiB;
constexpr size_t WS_GATES = WS_Z + 288 * MiB;
constexpr size_t WS_MERGED = 888 * MiB;
constexpr size_t WS_END = 1016 * MiB;

__device__ __forceinline__ float bf2f(bf16_t h) { return __uint_as_float(((u32)h) << 16); }
__device__ __forceinline__ bf16_t f2bf(float f) { u32 u = __float_as_uint(f); u += 0x7fffu + ((u >> 16) & 1u); return (bf16_t)(u >> 16); }
__device__ __forceinline__ float wave_sum(float v) {
#pragma unroll
    for (int o = 1; o < 64; o <<= 1) v += __shfl_xor(v, o);
    return v;
}
__device__ __forceinline__ float sigmoidf_(float x) { return 1.f / (1.f + __expf(-x)); }

namespace pg8 {
#define PG8_LAS __attribute__((address_space(3)))
typedef short bf16x8 __attribute__((ext_vector_type(8)));
typedef float f32x4 __attribute__((ext_vector_type(4)));
typedef unsigned u32x4 __attribute__((ext_vector_type(4)));
constexpr int BM = 256, BK = 64, HALF = 128, HTB = HALF * BK * 2  , STAGE_BYTES = 8 * HTB, NXCD = 8, WGM = 8;

__host__ __device__ __forceinline__ int lds_byte(int r, int c) { const int st = (r >> 4) * 2 + (c >> 5), rr = r & 15, cc = c & 31, ob = rr * 64 + cc * 2; return st * 1024 + (ob ^ (((ob >> 9) & 1) << 5)); }
__host__ __device__ __forceinline__ void stage_rc(int b, int& R, int& C) { const int st = b / 1024, sb = b % 1024, swz = sb ^ (((sb >> 9) & 1) << 5); R = (st >> 1) * 16 + swz / 64; C = (st & 1) * 32 + (swz % 64) / 2; }
__host__ __device__ __forceinline__ int perm32(int rho) { const int n = rho >> 4, i = rho & 15; return 8 * (i >> 2) + 4 * n + (i & 3); }

struct Unit { int pm, pn; };
struct Gemm { const bf16_t* A; const bf16_t* Bt; int lda, ldb, K; };

struct StaticOrder {
    int nM, nN, nwg, G, c;
    __host__ __device__ void init(int M, int N, int G_, int c_) { nM = M / BM; nN = N / BM; nwg = nM * nN; G = G_; c = c_; }
    __host__ __device__ bool next(int i, Unit& u) const {
        const long L = (long)i * G + c; if (L >= nwg) return false;
        int wgid = (int)L; { const int q = nwg / NXCD, r = nwg % NXCD, xcd = wgid % NXCD, off = wgid / NXCD; wgid = (xcd < r ? xcd * (q + 1) : r * (q + 1) + (xcd - r) * q) + off; }
        const int nig = WGM * nN, gid = wgid / nig, fm = gid * WGM, gsz = (nM - fm) < WGM ? (nM - fm) : WGM;
        u.pm = fm + ((wgid % nig) % gsz); u.pn = (wgid % nig) / gsz; return true;
    }
};
typedef float f32x2_c __attribute__((ext_vector_type(2))); typedef __bf16 bf16x2_c __attribute__((ext_vector_type(2)));
__device__ __forceinline__ unsigned cvt_pk_bf16(float lo, float hi) { const f32x2_c v = {lo, hi}; const bf16x2_c b = __builtin_convertvector(v, bf16x2_c); return __builtin_bit_cast(unsigned, b); }
__device__ __forceinline__ float bflo(unsigned w) { return __uint_as_float(w << 16); }
__device__ __forceinline__ float bfhi(unsigned w) { return __uint_as_float(w & 0xffff0000u); }

__device__ __forceinline__ float ssq_sum16(const float* p) {
    const f32x4 a = *(const f32x4*)p, b = *(const f32x4*)(p + 4), c = *(const f32x4*)(p + 8), d = *(const f32x4*)(p + 12);
    return (((a[0] + a[1]) + (a[2] + a[3])) + ((b[0] + b[1]) + (b[2] + b[3]))) + (((c[0] + c[1]) + (c[2] + c[3])) + ((d[0] + d[1]) + (d[2] + d[3])));
}
template <bool SSQ> struct EpiRowScale {
    static constexpr bool PERM = true;
    bf16_t* O; int ldc; const float* rs;
    __device__ __forceinline__ void operator()(const f32x4 (&acc)[2][2][4][2], const Unit& u, int wr, int wc, int fr, int fq) const {
        const int row0 = u.pm * BM + wr * 64 + fr, col0 = u.pn * BM + wc * 32 + 8 * fq;
#pragma unroll
        for (int ai = 0; ai < 2; ++ai)
#pragma unroll
            for (int m = 0; m < 4; ++m) {
                const int row = row0 + ai * HALF + m * 16;
                float s; if (SSQ) s = rsqrtf(ssq_sum16(rs + (size_t)row * 16) * (1.f / 1024.f) + NORM_EPS); else s = rs[row];
                bf16_t* rowp = O + (size_t)row * ldc + col0;
#pragma unroll
                for (int bj = 0; bj < 2; ++bj) {
                    const f32x4 v0 = acc[ai][bj][m][0] * s, v1 = acc[ai][bj][m][1] * s;
                    u32x4 w; w.x = cvt_pk_bf16(v0[0], v0[1]); w.y = cvt_pk_bf16(v0[2], v0[3]); w.z = cvt_pk_bf16(v1[0], v1[1]); w.w = cvt_pk_bf16(v1[2], v1[3]);
                    *(u32x4*)(rowp + bj * HALF) = w;
                }
            }
    }
};
template <bool ACCUM> struct EpiGate {
    static constexpr bool PERM = true;
    bf16_t* mg; const bf16_t* z; int gcol;
    __device__ __forceinline__ void operator()(const f32x4 (&acc)[2][2][4][2], const Unit& u, int wr, int wc, int fr, int fq) const {
        const int row0 = u.pm * BM + wr * 64 + fr, col0 = u.pn * BM + wc * 32 + 8 * fq;
#pragma unroll
        for (int ai = 0; ai < 2; ++ai)
#pragma unroll
            for (int m = 0; m < 4; ++m) {
                const int row = row0 + ai * HALF + m * 16;
                const bf16_t* gp = z + (size_t)row * NZ + gcol + col0;
                bf16_t* rowp = mg + (size_t)row * DM + col0;
#pragma unroll
                for (int bj = 0; bj < 2; ++bj) {
                    const u32x4 g = *(const u32x4*)(gp + bj * HALF);
                    const f32x4 a0 = acc[ai][bj][m][0], a1 = acc[ai][bj][m][1];
                    float r[8];
                    r[0] = sigmoidf_(bflo(g.x)) * a0[0]; r[1] = sigmoidf_(bfhi(g.x)) * a0[1]; r[2] = sigmoidf_(bflo(g.y)) * a0[2]; r[3] = sigmoidf_(bfhi(g.y)) * a0[3];
                    r[4] = sigmoidf_(bflo(g.z)) * a1[0]; r[5] = sigmoidf_(bfhi(g.z)) * a1[1]; r[6] = sigmoidf_(bflo(g.w)) * a1[2]; r[7] = sigmoidf_(bfhi(g.w)) * a1[3];
                    if (ACCUM) { const u32x4 o = *(const u32x4*)(rowp + bj * HALF);
                        r[0] += bflo(o.x); r[1] += bfhi(o.x); r[2] += bflo(o.y); r[3] += bfhi(o.y); r[4] += bflo(o.z); r[5] += bfhi(o.z); r[6] += bflo(o.w); r[7] += bfhi(o.w); }
                    u32x4 w; w.x = cvt_pk_bf16(r[0], r[1]); w.y = cvt_pk_bf16(r[2], r[3]); w.z = cvt_pk_bf16(r[4], r[5]); w.w = cvt_pk_bf16(r[6], r[7]);
                    *(u32x4*)(rowp + bj * HALF) = w;
                }
            }
    }
};
struct EpiX2 {
    static constexpr bool PERM = true;
    const float* x; float* x2; bf16_t* x2b; float* ssq;
    __device__ __forceinline__ void operator()(const f32x4 (&acc)[2][2][4][2], const Unit& u, int wr, int wc, int fr, int fq) const {
        const int row0 = u.pm * BM + wr * 64 + fr, col0 = u.pn * BM + wc * 32 + 8 * fq;
#pragma unroll
        for (int ai = 0; ai < 2; ++ai)
#pragma unroll
            for (int m = 0; m < 4; ++m) {
                const int row = row0 + ai * HALF + m * 16;
                const size_t off = (size_t)row * DM + col0;
                float ss = 0.f;
#pragma unroll
                for (int bj = 0; bj < 2; ++bj) {
                    const f32x4 x0 = *(const f32x4*)(x + off + bj * HALF), x1 = *(const f32x4*)(x + off + bj * HALF + 4);
                    const f32x4 o0 = x0 + acc[ai][bj][m][0], o1 = x1 + acc[ai][bj][m][1];
                    u32x4 w; w.x = cvt_pk_bf16(o0[0], o0[1]); w.y = cvt_pk_bf16(o0[2], o0[3]); w.z = cvt_pk_bf16(o1[0], o1[1]); w.w = cvt_pk_bf16(o1[2], o1[3]);
                    *(u32x4*)(x2b + off + bj * HALF) = w;
                    ss += (o0[0] * o0[0] + o0[1] * o0[1]) + (o0[2] * o0[2] + o0[3] * o0[3]) + (o1[0] * o1[0] + o1[1] * o1[1]) + (o1[2] * o1[2] + o1[3] * o1[3]);
                }
                ss += __shfl_xor(ss, 16); ss += __shfl_xor(ss, 32);
                if (fq == 0) ssq[(size_t)row * 16 + (u.pn & 3) * 4 + wc] = ss;
            }
    }
};

template <class Epi, class Sched>
__device__ __forceinline__ void gemm_phase(PG8_LAS unsigned char* lds, const Gemm g, const Sched& S, const Epi& E) {
    const int tid = threadIdx.x, wid = __builtin_amdgcn_readfirstlane(tid >> 6), lane = tid & 63, wr = wid >> 2, wc = wid & 3, fr = lane & 15, fq = lane >> 4;
    const int K = g.K, nt = K / BK;
    unsigned voffA[2], voffB[2];
#pragma unroll
    for (int i = 0; i < 2; ++i) { int R, C; stage_rc(tid * 16 + i * 8192, R, C); const int Rb = Epi::PERM ? ((R & ~31) + perm32(R & 31)) : R;
        voffA[i] = (unsigned)(R * g.lda + C) * 2u; voffB[i] = (unsigned)(Rb * g.ldb + C) * 2u; }
    const size_t kstep = (size_t)(BK * 2);
    const size_t hstepA = (size_t)HALF * g.lda * 2, hstepB = (size_t)HALF * g.ldb * 2;
    const size_t tstepA = 2 * hstepA, tstepB = 2 * hstepB;
    const unsigned ldsw = (unsigned)wid * 1024u;
    const int aoff = lds_byte(wr * 64 + fr, fq * 8), boff = lds_byte(wc * 32 + fr, fq * 8);
#define PG8_SA(b, h) (((b) * 2 + (h)) * HTB)
#define PG8_SB(b, h) ((4 + (b) * 2 + (h)) * HTB)
#define PG8_STAGE(bufoff, gbase, voff) do { _Pragma("unroll") for (int _i = 0; _i < 2; ++_i) \
        __builtin_amdgcn_global_load_lds((const unsigned*)((const char*)(gbase) + (voff)[_i]), (PG8_LAS unsigned*)(lds + (bufoff) + ldsw + _i * 8192), 16, 0, 0); } while (0)
#define PG8_LDA(dst, b, h) do { _Pragma("unroll") for (int m = 0; m < 4; ++m) _Pragma("unroll") for (int k = 0; k < 2; ++k) dst[m][k] = *(const PG8_LAS bf16x8*)(lds + PG8_SA(b, h) + aoff + m * 2048 + k * 1024); } while (0)
#define PG8_LDB(dst, b, h) do { _Pragma("unroll") for (int n = 0; n < 2; ++n) _Pragma("unroll") for (int k = 0; k < 2; ++k) dst[n][k] = *(const PG8_LAS bf16x8*)(lds + PG8_SB(b, h) + boff + n * 2048 + k * 1024); } while (0)
#define PG8_MMA(ai, bj, At, Bt) do { __builtin_amdgcn_s_setprio(1); _Pragma("unroll") for (int m = 0; m < 4; ++m) _Pragma("unroll") for (int n = 0; n < 2; ++n) _Pragma("unroll") for (int k = 0; k < 2; ++k) \
        acc[ai][bj][m][n] = __builtin_amdgcn_mfma_f32_16x16x32_bf16(Bt[n][k], At[m][k], acc[ai][bj][m][n], 0, 0, 0); __builtin_amdgcn_s_setprio(0); } while (0)
#define PG8_WAIT_V(n) asm volatile("s_waitcnt vmcnt(" #n ")" ::: "memory")
#define PG8_WAIT_L(n) asm volatile("s_waitcnt lgkmcnt(" #n ")" ::: "memory")
#define PG8_BAR __builtin_amdgcn_s_barrier()
#define PG8_SCHED __builtin_amdgcn_sched_barrier(0)
    Unit cur, nxt; int ui = 0;
    if (!S.next(0, cur)) return;
    f32x4 acc[2][2][4][2];
#pragma unroll
    for (int a = 0; a < 2; ++a)
#pragma unroll
        for (int b = 0; b < 2; ++b)
#pragma unroll
            for (int m = 0; m < 4; ++m)
#pragma unroll
                for (int n = 0; n < 2; ++n) acc[a][b][m][n] = (f32x4){0.f, 0.f, 0.f, 0.f};
    bf16x8 At[4][2], B0[2][2], B1[2][2];
    const char* cA = (const char*)g.A + (size_t)cur.pm * tstepA; const char* cB = (const char*)g.Bt + (size_t)cur.pn * tstepB;
    PG8_STAGE(PG8_SB(0, 0), cB, voffB); PG8_STAGE(PG8_SB(0, 1), cB + hstepB, voffB); PG8_STAGE(PG8_SA(0, 0), cA, voffA); PG8_STAGE(PG8_SA(0, 1), cA + hstepA, voffA);
    if (wr == 1) PG8_BAR;
    PG8_WAIT_V(2); PG8_BAR;
    PG8_STAGE(PG8_SB(1, 0), cB + kstep, voffB); PG8_STAGE(PG8_SA(1, 0), cA + kstep, voffA); PG8_STAGE(PG8_SB(1, 1), cB + hstepB + kstep, voffB);
    PG8_WAIT_V(6); PG8_BAR;
    for (;;) {
        const bool has_next = S.next(ui + 1, nxt);
        const char* nA = has_next ? (const char*)g.A + (size_t)nxt.pm * tstepA : cA; const char* nB = has_next ? (const char*)g.Bt + (size_t)nxt.pn * tstepB : cB;
        for (int t = 0; t < nt; t += 2) {
            const bool last = (t == nt - 2);
            const char* a1 = cA + (size_t)(t + 1) * kstep;
            const char* a2 = last ? nA : cA + (size_t)(t + 2) * kstep; const char* b2 = last ? nB : cB + (size_t)(t + 2) * kstep;
            const char* a3 = a2 + kstep; const char* b3 = b2 + kstep;
            PG8_LDB(B0, 0, 0); PG8_LDB(B1, 0, 1); PG8_SCHED; PG8_LDA(At, 0, 0); PG8_STAGE(PG8_SA(1, 1), a1 + hstepA, voffA);
            PG8_WAIT_V(8); PG8_WAIT_L(0); PG8_BAR; PG8_MMA(0, 0, At, B0); PG8_MMA(0, 1, At, B1); PG8_BAR; PG8_SCHED;
            PG8_LDA(At, 0, 1); PG8_STAGE(PG8_SB(0, 0), b2, voffB); PG8_STAGE(PG8_SB(0, 1), b2 + hstepB, voffB); PG8_STAGE(PG8_SA(0, 0), a2, voffA);
            PG8_WAIT_V(8); PG8_WAIT_L(0); PG8_BAR; PG8_MMA(1, 0, At, B0); PG8_MMA(1, 1, At, B1); PG8_BAR; PG8_SCHED;
            PG8_LDB(B0, 1, 0); PG8_LDB(B1, 1, 1); PG8_SCHED; PG8_LDA(At, 1, 0); PG8_STAGE(PG8_SA(0, 1), a2 + hstepA, voffA);
            PG8_WAIT_V(8); PG8_WAIT_L(0); PG8_BAR; PG8_MMA(0, 0, At, B0); PG8_MMA(0, 1, At, B1); PG8_BAR; PG8_SCHED;
            PG8_LDA(At, 1, 1); PG8_STAGE(PG8_SB(1, 0), b3, voffB); PG8_STAGE(PG8_SB(1, 1), b3 + hstepB, voffB); PG8_STAGE(PG8_SA(1, 0), a3, voffA);
            PG8_WAIT_V(8); PG8_WAIT_L(0); PG8_BAR; PG8_MMA(1, 0, At, B0); PG8_MMA(1, 1, At, B1); PG8_BAR; PG8_SCHED;
        }
        if (wr == 0) PG8_BAR;
        E(acc, cur, wr, wc, fr, fq);
        if (!has_next) break;
#pragma unroll
        for (int a = 0; a < 2; ++a)
#pragma unroll
            for (int b = 0; b < 2; ++b)
#pragma unroll
                for (int m = 0; m < 4; ++m)
#pragma unroll
                    for (int n = 0; n < 2; ++n) acc[a][b][m][n] = (f32x4){0.f, 0.f, 0.f, 0.f};
        cur = nxt; cA = nA; cB = nB; ++ui;
        if (wr == 1) PG8_BAR;
    }
    PG8_WAIT_V(0);
    PG8_BAR;
#undef PG8_SA
#undef PG8_SB
#undef PG8_STAGE
#undef PG8_LDA
#undef PG8_LDB
#undef PG8_MMA
#undef PG8_WAIT_V
#undef PG8_WAIT_L
#undef PG8_BAR
#undef PG8_SCHED
}
}

constexpr int NWAVES = 8;
constexpr int LDS_RING_BYTES = 131072, LDSCTL_OFF = 143360, MISC_OFF = LDSCTL_OFF + 320, LDS_BYTES = 147456;
#define LAS __attribute__((address_space(3)))
#define GAS __attribute__((address_space(1)))
typedef float f32x4 __attribute__((ext_vector_type(4)));
typedef unsigned v4u __attribute__((ext_vector_type(4)));
typedef unsigned v2u __attribute__((ext_vector_type(2)));
#define LDS_WAIT() asm volatile("s_waitcnt lgkmcnt(0)" ::: "memory")

constexpr int CW_BAR = 4096;
#define XB_TMO      128
#define XB_XCNT(j)  (256  + 64 * (j))
#define XB_XSUB(j)  (1280 + 64 * (j))
#define XB_XGEN(j)  (2304 + 64 * (j))
#define XB_TOP      3328
#define XB_TOPGEN   3392
#define XCD_BAR_WORDS 3456
#define XB_SPIN_CAP (1u << 20)
__device__ __forceinline__ unsigned xb_ld(unsigned* p)              { return __hip_atomic_load(p, __ATOMIC_RELAXED, __HIP_MEMORY_SCOPE_AGENT); }
__device__ __forceinline__ unsigned xb_add(unsigned* p, unsigned v) { return __hip_atomic_fetch_add(p, v, __ATOMIC_RELAXED, __HIP_MEMORY_SCOPE_AGENT); }
__device__ __forceinline__ unsigned xb_xcc_id() { return (unsigned)__builtin_amdgcn_s_getreg((3 << 11) | 20) & 0xFu; }
#define XB_SPIN(cond, bar) do { unsigned _sp = 0; while (cond) { __builtin_amdgcn_s_sleep(1); \
    if ((++_sp & 255u) == 0u) { if (xb_ld(&(bar)[XB_TMO])) break; if (_sp > XB_SPIN_CAP) { atomicAdd(&(bar)[XB_TMO], 1u); break; } } } } while (0)
struct XcdBarrier { unsigned* bar; unsigned x; volatile LAS unsigned* st; };
__device__ __forceinline__ XcdBarrier xcd_barrier_post(unsigned* bar, volatile LAS unsigned* st) {
    XcdBarrier b; b.bar = bar; b.x = xb_xcc_id(); b.st = st;
    if (threadIdx.x == 0) (void)xb_add(&bar[XB_XCNT(b.x)], 1u);
    return b;
}
__device__ __forceinline__ void xcd_barrier_complete(unsigned* bar, unsigned x, unsigned& nloc, unsigned& nx) {
    const unsigned G = gridDim.x * gridDim.y * gridDim.z;
    unsigned sum, cnt, mine, sp = 0u;
    for (;;) {
        sum = 0u; cnt = 0u; mine = 0u;
#pragma unroll
        for (unsigned j = 0; j < 16; ++j) { const unsigned c = xb_ld(&bar[XB_XCNT(j)]); sum += c; cnt += (c > 0u) ? 1u : 0u; mine = (j == x) ? c : mine; }
        if (sum == G) break;
        __builtin_amdgcn_s_sleep(1);
        if ((++sp & 255u) == 0u) { if (xb_ld(&bar[XB_TMO])) break; if (sp > XB_SPIN_CAP) { atomicAdd(&bar[XB_TMO], 1u); break; } }
    }
    nloc = mine > 0u ? mine : 1u; nx = cnt > 0u ? cnt : 1u;
}
__device__ __forceinline__ void xcd_barrier(const XcdBarrier& b) {
    asm volatile("s_waitcnt vmcnt(0)" ::: "memory");
    __syncthreads();
    if (threadIdx.x == 0) {
        unsigned* bar = b.bar;
        __builtin_amdgcn_s_waitcnt(0);
        unsigned nloc = b.st[0], nx = b.st[1];
        if (nloc == 0u) { xcd_barrier_complete(bar, b.x, nloc, nx); b.st[0] = nloc; b.st[1] = nx; }
        const unsigned old = xb_add(&bar[XB_XSUB(b.x)], 1u);
        const unsigned gen = old / nloc;
        if (old + 1u == (gen + 1u) * nloc) {
            __builtin_amdgcn_fence(__ATOMIC_RELEASE, "agent");
            asm volatile("s_waitcnt vmcnt(0)" ::: "memory");
            const unsigned og = xb_add(&bar[XB_TOP], 1u);
            const unsigned tg = og / nx;
            if (og + 1u == (tg + 1u) * nx) xb_add(&bar[XB_TOPGEN], 1u);
            else XB_SPIN(xb_ld(&bar[XB_TOPGEN]) == tg, bar);
            __builtin_amdgcn_fence(__ATOMIC_ACQUIRE, "agent");
            xb_add(&bar[XB_XGEN(b.x)], 1u);
            asm volatile("s_waitcnt vmcnt(0)" ::: "memory");
        } else {
            XB_SPIN(xb_ld(&bar[XB_XGEN(b.x)]) == gen, bar);
            __builtin_amdgcn_fence(__ATOMIC_ACQUIRE, "agent");
            asm volatile("s_waitcnt vmcnt(0)" ::: "memory");
        }
    }
    __syncthreads();
}

struct Args { const float* in[28]; float* out; unsigned char* ws; int ph_lo, ph_hi, li, pad; };

__device__ __forceinline__ void p0_transpose_item(const float* W, const float* sc, int K, int N, bf16_t* WT, LAS float* scr, int item, int lane) {
    const int nblk = N / 32, kb = item / nblk, nb = item % nblk, k0 = 64 * kb, n0 = 32 * nb;
#pragma unroll 8
    for (int i = 0; i < 32; ++i) { const int kk = 2 * i + (lane >> 5); const float s = sc ? sc[k0 + kk] : 1.f; scr[kk * 33 + (lane & 31)] = W[(size_t)(k0 + kk) * N + n0 + (lane & 31)] * s; }
    LDS_WAIT(); asm volatile("" ::: "memory");
    const int c = lane & 7;
#pragma unroll
    for (int j = 0; j < 4; ++j) { const int n = (lane >> 3) + 8 * j; const LAS float* s = scr + (8 * c) * 33 + n;
        v4u o; o.x = pg8::cvt_pk_bf16(s[0 * 33], s[1 * 33]); o.y = pg8::cvt_pk_bf16(s[2 * 33], s[3 * 33]); o.z = pg8::cvt_pk_bf16(s[4 * 33], s[5 * 33]); o.w = pg8::cvt_pk_bf16(s[6 * 33], s[7 * 33]);
        *(v4u*)(WT + (size_t)(n0 + n) * K + k0 + 8 * c) = o; }
    LDS_WAIT(); asm volatile("" ::: "memory");
}
typedef unsigned v6u_t __attribute__((ext_vector_type(6)));
typedef unsigned v3u_t __attribute__((ext_vector_type(3)));
typedef float v16f_t __attribute__((ext_vector_type(16)));
typedef float v32f_t __attribute__((ext_vector_type(32)));
__device__ __forceinline__ void p0_row_fp6(const float* in, const float* cs, unsigned char* out, float* sc, int lane) {
    f32x4 v[4]; float mx = 0.f;
#pragma unroll
    for (int i = 0; i < 4; ++i) { v[i] = *(const f32x4*)(in + lane * 16 + 4 * i); if (cs) v[i] = v[i] * *(const f32x4*)(cs + lane * 16 + 4 * i);
        mx = fmaxf(mx, fmaxf(fmaxf(fabsf(v[i][0]), fabsf(v[i][1])), fmaxf(fabsf(v[i][2]), fabsf(v[i][3])))); }
#pragma unroll
    for (int o = 1; o < 64; o <<= 1) mx = fmaxf(mx, __shfl_xor(mx, o));
    mx = fmaxf(mx, 1e-30f);
    const float q = 7.5f / mx;
    v16f_t a, b;
#pragma unroll
    for (int i = 0; i < 16; ++i) { a[i] = 0.f; b[i] = 0.f; }
#pragma unroll
    for (int i = 0; i < 8; ++i) { a[i] = v[(2 * i) >> 2][(2 * i) & 3] * q; b[i] = v[(2 * i + 1) >> 2][(2 * i + 1) & 3] * q; }
    const v6u_t p = __builtin_amdgcn_cvt_scalef32_2xpk16_fp6_f32(a, b, 1.0f);
    *(v3u_t*)(out + lane * 12) = (v3u_t){p[0], p[1], p[2]};
    if (lane == 0) *sc = mx * (1.f / 7.5f);
}
__device__ __forceinline__ void p0_convert(const float* in, const float* cs, bf16_t* out, size_t n, int gw, int NGW, int lane) {
    for (size_t i = ((size_t)gw * 64 + lane) * 8; i < n; i += (size_t)NGW * 512) {
        f32x4 a = *(const f32x4*)(in + i), b = *(const f32x4*)(in + i + 4);
        if (cs) { const int c = (int)(i & 1023); a = a * *(const f32x4*)(cs + c); b = b * *(const f32x4*)(cs + c + 4); }
        v4u o; o.x = pg8::cvt_pk_bf16(a[0], a[1]); o.y = pg8::cvt_pk_bf16(a[2], a[3]); o.z = pg8::cvt_pk_bf16(b[0], b[1]); o.w = pg8::cvt_pk_bf16(b[2], b[3]);
        *(v4u*)(out + i) = o;
    }
}

namespace da {
typedef short bf16x8 __attribute__((ext_vector_type(8)));
typedef short s16x4 __attribute__((ext_vector_type(4)));
typedef float f32x16 __attribute__((ext_vector_type(16)));
constexpr float LOG2E = 1.4426950408889634f;
constexpr int SLOT = 32768, SCR_OFF = 65536, COMB_OFF = 69632;
__device__ __forceinline__ int crow(int r, int hi) { return (r & 3) + 8 * (r >> 2) + 4 * hi; }
__device__ __forceinline__ s16x4 vtr(const LAS unsigned char* p) { return __builtin_bit_cast(s16x4, __builtin_amdgcn_ds_read_tr16_b64_v4i16((LAS s16x4*)p)); }

__device__ __forceinline__ void attn_unit(LAS unsigned char* lds, const bf16_t* __restrict__ z, bf16_t* __restrict__ yb, const float* __restrict__ subln_w, float lam,
                                          int b, int h, int qblk, int wave, int lane) {
    const int r32 = lane & 31, hi = lane >> 5, map = wave >> 2, qs = wave & 3;
    const int q0 = qblk * 128 + qs * 32;
    const size_t rowb = (size_t)b * SEQ;
    const float slope2 = exp2f(-2.f * (float)(h + 1)) * LOG2E;
    bf16x8 qr[4];
    {
        const bf16_t* qp = z + (rowb + q0 + r32) * NZ + C_Q + h * 128 + map * 64 + hi * 8;
        constexpr float c2 = 0.125f * LOG2E;
#pragma unroll
        for (int d0 = 0; d0 < 4; ++d0) {
            const v4u w = *(const v4u*)(qp + d0 * 16);
            v4u o; o.x = pg8::cvt_pk_bf16(pg8::bflo(w.x) * c2, pg8::bfhi(w.x) * c2); o.y = pg8::cvt_pk_bf16(pg8::bflo(w.y) * c2, pg8::bfhi(w.y) * c2);
            o.z = pg8::cvt_pk_bf16(pg8::bflo(w.z) * c2, pg8::bfhi(w.z) * c2); o.w = pg8::cvt_pk_bf16(pg8::bflo(w.w) * c2, pg8::bfhi(w.w) * c2);
            qr[d0] = __builtin_bit_cast(bf16x8, o);
        }
    }
    const int qpos = q0 + r32;
    const float qterm = slope2 * (float)(4 * hi - qpos);
    LAS float* wsf = (LAS float*)(lds + SCR_OFF) + wave * 64;
    f32x16 o[4];
#pragma unroll
    for (int d = 0; d < 4; ++d) o[d] = (f32x16){};
    float m = -1e30f, lsum = 0.f;
    const int NT = 2 * qblk + 2;
    const bf16_t* ksrc0 = z + (rowb + lane) * NZ + C_ZK + h * 128 + wave * 8;
    const int pc0 = 2 * wave, pc1 = 2 * wave + 1;
    const bf16_t* vsrc0 = z + (rowb + 16 * (pc0 & 3) + (lane >> 2)) * NZ + C_ZV + h * 128 + 32 * (pc0 >> 2) + (lane & 3) * 8;
    const bf16_t* vsrc1 = z + (rowb + 16 * (pc1 & 3) + (lane >> 2)) * NZ + C_ZV + h * 128 + 32 * (pc1 >> 2) + (lane & 3) * 8;
#define DA_STAGE(j, slot) do { const size_t _o = (size_t)(j) * 64 * NZ; LAS unsigned char* _s = lds + (slot) * SLOT; \
        __builtin_amdgcn_global_load_lds((const unsigned*)(ksrc0 + _o), (LAS unsigned*)(_s + wave * 1024), 16, 0, 0); \
        __builtin_amdgcn_global_load_lds((const unsigned*)(ksrc0 + _o + 64), (LAS unsigned*)(_s + 8192 + wave * 1024), 16, 0, 0); \
        __builtin_amdgcn_global_load_lds((const unsigned*)(vsrc0 + _o), (LAS unsigned*)(_s + 16384 + pc0 * 1024), 16, 0, 0); \
        __builtin_amdgcn_global_load_lds((const unsigned*)(vsrc1 + _o), (LAS unsigned*)(_s + 16384 + pc1 * 1024), 16, 0, 0); } while (0)
    DA_STAGE(0, 0);
    for (int j = 0; j < NT; ++j) {
        asm volatile("s_waitcnt vmcnt(0)" ::: "memory");
        __syncthreads();
        if (j + 1 < NT) DA_STAGE(j + 1, (j + 1) & 1);
        if (64 * j > q0 + 31) continue;
        const LAS unsigned char* slot = lds + (j & 1) * SLOT;
        f32x16 c0, c1;
        {
            const float tb = slope2 * (float)(64 * j) + qterm;
#pragma unroll
            for (int r = 0; r < 16; ++r) { c0[r] = tb + slope2 * (float)((r & 3) + 8 * (r >> 2)); c1[r] = c0[r] + 32.f * slope2; }
        }
        const LAS unsigned char* kb = slot + map * 8192 + hi * 1024 + r32 * 16;
#pragma unroll
        for (int d0 = 0; d0 < 4; ++d0) {
            const bf16x8 k0 = *(const LAS bf16x8*)(kb + d0 * 2048), k1 = *(const LAS bf16x8*)(kb + d0 * 2048 + 512);
            c0 = __builtin_amdgcn_mfma_f32_32x32x16_bf16(k0, qr[d0], c0, 0, 0, 0);
            c1 = __builtin_amdgcn_mfma_f32_32x32x16_bf16(k1, qr[d0], c1, 0, 0, 0);
        }
        if (64 * j + 63 > q0) {
            const int kb0 = 64 * j + 4 * hi;
#pragma unroll
            for (int r = 0; r < 16; ++r) { const int kv = kb0 + (r & 3) + 8 * (r >> 2); if (kv > qpos) c0[r] = -INFINITY; if (kv + 32 > qpos) c1[r] = -INFINITY; }
        }
        float mt = fmaxf(c0[0], c1[0]);
#pragma unroll
        for (int r = 1; r < 16; ++r) mt = fmaxf(mt, fmaxf(c0[r], c1[r]));
        mt = fmaxf(mt, __shfl_xor(mt, 32));
        float mnew = m;
        if (__any(mt > m + 8.f)) {
            mnew = fmaxf(m, mt);
            const float alpha = __builtin_amdgcn_exp2f(m - mnew);
            lsum *= alpha;
            if (hi == 0) wsf[r32] = alpha;
            float a[16];
#pragma unroll
            for (int g = 0; g < 4; ++g) { const f32x4 t = *(const LAS f32x4*)(wsf + 8 * g + 4 * hi); a[4 * g] = t[0]; a[4 * g + 1] = t[1]; a[4 * g + 2] = t[2]; a[4 * g + 3] = t[3]; }
#pragma unroll
            for (int d = 0; d < 4; ++d)
#pragma unroll
                for (int r = 0; r < 16; ++r) o[d][r] *= a[r];
        }
        m = mnew;
        float ps = 0.f;
#pragma unroll
        for (int r = 0; r < 16; ++r) { c0[r] = __builtin_amdgcn_exp2f(c0[r] - m); c1[r] = __builtin_amdgcn_exp2f(c1[r] - m); ps += c0[r] + c1[r]; }
        lsum += ps;
        v4u pw[4];
#pragma unroll
        for (int g = 0; g < 2; ++g) {
            pw[g].x = pg8::cvt_pk_bf16(c0[8 * g], c0[8 * g + 1]); pw[g].y = pg8::cvt_pk_bf16(c0[8 * g + 2], c0[8 * g + 3]); pw[g].z = pg8::cvt_pk_bf16(c0[8 * g + 4], c0[8 * g + 5]); pw[g].w = pg8::cvt_pk_bf16(c0[8 * g + 6], c0[8 * g + 7]);
            pw[2 + g].x = pg8::cvt_pk_bf16(c1[8 * g], c1[8 * g + 1]); pw[2 + g].y = pg8::cvt_pk_bf16(c1[8 * g + 2], c1[8 * g + 3]); pw[2 + g].z = pg8::cvt_pk_bf16(c1[8 * g + 4], c1[8 * g + 5]); pw[2 + g].w = pg8::cvt_pk_bf16(c1[8 * g + 6], c1[8 * g + 7]);
        }
        const LAS unsigned char* vb = slot + 16384 + ((lane >> 4) & 1) * 32 + (lane & 3) * 8 + (4 * hi + ((lane & 15) >> 2)) * 64;
#pragma unroll
        for (int d = 0; d < 4; ++d)
#pragma unroll
            for (int kg = 0; kg < 4; ++kg) {
                const s16x4 lo = vtr(vb + (d * 4 + kg) * 1024), hh = vtr(vb + (d * 4 + kg) * 1024 + 512);
                const bf16x8 vf = (bf16x8){lo[0], lo[1], lo[2], lo[3], hh[0], hh[1], hh[2], hh[3]};
                o[d] = __builtin_amdgcn_mfma_f32_32x32x16_bf16(__builtin_bit_cast(bf16x8, pw[kg]), vf, o[d], 0, 0, 0);
            }
    }
#undef DA_STAGE
    lsum += __shfl_xor(lsum, 32);
    if (hi == 0) wsf[r32] = 1.f / lsum;
    float il[16];
#pragma unroll
    for (int g = 0; g < 4; ++g) { const f32x4 t = *(const LAS f32x4*)(wsf + 8 * g + 4 * hi); il[4 * g] = t[0]; il[4 * g + 1] = t[1]; il[4 * g + 2] = t[2]; il[4 * g + 3] = t[3]; }
    LAS float* comb = (LAS float*)(lds + COMB_OFF) + qs * 4096;
    if (map == 1) {
#pragma unroll
        for (int d = 0; d < 4; ++d)
#pragma unroll
            for (int r = 0; r < 16; ++r) comb[crow(r, hi) * 128 + 32 * d + r32] = o[d][r] * il[r];
    }
    __syncthreads();
    if (map == 0) {
        float sw[4];
#pragma unroll
        for (int d = 0; d < 4; ++d) sw[d] = subln_w[32 * d + r32] * (1.f - LAM_INIT);
#pragma unroll
        for (int r = 0; r < 16; ++r) {
            float v[4], ss = 0.f;
#pragma unroll
            for (int d = 0; d < 4; ++d) { v[d] = o[d][r] * il[r] - lam * comb[crow(r, hi) * 128 + 32 * d + r32]; ss += v[d] * v[d]; }
            ss += __shfl_xor(ss, 1); ss += __shfl_xor(ss, 2); ss += __shfl_xor(ss, 4); ss += __shfl_xor(ss, 8); ss += __shfl_xor(ss, 16);
            const float rs = rsqrtf(ss * (1.f / 128.f) + SUBLN_EPS);
            bf16_t* op = yb + (rowb + q0 + crow(r, hi)) * 512 + h * 128 + r32;
#pragma unroll
            for (int d = 0; d < 4; ++d) op[32 * d] = f2bf(v[d] * rs * sw[d]);
        }
    }
    __syncthreads();
}
}

namespace rw {
typedef short bf16x8 __attribute__((ext_vector_type(8)));
typedef float f32x2 __attribute__((ext_vector_type(2)));
constexpr int CH = 32, ACT_PITCH = 528;
constexpr int OFF_ACT = 0, OFF_RKV = 16896, OFF_VEC = 41472, OFF_G = 82432, OFF_Y = 90624, OFF_NRM = 98816, OFF_SCL = 99328, OFF_CT = 99840, OFF_SCP = 102400;
template <int CTRL> __device__ __forceinline__ float dppf(float x) { return __builtin_bit_cast(float, __builtin_amdgcn_mov_dpp(__builtin_bit_cast(int, x), CTRL, 0xf, 0xf, true)); }
__device__ __forceinline__ float row_allsum(float v) { v += dppf<0x128>(v); v += dppf<0x124>(v); v += dppf<0x122>(v); v += dppf<0x121>(v); return v; }
__device__ __forceinline__ void row_allsum4(float& a, float& b, float& c, float& d) {
#define RW_DPP4(n) "v_add_f32_dpp %0, %0, %0 row_ror:" #n " row_mask:0xf bank_mask:0xf\n\tv_add_f32_dpp %1, %1, %1 row_ror:" #n " row_mask:0xf bank_mask:0xf\n\t" \
                   "v_add_f32_dpp %2, %2, %2 row_ror:" #n " row_mask:0xf bank_mask:0xf\n\tv_add_f32_dpp %3, %3, %3 row_ror:" #n " row_mask:0xf bank_mask:0xf\n\t"
    asm volatile("s_nop 1\n\t" RW_DPP4(8) RW_DPP4(4) RW_DPP4(2) RW_DPP4(1) "s_nop 1" : "+v"(a), "+v"(b), "+v"(c), "+v"(d));
#undef RW_DPP4
}
__device__ __forceinline__ f32x4 ld4bf(const bf16_t* p) { const v2u w = *(const v2u*)p; return (f32x4){pg8::bflo(w.x), pg8::bfhi(w.x), pg8::bflo(w.y), pg8::bfhi(w.y)}; }
__device__ __forceinline__ float fsig(float x) { return __builtin_amdgcn_rcpf(1.f + __expf(-x)); }
__device__ __forceinline__ float ftanh(float x) { return 1.f - 2.f * __builtin_amdgcn_rcpf(1.f + __expf(2.f * x)); }
struct ZRow { v2u r, k, v, w, a; v4u g; };
__device__ __forceinline__ ZRow ldrow(const bf16_t* zr, int c4, int cg) {
    ZRow o; o.r = *(const v2u*)(zr + C_R + c4); o.k = *(const v2u*)(zr + C_K + c4); o.v = *(const v2u*)(zr + C_V + c4); o.w = *(const v2u*)(zr + C_WL + 4 * cg); o.a = *(const v2u*)(zr + C_AL + 4 * cg);
    o.g = *(const v4u*)(zr + C_GL + 8 * cg); return o;
}
__device__ __forceinline__ f32x4 up4(v2u w) { return (f32x4){pg8::bflo(w.x), pg8::bfhi(w.x), pg8::bflo(w.y), pg8::bfhi(w.y)}; }

struct ScanP { const float *mu, *w0, *w2, *a0, *a2, *g2, *k_k, *k_a, *r_k, *lnx_w, *lnx_b; };
__device__ __forceinline__ void scan_unit(LAS unsigned char* lds, const bf16_t* __restrict__ z, bf16_t* __restrict__ ya, const ScanP P, int b, int h, int tid, int wave, int lane) {
    const float* mu = P.mu; const float* w0 = P.w0; const float* w2 = P.w2; const float* a0 = P.a0; const float* a2 = P.a2; const float* g2 = P.g2;
    const float* k_k = P.k_k; const float* k_a = P.k_a; const float* r_k = P.r_k; const float* lnx_w = P.lnx_w; const float* lnx_b = P.lnx_b;
    const size_t rowb = (size_t)b * SEQ;
    const int tl = tid >> 4, cg = tid & 15;
    const int nt = wave & 3, rl = lane & 15, rg = lane >> 4;
    LAS float* rkv = (LAS float*)(lds + OFF_RKV); LAS float* vec = (LAS float*)(lds + OFF_VEC); LAS float* gbuf = (LAS float*)(lds + OFF_G);
    LAS float* ybuf = (LAS float*)(lds + OFF_Y); LAS float* nrm = (LAS float*)(lds + OFF_NRM); LAS float* scl = (LAS float*)(lds + OFF_SCL); LAS float* scp = (LAS float*)(lds + OFF_SCP);
    bf16x8 bfr[8];
    {
        const int col = h * 64 + 16 * nt + rl;
#pragma unroll
        for (int f = 0; f < 8; ++f) {
            const float* src = (f < 2) ? w2 : (f < 4) ? a2 : g2;
            const int kb = ((f < 4) ? 32 * (f & 1) : 32 * (f - 4)) + 8 * rg;
            float e[8];
#pragma unroll
            for (int j = 0; j < 8; ++j) e[j] = src[(size_t)(kb + j) * 512 + col];
            v4u p; p.x = pg8::cvt_pk_bf16(e[0], e[1]); p.y = pg8::cvt_pk_bf16(e[2], e[3]); p.z = pg8::cvt_pk_bf16(e[4], e[5]); p.w = pg8::cvt_pk_bf16(e[6], e[7]);
            bfr[f] = __builtin_bit_cast(bf16x8, p);
        }
    }
    const int mt = wave >> 2;
    const int hc = h * 64 + 16 * nt + rl;
    const float w0c = w0[hc], a0c = a0[hc], kkc = k_k[hc], kac = k_a[hc], rkc = r_k[hc];
    const int c4 = h * 64 + 4 * cg;
    f32x2 St[4];
#pragma unroll
    for (int i = 0; i < 4; ++i) St[i] = (f32x2){0.f, 0.f};
    const int ra = 8 * wave + 2 * rg;
    LAS float* ctab = (LAS float*)(lds + OFF_CT);
    if (tl == 0) {
        LAS float* ct = ctab + cg * 36;
        *(LAS f32x4*)(ct + 0) = *(const f32x4*)(mu + C_R + c4); *(LAS f32x4*)(ct + 4) = *(const f32x4*)(mu + C_K + c4); *(LAS f32x4*)(ct + 8) = *(const f32x4*)(mu + C_V + c4);
        *(LAS f32x4*)(ct + 12) = *(const f32x4*)(mu + C_WL + 4 * cg); *(LAS f32x4*)(ct + 16) = *(const f32x4*)(mu + C_AL + 4 * cg);
        *(LAS f32x4*)(ct + 20) = *(const f32x4*)(mu + C_GL + 8 * cg); *(LAS f32x4*)(ct + 24) = *(const f32x4*)(mu + C_GL + 8 * cg + 4);
        *(LAS f32x4*)(ct + 28) = *(const f32x4*)(lnx_w + c4); *(LAS f32x4*)(ct + 32) = *(const f32x4*)(lnx_b + c4);
    }
    __syncthreads();
    const LAS float* myct = ctab + cg * 36;
    ZRow zc = ldrow(z + (rowb + tl) * NZ, c4, cg), zp;
    if (tl > 0) zp = ldrow(z + (rowb + tl - 1) * NZ, c4, cg); else { zp.r = zp.k = zp.v = zp.w = zp.a = (v2u){0u, 0u}; zp.g = (v4u){0u, 0u, 0u, 0u}; }
    for (int t0 = 0; t0 < SEQ; t0 += CH) {
        {
            const f32x4 cr = up4(zc.r), ck = up4(zc.k), cv = up4(zc.v), cw = up4(zc.w), ca = up4(zc.a);
            const f32x4 cg0 = (f32x4){pg8::bflo(zc.g.x), pg8::bfhi(zc.g.x), pg8::bflo(zc.g.y), pg8::bfhi(zc.g.y)}, cg1 = (f32x4){pg8::bflo(zc.g.z), pg8::bfhi(zc.g.z), pg8::bflo(zc.g.w), pg8::bfhi(zc.g.w)};
            const f32x4 pr = up4(zp.r), pk = up4(zp.k), pv = up4(zp.v), pw = up4(zp.w), pa = up4(zp.a);
            const f32x4 pg0 = (f32x4){pg8::bflo(zp.g.x), pg8::bfhi(zp.g.x), pg8::bflo(zp.g.y), pg8::bfhi(zp.g.y)}, pg1 = (f32x4){pg8::bflo(zp.g.z), pg8::bfhi(zp.g.z), pg8::bflo(zp.g.w), pg8::bfhi(zp.g.w)};
            if (t0 + CH < SEQ) { zc = ldrow(z + (rowb + t0 + CH + tl) * NZ, c4, cg); zp = ldrow(z + (rowb + t0 + CH + tl - 1) * NZ, c4, cg); }
            const f32x4 rs_ = cr + (pr - cr) * *(const LAS f32x4*)(myct + 0), ks_ = ck + (pk - ck) * *(const LAS f32x4*)(myct + 4), vs_ = cv + (pv - cv) * *(const LAS f32x4*)(myct + 8);
            const f32x4 ws_ = cw + (pw - cw) * *(const LAS f32x4*)(myct + 12), as_ = ca + (pa - ca) * *(const LAS f32x4*)(myct + 16);
            const f32x4 g0_ = cg0 + (pg0 - cg0) * *(const LAS f32x4*)(myct + 20), g1_ = cg1 + (pg1 - cg1) * *(const LAS f32x4*)(myct + 24);
            *(LAS f32x4*)(rkv + 0 * 2048 + tl * 64 + 4 * cg) = rs_; *(LAS f32x4*)(rkv + 1 * 2048 + tl * 64 + 4 * cg) = ks_; *(LAS f32x4*)(rkv + 2 * 2048 + tl * 64 + 4 * cg) = vs_;
            LAS unsigned char* ar = lds + OFF_ACT + tl * ACT_PITCH;
            v2u tw; tw.x = pg8::cvt_pk_bf16(ftanh(ws_[0]), ftanh(ws_[1])); tw.y = pg8::cvt_pk_bf16(ftanh(ws_[2]), ftanh(ws_[3]));
            *(LAS v2u*)(ar + 8 * cg) = tw;
            v2u aw; aw.x = pg8::cvt_pk_bf16(as_[0], as_[1]); aw.y = pg8::cvt_pk_bf16(as_[2], as_[3]);
            *(LAS v2u*)(ar + 128 + 8 * cg) = aw;
            v4u gw; gw.x = pg8::cvt_pk_bf16(fsig(g0_[0]), fsig(g0_[1])); gw.y = pg8::cvt_pk_bf16(fsig(g0_[2]), fsig(g0_[3]));
            gw.z = pg8::cvt_pk_bf16(fsig(g1_[0]), fsig(g1_[1])); gw.w = pg8::cvt_pk_bf16(fsig(g1_[2]), fsig(g1_[3]));
            *(LAS v4u*)(ar + 256 + 16 * cg) = gw;
        }
        __syncthreads();
        f32x4 accw = (f32x4){0.f, 0.f, 0.f, 0.f}, acca = accw, accg = accw;
        {
            const LAS unsigned char* ap = lds + OFF_ACT + (16 * mt + rl) * ACT_PITCH + 8 * rg * 2;
#pragma unroll
            for (int f = 0; f < 8; ++f) {
                const bf16x8 a = *(const LAS bf16x8*)(ap + f * 64);
                if (f < 2) accw = __builtin_amdgcn_mfma_f32_16x16x32_bf16(a, bfr[f], accw, 0, 0, 0);
                else if (f < 4) acca = __builtin_amdgcn_mfma_f32_16x16x32_bf16(a, bfr[f], acca, 0, 0, 0);
                else accg = __builtin_amdgcn_mfma_f32_16x16x32_bf16(a, bfr[f], accg, 0, 0, 0);
            }
        }
        float dec[4], av[4], kk[4];
        {
            const int c = 16 * nt + rl;
            float n2[4];
#pragma unroll
            for (int r = 0; r < 4; ++r) {
                const int tok = 16 * mt + 4 * rg + r;
                gbuf[tok * 64 + c] = accg[r];
                const float nx = -(w0c + accw[r]);
                const float sp = nx > 20.f ? nx : __logf(1.f + __expf(nx));
                dec[r] = __expf(-__expf(-sp - 0.5f));
                av[r] = fsig(a0c + acca[r]);
                kk[r] = rkv[1 * 2048 + tok * 64 + c] * kkc;
                n2[r] = kk[r] * kk[r];
            }
            row_allsum4(n2[0], n2[1], n2[2], n2[3]);
            if (rl == 0) {
#pragma unroll
                for (int r = 0; r < 4; ++r) nrm[(16 * mt + 4 * rg + r) * 4 + nt] = n2[r];
            }
        }
        __syncthreads();
        {
            const int c = 16 * nt + rl;
#pragma unroll
            for (int r = 0; r < 4; ++r) {
                const int tok = 16 * mt + 4 * rg + r;
                const f32x4 n4 = *(const LAS f32x4*)(nrm + tok * 4);
                const float ksv = rkv[1 * 2048 + tok * 64 + c], rsv = rkv[0 * 2048 + tok * 64 + c];
                const float inv = __builtin_amdgcn_rcpf(fmaxf(sqrtf((n4[0] + n4[1]) + (n4[2] + n4[3])), 1e-12f));
                const float kkn = kk[r] * inv, beta = kkn * av[r], kmod = ksv * (1.f + (av[r] - 1.f) * kac);
                LAS float* vp = vec + tok * 320 + c;
                vp[0] = dec[r]; vp[64] = beta; vp[128] = -kkn; vp[192] = kmod; vp[256] = dec[r] * rsv;
                float pbr = beta * rsv, pkr = kmod * rsv, pbo = rsv * kmod * rkc, dum = 0.f;
                row_allsum4(pbr, pkr, pbo, dum);
                if (rl == 0) *(LAS f32x4*)(scp + (tok * 4 + nt) * 4) = (f32x4){pbr, pkr, pbo, 0.f};
            }
        }
        __syncthreads();
        if (tid < CH) {
            const f32x4 p0 = *(const LAS f32x4*)(scp + tid * 16), p1 = *(const LAS f32x4*)(scp + tid * 16 + 4), p2 = *(const LAS f32x4*)(scp + tid * 16 + 8), p3 = *(const LAS f32x4*)(scp + tid * 16 + 12);
            *(LAS f32x4*)(scl + 4 * tid) = (p0 + p1) + (p2 + p3);
        }
        __syncthreads();
        {
            const LAS float* vb0 = vec + 4 * rl; const LAS float* rv0 = rkv + 2 * 2048 + ra;
#define RW_DECL(P) f32x4 d4##P, b4##P, n4##P, k4##P, q4##P; f32x2 v2##P, s2##P
#define RW_LOAD(P, tk_) do { d4##P = *(const LAS f32x4*)(vb0 + (tk_) * 320); b4##P = *(const LAS f32x4*)(vb0 + (tk_) * 320 + 64); n4##P = *(const LAS f32x4*)(vb0 + (tk_) * 320 + 128); \
                k4##P = *(const LAS f32x4*)(vb0 + (tk_) * 320 + 192); q4##P = *(const LAS f32x4*)(vb0 + (tk_) * 320 + 256); \
                v2##P = *(const LAS f32x2*)(rv0 + (tk_) * 64); s2##P = *(const LAS f32x2*)(scl + (tk_) * 4); } while (0)
#define RW_STEP(P, tk_) do { \
                f32x2 sa = St[0] * n4##P[0] + St[1] * n4##P[1] + St[2] * n4##P[2] + St[3] * n4##P[3]; \
                f32x2 yy = St[0] * q4##P[0] + St[1] * q4##P[1] + St[2] * q4##P[2] + St[3] * q4##P[3]; \
                float sa0 = sa[0], sa1 = sa[1], yy0 = yy[0], yy1 = yy[1]; \
                row_allsum4(sa0, sa1, yy0, yy1); \
                sa = (f32x2){sa0, sa1}; \
                _Pragma("unroll") for (int i = 0; i < 4; ++i) St[i] = St[i] * d4##P[i] + sa * b4##P[i] + v2##P * k4##P[i]; \
                const f32x2 yo = (f32x2){yy0, yy1} + sa * s2##P[0] + v2##P * s2##P[1]; \
                if (rl == 0) *(LAS f32x2*)(ybuf + (tk_) * 64 + ra) = yo; } while (0)
            RW_DECL(A); RW_DECL(B);
            RW_LOAD(A, 0);
            for (int tk = 0; tk < CH; tk += 2) {
                RW_LOAD(B, tk + 1);
                RW_STEP(A, tk);
                if (tk + 2 < CH) RW_LOAD(A, tk + 2);
                RW_STEP(B, tk + 1);
            }
#undef RW_DECL
#undef RW_LOAD
#undef RW_STEP
        }
        __syncthreads();
        {
            const f32x4 y4 = *(const LAS f32x4*)(ybuf + tl * 64 + 4 * cg);
            const float mean = row_allsum((y4[0] + y4[1]) + (y4[2] + y4[3])) * (1.f / 64.f);
            const f32x4 dv = y4 - mean;
            const float var = row_allsum((dv[0] * dv[0] + dv[1] * dv[1]) + (dv[2] * dv[2] + dv[3] * dv[3])) * (1.f / 64.f);
            const float rs_ = rsqrtf(var + GN_EPS);
            const f32x4 yn = dv * rs_ * *(const LAS f32x4*)(myct + 28) + *(const LAS f32x4*)(myct + 32);
            const float bonus = scl[tl * 4 + 2];
            const f32x4 vs_ = *(const LAS f32x4*)(rkv + 2 * 2048 + tl * 64 + 4 * cg), g4 = *(const LAS f32x4*)(gbuf + tl * 64 + 4 * cg);
            const f32x4 o = (yn + vs_ * bonus) * g4;
            v2u w; w.x = pg8::cvt_pk_bf16(o[0], o[1]); w.y = pg8::cvt_pk_bf16(o[2], o[3]);
            *(v2u*)(ya + (rowb + t0 + tl) * 512 + c4) = w;
        }
        __syncthreads();
    }
}
}

typedef __bf16 bf16x2_t __attribute__((ext_vector_type(2)));
__device__ __forceinline__ float dot2bf(unsigned a, unsigned b, float c) { return __builtin_amdgcn_fdot2_f32_bf16(__builtin_bit_cast(bf16x2_t, a), __builtin_bit_cast(bf16x2_t, b), c, false); }
__device__ __forceinline__ unsigned f2ord(float f) { const unsigned u = __float_as_uint(f); return (u & 0x80000000u) ? ~u : (u | 0x80000000u); }
__device__ __forceinline__ float ord2f(unsigned o) { return __uint_as_float((o & 0x80000000u) ? (o ^ 0x80000000u) : ~o); }
__device__ __forceinline__ unsigned row_allmax_u32(unsigned v) {
    v = max(v, (unsigned)__builtin_amdgcn_update_dpp(0, (int)v, 0x128, 0xf, 0xf, false));
    v = max(v, (unsigned)__builtin_amdgcn_update_dpp(0, (int)v, 0x124, 0xf, 0xf, false));
    v = max(v, (unsigned)__builtin_amdgcn_update_dpp(0, (int)v, 0x122, 0xf, 0xf, false));
    v = max(v, (unsigned)__builtin_amdgcn_update_dpp(0, (int)v, 0x121, 0xf, 0xf, false));
    return v;
}

constexpr int TK_PITCH = 272, TK_HALF = 128 * TK_PITCH;
typedef short tk_bf16x8 __attribute__((ext_vector_type(8)));
__device__ __forceinline__ void topk_loadq(tk_bf16x8 (&qa)[8], const bf16_t* __restrict__ qb, int t0, int h, int lane) {
    const bf16_t* qp = qb + (size_t)(t0 + (lane & 15)) * 2048 + h * 256 + 8 * (lane >> 4);
#pragma unroll
    for (int i = 0; i < 8; ++i) qa[i] = *(const tk_bf16x8*)(qp + i * 32);
}
__device__ __forceinline__ void topk_item(const tk_bf16x8 (&qa)[8], const LAS unsigned char* klds, int* __restrict__ ids, float* __restrict__ gates, int t0, int h, int lane) {
    const int rl = lane & 15, rg = lane >> 4;
    unsigned top[2][4];
#pragma unroll
    for (int c = 0; c < 2; ++c) {
        f32x4 acc[8];
#pragma unroll
        for (int nt = 0; nt < 8; ++nt) acc[nt] = (f32x4){64.f, 64.f, 64.f, 64.f};
        const LAS unsigned char* kp = klds + c * TK_HALF + rl * TK_PITCH + 16 * rg;
#pragma unroll
        for (int ks = 0; ks < 4; ++ks) {
#pragma unroll
            for (int nt = 0; nt < 8; ++nt) { const tk_bf16x8 b = *(const LAS tk_bf16x8*)(kp + nt * 16 * TK_PITCH + ks * 64); acc[nt] = __builtin_amdgcn_mfma_f32_16x16x32_bf16(qa[c * 4 + ks], b, acc[nt], 0, 0, 0); }
            __builtin_amdgcn_sched_barrier(0);
        }
        unsigned k[4][8];
#pragma unroll
        for (int r = 0; r < 4; ++r) {
#pragma unroll
            for (int nt = 0; nt < 8; ++nt) k[r][nt] = (__float_as_uint(fmaxf(acc[nt][r], 1.f)) & ~127u) | (unsigned)(127 - (nt * 16 + rl));
#define TK_CE(i, j) do { const unsigned a_ = max(k[r][i], k[r][j]), b_ = min(k[r][i], k[r][j]); k[r][i] = a_; k[r][j] = b_; } while (0)
            TK_CE(0, 1); TK_CE(2, 3); TK_CE(4, 5); TK_CE(6, 7); TK_CE(0, 2); TK_CE(1, 3); TK_CE(4, 6); TK_CE(5, 7); TK_CE(1, 2); TK_CE(5, 6);
            TK_CE(0, 4); TK_CE(1, 5); TK_CE(2, 6); TK_CE(3, 7); TK_CE(2, 4); TK_CE(3, 5); TK_CE(1, 2); TK_CE(3, 4); TK_CE(5, 6);
#undef TK_CE
        }
        unsigned tp[4] = {0u, 0u, 0u, 0u};
        for (int round = 0; round < 16; ++round) {
#pragma unroll
            for (int r = 0; r < 4; ++r) {
                const unsigned m = row_allmax_u32(k[r][0]);
                tp[r] = (rl == round) ? m : tp[r];
                const bool win = (k[r][0] == m);
                k[r][0] = win ? k[r][1] : k[r][0]; k[r][1] = win ? k[r][2] : k[r][1]; k[r][2] = win ? k[r][3] : k[r][2]; k[r][3] = win ? k[r][4] : k[r][3];
                k[r][4] = win ? k[r][5] : k[r][4]; k[r][5] = win ? k[r][6] : k[r][5]; k[r][6] = win ? k[r][7] : k[r][6]; k[r][7] = win ? 0u : k[r][7];
            }
        }
#pragma unroll
        for (int r = 0; r < 4; ++r) top[c][r] = tp[r];
    }
    const int rowbase = lane & 48;
    float v1[4]; int n1[4], ptr[4], myid[4]; unsigned k2[4], myv[4];
#pragma unroll
    for (int r = 0; r < 4; ++r) { v1[r] = __uint_as_float(top[0][r] & ~127u); n1[r] = 127 - (int)(top[0][r] & 127u); ptr[r] = 0; k2[r] = (unsigned)__builtin_amdgcn_ds_bpermute(rowbase * 4, (int)top[1][r]); myid[r] = 0; myv[r] = 0u; }
    for (int round = 0; round < 16; ++round) {
#pragma unroll
        for (int r = 0; r < 4; ++r) {
            const float head = v1[r] + __uint_as_float(k2[r] & ~127u);
            const unsigned key = (ptr[r] < 16) ? ((__float_as_uint(head) & ~15u) | (unsigned)(15 - rl)) : 0u;
            const unsigned m = row_allmax_u32(key);
            const bool win = (key == m);
            const unsigned wid = row_allmax_u32(win ? (unsigned)(n1[r] * 128 + (127 - (int)(k2[r] & 127u))) + 1u : 0u);
            myid[r] = (rl == round) ? (int)wid - 1 : myid[r];
            myv[r] = (rl == round) ? m : myv[r];
            ptr[r] += win ? 1 : 0;
            k2[r] = (unsigned)__builtin_amdgcn_ds_bpermute((rowbase + (ptr[r] & 15)) * 4, (int)top[1][r]);
        }
    }
#pragma unroll
    for (int r = 0; r < 4; ++r) {
        const float val = __uint_as_float(myv[r] & ~15u);
        const float vmax = __uint_as_float((unsigned)__builtin_amdgcn_ds_bpermute(rowbase * 4, (int)__float_as_uint(val)));
        const float e = __expf(val - vmax);
        const float sum = rw::row_allsum(e);
        gates[(size_t)(t0 + 4 * rg + r) * 128 + h * 16 + rl] = e / sum; ids[(size_t)(t0 + 4 * rg + r) * 128 + h * 16 + rl] = myid[r];
    }
}

typedef float f32x2 __attribute__((ext_vector_type(2)));
__device__ __forceinline__ void peer_token(const bf16_t* __restrict__ x2b, const float* __restrict__ ssq2, const int* __restrict__ ids, const float* __restrict__ gates,
                                           const unsigned char* __restrict__ U8, const unsigned char* __restrict__ V8, const float* __restrict__ usc, const float* __restrict__ vsc,
                                           const float* __restrict__ fw, float* __restrict__ out, int t, int lane) {
    const int l16 = lane * 16;
    f32x2 hx[8];
    {
        const v4u h0 = *(const v4u*)(x2b + (size_t)t * DM + l16), h1 = *(const v4u*)(x2b + (size_t)t * DM + l16 + 8);
        const unsigned hw[8] = {h0.x, h0.y, h0.z, h0.w, h1.x, h1.y, h1.z, h1.w};
#pragma unroll
        for (int i = 0; i < 8; ++i) hx[i] = (f32x2){pg8::bflo(hw[i]), pg8::bfhi(hw[i])};
    }
    const int idA = ids[(size_t)t * 128 + lane], idB = ids[(size_t)t * 128 + 64 + lane];
    const float rs = rsqrtf(pg8::ssq_sum16(ssq2 + (size_t)t * 16) * (1.f / DM) + NORM_EPS);
    const float suA = rs * usc[idA], suB = rs * usc[idB];
    const float svA = gates[(size_t)t * 128 + lane] * vsc[idA], svB = gates[(size_t)t * 128 + 64 + lane] * vsc[idB];
    f32x2 y[8];
#pragma unroll
    for (int i = 0; i < 8; ++i) y[i] = (f32x2){0.f, 0.f};
    const int bit0 = lane & 1, bit1 = (lane >> 1) & 1, bit2 = (lane >> 2) & 1;
    const int myk = 4 * bit0 + 2 * bit1 + bit2;
    for (int g = 0; g < 16; ++g) {
        const int idsel = (g < 8) ? idA : idB; const float susel = (g < 8) ? suA : suB, svsel = (g < 8) ? svA : svB; const int lb = (g * 8) & 63;
        v3u_t uw[8], vw[8];
#pragma unroll
        for (int k = 0; k < 8; ++k) { const int e = __builtin_amdgcn_readlane(idsel, lb + k); uw[k] = *(const v3u_t*)(U8 + (size_t)e * 768 + lane * 12); vw[k] = *(const v3u_t*)(V8 + (size_t)e * 768 + lane * 12); }
        float d[8];
#pragma unroll
        for (int k = 0; k < 8; ++k) {
            const v32f_t f = __builtin_amdgcn_cvt_scalef32_pk32_f32_fp6((v6u_t){uw[k][0], uw[k][1], uw[k][2], 0u, 0u, 0u}, 1.0f);
            f32x2 a = (f32x2){0.f, 0.f};
#pragma unroll
            for (int i = 0; i < 8; ++i) a += (f32x2){f[2 * i], f[2 * i + 1]} * hx[i];
            d[k] = a[0] + a[1];
            __builtin_amdgcn_sched_barrier(0);
        }
        float r4[4];
#pragma unroll
        for (int k = 0; k < 4; ++k) { const float send = bit0 ? d[k] : d[k + 4], keep = bit0 ? d[k + 4] : d[k]; r4[k] = keep + __shfl_xor(send, 1); }
        float r2[2];
#pragma unroll
        for (int k = 0; k < 2; ++k) { const float send = bit1 ? r4[k] : r4[k + 2], keep = bit1 ? r4[k + 2] : r4[k]; r2[k] = keep + __shfl_xor(send, 2); }
        float r1;
        { const float send = bit2 ? r2[0] : r2[1], keep = bit2 ? r2[1] : r2[0]; r1 = keep + __shfl_xor(send, 4); }
        r1 += __shfl_xor(r1, 8); r1 += __shfl_xor(r1, 16); r1 += __shfl_xor(r1, 32);
        const float dd = r1 * __shfl(susel, lb + myk);
        const float act = 0.5f * dd * (1.f + erff(dd * 0.70710678118654752f)) * __shfl(svsel, lb + myk);
#pragma unroll
        for (int k = 0; k < 8; ++k) {
            const float a = __uint_as_float((unsigned)__builtin_amdgcn_readlane((int)__float_as_uint(act), ((k & 1) << 2) | (k & 2) | ((k >> 2) & 1)));
            const f32x2 a2 = (f32x2){a, a};
            const v32f_t f = __builtin_amdgcn_cvt_scalef32_pk32_f32_fp6((v6u_t){vw[k][0], vw[k][1], vw[k][2], 0u, 0u, 0u}, 1.0f);
#pragma unroll
            for (int i = 0; i < 8; ++i) y[i] += (f32x2){f[2 * i], f[2 * i + 1]} * a2;
            __builtin_amdgcn_sched_barrier(0);
        }
    }
    float* orow = out + (size_t)t * DM + l16;
    float ss = 0.f;
    f32x4 o4[4];
#pragma unroll
    for (int i = 0; i < 4; ++i) { o4[i] = (f32x4){hx[2 * i][0] + y[2 * i][0], hx[2 * i][1] + y[2 * i][1], hx[2 * i + 1][0] + y[2 * i + 1][0], hx[2 * i + 1][1] + y[2 * i + 1][1]};
        ss += (o4[i][0] * o4[i][0] + o4[i][1] * o4[i][1]) + (o4[i][2] * o4[i][2] + o4[i][3] * o4[i][3]); }
    ss = wave_sum(ss);
    const float r = rsqrtf(ss * (1.f / DM) + NORM_EPS);
#pragma unroll
    for (int i = 0; i < 4; ++i) *(f32x4*)(orow + 4 * i) = o4[i] * r * *(const f32x4*)(fw + l16 + 4 * i);
}

__global__ void __launch_bounds__(NWAVES * 64, 2) mk_fwd(Args args) {
    extern __shared__ __attribute__((aligned(16))) unsigned char lds_raw[];
    LAS unsigned char* lds = (LAS unsigned char*)lds_raw;
    volatile LAS unsigned* MISC = (volatile LAS unsigned*)(lds + MISC_OFF);
    const int tid = threadIdx.x, lane = tid & 63, wave = __builtin_amdgcn_readfirstlane(tid >> 6);
    const int G = gridDim.x; const int bx = blockIdx.x; const int vcu = (G % 8 == 0) ? (bx % 8) * (G / 8) + bx / 8 : bx;
    unsigned char* ws = args.ws;
    unsigned* ctl = (unsigned*)(ws + WS_CTL);
    for (int u = tid; u < (LDS_BYTES - LDSCTL_OFF) / 4; u += NWAVES * 64) ((LAS unsigned*)(lds + LDSCTL_OFF))[u] = 0u;
    __syncthreads();
    XcdBarrier bar = xcd_barrier_post(ctl + CW_BAR + args.li * XCD_BAR_WORDS, MISC + 8);
    const int lo = args.ph_lo, hi = args.ph_hi;
#define IN(k) (lo <= (k) && (k) < hi)
#define BOTH(k) (IN(k) && IN((k) + 1))
    bf16_t* WinT = (bf16_t*)(ws + WS_WIN); bf16_t* PaT = (bf16_t*)(ws + WS_PA); bf16_t* PbT = (bf16_t*)(ws + WS_PB); bf16_t* WoT = (bf16_t*)(ws + WS_WO);
    bf16_t* WqT = (bf16_t*)(ws + WS_WQ); bf16_t* KeysB = (bf16_t*)(ws + WS_KEYS);
    float* rstd1 = (float*)(ws + WS_RSTD1); float* ssq2 = (float*)(ws + WS_RSTD2); float* scal = (float*)(ws + WS_SCAL);
    unsigned char* U8 = ws + WS_U; unsigned char* V8 = ws + WS_V; float* usc = (float*)(ws + WS_USC); float* vsc = (float*)(ws + WS_VSC);
    bf16_t* xb = (bf16_t*)(ws + WS_XB); bf16_t* ya = (bf16_t*)(ws + WS_YA); bf16_t* yb = (bf16_t*)(ws + WS_YB); bf16_t* x2b = (bf16_t*)(ws + WS_X2B);
    bf16_t* z = (bf16_t*)(ws + WS_Z); bf16_t* qb = (bf16_t*)(ws + WS_Q);
    bf16_t* merged = (bf16_t*)(ws + WS_MERGED);
    const int gw = vcu * NWAVES + wave, NGW = G * NWAVES;

    if (IN(0)) {
        LAS float* scr = (LAS float*)(lds + wave * 16384);
        constexpr int I_IN = (DM / 64) * (NZ / 32), I_PA = (512 / 64) * (DM / 32), I_WO = (DM / 64) * (DM / 32), I_WQ = (DM / 64) * (2048 / 32);
        constexpr int NITEMS = I_IN + 2 * I_PA + I_WO + I_WQ;
        for (int it = gw; it < NITEMS; it += NGW) {
            int r = it;
            if (r < I_IN) { p0_transpose_item(args.in[2], args.in[1], DM, NZ, WinT, scr, r, lane); continue; } r -= I_IN;
            if (r < I_PA) { p0_transpose_item(args.in[19], nullptr, 512, DM, PaT, scr, r, lane); continue; } r -= I_PA;
            if (r < I_PA) { p0_transpose_item(args.in[20], nullptr, 512, DM, PbT, scr, r, lane); continue; } r -= I_PA;
            if (r < I_WO) { p0_transpose_item(args.in[21], nullptr, DM, DM, WoT, scr, r, lane); continue; } r -= I_WO;
            p0_transpose_item(args.in[23], args.in[22], DM, 2048, WqT, scr, r, lane);
        }
        p0_convert(args.in[24], nullptr, KeysB, (size_t)16 * 128 * 128, gw, NGW, lane);
        for (int e = gw; e < 2 * NEXP; e += NGW) {
            const bool isu = e < NEXP; const int row = isu ? e : e - NEXP;
            p0_row_fp6((isu ? args.in[25] : args.in[26]) + (size_t)row * DM, isu ? args.in[22] : nullptr, (isu ? U8 : V8) + (size_t)row * 768, (isu ? usc : vsc) + row, lane);
        }
        for (int m = gw; m < T_TOK; m += NGW) {
            const f32x4* xr = (const f32x4*)(args.in[0] + (size_t)m * DM) + lane;
            f32x4 v[4]; float s = 0.f;
#pragma unroll
            for (int j = 0; j < 4; ++j) { v[j] = xr[64 * j]; s += (v[j][0] * v[j][0] + v[j][1] * v[j][1]) + (v[j][2] * v[j][2] + v[j][3] * v[j][3]); }
            s = wave_sum(s);
            v2u* o8 = (v2u*)(xb + (size_t)m * DM) + lane;
#pragma unroll
            for (int j = 0; j < 4; ++j) { v2u w; w.x = pg8::cvt_pk_bf16(v[j][0], v[j][1]); w.y = pg8::cvt_pk_bf16(v[j][2], v[j][3]); o8[64 * j] = w; }
            if (lane == 0) rstd1[m] = rsqrtf(s * (1.f / DM) + NORM_EPS);
        }
        if (gw == 0) {
            const float a = wave_sum(args.in[14][lane] * args.in[15][lane]), b = wave_sum(args.in[16][lane] * args.in[17][lane]);
            if (lane == 0) scal[0] = __expf(a) - __expf(b) + LAM_INIT;
        }
        if (BOTH(0)) xcd_barrier(bar);
    }
    if (IN(1)) {
        pg8::Gemm g{xb, WinT, DM, DM, DM}; pg8::StaticOrder S; S.init(T_TOK, NZ, G, bx);
        pg8::EpiRowScale<false> E{z, NZ, rstd1};
        for (int rep = 0; rep < REPS(1); ++rep) pg8::gemm_phase(lds, g, S, E);
        if (BOTH(1)) xcd_barrier(bar);
    }
    if (IN(2)) {
        {
            const rw::ScanP P{args.in[3], args.in[4], args.in[5], args.in[6], args.in[7], args.in[8], args.in[9], args.in[10], args.in[11], args.in[12], args.in[13]};
            for (int rep = 0; rep < REPS(2); ++rep) for (int u = vcu; u < NB * 8; u += G) rw::scan_unit(lds, z, ya, P, u >> 3, u & 7, tid, wave, lane);
        }
        const float lam = scal[0];
        for (int rep = 0; rep < REPS(10); ++rep) for (int i = 0;; ++i) {
            const int idx = vcu + i * G; if (idx >= 2048) break;
            const int slot = idx >> 8, v = idx & 255, bh = v >> 1, a = (v & 1) * 4 + (slot >> 1), qblk = (slot & 1) ? 15 - a : a;
            da::attn_unit(lds, z, yb, args.in[18], lam, bh >> 2, bh & 3, qblk, wave, lane);
        }
        if (BOTH(2)) xcd_barrier(bar);
    }
    if (IN(3)) {
        pg8::Gemm g{ya, PaT, 512, 512, 512}; pg8::StaticOrder S; S.init(T_TOK, DM, G, bx);
        pg8::EpiGate<false> E{merged, z, C_GA};
        pg8::gemm_phase(lds, g, S, E);
        if (BOTH(3)) xcd_barrier(bar);
    }
    if (IN(4)) {
        pg8::Gemm g{yb, PbT, 512, 512, 512}; pg8::StaticOrder S; S.init(T_TOK, DM, G, bx);
        pg8::EpiGate<true> E{merged, z, C_GB};
        pg8::gemm_phase(lds, g, S, E);
        if (BOTH(4)) xcd_barrier(bar);
    }
    if (IN(5)) {
        pg8::Gemm g{merged, WoT, DM, DM, DM}; pg8::StaticOrder S; S.init(T_TOK, DM, G, bx);
        pg8::EpiX2 E{args.in[0], args.out, x2b, ssq2};
        pg8::gemm_phase(lds, g, S, E);
        if (BOTH(5)) xcd_barrier(bar);
    }
    if (IN(6)) {
        pg8::Gemm g{x2b, WqT, DM, DM, DM}; pg8::StaticOrder S; S.init(T_TOK, 2048, G, bx);
        pg8::EpiRowScale<true> E{qb, 2048, ssq2};
        for (int rep = 0; rep < REPS(6); ++rep) pg8::gemm_phase(lds, g, S, E);
        if (BOTH(6)) xcd_barrier(bar);
    }
    if (IN(7)) {
        int* ids = (int*)(ws + WS_IDS); float* gates = (float*)(ws + WS_GATES);
        for (int rep = 0; rep < REPS(7); ++rep)
        for (int h = 0; h < 8; ++h) {
            __syncthreads();
            {
                const bf16_t* ksrc = KeysB + (size_t)h * 2 * 128 * 128;
#pragma unroll
                for (int i = 0; i < 8; ++i) { const int chunk = tid + i * 512, row = chunk >> 4, cc = chunk & 15;
                    *(LAS v4u*)(lds + (row >> 7) * TK_HALF + (row & 127) * TK_PITCH + cc * 16) = *(const v4u*)(ksrc + (size_t)row * 128 + cc * 8); }
            }
            __syncthreads();
            for (int tile = gw; tile < 4096; tile += NGW) {
                tk_bf16x8 qa[8];
                topk_loadq(qa, qb, tile * 16, h, lane);
                topk_item(qa, lds, ids, gates, tile * 16, h, lane);
            }
        }
        if (BOTH(7)) xcd_barrier(bar);
    }
    if (IN(8)) {
        const int* ids = (const int*)(ws + WS_IDS); const float* gates = (const float*)(ws + WS_GATES);
        for (int t = gw; t < T_TOK; t += NGW) peer_token(x2b, ssq2, ids, gates, U8, V8, usc, vsc, args.in[27], args.out, t, lane);
    }
#undef IN
#undef BOTH
}

extern "C" void kernel_launch(void* const* d_in, const int* in_sizes, int n_in, void* d_out, int out_size, void* d_ws, size_t ws_size, hipStream_t stream) {
    static int grid = 0;
    if (grid == 0) {
        if (n_in != 28 || in_sizes[0] != T_TOK * DM || out_size != T_TOK * DM || ws_size < WS_END) {
            fprintf(stderr, "kernel_launch: unexpected shapes / workspace (n_in %d, ws %zu < %zu)\n", n_in, ws_size, (size_t)WS_END); grid = -1; return; }
        int dev = 0, cus = 0;
        if (hipGetDevice(&dev) != hipSuccess || hipDeviceGetAttribute(&cus, hipDeviceAttributeMultiprocessorCount, dev) != hipSuccess) { grid = -1; return; }
        if (hipFuncSetAttribute((const void*)mk_fwd, hipFuncAttributeMaxDynamicSharedMemorySize, LDS_BYTES) != hipSuccess) { fprintf(stderr, "kernel_launch: hipFuncSetAttribute failed\n"); grid = -1; return; }
        grid = cus;
    }
    if (grid < 0) return;
    unsigned char* ws = (unsigned char*)d_ws;
    float* out = (float*)d_out;
    (void)hipMemsetAsync(ws + WS_CTL, 0, 1 * MiB, stream);
    Args a{};
    for (int i = 0; i < 28; ++i) a.in[i] = (const float*)d_in[i];
    a.out = out; a.ws = ws;
    a.ph_lo = 0; a.ph_hi = 9; a.li = 0;
    hipLaunchKernelGGL(mk_fwd, dim3(grid), dim3(NWAVES * 64), LDS_BYTES, stream, a);
}
```

```cpp
#include <hip/hip_runtime.h>
#include <stdint.h>
#include <cstdio>

typedef unsigned short bf16_t;
typedef unsigned int u32;

#ifndef PROBE_REP
#define PROBE_REP 0
#endif
#define REPS(k) (((PROBE_REP >> (k)) & 1) ? 2 : 1)
constexpr int T_TOK = 65536, DM = 1024, SEQ = 2048, NB = 32;
constexpr int NZ = 5376;
constexpr int C_R = 0, C_K = 512, C_V = 1024, C_WL = 1536, C_AL = 1600, C_GL = 1664, C_Q = 1792, C_ZK = 2304, C_ZV = 2816, C_GA = 3328, C_GB = 4352;
constexpr int NEXP = 16384;
constexpr float NORM_EPS = 1e-6f, GN_EPS = 64e-5f, SUBLN_EPS = 1e-5f;
constexpr float LAM_INIT = 0.2f;

constexpr size_t MiB = 1u << 20;
constexpr size_t WS_CTL = 0;
constexpr size_t WS_WIN = 1 * MiB;
constexpr size_t WS_PA = 12 * MiB;
constexpr size_t WS_PB = 13 * MiB;
constexpr size_t WS_WO = 14 * MiB;
constexpr size_t WS_WQ = 16 * MiB;
constexpr size_t WS_KEYS = 20 * MiB;
constexpr size_t WS_RSTD1 = 21 * MiB;
constexpr size_t WS_RSTD2 = 58 * MiB;
constexpr size_t WS_SCAL = 23 * MiB;
constexpr size_t WS_U = 24 * MiB;
constexpr size_t WS_V = 40 * MiB;
constexpr size_t WS_USC = 56 * MiB;
constexpr size_t WS_VSC = 57 * MiB;
constexpr size_t WS_XB = 88 * MiB;
constexpr size_t WS_YA = WS_XB;
constexpr size_t WS_YB = WS_XB + 64 * MiB;
constexpr size_t WS_X2B = WS_XB;
constexpr size_t WS_Z = 216 * MiB;
constexpr size_t WS_Q = WS_Z;
constexpr size_t WS_IDS = WS_Z + 256 * MiB;
constexpr size_t WS_GATES = WS_Z + 288 * MiB;
constexpr size_t WS_MERGED = 888 * MiB;
constexpr size_t WS_END = 1016 * MiB;

__device__ __forceinline__ float bf2f(bf16_t h) { return __uint_as_float(((u32)h) << 16); }
__device__ __forceinline__ bf16_t f2bf(float f) { u32 u = __float_as_uint(f); u += 0x7fffu + ((u >> 16) & 1u); return (bf16_t)(u >> 16); }
__device__ __forceinline__ float wave_sum(float v) {
#pragma unroll
    for (int o = 1; o < 64; o <<= 1) v += __shfl_xor(v, o);
    return v;
}
__device__ __forceinline__ float sigmoidf_(float x) { return 1.f / (1.f + __expf(-x)); }

namespace pg8 {
#define PG8_LAS __attribute__((address_space(3)))
typedef short bf16x8 __attribute__((ext_vector_type(8)));
typedef float f32x4 __attribute__((ext_vector_type(4)));
typedef unsigned u32x4 __attribute__((ext_vector_type(4)));
constexpr int BM = 256, BK = 64, HALF = 128, HTB = HALF * BK * 2  , STAGE_BYTES = 8 * HTB, NXCD = 8, WGM = 8;

__host__ __device__ __forceinline__ int lds_byte(int r, int c) { const int st = (r >> 4) * 2 + (c >> 5), rr = r & 15, cc = c & 31, ob = rr * 64 + cc * 2; return st * 1024 + (ob ^ (((ob >> 9) & 1) << 5)); }
__host__ __device__ __forceinline__ void stage_rc(int b, int& R, int& C) { const int st = b / 1024, sb = b % 1024, swz = sb ^ (((sb >> 9) & 1) << 5); R = (st >> 1) * 16 + swz / 64; C = (st & 1) * 32 + (swz % 64) / 2; }
__host__ __device__ __forceinline__ int perm32(int rho) { const int n = rho >> 4, i = rho & 15; return 8 * (i >> 2) + 4 * n + (i & 3); }

struct Unit { int pm, pn; };
struct Gemm { const bf16_t* A; const bf16_t* Bt; int lda, ldb, K; };

struct StaticOrder {
    int nM, nN, nwg, G, c;
    __host__ __device__ void init(int M, int N, int G_, int c_) { nM = M / BM; nN = N / BM; nwg = nM * nN; G = G_; c = c_; }
    __host__ __device__ bool next(int i, Unit& u) const {
        const long L = (long)i * G + c; if (L >= nwg) return false;
        int wgid = (int)L; { const int q = nwg / NXCD, r = nwg % NXCD, xcd = wgid % NXCD, off = wgid / NXCD; wgid = (xcd < r ? xcd * (q + 1) : r * (q + 1) + (xcd - r) * q) + off; }
        const int nig = WGM * nN, gid = wgid / nig, fm = gid * WGM, gsz = (nM - fm) < WGM ? (nM - fm) : WGM;
        u.pm = fm + ((wgid % nig) % gsz); u.pn = (wgid % nig) / gsz; return true;
    }
};
typedef float f32x2_c __attribute__((ext_vector_type(2))); typedef __bf16 bf16x2_c __attribute__((ext_vector_type(2)));
__device__ __forceinline__ unsigned cvt_pk_bf16(float lo, float hi) { const f32x2_c v = {lo, hi}; const bf16x2_c b = __builtin_convertvector(v, bf16x2_c); return __builtin_bit_cast(unsigned, b); }
__device__ __forceinline__ float bflo(unsigned w) { return __uint_as_float(w << 16); }
__device__ __forceinline__ float bfhi(unsigned w) { return __uint_as_float(w & 0xffff0000u); }

__device__ __forceinline__ float ssq_sum16(const float* p) {
    const f32x4 a = *(const f32x4*)p, b = *(const f32x4*)(p + 4), c = *(const f32x4*)(p + 8), d = *(const f32x4*)(p + 12);
    return (((a[0] + a[1]) + (a[2] + a[3])) + ((b[0] + b[1]) + (b[2] + b[3]))) + (((c[0] + c[1]) + (c[2] + c[3])) + ((d[0] + d[1]) + (d[2] + d[3])));
}
template <bool SSQ> struct EpiRowScale {
    static constexpr bool PERM = true;
    bf16_t* O; int ldc; const float* rs;
    __device__ __forceinline__ void operator()(const f32x4 (&acc)[2][2][4][2], const Unit& u, int wr, int wc, int fr, int fq) const {
        const int row0 = u.pm * BM + wr * 64 + fr, col0 = u.pn * BM + wc * 32 + 8 * fq;
#pragma unroll
        for (int ai = 0; ai < 2; ++ai)
#pragma unroll
            for (int m = 0; m < 4; ++m) {
                const int row = row0 + ai * HALF + m * 16;
                float s; if (SSQ) s = rsqrtf(ssq_sum16(rs + (size_t)row * 16) * (1.f / 1024.f) + NORM_EPS); else s = rs[row];
                bf16_t* rowp = O + (size_t)row * ldc + col0;
#pragma unroll
                for (int bj = 0; bj < 2; ++bj) {
                    const f32x4 v0 = acc[ai][bj][m][0] * s, v1 = acc[ai][bj][m][1] * s;
                    u32x4 w; w.x = cvt_pk_bf16(v0[0], v0[1]); w.y = cvt_pk_bf16(v0[2], v0[3]); w.z = cvt_pk_bf16(v1[0], v1[1]); w.w = cvt_pk_bf16(v1[2], v1[3]);
                    *(u32x4*)(rowp + bj * HALF) = w;
                }
            }
    }
};
template <bool ACCUM> struct EpiGate {
    static constexpr bool PERM = true;
    bf16_t* mg; const bf16_t* z; int gcol;
    __device__ __forceinline__ void operator()(const f32x4 (&acc)[2][2][4][2], const Unit& u, int wr, int wc, int fr, int fq) const {
        const int row0 = u.pm * BM + wr * 64 + fr, col0 = u.pn * BM + wc * 32 + 8 * fq;
#pragma unroll
        for (int ai = 0; ai < 2; ++ai)
#pragma unroll
            for (int m = 0; m < 4; ++m) {
                const int row = row0 + ai * HALF + m * 16;
                const bf16_t* gp = z + (size_t)row * NZ + gcol + col0;
                bf16_t* rowp = mg + (size_t)row * DM + col0;
#pragma unroll
                for (int bj = 0; bj < 2; ++bj) {
                    const u32x4 g = *(const u32x4*)(gp + bj * HALF);
                    const f32x4 a0 = acc[ai][bj][m][0], a1 = acc[ai][bj][m][1];
                    float r[8];
                    r[0] = sigmoidf_(bflo(g.x)) * a0[0]; r[1] = sigmoidf_(bfhi(g.x)) * a0[1]; r[2] = sigmoidf_(bflo(g.y)) * a0[2]; r[3] = sigmoidf_(bfhi(g.y)) * a0[3];
                    r[4] = sigmoidf_(bflo(g.z)) * a1[0]; r[5] = sigmoidf_(bfhi(g.z)) * a1[1]; r[6] = sigmoidf_(bflo(g.w)) * a1[2]; r[7] = sigmoidf_(bfhi(g.w)) * a1[3];
                    if (ACCUM) { const u32x4 o = *(const u32x4*)(rowp + bj * HALF);
                        r[0] += bflo(o.x); r[1] += bfhi(o.x); r[2] += bflo(o.y); r[3] += bfhi(o.y); r[4] += bflo(o.z); r[5] += bfhi(o.z); r[6] += bflo(o.w); r[7] += bfhi(o.w); }
                    u32x4 w; w.x = cvt_pk_bf16(r[0], r[1]); w.y = cvt_pk_bf16(r[2], r[3]); w.z = cvt_pk_bf16(r[4], r[5]); w.w = cvt_pk_bf16(r[6], r[7]);
                    *(u32x4*)(rowp + bj * HALF) = w;
                }
            }
    }
};
struct EpiX2 {
    static constexpr bool PERM = true;
    const float* x; float* x2; bf16_t* x2b; float* ssq;
    __device__ __forceinline__ void operator()(const f32x4 (&acc)[2][2][4][2], const Unit& u, int wr, int wc, int fr, int fq) const {
        const int row0 = u.pm * BM + wr * 64 + fr, col0 = u.pn * BM + wc * 32 + 8 * fq;
#pragma unroll
        for (int ai = 0; ai < 2; ++ai)
#pragma unroll
            for (int m = 0; m < 4; ++m) {
                const int row = row0 + ai * HALF + m * 16;
                const size_t off = (size_t)row * DM + col0;
                float ss = 0.f;
#pragma unroll
                for (int bj = 0; bj < 2; ++bj) {
                    const f32x4 x0 = *(const f32x4*)(x + off + bj * HALF), x1 = *(const f32x4*)(x + off + bj * HALF + 4);
                    const f32x4 o0 = x0 + acc[ai][bj][m][0], o1 = x1 + acc[ai][bj][m][1];
                    u32x4 w; w.x = cvt_pk_bf16(o0[0], o0[1]); w.y = cvt_pk_bf16(o0[2], o0[3]); w.z = cvt_pk_bf16(o1[0], o1[1]); w.w = cvt_pk_bf16(o1[2], o1[3]);
                    *(u32x4*)(x2b + off + bj * HALF) = w;
                    ss += (o0[0] * o0[0] + o0[1] * o0[1]) + (o0[2] * o0[2] + o0[3] * o0[3]) + (o1[0] * o1[0] + o1[1] * o1[1]) + (o1[2] * o1[2] + o1[3] * o1[3]);
                }
                ss += __shfl_xor(ss, 16); ss += __shfl_xor(ss, 32);
                if (fq == 0) ssq[(size_t)row * 16 + (u.pn & 3) * 4 + wc] = ss;
            }
    }
};

template <class Epi, class Sched>
__device__ __forceinline__ void gemm_phase(PG8_LAS unsigned char* lds, const Gemm g, const Sched& S, const Epi& E) {
    const int tid = threadIdx.x, wid = __builtin_amdgcn_readfirstlane(tid >> 6), lane = tid & 63, wr = wid >> 2, wc = wid & 3, fr = lane & 15, fq = lane >> 4;
    const int K = g.K, nt = K / BK;
    unsigned voffA[2], voffB[2];
#pragma unroll
    for (int i = 0; i < 2; ++i) { int R, C; stage_rc(tid * 16 + i * 8192, R, C); const int Rb = Epi::PERM ? ((R & ~31) + perm32(R & 31)) : R;
        voffA[i] = (unsigned)(R * g.lda + C) * 2u; voffB[i] = (unsigned)(Rb * g.ldb + C) * 2u; }
    const size_t kstep = (size_t)(BK * 2);
    const size_t hstepA = (size_t)HALF * g.lda * 2, hstepB = (size_t)HALF * g.ldb * 2;
    const size_t tstepA = 2 * hstepA, tstepB = 2 * hstepB;
    const unsigned ldsw = (unsigned)wid * 1024u;
    const int aoff = lds_byte(wr * 64 + fr, fq * 8), boff = lds_byte(wc * 32 + fr, fq * 8);
#define PG8_SA(b, h) (((b) * 2 + (h)) * HTB)
#define PG8_SB(b, h) ((4 + (b) * 2 + (h)) * HTB)
#define PG8_STAGE(bufoff, gbase, voff) do { _Pragma("unroll") for (int _i = 0; _i < 2; ++_i) \
        __builtin_amdgcn_global_load_lds((const unsigned*)((const char*)(gbase) + (voff)[_i]), (PG8_LAS unsigned*)(lds + (bufoff) + ldsw + _i * 8192), 16, 0, 0); } while (0)
#define PG8_LDA(dst, b, h) do { _Pragma("unroll") for (int m = 0; m < 4; ++m) _Pragma("unroll") for (int k = 0; k < 2; ++k) dst[m][k] = *(const PG8_LAS bf16x8*)(lds + PG8_SA(b, h) + aoff + m * 2048 + k * 1024); } while (0)
#define PG8_LDB(dst, b, h) do { _Pragma("unroll") for (int n = 0; n < 2; ++n) _Pragma("unroll") for (int k = 0; k < 2; ++k) dst[n][k] = *(const PG8_LAS bf16x8*)(lds + PG8_SB(b, h) + boff + n * 2048 + k * 1024); } while (0)
#define PG8_MMA(ai, bj, At, Bt) do { __builtin_amdgcn_s_setprio(1); _Pragma("unroll") for (int m = 0; m < 4; ++m) _Pragma("unroll") for (int n = 0; n < 2; ++n) _Pragma("unroll") for (int k = 0; k < 2; ++k) \
        acc[ai][bj][m][n] = __builtin_amdgcn_mfma_f32_16x16x32_bf16(Bt[n][k], At[m][k], acc[ai][bj][m][n], 0, 0, 0); __builtin_amdgcn_s_setprio(0); } while (0)
#define PG8_WAIT_V(n) asm volatile("s_waitcnt vmcnt(" #n ")" ::: "memory")
#define PG8_WAIT_L(n) asm volatile("s_waitcnt lgkmcnt(" #n ")" ::: "memory")
#define PG8_BAR __builtin_amdgcn_s_barrier()
#define PG8_SCHED __builtin_amdgcn_sched_barrier(0)
    Unit cur, nxt; int ui = 0;
    if (!S.next(0, cur)) return;
    f32x4 acc[2][2][4][2];
#pragma unroll
    for (int a = 0; a < 2; ++a)
#pragma unroll
        for (int b = 0; b < 2; ++b)
#pragma unroll
            for (int m = 0; m < 4; ++m)
#pragma unroll
                for (int n = 0; n < 2; ++n) acc[a][b][m][n] = (f32x4){0.f, 0.f, 0.f, 0.f};
    bf16x8 At[4][2], B0[2][2], B1[2][2];
    const char* cA = (const char*)g.A + (size_t)cur.pm * tstepA; const char* cB = (const char*)g.Bt + (size_t)cur.pn * tstepB;
    PG8_STAGE(PG8_SB(0, 0), cB, voffB); PG8_STAGE(PG8_SB(0, 1), cB + hstepB, voffB); PG8_STAGE(PG8_SA(0, 0), cA, voffA); PG8_STAGE(PG8_SA(0, 1), cA + hstepA, voffA);
    if (wr == 1) PG8_BAR;
    PG8_WAIT_V(2); PG8_BAR;
    PG8_STAGE(PG8_SB(1, 0), cB + kstep, voffB); PG8_STAGE(PG8_SA(1, 0), cA + kstep, voffA); PG8_STAGE(PG8_SB(1, 1), cB + hstepB + kstep, voffB);
    PG8_WAIT_V(6); PG8_BAR;
    for (;;) {
        const bool has_next = S.next(ui + 1, nxt);
        const char* nA = has_next ? (const char*)g.A + (size_t)nxt.pm * tstepA : cA; const char* nB = has_next ? (const char*)g.Bt + (size_t)nxt.pn * tstepB : cB;
        for (int t = 0; t < nt; t += 2) {
            const bool last = (t == nt - 2);
            const char* a1 = cA + (size_t)(t + 1) * kstep;
            const char* a2 = last ? nA : cA + (size_t)(t + 2) * kstep; const char* b2 = last ? nB : cB + (size_t)(t + 2) * kstep;
            const char* a3 = a2 + kstep; const char* b3 = b2 + kstep;
            PG8_LDB(B0, 0, 0); PG8_LDB(B1, 0, 1); PG8_SCHED; PG8_LDA(At, 0, 0); PG8_STAGE(PG8_SA(1, 1), a1 + hstepA, voffA);
            PG8_WAIT_V(8); PG8_WAIT_L(0); PG8_BAR; PG8_MMA(0, 0, At, B0); PG8_MMA(0, 1, At, B1); PG8_BAR; PG8_SCHED;
            PG8_LDA(At, 0, 1); PG8_STAGE(PG8_SB(0, 0), b2, voffB); PG8_STAGE(PG8_SB(0, 1), b2 + hstepB, voffB); PG8_STAGE(PG8_SA(0, 0), a2, voffA);
            PG8_WAIT_V(8); PG8_WAIT_L(0); PG8_BAR; PG8_MMA(1, 0, At, B0); PG8_MMA(1, 1, At, B1); PG8_BAR; PG8_SCHED;
            PG8_LDB(B0, 1, 0); PG8_LDB(B1, 1, 1); PG8_SCHED; PG8_LDA(At, 1, 0); PG8_STAGE(PG8_SA(0, 1), a2 + hstepA, voffA);
            PG8_WAIT_V(8); PG8_WAIT_L(0); PG8_BAR; PG8_MMA(0, 0, At, B0); PG8_MMA(0, 1, At, B1); PG8_BAR; PG8_SCHED;
            PG8_LDA(At, 1, 1); PG8_STAGE(PG8_SB(1, 0), b3, voffB); PG8_STAGE(PG8_SB(1, 1), b3 + hstepB, voffB); PG8_STAGE(PG8_SA(1, 0), a3, voffA);
            PG8_WAIT_V(8); PG8_WAIT_L(0); PG8_BAR; PG8_MMA(1, 0, At, B0); PG8_MMA(1, 1, At, B1); PG8_BAR; PG8_SCHED;
        }
        if (wr == 0) PG8_BAR;
        E(acc, cur, wr, wc, fr, fq);
        if (!has_next) break;
#pragma unroll
        for (int a = 0; a < 2; ++a)
#pragma unroll
            for (int b = 0; b < 2; ++b)
#pragma unroll
                for (int m = 0; m < 4; ++m)
#pragma unroll
                    for (int n = 0; n < 2; ++n) acc[a][b][m][n] = (f32x4){0.f, 0.f, 0.f, 0.f};
        cur = nxt; cA = nA; cB = nB; ++ui;
        if (wr == 1) PG8_BAR;
    }
    PG8_WAIT_V(0);
    PG8_BAR;
#undef PG8_SA
#undef PG8_SB
#undef PG8_STAGE
#undef PG8_LDA
#undef PG8_LDB
#undef PG8_MMA
#undef PG8_WAIT_V
#undef PG8_WAIT_L
#undef PG8_BAR
#undef PG8_SCHED
}
}

constexpr int NWAVES = 8;
constexpr int LDS_RING_BYTES = 131072, LDSCTL_OFF = 143360, MISC_OFF = LDSCTL_OFF + 320, LDS_BYTES = 147456;
#define LAS __attribute__((address_space(3)))
#define GAS __attribute__((address_space(1)))
typedef float f32x4 __attribute__((ext_vector_type(4)));
typedef unsigned v4u __attribute__((ext_vector_type(4)));
typedef unsigned v2u __attribute__((ext_vector_type(2)));
#define LDS_WAIT() asm volatile("s_waitcnt lgkmcnt(0)" ::: "memory")

constexpr int CW_BAR = 4096;
#define XB_TMO      128
#define XB_XCNT(j)  (256  + 64 * (j))
#define XB_XSUB(j)  (1280 + 64 * (j))
#define XB_XGEN(j)  (2304 + 64 * (j))
#define XB_TOP      3328
#define XB_TOPGEN   3392
#define XCD_BAR_WORDS 3456
#define XB_SPIN_CAP (1u << 20)
__device__ __forceinline__ unsigned xb_ld(unsigned* p)              { return __hip_atomic_load(p, __ATOMIC_RELAXED, __HIP_MEMORY_SCOPE_AGENT); }
__device__ __forceinline__ unsigned xb_add(unsigned* p, unsigned v) { return __hip_atomic_fetch_add(p, v, __ATOMIC_RELAXED, __HIP_MEMORY_SCOPE_AGENT); }
__device__ __forceinline__ unsigned xb_xcc_id() { return (unsigned)__builtin_amdgcn_s_getreg((3 << 11) | 20) & 0xFu; }
#define XB_SPIN(cond, bar) do { unsigned _sp = 0; while (cond) { __builtin_amdgcn_s_sleep(1); \
    if ((++_sp & 255u) == 0u) { if (xb_ld(&(bar)[XB_TMO])) break; if (_sp > XB_SPIN_CAP) { atomicAdd(&(bar)[XB_TMO], 1u); break; } } } } while (0)
struct XcdBarrier { unsigned* bar; unsigned x; volatile LAS unsigned* st; };
__device__ __forceinline__ XcdBarrier xcd_barrier_post(unsigned* bar, volatile LAS unsigned* st) {
    XcdBarrier b; b.bar = bar; b.x = xb_xcc_id(); b.st = st;
    if (threadIdx.x == 0) (void)xb_add(&bar[XB_XCNT(b.x)], 1u);
    return b;
}
__device__ __forceinline__ void xcd_barrier_complete(unsigned* bar, unsigned x, unsigned& nloc, unsigned& nx) {
    const unsigned G = gridDim.x * gridDim.y * gridDim.z;
    unsigned sum, cnt, mine, sp = 0u;
    for (;;) {
        sum = 0u; cnt = 0u; mine = 0u;
#pragma unroll
        for (unsigned j = 0; j < 16; ++j) { const unsigned c = xb_ld(&bar[XB_XCNT(j)]); sum += c; cnt += (c > 0u) ? 1u : 0u; mine = (j == x) ? c : mine; }
        if (sum == G) break;
        __builtin_amdgcn_s_sleep(1);
        if ((++sp & 255u) == 0u) { if (xb_ld(&bar[XB_TMO])) break; if (sp > XB_SPIN_CAP) { atomicAdd(&bar[XB_TMO], 1u); break; } }
    }
    nloc = mine > 0u ? mine : 1u; nx = cnt > 0u ? cnt : 1u;
}
__device__ __forceinline__ void xcd_barrier(const XcdBarrier& b) {
    asm volatile("s_waitcnt vmcnt(0)" ::: "memory");
    __syncthreads();
    if (threadIdx.x == 0) {
        unsigned* bar = b.bar;
        __builtin_amdgcn_s_waitcnt(0);
        unsigned nloc = b.st[0], nx = b.st[1];
        if (nloc == 0u) { xcd_barrier_complete(bar, b.x, nloc, nx); b.st[0] = nloc; b.st[1] = nx; }
        const unsigned old = xb_add(&bar[XB_XSUB(b.x)], 1u);
        const unsigned gen = old / nloc;
        if (old + 1u == (gen + 1u) * nloc) {
            __builtin_amdgcn_fence(__ATOMIC_RELEASE, "agent");
            asm volatile("s_waitcnt vmcnt(0)" ::: "memory");
            const unsigned og = xb_add(&bar[XB_TOP], 1u);
            const unsigned tg = og / nx;
            if (og + 1u == (tg + 1u) * nx) xb_add(&bar[XB_TOPGEN], 1u);
            else XB_SPIN(xb_ld(&bar[XB_TOPGEN]) == tg, bar);
            __builtin_amdgcn_fence(__ATOMIC_ACQUIRE, "agent");
            xb_add(&bar[XB_XGEN(b.x)], 1u);
            asm volatile("s_waitcnt vmcnt(0)" ::: "memory");
        } else {
            XB_SPIN(xb_ld(&bar[XB_XGEN(b.x)]) == gen, bar);
            __builtin_amdgcn_fence(__ATOMIC_ACQUIRE, "agent");
            asm volatile("s_waitcnt vmcnt(0)" ::: "memory");
        }
    }
    __syncthreads();
}

struct Args { const float* in[28]; float* out; unsigned char* ws; int ph_lo, ph_hi, li, pad; };

__device__ __forceinline__ void p0_transpose_item(const float* W, const float* sc, int K, int N, bf16_t* WT, LAS float* scr, int item, int lane) {
    const int nblk = N / 32, kb = item / nblk, nb = item % nblk, k0 = 64 * kb, n0 = 32 * nb;
#pragma unroll 8
    for (int i = 0; i < 32; ++i) { const int kk = 2 * i + (lane >> 5); const float s = sc ? sc[k0 + kk] : 1.f; scr[kk * 33 + (lane & 31)] = W[(size_t)(k0 + kk) * N + n0 + (lane & 31)] * s; }
    LDS_WAIT(); asm volatile("" ::: "memory");
    const int c = lane & 7;
#pragma unroll
    for (int j = 0; j < 4; ++j) { const int n = (lane >> 3) + 8 * j; const LAS float* s = scr + (8 * c) * 33 + n;
        v4u o; o.x = pg8::cvt_pk_bf16(s[0 * 33], s[1 * 33]); o.y = pg8::cvt_pk_bf16(s[2 * 33], s[3 * 33]); o.z = pg8::cvt_pk_bf16(s[4 * 33], s[5 * 33]); o.w = pg8::cvt_pk_bf16(s[6 * 33], s[7 * 33]);
        *(v4u*)(WT + (size_t)(n0 + n) * K + k0 + 8 * c) = o; }
    LDS_WAIT(); asm volatile("" ::: "memory");
}
typedef unsigned v6u_t __attribute__((ext_vector_type(6)));
typedef unsigned v3u_t __attribute__((ext_vector_type(3)));
typedef float v16f_t __attribute__((ext_vector_type(16)));
typedef float v32f_t __attribute__((ext_vector_type(32)));
__device__ __forceinline__ void p0_row_fp6(const float* in, const float* cs, unsigned char* out, float* sc, int lane) {
    f32x4 v[4]; float mx = 0.f;
#pragma unroll
    for (int i = 0; i < 4; ++i) { v[i] = *(const f32x4*)(in + lane * 16 + 4 * i); if (cs) v[i] = v[i] * *(const f32x4*)(cs + lane * 16 + 4 * i);
        mx = fmaxf(mx, fmaxf(fmaxf(fabsf(v[i][0]), fabsf(v[i][1])), fmaxf(fabsf(v[i][2]), fabsf(v[i][3])))); }
#pragma unroll
    for (int o = 1; o < 64; o <<= 1) mx = fmaxf(mx, __shfl_xor(mx, o));
    mx = fmaxf(mx, 1e-30f);
    const float q = 7.5f / mx;
    v16f_t a, b;
#pragma unroll
    for (int i = 0; i < 16; ++i) { a[i] = 0.f; b[i] = 0.f; }
#pragma unroll
    for (int i = 0; i < 8; ++i) { a[i] = v[(2 * i) >> 2][(2 * i) & 3] * q; b[i] = v[(2 * i + 1) >> 2][(2 * i + 1) & 3] * q; }
    const v6u_t p = __builtin_amdgcn_cvt_scalef32_2xpk16_fp6_f32(a, b, 1.0f);
    *(v3u_t*)(out + lane * 12) = (v3u_t){p[0], p[1], p[2]};
    if (lane == 0) *sc = mx * (1.f / 7.5f);
}
__device__ __forceinline__ void p0_convert(const float* in, const float* cs, bf16_t* out, size_t n, int gw, int NGW, int lane) {
    for (size_t i = ((size_t)gw * 64 + lane) * 8; i < n; i += (size_t)NGW * 512) {
        f32x4 a = *(const f32x4*)(in + i), b = *(const f32x4*)(in + i + 4);
        if (cs) { const int c = (int)(i & 1023); a = a * *(const f32x4*)(cs + c); b = b * *(const f32x4*)(cs + c + 4); }
        v4u o; o.x = pg8::cvt_pk_bf16(a[0], a[1]); o.y = pg8::cvt_pk_bf16(a[2], a[3]); o.z = pg8::cvt_pk_bf16(b[0], b[1]); o.w = pg8::cvt_pk_bf16(b[2], b[3]);
        *(v4u*)(out + i) = o;
    }
}

namespace da {
typedef short bf16x8 __attribute__((ext_vector_type(8)));
typedef short s16x4 __attribute__((ext_vector_type(4)));
typedef float f32x16 __attribute__((ext_vector_type(16)));
typedef const LAS unsigned char* lcp;
constexpr float LOG2E = 1.4426950408889634f, C2 = 0.125f * LOG2E, THR = 8.f;
constexpr int RSLOT = 16384, LDS_KR = 0, LDS_VR = 3 * RSLOT, SCR_OFF = 6 * RSLOT, COMB_OFF = 0;
#define DA_SBAR() __builtin_amdgcn_sched_barrier(0)
#define DA_PIN(x) asm volatile("" : "+v"(x))
#define DA_MFMA(a, b, c) __builtin_amdgcn_mfma_f32_32x32x16_bf16(a, b, c, 0, 0, 0)
#define DA_WAIT_BAR(N) asm volatile("s_waitcnt vmcnt(" #N ") lgkmcnt(0)\n\ts_barrier" ::: "memory")
#define DA_MX3(a, b, c) __builtin_fmaxf(__builtin_fmaxf((a), (b)), (c))
__device__ __forceinline__ int crow(int r, int hi) { return (r & 3) + 8 * (r >> 2) + 4 * hi; }
__device__ __forceinline__ s16x4 vtr(lcp p) { return __builtin_bit_cast(s16x4, __builtin_amdgcn_ds_read_tr16_b64_v4i16((LAS s16x4*)p)); }
__device__ __forceinline__ unsigned cvtpk(float lo, float hi) { unsigned r; asm("v_cvt_pk_bf16_f32 %0, %1, %2" : "=v"(r) : "v"(lo), "v"(hi)); return r; }
__device__ __forceinline__ void glds16(const void* g, unsigned lds_base) {
    unsigned sv; asm volatile("s_mov_b32 %0, m0\n\ts_mov_b32 m0, %2\n\ts_nop 0\n\tglobal_load_lds_dwordx4 %1, off\n\ts_mov_b32 m0, %0" : "=&s"(sv) : "v"(g), "s"(lds_base) : "memory"); }
__device__ __forceinline__ void glds16_o128(const void* g, unsigned lds_base) {
    unsigned sv; asm volatile("s_mov_b32 %0, m0\n\ts_mov_b32 m0, %2\n\ts_nop 0\n\tglobal_load_lds_dwordx4 %1, off offset:128\n\ts_mov_b32 m0, %0" : "=&s"(sv) : "v"(g), "s"(lds_base) : "memory"); }
__device__ __forceinline__ void kload2(bf16x8* kf, lcp kp, int d0) { kf[2 * d0] = *(const LAS bf16x8*)(kp + d0 * 2048); kf[2 * d0 + 1] = *(const LAS bf16x8*)(kp + d0 * 2048 + 512); }
__device__ __forceinline__ float max16(const f32x16& p) {
    float a = DA_MX3(p[0], p[1], p[2]), b = DA_MX3(p[3], p[4], p[5]); a = DA_MX3(a, p[6], p[7]); b = DA_MX3(b, p[8], p[9]); a = DA_MX3(a, p[10], p[11]); b = DA_MX3(b, p[12], p[13]);
    a = DA_MX3(a, p[14], p[15]); return __builtin_fmaxf(a, b); }
__device__ __forceinline__ float rowmax(const f32x16& p0, const f32x16& p1, float offA, float offB) {
    const float m = __builtin_fmaxf(__builtin_fmaf(max16(p0), C2, offA), __builtin_fmaf(max16(p1), C2, offB));
    auto rr = __builtin_amdgcn_permlane32_swap(__float_as_uint(m), __float_as_uint(m), false, false);
    return __builtin_fmaxf(__uint_as_float(rr[0]), __uint_as_float(rr[1])); }
__device__ __forceinline__ void cmask(f32x16& p0, f32x16& p1, int jb, int qrel, int hi) {
    const int kb = 64 * jb + 4 * hi;
#pragma unroll
    for (int r = 0; r < 16; ++r) { const int kv = kb + (r & 3) + 8 * (r >> 2); if (kv > qrel) p0[r] = -INFINITY; if (kv + 32 > qrel) p1[r] = -INFINITY; } }

__device__ __forceinline__ void attn_epilogue_body(LAS unsigned char* lds, f32x16 (&o)[4], float l_reg, bf16_t* __restrict__ yb, const float* __restrict__ subln_w, float lam,
                                                   size_t rowb, int q0, int h, int wave, int lane) {
    asm volatile("" : "+v"(lane));
    const int r32 = lane & 31, hi = lane >> 5, map = wave >> 2, qs = wave & 3;
    LAS float* wsf = (LAS float*)(lds + SCR_OFF) + wave * 64;
    if (hi == 0) wsf[r32] = 1.f / l_reg;
    float il[16];
#pragma unroll
    for (int g = 0; g < 4; ++g) { const f32x4 t4 = *(const LAS f32x4*)(wsf + 8 * g + 4 * hi); il[4 * g] = t4[0]; il[4 * g + 1] = t4[1]; il[4 * g + 2] = t4[2]; il[4 * g + 3] = t4[3]; }
    __syncthreads();
    LAS float* comb = (LAS float*)(lds + COMB_OFF) + qs * 4096;
    if (map == 1) {
#pragma unroll
        for (int d = 0; d < 4; ++d)
#pragma unroll
            for (int r = 0; r < 16; ++r) comb[crow(r, hi) * 128 + 32 * d + r32] = o[d][r] * il[r];
    }
    __syncthreads();
    if (map == 0) {
        float sw[4];
#pragma unroll
        for (int d = 0; d < 4; ++d) sw[d] = subln_w[32 * d + r32] * (1.f - LAM_INIT);
#pragma unroll
        for (int r = 0; r < 16; ++r) {
            float v[4], ss = 0.f;
#pragma unroll
            for (int d = 0; d < 4; ++d) { v[d] = o[d][r] * il[r] - lam * comb[crow(r, hi) * 128 + 32 * d + r32]; ss += v[d] * v[d]; }
            ss += __shfl_xor(ss, 1); ss += __shfl_xor(ss, 2); ss += __shfl_xor(ss, 4); ss += __shfl_xor(ss, 8); ss += __shfl_xor(ss, 16);
            const float rs = rsqrtf(ss * (1.f / 128.f) + SUBLN_EPS);
            bf16_t* op = yb + (rowb + q0 + crow(r, hi)) * 512 + h * 128 + r32;
#pragma unroll
            for (int d = 0; d < 4; ++d) op[32 * d] = f2bf(v[d] * rs * sw[d]);
        }
    }
    __syncthreads();
}
__device__ __forceinline__ void attn_unit(LAS unsigned char* lds, const bf16_t* __restrict__ z, bf16_t* __restrict__ yb, const float* __restrict__ subln_w, float lam,
                                          int b, int h, int qblk, int wave_, int lane) {
    const int wave = __builtin_amdgcn_readfirstlane(wave_);
    const int r32 = lane & 31, hi = lane >> 5, map = wave >> 2, qs = wave & 3;
    const int q0 = qblk * 128 + qs * 32, NT = 2 * qblk + 2, qrel = qs * 32 + r32;
    const size_t rowb = (size_t)b * SEQ;
    const float slope = exp2f(-2.f * (float)(h + 1)), slope2 = slope * LOG2E, s64 = 64.f * slope2, s32 = 32.f * slope2;
    const unsigned lds0 = (unsigned)(uintptr_t)lds;
    LAS float* wsf = (LAS float*)(lds + SCR_OFF) + wave * 64;
    const bf16_t* ksrc = z + (rowb + lane) * NZ + C_ZK + h * 128 + wave * 8;
    const int pc0 = 2 * wave;
    const bf16_t* vsrc0 = z + (rowb + 16 * (pc0 & 3) + (lane >> 2)) * NZ + C_ZV + h * 128 + 32 * (pc0 >> 2) + (lane & 3) * 8;
    const unsigned kdst = lds0 + LDS_KR + wave * 1024, vdst = lds0 + LDS_VR + pc0 * 1024;
#define DMA_K(t, slot) do { const bf16_t* k_ = ksrc + (size_t)(t) * 64 * NZ; const unsigned d_ = (unsigned)__builtin_amdgcn_readfirstlane(kdst + (slot)); glds16(k_, d_); glds16_o128(k_, d_ + 8192 - 128); } while (0)
#define DMA_V(t, slot) do { const size_t o_ = (size_t)(t) * 64 * NZ; const unsigned d_ = (unsigned)__builtin_amdgcn_readfirstlane(vdst + (slot)); glds16(vsrc0 + o_, d_); glds16(vsrc0 + o_ + 16 * NZ, d_ + 1024); } while (0)
    const lcp vp0 = lds + LDS_VR + ((lane >> 4) & 1) * 32 + (lane & 3) * 8 + (4 * hi + ((lane & 15) >> 2)) * 64;
    const lcp kp0 = lds + LDS_KR + map * 8192 + hi * 1024 + r32 * 16;
    DMA_K(0, 0); DMA_V(0, 0); DMA_K(1, RSLOT);
    bf16x8 qr[4];
    {
        const bf16_t* qp = z + (rowb + q0 + r32) * NZ + C_Q + h * 128 + map * 64 + hi * 8;
#pragma unroll
        for (int d0 = 0; d0 < 4; ++d0) qr[d0] = *(const bf16x8*)(qp + d0 * 16);
    }
    f32x16 bias16;
#pragma unroll
    for (int r = 0; r < 16; ++r) bias16[r] = (8.f * slope) * (float)((r & 3) + 8 * (r >> 2));
    DA_PIN(bias16);
    float mhat = 0.f, l_reg = 0.f, offA = slope2 * (float)(4 * hi);
    f32x16 o[4];
#pragma unroll
    for (int d = 0; d < 4; ++d) o[d] = (f32x16){};
    bool resc = false;
    f32x16 c0, c1; bf16x8 kf[8]; s16x4 vlo[4], vhi[4]; v4u pw0, pw1, pw2, pw3;
    int sl_prev = 0, sl_cur = 0, sl_next = RSLOT;
#define ROT() do { sl_prev = sl_cur; sl_cur = sl_next; sl_next = (sl_next == 2 * RSLOT) ? 0 : sl_next + RSLOT; } while (0)
#define EX(v, nm) __builtin_amdgcn_exp2f(__builtin_fmaf((v), C2, (nm)))
#define RESC() do { if (resc) { _Pragma("unroll") for (int d_ = 0; d_ < 4; ++d_) _Pragma("unroll") for (int r = 0; r < 16; ++r) o[d_][r] *= wsf[crow(r, hi)]; } } while (0)
#define PKW(P, i) pg8::cvt_pk_bf16(P[i], P[(i) + 1])
    DMA_K(2, 2 * RSLOT);
    DA_WAIT_BAR(6);
#pragma unroll
    for (int d0 = 0; d0 < 4; ++d0) kload2(kf, kp0, d0);
    c0 = DA_MFMA(kf[0], qr[0], bias16); c1 = DA_MFMA(kf[1], qr[0], bias16); c0 = DA_MFMA(kf[2], qr[1], c0); c1 = DA_MFMA(kf[3], qr[1], c1);
    c0 = DA_MFMA(kf[4], qr[2], c0); c1 = DA_MFMA(kf[5], qr[2], c1); c0 = DA_MFMA(kf[6], qr[3], c0); c1 = DA_MFMA(kf[7], qr[3], c1);
    if (NT == 2) cmask(c0, c1, 0, qrel, hi);
    { mhat = rowmax(c0, c1, offA, offA + s32); const float nmh0 = offA - mhat, nmh1 = nmh0 + s32; float sacc = 0.f;
#pragma unroll
      for (int r = 0; r < 16; ++r) { c0[r] = EX(c0[r], nmh0); c1[r] = EX(c1[r], nmh1); sacc += c0[r] + c1[r]; }
      l_reg = sacc; }
    pw0 = (v4u){PKW(c0, 0), PKW(c0, 2), PKW(c0, 4), PKW(c0, 6)}; pw1 = (v4u){PKW(c0, 8), PKW(c0, 10), PKW(c0, 12), PKW(c0, 14)};
    pw2 = (v4u){PKW(c1, 0), PKW(c1, 2), PKW(c1, 4), PKW(c1, 6)}; pw3 = (v4u){PKW(c1, 8), PKW(c1, 10), PKW(c1, 12), PKW(c1, 14)};
    DA_WAIT_BAR(0);
    DMA_K(3, 0); DMA_V(1, RSLOT); ROT();
#pragma unroll
    for (int d0 = 0; d0 < 4; ++d0) kload2(kf, kp0 + sl_cur, d0);
    if (NT == 2) { DA_WAIT_BAR(0); } else { DA_WAIT_BAR(4); }
#define PAF(k) __builtin_bit_cast(bf16x8, pw##k)
#define VFR(i) (bf16x8){vlo[(i) & 3][0], vlo[(i) & 3][1], vlo[(i) & 3][2], vlo[(i) & 3][3], vhi[(i) & 3][0], vhi[(i) & 3][1], vhi[(i) & 3][2], vhi[(i) & 3][3]}
#define VOFF(i) ((((i) & 3) * 4 + ((i) >> 2)) * 1024)
#define VRD(i) do { vlo[(i) & 3] = vtr(vp_ + VOFF(i)); vhi[(i) & 3] = vtr(vp_ + VOFF(i) + 512); DA_SBAR(); } while (0)
#define KRD(G, d0) do { if (G) { kload2(kf, kp0 + sl_next, d0); DA_SBAR(); } } while (0)
#define GAPA(MF) do { MF; DA_SBAR(); } while (0)
#define GAPB(MF, X, i, nm, A0, A1, EXTRA) do { MF; X[i] = EX(X[i], nm); X[(i) + 1] = EX(X[(i) + 1], nm); sacc += A0; sacc += A1; EXTRA; DA_PIN(X); DA_PIN(sacc); DA_SBAR(); } while (0)
#define STEP(t, MASK, GK, GV, GL) do { DA_SBAR(); \
    const lcp vp_ = vp0 + sl_prev; \
            GAPA(c0 = DA_MFMA(kf[0], qr[0], bias16)); GAPA(c1 = DA_MFMA(kf[1], qr[0], bias16)); GAPA(c0 = DA_MFMA(kf[2], qr[1], c0)); GAPA(c1 = DA_MFMA(kf[3], qr[1], c1)); \
    VRD(0); GAPA(c0 = DA_MFMA(kf[4], qr[2], c0)); VRD(1); GAPA(c1 = DA_MFMA(kf[5], qr[2], c1)); VRD(2); GAPA(c0 = DA_MFMA(kf[6], qr[3], c0)); VRD(3); GAPA(c1 = DA_MFMA(kf[7], qr[3], c1)); \
    offA += s64; \
    if (GK) DMA_K((t) + 3, sl_cur); if (GV) DMA_V((t) + 1, sl_next); \
    if (MASK) cmask(c0, c1, (t) - (NT - 2), qrel, hi); \
    { const float rm = rowmax(c0, c1, offA, offA + s32) - mhat; resc = false; \
      if (__builtin_expect(__any(rm > THR), 0)) { const float dl = __builtin_fmaxf(rm, 0.f); mhat += dl; \
          const float f = __builtin_amdgcn_exp2f(-dl); l_reg *= f; if (hi == 0) wsf[r32] = f; resc = true; } } \
    const float nmh0 = offA - mhat, nmh1 = nmh0 + s32; float sacc = 0.f; DA_SBAR(); \
    GAPB(o[0] = DA_MFMA(PAF(0), VFR(0), o[0]), c0, 0, nmh0, 0.f, 0.f, );             VRD(4); \
    GAPB(o[1] = DA_MFMA(PAF(0), VFR(1), o[1]), c0, 2, nmh0, c0[0], c0[1], );         VRD(5); \
    GAPB(o[2] = DA_MFMA(PAF(0), VFR(2), o[2]), c0, 4, nmh0, c0[2], c0[3], );         VRD(6); \
    GAPB(o[3] = DA_MFMA(PAF(0), VFR(3), o[3]), c0, 6, nmh0, c0[4], c0[5], );         VRD(7); \
    GAPB(o[0] = DA_MFMA(PAF(1), VFR(4), o[0]), c0, 8, nmh0, c0[6], c0[7], pw0[0] = PKW(c0, 0); pw0[1] = PKW(c0, 2); DA_PIN(pw0));    VRD(8); \
    GAPB(o[1] = DA_MFMA(PAF(1), VFR(5), o[1]), c0, 10, nmh0, c0[8], c0[9], pw0[2] = PKW(c0, 4); pw0[3] = PKW(c0, 6); DA_PIN(pw0));   VRD(9); \
    GAPB(o[2] = DA_MFMA(PAF(1), VFR(6), o[2]), c0, 12, nmh0, c0[10], c0[11], );      VRD(10); \
    GAPB(o[3] = DA_MFMA(PAF(1), VFR(7), o[3]), c0, 14, nmh0, c0[12], c0[13], );      VRD(11); \
    GAPB(o[0] = DA_MFMA(PAF(2), VFR(8), o[0]), c1, 0, nmh1, c0[14], c0[15], pw1[0] = PKW(c0, 8); pw1[1] = PKW(c0, 10); DA_PIN(pw1));  VRD(12); \
    GAPB(o[1] = DA_MFMA(PAF(2), VFR(9), o[1]), c1, 2, nmh1, c1[0], c1[1], pw1[2] = PKW(c0, 12); pw1[3] = PKW(c0, 14); DA_PIN(pw1));   VRD(13); \
    GAPB(o[2] = DA_MFMA(PAF(2), VFR(10), o[2]), c1, 4, nmh1, c1[2], c1[3], );        VRD(14); \
    GAPB(o[3] = DA_MFMA(PAF(2), VFR(11), o[3]), c1, 6, nmh1, c1[4], c1[5], );        VRD(15); \
    GAPB(o[0] = DA_MFMA(PAF(3), VFR(12), o[0]), c1, 8, nmh1, c1[6], c1[7], pw2[0] = PKW(c1, 0); pw2[1] = PKW(c1, 2); DA_PIN(pw2));   KRD(GL, 0); \
    GAPB(o[1] = DA_MFMA(PAF(3), VFR(13), o[1]), c1, 10, nmh1, c1[8], c1[9], pw2[2] = PKW(c1, 4); pw2[3] = PKW(c1, 6); DA_PIN(pw2));  KRD(GL, 1); \
    GAPB(o[2] = DA_MFMA(PAF(3), VFR(14), o[2]), c1, 12, nmh1, c1[10], c1[11], );     KRD(GL, 2); \
    GAPB(o[3] = DA_MFMA(PAF(3), VFR(15), o[3]), c1, 14, nmh1, c1[12], c1[13], );     KRD(GL, 3); \
    sacc += c1[14]; sacc += c1[15]; l_reg += sacc; \
    pw3[0] = PKW(c1, 8); pw3[1] = PKW(c1, 10); pw3[2] = PKW(c1, 12); pw3[3] = PKW(c1, 14); DA_PIN(pw3); \
    } while (0)
#define ENDW(tt) do { if ((tt) + 3 < NT) { DA_WAIT_BAR(4); } else if ((tt) + 2 < NT) { DA_WAIT_BAR(2); } else { DA_WAIT_BAR(0); } } while (0)
    int t = 1;
    for (; t + 3 < NT; ++t) {
        STEP(t, false, true, true, true); DA_WAIT_BAR(4); RESC(); ROT();
    }
    for (; t + 1 < NT; ++t) {
        STEP(t, true, (t + 3 < NT), (t + 1 < NT), (t + 1 < NT)); ENDW(t); RESC(); ROT();
    }
    STEP(NT - 1, true, false, false, false); RESC();
    { const lcp vp_ = vp0 + sl_cur;
#define DRN(k, i) do { const s16x4 lo_ = vtr(vp_ + VOFF(i)), hh_ = vtr(vp_ + VOFF(i) + 512); \
        o[(i) & 3] = DA_MFMA(PAF(k), ((bf16x8){lo_[0], lo_[1], lo_[2], lo_[3], hh_[0], hh_[1], hh_[2], hh_[3]}), o[(i) & 3]); } while (0)
      DRN(0, 0); DRN(0, 1); DRN(0, 2); DRN(0, 3); DRN(1, 4); DRN(1, 5); DRN(1, 6); DRN(1, 7); DRN(2, 8); DRN(2, 9); DRN(2, 10); DRN(2, 11); DRN(3, 12); DRN(3, 13); DRN(3, 14); DRN(3, 15);
#undef DRN
    }
#undef DMA_K
#undef DMA_V
#undef ROT
#undef EX
#undef RESC
#undef PKW
#undef PAF
#undef VFR
#undef VOFF
#undef VRD
#undef KRD
#undef GAPA
#undef GAPB
#undef STEP
#undef ENDW
    { auto rr = __builtin_amdgcn_permlane32_swap(__float_as_uint(l_reg), __float_as_uint(l_reg), false, false); l_reg = __uint_as_float(rr[0]) + __uint_as_float(rr[1]); }
    attn_epilogue_body(lds, o, l_reg, yb, subln_w, lam, rowb, q0, h, wave, lane);
}
}

namespace rw {
typedef short bf16x8 __attribute__((ext_vector_type(8)));
typedef float f32x2 __attribute__((ext_vector_type(2)));
constexpr int CH = 32, ACT_PITCH = 528;
constexpr int OFF_ACT = 0, OFF_RKV = 16896, OFF_VEC = 41472, OFF_G = 82432, OFF_Y = 90624, OFF_NRM = 98816, OFF_SCL = 99328, OFF_CT = 99840, OFF_SCP = 102400;
template <int CTRL> __device__ __forceinline__ float dppf(float x) { return __builtin_bit_cast(float, __builtin_amdgcn_mov_dpp(__builtin_bit_cast(int, x), CTRL, 0xf, 0xf, true)); }
__device__ __forceinline__ float row_allsum(float v) { v += dppf<0x128>(v); v += dppf<0x124>(v); v += dppf<0x122>(v); v += dppf<0x121>(v); return v; }
__device__ __forceinline__ void row_allsum4(float& a, float& b, float& c, float& d) {
#define RW_DPP4(n) "v_add_f32_dpp %0, %0, %0 row_ror:" #n " row_mask:0xf bank_mask:0xf\n\tv_add_f32_dpp %1, %1, %1 row_ror:" #n " row_mask:0xf bank_mask:0xf\n\t" \
                   "v_add_f32_dpp %2, %2, %2 row_ror:" #n " row_mask:0xf bank_mask:0xf\n\tv_add_f32_dpp %3, %3, %3 row_ror:" #n " row_mask:0xf bank_mask:0xf\n\t"
    asm volatile("s_nop 1\n\t" RW_DPP4(8) RW_DPP4(4) RW_DPP4(2) RW_DPP4(1) "s_nop 1" : "+v"(a), "+v"(b), "+v"(c), "+v"(d));
#undef RW_DPP4
}
__device__ __forceinline__ f32x4 ld4bf(const bf16_t* p) { const v2u w = *(const v2u*)p; return (f32x4){pg8::bflo(w.x), pg8::bfhi(w.x), pg8::bflo(w.y), pg8::bfhi(w.y)}; }
__device__ __forceinline__ float fsig(float x) { return __builtin_amdgcn_rcpf(1.f + __expf(-x)); }
__device__ __forceinline__ float ftanh(float x) { return 1.f - 2.f * __builtin_amdgcn_rcpf(1.f + __expf(2.f * x)); }
struct ZRow { v2u r, k, v, w, a; v4u g; };
__device__ __forceinline__ ZRow ldrow(const bf16_t* zr, int c4, int cg) {
    ZRow o; o.r = *(const v2u*)(zr + C_R + c4); o.k = *(const v2u*)(zr + C_K + c4); o.v = *(const v2u*)(zr + C_V + c4); o.w = *(const v2u*)(zr + C_WL + 4 * cg); o.a = *(const v2u*)(zr + C_AL + 4 * cg);
    o.g = *(const v4u*)(zr + C_GL + 8 * cg); return o;
}
__device__ __forceinline__ f32x4 up4(v2u w) { return (f32x4){pg8::bflo(w.x), pg8::bfhi(w.x), pg8::bflo(w.y), pg8::bfhi(w.y)}; }

struct ScanP { const float *mu, *w0, *w2, *a0, *a2, *g2, *k_k, *k_a, *r_k, *lnx_w, *lnx_b; };
__device__ __forceinline__ void scan_unit(LAS unsigned char* lds, const bf16_t* __restrict__ z, bf16_t* __restrict__ ya, const ScanP P, int b, int h, int tid, int wave, int lane) {
    const float* mu = P.mu; const float* w0 = P.w0; const float* w2 = P.w2; const float* a0 = P.a0; const float* a2 = P.a2; const float* g2 = P.g2;
    const float* k_k = P.k_k; const float* k_a = P.k_a; const float* r_k = P.r_k; const float* lnx_w = P.lnx_w; const float* lnx_b = P.lnx_b;
    const size_t rowb = (size_t)b * SEQ;
    const int tl = tid >> 4, cg = tid & 15;
    const int nt = wave & 3, rl = lane & 15, rg = lane >> 4;
    LAS float* rkv = (LAS float*)(lds + OFF_RKV); LAS float* vec = (LAS float*)(lds + OFF_VEC); LAS float* gbuf = (LAS float*)(lds + OFF_G);
    LAS float* ybuf = (LAS float*)(lds + OFF_Y); LAS float* nrm = (LAS float*)(lds + OFF_NRM); LAS float* scl = (LAS float*)(lds + OFF_SCL); LAS float* scp = (LAS float*)(lds + OFF_SCP);
    bf16x8 bfr[8];
    {
        const int col = h * 64 + 16 * nt + rl;
#pragma unroll
        for (int f = 0; f < 8; ++f) {
            const float* src = (f < 2) ? w2 : (f < 4) ? a2 : g2;
            const int kb = ((f < 4) ? 32 * (f & 1) : 32 * (f - 4)) + 8 * rg;
            float e[8];
#pragma unroll
            for (int j = 0; j < 8; ++j) e[j] = src[(size_t)(kb + j) * 512 + col];
            v4u p; p.x = pg8::cvt_pk_bf16(e[0], e[1]); p.y = pg8::cvt_pk_bf16(e[2], e[3]); p.z = pg8::cvt_pk_bf16(e[4], e[5]); p.w = pg8::cvt_pk_bf16(e[6], e[7]);
            bfr[f] = __builtin_bit_cast(bf16x8, p);
        }
    }
    const int mt = wave >> 2;
    const int hc = h * 64 + 16 * nt + rl;
    const float w0c = w0[hc], a0c = a0[hc], kkc = k_k[hc], kac = k_a[hc], rkc = r_k[hc];
    const int c4 = h * 64 + 4 * cg;
    f32x2 St[4];
#pragma unroll
    for (int i = 0; i < 4; ++i) St[i] = (f32x2){0.f, 0.f};
    const int ra = 8 * wave + 2 * rg;
    LAS float* ctab = (LAS float*)(lds + OFF_CT);
    if (tl == 0) {
        LAS float* ct = ctab + cg * 36;
        *(LAS f32x4*)(ct + 0) = *(const f32x4*)(mu + C_R + c4); *(LAS f32x4*)(ct + 4) = *(const f32x4*)(mu + C_K + c4); *(LAS f32x4*)(ct + 8) = *(const f32x4*)(mu + C_V + c4);
        *(LAS f32x4*)(ct + 12) = *(const f32x4*)(mu + C_WL + 4 * cg); *(LAS f32x4*)(ct + 16) = *(const f32x4*)(mu + C_AL + 4 * cg);
        *(LAS f32x4*)(ct + 20) = *(const f32x4*)(mu + C_GL + 8 * cg); *(LAS f32x4*)(ct + 24) = *(const f32x4*)(mu + C_GL + 8 * cg + 4);
        *(LAS f32x4*)(ct + 28) = *(const f32x4*)(lnx_w + c4); *(LAS f32x4*)(ct + 32) = *(const f32x4*)(lnx_b + c4);
    }
    __syncthreads();
    const LAS float* myct = ctab + cg * 36;
    ZRow zc = ldrow(z + (rowb + tl) * NZ, c4, cg), zp;
    if (tl > 0) zp = ldrow(z + (rowb + tl - 1) * NZ, c4, cg); else { zp.r = zp.k = zp.v = zp.w = zp.a = (v2u){0u, 0u}; zp.g = (v4u){0u, 0u, 0u, 0u}; }
    for (int t0 = 0; t0 < SEQ; t0 += CH) {
        {
            const f32x4 cr = up4(zc.r), ck = up4(zc.k), cv = up4(zc.v), cw = up4(zc.w), ca = up4(zc.a);
            const f32x4 cg0 = (f32x4){pg8::bflo(zc.g.x), pg8::bfhi(zc.g.x), pg8::bflo(zc.g.y), pg8::bfhi(zc.g.y)}, cg1 = (f32x4){pg8::bflo(zc.g.z), pg8::bfhi(zc.g.z), pg8::bflo(zc.g.w), pg8::bfhi(zc.g.w)};
            const f32x4 pr = up4(zp.r), pk = up4(zp.k), pv = up4(zp.v), pw = up4(zp.w), pa = up4(zp.a);
            const f32x4 pg0 = (f32x4){pg8::bflo(zp.g.x), pg8::bfhi(zp.g.x), pg8::bflo(zp.g.y), pg8::bfhi(zp.g.y)}, pg1 = (f32x4){pg8::bflo(zp.g.z), pg8::bfhi(zp.g.z), pg8::bflo(zp.g.w), pg8::bfhi(zp.g.w)};
            if (t0 + CH < SEQ) { zc = ldrow(z + (rowb + t0 + CH + tl) * NZ, c4, cg); zp = ldrow(z + (rowb + t0 + CH + tl - 1) * NZ, c4, cg); }
            const f32x4 rs_ = cr + (pr - cr) * *(const LAS f32x4*)(myct + 0), ks_ = ck + (pk - ck) * *(const LAS f32x4*)(myct + 4), vs_ = cv + (pv - cv) * *(const LAS f32x4*)(myct + 8);
            const f32x4 ws_ = cw + (pw - cw) * *(const LAS f32x4*)(myct + 12), as_ = ca + (pa - ca) * *(const LAS f32x4*)(myct + 16);
            const f32x4 g0_ = cg0 + (pg0 - cg0) * *(const LAS f32x4*)(myct + 20), g1_ = cg1 + (pg1 - cg1) * *(const LAS f32x4*)(myct + 24);
            *(LAS f32x4*)(rkv + 0 * 2048 + tl * 64 + 4 * cg) = rs_; *(LAS f32x4*)(rkv + 1 * 2048 + tl * 64 + 4 * cg) = ks_; *(LAS f32x4*)(rkv + 2 * 2048 + tl * 64 + 4 * cg) = vs_;
            LAS unsigned char* ar = lds + OFF_ACT + tl * ACT_PITCH;
            v2u tw; tw.x = pg8::cvt_pk_bf16(ftanh(ws_[0]), ftanh(ws_[1])); tw.y = pg8::cvt_pk_bf16(ftanh(ws_[2]), ftanh(ws_[3]));
            *(LAS v2u*)(ar + 8 * cg) = tw;
            v2u aw; aw.x = pg8::cvt_pk_bf16(as_[0], as_[1]); aw.y = pg8::cvt_pk_bf16(as_[2], as_[3]);
            *(LAS v2u*)(ar + 128 + 8 * cg) = aw;
            v4u gw; gw.x = pg8::cvt_pk_bf16(fsig(g0_[0]), fsig(g0_[1])); gw.y = pg8::cvt_pk_bf16(fsig(g0_[2]), fsig(g0_[3]));
            gw.z = pg8::cvt_pk_bf16(fsig(g1_[0]), fsig(g1_[1])); gw.w = pg8::cvt_pk_bf16(fsig(g1_[2]), fsig(g1_[3]));
            *(LAS v4u*)(ar + 256 + 16 * cg) = gw;
        }
        __syncthreads();
        f32x4 accw = (f32x4){0.f, 0.f, 0.f, 0.f}, acca = accw, accg = accw;
        {
            const LAS unsigned char* ap = lds + OFF_ACT + (16 * mt + rl) * ACT_PITCH + 8 * rg * 2;
#pragma unroll
            for (int f = 0; f < 8; ++f) {
                const bf16x8 a = *(const LAS bf16x8*)(ap + f * 64);
                if (f < 2) accw = __builtin_amdgcn_mfma_f32_16x16x32_bf16(a, bfr[f], accw, 0, 0, 0);
                else if (f < 4) acca = __builtin_amdgcn_mfma_f32_16x16x32_bf16(a, bfr[f], acca, 0, 0, 0);
                else accg = __builtin_amdgcn_mfma_f32_16x16x32_bf16(a, bfr[f], accg, 0, 0, 0);
            }
        }
        float dec[4], av[4], kk[4];
        {
            const int c = 16 * nt + rl;
            float n2[4];
#pragma unroll
            for (int r = 0; r < 4; ++r) {
                const int tok = 16 * mt + 4 * rg + r;
                gbuf[tok * 64 + c] = accg[r];
                const float nx = -(w0c + accw[r]);
                const float sp = nx > 20.f ? nx : __logf(1.f + __expf(nx));
                dec[r] = __expf(-__expf(-sp - 0.5f));
                av[r] = fsig(a0c + acca[r]);
                kk[r] = rkv[1 * 2048 + tok * 64 + c] * kkc;
                n2[r] = kk[r] * kk[r];
            }
            row_allsum4(n2[0], n2[1], n2[2], n2[3]);
            if (rl == 0) {
#pragma unroll
                for (int r = 0; r < 4; ++r) nrm[(16 * mt + 4 * rg + r) * 4 + nt] = n2[r];
            }
        }
        __syncthreads();
        {
            const int c = 16 * nt + rl;
#pragma unroll
            for (int r = 0; r < 4; ++r) {
                const int tok = 16 * mt + 4 * rg + r;
                const f32x4 n4 = *(const LAS f32x4*)(nrm + tok * 4);
                const float ksv = rkv[1 * 2048 + tok * 64 + c], rsv = rkv[0 * 2048 + tok * 64 + c];
                const float inv = __builtin_amdgcn_rcpf(fmaxf(sqrtf((n4[0] + n4[1]) + (n4[2] + n4[3])), 1e-12f));
                const float kkn = kk[r] * inv, beta = kkn * av[r], kmod = ksv * (1.f + (av[r] - 1.f) * kac);
                LAS float* vp = vec + tok * 320 + c;
                vp[0] = dec[r]; vp[64] = beta; vp[128] = -kkn; vp[192] = kmod; vp[256] = dec[r] * rsv;
                float pbr = beta * rsv, pkr = kmod * rsv, pbo = rsv * kmod * rkc, dum = 0.f;
                row_allsum4(pbr, pkr, pbo, dum);
                if (rl == 0) *(LAS f32x4*)(scp + (tok * 4 + nt) * 4) = (f32x4){pbr, pkr, pbo, 0.f};
            }
        }
        __syncthreads();
        if (tid < CH) {
            const f32x4 p0 = *(const LAS f32x4*)(scp + tid * 16), p1 = *(const LAS f32x4*)(scp + tid * 16 + 4), p2 = *(const LAS f32x4*)(scp + tid * 16 + 8), p3 = *(const LAS f32x4*)(scp + tid * 16 + 12);
            *(LAS f32x4*)(scl + 4 * tid) = (p0 + p1) + (p2 + p3);
        }
        __syncthreads();
        {
            const LAS float* vb0 = vec + 4 * rl; const LAS float* rv0 = rkv + 2 * 2048 + ra;
#define RW_DECL(P) f32x4 d4##P, b4##P, n4##P, k4##P, q4##P; f32x2 v2##P, s2##P
#define RW_LOAD(P, tk_) do { d4##P = *(const LAS f32x4*)(vb0 + (tk_) * 320); b4##P = *(const LAS f32x4*)(vb0 + (tk_) * 320 + 64); n4##P = *(const LAS f32x4*)(vb0 + (tk_) * 320 + 128); \
                k4##P = *(const LAS f32x4*)(vb0 + (tk_) * 320 + 192); q4##P = *(const LAS f32x4*)(vb0 + (tk_) * 320 + 256); \
                v2##P = *(const LAS f32x2*)(rv0 + (tk_) * 64); s2##P = *(const LAS f32x2*)(scl + (tk_) * 4); } while (0)
#define RW_STEP(P, tk_) do { \
                f32x2 sa = St[0] * n4##P[0] + St[1] * n4##P[1] + St[2] * n4##P[2] + St[3] * n4##P[3]; \
                f32x2 yy = St[0] * q4##P[0] + St[1] * q4##P[1] + St[2] * q4##P[2] + St[3] * q4##P[3]; \
                float sa0 = sa[0], sa1 = sa[1], yy0 = yy[0], yy1 = yy[1]; \
                row_allsum4(sa0, sa1, yy0, yy1); \
                sa = (f32x2){sa0, sa1}; \
                _Pragma("unroll") for (int i = 0; i < 4; ++i) St[i] = St[i] * d4##P[i] + sa * b4##P[i] + v2##P * k4##P[i]; \
                const f32x2 yo = (f32x2){yy0, yy1} + sa * s2##P[0] + v2##P * s2##P[1]; \
                if (rl == 0) *(LAS f32x2*)(ybuf + (tk_) * 64 + ra) = yo; } while (0)
            RW_DECL(A); RW_DECL(B);
            RW_LOAD(A, 0);
            for (int tk = 0; tk < CH; tk += 2) {
                RW_LOAD(B, tk + 1);
                RW_STEP(A, tk);
                if (tk + 2 < CH) RW_LOAD(A, tk + 2);
                RW_STEP(B, tk + 1);
            }
#undef RW_DECL
#undef RW_LOAD
#undef RW_STEP
        }
        __syncthreads();
        {
            const f32x4 y4 = *(const LAS f32x4*)(ybuf + tl * 64 + 4 * cg);
            const float mean = row_allsum((y4[0] + y4[1]) + (y4[2] + y4[3])) * (1.f / 64.f);
            const f32x4 dv = y4 - mean;
            const float var = row_allsum((dv[0] * dv[0] + dv[1] * dv[1]) + (dv[2] * dv[2] + dv[3] * dv[3])) * (1.f / 64.f);
            const float rs_ = rsqrtf(var + GN_EPS);
            const f32x4 yn = dv * rs_ * *(const LAS f32x4*)(myct + 28) + *(const LAS f32x4*)(myct + 32);
            const float bonus = scl[tl * 4 + 2];
            const f32x4 vs_ = *(const LAS f32x4*)(rkv + 2 * 2048 + tl * 64 + 4 * cg), g4 = *(const LAS f32x4*)(gbuf + tl * 64 + 4 * cg);
            const f32x4 o = (yn + vs_ * bonus) * g4;
            v2u w; w.x = pg8::cvt_pk_bf16(o[0], o[1]); w.y = pg8::cvt_pk_bf16(o[2], o[3]);
            *(v2u*)(ya + (rowb + t0 + tl) * 512 + c4) = w;
        }
        __syncthreads();
    }
}
}

typedef __bf16 bf16x2_t __attribute__((ext_vector_type(2)));
__device__ __forceinline__ float dot2bf(unsigned a, unsigned b, float c) { return __builtin_amdgcn_fdot2_f32_bf16(__builtin_bit_cast(bf16x2_t, a), __builtin_bit_cast(bf16x2_t, b), c, false); }
__device__ __forceinline__ unsigned f2ord(float f) { const unsigned u = __float_as_uint(f); return (u & 0x80000000u) ? ~u : (u | 0x80000000u); }
__device__ __forceinline__ float ord2f(unsigned o) { return __uint_as_float((o & 0x80000000u) ? (o ^ 0x80000000u) : ~o); }
__device__ __forceinline__ unsigned row_allmax_u32(unsigned v) {
    v = max(v, (unsigned)__builtin_amdgcn_update_dpp(0, (int)v, 0x128, 0xf, 0xf, false));
    v = max(v, (unsigned)__builtin_amdgcn_update_dpp(0, (int)v, 0x124, 0xf, 0xf, false));
    v = max(v, (unsigned)__builtin_amdgcn_update_dpp(0, (int)v, 0x122, 0xf, 0xf, false));
    v = max(v, (unsigned)__builtin_amdgcn_update_dpp(0, (int)v, 0x121, 0xf, 0xf, false));
    return v;
}

constexpr int TK_PITCH = 272, TK_HALF = 128 * TK_PITCH;
typedef short tk_bf16x8 __attribute__((ext_vector_type(8)));
__device__ __forceinline__ void topk_loadq(tk_bf16x8 (&qa)[8], const bf16_t* __restrict__ qb, int t0, int h, int lane) {
    const bf16_t* qp = qb + (size_t)(t0 + (lane & 15)) * 2048 + h * 256 + 8 * (lane >> 4);
#pragma unroll
    for (int i = 0; i < 8; ++i) qa[i] = *(const tk_bf16x8*)(qp + i * 32);
}
__device__ __forceinline__ void topk_item(const tk_bf16x8 (&qa)[8], const LAS unsigned char* klds, int* __restrict__ ids, float* __restrict__ gates, int t0, int h, int lane) {
    const int rl = lane & 15, rg = lane >> 4;
    unsigned top[2][4];
#pragma unroll
    for (int c = 0; c < 2; ++c) {
        f32x4 acc[8];
#pragma unroll
        for (int nt = 0; nt < 8; ++nt) acc[nt] = (f32x4){64.f, 64.f, 64.f, 64.f};
        const LAS unsigned char* kp = klds + c * TK_HALF + rl * TK_PITCH + 16 * rg;
#pragma unroll
        for (int ks = 0; ks < 4; ++ks) {
#pragma unroll
            for (int nt = 0; nt < 8; ++nt) { const tk_bf16x8 b = *(const LAS tk_bf16x8*)(kp + nt * 16 * TK_PITCH + ks * 64); acc[nt] = __builtin_amdgcn_mfma_f32_16x16x32_bf16(qa[c * 4 + ks], b, acc[nt], 0, 0, 0); }
            __builtin_amdgcn_sched_barrier(0);
        }
        unsigned k[4][8];
#pragma unroll
        for (int r = 0; r < 4; ++r) {
#pragma unroll
            for (int nt = 0; nt < 8; ++nt) k[r][nt] = (__float_as_uint(fmaxf(acc[nt][r], 1.f)) & ~127u) | (unsigned)(127 - (nt * 16 + rl));
#define TK_CE(i, j) do { const unsigned a_ = max(k[r][i], k[r][j]), b_ = min(k[r][i], k[r][j]); k[r][i] = a_; k[r][j] = b_; } while (0)
            TK_CE(0, 1); TK_CE(2, 3); TK_CE(4, 5); TK_CE(6, 7); TK_CE(0, 2); TK_CE(1, 3); TK_CE(4, 6); TK_CE(5, 7); TK_CE(1, 2); TK_CE(5, 6);
            TK_CE(0, 4); TK_CE(1, 5); TK_CE(2, 6); TK_CE(3, 7); TK_CE(2, 4); TK_CE(3, 5); TK_CE(1, 2); TK_CE(3, 4); TK_CE(5, 6);
#undef TK_CE
        }
        unsigned tp[4] = {0u, 0u, 0u, 0u};
        for (int round = 0; round < 16; ++round) {
#pragma unroll
            for (int r = 0; r < 4; ++r) {
                const unsigned m = row_allmax_u32(k[r][0]);
                tp[r] = (rl == round) ? m : tp[r];
                const bool win = (k[r][0] == m);
                k[r][0] = win ? k[r][1] : k[r][0]; k[r][1] = win ? k[r][2] : k[r][1]; k[r][2] = win ? k[r][3] : k[r][2]; k[r][3] = win ? k[r][4] : k[r][3];
                k[r][4] = win ? k[r][5] : k[r][4]; k[r][5] = win ? k[r][6] : k[r][5]; k[r][6] = win ? k[r][7] : k[r][6]; k[r][7] = win ? 0u : k[r][7];
            }
        }
#pragma unroll
        for (int r = 0; r < 4; ++r) top[c][r] = tp[r];
    }
    const int rowbase = lane & 48;
    float v1[4]; int n1[4], ptr[4], myid[4]; unsigned k2[4], myv[4];
#pragma unroll
    for (int r = 0; r < 4; ++r) { v1[r] = __uint_as_float(top[0][r] & ~127u); n1[r] = 127 - (int)(top[0][r] & 127u); ptr[r] = 0; k2[r] = (unsigned)__builtin_amdgcn_ds_bpermute(rowbase * 4, (int)top[1][r]); myid[r] = 0; myv[r] = 0u; }
    for (int round = 0; round < 16; ++round) {
#pragma unroll
        for (int r = 0; r < 4; ++r) {
            const float head = v1[r] + __uint_as_float(k2[r] & ~127u);
            const unsigned key = (ptr[r] < 16) ? ((__float_as_uint(head) & ~15u) | (unsigned)(15 - rl)) : 0u;
            const unsigned m = row_allmax_u32(key);
            const bool win = (key == m);
            const unsigned wid = row_allmax_u32(win ? (unsigned)(n1[r] * 128 + (127 - (int)(k2[r] & 127u))) + 1u : 0u);
            myid[r] = (rl == round) ? (int)wid - 1 : myid[r];
            myv[r] = (rl == round) ? m : myv[r];
            ptr[r] += win ? 1 : 0;
            k2[r] = (unsigned)__builtin_amdgcn_ds_bpermute((rowbase + (ptr[r] & 15)) * 4, (int)top[1][r]);
        }
    }
#pragma unroll
    for (int r = 0; r < 4; ++r) {
        const float val = __uint_as_float(myv[r] & ~15u);
        const float vmax = __uint_as_float((unsigned)__builtin_amdgcn_ds_bpermute(rowbase * 4, (int)__float_as_uint(val)));
        const float e = __expf(val - vmax);
        const float sum = rw::row_allsum(e);
        gates[(size_t)(t0 + 4 * rg + r) * 128 + h * 16 + rl] = e / sum; ids[(size_t)(t0 + 4 * rg + r) * 128 + h * 16 + rl] = myid[r];
    }
}

typedef float f32x2 __attribute__((ext_vector_type(2)));
__device__ __forceinline__ void peer_token(const bf16_t* __restrict__ x2b, const float* __restrict__ ssq2, const int* __restrict__ ids, const float* __restrict__ gates,
                                           const unsigned char* __restrict__ U8, const unsigned char* __restrict__ V8, const float* __restrict__ usc, const float* __restrict__ vsc,
                                           const float* __restrict__ fw, float* __restrict__ out, int t, int lane) {
    const int l16 = lane * 16;
    f32x2 hx[8];
    {
        const v4u h0 = *(const v4u*)(x2b + (size_t)t * DM + l16), h1 = *(const v4u*)(x2b + (size_t)t * DM + l16 + 8);
        const unsigned hw[8] = {h0.x, h0.y, h0.z, h0.w, h1.x, h1.y, h1.z, h1.w};
#pragma unroll
        for (int i = 0; i < 8; ++i) hx[i] = (f32x2){pg8::bflo(hw[i]), pg8::bfhi(hw[i])};
    }
    const int idA = ids[(size_t)t * 128 + lane], idB = ids[(size_t)t * 128 + 64 + lane];
    const float rs = rsqrtf(pg8::ssq_sum16(ssq2 + (size_t)t * 16) * (1.f / DM) + NORM_EPS);
    const float suA = rs * usc[idA], suB = rs * usc[idB];
    const float svA = gates[(size_t)t * 128 + lane] * vsc[idA], svB = gates[(size_t)t * 128 + 64 + lane] * vsc[idB];
    f32x2 y[8];
#pragma unroll
    for (int i = 0; i < 8; ++i) y[i] = (f32x2){0.f, 0.f};
    const int bit0 = lane & 1, bit1 = (lane >> 1) & 1, bit2 = (lane >> 2) & 1;
    const int myk = 4 * bit0 + 2 * bit1 + bit2;
    for (int g = 0; g < 16; ++g) {
        const int idsel = (g < 8) ? idA : idB; const float susel = (g < 8) ? suA : suB, svsel = (g < 8) ? svA : svB; const int lb = (g * 8) & 63;
        v3u_t uw[8], vw[8];
#pragma unroll
        for (int k = 0; k < 8; ++k) { const int e = __builtin_amdgcn_readlane(idsel, lb + k); uw[k] = *(const v3u_t*)(U8 + (size_t)e * 768 + lane * 12); vw[k] = *(const v3u_t*)(V8 + (size_t)e * 768 + lane * 12); }
        float d[8];
#pragma unroll
        for (int k = 0; k < 8; ++k) {
            const v32f_t f = __builtin_amdgcn_cvt_scalef32_pk32_f32_fp6((v6u_t){uw[k][0], uw[k][1], uw[k][2], 0u, 0u, 0u}, 1.0f);
            f32x2 a = (f32x2){0.f, 0.f};
#pragma unroll
            for (int i = 0; i < 8; ++i) a += (f32x2){f[2 * i], f[2 * i + 1]} * hx[i];
            d[k] = a[0] + a[1];
            __builtin_amdgcn_sched_barrier(0);
        }
        float r4[4];
#pragma unroll
        for (int k = 0; k < 4; ++k) { const float send = bit0 ? d[k] : d[k + 4], keep = bit0 ? d[k + 4] : d[k]; r4[k] = keep + __shfl_xor(send, 1); }
        float r2[2];
#pragma unroll
        for (int k = 0; k < 2; ++k) { const float send = bit1 ? r4[k] : r4[k + 2], keep = bit1 ? r4[k + 2] : r4[k]; r2[k] = keep + __shfl_xor(send, 2); }
        float r1;
        { const float send = bit2 ? r2[0] : r2[1], keep = bit2 ? r2[1] : r2[0]; r1 = keep + __shfl_xor(send, 4); }
        r1 += __shfl_xor(r1, 8); r1 += __shfl_xor(r1, 16); r1 += __shfl_xor(r1, 32);
        const float dd = r1 * __shfl(susel, lb + myk);
        const float act = 0.5f * dd * (1.f + erff(dd * 0.70710678118654752f)) * __shfl(svsel, lb + myk);
#pragma unroll
        for (int k = 0; k < 8; ++k) {
            const float a = __uint_as_float((unsigned)__builtin_amdgcn_readlane((int)__float_as_uint(act), ((k & 1) << 2) | (k & 2) | ((k >> 2) & 1)));
            const f32x2 a2 = (f32x2){a, a};
            const v32f_t f = __builtin_amdgcn_cvt_scalef32_pk32_f32_fp6((v6u_t){vw[k][0], vw[k][1], vw[k][2], 0u, 0u, 0u}, 1.0f);
#pragma unroll
            for (int i = 0; i < 8; ++i) y[i] += (f32x2){f[2 * i], f[2 * i + 1]} * a2;
            __builtin_amdgcn_sched_barrier(0);
        }
    }
    float* orow = out + (size_t)t * DM + l16;
    float ss = 0.f;
    f32x4 o4[4];
#pragma unroll
    for (int i = 0; i < 4; ++i) { o4[i] = (f32x4){hx[2 * i][0] + y[2 * i][0], hx[2 * i][1] + y[2 * i][1], hx[2 * i + 1][0] + y[2 * i + 1][0], hx[2 * i + 1][1] + y[2 * i + 1][1]};
        ss += (o4[i][0] * o4[i][0] + o4[i][1] * o4[i][1]) + (o4[i][2] * o4[i][2] + o4[i][3] * o4[i][3]); }
    ss = wave_sum(ss);
    const float r = rsqrtf(ss * (1.f / DM) + NORM_EPS);
#pragma unroll
    for (int i = 0; i < 4; ++i) *(f32x4*)(orow + 4 * i) = o4[i] * r * *(const f32x4*)(fw + l16 + 4 * i);
}

__global__ void __launch_bounds__(NWAVES * 64, 2) mk_fwd(Args args) {
    extern __shared__ __attribute__((aligned(16))) unsigned char lds_raw[];
    LAS unsigned char* lds = (LAS unsigned char*)lds_raw;
    volatile LAS unsigned* MISC = (volatile LAS unsigned*)(lds + MISC_OFF);
    const int tid = threadIdx.x, lane = tid & 63, wave = __builtin_amdgcn_readfirstlane(tid >> 6);
    const int G = gridDim.x; const int bx = blockIdx.x; const int vcu = (G % 8 == 0) ? (bx % 8) * (G / 8) + bx / 8 : bx;
    unsigned char* ws = args.ws;
    unsigned* ctl = (unsigned*)(ws + WS_CTL);
    for (int u = tid; u < (LDS_BYTES - LDSCTL_OFF) / 4; u += NWAVES * 64) ((LAS unsigned*)(lds + LDSCTL_OFF))[u] = 0u;
    __syncthreads();
    XcdBarrier bar = xcd_barrier_post(ctl + CW_BAR + args.li * XCD_BAR_WORDS, MISC + 8);
    const int lo = args.ph_lo, hi = args.ph_hi;
#define IN(k) (lo <= (k) && (k) < hi)
#define BOTH(k) (IN(k) && IN((k) + 1))
    bf16_t* WinT = (bf16_t*)(ws + WS_WIN); bf16_t* PaT = (bf16_t*)(ws + WS_PA); bf16_t* PbT = (bf16_t*)(ws + WS_PB); bf16_t* WoT = (bf16_t*)(ws + WS_WO);
    bf16_t* WqT = (bf16_t*)(ws + WS_WQ); bf16_t* KeysB = (bf16_t*)(ws + WS_KEYS);
    float* rstd1 = (float*)(ws + WS_RSTD1); float* ssq2 = (float*)(ws + WS_RSTD2); float* scal = (float*)(ws + WS_SCAL);
    unsigned char* U8 = ws + WS_U; unsigned char* V8 = ws + WS_V; float* usc = (float*)(ws + WS_USC); float* vsc = (float*)(ws + WS_VSC);
    bf16_t* xb = (bf16_t*)(ws + WS_XB); bf16_t* ya = (bf16_t*)(ws + WS_YA); bf16_t* yb = (bf16_t*)(ws + WS_YB); bf16_t* x2b = (bf16_t*)(ws + WS_X2B);
    bf16_t* z = (bf16_t*)(ws + WS_Z); bf16_t* qb = (bf16_t*)(ws + WS_Q);
    bf16_t* merged = (bf16_t*)(ws + WS_MERGED);
    const int gw = vcu * NWAVES + wave, NGW = G * NWAVES;

    if (IN(0)) {
        LAS float* scr = (LAS float*)(lds + wave * 16384);
        constexpr int I_IN = (DM / 64) * (NZ / 32), I_PA = (512 / 64) * (DM / 32), I_WO = (DM / 64) * (DM / 32), I_WQ = (DM / 64) * (2048 / 32);
        constexpr int NITEMS = I_IN + 2 * I_PA + I_WO + I_WQ;
        for (int it = gw; it < NITEMS; it += NGW) {
            int r = it;
            if (r < I_IN) { p0_transpose_item(args.in[2], args.in[1], DM, NZ, WinT, scr, r, lane); continue; } r -= I_IN;
            if (r < I_PA) { p0_transpose_item(args.in[19], nullptr, 512, DM, PaT, scr, r, lane); continue; } r -= I_PA;
            if (r < I_PA) { p0_transpose_item(args.in[20], nullptr, 512, DM, PbT, scr, r, lane); continue; } r -= I_PA;
            if (r < I_WO) { p0_transpose_item(args.in[21], nullptr, DM, DM, WoT, scr, r, lane); continue; } r -= I_WO;
            p0_transpose_item(args.in[23], args.in[22], DM, 2048, WqT, scr, r, lane);
        }
        p0_convert(args.in[24], nullptr, KeysB, (size_t)16 * 128 * 128, gw, NGW, lane);
        for (int e = gw; e < 2 * NEXP; e += NGW) {
            const bool isu = e < NEXP; const int row = isu ? e : e - NEXP;
            p0_row_fp6((isu ? args.in[25] : args.in[26]) + (size_t)row * DM, isu ? args.in[22] : nullptr, (isu ? U8 : V8) + (size_t)row * 768, (isu ? usc : vsc) + row, lane);
        }
        for (int m = gw; m < T_TOK; m += NGW) {
            const f32x4* xr = (const f32x4*)(args.in[0] + (size_t)m * DM) + lane;
            f32x4 v[4]; float s = 0.f;
#pragma unroll
            for (int j = 0; j < 4; ++j) { v[j] = xr[64 * j]; s += (v[j][0] * v[j][0] + v[j][1] * v[j][1]) + (v[j][2] * v[j][2] + v[j][3] * v[j][3]); }
            s = wave_sum(s);
            v2u* o8 = (v2u*)(xb + (size_t)m * DM) + lane;
#pragma unroll
            for (int j = 0; j < 4; ++j) { v2u w; w.x = pg8::cvt_pk_bf16(v[j][0], v[j][1]); w.y = pg8::cvt_pk_bf16(v[j][2], v[j][3]); o8[64 * j] = w; }
            if (lane == 0) rstd1[m] = rsqrtf(s * (1.f / DM) + NORM_EPS);
        }
        if (gw == 0) {
            const float a = wave_sum(args.in[14][lane] * args.in[15][lane]), b = wave_sum(args.in[16][lane] * args.in[17][lane]);
            if (lane == 0) scal[0] = __expf(a) - __expf(b) + LAM_INIT;
        }
        if (BOTH(0)) xcd_barrier(bar);
    }
    if (IN(1)) {
        pg8::Gemm g{xb, WinT, DM, DM, DM}; pg8::StaticOrder S; S.init(T_TOK, NZ, G, bx);
        pg8::EpiRowScale<false> E{z, NZ, rstd1};
        for (int rep = 0; rep < REPS(1); ++rep) pg8::gemm_phase(lds, g, S, E);
        if (BOTH(1)) xcd_barrier(bar);
    }
    if (IN(2)) {
        {
            const rw::ScanP P{args.in[3], args.in[4], args.in[5], args.in[6], args.in[7], args.in[8], args.in[9], args.in[10], args.in[11], args.in[12], args.in[13]};
            for (int rep = 0; rep < REPS(2); ++rep) for (int u = vcu; u < NB * 8; u += G) rw::scan_unit(lds, z, ya, P, u >> 3, u & 7, tid, wave, lane);
        }
        const float lam = scal[0];
        __syncthreads();
        for (int i = 0;; ++i) {
            int idx = vcu + i * G; if (idx >= 2048 * REPS(10)) break;
            idx &= 2047;
            const int slot = idx >> 8, v = idx & 255, bh = v >> 1, a = (v & 1) * 4 + (slot >> 1), qblk = (slot & 1) ? 15 - a : a;
            da::attn_unit(lds, z, yb, args.in[18], lam, bh >> 2, bh & 3, qblk, wave, lane);
        }
        if (BOTH(2)) xcd_barrier(bar);
    }
    if (IN(3)) {
        pg8::Gemm g{ya, PaT, 512, 512, 512}; pg8::StaticOrder S; S.init(T_TOK, DM, G, bx);
        pg8::EpiGate<false> E{merged, z, C_GA};
        pg8::gemm_phase(lds, g, S, E);
        if (BOTH(3)) xcd_barrier(bar);
    }
    if (IN(4)) {
        pg8::Gemm g{yb, PbT, 512, 512, 512}; pg8::StaticOrder S; S.init(T_TOK, DM, G, bx);
        pg8::EpiGate<true> E{merged, z, C_GB};
        pg8::gemm_phase(lds, g, S, E);
        if (BOTH(4)) xcd_barrier(bar);
    }
    if (IN(5)) {
        pg8::Gemm g{merged, WoT, DM, DM, DM}; pg8::StaticOrder S; S.init(T_TOK, DM, G, bx);
        pg8::EpiX2 E{args.in[0], args.out, x2b, ssq2};
        pg8::gemm_phase(lds, g, S, E);
        if (BOTH(5)) xcd_barrier(bar);
    }
    if (IN(6)) {
        pg8::Gemm g{x2b, WqT, DM, DM, DM}; pg8::StaticOrder S; S.init(T_TOK, 2048, G, bx);
        pg8::EpiRowScale<true> E{qb, 2048, ssq2};
        for (int rep = 0; rep < REPS(6); ++rep) pg8::gemm_phase(lds, g, S, E);
        if (BOTH(6)) xcd_barrier(bar);
    }
    if (IN(7)) {
        int* ids = (int*)(ws + WS_IDS); float* gates = (float*)(ws + WS_GATES);
        for (int rep = 0; rep < REPS(7); ++rep)
        for (int h = 0; h < 8; ++h) {
            __syncthreads();
            {
                const bf16_t* ksrc = KeysB + (size_t)h * 2 * 128 * 128;
#pragma unroll
                for (int i = 0; i < 8; ++i) { const int chunk = tid + i * 512, row = chunk >> 4, cc = chunk & 15;
                    *(LAS v4u*)(lds + (row >> 7) * TK_HALF + (row & 127) * TK_PITCH + cc * 16) = *(const v4u*)(ksrc + (size_t)row * 128 + cc * 8); }
            }
            __syncthreads();
            for (int tile = gw; tile < 4096; tile += NGW) {
                tk_bf16x8 qa[8];
                topk_loadq(qa, qb, tile * 16, h, lane);
                topk_item(qa, lds, ids, gates, tile * 16, h, lane);
            }
        }
        if (BOTH(7)) xcd_barrier(bar);
    }
    if (IN(8)) {
        const int* ids = (const int*)(ws + WS_IDS); const float* gates = (const float*)(ws + WS_GATES);
        for (int t = gw; t < T_TOK; t += NGW) peer_token(x2b, ssq2, ids, gates, U8, V8, usc, vsc, args.in[27], args.out, t, lane);
    }
#undef IN
#undef BOTH
}

extern "C" void kernel_launch(void* const* d_in, const int* in_sizes, int n_in, void* d_out, int out_size, void* d_ws, size_t ws_size, hipStream_t stream) {
    static int grid = 0;
    if (grid == 0) {
        if (n_in != 28 || in_sizes[0] != T_TOK * DM || out_size != T_TOK * DM || ws_size < WS_END) {
            fprintf(stderr, "kernel_launch: unexpected shapes / workspace (n_in %d, ws %zu < %zu)\n", n_in, ws_size, (size_t)WS_END); grid = -1; return; }
        int dev = 0, cus = 0;
        if (hipGetDevice(&dev) != hipSuccess || hipDeviceGetAttribute(&cus, hipDeviceAttributeMultiprocessorCount, dev) != hipSuccess) { grid = -1; return; }
        if (hipFuncSetAttribute((const void*)mk_fwd, hipFuncAttributeMaxDynamicSharedMemorySize, LDS_BYTES) != hipSuccess) { fprintf(stderr, "kernel_launch: hipFuncSetAttribute failed\n"); grid = -1; return; }
        grid = cus;
    }
    if (grid < 0) return;
    unsigned char* ws = (unsigned char*)d_ws;
    float* out = (float*)d_out;
    (void)hipMemsetAsync(ws + WS_CTL, 0, 1 * MiB, stream);
    Args a{};
    for (int i = 0; i < 28; ++i) a.in[i] = (const float*)d_in[i];
    a.out = out; a.ws = ws;
    a.ph_lo = 0; a.ph_hi = 9; a.li = 0;
    hipLaunchKernelGGL(mk_fwd, dim3(grid), dim3(NWAVES * 64), LDS_BYTES, stream, a);
}
```

```cpp
#include <hip/hip_runtime.h>
#include <stdint.h>
#include <cstdio>

typedef unsigned short bf16_t;
typedef unsigned int u32;

#ifndef PROBE_REP
#define PROBE_REP 0
#endif
#define REPS(k) (((PROBE_REP >> (k)) & 1) ? 2 : 1)
constexpr int T_TOK = 65536, DM = 1024, SEQ = 2048, NB = 32;
constexpr int NZ = 5376;
constexpr int C_R = 0, C_K = 512, C_V = 1024, C_WL = 1536, C_AL = 1600, C_GL = 1664, C_Q = 1792, C_ZK = 2304, C_ZV = 2816, C_GA = 3328, C_GB = 4352;
constexpr int NEXP = 16384;
constexpr float NORM_EPS = 1e-6f, GN_EPS = 64e-5f, SUBLN_EPS = 1e-5f;
constexpr float LAM_INIT = 0.2f;

constexpr size_t MiB = 1u << 20;
constexpr size_t WS_CTL = 0;
constexpr size_t WS_WIN = 1 * MiB;
constexpr size_t WS_PA = 12 * MiB;
constexpr size_t WS_PB = 13 * MiB;
constexpr size_t WS_WO = 14 * MiB;
constexpr size_t WS_WQ = 16 * MiB;
constexpr size_t WS_KEYS = 20 * MiB;
constexpr size_t WS_RSTD1 = 21 * MiB;
constexpr size_t WS_RSTD2 = 58 * MiB;
constexpr size_t WS_SCAL = 23 * MiB;
constexpr size_t WS_U = 24 * MiB;
constexpr size_t WS_V = 40 * MiB;
constexpr size_t WS_USC = 56 * MiB;
constexpr size_t WS_VSC = 57 * MiB;
constexpr size_t WS_XB = 88 * MiB;
constexpr size_t WS_YA = WS_XB;
constexpr size_t WS_YB = WS_XB + 64 * MiB;
constexpr size_t WS_X2B = WS_XB;
constexpr size_t WS_Z = 216 * MiB;
constexpr size_t WS_Q = WS_Z;
constexpr size_t WS_IDS = WS_Z + 256 * MiB;
constexpr size_t WS_GATES = WS_Z + 288 * MiB;
constexpr size_t WS_MERGED = 888 * MiB;
constexpr size_t WS_END = 1016 * MiB;

__device__ __forceinline__ float bf2f(bf16_t h) { return __uint_as_float(((u32)h) << 16); }
__device__ __forceinline__ bf16_t f2bf(float f) { u32 u = __float_as_uint(f); u += 0x7fffu + ((u >> 16) & 1u); return (bf16_t)(u >> 16); }
__device__ __forceinline__ float wave_sum(float v) {
#pragma unroll
    for (int o = 1; o < 64; o <<= 1) v += __shfl_xor(v, o);
    return v;
}
__device__ __forceinline__ float sigmoidf_(float x) { return 1.f / (1.f + __expf(-x)); }

namespace pg8 {
#define PG8_LAS __attribute__((address_space(3)))
typedef short bf16x8 __attribute__((ext_vector_type(8)));
typedef float f32x4 __attribute__((ext_vector_type(4)));
typedef unsigned u32x4 __attribute__((ext_vector_type(4)));
constexpr int BM = 256, BK = 64, HALF = 128, HTB = HALF * BK * 2  , STAGE_BYTES = 8 * HTB, NXCD = 8, WGM = 8;

__host__ __device__ __forceinline__ int lds_byte(int r, int c) { const int st = (r >> 4) * 2 + (c >> 5), rr = r & 15, cc = c & 31, ob = rr * 64 + cc * 2; return st * 1024 + (ob ^ (((ob >> 9) & 1) << 5)); }
__host__ __device__ __forceinline__ void stage_rc(int b, int& R, int& C) { const int st = b / 1024, sb = b % 1024, swz = sb ^ (((sb >> 9) & 1) << 5); R = (st >> 1) * 16 + swz / 64; C = (st & 1) * 32 + (swz % 64) / 2; }
__host__ __device__ __forceinline__ int perm32(int rho) { const int n = rho >> 4, i = rho & 15; return 8 * (i >> 2) + 4 * n + (i & 3); }

struct Unit { int pm, pn; };
struct Gemm { const bf16_t* A; const bf16_t* Bt; int lda, ldb, K; };

struct StaticOrder {
    int nM, nN, nwg, G, c;
    __host__ __device__ void init(int M, int N, int G_, int c_) { nM = M / BM; nN = N / BM; nwg = nM * nN; G = G_; c = c_; }
    __host__ __device__ bool next(int i, Unit& u) const {
        const long L = (long)i * G + c; if (L >= nwg) return false;
        int wgid = (int)L; { const int q = nwg / NXCD, r = nwg % NXCD, xcd = wgid % NXCD, off = wgid / NXCD; wgid = (xcd < r ? xcd * (q + 1) : r * (q + 1) + (xcd - r) * q) + off; }
        const int nig = WGM * nN, gid = wgid / nig, fm = gid * WGM, gsz = (nM - fm) < WGM ? (nM - fm) : WGM;
        u.pm = fm + ((wgid % nig) % gsz); u.pn = (wgid % nig) / gsz; return true;
    }
};
typedef float f32x2_c __attribute__((ext_vector_type(2))); typedef __bf16 bf16x2_c __attribute__((ext_vector_type(2)));
__device__ __forceinline__ unsigned cvt_pk_bf16(float lo, float hi) { const f32x2_c v = {lo, hi}; const bf16x2_c b = __builtin_convertvector(v, bf16x2_c); return __builtin_bit_cast(unsigned, b); }
__device__ __forceinline__ float bflo(unsigned w) { return __uint_as_float(w << 16); }
__device__ __forceinline__ float bfhi(unsigned w) { return __uint_as_float(w & 0xffff0000u); }

__device__ __forceinline__ float ssq_sum16(const float* p) {
    const f32x4 a = *(const f32x4*)p, b = *(const f32x4*)(p + 4), c = *(const f32x4*)(p + 8), d = *(const f32x4*)(p + 12);
    return (((a[0] + a[1]) + (a[2] + a[3])) + ((b[0] + b[1]) + (b[2] + b[3]))) + (((c[0] + c[1]) + (c[2] + c[3])) + ((d[0] + d[1]) + (d[2] + d[3])));
}
template <bool SSQ> struct EpiRowScale {
    static constexpr bool PERM = true;
    bf16_t* O; int ldc; const float* rs;
    __device__ __forceinline__ void operator()(const f32x4 (&acc)[2][2][4][2], const Unit& u, int wr, int wc, int fr, int fq) const {
        const int row0 = u.pm * BM + wr * 64 + fr, col0 = u.pn * BM + wc * 32 + 8 * fq;
#pragma unroll
        for (int ai = 0; ai < 2; ++ai)
#pragma unroll
            for (int m = 0; m < 4; ++m) {
                const int row = row0 + ai * HALF + m * 16;
                float s; if (SSQ) s = rsqrtf(ssq_sum16(rs + (size_t)row * 16) * (1.f / 1024.f) + NORM_EPS); else s = rs[row];
                bf16_t* rowp = O + (size_t)row * ldc + col0;
#pragma unroll
                for (int bj = 0; bj < 2; ++bj) {
                    const f32x4 v0 = acc[ai][bj][m][0] * s, v1 = acc[ai][bj][m][1] * s;
                    u32x4 w; w.x = cvt_pk_bf16(v0[0], v0[1]); w.y = cvt_pk_bf16(v0[2], v0[3]); w.z = cvt_pk_bf16(v1[0], v1[1]); w.w = cvt_pk_bf16(v1[2], v1[3]);
                    *(u32x4*)(rowp + bj * HALF) = w;
                }
            }
    }
};
template <bool ACCUM> struct EpiGate {
    static constexpr bool PERM = true;
    bf16_t* mg; const bf16_t* z; int gcol;
    __device__ __forceinline__ void operator()(const f32x4 (&acc)[2][2][4][2], const Unit& u, int wr, int wc, int fr, int fq) const {
        const int row0 = u.pm * BM + wr * 64 + fr, col0 = u.pn * BM + wc * 32 + 8 * fq;
#pragma unroll
        for (int ai = 0; ai < 2; ++ai)
#pragma unroll
            for (int m = 0; m < 4; ++m) {
                const int row = row0 + ai * HALF + m * 16;
                const bf16_t* gp = z + (size_t)row * NZ + gcol + col0;
                bf16_t* rowp = mg + (size_t)row * DM + col0;
#pragma unroll
                for (int bj = 0; bj < 2; ++bj) {
                    const u32x4 g = *(const u32x4*)(gp + bj * HALF);
                    const f32x4 a0 = acc[ai][bj][m][0], a1 = acc[ai][bj][m][1];
                    float r[8];
                    r[0] = sigmoidf_(bflo(g.x)) * a0[0]; r[1] = sigmoidf_(bfhi(g.x)) * a0[1]; r[2] = sigmoidf_(bflo(g.y)) * a0[2]; r[3] = sigmoidf_(bfhi(g.y)) * a0[3];
                    r[4] = sigmoidf_(bflo(g.z)) * a1[0]; r[5] = sigmoidf_(bfhi(g.z)) * a1[1]; r[6] = sigmoidf_(bflo(g.w)) * a1[2]; r[7] = sigmoidf_(bfhi(g.w)) * a1[3];
                    if (ACCUM) { const u32x4 o = *(const u32x4*)(rowp + bj * HALF);
                        r[0] += bflo(o.x); r[1] += bfhi(o.x); r[2] += bflo(o.y); r[3] += bfhi(o.y); r[4] += bflo(o.z); r[5] += bfhi(o.z); r[6] += bflo(o.w); r[7] += bfhi(o.w); }
                    u32x4 w; w.x = cvt_pk_bf16(r[0], r[1]); w.y = cvt_pk_bf16(r[2], r[3]); w.z = cvt_pk_bf16(r[4], r[5]); w.w = cvt_pk_bf16(r[6], r[7]);
                    *(u32x4*)(rowp + bj * HALF) = w;
                }
            }
    }
};
struct EpiX2 {
    static constexpr bool PERM = true;
    const float* x; float* x2; bf16_t* x2b; float* ssq;
    __device__ __forceinline__ void operator()(const f32x4 (&acc)[2][2][4][2], const Unit& u, int wr, int wc, int fr, int fq) const {
        const int row0 = u.pm * BM + wr * 64 + fr, col0 = u.pn * BM + wc * 32 + 8 * fq;
#pragma unroll
        for (int ai = 0; ai < 2; ++ai)
#pragma unroll
            for (int m = 0; m < 4; ++m) {
                const int row = row0 + ai * HALF + m * 16;
                const size_t off = (size_t)row * DM + col0;
                float ss = 0.f;
#pragma unroll
                for (int bj = 0; bj < 2; ++bj) {
                    const f32x4 x0 = *(const f32x4*)(x + off + bj * HALF), x1 = *(const f32x4*)(x + off + bj * HALF + 4);
                    const f32x4 o0 = x0 + acc[ai][bj][m][0], o1 = x1 + acc[ai][bj][m][1];
                    u32x4 w; w.x = cvt_pk_bf16(o0[0], o0[1]); w.y = cvt_pk_bf16(o0[2], o0[3]); w.z = cvt_pk_bf16(o1[0], o1[1]); w.w = cvt_pk_bf16(o1[2], o1[3]);
                    *(u32x4*)(x2b + off + bj * HALF) = w;
                    ss += (o0[0] * o0[0] + o0[1] * o0[1]) + (o0[2] * o0[2] + o0[3] * o0[3]) + (o1[0] * o1[0] + o1[1] * o1[1]) + (o1[2] * o1[2] + o1[3] * o1[3]);
                }
                ss += __shfl_xor(ss, 16); ss += __shfl_xor(ss, 32);
                if (fq == 0) ssq[(size_t)row * 16 + (u.pn & 3) * 4 + wc] = ss;
            }
    }
};

template <class Epi, class Sched>
__device__ __forceinline__ void gemm_phase(PG8_LAS unsigned char* lds, const Gemm g, const Sched& S, const Epi& E) {
    const int tid = threadIdx.x, wid = __builtin_amdgcn_readfirstlane(tid >> 6), lane = tid & 63, wr = wid >> 2, wc = wid & 3, fr = lane & 15, fq = lane >> 4;
    const int K = g.K, nt = K / BK;
    unsigned voffA[2], voffB[2];
#pragma unroll
    for (int i = 0; i < 2; ++i) { int R, C; stage_rc(tid * 16 + i * 8192, R, C); const int Rb = Epi::PERM ? ((R & ~31) + perm32(R & 31)) : R;
        voffA[i] = (unsigned)(R * g.lda + C) * 2u; voffB[i] = (unsigned)(Rb * g.ldb + C) * 2u; }
    const size_t kstep = (size_t)(BK * 2);
    const size_t hstepA = (size_t)HALF * g.lda * 2, hstepB = (size_t)HALF * g.ldb * 2;
    const size_t tstepA = 2 * hstepA, tstepB = 2 * hstepB;
    const unsigned ldsw = (unsigned)wid * 1024u;
    const int aoff = lds_byte(wr * 64 + fr, fq * 8), boff = lds_byte(wc * 32 + fr, fq * 8);
#define PG8_SA(b, h) (((b) * 2 + (h)) * HTB)
#define PG8_SB(b, h) ((4 + (b) * 2 + (h)) * HTB)
#define PG8_STAGE(bufoff, gbase, voff) do { _Pragma("unroll") for (int _i = 0; _i < 2; ++_i) \
        __builtin_amdgcn_global_load_lds((const unsigned*)((const char*)(gbase) + (voff)[_i]), (PG8_LAS unsigned*)(lds + (bufoff) + ldsw + _i * 8192), 16, 0, 0); } while (0)
#define PG8_LDA(dst, b, h) do { _Pragma("unroll") for (int m = 0; m < 4; ++m) _Pragma("unroll") for (int k = 0; k < 2; ++k) dst[m][k] = *(const PG8_LAS bf16x8*)(lds + PG8_SA(b, h) + aoff + m * 2048 + k * 1024); } while (0)
#define PG8_LDB(dst, b, h) do { _Pragma("unroll") for (int n = 0; n < 2; ++n) _Pragma("unroll") for (int k = 0; k < 2; ++k) dst[n][k] = *(const PG8_LAS bf16x8*)(lds + PG8_SB(b, h) + boff + n * 2048 + k * 1024); } while (0)
#define PG8_MMA(ai, bj, At, Bt) do { __builtin_amdgcn_s_setprio(1); _Pragma("unroll") for (int m = 0; m < 4; ++m) _Pragma("unroll") for (int n = 0; n < 2; ++n) _Pragma("unroll") for (int k = 0; k < 2; ++k) \
        acc[ai][bj][m][n] = __builtin_amdgcn_mfma_f32_16x16x32_bf16(Bt[n][k], At[m][k], acc[ai][bj][m][n], 0, 0, 0); __builtin_amdgcn_s_setprio(0); } while (0)
#define PG8_WAIT_V(n) asm volatile("s_waitcnt vmcnt(" #n ")" ::: "memory")
#define PG8_WAIT_L(n) asm volatile("s_waitcnt lgkmcnt(" #n ")" ::: "memory")
#define PG8_BAR __builtin_amdgcn_s_barrier()
#define PG8_SCHED __builtin_amdgcn_sched_barrier(0)
    Unit cur, nxt; int ui = 0;
    if (!S.next(0, cur)) return;
    f32x4 acc[2][2][4][2];
#pragma unroll
    for (int a = 0; a < 2; ++a)
#pragma unroll
        for (int b = 0; b < 2; ++b)
#pragma unroll
            for (int m = 0; m < 4; ++m)
#pragma unroll
                for (int n = 0; n < 2; ++n) acc[a][b][m][n] = (f32x4){0.f, 0.f, 0.f, 0.f};
    bf16x8 At[4][2], B0[2][2], B1[2][2];
    const char* cA = (const char*)g.A + (size_t)cur.pm * tstepA; const char* cB = (const char*)g.Bt + (size_t)cur.pn * tstepB;
    PG8_STAGE(PG8_SB(0, 0), cB, voffB); PG8_STAGE(PG8_SB(0, 1), cB + hstepB, voffB); PG8_STAGE(PG8_SA(0, 0), cA, voffA); PG8_STAGE(PG8_SA(0, 1), cA + hstepA, voffA);
    if (wr == 1) PG8_BAR;
    PG8_WAIT_V(2); PG8_BAR;
    PG8_STAGE(PG8_SB(1, 0), cB + kstep, voffB); PG8_STAGE(PG8_SA(1, 0), cA + kstep, voffA); PG8_STAGE(PG8_SB(1, 1), cB + hstepB + kstep, voffB);
    PG8_WAIT_V(6); PG8_BAR;
    for (;;) {
        const bool has_next = S.next(ui + 1, nxt);
        const char* nA = has_next ? (const char*)g.A + (size_t)nxt.pm * tstepA : cA; const char* nB = has_next ? (const char*)g.Bt + (size_t)nxt.pn * tstepB : cB;
        for (int t = 0; t < nt; t += 2) {
            const bool last = (t == nt - 2);
            const char* a1 = cA + (size_t)(t + 1) * kstep;
            const char* a2 = last ? nA : cA + (size_t)(t + 2) * kstep; const char* b2 = last ? nB : cB + (size_t)(t + 2) * kstep;
            const char* a3 = a2 + kstep; const char* b3 = b2 + kstep;
            PG8_LDB(B0, 0, 0); PG8_LDB(B1, 0, 1); PG8_SCHED; PG8_LDA(At, 0, 0); PG8_STAGE(PG8_SA(1, 1), a1 + hstepA, voffA);
            PG8_WAIT_V(8); PG8_WAIT_L(0); PG8_BAR; PG8_MMA(0, 0, At, B0); PG8_MMA(0, 1, At, B1); PG8_BAR; PG8_SCHED;
            PG8_LDA(At, 0, 1); PG8_STAGE(PG8_SB(0, 0), b2, voffB); PG8_STAGE(PG8_SB(0, 1), b2 + hstepB, voffB); PG8_STAGE(PG8_SA(0, 0), a2, voffA);
            PG8_WAIT_V(8); PG8_WAIT_L(0); PG8_BAR; PG8_MMA(1, 0, At, B0); PG8_MMA(1, 1, At, B1); PG8_BAR; PG8_SCHED;
            PG8_LDB(B0, 1, 0); PG8_LDB(B1, 1, 1); PG8_SCHED; PG8_LDA(At, 1, 0); PG8_STAGE(PG8_SA(0, 1), a2 + hstepA, voffA);
            PG8_WAIT_V(8); PG8_WAIT_L(0); PG8_BAR; PG8_MMA(0, 0, At, B0); PG8_MMA(0, 1, At, B1); PG8_BAR; PG8_SCHED;
            PG8_LDA(At, 1, 1); PG8_STAGE(PG8_SB(1, 0), b3, voffB); PG8_STAGE(PG8_SB(1, 1), b3 + hstepB, voffB); PG8_STAGE(PG8_SA(1, 0), a3, voffA);
            PG8_WAIT_V(8); PG8_WAIT_L(0); PG8_BAR; PG8_MMA(1, 0, At, B0); PG8_MMA(1, 1, At, B1); PG8_BAR; PG8_SCHED;
        }
        if (wr == 0) PG8_BAR;
        E(acc, cur, wr, wc, fr, fq);
        if (!has_next) break;
#pragma unroll
        for (int a = 0; a < 2; ++a)
#pragma unroll
            for (int b = 0; b < 2; ++b)
#pragma unroll
                for (int m = 0; m < 4; ++m)
#pragma unroll
                    for (int n = 0; n < 2; ++n) acc[a][b][m][n] = (f32x4){0.f, 0.f, 0.f, 0.f};
        cur = nxt; cA = nA; cB = nB; ++ui;
        if (wr == 1) PG8_BAR;
    }
    PG8_WAIT_V(0);
    PG8_BAR;
#undef PG8_SA
#undef PG8_SB
#undef PG8_STAGE
#undef PG8_LDA
#undef PG8_LDB
#undef PG8_MMA
#undef PG8_WAIT_V
#undef PG8_WAIT_L
#undef PG8_BAR
#undef PG8_SCHED
}
}

constexpr int NWAVES = 8;
constexpr int LDS_RING_BYTES = 131072, LDSCTL_OFF = 143360, MISC_OFF = LDSCTL_OFF + 320, LDS_BYTES = 147456;
#define LAS __attribute__((address_space(3)))
#define GAS __attribute__((address_space(1)))
typedef float f32x4 __attribute__((ext_vector_type(4)));
typedef unsigned v4u __attribute__((ext_vector_type(4)));
typedef unsigned v2u __attribute__((ext_vector_type(2)));
#define LDS_WAIT() asm volatile("s_waitcnt lgkmcnt(0)" ::: "memory")

constexpr int CW_BAR = 4096;
#define XB_TMO      128
#define XB_XCNT(j)  (256  + 64 * (j))
#define XB_XSUB(j)  (1280 + 64 * (j))
#define XB_XGEN(j)  (2304 + 64 * (j))
#define XB_TOP      3328
#define XB_TOPGEN   3392
#define XCD_BAR_WORDS 3456
#define XB_SPIN_CAP (1u << 20)
__device__ __forceinline__ unsigned xb_ld(unsigned* p)              { return __hip_atomic_load(p, __ATOMIC_RELAXED, __HIP_MEMORY_SCOPE_AGENT); }
__device__ __forceinline__ unsigned xb_add(unsigned* p, unsigned v) { return __hip_atomic_fetch_add(p, v, __ATOMIC_RELAXED, __HIP_MEMORY_SCOPE_AGENT); }
__device__ __forceinline__ unsigned xb_xcc_id() { return (unsigned)__builtin_amdgcn_s_getreg((3 << 11) | 20) & 0xFu; }
#define XB_SPIN(cond, bar) do { unsigned _sp = 0; while (cond) { __builtin_amdgcn_s_sleep(1); \
    if ((++_sp & 255u) == 0u) { if (xb_ld(&(bar)[XB_TMO])) break; if (_sp > XB_SPIN_CAP) { atomicAdd(&(bar)[XB_TMO], 1u); break; } } } } while (0)
struct XcdBarrier { unsigned* bar; unsigned x; volatile LAS unsigned* st; };
__device__ __forceinline__ XcdBarrier xcd_barrier_post(unsigned* bar, volatile LAS unsigned* st) {
    XcdBarrier b; b.bar = bar; b.x = xb_xcc_id(); b.st = st;
    if (threadIdx.x == 0) (void)xb_add(&bar[XB_XCNT(b.x)], 1u);
    return b;
}
__device__ __forceinline__ void xcd_barrier_complete(unsigned* bar, unsigned x, unsigned& nloc, unsigned& nx) {
    const unsigned G = gridDim.x * gridDim.y * gridDim.z;
    unsigned sum, cnt, mine, sp = 0u;
    for (;;) {
        sum = 0u; cnt = 0u; mine = 0u;
#pragma unroll
        for (unsigned j = 0; j < 16; ++j) { const unsigned c = xb_ld(&bar[XB_XCNT(j)]); sum += c; cnt += (c > 0u) ? 1u : 0u; mine = (j == x) ? c : mine; }
        if (sum == G) break;
        __builtin_amdgcn_s_sleep(1);
        if ((++sp & 255u) == 0u) { if (xb_ld(&bar[XB_TMO])) break; if (sp > XB_SPIN_CAP) { atomicAdd(&bar[XB_TMO], 1u); break; } }
    }
    nloc = mine > 0u ? mine : 1u; nx = cnt > 0u ? cnt : 1u;
}
__device__ __forceinline__ void xcd_barrier(const XcdBarrier& b) {
    asm volatile("s_waitcnt vmcnt(0)" ::: "memory");
    __syncthreads();
    if (threadIdx.x == 0) {
        unsigned* bar = b.bar;
        __builtin_amdgcn_s_waitcnt(0);
        unsigned nloc = b.st[0], nx = b.st[1];
        if (nloc == 0u) { xcd_barrier_complete(bar, b.x, nloc, nx); b.st[0] = nloc; b.st[1] = nx; }
        const unsigned old = xb_add(&bar[XB_XSUB(b.x)], 1u);
        const unsigned gen = old / nloc;
        if (old + 1u == (gen + 1u) * nloc) {
            __builtin_amdgcn_fence(__ATOMIC_RELEASE, "agent");
            asm volatile("s_waitcnt vmcnt(0)" ::: "memory");
            const unsigned og = xb_add(&bar[XB_TOP], 1u);
            const unsigned tg = og / nx;
            if (og + 1u == (tg + 1u) * nx) xb_add(&bar[XB_TOPGEN], 1u);
            else XB_SPIN(xb_ld(&bar[XB_TOPGEN]) == tg, bar);
            __builtin_amdgcn_fence(__ATOMIC_ACQUIRE, "agent");
            xb_add(&bar[XB_XGEN(b.x)], 1u);
            asm volatile("s_waitcnt vmcnt(0)" ::: "memory");
        } else {
            XB_SPIN(xb_ld(&bar[XB_XGEN(b.x)]) == gen, bar);
            __builtin_amdgcn_fence(__ATOMIC_ACQUIRE, "agent");
            asm volatile("s_waitcnt vmcnt(0)" ::: "memory");
        }
    }
    __syncthreads();
}

struct Args { const float* in[28]; float* out; unsigned char* ws; int ph_lo, ph_hi, li, pad; };

__device__ __forceinline__ void p0_transpose_item(const float* W, const float* sc, int K, int N, bf16_t* WT, LAS float* scr, int item, int lane) {
    const int nblk = N / 32, kb = item / nblk, nb = item % nblk, k0 = 64 * kb, n0 = 32 * nb;
#pragma unroll 8
    for (int i = 0; i < 32; ++i) { const int kk = 2 * i + (lane >> 5); const float s = sc ? sc[k0 + kk] : 1.f; scr[kk * 33 + (lane & 31)] = W[(size_t)(k0 + kk) * N + n0 + (lane & 31)] * s; }
    LDS_WAIT(); asm volatile("" ::: "memory");
    const int c = lane & 7;
#pragma unroll
    for (int j = 0; j < 4; ++j) { const int n = (lane >> 3) + 8 * j; const LAS float* s = scr + (8 * c) * 33 + n;
        v4u o; o.x = pg8::cvt_pk_bf16(s[0 * 33], s[1 * 33]); o.y = pg8::cvt_pk_bf16(s[2 * 33], s[3 * 33]); o.z = pg8::cvt_pk_bf16(s[4 * 33], s[5 * 33]); o.w = pg8::cvt_pk_bf16(s[6 * 33], s[7 * 33]);
        *(v4u*)(WT + (size_t)(n0 + n) * K + k0 + 8 * c) = o; }
    LDS_WAIT(); asm volatile("" ::: "memory");
}
typedef unsigned v6u_t __attribute__((ext_vector_type(6)));
typedef unsigned v3u_t __attribute__((ext_vector_type(3)));
typedef float v16f_t __attribute__((ext_vector_type(16)));
typedef float v32f_t __attribute__((ext_vector_type(32)));
__device__ __forceinline__ void p0_row_fp6(const float* in, const float* cs, unsigned char* out, float* sc, int lane) {
    f32x4 v[4]; float mx = 0.f;
#pragma unroll
    for (int i = 0; i < 4; ++i) { v[i] = *(const f32x4*)(in + lane * 16 + 4 * i); if (cs) v[i] = v[i] * *(const f32x4*)(cs + lane * 16 + 4 * i);
        mx = fmaxf(mx, fmaxf(fmaxf(fabsf(v[i][0]), fabsf(v[i][1])), fmaxf(fabsf(v[i][2]), fabsf(v[i][3])))); }
#pragma unroll
    for (int o = 1; o < 64; o <<= 1) mx = fmaxf(mx, __shfl_xor(mx, o));
    mx = fmaxf(mx, 1e-30f);
    const float q = 7.5f / mx;
    v16f_t a, b;
#pragma unroll
    for (int i = 0; i < 16; ++i) { a[i] = 0.f; b[i] = 0.f; }
#pragma unroll
    for (int i = 0; i < 8; ++i) { a[i] = v[(2 * i) >> 2][(2 * i) & 3] * q; b[i] = v[(2 * i + 1) >> 2][(2 * i + 1) & 3] * q; }
    const v6u_t p = __builtin_amdgcn_cvt_scalef32_2xpk16_fp6_f32(a, b, 1.0f);
    *(v3u_t*)(out + lane * 12) = (v3u_t){p[0], p[1], p[2]};
    if (lane == 0) *sc = mx * (1.f / 7.5f);
}
__device__ __forceinline__ void p0_convert(const float* in, const float* cs, bf16_t* out, size_t n, int gw, int NGW, int lane) {
    for (size_t i = ((size_t)gw * 64 + lane) * 8; i < n; i += (size_t)NGW * 512) {
        f32x4 a = *(const f32x4*)(in + i), b = *(const f32x4*)(in + i + 4);
        if (cs) { const int c = (int)(i & 1023); a = a * *(const f32x4*)(cs + c); b = b * *(const f32x4*)(cs + c + 4); }
        v4u o; o.x = pg8::cvt_pk_bf16(a[0], a[1]); o.y = pg8::cvt_pk_bf16(a[2], a[3]); o.z = pg8::cvt_pk_bf16(b[0], b[1]); o.w = pg8::cvt_pk_bf16(b[2], b[3]);
        *(v4u*)(out + i) = o;
    }
}

namespace da {
typedef short bf16x8 __attribute__((ext_vector_type(8)));
typedef short s16x4 __attribute__((ext_vector_type(4)));
typedef float f32x16 __attribute__((ext_vector_type(16)));
typedef const LAS unsigned char* lcp;
constexpr float LOG2E = 1.4426950408889634f, C2 = 0.125f * LOG2E, THR = 8.f;
constexpr int RSLOT = 16384, LDS_KR = 0, LDS_VR = 4 * RSLOT, SCR_OFF = 8 * RSLOT, COMB_OFF = 0;
#define DA_SBAR() __builtin_amdgcn_sched_barrier(0)
#define DA_PIN(x) asm volatile("" : "+v"(x))
#define DA_MFMA(a, b, c) __builtin_amdgcn_mfma_f32_32x32x16_bf16(a, b, c, 0, 0, 0)
#define DA_WAIT_BAR(N) asm volatile("s_waitcnt vmcnt(" #N ") lgkmcnt(0)\n\ts_barrier" ::: "memory")
#define DA_MX3(a, b, c) __builtin_fmaxf(__builtin_fmaxf((a), (b)), (c))
__device__ __forceinline__ int crow(int r, int hi) { return (r & 3) + 8 * (r >> 2) + 4 * hi; }
__device__ __forceinline__ s16x4 vtr(lcp p) { return __builtin_bit_cast(s16x4, __builtin_amdgcn_ds_read_tr16_b64_v4i16((LAS s16x4*)p)); }
__device__ __forceinline__ unsigned cvtpk(float lo, float hi) { unsigned r; asm("v_cvt_pk_bf16_f32 %0, %1, %2" : "=v"(r) : "v"(lo), "v"(hi)); return r; }
__device__ __forceinline__ void glds16(const void* g, unsigned lds_base) {
    unsigned sv; asm volatile("s_mov_b32 %0, m0\n\ts_mov_b32 m0, %2\n\ts_nop 0\n\tglobal_load_lds_dwordx4 %1, off\n\ts_mov_b32 m0, %0" : "=&s"(sv) : "v"(g), "s"(lds_base) : "memory"); }
__device__ __forceinline__ void glds16_o128(const void* g, unsigned lds_base) {
    unsigned sv; asm volatile("s_mov_b32 %0, m0\n\ts_mov_b32 m0, %2\n\ts_nop 0\n\tglobal_load_lds_dwordx4 %1, off offset:128\n\ts_mov_b32 m0, %0" : "=&s"(sv) : "v"(g), "s"(lds_base) : "memory"); }
__device__ __forceinline__ void kload2(bf16x8* kf, lcp kp, int d0) { kf[2 * d0] = *(const LAS bf16x8*)(kp + d0 * 2048); kf[2 * d0 + 1] = *(const LAS bf16x8*)(kp + d0 * 2048 + 512); }
__device__ __forceinline__ float max16(const f32x16& p) {
    float a = DA_MX3(p[0], p[1], p[2]), b = DA_MX3(p[3], p[4], p[5]); a = DA_MX3(a, p[6], p[7]); b = DA_MX3(b, p[8], p[9]); a = DA_MX3(a, p[10], p[11]); b = DA_MX3(b, p[12], p[13]);
    a = DA_MX3(a, p[14], p[15]); return __builtin_fmaxf(a, b); }
__device__ __forceinline__ float rowmax(const f32x16& p0, const f32x16& p1, float offA, float offB) {
    const float m = __builtin_fmaxf(__builtin_fmaf(max16(p0), C2, offA), __builtin_fmaf(max16(p1), C2, offB));
    auto rr = __builtin_amdgcn_permlane32_swap(__float_as_uint(m), __float_as_uint(m), false, false);
    return __builtin_fmaxf(__uint_as_float(rr[0]), __uint_as_float(rr[1])); }
__device__ __forceinline__ void cmask(f32x16& p0, f32x16& p1, int jb, int qrel, int hi) {
    const int kb = 64 * jb + 4 * hi;
#pragma unroll
    for (int r = 0; r < 16; ++r) { const int kv = kb + (r & 3) + 8 * (r >> 2); if (kv > qrel) p0[r] = -INFINITY; if (kv + 32 > qrel) p1[r] = -INFINITY; } }

__device__ __forceinline__ void attn_epilogue_body(LAS unsigned char* lds, f32x16 (&o)[4], float l_reg, bf16_t* __restrict__ yb, const float* __restrict__ subln_w, float lam,
                                                   size_t rowb, int q0, int h, int wave, int lane) {
    asm volatile("" : "+v"(lane));
    const int r32 = lane & 31, hi = lane >> 5, map = wave >> 2, qs = wave & 3;
    LAS float* wsf = (LAS float*)(lds + SCR_OFF) + wave * 64;
    if (hi == 0) wsf[r32] = 1.f / l_reg;
    float il[16];
#pragma unroll
    for (int g = 0; g < 4; ++g) { const f32x4 t4 = *(const LAS f32x4*)(wsf + 8 * g + 4 * hi); il[4 * g] = t4[0]; il[4 * g + 1] = t4[1]; il[4 * g + 2] = t4[2]; il[4 * g + 3] = t4[3]; }
    __syncthreads();
    LAS float* comb = (LAS float*)(lds + COMB_OFF) + qs * 4096;
    if (map == 1) {
#pragma unroll
        for (int d = 0; d < 4; ++d)
#pragma unroll
            for (int r = 0; r < 16; ++r) comb[crow(r, hi) * 128 + 32 * d + r32] = o[d][r] * il[r];
    }
    __syncthreads();
    if (map == 0) {
        float sw[4];
#pragma unroll
        for (int d = 0; d < 4; ++d) sw[d] = subln_w[32 * d + r32] * (1.f - LAM_INIT);
#pragma unroll
        for (int r = 0; r < 16; ++r) {
            float v[4], ss = 0.f;
#pragma unroll
            for (int d = 0; d < 4; ++d) { v[d] = o[d][r] * il[r] - lam * comb[crow(r, hi) * 128 + 32 * d + r32]; ss += v[d] * v[d]; }
            ss += __shfl_xor(ss, 1); ss += __shfl_xor(ss, 2); ss += __shfl_xor(ss, 4); ss += __shfl_xor(ss, 8); ss += __shfl_xor(ss, 16);
            const float rs = rsqrtf(ss * (1.f / 128.f) + SUBLN_EPS);
            bf16_t* op = yb + (rowb + q0 + crow(r, hi)) * 512 + h * 128 + r32;
#pragma unroll
            for (int d = 0; d < 4; ++d) op[32 * d] = f2bf(v[d] * rs * sw[d]);
        }
    }
    __syncthreads();
}
__device__ __forceinline__ void attn_unit(LAS unsigned char* lds, const bf16_t* __restrict__ z, bf16_t* __restrict__ yb, const float* __restrict__ subln_w, float lam,
                                          int b, int h, int qblk, int wave_, int lane) {
    const int wave = __builtin_amdgcn_readfirstlane(wave_);
    const int r32 = lane & 31, hi = lane >> 5, map = wave >> 2, qs = wave & 3;
    const int q0 = qblk * 128 + qs * 32, NT = 2 * qblk + 2, qrel = qs * 32 + r32;
    const size_t rowb = (size_t)b * SEQ;
    const float slope = exp2f(-2.f * (float)(h + 1)), slope2 = slope * LOG2E, s64 = 64.f * slope2, s32 = 32.f * slope2;
    const unsigned lds0 = (unsigned)(uintptr_t)lds;
    LAS float* wsf = (LAS float*)(lds + SCR_OFF) + wave * 64;
    const bf16_t* ksrc = z + (rowb + lane) * NZ + C_ZK + h * 128 + wave * 8;
    const int pc0 = 2 * wave;
    const bf16_t* vsrc0 = z + (rowb + 16 * (pc0 & 3) + (lane >> 2)) * NZ + C_ZV + h * 128 + 32 * (pc0 >> 2) + (lane & 3) * 8;
    const unsigned kdst = lds0 + LDS_KR + wave * 1024, vdst = lds0 + LDS_VR + pc0 * 1024;
#define DMA_K(t, slot) do { const bf16_t* k_ = ksrc + (size_t)(t) * 64 * NZ; const unsigned d_ = (unsigned)__builtin_amdgcn_readfirstlane(kdst + (slot)); glds16(k_, d_); glds16_o128(k_, d_ + 8192 - 128); } while (0)
#define DMA_V(t, slot) do { const size_t o_ = (size_t)(t) * 64 * NZ; const unsigned d_ = (unsigned)__builtin_amdgcn_readfirstlane(vdst + (slot)); glds16(vsrc0 + o_, d_); glds16(vsrc0 + o_ + 16 * NZ, d_ + 1024); } while (0)
    const lcp vp0 = lds + LDS_VR + ((lane >> 4) & 1) * 32 + (lane & 3) * 8 + (4 * hi + ((lane & 15) >> 2)) * 64;
    const lcp kp0 = lds + LDS_KR + map * 8192 + hi * 1024 + r32 * 16;
    DMA_K(0, 0); DMA_V(0, 0); DMA_K(1, RSLOT);
    bf16x8 qr[4];
    {
        const bf16_t* qp = z + (rowb + q0 + r32) * NZ + C_Q + h * 128 + map * 64 + hi * 8;
#pragma unroll
        for (int d0 = 0; d0 < 4; ++d0) qr[d0] = *(const bf16x8*)(qp + d0 * 16);
    }
    f32x16 bias16;
#pragma unroll
    for (int r = 0; r < 16; ++r) bias16[r] = (8.f * slope) * (float)((r & 3) + 8 * (r >> 2));
    DA_PIN(bias16);
    float mhat = 0.f, l_reg = 0.f, offA = slope2 * (float)(4 * hi);
    f32x16 o[4];
#pragma unroll
    for (int d = 0; d < 4; ++d) o[d] = (f32x16){};
    bool resc = false;
    f32x16 c0, c1; bf16x8 kf[8]; s16x4 vlo[4], vhi[4]; v4u pw0, pw1, pw2, pw3;
#define SL(t) ((((t)) & 3) * RSLOT)
#define EX(v, nm) __builtin_amdgcn_exp2f(__builtin_fmaf((v), C2, (nm)))
#define RESC() do { if (resc) { _Pragma("unroll") for (int d_ = 0; d_ < 4; ++d_) _Pragma("unroll") for (int r = 0; r < 16; ++r) o[d_][r] *= wsf[crow(r, hi)]; } } while (0)
#define PKW(P, i) pg8::cvt_pk_bf16(P[i], P[(i) + 1])
    DMA_K(2, 2 * RSLOT); DMA_K(3, 3 * RSLOT); DMA_V(1, RSLOT);
    DA_WAIT_BAR(10);
#pragma unroll
    for (int d0 = 0; d0 < 4; ++d0) kload2(kf, kp0, d0);
    c0 = DA_MFMA(kf[0], qr[0], bias16); c1 = DA_MFMA(kf[1], qr[0], bias16); c0 = DA_MFMA(kf[2], qr[1], c0); c1 = DA_MFMA(kf[3], qr[1], c1);
    c0 = DA_MFMA(kf[4], qr[2], c0); c1 = DA_MFMA(kf[5], qr[2], c1); c0 = DA_MFMA(kf[6], qr[3], c0); c1 = DA_MFMA(kf[7], qr[3], c1);
    if (NT == 2) cmask(c0, c1, 0, qrel, hi);
    { mhat = rowmax(c0, c1, offA, offA + s32); const float nmh0 = offA - mhat, nmh1 = nmh0 + s32; float sacc = 0.f;
#pragma unroll
      for (int r = 0; r < 16; ++r) { c0[r] = EX(c0[r], nmh0); c1[r] = EX(c1[r], nmh1); sacc += c0[r] + c1[r]; }
      l_reg = sacc; }
    pw0 = (v4u){PKW(c0, 0), PKW(c0, 2), PKW(c0, 4), PKW(c0, 6)}; pw1 = (v4u){PKW(c0, 8), PKW(c0, 10), PKW(c0, 12), PKW(c0, 14)};
    pw2 = (v4u){PKW(c1, 0), PKW(c1, 2), PKW(c1, 4), PKW(c1, 6)}; pw3 = (v4u){PKW(c1, 8), PKW(c1, 10), PKW(c1, 12), PKW(c1, 14)};
    DA_WAIT_BAR(6);
    DMA_K(4, 0); DMA_V(2, 2 * RSLOT);
#pragma unroll
    for (int d0 = 0; d0 < 4; ++d0) kload2(kf, kp0 + RSLOT, d0);
    if (NT == 2) { DA_WAIT_BAR(0); } else { DA_WAIT_BAR(8); }
#define PAF(k) __builtin_bit_cast(bf16x8, pw##k)
#define VFR(i) (bf16x8){vlo[(i) & 3][0], vlo[(i) & 3][1], vlo[(i) & 3][2], vlo[(i) & 3][3], vhi[(i) & 3][0], vhi[(i) & 3][1], vhi[(i) & 3][2], vhi[(i) & 3][3]}
#define VOFF(i) ((((i) & 3) * 4 + ((i) >> 2)) * 1024)
#define VRD(i) do { vlo[(i) & 3] = vtr(vp_ + VOFF(i)); vhi[(i) & 3] = vtr(vp_ + VOFF(i) + 512); DA_SBAR(); } while (0)
#define KRD(G, d0) do { if (G) { kload2(kf, kp0 + sl_next_, d0); DA_SBAR(); } } while (0)
#define GAPA(MF) do { MF; DA_SBAR(); } while (0)
#define GAPB(MF, X, i, nm, A0, A1, EXTRA) do { MF; X[i] = EX(X[i], nm); X[(i) + 1] = EX(X[(i) + 1], nm); sacc += A0; sacc += A1; EXTRA; DA_PIN(X); DA_PIN(sacc); DA_SBAR(); } while (0)
#define STEP(t, MASK, GK, GV, GL) do { DA_SBAR(); \
    const lcp vp_ = vp0 + SL((t) - 1); const int sl_next_ = SL((t) + 1); \
            GAPA(c0 = DA_MFMA(kf[0], qr[0], bias16)); GAPA(c1 = DA_MFMA(kf[1], qr[0], bias16)); GAPA(c0 = DA_MFMA(kf[2], qr[1], c0)); GAPA(c1 = DA_MFMA(kf[3], qr[1], c1)); \
    VRD(0); GAPA(c0 = DA_MFMA(kf[4], qr[2], c0)); VRD(1); GAPA(c1 = DA_MFMA(kf[5], qr[2], c1)); VRD(2); GAPA(c0 = DA_MFMA(kf[6], qr[3], c0)); VRD(3); GAPA(c1 = DA_MFMA(kf[7], qr[3], c1)); \
    offA += s64; \
    if (GK) DMA_K((t) + 4, SL(t)); if (GV) DMA_V((t) + 2, SL((t) + 2)); \
    if (MASK) cmask(c0, c1, (t) - (NT - 2), qrel, hi); \
    { const float rm = rowmax(c0, c1, offA, offA + s32) - mhat; resc = false; \
      if (__builtin_expect(__any(rm > THR), 0)) { const float dl = __builtin_fmaxf(rm, 0.f); mhat += dl; \
          const float f = __builtin_amdgcn_exp2f(-dl); l_reg *= f; if (hi == 0) wsf[r32] = f; resc = true; } } \
    const float nmh0 = offA - mhat, nmh1 = nmh0 + s32; float sacc = 0.f; DA_SBAR(); \
    GAPB(o[0] = DA_MFMA(PAF(0), VFR(0), o[0]), c0, 0, nmh0, 0.f, 0.f, );             VRD(4); \
    GAPB(o[1] = DA_MFMA(PAF(0), VFR(1), o[1]), c0, 2, nmh0, c0[0], c0[1], );         VRD(5); \
    GAPB(o[2] = DA_MFMA(PAF(0), VFR(2), o[2]), c0, 4, nmh0, c0[2], c0[3], );         VRD(6); \
    GAPB(o[3] = DA_MFMA(PAF(0), VFR(3), o[3]), c0, 6, nmh0, c0[4], c0[5], );         VRD(7); \
    GAPB(o[0] = DA_MFMA(PAF(1), VFR(4), o[0]), c0, 8, nmh0, c0[6], c0[7], pw0[0] = PKW(c0, 0); pw0[1] = PKW(c0, 2); DA_PIN(pw0));    VRD(8); \
    GAPB(o[1] = DA_MFMA(PAF(1), VFR(5), o[1]), c0, 10, nmh0, c0[8], c0[9], pw0[2] = PKW(c0, 4); pw0[3] = PKW(c0, 6); DA_PIN(pw0));   VRD(9); \
    GAPB(o[2] = DA_MFMA(PAF(1), VFR(6), o[2]), c0, 12, nmh0, c0[10], c0[11], );      VRD(10); \
    GAPB(o[3] = DA_MFMA(PAF(1), VFR(7), o[3]), c0, 14, nmh0, c0[12], c0[13], );      VRD(11); \
    GAPB(o[0] = DA_MFMA(PAF(2), VFR(8), o[0]), c1, 0, nmh1, c0[14], c0[15], pw1[0] = PKW(c0, 8); pw1[1] = PKW(c0, 10); DA_PIN(pw1));  VRD(12); \
    GAPB(o[1] = DA_MFMA(PAF(2), VFR(9), o[1]), c1, 2, nmh1, c1[0], c1[1], pw1[2] = PKW(c0, 12); pw1[3] = PKW(c0, 14); DA_PIN(pw1));   VRD(13); \
    GAPB(o[2] = DA_MFMA(PAF(2), VFR(10), o[2]), c1, 4, nmh1, c1[2], c1[3], );        VRD(14); \
    GAPB(o[3] = DA_MFMA(PAF(2), VFR(11), o[3]), c1, 6, nmh1, c1[4], c1[5], );        VRD(15); \
    GAPB(o[0] = DA_MFMA(PAF(3), VFR(12), o[0]), c1, 8, nmh1, c1[6], c1[7], pw2[0] = PKW(c1, 0); pw2[1] = PKW(c1, 2); DA_PIN(pw2));   KRD(GL, 0); \
    GAPB(o[1] = DA_MFMA(PAF(3), VFR(13), o[1]), c1, 10, nmh1, c1[8], c1[9], pw2[2] = PKW(c1, 4); pw2[3] = PKW(c1, 6); DA_PIN(pw2));  KRD(GL, 1); \
    GAPB(o[2] = DA_MFMA(PAF(3), VFR(14), o[2]), c1, 12, nmh1, c1[10], c1[11], );     KRD(GL, 2); \
    GAPB(o[3] = DA_MFMA(PAF(3), VFR(15), o[3]), c1, 14, nmh1, c1[12], c1[13], );     KRD(GL, 3); \
    sacc += c1[14]; sacc += c1[15]; l_reg += sacc; \
    pw3[0] = PKW(c1, 8); pw3[1] = PKW(c1, 10); pw3[2] = PKW(c1, 12); pw3[3] = PKW(c1, 14); DA_PIN(pw3); \
    } while (0)
#define ENDW(tt) do { if ((tt) + 4 < NT) { DA_WAIT_BAR(8); } else if ((tt) + 3 < NT) { DA_WAIT_BAR(6); } else if ((tt) + 2 < NT) { DA_WAIT_BAR(4); } else { DA_WAIT_BAR(0); } } while (0)
    int t = 1;
    for (; t + 4 < NT; ++t) {
        STEP(t, false, true, true, true); DA_WAIT_BAR(8); RESC();
    }
    for (; t + 1 < NT; ++t) {
        STEP(t, true, (t + 4 < NT), (t + 2 < NT), (t + 1 < NT)); ENDW(t); RESC();
    }
    STEP(NT - 1, true, false, false, false); RESC();
    { const lcp vp_ = vp0 + SL(NT - 1);
#define DRN(k, i) do { const s16x4 lo_ = vtr(vp_ + VOFF(i)), hh_ = vtr(vp_ + VOFF(i) + 512); \
        o[(i) & 3] = DA_MFMA(PAF(k), ((bf16x8){lo_[0], lo_[1], lo_[2], lo_[3], hh_[0], hh_[1], hh_[2], hh_[3]}), o[(i) & 3]); } while (0)
      DRN(0, 0); DRN(0, 1); DRN(0, 2); DRN(0, 3); DRN(1, 4); DRN(1, 5); DRN(1, 6); DRN(1, 7); DRN(2, 8); DRN(2, 9); DRN(2, 10); DRN(2, 11); DRN(3, 12); DRN(3, 13); DRN(3, 14); DRN(3, 15);
#undef DRN
    }
#undef DMA_K
#undef DMA_V
#undef SL
#undef EX
#undef RESC
#undef PKW
#undef PAF
#undef VFR
#undef VOFF
#undef VRD
#undef KRD
#undef GAPA
#undef GAPB
#undef STEP
#undef ENDW
    { auto rr = __builtin_amdgcn_permlane32_swap(__float_as_uint(l_reg), __float_as_uint(l_reg), false, false); l_reg = __uint_as_float(rr[0]) + __uint_as_float(rr[1]); }
    attn_epilogue_body(lds, o, l_reg, yb, subln_w, lam, rowb, q0, h, wave, lane);
}
}

namespace rw {
typedef short bf16x8 __attribute__((ext_vector_type(8)));
typedef float f32x2 __attribute__((ext_vector_type(2)));
constexpr int CH = 32, ACT_PITCH = 528;
constexpr int OFF_ACT = 0, OFF_RKV = 16896, OFF_VEC = 41472, OFF_G = 82432, OFF_Y = 90624, OFF_NRM = 98816, OFF_SCL = 99328, OFF_CT = 99840, OFF_SCP = 102400;
template <int CTRL> __device__ __forceinline__ float dppf(float x) { return __builtin_bit_cast(float, __builtin_amdgcn_mov_dpp(__builtin_bit_cast(int, x), CTRL, 0xf, 0xf, true)); }
__device__ __forceinline__ float row_allsum(float v) { v += dppf<0x128>(v); v += dppf<0x124>(v); v += dppf<0x122>(v); v += dppf<0x121>(v); return v; }
__device__ __forceinline__ void row_allsum4(float& a, float& b, float& c, float& d) {
#define RW_DPP4(n) "v_add_f32_dpp %0, %0, %0 row_ror:" #n " row_mask:0xf bank_mask:0xf\n\tv_add_f32_dpp %1, %1, %1 row_ror:" #n " row_mask:0xf bank_mask:0xf\n\t" \
                   "v_add_f32_dpp %2, %2, %2 row_ror:" #n " row_mask:0xf bank_mask:0xf\n\tv_add_f32_dpp %3, %3, %3 row_ror:" #n " row_mask:0xf bank_mask:0xf\n\t"
    asm volatile("s_nop 1\n\t" RW_DPP4(8) RW_DPP4(4) RW_DPP4(2) RW_DPP4(1) "s_nop 1" : "+v"(a), "+v"(b), "+v"(c), "+v"(d));
#undef RW_DPP4
}
__device__ __forceinline__ f32x4 ld4bf(const bf16_t* p) { const v2u w = *(const v2u*)p; return (f32x4){pg8::bflo(w.x), pg8::bfhi(w.x), pg8::bflo(w.y), pg8::bfhi(w.y)}; }
__device__ __forceinline__ float fsig(float x) { return __builtin_amdgcn_rcpf(1.f + __expf(-x)); }
__device__ __forceinline__ float ftanh(float x) { return 1.f - 2.f * __builtin_amdgcn_rcpf(1.f + __expf(2.f * x)); }
struct ZRow { v2u r, k, v, w, a; v4u g; };
__device__ __forceinline__ ZRow ldrow(const bf16_t* zr, int c4, int cg) {
    ZRow o; o.r = *(const v2u*)(zr + C_R + c4); o.k = *(const v2u*)(zr + C_K + c4); o.v = *(const v2u*)(zr + C_V + c4); o.w = *(const v2u*)(zr + C_WL + 4 * cg); o.a = *(const v2u*)(zr + C_AL + 4 * cg);
    o.g = *(const v4u*)(zr + C_GL + 8 * cg); return o;
}
__device__ __forceinline__ f32x4 up4(v2u w) { return (f32x4){pg8::bflo(w.x), pg8::bfhi(w.x), pg8::bflo(w.y), pg8::bfhi(w.y)}; }

struct ScanP { const float *mu, *w0, *w2, *a0, *a2, *g2, *k_k, *k_a, *r_k, *lnx_w, *lnx_b; };
__device__ __forceinline__ void scan_unit(LAS unsigned char* lds, const bf16_t* __restrict__ z, bf16_t* __restrict__ ya, const ScanP P, int b, int h, int tid, int wave, int lane) {
    const float* mu = P.mu; const float* w0 = P.w0; const float* w2 = P.w2; const float* a0 = P.a0; const float* a2 = P.a2; const float* g2 = P.g2;
    const float* k_k = P.k_k; const float* k_a = P.k_a; const float* r_k = P.r_k; const float* lnx_w = P.lnx_w; const float* lnx_b = P.lnx_b;
    const size_t rowb = (size_t)b * SEQ;
    const int tl = tid >> 4, cg = tid & 15;
    const int nt = wave & 3, rl = lane & 15, rg = lane >> 4;
    LAS float* rkv = (LAS float*)(lds + OFF_RKV); LAS float* vec = (LAS float*)(lds + OFF_VEC); LAS float* gbuf = (LAS float*)(lds + OFF_G);
    LAS float* ybuf = (LAS float*)(lds + OFF_Y); LAS float* nrm = (LAS float*)(lds + OFF_NRM); LAS float* scl = (LAS float*)(lds + OFF_SCL); LAS float* scp = (LAS float*)(lds + OFF_SCP);
    bf16x8 bfr[8];
    {
        const int col = h * 64 + 16 * nt + rl;
#pragma unroll
        for (int f = 0; f < 8; ++f) {
            const float* src = (f < 2) ? w2 : (f < 4) ? a2 : g2;
            const int kb = ((f < 4) ? 32 * (f & 1) : 32 * (f - 4)) + 8 * rg;
            float e[8];
#pragma unroll
            for (int j = 0; j < 8; ++j) e[j] = src[(size_t)(kb + j) * 512 + col];
            v4u p; p.x = pg8::cvt_pk_bf16(e[0], e[1]); p.y = pg8::cvt_pk_bf16(e[2], e[3]); p.z = pg8::cvt_pk_bf16(e[4], e[5]); p.w = pg8::cvt_pk_bf16(e[6], e[7]);
            bfr[f] = __builtin_bit_cast(bf16x8, p);
        }
    }
    const int mt = wave >> 2;
    const int hc = h * 64 + 16 * nt + rl;
    const float w0c = w0[hc], a0c = a0[hc], kkc = k_k[hc], kac = k_a[hc], rkc = r_k[hc];
    const int c4 = h * 64 + 4 * cg;
    f32x2 St[4];
#pragma unroll
    for (int i = 0; i < 4; ++i) St[i] = (f32x2){0.f, 0.f};
    const int ra = 8 * wave + 2 * rg;
    LAS float* ctab = (LAS float*)(lds + OFF_CT);
    if (tl == 0) {
        LAS float* ct = ctab + cg * 36;
        *(LAS f32x4*)(ct + 0) = *(const f32x4*)(mu + C_R + c4); *(LAS f32x4*)(ct + 4) = *(const f32x4*)(mu + C_K + c4); *(LAS f32x4*)(ct + 8) = *(const f32x4*)(mu + C_V + c4);
        *(LAS f32x4*)(ct + 12) = *(const f32x4*)(mu + C_WL + 4 * cg); *(LAS f32x4*)(ct + 16) = *(const f32x4*)(mu + C_AL + 4 * cg);
        *(LAS f32x4*)(ct + 20) = *(const f32x4*)(mu + C_GL + 8 * cg); *(LAS f32x4*)(ct + 24) = *(const f32x4*)(mu + C_GL + 8 * cg + 4);
        *(LAS f32x4*)(ct + 28) = *(const f32x4*)(lnx_w + c4); *(LAS f32x4*)(ct + 32) = *(const f32x4*)(lnx_b + c4);
    }
    __syncthreads();
    const LAS float* myct = ctab + cg * 36;
    ZRow zc = ldrow(z + (rowb + tl) * NZ, c4, cg), zp;
    if (tl > 0) zp = ldrow(z + (rowb + tl - 1) * NZ, c4, cg); else { zp.r = zp.k = zp.v = zp.w = zp.a = (v2u){0u, 0u}; zp.g = (v4u){0u, 0u, 0u, 0u}; }
    for (int t0 = 0; t0 < SEQ; t0 += CH) {
        {
            const f32x4 cr = up4(zc.r), ck = up4(zc.k), cv = up4(zc.v), cw = up4(zc.w), ca = up4(zc.a);
            const f32x4 cg0 = (f32x4){pg8::bflo(zc.g.x), pg8::bfhi(zc.g.x), pg8::bflo(zc.g.y), pg8::bfhi(zc.g.y)}, cg1 = (f32x4){pg8::bflo(zc.g.z), pg8::bfhi(zc.g.z), pg8::bflo(zc.g.w), pg8::bfhi(zc.g.w)};
            const f32x4 pr = up4(zp.r), pk = up4(zp.k), pv = up4(zp.v), pw = up4(zp.w), pa = up4(zp.a);
            const f32x4 pg0 = (f32x4){pg8::bflo(zp.g.x), pg8::bfhi(zp.g.x), pg8::bflo(zp.g.y), pg8::bfhi(zp.g.y)}, pg1 = (f32x4){pg8::bflo(zp.g.z), pg8::bfhi(zp.g.z), pg8::bflo(zp.g.w), pg8::bfhi(zp.g.w)};
            if (t0 + CH < SEQ) { zc = ldrow(z + (rowb + t0 + CH + tl) * NZ, c4, cg); zp = ldrow(z + (rowb + t0 + CH + tl - 1) * NZ, c4, cg); }
            const f32x4 rs_ = cr + (pr - cr) * *(const LAS f32x4*)(myct + 0), ks_ = ck + (pk - ck) * *(const LAS f32x4*)(myct + 4), vs_ = cv + (pv - cv) * *(const LAS f32x4*)(myct + 8);
            const f32x4 ws_ = cw + (pw - cw) * *(const LAS f32x4*)(myct + 12), as_ = ca + (pa - ca) * *(const LAS f32x4*)(myct + 16);
            const f32x4 g0_ = cg0 + (pg0 - cg0) * *(const LAS f32x4*)(myct + 20), g1_ = cg1 + (pg1 - cg1) * *(const LAS f32x4*)(myct + 24);
            *(LAS f32x4*)(rkv + 0 * 2048 + tl * 64 + 4 * cg) = rs_; *(LAS f32x4*)(rkv + 1 * 2048 + tl * 64 + 4 * cg) = ks_; *(LAS f32x4*)(rkv + 2 * 2048 + tl * 64 + 4 * cg) = vs_;
            LAS unsigned char* ar = lds + OFF_ACT + tl * ACT_PITCH;
            v2u tw; tw.x = pg8::cvt_pk_bf16(ftanh(ws_[0]), ftanh(ws_[1])); tw.y = pg8::cvt_pk_bf16(ftanh(ws_[2]), ftanh(ws_[3]));
            *(LAS v2u*)(ar + 8 * cg) = tw;
            v2u aw; aw.x = pg8::cvt_pk_bf16(as_[0], as_[1]); aw.y = pg8::cvt_pk_bf16(as_[2], as_[3]);
            *(LAS v2u*)(ar + 128 + 8 * cg) = aw;
            v4u gw; gw.x = pg8::cvt_pk_bf16(fsig(g0_[0]), fsig(g0_[1])); gw.y = pg8::cvt_pk_bf16(fsig(g0_[2]), fsig(g0_[3]));
            gw.z = pg8::cvt_pk_bf16(fsig(g1_[0]), fsig(g1_[1])); gw.w = pg8::cvt_pk_bf16(fsig(g1_[2]), fsig(g1_[3]));
            *(LAS v4u*)(ar + 256 + 16 * cg) = gw;
        }
        __syncthreads();
        f32x4 accw = (f32x4){0.f, 0.f, 0.f, 0.f}, acca = accw, accg = accw;
        {
            const LAS unsigned char* ap = lds + OFF_ACT + (16 * mt + rl) * ACT_PITCH + 8 * rg * 2;
#pragma unroll
            for (int f = 0; f < 8; ++f) {
                const bf16x8 a = *(const LAS bf16x8*)(ap + f * 64);
                if (f < 2) accw = __builtin_amdgcn_mfma_f32_16x16x32_bf16(a, bfr[f], accw, 0, 0, 0);
                else if (f < 4) acca = __builtin_amdgcn_mfma_f32_16x16x32_bf16(a, bfr[f], acca, 0, 0, 0);
                else accg = __builtin_amdgcn_mfma_f32_16x16x32_bf16(a, bfr[f], accg, 0, 0, 0);
            }
        }
        float dec[4], av[4], kk[4];
        {
            const int c = 16 * nt + rl;
            float n2[4];
#pragma unroll
            for (int r = 0; r < 4; ++r) {
                const int tok = 16 * mt + 4 * rg + r;
                gbuf[tok * 64 + c] = accg[r];
                const float nx = -(w0c + accw[r]);
                const float sp = nx > 20.f ? nx : __logf(1.f + __expf(nx));
                dec[r] = __expf(-__expf(-sp - 0.5f));
                av[r] = fsig(a0c + acca[r]);
                kk[r] = rkv[1 * 2048 + tok * 64 + c] * kkc;
                n2[r] = kk[r] * kk[r];
            }
            row_allsum4(n2[0], n2[1], n2[2], n2[3]);
            if (rl == 0) {
#pragma unroll
                for (int r = 0; r < 4; ++r) nrm[(16 * mt + 4 * rg + r) * 4 + nt] = n2[r];
            }
        }
        __syncthreads();
        {
            const int c = 16 * nt + rl;
#pragma unroll
            for (int r = 0; r < 4; ++r) {
                const int tok = 16 * mt + 4 * rg + r;
                const f32x4 n4 = *(const LAS f32x4*)(nrm + tok * 4);
                const float ksv = rkv[1 * 2048 + tok * 64 + c], rsv = rkv[0 * 2048 + tok * 64 + c];
                const float inv = __builtin_amdgcn_rcpf(fmaxf(sqrtf((n4[0] + n4[1]) + (n4[2] + n4[3])), 1e-12f));
                const float kkn = kk[r] * inv, beta = kkn * av[r], kmod = ksv * (1.f + (av[r] - 1.f) * kac);
                LAS float* vp = vec + tok * 320 + c;
                vp[0] = dec[r]; vp[64] = beta; vp[128] = -kkn; vp[192] = kmod; vp[256] = dec[r] * rsv;
                float pbr = beta * rsv, pkr = kmod * rsv, pbo = rsv * kmod * rkc, dum = 0.f;
                row_allsum4(pbr, pkr, pbo, dum);
                if (rl == 0) *(LAS f32x4*)(scp + (tok * 4 + nt) * 4) = (f32x4){pbr, pkr, pbo, 0.f};
            }
        }
        __syncthreads();
        if (tid < CH) {
            const f32x4 p0 = *(const LAS f32x4*)(scp + tid * 16), p1 = *(const LAS f32x4*)(scp + tid * 16 + 4), p2 = *(const LAS f32x4*)(scp + tid * 16 + 8), p3 = *(const LAS f32x4*)(scp + tid * 16 + 12);
            *(LAS f32x4*)(scl + 4 * tid) = (p0 + p1) + (p2 + p3);
        }
        __syncthreads();
        {
            const LAS float* vb0 = vec + 4 * rl; const LAS float* rv0 = rkv + 2 * 2048 + ra;
#define RW_DECL(P) f32x4 d4##P, b4##P, n4##P, k4##P, q4##P; f32x2 v2##P, s2##P
#define RW_LOAD(P, tk_) do { d4##P = *(const LAS f32x4*)(vb0 + (tk_) * 320); b4##P = *(const LAS f32x4*)(vb0 + (tk_) * 320 + 64); n4##P = *(const LAS f32x4*)(vb0 + (tk_) * 320 + 128); \
                k4##P = *(const LAS f32x4*)(vb0 + (tk_) * 320 + 192); q4##P = *(const LAS f32x4*)(vb0 + (tk_) * 320 + 256); \
                v2##P = *(const LAS f32x2*)(rv0 + (tk_) * 64); s2##P = *(const LAS f32x2*)(scl + (tk_) * 4); } while (0)
#define RW_STEP(P, tk_) do { \
                f32x2 sa = St[0] * n4##P[0] + St[1] * n4##P[1] + St[2] * n4##P[2] + St[3] * n4##P[3]; \
                f32x2 yy = St[0] * q4##P[0] + St[1] * q4##P[1] + St[2] * q4##P[2] + St[3] * q4##P[3]; \
                float sa0 = sa[0], sa1 = sa[1], yy0 = yy[0], yy1 = yy[1]; \
                row_allsum4(sa0, sa1, yy0, yy1); \
                sa = (f32x2){sa0, sa1}; \
                _Pragma("unroll") for (int i = 0; i < 4; ++i) St[i] = St[i] * d4##P[i] + sa * b4##P[i] + v2##P * k4##P[i]; \
                const f32x2 yo = (f32x2){yy0, yy1} + sa * s2##P[0] + v2##P * s2##P[1]; \
                if (rl == 0) *(LAS f32x2*)(ybuf + (tk_) * 64 + ra) = yo; } while (0)
            RW_DECL(A); RW_DECL(B);
            RW_LOAD(A, 0);
            for (int tk = 0; tk < CH; tk += 2) {
                RW_LOAD(B, tk + 1);
                RW_STEP(A, tk);
                if (tk + 2 < CH) RW_LOAD(A, tk + 2);
                RW_STEP(B, tk + 1);
            }
#undef RW_DECL
#undef RW_LOAD
#undef RW_STEP
        }
        __syncthreads();
        {
            const f32x4 y4 = *(const LAS f32x4*)(ybuf + tl * 64 + 4 * cg);
            const float mean = row_allsum((y4[0] + y4[1]) + (y4[2] + y4[3])) * (1.f / 64.f);
            const f32x4 dv = y4 - mean;
            const float var = row_allsum((dv[0] * dv[0] + dv[1] * dv[1]) + (dv[2] * dv[2] + dv[3] * dv[3])) * (1.f / 64.f);
            const float rs_ = rsqrtf(var + GN_EPS);
            const f32x4 yn = dv * rs_ * *(const LAS f32x4*)(myct + 28) + *(const LAS f32x4*)(myct + 32);
            const float bonus = scl[tl * 4 + 2];
            const f32x4 vs_ = *(const LAS f32x4*)(rkv + 2 * 2048 + tl * 64 + 4 * cg), g4 = *(const LAS f32x4*)(gbuf + tl * 64 + 4 * cg);
            const f32x4 o = (yn + vs_ * bonus) * g4;
            v2u w; w.x = pg8::cvt_pk_bf16(o[0], o[1]); w.y = pg8::cvt_pk_bf16(o[2], o[3]);
            *(v2u*)(ya + (rowb + t0 + tl) * 512 + c4) = w;
        }
        __syncthreads();
    }
}
}

typedef __bf16 bf16x2_t __attribute__((ext_vector_type(2)));
__device__ __forceinline__ float dot2bf(unsigned a, unsigned b, float c) { return __builtin_amdgcn_fdot2_f32_bf16(__builtin_bit_cast(bf16x2_t, a), __builtin_bit_cast(bf16x2_t, b), c, false); }
__device__ __forceinline__ unsigned f2ord(float f) { const unsigned u = __float_as_uint(f); return (u & 0x80000000u) ? ~u : (u | 0x80000000u); }
__device__ __forceinline__ float ord2f(unsigned o) { return __uint_as_float((o & 0x80000000u) ? (o ^ 0x80000000u) : ~o); }
__device__ __forceinline__ unsigned row_allmax_u32(unsigned v) {
    v = max(v, (unsigned)__builtin_amdgcn_update_dpp(0, (int)v, 0x128, 0xf, 0xf, false));
    v = max(v, (unsigned)__builtin_amdgcn_update_dpp(0, (int)v, 0x124, 0xf, 0xf, false));
    v = max(v, (unsigned)__builtin_amdgcn_update_dpp(0, (int)v, 0x122, 0xf, 0xf, false));
    v = max(v, (unsigned)__builtin_amdgcn_update_dpp(0, (int)v, 0x121, 0xf, 0xf, false));
    return v;
}

constexpr int TK_PITCH = 272, TK_HALF = 128 * TK_PITCH;
typedef short tk_bf16x8 __attribute__((ext_vector_type(8)));
__device__ __forceinline__ void topk_loadq(tk_bf16x8 (&qa)[8], const bf16_t* __restrict__ qb, int t0, int h, int lane) {
    const bf16_t* qp = qb + (size_t)(t0 + (lane & 15)) * 2048 + h * 256 + 8 * (lane >> 4);
#pragma unroll
    for (int i = 0; i < 8; ++i) qa[i] = *(const tk_bf16x8*)(qp + i * 32);
}
__device__ __forceinline__ void topk_item(const tk_bf16x8 (&qa)[8], const LAS unsigned char* klds, int* __restrict__ ids, float* __restrict__ gates, int t0, int h, int lane) {
    const int rl = lane & 15, rg = lane >> 4;
    unsigned top[2][4];
#pragma unroll
    for (int c = 0; c < 2; ++c) {
        f32x4 acc[8];
#pragma unroll
        for (int nt = 0; nt < 8; ++nt) acc[nt] = (f32x4){64.f, 64.f, 64.f, 64.f};
        const LAS unsigned char* kp = klds + c * TK_HALF + rl * TK_PITCH + 16 * rg;
#pragma unroll
        for (int ks = 0; ks < 4; ++ks) {
#pragma unroll
            for (int nt = 0; nt < 8; ++nt) { const tk_bf16x8 b = *(const LAS tk_bf16x8*)(kp + nt * 16 * TK_PITCH + ks * 64); acc[nt] = __builtin_amdgcn_mfma_f32_16x16x32_bf16(qa[c * 4 + ks], b, acc[nt], 0, 0, 0); }
            __builtin_amdgcn_sched_barrier(0);
        }
        unsigned k[4][8];
#pragma unroll
        for (int r = 0; r < 4; ++r) {
#pragma unroll
            for (int nt = 0; nt < 8; ++nt) k[r][nt] = (__float_as_uint(fmaxf(acc[nt][r], 1.f)) & ~127u) | (unsigned)(127 - (nt * 16 + rl));
#define TK_CE(i, j) do { const unsigned a_ = max(k[r][i], k[r][j]), b_ = min(k[r][i], k[r][j]); k[r][i] = a_; k[r][j] = b_; } while (0)
            TK_CE(0, 1); TK_CE(2, 3); TK_CE(4, 5); TK_CE(6, 7); TK_CE(0, 2); TK_CE(1, 3); TK_CE(4, 6); TK_CE(5, 7); TK_CE(1, 2); TK_CE(5, 6);
            TK_CE(0, 4); TK_CE(1, 5); TK_CE(2, 6); TK_CE(3, 7); TK_CE(2, 4); TK_CE(3, 5); TK_CE(1, 2); TK_CE(3, 4); TK_CE(5, 6);
#undef TK_CE
        }
        unsigned tp[4] = {0u, 0u, 0u, 0u};
        for (int round = 0; round < 16; ++round) {
#pragma unroll
            for (int r = 0; r < 4; ++r) {
                const unsigned m = row_allmax_u32(k[r][0]);
                tp[r] = (rl == round) ? m : tp[r];
                const bool win = (k[r][0] == m);
                k[r][0] = win ? k[r][1] : k[r][0]; k[r][1] = win ? k[r][2] : k[r][1]; k[r][2] = win ? k[r][3] : k[r][2]; k[r][3] = win ? k[r][4] : k[r][3];
                k[r][4] = win ? k[r][5] : k[r][4]; k[r][5] = win ? k[r][6] : k[r][5]; k[r][6] = win ? k[r][7] : k[r][6]; k[r][7] = win ? 0u : k[r][7];
            }
        }
#pragma unroll
        for (int r = 0; r < 4; ++r) top[c][r] = tp[r];
    }
    const int rowbase = lane & 48;
    float v1[4]; int n1[4], ptr[4], myid[4]; unsigned k2[4], myv[4];
#pragma unroll
    for (int r = 0; r < 4; ++r) { v1[r] = __uint_as_float(top[0][r] & ~127u); n1[r] = 127 - (int)(top[0][r] & 127u); ptr[r] = 0; k2[r] = (unsigned)__builtin_amdgcn_ds_bpermute(rowbase * 4, (int)top[1][r]); myid[r] = 0; myv[r] = 0u; }
    for (int round = 0; round < 16; ++round) {
#pragma unroll
        for (int r = 0; r < 4; ++r) {
            const float head = v1[r] + __uint_as_float(k2[r] & ~127u);
            const unsigned key = (ptr[r] < 16) ? ((__float_as_uint(head) & ~15u) | (unsigned)(15 - rl)) : 0u;
            const unsigned m = row_allmax_u32(key);
            const bool win = (key == m);
            const unsigned wid = row_allmax_u32(win ? (unsigned)(n1[r] * 128 + (127 - (int)(k2[r] & 127u))) + 1u : 0u);
            myid[r] = (rl == round) ? (int)wid - 1 : myid[r];
            myv[r] = (rl == round) ? m : myv[r];
            ptr[r] += win ? 1 : 0;
            k2[r] = (unsigned)__builtin_amdgcn_ds_bpermute((rowbase + (ptr[r] & 15)) * 4, (int)top[1][r]);
        }
    }
#pragma unroll
    for (int r = 0; r < 4; ++r) {
        const float val = __uint_as_float(myv[r] & ~15u);
        const float vmax = __uint_as_float((unsigned)__builtin_amdgcn_ds_bpermute(rowbase * 4, (int)__float_as_uint(val)));
        const float e = __expf(val - vmax);
        const float sum = rw::row_allsum(e);
        gates[(size_t)(t0 + 4 * rg + r) * 128 + h * 16 + rl] = e / sum; ids[(size_t)(t0 + 4 * rg + r) * 128 + h * 16 + rl] = myid[r];
    }
}

typedef float f32x2 __attribute__((ext_vector_type(2)));
__device__ __forceinline__ void peer_token(const bf16_t* __restrict__ x2b, const float* __restrict__ ssq2, const int* __restrict__ ids, const float* __restrict__ gates,
                                           const unsigned char* __restrict__ U8, const unsigned char* __restrict__ V8, const float* __restrict__ usc, const float* __restrict__ vsc,
                                           const float* __restrict__ fw, float* __restrict__ out, int t, int lane) {
    const int l16 = lane * 16;
    f32x2 hx[8];
    {
        const v4u h0 = *(const v4u*)(x2b + (size_t)t * DM + l16), h1 = *(const v4u*)(x2b + (size_t)t * DM + l16 + 8);
        const unsigned hw[8] = {h0.x, h0.y, h0.z, h0.w, h1.x, h1.y, h1.z, h1.w};
#pragma unroll
        for (int i = 0; i < 8; ++i) hx[i] = (f32x2){pg8::bflo(hw[i]), pg8::bfhi(hw[i])};
    }
    const int idA = ids[(size_t)t * 128 + lane], idB = ids[(size_t)t * 128 + 64 + lane];
    const float rs = rsqrtf(pg8::ssq_sum16(ssq2 + (size_t)t * 16) * (1.f / DM) + NORM_EPS);
    const float suA = rs * usc[idA], suB = rs * usc[idB];
    const float svA = gates[(size_t)t * 128 + lane] * vsc[idA], svB = gates[(size_t)t * 128 + 64 + lane] * vsc[idB];
    f32x2 y[8];
#pragma unroll
    for (int i = 0; i < 8; ++i) y[i] = (f32x2){0.f, 0.f};
    const int bit0 = lane & 1, bit1 = (lane >> 1) & 1, bit2 = (lane >> 2) & 1;
    const int myk = 4 * bit0 + 2 * bit1 + bit2;
    for (int g = 0; g < 16; ++g) {
        const int idsel = (g < 8) ? idA : idB; const float susel = (g < 8) ? suA : suB, svsel = (g < 8) ? svA : svB; const int lb = (g * 8) & 63;
        v3u_t uw[8], vw[8];
#pragma unroll
        for (int k = 0; k < 8; ++k) { const int e = __builtin_amdgcn_readlane(idsel, lb + k); uw[k] = *(const v3u_t*)(U8 + (size_t)e * 768 + lane * 12); vw[k] = *(const v3u_t*)(V8 + (size_t)e * 768 + lane * 12); }
        float d[8];
#pragma unroll
        for (int k = 0; k < 8; ++k) {
            const v32f_t f = __builtin_amdgcn_cvt_scalef32_pk32_f32_fp6((v6u_t){uw[k][0], uw[k][1], uw[k][2], 0u, 0u, 0u}, 1.0f);
            f32x2 a = (f32x2){0.f, 0.f};
#pragma unroll
            for (int i = 0; i < 8; ++i) a += (f32x2){f[2 * i], f[2 * i + 1]} * hx[i];
            d[k] = a[0] + a[1];
            __builtin_amdgcn_sched_barrier(0);
        }
        float r4[4];
#pragma unroll
        for (int k = 0; k < 4; ++k) { const float send = bit0 ? d[k] : d[k + 4], keep = bit0 ? d[k + 4] : d[k]; r4[k] = keep + __shfl_xor(send, 1); }
        float r2[2];
#pragma unroll
        for (int k = 0; k < 2; ++k) { const float send = bit1 ? r4[k] : r4[k + 2], keep = bit1 ? r4[k + 2] : r4[k]; r2[k] = keep + __shfl_xor(send, 2); }
        float r1;
        { const float send = bit2 ? r2[0] : r2[1], keep = bit2 ? r2[1] : r2[0]; r1 = keep + __shfl_xor(send, 4); }
        r1 += __shfl_xor(r1, 8); r1 += __shfl_xor(r1, 16); r1 += __shfl_xor(r1, 32);
        const float dd = r1 * __shfl(susel, lb + myk);
        const float act = 0.5f * dd * (1.f + erff(dd * 0.70710678118654752f)) * __shfl(svsel, lb + myk);
#pragma unroll
        for (int k = 0; k < 8; ++k) {
            const float a = __uint_as_float((unsigned)__builtin_amdgcn_readlane((int)__float_as_uint(act), ((k & 1) << 2) | (k & 2) | ((k >> 2) & 1)));
            const f32x2 a2 = (f32x2){a, a};
            const v32f_t f = __builtin_amdgcn_cvt_scalef32_pk32_f32_fp6((v6u_t){vw[k][0], vw[k][1], vw[k][2], 0u, 0u, 0u}, 1.0f);
#pragma unroll
            for (int i = 0; i < 8; ++i) y[i] += (f32x2){f[2 * i], f[2 * i + 1]} * a2;
            __builtin_amdgcn_sched_barrier(0);
        }
    }
    float* orow = out + (size_t)t * DM + l16;
    float ss = 0.f;
    f32x4 o4[4];
#pragma unroll
    for (int i = 0; i < 4; ++i) { o4[i] = (f32x4){hx[2 * i][0] + y[2 * i][0], hx[2 * i][1] + y[2 * i][1], hx[2 * i + 1][0] + y[2 * i + 1][0], hx[2 * i + 1][1] + y[2 * i + 1][1]};
        ss += (o4[i][0] * o4[i][0] + o4[i][1] * o4[i][1]) + (o4[i][2] * o4[i][2] + o4[i][3] * o4[i][3]); }
    ss = wave_sum(ss);
    const float r = rsqrtf(ss * (1.f / DM) + NORM_EPS);
#pragma unroll
    for (int i = 0; i < 4; ++i) *(f32x4*)(orow + 4 * i) = o4[i] * r * *(const f32x4*)(fw + l16 + 4 * i);
}

__global__ void __launch_bounds__(NWAVES * 64, 2) mk_fwd(Args args) {
    extern __shared__ __attribute__((aligned(16))) unsigned char lds_raw[];
    LAS unsigned char* lds = (LAS unsigned char*)lds_raw;
    volatile LAS unsigned* MISC = (volatile LAS unsigned*)(lds + MISC_OFF);
    const int tid = threadIdx.x, lane = tid & 63, wave = __builtin_amdgcn_readfirstlane(tid >> 6);
    const int G = gridDim.x; const int bx = blockIdx.x; const int vcu = (G % 8 == 0) ? (bx % 8) * (G / 8) + bx / 8 : bx;
    unsigned char* ws = args.ws;
    unsigned* ctl = (unsigned*)(ws + WS_CTL);
    for (int u = tid; u < (LDS_BYTES - LDSCTL_OFF) / 4; u += NWAVES * 64) ((LAS unsigned*)(lds + LDSCTL_OFF))[u] = 0u;
    __syncthreads();
    XcdBarrier bar = xcd_barrier_post(ctl + CW_BAR + args.li * XCD_BAR_WORDS, MISC + 8);
    const int lo = args.ph_lo, hi = args.ph_hi;
#define IN(k) (lo <= (k) && (k) < hi)
#define BOTH(k) (IN(k) && IN((k) + 1))
    bf16_t* WinT = (bf16_t*)(ws + WS_WIN); bf16_t* PaT = (bf16_t*)(ws + WS_PA); bf16_t* PbT = (bf16_t*)(ws + WS_PB); bf16_t* WoT = (bf16_t*)(ws + WS_WO);
    bf16_t* WqT = (bf16_t*)(ws + WS_WQ); bf16_t* KeysB = (bf16_t*)(ws + WS_KEYS);
    float* rstd1 = (float*)(ws + WS_RSTD1); float* ssq2 = (float*)(ws + WS_RSTD2); float* scal = (float*)(ws + WS_SCAL);
    unsigned char* U8 = ws + WS_U; unsigned char* V8 = ws + WS_V; float* usc = (float*)(ws + WS_USC); float* vsc = (float*)(ws + WS_VSC);
    bf16_t* xb = (bf16_t*)(ws + WS_XB); bf16_t* ya = (bf16_t*)(ws + WS_YA); bf16_t* yb = (bf16_t*)(ws + WS_YB); bf16_t* x2b = (bf16_t*)(ws + WS_X2B);
    bf16_t* z = (bf16_t*)(ws + WS_Z); bf16_t* qb = (bf16_t*)(ws + WS_Q);
    bf16_t* merged = (bf16_t*)(ws + WS_MERGED);
    const int gw = vcu * NWAVES + wave, NGW = G * NWAVES;

    if (IN(0)) {
        LAS float* scr = (LAS float*)(lds + wave * 16384);
        constexpr int I_IN = (DM / 64) * (NZ / 32), I_PA = (512 / 64) * (DM / 32), I_WO = (DM / 64) * (DM / 32), I_WQ = (DM / 64) * (2048 / 32);
        constexpr int NITEMS = I_IN + 2 * I_PA + I_WO + I_WQ;
        for (int it = gw; it < NITEMS; it += NGW) {
            int r = it;
            if (r < I_IN) { p0_transpose_item(args.in[2], args.in[1], DM, NZ, WinT, scr, r, lane); continue; } r -= I_IN;
            if (r < I_PA) { p0_transpose_item(args.in[19], nullptr, 512, DM, PaT, scr, r, lane); continue; } r -= I_PA;
            if (r < I_PA) { p0_transpose_item(args.in[20], nullptr, 512, DM, PbT, scr, r, lane); continue; } r -= I_PA;
            if (r < I_WO) { p0_transpose_item(args.in[21], nullptr, DM, DM, WoT, scr, r, lane); continue; } r -= I_WO;
            p0_transpose_item(args.in[23], args.in[22], DM, 2048, WqT, scr, r, lane);
        }
        p0_convert(args.in[24], nullptr, KeysB, (size_t)16 * 128 * 128, gw, NGW, lane);
        for (int e = gw; e < 2 * NEXP; e += NGW) {
            const bool isu = e < NEXP; const int row = isu ? e : e - NEXP;
            p0_row_fp6((isu ? args.in[25] : args.in[26]) + (size_t)row * DM, isu ? args.in[22] : nullptr, (isu ? U8 : V8) + (size_t)row * 768, (isu ? usc : vsc) + row, lane);
        }
        for (int m = gw; m < T_TOK; m += NGW) {
            const f32x4* xr = (const f32x4*)(args.in[0] + (size_t)m * DM) + lane;
            f32x4 v[4]; float s = 0.f;
#pragma unroll
            for (int j = 0; j < 4; ++j) { v[j] = xr[64 * j]; s += (v[j][0] * v[j][0] + v[j][1] * v[j][1]) + (v[j][2] * v[j][2] + v[j][3] * v[j][3]); }
            s = wave_sum(s);
            v2u* o8 = (v2u*)(xb + (size_t)m * DM) + lane;
#pragma unroll
            for (int j = 0; j < 4; ++j) { v2u w; w.x = pg8::cvt_pk_bf16(v[j][0], v[j][1]); w.y = pg8::cvt_pk_bf16(v[j][2], v[j][3]); o8[64 * j] = w; }
            if (lane == 0) rstd1[m] = rsqrtf(s * (1.f / DM) + NORM_EPS);
        }
        if (gw == 0) {
            const float a = wave_sum(args.in[14][lane] * args.in[15][lane]), b = wave_sum(args.in[16][lane] * args.in[17][lane]);
            if (lane == 0) scal[0] = __expf(a) - __expf(b) + LAM_INIT;
        }
        if (BOTH(0)) xcd_barrier(bar);
    }
    if (IN(1)) {
        pg8::Gemm g{xb, WinT, DM, DM, DM}; pg8::StaticOrder S; S.init(T_TOK, NZ, G, bx);
        pg8::EpiRowScale<false> E{z, NZ, rstd1};
        for (int rep = 0; rep < REPS(1); ++rep) pg8::gemm_phase(lds, g, S, E);
        if (BOTH(1)) xcd_barrier(bar);
    }
    if (IN(2)) {
        {
            const rw::ScanP P{args.in[3], args.in[4], args.in[5], args.in[6], args.in[7], args.in[8], args.in[9], args.in[10], args.in[11], args.in[12], args.in[13]};
            for (int rep = 0; rep < REPS(2); ++rep) for (int u = vcu; u < NB * 8; u += G) rw::scan_unit(lds, z, ya, P, u >> 3, u & 7, tid, wave, lane);
        }
        const float lam = scal[0];
        __syncthreads();
        for (int i = 0;; ++i) {
            int idx = vcu + i * G; if (idx >= 2048 * REPS(10)) break;
            idx &= 2047;
            const int slot = idx >> 8, v = idx & 255, bh = v >> 1, a = (v & 1) * 4 + (slot >> 1), qblk = (slot & 1) ? 15 - a : a;
            da::attn_unit(lds, z, yb, args.in[18], lam, bh >> 2, bh & 3, qblk, wave, lane);
        }
        if (BOTH(2)) xcd_barrier(bar);
    }
    if (IN(3)) {
        pg8::Gemm g{ya, PaT, 512, 512, 512}; pg8::StaticOrder S; S.init(T_TOK, DM, G, bx);
        pg8::EpiGate<false> E{merged, z, C_GA};
        pg8::gemm_phase(lds, g, S, E);
        if (BOTH(3)) xcd_barrier(bar);
    }
    if (IN(4)) {
        pg8::Gemm g{yb, PbT, 512, 512, 512}; pg8::StaticOrder S; S.init(T_TOK, DM, G, bx);
        pg8::EpiGate<true> E{merged, z, C_GB};
        pg8::gemm_phase(lds, g, S, E);
        if (BOTH(4)) xcd_barrier(bar);
    }
    if (IN(5)) {
        pg8::Gemm g{merged, WoT, DM, DM, DM}; pg8::StaticOrder S; S.init(T_TOK, DM, G, bx);
        pg8::EpiX2 E{args.in[0], args.out, x2b, ssq2};
        pg8::gemm_phase(lds, g, S, E);
        if (BOTH(5)) xcd_barrier(bar);
    }
    if (IN(6)) {
        pg8::Gemm g{x2b, WqT, DM, DM, DM}; pg8::StaticOrder S; S.init(T_TOK, 2048, G, bx);
        pg8::EpiRowScale<true> E{qb, 2048, ssq2};
        for (int rep = 0; rep < REPS(6); ++rep) pg8::gemm_phase(lds, g, S, E);
        if (BOTH(6)) xcd_barrier(bar);
    }
    if (IN(7)) {
        int* ids = (int*)(ws + WS_IDS); float* gates = (float*)(ws + WS_GATES);
        for (int rep = 0; rep < REPS(7); ++rep)
        for (int h = 0; h < 8; ++h) {
            __syncthreads();
            {
                const bf16_t* ksrc = KeysB + (size_t)h * 2 * 128 * 128;
#pragma unroll
                for (int i = 0; i < 8; ++i) { const int chunk = tid + i * 512, row = chunk >> 4, cc = chunk & 15;
                    *(LAS v4u*)(lds + (row >> 7) * TK_HALF + (row & 127) * TK_PITCH + cc * 16) = *(const v4u*)(ksrc + (size_t)row * 128 + cc * 8); }
            }
            __syncthreads();
            for (int tile = gw; tile < 4096; tile += NGW) {
                tk_bf16x8 qa[8];
                topk_loadq(qa, qb, tile * 16, h, lane);
                topk_item(qa, lds, ids, gates, tile * 16, h, lane);
            }
        }
        if (BOTH(7)) xcd_barrier(bar);
    }
    if (IN(8)) {
        const int* ids = (const int*)(ws + WS_IDS); const float* gates = (const float*)(ws + WS_GATES);
        for (int t = gw; t < T_TOK; t += NGW) peer_token(x2b, ssq2, ids, gates, U8, V8, usc, vsc, args.in[27], args.out, t, lane);
    }
#undef IN
#undef BOTH
}

extern "C" void kernel_launch(void* const* d_in, const int* in_sizes, int n_in, void* d_out, int out_size, void* d_ws, size_t ws_size, hipStream_t stream) {
    static int grid = 0;
    if (grid == 0) {
        if (n_in != 28 || in_sizes[0] != T_TOK * DM || out_size != T_TOK * DM || ws_size < WS_END) {
            fprintf(stderr, "kernel_launch: unexpected shapes / workspace (n_in %d, ws %zu < %zu)\n", n_in, ws_size, (size_t)WS_END); grid = -1; return; }
        int dev = 0, cus = 0;
        if (hipGetDevice(&dev) != hipSuccess || hipDeviceGetAttribute(&cus, hipDeviceAttributeMultiprocessorCount, dev) != hipSuccess) { grid = -1; return; }
        if (hipFuncSetAttribute((const void*)mk_fwd, hipFuncAttributeMaxDynamicSharedMemorySize, LDS_BYTES) != hipSuccess) { fprintf(stderr, "kernel_launch: hipFuncSetAttribute failed\n"); grid = -1; return; }
        grid = cus;
    }
    if (grid < 0) return;
    unsigned char* ws = (unsigned char*)d_ws;
    float* out = (float*)d_out;
    (void)hipMemsetAsync(ws + WS_CTL, 0, 1 * MiB, stream);
    Args a{};
    for (int i = 0; i < 28; ++i) a.in[i] = (const float*)d_in[i];
    a.out = out; a.ws = ws;
    a.ph_lo = 0; a.ph_hi = 9; a.li = 0;
    hipLaunchKernelGGL(mk_fwd, dim3(grid), dim3(NWAVES * 64), LDS_BYTES, stream, a);
}
```

```cpp
#include <hip/hip_runtime.h>
#include <stdint.h>
#include <cstdio>

typedef unsigned short bf16_t;
typedef unsigned int u32;

#ifndef PROBE_REP
#define PROBE_REP 0
#endif
#define REPS(k) (((PROBE_REP >> (k)) & 1) ? 2 : 1)
constexpr int T_TOK = 65536, DM = 1024, SEQ = 2048, NB = 32;
constexpr int NZ = 5376;
constexpr int C_R = 0, C_K = 512, C_V = 1024, C_WL = 1536, C_AL = 1600, C_GL = 1664, C_Q = 1792, C_ZK = 2304, C_ZV = 2816, C_GA = 3328, C_GB = 4352;
constexpr int NEXP = 16384;
constexpr float NORM_EPS = 1e-6f, GN_EPS = 64e-5f, SUBLN_EPS = 1e-5f;
constexpr float LAM_INIT = 0.2f;

constexpr size_t MiB = 1u << 20;
constexpr size_t WS_CTL = 0;
constexpr size_t WS_WIN = 1 * MiB;
constexpr size_t WS_PA = 12 * MiB;
constexpr size_t WS_PB = 13 * MiB;
constexpr size_t WS_WO = 14 * MiB;
constexpr size_t WS_WQ = 16 * MiB;
constexpr size_t WS_KEYS = 20 * MiB;
constexpr size_t WS_RSTD1 = 21 * MiB;
constexpr size_t WS_RSTD2 = 58 * MiB;
constexpr size_t WS_SCAL = 23 * MiB;
constexpr size_t WS_U = 24 * MiB;
constexpr size_t WS_V = 40 * MiB;
constexpr size_t WS_USC = 56 * MiB;
constexpr size_t WS_VSC = 57 * MiB;
constexpr size_t WS_XB = 88 * MiB;
constexpr size_t WS_YA = WS_XB;
constexpr size_t WS_YB = WS_XB + 64 * MiB;
constexpr size_t WS_X2B = WS_XB;
constexpr size_t WS_Z = 216 * MiB;
constexpr size_t WS_Q = WS_Z;
constexpr size_t WS_IDS = WS_Z + 256 * MiB;
constexpr size_t WS_GATES = WS_Z + 288 * MiB;
constexpr size_t WS_MERGED = 888 * MiB;
constexpr size_t WS_END = 1016 * MiB;

__device__ __forceinline__ float bf2f(bf16_t h) { return __uint_as_float(((u32)h) << 16); }
__device__ __forceinline__ bf16_t f2bf(float f) { u32 u = __float_as_uint(f); u += 0x7fffu + ((u >> 16) & 1u); return (bf16_t)(u >> 16); }
__device__ __forceinline__ float wave_sum(float v) {
#pragma unroll
    for (int o = 1; o < 64; o <<= 1) v += __shfl_xor(v, o);
    return v;
}
__device__ __forceinline__ float sigmoidf_(float x) { return 1.f / (1.f + __expf(-x)); }

namespace pg8 {
#define PG8_LAS __attribute__((address_space(3)))
typedef short bf16x8 __attribute__((ext_vector_type(8)));
typedef float f32x4 __attribute__((ext_vector_type(4)));
typedef unsigned u32x4 __attribute__((ext_vector_type(4)));
constexpr int BM = 256, BK = 64, HALF = 128, HTB = HALF * BK * 2  , STAGE_BYTES = 8 * HTB, NXCD = 8, WGM = 8;

__host__ __device__ __forceinline__ int lds_byte(int r, int c) { const int st = (r >> 4) * 2 + (c >> 5), rr = r & 15, cc = c & 31, ob = rr * 64 + cc * 2; return st * 1024 + (ob ^ (((ob >> 9) & 1) << 5)); }
__host__ __device__ __forceinline__ void stage_rc(int b, int& R, int& C) { const int st = b / 1024, sb = b % 1024, swz = sb ^ (((sb >> 9) & 1) << 5); R = (st >> 1) * 16 + swz / 64; C = (st & 1) * 32 + (swz % 64) / 2; }
__host__ __device__ __forceinline__ int perm32(int rho) { const int n = rho >> 4, i = rho & 15; return 8 * (i >> 2) + 4 * n + (i & 3); }

struct Unit { int pm, pn; };
struct Gemm { const bf16_t* A; const bf16_t* Bt; int lda, ldb, K; };

struct StaticOrder {
    int nM, nN, nwg, G, c;
    __host__ __device__ void init(int M, int N, int G_, int c_) { nM = M / BM; nN = N / BM; nwg = nM * nN; G = G_; c = c_; }
    __host__ __device__ bool next(int i, Unit& u) const {
        const long L = (long)i * G + c; if (L >= nwg) return false;
        int wgid = (int)L; { const int q = nwg / NXCD, r = nwg % NXCD, xcd = wgid % NXCD, off = wgid / NXCD; wgid = (xcd < r ? xcd * (q + 1) : r * (q + 1) + (xcd - r) * q) + off; }
        const int nig = WGM * nN, gid = wgid / nig, fm = gid * WGM, gsz = (nM - fm) < WGM ? (nM - fm) : WGM;
        u.pm = fm + ((wgid % nig) % gsz); u.pn = (wgid % nig) / gsz; return true;
    }
};
typedef float f32x2_c __attribute__((ext_vector_type(2))); typedef __bf16 bf16x2_c __attribute__((ext_vector_type(2)));
__device__ __forceinline__ unsigned cvt_pk_bf16(float lo, float hi) { const f32x2_c v = {lo, hi}; const bf16x2_c b = __builtin_convertvector(v, bf16x2_c); return __builtin_bit_cast(unsigned, b); }
__device__ __forceinline__ float bflo(unsigned w) { return __uint_as_float(w << 16); }
__device__ __forceinline__ float bfhi(unsigned w) { return __uint_as_float(w & 0xffff0000u); }

__device__ __forceinline__ float ssq_sum16(const float* p) {
    const f32x4 a = *(const f32x4*)p, b = *(const f32x4*)(p + 4), c = *(const f32x4*)(p + 8), d = *(const f32x4*)(p + 12);
    return (((a[0] + a[1]) + (a[2] + a[3])) + ((b[0] + b[1]) + (b[2] + b[3]))) + (((c[0] + c[1]) + (c[2] + c[3])) + ((d[0] + d[1]) + (d[2] + d[3])));
}
template <bool SSQ> struct EpiRowScale {
    static constexpr bool PERM = true;
    bf16_t* O; int ldc; const float* rs;
    __device__ __forceinline__ void operator()(const f32x4 (&acc)[2][2][4][2], const Unit& u, int wr, int wc, int fr, int fq) const {
        const int row0 = u.pm * BM + wr * 64 + fr, col0 = u.pn * BM + wc * 32 + 8 * fq;
#pragma unroll
        for (int ai = 0; ai < 2; ++ai)
#pragma unroll
            for (int m = 0; m < 4; ++m) {
                const int row = row0 + ai * HALF + m * 16;
                float s; if (SSQ) s = rsqrtf(ssq_sum16(rs + (size_t)row * 16) * (1.f / 1024.f) + NORM_EPS); else s = rs[row];
                bf16_t* rowp = O + (size_t)row * ldc + col0;
#pragma unroll
                for (int bj = 0; bj < 2; ++bj) {
                    const f32x4 v0 = acc[ai][bj][m][0] * s, v1 = acc[ai][bj][m][1] * s;
                    u32x4 w; w.x = cvt_pk_bf16(v0[0], v0[1]); w.y = cvt_pk_bf16(v0[2], v0[3]); w.z = cvt_pk_bf16(v1[0], v1[1]); w.w = cvt_pk_bf16(v1[2], v1[3]);
                    *(u32x4*)(rowp + bj * HALF) = w;
                }
            }
    }
};
template <bool ACCUM> struct EpiGate {
    static constexpr bool PERM = true;
    bf16_t* mg; const bf16_t* z; int gcol;
    __device__ __forceinline__ void operator()(const f32x4 (&acc)[2][2][4][2], const Unit& u, int wr, int wc, int fr, int fq) const {
        const int row0 = u.pm * BM + wr * 64 + fr, col0 = u.pn * BM + wc * 32 + 8 * fq;
#pragma unroll
        for (int ai = 0; ai < 2; ++ai)
#pragma unroll
            for (int m = 0; m < 4; ++m) {
                const int row = row0 + ai * HALF + m * 16;
                const bf16_t* gp = z + (size_t)row * NZ + gcol + col0;
                bf16_t* rowp = mg + (size_t)row * DM + col0;
#pragma unroll
                for (int bj = 0; bj < 2; ++bj) {
                    const u32x4 g = *(const u32x4*)(gp + bj * HALF);
                    const f32x4 a0 = acc[ai][bj][m][0], a1 = acc[ai][bj][m][1];
                    float r[8];
                    r[0] = sigmoidf_(bflo(g.x)) * a0[0]; r[1] = sigmoidf_(bfhi(g.x)) * a0[1]; r[2] = sigmoidf_(bflo(g.y)) * a0[2]; r[3] = sigmoidf_(bfhi(g.y)) * a0[3];
                    r[4] = sigmoidf_(bflo(g.z)) * a1[0]; r[5] = sigmoidf_(bfhi(g.z)) * a1[1]; r[6] = sigmoidf_(bflo(g.w)) * a1[2]; r[7] = sigmoidf_(bfhi(g.w)) * a1[3];
                    if (ACCUM) { const u32x4 o = *(const u32x4*)(rowp + bj * HALF);
                        r[0] += bflo(o.x); r[1] += bfhi(o.x); r[2] += bflo(o.y); r[3] += bfhi(o.y); r[4] += bflo(o.z); r[5] += bfhi(o.z); r[6] += bflo(o.w); r[7] += bfhi(o.w); }
                    u32x4 w; w.x = cvt_pk_bf16(r[0], r[1]); w.y = cvt_pk_bf16(r[2], r[3]); w.z = cvt_pk_bf16(r[4], r[5]); w.w = cvt_pk_bf16(r[6], r[7]);
                    *(u32x4*)(rowp + bj * HALF) = w;
                }
            }
    }
};
struct EpiX2 {
    static constexpr bool PERM = true;
    const float* x; float* x2; bf16_t* x2b; float* ssq;
    __device__ __forceinline__ void operator()(const f32x4 (&acc)[2][2][4][2], const Unit& u, int wr, int wc, int fr, int fq) const {
        const int row0 = u.pm * BM + wr * 64 + fr, col0 = u.pn * BM + wc * 32 + 8 * fq;
#pragma unroll
        for (int ai = 0; ai < 2; ++ai)
#pragma unroll
            for (int m = 0; m < 4; ++m) {
                const int row = row0 + ai * HALF + m * 16;
                const size_t off = (size_t)row * DM + col0;
                float ss = 0.f;
#pragma unroll
                for (int bj = 0; bj < 2; ++bj) {
                    const f32x4 x0 = *(const f32x4*)(x + off + bj * HALF), x1 = *(const f32x4*)(x + off + bj * HALF + 4);
                    const f32x4 o0 = x0 + acc[ai][bj][m][0], o1 = x1 + acc[ai][bj][m][1];
                    u32x4 w; w.x = cvt_pk_bf16(o0[0], o0[1]); w.y = cvt_pk_bf16(o0[2], o0[3]); w.z = cvt_pk_bf16(o1[0], o1[1]); w.w = cvt_pk_bf16(o1[2], o1[3]);
                    *(u32x4*)(x2b + off + bj * HALF) = w;
                    ss += (o0[0] * o0[0] + o0[1] * o0[1]) + (o0[2] * o0[2] + o0[3] * o0[3]) + (o1[0] * o1[0] + o1[1] * o1[1]) + (o1[2] * o1[2] + o1[3] * o1[3]);
                }
                ss += __shfl_xor(ss, 16); ss += __shfl_xor(ss, 32);
                if (fq == 0) ssq[(size_t)row * 16 + (u.pn & 3) * 4 + wc] = ss;
            }
    }
};

template <class Epi, class Sched>
__device__ __forceinline__ void gemm_phase(PG8_LAS unsigned char* lds, const Gemm g, const Sched& S, const Epi& E) {
    const int tid = threadIdx.x, wid = __builtin_amdgcn_readfirstlane(tid >> 6), lane = tid & 63, wr = wid >> 2, wc = wid & 3, fr = lane & 15, fq = lane >> 4;
    const int K = g.K, nt = K / BK;
    unsigned voffA[2], voffB[2];
#pragma unroll
    for (int i = 0; i < 2; ++i) { int R, C; stage_rc(tid * 16 + i * 8192, R, C); const int Rb = Epi::PERM ? ((R & ~31) + perm32(R & 31)) : R;
        voffA[i] = (unsigned)(R * g.lda + C) * 2u; voffB[i] = (unsigned)(Rb * g.ldb + C) * 2u; }
    const size_t kstep = (size_t)(BK * 2);
    const size_t hstepA = (size_t)HALF * g.lda * 2, hstepB = (size_t)HALF * g.ldb * 2;
    const size_t tstepA = 2 * hstepA, tstepB = 2 * hstepB;
    const unsigned ldsw = (unsigned)wid * 1024u;
    const int aoff = lds_byte(wr * 64 + fr, fq * 8), boff = lds_byte(wc * 32 + fr, fq * 8);
#define PG8_SA(b, h) (((b) * 2 + (h)) * HTB)
#define PG8_SB(b, h) ((4 + (b) * 2 + (h)) * HTB)
#define PG8_STAGE(bufoff, gbase, voff) do { _Pragma("unroll") for (int _i = 0; _i < 2; ++_i) \
        __builtin_amdgcn_global_load_lds((const unsigned*)((const char*)(gbase) + (voff)[_i]), (PG8_LAS unsigned*)(lds + (bufoff) + ldsw + _i * 8192), 16, 0, 0); } while (0)
#define PG8_LDA(dst, b, h) do { _Pragma("unroll") for (int m = 0; m < 4; ++m) _Pragma("unroll") for (int k = 0; k < 2; ++k) dst[m][k] = *(const PG8_LAS bf16x8*)(lds + PG8_SA(b, h) + aoff + m * 2048 + k * 1024); } while (0)
#define PG8_LDB(dst, b, h) do { _Pragma("unroll") for (int n = 0; n < 2; ++n) _Pragma("unroll") for (int k = 0; k < 2; ++k) dst[n][k] = *(const PG8_LAS bf16x8*)(lds + PG8_SB(b, h) + boff + n * 2048 + k * 1024); } while (0)
#define PG8_MMA(ai, bj, At, Bt) do { __builtin_amdgcn_s_setprio(1); _Pragma("unroll") for (int m = 0; m < 4; ++m) _Pragma("unroll") for (int n = 0; n < 2; ++n) _Pragma("unroll") for (int k = 0; k < 2; ++k) \
        acc[ai][bj][m][n] = __builtin_amdgcn_mfma_f32_16x16x32_bf16(Bt[n][k], At[m][k], acc[ai][bj][m][n], 0, 0, 0); __builtin_amdgcn_s_setprio(0); } while (0)
#define PG8_WAIT_V(n) asm volatile("s_waitcnt vmcnt(" #n ")" ::: "memory")
#define PG8_WAIT_L(n) asm volatile("s_waitcnt lgkmcnt(" #n ")" ::: "memory")
#define PG8_BAR __builtin_amdgcn_s_barrier()
#define PG8_SCHED __builtin_amdgcn_sched_barrier(0)
    Unit cur, nxt; int ui = 0;
    if (!S.next(0, cur)) return;
    f32x4 acc[2][2][4][2];
#pragma unroll
    for (int a = 0; a < 2; ++a)
#pragma unroll
        for (int b = 0; b < 2; ++b)
#pragma unroll
            for (int m = 0; m < 4; ++m)
#pragma unroll
                for (int n = 0; n < 2; ++n) acc[a][b][m][n] = (f32x4){0.f, 0.f, 0.f, 0.f};
    bf16x8 At[4][2], B0[2][2], B1[2][2];
    const char* cA = (const char*)g.A + (size_t)cur.pm * tstepA; const char* cB = (const char*)g.Bt + (size_t)cur.pn * tstepB;
    PG8_STAGE(PG8_SB(0, 0), cB, voffB); PG8_STAGE(PG8_SB(0, 1), cB + hstepB, voffB); PG8_STAGE(PG8_SA(0, 0), cA, voffA); PG8_STAGE(PG8_SA(0, 1), cA + hstepA, voffA);
    if (wr == 1) PG8_BAR;
    PG8_WAIT_V(2); PG8_BAR;
    PG8_STAGE(PG8_SB(1, 0), cB + kstep, voffB); PG8_STAGE(PG8_SA(1, 0), cA + kstep, voffA); PG8_STAGE(PG8_SB(1, 1), cB + hstepB + kstep, voffB);
    PG8_WAIT_V(6); PG8_BAR;
    for (;;) {
        const bool has_next = S.next(ui + 1, nxt);
        const char* nA = has_next ? (const char*)g.A + (size_t)nxt.pm * tstepA : cA; const char* nB = has_next ? (const char*)g.Bt + (size_t)nxt.pn * tstepB : cB;
        for (int t = 0; t < nt; t += 2) {
            const bool last = (t == nt - 2);
            const char* a1 = cA + (size_t)(t + 1) * kstep;
            const char* a2 = last ? nA : cA + (size_t)(t + 2) * kstep; const char* b2 = last ? nB : cB + (size_t)(t + 2) * kstep;
            const char* a3 = a2 + kstep; const char* b3 = b2 + kstep;
            PG8_LDB(B0, 0, 0); PG8_LDB(B1, 0, 1); PG8_SCHED; PG8_LDA(At, 0, 0); PG8_STAGE(PG8_SA(1, 1), a1 + hstepA, voffA);
            PG8_WAIT_V(8); PG8_WAIT_L(0); PG8_BAR; PG8_MMA(0, 0, At, B0); PG8_MMA(0, 1, At, B1); PG8_BAR; PG8_SCHED;
            PG8_LDA(At, 0, 1); PG8_STAGE(PG8_SB(0, 0), b2, voffB); PG8_STAGE(PG8_SB(0, 1), b2 + hstepB, voffB); PG8_STAGE(PG8_SA(0, 0), a2, voffA);
            PG8_WAIT_V(8); PG8_WAIT_L(0); PG8_BAR; PG8_MMA(1, 0, At, B0); PG8_MMA(1, 1, At, B1); PG8_BAR; PG8_SCHED;
            PG8_LDB(B0, 1, 0); PG8_LDB(B1, 1, 1); PG8_SCHED; PG8_LDA(At, 1, 0); PG8_STAGE(PG8_SA(0, 1), a2 + hstepA, voffA);
            PG8_WAIT_V(8); PG8_WAIT_L(0); PG8_BAR; PG8_MMA(0, 0, At, B0); PG8_MMA(0, 1, At, B1); PG8_BAR; PG8_SCHED;
            PG8_LDA(At, 1, 1); PG8_STAGE(PG8_SB(1, 0), b3, voffB); PG8_STAGE(PG8_SB(1, 1), b3 + hstepB, voffB); PG8_STAGE(PG8_SA(1, 0), a3, voffA);
            PG8_WAIT_V(8); PG8_WAIT_L(0); PG8_BAR; PG8_MMA(1, 0, At, B0); PG8_MMA(1, 1, At, B1); PG8_BAR; PG8_SCHED;
        }
        if (wr == 0) PG8_BAR;
        E(acc, cur, wr, wc, fr, fq);
        if (!has_next) break;
#pragma unroll
        for (int a = 0; a < 2; ++a)
#pragma unroll
            for (int b = 0; b < 2; ++b)
#pragma unroll
                for (int m = 0; m < 4; ++m)
#pragma unroll
                    for (int n = 0; n < 2; ++n) acc[a][b][m][n] = (f32x4){0.f, 0.f, 0.f, 0.f};
        cur = nxt; cA = nA; cB = nB; ++ui;
        if (wr == 1) PG8_BAR;
    }
    PG8_WAIT_V(0);
    PG8_BAR;
#undef PG8_SA
#undef PG8_SB
#undef PG8_STAGE
#undef PG8_LDA
#undef PG8_LDB
#undef PG8_MMA
#undef PG8_WAIT_V
#undef PG8_WAIT_L
#undef PG8_BAR
#undef PG8_SCHED
}
}

constexpr int NWAVES = 8;
constexpr int LDS_RING_BYTES = 131072, LDSCTL_OFF = 143360, MISC_OFF = LDSCTL_OFF + 320, LDS_BYTES = 147456;
#define LAS __attribute__((address_space(3)))
#define GAS __attribute__((address_space(1)))
typedef float f32x4 __attribute__((ext_vector_type(4)));
typedef unsigned v4u __attribute__((ext_vector_type(4)));
typedef unsigned v2u __attribute__((ext_vector_type(2)));
#define LDS_WAIT() asm volatile("s_waitcnt lgkmcnt(0)" ::: "memory")

constexpr int CW_BAR = 4096;
#define XB_TMO      128
#define XB_XCNT(j)  (256  + 64 * (j))
#define XB_XSUB(j)  (1280 + 64 * (j))
#define XB_XGEN(j)  (2304 + 64 * (j))
#define XB_TOP      3328
#define XB_TOPGEN   3392
#define XCD_BAR_WORDS 3456
#define XB_SPIN_CAP (1u << 20)
__device__ __forceinline__ unsigned xb_ld(unsigned* p)              { return __hip_atomic_load(p, __ATOMIC_RELAXED, __HIP_MEMORY_SCOPE_AGENT); }
__device__ __forceinline__ unsigned xb_add(unsigned* p, unsigned v) { return __hip_atomic_fetch_add(p, v, __ATOMIC_RELAXED, __HIP_MEMORY_SCOPE_AGENT); }
__device__ __forceinline__ unsigned xb_xcc_id() { return (unsigned)__builtin_amdgcn_s_getreg((3 << 11) | 20) & 0xFu; }
#define XB_SPIN(cond, bar) do { unsigned _sp = 0; while (cond) { __builtin_amdgcn_s_sleep(1); \
    if ((++_sp & 255u) == 0u) { if (xb_ld(&(bar)[XB_TMO])) break; if (_sp > XB_SPIN_CAP) { atomicAdd(&(bar)[XB_TMO], 1u); break; } } } } while (0)
struct XcdBarrier { unsigned* bar; unsigned x; volatile LAS unsigned* st; };
__device__ __forceinline__ XcdBarrier xcd_barrier_post(unsigned* bar, volatile LAS unsigned* st) {
    XcdBarrier b; b.bar = bar; b.x = xb_xcc_id(); b.st = st;
    if (threadIdx.x == 0) (void)xb_add(&bar[XB_XCNT(b.x)], 1u);
    return b;
}
__device__ __forceinline__ void xcd_barrier_complete(unsigned* bar, unsigned x, unsigned& nloc, unsigned& nx) {
    const unsigned G = gridDim.x * gridDim.y * gridDim.z;
    unsigned sum, cnt, mine, sp = 0u;
    for (;;) {
        sum = 0u; cnt = 0u; mine = 0u;
#pragma unroll
        for (unsigned j = 0; j < 16; ++j) { const unsigned c = xb_ld(&bar[XB_XCNT(j)]); sum += c; cnt += (c > 0u) ? 1u : 0u; mine = (j == x) ? c : mine; }
        if (sum == G) break;
        __builtin_amdgcn_s_sleep(1);
        if ((++sp & 255u) == 0u) { if (xb_ld(&bar[XB_TMO])) break; if (sp > XB_SPIN_CAP) { atomicAdd(&bar[XB_TMO], 1u); break; } }
    }
    nloc = mine > 0u ? mine : 1u; nx = cnt > 0u ? cnt : 1u;
}
__device__ __forceinline__ void xcd_barrier(const XcdBarrier& b) {
    asm volatile("s_waitcnt vmcnt(0)" ::: "memory");
    __syncthreads();
    if (threadIdx.x == 0) {
        unsigned* bar = b.bar;
        __builtin_amdgcn_s_waitcnt(0);
        unsigned nloc = b.st[0], nx = b.st[1];
        if (nloc == 0u) { xcd_barrier_complete(bar, b.x, nloc, nx); b.st[0] = nloc; b.st[1] = nx; }
        const unsigned old = xb_add(&bar[XB_XSUB(b.x)], 1u);
        const unsigned gen = old / nloc;
        if (old + 1u == (gen + 1u) * nloc) {
            __builtin_amdgcn_fence(__ATOMIC_RELEASE, "agent");
            asm volatile("s_waitcnt vmcnt(0)" ::: "memory");
            const unsigned og = xb_add(&bar[XB_TOP], 1u);
            const unsigned tg = og / nx;
            if (og + 1u == (tg + 1u) * nx) xb_add(&bar[XB_TOPGEN], 1u);
            else XB_SPIN(xb_ld(&bar[XB_TOPGEN]) == tg, bar);
            __builtin_amdgcn_fence(__ATOMIC_ACQUIRE, "agent");
            xb_add(&bar[XB_XGEN(b.x)], 1u);
            asm volatile("s_waitcnt vmcnt(0)" ::: "memory");
        } else {
            XB_SPIN(xb_ld(&bar[XB_XGEN(b.x)]) == gen, bar);
            __builtin_amdgcn_fence(__ATOMIC_ACQUIRE, "agent");
            asm volatile("s_waitcnt vmcnt(0)" ::: "memory");
        }
    }
    __syncthreads();
}

struct Args { const float* in[28]; float* out; unsigned char* ws; int ph_lo, ph_hi, li, pad; };

__device__ __forceinline__ void p0_transpose_item(const float* W, const float* sc, int K, int N, bf16_t* WT, LAS float* scr, int item, int lane) {
    const int nblk = N / 32, kb = item / nblk, nb = item % nblk, k0 = 64 * kb, n0 = 32 * nb;
#pragma unroll 8
    for (int i = 0; i < 32; ++i) { const int kk = 2 * i + (lane >> 5); const float s = sc ? sc[k0 + kk] : 1.f; scr[kk * 33 + (lane & 31)] = W[(size_t)(k0 + kk) * N + n0 + (lane & 31)] * s; }
    LDS_WAIT(); asm volatile("" ::: "memory");
    const int c = lane & 7;
#pragma unroll
    for (int j = 0; j < 4; ++j) { const int n = (lane >> 3) + 8 * j; const LAS float* s = scr + (8 * c) * 33 + n;
        v4u o; o.x = pg8::cvt_pk_bf16(s[0 * 33], s[1 * 33]); o.y = pg8::cvt_pk_bf16(s[2 * 33], s[3 * 33]); o.z = pg8::cvt_pk_bf16(s[4 * 33], s[5 * 33]); o.w = pg8::cvt_pk_bf16(s[6 * 33], s[7 * 33]);
        *(v4u*)(WT + (size_t)(n0 + n) * K + k0 + 8 * c) = o; }
    LDS_WAIT(); asm volatile("" ::: "memory");
}
typedef unsigned v6u_t __attribute__((ext_vector_type(6)));
typedef unsigned v3u_t __attribute__((ext_vector_type(3)));
typedef float v16f_t __attribute__((ext_vector_type(16)));
typedef float v32f_t __attribute__((ext_vector_type(32)));
__device__ __forceinline__ void p0_row_fp6(const float* in, const float* cs, unsigned char* out, float* sc, int lane) {
    f32x4 v[4]; float mx = 0.f;
#pragma unroll
    for (int i = 0; i < 4; ++i) { v[i] = *(const f32x4*)(in + lane * 16 + 4 * i); if (cs) v[i] = v[i] * *(const f32x4*)(cs + lane * 16 + 4 * i);
        mx = fmaxf(mx, fmaxf(fmaxf(fabsf(v[i][0]), fabsf(v[i][1])), fmaxf(fabsf(v[i][2]), fabsf(v[i][3])))); }
#pragma unroll
    for (int o = 1; o < 64; o <<= 1) mx = fmaxf(mx, __shfl_xor(mx, o));
    mx = fmaxf(mx, 1e-30f);
    const float q = 7.5f / mx;
    v16f_t a, b;
#pragma unroll
    for (int i = 0; i < 16; ++i) { a[i] = 0.f; b[i] = 0.f; }
#pragma unroll
    for (int i = 0; i < 8; ++i) { a[i] = v[(2 * i) >> 2][(2 * i) & 3] * q; b[i] = v[(2 * i + 1) >> 2][(2 * i + 1) & 3] * q; }
    const v6u_t p = __builtin_amdgcn_cvt_scalef32_2xpk16_fp6_f32(a, b, 1.0f);
    *(v3u_t*)(out + lane * 12) = (v3u_t){p[0], p[1], p[2]};
    if (lane == 0) *sc = mx * (1.f / 7.5f);
}
__device__ __forceinline__ void p0_convert(const float* in, const float* cs, bf16_t* out, size_t n, int gw, int NGW, int lane) {
    for (size_t i = ((size_t)gw * 64 + lane) * 8; i < n; i += (size_t)NGW * 512) {
        f32x4 a = *(const f32x4*)(in + i), b = *(const f32x4*)(in + i + 4);
        if (cs) { const int c = (int)(i & 1023); a = a * *(const f32x4*)(cs + c); b = b * *(const f32x4*)(cs + c + 4); }
        v4u o; o.x = pg8::cvt_pk_bf16(a[0], a[1]); o.y = pg8::cvt_pk_bf16(a[2], a[3]); o.z = pg8::cvt_pk_bf16(b[0], b[1]); o.w = pg8::cvt_pk_bf16(b[2], b[3]);
        *(v4u*)(out + i) = o;
    }
}

namespace da {
typedef short bf16x8 __attribute__((ext_vector_type(8)));
typedef short s16x4 __attribute__((ext_vector_type(4)));
typedef float f32x16 __attribute__((ext_vector_type(16)));
typedef const LAS unsigned char* lcp;
constexpr float LOG2E = 1.4426950408889634f, C2 = 0.125f * LOG2E, THR = 8.f;
constexpr int RSLOT = 16384, LDS_KR = 0, LDS_VR = 4 * RSLOT, SCR_OFF = 8 * RSLOT, COMB_OFF = 0;
#define DA_SBAR() __builtin_amdgcn_sched_barrier(0)
#define DA_PIN(x) asm volatile("" : "+v"(x))
#define DA_MFMA(a, b, c) __builtin_amdgcn_mfma_f32_32x32x16_bf16(a, b, c, 0, 0, 0)
#define DA_WAIT_BAR(N) asm volatile("s_waitcnt vmcnt(" #N ") lgkmcnt(0)\n\ts_barrier" ::: "memory")
#define DA_MX3(a, b, c) __builtin_fmaxf(__builtin_fmaxf((a), (b)), (c))
__device__ __forceinline__ int crow(int r, int hi) { return (r & 3) + 8 * (r >> 2) + 4 * hi; }
__device__ __forceinline__ s16x4 vtr(lcp p) { return __builtin_bit_cast(s16x4, __builtin_amdgcn_ds_read_tr16_b64_v4i16((LAS s16x4*)p)); }
__device__ __forceinline__ unsigned cvtpk(float lo, float hi) { unsigned r; asm("v_cvt_pk_bf16_f32 %0, %1, %2" : "=v"(r) : "v"(lo), "v"(hi)); return r; }
__device__ __forceinline__ void glds16(const void* g, unsigned lds_base) {
    unsigned sv; asm volatile("s_mov_b32 %0, m0\n\ts_mov_b32 m0, %2\n\ts_nop 0\n\tglobal_load_lds_dwordx4 %1, off\n\ts_mov_b32 m0, %0" : "=&s"(sv) : "v"(g), "s"(lds_base) : "memory"); }
__device__ __forceinline__ void glds16_o128(const void* g, unsigned lds_base) {
    unsigned sv; asm volatile("s_mov_b32 %0, m0\n\ts_mov_b32 m0, %2\n\ts_nop 0\n\tglobal_load_lds_dwordx4 %1, off offset:128\n\ts_mov_b32 m0, %0" : "=&s"(sv) : "v"(g), "s"(lds_base) : "memory"); }
__device__ __forceinline__ void kload2(bf16x8* kf, lcp kp, int d0) { kf[2 * d0] = *(const LAS bf16x8*)(kp + d0 * 2048); kf[2 * d0 + 1] = *(const LAS bf16x8*)(kp + d0 * 2048 + 512); }
__device__ __forceinline__ float max16(const f32x16& p) {
    float a = DA_MX3(p[0], p[1], p[2]), b = DA_MX3(p[3], p[4], p[5]); a = DA_MX3(a, p[6], p[7]); b = DA_MX3(b, p[8], p[9]); a = DA_MX3(a, p[10], p[11]); b = DA_MX3(b, p[12], p[13]);
    a = DA_MX3(a, p[14], p[15]); return __builtin_fmaxf(a, b); }
__device__ __forceinline__ float rowmax(const f32x16& p0, const f32x16& p1, float offA, float offB) {
    const float m = __builtin_fmaxf(__builtin_fmaf(max16(p0), C2, offA), __builtin_fmaf(max16(p1), C2, offB));
    auto rr = __builtin_amdgcn_permlane32_swap(__float_as_uint(m), __float_as_uint(m), false, false);
    return __builtin_fmaxf(__uint_as_float(rr[0]), __uint_as_float(rr[1])); }
__device__ __forceinline__ void cmask(f32x16& p0, f32x16& p1, int jb, int qrel, int hi) {
    const int kb = 64 * jb + 4 * hi;
#pragma unroll
    for (int r = 0; r < 16; ++r) { const int kv = kb + (r & 3) + 8 * (r >> 2); if (kv > qrel) p0[r] = -INFINITY; if (kv + 32 > qrel) p1[r] = -INFINITY; } }

__device__ __forceinline__ void attn_epilogue_body(LAS unsigned char* lds, f32x16 (&o)[4], float l_reg, bf16_t* __restrict__ yb, const float* __restrict__ subln_w, float lam,
                                                   size_t rowb, int q0, int h, int wave, int lane) {
    asm volatile("" : "+v"(lane));
    const int r32 = lane & 31, hi = lane >> 5, map = wave >> 2, qs = wave & 3;
    LAS float* wsf = (LAS float*)(lds + SCR_OFF) + wave * 64;
    if (hi == 0) wsf[r32] = 1.f / l_reg;
    float il[16];
#pragma unroll
    for (int g = 0; g < 4; ++g) { const f32x4 t4 = *(const LAS f32x4*)(wsf + 8 * g + 4 * hi); il[4 * g] = t4[0]; il[4 * g + 1] = t4[1]; il[4 * g + 2] = t4[2]; il[4 * g + 3] = t4[3]; }
    __syncthreads();
    LAS float* comb = (LAS float*)(lds + COMB_OFF) + qs * 4096;
    if (map == 1) {
#pragma unroll
        for (int d = 0; d < 4; ++d)
#pragma unroll
            for (int r = 0; r < 16; ++r) comb[crow(r, hi) * 128 + 32 * d + r32] = o[d][r] * il[r];
    }
    __syncthreads();
    if (map == 0) {
        float sw[4];
#pragma unroll
        for (int d = 0; d < 4; ++d) sw[d] = subln_w[32 * d + r32] * (1.f - LAM_INIT);
#pragma unroll
        for (int r = 0; r < 16; ++r) {
            float v[4], ss = 0.f;
#pragma unroll
            for (int d = 0; d < 4; ++d) { v[d] = o[d][r] * il[r] - lam * comb[crow(r, hi) * 128 + 32 * d + r32]; ss += v[d] * v[d]; }
            ss += __shfl_xor(ss, 1); ss += __shfl_xor(ss, 2); ss += __shfl_xor(ss, 4); ss += __shfl_xor(ss, 8); ss += __shfl_xor(ss, 16);
            const float rs = rsqrtf(ss * (1.f / 128.f) + SUBLN_EPS);
            bf16_t* op = yb + (rowb + q0 + crow(r, hi)) * 512 + h * 128 + r32;
#pragma unroll
            for (int d = 0; d < 4; ++d) op[32 * d] = f2bf(v[d] * rs * sw[d]);
        }
    }
    __syncthreads();
}
__device__ __forceinline__ void attn_unit(LAS unsigned char* lds, const bf16_t* __restrict__ z, bf16_t* __restrict__ yb, const float* __restrict__ subln_w, float lam,
                                          int b, int h, int qblk, int wave_, int lane) {
    const int wave = __builtin_amdgcn_readfirstlane(wave_);
    const int r32 = lane & 31, hi = lane >> 5, map = wave >> 2, qs = wave & 3;
    const int q0 = qblk * 128 + qs * 32, NT = 2 * qblk + 2, qrel = qs * 32 + r32;
    const size_t rowb = (size_t)b * SEQ;
    const float slope = exp2f(-2.f * (float)(h + 1)), slope2 = slope * LOG2E, s64 = 64.f * slope2, s32 = 32.f * slope2;
    const unsigned lds0 = (unsigned)(uintptr_t)lds;
    LAS float* wsf = (LAS float*)(lds + SCR_OFF) + wave * 64;
    const bf16_t* ksrc = z + (rowb + lane) * NZ + C_ZK + h * 128 + wave * 8;
    const int pc0 = 2 * wave;
    const bf16_t* vsrc0 = z + (rowb + 16 * (pc0 & 3) + (lane >> 2)) * NZ + C_ZV + h * 128 + 32 * (pc0 >> 2) + (lane & 3) * 8;
    const unsigned kdst = lds0 + LDS_KR + wave * 1024, vdst = lds0 + LDS_VR + pc0 * 1024;
#define DMA_K(t, slot) do { const bf16_t* k_ = ksrc + (size_t)(t) * 64 * NZ; const unsigned d_ = (unsigned)__builtin_amdgcn_readfirstlane(kdst + (slot)); glds16(k_, d_); glds16_o128(k_, d_ + 8192 - 128); } while (0)
#define DMA_V(t, slot) do { const size_t o_ = (size_t)(t) * 64 * NZ; const unsigned d_ = (unsigned)__builtin_amdgcn_readfirstlane(vdst + (slot)); glds16(vsrc0 + o_, d_); glds16(vsrc0 + o_ + 16 * NZ, d_ + 1024); } while (0)
    const lcp vp0 = lds + LDS_VR + ((lane >> 4) & 1) * 32 + (lane & 3) * 8 + (4 * hi + ((lane & 15) >> 2)) * 64;
    const lcp kp0 = lds + LDS_KR + map * 8192 + hi * 1024 + r32 * 16;
    DMA_K(0, 0); DMA_V(0, 0); DMA_K(1, RSLOT);
    bf16x8 qr[4];
    {
        const bf16_t* qp = z + (rowb + q0 + r32) * NZ + C_Q + h * 128 + map * 64 + hi * 8;
#pragma unroll
        for (int d0 = 0; d0 < 4; ++d0) qr[d0] = *(const bf16x8*)(qp + d0 * 16);
    }
    f32x16 bias16;
#pragma unroll
    for (int r = 0; r < 16; ++r) bias16[r] = (8.f * slope) * (float)((r & 3) + 8 * (r >> 2));
    DA_PIN(bias16);
    float mhat = 0.f, l_reg = 0.f, offA = slope2 * (float)(4 * hi);
    f32x16 o[4];
#pragma unroll
    for (int d = 0; d < 4; ++d) o[d] = (f32x16){};
    bool resc = false;
    f32x16 c0, c1; bf16x8 kf[8]; s16x4 vlo[4], vhi[4]; v4u pw0, pw1, pw2, pw3;
#define SL(t) ((((t)) & 3) * RSLOT)
#define EX(v, nm) __builtin_amdgcn_exp2f(__builtin_fmaf((v), C2, (nm)))
#define RESC() do { if (resc) { _Pragma("unroll") for (int d_ = 0; d_ < 4; ++d_) _Pragma("unroll") for (int r = 0; r < 16; ++r) o[d_][r] *= wsf[crow(r, hi)]; } } while (0)
#define PKW(P, i) pg8::cvt_pk_bf16(P[i], P[(i) + 1])
    DMA_K(2, 2 * RSLOT); DMA_K(3, 3 * RSLOT); DMA_V(1, RSLOT);
    DA_WAIT_BAR(10);
#pragma unroll
    for (int d0 = 0; d0 < 4; ++d0) kload2(kf, kp0, d0);
    c0 = DA_MFMA(kf[0], qr[0], bias16); c1 = DA_MFMA(kf[1], qr[0], bias16); c0 = DA_MFMA(kf[2], qr[1], c0); c1 = DA_MFMA(kf[3], qr[1], c1);
    c0 = DA_MFMA(kf[4], qr[2], c0); c1 = DA_MFMA(kf[5], qr[2], c1); c0 = DA_MFMA(kf[6], qr[3], c0); c1 = DA_MFMA(kf[7], qr[3], c1);
    if (NT == 2) cmask(c0, c1, 0, qrel, hi);
    { mhat = rowmax(c0, c1, offA, offA + s32); const float nmh0 = offA - mhat, nmh1 = nmh0 + s32; float sacc = 0.f;
#pragma unroll
      for (int r = 0; r < 16; ++r) { c0[r] = EX(c0[r], nmh0); c1[r] = EX(c1[r], nmh1); sacc += c0[r] + c1[r]; }
      l_reg = sacc; }
    pw0 = (v4u){PKW(c0, 0), PKW(c0, 2), PKW(c0, 4), PKW(c0, 6)}; pw1 = (v4u){PKW(c0, 8), PKW(c0, 10), PKW(c0, 12), PKW(c0, 14)};
    pw2 = (v4u){PKW(c1, 0), PKW(c1, 2), PKW(c1, 4), PKW(c1, 6)}; pw3 = (v4u){PKW(c1, 8), PKW(c1, 10), PKW(c1, 12), PKW(c1, 14)};
    DA_WAIT_BAR(6);
    DMA_K(4, 0); DMA_V(2, 2 * RSLOT);
#pragma unroll
    for (int d0 = 0; d0 < 4; ++d0) kload2(kf, kp0 + RSLOT, d0);
    if (NT == 2) { DA_WAIT_BAR(0); } else { DA_WAIT_BAR(8); }
#define PAF(k) __builtin_bit_cast(bf16x8, pw##k)
#define VFR(i) (bf16x8){vlo[(i) & 3][0], vlo[(i) & 3][1], vlo[(i) & 3][2], vlo[(i) & 3][3], vhi[(i) & 3][0], vhi[(i) & 3][1], vhi[(i) & 3][2], vhi[(i) & 3][3]}
#define VOFF(i) ((((i) & 3) * 4 + ((i) >> 2)) * 1024)
#define VRD(i) do { vlo[(i) & 3] = vtr(vp_ + VOFF(i)); vhi[(i) & 3] = vtr(vp_ + VOFF(i) + 512); DA_SBAR(); } while (0)
#define KRD(G, d0) do { if (G) { kload2(kf, kp0 + sl_next_, d0); DA_SBAR(); } } while (0)
#define GAPA(MF) do { MF; DA_SBAR(); } while (0)
#define GAPB(MF, X, i, nm, A0, A1, EXTRA) do { MF; X[i] = EX(X[i], nm); X[(i) + 1] = EX(X[(i) + 1], nm); sacc += A0; sacc += A1; EXTRA; DA_PIN(X); DA_PIN(sacc); DA_SBAR(); } while (0)
#define STEP(t, MASK, GK, GV, GL) do { DA_SBAR(); \
    const lcp vp_ = vp0 + SL((t) - 1); const int sl_next_ = SL((t) + 1); \
            GAPA(c0 = DA_MFMA(kf[0], qr[0], bias16)); GAPA(c1 = DA_MFMA(kf[1], qr[0], bias16)); GAPA(c0 = DA_MFMA(kf[2], qr[1], c0)); GAPA(c1 = DA_MFMA(kf[3], qr[1], c1)); \
    VRD(0); GAPA(c0 = DA_MFMA(kf[4], qr[2], c0)); VRD(1); GAPA(c1 = DA_MFMA(kf[5], qr[2], c1)); VRD(2); GAPA(c0 = DA_MFMA(kf[6], qr[3], c0)); VRD(3); GAPA(c1 = DA_MFMA(kf[7], qr[3], c1)); \
    offA += s64; \
    if (GK) DMA_K((t) + 4, SL(t)); if (GV) DMA_V((t) + 2, SL((t) + 2)); \
    if (MASK) cmask(c0, c1, (t) - (NT - 2), qrel, hi); \
    { const float rm = rowmax(c0, c1, offA, offA + s32) - mhat; resc = false; \
      if (__builtin_expect(__any(rm > THR), 0)) { const float dl = __builtin_fmaxf(rm, 0.f); mhat += dl; \
          const float f = __builtin_amdgcn_exp2f(-dl); l_reg *= f; if (hi == 0) wsf[r32] = f; resc = true; } } \
    const float nmh0 = offA - mhat, nmh1 = nmh0 + s32; float sacc = 0.f; DA_SBAR(); \
    GAPB(o[0] = DA_MFMA(PAF(0), VFR(0), o[0]), c0, 0, nmh0, 0.f, 0.f, );             VRD(4); \
    GAPB(o[1] = DA_MFMA(PAF(0), VFR(1), o[1]), c0, 2, nmh0, c0[0], c0[1], );         VRD(5); \
    GAPB(o[2] = DA_MFMA(PAF(0), VFR(2), o[2]), c0, 4, nmh0, c0[2], c0[3], );         VRD(6); \
    GAPB(o[3] = DA_MFMA(PAF(0), VFR(3), o[3]), c0, 6, nmh0, c0[4], c0[5], );         VRD(7); \
    GAPB(o[0] = DA_MFMA(PAF(1), VFR(4), o[0]), c0, 8, nmh0, c0[6], c0[7], pw0[0] = PKW(c0, 0); pw0[1] = PKW(c0, 2); DA_PIN(pw0));    VRD(8); \
    GAPB(o[1] = DA_MFMA(PAF(1), VFR(5), o[1]), c0, 10, nmh0, c0[8], c0[9], pw0[2] = PKW(c0, 4); pw0[3] = PKW(c0, 6); DA_PIN(pw0));   VRD(9); \
    GAPB(o[2] = DA_MFMA(PAF(1), VFR(6), o[2]), c0, 12, nmh0, c0[10], c0[11], );      VRD(10); \
    GAPB(o[3] = DA_MFMA(PAF(1), VFR(7), o[3]), c0, 14, nmh0, c0[12], c0[13], );      VRD(11); \
    GAPB(o[0] = DA_MFMA(PAF(2), VFR(8), o[0]), c1, 0, nmh1, c0[14], c0[15], pw1[0] = PKW(c0, 8); pw1[1] = PKW(c0, 10); DA_PIN(pw1));  VRD(12); \
    GAPB(o[1] = DA_MFMA(PAF(2), VFR(9), o[1]), c1, 2, nmh1, c1[0], c1[1], pw1[2] = PKW(c0, 12); pw1[3] = PKW(c0, 14); DA_PIN(pw1));   VRD(13); \
    GAPB(o[2] = DA_MFMA(PAF(2), VFR(10), o[2]), c1, 4, nmh1, c1[2], c1[3], );        VRD(14); \
    GAPB(o[3] = DA_MFMA(PAF(2), VFR(11), o[3]), c1, 6, nmh1, c1[4], c1[5], );        VRD(15); \
    GAPB(o[0] = DA_MFMA(PAF(3), VFR(12), o[0]), c1, 8, nmh1, c1[6], c1[7], pw2[0] = PKW(c1, 0); pw2[1] = PKW(c1, 2); DA_PIN(pw2));   KRD(GL, 0); \
    GAPB(o[1] = DA_MFMA(PAF(3), VFR(13), o[1]), c1, 10, nmh1, c1[8], c1[9], pw2[2] = PKW(c1, 4); pw2[3] = PKW(c1, 6); DA_PIN(pw2));  KRD(GL, 1); \
    GAPB(o[2] = DA_MFMA(PAF(3), VFR(14), o[2]), c1, 12, nmh1, c1[10], c1[11], );     KRD(GL, 2); \
    GAPB(o[3] = DA_MFMA(PAF(3), VFR(15), o[3]), c1, 14, nmh1, c1[12], c1[13], );     KRD(GL, 3); \
    sacc += c1[14]; sacc += c1[15]; l_reg += sacc; \
    pw3[0] = PKW(c1, 8); pw3[1] = PKW(c1, 10); pw3[2] = PKW(c1, 12); pw3[3] = PKW(c1, 14); DA_PIN(pw3); \
    } while (0)
#define ENDW(tt) do { if ((tt) + 4 < NT) { DA_WAIT_BAR(8); } else if ((tt) + 3 < NT) { DA_WAIT_BAR(6); } else if ((tt) + 2 < NT) { DA_WAIT_BAR(4); } else { DA_WAIT_BAR(0); } } while (0)
    int t = 1;
    for (; t + 4 < NT; ++t) {
        STEP(t, false, true, true, true); DA_WAIT_BAR(8); RESC();
    }
    for (; t + 1 < NT; ++t) {
        STEP(t, true, (t + 4 < NT), (t + 2 < NT), (t + 1 < NT)); ENDW(t); RESC();
    }
    STEP(NT - 1, true, false, false, false); RESC();
    { const lcp vp_ = vp0 + SL(NT - 1);
#define DRN(k, i) do { const s16x4 lo_ = vtr(vp_ + VOFF(i)), hh_ = vtr(vp_ + VOFF(i) + 512); \
        o[(i) & 3] = DA_MFMA(PAF(k), ((bf16x8){lo_[0], lo_[1], lo_[2], lo_[3], hh_[0], hh_[1], hh_[2], hh_[3]}), o[(i) & 3]); } while (0)
      DRN(0, 0); DRN(0, 1); DRN(0, 2); DRN(0, 3); DRN(1, 4); DRN(1, 5); DRN(1, 6); DRN(1, 7); DRN(2, 8); DRN(2, 9); DRN(2, 10); DRN(2, 11); DRN(3, 12); DRN(3, 13); DRN(3, 14); DRN(3, 15);
#undef DRN
    }
#undef DMA_K
#undef DMA_V
#undef SL
#undef EX
#undef RESC
#undef PKW
#undef PAF
#undef VFR
#undef VOFF
#undef VRD
#undef KRD
#undef GAPA
#undef GAPB
#undef STEP
#undef ENDW
    { auto rr = __builtin_amdgcn_permlane32_swap(__float_as_uint(l_reg), __float_as_uint(l_reg), false, false); l_reg = __uint_as_float(rr[0]) + __uint_as_float(rr[1]); }
    attn_epilogue_body(lds, o, l_reg, yb, subln_w, lam, rowb, q0, h, wave, lane);
}
}

namespace rw {
typedef short bf16x8 __attribute__((ext_vector_type(8)));
typedef float f32x2 __attribute__((ext_vector_type(2)));
typedef short s16x4 __attribute__((ext_vector_type(4)));
constexpr int CH = 32, ACT_PITCH = 528;
constexpr int OFF_HAT = 41472, HAT_PITCH = 144, HAT_SZ = 32 * HAT_PITCH, OFF_TIL = OFF_HAT + 4 * HAT_SZ, TIL_PITCH = 40, TIL_SZ = 64 * TIL_PITCH, OFF_GR = OFF_TIL + 4 * TIL_SZ, OFF_WC = OFF_GR + 10 * 1024;
constexpr int OFF_ACT = 0, OFF_RKV = 16896, OFF_VEC = 41472, OFF_G = 82432, OFF_Y = 90624, OFF_NRM = 98816, OFF_SCL = 99328, OFF_CT = 99840, OFF_SCP = 102400;
template <int CTRL> __device__ __forceinline__ float dppf(float x) { return __builtin_bit_cast(float, __builtin_amdgcn_mov_dpp(__builtin_bit_cast(int, x), CTRL, 0xf, 0xf, true)); }
__device__ __forceinline__ float row_allsum(float v) { v += dppf<0x128>(v); v += dppf<0x124>(v); v += dppf<0x122>(v); v += dppf<0x121>(v); return v; }
__device__ __forceinline__ void row_allsum4(float& a, float& b, float& c, float& d) {
#define RW_DPP4(n) "v_add_f32_dpp %0, %0, %0 row_ror:" #n " row_mask:0xf bank_mask:0xf\n\tv_add_f32_dpp %1, %1, %1 row_ror:" #n " row_mask:0xf bank_mask:0xf\n\t" \
                   "v_add_f32_dpp %2, %2, %2 row_ror:" #n " row_mask:0xf bank_mask:0xf\n\tv_add_f32_dpp %3, %3, %3 row_ror:" #n " row_mask:0xf bank_mask:0xf\n\t"
    asm volatile("s_nop 1\n\t" RW_DPP4(8) RW_DPP4(4) RW_DPP4(2) RW_DPP4(1) "s_nop 1" : "+v"(a), "+v"(b), "+v"(c), "+v"(d));
#undef RW_DPP4
}
__device__ __forceinline__ f32x4 ld4bf(const bf16_t* p) { const v2u w = *(const v2u*)p; return (f32x4){pg8::bflo(w.x), pg8::bfhi(w.x), pg8::bflo(w.y), pg8::bfhi(w.y)}; }
__device__ __forceinline__ float fsig(float x) { return __builtin_amdgcn_rcpf(1.f + __expf(-x)); }
__device__ __forceinline__ float ftanh(float x) { return 1.f - 2.f * __builtin_amdgcn_rcpf(1.f + __expf(2.f * x)); }
struct ZRow { v2u r, k, v, w, a; v4u g; };
__device__ __forceinline__ ZRow ldrow(const bf16_t* zr, int c4, int cg) {
    ZRow o; o.r = *(const v2u*)(zr + C_R + c4); o.k = *(const v2u*)(zr + C_K + c4); o.v = *(const v2u*)(zr + C_V + c4); o.w = *(const v2u*)(zr + C_WL + 4 * cg); o.a = *(const v2u*)(zr + C_AL + 4 * cg);
    o.g = *(const v4u*)(zr + C_GL + 8 * cg); return o;
}
__device__ __forceinline__ f32x4 up4(v2u w) { return (f32x4){pg8::bflo(w.x), pg8::bfhi(w.x), pg8::bflo(w.y), pg8::bfhi(w.y)}; }

struct ScanP { const float *mu, *w0, *w2, *a0, *a2, *g2, *k_k, *k_a, *r_k, *lnx_w, *lnx_b; };
__device__ __forceinline__ void scan_unit(LAS unsigned char* lds, const bf16_t* __restrict__ z, bf16_t* __restrict__ ya, const ScanP P, int b, int h, int tid, int wave, int lane) {
    asm volatile("" : "+v"(tid)); lane = tid & 63;
    const float* mu = P.mu; const float* w0 = P.w0; const float* w2 = P.w2; const float* a0 = P.a0; const float* a2 = P.a2; const float* g2 = P.g2;
    const float* k_k = P.k_k; const float* k_a = P.k_a; const float* r_k = P.r_k; const float* lnx_w = P.lnx_w; const float* lnx_b = P.lnx_b;
    const size_t rowb = (size_t)b * SEQ;
    const int tl = tid >> 4, cg = tid & 15;
    const int nt = wave & 3, rl = lane & 15, rg = lane >> 4;
    LAS float* rkv = (LAS float*)(lds + OFF_RKV); LAS float* vec = (LAS float*)(lds + OFF_VEC); LAS float* gbuf = (LAS float*)(lds + OFF_G);
    LAS float* ybuf = (LAS float*)(lds + OFF_Y); LAS float* nrm = (LAS float*)(lds + OFF_NRM); LAS float* scl = (LAS float*)(lds + OFF_SCL); LAS float* scp = (LAS float*)(lds + OFF_SCP);
    bf16x8 bfr[8];
    {
        const int col = h * 64 + 16 * nt + rl;
#pragma unroll
        for (int f = 0; f < 8; ++f) {
            const float* src = (f < 2) ? w2 : (f < 4) ? a2 : g2;
            const int kb = ((f < 4) ? 32 * (f & 1) : 32 * (f - 4)) + 8 * rg;
            float e[8];
#pragma unroll
            for (int j = 0; j < 8; ++j) e[j] = src[(size_t)(kb + j) * 512 + col];
            v4u p; p.x = pg8::cvt_pk_bf16(e[0], e[1]); p.y = pg8::cvt_pk_bf16(e[2], e[3]); p.z = pg8::cvt_pk_bf16(e[4], e[5]); p.w = pg8::cvt_pk_bf16(e[6], e[7]);
            bfr[f] = __builtin_bit_cast(bf16x8, p);
            __builtin_amdgcn_sched_barrier(0);
        }
    }
    const int mt = wave >> 2;
    const int hc = h * 64 + 16 * nt + rl;
    const float w0c = w0[hc], a0c = a0[hc], kkc = k_k[hc], kac = k_a[hc], rkc = r_k[hc];
    const int c4 = h * 64 + 4 * cg;
    f32x4 ST[4];
#pragma unroll
    for (int i = 0; i < 4; ++i) ST[i] = (f32x4){0.f, 0.f, 0.f, 0.f};
    LAS float* ctab = (LAS float*)(lds + OFF_CT);
    if (tl == 0) {
        LAS float* ct = ctab + cg * 36;
        *(LAS f32x4*)(ct + 0) = *(const f32x4*)(mu + C_R + c4); *(LAS f32x4*)(ct + 4) = *(const f32x4*)(mu + C_K + c4); *(LAS f32x4*)(ct + 8) = *(const f32x4*)(mu + C_V + c4);
        *(LAS f32x4*)(ct + 12) = *(const f32x4*)(mu + C_WL + 4 * cg); *(LAS f32x4*)(ct + 16) = *(const f32x4*)(mu + C_AL + 4 * cg);
        *(LAS f32x4*)(ct + 20) = *(const f32x4*)(mu + C_GL + 8 * cg); *(LAS f32x4*)(ct + 24) = *(const f32x4*)(mu + C_GL + 8 * cg + 4);
        *(LAS f32x4*)(ct + 28) = *(const f32x4*)(lnx_w + c4); *(LAS f32x4*)(ct + 32) = *(const f32x4*)(lnx_b + c4);
    }
    __syncthreads();
    const LAS float* myct = ctab + cg * 36;
    ZRow zc = ldrow(z + (rowb + tl) * NZ, c4, cg), zp;
    if (tl > 0) zp = ldrow(z + (rowb + tl - 1) * NZ, c4, cg); else { zp.r = zp.k = zp.v = zp.w = zp.a = (v2u){0u, 0u}; zp.g = (v4u){0u, 0u, 0u, 0u}; }
    for (int t0 = 0; t0 < SEQ; t0 += CH) {
        {
            const f32x4 cr = up4(zc.r), ck = up4(zc.k), cv = up4(zc.v), cw = up4(zc.w), ca = up4(zc.a);
            const f32x4 cg0 = (f32x4){pg8::bflo(zc.g.x), pg8::bfhi(zc.g.x), pg8::bflo(zc.g.y), pg8::bfhi(zc.g.y)}, cg1 = (f32x4){pg8::bflo(zc.g.z), pg8::bfhi(zc.g.z), pg8::bflo(zc.g.w), pg8::bfhi(zc.g.w)};
            const f32x4 pr = up4(zp.r), pk = up4(zp.k), pv = up4(zp.v), pw = up4(zp.w), pa = up4(zp.a);
            const f32x4 pg0 = (f32x4){pg8::bflo(zp.g.x), pg8::bfhi(zp.g.x), pg8::bflo(zp.g.y), pg8::bfhi(zp.g.y)}, pg1 = (f32x4){pg8::bflo(zp.g.z), pg8::bfhi(zp.g.z), pg8::bflo(zp.g.w), pg8::bfhi(zp.g.w)};
            if (t0 + CH < SEQ) { zc = ldrow(z + (rowb + t0 + CH + tl) * NZ, c4, cg); zp = ldrow(z + (rowb + t0 + CH + tl - 1) * NZ, c4, cg); }
            const f32x4 rs_ = cr + (pr - cr) * *(const LAS f32x4*)(myct + 0), ks_ = ck + (pk - ck) * *(const LAS f32x4*)(myct + 4), vs_ = cv + (pv - cv) * *(const LAS f32x4*)(myct + 8);
            const f32x4 ws_ = cw + (pw - cw) * *(const LAS f32x4*)(myct + 12), as_ = ca + (pa - ca) * *(const LAS f32x4*)(myct + 16);
            const f32x4 g0_ = cg0 + (pg0 - cg0) * *(const LAS f32x4*)(myct + 20), g1_ = cg1 + (pg1 - cg1) * *(const LAS f32x4*)(myct + 24);
            *(LAS f32x4*)(rkv + 0 * 2048 + tl * 64 + 4 * cg) = rs_; *(LAS f32x4*)(rkv + 1 * 2048 + tl * 64 + 4 * cg) = ks_; *(LAS f32x4*)(rkv + 2 * 2048 + tl * 64 + 4 * cg) = vs_;
            LAS unsigned char* ar = lds + OFF_ACT + tl * ACT_PITCH;
            v2u tw; tw.x = pg8::cvt_pk_bf16(ftanh(ws_[0]), ftanh(ws_[1])); tw.y = pg8::cvt_pk_bf16(ftanh(ws_[2]), ftanh(ws_[3]));
            *(LAS v2u*)(ar + 8 * cg) = tw;
            v2u aw; aw.x = pg8::cvt_pk_bf16(as_[0], as_[1]); aw.y = pg8::cvt_pk_bf16(as_[2], as_[3]);
            *(LAS v2u*)(ar + 128 + 8 * cg) = aw;
            v4u gw; gw.x = pg8::cvt_pk_bf16(fsig(g0_[0]), fsig(g0_[1])); gw.y = pg8::cvt_pk_bf16(fsig(g0_[2]), fsig(g0_[3]));
            gw.z = pg8::cvt_pk_bf16(fsig(g1_[0]), fsig(g1_[1])); gw.w = pg8::cvt_pk_bf16(fsig(g1_[2]), fsig(g1_[3]));
            *(LAS v4u*)(ar + 256 + 16 * cg) = gw;
        }
        __syncthreads();
        f32x4 accw = (f32x4){0.f, 0.f, 0.f, 0.f}, acca = accw, accg = accw;
        {
            const LAS unsigned char* ap = lds + OFF_ACT + (16 * mt + rl) * ACT_PITCH + 8 * rg * 2;
#pragma unroll
            for (int f = 0; f < 8; ++f) {
                const bf16x8 a = *(const LAS bf16x8*)(ap + f * 64);
                if (f < 2) accw = __builtin_amdgcn_mfma_f32_16x16x32_bf16(a, bfr[f], accw, 0, 0, 0);
                else if (f < 4) acca = __builtin_amdgcn_mfma_f32_16x16x32_bf16(a, bfr[f], acca, 0, 0, 0);
                else accg = __builtin_amdgcn_mfma_f32_16x16x32_bf16(a, bfr[f], accg, 0, 0, 0);
            }
        }
        float lw[4], av[4], kk[4];
        {
            const int c = 16 * nt + rl;
            float n2[4];
#pragma unroll
            for (int r = 0; r < 4; ++r) {
                const int tok = 16 * mt + 4 * rg + r;
                gbuf[tok * 64 + c] = accg[r];
                const float nx = -(w0c + accw[r]);
                const float sp = nx > 20.f ? nx : __logf(1.f + __expf(nx));
                lw[r] = -__expf(-sp - 0.5f);
                av[r] = fsig(a0c + acca[r]);
                kk[r] = rkv[1 * 2048 + tok * 64 + c] * kkc;
                n2[r] = kk[r] * kk[r];
            }
            row_allsum4(n2[0], n2[1], n2[2], n2[3]);
            if (rl == 0) {
#pragma unroll
                for (int r = 0; r < 4; ++r) nrm[(16 * mt + 4 * rg + r) * 4 + nt] = n2[r];
            }
        }
        __syncthreads();
        {
            const int c = 16 * nt + rl;
            const float p0 = lw[0], p1 = p0 + lw[1], p2 = p1 + lw[2], p3 = p2 + lw[3];
            const float t1 = __shfl(p3, (lane - 16) & 63), t2 = __shfl(p3, (lane - 32) & 63), t3 = __shfl(p3, (lane - 48) & 63);
            const float E = (rg >= 1 ? t1 : 0.f) + (rg >= 2 ? t2 : 0.f) + (rg >= 3 ? t3 : 0.f);
            const float Ltot = __shfl(E + p3, rl + 48);
            const float pin[4] = {p0, p1, p2, p3};
            float bt[4], kt[4];
#pragma unroll
            for (int r = 0; r < 4; ++r) {
                const int tok = 16 * mt + 4 * rg + r;
                const f32x4 n4 = *(const LAS f32x4*)(nrm + tok * 4);
                const float ksv = rkv[1 * 2048 + tok * 64 + c], rsv = rkv[0 * 2048 + tok * 64 + c];
                const float inv = __builtin_amdgcn_rcpf(fmaxf(sqrtf((n4[0] + n4[1]) + (n4[2] + n4[3])), 1e-12f));
                const float kkn = kk[r] * inv, beta = kkn * av[r], kmod = ksv * (1.f + (av[r] - 1.f) * kac);
                const float L = E + pin[r], eL = __expf(L), ieL = __expf(-L), eLm = __expf(L - lw[r]), eT = __expf(Ltot - L);
                LAS unsigned char* hp = lds + OFF_HAT + tok * HAT_PITCH + c * 2;
                *(LAS bf16_t*)(hp) = f2bf(-kkn * eLm); *(LAS bf16_t*)(hp + HAT_SZ) = f2bf(beta * ieL); *(LAS bf16_t*)(hp + 2 * HAT_SZ) = f2bf(kmod * ieL); *(LAS bf16_t*)(hp + 3 * HAT_SZ) = f2bf(rsv * eL);
                bt[r] = beta * eT; kt[r] = kmod * eT;
                float pbr = beta * rsv, pkr = kmod * rsv, pbo = rsv * kmod * rkc, dum = 0.f;
                row_allsum4(pbr, pkr, pbo, dum);
                if (rl == 0) *(LAS f32x4*)(scp + (tok * 4 + nt) * 4) = (f32x4){pbr, pkr, pbo, 0.f};
            }
            LAS unsigned char* tp = lds + OFF_TIL + (2 * mt) * TIL_SZ + c * TIL_PITCH + 8 * rg;
            v2u w; w.x = pg8::cvt_pk_bf16(bt[0], bt[1]); w.y = pg8::cvt_pk_bf16(bt[2], bt[3]); *(LAS v2u*)(tp) = w;
            w.x = pg8::cvt_pk_bf16(kt[0], kt[1]); w.y = pg8::cvt_pk_bf16(kt[2], kt[3]); *(LAS v2u*)(tp + TIL_SZ) = w;
            if (rg == 0) ((LAS float*)(lds + OFF_WC))[mt * 64 + c] = __expf(Ltot);
        }
        __syncthreads();
        if (tid < CH) {
            const f32x4 p0 = *(const LAS f32x4*)(scp + tid * 16), p1 = *(const LAS f32x4*)(scp + tid * 16 + 4), p2 = *(const LAS f32x4*)(scp + tid * 16 + 8), p3 = *(const LAS f32x4*)(scp + tid * 16 + 12);
            *(LAS f32x4*)(scl + 4 * tid) = (p0 + p1) + (p2 + p3);
        }
        __syncthreads();
        int lane_ = lane; asm volatile("" : "+v"(lane_));
        const int rl_ = lane_ & 15, rg_ = lane_ >> 4;
        {
            const int c = wave >> 2, g = wave & 3;
            const LAS unsigned char* pa = lds + OFF_HAT + ((g & 1) ? 2 : 1) * HAT_SZ + (16 * c + rl_) * HAT_PITCH + 16 * rg_;
            const LAS unsigned char* pb = lds + OFF_HAT + ((g < 2) ? 0 : 3) * HAT_SZ + (16 * c + rl_) * HAT_PITCH + 16 * rg_;
            f32x4 acc = (f32x4){0.f, 0.f, 0.f, 0.f};
            acc = __builtin_amdgcn_mfma_f32_16x16x32_bf16(*(const LAS bf16x8*)(pa), *(const LAS bf16x8*)(pb), acc, 0, 0, 0);
            acc = __builtin_amdgcn_mfma_f32_16x16x32_bf16(*(const LAS bf16x8*)(pa + 64), *(const LAS bf16x8*)(pb + 64), acc, 0, 0, 0);
#pragma unroll
            for (int e = 0; e < 4; ++e) { const int row = 4 * rg_ + e; const bool keep = (g < 2) ? (row < rl_) : (row <= rl_); if (!keep) acc[e] = 0.f; }
            *(LAS f32x4*)(lds + OFF_GR + (c * 5 + g) * 1024 + lane_ * 16) = acc;
        }
        __syncthreads();
        if (wave == 0 && lane_ < 32) {
            const int c = lane_ >> 4, sc = lane_ & 15;
            const LAS float* tb = (const LAS float*)(lds + OFF_GR + (c * 5) * 1024);
            float m[16];
#pragma unroll
            for (int r = 15; r >= 0; --r) {
                float acc = 0.f;
#pragma unroll
                for (int u = r + 1; u < 16; ++u) acc = __builtin_fmaf(tb[(u + 16 * (r >> 2)) * 4 + (r & 3)], m[u], acc);
                m[r] = (r == sc) ? 1.f : ((r < sc) ? acc : 0.f);
            }
            LAS f32x4* mt_ = (LAS f32x4*)(lds + OFF_GR + (c * 5 + 4) * 1024);
#pragma unroll
            for (int q = 0; q < 4; ++q) mt_[sc + 16 * q] = (f32x4){m[4 * q], m[4 * q + 1], m[4 * q + 2], m[4 * q + 3]};
        }
        __syncthreads();
        if (wave < 4) {
            const int ib = wave;
#pragma unroll
            for (int c = 0; c < 2; ++c) {
                bf16x8 sb[2];
#pragma unroll
                for (int ks = 0; ks < 2; ++ks) {
                    v4u p; p.x = pg8::cvt_pk_bf16(ST[2 * ks][0], ST[2 * ks][1]); p.y = pg8::cvt_pk_bf16(ST[2 * ks][2], ST[2 * ks][3]);
                    p.z = pg8::cvt_pk_bf16(ST[2 * ks + 1][0], ST[2 * ks + 1][1]); p.w = pg8::cvt_pk_bf16(ST[2 * ks + 1][2], ST[2 * ks + 1][3]);
                    sb[ks] = __builtin_bit_cast(bf16x8, p);
                }
                const LAS unsigned char* ha = lds + OFF_HAT + (16 * c + rl_) * HAT_PITCH + 8 * rg_;
                f32x4 xt = (f32x4){0.f, 0.f, 0.f, 0.f}, yt = xt;
#pragma unroll
                for (int ks = 0; ks < 2; ++ks) {
                    v4u fa, fr; const v2u a0_ = *(const LAS v2u*)(ha + 64 * ks), a1_ = *(const LAS v2u*)(ha + 64 * ks + 32);
                    const v2u r0_ = *(const LAS v2u*)(ha + 3 * HAT_SZ + 64 * ks), r1_ = *(const LAS v2u*)(ha + 3 * HAT_SZ + 64 * ks + 32);
                    fa.x = a0_.x; fa.y = a0_.y; fa.z = a1_.x; fa.w = a1_.y; fr.x = r0_.x; fr.y = r0_.y; fr.z = r1_.x; fr.w = r1_.y;
                    xt = __builtin_amdgcn_mfma_f32_16x16x32_bf16(__builtin_bit_cast(bf16x8, fa), sb[ks], xt, 0, 0, 0);
                    yt = __builtin_amdgcn_mfma_f32_16x16x32_bf16(__builtin_bit_cast(bf16x8, fr), sb[ks], yt, 0, 0, 0);
                }
                const LAS float* vsrc = rkv + 2 * 2048 + (16 * c + 4 * rg_) * 64 + 16 * ib + rl_;
                v2u vb_; vb_.x = pg8::cvt_pk_bf16(vsrc[0], vsrc[64]); vb_.y = pg8::cvt_pk_bf16(vsrc[128], vsrc[192]);
                const s16x4 vb = __builtin_bit_cast(s16x4, vb_);
                const LAS unsigned char* gr = lds + OFF_GR + (c * 5) * 1024 + lane_ * 16;
#define RW_AFR(g_) ({ const f32x4 t_ = *(const LAS f32x4*)(gr + (g_) * 1024); v2u w_; w_.x = pg8::cvt_pk_bf16(t_[0], t_[1]); w_.y = pg8::cvt_pk_bf16(t_[2], t_[3]); __builtin_bit_cast(s16x4, w_); })
#define RW_PK4(x_) ({ v2u w_; w_.x = pg8::cvt_pk_bf16((x_)[0], (x_)[1]); w_.y = pg8::cvt_pk_bf16((x_)[2], (x_)[3]); __builtin_bit_cast(s16x4, w_); })
                const f32x4 zt = __builtin_amdgcn_mfma_f32_16x16x16bf16_1k(RW_AFR(1), vb, xt, 0, 0, 0);
                const f32x4 ut = __builtin_amdgcn_mfma_f32_16x16x16bf16_1k(RW_AFR(4), RW_PK4(zt), (f32x4){0.f, 0.f, 0.f, 0.f}, 0, 0, 0);
                const s16x4 ub = RW_PK4(ut);
                yt = __builtin_amdgcn_mfma_f32_16x16x16bf16_1k(RW_AFR(2), ub, yt, 0, 0, 0);
                yt = __builtin_amdgcn_mfma_f32_16x16x16bf16_1k(RW_AFR(3), vb, yt, 0, 0, 0);
#pragma unroll
                for (int e = 0; e < 4; ++e) ybuf[(16 * c + 4 * rg_ + e) * 64 + 16 * ib + rl_] = yt[e];
                const LAS unsigned char* tl_ = lds + OFF_TIL + (2 * c) * TIL_SZ + rl_ * TIL_PITCH + 8 * rg_;
                const LAS float* wc = (const LAS float*)(lds + OFF_WC) + c * 64 + 4 * rg_;
#pragma unroll
                for (int jt = 0; jt < 4; ++jt) {
                    f32x4 acc = ST[jt] * *(const LAS f32x4*)(wc + 16 * jt);
                    acc = __builtin_amdgcn_mfma_f32_16x16x16bf16_1k(*(const LAS s16x4*)(tl_ + TIL_SZ + 16 * jt * TIL_PITCH), vb, acc, 0, 0, 0);
                    acc = __builtin_amdgcn_mfma_f32_16x16x16bf16_1k(*(const LAS s16x4*)(tl_ + 16 * jt * TIL_PITCH), ub, acc, 0, 0, 0);
                    ST[jt] = acc;
                }
#undef RW_AFR
#undef RW_PK4
            }
        }
        __syncthreads();
        {
            const f32x4 y4 = *(const LAS f32x4*)(ybuf + tl * 64 + 4 * cg);
            const float mean = row_allsum((y4[0] + y4[1]) + (y4[2] + y4[3])) * (1.f / 64.f);
            const f32x4 dv = y4 - mean;
            const float var = row_allsum((dv[0] * dv[0] + dv[1] * dv[1]) + (dv[2] * dv[2] + dv[3] * dv[3])) * (1.f / 64.f);
            const float rs_ = rsqrtf(var + GN_EPS);
            const f32x4 yn = dv * rs_ * *(const LAS f32x4*)(myct + 28) + *(const LAS f32x4*)(myct + 32);
            const float bonus = scl[tl * 4 + 2];
            const f32x4 vs_ = *(const LAS f32x4*)(rkv + 2 * 2048 + tl * 64 + 4 * cg), g4 = *(const LAS f32x4*)(gbuf + tl * 64 + 4 * cg);
            const f32x4 o = (yn + vs_ * bonus) * g4;
            v2u w; w.x = pg8::cvt_pk_bf16(o[0], o[1]); w.y = pg8::cvt_pk_bf16(o[2], o[3]);
            *(v2u*)(ya + (rowb + t0 + tl) * 512 + c4) = w;
        }
        __syncthreads();
    }
}
}

typedef __bf16 bf16x2_t __attribute__((ext_vector_type(2)));
__device__ __forceinline__ float dot2bf(unsigned a, unsigned b, float c) { return __builtin_amdgcn_fdot2_f32_bf16(__builtin_bit_cast(bf16x2_t, a), __builtin_bit_cast(bf16x2_t, b), c, false); }
__device__ __forceinline__ unsigned f2ord(float f) { const unsigned u = __float_as_uint(f); return (u & 0x80000000u) ? ~u : (u | 0x80000000u); }
__device__ __forceinline__ float ord2f(unsigned o) { return __uint_as_float((o & 0x80000000u) ? (o ^ 0x80000000u) : ~o); }
__device__ __forceinline__ unsigned row_allmax_u32(unsigned v) {
    v = max(v, (unsigned)__builtin_amdgcn_update_dpp(0, (int)v, 0x128, 0xf, 0xf, false));
    v = max(v, (unsigned)__builtin_amdgcn_update_dpp(0, (int)v, 0x124, 0xf, 0xf, false));
    v = max(v, (unsigned)__builtin_amdgcn_update_dpp(0, (int)v, 0x122, 0xf, 0xf, false));
    v = max(v, (unsigned)__builtin_amdgcn_update_dpp(0, (int)v, 0x121, 0xf, 0xf, false));
    return v;
}

constexpr int TK_PITCH = 272, TK_HALF = 128 * TK_PITCH;
typedef short tk_bf16x8 __attribute__((ext_vector_type(8)));
__device__ __forceinline__ void topk_loadq(tk_bf16x8 (&qa)[8], const bf16_t* __restrict__ qb, int t0, int h, int lane) {
    const bf16_t* qp = qb + (size_t)(t0 + (lane & 15)) * 2048 + h * 256 + 8 * (lane >> 4);
#pragma unroll
    for (int i = 0; i < 8; ++i) qa[i] = *(const tk_bf16x8*)(qp + i * 32);
}
__device__ __forceinline__ void topk_item(const tk_bf16x8 (&qa)[8], const LAS unsigned char* klds, int* __restrict__ ids, float* __restrict__ gates, int t0, int h, int lane) {
    const int rl = lane & 15, rg = lane >> 4;
    unsigned top[2][4];
#pragma unroll
    for (int c = 0; c < 2; ++c) {
        f32x4 acc[8];
#pragma unroll
        for (int nt = 0; nt < 8; ++nt) acc[nt] = (f32x4){64.f, 64.f, 64.f, 64.f};
        const LAS unsigned char* kp = klds + c * TK_HALF + rl * TK_PITCH + 16 * rg;
#pragma unroll
        for (int ks = 0; ks < 4; ++ks) {
#pragma unroll
            for (int nt = 0; nt < 8; ++nt) { const tk_bf16x8 b = *(const LAS tk_bf16x8*)(kp + nt * 16 * TK_PITCH + ks * 64); acc[nt] = __builtin_amdgcn_mfma_f32_16x16x32_bf16(qa[c * 4 + ks], b, acc[nt], 0, 0, 0); }
            __builtin_amdgcn_sched_barrier(0);
        }
        unsigned k[4][8];
#pragma unroll
        for (int r = 0; r < 4; ++r) {
#pragma unroll
            for (int nt = 0; nt < 8; ++nt) k[r][nt] = (__float_as_uint(fmaxf(acc[nt][r], 1.f)) & ~127u) | (unsigned)(127 - (nt * 16 + rl));
#define TK_CE(i, j) do { const unsigned a_ = max(k[r][i], k[r][j]), b_ = min(k[r][i], k[r][j]); k[r][i] = a_; k[r][j] = b_; } while (0)
            TK_CE(0, 1); TK_CE(2, 3); TK_CE(4, 5); TK_CE(6, 7); TK_CE(0, 2); TK_CE(1, 3); TK_CE(4, 6); TK_CE(5, 7); TK_CE(1, 2); TK_CE(5, 6);
            TK_CE(0, 4); TK_CE(1, 5); TK_CE(2, 6); TK_CE(3, 7); TK_CE(2, 4); TK_CE(3, 5); TK_CE(1, 2); TK_CE(3, 4); TK_CE(5, 6);
#undef TK_CE
        }
        unsigned tp[4] = {0u, 0u, 0u, 0u};
        for (int round = 0; round < 16; ++round) {
#pragma unroll
            for (int r = 0; r < 4; ++r) {
                const unsigned m = row_allmax_u32(k[r][0]);
                tp[r] = (rl == round) ? m : tp[r];
                const bool win = (k[r][0] == m);
                k[r][0] = win ? k[r][1] : k[r][0]; k[r][1] = win ? k[r][2] : k[r][1]; k[r][2] = win ? k[r][3] : k[r][2]; k[r][3] = win ? k[r][4] : k[r][3];
                k[r][4] = win ? k[r][5] : k[r][4]; k[r][5] = win ? k[r][6] : k[r][5]; k[r][6] = win ? k[r][7] : k[r][6]; k[r][7] = win ? 0u : k[r][7];
            }
        }
#pragma unroll
        for (int r = 0; r < 4; ++r) top[c][r] = tp[r];
    }
    const int rowbase = lane & 48;
    float v1[4]; int n1[4], ptr[4], myid[4]; unsigned k2[4], myv[4];
#pragma unroll
    for (int r = 0; r < 4; ++r) { v1[r] = __uint_as_float(top[0][r] & ~127u); n1[r] = 127 - (int)(top[0][r] & 127u); ptr[r] = 0; k2[r] = (unsigned)__builtin_amdgcn_ds_bpermute(rowbase * 4, (int)top[1][r]); myid[r] = 0; myv[r] = 0u; }
    for (int round = 0; round < 16; ++round) {
#pragma unroll
        for (int r = 0; r < 4; ++r) {
            const float head = v1[r] + __uint_as_float(k2[r] & ~127u);
            const unsigned key = (ptr[r] < 16) ? ((__float_as_uint(head) & ~15u) | (unsigned)(15 - rl)) : 0u;
            const unsigned m = row_allmax_u32(key);
            const bool win = (key == m);
            const unsigned wid = row_allmax_u32(win ? (unsigned)(n1[r] * 128 + (127 - (int)(k2[r] & 127u))) + 1u : 0u);
            myid[r] = (rl == round) ? (int)wid - 1 : myid[r];
            myv[r] = (rl == round) ? m : myv[r];
            ptr[r] += win ? 1 : 0;
            k2[r] = (unsigned)__builtin_amdgcn_ds_bpermute((rowbase + (ptr[r] & 15)) * 4, (int)top[1][r]);
        }
    }
#pragma unroll
    for (int r = 0; r < 4; ++r) {
        const float val = __uint_as_float(myv[r] & ~15u);
        const float vmax = __uint_as_float((unsigned)__builtin_amdgcn_ds_bpermute(rowbase * 4, (int)__float_as_uint(val)));
        const float e = __expf(val - vmax);
        const float sum = rw::row_allsum(e);
        gates[(size_t)(t0 + 4 * rg + r) * 128 + h * 16 + rl] = e / sum; ids[(size_t)(t0 + 4 * rg + r) * 128 + h * 16 + rl] = myid[r];
    }
}

typedef float f32x2 __attribute__((ext_vector_type(2)));
__device__ __forceinline__ void peer_token(const bf16_t* __restrict__ x2b, const float* __restrict__ ssq2, const int* __restrict__ ids, const float* __restrict__ gates,
                                           const unsigned char* __restrict__ U8, const unsigned char* __restrict__ V8, const float* __restrict__ usc, const float* __restrict__ vsc,
                                           const float* __restrict__ fw, float* __restrict__ out, int t, int lane) {
    const int l16 = lane * 16;
    f32x2 hx[8];
    {
        const v4u h0 = *(const v4u*)(x2b + (size_t)t * DM + l16), h1 = *(const v4u*)(x2b + (size_t)t * DM + l16 + 8);
        const unsigned hw[8] = {h0.x, h0.y, h0.z, h0.w, h1.x, h1.y, h1.z, h1.w};
#pragma unroll
        for (int i = 0; i < 8; ++i) hx[i] = (f32x2){pg8::bflo(hw[i]), pg8::bfhi(hw[i])};
    }
    const int idA = ids[(size_t)t * 128 + lane], idB = ids[(size_t)t * 128 + 64 + lane];
    const float rs = rsqrtf(pg8::ssq_sum16(ssq2 + (size_t)t * 16) * (1.f / DM) + NORM_EPS);
    const float suA = rs * usc[idA], suB = rs * usc[idB];
    const float svA = gates[(size_t)t * 128 + lane] * vsc[idA], svB = gates[(size_t)t * 128 + 64 + lane] * vsc[idB];
    f32x2 y[8];
#pragma unroll
    for (int i = 0; i < 8; ++i) y[i] = (f32x2){0.f, 0.f};
    const int bit0 = lane & 1, bit1 = (lane >> 1) & 1, bit2 = (lane >> 2) & 1;
    const int myk = 4 * bit0 + 2 * bit1 + bit2;
    for (int g = 0; g < 16; ++g) {
        const int idsel = (g < 8) ? idA : idB; const float susel = (g < 8) ? suA : suB, svsel = (g < 8) ? svA : svB; const int lb = (g * 8) & 63;
        v3u_t uw[8], vw[8];
#pragma unroll
        for (int k = 0; k < 8; ++k) { const int e = __builtin_amdgcn_readlane(idsel, lb + k); uw[k] = *(const v3u_t*)(U8 + (size_t)e * 768 + lane * 12); vw[k] = *(const v3u_t*)(V8 + (size_t)e * 768 + lane * 12); }
        float d[8];
#pragma unroll
        for (int k = 0; k < 8; ++k) {
            const v32f_t f = __builtin_amdgcn_cvt_scalef32_pk32_f32_fp6((v6u_t){uw[k][0], uw[k][1], uw[k][2], 0u, 0u, 0u}, 1.0f);
            f32x2 a = (f32x2){0.f, 0.f};
#pragma unroll
            for (int i = 0; i < 8; ++i) a += (f32x2){f[2 * i], f[2 * i + 1]} * hx[i];
            d[k] = a[0] + a[1];
            __builtin_amdgcn_sched_barrier(0);
        }
        float r4[4];
#pragma unroll
        for (int k = 0; k < 4; ++k) { const float send = bit0 ? d[k] : d[k + 4], keep = bit0 ? d[k + 4] : d[k]; r4[k] = keep + __shfl_xor(send, 1); }
        float r2[2];
#pragma unroll
        for (int k = 0; k < 2; ++k) { const float send = bit1 ? r4[k] : r4[k + 2], keep = bit1 ? r4[k + 2] : r4[k]; r2[k] = keep + __shfl_xor(send, 2); }
        float r1;
        { const float send = bit2 ? r2[0] : r2[1], keep = bit2 ? r2[1] : r2[0]; r1 = keep + __shfl_xor(send, 4); }
        r1 += __shfl_xor(r1, 8); r1 += __shfl_xor(r1, 16); r1 += __shfl_xor(r1, 32);
        const float dd = r1 * __shfl(susel, lb + myk);
        const float act = 0.5f * dd * (1.f + erff(dd * 0.70710678118654752f)) * __shfl(svsel, lb + myk);
#pragma unroll
        for (int k = 0; k < 8; ++k) {
            const float a = __uint_as_float((unsigned)__builtin_amdgcn_readlane((int)__float_as_uint(act), ((k & 1) << 2) | (k & 2) | ((k >> 2) & 1)));
            const f32x2 a2 = (f32x2){a, a};
            const v32f_t f = __builtin_amdgcn_cvt_scalef32_pk32_f32_fp6((v6u_t){vw[k][0], vw[k][1], vw[k][2], 0u, 0u, 0u}, 1.0f);
#pragma unroll
            for (int i = 0; i < 8; ++i) y[i] += (f32x2){f[2 * i], f[2 * i + 1]} * a2;
            __builtin_amdgcn_sched_barrier(0);
        }
    }
    float* orow = out + (size_t)t * DM + l16;
    float ss = 0.f;
    f32x4 o4[4];
#pragma unroll
    for (int i = 0; i < 4; ++i) { o4[i] = (f32x4){hx[2 * i][0] + y[2 * i][0], hx[2 * i][1] + y[2 * i][1], hx[2 * i + 1][0] + y[2 * i + 1][0], hx[2 * i + 1][1] + y[2 * i + 1][1]};
        ss += (o4[i][0] * o4[i][0] + o4[i][1] * o4[i][1]) + (o4[i][2] * o4[i][2] + o4[i][3] * o4[i][3]); }
    ss = wave_sum(ss);
    const float r = rsqrtf(ss * (1.f / DM) + NORM_EPS);
#pragma unroll
    for (int i = 0; i < 4; ++i) *(f32x4*)(orow + 4 * i) = o4[i] * r * *(const f32x4*)(fw + l16 + 4 * i);
}

__global__ void __launch_bounds__(NWAVES * 64, 2) mk_fwd(Args args) {
    extern __shared__ __attribute__((aligned(16))) unsigned char lds_raw[];
    LAS unsigned char* lds = (LAS unsigned char*)lds_raw;
    volatile LAS unsigned* MISC = (volatile LAS unsigned*)(lds + MISC_OFF);
    const int tid = threadIdx.x, lane = tid & 63, wave = __builtin_amdgcn_readfirstlane(tid >> 6);
    const int G = gridDim.x; const int bx = blockIdx.x; const int vcu = (G % 8 == 0) ? (bx % 8) * (G / 8) + bx / 8 : bx;
    unsigned char* ws = args.ws;
    unsigned* ctl = (unsigned*)(ws + WS_CTL);
    for (int u = tid; u < (LDS_BYTES - LDSCTL_OFF) / 4; u += NWAVES * 64) ((LAS unsigned*)(lds + LDSCTL_OFF))[u] = 0u;
    __syncthreads();
    XcdBarrier bar = xcd_barrier_post(ctl + CW_BAR + args.li * XCD_BAR_WORDS, MISC + 8);
    const int lo = args.ph_lo, hi = args.ph_hi;
#define IN(k) (lo <= (k) && (k) < hi)
#define BOTH(k) (IN(k) && IN((k) + 1))
    bf16_t* WinT = (bf16_t*)(ws + WS_WIN); bf16_t* PaT = (bf16_t*)(ws + WS_PA); bf16_t* PbT = (bf16_t*)(ws + WS_PB); bf16_t* WoT = (bf16_t*)(ws + WS_WO);
    bf16_t* WqT = (bf16_t*)(ws + WS_WQ); bf16_t* KeysB = (bf16_t*)(ws + WS_KEYS);
    float* rstd1 = (float*)(ws + WS_RSTD1); float* ssq2 = (float*)(ws + WS_RSTD2); float* scal = (float*)(ws + WS_SCAL);
    unsigned char* U8 = ws + WS_U; unsigned char* V8 = ws + WS_V; float* usc = (float*)(ws + WS_USC); float* vsc = (float*)(ws + WS_VSC);
    bf16_t* xb = (bf16_t*)(ws + WS_XB); bf16_t* ya = (bf16_t*)(ws + WS_YA); bf16_t* yb = (bf16_t*)(ws + WS_YB); bf16_t* x2b = (bf16_t*)(ws + WS_X2B);
    bf16_t* z = (bf16_t*)(ws + WS_Z); bf16_t* qb = (bf16_t*)(ws + WS_Q);
    bf16_t* merged = (bf16_t*)(ws + WS_MERGED);
    const int gw = vcu * NWAVES + wave, NGW = G * NWAVES;

    if (IN(0)) {
        LAS float* scr = (LAS float*)(lds + wave * 16384);
        constexpr int I_IN = (DM / 64) * (NZ / 32), I_PA = (512 / 64) * (DM / 32), I_WO = (DM / 64) * (DM / 32), I_WQ = (DM / 64) * (2048 / 32);
        constexpr int NITEMS = I_IN + 2 * I_PA + I_WO + I_WQ;
        for (int it = gw; it < NITEMS; it += NGW) {
            int r = it;
            if (r < I_IN) { p0_transpose_item(args.in[2], args.in[1], DM, NZ, WinT, scr, r, lane); continue; } r -= I_IN;
            if (r < I_PA) { p0_transpose_item(args.in[19], nullptr, 512, DM, PaT, scr, r, lane); continue; } r -= I_PA;
            if (r < I_PA) { p0_transpose_item(args.in[20], nullptr, 512, DM, PbT, scr, r, lane); continue; } r -= I_PA;
            if (r < I_WO) { p0_transpose_item(args.in[21], nullptr, DM, DM, WoT, scr, r, lane); continue; } r -= I_WO;
            p0_transpose_item(args.in[23], args.in[22], DM, 2048, WqT, scr, r, lane);
        }
        p0_convert(args.in[24], nullptr, KeysB, (size_t)16 * 128 * 128, gw, NGW, lane);
        for (int e = gw; e < 2 * NEXP; e += NGW) {
            const bool isu = e < NEXP; const int row = isu ? e : e - NEXP;
            p0_row_fp6((isu ? args.in[25] : args.in[26]) + (size_t)row * DM, isu ? args.in[22] : nullptr, (isu ? U8 : V8) + (size_t)row * 768, (isu ? usc : vsc) + row, lane);
        }
        for (int m = gw; m < T_TOK; m += NGW) {
            const f32x4* xr = (const f32x4*)(args.in[0] + (size_t)m * DM) + lane;
            f32x4 v[4]; float s = 0.f;
#pragma unroll
            for (int j = 0; j < 4; ++j) { v[j] = xr[64 * j]; s += (v[j][0] * v[j][0] + v[j][1] * v[j][1]) + (v[j][2] * v[j][2] + v[j][3] * v[j][3]); }
            s = wave_sum(s);
            v2u* o8 = (v2u*)(xb + (size_t)m * DM) + lane;
#pragma unroll
            for (int j = 0; j < 4; ++j) { v2u w; w.x = pg8::cvt_pk_bf16(v[j][0], v[j][1]); w.y = pg8::cvt_pk_bf16(v[j][2], v[j][3]); o8[64 * j] = w; }
            if (lane == 0) rstd1[m] = rsqrtf(s * (1.f / DM) + NORM_EPS);
        }
        if (gw == 0) {
            const float a = wave_sum(args.in[14][lane] * args.in[15][lane]), b = wave_sum(args.in[16][lane] * args.in[17][lane]);
            if (lane == 0) scal[0] = __expf(a) - __expf(b) + LAM_INIT;
        }
        if (BOTH(0)) xcd_barrier(bar);
    }
    if (IN(1)) {
        pg8::Gemm g{xb, WinT, DM, DM, DM}; pg8::StaticOrder S; S.init(T_TOK, NZ, G, bx);
        pg8::EpiRowScale<false> E{z, NZ, rstd1};
        for (int rep = 0; rep < REPS(1); ++rep) pg8::gemm_phase(lds, g, S, E);
        if (BOTH(1)) xcd_barrier(bar);
    }
    if (IN(2)) {
        {
            const rw::ScanP P{args.in[3], args.in[4], args.in[5], args.in[6], args.in[7], args.in[8], args.in[9], args.in[10], args.in[11], args.in[12], args.in[13]};
            for (int rep = 0; rep < REPS(2); ++rep) for (int u = vcu; u < NB * 8; u += G) rw::scan_unit(lds, z, ya, P, u >> 3, u & 7, tid, wave, lane);
        }
        const float lam = scal[0];
        __syncthreads();
        for (int i = 0;; ++i) {
            int idx = vcu + i * G; if (idx >= 2048 * REPS(10)) break;
            idx &= 2047;
            const int slot = idx >> 8, v = idx & 255, bh = v >> 1, a = (v & 1) * 4 + (slot >> 1), qblk = (slot & 1) ? 15 - a : a;
            da::attn_unit(lds, z, yb, args.in[18], lam, bh >> 2, bh & 3, qblk, wave, lane);
        }
        if (BOTH(2)) xcd_barrier(bar);
    }
    if (IN(3)) {
        pg8::Gemm g{ya, PaT, 512, 512, 512}; pg8::StaticOrder S; S.init(T_TOK, DM, G, bx);
        pg8::EpiGate<false> E{merged, z, C_GA};
        pg8::gemm_phase(lds, g, S, E);
        if (BOTH(3)) xcd_barrier(bar);
    }
    if (IN(4)) {
        pg8::Gemm g{yb, PbT, 512, 512, 512}; pg8::StaticOrder S; S.init(T_TOK, DM, G, bx);
        pg8::EpiGate<true> E{merged, z, C_GB};
        pg8::gemm_phase(lds, g, S, E);
        if (BOTH(4)) xcd_barrier(bar);
    }
    if (IN(5)) {
        pg8::Gemm g{merged, WoT, DM, DM, DM}; pg8::StaticOrder S; S.init(T_TOK, DM, G, bx);
        pg8::EpiX2 E{args.in[0], args.out, x2b, ssq2};
        pg8::gemm_phase(lds, g, S, E);
        if (BOTH(5)) xcd_barrier(bar);
    }
    if (IN(6)) {
        pg8::Gemm g{x2b, WqT, DM, DM, DM}; pg8::StaticOrder S; S.init(T_TOK, 2048, G, bx);
        pg8::EpiRowScale<true> E{qb, 2048, ssq2};
        for (int rep = 0; rep < REPS(6); ++rep) pg8::gemm_phase(lds, g, S, E);
        if (BOTH(6)) xcd_barrier(bar);
    }
    if (IN(7)) {
        int* ids = (int*)(ws + WS_IDS); float* gates = (float*)(ws + WS_GATES);
        for (int rep = 0; rep < REPS(7); ++rep)
        for (int h = 0; h < 8; ++h) {
            __syncthreads();
            {
                const bf16_t* ksrc = KeysB + (size_t)h * 2 * 128 * 128;
#pragma unroll
                for (int i = 0; i < 8; ++i) { const int chunk = tid + i * 512, row = chunk >> 4, cc = chunk & 15;
                    *(LAS v4u*)(lds + (row >> 7) * TK_HALF + (row & 127) * TK_PITCH + cc * 16) = *(const v4u*)(ksrc + (size_t)row * 128 + cc * 8); }
            }
            __syncthreads();
            for (int tile = gw; tile < 4096; tile += NGW) {
                tk_bf16x8 qa[8];
                topk_loadq(qa, qb, tile * 16, h, lane);
                topk_item(qa, lds, ids, gates, tile * 16, h, lane);
            }
        }
        if (BOTH(7)) xcd_barrier(bar);
    }
    if (IN(8)) {
        const int* ids = (const int*)(ws + WS_IDS); const float* gates = (const float*)(ws + WS_GATES);
        for (int t = gw; t < T_TOK; t += NGW) peer_token(x2b, ssq2, ids, gates, U8, V8, usc, vsc, args.in[27], args.out, t, lane);
    }
#undef IN
#undef BOTH
}

extern "C" void kernel_launch(void* const* d_in, const int* in_sizes, int n_in, void* d_out, int out_size, void* d_ws, size_t ws_size, hipStream_t stream) {
    static int grid = 0;
    if (grid == 0) {
        if (n_in != 28 || in_sizes[0] != T_TOK * DM || out_size != T_TOK * DM || ws_size < WS_END) {
            fprintf(stderr, "kernel_launch: unexpected shapes / workspace (n_in %d, ws %zu < %zu)\n", n_in, ws_size, (size_t)WS_END); grid = -1; return; }
        int dev = 0, cus = 0;
        if (hipGetDevice(&dev) != hipSuccess || hipDeviceGetAttribute(&cus, hipDeviceAttributeMultiprocessorCount, dev) != hipSuccess) { grid = -1; return; }
        if (hipFuncSetAttribute((const void*)mk_fwd, hipFuncAttributeMaxDynamicSharedMemorySize, LDS_BYTES) != hipSuccess) { fprintf(stderr, "kernel_launch: hipFuncSetAttribute failed\n"); grid = -1; return; }
        grid = cus;
    }
    if (grid < 0) return;
    unsigned char* ws = (unsigned char*)d_ws;
    float* out = (float*)d_out;
    (void)hipMemsetAsync(ws + WS_CTL, 0, 1 * MiB, stream);
    Args a{};
    for (int i = 0; i < 28; ++i) a.in[i] = (const float*)d_in[i];
    a.out = out; a.ws = ws;
    a.ph_lo = 0; a.ph_hi = 9; a.li = 0;
    hipLaunchKernelGGL(mk_fwd, dim3(grid), dim3(NWAVES * 64), LDS_BYTES, stream, a);
}
```

```cpp
#include <hip/hip_runtime.h>
#include <stdint.h>
#include <cstdio>

typedef unsigned short bf16_t;
typedef unsigned int u32;

#ifndef PROBE_REP
#define PROBE_REP 0
#endif
#define REPS(k) (((PROBE_REP >> (k)) & 1) ? 2 : 1)
constexpr int T_TOK = 65536, DM = 1024, SEQ = 2048, NB = 32;
constexpr int NZ = 5376;
constexpr int C_R = 0, C_K = 512, C_V = 1024, C_WL = 1536, C_AL = 1600, C_GL = 1664, C_Q = 1792, C_ZK = 2304, C_ZV = 2816, C_GA = 3328, C_GB = 4352;
constexpr int NEXP = 16384;
constexpr float NORM_EPS = 1e-6f, GN_EPS = 64e-5f, SUBLN_EPS = 1e-5f;
constexpr float LAM_INIT = 0.2f;

constexpr size_t MiB = 1u << 20;
constexpr size_t WS_CTL = 0;
constexpr size_t WS_WIN = 1 * MiB;
constexpr size_t WS_PA = 12 * MiB;
constexpr size_t WS_PB = 13 * MiB;
constexpr size_t WS_WO = 14 * MiB;
constexpr size_t WS_WQ = 16 * MiB;
constexpr size_t WS_KEYS = 20 * MiB;
constexpr size_t WS_RSTD1 = 21 * MiB;
constexpr size_t WS_RSTD2 = 58 * MiB;
constexpr size_t WS_SCAL = 23 * MiB;
constexpr size_t WS_U = 24 * MiB;
constexpr size_t WS_V = 40 * MiB;
constexpr size_t WS_USC = 56 * MiB;
constexpr size_t WS_VSC = 57 * MiB;
constexpr size_t WS_XB = 88 * MiB;
constexpr size_t WS_YA = WS_XB;
constexpr size_t WS_YB = WS_XB + 64 * MiB;
constexpr size_t WS_X2B = WS_XB;
constexpr size_t WS_Z = 216 * MiB;
constexpr size_t WS_Q = WS_Z;
constexpr size_t WS_IDS = WS_Z + 256 * MiB;
constexpr size_t WS_GATES = WS_Z + 288 * MiB;
constexpr size_t WS_MERGED = 888 * MiB;
constexpr size_t WS_END = 1016 * MiB;

__device__ __forceinline__ float bf2f(bf16_t h) { return __uint_as_float(((u32)h) << 16); }
__device__ __forceinline__ bf16_t f2bf(float f) { u32 u = __float_as_uint(f); u += 0x7fffu + ((u >> 16) & 1u); return (bf16_t)(u >> 16); }
__device__ __forceinline__ float wave_sum(float v) {
#pragma unroll
    for (int o = 1; o < 64; o <<= 1) v += __shfl_xor(v, o);
    return v;
}
__device__ __forceinline__ float sigmoidf_(float x) { return 1.f / (1.f + __expf(-x)); }

namespace pg8 {
#define PG8_LAS __attribute__((address_space(3)))
typedef short bf16x8 __attribute__((ext_vector_type(8)));
typedef float f32x4 __attribute__((ext_vector_type(4)));
typedef unsigned u32x4 __attribute__((ext_vector_type(4)));
constexpr int BM = 256, BK = 64, HALF = 128, HTB = HALF * BK * 2  , STAGE_BYTES = 8 * HTB, NXCD = 8, WGM = 8;

__host__ __device__ __forceinline__ int lds_byte(int r, int c) { const int st = (r >> 4) * 2 + (c >> 5), rr = r & 15, cc = c & 31, ob = rr * 64 + cc * 2; return st * 1024 + (ob ^ (((ob >> 9) & 1) << 5)); }
__host__ __device__ __forceinline__ void stage_rc(int b, int& R, int& C) { const int st = b / 1024, sb = b % 1024, swz = sb ^ (((sb >> 9) & 1) << 5); R = (st >> 1) * 16 + swz / 64; C = (st & 1) * 32 + (swz % 64) / 2; }
__host__ __device__ __forceinline__ int perm32(int rho) { const int n = rho >> 4, i = rho & 15; return 8 * (i >> 2) + 4 * n + (i & 3); }

struct Unit { int pm, pn; };
struct Gemm { const bf16_t* A; const bf16_t* Bt; int lda, ldb, K; };

struct StaticOrder {
    int nM, nN, nwg, G, c;
    __host__ __device__ void init(int M, int N, int G_, int c_) { nM = M / BM; nN = N / BM; nwg = nM * nN; G = G_; c = c_; }
    __host__ __device__ bool next(int i, Unit& u) const {
        const long L = (long)i * G + c; if (L >= nwg) return false;
        int wgid = (int)L; { const int q = nwg / NXCD, r = nwg % NXCD, xcd = wgid % NXCD, off = wgid / NXCD; wgid = (xcd < r ? xcd * (q + 1) : r * (q + 1) + (xcd - r) * q) + off; }
        const int nig = WGM * nN, gid = wgid / nig, fm = gid * WGM, gsz = (nM - fm) < WGM ? (nM - fm) : WGM;
        u.pm = fm + ((wgid % nig) % gsz); u.pn = (wgid % nig) / gsz; return true;
    }
};
typedef float f32x2_c __attribute__((ext_vector_type(2))); typedef __bf16 bf16x2_c __attribute__((ext_vector_type(2)));
__device__ __forceinline__ unsigned cvt_pk_bf16(float lo, float hi) { const f32x2_c v = {lo, hi}; const bf16x2_c b = __builtin_convertvector(v, bf16x2_c); return __builtin_bit_cast(unsigned, b); }
__device__ __forceinline__ float bflo(unsigned w) { return __uint_as_float(w << 16); }
__device__ __forceinline__ float bfhi(unsigned w) { return __uint_as_float(w & 0xffff0000u); }

__device__ __forceinline__ float ssq_sum16(const float* p) {
    const f32x4 a = *(const f32x4*)p, b = *(const f32x4*)(p + 4), c = *(const f32x4*)(p + 8), d = *(const f32x4*)(p + 12);
    return (((a[0] + a[1]) + (a[2] + a[3])) + ((b[0] + b[1]) + (b[2] + b[3]))) + (((c[0] + c[1]) + (c[2] + c[3])) + ((d[0] + d[1]) + (d[2] + d[3])));
}
template <bool SSQ> struct EpiRowScale {
    static constexpr bool PERM = true;
    bf16_t* O; int ldc; const float* rs;
    __device__ __forceinline__ void operator()(const f32x4 (&acc)[2][2][4][2], const Unit& u, int wr, int wc, int fr, int fq) const {
        const int row0 = u.pm * BM + wr * 64 + fr, col0 = u.pn * BM + wc * 32 + 8 * fq;
#pragma unroll
        for (int ai = 0; ai < 2; ++ai)
#pragma unroll
            for (int m = 0; m < 4; ++m) {
                const int row = row0 + ai * HALF + m * 16;
                float s; if (SSQ) s = rsqrtf(ssq_sum16(rs + (size_t)row * 16) * (1.f / 1024.f) + NORM_EPS); else s = rs[row];
                bf16_t* rowp = O + (size_t)row * ldc + col0;
#pragma unroll
                for (int bj = 0; bj < 2; ++bj) {
                    const f32x4 v0 = acc[ai][bj][m][0] * s, v1 = acc[ai][bj][m][1] * s;
                    u32x4 w; w.x = cvt_pk_bf16(v0[0], v0[1]); w.y = cvt_pk_bf16(v0[2], v0[3]); w.z = cvt_pk_bf16(v1[0], v1[1]); w.w = cvt_pk_bf16(v1[2], v1[3]);
                    *(u32x4*)(rowp + bj * HALF) = w;
                }
            }
    }
};
template <bool ACCUM> struct EpiGate {
    static constexpr bool PERM = true;
    bf16_t* mg; const bf16_t* z; int gcol;
    __device__ __forceinline__ void operator()(const f32x4 (&acc)[2][2][4][2], const Unit& u, int wr, int wc, int fr, int fq) const {
        const int row0 = u.pm * BM + wr * 64 + fr, col0 = u.pn * BM + wc * 32 + 8 * fq;
#pragma unroll
        for (int ai = 0; ai < 2; ++ai)
#pragma unroll
            for (int m = 0; m < 4; ++m) {
                const int row = row0 + ai * HALF + m * 16;
                const bf16_t* gp = z + (size_t)row * NZ + gcol + col0;
                bf16_t* rowp = mg + (size_t)row * DM + col0;
#pragma unroll
                for (int bj = 0; bj < 2; ++bj) {
                    const u32x4 g = *(const u32x4*)(gp + bj * HALF);
                    const f32x4 a0 = acc[ai][bj][m][0], a1 = acc[ai][bj][m][1];
                    float r[8];
                    r[0] = sigmoidf_(bflo(g.x)) * a0[0]; r[1] = sigmoidf_(bfhi(g.x)) * a0[1]; r[2] = sigmoidf_(bflo(g.y)) * a0[2]; r[3] = sigmoidf_(bfhi(g.y)) * a0[3];
                    r[4] = sigmoidf_(bflo(g.z)) * a1[0]; r[5] = sigmoidf_(bfhi(g.z)) * a1[1]; r[6] = sigmoidf_(bflo(g.w)) * a1[2]; r[7] = sigmoidf_(bfhi(g.w)) * a1[3];
                    if (ACCUM) { const u32x4 o = *(const u32x4*)(rowp + bj * HALF);
                        r[0] += bflo(o.x); r[1] += bfhi(o.x); r[2] += bflo(o.y); r[3] += bfhi(o.y); r[4] += bflo(o.z); r[5] += bfhi(o.z); r[6] += bflo(o.w); r[7] += bfhi(o.w); }
                    u32x4 w; w.x = cvt_pk_bf16(r[0], r[1]); w.y = cvt_pk_bf16(r[2], r[3]); w.z = cvt_pk_bf16(r[4], r[5]); w.w = cvt_pk_bf16(r[6], r[7]);
                    *(u32x4*)(rowp + bj * HALF) = w;
                }
            }
    }
};
struct EpiX2 {
    static constexpr bool PERM = true;
    const float* x; float* x2; bf16_t* x2b; float* ssq;
    __device__ __forceinline__ void operator()(const f32x4 (&acc)[2][2][4][2], const Unit& u, int wr, int wc, int fr, int fq) const {
        const int row0 = u.pm * BM + wr * 64 + fr, col0 = u.pn * BM + wc * 32 + 8 * fq;
#pragma unroll
        for (int ai = 0; ai < 2; ++ai)
#pragma unroll
            for (int m = 0; m < 4; ++m) {
                const int row = row0 + ai * HALF + m * 16;
                const size_t off = (size_t)row * DM + col0;
                float ss = 0.f;
#pragma unroll
                for (int bj = 0; bj < 2; ++bj) {
                    const f32x4 x0 = *(const f32x4*)(x + off + bj * HALF), x1 = *(const f32x4*)(x + off + bj * HALF + 4);
                    const f32x4 o0 = x0 + acc[ai][bj][m][0], o1 = x1 + acc[ai][bj][m][1];
                    u32x4 w; w.x = cvt_pk_bf16(o0[0], o0[1]); w.y = cvt_pk_bf16(o0[2], o0[3]); w.z = cvt_pk_bf16(o1[0], o1[1]); w.w = cvt_pk_bf16(o1[2], o1[3]);
                    *(u32x4*)(x2b + off + bj * HALF) = w;
                    ss += (o0[0] * o0[0] + o0[1] * o0[1]) + (o0[2] * o0[2] + o0[3] * o0[3]) + (o1[0] * o1[0] + o1[1] * o1[1]) + (o1[2] * o1[2] + o1[3] * o1[3]);
                }
                ss += __shfl_xor(ss, 16); ss += __shfl_xor(ss, 32);
                if (fq == 0) ssq[(size_t)row * 16 + (u.pn & 3) * 4 + wc] = ss;
            }
    }
};

template <class Epi, class Sched>
__device__ __forceinline__ void gemm_phase(PG8_LAS unsigned char* lds, const Gemm g, const Sched& S, const Epi& E) {
    const int tid = threadIdx.x, wid = __builtin_amdgcn_readfirstlane(tid >> 6), lane = tid & 63, wr = wid >> 2, wc = wid & 3, fr = lane & 15, fq = lane >> 4;
    const int K = g.K, nt = K / BK;
    unsigned voffA[2], voffB[2];
#pragma unroll
    for (int i = 0; i < 2; ++i) { int R, C; stage_rc(tid * 16 + i * 8192, R, C); const int Rb = Epi::PERM ? ((R & ~31) + perm32(R & 31)) : R;
        voffA[i] = (unsigned)(R * g.lda + C) * 2u; voffB[i] = (unsigned)(Rb * g.ldb + C) * 2u; }
    const size_t kstep = (size_t)(BK * 2);
    const size_t hstepA = (size_t)HALF * g.lda * 2, hstepB = (size_t)HALF * g.ldb * 2;
    const size_t tstepA = 2 * hstepA, tstepB = 2 * hstepB;
    const unsigned ldsw = (unsigned)wid * 1024u;
    const int aoff = lds_byte(wr * 64 + fr, fq * 8), boff = lds_byte(wc * 32 + fr, fq * 8);
#define PG8_SA(b, h) (((b) * 2 + (h)) * HTB)
#define PG8_SB(b, h) ((4 + (b) * 2 + (h)) * HTB)
#define PG8_STAGE(bufoff, gbase, voff) do { _Pragma("unroll") for (int _i = 0; _i < 2; ++_i) \
        __builtin_amdgcn_global_load_lds((const unsigned*)((const char*)(gbase) + (voff)[_i]), (PG8_LAS unsigned*)(lds + (bufoff) + ldsw + _i * 8192), 16, 0, 0); } while (0)
#define PG8_LDA(dst, b, h) do { _Pragma("unroll") for (int m = 0; m < 4; ++m) _Pragma("unroll") for (int k = 0; k < 2; ++k) dst[m][k] = *(const PG8_LAS bf16x8*)(lds + PG8_SA(b, h) + aoff + m * 2048 + k * 1024); } while (0)
#define PG8_LDB(dst, b, h) do { _Pragma("unroll") for (int n = 0; n < 2; ++n) _Pragma("unroll") for (int k = 0; k < 2; ++k) dst[n][k] = *(const PG8_LAS bf16x8*)(lds + PG8_SB(b, h) + boff + n * 2048 + k * 1024); } while (0)
#define PG8_MMA(ai, bj, At, Bt) do { __builtin_amdgcn_s_setprio(1); _Pragma("unroll") for (int m = 0; m < 4; ++m) _Pragma("unroll") for (int n = 0; n < 2; ++n) _Pragma("unroll") for (int k = 0; k < 2; ++k) \
        acc[ai][bj][m][n] = __builtin_amdgcn_mfma_f32_16x16x32_bf16(Bt[n][k], At[m][k], acc[ai][bj][m][n], 0, 0, 0); __builtin_amdgcn_s_setprio(0); } while (0)
#define PG8_WAIT_V(n) asm volatile("s_waitcnt vmcnt(" #n ")" ::: "memory")
#define PG8_WAIT_L(n) asm volatile("s_waitcnt lgkmcnt(" #n ")" ::: "memory")
#define PG8_BAR __builtin_amdgcn_s_barrier()
#define PG8_SCHED __builtin_amdgcn_sched_barrier(0)
    Unit cur, nxt; int ui = 0;
    if (!S.next(0, cur)) return;
    f32x4 acc[2][2][4][2];
#pragma unroll
    for (int a = 0; a < 2; ++a)
#pragma unroll
        for (int b = 0; b < 2; ++b)
#pragma unroll
            for (int m = 0; m < 4; ++m)
#pragma unroll
                for (int n = 0; n < 2; ++n) acc[a][b][m][n] = (f32x4){0.f, 0.f, 0.f, 0.f};
    bf16x8 At[4][2], B0[2][2], B1[2][2];
    const char* cA = (const char*)g.A + (size_t)cur.pm * tstepA; const char* cB = (const char*)g.Bt + (size_t)cur.pn * tstepB;
    PG8_STAGE(PG8_SB(0, 0), cB, voffB); PG8_STAGE(PG8_SB(0, 1), cB + hstepB, voffB); PG8_STAGE(PG8_SA(0, 0), cA, voffA); PG8_STAGE(PG8_SA(0, 1), cA + hstepA, voffA);
    if (wr == 1) PG8_BAR;
    PG8_WAIT_V(2); PG8_BAR;
    PG8_STAGE(PG8_SB(1, 0), cB + kstep, voffB); PG8_STAGE(PG8_SA(1, 0), cA + kstep, voffA); PG8_STAGE(PG8_SB(1, 1), cB + hstepB + kstep, voffB);
    PG8_WAIT_V(6); PG8_BAR;
    for (;;) {
        const bool has_next = S.next(ui + 1, nxt);
        const char* nA = has_next ? (const char*)g.A + (size_t)nxt.pm * tstepA : cA; const char* nB = has_next ? (const char*)g.Bt + (size_t)nxt.pn * tstepB : cB;
        for (int t = 0; t < nt; t += 2) {
            const bool last = (t == nt - 2);
            const char* a1 = cA + (size_t)(t + 1) * kstep;
            const char* a2 = last ? nA : cA + (size_t)(t + 2) * kstep; const char* b2 = last ? nB : cB + (size_t)(t + 2) * kstep;
            const char* a3 = a2 + kstep; const char* b3 = b2 + kstep;
            PG8_LDB(B0, 0, 0); PG8_LDB(B1, 0, 1); PG8_SCHED; PG8_LDA(At, 0, 0); PG8_STAGE(PG8_SA(1, 1), a1 + hstepA, voffA);
            PG8_WAIT_V(8); PG8_WAIT_L(0); PG8_BAR; PG8_MMA(0, 0, At, B0); PG8_MMA(0, 1, At, B1); PG8_BAR; PG8_SCHED;
            PG8_LDA(At, 0, 1); PG8_STAGE(PG8_SB(0, 0), b2, voffB); PG8_STAGE(PG8_SB(0, 1), b2 + hstepB, voffB); PG8_STAGE(PG8_SA(0, 0), a2, voffA);
            PG8_WAIT_V(8); PG8_WAIT_L(0); PG8_BAR; PG8_MMA(1, 0, At, B0); PG8_MMA(1, 1, At, B1); PG8_BAR; PG8_SCHED;
            PG8_LDB(B0, 1, 0); PG8_LDB(B1, 1, 1); PG8_SCHED; PG8_LDA(At, 1, 0); PG8_STAGE(PG8_SA(0, 1), a2 + hstepA, voffA);
            PG8_WAIT_V(8); PG8_WAIT_L(0); PG8_BAR; PG8_MMA(0, 0, At, B0); PG8_MMA(0, 1, At, B1); PG8_BAR; PG8_SCHED;
            PG8_LDA(At, 1, 1); PG8_STAGE(PG8_SB(1, 0), b3, voffB); PG8_STAGE(PG8_SB(1, 1), b3 + hstepB, voffB); PG8_STAGE(PG8_SA(1, 0), a3, voffA);
            PG8_WAIT_V(8); PG8_WAIT_L(0); PG8_BAR; PG8_MMA(1, 0, At, B0); PG8_MMA(1, 1, At, B1); PG8_BAR; PG8_SCHED;
        }
        if (wr == 0) PG8_BAR;
        E(acc, cur, wr, wc, fr, fq);
        if (!has_next) break;
#pragma unroll
        for (int a = 0; a < 2; ++a)
#pragma unroll
            for (int b = 0; b < 2; ++b)
#pragma unroll
                for (int m = 0; m < 4; ++m)
#pragma unroll
                    for (int n = 0; n < 2; ++n) acc[a][b][m][n] = (f32x4){0.f, 0.f, 0.f, 0.f};
        cur = nxt; cA = nA; cB = nB; ++ui;
        if (wr == 1) PG8_BAR;
    }
    PG8_WAIT_V(0);
    PG8_BAR;
#undef PG8_SA
#undef PG8_SB
#undef PG8_STAGE
#undef PG8_LDA
#undef PG8_LDB
#undef PG8_MMA
#undef PG8_WAIT_V
#undef PG8_WAIT_L
#undef PG8_BAR
#undef PG8_SCHED
}
}

constexpr int NWAVES = 8;
constexpr int LDS_RING_BYTES = 131072, LDSCTL_OFF = 143360, MISC_OFF = LDSCTL_OFF + 320, LDS_BYTES = 147456;
#define LAS __attribute__((address_space(3)))
#define GAS __attribute__((address_space(1)))
typedef float f32x4 __attribute__((ext_vector_type(4)));
typedef unsigned v4u __attribute__((ext_vector_type(4)));
typedef unsigned v2u __attribute__((ext_vector_type(2)));
#define LDS_WAIT() asm volatile("s_waitcnt lgkmcnt(0)" ::: "memory")

constexpr int CW_BAR = 4096;
#define XB_TMO      128
#define XB_XCNT(j)  (256  + 64 * (j))
#define XB_XSUB(j)  (1280 + 64 * (j))
#define XB_XGEN(j)  (2304 + 64 * (j))
#define XB_TOP      3328
#define XB_TOPGEN   3392
#define XCD_BAR_WORDS 3456
#define XB_SPIN_CAP (1u << 20)
__device__ __forceinline__ unsigned xb_ld(unsigned* p)              { return __hip_atomic_load(p, __ATOMIC_RELAXED, __HIP_MEMORY_SCOPE_AGENT); }
__device__ __forceinline__ unsigned xb_add(unsigned* p, unsigned v) { return __hip_atomic_fetch_add(p, v, __ATOMIC_RELAXED, __HIP_MEMORY_SCOPE_AGENT); }
__device__ __forceinline__ unsigned xb_xcc_id() { return (unsigned)__builtin_amdgcn_s_getreg((3 << 11) | 20) & 0xFu; }
#define XB_SPIN(cond, bar) do { unsigned _sp = 0; while (cond) { __builtin_amdgcn_s_sleep(1); \
    if ((++_sp & 255u) == 0u) { if (xb_ld(&(bar)[XB_TMO])) break; if (_sp > XB_SPIN_CAP) { atomicAdd(&(bar)[XB_TMO], 1u); break; } } } } while (0)
struct XcdBarrier { unsigned* bar; unsigned x; volatile LAS unsigned* st; };
__device__ __forceinline__ XcdBarrier xcd_barrier_post(unsigned* bar, volatile LAS unsigned* st) {
    XcdBarrier b; b.bar = bar; b.x = xb_xcc_id(); b.st = st;
    if (threadIdx.x == 0) (void)xb_add(&bar[XB_XCNT(b.x)], 1u);
    return b;
}
__device__ __forceinline__ void xcd_barrier_complete(unsigned* bar, unsigned x, unsigned& nloc, unsigned& nx) {
    const unsigned G = gridDim.x * gridDim.y * gridDim.z;
    unsigned sum, cnt, mine, sp = 0u;
    for (;;) {
        sum = 0u; cnt = 0u; mine = 0u;
#pragma unroll
        for (unsigned j = 0; j < 16; ++j) { const unsigned c = xb_ld(&bar[XB_XCNT(j)]); sum += c; cnt += (c > 0u) ? 1u : 0u; mine = (j == x) ? c : mine; }
        if (sum == G) break;
        __builtin_amdgcn_s_sleep(1);
        if ((++sp & 255u) == 0u) { if (xb_ld(&bar[XB_TMO])) break; if (sp > XB_SPIN_CAP) { atomicAdd(&bar[XB_TMO], 1u); break; } }
    }
    nloc = mine > 0u ? mine : 1u; nx = cnt > 0u ? cnt : 1u;
}
__device__ __forceinline__ void xcd_barrier(const XcdBarrier& b) {
    asm volatile("s_waitcnt vmcnt(0)" ::: "memory");
    __syncthreads();
    if (threadIdx.x == 0) {
        unsigned* bar = b.bar;
        __builtin_amdgcn_s_waitcnt(0);
        unsigned nloc = b.st[0], nx = b.st[1];
        if (nloc == 0u) { xcd_barrier_complete(bar, b.x, nloc, nx); b.st[0] = nloc; b.st[1] = nx; }
        const unsigned old = xb_add(&bar[XB_XSUB(b.x)], 1u);
        const unsigned gen = old / nloc;
        if (old + 1u == (gen + 1u) * nloc) {
            __builtin_amdgcn_fence(__ATOMIC_RELEASE, "agent");
            asm volatile("s_waitcnt vmcnt(0)" ::: "memory");
            const unsigned og = xb_add(&bar[XB_TOP], 1u);
            const unsigned tg = og / nx;
            if (og + 1u == (tg + 1u) * nx) xb_add(&bar[XB_TOPGEN], 1u);
            else XB_SPIN(xb_ld(&bar[XB_TOPGEN]) == tg, bar);
            __builtin_amdgcn_fence(__ATOMIC_ACQUIRE, "agent");
            xb_add(&bar[XB_XGEN(b.x)], 1u);
            asm volatile("s_waitcnt vmcnt(0)" ::: "memory");
        } else {
            XB_SPIN(xb_ld(&bar[XB_XGEN(b.x)]) == gen, bar);
            __builtin_amdgcn_fence(__ATOMIC_ACQUIRE, "agent");
            asm volatile("s_waitcnt vmcnt(0)" ::: "memory");
        }
    }
    __syncthreads();
}

struct Args { const float* in[28]; float* out; unsigned char* ws; int ph_lo, ph_hi, li, pad; };

__device__ __forceinline__ void p0_transpose_item(const float* W, const float* sc, int K, int N, bf16_t* WT, LAS float* scr, int item, int lane) {
    const int nblk = N / 32, kb = item / nblk, nb = item % nblk, k0 = 64 * kb, n0 = 32 * nb;
#pragma unroll 8
    for (int i = 0; i < 32; ++i) { const int kk = 2 * i + (lane >> 5); const float s = sc ? sc[k0 + kk] : 1.f; scr[kk * 33 + (lane & 31)] = W[(size_t)(k0 + kk) * N + n0 + (lane & 31)] * s; }
    LDS_WAIT(); asm volatile("" ::: "memory");
    const int c = lane & 7;
#pragma unroll
    for (int j = 0; j < 4; ++j) { const int n = (lane >> 3) + 8 * j; const LAS float* s = scr + (8 * c) * 33 + n;
        v4u o; o.x = pg8::cvt_pk_bf16(s[0 * 33], s[1 * 33]); o.y = pg8::cvt_pk_bf16(s[2 * 33], s[3 * 33]); o.z = pg8::cvt_pk_bf16(s[4 * 33], s[5 * 33]); o.w = pg8::cvt_pk_bf16(s[6 * 33], s[7 * 33]);
        *(v4u*)(WT + (size_t)(n0 + n) * K + k0 + 8 * c) = o; }
    LDS_WAIT(); asm volatile("" ::: "memory");
}
typedef unsigned v6u_t __attribute__((ext_vector_type(6)));
typedef unsigned v3u_t __attribute__((ext_vector_type(3)));
typedef float v16f_t __attribute__((ext_vector_type(16)));
typedef float v32f_t __attribute__((ext_vector_type(32)));
__device__ __forceinline__ void p0_row_fp6(const float* in, const float* cs, unsigned char* out, float* sc, int lane) {
    f32x4 v[4]; float mx = 0.f;
#pragma unroll
    for (int i = 0; i < 4; ++i) { v[i] = *(const f32x4*)(in + lane * 16 + 4 * i); if (cs) v[i] = v[i] * *(const f32x4*)(cs + lane * 16 + 4 * i);
        mx = fmaxf(mx, fmaxf(fmaxf(fabsf(v[i][0]), fabsf(v[i][1])), fmaxf(fabsf(v[i][2]), fabsf(v[i][3])))); }
#pragma unroll
    for (int o = 1; o < 64; o <<= 1) mx = fmaxf(mx, __shfl_xor(mx, o));
    mx = fmaxf(mx, 1e-30f);
    const float q = 7.5f / mx;
    v16f_t a, b;
#pragma unroll
    for (int i = 0; i < 16; ++i) { a[i] = 0.f; b[i] = 0.f; }
#pragma unroll
    for (int i = 0; i < 8; ++i) { a[i] = v[(2 * i) >> 2][(2 * i) & 3] * q; b[i] = v[(2 * i + 1) >> 2][(2 * i + 1) & 3] * q; }
    const v6u_t p = __builtin_amdgcn_cvt_scalef32_2xpk16_fp6_f32(a, b, 1.0f);
    *(v3u_t*)(out + lane * 12) = (v3u_t){p[0], p[1], p[2]};
    if (lane == 0) *sc = mx * (1.f / 7.5f);
}
__device__ __forceinline__ void p0_convert(const float* in, const float* cs, bf16_t* out, size_t n, int gw, int NGW, int lane) {
    for (size_t i = ((size_t)gw * 64 + lane) * 8; i < n; i += (size_t)NGW * 512) {
        f32x4 a = *(const f32x4*)(in + i), b = *(const f32x4*)(in + i + 4);
        if (cs) { const int c = (int)(i & 1023); a = a * *(const f32x4*)(cs + c); b = b * *(const f32x4*)(cs + c + 4); }
        v4u o; o.x = pg8::cvt_pk_bf16(a[0], a[1]); o.y = pg8::cvt_pk_bf16(a[2], a[3]); o.z = pg8::cvt_pk_bf16(b[0], b[1]); o.w = pg8::cvt_pk_bf16(b[2], b[3]);
        *(v4u*)(out + i) = o;
    }
}

namespace da {
typedef short bf16x8 __attribute__((ext_vector_type(8)));
typedef short s16x4 __attribute__((ext_vector_type(4)));
typedef float f32x16 __attribute__((ext_vector_type(16)));
typedef const LAS unsigned char* lcp;
constexpr float LOG2E = 1.4426950408889634f, C2 = 0.125f * LOG2E, THR = 8.f;
constexpr int RSLOT = 16384, LDS_KR = 0, LDS_VR = 4 * RSLOT, SCR_OFF = 8 * RSLOT, COMB_OFF = 0;
#define DA_SBAR() __builtin_amdgcn_sched_barrier(0)
#define DA_PIN(x) asm volatile("" : "+v"(x))
#define DA_MFMA(a, b, c) __builtin_amdgcn_mfma_f32_32x32x16_bf16(a, b, c, 0, 0, 0)
#define DA_WAIT_BAR(N) asm volatile("s_waitcnt vmcnt(" #N ") lgkmcnt(0)\n\ts_barrier" ::: "memory")
#define DA_MX3(a, b, c) __builtin_fmaxf(__builtin_fmaxf((a), (b)), (c))
__device__ __forceinline__ int crow(int r, int hi) { return (r & 3) + 8 * (r >> 2) + 4 * hi; }
__device__ __forceinline__ s16x4 vtr(lcp p) { return __builtin_bit_cast(s16x4, __builtin_amdgcn_ds_read_tr16_b64_v4i16((LAS s16x4*)p)); }
__device__ __forceinline__ unsigned cvtpk(float lo, float hi) { unsigned r; asm("v_cvt_pk_bf16_f32 %0, %1, %2" : "=v"(r) : "v"(lo), "v"(hi)); return r; }
__device__ __forceinline__ void glds16(const void* g, unsigned lds_base) {
    unsigned sv; asm volatile("s_mov_b32 %0, m0\n\ts_mov_b32 m0, %2\n\ts_nop 0\n\tglobal_load_lds_dwordx4 %1, off\n\ts_mov_b32 m0, %0" : "=&s"(sv) : "v"(g), "s"(lds_base) : "memory"); }
__device__ __forceinline__ void glds16_o128(const void* g, unsigned lds_base) {
    unsigned sv; asm volatile("s_mov_b32 %0, m0\n\ts_mov_b32 m0, %2\n\ts_nop 0\n\tglobal_load_lds_dwordx4 %1, off offset:128\n\ts_mov_b32 m0, %0" : "=&s"(sv) : "v"(g), "s"(lds_base) : "memory"); }
__device__ __forceinline__ void kload2(bf16x8* kf, lcp kp, int d0) { kf[2 * d0] = *(const LAS bf16x8*)(kp + d0 * 2048); kf[2 * d0 + 1] = *(const LAS bf16x8*)(kp + d0 * 2048 + 512); }
__device__ __forceinline__ float max16(const f32x16& p) {
    float a = DA_MX3(p[0], p[1], p[2]), b = DA_MX3(p[3], p[4], p[5]); a = DA_MX3(a, p[6], p[7]); b = DA_MX3(b, p[8], p[9]); a = DA_MX3(a, p[10], p[11]); b = DA_MX3(b, p[12], p[13]);
    a = DA_MX3(a, p[14], p[15]); return __builtin_fmaxf(a, b); }
__device__ __forceinline__ float rowmax(const f32x16& p0, const f32x16& p1, float offA, float offB) {
    const float m = __builtin_fmaxf(__builtin_fmaf(max16(p0), C2, offA), __builtin_fmaf(max16(p1), C2, offB));
    auto rr = __builtin_amdgcn_permlane32_swap(__float_as_uint(m), __float_as_uint(m), false, false);
    return __builtin_fmaxf(__uint_as_float(rr[0]), __uint_as_float(rr[1])); }
__device__ __forceinline__ void cmask(f32x16& p0, f32x16& p1, int jb, int qrel, int hi) {
    const int kb = 64 * jb + 4 * hi;
#pragma unroll
    for (int r = 0; r < 16; ++r) { const int kv = kb + (r & 3) + 8 * (r >> 2); if (kv > qrel) p0[r] = -INFINITY; if (kv + 32 > qrel) p1[r] = -INFINITY; } }

__device__ __forceinline__ void attn_epilogue_body(LAS unsigned char* lds, f32x16 (&o)[4], float l_reg, bf16_t* __restrict__ yb, const float* __restrict__ subln_w, float lam,
                                                   size_t rowb, int q0, int h, int wave, int lane) {
    asm volatile("" : "+v"(lane));
    const int r32 = lane & 31, hi = lane >> 5, map = wave >> 2, qs = wave & 3;
    LAS float* wsf = (LAS float*)(lds + SCR_OFF) + wave * 64;
    if (hi == 0) wsf[r32] = 1.f / l_reg;
    float il[16];
#pragma unroll
    for (int g = 0; g < 4; ++g) { const f32x4 t4 = *(const LAS f32x4*)(wsf + 8 * g + 4 * hi); il[4 * g] = t4[0]; il[4 * g + 1] = t4[1]; il[4 * g + 2] = t4[2]; il[4 * g + 3] = t4[3]; }
    __syncthreads();
    LAS float* comb = (LAS float*)(lds + COMB_OFF) + qs * 4096;
    if (map == 1) {
#pragma unroll
        for (int d = 0; d < 4; ++d)
#pragma unroll
            for (int r = 0; r < 16; ++r) comb[crow(r, hi) * 128 + 32 * d + r32] = o[d][r] * il[r];
    }
    __syncthreads();
    if (map == 0) {
        float sw[4];
#pragma unroll
        for (int d = 0; d < 4; ++d) sw[d] = subln_w[32 * d + r32] * (1.f - LAM_INIT);
#pragma unroll
        for (int r = 0; r < 16; ++r) {
            float v[4], ss = 0.f;
#pragma unroll
            for (int d = 0; d < 4; ++d) { v[d] = o[d][r] * il[r] - lam * comb[crow(r, hi) * 128 + 32 * d + r32]; ss += v[d] * v[d]; }
            ss += __shfl_xor(ss, 1); ss += __shfl_xor(ss, 2); ss += __shfl_xor(ss, 4); ss += __shfl_xor(ss, 8); ss += __shfl_xor(ss, 16);
            const float rs = rsqrtf(ss * (1.f / 128.f) + SUBLN_EPS);
            bf16_t* op = yb + (rowb + q0 + crow(r, hi)) * 512 + h * 128 + r32;
#pragma unroll
            for (int d = 0; d < 4; ++d) op[32 * d] = f2bf(v[d] * rs * sw[d]);
        }
    }
    __syncthreads();
}
__device__ __forceinline__ void attn_unit(LAS unsigned char* lds, const bf16_t* __restrict__ z, bf16_t* __restrict__ yb, const float* __restrict__ subln_w, float lam,
                                          int b, int h, int qblk, int wave_, int lane) {
    const int wave = __builtin_amdgcn_readfirstlane(wave_);
    const int r32 = lane & 31, hi = lane >> 5, map = wave >> 2, qs = wave & 3;
    const int q0 = qblk * 128 + qs * 32, NT = 2 * qblk + 2, qrel = qs * 32 + r32;
    const size_t rowb = (size_t)b * SEQ;
    const float slope = exp2f(-2.f * (float)(h + 1)), slope2 = slope * LOG2E, s64 = 64.f * slope2, s32 = 32.f * slope2;
    const unsigned lds0 = (unsigned)(uintptr_t)lds;
    LAS float* wsf = (LAS float*)(lds + SCR_OFF) + wave * 64;
    const bf16_t* ksrc = z + (rowb + lane) * NZ + C_ZK + h * 128 + wave * 8;
    const int pc0 = 2 * wave;
    const bf16_t* vsrc0 = z + (rowb + 16 * (pc0 & 3) + (lane >> 2)) * NZ + C_ZV + h * 128 + 32 * (pc0 >> 2) + (lane & 3) * 8;
    const unsigned kdst = lds0 + LDS_KR + wave * 1024, vdst = lds0 + LDS_VR + pc0 * 1024;
#define DMA_K(t, slot) do { const bf16_t* k_ = ksrc + (size_t)(t) * 64 * NZ; const unsigned d_ = (unsigned)__builtin_amdgcn_readfirstlane(kdst + (slot)); glds16(k_, d_); glds16_o128(k_, d_ + 8192 - 128); } while (0)
#define DMA_V(t, slot) do { const size_t o_ = (size_t)(t) * 64 * NZ; const unsigned d_ = (unsigned)__builtin_amdgcn_readfirstlane(vdst + (slot)); glds16(vsrc0 + o_, d_); glds16(vsrc0 + o_ + 16 * NZ, d_ + 1024); } while (0)
    const lcp vp0 = lds + LDS_VR + ((lane >> 4) & 1) * 32 + (lane & 3) * 8 + (4 * hi + ((lane & 15) >> 2)) * 64;
    const lcp kp0 = lds + LDS_KR + map * 8192 + hi * 1024 + r32 * 16;
    DMA_K(0, 0); DMA_V(0, 0); DMA_K(1, RSLOT);
    bf16x8 qr[4];
    {
        const bf16_t* qp = z + (rowb + q0 + r32) * NZ + C_Q + h * 128 + map * 64 + hi * 8;
#pragma unroll
        for (int d0 = 0; d0 < 4; ++d0) qr[d0] = *(const bf16x8*)(qp + d0 * 16);
    }
    f32x16 bias16;
#pragma unroll
    for (int r = 0; r < 16; ++r) bias16[r] = (8.f * slope) * (float)((r & 3) + 8 * (r >> 2));
    DA_PIN(bias16);
    float mhat = 0.f, l_reg = 0.f, offA = slope2 * (float)(4 * hi);
    f32x16 o[4];
#pragma unroll
    for (int d = 0; d < 4; ++d) o[d] = (f32x16){};
    bool resc = false;
    f32x16 c0, c1; bf16x8 kf[8]; s16x4 vlo[4], vhi[4]; v4u pw0, pw1, pw2, pw3;
#define SL(t) ((((t)) & 3) * RSLOT)
#define EX(v, nm) __builtin_amdgcn_exp2f(__builtin_fmaf((v), C2, (nm)))
#define RESC() do { if (resc) { _Pragma("unroll") for (int d_ = 0; d_ < 4; ++d_) _Pragma("unroll") for (int r = 0; r < 16; ++r) o[d_][r] *= wsf[crow(r, hi)]; } } while (0)
#define PKW(P, i) pg8::cvt_pk_bf16(P[i], P[(i) + 1])
    DMA_K(2, 2 * RSLOT); DMA_K(3, 3 * RSLOT); DMA_V(1, RSLOT);
    DA_WAIT_BAR(10);
#pragma unroll
    for (int d0 = 0; d0 < 4; ++d0) kload2(kf, kp0, d0);
    c0 = DA_MFMA(kf[0], qr[0], bias16); c1 = DA_MFMA(kf[1], qr[0], bias16); c0 = DA_MFMA(kf[2], qr[1], c0); c1 = DA_MFMA(kf[3], qr[1], c1);
    c0 = DA_MFMA(kf[4], qr[2], c0); c1 = DA_MFMA(kf[5], qr[2], c1); c0 = DA_MFMA(kf[6], qr[3], c0); c1 = DA_MFMA(kf[7], qr[3], c1);
    if (NT == 2) cmask(c0, c1, 0, qrel, hi);
    { mhat = rowmax(c0, c1, offA, offA + s32); const float nmh0 = offA - mhat, nmh1 = nmh0 + s32; float sacc = 0.f;
#pragma unroll
      for (int r = 0; r < 16; ++r) { c0[r] = EX(c0[r], nmh0); c1[r] = EX(c1[r], nmh1); sacc += c0[r] + c1[r]; }
      l_reg = sacc; }
    pw0 = (v4u){PKW(c0, 0), PKW(c0, 2), PKW(c0, 4), PKW(c0, 6)}; pw1 = (v4u){PKW(c0, 8), PKW(c0, 10), PKW(c0, 12), PKW(c0, 14)};
    pw2 = (v4u){PKW(c1, 0), PKW(c1, 2), PKW(c1, 4), PKW(c1, 6)}; pw3 = (v4u){PKW(c1, 8), PKW(c1, 10), PKW(c1, 12), PKW(c1, 14)};
    DA_WAIT_BAR(6);
    DMA_K(4, 0); DMA_V(2, 2 * RSLOT);
#pragma unroll
    for (int d0 = 0; d0 < 4; ++d0) kload2(kf, kp0 + RSLOT, d0);
    if (NT == 2) { DA_WAIT_BAR(0); } else { DA_WAIT_BAR(8); }
#define PAF(k) __builtin_bit_cast(bf16x8, pw##k)
#define VFR(i) (bf16x8){vlo[(i) & 3][0], vlo[(i) & 3][1], vlo[(i) & 3][2], vlo[(i) & 3][3], vhi[(i) & 3][0], vhi[(i) & 3][1], vhi[(i) & 3][2], vhi[(i) & 3][3]}
#define VOFF(i) ((((i) & 3) * 4 + ((i) >> 2)) * 1024)
#define VRD(i) do { vlo[(i) & 3] = vtr(vp_ + VOFF(i)); vhi[(i) & 3] = vtr(vp_ + VOFF(i) + 512); DA_SBAR(); } while (0)
#define KRD(G, d0) do { if (G) { kload2(kf, kp0 + sl_next_, d0); DA_SBAR(); } } while (0)
#define GAPA(MF) do { MF; DA_SBAR(); } while (0)
#define GAPB(MF, X, i, nm, A0, A1, EXTRA) do { MF; X[i] = EX(X[i], nm); X[(i) + 1] = EX(X[(i) + 1], nm); sacc += A0; sacc += A1; EXTRA; DA_PIN(X); DA_PIN(sacc); DA_SBAR(); } while (0)
#define STEP(t, MASK, GK, GV, GL) do { DA_SBAR(); \
    const lcp vp_ = vp0 + SL((t) - 1); const int sl_next_ = SL((t) + 1); \
            GAPA(c0 = DA_MFMA(kf[0], qr[0], bias16)); GAPA(c1 = DA_MFMA(kf[1], qr[0], bias16)); GAPA(c0 = DA_MFMA(kf[2], qr[1], c0)); GAPA(c1 = DA_MFMA(kf[3], qr[1], c1)); \
    VRD(0); GAPA(c0 = DA_MFMA(kf[4], qr[2], c0)); VRD(1); GAPA(c1 = DA_MFMA(kf[5], qr[2], c1)); VRD(2); GAPA(c0 = DA_MFMA(kf[6], qr[3], c0)); VRD(3); GAPA(c1 = DA_MFMA(kf[7], qr[3], c1)); \
    offA += s64; \
    if (GK) DMA_K((t) + 4, SL(t)); if (GV) DMA_V((t) + 2, SL((t) + 2)); \
    if (MASK) cmask(c0, c1, (t) - (NT - 2), qrel, hi); \
    { const float rm = rowmax(c0, c1, offA, offA + s32) - mhat; resc = false; \
      if (__builtin_expect(__any(rm > THR), 0)) { const float dl = __builtin_fmaxf(rm, 0.f); mhat += dl; \
          const float f = __builtin_amdgcn_exp2f(-dl); l_reg *= f; if (hi == 0) wsf[r32] = f; resc = true; } } \
    const float nmh0 = offA - mhat, nmh1 = nmh0 + s32; float sacc = 0.f; DA_SBAR(); \
    GAPB(o[0] = DA_MFMA(PAF(0), VFR(0), o[0]), c0, 0, nmh0, 0.f, 0.f, );             VRD(4); \
    GAPB(o[1] = DA_MFMA(PAF(0), VFR(1), o[1]), c0, 2, nmh0, c0[0], c0[1], );         VRD(5); \
    GAPB(o[2] = DA_MFMA(PAF(0), VFR(2), o[2]), c0, 4, nmh0, c0[2], c0[3], );         VRD(6); \
    GAPB(o[3] = DA_MFMA(PAF(0), VFR(3), o[3]), c0, 6, nmh0, c0[4], c0[5], );         VRD(7); \
    GAPB(o[0] = DA_MFMA(PAF(1), VFR(4), o[0]), c0, 8, nmh0, c0[6], c0[7], pw0[0] = PKW(c0, 0); pw0[1] = PKW(c0, 2); DA_PIN(pw0));    VRD(8); \
    GAPB(o[1] = DA_MFMA(PAF(1), VFR(5), o[1]), c0, 10, nmh0, c0[8], c0[9], pw0[2] = PKW(c0, 4); pw0[3] = PKW(c0, 6); DA_PIN(pw0));   VRD(9); \
    GAPB(o[2] = DA_MFMA(PAF(1), VFR(6), o[2]), c0, 12, nmh0, c0[10], c0[11], );      VRD(10); \
    GAPB(o[3] = DA_MFMA(PAF(1), VFR(7), o[3]), c0, 14, nmh0, c0[12], c0[13], );      VRD(11); \
    GAPB(o[0] = DA_MFMA(PAF(2), VFR(8), o[0]), c1, 0, nmh1, c0[14], c0[15], pw1[0] = PKW(c0, 8); pw1[1] = PKW(c0, 10); DA_PIN(pw1));  VRD(12); \
    GAPB(o[1] = DA_MFMA(PAF(2), VFR(9), o[1]), c1, 2, nmh1, c1[0], c1[1], pw1[2] = PKW(c0, 12); pw1[3] = PKW(c0, 14); DA_PIN(pw1));   VRD(13); \
    GAPB(o[2] = DA_MFMA(PAF(2), VFR(10), o[2]), c1, 4, nmh1, c1[2], c1[3], );        VRD(14); \
    GAPB(o[3] = DA_MFMA(PAF(2), VFR(11), o[3]), c1, 6, nmh1, c1[4], c1[5], );        VRD(15); \
    GAPB(o[0] = DA_MFMA(PAF(3), VFR(12), o[0]), c1, 8, nmh1, c1[6], c1[7], pw2[0] = PKW(c1, 0); pw2[1] = PKW(c1, 2); DA_PIN(pw2));   KRD(GL, 0); \
    GAPB(o[1] = DA_MFMA(PAF(3), VFR(13), o[1]), c1, 10, nmh1, c1[8], c1[9], pw2[2] = PKW(c1, 4); pw2[3] = PKW(c1, 6); DA_PIN(pw2));  KRD(GL, 1); \
    GAPB(o[2] = DA_MFMA(PAF(3), VFR(14), o[2]), c1, 12, nmh1, c1[10], c1[11], );     KRD(GL, 2); \
    GAPB(o[3] = DA_MFMA(PAF(3), VFR(15), o[3]), c1, 14, nmh1, c1[12], c1[13], );     KRD(GL, 3); \
    sacc += c1[14]; sacc += c1[15]; l_reg += sacc; \
    pw3[0] = PKW(c1, 8); pw3[1] = PKW(c1, 10); pw3[2] = PKW(c1, 12); pw3[3] = PKW(c1, 14); DA_PIN(pw3); \
    } while (0)
#define ENDW(tt) do { if ((tt) + 4 < NT) { DA_WAIT_BAR(8); } else if ((tt) + 3 < NT) { DA_WAIT_BAR(6); } else if ((tt) + 2 < NT) { DA_WAIT_BAR(4); } else { DA_WAIT_BAR(0); } } while (0)
    int t = 1;
    for (; t + 4 < NT; ++t) {
        STEP(t, false, true, true, true); DA_WAIT_BAR(8); RESC();
    }
    for (; t + 1 < NT; ++t) {
        STEP(t, true, (t + 4 < NT), (t + 2 < NT), (t + 1 < NT)); ENDW(t); RESC();
    }
    STEP(NT - 1, true, false, false, false); RESC();
    { const lcp vp_ = vp0 + SL(NT - 1);
#define DRN(k, i) do { const s16x4 lo_ = vtr(vp_ + VOFF(i)), hh_ = vtr(vp_ + VOFF(i) + 512); \
        o[(i) & 3] = DA_MFMA(PAF(k), ((bf16x8){lo_[0], lo_[1], lo_[2], lo_[3], hh_[0], hh_[1], hh_[2], hh_[3]}), o[(i) & 3]); } while (0)
      DRN(0, 0); DRN(0, 1); DRN(0, 2); DRN(0, 3); DRN(1, 4); DRN(1, 5); DRN(1, 6); DRN(1, 7); DRN(2, 8); DRN(2, 9); DRN(2, 10); DRN(2, 11); DRN(3, 12); DRN(3, 13); DRN(3, 14); DRN(3, 15);
#undef DRN
    }
#undef DMA_K
#undef DMA_V
#undef SL
#undef EX
#undef RESC
#undef PKW
#undef PAF
#undef VFR
#undef VOFF
#undef VRD
#undef KRD
#undef GAPA
#undef GAPB
#undef STEP
#undef ENDW
    { auto rr = __builtin_amdgcn_permlane32_swap(__float_as_uint(l_reg), __float_as_uint(l_reg), false, false); l_reg = __uint_as_float(rr[0]) + __uint_as_float(rr[1]); }
    attn_epilogue_body(lds, o, l_reg, yb, subln_w, lam, rowb, q0, h, wave, lane);
}
}

namespace rw {
typedef short bf16x8 __attribute__((ext_vector_type(8)));
typedef float f32x2 __attribute__((ext_vector_type(2)));
typedef short s16x4 __attribute__((ext_vector_type(4)));
constexpr int CH = 32, ACT_PITCH = 528;
constexpr int OFF_HAT = 41472, HAT_PITCH = 144, HAT_SZ = 32 * HAT_PITCH, OFF_TIL = OFF_HAT + 4 * HAT_SZ, TIL_PITCH = 40, TIL_SZ = 64 * TIL_PITCH, OFF_GR = OFF_TIL + 4 * TIL_SZ, OFF_WC = OFF_GR + 10 * 1024;
constexpr int OFF_ACT = 0, OFF_RKV = 16896, OFF_VEC = 41472, OFF_G = 82432, OFF_Y = 90624, OFF_NRM = 98816, OFF_SCL = 99328, OFF_CT = 99840, OFF_SCP = 102400;
template <int CTRL> __device__ __forceinline__ float dppf(float x) { return __builtin_bit_cast(float, __builtin_amdgcn_mov_dpp(__builtin_bit_cast(int, x), CTRL, 0xf, 0xf, true)); }
__device__ __forceinline__ float row_allsum(float v) { v += dppf<0x128>(v); v += dppf<0x124>(v); v += dppf<0x122>(v); v += dppf<0x121>(v); return v; }
__device__ __forceinline__ void row_allsum4(float& a, float& b, float& c, float& d) {
#define RW_DPP4(n) "v_add_f32_dpp %0, %0, %0 row_ror:" #n " row_mask:0xf bank_mask:0xf\n\tv_add_f32_dpp %1, %1, %1 row_ror:" #n " row_mask:0xf bank_mask:0xf\n\t" \
                   "v_add_f32_dpp %2, %2, %2 row_ror:" #n " row_mask:0xf bank_mask:0xf\n\tv_add_f32_dpp %3, %3, %3 row_ror:" #n " row_mask:0xf bank_mask:0xf\n\t"
    asm volatile("s_nop 1\n\t" RW_DPP4(8) RW_DPP4(4) RW_DPP4(2) RW_DPP4(1) "s_nop 1" : "+v"(a), "+v"(b), "+v"(c), "+v"(d));
#undef RW_DPP4
}
__device__ __forceinline__ f32x4 ld4bf(const bf16_t* p) { const v2u w = *(const v2u*)p; return (f32x4){pg8::bflo(w.x), pg8::bfhi(w.x), pg8::bflo(w.y), pg8::bfhi(w.y)}; }
__device__ __forceinline__ float fsig(float x) { return __builtin_amdgcn_rcpf(1.f + __expf(-x)); }
__device__ __forceinline__ float ftanh(float x) { return 1.f - 2.f * __builtin_amdgcn_rcpf(1.f + __expf(2.f * x)); }
struct ZRow { v2u r, k, v, w, a; v4u g; };
__device__ __forceinline__ ZRow ldrow(const bf16_t* zr, int c4, int cg) {
    ZRow o; o.r = *(const v2u*)(zr + C_R + c4); o.k = *(const v2u*)(zr + C_K + c4); o.v = *(const v2u*)(zr + C_V + c4); o.w = *(const v2u*)(zr + C_WL + 4 * cg); o.a = *(const v2u*)(zr + C_AL + 4 * cg);
    o.g = *(const v4u*)(zr + C_GL + 8 * cg); return o;
}
__device__ __forceinline__ f32x4 up4(v2u w) { return (f32x4){pg8::bflo(w.x), pg8::bfhi(w.x), pg8::bflo(w.y), pg8::bfhi(w.y)}; }

struct ScanP { const float *mu, *w0, *w2, *a0, *a2, *g2, *k_k, *k_a, *r_k, *lnx_w, *lnx_b; };
__device__ __forceinline__ void scan_unit(LAS unsigned char* lds, const bf16_t* __restrict__ z, bf16_t* __restrict__ ya, const ScanP P, int b, int h, int tid, int wave, int lane) {
    asm volatile("" : "+v"(tid)); lane = tid & 63;
    const float* mu = P.mu; const float* w0 = P.w0; const float* w2 = P.w2; const float* a0 = P.a0; const float* a2 = P.a2; const float* g2 = P.g2;
    const float* k_k = P.k_k; const float* k_a = P.k_a; const float* r_k = P.r_k; const float* lnx_w = P.lnx_w; const float* lnx_b = P.lnx_b;
    const size_t rowb = (size_t)b * SEQ;
    const int tl = tid >> 4, cg = tid & 15;
    const int nt = wave & 3, rl = lane & 15, rg = lane >> 4;
    LAS float* rkv = (LAS float*)(lds + OFF_RKV); LAS float* vec = (LAS float*)(lds + OFF_VEC); LAS float* gbuf = (LAS float*)(lds + OFF_G);
    LAS float* ybuf = (LAS float*)(lds + OFF_Y); LAS float* nrm = (LAS float*)(lds + OFF_NRM); LAS float* scl = (LAS float*)(lds + OFF_SCL); LAS float* scp = (LAS float*)(lds + OFF_SCP);
    bf16x8 bfr[8];
    {
        const int col = h * 64 + 16 * nt + rl;
#pragma unroll
        for (int f = 0; f < 8; ++f) {
            const float* src = (f < 2) ? w2 : (f < 4) ? a2 : g2;
            const int kb = ((f < 4) ? 32 * (f & 1) : 32 * (f - 4)) + 8 * rg;
            float e[8];
#pragma unroll
            for (int j = 0; j < 8; ++j) e[j] = src[(size_t)(kb + j) * 512 + col];
            v4u p; p.x = pg8::cvt_pk_bf16(e[0], e[1]); p.y = pg8::cvt_pk_bf16(e[2], e[3]); p.z = pg8::cvt_pk_bf16(e[4], e[5]); p.w = pg8::cvt_pk_bf16(e[6], e[7]);
            bfr[f] = __builtin_bit_cast(bf16x8, p);
            __builtin_amdgcn_sched_barrier(0);
        }
    }
    const int mt = wave >> 2;
    const int hc = h * 64 + 16 * nt + rl;
    const float w0c = w0[hc], a0c = a0[hc], kkc = k_k[hc], kac = k_a[hc], rkc = r_k[hc];
    const int c4 = h * 64 + 4 * cg;
    f32x4 ST[4];
#pragma unroll
    for (int i = 0; i < 4; ++i) ST[i] = (f32x4){0.f, 0.f, 0.f, 0.f};
    LAS float* ctab = (LAS float*)(lds + OFF_CT);
    if (tl == 0) {
        LAS float* ct = ctab + cg * 36;
        *(LAS f32x4*)(ct + 0) = *(const f32x4*)(mu + C_R + c4); *(LAS f32x4*)(ct + 4) = *(const f32x4*)(mu + C_K + c4); *(LAS f32x4*)(ct + 8) = *(const f32x4*)(mu + C_V + c4);
        *(LAS f32x4*)(ct + 12) = *(const f32x4*)(mu + C_WL + 4 * cg); *(LAS f32x4*)(ct + 16) = *(const f32x4*)(mu + C_AL + 4 * cg);
        *(LAS f32x4*)(ct + 20) = *(const f32x4*)(mu + C_GL + 8 * cg); *(LAS f32x4*)(ct + 24) = *(const f32x4*)(mu + C_GL + 8 * cg + 4);
        *(LAS f32x4*)(ct + 28) = *(const f32x4*)(lnx_w + c4); *(LAS f32x4*)(ct + 32) = *(const f32x4*)(lnx_b + c4);
    }
    __syncthreads();
    const LAS float* myct = ctab + cg * 36;
    ZRow zc = ldrow(z + (rowb + tl) * NZ, c4, cg), zp;
    if (tl > 0) zp = ldrow(z + (rowb + tl - 1) * NZ, c4, cg); else { zp.r = zp.k = zp.v = zp.w = zp.a = (v2u){0u, 0u}; zp.g = (v4u){0u, 0u, 0u, 0u}; }
    for (int t0 = 0; t0 < SEQ; t0 += CH) {
        {
            const f32x4 cr = up4(zc.r), ck = up4(zc.k), cv = up4(zc.v), cw = up4(zc.w), ca = up4(zc.a);
            const f32x4 cg0 = (f32x4){pg8::bflo(zc.g.x), pg8::bfhi(zc.g.x), pg8::bflo(zc.g.y), pg8::bfhi(zc.g.y)}, cg1 = (f32x4){pg8::bflo(zc.g.z), pg8::bfhi(zc.g.z), pg8::bflo(zc.g.w), pg8::bfhi(zc.g.w)};
            const f32x4 pr = up4(zp.r), pk = up4(zp.k), pv = up4(zp.v), pw = up4(zp.w), pa = up4(zp.a);
            const f32x4 pg0 = (f32x4){pg8::bflo(zp.g.x), pg8::bfhi(zp.g.x), pg8::bflo(zp.g.y), pg8::bfhi(zp.g.y)}, pg1 = (f32x4){pg8::bflo(zp.g.z), pg8::bfhi(zp.g.z), pg8::bflo(zp.g.w), pg8::bfhi(zp.g.w)};
            if (t0 + CH < SEQ) { zc = ldrow(z + (rowb + t0 + CH + tl) * NZ, c4, cg); zp = ldrow(z + (rowb + t0 + CH + tl - 1) * NZ, c4, cg); }
            const f32x4 rs_ = cr + (pr - cr) * *(const LAS f32x4*)(myct + 0), ks_ = ck + (pk - ck) * *(const LAS f32x4*)(myct + 4), vs_ = cv + (pv - cv) * *(const LAS f32x4*)(myct + 8);
            const f32x4 ws_ = cw + (pw - cw) * *(const LAS f32x4*)(myct + 12), as_ = ca + (pa - ca) * *(const LAS f32x4*)(myct + 16);
            const f32x4 g0_ = cg0 + (pg0 - cg0) * *(const LAS f32x4*)(myct + 20), g1_ = cg1 + (pg1 - cg1) * *(const LAS f32x4*)(myct + 24);
            *(LAS f32x4*)(rkv + 0 * 2048 + tl * 64 + 4 * cg) = rs_; *(LAS f32x4*)(rkv + 1 * 2048 + tl * 64 + 4 * cg) = ks_; *(LAS f32x4*)(rkv + 2 * 2048 + tl * 64 + 4 * cg) = vs_;
            LAS unsigned char* ar = lds + OFF_ACT + tl * ACT_PITCH;
            v2u tw; tw.x = pg8::cvt_pk_bf16(ftanh(ws_[0]), ftanh(ws_[1])); tw.y = pg8::cvt_pk_bf16(ftanh(ws_[2]), ftanh(ws_[3]));
            *(LAS v2u*)(ar + 8 * cg) = tw;
            v2u aw; aw.x = pg8::cvt_pk_bf16(as_[0], as_[1]); aw.y = pg8::cvt_pk_bf16(as_[2], as_[3]);
            *(LAS v2u*)(ar + 128 + 8 * cg) = aw;
            v4u gw; gw.x = pg8::cvt_pk_bf16(fsig(g0_[0]), fsig(g0_[1])); gw.y = pg8::cvt_pk_bf16(fsig(g0_[2]), fsig(g0_[3]));
            gw.z = pg8::cvt_pk_bf16(fsig(g1_[0]), fsig(g1_[1])); gw.w = pg8::cvt_pk_bf16(fsig(g1_[2]), fsig(g1_[3]));
            *(LAS v4u*)(ar + 256 + 16 * cg) = gw;
        }
        __syncthreads();
        f32x4 accw = (f32x4){0.f, 0.f, 0.f, 0.f}, acca = accw, accg = accw;
        {
            const LAS unsigned char* ap = lds + OFF_ACT + (16 * mt + rl) * ACT_PITCH + 8 * rg * 2;
#pragma unroll
            for (int f = 0; f < 8; ++f) {
                const bf16x8 a = *(const LAS bf16x8*)(ap + f * 64);
                if (f < 2) accw = __builtin_amdgcn_mfma_f32_16x16x32_bf16(a, bfr[f], accw, 0, 0, 0);
                else if (f < 4) acca = __builtin_amdgcn_mfma_f32_16x16x32_bf16(a, bfr[f], acca, 0, 0, 0);
                else accg = __builtin_amdgcn_mfma_f32_16x16x32_bf16(a, bfr[f], accg, 0, 0, 0);
            }
        }
        float lw[4], av[4], kk[4];
        {
            const int c = 16 * nt + rl;
            float n2[4];
#pragma unroll
            for (int r = 0; r < 4; ++r) {
                const int tok = 16 * mt + 4 * rg + r;
                gbuf[tok * 64 + c] = accg[r];
                const float nx = -(w0c + accw[r]);
                const float sp = nx > 20.f ? nx : __logf(1.f + __expf(nx));
                lw[r] = -__expf(-sp - 0.5f);
                av[r] = fsig(a0c + acca[r]);
                kk[r] = rkv[1 * 2048 + tok * 64 + c] * kkc;
                n2[r] = kk[r] * kk[r];
            }
            row_allsum4(n2[0], n2[1], n2[2], n2[3]);
            if (rl == 0) {
#pragma unroll
                for (int r = 0; r < 4; ++r) nrm[(16 * mt + 4 * rg + r) * 4 + nt] = n2[r];
            }
        }
        __syncthreads();
        {
            const int c = 16 * nt + rl;
            const float p0 = lw[0], p1 = p0 + lw[1], p2 = p1 + lw[2], p3 = p2 + lw[3];
            const float t1 = __shfl(p3, (lane - 16) & 63), t2 = __shfl(p3, (lane - 32) & 63), t3 = __shfl(p3, (lane - 48) & 63);
            const float E = (rg >= 1 ? t1 : 0.f) + (rg >= 2 ? t2 : 0.f) + (rg >= 3 ? t3 : 0.f);
            const float Ltot = __shfl(E + p3, rl + 48);
            const float pin[4] = {p0, p1, p2, p3};
            float bt[4], kt[4];
#pragma unroll
            for (int r = 0; r < 4; ++r) {
                const int tok = 16 * mt + 4 * rg + r;
                const f32x4 n4 = *(const LAS f32x4*)(nrm + tok * 4);
                const float ksv = rkv[1 * 2048 + tok * 64 + c], rsv = rkv[0 * 2048 + tok * 64 + c];
                const float inv = __builtin_amdgcn_rcpf(fmaxf(sqrtf((n4[0] + n4[1]) + (n4[2] + n4[3])), 1e-12f));
                const float kkn = kk[r] * inv, beta = kkn * av[r], kmod = ksv * (1.f + (av[r] - 1.f) * kac);
                const float L = E + pin[r], eL = __expf(L), ieL = __expf(-L), eLm = __expf(L - lw[r]), eT = __expf(Ltot - L);
                LAS unsigned char* hp = lds + OFF_HAT + tok * HAT_PITCH + c * 2;
                *(LAS bf16_t*)(hp) = f2bf(-kkn * eLm); *(LAS bf16_t*)(hp + HAT_SZ) = f2bf(beta * ieL); *(LAS bf16_t*)(hp + 2 * HAT_SZ) = f2bf(kmod * ieL); *(LAS bf16_t*)(hp + 3 * HAT_SZ) = f2bf(rsv * eL);
                bt[r] = beta * eT; kt[r] = kmod * eT;
                float pbr = beta * rsv, pkr = kmod * rsv, pbo = rsv * kmod * rkc, dum = 0.f;
                row_allsum4(pbr, pkr, pbo, dum);
                if (rl == 0) *(LAS f32x4*)(scp + (tok * 4 + nt) * 4) = (f32x4){pbr, pkr, pbo, 0.f};
            }
            LAS unsigned char* tp = lds + OFF_TIL + (2 * mt) * TIL_SZ + c * TIL_PITCH + 8 * rg;
            v2u w; w.x = pg8::cvt_pk_bf16(bt[0], bt[1]); w.y = pg8::cvt_pk_bf16(bt[2], bt[3]); *(LAS v2u*)(tp) = w;
            w.x = pg8::cvt_pk_bf16(kt[0], kt[1]); w.y = pg8::cvt_pk_bf16(kt[2], kt[3]); *(LAS v2u*)(tp + TIL_SZ) = w;
            if (rg == 0) ((LAS float*)(lds + OFF_WC))[mt * 64 + c] = __expf(Ltot);
        }
        __syncthreads();
        if (tid < CH) {
            const f32x4 p0 = *(const LAS f32x4*)(scp + tid * 16), p1 = *(const LAS f32x4*)(scp + tid * 16 + 4), p2 = *(const LAS f32x4*)(scp + tid * 16 + 8), p3 = *(const LAS f32x4*)(scp + tid * 16 + 12);
            *(LAS f32x4*)(scl + 4 * tid) = (p0 + p1) + (p2 + p3);
        }
        int lane_ = lane; asm volatile("" : "+v"(lane_));
        const int rl_ = lane_ & 15, rg_ = lane_ >> 4;
        {
            const int c = wave >> 2, g = wave & 3;
            const LAS unsigned char* pa = lds + OFF_HAT + ((g & 1) ? 2 : 1) * HAT_SZ + (16 * c + rl_) * HAT_PITCH + 16 * rg_;
            const LAS unsigned char* pb = lds + OFF_HAT + ((g < 2) ? 0 : 3) * HAT_SZ + (16 * c + rl_) * HAT_PITCH + 16 * rg_;
            f32x4 acc = (f32x4){0.f, 0.f, 0.f, 0.f};
            acc = __builtin_amdgcn_mfma_f32_16x16x32_bf16(*(const LAS bf16x8*)(pa), *(const LAS bf16x8*)(pb), acc, 0, 0, 0);
            acc = __builtin_amdgcn_mfma_f32_16x16x32_bf16(*(const LAS bf16x8*)(pa + 64), *(const LAS bf16x8*)(pb + 64), acc, 0, 0, 0);
#pragma unroll
            for (int e = 0; e < 4; ++e) { const int row = 4 * rg_ + e; const bool keep = (g < 2) ? (row < rl_) : (row <= rl_); if (!keep) acc[e] = 0.f; }
            *(LAS f32x4*)(lds + OFF_GR + (c * 5 + g) * 1024 + lane_ * 16) = acc;
            if (g == 0) {
                asm volatile("s_waitcnt lgkmcnt(0)" ::: "memory");
                if (lane_ < 16) {
                    const int sc = lane_;
                    const LAS float* tb = (const LAS float*)(lds + OFF_GR + (c * 5) * 1024);
                    float m[16], ps[16];
#pragma unroll
                    for (int r = 0; r < 16; ++r) ps[r] = 0.f;
#pragma unroll
                    for (int u = 15; u >= 0; --u) {
                        m[u] = (u == sc) ? 1.f : ((u < sc) ? ps[u] : 0.f);
#pragma unroll
                        for (int r = 0; r < u; ++r) ps[r] = __builtin_fmaf(tb[(u + 16 * (r >> 2)) * 4 + (r & 3)], m[u], ps[r]);
                    }
                    LAS f32x4* mt_ = (LAS f32x4*)(lds + OFF_GR + (c * 5 + 4) * 1024);
#pragma unroll
                    for (int q = 0; q < 4; ++q) mt_[sc + 16 * q] = (f32x4){m[4 * q], m[4 * q + 1], m[4 * q + 2], m[4 * q + 3]};
                }
            }
        }
        __syncthreads();
        if (wave < 4) {
            const int ib = wave;
#pragma unroll
            for (int c = 0; c < 2; ++c) {
                bf16x8 sb[2];
#pragma unroll
                for (int ks = 0; ks < 2; ++ks) {
                    v4u p; p.x = pg8::cvt_pk_bf16(ST[2 * ks][0], ST[2 * ks][1]); p.y = pg8::cvt_pk_bf16(ST[2 * ks][2], ST[2 * ks][3]);
                    p.z = pg8::cvt_pk_bf16(ST[2 * ks + 1][0], ST[2 * ks + 1][1]); p.w = pg8::cvt_pk_bf16(ST[2 * ks + 1][2], ST[2 * ks + 1][3]);
                    sb[ks] = __builtin_bit_cast(bf16x8, p);
                }
                const LAS unsigned char* ha = lds + OFF_HAT + (16 * c + rl_) * HAT_PITCH + 8 * rg_;
                f32x4 xt = (f32x4){0.f, 0.f, 0.f, 0.f}, yt = xt;
#pragma unroll
                for (int ks = 0; ks < 2; ++ks) {
                    v4u fa, fr; const v2u a0_ = *(const LAS v2u*)(ha + 64 * ks), a1_ = *(const LAS v2u*)(ha + 64 * ks + 32);
                    const v2u r0_ = *(const LAS v2u*)(ha + 3 * HAT_SZ + 64 * ks), r1_ = *(const LAS v2u*)(ha + 3 * HAT_SZ + 64 * ks + 32);
                    fa.x = a0_.x; fa.y = a0_.y; fa.z = a1_.x; fa.w = a1_.y; fr.x = r0_.x; fr.y = r0_.y; fr.z = r1_.x; fr.w = r1_.y;
                    xt = __builtin_amdgcn_mfma_f32_16x16x32_bf16(__builtin_bit_cast(bf16x8, fa), sb[ks], xt, 0, 0, 0);
                    yt = __builtin_amdgcn_mfma_f32_16x16x32_bf16(__builtin_bit_cast(bf16x8, fr), sb[ks], yt, 0, 0, 0);
                }
                const LAS float* vsrc = rkv + 2 * 2048 + (16 * c + 4 * rg_) * 64 + 16 * ib + rl_;
                v2u vb_; vb_.x = pg8::cvt_pk_bf16(vsrc[0], vsrc[64]); vb_.y = pg8::cvt_pk_bf16(vsrc[128], vsrc[192]);
                const s16x4 vb = __builtin_bit_cast(s16x4, vb_);
                const LAS unsigned char* gr = lds + OFF_GR + (c * 5) * 1024 + lane_ * 16;
#define RW_AFR(g_) ({ const f32x4 t_ = *(const LAS f32x4*)(gr + (g_) * 1024); v2u w_; w_.x = pg8::cvt_pk_bf16(t_[0], t_[1]); w_.y = pg8::cvt_pk_bf16(t_[2], t_[3]); __builtin_bit_cast(s16x4, w_); })
#define RW_PK4(x_) ({ v2u w_; w_.x = pg8::cvt_pk_bf16((x_)[0], (x_)[1]); w_.y = pg8::cvt_pk_bf16((x_)[2], (x_)[3]); __builtin_bit_cast(s16x4, w_); })
                const f32x4 zt = __builtin_amdgcn_mfma_f32_16x16x16bf16_1k(RW_AFR(1), vb, xt, 0, 0, 0);
                const f32x4 ut = __builtin_amdgcn_mfma_f32_16x16x16bf16_1k(RW_AFR(4), RW_PK4(zt), (f32x4){0.f, 0.f, 0.f, 0.f}, 0, 0, 0);
                const s16x4 ub = RW_PK4(ut);
                yt = __builtin_amdgcn_mfma_f32_16x16x16bf16_1k(RW_AFR(2), ub, yt, 0, 0, 0);
                yt = __builtin_amdgcn_mfma_f32_16x16x16bf16_1k(RW_AFR(3), vb, yt, 0, 0, 0);
#pragma unroll
                for (int e = 0; e < 4; ++e) ybuf[(16 * c + 4 * rg_ + e) * 64 + 16 * ib + rl_] = yt[e];
                const LAS unsigned char* tl_ = lds + OFF_TIL + (2 * c) * TIL_SZ + rl_ * TIL_PITCH + 8 * rg_;
                const LAS float* wc = (const LAS float*)(lds + OFF_WC) + c * 64 + 4 * rg_;
#pragma unroll
                for (int jt = 0; jt < 4; ++jt) {
                    f32x4 acc = ST[jt] * *(const LAS f32x4*)(wc + 16 * jt);
                    acc = __builtin_amdgcn_mfma_f32_16x16x16bf16_1k(*(const LAS s16x4*)(tl_ + TIL_SZ + 16 * jt * TIL_PITCH), vb, acc, 0, 0, 0);
                    acc = __builtin_amdgcn_mfma_f32_16x16x16bf16_1k(*(const LAS s16x4*)(tl_ + 16 * jt * TIL_PITCH), ub, acc, 0, 0, 0);
                    ST[jt] = acc;
                }
#undef RW_AFR
#undef RW_PK4
            }
        }
        __syncthreads();
        {
            const f32x4 y4 = *(const LAS f32x4*)(ybuf + tl * 64 + 4 * cg);
            const float mean = row_allsum((y4[0] + y4[1]) + (y4[2] + y4[3])) * (1.f / 64.f);
            const f32x4 dv = y4 - mean;
            const float var = row_allsum((dv[0] * dv[0] + dv[1] * dv[1]) + (dv[2] * dv[2] + dv[3] * dv[3])) * (1.f / 64.f);
            const float rs_ = rsqrtf(var + GN_EPS);
            const f32x4 yn = dv * rs_ * *(const LAS f32x4*)(myct + 28) + *(const LAS f32x4*)(myct + 32);
            const float bonus = scl[tl * 4 + 2];
            const f32x4 vs_ = *(const LAS f32x4*)(rkv + 2 * 2048 + tl * 64 + 4 * cg), g4 = *(const LAS f32x4*)(gbuf + tl * 64 + 4 * cg);
            const f32x4 o = (yn + vs_ * bonus) * g4;
            v2u w; w.x = pg8::cvt_pk_bf16(o[0], o[1]); w.y = pg8::cvt_pk_bf16(o[2], o[3]);
            *(v2u*)(ya + (rowb + t0 + tl) * 512 + c4) = w;
        }
        __syncthreads();
    }
}
}

typedef __bf16 bf16x2_t __attribute__((ext_vector_type(2)));
__device__ __forceinline__ float dot2bf(unsigned a, unsigned b, float c) { return __builtin_amdgcn_fdot2_f32_bf16(__builtin_bit_cast(bf16x2_t, a), __builtin_bit_cast(bf16x2_t, b), c, false); }
__device__ __forceinline__ unsigned f2ord(float f) { const unsigned u = __float_as_uint(f); return (u & 0x80000000u) ? ~u : (u | 0x80000000u); }
__device__ __forceinline__ float ord2f(unsigned o) { return __uint_as_float((o & 0x80000000u) ? (o ^ 0x80000000u) : ~o); }
__device__ __forceinline__ unsigned row_allmax_u32(unsigned v) {
    v = max(v, (unsigned)__builtin_amdgcn_update_dpp(0, (int)v, 0x128, 0xf, 0xf, false));
    v = max(v, (unsigned)__builtin_amdgcn_update_dpp(0, (int)v, 0x124, 0xf, 0xf, false));
    v = max(v, (unsigned)__builtin_amdgcn_update_dpp(0, (int)v, 0x122, 0xf, 0xf, false));
    v = max(v, (unsigned)__builtin_amdgcn_update_dpp(0, (int)v, 0x121, 0xf, 0xf, false));
    return v;
}

constexpr int TK_PITCH = 272, TK_HALF = 128 * TK_PITCH;
typedef short tk_bf16x8 __attribute__((ext_vector_type(8)));
__device__ __forceinline__ void topk_loadq(tk_bf16x8 (&qa)[8], const bf16_t* __restrict__ qb, int t0, int h, int lane) {
    const bf16_t* qp = qb + (size_t)(t0 + (lane & 15)) * 2048 + h * 256 + 8 * (lane >> 4);
#pragma unroll
    for (int i = 0; i < 8; ++i) qa[i] = *(const tk_bf16x8*)(qp + i * 32);
}
__device__ __forceinline__ void topk_item(const tk_bf16x8 (&qa)[8], const LAS unsigned char* klds, int* __restrict__ ids, float* __restrict__ gates, int t0, int h, int lane) {
    const int rl = lane & 15, rg = lane >> 4;
    unsigned top[2][4];
#pragma unroll
    for (int c = 0; c < 2; ++c) {
        f32x4 acc[8];
#pragma unroll
        for (int nt = 0; nt < 8; ++nt) acc[nt] = (f32x4){64.f, 64.f, 64.f, 64.f};
        const LAS unsigned char* kp = klds + c * TK_HALF + rl * TK_PITCH + 16 * rg;
#pragma unroll
        for (int ks = 0; ks < 4; ++ks) {
#pragma unroll
            for (int nt = 0; nt < 8; ++nt) { const tk_bf16x8 b = *(const LAS tk_bf16x8*)(kp + nt * 16 * TK_PITCH + ks * 64); acc[nt] = __builtin_amdgcn_mfma_f32_16x16x32_bf16(qa[c * 4 + ks], b, acc[nt], 0, 0, 0); }
            __builtin_amdgcn_sched_barrier(0);
        }
        unsigned k[4][8];
#pragma unroll
        for (int r = 0; r < 4; ++r) {
#pragma unroll
            for (int nt = 0; nt < 8; ++nt) k[r][nt] = (__float_as_uint(fmaxf(acc[nt][r], 1.f)) & ~127u) | (unsigned)(127 - (nt * 16 + rl));
#define TK_CE(i, j) do { const unsigned a_ = max(k[r][i], k[r][j]), b_ = min(k[r][i], k[r][j]); k[r][i] = a_; k[r][j] = b_; } while (0)
            TK_CE(0, 1); TK_CE(2, 3); TK_CE(4, 5); TK_CE(6, 7); TK_CE(0, 2); TK_CE(1, 3); TK_CE(4, 6); TK_CE(5, 7); TK_CE(1, 2); TK_CE(5, 6);
            TK_CE(0, 4); TK_CE(1, 5); TK_CE(2, 6); TK_CE(3, 7); TK_CE(2, 4); TK_CE(3, 5); TK_CE(1, 2); TK_CE(3, 4); TK_CE(5, 6);
#undef TK_CE
        }
        unsigned tp[4] = {0u, 0u, 0u, 0u};
        for (int round = 0; round < 16; ++round) {
#pragma unroll
            for (int r = 0; r < 4; ++r) {
                const unsigned m = row_allmax_u32(k[r][0]);
                tp[r] = (rl == round) ? m : tp[r];
                const bool win = (k[r][0] == m);
                k[r][0] = win ? k[r][1] : k[r][0]; k[r][1] = win ? k[r][2] : k[r][1]; k[r][2] = win ? k[r][3] : k[r][2]; k[r][3] = win ? k[r][4] : k[r][3];
                k[r][4] = win ? k[r][5] : k[r][4]; k[r][5] = win ? k[r][6] : k[r][5]; k[r][6] = win ? k[r][7] : k[r][6]; k[r][7] = win ? 0u : k[r][7];
            }
        }
#pragma unroll
        for (int r = 0; r < 4; ++r) top[c][r] = tp[r];
    }
    const int rowbase = lane & 48;
    float v1[4]; int n1[4], ptr[4], myid[4]; unsigned k2[4], myv[4];
#pragma unroll
    for (int r = 0; r < 4; ++r) { v1[r] = __uint_as_float(top[0][r] & ~127u); n1[r] = 127 - (int)(top[0][r] & 127u); ptr[r] = 0; k2[r] = (unsigned)__builtin_amdgcn_ds_bpermute(rowbase * 4, (int)top[1][r]); myid[r] = 0; myv[r] = 0u; }
    for (int round = 0; round < 16; ++round) {
#pragma unroll
        for (int r = 0; r < 4; ++r) {
            const float head = v1[r] + __uint_as_float(k2[r] & ~127u);
            const unsigned key = (ptr[r] < 16) ? ((__float_as_uint(head) & ~15u) | (unsigned)(15 - rl)) : 0u;
            const unsigned m = row_allmax_u32(key);
            const bool win = (key == m);
            const unsigned wid = row_allmax_u32(win ? (unsigned)(n1[r] * 128 + (127 - (int)(k2[r] & 127u))) + 1u : 0u);
            myid[r] = (rl == round) ? (int)wid - 1 : myid[r];
            myv[r] = (rl == round) ? m : myv[r];
            ptr[r] += win ? 1 : 0;
            k2[r] = (unsigned)__builtin_amdgcn_ds_bpermute((rowbase + (ptr[r] & 15)) * 4, (int)top[1][r]);
        }
    }
#pragma unroll
    for (int r = 0; r < 4; ++r) {
        const float val = __uint_as_float(myv[r] & ~15u);
        const float vmax = __uint_as_float((unsigned)__builtin_amdgcn_ds_bpermute(rowbase * 4, (int)__float_as_uint(val)));
        const float e = __expf(val - vmax);
        const float sum = rw::row_allsum(e);
        gates[(size_t)(t0 + 4 * rg + r) * 128 + h * 16 + rl] = e / sum; ids[(size_t)(t0 + 4 * rg + r) * 128 + h * 16 + rl] = myid[r];
    }
}

typedef float f32x2 __attribute__((ext_vector_type(2)));
__device__ __forceinline__ void peer_token(const bf16_t* __restrict__ x2b, const float* __restrict__ ssq2, const int* __restrict__ ids, const float* __restrict__ gates,
                                           const unsigned char* __restrict__ U8, const unsigned char* __restrict__ V8, const float* __restrict__ usc, const float* __restrict__ vsc,
                                           const float* __restrict__ fw, float* __restrict__ out, int t, int lane) {
    const int l16 = lane * 16;
    f32x2 hx[8];
    {
        const v4u h0 = *(const v4u*)(x2b + (size_t)t * DM + l16), h1 = *(const v4u*)(x2b + (size_t)t * DM + l16 + 8);
        const unsigned hw[8] = {h0.x, h0.y, h0.z, h0.w, h1.x, h1.y, h1.z, h1.w};
#pragma unroll
        for (int i = 0; i < 8; ++i) hx[i] = (f32x2){pg8::bflo(hw[i]), pg8::bfhi(hw[i])};
    }
    const int idA = ids[(size_t)t * 128 + lane], idB = ids[(size_t)t * 128 + 64 + lane];
    const float rs = rsqrtf(pg8::ssq_sum16(ssq2 + (size_t)t * 16) * (1.f / DM) + NORM_EPS);
    const float suA = rs * usc[idA], suB = rs * usc[idB];
    const float svA = gates[(size_t)t * 128 + lane] * vsc[idA], svB = gates[(size_t)t * 128 + 64 + lane] * vsc[idB];
    f32x2 y[8];
#pragma unroll
    for (int i = 0; i < 8; ++i) y[i] = (f32x2){0.f, 0.f};
    const int bit0 = lane & 1, bit1 = (lane >> 1) & 1, bit2 = (lane >> 2) & 1;
    const int myk = 4 * bit0 + 2 * bit1 + bit2;
    for (int g = 0; g < 16; ++g) {
        const int idsel = (g < 8) ? idA : idB; const float susel = (g < 8) ? suA : suB, svsel = (g < 8) ? svA : svB; const int lb = (g * 8) & 63;
        v3u_t uw[8], vw[8];
#pragma unroll
        for (int k = 0; k < 8; ++k) { const int e = __builtin_amdgcn_readlane(idsel, lb + k); uw[k] = *(const v3u_t*)(U8 + (size_t)e * 768 + lane * 12); vw[k] = *(const v3u_t*)(V8 + (size_t)e * 768 + lane * 12); }
        float d[8];
#pragma unroll
        for (int k = 0; k < 8; ++k) {
            const v32f_t f = __builtin_amdgcn_cvt_scalef32_pk32_f32_fp6((v6u_t){uw[k][0], uw[k][1], uw[k][2], 0u, 0u, 0u}, 1.0f);
            f32x2 a = (f32x2){0.f, 0.f};
#pragma unroll
            for (int i = 0; i < 8; ++i) a += (f32x2){f[2 * i], f[2 * i + 1]} * hx[i];
            d[k] = a[0] + a[1];
            __builtin_amdgcn_sched_barrier(0);
        }
        float r4[4];
#pragma unroll
        for (int k = 0; k < 4; ++k) { const float send = bit0 ? d[k] : d[k + 4], keep = bit0 ? d[k + 4] : d[k]; r4[k] = keep + __shfl_xor(send, 1); }
        float r2[2];
#pragma unroll
        for (int k = 0; k < 2; ++k) { const float send = bit1 ? r4[k] : r4[k + 2], keep = bit1 ? r4[k + 2] : r4[k]; r2[k] = keep + __shfl_xor(send, 2); }
        float r1;
        { const float send = bit2 ? r2[0] : r2[1], keep = bit2 ? r2[1] : r2[0]; r1 = keep + __shfl_xor(send, 4); }
        r1 += __shfl_xor(r1, 8); r1 += __shfl_xor(r1, 16); r1 += __shfl_xor(r1, 32);
        const float dd = r1 * __shfl(susel, lb + myk);
        const float act = 0.5f * dd * (1.f + erff(dd * 0.70710678118654752f)) * __shfl(svsel, lb + myk);
#pragma unroll
        for (int k = 0; k < 8; ++k) {
            const float a = __uint_as_float((unsigned)__builtin_amdgcn_readlane((int)__float_as_uint(act), ((k & 1) << 2) | (k & 2) | ((k >> 2) & 1)));
            const f32x2 a2 = (f32x2){a, a};
            const v32f_t f = __builtin_amdgcn_cvt_scalef32_pk32_f32_fp6((v6u_t){vw[k][0], vw[k][1], vw[k][2], 0u, 0u, 0u}, 1.0f);
#pragma unroll
            for (int i = 0; i < 8; ++i) y[i] += (f32x2){f[2 * i], f[2 * i + 1]} * a2;
            __builtin_amdgcn_sched_barrier(0);
        }
    }
    float* orow = out + (size_t)t * DM + l16;
    float ss = 0.f;
    f32x4 o4[4];
#pragma unroll
    for (int i = 0; i < 4; ++i) { o4[i] = (f32x4){hx[2 * i][0] + y[2 * i][0], hx[2 * i][1] + y[2 * i][1], hx[2 * i + 1][0] + y[2 * i + 1][0], hx[2 * i + 1][1] + y[2 * i + 1][1]};
        ss += (o4[i][0] * o4[i][0] + o4[i][1] * o4[i][1]) + (o4[i][2] * o4[i][2] + o4[i][3] * o4[i][3]); }
    ss = wave_sum(ss);
    const float r = rsqrtf(ss * (1.f / DM) + NORM_EPS);
#pragma unroll
    for (int i = 0; i < 4; ++i) *(f32x4*)(orow + 4 * i) = o4[i] * r * *(const f32x4*)(fw + l16 + 4 * i);
}

__global__ void __launch_bounds__(NWAVES * 64, 2) mk_fwd(Args args) {
    extern __shared__ __attribute__((aligned(16))) unsigned char lds_raw[];
    LAS unsigned char* lds = (LAS unsigned char*)lds_raw;
    volatile LAS unsigned* MISC = (volatile LAS unsigned*)(lds + MISC_OFF);
    const int tid = threadIdx.x, lane = tid & 63, wave = __builtin_amdgcn_readfirstlane(tid >> 6);
    const int G = gridDim.x; const int bx = blockIdx.x; const int vcu = (G % 8 == 0) ? (bx % 8) * (G / 8) + bx / 8 : bx;
    unsigned char* ws = args.ws;
    unsigned* ctl = (unsigned*)(ws + WS_CTL);
    for (int u = tid; u < (LDS_BYTES - LDSCTL_OFF) / 4; u += NWAVES * 64) ((LAS unsigned*)(lds + LDSCTL_OFF))[u] = 0u;
    __syncthreads();
    XcdBarrier bar = xcd_barrier_post(ctl + CW_BAR + args.li * XCD_BAR_WORDS, MISC + 8);
    const int lo = args.ph_lo, hi = args.ph_hi;
#define IN(k) (lo <= (k) && (k) < hi)
#define BOTH(k) (IN(k) && IN((k) + 1))
    bf16_t* WinT = (bf16_t*)(ws + WS_WIN); bf16_t* PaT = (bf16_t*)(ws + WS_PA); bf16_t* PbT = (bf16_t*)(ws + WS_PB); bf16_t* WoT = (bf16_t*)(ws + WS_WO);
    bf16_t* WqT = (bf16_t*)(ws + WS_WQ); bf16_t* KeysB = (bf16_t*)(ws + WS_KEYS);
    float* rstd1 = (float*)(ws + WS_RSTD1); float* ssq2 = (float*)(ws + WS_RSTD2); float* scal = (float*)(ws + WS_SCAL);
    unsigned char* U8 = ws + WS_U; unsigned char* V8 = ws + WS_V; float* usc = (float*)(ws + WS_USC); float* vsc = (float*)(ws + WS_VSC);
    bf16_t* xb = (bf16_t*)(ws + WS_XB); bf16_t* ya = (bf16_t*)(ws + WS_YA); bf16_t* yb = (bf16_t*)(ws + WS_YB); bf16_t* x2b = (bf16_t*)(ws + WS_X2B);
    bf16_t* z = (bf16_t*)(ws + WS_Z); bf16_t* qb = (bf16_t*)(ws + WS_Q);
    bf16_t* merged = (bf16_t*)(ws + WS_MERGED);
    const int gw = vcu * NWAVES + wave, NGW = G * NWAVES;

    if (IN(0)) {
        LAS float* scr = (LAS float*)(lds + wave * 16384);
        constexpr int I_IN = (DM / 64) * (NZ / 32), I_PA = (512 / 64) * (DM / 32), I_WO = (DM / 64) * (DM / 32), I_WQ = (DM / 64) * (2048 / 32);
        constexpr int NITEMS = I_IN + 2 * I_PA + I_WO + I_WQ;
        for (int it = gw; it < NITEMS; it += NGW) {
            int r = it;
            if (r < I_IN) { p0_transpose_item(args.in[2], args.in[1], DM, NZ, WinT, scr, r, lane); continue; } r -= I_IN;
            if (r < I_PA) { p0_transpose_item(args.in[19], nullptr, 512, DM, PaT, scr, r, lane); continue; } r -= I_PA;
            if (r < I_PA) { p0_transpose_item(args.in[20], nullptr, 512, DM, PbT, scr, r, lane); continue; } r -= I_PA;
            if (r < I_WO) { p0_transpose_item(args.in[21], nullptr, DM, DM, WoT, scr, r, lane); continue; } r -= I_WO;
            p0_transpose_item(args.in[23], args.in[22], DM, 2048, WqT, scr, r, lane);
        }
        p0_convert(args.in[24], nullptr, KeysB, (size_t)16 * 128 * 128, gw, NGW, lane);
        for (int e = gw; e < 2 * NEXP; e += NGW) {
            const bool isu = e < NEXP; const int row = isu ? e : e - NEXP;
            p0_row_fp6((isu ? args.in[25] : args.in[26]) + (size_t)row * DM, isu ? args.in[22] : nullptr, (isu ? U8 : V8) + (size_t)row * 768, (isu ? usc : vsc) + row, lane);
        }
        for (int m = gw; m < T_TOK; m += NGW) {
            const f32x4* xr = (const f32x4*)(args.in[0] + (size_t)m * DM) + lane;
            f32x4 v[4]; float s = 0.f;
#pragma unroll
            for (int j = 0; j < 4; ++j) { v[j] = xr[64 * j]; s += (v[j][0] * v[j][0] + v[j][1] * v[j][1]) + (v[j][2] * v[j][2] + v[j][3] * v[j][3]); }
            s = wave_sum(s);
            v2u* o8 = (v2u*)(xb + (size_t)m * DM) + lane;
#pragma unroll
            for (int j = 0; j < 4; ++j) { v2u w; w.x = pg8::cvt_pk_bf16(v[j][0], v[j][1]); w.y = pg8::cvt_pk_bf16(v[j][2], v[j][3]); o8[64 * j] = w; }
            if (lane == 0) rstd1[m] = rsqrtf(s * (1.f / DM) + NORM_EPS);
        }
        if (gw == 0) {
            const float a = wave_sum(args.in[14][lane] * args.in[15][lane]), b = wave_sum(args.in[16][lane] * args.in[17][lane]);
            if (lane == 0) scal[0] = __expf(a) - __expf(b) + LAM_INIT;
        }
        if (BOTH(0)) xcd_barrier(bar);
    }
    if (IN(1)) {
        pg8::Gemm g{xb, WinT, DM, DM, DM}; pg8::StaticOrder S; S.init(T_TOK, NZ, G, bx);
        pg8::EpiRowScale<false> E{z, NZ, rstd1};
        for (int rep = 0; rep < REPS(1); ++rep) pg8::gemm_phase(lds, g, S, E);
        if (BOTH(1)) xcd_barrier(bar);
    }
    if (IN(2)) {
        {
            const rw::ScanP P{args.in[3], args.in[4], args.in[5], args.in[6], args.in[7], args.in[8], args.in[9], args.in[10], args.in[11], args.in[12], args.in[13]};
            for (int rep = 0; rep < REPS(2); ++rep) for (int u = vcu; u < NB * 8; u += G) rw::scan_unit(lds, z, ya, P, u >> 3, u & 7, tid, wave, lane);
        }
        const float lam = scal[0];
        __syncthreads();
        for (int i = 0;; ++i) {
            int idx = vcu + i * G; if (idx >= 2048 * REPS(10)) break;
            idx &= 2047;
            const int slot = idx >> 8, v = idx & 255, bh = v >> 1, a = (v & 1) * 4 + (slot >> 1), qblk = (slot & 1) ? 15 - a : a;
            da::attn_unit(lds, z, yb, args.in[18], lam, bh >> 2, bh & 3, qblk, wave, lane);
        }
        if (BOTH(2)) xcd_barrier(bar);
    }
    if (IN(3)) {
        pg8::Gemm g{ya, PaT, 512, 512, 512}; pg8::StaticOrder S; S.init(T_TOK, DM, G, bx);
        pg8::EpiGate<false> E{merged, z, C_GA};
        pg8::gemm_phase(lds, g, S, E);
        if (BOTH(3)) xcd_barrier(bar);
    }
    if (IN(4)) {
        pg8::Gemm g{yb, PbT, 512, 512, 512}; pg8::StaticOrder S; S.init(T_TOK, DM, G, bx);
        pg8::EpiGate<true> E{merged, z, C_GB};
        pg8::gemm_phase(lds, g, S, E);
        if (BOTH(4)) xcd_barrier(bar);
    }
    if (IN(5)) {
        pg8::Gemm g{merged, WoT, DM, DM, DM}; pg8::StaticOrder S; S.init(T_TOK, DM, G, bx);
        pg8::EpiX2 E{args.in[0], args.out, x2b, ssq2};
        pg8::gemm_phase(lds, g, S, E);
        if (BOTH(5)) xcd_barrier(bar);
    }
    if (IN(6)) {
        pg8::Gemm g{x2b, WqT, DM, DM, DM}; pg8::StaticOrder S; S.init(T_TOK, 2048, G, bx);
        pg8::EpiRowScale<true> E{qb, 2048, ssq2};
        for (int rep = 0; rep < REPS(6); ++rep) pg8::gemm_phase(lds, g, S, E);
        if (BOTH(6)) xcd_barrier(bar);
    }
    if (IN(7)) {
        int* ids = (int*)(ws + WS_IDS); float* gates = (float*)(ws + WS_GATES);
        for (int rep = 0; rep < REPS(7); ++rep)
        for (int h = 0; h < 8; ++h) {
            __syncthreads();
            {
                const bf16_t* ksrc = KeysB + (size_t)h * 2 * 128 * 128;
#pragma unroll
                for (int i = 0; i < 8; ++i) { const int chunk = tid + i * 512, row = chunk >> 4, cc = chunk & 15;
                    *(LAS v4u*)(lds + (row >> 7) * TK_HALF + (row & 127) * TK_PITCH + cc * 16) = *(const v4u*)(ksrc + (size_t)row * 128 + cc * 8); }
            }
            __syncthreads();
            for (int tile = gw; tile < 4096; tile += NGW) {
                tk_bf16x8 qa[8];
                topk_loadq(qa, qb, tile * 16, h, lane);
                topk_item(qa, lds, ids, gates, tile * 16, h, lane);
            }
        }
        if (BOTH(7)) xcd_barrier(bar);
    }
    if (IN(8)) {
        const int* ids = (const int*)(ws + WS_IDS); const float* gates = (const float*)(ws + WS_GATES);
        for (int t = gw; t < T_TOK; t += NGW) peer_token(x2b, ssq2, ids, gates, U8, V8, usc, vsc, args.in[27], args.out, t, lane);
    }
#undef IN
#undef BOTH
}

extern "C" void kernel_launch(void* const* d_in, const int* in_sizes, int n_in, void* d_out, int out_size, void* d_ws, size_t ws_size, hipStream_t stream) {
    static int grid = 0;
    if (grid == 0) {
        if (n_in != 28 || in_sizes[0] != T_TOK * DM || out_size != T_TOK * DM || ws_size < WS_END) {
            fprintf(stderr, "kernel_launch: unexpected shapes / workspace (n_in %d, ws %zu < %zu)\n", n_in, ws_size, (size_t)WS_END); grid = -1; return; }
        int dev = 0, cus = 0;
        if (hipGetDevice(&dev) != hipSuccess || hipDeviceGetAttribute(&cus, hipDeviceAttributeMultiprocessorCount, dev) != hipSuccess) { grid = -1; return; }
        if (hipFuncSetAttribute((const void*)mk_fwd, hipFuncAttributeMaxDynamicSharedMemorySize, LDS_BYTES) != hipSuccess) { fprintf(stderr, "kernel_launch: hipFuncSetAttribute failed\n"); grid = -1; return; }
        grid = cus;
    }
    if (grid < 0) return;
    unsigned char* ws = (unsigned char*)d_ws;
    float* out = (float*)d_out;
    (void)hipMemsetAsync(ws + WS_CTL, 0, 1 * MiB, stream);
    Args a{};
    for (int i = 0; i < 28; ++i) a.in[i] = (const float*)d_in[i];
    a.out = out; a.ws = ws;
    a.ph_lo = 0; a.ph_hi = 9; a.li = 0;
    hipLaunchKernelGGL(mk_fwd, dim3(grid), dim3(NWAVES * 64), LDS_BYTES, stream, a);
}
```

```cpp
#include <hip/hip_runtime.h>
#include <stdint.h>
#include <cstdio>

typedef unsigned short bf16_t;
typedef unsigned int u32;

#ifndef PROBE_REP
#define PROBE_REP 0
#endif
#define REPS(k) (((PROBE_REP >> (k)) & 1) ? 2 : 1)
constexpr int T_TOK = 65536, DM = 1024, SEQ = 2048, NB = 32;
constexpr int NZ = 5376;
constexpr int C_R = 0, C_K = 512, C_V = 1024, C_WL = 1536, C_AL = 1600, C_GL = 1664, C_Q = 1792, C_ZK = 2304, C_ZV = 2816, C_GA = 3328, C_GB = 4352;
constexpr int NEXP = 16384;
constexpr float NORM_EPS = 1e-6f, GN_EPS = 64e-5f, SUBLN_EPS = 1e-5f;
constexpr float LAM_INIT = 0.2f;

constexpr size_t MiB = 1u << 20;
constexpr size_t WS_CTL = 0;
constexpr size_t WS_WIN = 1 * MiB;
constexpr size_t WS_PA = 12 * MiB;
constexpr size_t WS_PB = 13 * MiB;
constexpr size_t WS_WO = 14 * MiB;
constexpr size_t WS_WQ = 16 * MiB;
constexpr size_t WS_KEYS = 20 * MiB;
constexpr size_t WS_RSTD1 = 21 * MiB;
constexpr size_t WS_RSTD2 = 58 * MiB;
constexpr size_t WS_SCAL = 23 * MiB;
constexpr size_t WS_U = 24 * MiB;
constexpr size_t WS_V = 40 * MiB;
constexpr size_t WS_USC = 56 * MiB;
constexpr size_t WS_VSC = 57 * MiB;
constexpr size_t WS_XB = 88 * MiB;
constexpr size_t WS_YA = WS_XB;
constexpr size_t WS_YB = WS_XB + 64 * MiB;
constexpr size_t WS_X2B = WS_XB;
constexpr size_t WS_Z = 216 * MiB;
constexpr size_t WS_Q = WS_Z;
constexpr size_t WS_IDS = WS_Z + 256 * MiB;
constexpr size_t WS_GATES = WS_Z + 288 * MiB;
constexpr size_t WS_MERGED = 888 * MiB;
constexpr size_t WS_END = 1016 * MiB;

__device__ __forceinline__ float bf2f(bf16_t h) { return __uint_as_float(((u32)h) << 16); }
__device__ __forceinline__ bf16_t f2bf(float f) { u32 u = __float_as_uint(f); u += 0x7fffu + ((u >> 16) & 1u); return (bf16_t)(u >> 16); }
__device__ __forceinline__ float wave_sum(float v) {
#pragma unroll
    for (int o = 1; o < 64; o <<= 1) v += __shfl_xor(v, o);
    return v;
}
__device__ __forceinline__ float sigmoidf_(float x) { return 1.f / (1.f + __expf(-x)); }

namespace pg8 {
#define PG8_LAS __attribute__((address_space(3)))
typedef short bf16x8 __attribute__((ext_vector_type(8)));
typedef float f32x4 __attribute__((ext_vector_type(4)));
typedef unsigned u32x4 __attribute__((ext_vector_type(4)));
constexpr int BM = 256, BK = 64, HALF = 128, HTB = HALF * BK * 2  , STAGE_BYTES = 8 * HTB, NXCD = 8, WGM = 8;

__host__ __device__ __forceinline__ int lds_byte(int r, int c) { const int st = (r >> 4) * 2 + (c >> 5), rr = r & 15, cc = c & 31, ob = rr * 64 + cc * 2; return st * 1024 + (ob ^ (((ob >> 9) & 1) << 5)); }
__host__ __device__ __forceinline__ void stage_rc(int b, int& R, int& C) { const int st = b / 1024, sb = b % 1024, swz = sb ^ (((sb >> 9) & 1) << 5); R = (st >> 1) * 16 + swz / 64; C = (st & 1) * 32 + (swz % 64) / 2; }
__host__ __device__ __forceinline__ int perm32(int rho) { const int n = rho >> 4, i = rho & 15; return 8 * (i >> 2) + 4 * n + (i & 3); }

struct Unit { int pm, pn; };
struct Gemm { const bf16_t* A; const bf16_t* Bt; int lda, ldb, K; };

struct StaticOrder {
    int nM, nN, nwg, G, c;
    __host__ __device__ void init(int M, int N, int G_, int c_) { nM = M / BM; nN = N / BM; nwg = nM * nN; G = G_; c = c_; }
    __host__ __device__ bool next(int i, Unit& u) const {
        const long L = (long)i * G + c; if (L >= nwg) return false;
        int wgid = (int)L; { const int q = nwg / NXCD, r = nwg % NXCD, xcd = wgid % NXCD, off = wgid / NXCD; wgid = (xcd < r ? xcd * (q + 1) : r * (q + 1) + (xcd - r) * q) + off; }
        const int nig = WGM * nN, gid = wgid / nig, fm = gid * WGM, gsz = (nM - fm) < WGM ? (nM - fm) : WGM;
        u.pm = fm + ((wgid % nig) % gsz); u.pn = (wgid % nig) / gsz; return true;
    }
};
typedef float f32x2_c __attribute__((ext_vector_type(2))); typedef __bf16 bf16x2_c __attribute__((ext_vector_type(2)));
__device__ __forceinline__ unsigned cvt_pk_bf16(float lo, float hi) { const f32x2_c v = {lo, hi}; const bf16x2_c b = __builtin_convertvector(v, bf16x2_c); return __builtin_bit_cast(unsigned, b); }
__device__ __forceinline__ float bflo(unsigned w) { return __uint_as_float(w << 16); }
__device__ __forceinline__ float bfhi(unsigned w) { return __uint_as_float(w & 0xffff0000u); }

__device__ __forceinline__ float ssq_sum16(const float* p) {
    const f32x4 a = *(const f32x4*)p, b = *(const f32x4*)(p + 4), c = *(const f32x4*)(p + 8), d = *(const f32x4*)(p + 12);
    return (((a[0] + a[1]) + (a[2] + a[3])) + ((b[0] + b[1]) + (b[2] + b[3]))) + (((c[0] + c[1]) + (c[2] + c[3])) + ((d[0] + d[1]) + (d[2] + d[3])));
}
template <bool SSQ> struct EpiRowScale {
    static constexpr bool PERM = true;
    bf16_t* O; int ldc; const float* rs;
    __device__ __forceinline__ void operator()(const f32x4 (&acc)[2][2][4][2], const Unit& u, int wr, int wc, int fr, int fq) const {
        const int row0 = u.pm * BM + wr * 64 + fr, col0 = u.pn * BM + wc * 32 + 8 * fq;
#pragma unroll
        for (int ai = 0; ai < 2; ++ai)
#pragma unroll
            for (int m = 0; m < 4; ++m) {
                const int row = row0 + ai * HALF + m * 16;
                float s; if (SSQ) s = rsqrtf(ssq_sum16(rs + (size_t)row * 16) * (1.f / 1024.f) + NORM_EPS); else s = rs[row];
                bf16_t* rowp = O + (size_t)row * ldc + col0;
#pragma unroll
                for (int bj = 0; bj < 2; ++bj) {
                    const f32x4 v0 = acc[ai][bj][m][0] * s, v1 = acc[ai][bj][m][1] * s;
                    u32x4 w; w.x = cvt_pk_bf16(v0[0], v0[1]); w.y = cvt_pk_bf16(v0[2], v0[3]); w.z = cvt_pk_bf16(v1[0], v1[1]); w.w = cvt_pk_bf16(v1[2], v1[3]);
                    *(u32x4*)(rowp + bj * HALF) = w;
                }
            }
    }
};
template <bool ACCUM> struct EpiGate {
    static constexpr bool PERM = true;
    bf16_t* mg; const bf16_t* z; int gcol;
    __device__ __forceinline__ void operator()(const f32x4 (&acc)[2][2][4][2], const Unit& u, int wr, int wc, int fr, int fq) const {
        const int row0 = u.pm * BM + wr * 64 + fr, col0 = u.pn * BM + wc * 32 + 8 * fq;
#pragma unroll
        for (int ai = 0; ai < 2; ++ai)
#pragma unroll
            for (int m = 0; m < 4; ++m) {
                const int row = row0 + ai * HALF + m * 16;
                const bf16_t* gp = z + (size_t)row * NZ + gcol + col0;
                bf16_t* rowp = mg + (size_t)row * DM + col0;
#pragma unroll
                for (int bj = 0; bj < 2; ++bj) {
                    const u32x4 g = *(const u32x4*)(gp + bj * HALF);
                    const f32x4 a0 = acc[ai][bj][m][0], a1 = acc[ai][bj][m][1];
                    float r[8];
                    r[0] = sigmoidf_(bflo(g.x)) * a0[0]; r[1] = sigmoidf_(bfhi(g.x)) * a0[1]; r[2] = sigmoidf_(bflo(g.y)) * a0[2]; r[3] = sigmoidf_(bfhi(g.y)) * a0[3];
                    r[4] = sigmoidf_(bflo(g.z)) * a1[0]; r[5] = sigmoidf_(bfhi(g.z)) * a1[1]; r[6] = sigmoidf_(bflo(g.w)) * a1[2]; r[7] = sigmoidf_(bfhi(g.w)) * a1[3];
                    if (ACCUM) { const u32x4 o = *(const u32x4*)(rowp + bj * HALF);
                        r[0] += bflo(o.x); r[1] += bfhi(o.x); r[2] += bflo(o.y); r[3] += bfhi(o.y); r[4] += bflo(o.z); r[5] += bfhi(o.z); r[6] += bflo(o.w); r[7] += bfhi(o.w); }
                    u32x4 w; w.x = cvt_pk_bf16(r[0], r[1]); w.y = cvt_pk_bf16(r[2], r[3]); w.z = cvt_pk_bf16(r[4], r[5]); w.w = cvt_pk_bf16(r[6], r[7]);
                    *(u32x4*)(rowp + bj * HALF) = w;
                }
            }
    }
};
struct EpiX2 {
    static constexpr bool PERM = true;
    const float* x; float* x2; bf16_t* x2b; float* ssq;
    __device__ __forceinline__ void operator()(const f32x4 (&acc)[2][2][4][2], const Unit& u, int wr, int wc, int fr, int fq) const {
        const int row0 = u.pm * BM + wr * 64 + fr, col0 = u.pn * BM + wc * 32 + 8 * fq;
#pragma unroll
        for (int ai = 0; ai < 2; ++ai)
#pragma unroll
            for (int m = 0; m < 4; ++m) {
                const int row = row0 + ai * HALF + m * 16;
                const size_t off = (size_t)row * DM + col0;
                float ss = 0.f;
#pragma unroll
                for (int bj = 0; bj < 2; ++bj) {
                    const f32x4 x0 = *(const f32x4*)(x + off + bj * HALF), x1 = *(const f32x4*)(x + off + bj * HALF + 4);
                    const f32x4 o0 = x0 + acc[ai][bj][m][0], o1 = x1 + acc[ai][bj][m][1];
                    u32x4 w; w.x = cvt_pk_bf16(o0[0], o0[1]); w.y = cvt_pk_bf16(o0[2], o0[3]); w.z = cvt_pk_bf16(o1[0], o1[1]); w.w = cvt_pk_bf16(o1[2], o1[3]);
                    *(u32x4*)(x2b + off + bj * HALF) = w;
                    ss += (o0[0] * o0[0] + o0[1] * o0[1]) + (o0[2] * o0[2] + o0[3] * o0[3]) + (o1[0] * o1[0] + o1[1] * o1[1]) + (o1[2] * o1[2] + o1[3] * o1[3]);
                }
                ss += __shfl_xor(ss, 16); ss += __shfl_xor(ss, 32);
                if (fq == 0) ssq[(size_t)row * 16 + (u.pn & 3) * 4 + wc] = ss;
            }
    }
};

template <class Epi, class Sched>
__device__ __forceinline__ void gemm_phase(PG8_LAS unsigned char* lds, const Gemm g, const Sched& S, const Epi& E) {
    const int tid = threadIdx.x, wid = __builtin_amdgcn_readfirstlane(tid >> 6), lane = tid & 63, wr = wid >> 2, wc = wid & 3, fr = lane & 15, fq = lane >> 4;
    const int K = g.K, nt = K / BK;
    unsigned voffA[2], voffB[2];
#pragma unroll
    for (int i = 0; i < 2; ++i) { int R, C; stage_rc(tid * 16 + i * 8192, R, C); const int Rb = Epi::PERM ? ((R & ~31) + perm32(R & 31)) : R;
        voffA[i] = (unsigned)(R * g.lda + C) * 2u; voffB[i] = (unsigned)(Rb * g.ldb + C) * 2u; }
    const size_t kstep = (size_t)(BK * 2);
    const size_t hstepA = (size_t)HALF * g.lda * 2, hstepB = (size_t)HALF * g.ldb * 2;
    const size_t tstepA = 2 * hstepA, tstepB = 2 * hstepB;
    const unsigned ldsw = (unsigned)wid * 1024u;
    const int aoff = lds_byte(wr * 64 + fr, fq * 8), boff = lds_byte(wc * 32 + fr, fq * 8);
#define PG8_SA(b, h) (((b) * 2 + (h)) * HTB)
#define PG8_SB(b, h) ((4 + (b) * 2 + (h)) * HTB)
#define PG8_STAGE(bufoff, gbase, voff) do { _Pragma("unroll") for (int _i = 0; _i < 2; ++_i) \
        __builtin_amdgcn_global_load_lds((const unsigned*)((const char*)(gbase) + (voff)[_i]), (PG8_LAS unsigned*)(lds + (bufoff) + ldsw + _i * 8192), 16, 0, 0); } while (0)
#define PG8_LDA(dst, b, h) do { _Pragma("unroll") for (int m = 0; m < 4; ++m) _Pragma("unroll") for (int k = 0; k < 2; ++k) dst[m][k] = *(const PG8_LAS bf16x8*)(lds + PG8_SA(b, h) + aoff + m * 2048 + k * 1024); } while (0)
#define PG8_LDB(dst, b, h) do { _Pragma("unroll") for (int n = 0; n < 2; ++n) _Pragma("unroll") for (int k = 0; k < 2; ++k) dst[n][k] = *(const PG8_LAS bf16x8*)(lds + PG8_SB(b, h) + boff + n * 2048 + k * 1024); } while (0)
#define PG8_MMA(ai, bj, At, Bt) do { __builtin_amdgcn_s_setprio(1); _Pragma("unroll") for (int m = 0; m < 4; ++m) _Pragma("unroll") for (int n = 0; n < 2; ++n) _Pragma("unroll") for (int k = 0; k < 2; ++k) \
        acc[ai][bj][m][n] = __builtin_amdgcn_mfma_f32_16x16x32_bf16(Bt[n][k], At[m][k], acc[ai][bj][m][n], 0, 0, 0); __builtin_amdgcn_s_setprio(0); } while (0)
#define PG8_WAIT_V(n) asm volatile("s_waitcnt vmcnt(" #n ")" ::: "memory")
#define PG8_WAIT_L(n) asm volatile("s_waitcnt lgkmcnt(" #n ")" ::: "memory")
#define PG8_BAR __builtin_amdgcn_s_barrier()
#define PG8_SCHED __builtin_amdgcn_sched_barrier(0)
    Unit cur, nxt; int ui = 0;
    if (!S.next(0, cur)) return;
    f32x4 acc[2][2][4][2];
#pragma unroll
    for (int a = 0; a < 2; ++a)
#pragma unroll
        for (int b = 0; b < 2; ++b)
#pragma unroll
            for (int m = 0; m < 4; ++m)
#pragma unroll
                for (int n = 0; n < 2; ++n) acc[a][b][m][n] = (f32x4){0.f, 0.f, 0.f, 0.f};
    bf16x8 At[4][2], B0[2][2], B1[2][2];
    const char* cA = (const char*)g.A + (size_t)cur.pm * tstepA; const char* cB = (const char*)g.Bt + (size_t)cur.pn * tstepB;
    PG8_STAGE(PG8_SB(0, 0), cB, voffB); PG8_STAGE(PG8_SB(0, 1), cB + hstepB, voffB); PG8_STAGE(PG8_SA(0, 0), cA, voffA); PG8_STAGE(PG8_SA(0, 1), cA + hstepA, voffA);
    if (wr == 1) PG8_BAR;
    PG8_WAIT_V(2); PG8_BAR;
    PG8_STAGE(PG8_SB(1, 0), cB + kstep, voffB); PG8_STAGE(PG8_SA(1, 0), cA + kstep, voffA); PG8_STAGE(PG8_SB(1, 1), cB + hstepB + kstep, voffB);
    PG8_WAIT_V(6); PG8_BAR;
    for (;;) {
        const bool has_next = S.next(ui + 1, nxt);
        const char* nA = has_next ? (const char*)g.A + (size_t)nxt.pm * tstepA : cA; const char* nB = has_next ? (const char*)g.Bt + (size_t)nxt.pn * tstepB : cB;
        for (int t = 0; t < nt; t += 2) {
            const bool last = (t == nt - 2);
            const char* a1 = cA + (size_t)(t + 1) * kstep;
            const char* a2 = last ? nA : cA + (size_t)(t + 2) * kstep; const char* b2 = last ? nB : cB + (size_t)(t + 2) * kstep;
            const char* a3 = a2 + kstep; const char* b3 = b2 + kstep;
            PG8_LDB(B0, 0, 0); PG8_LDB(B1, 0, 1); PG8_SCHED; PG8_LDA(At, 0, 0); PG8_STAGE(PG8_SA(1, 1), a1 + hstepA, voffA);
            PG8_WAIT_V(8); PG8_WAIT_L(0); PG8_BAR; PG8_MMA(0, 0, At, B0); PG8_MMA(0, 1, At, B1); PG8_BAR; PG8_SCHED;
            PG8_LDA(At, 0, 1); PG8_STAGE(PG8_SB(0, 0), b2, voffB); PG8_STAGE(PG8_SB(0, 1), b2 + hstepB, voffB); PG8_STAGE(PG8_SA(0, 0), a2, voffA);
            PG8_WAIT_V(8); PG8_WAIT_L(0); PG8_BAR; PG8_MMA(1, 0, At, B0); PG8_MMA(1, 1, At, B1); PG8_BAR; PG8_SCHED;
            PG8_LDB(B0, 1, 0); PG8_LDB(B1, 1, 1); PG8_SCHED; PG8_LDA(At, 1, 0); PG8_STAGE(PG8_SA(0, 1), a2 + hstepA, voffA);
            PG8_WAIT_V(8); PG8_WAIT_L(0); PG8_BAR; PG8_MMA(0, 0, At, B0); PG8_MMA(0, 1, At, B1); PG8_BAR; PG8_SCHED;
            PG8_LDA(At, 1, 1); PG8_STAGE(PG8_SB(1, 0), b3, voffB); PG8_STAGE(PG8_SB(1, 1), b3 + hstepB, voffB); PG8_STAGE(PG8_SA(1, 0), a3, voffA);
            PG8_WAIT_V(8); PG8_WAIT_L(0); PG8_BAR; PG8_MMA(1, 0, At, B0); PG8_MMA(1, 1, At, B1); PG8_BAR; PG8_SCHED;
        }
        if (wr == 0) PG8_BAR;
        E(acc, cur, wr, wc, fr, fq);
        if (!has_next) break;
#pragma unroll
        for (int a = 0; a < 2; ++a)
#pragma unroll
            for (int b = 0; b < 2; ++b)
#pragma unroll
                for (int m = 0; m < 4; ++m)
#pragma unroll
                    for (int n = 0; n < 2; ++n) acc[a][b][m][n] = (f32x4){0.f, 0.f, 0.f, 0.f};
        cur = nxt; cA = nA; cB = nB; ++ui;
        if (wr == 1) PG8_BAR;
    }
    PG8_WAIT_V(0);
    PG8_BAR;
#undef PG8_SA
#undef PG8_SB
#undef PG8_STAGE
#undef PG8_LDA
#undef PG8_LDB
#undef PG8_MMA
#undef PG8_WAIT_V
#undef PG8_WAIT_L
#undef PG8_BAR
#undef PG8_SCHED
}
}

constexpr int NWAVES = 8;
constexpr int LDS_RING_BYTES = 131072, LDSCTL_OFF = 143360, MISC_OFF = LDSCTL_OFF + 320, LDS_BYTES = 147456;
#define LAS __attribute__((address_space(3)))
#define GAS __attribute__((address_space(1)))
typedef float f32x4 __attribute__((ext_vector_type(4)));
typedef unsigned v4u __attribute__((ext_vector_type(4)));
typedef unsigned v2u __attribute__((ext_vector_type(2)));
#define LDS_WAIT() asm volatile("s_waitcnt lgkmcnt(0)" ::: "memory")

constexpr int CW_BAR = 4096;
#define XB_TMO      128
#define XB_XCNT(j)  (256  + 64 * (j))
#define XB_XSUB(j)  (1280 + 64 * (j))
#define XB_XGEN(j)  (2304 + 64 * (j))
#define XB_TOP      3328
#define XB_TOPGEN   3392
#define XCD_BAR_WORDS 3456
#define XB_SPIN_CAP (1u << 20)
__device__ __forceinline__ unsigned xb_ld(unsigned* p)              { return __hip_atomic_load(p, __ATOMIC_RELAXED, __HIP_MEMORY_SCOPE_AGENT); }
__device__ __forceinline__ unsigned xb_add(unsigned* p, unsigned v) { return __hip_atomic_fetch_add(p, v, __ATOMIC_RELAXED, __HIP_MEMORY_SCOPE_AGENT); }
__device__ __forceinline__ unsigned xb_xcc_id() { return (unsigned)__builtin_amdgcn_s_getreg((3 << 11) | 20) & 0xFu; }
#define XB_SPIN(cond, bar) do { unsigned _sp = 0; while (cond) { __builtin_amdgcn_s_sleep(1); \
    if ((++_sp & 255u) == 0u) { if (xb_ld(&(bar)[XB_TMO])) break; if (_sp > XB_SPIN_CAP) { atomicAdd(&(bar)[XB_TMO], 1u); break; } } } } while (0)
struct XcdBarrier { unsigned* bar; unsigned x; volatile LAS unsigned* st; };
__device__ __forceinline__ XcdBarrier xcd_barrier_post(unsigned* bar, volatile LAS unsigned* st) {
    XcdBarrier b; b.bar = bar; b.x = xb_xcc_id(); b.st = st;
    if (threadIdx.x == 0) (void)xb_add(&bar[XB_XCNT(b.x)], 1u);
    return b;
}
__device__ __forceinline__ void xcd_barrier_complete(unsigned* bar, unsigned x, unsigned& nloc, unsigned& nx) {
    const unsigned G = gridDim.x * gridDim.y * gridDim.z;
    unsigned sum, cnt, mine, sp = 0u;
    for (;;) {
        sum = 0u; cnt = 0u; mine = 0u;
#pragma unroll
        for (unsigned j = 0; j < 16; ++j) { const unsigned c = xb_ld(&bar[XB_XCNT(j)]); sum += c; cnt += (c > 0u) ? 1u : 0u; mine = (j == x) ? c : mine; }
        if (sum == G) break;
        __builtin_amdgcn_s_sleep(1);
        if ((++sp & 255u) == 0u) { if (xb_ld(&bar[XB_TMO])) break; if (sp > XB_SPIN_CAP) { atomicAdd(&bar[XB_TMO], 1u); break; } }
    }
    nloc = mine > 0u ? mine : 1u; nx = cnt > 0u ? cnt : 1u;
}
__device__ __forceinline__ void xcd_barrier(const XcdBarrier& b) {
    asm volatile("s_waitcnt vmcnt(0)" ::: "memory");
    __syncthreads();
    if (threadIdx.x == 0) {
        unsigned* bar = b.bar;
        __builtin_amdgcn_s_waitcnt(0);
        unsigned nloc = b.st[0], nx = b.st[1];
        if (nloc == 0u) { xcd_barrier_complete(bar, b.x, nloc, nx); b.st[0] = nloc; b.st[1] = nx; }
        const unsigned old = xb_add(&bar[XB_XSUB(b.x)], 1u);
        const unsigned gen = old / nloc;
        if (old + 1u == (gen + 1u) * nloc) {
            __builtin_amdgcn_fence(__ATOMIC_RELEASE, "agent");
            asm volatile("s_waitcnt vmcnt(0)" ::: "memory");
            const unsigned og = xb_add(&bar[XB_TOP], 1u);
            const unsigned tg = og / nx;
            if (og + 1u == (tg + 1u) * nx) xb_add(&bar[XB_TOPGEN], 1u);
            else XB_SPIN(xb_ld(&bar[XB_TOPGEN]) == tg, bar);
            __builtin_amdgcn_fence(__ATOMIC_ACQUIRE, "agent");
            xb_add(&bar[XB_XGEN(b.x)], 1u);
            asm volatile("s_waitcnt vmcnt(0)" ::: "memory");
        } else {
            XB_SPIN(xb_ld(&bar[XB_XGEN(b.x)]) == gen, bar);
            __builtin_amdgcn_fence(__ATOMIC_ACQUIRE, "agent");
            asm volatile("s_waitcnt vmcnt(0)" ::: "memory");
        }
    }
    __syncthreads();
}

struct Args { const float* in[28]; float* out; unsigned char* ws; int ph_lo, ph_hi, li, pad; };

__device__ __forceinline__ void p0_transpose_item(const float* W, const float* sc, int K, int N, bf16_t* WT, LAS float* scr, int item, int lane) {
    const int nblk = N / 32, kb = item / nblk, nb = item % nblk, k0 = 64 * kb, n0 = 32 * nb;
#pragma unroll 8
    for (int i = 0; i < 32; ++i) { const int kk = 2 * i + (lane >> 5); const float s = sc ? sc[k0 + kk] : 1.f; scr[kk * 33 + (lane & 31)] = W[(size_t)(k0 + kk) * N + n0 + (lane & 31)] * s; }
    LDS_WAIT(); asm volatile("" ::: "memory");
    const int c = lane & 7;
#pragma unroll
    for (int j = 0; j < 4; ++j) { const int n = (lane >> 3) + 8 * j; const LAS float* s = scr + (8 * c) * 33 + n;
        v4u o; o.x = pg8::cvt_pk_bf16(s[0 * 33], s[1 * 33]); o.y = pg8::cvt_pk_bf16(s[2 * 33], s[3 * 33]); o.z = pg8::cvt_pk_bf16(s[4 * 33], s[5 * 33]); o.w = pg8::cvt_pk_bf16(s[6 * 33], s[7 * 33]);
        *(v4u*)(WT + (size_t)(n0 + n) * K + k0 + 8 * c) = o; }
    LDS_WAIT(); asm volatile("" ::: "memory");
}
typedef unsigned v6u_t __attribute__((ext_vector_type(6)));
typedef unsigned v3u_t __attribute__((ext_vector_type(3)));
typedef float v16f_t __attribute__((ext_vector_type(16)));
typedef float v32f_t __attribute__((ext_vector_type(32)));
__device__ __forceinline__ void p0_row_fp6(const float* in, const float* cs, unsigned char* out, float* sc, int lane) {
    f32x4 v[4]; float mx = 0.f;
#pragma unroll
    for (int i = 0; i < 4; ++i) { v[i] = *(const f32x4*)(in + lane * 16 + 4 * i); if (cs) v[i] = v[i] * *(const f32x4*)(cs + lane * 16 + 4 * i);
        mx = fmaxf(mx, fmaxf(fmaxf(fabsf(v[i][0]), fabsf(v[i][1])), fmaxf(fabsf(v[i][2]), fabsf(v[i][3])))); }
#pragma unroll
    for (int o = 1; o < 64; o <<= 1) mx = fmaxf(mx, __shfl_xor(mx, o));
    mx = fmaxf(mx, 1e-30f);
    const float q = 7.5f / mx;
    v16f_t a, b;
#pragma unroll
    for (int i = 0; i < 16; ++i) { a[i] = 0.f; b[i] = 0.f; }
#pragma unroll
    for (int i = 0; i < 8; ++i) { a[i] = v[(2 * i) >> 2][(2 * i) & 3] * q; b[i] = v[(2 * i + 1) >> 2][(2 * i + 1) & 3] * q; }
    const v6u_t p = __builtin_amdgcn_cvt_scalef32_2xpk16_fp6_f32(a, b, 1.0f);
    *(v3u_t*)(out + lane * 12) = (v3u_t){p[0], p[1], p[2]};
    if (lane == 0) *sc = mx * (1.f / 7.5f);
}
__device__ __forceinline__ void p0_convert(const float* in, const float* cs, bf16_t* out, size_t n, int gw, int NGW, int lane) {
    for (size_t i = ((size_t)gw * 64 + lane) * 8; i < n; i += (size_t)NGW * 512) {
        f32x4 a = *(const f32x4*)(in + i), b = *(const f32x4*)(in + i + 4);
        if (cs) { const int c = (int)(i & 1023); a = a * *(const f32x4*)(cs + c); b = b * *(const f32x4*)(cs + c + 4); }
        v4u o; o.x = pg8::cvt_pk_bf16(a[0], a[1]); o.y = pg8::cvt_pk_bf16(a[2], a[3]); o.z = pg8::cvt_pk_bf16(b[0], b[1]); o.w = pg8::cvt_pk_bf16(b[2], b[3]);
        *(v4u*)(out + i) = o;
    }
}

namespace da {
typedef short bf16x8 __attribute__((ext_vector_type(8)));
typedef short s16x4 __attribute__((ext_vector_type(4)));
typedef float f32x16 __attribute__((ext_vector_type(16)));
typedef const LAS unsigned char* lcp;
constexpr float LOG2E = 1.4426950408889634f, C2 = 0.125f * LOG2E, THR = 8.f;
constexpr int RSLOT = 16384, LDS_KR = 0, LDS_VR = 4 * RSLOT, SCR_OFF = 8 * RSLOT, COMB_OFF = 0;
#define DA_SBAR() __builtin_amdgcn_sched_barrier(0)
#define DA_PIN(x) asm volatile("" : "+v"(x))
#define DA_MFMA(a, b, c) __builtin_amdgcn_mfma_f32_32x32x16_bf16(a, b, c, 0, 0, 0)
#define DA_WAIT_BAR(N) asm volatile("s_waitcnt vmcnt(" #N ") lgkmcnt(0)\n\ts_barrier" ::: "memory")
#define DA_MX3(a, b, c) __builtin_fmaxf(__builtin_fmaxf((a), (b)), (c))
__device__ __forceinline__ int crow(int r, int hi) { return (r & 3) + 8 * (r >> 2) + 4 * hi; }
__device__ __forceinline__ s16x4 vtr(lcp p) { return __builtin_bit_cast(s16x4, __builtin_amdgcn_ds_read_tr16_b64_v4i16((LAS s16x4*)p)); }
__device__ __forceinline__ unsigned cvtpk(float lo, float hi) { unsigned r; asm("v_cvt_pk_bf16_f32 %0, %1, %2" : "=v"(r) : "v"(lo), "v"(hi)); return r; }
__device__ __forceinline__ void glds16(const void* g, unsigned lds_base) {
    unsigned sv; asm volatile("s_mov_b32 %0, m0\n\ts_mov_b32 m0, %2\n\ts_nop 0\n\tglobal_load_lds_dwordx4 %1, off\n\ts_mov_b32 m0, %0" : "=&s"(sv) : "v"(g), "s"(lds_base) : "memory"); }
__device__ __forceinline__ void glds16_o128(const void* g, unsigned lds_base) {
    unsigned sv; asm volatile("s_mov_b32 %0, m0\n\ts_mov_b32 m0, %2\n\ts_nop 0\n\tglobal_load_lds_dwordx4 %1, off offset:128\n\ts_mov_b32 m0, %0" : "=&s"(sv) : "v"(g), "s"(lds_base) : "memory"); }
__device__ __forceinline__ void kload2(bf16x8* kf, lcp kp, int d0) { kf[2 * d0] = *(const LAS bf16x8*)(kp + d0 * 2048); kf[2 * d0 + 1] = *(const LAS bf16x8*)(kp + d0 * 2048 + 512); }
__device__ __forceinline__ float max16(const f32x16& p) {
    float a = DA_MX3(p[0], p[1], p[2]), b = DA_MX3(p[3], p[4], p[5]); a = DA_MX3(a, p[6], p[7]); b = DA_MX3(b, p[8], p[9]); a = DA_MX3(a, p[10], p[11]); b = DA_MX3(b, p[12], p[13]);
    a = DA_MX3(a, p[14], p[15]); return __builtin_fmaxf(a, b); }
__device__ __forceinline__ float rowmax(const f32x16& p0, const f32x16& p1, float offA, float offB) {
    const float m = __builtin_fmaxf(__builtin_fmaf(max16(p0), C2, offA), __builtin_fmaf(max16(p1), C2, offB));
    auto rr = __builtin_amdgcn_permlane32_swap(__float_as_uint(m), __float_as_uint(m), false, false);
    return __builtin_fmaxf(__uint_as_float(rr[0]), __uint_as_float(rr[1])); }
__device__ __forceinline__ void cmask(f32x16& p0, f32x16& p1, int jb, int qrel, int hi) {
    const int kb = 64 * jb + 4 * hi;
#pragma unroll
    for (int r = 0; r < 16; ++r) { const int kv = kb + (r & 3) + 8 * (r >> 2); if (kv > qrel) p0[r] = -INFINITY; if (kv + 32 > qrel) p1[r] = -INFINITY; } }

__device__ __forceinline__ void attn_epilogue_body(LAS unsigned char* lds, f32x16 (&o)[4], float l_reg, bf16_t* __restrict__ yb, const float* __restrict__ subln_w, float lam,
                                                   size_t rowb, int q0, int h, int wave, int lane) {
    asm volatile("" : "+v"(lane));
    const int r32 = lane & 31, hi = lane >> 5, map = wave >> 2, qs = wave & 3;
    LAS float* wsf = (LAS float*)(lds + SCR_OFF) + wave * 64;
    if (hi == 0) wsf[r32] = 1.f / l_reg;
    float il[16];
#pragma unroll
    for (int g = 0; g < 4; ++g) { const f32x4 t4 = *(const LAS f32x4*)(wsf + 8 * g + 4 * hi); il[4 * g] = t4[0]; il[4 * g + 1] = t4[1]; il[4 * g + 2] = t4[2]; il[4 * g + 3] = t4[3]; }
    __syncthreads();
    LAS float* comb = (LAS float*)(lds + COMB_OFF) + qs * 4096;
    if (map == 1) {
#pragma unroll
        for (int d = 0; d < 4; ++d)
#pragma unroll
            for (int r = 0; r < 16; ++r) comb[crow(r, hi) * 128 + 32 * d + r32] = o[d][r] * il[r];
    }
    __syncthreads();
    if (map == 0) {
        float sw[4];
#pragma unroll
        for (int d = 0; d < 4; ++d) sw[d] = subln_w[32 * d + r32] * (1.f - LAM_INIT);
#pragma unroll
        for (int r = 0; r < 16; ++r) {
            float v[4], ss = 0.f;
#pragma unroll
            for (int d = 0; d < 4; ++d) { v[d] = o[d][r] * il[r] - lam * comb[crow(r, hi) * 128 + 32 * d + r32]; ss += v[d] * v[d]; }
            ss += __shfl_xor(ss, 1); ss += __shfl_xor(ss, 2); ss += __shfl_xor(ss, 4); ss += __shfl_xor(ss, 8); ss += __shfl_xor(ss, 16);
            const float rs = rsqrtf(ss * (1.f / 128.f) + SUBLN_EPS);
            bf16_t* op = yb + (rowb + q0 + crow(r, hi)) * 512 + h * 128 + r32;
#pragma unroll
            for (int d = 0; d < 4; ++d) op[32 * d] = f2bf(v[d] * rs * sw[d]);
        }
    }
    __syncthreads();
}
__device__ __forceinline__ void attn_unit(LAS unsigned char* lds, const bf16_t* __restrict__ z, bf16_t* __restrict__ yb, const float* __restrict__ subln_w, float lam,
                                          int b, int h, int qblk, int wave_, int lane) {
    const int wave = __builtin_amdgcn_readfirstlane(wave_);
    const int r32 = lane & 31, hi = lane >> 5, map = wave >> 2, qs = wave & 3;
    const int q0 = qblk * 128 + qs * 32, NT = 2 * qblk + 2, qrel = qs * 32 + r32;
    const size_t rowb = (size_t)b * SEQ;
    const float slope = exp2f(-2.f * (float)(h + 1)), slope2 = slope * LOG2E, s64 = 64.f * slope2, s32 = 32.f * slope2;
    const unsigned lds0 = (unsigned)(uintptr_t)lds;
    LAS float* wsf = (LAS float*)(lds + SCR_OFF) + wave * 64;
    const bf16_t* ksrc = z + (rowb + lane) * NZ + C_ZK + h * 128 + wave * 8;
    const int pc0 = 2 * wave;
    const bf16_t* vsrc0 = z + (rowb + 16 * (pc0 & 3) + (lane >> 2)) * NZ + C_ZV + h * 128 + 32 * (pc0 >> 2) + (lane & 3) * 8;
    const unsigned kdst = lds0 + LDS_KR + wave * 1024, vdst = lds0 + LDS_VR + pc0 * 1024;
#define DMA_K(t, slot) do { const bf16_t* k_ = ksrc + (size_t)(t) * 64 * NZ; const unsigned d_ = (unsigned)__builtin_amdgcn_readfirstlane(kdst + (slot)); glds16(k_, d_); glds16_o128(k_, d_ + 8192 - 128); } while (0)
#define DMA_V(t, slot) do { const size_t o_ = (size_t)(t) * 64 * NZ; const unsigned d_ = (unsigned)__builtin_amdgcn_readfirstlane(vdst + (slot)); glds16(vsrc0 + o_, d_); glds16(vsrc0 + o_ + 16 * NZ, d_ + 1024); } while (0)
    const lcp vp0 = lds + LDS_VR + ((lane >> 4) & 1) * 32 + (lane & 3) * 8 + (4 * hi + ((lane & 15) >> 2)) * 64;
    const lcp kp0 = lds + LDS_KR + map * 8192 + hi * 1024 + r32 * 16;
    DMA_K(0, 0); DMA_V(0, 0); DMA_K(1, RSLOT);
    bf16x8 qr[4];
    {
        const bf16_t* qp = z + (rowb + q0 + r32) * NZ + C_Q + h * 128 + map * 64 + hi * 8;
#pragma unroll
        for (int d0 = 0; d0 < 4; ++d0) qr[d0] = *(const bf16x8*)(qp + d0 * 16);
    }
    f32x16 bias16;
#pragma unroll
    for (int r = 0; r < 16; ++r) bias16[r] = (8.f * slope) * (float)((r & 3) + 8 * (r >> 2));
    DA_PIN(bias16);
    float mhat = 0.f, l_reg = 0.f, offA = slope2 * (float)(4 * hi);
    f32x16 o[4];
#pragma unroll
    for (int d = 0; d < 4; ++d) o[d] = (f32x16){};
    bool resc = false;
    f32x16 c0, c1; bf16x8 kf[8]; s16x4 vlo[4], vhi[4]; v4u pw0, pw1, pw2, pw3;
#define SL(t) ((((t)) & 3) * RSLOT)
#define EX(v, nm) __builtin_amdgcn_exp2f(__builtin_fmaf((v), C2, (nm)))
#define RESC() do { if (resc) { _Pragma("unroll") for (int d_ = 0; d_ < 4; ++d_) _Pragma("unroll") for (int r = 0; r < 16; ++r) o[d_][r] *= wsf[crow(r, hi)]; } } while (0)
#define PKW(P, i) pg8::cvt_pk_bf16(P[i], P[(i) + 1])
    DMA_K(2, 2 * RSLOT); DMA_K(3, 3 * RSLOT); DMA_V(1, RSLOT);
    DA_WAIT_BAR(10);
#pragma unroll
    for (int d0 = 0; d0 < 4; ++d0) kload2(kf, kp0, d0);
    c0 = DA_MFMA(kf[0], qr[0], bias16); c1 = DA_MFMA(kf[1], qr[0], bias16); c0 = DA_MFMA(kf[2], qr[1], c0); c1 = DA_MFMA(kf[3], qr[1], c1);
    c0 = DA_MFMA(kf[4], qr[2], c0); c1 = DA_MFMA(kf[5], qr[2], c1); c0 = DA_MFMA(kf[6], qr[3], c0); c1 = DA_MFMA(kf[7], qr[3], c1);
    if (NT == 2) cmask(c0, c1, 0, qrel, hi);
    { mhat = rowmax(c0, c1, offA, offA + s32); const float nmh0 = offA - mhat, nmh1 = nmh0 + s32; float sacc = 0.f;
#pragma unroll
      for (int r = 0; r < 16; ++r) { c0[r] = EX(c0[r], nmh0); c1[r] = EX(c1[r], nmh1); sacc += c0[r] + c1[r]; }
      l_reg = sacc; }
    pw0 = (v4u){PKW(c0, 0), PKW(c0, 2), PKW(c0, 4), PKW(c0, 6)}; pw1 = (v4u){PKW(c0, 8), PKW(c0, 10), PKW(c0, 12), PKW(c0, 14)};
    pw2 = (v4u){PKW(c1, 0), PKW(c1, 2), PKW(c1, 4), PKW(c1, 6)}; pw3 = (v4u){PKW(c1, 8), PKW(c1, 10), PKW(c1, 12), PKW(c1, 14)};
    DA_WAIT_BAR(6);
    DMA_K(4, 0); DMA_V(2, 2 * RSLOT);
#pragma unroll
    for (int d0 = 0; d0 < 4; ++d0) kload2(kf, kp0 + RSLOT, d0);
    if (NT == 2) { DA_WAIT_BAR(0); } else { DA_WAIT_BAR(8); }
#define PAF(k) __builtin_bit_cast(bf16x8, pw##k)
#define VFR(i) (bf16x8){vlo[(i) & 3][0], vlo[(i) & 3][1], vlo[(i) & 3][2], vlo[(i) & 3][3], vhi[(i) & 3][0], vhi[(i) & 3][1], vhi[(i) & 3][2], vhi[(i) & 3][3]}
#define VOFF(i) ((((i) & 3) * 4 + ((i) >> 2)) * 1024)
#define VRD(i) do { vlo[(i) & 3] = vtr(vp_ + VOFF(i)); vhi[(i) & 3] = vtr(vp_ + VOFF(i) + 512); DA_SBAR(); } while (0)
#define KRD(G, d0) do { if (G) { kload2(kf, kp0 + sl_next_, d0); DA_SBAR(); } } while (0)
#define GAPA(MF) do { MF; DA_SBAR(); } while (0)
#define GAPB(MF, X, i, nm, A0, A1, EXTRA) do { MF; X[i] = EX(X[i], nm); X[(i) + 1] = EX(X[(i) + 1], nm); sacc += A0; sacc += A1; EXTRA; DA_PIN(X); DA_PIN(sacc); DA_SBAR(); } while (0)
#define STEP(t, MASK, GK, GV, GL) do { DA_SBAR(); \
    const lcp vp_ = vp0 + SL((t) - 1); const int sl_next_ = SL((t) + 1); \
            GAPA(c0 = DA_MFMA(kf[0], qr[0], bias16)); GAPA(c1 = DA_MFMA(kf[1], qr[0], bias16)); GAPA(c0 = DA_MFMA(kf[2], qr[1], c0)); GAPA(c1 = DA_MFMA(kf[3], qr[1], c1)); \
    VRD(0); GAPA(c0 = DA_MFMA(kf[4], qr[2], c0)); VRD(1); GAPA(c1 = DA_MFMA(kf[5], qr[2], c1)); VRD(2); GAPA(c0 = DA_MFMA(kf[6], qr[3], c0)); VRD(3); GAPA(c1 = DA_MFMA(kf[7], qr[3], c1)); \
    offA += s64; \
    if (GK) DMA_K((t) + 4, SL(t)); if (GV) DMA_V((t) + 2, SL((t) + 2)); \
    if (MASK) cmask(c0, c1, (t) - (NT - 2), qrel, hi); \
    { const float rm = rowmax(c0, c1, offA, offA + s32) - mhat; resc = false; \
      if (__builtin_expect(__any(rm > THR), 0)) { const float dl = __builtin_fmaxf(rm, 0.f); mhat += dl; \
          const float f = __builtin_amdgcn_exp2f(-dl); l_reg *= f; if (hi == 0) wsf[r32] = f; resc = true; } } \
    const float nmh0 = offA - mhat, nmh1 = nmh0 + s32; float sacc = 0.f; DA_SBAR(); \
    GAPB(o[0] = DA_MFMA(PAF(0), VFR(0), o[0]), c0, 0, nmh0, 0.f, 0.f, );             VRD(4); \
    GAPB(o[1] = DA_MFMA(PAF(0), VFR(1), o[1]), c0, 2, nmh0, c0[0], c0[1], );         VRD(5); \
    GAPB(o[2] = DA_MFMA(PAF(0), VFR(2), o[2]), c0, 4, nmh0, c0[2], c0[3], );         VRD(6); \
    GAPB(o[3] = DA_MFMA(PAF(0), VFR(3), o[3]), c0, 6, nmh0, c0[4], c0[5], );         VRD(7); \
    GAPB(o[0] = DA_MFMA(PAF(1), VFR(4), o[0]), c0, 8, nmh0, c0[6], c0[7], pw0[0] = PKW(c0, 0); pw0[1] = PKW(c0, 2); DA_PIN(pw0));    VRD(8); \
    GAPB(o[1] = DA_MFMA(PAF(1), VFR(5), o[1]), c0, 10, nmh0, c0[8], c0[9], pw0[2] = PKW(c0, 4); pw0[3] = PKW(c0, 6); DA_PIN(pw0));   VRD(9); \
    GAPB(o[2] = DA_MFMA(PAF(1), VFR(6), o[2]), c0, 12, nmh0, c0[10], c0[11], );      VRD(10); \
    GAPB(o[3] = DA_MFMA(PAF(1), VFR(7), o[3]), c0, 14, nmh0, c0[12], c0[13], );      VRD(11); \
    GAPB(o[0] = DA_MFMA(PAF(2), VFR(8), o[0]), c1, 0, nmh1, c0[14], c0[15], pw1[0] = PKW(c0, 8); pw1[1] = PKW(c0, 10); DA_PIN(pw1));  VRD(12); \
    GAPB(o[1] = DA_MFMA(PAF(2), VFR(9), o[1]), c1, 2, nmh1, c1[0], c1[1], pw1[2] = PKW(c0, 12); pw1[3] = PKW(c0, 14); DA_PIN(pw1));   VRD(13); \
    GAPB(o[2] = DA_MFMA(PAF(2), VFR(10), o[2]), c1, 4, nmh1, c1[2], c1[3], );        VRD(14); \
    GAPB(o[3] = DA_MFMA(PAF(2), VFR(11), o[3]), c1, 6, nmh1, c1[4], c1[5], );        VRD(15); \
    GAPB(o[0] = DA_MFMA(PAF(3), VFR(12), o[0]), c1, 8, nmh1, c1[6], c1[7], pw2[0] = PKW(c1, 0); pw2[1] = PKW(c1, 2); DA_PIN(pw2));   KRD(GL, 0); \
    GAPB(o[1] = DA_MFMA(PAF(3), VFR(13), o[1]), c1, 10, nmh1, c1[8], c1[9], pw2[2] = PKW(c1, 4); pw2[3] = PKW(c1, 6); DA_PIN(pw2));  KRD(GL, 1); \
    GAPB(o[2] = DA_MFMA(PAF(3), VFR(14), o[2]), c1, 12, nmh1, c1[10], c1[11], );     KRD(GL, 2); \
    GAPB(o[3] = DA_MFMA(PAF(3), VFR(15), o[3]), c1, 14, nmh1, c1[12], c1[13], );     KRD(GL, 3); \
    sacc += c1[14]; sacc += c1[15]; l_reg += sacc; \
    pw3[0] = PKW(c1, 8); pw3[1] = PKW(c1, 10); pw3[2] = PKW(c1, 12); pw3[3] = PKW(c1, 14); DA_PIN(pw3); \
    } while (0)
#define ENDW(tt) do { if ((tt) + 4 < NT) { DA_WAIT_BAR(8); } else if ((tt) + 3 < NT) { DA_WAIT_BAR(6); } else if ((tt) + 2 < NT) { DA_WAIT_BAR(4); } else { DA_WAIT_BAR(0); } } while (0)
    int t = 1;
    for (; t + 4 < NT; ++t) {
        STEP(t, false, true, true, true); DA_WAIT_BAR(8); RESC();
    }
    for (; t + 1 < NT; ++t) {
        STEP(t, true, (t + 4 < NT), (t + 2 < NT), (t + 1 < NT)); ENDW(t); RESC();
    }
    STEP(NT - 1, true, false, false, false); RESC();
    { const lcp vp_ = vp0 + SL(NT - 1);
#define DRN(k, i) do { const s16x4 lo_ = vtr(vp_ + VOFF(i)), hh_ = vtr(vp_ + VOFF(i) + 512); \
        o[(i) & 3] = DA_MFMA(PAF(k), ((bf16x8){lo_[0], lo_[1], lo_[2], lo_[3], hh_[0], hh_[1], hh_[2], hh_[3]}), o[(i) & 3]); } while (0)
      DRN(0, 0); DRN(0, 1); DRN(0, 2); DRN(0, 3); DRN(1, 4); DRN(1, 5); DRN(1, 6); DRN(1, 7); DRN(2, 8); DRN(2, 9); DRN(2, 10); DRN(2, 11); DRN(3, 12); DRN(3, 13); DRN(3, 14); DRN(3, 15);
#undef DRN
    }
#undef DMA_K
#undef DMA_V
#undef SL
#undef EX
#undef RESC
#undef PKW
#undef PAF
#undef VFR
#undef VOFF
#undef VRD
#undef KRD
#undef GAPA
#undef GAPB
#undef STEP
#undef ENDW
    { auto rr = __builtin_amdgcn_permlane32_swap(__float_as_uint(l_reg), __float_as_uint(l_reg), false, false); l_reg = __uint_as_float(rr[0]) + __uint_as_float(rr[1]); }
    attn_epilogue_body(lds, o, l_reg, yb, subln_w, lam, rowb, q0, h, wave, lane);
}
}

namespace rw {
typedef short bf16x8 __attribute__((ext_vector_type(8)));
typedef float f32x2 __attribute__((ext_vector_type(2)));
typedef short s16x4 __attribute__((ext_vector_type(4)));
constexpr int CH = 32, ACT_PITCH = 528;
constexpr int OFF_HAT = 41472, HAT_PITCH = 144, HAT_SZ = 32 * HAT_PITCH, OFF_TIL = OFF_HAT + 4 * HAT_SZ, TIL_PITCH = 40, TIL_SZ = 64 * TIL_PITCH, OFF_GR = OFF_TIL + 4 * TIL_SZ, OFF_WC = OFF_GR + 10 * 1024;
constexpr int OFF_ACT = 0, OFF_RKV = 16896, OFF_VEC = 41472, OFF_G = 82432, OFF_Y = 90624, OFF_NRM = 98816, OFF_SCL = 99328, OFF_CT = 99840, OFF_SCP = 102400;
template <int CTRL> __device__ __forceinline__ float dppf(float x) { return __builtin_bit_cast(float, __builtin_amdgcn_mov_dpp(__builtin_bit_cast(int, x), CTRL, 0xf, 0xf, true)); }
__device__ __forceinline__ float row_allsum(float v) { v += dppf<0x128>(v); v += dppf<0x124>(v); v += dppf<0x122>(v); v += dppf<0x121>(v); return v; }
__device__ __forceinline__ void row_allsum4(float& a, float& b, float& c, float& d) {
#define RW_DPP4(n) "v_add_f32_dpp %0, %0, %0 row_ror:" #n " row_mask:0xf bank_mask:0xf\n\tv_add_f32_dpp %1, %1, %1 row_ror:" #n " row_mask:0xf bank_mask:0xf\n\t" \
                   "v_add_f32_dpp %2, %2, %2 row_ror:" #n " row_mask:0xf bank_mask:0xf\n\tv_add_f32_dpp %3, %3, %3 row_ror:" #n " row_mask:0xf bank_mask:0xf\n\t"
    asm volatile("s_nop 1\n\t" RW_DPP4(8) RW_DPP4(4) RW_DPP4(2) RW_DPP4(1) "s_nop 1" : "+v"(a), "+v"(b), "+v"(c), "+v"(d));
#undef RW_DPP4
}
__device__ __forceinline__ f32x4 ld4bf(const bf16_t* p) { const v2u w = *(const v2u*)p; return (f32x4){pg8::bflo(w.x), pg8::bfhi(w.x), pg8::bflo(w.y), pg8::bfhi(w.y)}; }
__device__ __forceinline__ float fsig(float x) { return __builtin_amdgcn_rcpf(1.f + __expf(-x)); }
__device__ __forceinline__ float ftanh(float x) { return 1.f - 2.f * __builtin_amdgcn_rcpf(1.f + __expf(2.f * x)); }
struct ZRow { v2u r, k, v, w, a; v4u g; };
__device__ __forceinline__ ZRow ldrow(const bf16_t* zr, int c4, int cg) {
    ZRow o; o.r = *(const v2u*)(zr + C_R + c4); o.k = *(const v2u*)(zr + C_K + c4); o.v = *(const v2u*)(zr + C_V + c4); o.w = *(const v2u*)(zr + C_WL + 4 * cg); o.a = *(const v2u*)(zr + C_AL + 4 * cg);
    o.g = *(const v4u*)(zr + C_GL + 8 * cg); return o;
}
__device__ __forceinline__ f32x4 up4(v2u w) { return (f32x4){pg8::bflo(w.x), pg8::bfhi(w.x), pg8::bflo(w.y), pg8::bfhi(w.y)}; }

struct ScanP { const float *mu, *w0, *w2, *a0, *a2, *g2, *k_k, *k_a, *r_k, *lnx_w, *lnx_b; };
__device__ __forceinline__ void scan_unit(LAS unsigned char* lds, const bf16_t* __restrict__ z, bf16_t* __restrict__ ya, const ScanP P, int b, int h, int tid, int wave, int lane) {
    asm volatile("" : "+v"(tid)); lane = tid & 63;
    const float* mu = P.mu; const float* w0 = P.w0; const float* w2 = P.w2; const float* a0 = P.a0; const float* a2 = P.a2; const float* g2 = P.g2;
    const float* k_k = P.k_k; const float* k_a = P.k_a; const float* r_k = P.r_k; const float* lnx_w = P.lnx_w; const float* lnx_b = P.lnx_b;
    const size_t rowb = (size_t)b * SEQ;
    const int tl = tid >> 4, cg = tid & 15;
    const int nt = wave & 3, rl = lane & 15, rg = lane >> 4;
    LAS float* rkv = (LAS float*)(lds + OFF_RKV); LAS float* vec = (LAS float*)(lds + OFF_VEC); LAS float* gbuf = (LAS float*)(lds + OFF_G);
    LAS float* ybuf = (LAS float*)(lds + OFF_Y); LAS float* nrm = (LAS float*)(lds + OFF_NRM); LAS float* scl = (LAS float*)(lds + OFF_SCL); LAS float* scp = (LAS float*)(lds + OFF_SCP);
    bf16x8 bfr[8];
    {
        const int col = h * 64 + 16 * nt + rl;
#pragma unroll
        for (int f = 0; f < 8; ++f) {
            const float* src = (f < 2) ? w2 : (f < 4) ? a2 : g2;
            const int kb = ((f < 4) ? 32 * (f & 1) : 32 * (f - 4)) + 8 * rg;
            float e[8];
#pragma unroll
            for (int j = 0; j < 8; ++j) e[j] = src[(size_t)(kb + j) * 512 + col];
            v4u p; p.x = pg8::cvt_pk_bf16(e[0], e[1]); p.y = pg8::cvt_pk_bf16(e[2], e[3]); p.z = pg8::cvt_pk_bf16(e[4], e[5]); p.w = pg8::cvt_pk_bf16(e[6], e[7]);
            bfr[f] = __builtin_bit_cast(bf16x8, p);
            __builtin_amdgcn_sched_barrier(0);
        }
    }
    const int mt = wave >> 2;
    const int hc = h * 64 + 16 * nt + rl;
    const float w0c = w0[hc], a0c = a0[hc], kkc = k_k[hc], kac = k_a[hc], rkc = r_k[hc];
    const int c4 = h * 64 + 4 * cg;
    f32x4 ST[4];
#pragma unroll
    for (int i = 0; i < 4; ++i) ST[i] = (f32x4){0.f, 0.f, 0.f, 0.f};
    LAS float* ctab = (LAS float*)(lds + OFF_CT);
    if (tl == 0) {
        LAS float* ct = ctab + cg * 36;
        *(LAS f32x4*)(ct + 0) = *(const f32x4*)(mu + C_R + c4); *(LAS f32x4*)(ct + 4) = *(const f32x4*)(mu + C_K + c4); *(LAS f32x4*)(ct + 8) = *(const f32x4*)(mu + C_V + c4);
        *(LAS f32x4*)(ct + 12) = *(const f32x4*)(mu + C_WL + 4 * cg); *(LAS f32x4*)(ct + 16) = *(const f32x4*)(mu + C_AL + 4 * cg);
        *(LAS f32x4*)(ct + 20) = *(const f32x4*)(mu + C_GL + 8 * cg); *(LAS f32x4*)(ct + 24) = *(const f32x4*)(mu + C_GL + 8 * cg + 4);
        *(LAS f32x4*)(ct + 28) = *(const f32x4*)(lnx_w + c4); *(LAS f32x4*)(ct + 32) = *(const f32x4*)(lnx_b + c4);
    }
    __syncthreads();
    const LAS float* myct = ctab + cg * 36;
    ZRow zc = ldrow(z + (rowb + tl) * NZ, c4, cg), zp;
    if (tl > 0) zp = ldrow(z + (rowb + tl - 1) * NZ, c4, cg); else { zp.r = zp.k = zp.v = zp.w = zp.a = (v2u){0u, 0u}; zp.g = (v4u){0u, 0u, 0u, 0u}; }
    for (int t0 = 0; t0 < SEQ; t0 += CH) {
        {
            const f32x4 cr = up4(zc.r), ck = up4(zc.k), cv = up4(zc.v), cw = up4(zc.w), ca = up4(zc.a);
            const f32x4 cg0 = (f32x4){pg8::bflo(zc.g.x), pg8::bfhi(zc.g.x), pg8::bflo(zc.g.y), pg8::bfhi(zc.g.y)}, cg1 = (f32x4){pg8::bflo(zc.g.z), pg8::bfhi(zc.g.z), pg8::bflo(zc.g.w), pg8::bfhi(zc.g.w)};
            const f32x4 pr = up4(zp.r), pk = up4(zp.k), pv = up4(zp.v), pw = up4(zp.w), pa = up4(zp.a);
            const f32x4 pg0 = (f32x4){pg8::bflo(zp.g.x), pg8::bfhi(zp.g.x), pg8::bflo(zp.g.y), pg8::bfhi(zp.g.y)}, pg1 = (f32x4){pg8::bflo(zp.g.z), pg8::bfhi(zp.g.z), pg8::bflo(zp.g.w), pg8::bfhi(zp.g.w)};
            if (t0 + CH < SEQ) { zc = ldrow(z + (rowb + t0 + CH + tl) * NZ, c4, cg); zp = ldrow(z + (rowb + t0 + CH + tl - 1) * NZ, c4, cg); }
            const f32x4 rs_ = cr + (pr - cr) * *(const LAS f32x4*)(myct + 0), ks_ = ck + (pk - ck) * *(const LAS f32x4*)(myct + 4), vs_ = cv + (pv - cv) * *(const LAS f32x4*)(myct + 8);
            const f32x4 ws_ = cw + (pw - cw) * *(const LAS f32x4*)(myct + 12), as_ = ca + (pa - ca) * *(const LAS f32x4*)(myct + 16);
            const f32x4 g0_ = cg0 + (pg0 - cg0) * *(const LAS f32x4*)(myct + 20), g1_ = cg1 + (pg1 - cg1) * *(const LAS f32x4*)(myct + 24);
            *(LAS f32x4*)(rkv + 0 * 2048 + tl * 64 + 4 * cg) = rs_; *(LAS f32x4*)(rkv + 1 * 2048 + tl * 64 + 4 * cg) = ks_; *(LAS f32x4*)(rkv + 2 * 2048 + tl * 64 + 4 * cg) = vs_;
            LAS unsigned char* ar = lds + OFF_ACT + tl * ACT_PITCH;
            v2u tw; tw.x = pg8::cvt_pk_bf16(ftanh(ws_[0]), ftanh(ws_[1])); tw.y = pg8::cvt_pk_bf16(ftanh(ws_[2]), ftanh(ws_[3]));
            *(LAS v2u*)(ar + 8 * cg) = tw;
            v2u aw; aw.x = pg8::cvt_pk_bf16(as_[0], as_[1]); aw.y = pg8::cvt_pk_bf16(as_[2], as_[3]);
            *(LAS v2u*)(ar + 128 + 8 * cg) = aw;
            v4u gw; gw.x = pg8::cvt_pk_bf16(fsig(g0_[0]), fsig(g0_[1])); gw.y = pg8::cvt_pk_bf16(fsig(g0_[2]), fsig(g0_[3]));
            gw.z = pg8::cvt_pk_bf16(fsig(g1_[0]), fsig(g1_[1])); gw.w = pg8::cvt_pk_bf16(fsig(g1_[2]), fsig(g1_[3]));
            *(LAS v4u*)(ar + 256 + 16 * cg) = gw;
        }
        __syncthreads();
        f32x4 accw = (f32x4){0.f, 0.f, 0.f, 0.f}, acca = accw, accg = accw;
        {
            const LAS unsigned char* ap = lds + OFF_ACT + (16 * mt + rl) * ACT_PITCH + 8 * rg * 2;
#pragma unroll
            for (int f = 0; f < 8; ++f) {
                const bf16x8 a = *(const LAS bf16x8*)(ap + f * 64);
                if (f < 2) accw = __builtin_amdgcn_mfma_f32_16x16x32_bf16(a, bfr[f], accw, 0, 0, 0);
                else if (f < 4) acca = __builtin_amdgcn_mfma_f32_16x16x32_bf16(a, bfr[f], acca, 0, 0, 0);
                else accg = __builtin_amdgcn_mfma_f32_16x16x32_bf16(a, bfr[f], accg, 0, 0, 0);
            }
        }
        float lw[4], av[4], kk[4];
        {
            const int c = 16 * nt + rl;
            float n2[4];
#pragma unroll
            for (int r = 0; r < 4; ++r) {
                const int tok = 16 * mt + 4 * rg + r;
                gbuf[tok * 64 + c] = accg[r];
                const float nx = -(w0c + accw[r]);
                const float sp = nx > 20.f ? nx : __logf(1.f + __expf(nx));
                lw[r] = -__expf(-sp - 0.5f);
                av[r] = fsig(a0c + acca[r]);
                kk[r] = rkv[1 * 2048 + tok * 64 + c] * kkc;
                n2[r] = kk[r] * kk[r];
            }
            row_allsum4(n2[0], n2[1], n2[2], n2[3]);
            if (rl == 0) {
#pragma unroll
                for (int r = 0; r < 4; ++r) nrm[(16 * mt + 4 * rg + r) * 4 + nt] = n2[r];
            }
        }
        __syncthreads();
        {
            const int c = 16 * nt + rl;
            const float p0 = lw[0], p1 = p0 + lw[1], p2 = p1 + lw[2], p3 = p2 + lw[3];
            const float t1 = __shfl(p3, (lane - 16) & 63), t2 = __shfl(p3, (lane - 32) & 63), t3 = __shfl(p3, (lane - 48) & 63);
            const float E = (rg >= 1 ? t1 : 0.f) + (rg >= 2 ? t2 : 0.f) + (rg >= 3 ? t3 : 0.f);
            const float Ltot = __shfl(E + p3, rl + 48);
            const float pin[4] = {p0, p1, p2, p3};
            float bt[4], kt[4];
#pragma unroll
            for (int r = 0; r < 4; ++r) {
                const int tok = 16 * mt + 4 * rg + r;
                const f32x4 n4 = *(const LAS f32x4*)(nrm + tok * 4);
                const float ksv = rkv[1 * 2048 + tok * 64 + c], rsv = rkv[0 * 2048 + tok * 64 + c];
                const float inv = __builtin_amdgcn_rcpf(fmaxf(sqrtf((n4[0] + n4[1]) + (n4[2] + n4[3])), 1e-12f));
                const float kkn = kk[r] * inv, beta = kkn * av[r], kmod = ksv * (1.f + (av[r] - 1.f) * kac);
                const float L = E + pin[r], eL = __expf(L), ieL = __expf(-L), eLm = __expf(L - lw[r]), eT = __expf(Ltot - L);
                LAS unsigned char* hp = lds + OFF_HAT + tok * HAT_PITCH + c * 2;
                *(LAS bf16_t*)(hp) = f2bf(-kkn * eLm); *(LAS bf16_t*)(hp + HAT_SZ) = f2bf(beta * ieL); *(LAS bf16_t*)(hp + 2 * HAT_SZ) = f2bf(kmod * ieL); *(LAS bf16_t*)(hp + 3 * HAT_SZ) = f2bf(rsv * eL);
                bt[r] = beta * eT; kt[r] = kmod * eT;
                float pbr = beta * rsv, pkr = kmod * rsv, pbo = rsv * kmod * rkc, dum = 0.f;
                row_allsum4(pbr, pkr, pbo, dum);
                if (rl == 0) *(LAS f32x4*)(scp + (tok * 4 + nt) * 4) = (f32x4){pbr, pkr, pbo, 0.f};
            }
            LAS unsigned char* tp = lds + OFF_TIL + (2 * mt) * TIL_SZ + c * TIL_PITCH + 8 * rg;
            v2u w; w.x = pg8::cvt_pk_bf16(bt[0], bt[1]); w.y = pg8::cvt_pk_bf16(bt[2], bt[3]); *(LAS v2u*)(tp) = w;
            w.x = pg8::cvt_pk_bf16(kt[0], kt[1]); w.y = pg8::cvt_pk_bf16(kt[2], kt[3]); *(LAS v2u*)(tp + TIL_SZ) = w;
            if (rg == 0) ((LAS float*)(lds + OFF_WC))[mt * 64 + c] = __expf(Ltot);
        }
        __syncthreads();
        if (tid < CH) {
            const f32x4 p0 = *(const LAS f32x4*)(scp + tid * 16), p1 = *(const LAS f32x4*)(scp + tid * 16 + 4), p2 = *(const LAS f32x4*)(scp + tid * 16 + 8), p3 = *(const LAS f32x4*)(scp + tid * 16 + 12);
            *(LAS f32x4*)(scl + 4 * tid) = (p0 + p1) + (p2 + p3);
        }
        int lane_ = lane; asm volatile("" : "+v"(lane_));
        const int rl_ = lane_ & 15, rg_ = lane_ >> 4;
        {
            const int c = wave >> 2, g = wave & 3;
            const LAS unsigned char* pa = lds + OFF_HAT + ((g & 1) ? 2 : 1) * HAT_SZ + (16 * c + rl_) * HAT_PITCH + 16 * rg_;
            const LAS unsigned char* pb = lds + OFF_HAT + ((g < 2) ? 0 : 3) * HAT_SZ + (16 * c + rl_) * HAT_PITCH + 16 * rg_;
            f32x4 acc = (f32x4){0.f, 0.f, 0.f, 0.f};
            acc = __builtin_amdgcn_mfma_f32_16x16x32_bf16(*(const LAS bf16x8*)(pa), *(const LAS bf16x8*)(pb), acc, 0, 0, 0);
            acc = __builtin_amdgcn_mfma_f32_16x16x32_bf16(*(const LAS bf16x8*)(pa + 64), *(const LAS bf16x8*)(pb + 64), acc, 0, 0, 0);
#pragma unroll
            for (int e = 0; e < 4; ++e) { const int row = 4 * rg_ + e; const bool keep = (g < 2) ? (row < rl_) : (row <= rl_); if (!keep) acc[e] = 0.f; }
            *(LAS f32x4*)(lds + OFF_GR + (c * 5 + g) * 1024 + lane_ * 16) = acc;
            if (g == 0) {
                asm volatile("s_waitcnt lgkmcnt(0)" ::: "memory");
                if (lane_ < 16) {
                    const int sc = lane_;
                    const LAS float* tb = (const LAS float*)(lds + OFF_GR + (c * 5) * 1024);
                    float m[16], ps[16];
#pragma unroll
                    for (int r = 0; r < 16; ++r) ps[r] = 0.f;
#pragma unroll
                    for (int u = 15; u >= 0; --u) {
                        m[u] = (u == sc) ? 1.f : ((u < sc) ? ps[u] : 0.f);
#pragma unroll
                        for (int r = 0; r < u; ++r) ps[r] = __builtin_fmaf(tb[(u + 16 * (r >> 2)) * 4 + (r & 3)], m[u], ps[r]);
                    }
                    LAS f32x4* mt_ = (LAS f32x4*)(lds + OFF_GR + (c * 5 + 4) * 1024);
#pragma unroll
                    for (int q = 0; q < 4; ++q) mt_[sc + 16 * q] = (f32x4){m[4 * q], m[4 * q + 1], m[4 * q + 2], m[4 * q + 3]};
                }
            }
        }
        __syncthreads();
        if (wave < 4) {
            const int ib = wave;
#pragma unroll
            for (int c = 0; c < 2; ++c) {
                bf16x8 sb[2];
#pragma unroll
                for (int ks = 0; ks < 2; ++ks) {
                    v4u p; p.x = pg8::cvt_pk_bf16(ST[2 * ks][0], ST[2 * ks][1]); p.y = pg8::cvt_pk_bf16(ST[2 * ks][2], ST[2 * ks][3]);
                    p.z = pg8::cvt_pk_bf16(ST[2 * ks + 1][0], ST[2 * ks + 1][1]); p.w = pg8::cvt_pk_bf16(ST[2 * ks + 1][2], ST[2 * ks + 1][3]);
                    sb[ks] = __builtin_bit_cast(bf16x8, p);
                }
                const LAS unsigned char* ha = lds + OFF_HAT + (16 * c + rl_) * HAT_PITCH + 8 * rg_;
                f32x4 xt = (f32x4){0.f, 0.f, 0.f, 0.f}, yt = xt;
#pragma unroll
                for (int ks = 0; ks < 2; ++ks) {
                    v4u fa, fr; const v2u a0_ = *(const LAS v2u*)(ha + 64 * ks), a1_ = *(const LAS v2u*)(ha + 64 * ks + 32);
                    const v2u r0_ = *(const LAS v2u*)(ha + 3 * HAT_SZ + 64 * ks), r1_ = *(const LAS v2u*)(ha + 3 * HAT_SZ + 64 * ks + 32);
                    fa.x = a0_.x; fa.y = a0_.y; fa.z = a1_.x; fa.w = a1_.y; fr.x = r0_.x; fr.y = r0_.y; fr.z = r1_.x; fr.w = r1_.y;
                    xt = __builtin_amdgcn_mfma_f32_16x16x32_bf16(__builtin_bit_cast(bf16x8, fa), sb[ks], xt, 0, 0, 0);
                    yt = __builtin_amdgcn_mfma_f32_16x16x32_bf16(__builtin_bit_cast(bf16x8, fr), sb[ks], yt, 0, 0, 0);
                }
                const LAS float* vsrc = rkv + 2 * 2048 + (16 * c + 4 * rg_) * 64 + 16 * ib + rl_;
                v2u vb_; vb_.x = pg8::cvt_pk_bf16(vsrc[0], vsrc[64]); vb_.y = pg8::cvt_pk_bf16(vsrc[128], vsrc[192]);
                const s16x4 vb = __builtin_bit_cast(s16x4, vb_);
                const LAS unsigned char* gr = lds + OFF_GR + (c * 5) * 1024 + lane_ * 16;
#define RW_AFR(g_) ({ const f32x4 t_ = *(const LAS f32x4*)(gr + (g_) * 1024); v2u w_; w_.x = pg8::cvt_pk_bf16(t_[0], t_[1]); w_.y = pg8::cvt_pk_bf16(t_[2], t_[3]); __builtin_bit_cast(s16x4, w_); })
#define RW_PK4(x_) ({ v2u w_; w_.x = pg8::cvt_pk_bf16((x_)[0], (x_)[1]); w_.y = pg8::cvt_pk_bf16((x_)[2], (x_)[3]); __builtin_bit_cast(s16x4, w_); })
                const f32x4 zt = __builtin_amdgcn_mfma_f32_16x16x16bf16_1k(RW_AFR(1), vb, xt, 0, 0, 0);
                const f32x4 ut = __builtin_amdgcn_mfma_f32_16x16x16bf16_1k(RW_AFR(4), RW_PK4(zt), (f32x4){0.f, 0.f, 0.f, 0.f}, 0, 0, 0);
                const s16x4 ub = RW_PK4(ut);
                yt = __builtin_amdgcn_mfma_f32_16x16x16bf16_1k(RW_AFR(2), ub, yt, 0, 0, 0);
                yt = __builtin_amdgcn_mfma_f32_16x16x16bf16_1k(RW_AFR(3), vb, yt, 0, 0, 0);
#pragma unroll
                for (int e = 0; e < 4; ++e) ybuf[(16 * c + 4 * rg_ + e) * 64 + 16 * ib + rl_] = yt[e];
                const LAS unsigned char* tl_ = lds + OFF_TIL + (2 * c) * TIL_SZ + rl_ * TIL_PITCH + 8 * rg_;
                const LAS float* wc = (const LAS float*)(lds + OFF_WC) + c * 64 + 4 * rg_;
#pragma unroll
                for (int jt = 0; jt < 4; ++jt) {
                    f32x4 acc = ST[jt] * *(const LAS f32x4*)(wc + 16 * jt);
                    acc = __builtin_amdgcn_mfma_f32_16x16x16bf16_1k(*(const LAS s16x4*)(tl_ + TIL_SZ + 16 * jt * TIL_PITCH), vb, acc, 0, 0, 0);
                    acc = __builtin_amdgcn_mfma_f32_16x16x16bf16_1k(*(const LAS s16x4*)(tl_ + 16 * jt * TIL_PITCH), ub, acc, 0, 0, 0);
                    ST[jt] = acc;
                }
#undef RW_AFR
#undef RW_PK4
            }
        }
        __syncthreads();
        {
            const f32x4 y4 = *(const LAS f32x4*)(ybuf + tl * 64 + 4 * cg);
            const float mean = row_allsum((y4[0] + y4[1]) + (y4[2] + y4[3])) * (1.f / 64.f);
            const f32x4 dv = y4 - mean;
            const float var = row_allsum((dv[0] * dv[0] + dv[1] * dv[1]) + (dv[2] * dv[2] + dv[3] * dv[3])) * (1.f / 64.f);
            const float rs_ = rsqrtf(var + GN_EPS);
            const f32x4 yn = dv * rs_ * *(const LAS f32x4*)(myct + 28) + *(const LAS f32x4*)(myct + 32);
            const float bonus = scl[tl * 4 + 2];
            const f32x4 vs_ = *(const LAS f32x4*)(rkv + 2 * 2048 + tl * 64 + 4 * cg), g4 = *(const LAS f32x4*)(gbuf + tl * 64 + 4 * cg);
            const f32x4 o = (yn + vs_ * bonus) * g4;
            v2u w; w.x = pg8::cvt_pk_bf16(o[0], o[1]); w.y = pg8::cvt_pk_bf16(o[2], o[3]);
            *(v2u*)(ya + (rowb + t0 + tl) * 512 + c4) = w;
        }
        __syncthreads();
    }
}
}

typedef __bf16 bf16x2_t __attribute__((ext_vector_type(2)));
__device__ __forceinline__ float dot2bf(unsigned a, unsigned b, float c) { return __builtin_amdgcn_fdot2_f32_bf16(__builtin_bit_cast(bf16x2_t, a), __builtin_bit_cast(bf16x2_t, b), c, false); }
__device__ __forceinline__ unsigned f2ord(float f) { const unsigned u = __float_as_uint(f); return (u & 0x80000000u) ? ~u : (u | 0x80000000u); }
__device__ __forceinline__ float ord2f(unsigned o) { return __uint_as_float((o & 0x80000000u) ? (o ^ 0x80000000u) : ~o); }
__device__ __forceinline__ unsigned row_allmax_u32(unsigned v) {
    v = max(v, (unsigned)__builtin_amdgcn_update_dpp(0, (int)v, 0x128, 0xf, 0xf, false));
    v = max(v, (unsigned)__builtin_amdgcn_update_dpp(0, (int)v, 0x124, 0xf, 0xf, false));
    v = max(v, (unsigned)__builtin_amdgcn_update_dpp(0, (int)v, 0x122, 0xf, 0xf, false));
    v = max(v, (unsigned)__builtin_amdgcn_update_dpp(0, (int)v, 0x121, 0xf, 0xf, false));
    return v;
}

constexpr int TK_PITCH = 272, TK_HALF = 128 * TK_PITCH;
typedef short tk_bf16x8 __attribute__((ext_vector_type(8)));
__device__ __forceinline__ void topk_loadq(tk_bf16x8 (&qa)[8], const bf16_t* __restrict__ qb, int t0, int h, int lane) {
    const bf16_t* qp = qb + (size_t)(t0 + (lane & 15)) * 2048 + h * 256 + 8 * (lane >> 4);
#pragma unroll
    for (int i = 0; i < 8; ++i) qa[i] = *(const tk_bf16x8*)(qp + i * 32);
}
__device__ __forceinline__ void topk_item(const tk_bf16x8 (&qa)[8], const LAS unsigned char* klds, int* __restrict__ ids, float* __restrict__ gates, int t0, int h, int lane) {
    const int rl = lane & 15, rg = lane >> 4;
    unsigned top[2][4];
#pragma unroll
    for (int c = 0; c < 2; ++c) {
        f32x4 acc[8];
#pragma unroll
        for (int nt = 0; nt < 8; ++nt) acc[nt] = (f32x4){64.f, 64.f, 64.f, 64.f};
        const LAS unsigned char* kp = klds + c * TK_HALF + rl * TK_PITCH + 16 * rg;
#pragma unroll
        for (int ks = 0; ks < 4; ++ks) {
#pragma unroll
            for (int nt = 0; nt < 8; ++nt) { const tk_bf16x8 b = *(const LAS tk_bf16x8*)(kp + nt * 16 * TK_PITCH + ks * 64); acc[nt] = __builtin_amdgcn_mfma_f32_16x16x32_bf16(qa[c * 4 + ks], b, acc[nt], 0, 0, 0); }
            __builtin_amdgcn_sched_barrier(0);
        }
        unsigned k[4][8];
#pragma unroll
        for (int r = 0; r < 4; ++r) {
#pragma unroll
            for (int nt = 0; nt < 8; ++nt) k[r][nt] = (__float_as_uint(fmaxf(acc[nt][r], 1.f)) & ~127u) | (unsigned)(127 - (nt * 16 + rl));
#define TK_CE(i, j) do { const unsigned a_ = max(k[r][i], k[r][j]), b_ = min(k[r][i], k[r][j]); k[r][i] = a_; k[r][j] = b_; } while (0)
            TK_CE(0, 1); TK_CE(2, 3); TK_CE(4, 5); TK_CE(6, 7); TK_CE(0, 2); TK_CE(1, 3); TK_CE(4, 6); TK_CE(5, 7); TK_CE(1, 2); TK_CE(5, 6);
            TK_CE(0, 4); TK_CE(1, 5); TK_CE(2, 6); TK_CE(3, 7); TK_CE(2, 4); TK_CE(3, 5); TK_CE(1, 2); TK_CE(3, 4); TK_CE(5, 6);
#undef TK_CE
        }
        unsigned tp[4] = {0u, 0u, 0u, 0u};
        for (int round = 0; round < 16; ++round) {
#pragma unroll
            for (int r = 0; r < 4; ++r) {
                const unsigned m = row_allmax_u32(k[r][0]);
                tp[r] = (rl == round) ? m : tp[r];
                const bool win = (k[r][0] == m);
                k[r][0] = win ? k[r][1] : k[r][0]; k[r][1] = win ? k[r][2] : k[r][1]; k[r][2] = win ? k[r][3] : k[r][2]; k[r][3] = win ? k[r][4] : k[r][3];
                k[r][4] = win ? k[r][5] : k[r][4]; k[r][5] = win ? k[r][6] : k[r][5]; k[r][6] = win ? k[r][7] : k[r][6]; k[r][7] = win ? 0u : k[r][7];
            }
        }
#pragma unroll
        for (int r = 0; r < 4; ++r) top[c][r] = tp[r];
    }
    const int rowbase = lane & 48;
    float v1[4]; int n1[4], ptr[4], myid[4]; unsigned k2[4], myv[4];
#pragma unroll
    for (int r = 0; r < 4; ++r) { v1[r] = __uint_as_float(top[0][r] & ~127u); n1[r] = 127 - (int)(top[0][r] & 127u); ptr[r] = 0; k2[r] = (unsigned)__builtin_amdgcn_ds_bpermute(rowbase * 4, (int)top[1][r]); myid[r] = 0; myv[r] = 0u; }
    for (int round = 0; round < 16; ++round) {
#pragma unroll
        for (int r = 0; r < 4; ++r) {
            const float head = v1[r] + __uint_as_float(k2[r] & ~127u);
            const unsigned key = (ptr[r] < 16) ? ((__float_as_uint(head) & ~15u) | (unsigned)(15 - rl)) : 0u;
            const unsigned m = row_allmax_u32(key);
            const bool win = (key == m);
            const unsigned wid = row_allmax_u32(win ? (unsigned)(n1[r] * 128 + (127 - (int)(k2[r] & 127u))) + 1u : 0u);
            myid[r] = (rl == round) ? (int)wid - 1 : myid[r];
            myv[r] = (rl == round) ? m : myv[r];
            ptr[r] += win ? 1 : 0;
            k2[r] = (unsigned)__builtin_amdgcn_ds_bpermute((rowbase + (ptr[r] & 15)) * 4, (int)top[1][r]);
        }
    }
#pragma unroll
    for (int r = 0; r < 4; ++r) {
        const float val = __uint_as_float(myv[r] & ~15u);
        const float vmax = __uint_as_float((unsigned)__builtin_amdgcn_ds_bpermute(rowbase * 4, (int)__float_as_uint(val)));
        const float e = __expf(val - vmax);
        const float sum = rw::row_allsum(e);
        gates[(size_t)(t0 + 4 * rg + r) * 128 + h * 16 + rl] = e / sum; ids[(size_t)(t0 + 4 * rg + r) * 128 + h * 16 + rl] = myid[r];
    }
}

typedef float f32x2 __attribute__((ext_vector_type(2)));
__device__ __forceinline__ void peer_token(const bf16_t* __restrict__ x2b, const float* __restrict__ ssq2, const int* __restrict__ ids, const float* __restrict__ gates,
                                           const unsigned char* __restrict__ U8, const unsigned char* __restrict__ V8, const float* __restrict__ usc, const float* __restrict__ vsc,
                                           const float* __restrict__ fw, float* __restrict__ out, int t, int lane) {
    const int l16 = lane * 16;
    f32x2 hx[8];
    {
        const v4u h0 = *(const v4u*)(x2b + (size_t)t * DM + l16), h1 = *(const v4u*)(x2b + (size_t)t * DM + l16 + 8);
        const unsigned hw[8] = {h0.x, h0.y, h0.z, h0.w, h1.x, h1.y, h1.z, h1.w};
#pragma unroll
        for (int i = 0; i < 8; ++i) hx[i] = (f32x2){pg8::bflo(hw[i]), pg8::bfhi(hw[i])};
    }
    const int idA = ids[(size_t)t * 128 + lane], idB = ids[(size_t)t * 128 + 64 + lane];
    const float rs = rsqrtf(pg8::ssq_sum16(ssq2 + (size_t)t * 16) * (1.f / DM) + NORM_EPS);
    const float suA = rs * usc[idA], suB = rs * usc[idB];
    const float svA = gates[(size_t)t * 128 + lane] * vsc[idA], svB = gates[(size_t)t * 128 + 64 + lane] * vsc[idB];
    f32x2 y[8];
#pragma unroll
    for (int i = 0; i < 8; ++i) y[i] = (f32x2){0.f, 0.f};
    const int bit0 = lane & 1, bit1 = (lane >> 1) & 1, bit2 = (lane >> 2) & 1;
    const int myk = 4 * bit0 + 2 * bit1 + bit2;
    for (int g = 0; g < 16; ++g) {
        const int idsel = (g < 8) ? idA : idB; const float susel = (g < 8) ? suA : suB, svsel = (g < 8) ? svA : svB; const int lb = (g * 8) & 63;
        v3u_t uw[8], vw[8];
#pragma unroll
        for (int k = 0; k < 8; ++k) { const int e = __builtin_amdgcn_readlane(idsel, lb + k); uw[k] = *(const v3u_t*)(U8 + (size_t)e * 768 + lane * 12); vw[k] = *(const v3u_t*)(V8 + (size_t)e * 768 + lane * 12); }
        float d[8];
#pragma unroll
        for (int k = 0; k < 8; k += 2) {
            const v32f_t f = __builtin_amdgcn_cvt_scalef32_pk32_f32_fp6((v6u_t){uw[k][0], uw[k][1], uw[k][2], uw[k + 1][0], uw[k + 1][1], uw[k + 1][2]}, 1.0f);
            f32x2 a = (f32x2){0.f, 0.f}, b = a;
#pragma unroll
            for (int i = 0; i < 8; ++i) { a += (f32x2){f[2 * i], f[2 * i + 1]} * hx[i]; b += (f32x2){f[16 + 2 * i], f[17 + 2 * i]} * hx[i]; }
            d[k] = a[0] + a[1]; d[k + 1] = b[0] + b[1];
            __builtin_amdgcn_sched_barrier(0);
        }
        float r4[4];
#pragma unroll
        for (int k = 0; k < 4; ++k) { const float send = bit0 ? d[k] : d[k + 4], keep = bit0 ? d[k + 4] : d[k]; r4[k] = keep + __shfl_xor(send, 1); }
        float r2[2];
#pragma unroll
        for (int k = 0; k < 2; ++k) { const float send = bit1 ? r4[k] : r4[k + 2], keep = bit1 ? r4[k + 2] : r4[k]; r2[k] = keep + __shfl_xor(send, 2); }
        float r1;
        { const float send = bit2 ? r2[0] : r2[1], keep = bit2 ? r2[1] : r2[0]; r1 = keep + __shfl_xor(send, 4); }
        r1 += __shfl_xor(r1, 8); r1 += __shfl_xor(r1, 16); r1 += __shfl_xor(r1, 32);
        const float dd = r1 * __shfl(susel, lb + myk);
        const float act = 0.5f * dd * (1.f + erff(dd * 0.70710678118654752f)) * __shfl(svsel, lb + myk);
#pragma unroll
        for (int k = 0; k < 8; k += 2) {
            const float a = __uint_as_float((unsigned)__builtin_amdgcn_readlane((int)__float_as_uint(act), ((k & 1) << 2) | (k & 2) | ((k >> 2) & 1)));
            const float b = __uint_as_float((unsigned)__builtin_amdgcn_readlane((int)__float_as_uint(act), (((k + 1) & 1) << 2) | ((k + 1) & 2) | (((k + 1) >> 2) & 1)));
            const f32x2 a2 = (f32x2){a, a}, b2 = (f32x2){b, b};
            const v32f_t f = __builtin_amdgcn_cvt_scalef32_pk32_f32_fp6((v6u_t){vw[k][0], vw[k][1], vw[k][2], vw[k + 1][0], vw[k + 1][1], vw[k + 1][2]}, 1.0f);
#pragma unroll
            for (int i = 0; i < 8; ++i) { y[i] += (f32x2){f[2 * i], f[2 * i + 1]} * a2; y[i] += (f32x2){f[16 + 2 * i], f[17 + 2 * i]} * b2; }
            __builtin_amdgcn_sched_barrier(0);
        }
    }
    float* orow = out + (size_t)t * DM + l16;
    float ss = 0.f;
    f32x4 o4[4];
#pragma unroll
    for (int i = 0; i < 4; ++i) { o4[i] = (f32x4){hx[2 * i][0] + y[2 * i][0], hx[2 * i][1] + y[2 * i][1], hx[2 * i + 1][0] + y[2 * i + 1][0], hx[2 * i + 1][1] + y[2 * i + 1][1]};
        ss += (o4[i][0] * o4[i][0] + o4[i][1] * o4[i][1]) + (o4[i][2] * o4[i][2] + o4[i][3] * o4[i][3]); }
    ss = wave_sum(ss);
    const float r = rsqrtf(ss * (1.f / DM) + NORM_EPS);
#pragma unroll
    for (int i = 0; i < 4; ++i) *(f32x4*)(orow + 4 * i) = o4[i] * r * *(const f32x4*)(fw + l16 + 4 * i);
}

__global__ void __launch_bounds__(NWAVES * 64, 2) mk_fwd(Args args) {
    extern __shared__ __attribute__((aligned(16))) unsigned char lds_raw[];
    LAS unsigned char* lds = (LAS unsigned char*)lds_raw;
    volatile LAS unsigned* MISC = (volatile LAS unsigned*)(lds + MISC_OFF);
    const int tid = threadIdx.x, lane = tid & 63, wave = __builtin_amdgcn_readfirstlane(tid >> 6);
    const int G = gridDim.x; const int bx = blockIdx.x; const int vcu = (G % 8 == 0) ? (bx % 8) * (G / 8) + bx / 8 : bx;
    unsigned char* ws = args.ws;
    unsigned* ctl = (unsigned*)(ws + WS_CTL);
    for (int u = tid; u < (LDS_BYTES - LDSCTL_OFF) / 4; u += NWAVES * 64) ((LAS unsigned*)(lds + LDSCTL_OFF))[u] = 0u;
    __syncthreads();
    XcdBarrier bar = xcd_barrier_post(ctl + CW_BAR + args.li * XCD_BAR_WORDS, MISC + 8);
    const int lo = args.ph_lo, hi = args.ph_hi;
#define IN(k) (lo <= (k) && (k) < hi)
#define BOTH(k) (IN(k) && IN((k) + 1))
    bf16_t* WinT = (bf16_t*)(ws + WS_WIN); bf16_t* PaT = (bf16_t*)(ws + WS_PA); bf16_t* PbT = (bf16_t*)(ws + WS_PB); bf16_t* WoT = (bf16_t*)(ws + WS_WO);
    bf16_t* WqT = (bf16_t*)(ws + WS_WQ); bf16_t* KeysB = (bf16_t*)(ws + WS_KEYS);
    float* rstd1 = (float*)(ws + WS_RSTD1); float* ssq2 = (float*)(ws + WS_RSTD2); float* scal = (float*)(ws + WS_SCAL);
    unsigned char* U8 = ws + WS_U; unsigned char* V8 = ws + WS_V; float* usc = (float*)(ws + WS_USC); float* vsc = (float*)(ws + WS_VSC);
    bf16_t* xb = (bf16_t*)(ws + WS_XB); bf16_t* ya = (bf16_t*)(ws + WS_YA); bf16_t* yb = (bf16_t*)(ws + WS_YB); bf16_t* x2b = (bf16_t*)(ws + WS_X2B);
    bf16_t* z = (bf16_t*)(ws + WS_Z); bf16_t* qb = (bf16_t*)(ws + WS_Q);
    bf16_t* merged = (bf16_t*)(ws + WS_MERGED);
    const int gw = vcu * NWAVES + wave, NGW = G * NWAVES;

    if (IN(0)) {
        LAS float* scr = (LAS float*)(lds + wave * 16384);
        constexpr int I_IN = (DM / 64) * (NZ / 32), I_PA = (512 / 64) * (DM / 32), I_WO = (DM / 64) * (DM / 32), I_WQ = (DM / 64) * (2048 / 32);
        constexpr int NITEMS = I_IN + 2 * I_PA + I_WO + I_WQ;
        for (int it = gw; it < NITEMS; it += NGW) {
            int r = it;
            if (r < I_IN) { p0_transpose_item(args.in[2], args.in[1], DM, NZ, WinT, scr, r, lane); continue; } r -= I_IN;
            if (r < I_PA) { p0_transpose_item(args.in[19], nullptr, 512, DM, PaT, scr, r, lane); continue; } r -= I_PA;
            if (r < I_PA) { p0_transpose_item(args.in[20], nullptr, 512, DM, PbT, scr, r, lane); continue; } r -= I_PA;
            if (r < I_WO) { p0_transpose_item(args.in[21], nullptr, DM, DM, WoT, scr, r, lane); continue; } r -= I_WO;
            p0_transpose_item(args.in[23], args.in[22], DM, 2048, WqT, scr, r, lane);
        }
        p0_convert(args.in[24], nullptr, KeysB, (size_t)16 * 128 * 128, gw, NGW, lane);
        for (int e = gw; e < 2 * NEXP; e += NGW) {
            const bool isu = e < NEXP; const int row = isu ? e : e - NEXP;
            p0_row_fp6((isu ? args.in[25] : args.in[26]) + (size_t)row * DM, isu ? args.in[22] : nullptr, (isu ? U8 : V8) + (size_t)row * 768, (isu ? usc : vsc) + row, lane);
        }
        for (int m = gw; m < T_TOK; m += NGW) {
            const f32x4* xr = (const f32x4*)(args.in[0] + (size_t)m * DM) + lane;
            f32x4 v[4]; float s = 0.f;
#pragma unroll
            for (int j = 0; j < 4; ++j) { v[j] = xr[64 * j]; s += (v[j][0] * v[j][0] + v[j][1] * v[j][1]) + (v[j][2] * v[j][2] + v[j][3] * v[j][3]); }
            s = wave_sum(s);
            v2u* o8 = (v2u*)(xb + (size_t)m * DM) + lane;
#pragma unroll
            for (int j = 0; j < 4; ++j) { v2u w; w.x = pg8::cvt_pk_bf16(v[j][0], v[j][1]); w.y = pg8::cvt_pk_bf16(v[j][2], v[j][3]); o8[64 * j] = w; }
            if (lane == 0) rstd1[m] = rsqrtf(s * (1.f / DM) + NORM_EPS);
        }
        if (gw == 0) {
            const float a = wave_sum(args.in[14][lane] * args.in[15][lane]), b = wave_sum(args.in[16][lane] * args.in[17][lane]);
            if (lane == 0) scal[0] = __expf(a) - __expf(b) + LAM_INIT;
        }
        if (BOTH(0)) xcd_barrier(bar);
    }
    if (IN(1)) {
        pg8::Gemm g{xb, WinT, DM, DM, DM}; pg8::StaticOrder S; S.init(T_TOK, NZ, G, bx);
        pg8::EpiRowScale<false> E{z, NZ, rstd1};
        for (int rep = 0; rep < REPS(1); ++rep) pg8::gemm_phase(lds, g, S, E);
        if (BOTH(1)) xcd_barrier(bar);
    }
    if (IN(2)) {
        {
            const rw::ScanP P{args.in[3], args.in[4], args.in[5], args.in[6], args.in[7], args.in[8], args.in[9], args.in[10], args.in[11], args.in[12], args.in[13]};
            for (int rep = 0; rep < REPS(2); ++rep) for (int u = vcu; u < NB * 8; u += G) rw::scan_unit(lds, z, ya, P, u >> 3, u & 7, tid, wave, lane);
        }
        const float lam = scal[0];
        __syncthreads();
        for (int i = 0;; ++i) {
            int idx = vcu + i * G; if (idx >= 2048 * REPS(10)) break;
            idx &= 2047;
            const int slot = idx >> 8, v = idx & 255, bh = v >> 1, a = (v & 1) * 4 + (slot >> 1), qblk = (slot & 1) ? 15 - a : a;
            da::attn_unit(lds, z, yb, args.in[18], lam, bh >> 2, bh & 3, qblk, wave, lane);
        }
        if (BOTH(2)) xcd_barrier(bar);
    }
    if (IN(3)) {
        pg8::Gemm g{ya, PaT, 512, 512, 512}; pg8::StaticOrder S; S.init(T_TOK, DM, G, bx);
        pg8::EpiGate<false> E{merged, z, C_GA};
        pg8::gemm_phase(lds, g, S, E);
        if (BOTH(3)) xcd_barrier(bar);
    }
    if (IN(4)) {
        pg8::Gemm g{yb, PbT, 512, 512, 512}; pg8::StaticOrder S; S.init(T_TOK, DM, G, bx);
        pg8::EpiGate<true> E{merged, z, C_GB};
        pg8::gemm_phase(lds, g, S, E);
        if (BOTH(4)) xcd_barrier(bar);
    }
    if (IN(5)) {
        pg8::Gemm g{merged, WoT, DM, DM, DM}; pg8::StaticOrder S; S.init(T_TOK, DM, G, bx);
        pg8::EpiX2 E{args.in[0], args.out, x2b, ssq2};
        pg8::gemm_phase(lds, g, S, E);
        if (BOTH(5)) xcd_barrier(bar);
    }
    if (IN(6)) {
        pg8::Gemm g{x2b, WqT, DM, DM, DM}; pg8::StaticOrder S; S.init(T_TOK, 2048, G, bx);
        pg8::EpiRowScale<true> E{qb, 2048, ssq2};
        for (int rep = 0; rep < REPS(6); ++rep) pg8::gemm_phase(lds, g, S, E);
        if (BOTH(6)) xcd_barrier(bar);
    }
    if (IN(7)) {
        int* ids = (int*)(ws + WS_IDS); float* gates = (float*)(ws + WS_GATES);
        for (int rep = 0; rep < REPS(7); ++rep)
        for (int h = 0; h < 8; ++h) {
            __syncthreads();
            {
                const bf16_t* ksrc = KeysB + (size_t)h * 2 * 128 * 128;
#pragma unroll
                for (int i = 0; i < 8; ++i) { const int chunk = tid + i * 512, row = chunk >> 4, cc = chunk & 15;
                    *(LAS v4u*)(lds + (row >> 7) * TK_HALF + (row & 127) * TK_PITCH + cc * 16) = *(const v4u*)(ksrc + (size_t)row * 128 + cc * 8); }
            }
            __syncthreads();
            for (int tile = gw; tile < 4096; tile += NGW) {
                tk_bf16x8 qa[8];
                topk_loadq(qa, qb, tile * 16, h, lane);
                topk_item(qa, lds, ids, gates, tile * 16, h, lane);
            }
        }
        if (BOTH(7)) xcd_barrier(bar);
    }
    if (IN(8)) {
        const int* ids = (const int*)(ws + WS_IDS); const float* gates = (const float*)(ws + WS_GATES);
        for (int t = gw; t < T_TOK; t += NGW) peer_token(x2b, ssq2, ids, gates, U8, V8, usc, vsc, args.in[27], args.out, t, lane);
    }
#undef IN
#undef BOTH
}

extern "C" void kernel_launch(void* const* d_in, const int* in_sizes, int n_in, void* d_out, int out_size, void* d_ws, size_t ws_size, hipStream_t stream) {
    static int grid = 0;
    if (grid == 0) {
        if (n_in != 28 || in_sizes[0] != T_TOK * DM || out_size != T_TOK * DM || ws_size < WS_END) {
            fprintf(stderr, "kernel_launch: unexpected shapes / workspace (n_in %d, ws %zu < %zu)\n", n_in, ws_size, (size_t)WS_END); grid = -1; return; }
        int dev = 0, cus = 0;
        if (hipGetDevice(&dev) != hipSuccess || hipDeviceGetAttribute(&cus, hipDeviceAttributeMultiprocessorCount, dev) != hipSuccess) { grid = -1; return; }
        if (hipFuncSetAttribute((const void*)mk_fwd, hipFuncAttributeMaxDynamicSharedMemorySize, LDS_BYTES) != hipSuccess) { fprintf(stderr, "kernel_launch: hipFuncSetAttribute failed\n"); grid = -1; return; }
        grid = cus;
    }
    if (grid < 0) return;
    unsigned char* ws = (unsigned char*)d_ws;
    float* out = (float*)d_out;
    (void)hipMemsetAsync(ws + WS_CTL, 0, 1 * MiB, stream);
    Args a{};
    for (int i = 0; i < 28; ++i) a.in[i] = (const float*)d_in[i];
    a.out = out; a.ws = ws;
    a.ph_lo = 0; a.ph_hi = 9; a.li = 0;
    hipLaunchKernelGGL(mk_fwd, dim3(grid), dim3(NWAVES * 64), LDS_BYTES, stream, a);
}
```

```cpp
#include <hip/hip_runtime.h>
#include <stdint.h>
#include <cstdio>

typedef unsigned short bf16_t;
typedef unsigned int u32;

#ifndef PROBE_REP
#define PROBE_REP 0
#endif
#define REPS(k) (((PROBE_REP >> (k)) & 1) ? 2 : 1)
constexpr int T_TOK = 65536, DM = 1024, SEQ = 2048, NB = 32;
constexpr int NZ = 5376;
constexpr int C_R = 0, C_K = 512, C_V = 1024, C_WL = 1536, C_AL = 1600, C_GL = 1664, C_Q = 1792, C_ZK = 2304, C_ZV = 2816, C_GA = 3328, C_GB = 4352;
constexpr int NEXP = 16384;
constexpr float NORM_EPS = 1e-6f, GN_EPS = 64e-5f, SUBLN_EPS = 1e-5f;
constexpr float LAM_INIT = 0.2f;

constexpr size_t MiB = 1u << 20;
constexpr size_t WS_CTL = 0;
constexpr size_t WS_WIN = 1 * MiB;
constexpr size_t WS_PA = 12 * MiB;
constexpr size_t WS_PB = 13 * MiB;
constexpr size_t WS_WO = 14 * MiB;
constexpr size_t WS_WQ = 16 * MiB;
constexpr size_t WS_KEYS = 20 * MiB;
constexpr size_t WS_RSTD1 = 21 * MiB;
constexpr size_t WS_RSTD2 = 58 * MiB;
constexpr size_t WS_SCAL = 23 * MiB;
constexpr size_t WS_U = 24 * MiB;
constexpr size_t WS_V = 40 * MiB;
constexpr size_t WS_USC = 56 * MiB;
constexpr size_t WS_VSC = 57 * MiB;
constexpr size_t WS_XB = 88 * MiB;
constexpr size_t WS_YA = WS_XB;
constexpr size_t WS_YB = WS_XB + 64 * MiB;
constexpr size_t WS_X2B = WS_XB;
constexpr size_t WS_Z = 216 * MiB;
constexpr size_t WS_Q = WS_Z;
constexpr size_t WS_IDS = WS_Z + 256 * MiB;
constexpr size_t WS_GATES = WS_Z + 288 * MiB;
constexpr size_t WS_MERGED = 888 * MiB;
constexpr size_t WS_END = 1016 * MiB;

__device__ __forceinline__ float bf2f(bf16_t h) { return __uint_as_float(((u32)h) << 16); }
__device__ __forceinline__ bf16_t f2bf(float f) { u32 u = __float_as_uint(f); u += 0x7fffu + ((u >> 16) & 1u); return (bf16_t)(u >> 16); }
__device__ __forceinline__ float wave_sum(float v) {
#pragma unroll
    for (int o = 1; o < 64; o <<= 1) v += __shfl_xor(v, o);
    return v;
}
__device__ __forceinline__ float sigmoidf_(float x) { return 1.f / (1.f + __expf(-x)); }

namespace pg8 {
#define PG8_LAS __attribute__((address_space(3)))
typedef short bf16x8 __attribute__((ext_vector_type(8)));
typedef float f32x4 __attribute__((ext_vector_type(4)));
typedef unsigned u32x4 __attribute__((ext_vector_type(4)));
constexpr int BM = 256, BK = 64, HALF = 128, HTB = HALF * BK * 2  , STAGE_BYTES = 8 * HTB, NXCD = 8, WGM = 8;

__host__ __device__ __forceinline__ int lds_byte(int r, int c) { const int st = (r >> 4) * 2 + (c >> 5), rr = r & 15, cc = c & 31, ob = rr * 64 + cc * 2; return st * 1024 + (ob ^ (((ob >> 9) & 1) << 5)); }
__host__ __device__ __forceinline__ void stage_rc(int b, int& R, int& C) { const int st = b / 1024, sb = b % 1024, swz = sb ^ (((sb >> 9) & 1) << 5); R = (st >> 1) * 16 + swz / 64; C = (st & 1) * 32 + (swz % 64) / 2; }
__host__ __device__ __forceinline__ int perm32(int rho) { const int n = rho >> 4, i = rho & 15; return 8 * (i >> 2) + 4 * n + (i & 3); }

struct Unit { int pm, pn; };
struct Gemm { const bf16_t* A; const bf16_t* Bt; int lda, ldb, K; };

struct StaticOrder {
    int nM, nN, nwg, G, c;
    __host__ __device__ void init(int M, int N, int G_, int c_) { nM = M / BM; nN = N / BM; nwg = nM * nN; G = G_; c = c_; }
    __host__ __device__ bool next(int i, Unit& u) const {
        const long L = (long)i * G + c; if (L >= nwg) return false;
        int wgid = (int)L; { const int q = nwg / NXCD, r = nwg % NXCD, xcd = wgid % NXCD, off = wgid / NXCD; wgid = (xcd < r ? xcd * (q + 1) : r * (q + 1) + (xcd - r) * q) + off; }
        const int nig = WGM * nN, gid = wgid / nig, fm = gid * WGM, gsz = (nM - fm) < WGM ? (nM - fm) : WGM;
        u.pm = fm + ((wgid % nig) % gsz); u.pn = (wgid % nig) / gsz; return true;
    }
};
typedef float f32x2_c __attribute__((ext_vector_type(2))); typedef __bf16 bf16x2_c __attribute__((ext_vector_type(2)));
__device__ __forceinline__ unsigned cvt_pk_bf16(float lo, float hi) { const f32x2_c v = {lo, hi}; const bf16x2_c b = __builtin_convertvector(v, bf16x2_c); return __builtin_bit_cast(unsigned, b); }
__device__ __forceinline__ float bflo(unsigned w) { return __uint_as_float(w << 16); }
__device__ __forceinline__ float bfhi(unsigned w) { return __uint_as_float(w & 0xffff0000u); }

__device__ __forceinline__ float ssq_sum16(const float* p) {
    const f32x4 a = *(const f32x4*)p, b = *(const f32x4*)(p + 4), c = *(const f32x4*)(p + 8), d = *(const f32x4*)(p + 12);
    return (((a[0] + a[1]) + (a[2] + a[3])) + ((b[0] + b[1]) + (b[2] + b[3]))) + (((c[0] + c[1]) + (c[2] + c[3])) + ((d[0] + d[1]) + (d[2] + d[3])));
}
template <bool SSQ> struct EpiRowScale {
    static constexpr bool PERM = true;
    bf16_t* O; int ldc; const float* rs;
    __device__ __forceinline__ void operator()(const f32x4 (&acc)[2][2][4][2], const Unit& u, int wr, int wc, int fr, int fq) const {
        const int row0 = u.pm * BM + wr * 64 + fr, col0 = u.pn * BM + wc * 32 + 8 * fq;
#pragma unroll
        for (int ai = 0; ai < 2; ++ai)
#pragma unroll
            for (int m = 0; m < 4; ++m) {
                const int row = row0 + ai * HALF + m * 16;
                float s; if (SSQ) s = rsqrtf(ssq_sum16(rs + (size_t)row * 16) * (1.f / 1024.f) + NORM_EPS); else s = rs[row];
                bf16_t* rowp = O + (size_t)row * ldc + col0;
#pragma unroll
                for (int bj = 0; bj < 2; ++bj) {
                    const f32x4 v0 = acc[ai][bj][m][0] * s, v1 = acc[ai][bj][m][1] * s;
                    u32x4 w; w.x = cvt_pk_bf16(v0[0], v0[1]); w.y = cvt_pk_bf16(v0[2], v0[3]); w.z = cvt_pk_bf16(v1[0], v1[1]); w.w = cvt_pk_bf16(v1[2], v1[3]);
                    *(u32x4*)(rowp + bj * HALF) = w;
                }
            }
    }
};
template <bool ACCUM> struct EpiGate {
    static constexpr bool PERM = true;
    bf16_t* mg; const bf16_t* z; int gcol;
    __device__ __forceinline__ void operator()(const f32x4 (&acc)[2][2][4][2], const Unit& u, int wr, int wc, int fr, int fq) const {
        const int row0 = u.pm * BM + wr * 64 + fr, col0 = u.pn * BM + wc * 32 + 8 * fq;
#pragma unroll
        for (int ai = 0; ai < 2; ++ai)
#pragma unroll
            for (int m = 0; m < 4; ++m) {
                const int row = row0 + ai * HALF + m * 16;
                const bf16_t* gp = z + (size_t)row * NZ + gcol + col0;
                bf16_t* rowp = mg + (size_t)row * DM + col0;
#pragma unroll
                for (int bj = 0; bj < 2; ++bj) {
                    const u32x4 g = *(const u32x4*)(gp + bj * HALF);
                    const f32x4 a0 = acc[ai][bj][m][0], a1 = acc[ai][bj][m][1];
                    float r[8];
                    r[0] = sigmoidf_(bflo(g.x)) * a0[0]; r[1] = sigmoidf_(bfhi(g.x)) * a0[1]; r[2] = sigmoidf_(bflo(g.y)) * a0[2]; r[3] = sigmoidf_(bfhi(g.y)) * a0[3];
                    r[4] = sigmoidf_(bflo(g.z)) * a1[0]; r[5] = sigmoidf_(bfhi(g.z)) * a1[1]; r[6] = sigmoidf_(bflo(g.w)) * a1[2]; r[7] = sigmoidf_(bfhi(g.w)) * a1[3];
                    if (ACCUM) { const u32x4 o = *(const u32x4*)(rowp + bj * HALF);
                        r[0] += bflo(o.x); r[1] += bfhi(o.x); r[2] += bflo(o.y); r[3] += bfhi(o.y); r[4] += bflo(o.z); r[5] += bfhi(o.z); r[6] += bflo(o.w); r[7] += bfhi(o.w); }
                    u32x4 w; w.x = cvt_pk_bf16(r[0], r[1]); w.y = cvt_pk_bf16(r[2], r[3]); w.z = cvt_pk_bf16(r[4], r[5]); w.w = cvt_pk_bf16(r[6], r[7]);
                    *(u32x4*)(rowp + bj * HALF) = w;
                }
            }
    }
};
struct EpiX2 {
    static constexpr bool PERM = true;
    const float* x; float* x2; bf16_t* x2b; float* ssq;
    __device__ __forceinline__ void operator()(const f32x4 (&acc)[2][2][4][2], const Unit& u, int wr, int wc, int fr, int fq) const {
        const int row0 = u.pm * BM + wr * 64 + fr, col0 = u.pn * BM + wc * 32 + 8 * fq;
#pragma unroll
        for (int ai = 0; ai < 2; ++ai)
#pragma unroll
            for (int m = 0; m < 4; ++m) {
                const int row = row0 + ai * HALF + m * 16;
                const size_t off = (size_t)row * DM + col0;
                float ss = 0.f;
#pragma unroll
                for (int bj = 0; bj < 2; ++bj) {
                    const f32x4 x0 = *(const f32x4*)(x + off + bj * HALF), x1 = *(const f32x4*)(x + off + bj * HALF + 4);
                    const f32x4 o0 = x0 + acc[ai][bj][m][0], o1 = x1 + acc[ai][bj][m][1];
                    u32x4 w; w.x = cvt_pk_bf16(o0[0], o0[1]); w.y = cvt_pk_bf16(o0[2], o0[3]); w.z = cvt_pk_bf16(o1[0], o1[1]); w.w = cvt_pk_bf16(o1[2], o1[3]);
                    *(u32x4*)(x2b + off + bj * HALF) = w;
                    ss += (o0[0] * o0[0] + o0[1] * o0[1]) + (o0[2] * o0[2] + o0[3] * o0[3]) + (o1[0] * o1[0] + o1[1] * o1[1]) + (o1[2] * o1[2] + o1[3] * o1[3]);
                }
                ss += __shfl_xor(ss, 16); ss += __shfl_xor(ss, 32);
                if (fq == 0) ssq[(size_t)row * 16 + (u.pn & 3) * 4 + wc] = ss;
            }
    }
};

template <class Epi, class Sched>
__device__ __forceinline__ void gemm_phase(PG8_LAS unsigned char* lds, const Gemm g, const Sched& S, const Epi& E) {
    const int tid = threadIdx.x, wid = __builtin_amdgcn_readfirstlane(tid >> 6), lane = tid & 63, wr = wid >> 2, wc = wid & 3, fr = lane & 15, fq = lane >> 4;
    const int K = g.K, nt = K / BK;
    unsigned voffA[2], voffB[2];
#pragma unroll
    for (int i = 0; i < 2; ++i) { int R, C; stage_rc(tid * 16 + i * 8192, R, C); const int Rb = Epi::PERM ? ((R & ~31) + perm32(R & 31)) : R;
        voffA[i] = (unsigned)(R * g.lda + C) * 2u; voffB[i] = (unsigned)(Rb * g.ldb + C) * 2u; }
    const size_t kstep = (size_t)(BK * 2);
    const size_t hstepA = (size_t)HALF * g.lda * 2, hstepB = (size_t)HALF * g.ldb * 2;
    const size_t tstepA = 2 * hstepA, tstepB = 2 * hstepB;
    const unsigned ldsw = (unsigned)wid * 1024u;
    const int aoff = lds_byte(wr * 64 + fr, fq * 8), boff = lds_byte(wc * 32 + fr, fq * 8);
#define PG8_SA(b, h) (((b) * 2 + (h)) * HTB)
#define PG8_SB(b, h) ((4 + (b) * 2 + (h)) * HTB)
#define PG8_STAGE(bufoff, gbase, voff) do { _Pragma("unroll") for (int _i = 0; _i < 2; ++_i) \
        __builtin_amdgcn_global_load_lds((const unsigned*)((const char*)(gbase) + (voff)[_i]), (PG8_LAS unsigned*)(lds + (bufoff) + ldsw + _i * 8192), 16, 0, 0); } while (0)
#define PG8_LDA(dst, b, h) do { _Pragma("unroll") for (int m = 0; m < 4; ++m) _Pragma("unroll") for (int k = 0; k < 2; ++k) dst[m][k] = *(const PG8_LAS bf16x8*)(lds + PG8_SA(b, h) + aoff + m * 2048 + k * 1024); } while (0)
#define PG8_LDB(dst, b, h) do { _Pragma("unroll") for (int n = 0; n < 2; ++n) _Pragma("unroll") for (int k = 0; k < 2; ++k) dst[n][k] = *(const PG8_LAS bf16x8*)(lds + PG8_SB(b, h) + boff + n * 2048 + k * 1024); } while (0)
#define PG8_MMA(ai, bj, At, Bt) do { __builtin_amdgcn_s_setprio(1); _Pragma("unroll") for (int m = 0; m < 4; ++m) _Pragma("unroll") for (int n = 0; n < 2; ++n) _Pragma("unroll") for (int k = 0; k < 2; ++k) \
        acc[ai][bj][m][n] = __builtin_amdgcn_mfma_f32_16x16x32_bf16(Bt[n][k], At[m][k], acc[ai][bj][m][n], 0, 0, 0); __builtin_amdgcn_s_setprio(0); } while (0)
#define PG8_WAIT_V(n) asm volatile("s_waitcnt vmcnt(" #n ")" ::: "memory")
#define PG8_WAIT_L(n) asm volatile("s_waitcnt lgkmcnt(" #n ")" ::: "memory")
#define PG8_BAR __builtin_amdgcn_s_barrier()
#define PG8_SCHED __builtin_amdgcn_sched_barrier(0)
    Unit cur, nxt; int ui = 0;
    if (!S.next(0, cur)) return;
    f32x4 acc[2][2][4][2];
#pragma unroll
    for (int a = 0; a < 2; ++a)
#pragma unroll
        for (int b = 0; b < 2; ++b)
#pragma unroll
            for (int m = 0; m < 4; ++m)
#pragma unroll
                for (int n = 0; n < 2; ++n) acc[a][b][m][n] = (f32x4){0.f, 0.f, 0.f, 0.f};
    bf16x8 At[4][2], B0[2][2], B1[2][2];
    const char* cA = (const char*)g.A + (size_t)cur.pm * tstepA; const char* cB = (const char*)g.Bt + (size_t)cur.pn * tstepB;
    PG8_STAGE(PG8_SB(0, 0), cB, voffB); PG8_STAGE(PG8_SB(0, 1), cB + hstepB, voffB); PG8_STAGE(PG8_SA(0, 0), cA, voffA); PG8_STAGE(PG8_SA(0, 1), cA + hstepA, voffA);
    if (wr == 1) PG8_BAR;
    PG8_WAIT_V(2); PG8_BAR;
    PG8_STAGE(PG8_SB(1, 0), cB + kstep, voffB); PG8_STAGE(PG8_SA(1, 0), cA + kstep, voffA); PG8_STAGE(PG8_SB(1, 1), cB + hstepB + kstep, voffB);
    PG8_WAIT_V(6); PG8_BAR;
    for (;;) {
        const bool has_next = S.next(ui + 1, nxt);
        const char* nA = has_next ? (const char*)g.A + (size_t)nxt.pm * tstepA : cA; const char* nB = has_next ? (const char*)g.Bt + (size_t)nxt.pn * tstepB : cB;
        for (int t = 0; t < nt; t += 2) {
            const bool last = (t == nt - 2);
            const char* a1 = cA + (size_t)(t + 1) * kstep;
            const char* a2 = last ? nA : cA + (size_t)(t + 2) * kstep; const char* b2 = last ? nB : cB + (size_t)(t + 2) * kstep;
            const char* a3 = a2 + kstep; const char* b3 = b2 + kstep;
            PG8_LDB(B0, 0, 0); PG8_LDB(B1, 0, 1); PG8_SCHED; PG8_LDA(At, 0, 0); PG8_STAGE(PG8_SA(1, 1), a1 + hstepA, voffA);
            PG8_WAIT_V(8); PG8_WAIT_L(0); PG8_BAR; PG8_MMA(0, 0, At, B0); PG8_MMA(0, 1, At, B1); PG8_BAR; PG8_SCHED;
            PG8_LDA(At, 0, 1); PG8_STAGE(PG8_SB(0, 0), b2, voffB); PG8_STAGE(PG8_SB(0, 1), b2 + hstepB, voffB); PG8_STAGE(PG8_SA(0, 0), a2, voffA);
            PG8_WAIT_V(8); PG8_WAIT_L(0); PG8_BAR; PG8_MMA(1, 0, At, B0); PG8_MMA(1, 1, At, B1); PG8_BAR; PG8_SCHED;
            PG8_LDB(B0, 1, 0); PG8_LDB(B1, 1, 1); PG8_SCHED; PG8_LDA(At, 1, 0); PG8_STAGE(PG8_SA(0, 1), a2 + hstepA, voffA);
            PG8_WAIT_V(8); PG8_WAIT_L(0); PG8_BAR; PG8_MMA(0, 0, At, B0); PG8_MMA(0, 1, At, B1); PG8_BAR; PG8_SCHED;
            PG8_LDA(At, 1, 1); PG8_STAGE(PG8_SB(1, 0), b3, voffB); PG8_STAGE(PG8_SB(1, 1), b3 + hstepB, voffB); PG8_STAGE(PG8_SA(1, 0), a3, voffA);
            PG8_WAIT_V(8); PG8_WAIT_L(0); PG8_BAR; PG8_MMA(1, 0, At, B0); PG8_MMA(1, 1, At, B1); PG8_BAR; PG8_SCHED;
        }
        if (wr == 0) PG8_BAR;
        E(acc, cur, wr, wc, fr, fq);
        if (!has_next) break;
#pragma unroll
        for (int a = 0; a < 2; ++a)
#pragma unroll
            for (int b = 0; b < 2; ++b)
#pragma unroll
                for (int m = 0; m < 4; ++m)
#pragma unroll
                    for (int n = 0; n < 2; ++n) acc[a][b][m][n] = (f32x4){0.f, 0.f, 0.f, 0.f};
        cur = nxt; cA = nA; cB = nB; ++ui;
        if (wr == 1) PG8_BAR;
    }
    PG8_WAIT_V(0);
    PG8_BAR;
#undef PG8_SA
#undef PG8_SB
#undef PG8_STAGE
#undef PG8_LDA
#undef PG8_LDB
#undef PG8_MMA
#undef PG8_WAIT_V
#undef PG8_WAIT_L
#undef PG8_BAR
#undef PG8_SCHED
}
}

constexpr int NWAVES = 8;
constexpr int LDS_RING_BYTES = 131072, LDSCTL_OFF = 143360, MISC_OFF = LDSCTL_OFF + 320, LDS_BYTES = 147456;
#define LAS __attribute__((address_space(3)))
#define GAS __attribute__((address_space(1)))
typedef float f32x4 __attribute__((ext_vector_type(4)));
typedef unsigned v4u __attribute__((ext_vector_type(4)));
typedef unsigned v2u __attribute__((ext_vector_type(2)));
#define LDS_WAIT() asm volatile("s_waitcnt lgkmcnt(0)" ::: "memory")

constexpr int CW_BAR = 4096;
#define XB_TMO      128
#define XB_XCNT(j)  (256  + 64 * (j))
#define XB_XSUB(j)  (1280 + 64 * (j))
#define XB_XGEN(j)  (2304 + 64 * (j))
#define XB_TOP      3328
#define XB_TOPGEN   3392
#define XCD_BAR_WORDS 3456
#define XB_SPIN_CAP (1u << 20)
__device__ __forceinline__ unsigned xb_ld(unsigned* p)              { return __hip_atomic_load(p, __ATOMIC_RELAXED, __HIP_MEMORY_SCOPE_AGENT); }
__device__ __forceinline__ unsigned xb_add(unsigned* p, unsigned v) { return __hip_atomic_fetch_add(p, v, __ATOMIC_RELAXED, __HIP_MEMORY_SCOPE_AGENT); }
__device__ __forceinline__ unsigned xb_xcc_id() { return (unsigned)__builtin_amdgcn_s_getreg((3 << 11) | 20) & 0xFu; }
#define XB_SPIN(cond, bar) do { unsigned _sp = 0; while (cond) { __builtin_amdgcn_s_sleep(1); \
    if ((++_sp & 255u) == 0u) { if (xb_ld(&(bar)[XB_TMO])) break; if (_sp > XB_SPIN_CAP) { atomicAdd(&(bar)[XB_TMO], 1u); break; } } } } while (0)
struct XcdBarrier { unsigned* bar; unsigned x; volatile LAS unsigned* st; };
__device__ __forceinline__ XcdBarrier xcd_barrier_post(unsigned* bar, volatile LAS unsigned* st) {
    XcdBarrier b; b.bar = bar; b.x = xb_xcc_id(); b.st = st;
    if (threadIdx.x == 0) (void)xb_add(&bar[XB_XCNT(b.x)], 1u);
    return b;
}
__device__ __forceinline__ void xcd_barrier_complete(unsigned* bar, unsigned x, unsigned& nloc, unsigned& nx) {
    const unsigned G = gridDim.x * gridDim.y * gridDim.z;
    unsigned sum, cnt, mine, sp = 0u;
    for (;;) {
        sum = 0u; cnt = 0u; mine = 0u;
#pragma unroll
        for (unsigned j = 0; j < 16; ++j) { const unsigned c = xb_ld(&bar[XB_XCNT(j)]); sum += c; cnt += (c > 0u) ? 1u : 0u; mine = (j == x) ? c : mine; }
        if (sum == G) break;
        __builtin_amdgcn_s_sleep(1);
        if ((++sp & 255u) == 0u) { if (xb_ld(&bar[XB_TMO])) break; if (sp > XB_SPIN_CAP) { atomicAdd(&bar[XB_TMO], 1u); break; } }
    }
    nloc = mine > 0u ? mine : 1u; nx = cnt > 0u ? cnt : 1u;
}
__device__ __forceinline__ void xcd_barrier(const XcdBarrier& b) {
    asm volatile("s_waitcnt vmcnt(0)" ::: "memory");
    __syncthreads();
    if (threadIdx.x == 0) {
        unsigned* bar = b.bar;
        __builtin_amdgcn_s_waitcnt(0);
        unsigned nloc = b.st[0], nx = b.st[1];
        if (nloc == 0u) { xcd_barrier_complete(bar, b.x, nloc, nx); b.st[0] = nloc; b.st[1] = nx; }
        const unsigned old = xb_add(&bar[XB_XSUB(b.x)], 1u);
        const unsigned gen = old / nloc;
        if (old + 1u == (gen + 1u) * nloc) {
            __builtin_amdgcn_fence(__ATOMIC_RELEASE, "agent");
            asm volatile("s_waitcnt vmcnt(0)" ::: "memory");
            const unsigned og = xb_add(&bar[XB_TOP], 1u);
            const unsigned tg = og / nx;
            if (og + 1u == (tg + 1u) * nx) xb_add(&bar[XB_TOPGEN], 1u);
            else XB_SPIN(xb_ld(&bar[XB_TOPGEN]) == tg, bar);
            __builtin_amdgcn_fence(__ATOMIC_ACQUIRE, "agent");
            xb_add(&bar[XB_XGEN(b.x)], 1u);
            asm volatile("s_waitcnt vmcnt(0)" ::: "memory");
        } else {
            XB_SPIN(xb_ld(&bar[XB_XGEN(b.x)]) == gen, bar);
            __builtin_amdgcn_fence(__ATOMIC_ACQUIRE, "agent");
            asm volatile("s_waitcnt vmcnt(0)" ::: "memory");
        }
    }
    __syncthreads();
}

struct Args { const float* in[28]; float* out; unsigned char* ws; int ph_lo, ph_hi, li, pad; };

__device__ __forceinline__ void p0_transpose_item(const float* W, const float* sc, int K, int N, bf16_t* WT, LAS float* scr, int item, int lane) {
    const int nblk = N / 32, kb = item / nblk, nb = item % nblk, k0 = 64 * kb, n0 = 32 * nb;
#pragma unroll 8
    for (int i = 0; i < 32; ++i) { const int kk = 2 * i + (lane >> 5); const float s = sc ? sc[k0 + kk] : 1.f; scr[kk * 33 + (lane & 31)] = W[(size_t)(k0 + kk) * N + n0 + (lane & 31)] * s; }
    LDS_WAIT(); asm volatile("" ::: "memory");
    const int c = lane & 7;
#pragma unroll
    for (int j = 0; j < 4; ++j) { const int n = (lane >> 3) + 8 * j; const LAS float* s = scr + (8 * c) * 33 + n;
        v4u o; o.x = pg8::cvt_pk_bf16(s[0 * 33], s[1 * 33]); o.y = pg8::cvt_pk_bf16(s[2 * 33], s[3 * 33]); o.z = pg8::cvt_pk_bf16(s[4 * 33], s[5 * 33]); o.w = pg8::cvt_pk_bf16(s[6 * 33], s[7 * 33]);
        *(v4u*)(WT + (size_t)(n0 + n) * K + k0 + 8 * c) = o; }
    LDS_WAIT(); asm volatile("" ::: "memory");
}
typedef unsigned v6u_t __attribute__((ext_vector_type(6)));
typedef unsigned v3u_t __attribute__((ext_vector_type(3)));
typedef float v16f_t __attribute__((ext_vector_type(16)));
typedef float v32f_t __attribute__((ext_vector_type(32)));
__device__ __forceinline__ void p0_row_fp6(const float* in, const float* cs, unsigned char* out, float* sc, int lane) {
    f32x4 v[4]; float mx = 0.f;
#pragma unroll
    for (int i = 0; i < 4; ++i) { v[i] = *(const f32x4*)(in + lane * 16 + 4 * i); if (cs) v[i] = v[i] * *(const f32x4*)(cs + lane * 16 + 4 * i);
        mx = fmaxf(mx, fmaxf(fmaxf(fabsf(v[i][0]), fabsf(v[i][1])), fmaxf(fabsf(v[i][2]), fabsf(v[i][3])))); }
#pragma unroll
    for (int o = 1; o < 64; o <<= 1) mx = fmaxf(mx, __shfl_xor(mx, o));
    mx = fmaxf(mx, 1e-30f);
    const float q = 7.5f / mx;
    v16f_t a, b;
#pragma unroll
    for (int i = 0; i < 16; ++i) { a[i] = 0.f; b[i] = 0.f; }
#pragma unroll
    for (int i = 0; i < 8; ++i) { a[i] = v[(2 * i) >> 2][(2 * i) & 3] * q; b[i] = v[(2 * i + 1) >> 2][(2 * i + 1) & 3] * q; }
    const v6u_t p = __builtin_amdgcn_cvt_scalef32_2xpk16_fp6_f32(a, b, 1.0f);
    *(v3u_t*)(out + lane * 12) = (v3u_t){p[0], p[1], p[2]};
    if (lane == 0) *sc = mx * (1.f / 7.5f);
}
__device__ __forceinline__ void p0_convert(const float* in, const float* cs, bf16_t* out, size_t n, int gw, int NGW, int lane) {
    for (size_t i = ((size_t)gw * 64 + lane) * 8; i < n; i += (size_t)NGW * 512) {
        f32x4 a = *(const f32x4*)(in + i), b = *(const f32x4*)(in + i + 4);
        if (cs) { const int c = (int)(i & 1023); a = a * *(const f32x4*)(cs + c); b = b * *(const f32x4*)(cs + c + 4); }
        v4u o; o.x = pg8::cvt_pk_bf16(a[0], a[1]); o.y = pg8::cvt_pk_bf16(a[2], a[3]); o.z = pg8::cvt_pk_bf16(b[0], b[1]); o.w = pg8::cvt_pk_bf16(b[2], b[3]);
        *(v4u*)(out + i) = o;
    }
}

namespace da {
typedef short bf16x8 __attribute__((ext_vector_type(8)));
typedef short s16x4 __attribute__((ext_vector_type(4)));
typedef float f32x16 __attribute__((ext_vector_type(16)));
typedef const LAS unsigned char* lcp;
constexpr float LOG2E = 1.4426950408889634f, C2 = 0.125f * LOG2E, THR = 8.f;
constexpr int RSLOT = 16384, LDS_KR = 0, LDS_VR = 4 * RSLOT, SCR_OFF = 8 * RSLOT, COMB_OFF = 0;
#define DA_SBAR() __builtin_amdgcn_sched_barrier(0)
#define DA_PIN(x) asm volatile("" : "+v"(x))
#define DA_MFMA(a, b, c) __builtin_amdgcn_mfma_f32_32x32x16_bf16(a, b, c, 0, 0, 0)
#define DA_WAIT_BAR(N) asm volatile("s_waitcnt vmcnt(" #N ") lgkmcnt(0)\n\ts_barrier" ::: "memory")
#define DA_MX3(a, b, c) __builtin_fmaxf(__builtin_fmaxf((a), (b)), (c))
__device__ __forceinline__ int crow(int r, int hi) { return (r & 3) + 8 * (r >> 2) + 4 * hi; }
__device__ __forceinline__ s16x4 vtr(lcp p) { return __builtin_bit_cast(s16x4, __builtin_amdgcn_ds_read_tr16_b64_v4i16((LAS s16x4*)p)); }
__device__ __forceinline__ unsigned cvtpk(float lo, float hi) { unsigned r; asm("v_cvt_pk_bf16_f32 %0, %1, %2" : "=v"(r) : "v"(lo), "v"(hi)); return r; }
__device__ __forceinline__ void glds16(const void* g, unsigned lds_base) {
    unsigned sv; asm volatile("s_mov_b32 %0, m0\n\ts_mov_b32 m0, %2\n\ts_nop 0\n\tglobal_load_lds_dwordx4 %1, off\n\ts_mov_b32 m0, %0" : "=&s"(sv) : "v"(g), "s"(lds_base) : "memory"); }
__device__ __forceinline__ void glds16_o128(const void* g, unsigned lds_base) {
    unsigned sv; asm volatile("s_mov_b32 %0, m0\n\ts_mov_b32 m0, %2\n\ts_nop 0\n\tglobal_load_lds_dwordx4 %1, off offset:128\n\ts_mov_b32 m0, %0" : "=&s"(sv) : "v"(g), "s"(lds_base) : "memory"); }
__device__ __forceinline__ void kload2(bf16x8* kf, lcp kp, int d0) { kf[2 * d0] = *(const LAS bf16x8*)(kp + d0 * 2048); kf[2 * d0 + 1] = *(const LAS bf16x8*)(kp + d0 * 2048 + 512); }
__device__ __forceinline__ float max16(const f32x16& p) {
    float a = DA_MX3(p[0], p[1], p[2]), b = DA_MX3(p[3], p[4], p[5]); a = DA_MX3(a, p[6], p[7]); b = DA_MX3(b, p[8], p[9]); a = DA_MX3(a, p[10], p[11]); b = DA_MX3(b, p[12], p[13]);
    a = DA_MX3(a, p[14], p[15]); return __builtin_fmaxf(a, b); }
__device__ __forceinline__ float rowmax(const f32x16& p0, const f32x16& p1, float offA, float offB) {
    const float m = __builtin_fmaxf(__builtin_fmaf(max16(p0), C2, offA), __builtin_fmaf(max16(p1), C2, offB));
    auto rr = __builtin_amdgcn_permlane32_swap(__float_as_uint(m), __float_as_uint(m), false, false);
    return __builtin_fmaxf(__uint_as_float(rr[0]), __uint_as_float(rr[1])); }
__device__ __forceinline__ void cmask(f32x16& p0, f32x16& p1, int jb, int qrel, int hi) {
    const int kb = 64 * jb + 4 * hi;
#pragma unroll
    for (int r = 0; r < 16; ++r) { const int kv = kb + (r & 3) + 8 * (r >> 2); if (kv > qrel) p0[r] = -INFINITY; if (kv + 32 > qrel) p1[r] = -INFINITY; } }

__device__ __forceinline__ void attn_epilogue_body(LAS unsigned char* lds, f32x16 (&o)[4], float l_reg, bf16_t* __restrict__ yb, const float* __restrict__ subln_w, float lam,
                                                   size_t rowb, int q0, int h, int wave, int lane) {
    asm volatile("" : "+v"(lane));
    const int r32 = lane & 31, hi = lane >> 5, map = wave >> 2, qs = wave & 3;
    LAS float* wsf = (LAS float*)(lds + SCR_OFF) + wave * 64;
    if (hi == 0) wsf[r32] = 1.f / l_reg;
    float il[16];
#pragma unroll
    for (int g = 0; g < 4; ++g) { const f32x4 t4 = *(const LAS f32x4*)(wsf + 8 * g + 4 * hi); il[4 * g] = t4[0]; il[4 * g + 1] = t4[1]; il[4 * g + 2] = t4[2]; il[4 * g + 3] = t4[3]; }
    __syncthreads();
    LAS float* comb = (LAS float*)(lds + COMB_OFF) + qs * 4096;
    if (map == 1) {
#pragma unroll
        for (int d = 0; d < 4; ++d)
#pragma unroll
            for (int r = 0; r < 16; ++r) comb[crow(r, hi) * 128 + 32 * d + r32] = o[d][r] * il[r];
    }
    __syncthreads();
    if (map == 0) {
        float sw[4];
#pragma unroll
        for (int d = 0; d < 4; ++d) sw[d] = subln_w[32 * d + r32] * (1.f - LAM_INIT);
#pragma unroll
        for (int r = 0; r < 16; ++r) {
            float v[4], ss = 0.f;
#pragma unroll
            for (int d = 0; d < 4; ++d) { v[d] = o[d][r] * il[r] - lam * comb[crow(r, hi) * 128 + 32 * d + r32]; ss += v[d] * v[d]; }
            ss += __shfl_xor(ss, 1); ss += __shfl_xor(ss, 2); ss += __shfl_xor(ss, 4); ss += __shfl_xor(ss, 8); ss += __shfl_xor(ss, 16);
            const float rs = rsqrtf(ss * (1.f / 128.f) + SUBLN_EPS);
            bf16_t* op = yb + (rowb + q0 + crow(r, hi)) * 512 + h * 128 + r32;
#pragma unroll
            for (int d = 0; d < 4; ++d) op[32 * d] = f2bf(v[d] * rs * sw[d]);
        }
    }
    __syncthreads();
}
__device__ __forceinline__ void attn_unit(LAS unsigned char* lds, const bf16_t* __restrict__ z, bf16_t* __restrict__ yb, const float* __restrict__ subln_w, float lam,
                                          int b, int h, int qblk, int wave_, int lane) {
    const int wave = __builtin_amdgcn_readfirstlane(wave_);
    const int r32 = lane & 31, hi = lane >> 5, map = wave >> 2, qs = wave & 3;
    const int q0 = qblk * 128 + qs * 32, NT = 2 * qblk + 2, qrel = qs * 32 + r32;
    const size_t rowb = (size_t)b * SEQ;
    const float slope = exp2f(-2.f * (float)(h + 1)), slope2 = slope * LOG2E, s64 = 64.f * slope2, s32 = 32.f * slope2;
    const unsigned lds0 = (unsigned)(uintptr_t)lds;
    LAS float* wsf = (LAS float*)(lds + SCR_OFF) + wave * 64;
    const bf16_t* ksrc = z + (rowb + lane) * NZ + C_ZK + h * 128 + wave * 8;
    const int pc0 = 2 * wave;
    const bf16_t* vsrc0 = z + (rowb + 16 * (pc0 & 3) + (lane >> 2)) * NZ + C_ZV + h * 128 + 32 * (pc0 >> 2) + (lane & 3) * 8;
    const unsigned kdst = lds0 + LDS_KR + wave * 1024, vdst = lds0 + LDS_VR + pc0 * 1024;
#define DMA_K(t, slot) do { const bf16_t* k_ = ksrc + (size_t)(t) * 64 * NZ; const unsigned d_ = (unsigned)__builtin_amdgcn_readfirstlane(kdst + (slot)); glds16(k_, d_); glds16_o128(k_, d_ + 8192 - 128); } while (0)
#define DMA_V(t, slot) do { const size_t o_ = (size_t)(t) * 64 * NZ; const unsigned d_ = (unsigned)__builtin_amdgcn_readfirstlane(vdst + (slot)); glds16(vsrc0 + o_, d_); glds16(vsrc0 + o_ + 16 * NZ, d_ + 1024); } while (0)
    const lcp vp0 = lds + LDS_VR + ((lane >> 4) & 1) * 32 + (lane & 3) * 8 + (4 * hi + ((lane & 15) >> 2)) * 64;
    const lcp kp0 = lds + LDS_KR + map * 8192 + hi * 1024 + r32 * 16;
    DMA_K(0, 0); DMA_V(0, 0); DMA_K(1, RSLOT);
    bf16x8 qr[4];
    {
        const bf16_t* qp = z + (rowb + q0 + r32) * NZ + C_Q + h * 128 + map * 64 + hi * 8;
#pragma unroll
        for (int d0 = 0; d0 < 4; ++d0) qr[d0] = *(const bf16x8*)(qp + d0 * 16);
    }
    f32x16 bias16;
#pragma unroll
    for (int r = 0; r < 16; ++r) bias16[r] = (8.f * slope) * (float)((r & 3) + 8 * (r >> 2));
    DA_PIN(bias16);
    float mhat = 0.f, l_reg = 0.f, offA = slope2 * (float)(4 * hi);
    f32x16 o[4];
#pragma unroll
    for (int d = 0; d < 4; ++d) o[d] = (f32x16){};
    bool resc = false;
    f32x16 c0, c1; bf16x8 kf[8]; s16x4 vlo[4], vhi[4]; v4u pw0, pw1, pw2, pw3;
#define SL(t) ((((t)) & 3) * RSLOT)
#define EX(v, nm) __builtin_amdgcn_exp2f(__builtin_fmaf((v), C2, (nm)))
#define RESC() do { if (resc) { _Pragma("unroll") for (int d_ = 0; d_ < 4; ++d_) _Pragma("unroll") for (int r = 0; r < 16; ++r) o[d_][r] *= wsf[crow(r, hi)]; } } while (0)
#define PKW(P, i) pg8::cvt_pk_bf16(P[i], P[(i) + 1])
    DMA_K(2, 2 * RSLOT); DMA_K(3, 3 * RSLOT); DMA_V(1, RSLOT);
    DA_WAIT_BAR(10);
#pragma unroll
    for (int d0 = 0; d0 < 4; ++d0) kload2(kf, kp0, d0);
    c0 = DA_MFMA(kf[0], qr[0], bias16); c1 = DA_MFMA(kf[1], qr[0], bias16); c0 = DA_MFMA(kf[2], qr[1], c0); c1 = DA_MFMA(kf[3], qr[1], c1);
    c0 = DA_MFMA(kf[4], qr[2], c0); c1 = DA_MFMA(kf[5], qr[2], c1); c0 = DA_MFMA(kf[6], qr[3], c0); c1 = DA_MFMA(kf[7], qr[3], c1);
    if (NT == 2) cmask(c0, c1, 0, qrel, hi);
    { mhat = rowmax(c0, c1, offA, offA + s32); const float nmh0 = offA - mhat, nmh1 = nmh0 + s32; float sacc = 0.f;
#pragma unroll
      for (int r = 0; r < 16; ++r) { c0[r] = EX(c0[r], nmh0); c1[r] = EX(c1[r], nmh1); sacc += c0[r] + c1[r]; }
      l_reg = sacc; }
    pw0 = (v4u){PKW(c0, 0), PKW(c0, 2), PKW(c0, 4), PKW(c0, 6)}; pw1 = (v4u){PKW(c0, 8), PKW(c0, 10), PKW(c0, 12), PKW(c0, 14)};
    pw2 = (v4u){PKW(c1, 0), PKW(c1, 2), PKW(c1, 4), PKW(c1, 6)}; pw3 = (v4u){PKW(c1, 8), PKW(c1, 10), PKW(c1, 12), PKW(c1, 14)};
    DA_WAIT_BAR(6);
    DMA_K(4, 0); DMA_V(2, 2 * RSLOT);
#pragma unroll
    for (int d0 = 0; d0 < 4; ++d0) kload2(kf, kp0 + RSLOT, d0);
    if (NT == 2) { DA_WAIT_BAR(0); } else { DA_WAIT_BAR(8); }
#define PAF(k) __builtin_bit_cast(bf16x8, pw##k)
#define VFR(i) (bf16x8){vlo[(i) & 3][0], vlo[(i) & 3][1], vlo[(i) & 3][2], vlo[(i) & 3][3], vhi[(i) & 3][0], vhi[(i) & 3][1], vhi[(i) & 3][2], vhi[(i) & 3][3]}
#define VOFF(i) ((((i) & 3) * 4 + ((i) >> 2)) * 1024)
#define VRD(i) do { vlo[(i) & 3] = vtr(vp_ + VOFF(i)); vhi[(i) & 3] = vtr(vp_ + VOFF(i) + 512); DA_SBAR(); } while (0)
#define KRD(G, d0) do { if (G) { kload2(kf, kp0 + sl_next_, d0); DA_SBAR(); } } while (0)
#define GAPA(MF) do { MF; DA_SBAR(); } while (0)
#define GAPB(MF, X, i, nm, A0, A1, EXTRA) do { MF; X[i] = EX(X[i], nm); X[(i) + 1] = EX(X[(i) + 1], nm); sacc += A0; sacc += A1; EXTRA; DA_PIN(X); DA_PIN(sacc); DA_SBAR(); } while (0)
#define STEP(t, MASK, GK, GV, GL) do { DA_SBAR(); \
    const lcp vp_ = vp0 + SL((t) - 1); const int sl_next_ = SL((t) + 1); \
            GAPA(c0 = DA_MFMA(kf[0], qr[0], bias16)); GAPA(c1 = DA_MFMA(kf[1], qr[0], bias16)); GAPA(c0 = DA_MFMA(kf[2], qr[1], c0)); GAPA(c1 = DA_MFMA(kf[3], qr[1], c1)); \
    VRD(0); GAPA(c0 = DA_MFMA(kf[4], qr[2], c0)); VRD(1); GAPA(c1 = DA_MFMA(kf[5], qr[2], c1)); VRD(2); GAPA(c0 = DA_MFMA(kf[6], qr[3], c0)); VRD(3); GAPA(c1 = DA_MFMA(kf[7], qr[3], c1)); \
    offA += s64; \
    if (GK) DMA_K((t) + 4, SL(t)); if (GV) DMA_V((t) + 2, SL((t) + 2)); \
    if (MASK) cmask(c0, c1, (t) - (NT - 2), qrel, hi); \
    { const float rm = rowmax(c0, c1, offA, offA + s32) - mhat; resc = false; \
      if (__builtin_expect(__any(rm > THR), 0)) { const float dl = __builtin_fmaxf(rm, 0.f); mhat += dl; \
          const float f = __builtin_amdgcn_exp2f(-dl); l_reg *= f; if (hi == 0) wsf[r32] = f; resc = true; } } \
    const float nmh0 = offA - mhat, nmh1 = nmh0 + s32; float sacc = 0.f; DA_SBAR(); \
    GAPB(o[0] = DA_MFMA(PAF(0), VFR(0), o[0]), c0, 0, nmh0, 0.f, 0.f, );             VRD(4); \
    GAPB(o[1] = DA_MFMA(PAF(0), VFR(1), o[1]), c0, 2, nmh0, c0[0], c0[1], );         VRD(5); \
    GAPB(o[2] = DA_MFMA(PAF(0), VFR(2), o[2]), c0, 4, nmh0, c0[2], c0[3], );         VRD(6); \
    GAPB(o[3] = DA_MFMA(PAF(0), VFR(3), o[3]), c0, 6, nmh0, c0[4], c0[5], );         VRD(7); \
    GAPB(o[0] = DA_MFMA(PAF(1), VFR(4), o[0]), c0, 8, nmh0, c0[6], c0[7], pw0[0] = PKW(c0, 0); pw0[1] = PKW(c0, 2); DA_PIN(pw0));    VRD(8); \
    GAPB(o[1] = DA_MFMA(PAF(1), VFR(5), o[1]), c0, 10, nmh0, c0[8], c0[9], pw0[2] = PKW(c0, 4); pw0[3] = PKW(c0, 6); DA_PIN(pw0));   VRD(9); \
    GAPB(o[2] = DA_MFMA(PAF(1), VFR(6), o[2]), c0, 12, nmh0, c0[10], c0[11], );      VRD(10); \
    GAPB(o[3] = DA_MFMA(PAF(1), VFR(7), o[3]), c0, 14, nmh0, c0[12], c0[13], );      VRD(11); \
    GAPB(o[0] = DA_MFMA(PAF(2), VFR(8), o[0]), c1, 0, nmh1, c0[14], c0[15], pw1[0] = PKW(c0, 8); pw1[1] = PKW(c0, 10); DA_PIN(pw1));  VRD(12); \
    GAPB(o[1] = DA_MFMA(PAF(2), VFR(9), o[1]), c1, 2, nmh1, c1[0], c1[1], pw1[2] = PKW(c0, 12); pw1[3] = PKW(c0, 14); DA_PIN(pw1));   VRD(13); \
    GAPB(o[2] = DA_MFMA(PAF(2), VFR(10), o[2]), c1, 4, nmh1, c1[2], c1[3], );        VRD(14); \
    GAPB(o[3] = DA_MFMA(PAF(2), VFR(11), o[3]), c1, 6, nmh1, c1[4], c1[5], );        VRD(15); \
    GAPB(o[0] = DA_MFMA(PAF(3), VFR(12), o[0]), c1, 8, nmh1, c1[6], c1[7], pw2[0] = PKW(c1, 0); pw2[1] = PKW(c1, 2); DA_PIN(pw2));   KRD(GL, 0); \
    GAPB(o[1] = DA_MFMA(PAF(3), VFR(13), o[1]), c1, 10, nmh1, c1[8], c1[9], pw2[2] = PKW(c1, 4); pw2[3] = PKW(c1, 6); DA_PIN(pw2));  KRD(GL, 1); \
    GAPB(o[2] = DA_MFMA(PAF(3), VFR(14), o[2]), c1, 12, nmh1, c1[10], c1[11], );     KRD(GL, 2); \
    GAPB(o[3] = DA_MFMA(PAF(3), VFR(15), o[3]), c1, 14, nmh1, c1[12], c1[13], );     KRD(GL, 3); \
    sacc += c1[14]; sacc += c1[15]; l_reg += sacc; \
    pw3[0] = PKW(c1, 8); pw3[1] = PKW(c1, 10); pw3[2] = PKW(c1, 12); pw3[3] = PKW(c1, 14); DA_PIN(pw3); \
    } while (0)
#define ENDW(tt) do { if ((tt) + 4 < NT) { DA_WAIT_BAR(8); } else if ((tt) + 3 < NT) { DA_WAIT_BAR(6); } else if ((tt) + 2 < NT) { DA_WAIT_BAR(4); } else { DA_WAIT_BAR(0); } } while (0)
    int t = 1;
    for (; t + 4 < NT; ++t) {
        STEP(t, false, true, true, true); DA_WAIT_BAR(8); RESC();
    }
    for (; t + 1 < NT; ++t) {
        STEP(t, true, (t + 4 < NT), (t + 2 < NT), (t + 1 < NT)); ENDW(t); RESC();
    }
    STEP(NT - 1, true, false, false, false); RESC();
    { const lcp vp_ = vp0 + SL(NT - 1);
#define DRN(k, i) do { const s16x4 lo_ = vtr(vp_ + VOFF(i)), hh_ = vtr(vp_ + VOFF(i) + 512); \
        o[(i) & 3] = DA_MFMA(PAF(k), ((bf16x8){lo_[0], lo_[1], lo_[2], lo_[3], hh_[0], hh_[1], hh_[2], hh_[3]}), o[(i) & 3]); } while (0)
      DRN(0, 0); DRN(0, 1); DRN(0, 2); DRN(0, 3); DRN(1, 4); DRN(1, 5); DRN(1, 6); DRN(1, 7); DRN(2, 8); DRN(2, 9); DRN(2, 10); DRN(2, 11); DRN(3, 12); DRN(3, 13); DRN(3, 14); DRN(3, 15);
#undef DRN
    }
#undef DMA_K
#undef DMA_V
#undef SL
#undef EX
#undef RESC
#undef PKW
#undef PAF
#undef VFR
#undef VOFF
#undef VRD
#undef KRD
#undef GAPA
#undef GAPB
#undef STEP
#undef ENDW
    { auto rr = __builtin_amdgcn_permlane32_swap(__float_as_uint(l_reg), __float_as_uint(l_reg), false, false); l_reg = __uint_as_float(rr[0]) + __uint_as_float(rr[1]); }
    attn_epilogue_body(lds, o, l_reg, yb, subln_w, lam, rowb, q0, h, wave, lane);
}
}

namespace rw {
typedef short bf16x8 __attribute__((ext_vector_type(8)));
typedef float f32x2 __attribute__((ext_vector_type(2)));
typedef short s16x4 __attribute__((ext_vector_type(4)));
constexpr int CH = 32, ACT_PITCH = 528;
constexpr int OFF_HAT = 41472, HAT_PITCH = 144, HAT_SZ = 32 * HAT_PITCH, OFF_TIL = OFF_HAT + 4 * HAT_SZ, TIL_PITCH = 40, TIL_SZ = 64 * TIL_PITCH, OFF_GR = OFF_TIL + 4 * TIL_SZ, OFF_WC = OFF_GR + 10 * 1024;
constexpr int OFF_ACT = 0, OFF_RKV = 16896, OFF_VEC = 41472, OFF_G = 82432, OFF_Y = 90624, OFF_NRM = 98816, OFF_SCL = 99328, OFF_CT = 99840, OFF_SCP = 102400;
template <int CTRL> __device__ __forceinline__ float dppf(float x) { return __builtin_bit_cast(float, __builtin_amdgcn_mov_dpp(__builtin_bit_cast(int, x), CTRL, 0xf, 0xf, true)); }
__device__ __forceinline__ float row_allsum(float v) { v += dppf<0x128>(v); v += dppf<0x124>(v); v += dppf<0x122>(v); v += dppf<0x121>(v); return v; }
__device__ __forceinline__ void row_allsum4(float& a, float& b, float& c, float& d) {
#define RW_DPP4(n) "v_add_f32_dpp %0, %0, %0 row_ror:" #n " row_mask:0xf bank_mask:0xf\n\tv_add_f32_dpp %1, %1, %1 row_ror:" #n " row_mask:0xf bank_mask:0xf\n\t" \
                   "v_add_f32_dpp %2, %2, %2 row_ror:" #n " row_mask:0xf bank_mask:0xf\n\tv_add_f32_dpp %3, %3, %3 row_ror:" #n " row_mask:0xf bank_mask:0xf\n\t"
    asm volatile("s_nop 1\n\t" RW_DPP4(8) RW_DPP4(4) RW_DPP4(2) RW_DPP4(1) "s_nop 1" : "+v"(a), "+v"(b), "+v"(c), "+v"(d));
#undef RW_DPP4
}
__device__ __forceinline__ f32x4 ld4bf(const bf16_t* p) { const v2u w = *(const v2u*)p; return (f32x4){pg8::bflo(w.x), pg8::bfhi(w.x), pg8::bflo(w.y), pg8::bfhi(w.y)}; }
__device__ __forceinline__ float fsig(float x) { return __builtin_amdgcn_rcpf(1.f + __expf(-x)); }
__device__ __forceinline__ float ftanh(float x) { return 1.f - 2.f * __builtin_amdgcn_rcpf(1.f + __expf(2.f * x)); }
struct ZRow { v2u r, k, v, w, a; v4u g; };
__device__ __forceinline__ ZRow ldrow(const bf16_t* zr, int c4, int cg) {
    ZRow o; o.r = *(const v2u*)(zr + C_R + c4); o.k = *(const v2u*)(zr + C_K + c4); o.v = *(const v2u*)(zr + C_V + c4); o.w = *(const v2u*)(zr + C_WL + 4 * cg); o.a = *(const v2u*)(zr + C_AL + 4 * cg);
    o.g = *(const v4u*)(zr + C_GL + 8 * cg); return o;
}
__device__ __forceinline__ f32x4 up4(v2u w) { return (f32x4){pg8::bflo(w.x), pg8::bfhi(w.x), pg8::bflo(w.y), pg8::bfhi(w.y)}; }

struct ScanP { const float *mu, *w0, *w2, *a0, *a2, *g2, *k_k, *k_a, *r_k, *lnx_w, *lnx_b; };
__device__ __forceinline__ void scan_unit(LAS unsigned char* lds, const bf16_t* __restrict__ z, bf16_t* __restrict__ ya, const ScanP P, int b, int h, int tid, int wave, int lane) {
    asm volatile("" : "+v"(tid)); lane = tid & 63;
    const float* mu = P.mu; const float* w0 = P.w0; const float* w2 = P.w2; const float* a0 = P.a0; const float* a2 = P.a2; const float* g2 = P.g2;
    const float* k_k = P.k_k; const float* k_a = P.k_a; const float* r_k = P.r_k; const float* lnx_w = P.lnx_w; const float* lnx_b = P.lnx_b;
    const size_t rowb = (size_t)b * SEQ;
    const int tl = tid >> 4, cg = tid & 15;
    const int nt = wave & 3, rl = lane & 15, rg = lane >> 4;
    LAS float* rkv = (LAS float*)(lds + OFF_RKV); LAS float* vec = (LAS float*)(lds + OFF_VEC); LAS float* gbuf = (LAS float*)(lds + OFF_G);
    LAS float* ybuf = (LAS float*)(lds + OFF_Y); LAS float* nrm = (LAS float*)(lds + OFF_NRM); LAS float* scl = (LAS float*)(lds + OFF_SCL); LAS float* scp = (LAS float*)(lds + OFF_SCP);
    bf16x8 bfr[8];
    {
        const int col = h * 64 + 16 * nt + rl;
#pragma unroll
        for (int f = 0; f < 8; ++f) {
            const float* src = (f < 2) ? w2 : (f < 4) ? a2 : g2;
            const int kb = ((f < 4) ? 32 * (f & 1) : 32 * (f - 4)) + 8 * rg;
            float e[8];
#pragma unroll
            for (int j = 0; j < 8; ++j) e[j] = src[(size_t)(kb + j) * 512 + col];
            v4u p; p.x = pg8::cvt_pk_bf16(e[0], e[1]); p.y = pg8::cvt_pk_bf16(e[2], e[3]); p.z = pg8::cvt_pk_bf16(e[4], e[5]); p.w = pg8::cvt_pk_bf16(e[6], e[7]);
            bfr[f] = __builtin_bit_cast(bf16x8, p);
            __builtin_amdgcn_sched_barrier(0);
        }
    }
    const int mt = wave >> 2;
    const int hc = h * 64 + 16 * nt + rl;
    const float w0c = w0[hc], a0c = a0[hc], kkc = k_k[hc], kac = k_a[hc], rkc = r_k[hc];
    const int c4 = h * 64 + 4 * cg;
    f32x4 ST[4];
#pragma unroll
    for (int i = 0; i < 4; ++i) ST[i] = (f32x4){0.f, 0.f, 0.f, 0.f};
    LAS float* ctab = (LAS float*)(lds + OFF_CT);
    if (tl == 0) {
        LAS float* ct = ctab + cg * 36;
        *(LAS f32x4*)(ct + 0) = *(const f32x4*)(mu + C_R + c4); *(LAS f32x4*)(ct + 4) = *(const f32x4*)(mu + C_K + c4); *(LAS f32x4*)(ct + 8) = *(const f32x4*)(mu + C_V + c4);
        *(LAS f32x4*)(ct + 12) = *(const f32x4*)(mu + C_WL + 4 * cg); *(LAS f32x4*)(ct + 16) = *(const f32x4*)(mu + C_AL + 4 * cg);
        *(LAS f32x4*)(ct + 20) = *(const f32x4*)(mu + C_GL + 8 * cg); *(LAS f32x4*)(ct + 24) = *(const f32x4*)(mu + C_GL + 8 * cg + 4);
        *(LAS f32x4*)(ct + 28) = *(const f32x4*)(lnx_w + c4); *(LAS f32x4*)(ct + 32) = *(const f32x4*)(lnx_b + c4);
    }
    __syncthreads();
    const LAS float* myct = ctab + cg * 36;
    ZRow zc = ldrow(z + (rowb + tl) * NZ, c4, cg), zp;
    if (tl > 0) zp = ldrow(z + (rowb + tl - 1) * NZ, c4, cg); else { zp.r = zp.k = zp.v = zp.w = zp.a = (v2u){0u, 0u}; zp.g = (v4u){0u, 0u, 0u, 0u}; }
    for (int t0 = 0; t0 < SEQ; t0 += CH) {
        {
            const f32x4 cr = up4(zc.r), ck = up4(zc.k), cv = up4(zc.v), cw = up4(zc.w), ca = up4(zc.a);
            const f32x4 cg0 = (f32x4){pg8::bflo(zc.g.x), pg8::bfhi(zc.g.x), pg8::bflo(zc.g.y), pg8::bfhi(zc.g.y)}, cg1 = (f32x4){pg8::bflo(zc.g.z), pg8::bfhi(zc.g.z), pg8::bflo(zc.g.w), pg8::bfhi(zc.g.w)};
            const f32x4 pr = up4(zp.r), pk = up4(zp.k), pv = up4(zp.v), pw = up4(zp.w), pa = up4(zp.a);
            const f32x4 pg0 = (f32x4){pg8::bflo(zp.g.x), pg8::bfhi(zp.g.x), pg8::bflo(zp.g.y), pg8::bfhi(zp.g.y)}, pg1 = (f32x4){pg8::bflo(zp.g.z), pg8::bfhi(zp.g.z), pg8::bflo(zp.g.w), pg8::bfhi(zp.g.w)};
            if (t0 + CH < SEQ) { zc = ldrow(z + (rowb + t0 + CH + tl) * NZ, c4, cg); zp = ldrow(z + (rowb + t0 + CH + tl - 1) * NZ, c4, cg); }
            const f32x4 rs_ = cr + (pr - cr) * *(const LAS f32x4*)(myct + 0), ks_ = ck + (pk - ck) * *(const LAS f32x4*)(myct + 4), vs_ = cv + (pv - cv) * *(const LAS f32x4*)(myct + 8);
            const f32x4 ws_ = cw + (pw - cw) * *(const LAS f32x4*)(myct + 12), as_ = ca + (pa - ca) * *(const LAS f32x4*)(myct + 16);
            const f32x4 g0_ = cg0 + (pg0 - cg0) * *(const LAS f32x4*)(myct + 20), g1_ = cg1 + (pg1 - cg1) * *(const LAS f32x4*)(myct + 24);
            *(LAS f32x4*)(rkv + 0 * 2048 + tl * 64 + 4 * cg) = rs_; *(LAS f32x4*)(rkv + 1 * 2048 + tl * 64 + 4 * cg) = ks_; *(LAS f32x4*)(rkv + 2 * 2048 + tl * 64 + 4 * cg) = vs_;
            LAS unsigned char* ar = lds + OFF_ACT + tl * ACT_PITCH;
            v2u tw; tw.x = pg8::cvt_pk_bf16(ftanh(ws_[0]), ftanh(ws_[1])); tw.y = pg8::cvt_pk_bf16(ftanh(ws_[2]), ftanh(ws_[3]));
            *(LAS v2u*)(ar + 8 * cg) = tw;
            v2u aw; aw.x = pg8::cvt_pk_bf16(as_[0], as_[1]); aw.y = pg8::cvt_pk_bf16(as_[2], as_[3]);
            *(LAS v2u*)(ar + 128 + 8 * cg) = aw;
            v4u gw; gw.x = pg8::cvt_pk_bf16(fsig(g0_[0]), fsig(g0_[1])); gw.y = pg8::cvt_pk_bf16(fsig(g0_[2]), fsig(g0_[3]));
            gw.z = pg8::cvt_pk_bf16(fsig(g1_[0]), fsig(g1_[1])); gw.w = pg8::cvt_pk_bf16(fsig(g1_[2]), fsig(g1_[3]));
            *(LAS v4u*)(ar + 256 + 16 * cg) = gw;
        }
        __syncthreads();
        f32x4 accw = (f32x4){0.f, 0.f, 0.f, 0.f}, acca = accw, accg = accw;
        {
            const LAS unsigned char* ap = lds + OFF_ACT + (16 * mt + rl) * ACT_PITCH + 8 * rg * 2;
#pragma unroll
            for (int f = 0; f < 8; ++f) {
                const bf16x8 a = *(const LAS bf16x8*)(ap + f * 64);
                if (f < 2) accw = __builtin_amdgcn_mfma_f32_16x16x32_bf16(a, bfr[f], accw, 0, 0, 0);
                else if (f < 4) acca = __builtin_amdgcn_mfma_f32_16x16x32_bf16(a, bfr[f], acca, 0, 0, 0);
                else accg = __builtin_amdgcn_mfma_f32_16x16x32_bf16(a, bfr[f], accg, 0, 0, 0);
            }
        }
        float lw[4], av[4], kk[4];
        {
            const int c = 16 * nt + rl;
            float n2[4];
#pragma unroll
            for (int r = 0; r < 4; ++r) {
                const int tok = 16 * mt + 4 * rg + r;
                gbuf[tok * 64 + c] = accg[r];
                const float nx = -(w0c + accw[r]);
                const float sp = nx > 20.f ? nx : __logf(1.f + __expf(nx));
                lw[r] = -__expf(-sp - 0.5f);
                av[r] = fsig(a0c + acca[r]);
                kk[r] = rkv[1 * 2048 + tok * 64 + c] * kkc;
                n2[r] = kk[r] * kk[r];
            }
            row_allsum4(n2[0], n2[1], n2[2], n2[3]);
            if (rl == 0) {
#pragma unroll
                for (int r = 0; r < 4; ++r) nrm[(16 * mt + 4 * rg + r) * 4 + nt] = n2[r];
            }
        }
        __syncthreads();
        {
            const int c = 16 * nt + rl;
            const float p0 = lw[0], p1 = p0 + lw[1], p2 = p1 + lw[2], p3 = p2 + lw[3];
            const float t1 = __shfl(p3, (lane - 16) & 63), t2 = __shfl(p3, (lane - 32) & 63), t3 = __shfl(p3, (lane - 48) & 63);
            const float E = (rg >= 1 ? t1 : 0.f) + (rg >= 2 ? t2 : 0.f) + (rg >= 3 ? t3 : 0.f);
            const float Ltot = __shfl(E + p3, rl + 48);
            const float pin[4] = {p0, p1, p2, p3};
            float bt[4], kt[4];
#pragma unroll
            for (int r = 0; r < 4; ++r) {
                const int tok = 16 * mt + 4 * rg + r;
                const f32x4 n4 = *(const LAS f32x4*)(nrm + tok * 4);
                const float ksv = rkv[1 * 2048 + tok * 64 + c], rsv = rkv[0 * 2048 + tok * 64 + c];
                const float inv = __builtin_amdgcn_rcpf(fmaxf(sqrtf((n4[0] + n4[1]) + (n4[2] + n4[3])), 1e-12f));
                const float kkn = kk[r] * inv, beta = kkn * av[r], kmod = ksv * (1.f + (av[r] - 1.f) * kac);
                const float L = E + pin[r], eL = __expf(L), ieL = __expf(-L), eLm = __expf(L - lw[r]), eT = __expf(Ltot - L);
                LAS unsigned char* hp = lds + OFF_HAT + tok * HAT_PITCH + c * 2;
                *(LAS bf16_t*)(hp) = f2bf(-kkn * eLm); *(LAS bf16_t*)(hp + HAT_SZ) = f2bf(beta * ieL); *(LAS bf16_t*)(hp + 2 * HAT_SZ) = f2bf(kmod * ieL); *(LAS bf16_t*)(hp + 3 * HAT_SZ) = f2bf(rsv * eL);
                bt[r] = beta * eT; kt[r] = kmod * eT;
                float pbr = beta * rsv, pkr = kmod * rsv, pbo = rsv * kmod * rkc, dum = 0.f;
                row_allsum4(pbr, pkr, pbo, dum);
                if (rl == 0) *(LAS f32x4*)(scp + (tok * 4 + nt) * 4) = (f32x4){pbr, pkr, pbo, 0.f};
            }
            LAS unsigned char* tp = lds + OFF_TIL + (2 * mt) * TIL_SZ + c * TIL_PITCH + 8 * rg;
            v2u w; w.x = pg8::cvt_pk_bf16(bt[0], bt[1]); w.y = pg8::cvt_pk_bf16(bt[2], bt[3]); *(LAS v2u*)(tp) = w;
            w.x = pg8::cvt_pk_bf16(kt[0], kt[1]); w.y = pg8::cvt_pk_bf16(kt[2], kt[3]); *(LAS v2u*)(tp + TIL_SZ) = w;
            if (rg == 0) ((LAS float*)(lds + OFF_WC))[mt * 64 + c] = __expf(Ltot);
        }
        __syncthreads();
        if (tid < CH) {
            const f32x4 p0 = *(const LAS f32x4*)(scp + tid * 16), p1 = *(const LAS f32x4*)(scp + tid * 16 + 4), p2 = *(const LAS f32x4*)(scp + tid * 16 + 8), p3 = *(const LAS f32x4*)(scp + tid * 16 + 12);
            *(LAS f32x4*)(scl + 4 * tid) = (p0 + p1) + (p2 + p3);
        }
        int lane_ = lane; asm volatile("" : "+v"(lane_));
        const int rl_ = lane_ & 15, rg_ = lane_ >> 4;
        {
            const int c = wave >> 2, g = wave & 3;
            const LAS unsigned char* pa = lds + OFF_HAT + ((g & 1) ? 2 : 1) * HAT_SZ + (16 * c + rl_) * HAT_PITCH + 16 * rg_;
            const LAS unsigned char* pb = lds + OFF_HAT + ((g < 2) ? 0 : 3) * HAT_SZ + (16 * c + rl_) * HAT_PITCH + 16 * rg_;
            f32x4 acc = (f32x4){0.f, 0.f, 0.f, 0.f};
            acc = __builtin_amdgcn_mfma_f32_16x16x32_bf16(*(const LAS bf16x8*)(pa), *(const LAS bf16x8*)(pb), acc, 0, 0, 0);
            acc = __builtin_amdgcn_mfma_f32_16x16x32_bf16(*(const LAS bf16x8*)(pa + 64), *(const LAS bf16x8*)(pb + 64), acc, 0, 0, 0);
#pragma unroll
            for (int e = 0; e < 4; ++e) { const int row = 4 * rg_ + e; const bool keep = (g < 2) ? (row < rl_) : (row <= rl_); if (!keep) acc[e] = 0.f; }
            *(LAS f32x4*)(lds + OFF_GR + (c * 5 + g) * 1024 + lane_ * 16) = acc;
            if (g == 0) {
                asm volatile("s_waitcnt lgkmcnt(0)" ::: "memory");
                if (lane_ < 16) {
                    const int sc = lane_;
                    const LAS float* tb = (const LAS float*)(lds + OFF_GR + (c * 5) * 1024);
                    float m[16], ps[16];
#pragma unroll
                    for (int r = 0; r < 16; ++r) ps[r] = 0.f;
#pragma unroll
                    for (int u = 15; u >= 0; --u) {
                        m[u] = (u == sc) ? 1.f : ((u < sc) ? ps[u] : 0.f);
#pragma unroll
                        for (int r = 0; r < u; ++r) ps[r] = __builtin_fmaf(tb[(u + 16 * (r >> 2)) * 4 + (r & 3)], m[u], ps[r]);
                    }
                    LAS f32x4* mt_ = (LAS f32x4*)(lds + OFF_GR + (c * 5 + 4) * 1024);
#pragma unroll
                    for (int q = 0; q < 4; ++q) mt_[sc + 16 * q] = (f32x4){m[4 * q], m[4 * q + 1], m[4 * q + 2], m[4 * q + 3]};
                }
            }
        }
        __syncthreads();
        if (wave < 4) {
            const int ib = wave;
#pragma unroll
            for (int c = 0; c < 2; ++c) {
                bf16x8 sb[2];
#pragma unroll
                for (int ks = 0; ks < 2; ++ks) {
                    v4u p; p.x = pg8::cvt_pk_bf16(ST[2 * ks][0], ST[2 * ks][1]); p.y = pg8::cvt_pk_bf16(ST[2 * ks][2], ST[2 * ks][3]);
                    p.z = pg8::cvt_pk_bf16(ST[2 * ks + 1][0], ST[2 * ks + 1][1]); p.w = pg8::cvt_pk_bf16(ST[2 * ks + 1][2], ST[2 * ks + 1][3]);
                    sb[ks] = __builtin_bit_cast(bf16x8, p);
                }
                const LAS unsigned char* ha = lds + OFF_HAT + (16 * c + rl_) * HAT_PITCH + 8 * rg_;
                f32x4 xt = (f32x4){0.f, 0.f, 0.f, 0.f}, yt = xt;
#pragma unroll
                for (int ks = 0; ks < 2; ++ks) {
                    v4u fa, fr; const v2u a0_ = *(const LAS v2u*)(ha + 64 * ks), a1_ = *(const LAS v2u*)(ha + 64 * ks + 32);
                    const v2u r0_ = *(const LAS v2u*)(ha + 3 * HAT_SZ + 64 * ks), r1_ = *(const LAS v2u*)(ha + 3 * HAT_SZ + 64 * ks + 32);
                    fa.x = a0_.x; fa.y = a0_.y; fa.z = a1_.x; fa.w = a1_.y; fr.x = r0_.x; fr.y = r0_.y; fr.z = r1_.x; fr.w = r1_.y;
                    xt = __builtin_amdgcn_mfma_f32_16x16x32_bf16(__builtin_bit_cast(bf16x8, fa), sb[ks], xt, 0, 0, 0);
                    yt = __builtin_amdgcn_mfma_f32_16x16x32_bf16(__builtin_bit_cast(bf16x8, fr), sb[ks], yt, 0, 0, 0);
                }
                const LAS float* vsrc = rkv + 2 * 2048 + (16 * c + 4 * rg_) * 64 + 16 * ib + rl_;
                v2u vb_; vb_.x = pg8::cvt_pk_bf16(vsrc[0], vsrc[64]); vb_.y = pg8::cvt_pk_bf16(vsrc[128], vsrc[192]);
                const s16x4 vb = __builtin_bit_cast(s16x4, vb_);
                const LAS unsigned char* gr = lds + OFF_GR + (c * 5) * 1024 + lane_ * 16;
#define RW_AFR(g_) ({ const f32x4 t_ = *(const LAS f32x4*)(gr + (g_) * 1024); v2u w_; w_.x = pg8::cvt_pk_bf16(t_[0], t_[1]); w_.y = pg8::cvt_pk_bf16(t_[2], t_[3]); __builtin_bit_cast(s16x4, w_); })
#define RW_PK4(x_) ({ v2u w_; w_.x = pg8::cvt_pk_bf16((x_)[0], (x_)[1]); w_.y = pg8::cvt_pk_bf16((x_)[2], (x_)[3]); __builtin_bit_cast(s16x4, w_); })
                const f32x4 zt = __builtin_amdgcn_mfma_f32_16x16x16bf16_1k(RW_AFR(1), vb, xt, 0, 0, 0);
                const f32x4 ut = __builtin_amdgcn_mfma_f32_16x16x16bf16_1k(RW_AFR(4), RW_PK4(zt), (f32x4){0.f, 0.f, 0.f, 0.f}, 0, 0, 0);
                const s16x4 ub = RW_PK4(ut);
                yt = __builtin_amdgcn_mfma_f32_16x16x16bf16_1k(RW_AFR(2), ub, yt, 0, 0, 0);
                yt = __builtin_amdgcn_mfma_f32_16x16x16bf16_1k(RW_AFR(3), vb, yt, 0, 0, 0);
#pragma unroll
                for (int e = 0; e < 4; ++e) ybuf[(16 * c + 4 * rg_ + e) * 64 + 16 * ib + rl_] = yt[e];
                const LAS unsigned char* tl_ = lds + OFF_TIL + (2 * c) * TIL_SZ + rl_ * TIL_PITCH + 8 * rg_;
                const LAS float* wc = (const LAS float*)(lds + OFF_WC) + c * 64 + 4 * rg_;
#pragma unroll
                for (int jt = 0; jt < 4; ++jt) {
                    f32x4 acc = ST[jt] * *(const LAS f32x4*)(wc + 16 * jt);
                    acc = __builtin_amdgcn_mfma_f32_16x16x16bf16_1k(*(const LAS s16x4*)(tl_ + TIL_SZ + 16 * jt * TIL_PITCH), vb, acc, 0, 0, 0);
                    acc = __builtin_amdgcn_mfma_f32_16x16x16bf16_1k(*(const LAS s16x4*)(tl_ + 16 * jt * TIL_PITCH), ub, acc, 0, 0, 0);
                    ST[jt] = acc;
                }
#undef RW_AFR
#undef RW_PK4
            }
        }
        __syncthreads();
        {
            const f32x4 y4 = *(const LAS f32x4*)(ybuf + tl * 64 + 4 * cg);
            const float mean = row_allsum((y4[0] + y4[1]) + (y4[2] + y4[3])) * (1.f / 64.f);
            const f32x4 dv = y4 - mean;
            const float var = row_allsum((dv[0] * dv[0] + dv[1] * dv[1]) + (dv[2] * dv[2] + dv[3] * dv[3])) * (1.f / 64.f);
            const float rs_ = rsqrtf(var + GN_EPS);
            const f32x4 yn = dv * rs_ * *(const LAS f32x4*)(myct + 28) + *(const LAS f32x4*)(myct + 32);
            const float bonus = scl[tl * 4 + 2];
            const f32x4 vs_ = *(const LAS f32x4*)(rkv + 2 * 2048 + tl * 64 + 4 * cg), g4 = *(const LAS f32x4*)(gbuf + tl * 64 + 4 * cg);
            const f32x4 o = (yn + vs_ * bonus) * g4;
            v2u w; w.x = pg8::cvt_pk_bf16(o[0], o[1]); w.y = pg8::cvt_pk_bf16(o[2], o[3]);
            *(v2u*)(ya + (rowb + t0 + tl) * 512 + c4) = w;
        }
        __syncthreads();
    }
}
}

typedef __bf16 bf16x2_t __attribute__((ext_vector_type(2)));
__device__ __forceinline__ float dot2bf(unsigned a, unsigned b, float c) { return __builtin_amdgcn_fdot2_f32_bf16(__builtin_bit_cast(bf16x2_t, a), __builtin_bit_cast(bf16x2_t, b), c, false); }
__device__ __forceinline__ unsigned f2ord(float f) { const unsigned u = __float_as_uint(f); return (u & 0x80000000u) ? ~u : (u | 0x80000000u); }
__device__ __forceinline__ float ord2f(unsigned o) { return __uint_as_float((o & 0x80000000u) ? (o ^ 0x80000000u) : ~o); }
__device__ __forceinline__ unsigned row_allmax_u32(unsigned v) {
    v = max(v, (unsigned)__builtin_amdgcn_update_dpp(0, (int)v, 0x128, 0xf, 0xf, false));
    v = max(v, (unsigned)__builtin_amdgcn_update_dpp(0, (int)v, 0x124, 0xf, 0xf, false));
    v = max(v, (unsigned)__builtin_amdgcn_update_dpp(0, (int)v, 0x122, 0xf, 0xf, false));
    v = max(v, (unsigned)__builtin_amdgcn_update_dpp(0, (int)v, 0x121, 0xf, 0xf, false));
    return v;
}

constexpr int TK_PITCH = 272, TK_HALF = 128 * TK_PITCH;
typedef short tk_bf16x8 __attribute__((ext_vector_type(8)));
__device__ __forceinline__ void topk_loadq(tk_bf16x8 (&qa)[8], const bf16_t* __restrict__ qb, int t0, int h, int lane) {
    const bf16_t* qp = qb + (size_t)(t0 + (lane & 15)) * 2048 + h * 256 + 8 * (lane >> 4);
#pragma unroll
    for (int i = 0; i < 8; ++i) qa[i] = *(const tk_bf16x8*)(qp + i * 32);
}
__device__ __forceinline__ void topk_item(const tk_bf16x8 (&qa)[8], const LAS unsigned char* klds, int* __restrict__ ids, float* __restrict__ gates, int t0, int h, int lane) {
    const int rl = lane & 15, rg = lane >> 4;
    unsigned top[2][4];
#pragma unroll
    for (int c = 0; c < 2; ++c) {
        f32x4 acc[8];
#pragma unroll
        for (int nt = 0; nt < 8; ++nt) acc[nt] = (f32x4){64.f, 64.f, 64.f, 64.f};
        const LAS unsigned char* kp = klds + c * TK_HALF + rl * TK_PITCH + 16 * rg;
#pragma unroll
        for (int ks = 0; ks < 4; ++ks) {
#pragma unroll
            for (int nt = 0; nt < 8; ++nt) { const tk_bf16x8 b = *(const LAS tk_bf16x8*)(kp + nt * 16 * TK_PITCH + ks * 64); acc[nt] = __builtin_amdgcn_mfma_f32_16x16x32_bf16(qa[c * 4 + ks], b, acc[nt], 0, 0, 0); }
            __builtin_amdgcn_sched_barrier(0);
        }
        unsigned k[4][8];
#pragma unroll
        for (int r = 0; r < 4; ++r) {
#pragma unroll
            for (int nt = 0; nt < 8; ++nt) k[r][nt] = (__float_as_uint(fmaxf(acc[nt][r], 1.f)) & ~127u) | (unsigned)(127 - (nt * 16 + rl));
#define TK_CE(i, j) do { const unsigned a_ = max(k[r][i], k[r][j]), b_ = min(k[r][i], k[r][j]); k[r][i] = a_; k[r][j] = b_; } while (0)
            TK_CE(0, 1); TK_CE(2, 3); TK_CE(4, 5); TK_CE(6, 7); TK_CE(0, 2); TK_CE(1, 3); TK_CE(4, 6); TK_CE(5, 7); TK_CE(1, 2); TK_CE(5, 6);
            TK_CE(0, 4); TK_CE(1, 5); TK_CE(2, 6); TK_CE(3, 7); TK_CE(2, 4); TK_CE(3, 5); TK_CE(1, 2); TK_CE(3, 4); TK_CE(5, 6);
#undef TK_CE
        }
        unsigned tp[4] = {0u, 0u, 0u, 0u};
        for (int round = 0; round < 16; ++round) {
#pragma unroll
            for (int r = 0; r < 4; ++r) {
                const unsigned m = row_allmax_u32(k[r][0]);
                tp[r] = (rl == round) ? m : tp[r];
                const bool win = (k[r][0] == m);
                k[r][0] = win ? k[r][1] : k[r][0]; k[r][1] = win ? k[r][2] : k[r][1]; k[r][2] = win ? k[r][3] : k[r][2]; k[r][3] = win ? k[r][4] : k[r][3];
                k[r][4] = win ? k[r][5] : k[r][4]; k[r][5] = win ? k[r][6] : k[r][5]; k[r][6] = win ? k[r][7] : k[r][6]; k[r][7] = win ? 0u : k[r][7];
            }
        }
#pragma unroll
        for (int r = 0; r < 4; ++r) top[c][r] = tp[r];
    }
    const int rowbase = lane & 48;
    float v1[4]; int n1[4], ptr[4], myid[4]; unsigned k2[4], myv[4];
#pragma unroll
    for (int r = 0; r < 4; ++r) { v1[r] = __uint_as_float(top[0][r] & ~127u); n1[r] = 127 - (int)(top[0][r] & 127u); ptr[r] = 0; k2[r] = (unsigned)__builtin_amdgcn_ds_bpermute(rowbase * 4, (int)top[1][r]); myid[r] = 0; myv[r] = 0u; }
    for (int round = 0; round < 16; ++round) {
#pragma unroll
        for (int r = 0; r < 4; ++r) {
            const float head = v1[r] + __uint_as_float(k2[r] & ~127u);
            const unsigned key = (ptr[r] < 16) ? ((__float_as_uint(head) & ~15u) | (unsigned)(15 - rl)) : 0u;
            const unsigned m = row_allmax_u32(key);
            const bool win = (key == m);
            const unsigned wid = row_allmax_u32(win ? (unsigned)(n1[r] * 128 + (127 - (int)(k2[r] & 127u))) + 1u : 0u);
            myid[r] = (rl == round) ? (int)wid - 1 : myid[r];
            myv[r] = (rl == round) ? m : myv[r];
            ptr[r] += win ? 1 : 0;
            k2[r] = (unsigned)__builtin_amdgcn_ds_bpermute((rowbase + (ptr[r] & 15)) * 4, (int)top[1][r]);
        }
    }
#pragma unroll
    for (int r = 0; r < 4; ++r) {
        const float val = __uint_as_float(myv[r] & ~15u);
        const float vmax = __uint_as_float((unsigned)__builtin_amdgcn_ds_bpermute(rowbase * 4, (int)__float_as_uint(val)));
        const float e = __expf(val - vmax);
        const float sum = rw::row_allsum(e);
        gates[(size_t)(t0 + 4 * rg + r) * 128 + h * 16 + rl] = e / sum; ids[(size_t)(t0 + 4 * rg + r) * 128 + h * 16 + rl] = myid[r];
    }
}

typedef float f32x2 __attribute__((ext_vector_type(2)));
__device__ __forceinline__ void peer_token(const bf16_t* __restrict__ x2b, const float* __restrict__ ssq2, const int* __restrict__ ids, const float* __restrict__ gates,
                                           const unsigned char* __restrict__ U8, const unsigned char* __restrict__ V8, const float* __restrict__ usc, const float* __restrict__ vsc,
                                           const float* __restrict__ fw, float* __restrict__ out, int t, int lane) {
    const int l16 = lane * 16;
    f32x2 hx[8];
    {
        const v4u h0 = *(const v4u*)(x2b + (size_t)t * DM + l16), h1 = *(const v4u*)(x2b + (size_t)t * DM + l16 + 8);
        const unsigned hw[8] = {h0.x, h0.y, h0.z, h0.w, h1.x, h1.y, h1.z, h1.w};
#pragma unroll
        for (int i = 0; i < 8; ++i) hx[i] = (f32x2){pg8::bflo(hw[i]), pg8::bfhi(hw[i])};
    }
    const int idA = ids[(size_t)t * 128 + lane], idB = ids[(size_t)t * 128 + 64 + lane];
    const float rs = rsqrtf(pg8::ssq_sum16(ssq2 + (size_t)t * 16) * (1.f / DM) + NORM_EPS);
    const float suA = rs * usc[idA], suB = rs * usc[idB];
    const float svA = gates[(size_t)t * 128 + lane] * vsc[idA], svB = gates[(size_t)t * 128 + 64 + lane] * vsc[idB];
    f32x2 y[8];
#pragma unroll
    for (int i = 0; i < 8; ++i) y[i] = (f32x2){0.f, 0.f};
    const int bit0 = lane & 1, bit1 = (lane >> 1) & 1, bit5 = lane >> 5;
    v3u_t uw[8], vw[8];
    const unsigned vo12 = (unsigned)lane * 12u;
#define PEER_LDU(g_) do { const int is_ = ((g_) < 8) ? idA : idB; const int lb_ = ((g_) * 8) & 63; _Pragma("unroll") for (int k = 0; k < 8; ++k) { const unsigned eo = (unsigned)__builtin_amdgcn_readlane(is_, lb_ + k) * 768u; \
        const unsigned char* rp_ = U8 + eo; uw[k] = *(const v3u_t*)(rp_ + vo12); } } while (0)
#define PEER_LDV(g_) do { const int is_ = ((g_) < 8) ? idA : idB; const int lb_ = ((g_) * 8) & 63; _Pragma("unroll") for (int k = 0; k < 8; ++k) { const unsigned eo = (unsigned)__builtin_amdgcn_readlane(is_, lb_ + k) * 768u; \
        const unsigned char* rp_ = V8 + eo; vw[k] = *(const v3u_t*)(rp_ + vo12); } } while (0)
    PEER_LDU(0); PEER_LDV(0);
    for (int g = 0; g < 16; ++g) {
        const float susel = (g < 8) ? suA : suB, svsel = (g < 8) ? svA : svB; const int lb = (g * 8) & 63;
        float d[8];
#pragma unroll
        for (int k = 0; k < 8; k += 2) {
            const v32f_t f = __builtin_amdgcn_cvt_scalef32_pk32_f32_fp6((v6u_t){uw[k][0], uw[k][1], uw[k][2], uw[k + 1][0], uw[k + 1][1], uw[k + 1][2]}, 1.0f);
            f32x2 a = (f32x2){0.f, 0.f}, b = a;
#pragma unroll
            for (int i = 0; i < 8; ++i) { a += (f32x2){f[2 * i], f[2 * i + 1]} * hx[i]; b += (f32x2){f[16 + 2 * i], f[17 + 2 * i]} * hx[i]; }
            d[k] = a[0] + a[1]; d[k + 1] = b[0] + b[1];
            __builtin_amdgcn_sched_barrier(0);
        }
        if (g + 1 < 16) PEER_LDU(g + 1);
        __builtin_amdgcn_sched_barrier(0);
#pragma unroll
        for (int k = 0; k < 8; ++k) d[k] *= __uint_as_float((unsigned)__builtin_amdgcn_readlane((int)__float_as_uint(susel), lb + k));
        float r4[4];
#pragma unroll
        for (int k = 0; k < 4; ++k) { const float send = bit0 ? d[k] : d[k + 4], keep = bit0 ? d[k + 4] : d[k]; r4[k] = keep + rw::dppf<0xB1>(send); }
        float r2[2];
#pragma unroll
        for (int k = 0; k < 2; ++k) { const float send = bit1 ? r4[k] : r4[k + 2], keep = bit1 ? r4[k + 2] : r4[k]; r2[k] = keep + rw::dppf<0x4E>(send); }
        float r1;
        { const float send = bit5 ? r2[0] : r2[1], keep = bit5 ? r2[1] : r2[0];
          auto rr = __builtin_amdgcn_permlane32_swap(__float_as_uint(send), __float_as_uint(send), false, false);
          r1 = keep + __uint_as_float(bit5 ? rr[0] : rr[1]); }
        r1 += rw::dppf<0x128>(r1); r1 += rw::dppf<0x124>(r1);
        r1 += __uint_as_float((unsigned)__builtin_amdgcn_ds_swizzle((int)__float_as_uint(r1), 0x401F));
        const float dd = r1;
        const float act = 0.5f * dd * (1.f + erff(dd * 0.70710678118654752f));
#pragma unroll
        for (int k = 0; k < 8; k += 2) {
#define PEER_LANE_OF(k_) ((((k_) >> 2) & 1) | ((((k_) >> 1) & 1) << 1) | (((k_) & 1) << 5))
            const float a = __uint_as_float((unsigned)__builtin_amdgcn_readlane((int)__float_as_uint(act), PEER_LANE_OF(k))) * __uint_as_float((unsigned)__builtin_amdgcn_readlane((int)__float_as_uint(svsel), lb + k));
            const float b = __uint_as_float((unsigned)__builtin_amdgcn_readlane((int)__float_as_uint(act), PEER_LANE_OF(k + 1))) * __uint_as_float((unsigned)__builtin_amdgcn_readlane((int)__float_as_uint(svsel), lb + k + 1));
#undef PEER_LANE_OF
            const f32x2 a2 = (f32x2){a, a}, b2 = (f32x2){b, b};
            const v32f_t f = __builtin_amdgcn_cvt_scalef32_pk32_f32_fp6((v6u_t){vw[k][0], vw[k][1], vw[k][2], vw[k + 1][0], vw[k + 1][1], vw[k + 1][2]}, 1.0f);
#pragma unroll
            for (int i = 0; i < 8; ++i) { y[i] += (f32x2){f[2 * i], f[2 * i + 1]} * a2; y[i] += (f32x2){f[16 + 2 * i], f[17 + 2 * i]} * b2; }
            __builtin_amdgcn_sched_barrier(0);
        }
        if (g + 1 < 16) PEER_LDV(g + 1);
        __builtin_amdgcn_sched_barrier(0);
    }
#undef PEER_LDU
#undef PEER_LDV
    float* orow = out + (size_t)t * DM + l16;
    float ss = 0.f;
    f32x4 o4[4];
#pragma unroll
    for (int i = 0; i < 4; ++i) { o4[i] = (f32x4){hx[2 * i][0] + y[2 * i][0], hx[2 * i][1] + y[2 * i][1], hx[2 * i + 1][0] + y[2 * i + 1][0], hx[2 * i + 1][1] + y[2 * i + 1][1]};
        ss += (o4[i][0] * o4[i][0] + o4[i][1] * o4[i][1]) + (o4[i][2] * o4[i][2] + o4[i][3] * o4[i][3]); }
    ss = wave_sum(ss);
    const float r = rsqrtf(ss * (1.f / DM) + NORM_EPS);
#pragma unroll
    for (int i = 0; i < 4; ++i) *(f32x4*)(orow + 4 * i) = o4[i] * r * *(const f32x4*)(fw + l16 + 4 * i);
}

__global__ void __launch_bounds__(NWAVES * 64, 2) mk_fwd(Args args) {
    extern __shared__ __attribute__((aligned(16))) unsigned char lds_raw[];
    LAS unsigned char* lds = (LAS unsigned char*)lds_raw;
    volatile LAS unsigned* MISC = (volatile LAS unsigned*)(lds + MISC_OFF);
    const int tid = threadIdx.x, lane = tid & 63, wave = __builtin_amdgcn_readfirstlane(tid >> 6);
    const int G = gridDim.x; const int bx = blockIdx.x; const int vcu = (G % 8 == 0) ? (bx % 8) * (G / 8) + bx / 8 : bx;
    unsigned char* ws = args.ws;
    unsigned* ctl = (unsigned*)(ws + WS_CTL);
    for (int u = tid; u < (LDS_BYTES - LDSCTL_OFF) / 4; u += NWAVES * 64) ((LAS unsigned*)(lds + LDSCTL_OFF))[u] = 0u;
    __syncthreads();
    XcdBarrier bar = xcd_barrier_post(ctl + CW_BAR + args.li * XCD_BAR_WORDS, MISC + 8);
    const int lo = args.ph_lo, hi = args.ph_hi;
#define IN(k) (lo <= (k) && (k) < hi)
#define BOTH(k) (IN(k) && IN((k) + 1))
    bf16_t* WinT = (bf16_t*)(ws + WS_WIN); bf16_t* PaT = (bf16_t*)(ws + WS_PA); bf16_t* PbT = (bf16_t*)(ws + WS_PB); bf16_t* WoT = (bf16_t*)(ws + WS_WO);
    bf16_t* WqT = (bf16_t*)(ws + WS_WQ); bf16_t* KeysB = (bf16_t*)(ws + WS_KEYS);
    float* rstd1 = (float*)(ws + WS_RSTD1); float* ssq2 = (float*)(ws + WS_RSTD2); float* scal = (float*)(ws + WS_SCAL);
    unsigned char* U8 = ws + WS_U; unsigned char* V8 = ws + WS_V; float* usc = (float*)(ws + WS_USC); float* vsc = (float*)(ws + WS_VSC);
    bf16_t* xb = (bf16_t*)(ws + WS_XB); bf16_t* ya = (bf16_t*)(ws + WS_YA); bf16_t* yb = (bf16_t*)(ws + WS_YB); bf16_t* x2b = (bf16_t*)(ws + WS_X2B);
    bf16_t* z = (bf16_t*)(ws + WS_Z); bf16_t* qb = (bf16_t*)(ws + WS_Q);
    bf16_t* merged = (bf16_t*)(ws + WS_MERGED);
    const int gw = vcu * NWAVES + wave, NGW = G * NWAVES;

    if (IN(0)) {
        LAS float* scr = (LAS float*)(lds + wave * 16384);
        constexpr int I_IN = (DM / 64) * (NZ / 32), I_PA = (512 / 64) * (DM / 32), I_WO = (DM / 64) * (DM / 32), I_WQ = (DM / 64) * (2048 / 32);
        constexpr int NITEMS = I_IN + 2 * I_PA + I_WO + I_WQ;
        for (int it = gw; it < NITEMS; it += NGW) {
            int r = it;
            if (r < I_IN) { p0_transpose_item(args.in[2], args.in[1], DM, NZ, WinT, scr, r, lane); continue; } r -= I_IN;
            if (r < I_PA) { p0_transpose_item(args.in[19], nullptr, 512, DM, PaT, scr, r, lane); continue; } r -= I_PA;
            if (r < I_PA) { p0_transpose_item(args.in[20], nullptr, 512, DM, PbT, scr, r, lane); continue; } r -= I_PA;
            if (r < I_WO) { p0_transpose_item(args.in[21], nullptr, DM, DM, WoT, scr, r, lane); continue; } r -= I_WO;
            p0_transpose_item(args.in[23], args.in[22], DM, 2048, WqT, scr, r, lane);
        }
        p0_convert(args.in[24], nullptr, KeysB, (size_t)16 * 128 * 128, gw, NGW, lane);
        for (int e = gw; e < 2 * NEXP; e += NGW) {
            const bool isu = e < NEXP; const int row = isu ? e : e - NEXP;
            p0_row_fp6((isu ? args.in[25] : args.in[26]) + (size_t)row * DM, isu ? args.in[22] : nullptr, (isu ? U8 : V8) + (size_t)row * 768, (isu ? usc : vsc) + row, lane);
        }
        for (int m = gw; m < T_TOK; m += NGW) {
            const f32x4* xr = (const f32x4*)(args.in[0] + (size_t)m * DM) + lane;
            f32x4 v[4]; float s = 0.f;
#pragma unroll
            for (int j = 0; j < 4; ++j) { v[j] = xr[64 * j]; s += (v[j][0] * v[j][0] + v[j][1] * v[j][1]) + (v[j][2] * v[j][2] + v[j][3] * v[j][3]); }
            s = wave_sum(s);
            v2u* o8 = (v2u*)(xb + (size_t)m * DM) + lane;
#pragma unroll
            for (int j = 0; j < 4; ++j) { v2u w; w.x = pg8::cvt_pk_bf16(v[j][0], v[j][1]); w.y = pg8::cvt_pk_bf16(v[j][2], v[j][3]); o8[64 * j] = w; }
            if (lane == 0) rstd1[m] = rsqrtf(s * (1.f / DM) + NORM_EPS);
        }
        if (gw == 0) {
            const float a = wave_sum(args.in[14][lane] * args.in[15][lane]), b = wave_sum(args.in[16][lane] * args.in[17][lane]);
            if (lane == 0) scal[0] = __expf(a) - __expf(b) + LAM_INIT;
        }
        if (BOTH(0)) xcd_barrier(bar);
    }
    if (IN(1)) {
        pg8::Gemm g{xb, WinT, DM, DM, DM}; pg8::StaticOrder S; S.init(T_TOK, NZ, G, bx);
        pg8::EpiRowScale<false> E{z, NZ, rstd1};
        for (int rep = 0; rep < REPS(1); ++rep) pg8::gemm_phase(lds, g, S, E);
        if (BOTH(1)) xcd_barrier(bar);
    }
    if (IN(2)) {
        {
            const rw::ScanP P{args.in[3], args.in[4], args.in[5], args.in[6], args.in[7], args.in[8], args.in[9], args.in[10], args.in[11], args.in[12], args.in[13]};
            for (int rep = 0; rep < REPS(2); ++rep) for (int u = vcu; u < NB * 8; u += G) rw::scan_unit(lds, z, ya, P, u >> 3, u & 7, tid, wave, lane);
        }
        const float lam = scal[0];
        __syncthreads();
        for (int i = 0;; ++i) {
            int idx = vcu + i * G; if (idx >= 2048 * REPS(10)) break;
            idx &= 2047;
            const int slot = idx >> 8, v = idx & 255, bh = v >> 1, a = (v & 1) * 4 + (slot >> 1), qblk = (slot & 1) ? 15 - a : a;
            da::attn_unit(lds, z, yb, args.in[18], lam, bh >> 2, bh & 3, qblk, wave, lane);
        }
        if (BOTH(2)) xcd_barrier(bar);
    }
    if (IN(3)) {
        pg8::Gemm g{ya, PaT, 512, 512, 512}; pg8::StaticOrder S; S.init(T_TOK, DM, G, bx);
        pg8::EpiGate<false> E{merged, z, C_GA};
        pg8::gemm_phase(lds, g, S, E);
        if (BOTH(3)) xcd_barrier(bar);
    }
    if (IN(4)) {
        pg8::Gemm g{yb, PbT, 512, 512, 512}; pg8::StaticOrder S; S.init(T_TOK, DM, G, bx);
        pg8::EpiGate<true> E{merged, z, C_GB};
        pg8::gemm_phase(lds, g, S, E);
        if (BOTH(4)) xcd_barrier(bar);
    }
    if (IN(5)) {
        pg8::Gemm g{merged, WoT, DM, DM, DM}; pg8::StaticOrder S; S.init(T_TOK, DM, G, bx);
        pg8::EpiX2 E{args.in[0], args.out, x2b, ssq2};
        pg8::gemm_phase(lds, g, S, E);
        if (BOTH(5)) xcd_barrier(bar);
    }
    if (IN(6)) {
        pg8::Gemm g{x2b, WqT, DM, DM, DM}; pg8::StaticOrder S; S.init(T_TOK, 2048, G, bx);
        pg8::EpiRowScale<true> E{qb, 2048, ssq2};
        for (int rep = 0; rep < REPS(6); ++rep) pg8::gemm_phase(lds, g, S, E);
        if (BOTH(6)) xcd_barrier(bar);
    }
    if (IN(7)) {
        int* ids = (int*)(ws + WS_IDS); float* gates = (float*)(ws + WS_GATES);
        for (int rep = 0; rep < REPS(7); ++rep)
        for (int h = 0; h < 8; ++h) {
            __syncthreads();
            {
                const bf16_t* ksrc = KeysB + (size_t)h * 2 * 128 * 128;
#pragma unroll
                for (int i = 0; i < 8; ++i) { const int chunk = tid + i * 512, row = chunk >> 4, cc = chunk & 15;
                    *(LAS v4u*)(lds + (row >> 7) * TK_HALF + (row & 127) * TK_PITCH + cc * 16) = *(const v4u*)(ksrc + (size_t)row * 128 + cc * 8); }
            }
            __syncthreads();
            for (int tile = gw; tile < 4096; tile += NGW) {
                tk_bf16x8 qa[8];
                topk_loadq(qa, qb, tile * 16, h, lane);
                topk_item(qa, lds, ids, gates, tile * 16, h, lane);
            }
        }
        if (BOTH(7)) xcd_barrier(bar);
    }
    if (IN(8)) {
        const int* ids = (const int*)(ws + WS_IDS); const float* gates = (const float*)(ws + WS_GATES);
        for (int t = gw; t < T_TOK; t += NGW) peer_token(x2b, ssq2, ids, gates, U8, V8, usc, vsc, args.in[27], args.out, t, lane);
    }
#undef IN
#undef BOTH
}

extern "C" void kernel_launch(void* const* d_in, const int* in_sizes, int n_in, void* d_out, int out_size, void* d_ws, size_t ws_size, hipStream_t stream) {
    static int grid = 0;
    if (grid == 0) {
        if (n_in != 28 || in_sizes[0] != T_TOK * DM || out_size != T_TOK * DM || ws_size < WS_END) {
            fprintf(stderr, "kernel_launch: unexpected shapes / workspace (n_in %d, ws %zu < %zu)\n", n_in, ws_size, (size_t)WS_END); grid = -1; return; }
        int dev = 0, cus = 0;
        if (hipGetDevice(&dev) != hipSuccess || hipDeviceGetAttribute(&cus, hipDeviceAttributeMultiprocessorCount, dev) != hipSuccess) { grid = -1; return; }
        if (hipFuncSetAttribute((const void*)mk_fwd, hipFuncAttributeMaxDynamicSharedMemorySize, LDS_BYTES) != hipSuccess) { fprintf(stderr, "kernel_launch: hipFuncSetAttribute failed\n"); grid = -1; return; }
        grid = cus;
    }
    if (grid < 0) return;
    unsigned char* ws = (unsigned char*)d_ws;
    float* out = (float*)d_out;
    (void)hipMemsetAsync(ws + WS_CTL, 0, 1 * MiB, stream);
    Args a{};
    for (int i = 0; i < 28; ++i) a.in[i] = (const float*)d_in[i];
    a.out = out; a.ws = ws;
    a.ph_lo = 0; a.ph_hi = 9; a.li = 0;
    hipLaunchKernelGGL(mk_fwd, dim3(grid), dim3(NWAVES * 64), LDS_BYTES, stream, a);
}
```

```cpp
#include <hip/hip_runtime.h>
#include <stdint.h>
#include <cstdio>

typedef unsigned short bf16_t;
typedef unsigned int u32;

#ifndef PROBE_REP
#define PROBE_REP 0
#endif
#define REPS(k) (((PROBE_REP >> (k)) & 1) ? 2 : 1)
constexpr int T_TOK = 65536, DM = 1024, SEQ = 2048, NB = 32;
constexpr int NZ = 5376;
constexpr int C_R = 0, C_K = 512, C_V = 1024, C_WL = 1536, C_AL = 1600, C_GL = 1664, C_Q = 1792, C_ZK = 2304, C_ZV = 2816, C_GA = 3328, C_GB = 4352;
constexpr int NEXP = 16384;
constexpr float NORM_EPS = 1e-6f, GN_EPS = 64e-5f, SUBLN_EPS = 1e-5f;
constexpr float LAM_INIT = 0.2f;

constexpr size_t MiB = 1u << 20;
constexpr size_t WS_CTL = 0;
constexpr size_t WS_WIN = 1 * MiB;
constexpr size_t WS_PA = 12 * MiB;
constexpr size_t WS_PB = 13 * MiB;
constexpr size_t WS_WO = 14 * MiB;
constexpr size_t WS_WQ = 16 * MiB;
constexpr size_t WS_KEYS = 20 * MiB;
constexpr size_t WS_RSTD1 = 21 * MiB;
constexpr size_t WS_RSTD2 = 58 * MiB;
constexpr size_t WS_SCAL = 23 * MiB;
constexpr size_t WS_U = 24 * MiB;
constexpr size_t WS_V = 40 * MiB;
constexpr size_t WS_USC = 56 * MiB;
constexpr size_t WS_VSC = 57 * MiB;
constexpr size_t WS_XB = 88 * MiB;
constexpr size_t WS_YA = WS_XB;
constexpr size_t WS_YB = WS_XB + 64 * MiB;
constexpr size_t WS_X2B = WS_XB;
constexpr size_t WS_Z = 216 * MiB;
constexpr size_t WS_Q = WS_Z;
constexpr size_t WS_IDS = WS_Z + 256 * MiB;
constexpr size_t WS_GATES = WS_Z + 288 * MiB;
constexpr size_t WS_MERGED = 888 * MiB;
constexpr size_t WS_END = 1016 * MiB;

__device__ __forceinline__ float bf2f(bf16_t h) { return __uint_as_float(((u32)h) << 16); }
__device__ __forceinline__ bf16_t f2bf(float f) { u32 u = __float_as_uint(f); u += 0x7fffu + ((u >> 16) & 1u); return (bf16_t)(u >> 16); }
__device__ __forceinline__ float wave_sum(float v) {
#pragma unroll
    for (int o = 1; o < 64; o <<= 1) v += __shfl_xor(v, o);
    return v;
}
__device__ __forceinline__ float sigmoidf_(float x) { return __builtin_amdgcn_rcpf(1.f + __expf(-x)); }

namespace pg8 {
#define PG8_LAS __attribute__((address_space(3)))
typedef short bf16x8 __attribute__((ext_vector_type(8)));
typedef float f32x4 __attribute__((ext_vector_type(4)));
typedef unsigned u32x4 __attribute__((ext_vector_type(4)));
constexpr int BM = 256, BK = 64, HALF = 128, HTB = HALF * BK * 2  , STAGE_BYTES = 8 * HTB, NXCD = 8, WGM = 8;

__host__ __device__ __forceinline__ int lds_byte(int r, int c) { const int st = (r >> 4) * 2 + (c >> 5), rr = r & 15, cc = c & 31, ob = rr * 64 + cc * 2; return st * 1024 + (ob ^ (((ob >> 9) & 1) << 5)); }
__host__ __device__ __forceinline__ void stage_rc(int b, int& R, int& C) { const int st = b / 1024, sb = b % 1024, swz = sb ^ (((sb >> 9) & 1) << 5); R = (st >> 1) * 16 + swz / 64; C = (st & 1) * 32 + (swz % 64) / 2; }
__host__ __device__ __forceinline__ int perm32(int rho) { const int n = rho >> 4, i = rho & 15; return 8 * (i >> 2) + 4 * n + (i & 3); }

struct Unit { int pm, pn; };
struct Gemm { const bf16_t* A; const bf16_t* Bt; int lda, ldb, K; };

struct StaticOrder {
    int nM, nN, nwg, G, c;
    __host__ __device__ void init(int M, int N, int G_, int c_) { nM = M / BM; nN = N / BM; nwg = nM * nN; G = G_; c = c_; }
    __host__ __device__ bool next(int i, Unit& u) const {
        const long L = (long)i * G + c; if (L >= nwg) return false;
        int wgid = (int)L; { const int q = nwg / NXCD, r = nwg % NXCD, xcd = wgid % NXCD, off = wgid / NXCD; wgid = (xcd < r ? xcd * (q + 1) : r * (q + 1) + (xcd - r) * q) + off; }
        const int nig = WGM * nN, gid = wgid / nig, fm = gid * WGM, gsz = (nM - fm) < WGM ? (nM - fm) : WGM;
        u.pm = fm + ((wgid % nig) % gsz); u.pn = (wgid % nig) / gsz; return true;
    }
};
typedef float f32x2_c __attribute__((ext_vector_type(2))); typedef __bf16 bf16x2_c __attribute__((ext_vector_type(2)));
__device__ __forceinline__ unsigned cvt_pk_bf16(float lo, float hi) { const f32x2_c v = {lo, hi}; const bf16x2_c b = __builtin_convertvector(v, bf16x2_c); return __builtin_bit_cast(unsigned, b); }
__device__ __forceinline__ float bflo(unsigned w) { return __uint_as_float(w << 16); }
__device__ __forceinline__ float bfhi(unsigned w) { return __uint_as_float(w & 0xffff0000u); }

__device__ __forceinline__ float ssq_sum16(const float* p) {
    const f32x4 a = *(const f32x4*)p, b = *(const f32x4*)(p + 4), c = *(const f32x4*)(p + 8), d = *(const f32x4*)(p + 12);
    return (((a[0] + a[1]) + (a[2] + a[3])) + ((b[0] + b[1]) + (b[2] + b[3]))) + (((c[0] + c[1]) + (c[2] + c[3])) + ((d[0] + d[1]) + (d[2] + d[3])));
}
template <bool SSQ> struct EpiRowScale {
    static constexpr bool PERM = true;
    bf16_t* O; int ldc; const float* rs;
    __device__ __forceinline__ void operator()(const f32x4 (&acc)[2][2][4][2], const Unit& u, int wr, int wc, int fr, int fq) const {
        const int row0 = u.pm * BM + wr * 64 + fr, col0 = u.pn * BM + wc * 32 + 8 * fq;
#pragma unroll
        for (int ai = 0; ai < 2; ++ai)
#pragma unroll
            for (int m = 0; m < 4; ++m) {
                const int row = row0 + ai * HALF + m * 16;
                float s; if (SSQ) s = rsqrtf(ssq_sum16(rs + (size_t)row * 16) * (1.f / 1024.f) + NORM_EPS); else s = rs[row];
                bf16_t* rowp = O + (size_t)row * ldc + col0;
#pragma unroll
                for (int bj = 0; bj < 2; ++bj) {
                    const f32x4 v0 = acc[ai][bj][m][0] * s, v1 = acc[ai][bj][m][1] * s;
                    u32x4 w; w.x = cvt_pk_bf16(v0[0], v0[1]); w.y = cvt_pk_bf16(v0[2], v0[3]); w.z = cvt_pk_bf16(v1[0], v1[1]); w.w = cvt_pk_bf16(v1[2], v1[3]);
                    *(u32x4*)(rowp + bj * HALF) = w;
                }
            }
    }
};
template <bool ACCUM> struct EpiGate {
    static constexpr bool PERM = true;
    bf16_t* mg; const bf16_t* z; int gcol;
    __device__ __forceinline__ void operator()(const f32x4 (&acc)[2][2][4][2], const Unit& u, int wr, int wc, int fr, int fq) const {
        const int row0 = u.pm * BM + wr * 64 + fr, col0 = u.pn * BM + wc * 32 + 8 * fq;
#pragma unroll
        for (int ai = 0; ai < 2; ++ai)
#pragma unroll
            for (int m = 0; m < 4; ++m) {
                const int row = row0 + ai * HALF + m * 16;
                const bf16_t* gp = z + (size_t)row * NZ + gcol + col0;
                bf16_t* rowp = mg + (size_t)row * DM + col0;
#pragma unroll
                for (int bj = 0; bj < 2; ++bj) {
                    const u32x4 g = *(const u32x4*)(gp + bj * HALF);
                    const f32x4 a0 = acc[ai][bj][m][0], a1 = acc[ai][bj][m][1];
                    float r[8];
                    r[0] = sigmoidf_(bflo(g.x)) * a0[0]; r[1] = sigmoidf_(bfhi(g.x)) * a0[1]; r[2] = sigmoidf_(bflo(g.y)) * a0[2]; r[3] = sigmoidf_(bfhi(g.y)) * a0[3];
                    r[4] = sigmoidf_(bflo(g.z)) * a1[0]; r[5] = sigmoidf_(bfhi(g.z)) * a1[1]; r[6] = sigmoidf_(bflo(g.w)) * a1[2]; r[7] = sigmoidf_(bfhi(g.w)) * a1[3];
                    if (ACCUM) { const u32x4 o = *(const u32x4*)(rowp + bj * HALF);
                        r[0] += bflo(o.x); r[1] += bfhi(o.x); r[2] += bflo(o.y); r[3] += bfhi(o.y); r[4] += bflo(o.z); r[5] += bfhi(o.z); r[6] += bflo(o.w); r[7] += bfhi(o.w); }
                    u32x4 w; w.x = cvt_pk_bf16(r[0], r[1]); w.y = cvt_pk_bf16(r[2], r[3]); w.z = cvt_pk_bf16(r[4], r[5]); w.w = cvt_pk_bf16(r[6], r[7]);
                    *(u32x4*)(rowp + bj * HALF) = w;
                }
            }
    }
};
struct EpiX2 {
    static constexpr bool PERM = true;
    const float* x; float* x2; bf16_t* x2b; float* ssq;
    __device__ __forceinline__ void operator()(const f32x4 (&acc)[2][2][4][2], const Unit& u, int wr, int wc, int fr, int fq) const {
        const int row0 = u.pm * BM + wr * 64 + fr, col0 = u.pn * BM + wc * 32 + 8 * fq;
#pragma unroll
        for (int ai = 0; ai < 2; ++ai)
#pragma unroll
            for (int m = 0; m < 4; ++m) {
                const int row = row0 + ai * HALF + m * 16;
                const size_t off = (size_t)row * DM + col0;
                float ss = 0.f;
#pragma unroll
                for (int bj = 0; bj < 2; ++bj) {
                    const f32x4 x0 = *(const f32x4*)(x + off + bj * HALF), x1 = *(const f32x4*)(x + off + bj * HALF + 4);
                    const f32x4 o0 = x0 + acc[ai][bj][m][0], o1 = x1 + acc[ai][bj][m][1];
                    u32x4 w; w.x = cvt_pk_bf16(o0[0], o0[1]); w.y = cvt_pk_bf16(o0[2], o0[3]); w.z = cvt_pk_bf16(o1[0], o1[1]); w.w = cvt_pk_bf16(o1[2], o1[3]);
                    *(u32x4*)(x2b + off + bj * HALF) = w;
                    ss += (o0[0] * o0[0] + o0[1] * o0[1]) + (o0[2] * o0[2] + o0[3] * o0[3]) + (o1[0] * o1[0] + o1[1] * o1[1]) + (o1[2] * o1[2] + o1[3] * o1[3]);
                }
                ss += __shfl_xor(ss, 16); ss += __shfl_xor(ss, 32);
                if (fq == 0) ssq[(size_t)row * 16 + (u.pn & 3) * 4 + wc] = ss;
            }
    }
};

template <class Epi, class Sched>
__device__ __forceinline__ void gemm_phase(PG8_LAS unsigned char* lds, const Gemm g, const Sched& S, const Epi& E) {
    const int tid = threadIdx.x, wid = __builtin_amdgcn_readfirstlane(tid >> 6), lane = tid & 63, wr = wid >> 2, wc = wid & 3, fr = lane & 15, fq = lane >> 4;
    const int K = g.K, nt = K / BK;
    unsigned voffA[2], voffB[2];
#pragma unroll
    for (int i = 0; i < 2; ++i) { int R, C; stage_rc(tid * 16 + i * 8192, R, C); const int Rb = Epi::PERM ? ((R & ~31) + perm32(R & 31)) : R;
        voffA[i] = (unsigned)(R * g.lda + C) * 2u; voffB[i] = (unsigned)(Rb * g.ldb + C) * 2u; }
    const size_t kstep = (size_t)(BK * 2);
    const size_t hstepA = (size_t)HALF * g.lda * 2, hstepB = (size_t)HALF * g.ldb * 2;
    const size_t tstepA = 2 * hstepA, tstepB = 2 * hstepB;
    const unsigned ldsw = (unsigned)wid * 1024u;
    const int aoff = lds_byte(wr * 64 + fr, fq * 8), boff = lds_byte(wc * 32 + fr, fq * 8);
#define PG8_SA(b, h) (((b) * 2 + (h)) * HTB)
#define PG8_SB(b, h) ((4 + (b) * 2 + (h)) * HTB)
#define PG8_STAGE(bufoff, gbase, voff) do { _Pragma("unroll") for (int _i = 0; _i < 2; ++_i) \
        __builtin_amdgcn_global_load_lds((const unsigned*)((const char*)(gbase) + (voff)[_i]), (PG8_LAS unsigned*)(lds + (bufoff) + ldsw + _i * 8192), 16, 0, 0); } while (0)
#define PG8_LDA(dst, b, h) do { _Pragma("unroll") for (int m = 0; m < 4; ++m) _Pragma("unroll") for (int k = 0; k < 2; ++k) dst[m][k] = *(const PG8_LAS bf16x8*)(lds + PG8_SA(b, h) + aoff + m * 2048 + k * 1024); } while (0)
#define PG8_LDB(dst, b, h) do { _Pragma("unroll") for (int n = 0; n < 2; ++n) _Pragma("unroll") for (int k = 0; k < 2; ++k) dst[n][k] = *(const PG8_LAS bf16x8*)(lds + PG8_SB(b, h) + boff + n * 2048 + k * 1024); } while (0)
#define PG8_MMA(ai, bj, At, Bt) do { __builtin_amdgcn_s_setprio(1); _Pragma("unroll") for (int m = 0; m < 4; ++m) _Pragma("unroll") for (int n = 0; n < 2; ++n) _Pragma("unroll") for (int k = 0; k < 2; ++k) \
        acc[ai][bj][m][n] = __builtin_amdgcn_mfma_f32_16x16x32_bf16(Bt[n][k], At[m][k], acc[ai][bj][m][n], 0, 0, 0); __builtin_amdgcn_s_setprio(0); } while (0)
#define PG8_WAIT_V(n) asm volatile("s_waitcnt vmcnt(" #n ")" ::: "memory")
#define PG8_WAIT_L(n) asm volatile("s_waitcnt lgkmcnt(" #n ")" ::: "memory")
#define PG8_BAR __builtin_amdgcn_s_barrier()
#define PG8_SCHED __builtin_amdgcn_sched_barrier(0)
    Unit cur, nxt; int ui = 0;
    if (!S.next(0, cur)) return;
    f32x4 acc[2][2][4][2];
#pragma unroll
    for (int a = 0; a < 2; ++a)
#pragma unroll
        for (int b = 0; b < 2; ++b)
#pragma unroll
            for (int m = 0; m < 4; ++m)
#pragma unroll
                for (int n = 0; n < 2; ++n) acc[a][b][m][n] = (f32x4){0.f, 0.f, 0.f, 0.f};
    bf16x8 At[4][2], B0[2][2], B1[2][2];
    const char* cA = (const char*)g.A + (size_t)cur.pm * tstepA; const char* cB = (const char*)g.Bt + (size_t)cur.pn * tstepB;
    PG8_STAGE(PG8_SB(0, 0), cB, voffB); PG8_STAGE(PG8_SB(0, 1), cB + hstepB, voffB); PG8_STAGE(PG8_SA(0, 0), cA, voffA); PG8_STAGE(PG8_SA(0, 1), cA + hstepA, voffA);
    if (wr == 1) PG8_BAR;
    PG8_WAIT_V(2); PG8_BAR;
    PG8_STAGE(PG8_SB(1, 0), cB + kstep, voffB); PG8_STAGE(PG8_SA(1, 0), cA + kstep, voffA); PG8_STAGE(PG8_SB(1, 1), cB + hstepB + kstep, voffB);
    PG8_WAIT_V(6); PG8_BAR;
    for (;;) {
        const bool has_next = S.next(ui + 1, nxt);
        const char* nA = has_next ? (const char*)g.A + (size_t)nxt.pm * tstepA : cA; const char* nB = has_next ? (const char*)g.Bt + (size_t)nxt.pn * tstepB : cB;
        for (int t = 0; t < nt; t += 2) {
            const bool last = (t == nt - 2);
            const char* a1 = cA + (size_t)(t + 1) * kstep;
            const char* a2 = last ? nA : cA + (size_t)(t + 2) * kstep; const char* b2 = last ? nB : cB + (size_t)(t + 2) * kstep;
            const char* a3 = a2 + kstep; const char* b3 = b2 + kstep;
            PG8_LDB(B0, 0, 0); PG8_LDB(B1, 0, 1); PG8_SCHED; PG8_LDA(At, 0, 0); PG8_STAGE(PG8_SA(1, 1), a1 + hstepA, voffA);
            PG8_WAIT_V(8); PG8_WAIT_L(0); PG8_BAR; PG8_MMA(0, 0, At, B0); PG8_MMA(0, 1, At, B1); PG8_BAR; PG8_SCHED;
            PG8_LDA(At, 0, 1); PG8_STAGE(PG8_SB(0, 0), b2, voffB); PG8_STAGE(PG8_SB(0, 1), b2 + hstepB, voffB); PG8_STAGE(PG8_SA(0, 0), a2, voffA);
            PG8_WAIT_V(8); PG8_WAIT_L(0); PG8_BAR; PG8_MMA(1, 0, At, B0); PG8_MMA(1, 1, At, B1); PG8_BAR; PG8_SCHED;
            PG8_LDB(B0, 1, 0); PG8_LDB(B1, 1, 1); PG8_SCHED; PG8_LDA(At, 1, 0); PG8_STAGE(PG8_SA(0, 1), a2 + hstepA, voffA);
            PG8_WAIT_V(8); PG8_WAIT_L(0); PG8_BAR; PG8_MMA(0, 0, At, B0); PG8_MMA(0, 1, At, B1); PG8_BAR; PG8_SCHED;
            PG8_LDA(At, 1, 1); PG8_STAGE(PG8_SB(1, 0), b3, voffB); PG8_STAGE(PG8_SB(1, 1), b3 + hstepB, voffB); PG8_STAGE(PG8_SA(1, 0), a3, voffA);
            PG8_WAIT_V(8); PG8_WAIT_L(0); PG8_BAR; PG8_MMA(1, 0, At, B0); PG8_MMA(1, 1, At, B1); PG8_BAR; PG8_SCHED;
        }
        if (wr == 0) PG8_BAR;
        E(acc, cur, wr, wc, fr, fq);
        if (!has_next) break;
#pragma unroll
        for (int a = 0; a < 2; ++a)
#pragma unroll
            for (int b = 0; b < 2; ++b)
#pragma unroll
                for (int m = 0; m < 4; ++m)
#pragma unroll
                    for (int n = 0; n < 2; ++n) acc[a][b][m][n] = (f32x4){0.f, 0.f, 0.f, 0.f};
        cur = nxt; cA = nA; cB = nB; ++ui;
        if (wr == 1) PG8_BAR;
    }
    PG8_WAIT_V(0);
    PG8_BAR;
#undef PG8_SA
#undef PG8_SB
#undef PG8_STAGE
#undef PG8_LDA
#undef PG8_LDB
#undef PG8_MMA
#undef PG8_WAIT_V
#undef PG8_WAIT_L
#undef PG8_BAR
#undef PG8_SCHED
}
}

constexpr int NWAVES = 8;
constexpr int LDS_RING_BYTES = 131072, LDSCTL_OFF = 143360, MISC_OFF = LDSCTL_OFF + 320, LDS_BYTES = 147456;
#define LAS __attribute__((address_space(3)))
#define GAS __attribute__((address_space(1)))
typedef float f32x4 __attribute__((ext_vector_type(4)));
typedef unsigned v4u __attribute__((ext_vector_type(4)));
typedef unsigned v2u __attribute__((ext_vector_type(2)));
#define LDS_WAIT() asm volatile("s_waitcnt lgkmcnt(0)" ::: "memory")

constexpr int CW_BAR = 4096;
#define XB_TMO      128
#define XB_XCNT(j)  (256  + 64 * (j))
#define XB_XSUB(j)  (1280 + 64 * (j))
#define XB_XGEN(j)  (2304 + 64 * (j))
#define XB_TOP      3328
#define XB_TOPGEN   3392
#define XCD_BAR_WORDS 3456
#define XB_SPIN_CAP (1u << 20)
__device__ __forceinline__ unsigned xb_ld(unsigned* p)              { return __hip_atomic_load(p, __ATOMIC_RELAXED, __HIP_MEMORY_SCOPE_AGENT); }
__device__ __forceinline__ unsigned xb_add(unsigned* p, unsigned v) { return __hip_atomic_fetch_add(p, v, __ATOMIC_RELAXED, __HIP_MEMORY_SCOPE_AGENT); }
__device__ __forceinline__ unsigned xb_xcc_id() { return (unsigned)__builtin_amdgcn_s_getreg((3 << 11) | 20) & 0xFu; }
#define XB_SPIN(cond, bar) do { unsigned _sp = 0; while (cond) { __builtin_amdgcn_s_sleep(1); \
    if ((++_sp & 255u) == 0u) { if (xb_ld(&(bar)[XB_TMO])) break; if (_sp > XB_SPIN_CAP) { atomicAdd(&(bar)[XB_TMO], 1u); break; } } } } while (0)
struct XcdBarrier { unsigned* bar; unsigned x; volatile LAS unsigned* st; };
__device__ __forceinline__ XcdBarrier xcd_barrier_post(unsigned* bar, volatile LAS unsigned* st) {
    XcdBarrier b; b.bar = bar; b.x = xb_xcc_id(); b.st = st;
    if (threadIdx.x == 0) (void)xb_add(&bar[XB_XCNT(b.x)], 1u);
    return b;
}
__device__ __forceinline__ void xcd_barrier_complete(unsigned* bar, unsigned x, unsigned& nloc, unsigned& nx) {
    const unsigned G = gridDim.x * gridDim.y * gridDim.z;
    unsigned sum, cnt, mine, sp = 0u;
    for (;;) {
        sum = 0u; cnt = 0u; mine = 0u;
#pragma unroll
        for (unsigned j = 0; j < 16; ++j) { const unsigned c = xb_ld(&bar[XB_XCNT(j)]); sum += c; cnt += (c > 0u) ? 1u : 0u; mine = (j == x) ? c : mine; }
        if (sum == G) break;
        __builtin_amdgcn_s_sleep(1);
        if ((++sp & 255u) == 0u) { if (xb_ld(&bar[XB_TMO])) break; if (sp > XB_SPIN_CAP) { atomicAdd(&bar[XB_TMO], 1u); break; } }
    }
    nloc = mine > 0u ? mine : 1u; nx = cnt > 0u ? cnt : 1u;
}
__device__ __forceinline__ void xcd_barrier(const XcdBarrier& b) {
    asm volatile("s_waitcnt vmcnt(0)" ::: "memory");
    __syncthreads();
    if (threadIdx.x == 0) {
        unsigned* bar = b.bar;
        __builtin_amdgcn_s_waitcnt(0);
        unsigned nloc = b.st[0], nx = b.st[1];
        if (nloc == 0u) { xcd_barrier_complete(bar, b.x, nloc, nx); b.st[0] = nloc; b.st[1] = nx; }
        const unsigned old = xb_add(&bar[XB_XSUB(b.x)], 1u);
        const unsigned gen = old / nloc;
        if (old + 1u == (gen + 1u) * nloc) {
            __builtin_amdgcn_fence(__ATOMIC_RELEASE, "agent");
            asm volatile("s_waitcnt vmcnt(0)" ::: "memory");
            const unsigned og = xb_add(&bar[XB_TOP], 1u);
            const unsigned tg = og / nx;
            if (og + 1u == (tg + 1u) * nx) xb_add(&bar[XB_TOPGEN], 1u);
            else XB_SPIN(xb_ld(&bar[XB_TOPGEN]) == tg, bar);
            __builtin_amdgcn_fence(__ATOMIC_ACQUIRE, "agent");
            xb_add(&bar[XB_XGEN(b.x)], 1u);
            asm volatile("s_waitcnt vmcnt(0)" ::: "memory");
        } else {
            XB_SPIN(xb_ld(&bar[XB_XGEN(b.x)]) == gen, bar);
            __builtin_amdgcn_fence(__ATOMIC_ACQUIRE, "agent");
            asm volatile("s_waitcnt vmcnt(0)" ::: "memory");
        }
    }
    __syncthreads();
}

struct Args { const float* in[28]; float* out; unsigned char* ws; int ph_lo, ph_hi, li, pad; };

__device__ __forceinline__ void p0_transpose_item(const float* W, const float* sc, int K, int N, bf16_t* WT, LAS float* scr, int item, int lane) {
    const int nblk = N / 32, kb = item / nblk, nb = item % nblk, k0 = 64 * kb, n0 = 32 * nb;
#pragma unroll 8
    for (int i = 0; i < 32; ++i) { const int kk = 2 * i + (lane >> 5); const float s = sc ? sc[k0 + kk] : 1.f; scr[kk * 33 + (lane & 31)] = W[(size_t)(k0 + kk) * N + n0 + (lane & 31)] * s; }
    LDS_WAIT(); asm volatile("" ::: "memory");
    const int c = lane & 7;
#pragma unroll
    for (int j = 0; j < 4; ++j) { const int n = (lane >> 3) + 8 * j; const LAS float* s = scr + (8 * c) * 33 + n;
        v4u o; o.x = pg8::cvt_pk_bf16(s[0 * 33], s[1 * 33]); o.y = pg8::cvt_pk_bf16(s[2 * 33], s[3 * 33]); o.z = pg8::cvt_pk_bf16(s[4 * 33], s[5 * 33]); o.w = pg8::cvt_pk_bf16(s[6 * 33], s[7 * 33]);
        *(v4u*)(WT + (size_t)(n0 + n) * K + k0 + 8 * c) = o; }
    LDS_WAIT(); asm volatile("" ::: "memory");
}
typedef unsigned v6u_t __attribute__((ext_vector_type(6)));
typedef unsigned v3u_t __attribute__((ext_vector_type(3)));
typedef float v16f_t __attribute__((ext_vector_type(16)));
typedef float v32f_t __attribute__((ext_vector_type(32)));
__device__ __forceinline__ void p0_row_fp6(const float* in, const float* cs, unsigned char* out, float* sc, int lane) {
    f32x4 v[4]; float mx = 0.f;
#pragma unroll
    for (int i = 0; i < 4; ++i) { v[i] = *(const f32x4*)(in + lane * 16 + 4 * i); if (cs) v[i] = v[i] * *(const f32x4*)(cs + lane * 16 + 4 * i);
        mx = fmaxf(mx, fmaxf(fmaxf(fabsf(v[i][0]), fabsf(v[i][1])), fmaxf(fabsf(v[i][2]), fabsf(v[i][3])))); }
#pragma unroll
    for (int o = 1; o < 64; o <<= 1) mx = fmaxf(mx, __shfl_xor(mx, o));
    mx = fmaxf(mx, 1e-30f);
    const float q = 7.5f / mx;
    v16f_t a, b;
#pragma unroll
    for (int i = 0; i < 16; ++i) { a[i] = 0.f; b[i] = 0.f; }
#pragma unroll
    for (int i = 0; i < 8; ++i) { a[i] = v[(2 * i) >> 2][(2 * i) & 3] * q; b[i] = v[(2 * i + 1) >> 2][(2 * i + 1) & 3] * q; }
    const v6u_t p = __builtin_amdgcn_cvt_scalef32_2xpk16_fp6_f32(a, b, 1.0f);
    *(v3u_t*)(out + lane * 12) = (v3u_t){p[0], p[1], p[2]};
    if (lane == 0) *sc = mx * (1.f / 7.5f);
}
__device__ __forceinline__ void p0_convert(const float* in, const float* cs, bf16_t* out, size_t n, int gw, int NGW, int lane) {
    for (size_t i = ((size_t)gw * 64 + lane) * 8; i < n; i += (size_t)NGW * 512) {
        f32x4 a = *(const f32x4*)(in + i), b = *(const f32x4*)(in + i + 4);
        if (cs) { const int c = (int)(i & 1023); a = a * *(const f32x4*)(cs + c); b = b * *(const f32x4*)(cs + c + 4); }
        v4u o; o.x = pg8::cvt_pk_bf16(a[0], a[1]); o.y = pg8::cvt_pk_bf16(a[2], a[3]); o.z = pg8::cvt_pk_bf16(b[0], b[1]); o.w = pg8::cvt_pk_bf16(b[2], b[3]);
        *(v4u*)(out + i) = o;
    }
}

namespace da {
typedef short bf16x8 __attribute__((ext_vector_type(8)));
typedef short s16x4 __attribute__((ext_vector_type(4)));
typedef float f32x16 __attribute__((ext_vector_type(16)));
typedef const LAS unsigned char* lcp;
constexpr float LOG2E = 1.4426950408889634f, C2 = 0.125f * LOG2E, THR = 8.f;
constexpr int RSLOT = 16384, LDS_KR = 0, LDS_VR = 4 * RSLOT, SCR_OFF = 8 * RSLOT, COMB_OFF = 0;
#define DA_SBAR() __builtin_amdgcn_sched_barrier(0)
#define DA_PIN(x) asm volatile("" : "+v"(x))
#define DA_MFMA(a, b, c) __builtin_amdgcn_mfma_f32_32x32x16_bf16(a, b, c, 0, 0, 0)
#define DA_WAIT_BAR(N) asm volatile("s_waitcnt vmcnt(" #N ") lgkmcnt(0)\n\ts_barrier" ::: "memory")
#define DA_MX3(a, b, c) __builtin_fmaxf(__builtin_fmaxf((a), (b)), (c))
__device__ __forceinline__ int crow(int r, int hi) { return (r & 3) + 8 * (r >> 2) + 4 * hi; }
__device__ __forceinline__ s16x4 vtr(lcp p) { return __builtin_bit_cast(s16x4, __builtin_amdgcn_ds_read_tr16_b64_v4i16((LAS s16x4*)p)); }
__device__ __forceinline__ unsigned cvtpk(float lo, float hi) { unsigned r; asm("v_cvt_pk_bf16_f32 %0, %1, %2" : "=v"(r) : "v"(lo), "v"(hi)); return r; }
__device__ __forceinline__ void glds16(const void* g, unsigned lds_base) {
    unsigned sv; asm volatile("s_mov_b32 %0, m0\n\ts_mov_b32 m0, %2\n\ts_nop 0\n\tglobal_load_lds_dwordx4 %1, off\n\ts_mov_b32 m0, %0" : "=&s"(sv) : "v"(g), "s"(lds_base) : "memory"); }
__device__ __forceinline__ void glds16_o128(const void* g, unsigned lds_base) {
    unsigned sv; asm volatile("s_mov_b32 %0, m0\n\ts_mov_b32 m0, %2\n\ts_nop 0\n\tglobal_load_lds_dwordx4 %1, off offset:128\n\ts_mov_b32 m0, %0" : "=&s"(sv) : "v"(g), "s"(lds_base) : "memory"); }
__device__ __forceinline__ void kload2(bf16x8* kf, lcp kp, int d0) { kf[2 * d0] = *(const LAS bf16x8*)(kp + d0 * 2048); kf[2 * d0 + 1] = *(const LAS bf16x8*)(kp + d0 * 2048 + 512); }
__device__ __forceinline__ float max16(const f32x16& p) {
    float a = DA_MX3(p[0], p[1], p[2]), b = DA_MX3(p[3], p[4], p[5]); a = DA_MX3(a, p[6], p[7]); b = DA_MX3(b, p[8], p[9]); a = DA_MX3(a, p[10], p[11]); b = DA_MX3(b, p[12], p[13]);
    a = DA_MX3(a, p[14], p[15]); return __builtin_fmaxf(a, b); }
__device__ __forceinline__ float rowmax(const f32x16& p0, const f32x16& p1, float offA, float offB) {
    const float m = __builtin_fmaxf(__builtin_fmaf(max16(p0), C2, offA), __builtin_fmaf(max16(p1), C2, offB));
    auto rr = __builtin_amdgcn_permlane32_swap(__float_as_uint(m), __float_as_uint(m), false, false);
    return __builtin_fmaxf(__uint_as_float(rr[0]), __uint_as_float(rr[1])); }
__device__ __forceinline__ void cmask(f32x16& p0, f32x16& p1, int jb, int qrel, int hi) {
    const int kb = 64 * jb + 4 * hi;
#pragma unroll
    for (int r = 0; r < 16; ++r) { const int kv = kb + (r & 3) + 8 * (r >> 2); if (kv > qrel) p0[r] = -INFINITY; if (kv + 32 > qrel) p1[r] = -INFINITY; } }

__device__ __forceinline__ void attn_epilogue_body(LAS unsigned char* lds, f32x16 (&o)[4], float l_reg, bf16_t* __restrict__ yb, const float* __restrict__ subln_w, float lam,
                                                   size_t rowb, int q0, int h, int wave, int lane) {
    asm volatile("" : "+v"(lane));
    const int r32 = lane & 31, hi = lane >> 5, map = wave >> 2, qs = wave & 3;
    LAS float* wsf = (LAS float*)(lds + SCR_OFF) + wave * 64;
    if (hi == 0) wsf[r32] = 1.f / l_reg;
    float il[16];
#pragma unroll
    for (int g = 0; g < 4; ++g) { const f32x4 t4 = *(const LAS f32x4*)(wsf + 8 * g + 4 * hi); il[4 * g] = t4[0]; il[4 * g + 1] = t4[1]; il[4 * g + 2] = t4[2]; il[4 * g + 3] = t4[3]; }
    __syncthreads();
    LAS float* comb = (LAS float*)(lds + COMB_OFF) + qs * 4096;
    if (map == 1) {
#pragma unroll
        for (int d = 0; d < 4; ++d)
#pragma unroll
            for (int r = 0; r < 16; ++r) comb[crow(r, hi) * 128 + 32 * d + r32] = o[d][r] * il[r];
    }
    __syncthreads();
    if (map == 0) {
        float sw[4];
#pragma unroll
        for (int d = 0; d < 4; ++d) sw[d] = subln_w[32 * d + r32] * (1.f - LAM_INIT);
#pragma unroll
        for (int r = 0; r < 16; ++r) {
            float v[4], ss = 0.f;
#pragma unroll
            for (int d = 0; d < 4; ++d) { v[d] = o[d][r] * il[r] - lam * comb[crow(r, hi) * 128 + 32 * d + r32]; ss += v[d] * v[d]; }
            ss += __shfl_xor(ss, 1); ss += __shfl_xor(ss, 2); ss += __shfl_xor(ss, 4); ss += __shfl_xor(ss, 8); ss += __shfl_xor(ss, 16);
            const float rs = rsqrtf(ss * (1.f / 128.f) + SUBLN_EPS);
            bf16_t* op = yb + (rowb + q0 + crow(r, hi)) * 512 + h * 128 + r32;
#pragma unroll
            for (int d = 0; d < 4; ++d) op[32 * d] = f2bf(v[d] * rs * sw[d]);
        }
    }
    __syncthreads();
}
__device__ __forceinline__ void attn_unit(LAS unsigned char* lds, const bf16_t* __restrict__ z, bf16_t* __restrict__ yb, const float* __restrict__ subln_w, float lam,
                                          int b, int h, int qblk, int wave_, int lane) {
    const int wave = __builtin_amdgcn_readfirstlane(wave_);
    const int r32 = lane & 31, hi = lane >> 5, map = wave >> 2, qs = wave & 3;
    const int q0 = qblk * 128 + qs * 32, NT = 2 * qblk + 2, qrel = qs * 32 + r32;
    const size_t rowb = (size_t)b * SEQ;
    const float slope = exp2f(-2.f * (float)(h + 1)), slope2 = slope * LOG2E, s64 = 64.f * slope2, s32 = 32.f * slope2;
    const unsigned lds0 = (unsigned)(uintptr_t)lds;
    LAS float* wsf = (LAS float*)(lds + SCR_OFF) + wave * 64;
    const bf16_t* ksrc = z + (rowb + lane) * NZ + C_ZK + h * 128 + wave * 8;
    const int pc0 = 2 * wave;
    const bf16_t* vsrc0 = z + (rowb + 16 * (pc0 & 3) + (lane >> 2)) * NZ + C_ZV + h * 128 + 32 * (pc0 >> 2) + (lane & 3) * 8;
    const unsigned kdst = lds0 + LDS_KR + wave * 1024, vdst = lds0 + LDS_VR + pc0 * 1024;
#define DMA_K(t, slot) do { const bf16_t* k_ = ksrc + (size_t)(t) * 64 * NZ; const unsigned d_ = (unsigned)__builtin_amdgcn_readfirstlane(kdst + (slot)); glds16(k_, d_); glds16_o128(k_, d_ + 8192 - 128); } while (0)
#define DMA_V(t, slot) do { const size_t o_ = (size_t)(t) * 64 * NZ; const unsigned d_ = (unsigned)__builtin_amdgcn_readfirstlane(vdst + (slot)); glds16(vsrc0 + o_, d_); glds16(vsrc0 + o_ + 16 * NZ, d_ + 1024); } while (0)
    const lcp vp0 = lds + LDS_VR + ((lane >> 4) & 1) * 32 + (lane & 3) * 8 + (4 * hi + ((lane & 15) >> 2)) * 64;
    const lcp kp0 = lds + LDS_KR + map * 8192 + hi * 1024 + r32 * 16;
    DMA_K(0, 0); DMA_V(0, 0); DMA_K(1, RSLOT);
    bf16x8 qr[4];
    {
        const bf16_t* qp = z + (rowb + q0 + r32) * NZ + C_Q + h * 128 + map * 64 + hi * 8;
#pragma unroll
        for (int d0 = 0; d0 < 4; ++d0) qr[d0] = *(const bf16x8*)(qp + d0 * 16);
    }
    f32x16 bias16;
#pragma unroll
    for (int r = 0; r < 16; ++r) bias16[r] = (8.f * slope) * (float)((r & 3) + 8 * (r >> 2));
    DA_PIN(bias16);
    float mhat = 0.f, l_reg = 0.f, offA = slope2 * (float)(4 * hi);
    f32x16 o[4];
#pragma unroll
    for (int d = 0; d < 4; ++d) o[d] = (f32x16){};
    bool resc = false;
    f32x16 c0, c1; bf16x8 kf[8]; s16x4 vlo[4], vhi[4]; v4u pw0, pw1, pw2, pw3;
#define SL(t) ((((t)) & 3) * RSLOT)
#define EX(v, nm) __builtin_amdgcn_exp2f(__builtin_fmaf((v), C2, (nm)))
#define RESC() do { if (resc) { _Pragma("unroll") for (int d_ = 0; d_ < 4; ++d_) _Pragma("unroll") for (int r = 0; r < 16; ++r) o[d_][r] *= wsf[crow(r, hi)]; } } while (0)
#define PKW(P, i) pg8::cvt_pk_bf16(P[i], P[(i) + 1])
    DMA_K(2, 2 * RSLOT); DMA_K(3, 3 * RSLOT); DMA_V(1, RSLOT);
    DA_WAIT_BAR(10);
#pragma unroll
    for (int d0 = 0; d0 < 4; ++d0) kload2(kf, kp0, d0);
    c0 = DA_MFMA(kf[0], qr[0], bias16); c1 = DA_MFMA(kf[1], qr[0], bias16); c0 = DA_MFMA(kf[2], qr[1], c0); c1 = DA_MFMA(kf[3], qr[1], c1);
    c0 = DA_MFMA(kf[4], qr[2], c0); c1 = DA_MFMA(kf[5], qr[2], c1); c0 = DA_MFMA(kf[6], qr[3], c0); c1 = DA_MFMA(kf[7], qr[3], c1);
    if (NT == 2) cmask(c0, c1, 0, qrel, hi);
    { mhat = rowmax(c0, c1, offA, offA + s32); const float nmh0 = offA - mhat, nmh1 = nmh0 + s32; float sacc = 0.f;
#pragma unroll
      for (int r = 0; r < 16; ++r) { c0[r] = EX(c0[r], nmh0); c1[r] = EX(c1[r], nmh1); sacc += c0[r] + c1[r]; }
      l_reg = sacc; }
    pw0 = (v4u){PKW(c0, 0), PKW(c0, 2), PKW(c0, 4), PKW(c0, 6)}; pw1 = (v4u){PKW(c0, 8), PKW(c0, 10), PKW(c0, 12), PKW(c0, 14)};
    pw2 = (v4u){PKW(c1, 0), PKW(c1, 2), PKW(c1, 4), PKW(c1, 6)}; pw3 = (v4u){PKW(c1, 8), PKW(c1, 10), PKW(c1, 12), PKW(c1, 14)};
    DA_WAIT_BAR(6);
    DMA_K(4, 0); DMA_V(2, 2 * RSLOT);
#pragma unroll
    for (int d0 = 0; d0 < 4; ++d0) kload2(kf, kp0 + RSLOT, d0);
    if (NT == 2) { DA_WAIT_BAR(0); } else { DA_WAIT_BAR(8); }
#define PAF(k) __builtin_bit_cast(bf16x8, pw##k)
#define VFR(i) (bf16x8){vlo[(i) & 3][0], vlo[(i) & 3][1], vlo[(i) & 3][2], vlo[(i) & 3][3], vhi[(i) & 3][0], vhi[(i) & 3][1], vhi[(i) & 3][2], vhi[(i) & 3][3]}
#define VOFF(i) ((((i) & 3) * 4 + ((i) >> 2)) * 1024)
#define VRD(i) do { vlo[(i) & 3] = vtr(vp_ + VOFF(i)); vhi[(i) & 3] = vtr(vp_ + VOFF(i) + 512); DA_SBAR(); } while (0)
#define KRD(G, d0) do { if (G) { kload2(kf, kp0 + sl_next_, d0); DA_SBAR(); } } while (0)
#define GAPA(MF) do { MF; DA_SBAR(); } while (0)
#define GAPB(MF, X, i, nm, A0, A1, EXTRA) do { MF; X[i] = EX(X[i], nm); X[(i) + 1] = EX(X[(i) + 1], nm); sacc += A0; sacc += A1; EXTRA; DA_PIN(X); DA_PIN(sacc); DA_SBAR(); } while (0)
#define STEP(t, MASK, GK, GV, GL) do { DA_SBAR(); \
    const lcp vp_ = vp0 + SL((t) - 1); const int sl_next_ = SL((t) + 1); \
            GAPA(c0 = DA_MFMA(kf[0], qr[0], bias16)); GAPA(c1 = DA_MFMA(kf[1], qr[0], bias16)); GAPA(c0 = DA_MFMA(kf[2], qr[1], c0)); GAPA(c1 = DA_MFMA(kf[3], qr[1], c1)); \
    VRD(0); GAPA(c0 = DA_MFMA(kf[4], qr[2], c0)); VRD(1); GAPA(c1 = DA_MFMA(kf[5], qr[2], c1)); VRD(2); GAPA(c0 = DA_MFMA(kf[6], qr[3], c0)); VRD(3); GAPA(c1 = DA_MFMA(kf[7], qr[3], c1)); \
    offA += s64; \
    if (GK) DMA_K((t) + 4, SL(t)); if (GV) DMA_V((t) + 2, SL((t) + 2)); \
    if (MASK) cmask(c0, c1, (t) - (NT - 2), qrel, hi); \
    { const float rm = rowmax(c0, c1, offA, offA + s32) - mhat; resc = false; \
      if (__builtin_expect(__any(rm > THR), 0)) { const float dl = __builtin_fmaxf(rm, 0.f); mhat += dl; \
          const float f = __builtin_amdgcn_exp2f(-dl); l_reg *= f; if (hi == 0) wsf[r32] = f; resc = true; } } \
    const float nmh0 = offA - mhat, nmh1 = nmh0 + s32; float sacc = 0.f; DA_SBAR(); \
    GAPB(o[0] = DA_MFMA(PAF(0), VFR(0), o[0]), c0, 0, nmh0, 0.f, 0.f, );             VRD(4); \
    GAPB(o[1] = DA_MFMA(PAF(0), VFR(1), o[1]), c0, 2, nmh0, c0[0], c0[1], );         VRD(5); \
    GAPB(o[2] = DA_MFMA(PAF(0), VFR(2), o[2]), c0, 4, nmh0, c0[2], c0[3], );         VRD(6); \
    GAPB(o[3] = DA_MFMA(PAF(0), VFR(3), o[3]), c0, 6, nmh0, c0[4], c0[5], );         VRD(7); \
    GAPB(o[0] = DA_MFMA(PAF(1), VFR(4), o[0]), c0, 8, nmh0, c0[6], c0[7], pw0[0] = PKW(c0, 0); pw0[1] = PKW(c0, 2); DA_PIN(pw0));    VRD(8); \
    GAPB(o[1] = DA_MFMA(PAF(1), VFR(5), o[1]), c0, 10, nmh0, c0[8], c0[9], pw0[2] = PKW(c0, 4); pw0[3] = PKW(c0, 6); DA_PIN(pw0));   VRD(9); \
    GAPB(o[2] = DA_MFMA(PAF(1), VFR(6), o[2]), c0, 12, nmh0, c0[10], c0[11], );      VRD(10); \
    GAPB(o[3] = DA_MFMA(PAF(1), VFR(7), o[3]), c0, 14, nmh0, c0[12], c0[13], );      VRD(11); \
    GAPB(o[0] = DA_MFMA(PAF(2), VFR(8), o[0]), c1, 0, nmh1, c0[14], c0[15], pw1[0] = PKW(c0, 8); pw1[1] = PKW(c0, 10); DA_PIN(pw1));  VRD(12); \
    GAPB(o[1] = DA_MFMA(PAF(2), VFR(9), o[1]), c1, 2, nmh1, c1[0], c1[1], pw1[2] = PKW(c0, 12); pw1[3] = PKW(c0, 14); DA_PIN(pw1));   VRD(13); \
    GAPB(o[2] = DA_MFMA(PAF(2), VFR(10), o[2]), c1, 4, nmh1, c1[2], c1[3], );        VRD(14); \
    GAPB(o[3] = DA_MFMA(PAF(2), VFR(11), o[3]), c1, 6, nmh1, c1[4], c1[5], );        VRD(15); \
    GAPB(o[0] = DA_MFMA(PAF(3), VFR(12), o[0]), c1, 8, nmh1, c1[6], c1[7], pw2[0] = PKW(c1, 0); pw2[1] = PKW(c1, 2); DA_PIN(pw2));   KRD(GL, 0); \
    GAPB(o[1] = DA_MFMA(PAF(3), VFR(13), o[1]), c1, 10, nmh1, c1[8], c1[9], pw2[2] = PKW(c1, 4); pw2[3] = PKW(c1, 6); DA_PIN(pw2));  KRD(GL, 1); \
    GAPB(o[2] = DA_MFMA(PAF(3), VFR(14), o[2]), c1, 12, nmh1, c1[10], c1[11], );     KRD(GL, 2); \
    GAPB(o[3] = DA_MFMA(PAF(3), VFR(15), o[3]), c1, 14, nmh1, c1[12], c1[13], );     KRD(GL, 3); \
    sacc += c1[14]; sacc += c1[15]; l_reg += sacc; \
    pw3[0] = PKW(c1, 8); pw3[1] = PKW(c1, 10); pw3[2] = PKW(c1, 12); pw3[3] = PKW(c1, 14); DA_PIN(pw3); \
    } while (0)
#define ENDW(tt) do { if ((tt) + 4 < NT) { DA_WAIT_BAR(8); } else if ((tt) + 3 < NT) { DA_WAIT_BAR(6); } else if ((tt) + 2 < NT) { DA_WAIT_BAR(4); } else { DA_WAIT_BAR(0); } } while (0)
    int t = 1;
    for (; t + 4 < NT; ++t) {
        STEP(t, false, true, true, true); DA_WAIT_BAR(8); RESC();
    }
    for (; t + 1 < NT; ++t) {
        STEP(t, true, (t + 4 < NT), (t + 2 < NT), (t + 1 < NT)); ENDW(t); RESC();
    }
    STEP(NT - 1, true, false, false, false); RESC();
    { const lcp vp_ = vp0 + SL(NT - 1);
#define DRN(k, i) do { const s16x4 lo_ = vtr(vp_ + VOFF(i)), hh_ = vtr(vp_ + VOFF(i) + 512); \
        o[(i) & 3] = DA_MFMA(PAF(k), ((bf16x8){lo_[0], lo_[1], lo_[2], lo_[3], hh_[0], hh_[1], hh_[2], hh_[3]}), o[(i) & 3]); } while (0)
      DRN(0, 0); DRN(0, 1); DRN(0, 2); DRN(0, 3); DRN(1, 4); DRN(1, 5); DRN(1, 6); DRN(1, 7); DRN(2, 8); DRN(2, 9); DRN(2, 10); DRN(2, 11); DRN(3, 12); DRN(3, 13); DRN(3, 14); DRN(3, 15);
#undef DRN
    }
#undef DMA_K
#undef DMA_V
#undef SL
#undef EX
#undef RESC
#undef PKW
#undef PAF
#undef VFR
#undef VOFF
#undef VRD
#undef KRD
#undef GAPA
#undef GAPB
#undef STEP
#undef ENDW
    { auto rr = __builtin_amdgcn_permlane32_swap(__float_as_uint(l_reg), __float_as_uint(l_reg), false, false); l_reg = __uint_as_float(rr[0]) + __uint_as_float(rr[1]); }
    attn_epilogue_body(lds, o, l_reg, yb, subln_w, lam, rowb, q0, h, wave, lane);
}
}

namespace rw {
typedef short bf16x8 __attribute__((ext_vector_type(8)));
typedef float f32x2 __attribute__((ext_vector_type(2)));
typedef short s16x4 __attribute__((ext_vector_type(4)));
constexpr int CH = 32, ACT_PITCH = 528;
constexpr int OFF_HAT = 41472, HAT_PITCH = 144, HAT_SZ = 32 * HAT_PITCH, OFF_TIL = OFF_HAT + 4 * HAT_SZ, TIL_PITCH = 40, TIL_SZ = 64 * TIL_PITCH, OFF_GR = OFF_TIL + 4 * TIL_SZ, OFF_WC = OFF_GR + 10 * 1024;
constexpr int OFF_ACT = 0, OFF_RKV = 16896, OFF_VEC = 41472, OFF_G = 82432, OFF_Y = 90624, OFF_NRM = 98816, OFF_SCL = 99328, OFF_CT = 99840, OFF_SCP = 102400;
template <int CTRL> __device__ __forceinline__ float dppf(float x) { return __builtin_bit_cast(float, __builtin_amdgcn_mov_dpp(__builtin_bit_cast(int, x), CTRL, 0xf, 0xf, true)); }
__device__ __forceinline__ float row_allsum(float v) { v += dppf<0x128>(v); v += dppf<0x124>(v); v += dppf<0x122>(v); v += dppf<0x121>(v); return v; }
__device__ __forceinline__ void row_allsum4(float& a, float& b, float& c, float& d) {
#define RW_DPP4(n) "v_add_f32_dpp %0, %0, %0 row_ror:" #n " row_mask:0xf bank_mask:0xf\n\tv_add_f32_dpp %1, %1, %1 row_ror:" #n " row_mask:0xf bank_mask:0xf\n\t" \
                   "v_add_f32_dpp %2, %2, %2 row_ror:" #n " row_mask:0xf bank_mask:0xf\n\tv_add_f32_dpp %3, %3, %3 row_ror:" #n " row_mask:0xf bank_mask:0xf\n\t"
    asm volatile("s_nop 1\n\t" RW_DPP4(8) RW_DPP4(4) RW_DPP4(2) RW_DPP4(1) "s_nop 1" : "+v"(a), "+v"(b), "+v"(c), "+v"(d));
#undef RW_DPP4
}
__device__ __forceinline__ f32x4 ld4bf(const bf16_t* p) { const v2u w = *(const v2u*)p; return (f32x4){pg8::bflo(w.x), pg8::bfhi(w.x), pg8::bflo(w.y), pg8::bfhi(w.y)}; }
__device__ __forceinline__ float fsig(float x) { return __builtin_amdgcn_rcpf(1.f + __expf(-x)); }
__device__ __forceinline__ float ftanh(float x) { return 1.f - 2.f * __builtin_amdgcn_rcpf(1.f + __expf(2.f * x)); }
struct ZRow { v2u r, k, v, w, a; v4u g; };
__device__ __forceinline__ ZRow ldrow(const bf16_t* zr, int c4, int cg) {
    ZRow o; o.r = *(const v2u*)(zr + C_R + c4); o.k = *(const v2u*)(zr + C_K + c4); o.v = *(const v2u*)(zr + C_V + c4); o.w = *(const v2u*)(zr + C_WL + 4 * cg); o.a = *(const v2u*)(zr + C_AL + 4 * cg);
    o.g = *(const v4u*)(zr + C_GL + 8 * cg); return o;
}
__device__ __forceinline__ f32x4 up4(v2u w) { return (f32x4){pg8::bflo(w.x), pg8::bfhi(w.x), pg8::bflo(w.y), pg8::bfhi(w.y)}; }

struct ScanP { const float *mu, *w0, *w2, *a0, *a2, *g2, *k_k, *k_a, *r_k, *lnx_w, *lnx_b; };
__device__ __forceinline__ void scan_unit(LAS unsigned char* lds, const bf16_t* __restrict__ z, bf16_t* __restrict__ ya, const ScanP P, int b, int h, int tid, int wave, int lane) {
    asm volatile("" : "+v"(tid)); lane = tid & 63;
    const float* mu = P.mu; const float* w0 = P.w0; const float* w2 = P.w2; const float* a0 = P.a0; const float* a2 = P.a2; const float* g2 = P.g2;
    const float* k_k = P.k_k; const float* k_a = P.k_a; const float* r_k = P.r_k; const float* lnx_w = P.lnx_w; const float* lnx_b = P.lnx_b;
    const size_t rowb = (size_t)b * SEQ;
    const int tl = tid >> 4, cg = tid & 15;
    const int nt = wave & 3, rl = lane & 15, rg = lane >> 4;
    LAS float* rkv = (LAS float*)(lds + OFF_RKV); LAS float* vec = (LAS float*)(lds + OFF_VEC); LAS float* gbuf = (LAS float*)(lds + OFF_G);
    LAS float* ybuf = (LAS float*)(lds + OFF_Y); LAS float* nrm = (LAS float*)(lds + OFF_NRM); LAS float* scl = (LAS float*)(lds + OFF_SCL); LAS float* scp = (LAS float*)(lds + OFF_SCP);
    bf16x8 bfr[8];
    {
        const int col = h * 64 + 16 * nt + rl;
#pragma unroll
        for (int f = 0; f < 8; ++f) {
            const float* src = (f < 2) ? w2 : (f < 4) ? a2 : g2;
            const int kb = ((f < 4) ? 32 * (f & 1) : 32 * (f - 4)) + 8 * rg;
            float e[8];
#pragma unroll
            for (int j = 0; j < 8; ++j) e[j] = src[(size_t)(kb + j) * 512 + col];
            v4u p; p.x = pg8::cvt_pk_bf16(e[0], e[1]); p.y = pg8::cvt_pk_bf16(e[2], e[3]); p.z = pg8::cvt_pk_bf16(e[4], e[5]); p.w = pg8::cvt_pk_bf16(e[6], e[7]);
            bfr[f] = __builtin_bit_cast(bf16x8, p);
            __builtin_amdgcn_sched_barrier(0);
        }
    }
    const int mt = wave >> 2;
    const int hc = h * 64 + 16 * nt + rl;
    const float w0c = w0[hc], a0c = a0[hc], kkc = k_k[hc], kac = k_a[hc], rkc = r_k[hc];
    const int c4 = h * 64 + 4 * cg;
    f32x4 ST[4];
#pragma unroll
    for (int i = 0; i < 4; ++i) ST[i] = (f32x4){0.f, 0.f, 0.f, 0.f};
    LAS float* ctab = (LAS float*)(lds + OFF_CT);
    if (tl == 0) {
        LAS float* ct = ctab + cg * 36;
        *(LAS f32x4*)(ct + 0) = *(const f32x4*)(mu + C_R + c4); *(LAS f32x4*)(ct + 4) = *(const f32x4*)(mu + C_K + c4); *(LAS f32x4*)(ct + 8) = *(const f32x4*)(mu + C_V + c4);
        *(LAS f32x4*)(ct + 12) = *(const f32x4*)(mu + C_WL + 4 * cg); *(LAS f32x4*)(ct + 16) = *(const f32x4*)(mu + C_AL + 4 * cg);
        *(LAS f32x4*)(ct + 20) = *(const f32x4*)(mu + C_GL + 8 * cg); *(LAS f32x4*)(ct + 24) = *(const f32x4*)(mu + C_GL + 8 * cg + 4);
        *(LAS f32x4*)(ct + 28) = *(const f32x4*)(lnx_w + c4); *(LAS f32x4*)(ct + 32) = *(const f32x4*)(lnx_b + c4);
    }
    __syncthreads();
    const LAS float* myct = ctab + cg * 36;
    ZRow zc = ldrow(z + (rowb + tl) * NZ, c4, cg), zp;
    if (tl > 0) zp = ldrow(z + (rowb + tl - 1) * NZ, c4, cg); else { zp.r = zp.k = zp.v = zp.w = zp.a = (v2u){0u, 0u}; zp.g = (v4u){0u, 0u, 0u, 0u}; }
    for (int t0 = 0; t0 < SEQ; t0 += CH) {
        {
            const f32x4 cr = up4(zc.r), ck = up4(zc.k), cv = up4(zc.v), cw = up4(zc.w), ca = up4(zc.a);
            const f32x4 cg0 = (f32x4){pg8::bflo(zc.g.x), pg8::bfhi(zc.g.x), pg8::bflo(zc.g.y), pg8::bfhi(zc.g.y)}, cg1 = (f32x4){pg8::bflo(zc.g.z), pg8::bfhi(zc.g.z), pg8::bflo(zc.g.w), pg8::bfhi(zc.g.w)};
            const f32x4 pr = up4(zp.r), pk = up4(zp.k), pv = up4(zp.v), pw = up4(zp.w), pa = up4(zp.a);
            const f32x4 pg0 = (f32x4){pg8::bflo(zp.g.x), pg8::bfhi(zp.g.x), pg8::bflo(zp.g.y), pg8::bfhi(zp.g.y)}, pg1 = (f32x4){pg8::bflo(zp.g.z), pg8::bfhi(zp.g.z), pg8::bflo(zp.g.w), pg8::bfhi(zp.g.w)};
            if (t0 + CH < SEQ) { zc = ldrow(z + (rowb + t0 + CH + tl) * NZ, c4, cg); zp = ldrow(z + (rowb + t0 + CH + tl - 1) * NZ, c4, cg); }
            const f32x4 rs_ = cr + (pr - cr) * *(const LAS f32x4*)(myct + 0), ks_ = ck + (pk - ck) * *(const LAS f32x4*)(myct + 4), vs_ = cv + (pv - cv) * *(const LAS f32x4*)(myct + 8);
            const f32x4 ws_ = cw + (pw - cw) * *(const LAS f32x4*)(myct + 12), as_ = ca + (pa - ca) * *(const LAS f32x4*)(myct + 16);
            const f32x4 g0_ = cg0 + (pg0 - cg0) * *(const LAS f32x4*)(myct + 20), g1_ = cg1 + (pg1 - cg1) * *(const LAS f32x4*)(myct + 24);
            *(LAS f32x4*)(rkv + 0 * 2048 + tl * 64 + 4 * cg) = rs_; *(LAS f32x4*)(rkv + 1 * 2048 + tl * 64 + 4 * cg) = ks_; *(LAS f32x4*)(rkv + 2 * 2048 + tl * 64 + 4 * cg) = vs_;
            LAS unsigned char* ar = lds + OFF_ACT + tl * ACT_PITCH;
            v2u tw; tw.x = pg8::cvt_pk_bf16(ftanh(ws_[0]), ftanh(ws_[1])); tw.y = pg8::cvt_pk_bf16(ftanh(ws_[2]), ftanh(ws_[3]));
            *(LAS v2u*)(ar + 8 * cg) = tw;
            v2u aw; aw.x = pg8::cvt_pk_bf16(as_[0], as_[1]); aw.y = pg8::cvt_pk_bf16(as_[2], as_[3]);
            *(LAS v2u*)(ar + 128 + 8 * cg) = aw;
            v4u gw; gw.x = pg8::cvt_pk_bf16(fsig(g0_[0]), fsig(g0_[1])); gw.y = pg8::cvt_pk_bf16(fsig(g0_[2]), fsig(g0_[3]));
            gw.z = pg8::cvt_pk_bf16(fsig(g1_[0]), fsig(g1_[1])); gw.w = pg8::cvt_pk_bf16(fsig(g1_[2]), fsig(g1_[3]));
            *(LAS v4u*)(ar + 256 + 16 * cg) = gw;
        }
        __syncthreads();
        f32x4 accw = (f32x4){0.f, 0.f, 0.f, 0.f}, acca = accw, accg = accw;
        {
            const LAS unsigned char* ap = lds + OFF_ACT + (16 * mt + rl) * ACT_PITCH + 8 * rg * 2;
#pragma unroll
            for (int f = 0; f < 8; ++f) {
                const bf16x8 a = *(const LAS bf16x8*)(ap + f * 64);
                if (f < 2) accw = __builtin_amdgcn_mfma_f32_16x16x32_bf16(a, bfr[f], accw, 0, 0, 0);
                else if (f < 4) acca = __builtin_amdgcn_mfma_f32_16x16x32_bf16(a, bfr[f], acca, 0, 0, 0);
                else accg = __builtin_amdgcn_mfma_f32_16x16x32_bf16(a, bfr[f], accg, 0, 0, 0);
            }
        }
        float lw[4], av[4], kk[4];
        {
            const int c = 16 * nt + rl;
            float n2[4];
#pragma unroll
            for (int r = 0; r < 4; ++r) {
                const int tok = 16 * mt + 4 * rg + r;
                gbuf[tok * 64 + c] = accg[r];
                const float nx = -(w0c + accw[r]);
                const float sp = nx > 20.f ? nx : __logf(1.f + __expf(nx));
                lw[r] = -__expf(-sp - 0.5f);
                av[r] = fsig(a0c + acca[r]);
                kk[r] = rkv[1 * 2048 + tok * 64 + c] * kkc;
                n2[r] = kk[r] * kk[r];
            }
            row_allsum4(n2[0], n2[1], n2[2], n2[3]);
            if (rl == 0) {
#pragma unroll
                for (int r = 0; r < 4; ++r) nrm[(16 * mt + 4 * rg + r) * 4 + nt] = n2[r];
            }
        }
        __syncthreads();
        {
            const int c = 16 * nt + rl;
            const float p0 = lw[0], p1 = p0 + lw[1], p2 = p1 + lw[2], p3 = p2 + lw[3];
            const float t1 = __shfl(p3, (lane - 16) & 63), t2 = __shfl(p3, (lane - 32) & 63), t3 = __shfl(p3, (lane - 48) & 63);
            const float E = (rg >= 1 ? t1 : 0.f) + (rg >= 2 ? t2 : 0.f) + (rg >= 3 ? t3 : 0.f);
            const float Ltot = __shfl(E + p3, rl + 48);
            const float pin[4] = {p0, p1, p2, p3};
            float bt[4], kt[4];
#pragma unroll
            for (int r = 0; r < 4; ++r) {
                const int tok = 16 * mt + 4 * rg + r;
                const f32x4 n4 = *(const LAS f32x4*)(nrm + tok * 4);
                const float ksv = rkv[1 * 2048 + tok * 64 + c], rsv = rkv[0 * 2048 + tok * 64 + c];
                const float inv = __builtin_amdgcn_rcpf(fmaxf(sqrtf((n4[0] + n4[1]) + (n4[2] + n4[3])), 1e-12f));
                const float kkn = kk[r] * inv, beta = kkn * av[r], kmod = ksv * (1.f + (av[r] - 1.f) * kac);
                const float L = E + pin[r], eL = __expf(L), ieL = __expf(-L), eLm = __expf(L - lw[r]), eT = __expf(Ltot - L);
                LAS unsigned char* hp = lds + OFF_HAT + tok * HAT_PITCH + c * 2;
                *(LAS bf16_t*)(hp) = f2bf(-kkn * eLm); *(LAS bf16_t*)(hp + HAT_SZ) = f2bf(beta * ieL); *(LAS bf16_t*)(hp + 2 * HAT_SZ) = f2bf(kmod * ieL); *(LAS bf16_t*)(hp + 3 * HAT_SZ) = f2bf(rsv * eL);
                bt[r] = beta * eT; kt[r] = kmod * eT;
                float pbr = beta * rsv, pkr = kmod * rsv, pbo = rsv * kmod * rkc, dum = 0.f;
                row_allsum4(pbr, pkr, pbo, dum);
                if (rl == 0) *(LAS f32x4*)(scp + (tok * 4 + nt) * 4) = (f32x4){pbr, pkr, pbo, 0.f};
            }
            LAS unsigned char* tp = lds + OFF_TIL + (2 * mt) * TIL_SZ + c * TIL_PITCH + 8 * rg;
            v2u w; w.x = pg8::cvt_pk_bf16(bt[0], bt[1]); w.y = pg8::cvt_pk_bf16(bt[2], bt[3]); *(LAS v2u*)(tp) = w;
            w.x = pg8::cvt_pk_bf16(kt[0], kt[1]); w.y = pg8::cvt_pk_bf16(kt[2], kt[3]); *(LAS v2u*)(tp + TIL_SZ) = w;
            if (rg == 0) ((LAS float*)(lds + OFF_WC))[mt * 64 + c] = __expf(Ltot);
        }
        __syncthreads();
        if (tid < CH) {
            const f32x4 p0 = *(const LAS f32x4*)(scp + tid * 16), p1 = *(const LAS f32x4*)(scp + tid * 16 + 4), p2 = *(const LAS f32x4*)(scp + tid * 16 + 8), p3 = *(const LAS f32x4*)(scp + tid * 16 + 12);
            *(LAS f32x4*)(scl + 4 * tid) = (p0 + p1) + (p2 + p3);
        }
        int lane_ = lane; asm volatile("" : "+v"(lane_));
        const int rl_ = lane_ & 15, rg_ = lane_ >> 4;
        {
            const int c = wave >> 2, g = wave & 3;
            const LAS unsigned char* pa = lds + OFF_HAT + ((g & 1) ? 2 : 1) * HAT_SZ + (16 * c + rl_) * HAT_PITCH + 16 * rg_;
            const LAS unsigned char* pb = lds + OFF_HAT + ((g < 2) ? 0 : 3) * HAT_SZ + (16 * c + rl_) * HAT_PITCH + 16 * rg_;
            f32x4 acc = (f32x4){0.f, 0.f, 0.f, 0.f};
            acc = __builtin_amdgcn_mfma_f32_16x16x32_bf16(*(const LAS bf16x8*)(pa), *(const LAS bf16x8*)(pb), acc, 0, 0, 0);
            acc = __builtin_amdgcn_mfma_f32_16x16x32_bf16(*(const LAS bf16x8*)(pa + 64), *(const LAS bf16x8*)(pb + 64), acc, 0, 0, 0);
#pragma unroll
            for (int e = 0; e < 4; ++e) { const int row = 4 * rg_ + e; const bool keep = (g < 2) ? (row < rl_) : (row <= rl_); if (!keep) acc[e] = 0.f; }
            *(LAS f32x4*)(lds + OFF_GR + (c * 5 + g) * 1024 + lane_ * 16) = acc;
            if (g == 0) {
                asm volatile("s_waitcnt lgkmcnt(0)" ::: "memory");
                if (lane_ < 16) {
                    const int sc = lane_;
                    const LAS float* tb = (const LAS float*)(lds + OFF_GR + (c * 5) * 1024);
                    float m[16], ps[16];
#pragma unroll
                    for (int r = 0; r < 16; ++r) ps[r] = 0.f;
#pragma unroll
                    for (int u = 15; u >= 0; --u) {
                        m[u] = (u == sc) ? 1.f : ((u < sc) ? ps[u] : 0.f);
#pragma unroll
                        for (int r = 0; r < u; ++r) ps[r] = __builtin_fmaf(tb[(u + 16 * (r >> 2)) * 4 + (r & 3)], m[u], ps[r]);
                    }
                    LAS f32x4* mt_ = (LAS f32x4*)(lds + OFF_GR + (c * 5 + 4) * 1024);
#pragma unroll
                    for (int q = 0; q < 4; ++q) mt_[sc + 16 * q] = (f32x4){m[4 * q], m[4 * q + 1], m[4 * q + 2], m[4 * q + 3]};
                }
            }
        }
        __syncthreads();
        if (wave < 4) {
            const int ib = wave;
#pragma unroll
            for (int c = 0; c < 2; ++c) {
                bf16x8 sb[2];
#pragma unroll
                for (int ks = 0; ks < 2; ++ks) {
                    v4u p; p.x = pg8::cvt_pk_bf16(ST[2 * ks][0], ST[2 * ks][1]); p.y = pg8::cvt_pk_bf16(ST[2 * ks][2], ST[2 * ks][3]);
                    p.z = pg8::cvt_pk_bf16(ST[2 * ks + 1][0], ST[2 * ks + 1][1]); p.w = pg8::cvt_pk_bf16(ST[2 * ks + 1][2], ST[2 * ks + 1][3]);
                    sb[ks] = __builtin_bit_cast(bf16x8, p);
                }
                const LAS unsigned char* ha = lds + OFF_HAT + (16 * c + rl_) * HAT_PITCH + 8 * rg_;
                f32x4 xt = (f32x4){0.f, 0.f, 0.f, 0.f}, yt = xt;
#pragma unroll
                for (int ks = 0; ks < 2; ++ks) {
                    v4u fa, fr; const v2u a0_ = *(const LAS v2u*)(ha + 64 * ks), a1_ = *(const LAS v2u*)(ha + 64 * ks + 32);
                    const v2u r0_ = *(const LAS v2u*)(ha + 3 * HAT_SZ + 64 * ks), r1_ = *(const LAS v2u*)(ha + 3 * HAT_SZ + 64 * ks + 32);
                    fa.x = a0_.x; fa.y = a0_.y; fa.z = a1_.x; fa.w = a1_.y; fr.x = r0_.x; fr.y = r0_.y; fr.z = r1_.x; fr.w = r1_.y;
                    xt = __builtin_amdgcn_mfma_f32_16x16x32_bf16(__builtin_bit_cast(bf16x8, fa), sb[ks], xt, 0, 0, 0);
                    yt = __builtin_amdgcn_mfma_f32_16x16x32_bf16(__builtin_bit_cast(bf16x8, fr), sb[ks], yt, 0, 0, 0);
                }
                const LAS float* vsrc = rkv + 2 * 2048 + (16 * c + 4 * rg_) * 64 + 16 * ib + rl_;
                v2u vb_; vb_.x = pg8::cvt_pk_bf16(vsrc[0], vsrc[64]); vb_.y = pg8::cvt_pk_bf16(vsrc[128], vsrc[192]);
                const s16x4 vb = __builtin_bit_cast(s16x4, vb_);
                const LAS unsigned char* gr = lds + OFF_GR + (c * 5) * 1024 + lane_ * 16;
#define RW_AFR(g_) ({ const f32x4 t_ = *(const LAS f32x4*)(gr + (g_) * 1024); v2u w_; w_.x = pg8::cvt_pk_bf16(t_[0], t_[1]); w_.y = pg8::cvt_pk_bf16(t_[2], t_[3]); __builtin_bit_cast(s16x4, w_); })
#define RW_PK4(x_) ({ v2u w_; w_.x = pg8::cvt_pk_bf16((x_)[0], (x_)[1]); w_.y = pg8::cvt_pk_bf16((x_)[2], (x_)[3]); __builtin_bit_cast(s16x4, w_); })
                const f32x4 zt = __builtin_amdgcn_mfma_f32_16x16x16bf16_1k(RW_AFR(1), vb, xt, 0, 0, 0);
                const f32x4 ut = __builtin_amdgcn_mfma_f32_16x16x16bf16_1k(RW_AFR(4), RW_PK4(zt), (f32x4){0.f, 0.f, 0.f, 0.f}, 0, 0, 0);
                const s16x4 ub = RW_PK4(ut);
                yt = __builtin_amdgcn_mfma_f32_16x16x16bf16_1k(RW_AFR(2), ub, yt, 0, 0, 0);
                yt = __builtin_amdgcn_mfma_f32_16x16x16bf16_1k(RW_AFR(3), vb, yt, 0, 0, 0);
#pragma unroll
                for (int e = 0; e < 4; ++e) ybuf[(16 * c + 4 * rg_ + e) * 64 + 16 * ib + rl_] = yt[e];
                const LAS unsigned char* tl_ = lds + OFF_TIL + (2 * c) * TIL_SZ + rl_ * TIL_PITCH + 8 * rg_;
                const LAS float* wc = (const LAS float*)(lds + OFF_WC) + c * 64 + 4 * rg_;
#pragma unroll
                for (int jt = 0; jt < 4; ++jt) {
                    f32x4 acc = ST[jt] * *(const LAS f32x4*)(wc + 16 * jt);
                    acc = __builtin_amdgcn_mfma_f32_16x16x16bf16_1k(*(const LAS s16x4*)(tl_ + TIL_SZ + 16 * jt * TIL_PITCH), vb, acc, 0, 0, 0);
                    acc = __builtin_amdgcn_mfma_f32_16x16x16bf16_1k(*(const LAS s16x4*)(tl_ + 16 * jt * TIL_PITCH), ub, acc, 0, 0, 0);
                    ST[jt] = acc;
                }
#undef RW_AFR
#undef RW_PK4
            }
        }
        __syncthreads();
        {
            const f32x4 y4 = *(const LAS f32x4*)(ybuf + tl * 64 + 4 * cg);
            const float mean = row_allsum((y4[0] + y4[1]) + (y4[2] + y4[3])) * (1.f / 64.f);
            const f32x4 dv = y4 - mean;
            const float var = row_allsum((dv[0] * dv[0] + dv[1] * dv[1]) + (dv[2] * dv[2] + dv[3] * dv[3])) * (1.f / 64.f);
            const float rs_ = rsqrtf(var + GN_EPS);
            const f32x4 yn = dv * rs_ * *(const LAS f32x4*)(myct + 28) + *(const LAS f32x4*)(myct + 32);
            const float bonus = scl[tl * 4 + 2];
            const f32x4 vs_ = *(const LAS f32x4*)(rkv + 2 * 2048 + tl * 64 + 4 * cg), g4 = *(const LAS f32x4*)(gbuf + tl * 64 + 4 * cg);
            const f32x4 o = (yn + vs_ * bonus) * g4;
            v2u w; w.x = pg8::cvt_pk_bf16(o[0], o[1]); w.y = pg8::cvt_pk_bf16(o[2], o[3]);
            *(v2u*)(ya + (rowb + t0 + tl) * 512 + c4) = w;
        }
        __syncthreads();
    }
}
}

typedef __bf16 bf16x2_t __attribute__((ext_vector_type(2)));
__device__ __forceinline__ float dot2bf(unsigned a, unsigned b, float c) { return __builtin_amdgcn_fdot2_f32_bf16(__builtin_bit_cast(bf16x2_t, a), __builtin_bit_cast(bf16x2_t, b), c, false); }
__device__ __forceinline__ unsigned f2ord(float f) { const unsigned u = __float_as_uint(f); return (u & 0x80000000u) ? ~u : (u | 0x80000000u); }
__device__ __forceinline__ float ord2f(unsigned o) { return __uint_as_float((o & 0x80000000u) ? (o ^ 0x80000000u) : ~o); }
__device__ __forceinline__ unsigned row_allmax_u32(unsigned v) {
    v = max(v, (unsigned)__builtin_amdgcn_update_dpp(0, (int)v, 0x128, 0xf, 0xf, false));
    v = max(v, (unsigned)__builtin_amdgcn_update_dpp(0, (int)v, 0x124, 0xf, 0xf, false));
    v = max(v, (unsigned)__builtin_amdgcn_update_dpp(0, (int)v, 0x122, 0xf, 0xf, false));
    v = max(v, (unsigned)__builtin_amdgcn_update_dpp(0, (int)v, 0x121, 0xf, 0xf, false));
    return v;
}

constexpr int TK_PITCH = 272, TK_HALF = 128 * TK_PITCH;
typedef short tk_bf16x8 __attribute__((ext_vector_type(8)));
__device__ __forceinline__ void topk_loadq(tk_bf16x8 (&qa)[8], const bf16_t* __restrict__ qb, int t0, int h, int lane) {
    const bf16_t* qp = qb + (size_t)(t0 + (lane & 15)) * 2048 + h * 256 + 8 * (lane >> 4);
#pragma unroll
    for (int i = 0; i < 8; ++i) qa[i] = *(const tk_bf16x8*)(qp + i * 32);
}
__device__ __forceinline__ void topk_item(const tk_bf16x8 (&qa)[8], const LAS unsigned char* klds, int* __restrict__ ids, float* __restrict__ gates, int t0, int h, int lane) {
    const int rl = lane & 15, rg = lane >> 4;
    unsigned top[2][4];
#pragma unroll
    for (int c = 0; c < 2; ++c) {
        f32x4 acc[8];
#pragma unroll
        for (int nt = 0; nt < 8; ++nt) acc[nt] = (f32x4){64.f, 64.f, 64.f, 64.f};
        const LAS unsigned char* kp = klds + c * TK_HALF + rl * TK_PITCH + 16 * rg;
#pragma unroll
        for (int ks = 0; ks < 4; ++ks) {
#pragma unroll
            for (int nt = 0; nt < 8; ++nt) { const tk_bf16x8 b = *(const LAS tk_bf16x8*)(kp + nt * 16 * TK_PITCH + ks * 64); acc[nt] = __builtin_amdgcn_mfma_f32_16x16x32_bf16(qa[c * 4 + ks], b, acc[nt], 0, 0, 0); }
            __builtin_amdgcn_sched_barrier(0);
        }
        unsigned k[4][8];
#pragma unroll
        for (int r = 0; r < 4; ++r) {
#pragma unroll
            for (int nt = 0; nt < 8; ++nt) k[r][nt] = (__float_as_uint(fmaxf(acc[nt][r], 1.f)) & ~127u) | (unsigned)(127 - (nt * 16 + rl));
#define TK_CE(i, j) do { const unsigned a_ = max(k[r][i], k[r][j]), b_ = min(k[r][i], k[r][j]); k[r][i] = a_; k[r][j] = b_; } while (0)
            TK_CE(0, 1); TK_CE(2, 3); TK_CE(4, 5); TK_CE(6, 7); TK_CE(0, 2); TK_CE(1, 3); TK_CE(4, 6); TK_CE(5, 7); TK_CE(1, 2); TK_CE(5, 6);
            TK_CE(0, 4); TK_CE(1, 5); TK_CE(2, 6); TK_CE(3, 7); TK_CE(2, 4); TK_CE(3, 5); TK_CE(1, 2); TK_CE(3, 4); TK_CE(5, 6);
#undef TK_CE
        }
        unsigned tp[4] = {0u, 0u, 0u, 0u};
        for (int round = 0; round < 16; ++round) {
#pragma unroll
            for (int r = 0; r < 4; ++r) {
                const unsigned m = row_allmax_u32(k[r][0]);
                tp[r] = (rl == round) ? m : tp[r];
                const bool win = (k[r][0] == m);
                k[r][0] = win ? k[r][1] : k[r][0]; k[r][1] = win ? k[r][2] : k[r][1]; k[r][2] = win ? k[r][3] : k[r][2]; k[r][3] = win ? k[r][4] : k[r][3];
                k[r][4] = win ? k[r][5] : k[r][4]; k[r][5] = win ? k[r][6] : k[r][5]; k[r][6] = win ? k[r][7] : k[r][6]; k[r][7] = win ? 0u : k[r][7];
            }
        }
#pragma unroll
        for (int r = 0; r < 4; ++r) top[c][r] = tp[r];
    }
    const int rowbase = lane & 48;
    float v1[4]; int n1[4], ptr[4], myid[4]; unsigned k2[4], myv[4];
#pragma unroll
    for (int r = 0; r < 4; ++r) { v1[r] = __uint_as_float(top[0][r] & ~127u); n1[r] = 127 - (int)(top[0][r] & 127u); ptr[r] = 0; k2[r] = (unsigned)__builtin_amdgcn_ds_bpermute(rowbase * 4, (int)top[1][r]); myid[r] = 0; myv[r] = 0u; }
    for (int round = 0; round < 16; ++round) {
#pragma unroll
        for (int r = 0; r < 4; ++r) {
            const float head = v1[r] + __uint_as_float(k2[r] & ~127u);
            const unsigned key = (ptr[r] < 16) ? ((__float_as_uint(head) & ~15u) | (unsigned)(15 - rl)) : 0u;
            const unsigned m = row_allmax_u32(key);
            const bool win = (key == m);
            const unsigned wid = row_allmax_u32(win ? (unsigned)(n1[r] * 128 + (127 - (int)(k2[r] & 127u))) + 1u : 0u);
            myid[r] = (rl == round) ? (int)wid - 1 : myid[r];
            myv[r] = (rl == round) ? m : myv[r];
            ptr[r] += win ? 1 : 0;
            k2[r] = (unsigned)__builtin_amdgcn_ds_bpermute((rowbase + (ptr[r] & 15)) * 4, (int)top[1][r]);
        }
    }
#pragma unroll
    for (int r = 0; r < 4; ++r) {
        const float val = __uint_as_float(myv[r] & ~15u);
        const float vmax = __uint_as_float((unsigned)__builtin_amdgcn_ds_bpermute(rowbase * 4, (int)__float_as_uint(val)));
        const float e = __expf(val - vmax);
        const float sum = rw::row_allsum(e);
        gates[(size_t)(t0 + 4 * rg + r) * 128 + h * 16 + rl] = e / sum; ids[(size_t)(t0 + 4 * rg + r) * 128 + h * 16 + rl] = myid[r];
    }
}

typedef float f32x2 __attribute__((ext_vector_type(2)));
__device__ __forceinline__ void peer_token(const bf16_t* __restrict__ x2b, const float* __restrict__ ssq2, const int* __restrict__ ids, const float* __restrict__ gates,
                                           const unsigned char* __restrict__ U8, const unsigned char* __restrict__ V8, const float* __restrict__ usc, const float* __restrict__ vsc,
                                           const float* __restrict__ fw, float* __restrict__ out, int t, int lane) {
    const int l16 = lane * 16;
    f32x2 hx[8];
    {
        const v4u h0 = *(const v4u*)(x2b + (size_t)t * DM + l16), h1 = *(const v4u*)(x2b + (size_t)t * DM + l16 + 8);
        const unsigned hw[8] = {h0.x, h0.y, h0.z, h0.w, h1.x, h1.y, h1.z, h1.w};
#pragma unroll
        for (int i = 0; i < 8; ++i) hx[i] = (f32x2){pg8::bflo(hw[i]), pg8::bfhi(hw[i])};
    }
    const int idA = ids[(size_t)t * 128 + lane], idB = ids[(size_t)t * 128 + 64 + lane];
    const float rs = rsqrtf(pg8::ssq_sum16(ssq2 + (size_t)t * 16) * (1.f / DM) + NORM_EPS);
    const float suA = rs * usc[idA], suB = rs * usc[idB];
    const float svA = gates[(size_t)t * 128 + lane] * vsc[idA], svB = gates[(size_t)t * 128 + 64 + lane] * vsc[idB];
    f32x2 y[8];
#pragma unroll
    for (int i = 0; i < 8; ++i) y[i] = (f32x2){0.f, 0.f};
    const int bit0 = lane & 1, bit1 = (lane >> 1) & 1, bit5 = lane >> 5;
    v3u_t uw[8], vw[8];
    const unsigned vo12 = (unsigned)lane * 12u;
#define PEER_LDU(g_) do { const int is_ = ((g_) < 8) ? idA : idB; const int lb_ = ((g_) * 8) & 63; _Pragma("unroll") for (int k = 0; k < 8; ++k) { const unsigned eo = (unsigned)__builtin_amdgcn_readlane(is_, lb_ + k) * 768u; \
        const unsigned char* rp_ = U8 + eo; uw[k] = *(const v3u_t*)(rp_ + vo12); } } while (0)
#define PEER_LDV(g_) do { const int is_ = ((g_) < 8) ? idA : idB; const int lb_ = ((g_) * 8) & 63; _Pragma("unroll") for (int k = 0; k < 8; ++k) { const unsigned eo = (unsigned)__builtin_amdgcn_readlane(is_, lb_ + k) * 768u; \
        const unsigned char* rp_ = V8 + eo; vw[k] = *(const v3u_t*)(rp_ + vo12); } } while (0)
    PEER_LDU(0); PEER_LDV(0);
    for (int g = 0; g < 16; ++g) {
        const float susel = (g < 8) ? suA : suB, svsel = (g < 8) ? svA : svB; const int lb = (g * 8) & 63;
        float d[8];
#pragma unroll
        for (int k = 0; k < 8; k += 2) {
            const v32f_t f = __builtin_amdgcn_cvt_scalef32_pk32_f32_fp6((v6u_t){uw[k][0], uw[k][1], uw[k][2], uw[k + 1][0], uw[k + 1][1], uw[k + 1][2]}, 1.0f);
            f32x2 a = (f32x2){0.f, 0.f}, b = a;
#pragma unroll
            for (int i = 0; i < 8; ++i) { a += (f32x2){f[2 * i], f[2 * i + 1]} * hx[i]; b += (f32x2){f[16 + 2 * i], f[17 + 2 * i]} * hx[i]; }
            d[k] = a[0] + a[1]; d[k + 1] = b[0] + b[1];
            __builtin_amdgcn_sched_barrier(0);
        }
        if (g + 1 < 16) PEER_LDU(g + 1);
        __builtin_amdgcn_sched_barrier(0);
#pragma unroll
        for (int k = 0; k < 8; ++k) d[k] *= __uint_as_float((unsigned)__builtin_amdgcn_readlane((int)__float_as_uint(susel), lb + k));
        float r4[4];
#pragma unroll
        for (int k = 0; k < 4; ++k) { const float send = bit0 ? d[k] : d[k + 4], keep = bit0 ? d[k + 4] : d[k]; r4[k] = keep + rw::dppf<0xB1>(send); }
        float r2[2];
#pragma unroll
        for (int k = 0; k < 2; ++k) { const float send = bit1 ? r4[k] : r4[k + 2], keep = bit1 ? r4[k + 2] : r4[k]; r2[k] = keep + rw::dppf<0x4E>(send); }
        float r1;
        { const float send = bit5 ? r2[0] : r2[1], keep = bit5 ? r2[1] : r2[0];
          auto rr = __builtin_amdgcn_permlane32_swap(__float_as_uint(send), __float_as_uint(send), false, false);
          r1 = keep + __uint_as_float(bit5 ? rr[0] : rr[1]); }
        r1 += rw::dppf<0x128>(r1); r1 += rw::dppf<0x124>(r1);
        r1 += __uint_as_float((unsigned)__builtin_amdgcn_ds_swizzle((int)__float_as_uint(r1), 0x401F));
        const float dd = r1;
        const float act = 0.5f * dd * (1.f + erff(dd * 0.70710678118654752f));
#pragma unroll
        for (int k = 0; k < 8; k += 2) {
#define PEER_LANE_OF(k_) ((((k_) >> 2) & 1) | ((((k_) >> 1) & 1) << 1) | (((k_) & 1) << 5))
            const float a = __uint_as_float((unsigned)__builtin_amdgcn_readlane((int)__float_as_uint(act), PEER_LANE_OF(k))) * __uint_as_float((unsigned)__builtin_amdgcn_readlane((int)__float_as_uint(svsel), lb + k));
            const float b = __uint_as_float((unsigned)__builtin_amdgcn_readlane((int)__float_as_uint(act), PEER_LANE_OF(k + 1))) * __uint_as_float((unsigned)__builtin_amdgcn_readlane((int)__float_as_uint(svsel), lb + k + 1));
#undef PEER_LANE_OF
            const f32x2 a2 = (f32x2){a, a}, b2 = (f32x2){b, b};
            const v32f_t f = __builtin_amdgcn_cvt_scalef32_pk32_f32_fp6((v6u_t){vw[k][0], vw[k][1], vw[k][2], vw[k + 1][0], vw[k + 1][1], vw[k + 1][2]}, 1.0f);
#pragma unroll
            for (int i = 0; i < 8; ++i) { y[i] += (f32x2){f[2 * i], f[2 * i + 1]} * a2; y[i] += (f32x2){f[16 + 2 * i], f[17 + 2 * i]} * b2; }
            __builtin_amdgcn_sched_barrier(0);
        }
        if (g + 1 < 16) PEER_LDV(g + 1);
        __builtin_amdgcn_sched_barrier(0);
    }
#undef PEER_LDU
#undef PEER_LDV
    float* orow = out + (size_t)t * DM + l16;
    float ss = 0.f;
    f32x4 o4[4];
#pragma unroll
    for (int i = 0; i < 4; ++i) { o4[i] = (f32x4){hx[2 * i][0] + y[2 * i][0], hx[2 * i][1] + y[2 * i][1], hx[2 * i + 1][0] + y[2 * i + 1][0], hx[2 * i + 1][1] + y[2 * i + 1][1]};
        ss += (o4[i][0] * o4[i][0] + o4[i][1] * o4[i][1]) + (o4[i][2] * o4[i][2] + o4[i][3] * o4[i][3]); }
    ss = wave_sum(ss);
    const float r = rsqrtf(ss * (1.f / DM) + NORM_EPS);
#pragma unroll
    for (int i = 0; i < 4; ++i) *(f32x4*)(orow + 4 * i) = o4[i] * r * *(const f32x4*)(fw + l16 + 4 * i);
}

__global__ void __launch_bounds__(NWAVES * 64, 2) mk_fwd(Args args) {
    extern __shared__ __attribute__((aligned(16))) unsigned char lds_raw[];
    LAS unsigned char* lds = (LAS unsigned char*)lds_raw;
    volatile LAS unsigned* MISC = (volatile LAS unsigned*)(lds + MISC_OFF);
    const int tid = threadIdx.x, lane = tid & 63, wave = __builtin_amdgcn_readfirstlane(tid >> 6);
    const int G = gridDim.x; const int bx = blockIdx.x; const int vcu = (G % 8 == 0) ? (bx % 8) * (G / 8) + bx / 8 : bx;
    unsigned char* ws = args.ws;
    unsigned* ctl = (unsigned*)(ws + WS_CTL);
    for (int u = tid; u < (LDS_BYTES - LDSCTL_OFF) / 4; u += NWAVES * 64) ((LAS unsigned*)(lds + LDSCTL_OFF))[u] = 0u;
    __syncthreads();
    XcdBarrier bar = xcd_barrier_post(ctl + CW_BAR + args.li * XCD_BAR_WORDS, MISC + 8);
    const int lo = args.ph_lo, hi = args.ph_hi;
#define IN(k) (lo <= (k) && (k) < hi)
#define BOTH(k) (IN(k) && IN((k) + 1))
    bf16_t* WinT = (bf16_t*)(ws + WS_WIN); bf16_t* PaT = (bf16_t*)(ws + WS_PA); bf16_t* PbT = (bf16_t*)(ws + WS_PB); bf16_t* WoT = (bf16_t*)(ws + WS_WO);
    bf16_t* WqT = (bf16_t*)(ws + WS_WQ); bf16_t* KeysB = (bf16_t*)(ws + WS_KEYS);
    float* rstd1 = (float*)(ws + WS_RSTD1); float* ssq2 = (float*)(ws + WS_RSTD2); float* scal = (float*)(ws + WS_SCAL);
    unsigned char* U8 = ws + WS_U; unsigned char* V8 = ws + WS_V; float* usc = (float*)(ws + WS_USC); float* vsc = (float*)(ws + WS_VSC);
    bf16_t* xb = (bf16_t*)(ws + WS_XB); bf16_t* ya = (bf16_t*)(ws + WS_YA); bf16_t* yb = (bf16_t*)(ws + WS_YB); bf16_t* x2b = (bf16_t*)(ws + WS_X2B);
    bf16_t* z = (bf16_t*)(ws + WS_Z); bf16_t* qb = (bf16_t*)(ws + WS_Q);
    bf16_t* merged = (bf16_t*)(ws + WS_MERGED);
    const int gw = vcu * NWAVES + wave, NGW = G * NWAVES;

    if (IN(0)) {
        LAS float* scr = (LAS float*)(lds + wave * 16384);
        constexpr int I_IN = (DM / 64) * (NZ / 32), I_PA = (512 / 64) * (DM / 32), I_WO = (DM / 64) * (DM / 32), I_WQ = (DM / 64) * (2048 / 32);
        constexpr int NITEMS = I_IN + 2 * I_PA + I_WO + I_WQ;
        for (int it = gw; it < NITEMS; it += NGW) {
            int r = it;
            if (r < I_IN) { p0_transpose_item(args.in[2], args.in[1], DM, NZ, WinT, scr, r, lane); continue; } r -= I_IN;
            if (r < I_PA) { p0_transpose_item(args.in[19], nullptr, 512, DM, PaT, scr, r, lane); continue; } r -= I_PA;
            if (r < I_PA) { p0_transpose_item(args.in[20], nullptr, 512, DM, PbT, scr, r, lane); continue; } r -= I_PA;
            if (r < I_WO) { p0_transpose_item(args.in[21], nullptr, DM, DM, WoT, scr, r, lane); continue; } r -= I_WO;
            p0_transpose_item(args.in[23], args.in[22], DM, 2048, WqT, scr, r, lane);
        }
        p0_convert(args.in[24], nullptr, KeysB, (size_t)16 * 128 * 128, gw, NGW, lane);
        for (int e = gw; e < 2 * NEXP; e += NGW) {
            const bool isu = e < NEXP; const int row = isu ? e : e - NEXP;
            p0_row_fp6((isu ? args.in[25] : args.in[26]) + (size_t)row * DM, isu ? args.in[22] : nullptr, (isu ? U8 : V8) + (size_t)row * 768, (isu ? usc : vsc) + row, lane);
        }
        for (int m = gw; m < T_TOK; m += NGW) {
            const f32x4* xr = (const f32x4*)(args.in[0] + (size_t)m * DM) + lane;
            f32x4 v[4]; float s = 0.f;
#pragma unroll
            for (int j = 0; j < 4; ++j) { v[j] = xr[64 * j]; s += (v[j][0] * v[j][0] + v[j][1] * v[j][1]) + (v[j][2] * v[j][2] + v[j][3] * v[j][3]); }
            s = wave_sum(s);
            v2u* o8 = (v2u*)(xb + (size_t)m * DM) + lane;
#pragma unroll
            for (int j = 0; j < 4; ++j) { v2u w; w.x = pg8::cvt_pk_bf16(v[j][0], v[j][1]); w.y = pg8::cvt_pk_bf16(v[j][2], v[j][3]); o8[64 * j] = w; }
            if (lane == 0) rstd1[m] = rsqrtf(s * (1.f / DM) + NORM_EPS);
        }
        if (gw == 0) {
            const float a = wave_sum(args.in[14][lane] * args.in[15][lane]), b = wave_sum(args.in[16][lane] * args.in[17][lane]);
            if (lane == 0) scal[0] = __expf(a) - __expf(b) + LAM_INIT;
        }
        if (BOTH(0)) xcd_barrier(bar);
    }
    if (IN(1)) {
        pg8::Gemm g{xb, WinT, DM, DM, DM}; pg8::StaticOrder S; S.init(T_TOK, NZ, G, bx);
        pg8::EpiRowScale<false> E{z, NZ, rstd1};
        for (int rep = 0; rep < REPS(1); ++rep) pg8::gemm_phase(lds, g, S, E);
        if (BOTH(1)) xcd_barrier(bar);
    }
    if (IN(2)) {
        {
            const rw::ScanP P{args.in[3], args.in[4], args.in[5], args.in[6], args.in[7], args.in[8], args.in[9], args.in[10], args.in[11], args.in[12], args.in[13]};
            for (int rep = 0; rep < REPS(2); ++rep) for (int u = vcu; u < NB * 8; u += G) rw::scan_unit(lds, z, ya, P, u >> 3, u & 7, tid, wave, lane);
        }
        const float lam = scal[0];
        __syncthreads();
        for (int i = 0;; ++i) {
            int idx = vcu + i * G; if (idx >= 2048 * REPS(10)) break;
            idx &= 2047;
            const int slot = idx >> 8, v = idx & 255, bh = v >> 1, a = (v & 1) * 4 + (slot >> 1), qblk = (slot & 1) ? 15 - a : a;
            da::attn_unit(lds, z, yb, args.in[18], lam, bh >> 2, bh & 3, qblk, wave, lane);
        }
        if (BOTH(2)) xcd_barrier(bar);
    }
    if (IN(3)) {
        pg8::Gemm g{ya, PaT, 512, 512, 512}; pg8::StaticOrder S; S.init(T_TOK, DM, G, bx);
        pg8::EpiGate<false> E{merged, z, C_GA};
        pg8::gemm_phase(lds, g, S, E);
        if (BOTH(3)) xcd_barrier(bar);
    }
    if (IN(4)) {
        pg8::Gemm g{yb, PbT, 512, 512, 512}; pg8::StaticOrder S; S.init(T_TOK, DM, G, bx);
        pg8::EpiGate<true> E{merged, z, C_GB};
        pg8::gemm_phase(lds, g, S, E);
        if (BOTH(4)) xcd_barrier(bar);
    }
    if (IN(5)) {
        pg8::Gemm g{merged, WoT, DM, DM, DM}; pg8::StaticOrder S; S.init(T_TOK, DM, G, bx);
        pg8::EpiX2 E{args.in[0], args.out, x2b, ssq2};
        pg8::gemm_phase(lds, g, S, E);
        if (BOTH(5)) xcd_barrier(bar);
    }
    if (IN(6)) {
        pg8::Gemm g{x2b, WqT, DM, DM, DM}; pg8::StaticOrder S; S.init(T_TOK, 2048, G, bx);
        pg8::EpiRowScale<true> E{qb, 2048, ssq2};
        for (int rep = 0; rep < REPS(6); ++rep) pg8::gemm_phase(lds, g, S, E);
        if (BOTH(6)) xcd_barrier(bar);
    }
    if (IN(7)) {
        int* ids = (int*)(ws + WS_IDS); float* gates = (float*)(ws + WS_GATES);
        for (int rep = 0; rep < REPS(7); ++rep)
        for (int h = 0; h < 8; ++h) {
            __syncthreads();
            {
                const bf16_t* ksrc = KeysB + (size_t)h * 2 * 128 * 128;
#pragma unroll
                for (int i = 0; i < 8; ++i) { const int chunk = tid + i * 512, row = chunk >> 4, cc = chunk & 15;
                    *(LAS v4u*)(lds + (row >> 7) * TK_HALF + (row & 127) * TK_PITCH + cc * 16) = *(const v4u*)(ksrc + (size_t)row * 128 + cc * 8); }
            }
            __syncthreads();
            for (int tile = gw; tile < 4096; tile += NGW) {
                tk_bf16x8 qa[8];
                topk_loadq(qa, qb, tile * 16, h, lane);
                topk_item(qa, lds, ids, gates, tile * 16, h, lane);
            }
        }
        if (BOTH(7)) xcd_barrier(bar);
    }
    if (IN(8)) {
        const int* ids = (const int*)(ws + WS_IDS); const float* gates = (const float*)(ws + WS_GATES);
        for (int t = gw; t < T_TOK; t += NGW) peer_token(x2b, ssq2, ids, gates, U8, V8, usc, vsc, args.in[27], args.out, t, lane);
    }
#undef IN
#undef BOTH
}

extern "C" void kernel_launch(void* const* d_in, const int* in_sizes, int n_in, void* d_out, int out_size, void* d_ws, size_t ws_size, hipStream_t stream) {
    static int grid = 0;
    if (grid == 0) {
        if (n_in != 28 || in_sizes[0] != T_TOK * DM || out_size != T_TOK * DM || ws_size < WS_END) {
            fprintf(stderr, "kernel_launch: unexpected shapes / workspace (n_in %d, ws %zu < %zu)\n", n_in, ws_size, (size_t)WS_END); grid = -1; return; }
        int dev = 0, cus = 0;
        if (hipGetDevice(&dev) != hipSuccess || hipDeviceGetAttribute(&cus, hipDeviceAttributeMultiprocessorCount, dev) != hipSuccess) { grid = -1; return; }
        if (hipFuncSetAttribute((const void*)mk_fwd, hipFuncAttributeMaxDynamicSharedMemorySize, LDS_BYTES) != hipSuccess) { fprintf(stderr, "kernel_launch: hipFuncSetAttribute failed\n"); grid = -1; return; }
        grid = cus;
    }
    if (grid < 0) return;
    unsigned char* ws = (unsigned char*)d_ws;
    float* out = (float*)d_out;
    (void)hipMemsetAsync(ws + WS_CTL, 0, 1 * MiB, stream);
    Args a{};
    for (int i = 0; i < 28; ++i) a.in[i] = (const float*)d_in[i];
    a.out = out; a.ws = ws;
    a.ph_lo = 0; a.ph_hi = 9; a.li = 0;
    hipLaunchKernelGGL(mk_fwd, dim3(grid), dim3(NWAVES * 64), LDS_BYTES, stream, a);
}
```

```cpp
#include <hip/hip_runtime.h>
#include <stdint.h>
#include <cstdio>

typedef unsigned short bf16_t;
typedef unsigned int u32;

#ifndef PROBE_REP
#define PROBE_REP 0
#endif
#define REPS(k) (((PROBE_REP >> (k)) & 1) ? 2 : 1)
constexpr int T_TOK = 65536, DM = 1024, SEQ = 2048, NB = 32;
constexpr int NZ = 5376;
constexpr int C_R = 0, C_K = 512, C_V = 1024, C_WL = 1536, C_AL = 1600, C_GL = 1664, C_Q = 1792, C_ZK = 2304, C_ZV = 2816, C_GA = 3328, C_GB = 4352;
constexpr int NEXP = 16384;
constexpr float NORM_EPS = 1e-6f, GN_EPS = 64e-5f, SUBLN_EPS = 1e-5f;
constexpr float LAM_INIT = 0.2f;

constexpr size_t MiB = 1u << 20;
constexpr size_t WS_CTL = 0;
constexpr size_t WS_WIN = 1 * MiB;
constexpr size_t WS_PA = 12 * MiB;
constexpr size_t WS_PB = 13 * MiB;
constexpr size_t WS_WO = 14 * MiB;
constexpr size_t WS_WQ = 16 * MiB;
constexpr size_t WS_KEYS = 20 * MiB;
constexpr size_t WS_RSTD1 = 21 * MiB;
constexpr size_t WS_RSTD2 = 58 * MiB;
constexpr size_t WS_SCAL = 23 * MiB;
constexpr size_t WS_U = 24 * MiB;
constexpr size_t WS_V = 40 * MiB;
constexpr size_t WS_USC = 56 * MiB;
constexpr size_t WS_VSC = 57 * MiB;
constexpr size_t WS_XB = 88 * MiB;
constexpr size_t WS_YA = WS_XB;
constexpr size_t WS_YB = WS_XB + 64 * MiB;
constexpr size_t WS_X2B = WS_XB;
constexpr size_t WS_Z = 216 * MiB;
constexpr size_t WS_Q = WS_Z;
constexpr size_t WS_IDS = WS_Z + 256 * MiB;
constexpr size_t WS_GATES = WS_Z + 288 * MiB;
constexpr size_t WS_MERGED = 888 * MiB;
constexpr size_t WS_END = 1016 * MiB;

__device__ __forceinline__ float bf2f(bf16_t h) { return __uint_as_float(((u32)h) << 16); }
__device__ __forceinline__ bf16_t f2bf(float f) { u32 u = __float_as_uint(f); u += 0x7fffu + ((u >> 16) & 1u); return (bf16_t)(u >> 16); }
__device__ __forceinline__ float wave_sum(float v) {
#pragma unroll
    for (int o = 1; o < 64; o <<= 1) v += __shfl_xor(v, o);
    return v;
}
__device__ __forceinline__ float sigmoidf_(float x) { return __builtin_amdgcn_rcpf(1.f + __expf(-x)); }

namespace pg8 {
#define PG8_LAS __attribute__((address_space(3)))
typedef short bf16x8 __attribute__((ext_vector_type(8)));
typedef float f32x4 __attribute__((ext_vector_type(4)));
typedef unsigned u32x4 __attribute__((ext_vector_type(4)));
constexpr int BM = 256, BK = 64, HALF = 128, HTB = HALF * BK * 2  , STAGE_BYTES = 8 * HTB, NXCD = 8, WGM = 8;

__host__ __device__ __forceinline__ int lds_byte(int r, int c) { const int st = (r >> 4) * 2 + (c >> 5), rr = r & 15, cc = c & 31, ob = rr * 64 + cc * 2; return st * 1024 + (ob ^ (((ob >> 9) & 1) << 5)); }
__host__ __device__ __forceinline__ void stage_rc(int b, int& R, int& C) { const int st = b / 1024, sb = b % 1024, swz = sb ^ (((sb >> 9) & 1) << 5); R = (st >> 1) * 16 + swz / 64; C = (st & 1) * 32 + (swz % 64) / 2; }
__host__ __device__ __forceinline__ int perm32(int rho) { const int n = rho >> 4, i = rho & 15; return 8 * (i >> 2) + 4 * n + (i & 3); }

struct Unit { int pm, pn; };
struct Gemm { const bf16_t* A; const bf16_t* Bt; int lda, ldb, K; };

struct StaticOrder {
    int nM, nN, nwg, G, c;
    __host__ __device__ void init(int M, int N, int G_, int c_) { nM = M / BM; nN = N / BM; nwg = nM * nN; G = G_; c = c_; }
    __host__ __device__ bool next(int i, Unit& u) const {
        const long L = (long)i * G + c; if (L >= nwg) return false;
        int wgid = (int)L; { const int q = nwg / NXCD, r = nwg % NXCD, xcd = wgid % NXCD, off = wgid / NXCD; wgid = (xcd < r ? xcd * (q + 1) : r * (q + 1) + (xcd - r) * q) + off; }
        const int nig = WGM * nN, gid = wgid / nig, fm = gid * WGM, gsz = (nM - fm) < WGM ? (nM - fm) : WGM;
        u.pm = fm + ((wgid % nig) % gsz); u.pn = (wgid % nig) / gsz; return true;
    }
};
typedef float f32x2_c __attribute__((ext_vector_type(2))); typedef __bf16 bf16x2_c __attribute__((ext_vector_type(2)));
__device__ __forceinline__ unsigned cvt_pk_bf16(float lo, float hi) { const f32x2_c v = {lo, hi}; const bf16x2_c b = __builtin_convertvector(v, bf16x2_c); return __builtin_bit_cast(unsigned, b); }
__device__ __forceinline__ float bflo(unsigned w) { return __uint_as_float(w << 16); }
__device__ __forceinline__ float bfhi(unsigned w) { return __uint_as_float(w & 0xffff0000u); }

__device__ __forceinline__ float ssq_sum16(const float* p) {
    const f32x4 a = *(const f32x4*)p, b = *(const f32x4*)(p + 4), c = *(const f32x4*)(p + 8), d = *(const f32x4*)(p + 12);
    return (((a[0] + a[1]) + (a[2] + a[3])) + ((b[0] + b[1]) + (b[2] + b[3]))) + (((c[0] + c[1]) + (c[2] + c[3])) + ((d[0] + d[1]) + (d[2] + d[3])));
}
template <bool SSQ> struct EpiRowScale {
    static constexpr bool PERM = true;
    bf16_t* O; int ldc; const float* rs;
    __device__ __forceinline__ void operator()(const f32x4 (&acc)[2][2][4][2], const Unit& u, int wr, int wc, int fr, int fq) const {
        const int row0 = u.pm * BM + wr * 64 + fr, col0 = u.pn * BM + wc * 32 + 8 * fq;
#pragma unroll
        for (int ai = 0; ai < 2; ++ai)
#pragma unroll
            for (int m = 0; m < 4; ++m) {
                const int row = row0 + ai * HALF + m * 16;
                float s; if (SSQ) s = rsqrtf(ssq_sum16(rs + (size_t)row * 16) * (1.f / 1024.f) + NORM_EPS); else s = rs[row];
                bf16_t* rowp = O + (size_t)row * ldc + col0;
#pragma unroll
                for (int bj = 0; bj < 2; ++bj) {
                    const f32x4 v0 = acc[ai][bj][m][0] * s, v1 = acc[ai][bj][m][1] * s;
                    u32x4 w; w.x = cvt_pk_bf16(v0[0], v0[1]); w.y = cvt_pk_bf16(v0[2], v0[3]); w.z = cvt_pk_bf16(v1[0], v1[1]); w.w = cvt_pk_bf16(v1[2], v1[3]);
                    *(u32x4*)(rowp + bj * HALF) = w;
                }
            }
    }
};
template <bool ACCUM> struct EpiGate {
    static constexpr bool PERM = true;
    bf16_t* mg; const bf16_t* z; int gcol;
    __device__ __forceinline__ void operator()(const f32x4 (&acc)[2][2][4][2], const Unit& u, int wr, int wc, int fr, int fq) const {
        const int row0 = u.pm * BM + wr * 64 + fr, col0 = u.pn * BM + wc * 32 + 8 * fq;
#pragma unroll
        for (int ai = 0; ai < 2; ++ai)
#pragma unroll
            for (int m = 0; m < 4; ++m) {
                const int row = row0 + ai * HALF + m * 16;
                const bf16_t* gp = z + (size_t)row * NZ + gcol + col0;
                bf16_t* rowp = mg + (size_t)row * DM + col0;
#pragma unroll
                for (int bj = 0; bj < 2; ++bj) {
                    const u32x4 g = *(const u32x4*)(gp + bj * HALF);
                    const f32x4 a0 = acc[ai][bj][m][0], a1 = acc[ai][bj][m][1];
                    float r[8];
                    r[0] = sigmoidf_(bflo(g.x)) * a0[0]; r[1] = sigmoidf_(bfhi(g.x)) * a0[1]; r[2] = sigmoidf_(bflo(g.y)) * a0[2]; r[3] = sigmoidf_(bfhi(g.y)) * a0[3];
                    r[4] = sigmoidf_(bflo(g.z)) * a1[0]; r[5] = sigmoidf_(bfhi(g.z)) * a1[1]; r[6] = sigmoidf_(bflo(g.w)) * a1[2]; r[7] = sigmoidf_(bfhi(g.w)) * a1[3];
                    if (ACCUM) { const u32x4 o = *(const u32x4*)(rowp + bj * HALF);
                        r[0] += bflo(o.x); r[1] += bfhi(o.x); r[2] += bflo(o.y); r[3] += bfhi(o.y); r[4] += bflo(o.z); r[5] += bfhi(o.z); r[6] += bflo(o.w); r[7] += bfhi(o.w); }
                    u32x4 w; w.x = cvt_pk_bf16(r[0], r[1]); w.y = cvt_pk_bf16(r[2], r[3]); w.z = cvt_pk_bf16(r[4], r[5]); w.w = cvt_pk_bf16(r[6], r[7]);
                    *(u32x4*)(rowp + bj * HALF) = w;
                }
            }
    }
};
struct EpiX2 {
    static constexpr bool PERM = true;
    const float* x; float* x2; bf16_t* x2b; float* ssq;
    __device__ __forceinline__ void operator()(const f32x4 (&acc)[2][2][4][2], const Unit& u, int wr, int wc, int fr, int fq) const {
        const int row0 = u.pm * BM + wr * 64 + fr, col0 = u.pn * BM + wc * 32 + 8 * fq;
#pragma unroll
        for (int ai = 0; ai < 2; ++ai)
#pragma unroll
            for (int m = 0; m < 4; ++m) {
                const int row = row0 + ai * HALF + m * 16;
                const size_t off = (size_t)row * DM + col0;
                float ss = 0.f;
#pragma unroll
                for (int bj = 0; bj < 2; ++bj) {
                    const f32x4 x0 = *(const f32x4*)(x + off + bj * HALF), x1 = *(const f32x4*)(x + off + bj * HALF + 4);
                    const f32x4 o0 = x0 + acc[ai][bj][m][0], o1 = x1 + acc[ai][bj][m][1];
                    u32x4 w; w.x = cvt_pk_bf16(o0[0], o0[1]); w.y = cvt_pk_bf16(o0[2], o0[3]); w.z = cvt_pk_bf16(o1[0], o1[1]); w.w = cvt_pk_bf16(o1[2], o1[3]);
                    *(u32x4*)(x2b + off + bj * HALF) = w;
                    ss += (o0[0] * o0[0] + o0[1] * o0[1]) + (o0[2] * o0[2] + o0[3] * o0[3]) + (o1[0] * o1[0] + o1[1] * o1[1]) + (o1[2] * o1[2] + o1[3] * o1[3]);
                }
                ss += __shfl_xor(ss, 16); ss += __shfl_xor(ss, 32);
                if (fq == 0) ssq[(size_t)row * 16 + (u.pn & 3) * 4 + wc] = ss;
            }
    }
};

template <class Epi, class Sched>
__device__ __forceinline__ void gemm_phase(PG8_LAS unsigned char* lds, const Gemm g, const Sched& S, const Epi& E) {
    const int tid = threadIdx.x, wid = __builtin_amdgcn_readfirstlane(tid >> 6), lane = tid & 63, wr = wid >> 2, wc = wid & 3, fr = lane & 15, fq = lane >> 4;
    const int K = g.K, nt = K / BK;
    unsigned voffA[2], voffB[2];
#pragma unroll
    for (int i = 0; i < 2; ++i) { int R, C; stage_rc(tid * 16 + i * 8192, R, C); const int Rb = Epi::PERM ? ((R & ~31) + perm32(R & 31)) : R;
        voffA[i] = (unsigned)(R * g.lda + C) * 2u; voffB[i] = (unsigned)(Rb * g.ldb + C) * 2u; }
    const size_t kstep = (size_t)(BK * 2);
    const size_t hstepA = (size_t)HALF * g.lda * 2, hstepB = (size_t)HALF * g.ldb * 2;
    const size_t tstepA = 2 * hstepA, tstepB = 2 * hstepB;
    const unsigned ldsw = (unsigned)wid * 1024u;
    const int aoff = lds_byte(wr * 64 + fr, fq * 8), boff = lds_byte(wc * 32 + fr, fq * 8);
#define PG8_SA(b, h) (((b) * 2 + (h)) * HTB)
#define PG8_SB(b, h) ((4 + (b) * 2 + (h)) * HTB)
#define PG8_STAGE(bufoff, gbase, voff) do { _Pragma("unroll") for (int _i = 0; _i < 2; ++_i) \
        __builtin_amdgcn_global_load_lds((const unsigned*)((const char*)(gbase) + (voff)[_i]), (PG8_LAS unsigned*)(lds + (bufoff) + ldsw + _i * 8192), 16, 0, 0); } while (0)
#define PG8_LDA(dst, b, h) do { _Pragma("unroll") for (int m = 0; m < 4; ++m) _Pragma("unroll") for (int k = 0; k < 2; ++k) dst[m][k] = *(const PG8_LAS bf16x8*)(lds + PG8_SA(b, h) + aoff + m * 2048 + k * 1024); } while (0)
#define PG8_LDB(dst, b, h) do { _Pragma("unroll") for (int n = 0; n < 2; ++n) _Pragma("unroll") for (int k = 0; k < 2; ++k) dst[n][k] = *(const PG8_LAS bf16x8*)(lds + PG8_SB(b, h) + boff + n * 2048 + k * 1024); } while (0)
#define PG8_MMA(ai, bj, At, Bt) do { __builtin_amdgcn_s_setprio(1); _Pragma("unroll") for (int m = 0; m < 4; ++m) _Pragma("unroll") for (int n = 0; n < 2; ++n) _Pragma("unroll") for (int k = 0; k < 2; ++k) \
        acc[ai][bj][m][n] = __builtin_amdgcn_mfma_f32_16x16x32_bf16(Bt[n][k], At[m][k], acc[ai][bj][m][n], 0, 0, 0); __builtin_amdgcn_s_setprio(0); } while (0)
#define PG8_WAIT_V(n) asm volatile("s_waitcnt vmcnt(" #n ")" ::: "memory")
#define PG8_WAIT_L(n) asm volatile("s_waitcnt lgkmcnt(" #n ")" ::: "memory")
#define PG8_BAR __builtin_amdgcn_s_barrier()
#define PG8_SCHED __builtin_amdgcn_sched_barrier(0)
    Unit cur, nxt; int ui = 0;
    if (!S.next(0, cur)) return;
    f32x4 acc[2][2][4][2];
#pragma unroll
    for (int a = 0; a < 2; ++a)
#pragma unroll
        for (int b = 0; b < 2; ++b)
#pragma unroll
            for (int m = 0; m < 4; ++m)
#pragma unroll
                for (int n = 0; n < 2; ++n) acc[a][b][m][n] = (f32x4){0.f, 0.f, 0.f, 0.f};
    bf16x8 At[4][2], B0[2][2], B1[2][2];
    const char* cA = (const char*)g.A + (size_t)cur.pm * tstepA; const char* cB = (const char*)g.Bt + (size_t)cur.pn * tstepB;
    PG8_STAGE(PG8_SB(0, 0), cB, voffB); PG8_STAGE(PG8_SB(0, 1), cB + hstepB, voffB); PG8_STAGE(PG8_SA(0, 0), cA, voffA); PG8_STAGE(PG8_SA(0, 1), cA + hstepA, voffA);
    if (wr == 1) PG8_BAR;
    PG8_WAIT_V(2); PG8_BAR;
    PG8_STAGE(PG8_SB(1, 0), cB + kstep, voffB); PG8_STAGE(PG8_SA(1, 0), cA + kstep, voffA); PG8_STAGE(PG8_SB(1, 1), cB + hstepB + kstep, voffB);
    PG8_WAIT_V(6); PG8_BAR;
    for (;;) {
        const bool has_next = S.next(ui + 1, nxt);
        const char* nA = has_next ? (const char*)g.A + (size_t)nxt.pm * tstepA : cA; const char* nB = has_next ? (const char*)g.Bt + (size_t)nxt.pn * tstepB : cB;
        for (int t = 0; t < nt; t += 2) {
            const bool last = (t == nt - 2);
            const char* a1 = cA + (size_t)(t + 1) * kstep;
            const char* a2 = last ? nA : cA + (size_t)(t + 2) * kstep; const char* b2 = last ? nB : cB + (size_t)(t + 2) * kstep;
            const char* a3 = a2 + kstep; const char* b3 = b2 + kstep;
            PG8_LDB(B0, 0, 0); PG8_LDB(B1, 0, 1); PG8_SCHED; PG8_LDA(At, 0, 0); PG8_STAGE(PG8_SA(1, 1), a1 + hstepA, voffA);
            PG8_WAIT_V(8); PG8_WAIT_L(0); PG8_BAR; PG8_MMA(0, 0, At, B0); PG8_MMA(0, 1, At, B1); PG8_BAR; PG8_SCHED;
            PG8_LDA(At, 0, 1); PG8_STAGE(PG8_SB(0, 0), b2, voffB); PG8_STAGE(PG8_SB(0, 1), b2 + hstepB, voffB); PG8_STAGE(PG8_SA(0, 0), a2, voffA);
            PG8_WAIT_V(8); PG8_WAIT_L(0); PG8_BAR; PG8_MMA(1, 0, At, B0); PG8_MMA(1, 1, At, B1); PG8_BAR; PG8_SCHED;
            PG8_LDB(B0, 1, 0); PG8_LDB(B1, 1, 1); PG8_SCHED; PG8_LDA(At, 1, 0); PG8_STAGE(PG8_SA(0, 1), a2 + hstepA, voffA);
            PG8_WAIT_V(8); PG8_WAIT_L(0); PG8_BAR; PG8_MMA(0, 0, At, B0); PG8_MMA(0, 1, At, B1); PG8_BAR; PG8_SCHED;
            PG8_LDA(At, 1, 1); PG8_STAGE(PG8_SB(1, 0), b3, voffB); PG8_STAGE(PG8_SB(1, 1), b3 + hstepB, voffB); PG8_STAGE(PG8_SA(1, 0), a3, voffA);
            PG8_WAIT_V(8); PG8_WAIT_L(0); PG8_BAR; PG8_MMA(1, 0, At, B0); PG8_MMA(1, 1, At, B1); PG8_BAR; PG8_SCHED;
        }
        if (wr == 0) PG8_BAR;
        E(acc, cur, wr, wc, fr, fq);
        if (!has_next) break;
#pragma unroll
        for (int a = 0; a < 2; ++a)
#pragma unroll
            for (int b = 0; b < 2; ++b)
#pragma unroll
                for (int m = 0; m < 4; ++m)
#pragma unroll
                    for (int n = 0; n < 2; ++n) acc[a][b][m][n] = (f32x4){0.f, 0.f, 0.f, 0.f};
        cur = nxt; cA = nA; cB = nB; ++ui;
        if (wr == 1) PG8_BAR;
    }
    PG8_WAIT_V(0);
    PG8_BAR;
#undef PG8_SA
#undef PG8_SB
#undef PG8_STAGE
#undef PG8_LDA
#undef PG8_LDB
#undef PG8_MMA
#undef PG8_WAIT_V
#undef PG8_WAIT_L
#undef PG8_BAR
#undef PG8_SCHED
}
}

constexpr int NWAVES = 8;
constexpr int LDS_RING_BYTES = 131072, LDSCTL_OFF = 143360, MISC_OFF = LDSCTL_OFF + 320, LDS_BYTES = 147456;
#define LAS __attribute__((address_space(3)))
#define GAS __attribute__((address_space(1)))
typedef float f32x4 __attribute__((ext_vector_type(4)));
typedef unsigned v4u __attribute__((ext_vector_type(4)));
typedef unsigned v2u __attribute__((ext_vector_type(2)));
#define LDS_WAIT() asm volatile("s_waitcnt lgkmcnt(0)" ::: "memory")

constexpr int CW_BAR = 4096;
#define XB_TMO      128
#define XB_XCNT(j)  (256  + 64 * (j))
#define XB_XSUB(j)  (1280 + 64 * (j))
#define XB_XGEN(j)  (2304 + 64 * (j))
#define XB_TOP      3328
#define XB_TOPGEN   3392
#define XCD_BAR_WORDS 3456
#define XB_SPIN_CAP (1u << 20)
__device__ __forceinline__ unsigned xb_ld(unsigned* p)              { return __hip_atomic_load(p, __ATOMIC_RELAXED, __HIP_MEMORY_SCOPE_AGENT); }
__device__ __forceinline__ unsigned xb_add(unsigned* p, unsigned v) { return __hip_atomic_fetch_add(p, v, __ATOMIC_RELAXED, __HIP_MEMORY_SCOPE_AGENT); }
__device__ __forceinline__ unsigned xb_xcc_id() { return (unsigned)__builtin_amdgcn_s_getreg((3 << 11) | 20) & 0xFu; }
#define XB_SPIN(cond, bar) do { unsigned _sp = 0; while (cond) { __builtin_amdgcn_s_sleep(1); \
    if ((++_sp & 255u) == 0u) { if (xb_ld(&(bar)[XB_TMO])) break; if (_sp > XB_SPIN_CAP) { atomicAdd(&(bar)[XB_TMO], 1u); break; } } } } while (0)
struct XcdBarrier { unsigned* bar; unsigned x; volatile LAS unsigned* st; };
__device__ __forceinline__ XcdBarrier xcd_barrier_post(unsigned* bar, volatile LAS unsigned* st) {
    XcdBarrier b; b.bar = bar; b.x = xb_xcc_id(); b.st = st;
    if (threadIdx.x == 0) (void)xb_add(&bar[XB_XCNT(b.x)], 1u);
    return b;
}
__device__ __forceinline__ void xcd_barrier_complete(unsigned* bar, unsigned x, unsigned& nloc, unsigned& nx) {
    const unsigned G = gridDim.x * gridDim.y * gridDim.z;
    unsigned sum, cnt, mine, sp = 0u;
    for (;;) {
        sum = 0u; cnt = 0u; mine = 0u;
#pragma unroll
        for (unsigned j = 0; j < 16; ++j) { const unsigned c = xb_ld(&bar[XB_XCNT(j)]); sum += c; cnt += (c > 0u) ? 1u : 0u; mine = (j == x) ? c : mine; }
        if (sum == G) break;
        __builtin_amdgcn_s_sleep(1);
        if ((++sp & 255u) == 0u) { if (xb_ld(&bar[XB_TMO])) break; if (sp > XB_SPIN_CAP) { atomicAdd(&bar[XB_TMO], 1u); break; } }
    }
    nloc = mine > 0u ? mine : 1u; nx = cnt > 0u ? cnt : 1u;
}
__device__ __forceinline__ void xcd_barrier(const XcdBarrier& b) {
    asm volatile("s_waitcnt vmcnt(0)" ::: "memory");
    __syncthreads();
    if (threadIdx.x == 0) {
        unsigned* bar = b.bar;
        __builtin_amdgcn_s_waitcnt(0);
        unsigned nloc = b.st[0], nx = b.st[1];
        if (nloc == 0u) { xcd_barrier_complete(bar, b.x, nloc, nx); b.st[0] = nloc; b.st[1] = nx; }
        const unsigned old = xb_add(&bar[XB_XSUB(b.x)], 1u);
        const unsigned gen = old / nloc;
        if (old + 1u == (gen + 1u) * nloc) {
            __builtin_amdgcn_fence(__ATOMIC_RELEASE, "agent");
            asm volatile("s_waitcnt vmcnt(0)" ::: "memory");
            const unsigned og = xb_add(&bar[XB_TOP], 1u);
            const unsigned tg = og / nx;
            if (og + 1u == (tg + 1u) * nx) xb_add(&bar[XB_TOPGEN], 1u);
            else XB_SPIN(xb_ld(&bar[XB_TOPGEN]) == tg, bar);
            __builtin_amdgcn_fence(__ATOMIC_ACQUIRE, "agent");
            xb_add(&bar[XB_XGEN(b.x)], 1u);
            asm volatile("s_waitcnt vmcnt(0)" ::: "memory");
        } else {
            XB_SPIN(xb_ld(&bar[XB_XGEN(b.x)]) == gen, bar);
            __builtin_amdgcn_fence(__ATOMIC_ACQUIRE, "agent");
            asm volatile("s_waitcnt vmcnt(0)" ::: "memory");
        }
    }
    __syncthreads();
}

struct Args { const float* in[28]; float* out; unsigned char* ws; int ph_lo, ph_hi, li, pad; };

__device__ __forceinline__ void p0_transpose_item(const float* W, const float* sc, int K, int N, bf16_t* WT, LAS float* scr, int item, int lane) {
    const int nblk = N / 32, kb = item / nblk, nb = item % nblk, k0 = 64 * kb, n0 = 32 * nb;
#pragma unroll 8
    for (int i = 0; i < 32; ++i) { const int kk = 2 * i + (lane >> 5); const float s = sc ? sc[k0 + kk] : 1.f; scr[kk * 33 + (lane & 31)] = W[(size_t)(k0 + kk) * N + n0 + (lane & 31)] * s; }
    LDS_WAIT(); asm volatile("" ::: "memory");
    const int c = lane & 7;
#pragma unroll
    for (int j = 0; j < 4; ++j) { const int n = (lane >> 3) + 8 * j; const LAS float* s = scr + (8 * c) * 33 + n;
        v4u o; o.x = pg8::cvt_pk_bf16(s[0 * 33], s[1 * 33]); o.y = pg8::cvt_pk_bf16(s[2 * 33], s[3 * 33]); o.z = pg8::cvt_pk_bf16(s[4 * 33], s[5 * 33]); o.w = pg8::cvt_pk_bf16(s[6 * 33], s[7 * 33]);
        *(v4u*)(WT + (size_t)(n0 + n) * K + k0 + 8 * c) = o; }
    LDS_WAIT(); asm volatile("" ::: "memory");
}
typedef unsigned v6u_t __attribute__((ext_vector_type(6)));
typedef unsigned v3u_t __attribute__((ext_vector_type(3)));
typedef float v16f_t __attribute__((ext_vector_type(16)));
typedef float v32f_t __attribute__((ext_vector_type(32)));
__device__ __forceinline__ void p0_row_fp6(const float* in, const float* cs, unsigned char* out, float* sc, int lane) {
    f32x4 v[4]; float mx = 0.f;
#pragma unroll
    for (int i = 0; i < 4; ++i) { v[i] = *(const f32x4*)(in + lane * 16 + 4 * i); if (cs) v[i] = v[i] * *(const f32x4*)(cs + lane * 16 + 4 * i);
        mx = fmaxf(mx, fmaxf(fmaxf(fabsf(v[i][0]), fabsf(v[i][1])), fmaxf(fabsf(v[i][2]), fabsf(v[i][3])))); }
#pragma unroll
    for (int o = 1; o < 64; o <<= 1) mx = fmaxf(mx, __shfl_xor(mx, o));
    mx = fmaxf(mx, 1e-30f);
    const float q = 7.5f / mx;
    v16f_t a, b;
#pragma unroll
    for (int i = 0; i < 16; ++i) { a[i] = 0.f; b[i] = 0.f; }
#pragma unroll
    for (int i = 0; i < 8; ++i) { a[i] = v[(2 * i) >> 2][(2 * i) & 3] * q; b[i] = v[(2 * i + 1) >> 2][(2 * i + 1) & 3] * q; }
    const v6u_t p = __builtin_amdgcn_cvt_scalef32_2xpk16_fp6_f32(a, b, 1.0f);
    *(v3u_t*)(out + lane * 12) = (v3u_t){p[0], p[1], p[2]};
    if (lane == 0) *sc = mx * (1.f / 7.5f);
}
__device__ __forceinline__ void p0_convert(const float* in, const float* cs, bf16_t* out, size_t n, int gw, int NGW, int lane) {
    for (size_t i = ((size_t)gw * 64 + lane) * 8; i < n; i += (size_t)NGW * 512) {
        f32x4 a = *(const f32x4*)(in + i), b = *(const f32x4*)(in + i + 4);
        if (cs) { const int c = (int)(i & 1023); a = a * *(const f32x4*)(cs + c); b = b * *(const f32x4*)(cs + c + 4); }
        v4u o; o.x = pg8::cvt_pk_bf16(a[0], a[1]); o.y = pg8::cvt_pk_bf16(a[2], a[3]); o.z = pg8::cvt_pk_bf16(b[0], b[1]); o.w = pg8::cvt_pk_bf16(b[2], b[3]);
        *(v4u*)(out + i) = o;
    }
}

namespace da {
typedef short bf16x8 __attribute__((ext_vector_type(8)));
typedef short s16x4 __attribute__((ext_vector_type(4)));
typedef float f32x16 __attribute__((ext_vector_type(16)));
typedef const LAS unsigned char* lcp;
constexpr float LOG2E = 1.4426950408889634f, C2 = 0.125f * LOG2E, THR = 8.f;
constexpr int RSLOT = 16384, LDS_KR = 0, LDS_VR = 4 * RSLOT, SCR_OFF = 8 * RSLOT, COMB_OFF = 0;
#define DA_SBAR() __builtin_amdgcn_sched_barrier(0)
#define DA_PIN(x) asm volatile("" : "+v"(x))
#define DA_MFMA(a, b, c) __builtin_amdgcn_mfma_f32_32x32x16_bf16(a, b, c, 0, 0, 0)
#define DA_WAIT_BAR(N) asm volatile("s_waitcnt vmcnt(" #N ") lgkmcnt(0)\n\ts_barrier" ::: "memory")
#define DA_MX3(a, b, c) __builtin_fmaxf(__builtin_fmaxf((a), (b)), (c))
__device__ __forceinline__ int crow(int r, int hi) { return (r & 3) + 8 * (r >> 2) + 4 * hi; }
__device__ __forceinline__ s16x4 vtr(lcp p) { return __builtin_bit_cast(s16x4, __builtin_amdgcn_ds_read_tr16_b64_v4i16((LAS s16x4*)p)); }
__device__ __forceinline__ unsigned cvtpk(float lo, float hi) { unsigned r; asm("v_cvt_pk_bf16_f32 %0, %1, %2" : "=v"(r) : "v"(lo), "v"(hi)); return r; }
__device__ __forceinline__ void glds16(const void* g, unsigned lds_base) {
    unsigned sv; asm volatile("s_mov_b32 %0, m0\n\ts_mov_b32 m0, %2\n\ts_nop 0\n\tglobal_load_lds_dwordx4 %1, off\n\ts_mov_b32 m0, %0" : "=&s"(sv) : "v"(g), "s"(lds_base) : "memory"); }
__device__ __forceinline__ void glds16_o128(const void* g, unsigned lds_base) {
    unsigned sv; asm volatile("s_mov_b32 %0, m0\n\ts_mov_b32 m0, %2\n\ts_nop 0\n\tglobal_load_lds_dwordx4 %1, off offset:128\n\ts_mov_b32 m0, %0" : "=&s"(sv) : "v"(g), "s"(lds_base) : "memory"); }
__device__ __forceinline__ void kload2(bf16x8* kf, lcp kp, int d0) { kf[2 * d0] = *(const LAS bf16x8*)(kp + d0 * 2048); kf[2 * d0 + 1] = *(const LAS bf16x8*)(kp + d0 * 2048 + 512); }
__device__ __forceinline__ float max16(const f32x16& p) {
    float a = DA_MX3(p[0], p[1], p[2]), b = DA_MX3(p[3], p[4], p[5]); a = DA_MX3(a, p[6], p[7]); b = DA_MX3(b, p[8], p[9]); a = DA_MX3(a, p[10], p[11]); b = DA_MX3(b, p[12], p[13]);
    a = DA_MX3(a, p[14], p[15]); return __builtin_fmaxf(a, b); }
__device__ __forceinline__ float rowmax(const f32x16& p0, const f32x16& p1, float offA, float offB) {
    const float m = __builtin_fmaxf(__builtin_fmaf(max16(p0), C2, offA), __builtin_fmaf(max16(p1), C2, offB));
    auto rr = __builtin_amdgcn_permlane32_swap(__float_as_uint(m), __float_as_uint(m), false, false);
    return __builtin_fmaxf(__uint_as_float(rr[0]), __uint_as_float(rr[1])); }
__device__ __forceinline__ void cmask(f32x16& p0, f32x16& p1, int jb, int qrel, int hi) {
    const int kb = 64 * jb + 4 * hi;
#pragma unroll
    for (int r = 0; r < 16; ++r) { const int kv = kb + (r & 3) + 8 * (r >> 2); if (kv > qrel) p0[r] = -INFINITY; if (kv + 32 > qrel) p1[r] = -INFINITY; } }

__device__ __forceinline__ void attn_epilogue_body(LAS unsigned char* lds, f32x16 (&o)[4], float l_reg, bf16_t* __restrict__ yb, const float* __restrict__ subln_w, float lam,
                                                   size_t rowb, int q0, int h, int wave, int lane) {
    asm volatile("" : "+v"(lane));
    const int r32 = lane & 31, hi = lane >> 5, map = wave >> 2, qs = wave & 3;
    LAS float* wsf = (LAS float*)(lds + SCR_OFF) + wave * 64;
    if (hi == 0) wsf[r32] = 1.f / l_reg;
    float il[16];
#pragma unroll
    for (int g = 0; g < 4; ++g) { const f32x4 t4 = *(const LAS f32x4*)(wsf + 8 * g + 4 * hi); il[4 * g] = t4[0]; il[4 * g + 1] = t4[1]; il[4 * g + 2] = t4[2]; il[4 * g + 3] = t4[3]; }
    __syncthreads();
    LAS float* comb = (LAS float*)(lds + COMB_OFF) + qs * 4096;
    if (map == 1) {
#pragma unroll
        for (int d = 0; d < 4; ++d)
#pragma unroll
            for (int r = 0; r < 16; ++r) comb[crow(r, hi) * 128 + 32 * d + r32] = o[d][r] * il[r];
    }
    __syncthreads();
    if (map == 0) {
        float sw[4];
#pragma unroll
        for (int d = 0; d < 4; ++d) sw[d] = subln_w[32 * d + r32] * (1.f - LAM_INIT);
#pragma unroll
        for (int r = 0; r < 16; ++r) {
            float v[4], ss = 0.f;
#pragma unroll
            for (int d = 0; d < 4; ++d) { v[d] = o[d][r] * il[r] - lam * comb[crow(r, hi) * 128 + 32 * d + r32]; ss += v[d] * v[d]; }
            ss += __shfl_xor(ss, 1); ss += __shfl_xor(ss, 2); ss += __shfl_xor(ss, 4); ss += __shfl_xor(ss, 8); ss += __shfl_xor(ss, 16);
            const float rs = rsqrtf(ss * (1.f / 128.f) + SUBLN_EPS);
            bf16_t* op = yb + (rowb + q0 + crow(r, hi)) * 512 + h * 128 + r32;
#pragma unroll
            for (int d = 0; d < 4; ++d) op[32 * d] = f2bf(v[d] * rs * sw[d]);
        }
    }
    __syncthreads();
}
__device__ __forceinline__ void attn_unit(LAS unsigned char* lds, const bf16_t* __restrict__ z, bf16_t* __restrict__ yb, const float* __restrict__ subln_w, float lam,
                                          int b, int h, int qblk, int wave_, int lane) {
    const int wave = __builtin_amdgcn_readfirstlane(wave_);
    const int r32 = lane & 31, hi = lane >> 5, map = wave >> 2, qs = wave & 3;
    const int q0 = qblk * 128 + qs * 32, NT = 2 * qblk + 2, qrel = qs * 32 + r32;
    const size_t rowb = (size_t)b * SEQ;
    const float slope = exp2f(-2.f * (float)(h + 1)), slope2 = slope * LOG2E, s64 = 64.f * slope2, s32 = 32.f * slope2;
    const unsigned lds0 = (unsigned)(uintptr_t)lds;
    LAS float* wsf = (LAS float*)(lds + SCR_OFF) + wave * 64;
    const bf16_t* ksrc = z + (rowb + lane) * NZ + C_ZK + h * 128 + wave * 8;
    const int pc0 = 2 * wave;
    const bf16_t* vsrc0 = z + (rowb + 16 * (pc0 & 3) + (lane >> 2)) * NZ + C_ZV + h * 128 + 32 * (pc0 >> 2) + (lane & 3) * 8;
    const unsigned kdst = lds0 + LDS_KR + wave * 1024, vdst = lds0 + LDS_VR + pc0 * 1024;
#define DMA_K(t, slot) do { const bf16_t* k_ = ksrc + (size_t)(t) * 64 * NZ; const unsigned d_ = (unsigned)__builtin_amdgcn_readfirstlane(kdst + (slot)); glds16(k_, d_); glds16_o128(k_, d_ + 8192 - 128); } while (0)
#define DMA_V(t, slot) do { const size_t o_ = (size_t)(t) * 64 * NZ; const unsigned d_ = (unsigned)__builtin_amdgcn_readfirstlane(vdst + (slot)); glds16(vsrc0 + o_, d_); glds16(vsrc0 + o_ + 16 * NZ, d_ + 1024); } while (0)
    const lcp vp0 = lds + LDS_VR + ((lane >> 4) & 1) * 32 + (lane & 3) * 8 + (4 * hi + ((lane & 15) >> 2)) * 64;
    const lcp kp0 = lds + LDS_KR + map * 8192 + hi * 1024 + r32 * 16;
    DMA_K(0, 0); DMA_V(0, 0); DMA_K(1, RSLOT);
    bf16x8 qr[4];
    {
        const bf16_t* qp = z + (rowb + q0 + r32) * NZ + C_Q + h * 128 + map * 64 + hi * 8;
#pragma unroll
        for (int d0 = 0; d0 < 4; ++d0) qr[d0] = *(const bf16x8*)(qp + d0 * 16);
    }
    f32x16 bias16;
#pragma unroll
    for (int r = 0; r < 16; ++r) bias16[r] = (8.f * slope) * (float)((r & 3) + 8 * (r >> 2));
    DA_PIN(bias16);
    float mhat = 0.f, l_reg = 0.f, offA = slope2 * (float)(4 * hi);
    f32x16 o[4];
#pragma unroll
    for (int d = 0; d < 4; ++d) o[d] = (f32x16){};
    bool resc = false;
    f32x16 c0, c1; bf16x8 kf[8]; s16x4 vlo[4], vhi[4]; v4u pw0, pw1, pw2, pw3;
#define SL(t) ((((t)) & 3) * RSLOT)
#define EX(v, nm) __builtin_amdgcn_exp2f(__builtin_fmaf((v), C2, (nm)))
#define RESC() do { if (resc) { _Pragma("unroll") for (int d_ = 0; d_ < 4; ++d_) _Pragma("unroll") for (int r = 0; r < 16; ++r) o[d_][r] *= wsf[crow(r, hi)]; } } while (0)
#define PKW(P, i) pg8::cvt_pk_bf16(P[i], P[(i) + 1])
    DMA_K(2, 2 * RSLOT); DMA_K(3, 3 * RSLOT); DMA_V(1, RSLOT);
    DA_WAIT_BAR(10);
#pragma unroll
    for (int d0 = 0; d0 < 4; ++d0) kload2(kf, kp0, d0);
    c0 = DA_MFMA(kf[0], qr[0], bias16); c1 = DA_MFMA(kf[1], qr[0], bias16); c0 = DA_MFMA(kf[2], qr[1], c0); c1 = DA_MFMA(kf[3], qr[1], c1);
    c0 = DA_MFMA(kf[4], qr[2], c0); c1 = DA_MFMA(kf[5], qr[2], c1); c0 = DA_MFMA(kf[6], qr[3], c0); c1 = DA_MFMA(kf[7], qr[3], c1);
    if (NT == 2) cmask(c0, c1, 0, qrel, hi);
    { mhat = rowmax(c0, c1, offA, offA + s32); const float nmh0 = offA - mhat, nmh1 = nmh0 + s32; float sacc = 0.f;
#pragma unroll
      for (int r = 0; r < 16; ++r) { c0[r] = EX(c0[r], nmh0); c1[r] = EX(c1[r], nmh1); sacc += c0[r] + c1[r]; }
      l_reg = sacc; }
    pw0 = (v4u){PKW(c0, 0), PKW(c0, 2), PKW(c0, 4), PKW(c0, 6)}; pw1 = (v4u){PKW(c0, 8), PKW(c0, 10), PKW(c0, 12), PKW(c0, 14)};
    pw2 = (v4u){PKW(c1, 0), PKW(c1, 2), PKW(c1, 4), PKW(c1, 6)}; pw3 = (v4u){PKW(c1, 8), PKW(c1, 10), PKW(c1, 12), PKW(c1, 14)};
    DA_WAIT_BAR(6);
    DMA_K(4, 0); DMA_V(2, 2 * RSLOT);
#pragma unroll
    for (int d0 = 0; d0 < 4; ++d0) kload2(kf, kp0 + RSLOT, d0);
    if (NT == 2) { DA_WAIT_BAR(0); } else { DA_WAIT_BAR(8); }
#define PAF(k) __builtin_bit_cast(bf16x8, pw##k)
#define VFR(i) (bf16x8){vlo[(i) & 3][0], vlo[(i) & 3][1], vlo[(i) & 3][2], vlo[(i) & 3][3], vhi[(i) & 3][0], vhi[(i) & 3][1], vhi[(i) & 3][2], vhi[(i) & 3][3]}
#define VOFF(i) ((((i) & 3) * 4 + ((i) >> 2)) * 1024)
#define VRD(i) do { vlo[(i) & 3] = vtr(vp_ + VOFF(i)); vhi[(i) & 3] = vtr(vp_ + VOFF(i) + 512); DA_SBAR(); } while (0)
#define KRD(G, d0) do { if (G) { kload2(kf, kp0 + sl_next_, d0); DA_SBAR(); } } while (0)
#define GAPA(MF) do { MF; DA_SBAR(); } while (0)
#define GAPB(MF, X, i, nm, A0, A1, EXTRA) do { MF; X[i] = EX(X[i], nm); X[(i) + 1] = EX(X[(i) + 1], nm); sacc += A0; sacc += A1; EXTRA; DA_PIN(X); DA_PIN(sacc); DA_SBAR(); } while (0)
#define STEP(t, MASK, GK, GV, GL) do { DA_SBAR(); \
    const lcp vp_ = vp0 + SL((t) - 1); const int sl_next_ = SL((t) + 1); \
            GAPA(c0 = DA_MFMA(kf[0], qr[0], bias16)); GAPA(c1 = DA_MFMA(kf[1], qr[0], bias16)); GAPA(c0 = DA_MFMA(kf[2], qr[1], c0)); GAPA(c1 = DA_MFMA(kf[3], qr[1], c1)); \
    VRD(0); GAPA(c0 = DA_MFMA(kf[4], qr[2], c0)); VRD(1); GAPA(c1 = DA_MFMA(kf[5], qr[2], c1)); VRD(2); GAPA(c0 = DA_MFMA(kf[6], qr[3], c0)); VRD(3); GAPA(c1 = DA_MFMA(kf[7], qr[3], c1)); \
    offA += s64; \
    if (GK) DMA_K((t) + 4, SL(t)); if (GV) DMA_V((t) + 2, SL((t) + 2)); \
    if (MASK) cmask(c0, c1, (t) - (NT - 2), qrel, hi); \
    { const float rm = rowmax(c0, c1, offA, offA + s32) - mhat; resc = false; \
      if (__builtin_expect(__any(rm > THR), 0)) { const float dl = __builtin_fmaxf(rm, 0.f); mhat += dl; \
          const float f = __builtin_amdgcn_exp2f(-dl); l_reg *= f; if (hi == 0) wsf[r32] = f; resc = true; } } \
    const float nmh0 = offA - mhat, nmh1 = nmh0 + s32; float sacc = 0.f; DA_SBAR(); \
    GAPB(o[0] = DA_MFMA(PAF(0), VFR(0), o[0]), c0, 0, nmh0, 0.f, 0.f, );             VRD(4); \
    GAPB(o[1] = DA_MFMA(PAF(0), VFR(1), o[1]), c0, 2, nmh0, c0[0], c0[1], );         VRD(5); \
    GAPB(o[2] = DA_MFMA(PAF(0), VFR(2), o[2]), c0, 4, nmh0, c0[2], c0[3], );         VRD(6); \
    GAPB(o[3] = DA_MFMA(PAF(0), VFR(3), o[3]), c0, 6, nmh0, c0[4], c0[5], );         VRD(7); \
    GAPB(o[0] = DA_MFMA(PAF(1), VFR(4), o[0]), c0, 8, nmh0, c0[6], c0[7], pw0[0] = PKW(c0, 0); pw0[1] = PKW(c0, 2); DA_PIN(pw0));    VRD(8); \
    GAPB(o[1] = DA_MFMA(PAF(1), VFR(5), o[1]), c0, 10, nmh0, c0[8], c0[9], pw0[2] = PKW(c0, 4); pw0[3] = PKW(c0, 6); DA_PIN(pw0));   VRD(9); \
    GAPB(o[2] = DA_MFMA(PAF(1), VFR(6), o[2]), c0, 12, nmh0, c0[10], c0[11], );      VRD(10); \
    GAPB(o[3] = DA_MFMA(PAF(1), VFR(7), o[3]), c0, 14, nmh0, c0[12], c0[13], );      VRD(11); \
    GAPB(o[0] = DA_MFMA(PAF(2), VFR(8), o[0]), c1, 0, nmh1, c0[14], c0[15], pw1[0] = PKW(c0, 8); pw1[1] = PKW(c0, 10); DA_PIN(pw1));  VRD(12); \
    GAPB(o[1] = DA_MFMA(PAF(2), VFR(9), o[1]), c1, 2, nmh1, c1[0], c1[1], pw1[2] = PKW(c0, 12); pw1[3] = PKW(c0, 14); DA_PIN(pw1));   VRD(13); \
    GAPB(o[2] = DA_MFMA(PAF(2), VFR(10), o[2]), c1, 4, nmh1, c1[2], c1[3], );        VRD(14); \
    GAPB(o[3] = DA_MFMA(PAF(2), VFR(11), o[3]), c1, 6, nmh1, c1[4], c1[5], );        VRD(15); \
    GAPB(o[0] = DA_MFMA(PAF(3), VFR(12), o[0]), c1, 8, nmh1, c1[6], c1[7], pw2[0] = PKW(c1, 0); pw2[1] = PKW(c1, 2); DA_PIN(pw2));   KRD(GL, 0); \
    GAPB(o[1] = DA_MFMA(PAF(3), VFR(13), o[1]), c1, 10, nmh1, c1[8], c1[9], pw2[2] = PKW(c1, 4); pw2[3] = PKW(c1, 6); DA_PIN(pw2));  KRD(GL, 1); \
    GAPB(o[2] = DA_MFMA(PAF(3), VFR(14), o[2]), c1, 12, nmh1, c1[10], c1[11], );     KRD(GL, 2); \
    GAPB(o[3] = DA_MFMA(PAF(3), VFR(15), o[3]), c1, 14, nmh1, c1[12], c1[13], );     KRD(GL, 3); \
    sacc += c1[14]; sacc += c1[15]; l_reg += sacc; \
    pw3[0] = PKW(c1, 8); pw3[1] = PKW(c1, 10); pw3[2] = PKW(c1, 12); pw3[3] = PKW(c1, 14); DA_PIN(pw3); \
    } while (0)
#define ENDW(tt) do { if ((tt) + 4 < NT) { DA_WAIT_BAR(8); } else if ((tt) + 3 < NT) { DA_WAIT_BAR(6); } else if ((tt) + 2 < NT) { DA_WAIT_BAR(4); } else { DA_WAIT_BAR(0); } } while (0)
    int t = 1;
    for (; t + 4 < NT; ++t) {
        STEP(t, false, true, true, true); DA_WAIT_BAR(8); RESC();
    }
    for (; t + 1 < NT; ++t) {
        STEP(t, true, (t + 4 < NT), (t + 2 < NT), (t + 1 < NT)); ENDW(t); RESC();
    }
    STEP(NT - 1, true, false, false, false); RESC();
    { const lcp vp_ = vp0 + SL(NT - 1);
#define DRN(k, i) do { const s16x4 lo_ = vtr(vp_ + VOFF(i)), hh_ = vtr(vp_ + VOFF(i) + 512); \
        o[(i) & 3] = DA_MFMA(PAF(k), ((bf16x8){lo_[0], lo_[1], lo_[2], lo_[3], hh_[0], hh_[1], hh_[2], hh_[3]}), o[(i) & 3]); } while (0)
      DRN(0, 0); DRN(0, 1); DRN(0, 2); DRN(0, 3); DRN(1, 4); DRN(1, 5); DRN(1, 6); DRN(1, 7); DRN(2, 8); DRN(2, 9); DRN(2, 10); DRN(2, 11); DRN(3, 12); DRN(3, 13); DRN(3, 14); DRN(3, 15);
#undef DRN
    }
#undef DMA_K
#undef DMA_V
#undef SL
#undef EX
#undef RESC
#undef PKW
#undef PAF
#undef VFR
#undef VOFF
#undef VRD
#undef KRD
#undef GAPA
#undef GAPB
#undef STEP
#undef ENDW
    { auto rr = __builtin_amdgcn_permlane32_swap(__float_as_uint(l_reg), __float_as_uint(l_reg), false, false); l_reg = __uint_as_float(rr[0]) + __uint_as_float(rr[1]); }
    attn_epilogue_body(lds, o, l_reg, yb, subln_w, lam, rowb, q0, h, wave, lane);
}
}

namespace rw {
typedef short bf16x8 __attribute__((ext_vector_type(8)));
typedef float f32x2 __attribute__((ext_vector_type(2)));
typedef short s16x4 __attribute__((ext_vector_type(4)));
constexpr int CH = 32, ACT_PITCH = 528;
constexpr int OFF_HAT = 41472, HAT_PITCH = 144, HAT_SZ = 32 * HAT_PITCH, OFF_TIL = OFF_HAT + 4 * HAT_SZ, TIL_PITCH = 40, TIL_SZ = 64 * TIL_PITCH, OFF_GR = OFF_TIL + 4 * TIL_SZ, OFF_WC = OFF_GR + 10 * 1024;
constexpr int OFF_ACT = 0, OFF_RKV = 16896, OFF_VEC = 41472, OFF_G = 82432, OFF_Y = 90624, OFF_NRM = 98816, OFF_SCL = 99328, OFF_CT = 99840, OFF_SCP = 102400;
template <int CTRL> __device__ __forceinline__ float dppf(float x) { return __builtin_bit_cast(float, __builtin_amdgcn_mov_dpp(__builtin_bit_cast(int, x), CTRL, 0xf, 0xf, true)); }
__device__ __forceinline__ float row_allsum(float v) { v += dppf<0x128>(v); v += dppf<0x124>(v); v += dppf<0x122>(v); v += dppf<0x121>(v); return v; }
__device__ __forceinline__ void row_allsum4(float& a, float& b, float& c, float& d) {
#define RW_DPP4(n) "v_add_f32_dpp %0, %0, %0 row_ror:" #n " row_mask:0xf bank_mask:0xf\n\tv_add_f32_dpp %1, %1, %1 row_ror:" #n " row_mask:0xf bank_mask:0xf\n\t" \
                   "v_add_f32_dpp %2, %2, %2 row_ror:" #n " row_mask:0xf bank_mask:0xf\n\tv_add_f32_dpp %3, %3, %3 row_ror:" #n " row_mask:0xf bank_mask:0xf\n\t"
    asm volatile("s_nop 1\n\t" RW_DPP4(8) RW_DPP4(4) RW_DPP4(2) RW_DPP4(1) "s_nop 1" : "+v"(a), "+v"(b), "+v"(c), "+v"(d));
#undef RW_DPP4
}
__device__ __forceinline__ f32x4 ld4bf(const bf16_t* p) { const v2u w = *(const v2u*)p; return (f32x4){pg8::bflo(w.x), pg8::bfhi(w.x), pg8::bflo(w.y), pg8::bfhi(w.y)}; }
__device__ __forceinline__ float fsig(float x) { return __builtin_amdgcn_rcpf(1.f + __expf(-x)); }
__device__ __forceinline__ float ftanh(float x) { return 1.f - 2.f * __builtin_amdgcn_rcpf(1.f + __expf(2.f * x)); }
struct ZRow { v2u r, k, v, w, a; v4u g; };
__device__ __forceinline__ ZRow ldrow(const bf16_t* zr, int c4, int cg) {
    ZRow o; o.r = *(const v2u*)(zr + C_R + c4); o.k = *(const v2u*)(zr + C_K + c4); o.v = *(const v2u*)(zr + C_V + c4); o.w = *(const v2u*)(zr + C_WL + 4 * cg); o.a = *(const v2u*)(zr + C_AL + 4 * cg);
    o.g = *(const v4u*)(zr + C_GL + 8 * cg); return o;
}
__device__ __forceinline__ f32x4 up4(v2u w) { return (f32x4){pg8::bflo(w.x), pg8::bfhi(w.x), pg8::bflo(w.y), pg8::bfhi(w.y)}; }

struct ScanP { const float *mu, *w0, *w2, *a0, *a2, *g2, *k_k, *k_a, *r_k, *lnx_w, *lnx_b; };
__device__ __forceinline__ void scan_unit(LAS unsigned char* lds, const bf16_t* __restrict__ z, bf16_t* __restrict__ ya, const ScanP P, int b, int h, int tid, int wave, int lane) {
    asm volatile("" : "+v"(tid)); lane = tid & 63;
    const float* mu = P.mu; const float* w0 = P.w0; const float* w2 = P.w2; const float* a0 = P.a0; const float* a2 = P.a2; const float* g2 = P.g2;
    const float* k_k = P.k_k; const float* k_a = P.k_a; const float* r_k = P.r_k; const float* lnx_w = P.lnx_w; const float* lnx_b = P.lnx_b;
    const size_t rowb = (size_t)b * SEQ;
    const int tl = tid >> 4, cg = tid & 15;
    const int nt = wave & 3, rl = lane & 15, rg = lane >> 4;
    LAS float* rkv = (LAS float*)(lds + OFF_RKV); LAS float* vec = (LAS float*)(lds + OFF_VEC); LAS float* gbuf = (LAS float*)(lds + OFF_G);
    LAS float* ybuf = (LAS float*)(lds + OFF_Y); LAS float* nrm = (LAS float*)(lds + OFF_NRM); LAS float* scl = (LAS float*)(lds + OFF_SCL); LAS float* scp = (LAS float*)(lds + OFF_SCP);
    bf16x8 bfr[8];
    {
        const int col = h * 64 + 16 * nt + rl;
#pragma unroll
        for (int f = 0; f < 8; ++f) {
            const float* src = (f < 2) ? w2 : (f < 4) ? a2 : g2;
            const int kb = ((f < 4) ? 32 * (f & 1) : 32 * (f - 4)) + 8 * rg;
            float e[8];
#pragma unroll
            for (int j = 0; j < 8; ++j) e[j] = src[(size_t)(kb + j) * 512 + col];
            v4u p; p.x = pg8::cvt_pk_bf16(e[0], e[1]); p.y = pg8::cvt_pk_bf16(e[2], e[3]); p.z = pg8::cvt_pk_bf16(e[4], e[5]); p.w = pg8::cvt_pk_bf16(e[6], e[7]);
            bfr[f] = __builtin_bit_cast(bf16x8, p);
            __builtin_amdgcn_sched_barrier(0);
        }
    }
    const int mt = wave >> 2;
    const int hc = h * 64 + 16 * nt + rl;
    const float w0c = w0[hc], a0c = a0[hc], kkc = k_k[hc], kac = k_a[hc], rkc = r_k[hc];
    const int c4 = h * 64 + 4 * cg;
    f32x4 ST[4];
#pragma unroll
    for (int i = 0; i < 4; ++i) ST[i] = (f32x4){0.f, 0.f, 0.f, 0.f};
    LAS float* ctab = (LAS float*)(lds + OFF_CT);
    if (tl == 0) {
        LAS float* ct = ctab + cg * 36;
        *(LAS f32x4*)(ct + 0) = *(const f32x4*)(mu + C_R + c4); *(LAS f32x4*)(ct + 4) = *(const f32x4*)(mu + C_K + c4); *(LAS f32x4*)(ct + 8) = *(const f32x4*)(mu + C_V + c4);
        *(LAS f32x4*)(ct + 12) = *(const f32x4*)(mu + C_WL + 4 * cg); *(LAS f32x4*)(ct + 16) = *(const f32x4*)(mu + C_AL + 4 * cg);
        *(LAS f32x4*)(ct + 20) = *(const f32x4*)(mu + C_GL + 8 * cg); *(LAS f32x4*)(ct + 24) = *(const f32x4*)(mu + C_GL + 8 * cg + 4);
        *(LAS f32x4*)(ct + 28) = *(const f32x4*)(lnx_w + c4); *(LAS f32x4*)(ct + 32) = *(const f32x4*)(lnx_b + c4);
    }
    __syncthreads();
    const LAS float* myct = ctab + cg * 36;
    ZRow zc = ldrow(z + (rowb + tl) * NZ, c4, cg), zp;
    if (tl > 0) zp = ldrow(z + (rowb + tl - 1) * NZ, c4, cg); else { zp.r = zp.k = zp.v = zp.w = zp.a = (v2u){0u, 0u}; zp.g = (v4u){0u, 0u, 0u, 0u}; }
    for (int t0 = 0; t0 < SEQ; t0 += CH) {
        {
            const f32x4 cr = up4(zc.r), ck = up4(zc.k), cv = up4(zc.v), cw = up4(zc.w), ca = up4(zc.a);
            const f32x4 cg0 = (f32x4){pg8::bflo(zc.g.x), pg8::bfhi(zc.g.x), pg8::bflo(zc.g.y), pg8::bfhi(zc.g.y)}, cg1 = (f32x4){pg8::bflo(zc.g.z), pg8::bfhi(zc.g.z), pg8::bflo(zc.g.w), pg8::bfhi(zc.g.w)};
            const f32x4 pr = up4(zp.r), pk = up4(zp.k), pv = up4(zp.v), pw = up4(zp.w), pa = up4(zp.a);
            const f32x4 pg0 = (f32x4){pg8::bflo(zp.g.x), pg8::bfhi(zp.g.x), pg8::bflo(zp.g.y), pg8::bfhi(zp.g.y)}, pg1 = (f32x4){pg8::bflo(zp.g.z), pg8::bfhi(zp.g.z), pg8::bflo(zp.g.w), pg8::bfhi(zp.g.w)};
            if (t0 + CH < SEQ) { zc = ldrow(z + (rowb + t0 + CH + tl) * NZ, c4, cg); zp = ldrow(z + (rowb + t0 + CH + tl - 1) * NZ, c4, cg); }
            const f32x4 rs_ = cr + (pr - cr) * *(const LAS f32x4*)(myct + 0), ks_ = ck + (pk - ck) * *(const LAS f32x4*)(myct + 4), vs_ = cv + (pv - cv) * *(const LAS f32x4*)(myct + 8);
            const f32x4 ws_ = cw + (pw - cw) * *(const LAS f32x4*)(myct + 12), as_ = ca + (pa - ca) * *(const LAS f32x4*)(myct + 16);
            const f32x4 g0_ = cg0 + (pg0 - cg0) * *(const LAS f32x4*)(myct + 20), g1_ = cg1 + (pg1 - cg1) * *(const LAS f32x4*)(myct + 24);
            *(LAS f32x4*)(rkv + 0 * 2048 + tl * 64 + 4 * cg) = rs_; *(LAS f32x4*)(rkv + 1 * 2048 + tl * 64 + 4 * cg) = ks_; *(LAS f32x4*)(rkv + 2 * 2048 + tl * 64 + 4 * cg) = vs_;
            LAS unsigned char* ar = lds + OFF_ACT + tl * ACT_PITCH;
            v2u tw; tw.x = pg8::cvt_pk_bf16(ftanh(ws_[0]), ftanh(ws_[1])); tw.y = pg8::cvt_pk_bf16(ftanh(ws_[2]), ftanh(ws_[3]));
            *(LAS v2u*)(ar + 8 * cg) = tw;
            v2u aw; aw.x = pg8::cvt_pk_bf16(as_[0], as_[1]); aw.y = pg8::cvt_pk_bf16(as_[2], as_[3]);
            *(LAS v2u*)(ar + 128 + 8 * cg) = aw;
            v4u gw; gw.x = pg8::cvt_pk_bf16(fsig(g0_[0]), fsig(g0_[1])); gw.y = pg8::cvt_pk_bf16(fsig(g0_[2]), fsig(g0_[3]));
            gw.z = pg8::cvt_pk_bf16(fsig(g1_[0]), fsig(g1_[1])); gw.w = pg8::cvt_pk_bf16(fsig(g1_[2]), fsig(g1_[3]));
            *(LAS v4u*)(ar + 256 + 16 * cg) = gw;
        }
        __syncthreads();
        f32x4 accw = (f32x4){0.f, 0.f, 0.f, 0.f}, acca = accw, accg = accw;
        {
            const LAS unsigned char* ap = lds + OFF_ACT + (16 * mt + rl) * ACT_PITCH + 8 * rg * 2;
#pragma unroll
            for (int f = 0; f < 8; ++f) {
                const bf16x8 a = *(const LAS bf16x8*)(ap + f * 64);
                if (f < 2) accw = __builtin_amdgcn_mfma_f32_16x16x32_bf16(a, bfr[f], accw, 0, 0, 0);
                else if (f < 4) acca = __builtin_amdgcn_mfma_f32_16x16x32_bf16(a, bfr[f], acca, 0, 0, 0);
                else accg = __builtin_amdgcn_mfma_f32_16x16x32_bf16(a, bfr[f], accg, 0, 0, 0);
            }
        }
        float lw[4], av[4], kk[4];
        {
            const int c = 16 * nt + rl;
            float n2[4];
#pragma unroll
            for (int r = 0; r < 4; ++r) {
                const int tok = 16 * mt + 4 * rg + r;
                gbuf[tok * 64 + c] = accg[r];
                const float nx = -(w0c + accw[r]);
                const float sp = nx > 20.f ? nx : __logf(1.f + __expf(nx));
                lw[r] = -__expf(-sp - 0.5f);
                av[r] = fsig(a0c + acca[r]);
                kk[r] = rkv[1 * 2048 + tok * 64 + c] * kkc;
                n2[r] = kk[r] * kk[r];
            }
            row_allsum4(n2[0], n2[1], n2[2], n2[3]);
            if (rl == 0) {
#pragma unroll
                for (int r = 0; r < 4; ++r) nrm[(16 * mt + 4 * rg + r) * 4 + nt] = n2[r];
            }
        }
        __syncthreads();
        {
            const int c = 16 * nt + rl;
            const float p0 = lw[0], p1 = p0 + lw[1], p2 = p1 + lw[2], p3 = p2 + lw[3];
            const float t1 = __shfl(p3, (lane - 16) & 63), t2 = __shfl(p3, (lane - 32) & 63), t3 = __shfl(p3, (lane - 48) & 63);
            const float E = (rg >= 1 ? t1 : 0.f) + (rg >= 2 ? t2 : 0.f) + (rg >= 3 ? t3 : 0.f);
            const float Ltot = __shfl(E + p3, rl + 48);
            const float pin[4] = {p0, p1, p2, p3};
            float bt[4], kt[4];
#pragma unroll
            for (int r = 0; r < 4; ++r) {
                const int tok = 16 * mt + 4 * rg + r;
                const f32x4 n4 = *(const LAS f32x4*)(nrm + tok * 4);
                const float ksv = rkv[1 * 2048 + tok * 64 + c], rsv = rkv[0 * 2048 + tok * 64 + c];
                const float inv = fminf(__builtin_amdgcn_rsqf((n4[0] + n4[1]) + (n4[2] + n4[3])), 1e12f);
                const float kkn = kk[r] * inv, beta = kkn * av[r], kmod = ksv * (1.f + (av[r] - 1.f) * kac);
                const float L = E + pin[r], eL = __expf(L), ieL = __expf(-L), eLm = __expf(L - lw[r]), eT = __expf(Ltot - L);
                LAS unsigned char* hp = lds + OFF_HAT + tok * HAT_PITCH + c * 2;
                *(LAS bf16_t*)(hp) = f2bf(-kkn * eLm); *(LAS bf16_t*)(hp + HAT_SZ) = f2bf(beta * ieL); *(LAS bf16_t*)(hp + 2 * HAT_SZ) = f2bf(kmod * ieL); *(LAS bf16_t*)(hp + 3 * HAT_SZ) = f2bf(rsv * eL);
                bt[r] = beta * eT; kt[r] = kmod * eT;
                float pbr = beta * rsv, pkr = kmod * rsv, pbo = rsv * kmod * rkc, dum = 0.f;
                row_allsum4(pbr, pkr, pbo, dum);
                if (rl == 0) *(LAS f32x4*)(scp + (tok * 4 + nt) * 4) = (f32x4){pbr, pkr, pbo, 0.f};
            }
            LAS unsigned char* tp = lds + OFF_TIL + (2 * mt) * TIL_SZ + c * TIL_PITCH + 8 * rg;
            v2u w; w.x = pg8::cvt_pk_bf16(bt[0], bt[1]); w.y = pg8::cvt_pk_bf16(bt[2], bt[3]); *(LAS v2u*)(tp) = w;
            w.x = pg8::cvt_pk_bf16(kt[0], kt[1]); w.y = pg8::cvt_pk_bf16(kt[2], kt[3]); *(LAS v2u*)(tp + TIL_SZ) = w;
            if (rg == 0) ((LAS float*)(lds + OFF_WC))[mt * 64 + c] = __expf(Ltot);
        }
        __syncthreads();
        if (tid < CH) {
            const f32x4 p0 = *(const LAS f32x4*)(scp + tid * 16), p1 = *(const LAS f32x4*)(scp + tid * 16 + 4), p2 = *(const LAS f32x4*)(scp + tid * 16 + 8), p3 = *(const LAS f32x4*)(scp + tid * 16 + 12);
            *(LAS f32x4*)(scl + 4 * tid) = (p0 + p1) + (p2 + p3);
        }
        int lane_ = lane; asm volatile("" : "+v"(lane_));
        const int rl_ = lane_ & 15, rg_ = lane_ >> 4;
        {
            const int c = wave >> 2, g = wave & 3;
            const LAS unsigned char* pa = lds + OFF_HAT + ((g & 1) ? 2 : 1) * HAT_SZ + (16 * c + rl_) * HAT_PITCH + 16 * rg_;
            const LAS unsigned char* pb = lds + OFF_HAT + ((g < 2) ? 0 : 3) * HAT_SZ + (16 * c + rl_) * HAT_PITCH + 16 * rg_;
            f32x4 acc = (f32x4){0.f, 0.f, 0.f, 0.f};
            acc = __builtin_amdgcn_mfma_f32_16x16x32_bf16(*(const LAS bf16x8*)(pa), *(const LAS bf16x8*)(pb), acc, 0, 0, 0);
            acc = __builtin_amdgcn_mfma_f32_16x16x32_bf16(*(const LAS bf16x8*)(pa + 64), *(const LAS bf16x8*)(pb + 64), acc, 0, 0, 0);
#pragma unroll
            for (int e = 0; e < 4; ++e) { const int row = 4 * rg_ + e; const bool keep = (g < 2) ? (row < rl_) : (row <= rl_); if (!keep) acc[e] = 0.f; }
            *(LAS f32x4*)(lds + OFF_GR + (c * 5 + g) * 1024 + lane_ * 16) = acc;
            if (g == 0) {
                asm volatile("s_waitcnt lgkmcnt(0)" ::: "memory");
                if (lane_ < 16) {
                    const int sc = lane_;
                    const LAS float* tb = (const LAS float*)(lds + OFF_GR + (c * 5) * 1024);
                    float m[16], ps[16];
#pragma unroll
                    for (int r = 0; r < 16; ++r) ps[r] = 0.f;
#pragma unroll
                    for (int u = 15; u >= 0; --u) {
                        m[u] = (u == sc) ? 1.f : ((u < sc) ? ps[u] : 0.f);
#pragma unroll
                        for (int r = 0; r < u; ++r) ps[r] = __builtin_fmaf(tb[(u + 16 * (r >> 2)) * 4 + (r & 3)], m[u], ps[r]);
                    }
                    LAS f32x4* mt_ = (LAS f32x4*)(lds + OFF_GR + (c * 5 + 4) * 1024);
#pragma unroll
                    for (int q = 0; q < 4; ++q) mt_[sc + 16 * q] = (f32x4){m[4 * q], m[4 * q + 1], m[4 * q + 2], m[4 * q + 3]};
                }
            }
        }
        __syncthreads();
        if (wave < 4) {
            const int ib = wave;
#pragma unroll
            for (int c = 0; c < 2; ++c) {
                bf16x8 sb[2];
#pragma unroll
                for (int ks = 0; ks < 2; ++ks) {
                    v4u p; p.x = pg8::cvt_pk_bf16(ST[2 * ks][0], ST[2 * ks][1]); p.y = pg8::cvt_pk_bf16(ST[2 * ks][2], ST[2 * ks][3]);
                    p.z = pg8::cvt_pk_bf16(ST[2 * ks + 1][0], ST[2 * ks + 1][1]); p.w = pg8::cvt_pk_bf16(ST[2 * ks + 1][2], ST[2 * ks + 1][3]);
                    sb[ks] = __builtin_bit_cast(bf16x8, p);
                }
                const LAS unsigned char* ha = lds + OFF_HAT + (16 * c + rl_) * HAT_PITCH + 8 * rg_;
                f32x4 xt = (f32x4){0.f, 0.f, 0.f, 0.f}, yt = xt;
#pragma unroll
                for (int ks = 0; ks < 2; ++ks) {
                    v4u fa, fr; const v2u a0_ = *(const LAS v2u*)(ha + 64 * ks), a1_ = *(const LAS v2u*)(ha + 64 * ks + 32);
                    const v2u r0_ = *(const LAS v2u*)(ha + 3 * HAT_SZ + 64 * ks), r1_ = *(const LAS v2u*)(ha + 3 * HAT_SZ + 64 * ks + 32);
                    fa.x = a0_.x; fa.y = a0_.y; fa.z = a1_.x; fa.w = a1_.y; fr.x = r0_.x; fr.y = r0_.y; fr.z = r1_.x; fr.w = r1_.y;
                    xt = __builtin_amdgcn_mfma_f32_16x16x32_bf16(__builtin_bit_cast(bf16x8, fa), sb[ks], xt, 0, 0, 0);
                    yt = __builtin_amdgcn_mfma_f32_16x16x32_bf16(__builtin_bit_cast(bf16x8, fr), sb[ks], yt, 0, 0, 0);
                }
                const LAS float* vsrc = rkv + 2 * 2048 + (16 * c + 4 * rg_) * 64 + 16 * ib + rl_;
                v2u vb_; vb_.x = pg8::cvt_pk_bf16(vsrc[0], vsrc[64]); vb_.y = pg8::cvt_pk_bf16(vsrc[128], vsrc[192]);
                const s16x4 vb = __builtin_bit_cast(s16x4, vb_);
                const LAS unsigned char* gr = lds + OFF_GR + (c * 5) * 1024 + lane_ * 16;
#define RW_AFR(g_) ({ const f32x4 t_ = *(const LAS f32x4*)(gr + (g_) * 1024); v2u w_; w_.x = pg8::cvt_pk_bf16(t_[0], t_[1]); w_.y = pg8::cvt_pk_bf16(t_[2], t_[3]); __builtin_bit_cast(s16x4, w_); })
#define RW_PK4(x_) ({ v2u w_; w_.x = pg8::cvt_pk_bf16((x_)[0], (x_)[1]); w_.y = pg8::cvt_pk_bf16((x_)[2], (x_)[3]); __builtin_bit_cast(s16x4, w_); })
                const f32x4 zt = __builtin_amdgcn_mfma_f32_16x16x16bf16_1k(RW_AFR(1), vb, xt, 0, 0, 0);
                const f32x4 ut = __builtin_amdgcn_mfma_f32_16x16x16bf16_1k(RW_AFR(4), RW_PK4(zt), (f32x4){0.f, 0.f, 0.f, 0.f}, 0, 0, 0);
                const s16x4 ub = RW_PK4(ut);
                yt = __builtin_amdgcn_mfma_f32_16x16x16bf16_1k(RW_AFR(2), ub, yt, 0, 0, 0);
                yt = __builtin_amdgcn_mfma_f32_16x16x16bf16_1k(RW_AFR(3), vb, yt, 0, 0, 0);
#pragma unroll
                for (int e = 0; e < 4; ++e) ybuf[(16 * c + 4 * rg_ + e) * 64 + 16 * ib + rl_] = yt[e];
                const LAS unsigned char* tl_ = lds + OFF_TIL + (2 * c) * TIL_SZ + rl_ * TIL_PITCH + 8 * rg_;
                const LAS float* wc = (const LAS float*)(lds + OFF_WC) + c * 64 + 4 * rg_;
#pragma unroll
                for (int jt = 0; jt < 4; ++jt) {
                    f32x4 acc = ST[jt] * *(const LAS f32x4*)(wc + 16 * jt);
                    acc = __builtin_amdgcn_mfma_f32_16x16x16bf16_1k(*(const LAS s16x4*)(tl_ + TIL_SZ + 16 * jt * TIL_PITCH), vb, acc, 0, 0, 0);
                    acc = __builtin_amdgcn_mfma_f32_16x16x16bf16_1k(*(const LAS s16x4*)(tl_ + 16 * jt * TIL_PITCH), ub, acc, 0, 0, 0);
                    ST[jt] = acc;
                }
#undef RW_AFR
#undef RW_PK4
            }
        }
        __syncthreads();
        {
            const f32x4 y4 = *(const LAS f32x4*)(ybuf + tl * 64 + 4 * cg);
            const float mean = row_allsum((y4[0] + y4[1]) + (y4[2] + y4[3])) * (1.f / 64.f);
            const f32x4 dv = y4 - mean;
            const float var = row_allsum((dv[0] * dv[0] + dv[1] * dv[1]) + (dv[2] * dv[2] + dv[3] * dv[3])) * (1.f / 64.f);
            const float rs_ = rsqrtf(var + GN_EPS);
            const f32x4 yn = dv * rs_ * *(const LAS f32x4*)(myct + 28) + *(const LAS f32x4*)(myct + 32);
            const float bonus = scl[tl * 4 + 2];
            const f32x4 vs_ = *(const LAS f32x4*)(rkv + 2 * 2048 + tl * 64 + 4 * cg), g4 = *(const LAS f32x4*)(gbuf + tl * 64 + 4 * cg);
            const f32x4 o = (yn + vs_ * bonus) * g4;
            v2u w; w.x = pg8::cvt_pk_bf16(o[0], o[1]); w.y = pg8::cvt_pk_bf16(o[2], o[3]);
            *(v2u*)(ya + (rowb + t0 + tl) * 512 + c4) = w;
        }
        __syncthreads();
    }
}
}

typedef __bf16 bf16x2_t __attribute__((ext_vector_type(2)));
__device__ __forceinline__ float dot2bf(unsigned a, unsigned b, float c) { return __builtin_amdgcn_fdot2_f32_bf16(__builtin_bit_cast(bf16x2_t, a), __builtin_bit_cast(bf16x2_t, b), c, false); }
__device__ __forceinline__ unsigned f2ord(float f) { const unsigned u = __float_as_uint(f); return (u & 0x80000000u) ? ~u : (u | 0x80000000u); }
__device__ __forceinline__ float ord2f(unsigned o) { return __uint_as_float((o & 0x80000000u) ? (o ^ 0x80000000u) : ~o); }
__device__ __forceinline__ unsigned row_allmax_u32(unsigned v) {
    v = max(v, (unsigned)__builtin_amdgcn_update_dpp(0, (int)v, 0x128, 0xf, 0xf, false));
    v = max(v, (unsigned)__builtin_amdgcn_update_dpp(0, (int)v, 0x124, 0xf, 0xf, false));
    v = max(v, (unsigned)__builtin_amdgcn_update_dpp(0, (int)v, 0x122, 0xf, 0xf, false));
    v = max(v, (unsigned)__builtin_amdgcn_update_dpp(0, (int)v, 0x121, 0xf, 0xf, false));
    return v;
}

constexpr int TK_PITCH = 272, TK_HALF = 128 * TK_PITCH;
typedef short tk_bf16x8 __attribute__((ext_vector_type(8)));
__device__ __forceinline__ void topk_loadq(tk_bf16x8 (&qa)[8], const bf16_t* __restrict__ qb, int t0, int h, int lane) {
    const bf16_t* qp = qb + (size_t)(t0 + (lane & 15)) * 2048 + h * 256 + 8 * (lane >> 4);
#pragma unroll
    for (int i = 0; i < 8; ++i) qa[i] = *(const tk_bf16x8*)(qp + i * 32);
}
__device__ __forceinline__ void topk_item(const tk_bf16x8 (&qa)[8], const LAS unsigned char* klds, int* __restrict__ ids, float* __restrict__ gates, int t0, int h, int lane) {
    const int rl = lane & 15, rg = lane >> 4;
    unsigned top[2][4];
#pragma unroll
    for (int c = 0; c < 2; ++c) {
        f32x4 acc[8];
#pragma unroll
        for (int nt = 0; nt < 8; ++nt) acc[nt] = (f32x4){64.f, 64.f, 64.f, 64.f};
        const LAS unsigned char* kp = klds + c * TK_HALF + rl * TK_PITCH + 16 * rg;
#pragma unroll
        for (int ks = 0; ks < 4; ++ks) {
#pragma unroll
            for (int nt = 0; nt < 8; ++nt) { const tk_bf16x8 b = *(const LAS tk_bf16x8*)(kp + nt * 16 * TK_PITCH + ks * 64); acc[nt] = __builtin_amdgcn_mfma_f32_16x16x32_bf16(qa[c * 4 + ks], b, acc[nt], 0, 0, 0); }
            __builtin_amdgcn_sched_barrier(0);
        }
        unsigned k[4][8];
#pragma unroll
        for (int r = 0; r < 4; ++r) {
#pragma unroll
            for (int nt = 0; nt < 8; ++nt) k[r][nt] = (__float_as_uint(fmaxf(acc[nt][r], 1.f)) & ~127u) | (unsigned)(127 - (nt * 16 + rl));
#define TK_CE(i, j) do { const unsigned a_ = max(k[r][i], k[r][j]), b_ = min(k[r][i], k[r][j]); k[r][i] = a_; k[r][j] = b_; } while (0)
            TK_CE(0, 1); TK_CE(2, 3); TK_CE(4, 5); TK_CE(6, 7); TK_CE(0, 2); TK_CE(1, 3); TK_CE(4, 6); TK_CE(5, 7); TK_CE(1, 2); TK_CE(5, 6);
            TK_CE(0, 4); TK_CE(1, 5); TK_CE(2, 6); TK_CE(3, 7); TK_CE(2, 4); TK_CE(3, 5); TK_CE(1, 2); TK_CE(3, 4); TK_CE(5, 6);
#undef TK_CE
        }
        unsigned tp[4] = {0u, 0u, 0u, 0u};
        for (int round = 0; round < 16; ++round) {
#pragma unroll
            for (int r = 0; r < 4; ++r) {
                const unsigned m = row_allmax_u32(k[r][0]);
                tp[r] = (rl == round) ? m : tp[r];
                const bool win = (k[r][0] == m);
                k[r][0] = win ? k[r][1] : k[r][0]; k[r][1] = win ? k[r][2] : k[r][1]; k[r][2] = win ? k[r][3] : k[r][2]; k[r][3] = win ? k[r][4] : k[r][3];
                k[r][4] = win ? k[r][5] : k[r][4]; k[r][5] = win ? k[r][6] : k[r][5]; k[r][6] = win ? k[r][7] : k[r][6]; k[r][7] = win ? 0u : k[r][7];
            }
        }
#pragma unroll
        for (int r = 0; r < 4; ++r) top[c][r] = tp[r];
    }
    const int rowbase = lane & 48;
    float v1[4]; int n1[4], ptr[4], myid[4]; unsigned k2[4], myv[4];
#pragma unroll
    for (int r = 0; r < 4; ++r) { v1[r] = __uint_as_float(top[0][r] & ~127u); n1[r] = 127 - (int)(top[0][r] & 127u); ptr[r] = 0; k2[r] = (unsigned)__builtin_amdgcn_ds_bpermute(rowbase * 4, (int)top[1][r]); myid[r] = 0; myv[r] = 0u; }
    for (int round = 0; round < 16; ++round) {
#pragma unroll
        for (int r = 0; r < 4; ++r) {
            const float head = v1[r] + __uint_as_float(k2[r] & ~127u);
            const unsigned key = (ptr[r] < 16) ? ((__float_as_uint(head) & ~15u) | (unsigned)(15 - rl)) : 0u;
            const unsigned m = row_allmax_u32(key);
            const bool win = (key == m);
            const unsigned wid = row_allmax_u32(win ? (unsigned)(n1[r] * 128 + (127 - (int)(k2[r] & 127u))) + 1u : 0u);
            myid[r] = (rl == round) ? (int)wid - 1 : myid[r];
            myv[r] = (rl == round) ? m : myv[r];
            ptr[r] += win ? 1 : 0;
            k2[r] = (unsigned)__builtin_amdgcn_ds_bpermute((rowbase + (ptr[r] & 15)) * 4, (int)top[1][r]);
        }
    }
#pragma unroll
    for (int r = 0; r < 4; ++r) {
        const float val = __uint_as_float(myv[r] & ~15u);
        const float vmax = __uint_as_float((unsigned)__builtin_amdgcn_ds_bpermute(rowbase * 4, (int)__float_as_uint(val)));
        const float e = __expf(val - vmax);
        const float sum = rw::row_allsum(e);
        gates[(size_t)(t0 + 4 * rg + r) * 128 + h * 16 + rl] = e / sum; ids[(size_t)(t0 + 4 * rg + r) * 128 + h * 16 + rl] = myid[r];
    }
}

typedef float f32x2 __attribute__((ext_vector_type(2)));
__device__ __forceinline__ void peer_token(const bf16_t* __restrict__ x2b, const float* __restrict__ ssq2, const int* __restrict__ ids, const float* __restrict__ gates,
                                           const unsigned char* __restrict__ U8, const unsigned char* __restrict__ V8, const float* __restrict__ usc, const float* __restrict__ vsc,
                                           const float* __restrict__ fw, float* __restrict__ out, int t, int lane) {
    const int l16 = lane * 16;
    f32x2 hx[8];
    {
        const v4u h0 = *(const v4u*)(x2b + (size_t)t * DM + l16), h1 = *(const v4u*)(x2b + (size_t)t * DM + l16 + 8);
        const unsigned hw[8] = {h0.x, h0.y, h0.z, h0.w, h1.x, h1.y, h1.z, h1.w};
#pragma unroll
        for (int i = 0; i < 8; ++i) hx[i] = (f32x2){pg8::bflo(hw[i]), pg8::bfhi(hw[i])};
    }
    const int idA = ids[(size_t)t * 128 + lane], idB = ids[(size_t)t * 128 + 64 + lane];
    const float rs = rsqrtf(pg8::ssq_sum16(ssq2 + (size_t)t * 16) * (1.f / DM) + NORM_EPS);
    const float suA = rs * usc[idA], suB = rs * usc[idB];
    const float svA = gates[(size_t)t * 128 + lane] * vsc[idA], svB = gates[(size_t)t * 128 + 64 + lane] * vsc[idB];
    f32x2 y[8];
#pragma unroll
    for (int i = 0; i < 8; ++i) y[i] = (f32x2){0.f, 0.f};
    const int bit0 = lane & 1, bit1 = (lane >> 1) & 1, bit5 = lane >> 5;
    v3u_t uw[8], vw[8];
    const unsigned vo12 = (unsigned)lane * 12u;
#define PEER_LDU(g_) do { const int is_ = ((g_) < 8) ? idA : idB; const int lb_ = ((g_) * 8) & 63; _Pragma("unroll") for (int k = 0; k < 8; ++k) { const unsigned eo = (unsigned)__builtin_amdgcn_readlane(is_, lb_ + k) * 768u; \
        const unsigned char* rp_ = U8 + eo; uw[k] = *(const v3u_t*)(rp_ + vo12); } } while (0)
#define PEER_LDV(g_) do { const int is_ = ((g_) < 8) ? idA : idB; const int lb_ = ((g_) * 8) & 63; _Pragma("unroll") for (int k = 0; k < 8; ++k) { const unsigned eo = (unsigned)__builtin_amdgcn_readlane(is_, lb_ + k) * 768u; \
        const unsigned char* rp_ = V8 + eo; vw[k] = *(const v3u_t*)(rp_ + vo12); } } while (0)
    PEER_LDU(0); PEER_LDV(0);
    for (int g = 0; g < 16; ++g) {
        const float susel = (g < 8) ? suA : suB, svsel = (g < 8) ? svA : svB; const int lb = (g * 8) & 63;
        float d[8];
#pragma unroll
        for (int k = 0; k < 8; k += 2) {
            const v32f_t f = __builtin_amdgcn_cvt_scalef32_pk32_f32_fp6((v6u_t){uw[k][0], uw[k][1], uw[k][2], uw[k + 1][0], uw[k + 1][1], uw[k + 1][2]}, 1.0f);
            f32x2 a = (f32x2){0.f, 0.f}, b = a;
#pragma unroll
            for (int i = 0; i < 8; ++i) { a += (f32x2){f[2 * i], f[2 * i + 1]} * hx[i]; b += (f32x2){f[16 + 2 * i], f[17 + 2 * i]} * hx[i]; }
            d[k] = a[0] + a[1]; d[k + 1] = b[0] + b[1];
            __builtin_amdgcn_sched_barrier(0);
        }
        if (g + 1 < 16) PEER_LDU(g + 1);
        __builtin_amdgcn_sched_barrier(0);
#pragma unroll
        for (int k = 0; k < 8; ++k) d[k] *= __uint_as_float((unsigned)__builtin_amdgcn_readlane((int)__float_as_uint(susel), lb + k));
        float r4[4];
#pragma unroll
        for (int k = 0; k < 4; ++k) { const float send = bit0 ? d[k] : d[k + 4], keep = bit0 ? d[k + 4] : d[k]; r4[k] = keep + rw::dppf<0xB1>(send); }
        float r2[2];
#pragma unroll
        for (int k = 0; k < 2; ++k) { const float send = bit1 ? r4[k] : r4[k + 2], keep = bit1 ? r4[k + 2] : r4[k]; r2[k] = keep + rw::dppf<0x4E>(send); }
        float r1;
        { const float send = bit5 ? r2[0] : r2[1], keep = bit5 ? r2[1] : r2[0];
          auto rr = __builtin_amdgcn_permlane32_swap(__float_as_uint(send), __float_as_uint(send), false, false);
          r1 = keep + __uint_as_float(bit5 ? rr[0] : rr[1]); }
        r1 += rw::dppf<0x128>(r1); r1 += rw::dppf<0x124>(r1);
        r1 += __uint_as_float((unsigned)__builtin_amdgcn_ds_swizzle((int)__float_as_uint(r1), 0x401F));
        const float dd = r1;
        const float act = 0.5f * dd * (1.f + erff(dd * 0.70710678118654752f));
#pragma unroll
        for (int k = 0; k < 8; k += 2) {
#define PEER_LANE_OF(k_) ((((k_) >> 2) & 1) | ((((k_) >> 1) & 1) << 1) | (((k_) & 1) << 5))
            const float a = __uint_as_float((unsigned)__builtin_amdgcn_readlane((int)__float_as_uint(act), PEER_LANE_OF(k))) * __uint_as_float((unsigned)__builtin_amdgcn_readlane((int)__float_as_uint(svsel), lb + k));
            const float b = __uint_as_float((unsigned)__builtin_amdgcn_readlane((int)__float_as_uint(act), PEER_LANE_OF(k + 1))) * __uint_as_float((unsigned)__builtin_amdgcn_readlane((int)__float_as_uint(svsel), lb + k + 1));
#undef PEER_LANE_OF
            const f32x2 a2 = (f32x2){a, a}, b2 = (f32x2){b, b};
            const v32f_t f = __builtin_amdgcn_cvt_scalef32_pk32_f32_fp6((v6u_t){vw[k][0], vw[k][1], vw[k][2], vw[k + 1][0], vw[k + 1][1], vw[k + 1][2]}, 1.0f);
#pragma unroll
            for (int i = 0; i < 8; ++i) { y[i] += (f32x2){f[2 * i], f[2 * i + 1]} * a2; y[i] += (f32x2){f[16 + 2 * i], f[17 + 2 * i]} * b2; }
            __builtin_amdgcn_sched_barrier(0);
        }
        if (g + 1 < 16) PEER_LDV(g + 1);
        __builtin_amdgcn_sched_barrier(0);
    }
#undef PEER_LDU
#undef PEER_LDV
    float* orow = out + (size_t)t * DM + l16;
    float ss = 0.f;
    f32x4 o4[4];
#pragma unroll
    for (int i = 0; i < 4; ++i) { o4[i] = (f32x4){hx[2 * i][0] + y[2 * i][0], hx[2 * i][1] + y[2 * i][1], hx[2 * i + 1][0] + y[2 * i + 1][0], hx[2 * i + 1][1] + y[2 * i + 1][1]};
        ss += (o4[i][0] * o4[i][0] + o4[i][1] * o4[i][1]) + (o4[i][2] * o4[i][2] + o4[i][3] * o4[i][3]); }
    ss = wave_sum(ss);
    const float r = rsqrtf(ss * (1.f / DM) + NORM_EPS);
#pragma unroll
    for (int i = 0; i < 4; ++i) *(f32x4*)(orow + 4 * i) = o4[i] * r * *(const f32x4*)(fw + l16 + 4 * i);
}

__global__ void __launch_bounds__(NWAVES * 64, 2) mk_fwd(Args args) {
    extern __shared__ __attribute__((aligned(16))) unsigned char lds_raw[];
    LAS unsigned char* lds = (LAS unsigned char*)lds_raw;
    volatile LAS unsigned* MISC = (volatile LAS unsigned*)(lds + MISC_OFF);
    const int tid = threadIdx.x, lane = tid & 63, wave = __builtin_amdgcn_readfirstlane(tid >> 6);
    const int G = gridDim.x; const int bx = blockIdx.x; const int vcu = (G % 8 == 0) ? (bx % 8) * (G / 8) + bx / 8 : bx;
    unsigned char* ws = args.ws;
    unsigned* ctl = (unsigned*)(ws + WS_CTL);
    for (int u = tid; u < (LDS_BYTES - LDSCTL_OFF) / 4; u += NWAVES * 64) ((LAS unsigned*)(lds + LDSCTL_OFF))[u] = 0u;
    __syncthreads();
    XcdBarrier bar = xcd_barrier_post(ctl + CW_BAR + args.li * XCD_BAR_WORDS, MISC + 8);
    const int lo = args.ph_lo, hi = args.ph_hi;
#define IN(k) (lo <= (k) && (k) < hi)
#define BOTH(k) (IN(k) && IN((k) + 1))
    bf16_t* WinT = (bf16_t*)(ws + WS_WIN); bf16_t* PaT = (bf16_t*)(ws + WS_PA); bf16_t* PbT = (bf16_t*)(ws + WS_PB); bf16_t* WoT = (bf16_t*)(ws + WS_WO);
    bf16_t* WqT = (bf16_t*)(ws + WS_WQ); bf16_t* KeysB = (bf16_t*)(ws + WS_KEYS);
    float* rstd1 = (float*)(ws + WS_RSTD1); float* ssq2 = (float*)(ws + WS_RSTD2); float* scal = (float*)(ws + WS_SCAL);
    unsigned char* U8 = ws + WS_U; unsigned char* V8 = ws + WS_V; float* usc = (float*)(ws + WS_USC); float* vsc = (float*)(ws + WS_VSC);
    bf16_t* xb = (bf16_t*)(ws + WS_XB); bf16_t* ya = (bf16_t*)(ws + WS_YA); bf16_t* yb = (bf16_t*)(ws + WS_YB); bf16_t* x2b = (bf16_t*)(ws + WS_X2B);
    bf16_t* z = (bf16_t*)(ws + WS_Z); bf16_t* qb = (bf16_t*)(ws + WS_Q);
    bf16_t* merged = (bf16_t*)(ws + WS_MERGED);
    const int gw = vcu * NWAVES + wave, NGW = G * NWAVES;

    if (IN(0)) {
        LAS float* scr = (LAS float*)(lds + wave * 16384);
        constexpr int I_IN = (DM / 64) * (NZ / 32), I_PA = (512 / 64) * (DM / 32), I_WO = (DM / 64) * (DM / 32), I_WQ = (DM / 64) * (2048 / 32);
        constexpr int NITEMS = I_IN + 2 * I_PA + I_WO + I_WQ;
        for (int it = gw; it < NITEMS; it += NGW) {
            int r = it;
            if (r < I_IN) { p0_transpose_item(args.in[2], args.in[1], DM, NZ, WinT, scr, r, lane); continue; } r -= I_IN;
            if (r < I_PA) { p0_transpose_item(args.in[19], nullptr, 512, DM, PaT, scr, r, lane); continue; } r -= I_PA;
            if (r < I_PA) { p0_transpose_item(args.in[20], nullptr, 512, DM, PbT, scr, r, lane); continue; } r -= I_PA;
            if (r < I_WO) { p0_transpose_item(args.in[21], nullptr, DM, DM, WoT, scr, r, lane); continue; } r -= I_WO;
            p0_transpose_item(args.in[23], args.in[22], DM, 2048, WqT, scr, r, lane);
        }
        p0_convert(args.in[24], nullptr, KeysB, (size_t)16 * 128 * 128, gw, NGW, lane);
        for (int e = gw; e < 2 * NEXP; e += NGW) {
            const bool isu = e < NEXP; const int row = isu ? e : e - NEXP;
            p0_row_fp6((isu ? args.in[25] : args.in[26]) + (size_t)row * DM, isu ? args.in[22] : nullptr, (isu ? U8 : V8) + (size_t)row * 768, (isu ? usc : vsc) + row, lane);
        }
        for (int m = gw; m < T_TOK; m += NGW) {
            const f32x4* xr = (const f32x4*)(args.in[0] + (size_t)m * DM) + lane;
            f32x4 v[4]; float s = 0.f;
#pragma unroll
            for (int j = 0; j < 4; ++j) { v[j] = xr[64 * j]; s += (v[j][0] * v[j][0] + v[j][1] * v[j][1]) + (v[j][2] * v[j][2] + v[j][3] * v[j][3]); }
            s = wave_sum(s);
            v2u* o8 = (v2u*)(xb + (size_t)m * DM) + lane;
#pragma unroll
            for (int j = 0; j < 4; ++j) { v2u w; w.x = pg8::cvt_pk_bf16(v[j][0], v[j][1]); w.y = pg8::cvt_pk_bf16(v[j][2], v[j][3]); o8[64 * j] = w; }
            if (lane == 0) rstd1[m] = rsqrtf(s * (1.f / DM) + NORM_EPS);
        }
        if (gw == 0) {
            const float a = wave_sum(args.in[14][lane] * args.in[15][lane]), b = wave_sum(args.in[16][lane] * args.in[17][lane]);
            if (lane == 0) scal[0] = __expf(a) - __expf(b) + LAM_INIT;
        }
        if (BOTH(0)) xcd_barrier(bar);
    }
    if (IN(1)) {
        pg8::Gemm g{xb, WinT, DM, DM, DM}; pg8::StaticOrder S; S.init(T_TOK, NZ, G, bx);
        pg8::EpiRowScale<false> E{z, NZ, rstd1};
        for (int rep = 0; rep < REPS(1); ++rep) pg8::gemm_phase(lds, g, S, E);
        if (BOTH(1)) xcd_barrier(bar);
    }
    if (IN(2)) {
        {
            const rw::ScanP P{args.in[3], args.in[4], args.in[5], args.in[6], args.in[7], args.in[8], args.in[9], args.in[10], args.in[11], args.in[12], args.in[13]};
            for (int rep = 0; rep < REPS(2); ++rep) for (int u = vcu; u < NB * 8; u += G) rw::scan_unit(lds, z, ya, P, u >> 3, u & 7, tid, wave, lane);
        }
        const float lam = scal[0];
        __syncthreads();
        for (int i = 0;; ++i) {
            int idx = vcu + i * G; if (idx >= 2048 * REPS(10)) break;
            idx &= 2047;
            const int slot = idx >> 8, v = idx & 255, bh = v >> 1, a = (v & 1) * 4 + (slot >> 1), qblk = (slot & 1) ? 15 - a : a;
            da::attn_unit(lds, z, yb, args.in[18], lam, bh >> 2, bh & 3, qblk, wave, lane);
        }
        if (BOTH(2)) xcd_barrier(bar);
    }
    if (IN(3)) {
        pg8::Gemm g{ya, PaT, 512, 512, 512}; pg8::StaticOrder S; S.init(T_TOK, DM, G, bx);
        pg8::EpiGate<false> E{merged, z, C_GA};
        pg8::gemm_phase(lds, g, S, E);
        if (BOTH(3)) xcd_barrier(bar);
    }
    if (IN(4)) {
        pg8::Gemm g{yb, PbT, 512, 512, 512}; pg8::StaticOrder S; S.init(T_TOK, DM, G, bx);
        pg8::EpiGate<true> E{merged, z, C_GB};
        pg8::gemm_phase(lds, g, S, E);
        if (BOTH(4)) xcd_barrier(bar);
    }
    if (IN(5)) {
        pg8::Gemm g{merged, WoT, DM, DM, DM}; pg8::StaticOrder S; S.init(T_TOK, DM, G, bx);
        pg8::EpiX2 E{args.in[0], args.out, x2b, ssq2};
        pg8::gemm_phase(lds, g, S, E);
        if (BOTH(5)) xcd_barrier(bar);
    }
    if (IN(6)) {
        pg8::Gemm g{x2b, WqT, DM, DM, DM}; pg8::StaticOrder S; S.init(T_TOK, 2048, G, bx);
        pg8::EpiRowScale<true> E{qb, 2048, ssq2};
        for (int rep = 0; rep < REPS(6); ++rep) pg8::gemm_phase(lds, g, S, E);
        if (BOTH(6)) xcd_barrier(bar);
    }
    if (IN(7)) {
        int* ids = (int*)(ws + WS_IDS); float* gates = (float*)(ws + WS_GATES);
        for (int rep = 0; rep < REPS(7); ++rep)
        for (int h = 0; h < 8; ++h) {
            __syncthreads();
            {
                const bf16_t* ksrc = KeysB + (size_t)h * 2 * 128 * 128;
#pragma unroll
                for (int i = 0; i < 8; ++i) { const int chunk = tid + i * 512, row = chunk >> 4, cc = chunk & 15;
                    *(LAS v4u*)(lds + (row >> 7) * TK_HALF + (row & 127) * TK_PITCH + cc * 16) = *(const v4u*)(ksrc + (size_t)row * 128 + cc * 8); }
            }
            __syncthreads();
            for (int tile = gw; tile < 4096; tile += NGW) {
                tk_bf16x8 qa[8];
                topk_loadq(qa, qb, tile * 16, h, lane);
                topk_item(qa, lds, ids, gates, tile * 16, h, lane);
            }
        }
        if (BOTH(7)) xcd_barrier(bar);
    }
    if (IN(8)) {
        const int* ids = (const int*)(ws + WS_IDS); const float* gates = (const float*)(ws + WS_GATES);
        for (int t = gw; t < T_TOK; t += NGW) peer_token(x2b, ssq2, ids, gates, U8, V8, usc, vsc, args.in[27], args.out, t, lane);
    }
#undef IN
#undef BOTH
}

extern "C" void kernel_launch(void* const* d_in, const int* in_sizes, int n_in, void* d_out, int out_size, void* d_ws, size_t ws_size, hipStream_t stream) {
    static int grid = 0;
    if (grid == 0) {
        if (n_in != 28 || in_sizes[0] != T_TOK * DM || out_size != T_TOK * DM || ws_size < WS_END) {
            fprintf(stderr, "kernel_launch: unexpected shapes / workspace (n_in %d, ws %zu < %zu)\n", n_in, ws_size, (size_t)WS_END); grid = -1; return; }
        int dev = 0, cus = 0;
        if (hipGetDevice(&dev) != hipSuccess || hipDeviceGetAttribute(&cus, hipDeviceAttributeMultiprocessorCount, dev) != hipSuccess) { grid = -1; return; }
        if (hipFuncSetAttribute((const void*)mk_fwd, hipFuncAttributeMaxDynamicSharedMemorySize, LDS_BYTES) != hipSuccess) { fprintf(stderr, "kernel_launch: hipFuncSetAttribute failed\n"); grid = -1; return; }
        grid = cus;
    }
    if (grid < 0) return;
    unsigned char* ws = (unsigned char*)d_ws;
    float* out = (float*)d_out;
    (void)hipMemsetAsync(ws + WS_CTL, 0, 1 * MiB, stream);
    Args a{};
    for (int i = 0; i < 28; ++i) a.in[i] = (const float*)d_in[i];
    a.out = out; a.ws = ws;
    a.ph_lo = 0; a.ph_hi = 9; a.li = 0;
    hipLaunchKernelGGL(mk_fwd, dim3(grid), dim3(NWAVES * 64), LDS_BYTES, stream, a);
}
```

```cpp
#include <hip/hip_runtime.h>
#include <stdint.h>
#include <cstdio>

typedef unsigned short bf16_t;
typedef unsigned int u32;

#ifndef PROBE_REP
#define PROBE_REP 0
#endif
#define REPS(k) (((PROBE_REP >> (k)) & 1) ? 2 : 1)
constexpr int T_TOK = 65536, DM = 1024, SEQ = 2048, NB = 32;
constexpr int NZ = 5376;
constexpr int C_R = 0, C_K = 512, C_V = 1024, C_WL = 1536, C_AL = 1600, C_GL = 1664, C_Q = 1792, C_ZK = 2304, C_ZV = 2816, C_GA = 3328, C_GB = 4352;
constexpr int NEXP = 16384;
constexpr float NORM_EPS = 1e-6f, GN_EPS = 64e-5f, SUBLN_EPS = 1e-5f;
constexpr float LAM_INIT = 0.2f;

constexpr size_t MiB = 1u << 20;
constexpr size_t WS_CTL = 0;
constexpr size_t WS_WIN = 1 * MiB;
constexpr size_t WS_PA = 12 * MiB;
constexpr size_t WS_PB = 13 * MiB;
constexpr size_t WS_WO = 14 * MiB;
constexpr size_t WS_WQ = 16 * MiB;
constexpr size_t WS_KEYS = 20 * MiB;
constexpr size_t WS_RSTD1 = 21 * MiB;
constexpr size_t WS_RSTD2 = 58 * MiB;
constexpr size_t WS_SCAL = 23 * MiB;
constexpr size_t WS_U = 24 * MiB;
constexpr size_t WS_V = 40 * MiB;
constexpr size_t WS_USC = 56 * MiB;
constexpr size_t WS_VSC = 57 * MiB;
constexpr size_t WS_XB = 88 * MiB;
constexpr size_t WS_YA = WS_XB;
constexpr size_t WS_YB = WS_XB + 64 * MiB;
constexpr size_t WS_X2B = WS_XB;
constexpr size_t WS_Z = 216 * MiB;
constexpr size_t WS_Q = WS_Z;
constexpr size_t WS_IDS = WS_Z + 256 * MiB;
constexpr size_t WS_GATES = WS_Z + 288 * MiB;
constexpr size_t WS_MERGED = 888 * MiB;
constexpr size_t WS_END = 1016 * MiB;

__device__ __forceinline__ float bf2f(bf16_t h) { return __uint_as_float(((u32)h) << 16); }
__device__ __forceinline__ bf16_t f2bf(float f) { u32 u = __float_as_uint(f); u += 0x7fffu + ((u >> 16) & 1u); return (bf16_t)(u >> 16); }
__device__ __forceinline__ float wave_sum(float v) {
#pragma unroll
    for (int o = 1; o < 64; o <<= 1) v += __shfl_xor(v, o);
    return v;
}
__device__ __forceinline__ float sigmoidf_(float x) { return __builtin_amdgcn_rcpf(1.f + __expf(-x)); }

namespace pg8 {
#define PG8_LAS __attribute__((address_space(3)))
typedef short bf16x8 __attribute__((ext_vector_type(8)));
typedef float f32x4 __attribute__((ext_vector_type(4)));
typedef unsigned u32x4 __attribute__((ext_vector_type(4)));
constexpr int BM = 256, BK = 64, HALF = 128, HTB = HALF * BK * 2  , STAGE_BYTES = 8 * HTB, NXCD = 8, WGM = 8;

__host__ __device__ __forceinline__ int lds_byte(int r, int c) { const int st = (r >> 4) * 2 + (c >> 5), rr = r & 15, cc = c & 31, ob = rr * 64 + cc * 2; return st * 1024 + (ob ^ (((ob >> 9) & 1) << 5)); }
__host__ __device__ __forceinline__ void stage_rc(int b, int& R, int& C) { const int st = b / 1024, sb = b % 1024, swz = sb ^ (((sb >> 9) & 1) << 5); R = (st >> 1) * 16 + swz / 64; C = (st & 1) * 32 + (swz % 64) / 2; }
__host__ __device__ __forceinline__ int perm32(int rho) { const int n = rho >> 4, i = rho & 15; return 8 * (i >> 2) + 4 * n + (i & 3); }

struct Unit { int pm, pn; };
struct Gemm { const bf16_t* A; const bf16_t* Bt; int lda, ldb, K; };

struct StaticOrder {
    int nM, nN, nwg, G, c;
    __host__ __device__ void init(int M, int N, int G_, int c_) { nM = M / BM; nN = N / BM; nwg = nM * nN; G = G_; c = c_; }
    __host__ __device__ bool next(int i, Unit& u) const {
        const long L = (long)i * G + c; if (L >= nwg) return false;
        int wgid = (int)L; { const int q = nwg / NXCD, r = nwg % NXCD, xcd = wgid % NXCD, off = wgid / NXCD; wgid = (xcd < r ? xcd * (q + 1) : r * (q + 1) + (xcd - r) * q) + off; }
        const int nig = WGM * nN, gid = wgid / nig, fm = gid * WGM, gsz = (nM - fm) < WGM ? (nM - fm) : WGM;
        u.pm = fm + ((wgid % nig) % gsz); u.pn = (wgid % nig) / gsz; return true;
    }
};
typedef float f32x2_c __attribute__((ext_vector_type(2))); typedef __bf16 bf16x2_c __attribute__((ext_vector_type(2)));
__device__ __forceinline__ unsigned cvt_pk_bf16(float lo, float hi) { const f32x2_c v = {lo, hi}; const bf16x2_c b = __builtin_convertvector(v, bf16x2_c); return __builtin_bit_cast(unsigned, b); }
__device__ __forceinline__ float bflo(unsigned w) { return __uint_as_float(w << 16); }
__device__ __forceinline__ float bfhi(unsigned w) { return __uint_as_float(w & 0xffff0000u); }

__device__ __forceinline__ float ssq_sum16(const float* p) {
    const f32x4 a = *(const f32x4*)p, b = *(const f32x4*)(p + 4), c = *(const f32x4*)(p + 8), d = *(const f32x4*)(p + 12);
    return (((a[0] + a[1]) + (a[2] + a[3])) + ((b[0] + b[1]) + (b[2] + b[3]))) + (((c[0] + c[1]) + (c[2] + c[3])) + ((d[0] + d[1]) + (d[2] + d[3])));
}
template <bool SSQ> struct EpiRowScale {
    static constexpr bool PERM = true;
    bf16_t* O; int ldc; const float* rs;
    __device__ __forceinline__ void operator()(const f32x4 (&acc)[2][2][4][2], const Unit& u, int wr, int wc, int fr, int fq) const {
        const int row0 = u.pm * BM + wr * 64 + fr, col0 = u.pn * BM + wc * 32 + 8 * fq;
#pragma unroll
        for (int ai = 0; ai < 2; ++ai)
#pragma unroll
            for (int m = 0; m < 4; ++m) {
                const int row = row0 + ai * HALF + m * 16;
                float s; if (SSQ) s = rsqrtf(ssq_sum16(rs + (size_t)row * 16) * (1.f / 1024.f) + NORM_EPS); else s = rs[row];
                bf16_t* rowp = O + (size_t)row * ldc + col0;
#pragma unroll
                for (int bj = 0; bj < 2; ++bj) {
                    const f32x4 v0 = acc[ai][bj][m][0] * s, v1 = acc[ai][bj][m][1] * s;
                    u32x4 w; w.x = cvt_pk_bf16(v0[0], v0[1]); w.y = cvt_pk_bf16(v0[2], v0[3]); w.z = cvt_pk_bf16(v1[0], v1[1]); w.w = cvt_pk_bf16(v1[2], v1[3]);
                    *(u32x4*)(rowp + bj * HALF) = w;
                }
            }
    }
};
template <bool ACCUM> struct EpiGate {
    static constexpr bool PERM = true;
    bf16_t* mg; const bf16_t* z; int gcol;
    __device__ __forceinline__ void operator()(const f32x4 (&acc)[2][2][4][2], const Unit& u, int wr, int wc, int fr, int fq) const {
        const int row0 = u.pm * BM + wr * 64 + fr, col0 = u.pn * BM + wc * 32 + 8 * fq;
#pragma unroll
        for (int ai = 0; ai < 2; ++ai)
#pragma unroll
            for (int m = 0; m < 4; ++m) {
                const int row = row0 + ai * HALF + m * 16;
                const bf16_t* gp = z + (size_t)row * NZ + gcol + col0;
                bf16_t* rowp = mg + (size_t)row * DM + col0;
#pragma unroll
                for (int bj = 0; bj < 2; ++bj) {
                    const u32x4 g = *(const u32x4*)(gp + bj * HALF);
                    const f32x4 a0 = acc[ai][bj][m][0], a1 = acc[ai][bj][m][1];
                    float r[8];
                    r[0] = sigmoidf_(bflo(g.x)) * a0[0]; r[1] = sigmoidf_(bfhi(g.x)) * a0[1]; r[2] = sigmoidf_(bflo(g.y)) * a0[2]; r[3] = sigmoidf_(bfhi(g.y)) * a0[3];
                    r[4] = sigmoidf_(bflo(g.z)) * a1[0]; r[5] = sigmoidf_(bfhi(g.z)) * a1[1]; r[6] = sigmoidf_(bflo(g.w)) * a1[2]; r[7] = sigmoidf_(bfhi(g.w)) * a1[3];
                    if (ACCUM) { const u32x4 o = *(const u32x4*)(rowp + bj * HALF);
                        r[0] += bflo(o.x); r[1] += bfhi(o.x); r[2] += bflo(o.y); r[3] += bfhi(o.y); r[4] += bflo(o.z); r[5] += bfhi(o.z); r[6] += bflo(o.w); r[7] += bfhi(o.w); }
                    u32x4 w; w.x = cvt_pk_bf16(r[0], r[1]); w.y = cvt_pk_bf16(r[2], r[3]); w.z = cvt_pk_bf16(r[4], r[5]); w.w = cvt_pk_bf16(r[6], r[7]);
                    *(u32x4*)(rowp + bj * HALF) = w;
                }
            }
    }
};
struct EpiX2 {
    static constexpr bool PERM = true;
    const float* x; float* x2; bf16_t* x2b; float* ssq;
    __device__ __forceinline__ void operator()(const f32x4 (&acc)[2][2][4][2], const Unit& u, int wr, int wc, int fr, int fq) const {
        const int row0 = u.pm * BM + wr * 64 + fr, col0 = u.pn * BM + wc * 32 + 8 * fq;
#pragma unroll
        for (int ai = 0; ai < 2; ++ai)
#pragma unroll
            for (int m = 0; m < 4; ++m) {
                const int row = row0 + ai * HALF + m * 16;
                const size_t off = (size_t)row * DM + col0;
                float ss = 0.f;
#pragma unroll
                for (int bj = 0; bj < 2; ++bj) {
                    const f32x4 x0 = *(const f32x4*)(x + off + bj * HALF), x1 = *(const f32x4*)(x + off + bj * HALF + 4);
                    const f32x4 o0 = x0 + acc[ai][bj][m][0], o1 = x1 + acc[ai][bj][m][1];
                    u32x4 w; w.x = cvt_pk_bf16(o0[0], o0[1]); w.y = cvt_pk_bf16(o0[2], o0[3]); w.z = cvt_pk_bf16(o1[0], o1[1]); w.w = cvt_pk_bf16(o1[2], o1[3]);
                    *(u32x4*)(x2b + off + bj * HALF) = w;
                    ss += (o0[0] * o0[0] + o0[1] * o0[1]) + (o0[2] * o0[2] + o0[3] * o0[3]) + (o1[0] * o1[0] + o1[1] * o1[1]) + (o1[2] * o1[2] + o1[3] * o1[3]);
                }
                ss += __shfl_xor(ss, 16); ss += __shfl_xor(ss, 32);
                if (fq == 0) ssq[(size_t)row * 16 + (u.pn & 3) * 4 + wc] = ss;
            }
    }
};

template <class Epi, class Sched>
__device__ __forceinline__ void gemm_phase(PG8_LAS unsigned char* lds, const Gemm g, const Sched& S, const Epi& E) {
    const int tid = threadIdx.x, wid = __builtin_amdgcn_readfirstlane(tid >> 6), lane = tid & 63, wr = wid >> 2, wc = wid & 3, fr = lane & 15, fq = lane >> 4;
    const int K = g.K, nt = K / BK;
    unsigned voffA[2], voffB[2];
#pragma unroll
    for (int i = 0; i < 2; ++i) { int R, C; stage_rc(tid * 16 + i * 8192, R, C); const int Rb = Epi::PERM ? ((R & ~31) + perm32(R & 31)) : R;
        voffA[i] = (unsigned)(R * g.lda + C) * 2u; voffB[i] = (unsigned)(Rb * g.ldb + C) * 2u; }
    const size_t kstep = (size_t)(BK * 2);
    const size_t hstepA = (size_t)HALF * g.lda * 2, hstepB = (size_t)HALF * g.ldb * 2;
    const size_t tstepA = 2 * hstepA, tstepB = 2 * hstepB;
    const unsigned ldsw = (unsigned)wid * 1024u;
    const int aoff = lds_byte(wr * 64 + fr, fq * 8), boff = lds_byte(wc * 32 + fr, fq * 8);
#define PG8_SA(b, h) (((b) * 2 + (h)) * HTB)
#define PG8_SB(b, h) ((4 + (b) * 2 + (h)) * HTB)
#define PG8_STAGE(bufoff, gbase, voff) do { _Pragma("unroll") for (int _i = 0; _i < 2; ++_i) \
        __builtin_amdgcn_global_load_lds((const unsigned*)((const char*)(gbase) + (voff)[_i]), (PG8_LAS unsigned*)(lds + (bufoff) + ldsw + _i * 8192), 16, 0, 0); } while (0)
#define PG8_LDA(dst, b, h) do { _Pragma("unroll") for (int m = 0; m < 4; ++m) _Pragma("unroll") for (int k = 0; k < 2; ++k) dst[m][k] = *(const PG8_LAS bf16x8*)(lds + PG8_SA(b, h) + aoff + m * 2048 + k * 1024); } while (0)
#define PG8_LDB(dst, b, h) do { _Pragma("unroll") for (int n = 0; n < 2; ++n) _Pragma("unroll") for (int k = 0; k < 2; ++k) dst[n][k] = *(const PG8_LAS bf16x8*)(lds + PG8_SB(b, h) + boff + n * 2048 + k * 1024); } while (0)
#define PG8_MMA(ai, bj, At, Bt) do { __builtin_amdgcn_s_setprio(1); _Pragma("unroll") for (int m = 0; m < 4; ++m) _Pragma("unroll") for (int n = 0; n < 2; ++n) _Pragma("unroll") for (int k = 0; k < 2; ++k) \
        acc[ai][bj][m][n] = __builtin_amdgcn_mfma_f32_16x16x32_bf16(Bt[n][k], At[m][k], acc[ai][bj][m][n], 0, 0, 0); __builtin_amdgcn_s_setprio(0); } while (0)
#define PG8_WAIT_V(n) asm volatile("s_waitcnt vmcnt(" #n ")" ::: "memory")
#define PG8_WAIT_L(n) asm volatile("s_waitcnt lgkmcnt(" #n ")" ::: "memory")
#define PG8_BAR __builtin_amdgcn_s_barrier()
#define PG8_SCHED __builtin_amdgcn_sched_barrier(0)
    Unit cur, nxt; int ui = 0;
    if (!S.next(0, cur)) return;
    f32x4 acc[2][2][4][2];
#pragma unroll
    for (int a = 0; a < 2; ++a)
#pragma unroll
        for (int b = 0; b < 2; ++b)
#pragma unroll
            for (int m = 0; m < 4; ++m)
#pragma unroll
                for (int n = 0; n < 2; ++n) acc[a][b][m][n] = (f32x4){0.f, 0.f, 0.f, 0.f};
    bf16x8 At[4][2], B0[2][2], B1[2][2];
    const char* cA = (const char*)g.A + (size_t)cur.pm * tstepA; const char* cB = (const char*)g.Bt + (size_t)cur.pn * tstepB;
    PG8_STAGE(PG8_SB(0, 0), cB, voffB); PG8_STAGE(PG8_SB(0, 1), cB + hstepB, voffB); PG8_STAGE(PG8_SA(0, 0), cA, voffA); PG8_STAGE(PG8_SA(0, 1), cA + hstepA, voffA);
    if (wr == 1) PG8_BAR;
    PG8_WAIT_V(2); PG8_BAR;
    PG8_STAGE(PG8_SB(1, 0), cB + kstep, voffB); PG8_STAGE(PG8_SA(1, 0), cA + kstep, voffA); PG8_STAGE(PG8_SB(1, 1), cB + hstepB + kstep, voffB);
    PG8_WAIT_V(6); PG8_BAR;
    for (;;) {
        const bool has_next = S.next(ui + 1, nxt);
        const char* nA = has_next ? (const char*)g.A + (size_t)nxt.pm * tstepA : cA; const char* nB = has_next ? (const char*)g.Bt + (size_t)nxt.pn * tstepB : cB;
        for (int t = 0; t < nt; t += 2) {
            const bool last = (t == nt - 2);
            const char* a1 = cA + (size_t)(t + 1) * kstep;
            const char* a2 = last ? nA : cA + (size_t)(t + 2) * kstep; const char* b2 = last ? nB : cB + (size_t)(t + 2) * kstep;
            const char* a3 = a2 + kstep; const char* b3 = b2 + kstep;
            PG8_LDB(B0, 0, 0); PG8_LDB(B1, 0, 1); PG8_SCHED; PG8_LDA(At, 0, 0); PG8_STAGE(PG8_SA(1, 1), a1 + hstepA, voffA);
            PG8_WAIT_V(8); PG8_WAIT_L(0); PG8_BAR; PG8_MMA(0, 0, At, B0); PG8_MMA(0, 1, At, B1); PG8_BAR; PG8_SCHED;
            PG8_LDA(At, 0, 1); PG8_STAGE(PG8_SB(0, 0), b2, voffB); PG8_STAGE(PG8_SB(0, 1), b2 + hstepB, voffB); PG8_STAGE(PG8_SA(0, 0), a2, voffA);
            PG8_WAIT_V(8); PG8_WAIT_L(0); PG8_BAR; PG8_MMA(1, 0, At, B0); PG8_MMA(1, 1, At, B1); PG8_BAR; PG8_SCHED;
            PG8_LDB(B0, 1, 0); PG8_LDB(B1, 1, 1); PG8_SCHED; PG8_LDA(At, 1, 0); PG8_STAGE(PG8_SA(0, 1), a2 + hstepA, voffA);
            PG8_WAIT_V(8); PG8_WAIT_L(0); PG8_BAR; PG8_MMA(0, 0, At, B0); PG8_MMA(0, 1, At, B1); PG8_BAR; PG8_SCHED;
            PG8_LDA(At, 1, 1); PG8_STAGE(PG8_SB(1, 0), b3, voffB); PG8_STAGE(PG8_SB(1, 1), b3 + hstepB, voffB); PG8_STAGE(PG8_SA(1, 0), a3, voffA);
            PG8_WAIT_V(8); PG8_WAIT_L(0); PG8_BAR; PG8_MMA(1, 0, At, B0); PG8_MMA(1, 1, At, B1); PG8_BAR; PG8_SCHED;
        }
        if (wr == 0) PG8_BAR;
        E(acc, cur, wr, wc, fr, fq);
        if (!has_next) break;
#pragma unroll
        for (int a = 0; a < 2; ++a)
#pragma unroll
            for (int b = 0; b < 2; ++b)
#pragma unroll
                for (int m = 0; m < 4; ++m)
#pragma unroll
                    for (int n = 0; n < 2; ++n) acc[a][b][m][n] = (f32x4){0.f, 0.f, 0.f, 0.f};
        cur = nxt; cA = nA; cB = nB; ++ui;
        if (wr == 1) PG8_BAR;
    }
    PG8_WAIT_V(0);
    PG8_BAR;
#undef PG8_SA
#undef PG8_SB
#undef PG8_STAGE
#undef PG8_LDA
#undef PG8_LDB
#undef PG8_MMA
#undef PG8_WAIT_V
#undef PG8_WAIT_L
#undef PG8_BAR
#undef PG8_SCHED
}
}

constexpr int NWAVES = 8;
constexpr int LDS_RING_BYTES = 131072, LDSCTL_OFF = 143360, MISC_OFF = LDSCTL_OFF + 320, LDS_BYTES = 147456;
#define LAS __attribute__((address_space(3)))
#define GAS __attribute__((address_space(1)))
typedef float f32x4 __attribute__((ext_vector_type(4)));
typedef unsigned v4u __attribute__((ext_vector_type(4)));
typedef unsigned v2u __attribute__((ext_vector_type(2)));
#define LDS_WAIT() asm volatile("s_waitcnt lgkmcnt(0)" ::: "memory")

constexpr int CW_BAR = 4096;
#define XB_TMO      128
#define XB_XCNT(j)  (256  + 64 * (j))
#define XB_XSUB(j)  (1280 + 64 * (j))
#define XB_XGEN(j)  (2304 + 64 * (j))
#define XB_TOP      3328
#define XB_TOPGEN   3392
#define XCD_BAR_WORDS 3456
#define XB_SPIN_CAP (1u << 20)
__device__ __forceinline__ unsigned xb_ld(unsigned* p)              { return __hip_atomic_load(p, __ATOMIC_RELAXED, __HIP_MEMORY_SCOPE_AGENT); }
__device__ __forceinline__ unsigned xb_add(unsigned* p, unsigned v) { return __hip_atomic_fetch_add(p, v, __ATOMIC_RELAXED, __HIP_MEMORY_SCOPE_AGENT); }
__device__ __forceinline__ unsigned xb_xcc_id() { return (unsigned)__builtin_amdgcn_s_getreg((3 << 11) | 20) & 0xFu; }
#define XB_SPIN(cond, bar) do { unsigned _sp = 0; while (cond) { __builtin_amdgcn_s_sleep(1); \
    if ((++_sp & 255u) == 0u) { if (xb_ld(&(bar)[XB_TMO])) break; if (_sp > XB_SPIN_CAP) { atomicAdd(&(bar)[XB_TMO], 1u); break; } } } } while (0)
struct XcdBarrier { unsigned* bar; unsigned x; volatile LAS unsigned* st; };
__device__ __forceinline__ XcdBarrier xcd_barrier_post(unsigned* bar, volatile LAS unsigned* st) {
    XcdBarrier b; b.bar = bar; b.x = xb_xcc_id(); b.st = st;
    if (threadIdx.x == 0) (void)xb_add(&bar[XB_XCNT(b.x)], 1u);
    return b;
}
__device__ __forceinline__ void xcd_barrier_complete(unsigned* bar, unsigned x, unsigned& nloc, unsigned& nx) {
    const unsigned G = gridDim.x * gridDim.y * gridDim.z;
    unsigned sum, cnt, mine, sp = 0u;
    for (;;) {
        sum = 0u; cnt = 0u; mine = 0u;
#pragma unroll
        for (unsigned j = 0; j < 16; ++j) { const unsigned c = xb_ld(&bar[XB_XCNT(j)]); sum += c; cnt += (c > 0u) ? 1u : 0u; mine = (j == x) ? c : mine; }
        if (sum == G) break;
        __builtin_amdgcn_s_sleep(1);
        if ((++sp & 255u) == 0u) { if (xb_ld(&bar[XB_TMO])) break; if (sp > XB_SPIN_CAP) { atomicAdd(&bar[XB_TMO], 1u); break; } }
    }
    nloc = mine > 0u ? mine : 1u; nx = cnt > 0u ? cnt : 1u;
}
__device__ __forceinline__ void xcd_barrier(const XcdBarrier& b) {
    asm volatile("s_waitcnt vmcnt(0)" ::: "memory");
    __syncthreads();
    if (threadIdx.x == 0) {
        unsigned* bar = b.bar;
        __builtin_amdgcn_s_waitcnt(0);
        unsigned nloc = b.st[0], nx = b.st[1];
        if (nloc == 0u) { xcd_barrier_complete(bar, b.x, nloc, nx); b.st[0] = nloc; b.st[1] = nx; }
        const unsigned old = xb_add(&bar[XB_XSUB(b.x)], 1u);
        const unsigned gen = old / nloc;
        if (old + 1u == (gen + 1u) * nloc) {
            __builtin_amdgcn_fence(__ATOMIC_RELEASE, "agent");
            asm volatile("s_waitcnt vmcnt(0)" ::: "memory");
            const unsigned og = xb_add(&bar[XB_TOP], 1u);
            const unsigned tg = og / nx;
            if (og + 1u == (tg + 1u) * nx) xb_add(&bar[XB_TOPGEN], 1u);
            else XB_SPIN(xb_ld(&bar[XB_TOPGEN]) == tg, bar);
            __builtin_amdgcn_fence(__ATOMIC_ACQUIRE, "agent");
            xb_add(&bar[XB_XGEN(b.x)], 1u);
            asm volatile("s_waitcnt vmcnt(0)" ::: "memory");
        } else {
            XB_SPIN(xb_ld(&bar[XB_XGEN(b.x)]) == gen, bar);
            __builtin_amdgcn_fence(__ATOMIC_ACQUIRE, "agent");
            asm volatile("s_waitcnt vmcnt(0)" ::: "memory");
        }
    }
    __syncthreads();
}

struct Args { const float* in[28]; float* out; unsigned char* ws; int ph_lo, ph_hi, li, pad; };

__device__ __forceinline__ void p0_transpose_item(const float* W, const float* sc, int K, int N, bf16_t* WT, LAS float* scr, int item, int lane) {
    const int nblk = N / 32, kb = item / nblk, nb = item % nblk, k0 = 64 * kb, n0 = 32 * nb;
#pragma unroll 8
    for (int i = 0; i < 32; ++i) { const int kk = 2 * i + (lane >> 5); const float s = sc ? sc[k0 + kk] : 1.f; scr[kk * 33 + (lane & 31)] = W[(size_t)(k0 + kk) * N + n0 + (lane & 31)] * s; }
    LDS_WAIT(); asm volatile("" ::: "memory");
    const int c = lane & 7;
#pragma unroll
    for (int j = 0; j < 4; ++j) { const int n = (lane >> 3) + 8 * j; const LAS float* s = scr + (8 * c) * 33 + n;
        v4u o; o.x = pg8::cvt_pk_bf16(s[0 * 33], s[1 * 33]); o.y = pg8::cvt_pk_bf16(s[2 * 33], s[3 * 33]); o.z = pg8::cvt_pk_bf16(s[4 * 33], s[5 * 33]); o.w = pg8::cvt_pk_bf16(s[6 * 33], s[7 * 33]);
        *(v4u*)(WT + (size_t)(n0 + n) * K + k0 + 8 * c) = o; }
    LDS_WAIT(); asm volatile("" ::: "memory");
}
typedef unsigned v6u_t __attribute__((ext_vector_type(6)));
typedef unsigned v3u_t __attribute__((ext_vector_type(3)));
typedef float v16f_t __attribute__((ext_vector_type(16)));
typedef float v32f_t __attribute__((ext_vector_type(32)));
__device__ __forceinline__ void p0_row_fp6(const float* in, const float* cs, unsigned char* out, float* sc, int lane) {
    f32x4 v[4]; float mx = 0.f;
#pragma unroll
    for (int i = 0; i < 4; ++i) { v[i] = *(const f32x4*)(in + lane * 16 + 4 * i); if (cs) v[i] = v[i] * *(const f32x4*)(cs + lane * 16 + 4 * i);
        mx = fmaxf(mx, fmaxf(fmaxf(fabsf(v[i][0]), fabsf(v[i][1])), fmaxf(fabsf(v[i][2]), fabsf(v[i][3])))); }
#pragma unroll
    for (int o = 1; o < 64; o <<= 1) mx = fmaxf(mx, __shfl_xor(mx, o));
    mx = fmaxf(mx, 1e-30f);
    const float q = 7.5f / mx;
    v16f_t a, b;
#pragma unroll
    for (int i = 0; i < 16; ++i) { a[i] = 0.f; b[i] = 0.f; }
#pragma unroll
    for (int i = 0; i < 8; ++i) { a[i] = v[(2 * i) >> 2][(2 * i) & 3] * q; b[i] = v[(2 * i + 1) >> 2][(2 * i + 1) & 3] * q; }
    const v6u_t p = __builtin_amdgcn_cvt_scalef32_2xpk16_fp6_f32(a, b, 1.0f);
    *(v3u_t*)(out + lane * 12) = (v3u_t){p[0], p[1], p[2]};
    if (lane == 0) *sc = mx * (1.f / 7.5f);
}
__device__ __forceinline__ void p0_convert(const float* in, const float* cs, bf16_t* out, size_t n, int gw, int NGW, int lane) {
    for (size_t i = ((size_t)gw * 64 + lane) * 8; i < n; i += (size_t)NGW * 512) {
        f32x4 a = *(const f32x4*)(in + i), b = *(const f32x4*)(in + i + 4);
        if (cs) { const int c = (int)(i & 1023); a = a * *(const f32x4*)(cs + c); b = b * *(const f32x4*)(cs + c + 4); }
        v4u o; o.x = pg8::cvt_pk_bf16(a[0], a[1]); o.y = pg8::cvt_pk_bf16(a[2], a[3]); o.z = pg8::cvt_pk_bf16(b[0], b[1]); o.w = pg8::cvt_pk_bf16(b[2], b[3]);
        *(v4u*)(out + i) = o;
    }
}

namespace da {
typedef short bf16x8 __attribute__((ext_vector_type(8)));
typedef short s16x4 __attribute__((ext_vector_type(4)));
typedef float f32x16 __attribute__((ext_vector_type(16)));
typedef const LAS unsigned char* lcp;
constexpr float LOG2E = 1.4426950408889634f, C2 = 0.125f * LOG2E, THR = 8.f;
constexpr int RSLOT = 16384, LDS_KR = 0, LDS_VR = 4 * RSLOT, SCR_OFF = 8 * RSLOT, COMB_OFF = 0;
#define DA_SBAR() __builtin_amdgcn_sched_barrier(0)
#define DA_PIN(x) asm volatile("" : "+v"(x))
#define DA_MFMA(a, b, c) __builtin_amdgcn_mfma_f32_32x32x16_bf16(a, b, c, 0, 0, 0)
#define DA_WAIT_BAR(N) asm volatile("s_waitcnt vmcnt(" #N ") lgkmcnt(0)\n\ts_barrier" ::: "memory")
#define DA_MX3(a, b, c) __builtin_fmaxf(__builtin_fmaxf((a), (b)), (c))
__device__ __forceinline__ int crow(int r, int hi) { return (r & 3) + 8 * (r >> 2) + 4 * hi; }
__device__ __forceinline__ s16x4 vtr(lcp p) { return __builtin_bit_cast(s16x4, __builtin_amdgcn_ds_read_tr16_b64_v4i16((LAS s16x4*)p)); }
__device__ __forceinline__ unsigned cvtpk(float lo, float hi) { unsigned r; asm("v_cvt_pk_bf16_f32 %0, %1, %2" : "=v"(r) : "v"(lo), "v"(hi)); return r; }
__device__ __forceinline__ void glds16(const void* g, unsigned lds_base) {
    unsigned sv; asm volatile("s_mov_b32 %0, m0\n\ts_mov_b32 m0, %2\n\ts_nop 0\n\tglobal_load_lds_dwordx4 %1, off\n\ts_mov_b32 m0, %0" : "=&s"(sv) : "v"(g), "s"(lds_base) : "memory"); }
__device__ __forceinline__ void glds16_o128(const void* g, unsigned lds_base) {
    unsigned sv; asm volatile("s_mov_b32 %0, m0\n\ts_mov_b32 m0, %2\n\ts_nop 0\n\tglobal_load_lds_dwordx4 %1, off offset:128\n\ts_mov_b32 m0, %0" : "=&s"(sv) : "v"(g), "s"(lds_base) : "memory"); }
__device__ __forceinline__ void kload2(bf16x8* kf, lcp kp, int d0) { kf[2 * d0] = *(const LAS bf16x8*)(kp + d0 * 2048); kf[2 * d0 + 1] = *(const LAS bf16x8*)(kp + d0 * 2048 + 512); }
__device__ __forceinline__ float max16(const f32x16& p) {
    float a = DA_MX3(p[0], p[1], p[2]), b = DA_MX3(p[3], p[4], p[5]); a = DA_MX3(a, p[6], p[7]); b = DA_MX3(b, p[8], p[9]); a = DA_MX3(a, p[10], p[11]); b = DA_MX3(b, p[12], p[13]);
    a = DA_MX3(a, p[14], p[15]); return __builtin_fmaxf(a, b); }
__device__ __forceinline__ float rowmax(const f32x16& p0, const f32x16& p1, float offA, float offB) {
    const float m = __builtin_fmaxf(__builtin_fmaf(max16(p0), C2, offA), __builtin_fmaf(max16(p1), C2, offB));
    auto rr = __builtin_amdgcn_permlane32_swap(__float_as_uint(m), __float_as_uint(m), false, false);
    return __builtin_fmaxf(__uint_as_float(rr[0]), __uint_as_float(rr[1])); }
__device__ __forceinline__ void cmask(f32x16& p0, f32x16& p1, int jb, int qrel, int hi) {
    const int kb = 64 * jb + 4 * hi;
#pragma unroll
    for (int r = 0; r < 16; ++r) { const int kv = kb + (r & 3) + 8 * (r >> 2); if (kv > qrel) p0[r] = -INFINITY; if (kv + 32 > qrel) p1[r] = -INFINITY; } }

__device__ __forceinline__ void attn_epilogue_body(LAS unsigned char* lds, f32x16 (&o)[4], float l_reg, bf16_t* __restrict__ yb, const float* __restrict__ subln_w, float lam,
                                                   size_t rowb, int q0, int h, int wave, int lane) {
    asm volatile("" : "+v"(lane));
    const int r32 = lane & 31, hi = lane >> 5, map = wave >> 2, qs = wave & 3;
    LAS float* wsf = (LAS float*)(lds + SCR_OFF) + wave * 64;
    if (hi == 0) wsf[r32] = __builtin_amdgcn_rcpf(l_reg);
    float il[16];
#pragma unroll
    for (int g = 0; g < 4; ++g) { const f32x4 t4 = *(const LAS f32x4*)(wsf + 8 * g + 4 * hi); il[4 * g] = t4[0]; il[4 * g + 1] = t4[1]; il[4 * g + 2] = t4[2]; il[4 * g + 3] = t4[3]; }
    __syncthreads();
    LAS float* comb = (LAS float*)(lds + COMB_OFF) + qs * 4096;
    if (map == 1) {
#pragma unroll
        for (int d = 0; d < 4; ++d)
#pragma unroll
            for (int r = 0; r < 16; ++r) comb[crow(r, hi) * 128 + 32 * d + r32] = o[d][r] * il[r];
    }
    __syncthreads();
    if (map == 0) {
        float sw[4];
#pragma unroll
        for (int d = 0; d < 4; ++d) sw[d] = subln_w[32 * d + r32] * (1.f - LAM_INIT);
#pragma unroll
        for (int r = 0; r < 16; ++r) {
            float v[4], ss = 0.f;
#pragma unroll
            for (int d = 0; d < 4; ++d) { v[d] = o[d][r] * il[r] - lam * comb[crow(r, hi) * 128 + 32 * d + r32]; ss += v[d] * v[d]; }
            ss += __shfl_xor(ss, 1); ss += __shfl_xor(ss, 2); ss += __shfl_xor(ss, 4); ss += __shfl_xor(ss, 8); ss += __shfl_xor(ss, 16);
            const float rs = rsqrtf(ss * (1.f / 128.f) + SUBLN_EPS);
            bf16_t* op = yb + (rowb + q0 + crow(r, hi)) * 512 + h * 128 + r32;
#pragma unroll
            for (int d = 0; d < 4; ++d) op[32 * d] = f2bf(v[d] * rs * sw[d]);
        }
    }
    __syncthreads();
}
__device__ __forceinline__ void attn_unit(LAS unsigned char* lds, const bf16_t* __restrict__ z, bf16_t* __restrict__ yb, const float* __restrict__ subln_w, float lam,
                                          int b, int h, int qblk, int wave_, int lane) {
    const int wave = __builtin_amdgcn_readfirstlane(wave_);
    const int r32 = lane & 31, hi = lane >> 5, map = wave >> 2, qs = wave & 3;
    const int q0 = qblk * 128 + qs * 32, NT = 2 * qblk + 2, qrel = qs * 32 + r32;
    const size_t rowb = (size_t)b * SEQ;
    const float slope = exp2f(-2.f * (float)(h + 1)), slope2 = slope * LOG2E, s64 = 64.f * slope2, s32 = 32.f * slope2;
    const unsigned lds0 = (unsigned)(uintptr_t)lds;
    LAS float* wsf = (LAS float*)(lds + SCR_OFF) + wave * 64;
    const bf16_t* ksrc = z + (rowb + lane) * NZ + C_ZK + h * 128 + wave * 8;
    const int pc0 = 2 * wave;
    const bf16_t* vsrc0 = z + (rowb + 16 * (pc0 & 3) + (lane >> 2)) * NZ + C_ZV + h * 128 + 32 * (pc0 >> 2) + (lane & 3) * 8;
    const unsigned kdst = lds0 + LDS_KR + wave * 1024, vdst = lds0 + LDS_VR + pc0 * 1024;
#define DMA_K(t, slot) do { const bf16_t* k_ = ksrc + (size_t)(t) * 64 * NZ; const unsigned d_ = (unsigned)__builtin_amdgcn_readfirstlane(kdst + (slot)); glds16(k_, d_); glds16_o128(k_, d_ + 8192 - 128); } while (0)
#define DMA_V(t, slot) do { const size_t o_ = (size_t)(t) * 64 * NZ; const unsigned d_ = (unsigned)__builtin_amdgcn_readfirstlane(vdst + (slot)); glds16(vsrc0 + o_, d_); glds16(vsrc0 + o_ + 16 * NZ, d_ + 1024); } while (0)
    const lcp vp0 = lds + LDS_VR + ((lane >> 4) & 1) * 32 + (lane & 3) * 8 + (4 * hi + ((lane & 15) >> 2)) * 64;
    const lcp kp0 = lds + LDS_KR + map * 8192 + hi * 1024 + r32 * 16;
    DMA_K(0, 0); DMA_V(0, 0); DMA_K(1, RSLOT);
    bf16x8 qr[4];
    {
        const bf16_t* qp = z + (rowb + q0 + r32) * NZ + C_Q + h * 128 + map * 64 + hi * 8;
#pragma unroll
        for (int d0 = 0; d0 < 4; ++d0) qr[d0] = *(const bf16x8*)(qp + d0 * 16);
    }
    f32x16 bias16;
#pragma unroll
    for (int r = 0; r < 16; ++r) bias16[r] = (8.f * slope) * (float)((r & 3) + 8 * (r >> 2));
    DA_PIN(bias16);
    float mhat = 0.f, l_reg = 0.f, offA = slope2 * (float)(4 * hi);
    f32x16 o[4];
#pragma unroll
    for (int d = 0; d < 4; ++d) o[d] = (f32x16){};
    bool resc = false;
    f32x16 c0, c1; bf16x8 kf[8]; s16x4 vlo[4], vhi[4]; v4u pw0, pw1, pw2, pw3;
#define SL(t) ((((t)) & 3) * RSLOT)
#define EX(v, nm) __builtin_amdgcn_exp2f(__builtin_fmaf((v), C2, (nm)))
#define RESC() do { if (resc) { _Pragma("unroll") for (int d_ = 0; d_ < 4; ++d_) _Pragma("unroll") for (int r = 0; r < 16; ++r) o[d_][r] *= wsf[crow(r, hi)]; } } while (0)
#define PKW(P, i) pg8::cvt_pk_bf16(P[i], P[(i) + 1])
    DMA_K(2, 2 * RSLOT); DMA_K(3, 3 * RSLOT); DMA_V(1, RSLOT);
    DA_WAIT_BAR(10);
#pragma unroll
    for (int d0 = 0; d0 < 4; ++d0) kload2(kf, kp0, d0);
    c0 = DA_MFMA(kf[0], qr[0], bias16); c1 = DA_MFMA(kf[1], qr[0], bias16); c0 = DA_MFMA(kf[2], qr[1], c0); c1 = DA_MFMA(kf[3], qr[1], c1);
    c0 = DA_MFMA(kf[4], qr[2], c0); c1 = DA_MFMA(kf[5], qr[2], c1); c0 = DA_MFMA(kf[6], qr[3], c0); c1 = DA_MFMA(kf[7], qr[3], c1);
    if (NT == 2) cmask(c0, c1, 0, qrel, hi);
    { mhat = rowmax(c0, c1, offA, offA + s32); const float nmh0 = offA - mhat, nmh1 = nmh0 + s32; float sacc = 0.f;
#pragma unroll
      for (int r = 0; r < 16; ++r) { c0[r] = EX(c0[r], nmh0); c1[r] = EX(c1[r], nmh1); sacc += c0[r] + c1[r]; }
      l_reg = sacc; }
    pw0 = (v4u){PKW(c0, 0), PKW(c0, 2), PKW(c0, 4), PKW(c0, 6)}; pw1 = (v4u){PKW(c0, 8), PKW(c0, 10), PKW(c0, 12), PKW(c0, 14)};
    pw2 = (v4u){PKW(c1, 0), PKW(c1, 2), PKW(c1, 4), PKW(c1, 6)}; pw3 = (v4u){PKW(c1, 8), PKW(c1, 10), PKW(c1, 12), PKW(c1, 14)};
    DA_WAIT_BAR(6);
    DMA_K(4, 0); DMA_V(2, 2 * RSLOT);
#pragma unroll
    for (int d0 = 0; d0 < 4; ++d0) kload2(kf, kp0 + RSLOT, d0);
    if (NT == 2) { DA_WAIT_BAR(0); } else { DA_WAIT_BAR(8); }
#define PAF(k) __builtin_bit_cast(bf16x8, pw##k)
#define VFR(i) (bf16x8){vlo[(i) & 3][0], vlo[(i) & 3][1], vlo[(i) & 3][2], vlo[(i) & 3][3], vhi[(i) & 3][0], vhi[(i) & 3][1], vhi[(i) & 3][2], vhi[(i) & 3][3]}
#define VOFF(i) ((((i) & 3) * 4 + ((i) >> 2)) * 1024)
#define VRD(i) do { vlo[(i) & 3] = vtr(vp_ + VOFF(i)); vhi[(i) & 3] = vtr(vp_ + VOFF(i) + 512); DA_SBAR(); } while (0)
#define KRD(G, d0) do { if (G) { kload2(kf, kp0 + sl_next_, d0); DA_SBAR(); } } while (0)
#define GAPA(MF) do { MF; DA_SBAR(); } while (0)
#define GAPB(MF, X, i, nm, A0, A1, EXTRA) do { MF; X[i] = EX(X[i], nm); X[(i) + 1] = EX(X[(i) + 1], nm); sacc += A0; sacc += A1; EXTRA; DA_PIN(X); DA_PIN(sacc); DA_SBAR(); } while (0)
#define STEP(t, MASK, GK, GV, GL) do { DA_SBAR(); \
    const lcp vp_ = vp0 + SL((t) - 1); const int sl_next_ = SL((t) + 1); \
            GAPA(c0 = DA_MFMA(kf[0], qr[0], bias16)); GAPA(c1 = DA_MFMA(kf[1], qr[0], bias16)); GAPA(c0 = DA_MFMA(kf[2], qr[1], c0)); GAPA(c1 = DA_MFMA(kf[3], qr[1], c1)); \
    VRD(0); GAPA(c0 = DA_MFMA(kf[4], qr[2], c0)); VRD(1); GAPA(c1 = DA_MFMA(kf[5], qr[2], c1)); VRD(2); GAPA(c0 = DA_MFMA(kf[6], qr[3], c0)); VRD(3); GAPA(c1 = DA_MFMA(kf[7], qr[3], c1)); \
    offA += s64; \
    if (GK) DMA_K((t) + 4, SL(t)); if (GV) DMA_V((t) + 2, SL((t) + 2)); \
    if (MASK) cmask(c0, c1, (t) - (NT - 2), qrel, hi); \
    { const float rm = rowmax(c0, c1, offA, offA + s32) - mhat; resc = false; \
      if (__builtin_expect(__any(rm > THR), 0)) { const float dl = __builtin_fmaxf(rm, 0.f); mhat += dl; \
          const float f = __builtin_amdgcn_exp2f(-dl); l_reg *= f; if (hi == 0) wsf[r32] = f; resc = true; } } \
    const float nmh0 = offA - mhat, nmh1 = nmh0 + s32; float sacc = 0.f; DA_SBAR(); \
    GAPB(o[0] = DA_MFMA(PAF(0), VFR(0), o[0]), c0, 0, nmh0, 0.f, 0.f, );             VRD(4); \
    GAPB(o[1] = DA_MFMA(PAF(0), VFR(1), o[1]), c0, 2, nmh0, c0[0], c0[1], );         VRD(5); \
    GAPB(o[2] = DA_MFMA(PAF(0), VFR(2), o[2]), c0, 4, nmh0, c0[2], c0[3], );         VRD(6); \
    GAPB(o[3] = DA_MFMA(PAF(0), VFR(3), o[3]), c0, 6, nmh0, c0[4], c0[5], );         VRD(7); \
    GAPB(o[0] = DA_MFMA(PAF(1), VFR(4), o[0]), c0, 8, nmh0, c0[6], c0[7], pw0[0] = PKW(c0, 0); pw0[1] = PKW(c0, 2); DA_PIN(pw0));    VRD(8); \
    GAPB(o[1] = DA_MFMA(PAF(1), VFR(5), o[1]), c0, 10, nmh0, c0[8], c0[9], pw0[2] = PKW(c0, 4); pw0[3] = PKW(c0, 6); DA_PIN(pw0));   VRD(9); \
    GAPB(o[2] = DA_MFMA(PAF(1), VFR(6), o[2]), c0, 12, nmh0, c0[10], c0[11], );      VRD(10); \
    GAPB(o[3] = DA_MFMA(PAF(1), VFR(7), o[3]), c0, 14, nmh0, c0[12], c0[13], );      VRD(11); \
    GAPB(o[0] = DA_MFMA(PAF(2), VFR(8), o[0]), c1, 0, nmh1, c0[14], c0[15], pw1[0] = PKW(c0, 8); pw1[1] = PKW(c0, 10); DA_PIN(pw1));  VRD(12); \
    GAPB(o[1] = DA_MFMA(PAF(2), VFR(9), o[1]), c1, 2, nmh1, c1[0], c1[1], pw1[2] = PKW(c0, 12); pw1[3] = PKW(c0, 14); DA_PIN(pw1));   VRD(13); \
    GAPB(o[2] = DA_MFMA(PAF(2), VFR(10), o[2]), c1, 4, nmh1, c1[2], c1[3], );        VRD(14); \
    GAPB(o[3] = DA_MFMA(PAF(2), VFR(11), o[3]), c1, 6, nmh1, c1[4], c1[5], );        VRD(15); \
    GAPB(o[0] = DA_MFMA(PAF(3), VFR(12), o[0]), c1, 8, nmh1, c1[6], c1[7], pw2[0] = PKW(c1, 0); pw2[1] = PKW(c1, 2); DA_PIN(pw2));   KRD(GL, 0); \
    GAPB(o[1] = DA_MFMA(PAF(3), VFR(13), o[1]), c1, 10, nmh1, c1[8], c1[9], pw2[2] = PKW(c1, 4); pw2[3] = PKW(c1, 6); DA_PIN(pw2));  KRD(GL, 1); \
    GAPB(o[2] = DA_MFMA(PAF(3), VFR(14), o[2]), c1, 12, nmh1, c1[10], c1[11], );     KRD(GL, 2); \
    GAPB(o[3] = DA_MFMA(PAF(3), VFR(15), o[3]), c1, 14, nmh1, c1[12], c1[13], );     KRD(GL, 3); \
    sacc += c1[14]; sacc += c1[15]; l_reg += sacc; \
    pw3[0] = PKW(c1, 8); pw3[1] = PKW(c1, 10); pw3[2] = PKW(c1, 12); pw3[3] = PKW(c1, 14); DA_PIN(pw3); \
    } while (0)
#define ENDW(tt) do { if ((tt) + 4 < NT) { DA_WAIT_BAR(8); } else if ((tt) + 3 < NT) { DA_WAIT_BAR(6); } else if ((tt) + 2 < NT) { DA_WAIT_BAR(4); } else { DA_WAIT_BAR(0); } } while (0)
    int t = 1;
    for (; t + 4 < NT; ++t) {
        STEP(t, false, true, true, true); DA_WAIT_BAR(8); RESC();
    }
    for (; t + 1 < NT; ++t) {
        STEP(t, true, (t + 4 < NT), (t + 2 < NT), (t + 1 < NT)); ENDW(t); RESC();
    }
    STEP(NT - 1, true, false, false, false); RESC();
    { const lcp vp_ = vp0 + SL(NT - 1);
#define DRN(k, i) do { const s16x4 lo_ = vtr(vp_ + VOFF(i)), hh_ = vtr(vp_ + VOFF(i) + 512); \
        o[(i) & 3] = DA_MFMA(PAF(k), ((bf16x8){lo_[0], lo_[1], lo_[2], lo_[3], hh_[0], hh_[1], hh_[2], hh_[3]}), o[(i) & 3]); } while (0)
      DRN(0, 0); DRN(0, 1); DRN(0, 2); DRN(0, 3); DRN(1, 4); DRN(1, 5); DRN(1, 6); DRN(1, 7); DRN(2, 8); DRN(2, 9); DRN(2, 10); DRN(2, 11); DRN(3, 12); DRN(3, 13); DRN(3, 14); DRN(3, 15);
#undef DRN
    }
#undef DMA_K
#undef DMA_V
#undef SL
#undef EX
#undef RESC
#undef PKW
#undef PAF
#undef VFR
#undef VOFF
#undef VRD
#undef KRD
#undef GAPA
#undef GAPB
#undef STEP
#undef ENDW
    { auto rr = __builtin_amdgcn_permlane32_swap(__float_as_uint(l_reg), __float_as_uint(l_reg), false, false); l_reg = __uint_as_float(rr[0]) + __uint_as_float(rr[1]); }
    attn_epilogue_body(lds, o, l_reg, yb, subln_w, lam, rowb, q0, h, wave, lane);
}
}

namespace rw {
typedef short bf16x8 __attribute__((ext_vector_type(8)));
typedef float f32x2 __attribute__((ext_vector_type(2)));
typedef short s16x4 __attribute__((ext_vector_type(4)));
constexpr int CH = 32, ACT_PITCH = 528;
constexpr int OFF_HAT = 41472, HAT_PITCH = 144, HAT_SZ = 32 * HAT_PITCH, OFF_TIL = OFF_HAT + 4 * HAT_SZ, TIL_PITCH = 40, TIL_SZ = 64 * TIL_PITCH, OFF_GR = OFF_TIL + 4 * TIL_SZ, OFF_WC = OFF_GR + 10 * 1024;
constexpr int OFF_ACT = 0, OFF_RKV = 16896, OFF_VEC = 41472, OFF_G = 82432, OFF_Y = 90624, OFF_NRM = 98816, OFF_SCL = 99328, OFF_CT = 99840, OFF_SCP = 102400;
template <int CTRL> __device__ __forceinline__ float dppf(float x) { return __builtin_bit_cast(float, __builtin_amdgcn_mov_dpp(__builtin_bit_cast(int, x), CTRL, 0xf, 0xf, true)); }
__device__ __forceinline__ float row_allsum(float v) { v += dppf<0x128>(v); v += dppf<0x124>(v); v += dppf<0x122>(v); v += dppf<0x121>(v); return v; }
__device__ __forceinline__ void row_allsum4(float& a, float& b, float& c, float& d) {
#define RW_DPP4(n) "v_add_f32_dpp %0, %0, %0 row_ror:" #n " row_mask:0xf bank_mask:0xf\n\tv_add_f32_dpp %1, %1, %1 row_ror:" #n " row_mask:0xf bank_mask:0xf\n\t" \
                   "v_add_f32_dpp %2, %2, %2 row_ror:" #n " row_mask:0xf bank_mask:0xf\n\tv_add_f32_dpp %3, %3, %3 row_ror:" #n " row_mask:0xf bank_mask:0xf\n\t"
    asm volatile("s_nop 1\n\t" RW_DPP4(8) RW_DPP4(4) RW_DPP4(2) RW_DPP4(1) "s_nop 1" : "+v"(a), "+v"(b), "+v"(c), "+v"(d));
#undef RW_DPP4
}
__device__ __forceinline__ f32x4 ld4bf(const bf16_t* p) { const v2u w = *(const v2u*)p; return (f32x4){pg8::bflo(w.x), pg8::bfhi(w.x), pg8::bflo(w.y), pg8::bfhi(w.y)}; }
__device__ __forceinline__ float fsig(float x) { return __builtin_amdgcn_rcpf(1.f + __expf(-x)); }
__device__ __forceinline__ float ftanh(float x) { return 1.f - 2.f * __builtin_amdgcn_rcpf(1.f + __expf(2.f * x)); }
struct ZRow { v2u r, k, v, w, a; v4u g; };
__device__ __forceinline__ ZRow ldrow(const bf16_t* zr, int c4, int cg) {
    ZRow o; o.r = *(const v2u*)(zr + C_R + c4); o.k = *(const v2u*)(zr + C_K + c4); o.v = *(const v2u*)(zr + C_V + c4); o.w = *(const v2u*)(zr + C_WL + 4 * cg); o.a = *(const v2u*)(zr + C_AL + 4 * cg);
    o.g = *(const v4u*)(zr + C_GL + 8 * cg); return o;
}
__device__ __forceinline__ f32x4 up4(v2u w) { return (f32x4){pg8::bflo(w.x), pg8::bfhi(w.x), pg8::bflo(w.y), pg8::bfhi(w.y)}; }

struct ScanP { const float *mu, *w0, *w2, *a0, *a2, *g2, *k_k, *k_a, *r_k, *lnx_w, *lnx_b; };
__device__ __forceinline__ void scan_unit(LAS unsigned char* lds, const bf16_t* __restrict__ z, bf16_t* __restrict__ ya, const ScanP P, int b, int h, int tid, int wave, int lane) {
    asm volatile("" : "+v"(tid)); lane = tid & 63;
    const float* mu = P.mu; const float* w0 = P.w0; const float* w2 = P.w2; const float* a0 = P.a0; const float* a2 = P.a2; const float* g2 = P.g2;
    const float* k_k = P.k_k; const float* k_a = P.k_a; const float* r_k = P.r_k; const float* lnx_w = P.lnx_w; const float* lnx_b = P.lnx_b;
    const size_t rowb = (size_t)b * SEQ;
    const int tl = tid >> 4, cg = tid & 15;
    const int nt = wave & 3, rl = lane & 15, rg = lane >> 4;
    LAS float* rkv = (LAS float*)(lds + OFF_RKV); LAS float* vec = (LAS float*)(lds + OFF_VEC); LAS float* gbuf = (LAS float*)(lds + OFF_G);
    LAS float* ybuf = (LAS float*)(lds + OFF_Y); LAS float* nrm = (LAS float*)(lds + OFF_NRM); LAS float* scl = (LAS float*)(lds + OFF_SCL); LAS float* scp = (LAS float*)(lds + OFF_SCP);
    bf16x8 bfr[8];
    {
        const int col = h * 64 + 16 * nt + rl;
#pragma unroll
        for (int f = 0; f < 8; ++f) {
            const float* src = (f < 2) ? w2 : (f < 4) ? a2 : g2;
            const int kb = ((f < 4) ? 32 * (f & 1) : 32 * (f - 4)) + 8 * rg;
            float e[8];
#pragma unroll
            for (int j = 0; j < 8; ++j) e[j] = src[(size_t)(kb + j) * 512 + col];
            v4u p; p.x = pg8::cvt_pk_bf16(e[0], e[1]); p.y = pg8::cvt_pk_bf16(e[2], e[3]); p.z = pg8::cvt_pk_bf16(e[4], e[5]); p.w = pg8::cvt_pk_bf16(e[6], e[7]);
            bfr[f] = __builtin_bit_cast(bf16x8, p);
            __builtin_amdgcn_sched_barrier(0);
        }
    }
    const int mt = wave >> 2;
    const int hc = h * 64 + 16 * nt + rl;
    const float w0c = w0[hc], a0c = a0[hc], kkc = k_k[hc], kac = k_a[hc], rkc = r_k[hc];
    const int c4 = h * 64 + 4 * cg;
    f32x4 ST[4];
#pragma unroll
    for (int i = 0; i < 4; ++i) ST[i] = (f32x4){0.f, 0.f, 0.f, 0.f};
    LAS float* ctab = (LAS float*)(lds + OFF_CT);
    if (tl == 0) {
        LAS float* ct = ctab + cg * 36;
        *(LAS f32x4*)(ct + 0) = *(const f32x4*)(mu + C_R + c4); *(LAS f32x4*)(ct + 4) = *(const f32x4*)(mu + C_K + c4); *(LAS f32x4*)(ct + 8) = *(const f32x4*)(mu + C_V + c4);
        *(LAS f32x4*)(ct + 12) = *(const f32x4*)(mu + C_WL + 4 * cg); *(LAS f32x4*)(ct + 16) = *(const f32x4*)(mu + C_AL + 4 * cg);
        *(LAS f32x4*)(ct + 20) = *(const f32x4*)(mu + C_GL + 8 * cg); *(LAS f32x4*)(ct + 24) = *(const f32x4*)(mu + C_GL + 8 * cg + 4);
        *(LAS f32x4*)(ct + 28) = *(const f32x4*)(lnx_w + c4); *(LAS f32x4*)(ct + 32) = *(const f32x4*)(lnx_b + c4);
    }
    __syncthreads();
    const LAS float* myct = ctab + cg * 36;
    ZRow zc = ldrow(z + (rowb + tl) * NZ, c4, cg), zp;
    if (tl > 0) zp = ldrow(z + (rowb + tl - 1) * NZ, c4, cg); else { zp.r = zp.k = zp.v = zp.w = zp.a = (v2u){0u, 0u}; zp.g = (v4u){0u, 0u, 0u, 0u}; }
    for (int t0 = 0; t0 < SEQ; t0 += CH) {
        {
            const f32x4 cr = up4(zc.r), ck = up4(zc.k), cv = up4(zc.v), cw = up4(zc.w), ca = up4(zc.a);
            const f32x4 cg0 = (f32x4){pg8::bflo(zc.g.x), pg8::bfhi(zc.g.x), pg8::bflo(zc.g.y), pg8::bfhi(zc.g.y)}, cg1 = (f32x4){pg8::bflo(zc.g.z), pg8::bfhi(zc.g.z), pg8::bflo(zc.g.w), pg8::bfhi(zc.g.w)};
            const f32x4 pr = up4(zp.r), pk = up4(zp.k), pv = up4(zp.v), pw = up4(zp.w), pa = up4(zp.a);
            const f32x4 pg0 = (f32x4){pg8::bflo(zp.g.x), pg8::bfhi(zp.g.x), pg8::bflo(zp.g.y), pg8::bfhi(zp.g.y)}, pg1 = (f32x4){pg8::bflo(zp.g.z), pg8::bfhi(zp.g.z), pg8::bflo(zp.g.w), pg8::bfhi(zp.g.w)};
            if (t0 + CH < SEQ) { zc = ldrow(z + (rowb + t0 + CH + tl) * NZ, c4, cg); zp = ldrow(z + (rowb + t0 + CH + tl - 1) * NZ, c4, cg); }
            const f32x4 rs_ = cr + (pr - cr) * *(const LAS f32x4*)(myct + 0), ks_ = ck + (pk - ck) * *(const LAS f32x4*)(myct + 4), vs_ = cv + (pv - cv) * *(const LAS f32x4*)(myct + 8);
            const f32x4 ws_ = cw + (pw - cw) * *(const LAS f32x4*)(myct + 12), as_ = ca + (pa - ca) * *(const LAS f32x4*)(myct + 16);
            const f32x4 g0_ = cg0 + (pg0 - cg0) * *(const LAS f32x4*)(myct + 20), g1_ = cg1 + (pg1 - cg1) * *(const LAS f32x4*)(myct + 24);
            *(LAS f32x4*)(rkv + 0 * 2048 + tl * 64 + 4 * cg) = rs_; *(LAS f32x4*)(rkv + 1 * 2048 + tl * 64 + 4 * cg) = ks_; *(LAS f32x4*)(rkv + 2 * 2048 + tl * 64 + 4 * cg) = vs_;
            LAS unsigned char* ar = lds + OFF_ACT + tl * ACT_PITCH;
            v2u tw; tw.x = pg8::cvt_pk_bf16(ftanh(ws_[0]), ftanh(ws_[1])); tw.y = pg8::cvt_pk_bf16(ftanh(ws_[2]), ftanh(ws_[3]));
            *(LAS v2u*)(ar + 8 * cg) = tw;
            v2u aw; aw.x = pg8::cvt_pk_bf16(as_[0], as_[1]); aw.y = pg8::cvt_pk_bf16(as_[2], as_[3]);
            *(LAS v2u*)(ar + 128 + 8 * cg) = aw;
            v4u gw; gw.x = pg8::cvt_pk_bf16(fsig(g0_[0]), fsig(g0_[1])); gw.y = pg8::cvt_pk_bf16(fsig(g0_[2]), fsig(g0_[3]));
            gw.z = pg8::cvt_pk_bf16(fsig(g1_[0]), fsig(g1_[1])); gw.w = pg8::cvt_pk_bf16(fsig(g1_[2]), fsig(g1_[3]));
            *(LAS v4u*)(ar + 256 + 16 * cg) = gw;
        }
        __syncthreads();
        f32x4 accw = (f32x4){0.f, 0.f, 0.f, 0.f}, acca = accw, accg = accw;
        {
            const LAS unsigned char* ap = lds + OFF_ACT + (16 * mt + rl) * ACT_PITCH + 8 * rg * 2;
#pragma unroll
            for (int f = 0; f < 8; ++f) {
                const bf16x8 a = *(const LAS bf16x8*)(ap + f * 64);
                if (f < 2) accw = __builtin_amdgcn_mfma_f32_16x16x32_bf16(a, bfr[f], accw, 0, 0, 0);
                else if (f < 4) acca = __builtin_amdgcn_mfma_f32_16x16x32_bf16(a, bfr[f], acca, 0, 0, 0);
                else accg = __builtin_amdgcn_mfma_f32_16x16x32_bf16(a, bfr[f], accg, 0, 0, 0);
            }
        }
        float lw[4], av[4], kk[4];
        {
            const int c = 16 * nt + rl;
            float n2[4];
#pragma unroll
            for (int r = 0; r < 4; ++r) {
                const int tok = 16 * mt + 4 * rg + r;
                gbuf[tok * 64 + c] = accg[r];
                const float nx = -(w0c + accw[r]);
                const float sp = nx > 20.f ? nx : __logf(1.f + __expf(nx));
                lw[r] = -__expf(-sp - 0.5f);
                av[r] = fsig(a0c + acca[r]);
                kk[r] = rkv[1 * 2048 + tok * 64 + c] * kkc;
                n2[r] = kk[r] * kk[r];
            }
            row_allsum4(n2[0], n2[1], n2[2], n2[3]);
            if (rl == 0) {
#pragma unroll
                for (int r = 0; r < 4; ++r) nrm[(16 * mt + 4 * rg + r) * 4 + nt] = n2[r];
            }
        }
        __syncthreads();
        {
            const int c = 16 * nt + rl;
            const float p0 = lw[0], p1 = p0 + lw[1], p2 = p1 + lw[2], p3 = p2 + lw[3];
            const float t1 = __shfl(p3, (lane - 16) & 63), t2 = __shfl(p3, (lane - 32) & 63), t3 = __shfl(p3, (lane - 48) & 63);
            const float E = (rg >= 1 ? t1 : 0.f) + (rg >= 2 ? t2 : 0.f) + (rg >= 3 ? t3 : 0.f);
            const float Ltot = __shfl(E + p3, rl + 48);
            const float pin[4] = {p0, p1, p2, p3};
            float bt[4], kt[4];
#pragma unroll
            for (int r = 0; r < 4; ++r) {
                const int tok = 16 * mt + 4 * rg + r;
                const f32x4 n4 = *(const LAS f32x4*)(nrm + tok * 4);
                const float ksv = rkv[1 * 2048 + tok * 64 + c], rsv = rkv[0 * 2048 + tok * 64 + c];
                const float inv = fminf(__builtin_amdgcn_rsqf((n4[0] + n4[1]) + (n4[2] + n4[3])), 1e12f);
                const float kkn = kk[r] * inv, beta = kkn * av[r], kmod = ksv * (1.f + (av[r] - 1.f) * kac);
                const float L = E + pin[r], eL = __expf(L), ieL = __expf(-L), eLm = __expf(L - lw[r]), eT = __expf(Ltot - L);
                LAS unsigned char* hp = lds + OFF_HAT + tok * HAT_PITCH + c * 2;
                *(LAS bf16_t*)(hp) = f2bf(-kkn * eLm); *(LAS bf16_t*)(hp + HAT_SZ) = f2bf(beta * ieL); *(LAS bf16_t*)(hp + 2 * HAT_SZ) = f2bf(kmod * ieL); *(LAS bf16_t*)(hp + 3 * HAT_SZ) = f2bf(rsv * eL);
                bt[r] = beta * eT; kt[r] = kmod * eT;
                float pbr = beta * rsv, pkr = kmod * rsv, pbo = rsv * kmod * rkc, dum = 0.f;
                row_allsum4(pbr, pkr, pbo, dum);
                if (rl == 0) *(LAS f32x4*)(scp + (tok * 4 + nt) * 4) = (f32x4){pbr, pkr, pbo, 0.f};
            }
            LAS unsigned char* tp = lds + OFF_TIL + (2 * mt) * TIL_SZ + c * TIL_PITCH + 8 * rg;
            v2u w; w.x = pg8::cvt_pk_bf16(bt[0], bt[1]); w.y = pg8::cvt_pk_bf16(bt[2], bt[3]); *(LAS v2u*)(tp) = w;
            w.x = pg8::cvt_pk_bf16(kt[0], kt[1]); w.y = pg8::cvt_pk_bf16(kt[2], kt[3]); *(LAS v2u*)(tp + TIL_SZ) = w;
            if (rg == 0) ((LAS float*)(lds + OFF_WC))[mt * 64 + c] = __expf(Ltot);
        }
        __syncthreads();
        if (tid < CH) {
            const f32x4 p0 = *(const LAS f32x4*)(scp + tid * 16), p1 = *(const LAS f32x4*)(scp + tid * 16 + 4), p2 = *(const LAS f32x4*)(scp + tid * 16 + 8), p3 = *(const LAS f32x4*)(scp + tid * 16 + 12);
            *(LAS f32x4*)(scl + 4 * tid) = (p0 + p1) + (p2 + p3);
        }
        int lane_ = lane; asm volatile("" : "+v"(lane_));
        const int rl_ = lane_ & 15, rg_ = lane_ >> 4;
        {
            const int c = wave >> 2, g = wave & 3;
            const LAS unsigned char* pa = lds + OFF_HAT + ((g & 1) ? 2 : 1) * HAT_SZ + (16 * c + rl_) * HAT_PITCH + 16 * rg_;
            const LAS unsigned char* pb = lds + OFF_HAT + ((g < 2) ? 0 : 3) * HAT_SZ + (16 * c + rl_) * HAT_PITCH + 16 * rg_;
            f32x4 acc = (f32x4){0.f, 0.f, 0.f, 0.f};
            acc = __builtin_amdgcn_mfma_f32_16x16x32_bf16(*(const LAS bf16x8*)(pa), *(const LAS bf16x8*)(pb), acc, 0, 0, 0);
            acc = __builtin_amdgcn_mfma_f32_16x16x32_bf16(*(const LAS bf16x8*)(pa + 64), *(const LAS bf16x8*)(pb + 64), acc, 0, 0, 0);
#pragma unroll
            for (int e = 0; e < 4; ++e) { const int row = 4 * rg_ + e; const bool keep = (g < 2) ? (row < rl_) : (row <= rl_); if (!keep) acc[e] = 0.f; }
            *(LAS f32x4*)(lds + OFF_GR + (c * 5 + g) * 1024 + lane_ * 16) = acc;
            if (g == 0) {
                asm volatile("s_waitcnt lgkmcnt(0)" ::: "memory");
                if (lane_ < 16) {
                    const int sc = lane_;
                    const LAS float* tb = (const LAS float*)(lds + OFF_GR + (c * 5) * 1024);
                    float m[16], ps[16];
#pragma unroll
                    for (int r = 0; r < 16; ++r) ps[r] = 0.f;
#pragma unroll
                    for (int u = 15; u >= 0; --u) {
                        m[u] = (u == sc) ? 1.f : ((u < sc) ? ps[u] : 0.f);
#pragma unroll
                        for (int r = 0; r < u; ++r) ps[r] = __builtin_fmaf(tb[(u + 16 * (r >> 2)) * 4 + (r & 3)], m[u], ps[r]);
                    }
                    LAS f32x4* mt_ = (LAS f32x4*)(lds + OFF_GR + (c * 5 + 4) * 1024);
#pragma unroll
                    for (int q = 0; q < 4; ++q) mt_[sc + 16 * q] = (f32x4){m[4 * q], m[4 * q + 1], m[4 * q + 2], m[4 * q + 3]};
                }
            }
        }
        __syncthreads();
        if (wave < 4) {
            const int ib = wave;
#pragma unroll
            for (int c = 0; c < 2; ++c) {
                bf16x8 sb[2];
#pragma unroll
                for (int ks = 0; ks < 2; ++ks) {
                    v4u p; p.x = pg8::cvt_pk_bf16(ST[2 * ks][0], ST[2 * ks][1]); p.y = pg8::cvt_pk_bf16(ST[2 * ks][2], ST[2 * ks][3]);
                    p.z = pg8::cvt_pk_bf16(ST[2 * ks + 1][0], ST[2 * ks + 1][1]); p.w = pg8::cvt_pk_bf16(ST[2 * ks + 1][2], ST[2 * ks + 1][3]);
                    sb[ks] = __builtin_bit_cast(bf16x8, p);
                }
                const LAS unsigned char* ha = lds + OFF_HAT + (16 * c + rl_) * HAT_PITCH + 8 * rg_;
                f32x4 xt = (f32x4){0.f, 0.f, 0.f, 0.f}, yt = xt;
#pragma unroll
                for (int ks = 0; ks < 2; ++ks) {
                    v4u fa, fr; const v2u a0_ = *(const LAS v2u*)(ha + 64 * ks), a1_ = *(const LAS v2u*)(ha + 64 * ks + 32);
                    const v2u r0_ = *(const LAS v2u*)(ha + 3 * HAT_SZ + 64 * ks), r1_ = *(const LAS v2u*)(ha + 3 * HAT_SZ + 64 * ks + 32);
                    fa.x = a0_.x; fa.y = a0_.y; fa.z = a1_.x; fa.w = a1_.y; fr.x = r0_.x; fr.y = r0_.y; fr.z = r1_.x; fr.w = r1_.y;
                    xt = __builtin_amdgcn_mfma_f32_16x16x32_bf16(__builtin_bit_cast(bf16x8, fa), sb[ks], xt, 0, 0, 0);
                    yt = __builtin_amdgcn_mfma_f32_16x16x32_bf16(__builtin_bit_cast(bf16x8, fr), sb[ks], yt, 0, 0, 0);
                }
                const LAS float* vsrc = rkv + 2 * 2048 + (16 * c + 4 * rg_) * 64 + 16 * ib + rl_;
                v2u vb_; vb_.x = pg8::cvt_pk_bf16(vsrc[0], vsrc[64]); vb_.y = pg8::cvt_pk_bf16(vsrc[128], vsrc[192]);
                const s16x4 vb = __builtin_bit_cast(s16x4, vb_);
                const LAS unsigned char* gr = lds + OFF_GR + (c * 5) * 1024 + lane_ * 16;
#define RW_AFR(g_) ({ const f32x4 t_ = *(const LAS f32x4*)(gr + (g_) * 1024); v2u w_; w_.x = pg8::cvt_pk_bf16(t_[0], t_[1]); w_.y = pg8::cvt_pk_bf16(t_[2], t_[3]); __builtin_bit_cast(s16x4, w_); })
#define RW_PK4(x_) ({ v2u w_; w_.x = pg8::cvt_pk_bf16((x_)[0], (x_)[1]); w_.y = pg8::cvt_pk_bf16((x_)[2], (x_)[3]); __builtin_bit_cast(s16x4, w_); })
                const f32x4 zt = __builtin_amdgcn_mfma_f32_16x16x16bf16_1k(RW_AFR(1), vb, xt, 0, 0, 0);
                const f32x4 ut = __builtin_amdgcn_mfma_f32_16x16x16bf16_1k(RW_AFR(4), RW_PK4(zt), (f32x4){0.f, 0.f, 0.f, 0.f}, 0, 0, 0);
                const s16x4 ub = RW_PK4(ut);
                yt = __builtin_amdgcn_mfma_f32_16x16x16bf16_1k(RW_AFR(2), ub, yt, 0, 0, 0);
                yt = __builtin_amdgcn_mfma_f32_16x16x16bf16_1k(RW_AFR(3), vb, yt, 0, 0, 0);
#pragma unroll
                for (int e = 0; e < 4; ++e) ybuf[(16 * c + 4 * rg_ + e) * 64 + 16 * ib + rl_] = yt[e];
                const LAS unsigned char* tl_ = lds + OFF_TIL + (2 * c) * TIL_SZ + rl_ * TIL_PITCH + 8 * rg_;
                const LAS float* wc = (const LAS float*)(lds + OFF_WC) + c * 64 + 4 * rg_;
#pragma unroll
                for (int jt = 0; jt < 4; ++jt) {
                    f32x4 acc = ST[jt] * *(const LAS f32x4*)(wc + 16 * jt);
                    acc = __builtin_amdgcn_mfma_f32_16x16x16bf16_1k(*(const LAS s16x4*)(tl_ + TIL_SZ + 16 * jt * TIL_PITCH), vb, acc, 0, 0, 0);
                    acc = __builtin_amdgcn_mfma_f32_16x16x16bf16_1k(*(const LAS s16x4*)(tl_ + 16 * jt * TIL_PITCH), ub, acc, 0, 0, 0);
                    ST[jt] = acc;
                }
#undef RW_AFR
#undef RW_PK4
            }
        }
        __syncthreads();
        {
            const f32x4 y4 = *(const LAS f32x4*)(ybuf + tl * 64 + 4 * cg);
            const float mean = row_allsum((y4[0] + y4[1]) + (y4[2] + y4[3])) * (1.f / 64.f);
            const f32x4 dv = y4 - mean;
            const float var = row_allsum((dv[0] * dv[0] + dv[1] * dv[1]) + (dv[2] * dv[2] + dv[3] * dv[3])) * (1.f / 64.f);
            const float rs_ = rsqrtf(var + GN_EPS);
            const f32x4 yn = dv * rs_ * *(const LAS f32x4*)(myct + 28) + *(const LAS f32x4*)(myct + 32);
            const float bonus = scl[tl * 4 + 2];
            const f32x4 vs_ = *(const LAS f32x4*)(rkv + 2 * 2048 + tl * 64 + 4 * cg), g4 = *(const LAS f32x4*)(gbuf + tl * 64 + 4 * cg);
            const f32x4 o = (yn + vs_ * bonus) * g4;
            v2u w; w.x = pg8::cvt_pk_bf16(o[0], o[1]); w.y = pg8::cvt_pk_bf16(o[2], o[3]);
            *(v2u*)(ya + (rowb + t0 + tl) * 512 + c4) = w;
        }
        __syncthreads();
    }
}
}

typedef __bf16 bf16x2_t __attribute__((ext_vector_type(2)));
__device__ __forceinline__ float dot2bf(unsigned a, unsigned b, float c) { return __builtin_amdgcn_fdot2_f32_bf16(__builtin_bit_cast(bf16x2_t, a), __builtin_bit_cast(bf16x2_t, b), c, false); }
__device__ __forceinline__ unsigned f2ord(float f) { const unsigned u = __float_as_uint(f); return (u & 0x80000000u) ? ~u : (u | 0x80000000u); }
__device__ __forceinline__ float ord2f(unsigned o) { return __uint_as_float((o & 0x80000000u) ? (o ^ 0x80000000u) : ~o); }
__device__ __forceinline__ unsigned row_allmax_u32(unsigned v) {
    v = max(v, (unsigned)__builtin_amdgcn_update_dpp(0, (int)v, 0x128, 0xf, 0xf, false));
    v = max(v, (unsigned)__builtin_amdgcn_update_dpp(0, (int)v, 0x124, 0xf, 0xf, false));
    v = max(v, (unsigned)__builtin_amdgcn_update_dpp(0, (int)v, 0x122, 0xf, 0xf, false));
    v = max(v, (unsigned)__builtin_amdgcn_update_dpp(0, (int)v, 0x121, 0xf, 0xf, false));
    return v;
}

constexpr int TK_PITCH = 272, TK_HALF = 128 * TK_PITCH;
typedef short tk_bf16x8 __attribute__((ext_vector_type(8)));
__device__ __forceinline__ void topk_loadq(tk_bf16x8 (&qa)[8], const bf16_t* __restrict__ qb, int t0, int h, int lane) {
    const bf16_t* qp = qb + (size_t)(t0 + (lane & 15)) * 2048 + h * 256 + 8 * (lane >> 4);
#pragma unroll
    for (int i = 0; i < 8; ++i) qa[i] = *(const tk_bf16x8*)(qp + i * 32);
}
__device__ __forceinline__ void topk_item(const tk_bf16x8 (&qa)[8], const LAS unsigned char* klds, int* __restrict__ ids, float* __restrict__ gates, int t0, int h, int lane) {
    const int rl = lane & 15, rg = lane >> 4;
    unsigned top[2][4];
#pragma unroll
    for (int c = 0; c < 2; ++c) {
        f32x4 acc[8];
#pragma unroll
        for (int nt = 0; nt < 8; ++nt) acc[nt] = (f32x4){64.f, 64.f, 64.f, 64.f};
        const LAS unsigned char* kp = klds + c * TK_HALF + rl * TK_PITCH + 16 * rg;
#pragma unroll
        for (int ks = 0; ks < 4; ++ks) {
#pragma unroll
            for (int nt = 0; nt < 8; ++nt) { const tk_bf16x8 b = *(const LAS tk_bf16x8*)(kp + nt * 16 * TK_PITCH + ks * 64); acc[nt] = __builtin_amdgcn_mfma_f32_16x16x32_bf16(qa[c * 4 + ks], b, acc[nt], 0, 0, 0); }
            __builtin_amdgcn_sched_barrier(0);
        }
        unsigned k[4][8];
#pragma unroll
        for (int r = 0; r < 4; ++r) {
#pragma unroll
            for (int nt = 0; nt < 8; ++nt) k[r][nt] = (__float_as_uint(fmaxf(acc[nt][r], 1.f)) & ~127u) | (unsigned)(127 - (nt * 16 + rl));
#define TK_CE(i, j) do { const unsigned a_ = max(k[r][i], k[r][j]), b_ = min(k[r][i], k[r][j]); k[r][i] = a_; k[r][j] = b_; } while (0)
            TK_CE(0, 1); TK_CE(2, 3); TK_CE(4, 5); TK_CE(6, 7); TK_CE(0, 2); TK_CE(1, 3); TK_CE(4, 6); TK_CE(5, 7); TK_CE(1, 2); TK_CE(5, 6);
            TK_CE(0, 4); TK_CE(1, 5); TK_CE(2, 6); TK_CE(3, 7); TK_CE(2, 4); TK_CE(3, 5); TK_CE(1, 2); TK_CE(3, 4); TK_CE(5, 6);
#undef TK_CE
        }
        unsigned tp[4] = {0u, 0u, 0u, 0u};
        for (int round = 0; round < 16; ++round) {
#pragma unroll
            for (int r = 0; r < 4; ++r) {
                const unsigned m = row_allmax_u32(k[r][0]);
                tp[r] = (rl == round) ? m : tp[r];
                const bool win = (k[r][0] == m);
                k[r][0] = win ? k[r][1] : k[r][0]; k[r][1] = win ? k[r][2] : k[r][1]; k[r][2] = win ? k[r][3] : k[r][2]; k[r][3] = win ? k[r][4] : k[r][3];
                k[r][4] = win ? k[r][5] : k[r][4]; k[r][5] = win ? k[r][6] : k[r][5]; k[r][6] = win ? k[r][7] : k[r][6]; k[r][7] = win ? 0u : k[r][7];
            }
        }
#pragma unroll
        for (int r = 0; r < 4; ++r) top[c][r] = tp[r];
    }
    const int rowbase = lane & 48;
    float v1[4]; int n1[4], ptr[4], myid[4]; unsigned k2[4], myv[4];
#pragma unroll
    for (int r = 0; r < 4; ++r) { v1[r] = __uint_as_float(top[0][r] & ~127u); n1[r] = 127 - (int)(top[0][r] & 127u); ptr[r] = 0; k2[r] = (unsigned)__builtin_amdgcn_ds_bpermute(rowbase * 4, (int)top[1][r]); myid[r] = 0; myv[r] = 0u; }
    for (int round = 0; round < 16; ++round) {
#pragma unroll
        for (int r = 0; r < 4; ++r) {
            const float head = v1[r] + __uint_as_float(k2[r] & ~127u);
            const unsigned key = (ptr[r] < 16) ? ((__float_as_uint(head) & ~15u) | (unsigned)(15 - rl)) : 0u;
            const unsigned m = row_allmax_u32(key);
            const bool win = (key == m);
            const unsigned wid = row_allmax_u32(win ? (unsigned)(n1[r] * 128 + (127 - (int)(k2[r] & 127u))) + 1u : 0u);
            myid[r] = (rl == round) ? (int)wid - 1 : myid[r];
            myv[r] = (rl == round) ? m : myv[r];
            ptr[r] += win ? 1 : 0;
            k2[r] = (unsigned)__builtin_amdgcn_ds_bpermute((rowbase + (ptr[r] & 15)) * 4, (int)top[1][r]);
        }
    }
#pragma unroll
    for (int r = 0; r < 4; ++r) {
        const float val = __uint_as_float(myv[r] & ~15u);
        const float vmax = __uint_as_float((unsigned)__builtin_amdgcn_ds_bpermute(rowbase * 4, (int)__float_as_uint(val)));
        const float e = __expf(val - vmax);
        const float sum = rw::row_allsum(e);
        gates[(size_t)(t0 + 4 * rg + r) * 128 + h * 16 + rl] = e * __builtin_amdgcn_rcpf(sum); ids[(size_t)(t0 + 4 * rg + r) * 128 + h * 16 + rl] = myid[r];
    }
}

typedef float f32x2 __attribute__((ext_vector_type(2)));
__device__ __forceinline__ void peer_token(const bf16_t* __restrict__ x2b, const float* __restrict__ ssq2, const int* __restrict__ ids, const float* __restrict__ gates,
                                           const unsigned char* __restrict__ U8, const unsigned char* __restrict__ V8, const float* __restrict__ usc, const float* __restrict__ vsc,
                                           const float* __restrict__ fw, float* __restrict__ out, int t, int lane) {
    const int l16 = lane * 16;
    f32x2 hx[8];
    {
        const v4u h0 = *(const v4u*)(x2b + (size_t)t * DM + l16), h1 = *(const v4u*)(x2b + (size_t)t * DM + l16 + 8);
        const unsigned hw[8] = {h0.x, h0.y, h0.z, h0.w, h1.x, h1.y, h1.z, h1.w};
#pragma unroll
        for (int i = 0; i < 8; ++i) hx[i] = (f32x2){pg8::bflo(hw[i]), pg8::bfhi(hw[i])};
    }
    const int idA = ids[(size_t)t * 128 + lane], idB = ids[(size_t)t * 128 + 64 + lane];
    const float rs = rsqrtf(pg8::ssq_sum16(ssq2 + (size_t)t * 16) * (1.f / DM) + NORM_EPS);
    const float suA = rs * usc[idA], suB = rs * usc[idB];
    const float svA = gates[(size_t)t * 128 + lane] * vsc[idA], svB = gates[(size_t)t * 128 + 64 + lane] * vsc[idB];
    f32x2 y[8];
#pragma unroll
    for (int i = 0; i < 8; ++i) y[i] = (f32x2){0.f, 0.f};
    const int bit0 = lane & 1, bit1 = (lane >> 1) & 1, bit5 = lane >> 5;
    v3u_t uw[8], vw[8];
    const unsigned vo12 = (unsigned)lane * 12u;
#define PEER_LDU(g_) do { const int is_ = ((g_) < 8) ? idA : idB; const int lb_ = ((g_) * 8) & 63; _Pragma("unroll") for (int k = 0; k < 8; ++k) { const unsigned eo = (unsigned)__builtin_amdgcn_readlane(is_, lb_ + k) * 768u; \
        const unsigned char* rp_ = U8 + eo; uw[k] = *(const v3u_t*)(rp_ + vo12); } } while (0)
#define PEER_LDV(g_) do { const int is_ = ((g_) < 8) ? idA : idB; const int lb_ = ((g_) * 8) & 63; _Pragma("unroll") for (int k = 0; k < 8; ++k) { const unsigned eo = (unsigned)__builtin_amdgcn_readlane(is_, lb_ + k) * 768u; \
        const unsigned char* rp_ = V8 + eo; vw[k] = *(const v3u_t*)(rp_ + vo12); } } while (0)
    PEER_LDU(0); PEER_LDV(0);
    for (int g = 0; g < 16; ++g) {
        const float susel = (g < 8) ? suA : suB, svsel = (g < 8) ? svA : svB; const int lb = (g * 8) & 63;
        float d[8];
#pragma unroll
        for (int k = 0; k < 8; k += 2) {
            const v32f_t f = __builtin_amdgcn_cvt_scalef32_pk32_f32_fp6((v6u_t){uw[k][0], uw[k][1], uw[k][2], uw[k + 1][0], uw[k + 1][1], uw[k + 1][2]}, 1.0f);
            f32x2 a = (f32x2){0.f, 0.f}, b = a;
#pragma unroll
            for (int i = 0; i < 8; ++i) { a += (f32x2){f[2 * i], f[2 * i + 1]} * hx[i]; b += (f32x2){f[16 + 2 * i], f[17 + 2 * i]} * hx[i]; }
            d[k] = a[0] + a[1]; d[k + 1] = b[0] + b[1];
            __builtin_amdgcn_sched_barrier(0);
        }
        if (g + 1 < 16) PEER_LDU(g + 1);
        __builtin_amdgcn_sched_barrier(0);
#pragma unroll
        for (int k = 0; k < 8; ++k) d[k] *= __uint_as_float((unsigned)__builtin_amdgcn_readlane((int)__float_as_uint(susel), lb + k));
        float r4[4];
#pragma unroll
        for (int k = 0; k < 4; ++k) { const float send = bit0 ? d[k] : d[k + 4], keep = bit0 ? d[k + 4] : d[k]; r4[k] = keep + rw::dppf<0xB1>(send); }
        float r2[2];
#pragma unroll
        for (int k = 0; k < 2; ++k) { const float send = bit1 ? r4[k] : r4[k + 2], keep = bit1 ? r4[k + 2] : r4[k]; r2[k] = keep + rw::dppf<0x4E>(send); }
        float r1;
        { const float send = bit5 ? r2[0] : r2[1], keep = bit5 ? r2[1] : r2[0];
          auto rr = __builtin_amdgcn_permlane32_swap(__float_as_uint(send), __float_as_uint(send), false, false);
          r1 = keep + __uint_as_float(bit5 ? rr[0] : rr[1]); }
        r1 += rw::dppf<0x128>(r1); r1 += rw::dppf<0x124>(r1);
        r1 += __uint_as_float((unsigned)__builtin_amdgcn_ds_swizzle((int)__float_as_uint(r1), 0x401F));
        const float dd = r1;
        const float act = 0.5f * dd * (1.f + erff(dd * 0.70710678118654752f));
#pragma unroll
        for (int k = 0; k < 8; k += 2) {
#define PEER_LANE_OF(k_) ((((k_) >> 2) & 1) | ((((k_) >> 1) & 1) << 1) | (((k_) & 1) << 5))
            const float a = __uint_as_float((unsigned)__builtin_amdgcn_readlane((int)__float_as_uint(act), PEER_LANE_OF(k))) * __uint_as_float((unsigned)__builtin_amdgcn_readlane((int)__float_as_uint(svsel), lb + k));
            const float b = __uint_as_float((unsigned)__builtin_amdgcn_readlane((int)__float_as_uint(act), PEER_LANE_OF(k + 1))) * __uint_as_float((unsigned)__builtin_amdgcn_readlane((int)__float_as_uint(svsel), lb + k + 1));
#undef PEER_LANE_OF
            const f32x2 a2 = (f32x2){a, a}, b2 = (f32x2){b, b};
            const v32f_t f = __builtin_amdgcn_cvt_scalef32_pk32_f32_fp6((v6u_t){vw[k][0], vw[k][1], vw[k][2], vw[k + 1][0], vw[k + 1][1], vw[k + 1][2]}, 1.0f);
#pragma unroll
            for (int i = 0; i < 8; ++i) { y[i] += (f32x2){f[2 * i], f[2 * i + 1]} * a2; y[i] += (f32x2){f[16 + 2 * i], f[17 + 2 * i]} * b2; }
            __builtin_amdgcn_sched_barrier(0);
        }
        if (g + 1 < 16) PEER_LDV(g + 1);
        __builtin_amdgcn_sched_barrier(0);
    }
#undef PEER_LDU
#undef PEER_LDV
    float* orow = out + (size_t)t * DM + l16;
    float ss = 0.f;
    f32x4 o4[4];
#pragma unroll
    for (int i = 0; i < 4; ++i) { o4[i] = (f32x4){hx[2 * i][0] + y[2 * i][0], hx[2 * i][1] + y[2 * i][1], hx[2 * i + 1][0] + y[2 * i + 1][0], hx[2 * i + 1][1] + y[2 * i + 1][1]};
        ss += (o4[i][0] * o4[i][0] + o4[i][1] * o4[i][1]) + (o4[i][2] * o4[i][2] + o4[i][3] * o4[i][3]); }
    ss = wave_sum(ss);
    const float r = rsqrtf(ss * (1.f / DM) + NORM_EPS);
#pragma unroll
    for (int i = 0; i < 4; ++i) *(f32x4*)(orow + 4 * i) = o4[i] * r * *(const f32x4*)(fw + l16 + 4 * i);
}

__global__ void __launch_bounds__(NWAVES * 64, 2) mk_fwd(Args args) {
    extern __shared__ __attribute__((aligned(16))) unsigned char lds_raw[];
    LAS unsigned char* lds = (LAS unsigned char*)lds_raw;
    volatile LAS unsigned* MISC = (volatile LAS unsigned*)(lds + MISC_OFF);
    const int tid = threadIdx.x, lane = tid & 63, wave = __builtin_amdgcn_readfirstlane(tid >> 6);
    const int G = gridDim.x; const int bx = blockIdx.x; const int vcu = (G % 8 == 0) ? (bx % 8) * (G / 8) + bx / 8 : bx;
    unsigned char* ws = args.ws;
    unsigned* ctl = (unsigned*)(ws + WS_CTL);
    for (int u = tid; u < (LDS_BYTES - LDSCTL_OFF) / 4; u += NWAVES * 64) ((LAS unsigned*)(lds + LDSCTL_OFF))[u] = 0u;
    __syncthreads();
    XcdBarrier bar = xcd_barrier_post(ctl + CW_BAR + args.li * XCD_BAR_WORDS, MISC + 8);
    const int lo = args.ph_lo, hi = args.ph_hi;
#define IN(k) (lo <= (k) && (k) < hi)
#define BOTH(k) (IN(k) && IN((k) + 1))
    bf16_t* WinT = (bf16_t*)(ws + WS_WIN); bf16_t* PaT = (bf16_t*)(ws + WS_PA); bf16_t* PbT = (bf16_t*)(ws + WS_PB); bf16_t* WoT = (bf16_t*)(ws + WS_WO);
    bf16_t* WqT = (bf16_t*)(ws + WS_WQ); bf16_t* KeysB = (bf16_t*)(ws + WS_KEYS);
    float* rstd1 = (float*)(ws + WS_RSTD1); float* ssq2 = (float*)(ws + WS_RSTD2); float* scal = (float*)(ws + WS_SCAL);
    unsigned char* U8 = ws + WS_U; unsigned char* V8 = ws + WS_V; float* usc = (float*)(ws + WS_USC); float* vsc = (float*)(ws + WS_VSC);
    bf16_t* xb = (bf16_t*)(ws + WS_XB); bf16_t* ya = (bf16_t*)(ws + WS_YA); bf16_t* yb = (bf16_t*)(ws + WS_YB); bf16_t* x2b = (bf16_t*)(ws + WS_X2B);
    bf16_t* z = (bf16_t*)(ws + WS_Z); bf16_t* qb = (bf16_t*)(ws + WS_Q);
    bf16_t* merged = (bf16_t*)(ws + WS_MERGED);
    const int gw = vcu * NWAVES + wave, NGW = G * NWAVES;

    if (IN(0)) {
        LAS float* scr = (LAS float*)(lds + wave * 16384);
        constexpr int I_IN = (DM / 64) * (NZ / 32), I_PA = (512 / 64) * (DM / 32), I_WO = (DM / 64) * (DM / 32), I_WQ = (DM / 64) * (2048 / 32);
        constexpr int NITEMS = I_IN + 2 * I_PA + I_WO + I_WQ;
        for (int it = gw; it < NITEMS; it += NGW) {
            int r = it;
            if (r < I_IN) { p0_transpose_item(args.in[2], args.in[1], DM, NZ, WinT, scr, r, lane); continue; } r -= I_IN;
            if (r < I_PA) { p0_transpose_item(args.in[19], nullptr, 512, DM, PaT, scr, r, lane); continue; } r -= I_PA;
            if (r < I_PA) { p0_transpose_item(args.in[20], nullptr, 512, DM, PbT, scr, r, lane); continue; } r -= I_PA;
            if (r < I_WO) { p0_transpose_item(args.in[21], nullptr, DM, DM, WoT, scr, r, lane); continue; } r -= I_WO;
            p0_transpose_item(args.in[23], args.in[22], DM, 2048, WqT, scr, r, lane);
        }
        p0_convert(args.in[24], nullptr, KeysB, (size_t)16 * 128 * 128, gw, NGW, lane);
        for (int e = gw; e < 2 * NEXP; e += NGW) {
            const bool isu = e < NEXP; const int row = isu ? e : e - NEXP;
            p0_row_fp6((isu ? args.in[25] : args.in[26]) + (size_t)row * DM, isu ? args.in[22] : nullptr, (isu ? U8 : V8) + (size_t)row * 768, (isu ? usc : vsc) + row, lane);
        }
        for (int m = gw; m < T_TOK; m += NGW) {
            const f32x4* xr = (const f32x4*)(args.in[0] + (size_t)m * DM) + lane;
            f32x4 v[4]; float s = 0.f;
#pragma unroll
            for (int j = 0; j < 4; ++j) { v[j] = xr[64 * j]; s += (v[j][0] * v[j][0] + v[j][1] * v[j][1]) + (v[j][2] * v[j][2] + v[j][3] * v[j][3]); }
            s = wave_sum(s);
            v2u* o8 = (v2u*)(xb + (size_t)m * DM) + lane;
#pragma unroll
            for (int j = 0; j < 4; ++j) { v2u w; w.x = pg8::cvt_pk_bf16(v[j][0], v[j][1]); w.y = pg8::cvt_pk_bf16(v[j][2], v[j][3]); o8[64 * j] = w; }
            if (lane == 0) rstd1[m] = rsqrtf(s * (1.f / DM) + NORM_EPS);
        }
        if (gw == 0) {
            const float a = wave_sum(args.in[14][lane] * args.in[15][lane]), b = wave_sum(args.in[16][lane] * args.in[17][lane]);
            if (lane == 0) scal[0] = __expf(a) - __expf(b) + LAM_INIT;
        }
        if (BOTH(0)) xcd_barrier(bar);
    }
    if (IN(1)) {
        pg8::Gemm g{xb, WinT, DM, DM, DM}; pg8::StaticOrder S; S.init(T_TOK, NZ, G, bx);
        pg8::EpiRowScale<false> E{z, NZ, rstd1};
        for (int rep = 0; rep < REPS(1); ++rep) pg8::gemm_phase(lds, g, S, E);
        if (BOTH(1)) xcd_barrier(bar);
    }
    if (IN(2)) {
        {
            const rw::ScanP P{args.in[3], args.in[4], args.in[5], args.in[6], args.in[7], args.in[8], args.in[9], args.in[10], args.in[11], args.in[12], args.in[13]};
            for (int rep = 0; rep < REPS(2); ++rep) for (int u = vcu; u < NB * 8; u += G) rw::scan_unit(lds, z, ya, P, u >> 3, u & 7, tid, wave, lane);
        }
        const float lam = scal[0];
        __syncthreads();
        for (int i = 0;; ++i) {
            int idx = vcu + i * G; if (idx >= 2048 * REPS(10)) break;
            idx &= 2047;
            const int slot = idx >> 8, v = idx & 255, bh = v >> 1, a = (v & 1) * 4 + (slot >> 1), qblk = (slot & 1) ? 15 - a : a;
            da::attn_unit(lds, z, yb, args.in[18], lam, bh >> 2, bh & 3, qblk, wave, lane);
        }
        if (BOTH(2)) xcd_barrier(bar);
    }
    if (IN(3)) {
        pg8::Gemm g{ya, PaT, 512, 512, 512}; pg8::StaticOrder S; S.init(T_TOK, DM, G, bx);
        pg8::EpiGate<false> E{merged, z, C_GA};
        pg8::gemm_phase(lds, g, S, E);
        if (BOTH(3)) xcd_barrier(bar);
    }
    if (IN(4)) {
        pg8::Gemm g{yb, PbT, 512, 512, 512}; pg8::StaticOrder S; S.init(T_TOK, DM, G, bx);
        pg8::EpiGate<true> E{merged, z, C_GB};
        pg8::gemm_phase(lds, g, S, E);
        if (BOTH(4)) xcd_barrier(bar);
    }
    if (IN(5)) {
        pg8::Gemm g{merged, WoT, DM, DM, DM}; pg8::StaticOrder S; S.init(T_TOK, DM, G, bx);
        pg8::EpiX2 E{args.in[0], args.out, x2b, ssq2};
        pg8::gemm_phase(lds, g, S, E);
        if (BOTH(5)) xcd_barrier(bar);
    }
    if (IN(6)) {
        pg8::Gemm g{x2b, WqT, DM, DM, DM}; pg8::StaticOrder S; S.init(T_TOK, 2048, G, bx);
        pg8::EpiRowScale<true> E{qb, 2048, ssq2};
        for (int rep = 0; rep < REPS(6); ++rep) pg8::gemm_phase(lds, g, S, E);
        if (BOTH(6)) xcd_barrier(bar);
    }
    if (IN(7)) {
        int* ids = (int*)(ws + WS_IDS); float* gates = (float*)(ws + WS_GATES);
        for (int rep = 0; rep < REPS(7); ++rep)
        for (int h = 0; h < 8; ++h) {
            __syncthreads();
            {
                const bf16_t* ksrc = KeysB + (size_t)h * 2 * 128 * 128;
#pragma unroll
                for (int i = 0; i < 8; ++i) { const int chunk = tid + i * 512, row = chunk >> 4, cc = chunk & 15;
                    *(LAS v4u*)(lds + (row >> 7) * TK_HALF + (row & 127) * TK_PITCH + cc * 16) = *(const v4u*)(ksrc + (size_t)row * 128 + cc * 8); }
            }
            __syncthreads();
            for (int tile = gw; tile < 4096; tile += NGW) {
                tk_bf16x8 qa[8];
                topk_loadq(qa, qb, tile * 16, h, lane);
                topk_item(qa, lds, ids, gates, tile * 16, h, lane);
            }
        }
        if (BOTH(7)) xcd_barrier(bar);
    }
    if (IN(8)) {
        const int* ids = (const int*)(ws + WS_IDS); const float* gates = (const float*)(ws + WS_GATES);
        for (int t = gw; t < T_TOK; t += NGW) peer_token(x2b, ssq2, ids, gates, U8, V8, usc, vsc, args.in[27], args.out, t, lane);
    }
#undef IN
#undef BOTH
}

extern "C" void kernel_launch(void* const* d_in, const int* in_sizes, int n_in, void* d_out, int out_size, void* d_ws, size_t ws_size, hipStream_t stream) {
    static int grid = 0;
    if (grid == 0) {
        if (n_in != 28 || in_sizes[0] != T_TOK * DM || out_size != T_TOK * DM || ws_size < WS_END) {
            fprintf(stderr, "kernel_launch: unexpected shapes / workspace (n_in %d, ws %zu < %zu)\n", n_in, ws_size, (size_t)WS_END); grid = -1; return; }
        int dev = 0, cus = 0;
        if (hipGetDevice(&dev) != hipSuccess || hipDeviceGetAttribute(&cus, hipDeviceAttributeMultiprocessorCount, dev) != hipSuccess) { grid = -1; return; }
        if (hipFuncSetAttribute((const void*)mk_fwd, hipFuncAttributeMaxDynamicSharedMemorySize, LDS_BYTES) != hipSuccess) { fprintf(stderr, "kernel_launch: hipFuncSetAttribute failed\n"); grid = -1; return; }
        grid = cus;
    }
    if (grid < 0) return;
    unsigned char* ws = (unsigned char*)d_ws;
    float* out = (float*)d_out;
    (void)hipMemsetAsync(ws + WS_CTL, 0, 1 * MiB, stream);
    Args a{};
    for (int i = 0; i < 28; ++i) a.in[i] = (const float*)d_in[i];
    a.out = out; a.ws = ws;
    a.ph_lo = 0; a.ph_hi = 9; a.li = 0;
    hipLaunchKernelGGL(mk_fwd, dim3(grid), dim3(NWAVES * 64), LDS_BYTES, stream, a);
}
```

```cpp
#include <hip/hip_runtime.h>
#include <stdint.h>
#include <cstdio>

typedef unsigned short bf16_t;
typedef unsigned int u32;

#ifndef PROBE_REP
#define PROBE_REP 0
#endif
#define REPS(k) (((PROBE_REP >> (k)) & 1) ? 2 : 1)
constexpr int T_TOK = 65536, DM = 1024, SEQ = 2048, NB = 32;
constexpr int NZ = 5376;
constexpr int C_R = 0, C_K = 512, C_V = 1024, C_WL = 1536, C_AL = 1600, C_GL = 1664, C_Q = 1792, C_ZK = 2304, C_ZV = 2816, C_GA = 3328, C_GB = 4352;
constexpr int NEXP = 16384;
constexpr float NORM_EPS = 1e-6f, GN_EPS = 64e-5f, SUBLN_EPS = 1e-5f;
constexpr float LAM_INIT = 0.2f;

constexpr size_t MiB = 1u << 20;
constexpr size_t WS_CTL = 0;
constexpr size_t WS_WIN = 1 * MiB;
constexpr size_t WS_PA = 12 * MiB;
constexpr size_t WS_PB = 13 * MiB;
constexpr size_t WS_WO = 14 * MiB;
constexpr size_t WS_WQ = 16 * MiB;
constexpr size_t WS_KEYS = 20 * MiB;
constexpr size_t WS_RSTD1 = 21 * MiB;
constexpr size_t WS_RSTD2 = 58 * MiB;
constexpr size_t WS_SCAL = 23 * MiB;
constexpr size_t WS_U = 24 * MiB;
constexpr size_t WS_V = 40 * MiB;
constexpr size_t WS_USC = 56 * MiB;
constexpr size_t WS_VSC = 57 * MiB;
constexpr size_t WS_XB = 88 * MiB;
constexpr size_t WS_YA = WS_XB;
constexpr size_t WS_YB = WS_XB + 64 * MiB;
constexpr size_t WS_X2B = WS_XB;
constexpr size_t WS_Z = 216 * MiB;
constexpr size_t WS_Q = WS_Z;
constexpr size_t WS_IDS = WS_Z + 256 * MiB;
constexpr size_t WS_GATES = WS_Z + 288 * MiB;
constexpr size_t WS_MERGED = 888 * MiB;
constexpr size_t WS_XQ = WS_MERGED;
constexpr size_t WS_WG8 = WS_MERGED + 64 * MiB;
constexpr size_t WS_END = 1016 * MiB;

__device__ __forceinline__ float bf2f(bf16_t h) { return __uint_as_float(((u32)h) << 16); }
__device__ __forceinline__ bf16_t f2bf(float f) { u32 u = __float_as_uint(f); u += 0x7fffu + ((u >> 16) & 1u); return (bf16_t)(u >> 16); }
__device__ __forceinline__ float wave_sum(float v) {
#pragma unroll
    for (int o = 1; o < 64; o <<= 1) v += __shfl_xor(v, o);
    return v;
}
__device__ __forceinline__ float sigmoidf_(float x) { return __builtin_amdgcn_rcpf(1.f + __expf(-x)); }

namespace pg8 {
#define PG8_LAS __attribute__((address_space(3)))
typedef short bf16x8 __attribute__((ext_vector_type(8)));
typedef float f32x4 __attribute__((ext_vector_type(4)));
typedef unsigned u32x4 __attribute__((ext_vector_type(4)));
constexpr int BM = 256, BK = 64, HALF = 128, HTB = HALF * BK * 2  , STAGE_BYTES = 8 * HTB, NXCD = 8, WGM = 8;

__host__ __device__ __forceinline__ int lds_byte(int r, int c) { const int st = (r >> 4) * 2 + (c >> 5), rr = r & 15, cc = c & 31, ob = rr * 64 + cc * 2; return st * 1024 + (ob ^ (((ob >> 9) & 1) << 5)); }
__host__ __device__ __forceinline__ void stage_rc(int b, int& R, int& C) { const int st = b / 1024, sb = b % 1024, swz = sb ^ (((sb >> 9) & 1) << 5); R = (st >> 1) * 16 + swz / 64; C = (st & 1) * 32 + (swz % 64) / 2; }
__host__ __device__ __forceinline__ int perm32(int rho) { const int n = rho >> 4, i = rho & 15; return 8 * (i >> 2) + 4 * n + (i & 3); }

struct Unit { int pm, pn; };
struct Gemm { const bf16_t* A; const bf16_t* Bt; int lda, ldb, K; };

struct StaticOrder {
    int nM, nN, nwg, G, c;
    __host__ __device__ void init(int M, int N, int G_, int c_) { nM = M / BM; nN = N / BM; nwg = nM * nN; G = G_; c = c_; }
    __host__ __device__ bool next(int i, Unit& u) const {
        const long L = (long)i * G + c; if (L >= nwg) return false;
        int wgid = (int)L; { const int q = nwg / NXCD, r = nwg % NXCD, xcd = wgid % NXCD, off = wgid / NXCD; wgid = (xcd < r ? xcd * (q + 1) : r * (q + 1) + (xcd - r) * q) + off; }
        const int nig = WGM * nN, gid = wgid / nig, fm = gid * WGM, gsz = (nM - fm) < WGM ? (nM - fm) : WGM;
        u.pm = fm + ((wgid % nig) % gsz); u.pn = (wgid % nig) / gsz; return true;
    }
};
typedef float f32x2_c __attribute__((ext_vector_type(2))); typedef __bf16 bf16x2_c __attribute__((ext_vector_type(2)));
__device__ __forceinline__ unsigned cvt_pk_bf16(float lo, float hi) { const f32x2_c v = {lo, hi}; const bf16x2_c b = __builtin_convertvector(v, bf16x2_c); return __builtin_bit_cast(unsigned, b); }
__device__ __forceinline__ float bflo(unsigned w) { return __uint_as_float(w << 16); }
__device__ __forceinline__ float bfhi(unsigned w) { return __uint_as_float(w & 0xffff0000u); }

__device__ __forceinline__ float ssq_sum16(const float* p) {
    const f32x4 a = *(const f32x4*)p, b = *(const f32x4*)(p + 4), c = *(const f32x4*)(p + 8), d = *(const f32x4*)(p + 12);
    return (((a[0] + a[1]) + (a[2] + a[3])) + ((b[0] + b[1]) + (b[2] + b[3]))) + (((c[0] + c[1]) + (c[2] + c[3])) + ((d[0] + d[1]) + (d[2] + d[3])));
}
template <bool SSQ> struct EpiRowScale {
    static constexpr bool PERM = true;
    bf16_t* O; int ldc; const float* rs; float mul = 1.f;
    __device__ __forceinline__ void operator()(const f32x4 (&acc)[2][2][4][2], const Unit& u, int wr, int wc, int fr, int fq) const {
        const int row0 = u.pm * BM + wr * 64 + fr, col0 = u.pn * BM + wc * 32 + 8 * fq;
#pragma unroll
        for (int ai = 0; ai < 2; ++ai)
#pragma unroll
            for (int m = 0; m < 4; ++m) {
                const int row = row0 + ai * HALF + m * 16;
                float s; if (SSQ) s = rsqrtf(ssq_sum16(rs + (size_t)row * 16) * (1.f / 1024.f) + NORM_EPS); else s = rs[row] * mul;
                bf16_t* rowp = O + (size_t)row * ldc + col0;
#pragma unroll
                for (int bj = 0; bj < 2; ++bj) {
                    const f32x4 v0 = acc[ai][bj][m][0] * s, v1 = acc[ai][bj][m][1] * s;
                    u32x4 w; w.x = cvt_pk_bf16(v0[0], v0[1]); w.y = cvt_pk_bf16(v0[2], v0[3]); w.z = cvt_pk_bf16(v1[0], v1[1]); w.w = cvt_pk_bf16(v1[2], v1[3]);
                    *(u32x4*)(rowp + bj * HALF) = w;
                }
            }
    }
};
template <bool ACCUM> struct EpiGate {
    static constexpr bool PERM = true;
    bf16_t* mg; const bf16_t* z; int gcol;
    __device__ __forceinline__ void operator()(const f32x4 (&acc)[2][2][4][2], const Unit& u, int wr, int wc, int fr, int fq) const {
        const int row0 = u.pm * BM + wr * 64 + fr, col0 = u.pn * BM + wc * 32 + 8 * fq;
#pragma unroll
        for (int ai = 0; ai < 2; ++ai)
#pragma unroll
            for (int m = 0; m < 4; ++m) {
                const int row = row0 + ai * HALF + m * 16;
                const bf16_t* gp = z + (size_t)row * NZ + gcol + col0;
                bf16_t* rowp = mg + (size_t)row * DM + col0;
#pragma unroll
                for (int bj = 0; bj < 2; ++bj) {
                    const u32x4 g = *(const u32x4*)(gp + bj * HALF);
                    const f32x4 a0 = acc[ai][bj][m][0], a1 = acc[ai][bj][m][1];
                    float r[8];
                    r[0] = sigmoidf_(bflo(g.x)) * a0[0]; r[1] = sigmoidf_(bfhi(g.x)) * a0[1]; r[2] = sigmoidf_(bflo(g.y)) * a0[2]; r[3] = sigmoidf_(bfhi(g.y)) * a0[3];
                    r[4] = sigmoidf_(bflo(g.z)) * a1[0]; r[5] = sigmoidf_(bfhi(g.z)) * a1[1]; r[6] = sigmoidf_(bflo(g.w)) * a1[2]; r[7] = sigmoidf_(bfhi(g.w)) * a1[3];
                    if (ACCUM) { const u32x4 o = *(const u32x4*)(rowp + bj * HALF);
                        r[0] += bflo(o.x); r[1] += bfhi(o.x); r[2] += bflo(o.y); r[3] += bfhi(o.y); r[4] += bflo(o.z); r[5] += bfhi(o.z); r[6] += bflo(o.w); r[7] += bfhi(o.w); }
                    u32x4 w; w.x = cvt_pk_bf16(r[0], r[1]); w.y = cvt_pk_bf16(r[2], r[3]); w.z = cvt_pk_bf16(r[4], r[5]); w.w = cvt_pk_bf16(r[6], r[7]);
                    *(u32x4*)(rowp + bj * HALF) = w;
                }
            }
    }
};
struct EpiX2 {
    static constexpr bool PERM = true;
    const float* x; float* x2; bf16_t* x2b; float* ssq;
    __device__ __forceinline__ void operator()(const f32x4 (&acc)[2][2][4][2], const Unit& u, int wr, int wc, int fr, int fq) const {
        const int row0 = u.pm * BM + wr * 64 + fr, col0 = u.pn * BM + wc * 32 + 8 * fq;
#pragma unroll
        for (int ai = 0; ai < 2; ++ai)
#pragma unroll
            for (int m = 0; m < 4; ++m) {
                const int row = row0 + ai * HALF + m * 16;
                const size_t off = (size_t)row * DM + col0;
                float ss = 0.f;
#pragma unroll
                for (int bj = 0; bj < 2; ++bj) {
                    const f32x4 x0 = *(const f32x4*)(x + off + bj * HALF), x1 = *(const f32x4*)(x + off + bj * HALF + 4);
                    const f32x4 o0 = x0 + acc[ai][bj][m][0], o1 = x1 + acc[ai][bj][m][1];
                    u32x4 w; w.x = cvt_pk_bf16(o0[0], o0[1]); w.y = cvt_pk_bf16(o0[2], o0[3]); w.z = cvt_pk_bf16(o1[0], o1[1]); w.w = cvt_pk_bf16(o1[2], o1[3]);
                    *(u32x4*)(x2b + off + bj * HALF) = w;
                    ss += (o0[0] * o0[0] + o0[1] * o0[1]) + (o0[2] * o0[2] + o0[3] * o0[3]) + (o1[0] * o1[0] + o1[1] * o1[1]) + (o1[2] * o1[2] + o1[3] * o1[3]);
                }
                ss += __shfl_xor(ss, 16); ss += __shfl_xor(ss, 32);
                if (fq == 0) ssq[(size_t)row * 16 + (u.pn & 3) * 4 + wc] = ss;
            }
    }
};

typedef int v8i_t __attribute__((ext_vector_type(8)));
template <class Epi, class Sched, bool F8 = false>
__device__ __forceinline__ void gemm_phase(PG8_LAS unsigned char* lds, const Gemm g, const Sched& S, const Epi& E) {
    const int tid = threadIdx.x, wid = __builtin_amdgcn_readfirstlane(tid >> 6), lane = tid & 63, wr = wid >> 2, wc = wid & 3, fr = lane & 15, fq = lane >> 4;
    const int K = g.K, nt = K / BK;
    unsigned voffA[2], voffB[2];
#pragma unroll
    for (int i = 0; i < 2; ++i) { int R, C; stage_rc(tid * 16 + i * 8192, R, C); const int Rb = Epi::PERM ? ((R & ~31) + perm32(R & 31)) : R;
        voffA[i] = (unsigned)(R * g.lda + C) * 2u; voffB[i] = (unsigned)(Rb * g.ldb + C) * 2u; }
    const size_t kstep = (size_t)(BK * 2);
    const size_t hstepA = (size_t)HALF * g.lda * 2, hstepB = (size_t)HALF * g.ldb * 2;
    const size_t tstepA = 2 * hstepA, tstepB = 2 * hstepB;
    const unsigned ldsw = (unsigned)wid * 1024u;
    const int aoff = lds_byte(wr * 64 + fr, fq * 8), boff = lds_byte(wc * 32 + fr, fq * 8);
    const int sub8 = (fq >> 1) * 1024 + fr * 64 + (((fq & 1) ^ (fr >> 3)) * 32);
    const int aoff8 = ((wr * 64) >> 4) * 2048 + sub8, boff8 = ((wc * 32) >> 4) * 2048 + sub8;
#define PG8_SA(b, h) (((b) * 2 + (h)) * HTB)
#define PG8_SB(b, h) ((4 + (b) * 2 + (h)) * HTB)
#define PG8_STAGE(bufoff, gbase, voff) do { _Pragma("unroll") for (int _i = 0; _i < 2; ++_i) \
        __builtin_amdgcn_global_load_lds((const unsigned*)((const char*)(gbase) + (voff)[_i]), (PG8_LAS unsigned*)(lds + (bufoff) + ldsw + _i * 8192), 16, 0, 0); } while (0)
#define PG8_LD8(p_) ({ typedef int i4_ __attribute__((ext_vector_type(4))); const i4_ lo_ = *(const PG8_LAS i4_*)(p_), hi_ = *(const PG8_LAS i4_*)((p_) + 16); __builtin_shufflevector(lo_, hi_, 0, 1, 2, 3, 4, 5, 6, 7); })
#define PG8_LDA(dst, b, h) do { if constexpr (F8) { _Pragma("unroll") for (int m = 0; m < 4; ++m) dst##8[m] = PG8_LD8(lds + PG8_SA(b, h) + aoff8 + m * 2048); } else { \
        _Pragma("unroll") for (int m = 0; m < 4; ++m) _Pragma("unroll") for (int k = 0; k < 2; ++k) dst[m][k] = *(const PG8_LAS bf16x8*)(lds + PG8_SA(b, h) + aoff + m * 2048 + k * 1024); } } while (0)
#define PG8_LDB(dst, b, h) do { if constexpr (F8) { _Pragma("unroll") for (int n = 0; n < 2; ++n) dst##8[n] = PG8_LD8(lds + PG8_SB(b, h) + boff8 + n * 2048); } else { \
        _Pragma("unroll") for (int n = 0; n < 2; ++n) _Pragma("unroll") for (int k = 0; k < 2; ++k) dst[n][k] = *(const PG8_LAS bf16x8*)(lds + PG8_SB(b, h) + boff + n * 2048 + k * 1024); } } while (0)
#define PG8_MMA(ai, bj, At, Bt) do { __builtin_amdgcn_s_setprio(1); if constexpr (F8) { _Pragma("unroll") for (int m = 0; m < 4; ++m) _Pragma("unroll") for (int n = 0; n < 2; ++n) \
        asm volatile("v_mfma_scale_f32_16x16x128_f8f6f4 %0, %1, %2, %0, %3, %3 op_sel_hi:[0,0,0]" : "+v"(acc[ai][bj][m][n]) : "v"(Bt##8[n]), "v"(At##8[m]), "v"(sc127)); } else { \
        _Pragma("unroll") for (int m = 0; m < 4; ++m) _Pragma("unroll") for (int n = 0; n < 2; ++n) _Pragma("unroll") for (int k = 0; k < 2; ++k) \
        acc[ai][bj][m][n] = __builtin_amdgcn_mfma_f32_16x16x32_bf16(Bt[n][k], At[m][k], acc[ai][bj][m][n], 0, 0, 0); } __builtin_amdgcn_s_setprio(0); } while (0)
#define PG8_WAIT_V(n) asm volatile("s_waitcnt vmcnt(" #n ")" ::: "memory")
#define PG8_WAIT_L(n) asm volatile("s_waitcnt lgkmcnt(" #n ")" ::: "memory")
#define PG8_BAR __builtin_amdgcn_s_barrier()
#define PG8_SCHED __builtin_amdgcn_sched_barrier(0)
    Unit cur, nxt; int ui = 0;
    if (!S.next(0, cur)) return;
    f32x4 acc[2][2][4][2];
#pragma unroll
    for (int a = 0; a < 2; ++a)
#pragma unroll
        for (int b = 0; b < 2; ++b)
#pragma unroll
            for (int m = 0; m < 4; ++m)
#pragma unroll
                for (int n = 0; n < 2; ++n) acc[a][b][m][n] = (f32x4){0.f, 0.f, 0.f, 0.f};
    bf16x8 At[4][2], B0[2][2], B1[2][2]; v8i_t At8[4], B08[2], B18[2];
    const int sc127 = 127;
    const char* cA = (const char*)g.A + (size_t)cur.pm * tstepA; const char* cB = (const char*)g.Bt + (size_t)cur.pn * tstepB;
    PG8_STAGE(PG8_SB(0, 0), cB, voffB); PG8_STAGE(PG8_SB(0, 1), cB + hstepB, voffB); PG8_STAGE(PG8_SA(0, 0), cA, voffA); PG8_STAGE(PG8_SA(0, 1), cA + hstepA, voffA);
    if (wr == 1) PG8_BAR;
    PG8_WAIT_V(2); PG8_BAR;
    PG8_STAGE(PG8_SB(1, 0), cB + kstep, voffB); PG8_STAGE(PG8_SA(1, 0), cA + kstep, voffA); PG8_STAGE(PG8_SB(1, 1), cB + hstepB + kstep, voffB);
    PG8_WAIT_V(6); PG8_BAR;
    for (;;) {
        const bool has_next = S.next(ui + 1, nxt);
        const char* nA = has_next ? (const char*)g.A + (size_t)nxt.pm * tstepA : cA; const char* nB = has_next ? (const char*)g.Bt + (size_t)nxt.pn * tstepB : cB;
#pragma nounroll
        for (int t = 0; t < nt; t += 2) {
            const bool last = (t == nt - 2);
            const char* a1 = cA + (size_t)(t + 1) * kstep;
            const char* a2 = last ? nA : cA + (size_t)(t + 2) * kstep; const char* b2 = last ? nB : cB + (size_t)(t + 2) * kstep;
            const char* a3 = a2 + kstep; const char* b3 = b2 + kstep;
            PG8_LDB(B0, 0, 0); PG8_LDB(B1, 0, 1); PG8_SCHED; PG8_LDA(At, 0, 0); PG8_STAGE(PG8_SA(1, 1), a1 + hstepA, voffA);
            PG8_WAIT_V(8); PG8_WAIT_L(0); PG8_BAR; PG8_MMA(0, 0, At, B0); PG8_MMA(0, 1, At, B1); PG8_BAR; PG8_SCHED;
            PG8_LDA(At, 0, 1); PG8_STAGE(PG8_SB(0, 0), b2, voffB); PG8_STAGE(PG8_SB(0, 1), b2 + hstepB, voffB); PG8_STAGE(PG8_SA(0, 0), a2, voffA);
            PG8_WAIT_V(8); PG8_WAIT_L(0); PG8_BAR; PG8_MMA(1, 0, At, B0); PG8_MMA(1, 1, At, B1); PG8_BAR; PG8_SCHED;
            PG8_LDB(B0, 1, 0); PG8_LDB(B1, 1, 1); PG8_SCHED; PG8_LDA(At, 1, 0); PG8_STAGE(PG8_SA(0, 1), a2 + hstepA, voffA);
            PG8_WAIT_V(8); PG8_WAIT_L(0); PG8_BAR; PG8_MMA(0, 0, At, B0); PG8_MMA(0, 1, At, B1); PG8_BAR; PG8_SCHED;
            PG8_LDA(At, 1, 1); PG8_STAGE(PG8_SB(1, 0), b3, voffB); PG8_STAGE(PG8_SB(1, 1), b3 + hstepB, voffB); PG8_STAGE(PG8_SA(1, 0), a3, voffA);
            PG8_WAIT_V(8); PG8_WAIT_L(0); PG8_BAR; PG8_MMA(1, 0, At, B0); PG8_MMA(1, 1, At, B1); PG8_BAR; PG8_SCHED;
        }
        if (wr == 0) PG8_BAR;
        if constexpr (F8) asm volatile("s_nop 15\n\ts_nop 15" ::: "memory");
        E(acc, cur, wr, wc, fr, fq);
        if (!has_next) break;
#pragma unroll
        for (int a = 0; a < 2; ++a)
#pragma unroll
            for (int b = 0; b < 2; ++b)
#pragma unroll
                for (int m = 0; m < 4; ++m)
#pragma unroll
                    for (int n = 0; n < 2; ++n) acc[a][b][m][n] = (f32x4){0.f, 0.f, 0.f, 0.f};
        cur = nxt; cA = nA; cB = nB; ++ui;
        if (wr == 1) PG8_BAR;
    }
    PG8_WAIT_V(0);
    PG8_BAR;
#undef PG8_SA
#undef PG8_SB
#undef PG8_STAGE
#undef PG8_LDA
#undef PG8_LD8
#undef PG8_LDB
#undef PG8_MMA
#undef PG8_WAIT_V
#undef PG8_WAIT_L
#undef PG8_BAR
#undef PG8_SCHED
}
}

constexpr int NWAVES = 8;
constexpr int LDS_RING_BYTES = 131072, LDSCTL_OFF = 143360, MISC_OFF = LDSCTL_OFF + 320, LDS_BYTES = 147456;
#define LAS __attribute__((address_space(3)))
#define GAS __attribute__((address_space(1)))
typedef float f32x4 __attribute__((ext_vector_type(4)));
typedef unsigned v4u __attribute__((ext_vector_type(4)));
typedef unsigned v2u __attribute__((ext_vector_type(2)));
#define LDS_WAIT() asm volatile("s_waitcnt lgkmcnt(0)" ::: "memory")

constexpr int CW_BAR = 4096;
#define XB_TMO      128
#define XB_XCNT(j)  (256  + 64 * (j))
#define XB_XSUB(j)  (1280 + 64 * (j))
#define XB_XGEN(j)  (2304 + 64 * (j))
#define XB_TOP      3328
#define XB_TOPGEN   3392
#define XCD_BAR_WORDS 3456
#define XB_SPIN_CAP (1u << 20)
__device__ __forceinline__ unsigned xb_ld(unsigned* p)              { return __hip_atomic_load(p, __ATOMIC_RELAXED, __HIP_MEMORY_SCOPE_AGENT); }
__device__ __forceinline__ unsigned xb_add(unsigned* p, unsigned v) { return __hip_atomic_fetch_add(p, v, __ATOMIC_RELAXED, __HIP_MEMORY_SCOPE_AGENT); }
__device__ __forceinline__ unsigned xb_xcc_id() { return (unsigned)__builtin_amdgcn_s_getreg((3 << 11) | 20) & 0xFu; }
#define XB_SPIN(cond, bar) do { unsigned _sp = 0; while (cond) { __builtin_amdgcn_s_sleep(1); \
    if ((++_sp & 255u) == 0u) { if (xb_ld(&(bar)[XB_TMO])) break; if (_sp > XB_SPIN_CAP) { atomicAdd(&(bar)[XB_TMO], 1u); break; } } } } while (0)
struct XcdBarrier { unsigned* bar; unsigned x; volatile LAS unsigned* st; };
__device__ __forceinline__ XcdBarrier xcd_barrier_post(unsigned* bar, volatile LAS unsigned* st) {
    XcdBarrier b; b.bar = bar; b.x = xb_xcc_id(); b.st = st;
    if (threadIdx.x == 0) (void)xb_add(&bar[XB_XCNT(b.x)], 1u);
    return b;
}
__device__ __forceinline__ void xcd_barrier_complete(unsigned* bar, unsigned x, unsigned& nloc, unsigned& nx) {
    const unsigned G = gridDim.x * gridDim.y * gridDim.z;
    unsigned sum, cnt, mine, sp = 0u;
    for (;;) {
        sum = 0u; cnt = 0u; mine = 0u;
#pragma unroll
        for (unsigned j = 0; j < 16; ++j) { const unsigned c = xb_ld(&bar[XB_XCNT(j)]); sum += c; cnt += (c > 0u) ? 1u : 0u; mine = (j == x) ? c : mine; }
        if (sum == G) break;
        __builtin_amdgcn_s_sleep(1);
        if ((++sp & 255u) == 0u) { if (xb_ld(&bar[XB_TMO])) break; if (sp > XB_SPIN_CAP) { atomicAdd(&bar[XB_TMO], 1u); break; } }
    }
    nloc = mine > 0u ? mine : 1u; nx = cnt > 0u ? cnt : 1u;
}
__device__ __forceinline__ void xcd_barrier(const XcdBarrier& b) {
    asm volatile("s_waitcnt vmcnt(0)" ::: "memory");
    __syncthreads();
    if (threadIdx.x == 0) {
        unsigned* bar = b.bar;
        __builtin_amdgcn_s_waitcnt(0);
        unsigned nloc = b.st[0], nx = b.st[1];
        if (nloc == 0u) { xcd_barrier_complete(bar, b.x, nloc, nx); b.st[0] = nloc; b.st[1] = nx; }
        const unsigned old = xb_add(&bar[XB_XSUB(b.x)], 1u);
        const unsigned gen = old / nloc;
        if (old + 1u == (gen + 1u) * nloc) {
            __builtin_amdgcn_fence(__ATOMIC_RELEASE, "agent");
            asm volatile("s_waitcnt vmcnt(0)" ::: "memory");
            const unsigned og = xb_add(&bar[XB_TOP], 1u);
            const unsigned tg = og / nx;
            if (og + 1u == (tg + 1u) * nx) xb_add(&bar[XB_TOPGEN], 1u);
            else XB_SPIN(xb_ld(&bar[XB_TOPGEN]) == tg, bar);
            __builtin_amdgcn_fence(__ATOMIC_ACQUIRE, "agent");
            xb_add(&bar[XB_XGEN(b.x)], 1u);
            asm volatile("s_waitcnt vmcnt(0)" ::: "memory");
        } else {
            XB_SPIN(xb_ld(&bar[XB_XGEN(b.x)]) == gen, bar);
            __builtin_amdgcn_fence(__ATOMIC_ACQUIRE, "agent");
            asm volatile("s_waitcnt vmcnt(0)" ::: "memory");
        }
    }
    __syncthreads();
}

struct Args { const float* in[28]; float* out; unsigned char* ws; int ph_lo, ph_hi, li, pad; };

__device__ __forceinline__ void p0_transpose_item(const float* W, const float* sc, int K, int N, bf16_t* WT, LAS float* scr, int item, int lane, unsigned char* W8 = nullptr, int n8 = 0) {
    const int nblk = N / 32, kb = item / nblk, nb = item % nblk, k0 = 64 * kb, n0 = 32 * nb;
#pragma unroll 8
    for (int i = 0; i < 32; ++i) { const int kk = 2 * i + (lane >> 5); const float s = sc ? sc[k0 + kk] : 1.f; scr[kk * 33 + (lane & 31)] = W[(size_t)(k0 + kk) * N + n0 + (lane & 31)] * s; }
    LDS_WAIT(); asm volatile("" ::: "memory");
    const int c = lane & 7;
#pragma unroll
    for (int j = 0; j < 4; ++j) { const int n = (lane >> 3) + 8 * j; const LAS float* s = scr + (8 * c) * 33 + n;
        v4u o; o.x = pg8::cvt_pk_bf16(s[0 * 33], s[1 * 33]); o.y = pg8::cvt_pk_bf16(s[2 * 33], s[3 * 33]); o.z = pg8::cvt_pk_bf16(s[4 * 33], s[5 * 33]); o.w = pg8::cvt_pk_bf16(s[6 * 33], s[7 * 33]);
        *(v4u*)(WT + (size_t)(n0 + n) * K + k0 + 8 * c) = o;
        if (W8 && n0 + n >= n8) {
            int p0 = 0, p1 = 0;
            p0 = __builtin_amdgcn_cvt_pk_fp8_f32(s[0 * 33] * 32.f, s[1 * 33] * 32.f, p0, false); p0 = __builtin_amdgcn_cvt_pk_fp8_f32(s[2 * 33] * 32.f, s[3 * 33] * 32.f, p0, true);
            p1 = __builtin_amdgcn_cvt_pk_fp8_f32(s[4 * 33] * 32.f, s[5 * 33] * 32.f, p1, false); p1 = __builtin_amdgcn_cvt_pk_fp8_f32(s[6 * 33] * 32.f, s[7 * 33] * 32.f, p1, true);
            *(v2u*)(W8 + (size_t)(n0 + n - n8) * K + k0 + 8 * c) = (v2u){(unsigned)p0, (unsigned)p1};
        } }
    LDS_WAIT(); asm volatile("" ::: "memory");
}
typedef unsigned v6u_t __attribute__((ext_vector_type(6)));
typedef unsigned v3u_t __attribute__((ext_vector_type(3)));
typedef float v16f_t __attribute__((ext_vector_type(16)));
typedef float v32f_t __attribute__((ext_vector_type(32)));
__device__ __forceinline__ void p0_row_fp6(const float* in, const float* cs, unsigned char* out, float* sc, int lane) {
    f32x4 v[4]; float mx = 0.f;
#pragma unroll
    for (int i = 0; i < 4; ++i) { v[i] = *(const f32x4*)(in + lane * 16 + 4 * i); if (cs) v[i] = v[i] * *(const f32x4*)(cs + lane * 16 + 4 * i);
        mx = fmaxf(mx, fmaxf(fmaxf(fabsf(v[i][0]), fabsf(v[i][1])), fmaxf(fabsf(v[i][2]), fabsf(v[i][3])))); }
#pragma unroll
    for (int o = 1; o < 64; o <<= 1) mx = fmaxf(mx, __shfl_xor(mx, o));
    mx = fmaxf(mx, 1e-30f);
    const float q = 7.5f / mx;
    v16f_t a, b;
#pragma unroll
    for (int i = 0; i < 16; ++i) { a[i] = 0.f; b[i] = 0.f; }
#pragma unroll
    for (int i = 0; i < 8; ++i) { a[i] = v[(2 * i) >> 2][(2 * i) & 3] * q; b[i] = v[(2 * i + 1) >> 2][(2 * i + 1) & 3] * q; }
    const v6u_t p = __builtin_amdgcn_cvt_scalef32_2xpk16_fp6_f32(a, b, 1.0f);
    *(v3u_t*)(out + lane * 12) = (v3u_t){p[0], p[1], p[2]};
    if (lane == 0) *sc = mx * (1.f / 7.5f);
}
__device__ __forceinline__ void p0_convert(const float* in, const float* cs, bf16_t* out, size_t n, int gw, int NGW, int lane) {
    for (size_t i = ((size_t)gw * 64 + lane) * 8; i < n; i += (size_t)NGW * 512) {
        f32x4 a = *(const f32x4*)(in + i), b = *(const f32x4*)(in + i + 4);
        if (cs) { const int c = (int)(i & 1023); a = a * *(const f32x4*)(cs + c); b = b * *(const f32x4*)(cs + c + 4); }
        v4u o; o.x = pg8::cvt_pk_bf16(a[0], a[1]); o.y = pg8::cvt_pk_bf16(a[2], a[3]); o.z = pg8::cvt_pk_bf16(b[0], b[1]); o.w = pg8::cvt_pk_bf16(b[2], b[3]);
        *(v4u*)(out + i) = o;
    }
}

namespace da {
typedef short bf16x8 __attribute__((ext_vector_type(8)));
typedef short s16x4 __attribute__((ext_vector_type(4)));
typedef float f32x16 __attribute__((ext_vector_type(16)));
typedef const LAS unsigned char* lcp;
constexpr float LOG2E = 1.4426950408889634f, C2 = 0.125f * LOG2E, THR = 8.f;
constexpr int RSLOT = 16384, LDS_KR = 0, LDS_VR = 4 * RSLOT, SCR_OFF = 8 * RSLOT, COMB_OFF = 0;
#define DA_SBAR() __builtin_amdgcn_sched_barrier(0)
#define DA_PIN(x) asm volatile("" : "+v"(x))
#define DA_MFMA(a, b, c) __builtin_amdgcn_mfma_f32_32x32x16_bf16(a, b, c, 0, 0, 0)
#define DA_WAIT_BAR(N) asm volatile("s_waitcnt vmcnt(" #N ") lgkmcnt(0)\n\ts_barrier" ::: "memory")
#define DA_MX3(a, b, c) __builtin_fmaxf(__builtin_fmaxf((a), (b)), (c))
__device__ __forceinline__ int crow(int r, int hi) { return (r & 3) + 8 * (r >> 2) + 4 * hi; }
__device__ __forceinline__ s16x4 vtr(lcp p) { return __builtin_bit_cast(s16x4, __builtin_amdgcn_ds_read_tr16_b64_v4i16((LAS s16x4*)p)); }
__device__ __forceinline__ unsigned cvtpk(float lo, float hi) { unsigned r; asm("v_cvt_pk_bf16_f32 %0, %1, %2" : "=v"(r) : "v"(lo), "v"(hi)); return r; }
__device__ __forceinline__ void glds16(const void* g, unsigned lds_base) {
    unsigned sv; asm volatile("s_mov_b32 %0, m0\n\ts_mov_b32 m0, %2\n\ts_nop 0\n\tglobal_load_lds_dwordx4 %1, off\n\ts_mov_b32 m0, %0" : "=&s"(sv) : "v"(g), "s"(lds_base) : "memory"); }
__device__ __forceinline__ void glds16_o128(const void* g, unsigned lds_base) {
    unsigned sv; asm volatile("s_mov_b32 %0, m0\n\ts_mov_b32 m0, %2\n\ts_nop 0\n\tglobal_load_lds_dwordx4 %1, off offset:128\n\ts_mov_b32 m0, %0" : "=&s"(sv) : "v"(g), "s"(lds_base) : "memory"); }
__device__ __forceinline__ void kload2(bf16x8* kf, lcp kp, int d0) { kf[2 * d0] = *(const LAS bf16x8*)(kp + d0 * 2048); kf[2 * d0 + 1] = *(const LAS bf16x8*)(kp + d0 * 2048 + 512); }
__device__ __forceinline__ float max16(const f32x16& p) {
    float a = DA_MX3(p[0], p[1], p[2]), b = DA_MX3(p[3], p[4], p[5]); a = DA_MX3(a, p[6], p[7]); b = DA_MX3(b, p[8], p[9]); a = DA_MX3(a, p[10], p[11]); b = DA_MX3(b, p[12], p[13]);
    a = DA_MX3(a, p[14], p[15]); return __builtin_fmaxf(a, b); }
__device__ __forceinline__ float rowmax(const f32x16& p0, const f32x16& p1, float offA, float offB) {
    const float m = __builtin_fmaxf(__builtin_fmaf(max16(p0), C2, offA), __builtin_fmaf(max16(p1), C2, offB));
    auto rr = __builtin_amdgcn_permlane32_swap(__float_as_uint(m), __float_as_uint(m), false, false);
    return __builtin_fmaxf(__uint_as_float(rr[0]), __uint_as_float(rr[1])); }
__device__ __forceinline__ void cmask(f32x16& p0, f32x16& p1, int jb, int qrel, int hi) {
    const int kb = 64 * jb + 4 * hi;
#pragma unroll
    for (int r = 0; r < 16; ++r) { const int kv = kb + (r & 3) + 8 * (r >> 2); if (kv > qrel) p0[r] = -INFINITY; if (kv + 32 > qrel) p1[r] = -INFINITY; } }

__device__ __forceinline__ void attn_epilogue_body(LAS unsigned char* lds, f32x16 (&o)[4], float l_reg, bf16_t* __restrict__ yb, const float* __restrict__ subln_w, float lam,
                                                   size_t rowb, int q0, int h, int wave, int lane) {
    asm volatile("" : "+v"(lane));
    const int r32 = lane & 31, hi = lane >> 5, map = wave >> 2, qs = wave & 3;
    LAS float* wsf = (LAS float*)(lds + SCR_OFF) + wave * 64;
    if (hi == 0) wsf[r32] = __builtin_amdgcn_rcpf(l_reg);
    float il[16];
#pragma unroll
    for (int g = 0; g < 4; ++g) { const f32x4 t4 = *(const LAS f32x4*)(wsf + 8 * g + 4 * hi); il[4 * g] = t4[0]; il[4 * g + 1] = t4[1]; il[4 * g + 2] = t4[2]; il[4 * g + 3] = t4[3]; }
    __syncthreads();
    LAS float* comb = (LAS float*)(lds + COMB_OFF) + qs * 4096;
    if (map == 1) {
#pragma unroll
        for (int d = 0; d < 4; ++d)
#pragma unroll
            for (int r = 0; r < 16; ++r) comb[crow(r, hi) * 128 + 32 * d + r32] = o[d][r] * il[r];
    }
    __syncthreads();
    if (map == 0) {
        float sw[4];
#pragma unroll
        for (int d = 0; d < 4; ++d) sw[d] = subln_w[32 * d + r32] * (1.f - LAM_INIT);
#pragma unroll
        for (int r = 0; r < 16; ++r) {
            float v[4], ss = 0.f;
#pragma unroll
            for (int d = 0; d < 4; ++d) { v[d] = o[d][r] * il[r] - lam * comb[crow(r, hi) * 128 + 32 * d + r32]; ss += v[d] * v[d]; }
            ss += __shfl_xor(ss, 1); ss += __shfl_xor(ss, 2); ss += __shfl_xor(ss, 4); ss += __shfl_xor(ss, 8); ss += __shfl_xor(ss, 16);
            const float rs = rsqrtf(ss * (1.f / 128.f) + SUBLN_EPS);
            bf16_t* op = yb + (rowb + q0 + crow(r, hi)) * 512 + h * 128 + r32;
#pragma unroll
            for (int d = 0; d < 4; ++d) op[32 * d] = f2bf(v[d] * rs * sw[d]);
        }
    }
    __syncthreads();
}
__device__ __forceinline__ void attn_unit(LAS unsigned char* lds, const bf16_t* __restrict__ z, bf16_t* __restrict__ yb, const float* __restrict__ subln_w, float lam,
                                          int b, int h, int qblk, int wave_, int lane) {
    const int wave = __builtin_amdgcn_readfirstlane(wave_);
    const int r32 = lane & 31, hi = lane >> 5, map = wave >> 2, qs = wave & 3;
    const int q0 = qblk * 128 + qs * 32, NT = 2 * qblk + 2, qrel = qs * 32 + r32;
    const size_t rowb = (size_t)b * SEQ;
    const float slope = exp2f(-2.f * (float)(h + 1)), slope2 = slope * LOG2E, s64 = 64.f * slope2, s32 = 32.f * slope2;
    const unsigned lds0 = (unsigned)(uintptr_t)lds;
    LAS float* wsf = (LAS float*)(lds + SCR_OFF) + wave * 64;
    const bf16_t* ksrc = z + (rowb + lane) * NZ + C_ZK + h * 128 + wave * 8;
    const int pc0 = 2 * wave;
    const bf16_t* vsrc0 = z + (rowb + 16 * (pc0 & 3) + (lane >> 2)) * NZ + C_ZV + h * 128 + 32 * (pc0 >> 2) + (lane & 3) * 8;
    const unsigned kdst = lds0 + LDS_KR + wave * 1024, vdst = lds0 + LDS_VR + pc0 * 1024;
#define DMA_K(t, slot) do { const bf16_t* k_ = ksrc + (size_t)(t) * 64 * NZ; const unsigned d_ = (unsigned)__builtin_amdgcn_readfirstlane(kdst + (slot)); glds16(k_, d_); glds16_o128(k_, d_ + 8192 - 128); } while (0)
#define DMA_V(t, slot) do { const size_t o_ = (size_t)(t) * 64 * NZ; const unsigned d_ = (unsigned)__builtin_amdgcn_readfirstlane(vdst + (slot)); glds16(vsrc0 + o_, d_); glds16(vsrc0 + o_ + 16 * NZ, d_ + 1024); } while (0)
    const lcp vp0 = lds + LDS_VR + ((lane >> 4) & 1) * 32 + (lane & 3) * 8 + (4 * hi + ((lane & 15) >> 2)) * 64;
    const lcp kp0 = lds + LDS_KR + map * 8192 + hi * 1024 + r32 * 16;
    DMA_K(0, 0); DMA_V(0, 0); DMA_K(1, RSLOT);
    bf16x8 qr[4];
    {
        const bf16_t* qp = z + (rowb + q0 + r32) * NZ + C_Q + h * 128 + map * 64 + hi * 8;
#pragma unroll
        for (int d0 = 0; d0 < 4; ++d0) qr[d0] = *(const bf16x8*)(qp + d0 * 16);
    }
    f32x16 bias16;
#pragma unroll
    for (int r = 0; r < 16; ++r) bias16[r] = (8.f * slope) * (float)((r & 3) + 8 * (r >> 2));
    DA_PIN(bias16);
    float mhat = 0.f, l_reg = 0.f, offA = slope2 * (float)(4 * hi);
    f32x16 o[4];
#pragma unroll
    for (int d = 0; d < 4; ++d) o[d] = (f32x16){};
    bool resc = false;
    f32x16 c0, c1; bf16x8 kf[8]; s16x4 vlo[4], vhi[4]; v4u pw0, pw1, pw2, pw3;
#define SL(t) ((((t)) & 3) * RSLOT)
#define EX(v, nm) __builtin_amdgcn_exp2f(__builtin_fmaf((v), C2, (nm)))
#define RESC() do { if (resc) { _Pragma("unroll") for (int d_ = 0; d_ < 4; ++d_) _Pragma("unroll") for (int r = 0; r < 16; ++r) o[d_][r] *= wsf[crow(r, hi)]; } } while (0)
#define PKW(P, i) pg8::cvt_pk_bf16(P[i], P[(i) + 1])
    DMA_K(2, 2 * RSLOT); DMA_K(3, 3 * RSLOT); DMA_V(1, RSLOT);
    DA_WAIT_BAR(10);
#pragma unroll
    for (int d0 = 0; d0 < 4; ++d0) kload2(kf, kp0, d0);
    c0 = DA_MFMA(kf[0], qr[0], bias16); c1 = DA_MFMA(kf[1], qr[0], bias16); c0 = DA_MFMA(kf[2], qr[1], c0); c1 = DA_MFMA(kf[3], qr[1], c1);
    c0 = DA_MFMA(kf[4], qr[2], c0); c1 = DA_MFMA(kf[5], qr[2], c1); c0 = DA_MFMA(kf[6], qr[3], c0); c1 = DA_MFMA(kf[7], qr[3], c1);
    if (NT == 2) cmask(c0, c1, 0, qrel, hi);
    { mhat = rowmax(c0, c1, offA, offA + s32); const float nmh0 = offA - mhat, nmh1 = nmh0 + s32; float sacc = 0.f;
#pragma unroll
      for (int r = 0; r < 16; ++r) { c0[r] = EX(c0[r], nmh0); c1[r] = EX(c1[r], nmh1); sacc += c0[r] + c1[r]; }
      l_reg = sacc; }
    pw0 = (v4u){PKW(c0, 0), PKW(c0, 2), PKW(c0, 4), PKW(c0, 6)}; pw1 = (v4u){PKW(c0, 8), PKW(c0, 10), PKW(c0, 12), PKW(c0, 14)};
    pw2 = (v4u){PKW(c1, 0), PKW(c1, 2), PKW(c1, 4), PKW(c1, 6)}; pw3 = (v4u){PKW(c1, 8), PKW(c1, 10), PKW(c1, 12), PKW(c1, 14)};
    DA_WAIT_BAR(6);
    DMA_K(4, 0); DMA_V(2, 2 * RSLOT);
#pragma unroll
    for (int d0 = 0; d0 < 4; ++d0) kload2(kf, kp0 + RSLOT, d0);
    if (NT == 2) { DA_WAIT_BAR(0); } else { DA_WAIT_BAR(8); }
#define PAF(k) __builtin_bit_cast(bf16x8, pw##k)
#define VFR(i) (bf16x8){vlo[(i) & 3][0], vlo[(i) & 3][1], vlo[(i) & 3][2], vlo[(i) & 3][3], vhi[(i) & 3][0], vhi[(i) & 3][1], vhi[(i) & 3][2], vhi[(i) & 3][3]}
#define VOFF(i) ((((i) & 3) * 4 + ((i) >> 2)) * 1024)
#define VRD(i) do { vlo[(i) & 3] = vtr(vp_ + VOFF(i)); vhi[(i) & 3] = vtr(vp_ + VOFF(i) + 512); DA_SBAR(); } while (0)
#define KRD(G, d0) do { if (G) { kload2(kf, kp0 + sl_next_, d0); DA_SBAR(); } } while (0)
#define GAPA(MF) do { MF; DA_SBAR(); } while (0)
#define GAPB(MF, X, i, nm, A0, A1, EXTRA) do { MF; X[i] = EX(X[i], nm); X[(i) + 1] = EX(X[(i) + 1], nm); sacc += A0; sacc += A1; EXTRA; DA_PIN(X); DA_PIN(sacc); DA_SBAR(); } while (0)
#define STEP(t, MASK, GK, GV, GL) do { DA_SBAR(); \
    const lcp vp_ = vp0 + SL((t) - 1); const int sl_next_ = SL((t) + 1); \
            GAPA(c0 = DA_MFMA(kf[0], qr[0], bias16)); GAPA(c1 = DA_MFMA(kf[1], qr[0], bias16)); GAPA(c0 = DA_MFMA(kf[2], qr[1], c0)); GAPA(c1 = DA_MFMA(kf[3], qr[1], c1)); \
    VRD(0); GAPA(c0 = DA_MFMA(kf[4], qr[2], c0)); VRD(1); GAPA(c1 = DA_MFMA(kf[5], qr[2], c1)); VRD(2); GAPA(c0 = DA_MFMA(kf[6], qr[3], c0)); VRD(3); GAPA(c1 = DA_MFMA(kf[7], qr[3], c1)); \
    offA += s64; \
    if (GK) DMA_K((t) + 4, SL(t)); if (GV) DMA_V((t) + 2, SL((t) + 2)); \
    if (MASK) cmask(c0, c1, (t) - (NT - 2), qrel, hi); \
    { const float rm = rowmax(c0, c1, offA, offA + s32) - mhat; resc = false; \
      if (__builtin_expect(__any(rm > THR), 0)) { const float dl = __builtin_fmaxf(rm, 0.f); mhat += dl; \
          const float f = __builtin_amdgcn_exp2f(-dl); l_reg *= f; if (hi == 0) wsf[r32] = f; resc = true; } } \
    const float nmh0 = offA - mhat, nmh1 = nmh0 + s32; float sacc = 0.f; DA_SBAR(); \
    GAPB(o[0] = DA_MFMA(PAF(0), VFR(0), o[0]), c0, 0, nmh0, 0.f, 0.f, );             VRD(4); \
    GAPB(o[1] = DA_MFMA(PAF(0), VFR(1), o[1]), c0, 2, nmh0, c0[0], c0[1], );         VRD(5); \
    GAPB(o[2] = DA_MFMA(PAF(0), VFR(2), o[2]), c0, 4, nmh0, c0[2], c0[3], );         VRD(6); \
    GAPB(o[3] = DA_MFMA(PAF(0), VFR(3), o[3]), c0, 6, nmh0, c0[4], c0[5], );         VRD(7); \
    GAPB(o[0] = DA_MFMA(PAF(1), VFR(4), o[0]), c0, 8, nmh0, c0[6], c0[7], pw0[0] = PKW(c0, 0); pw0[1] = PKW(c0, 2); DA_PIN(pw0));    VRD(8); \
    GAPB(o[1] = DA_MFMA(PAF(1), VFR(5), o[1]), c0, 10, nmh0, c0[8], c0[9], pw0[2] = PKW(c0, 4); pw0[3] = PKW(c0, 6); DA_PIN(pw0));   VRD(9); \
    GAPB(o[2] = DA_MFMA(PAF(1), VFR(6), o[2]), c0, 12, nmh0, c0[10], c0[11], );      VRD(10); \
    GAPB(o[3] = DA_MFMA(PAF(1), VFR(7), o[3]), c0, 14, nmh0, c0[12], c0[13], );      VRD(11); \
    GAPB(o[0] = DA_MFMA(PAF(2), VFR(8), o[0]), c1, 0, nmh1, c0[14], c0[15], pw1[0] = PKW(c0, 8); pw1[1] = PKW(c0, 10); DA_PIN(pw1));  VRD(12); \
    GAPB(o[1] = DA_MFMA(PAF(2), VFR(9), o[1]), c1, 2, nmh1, c1[0], c1[1], pw1[2] = PKW(c0, 12); pw1[3] = PKW(c0, 14); DA_PIN(pw1));   VRD(13); \
    GAPB(o[2] = DA_MFMA(PAF(2), VFR(10), o[2]), c1, 4, nmh1, c1[2], c1[3], );        VRD(14); \
    GAPB(o[3] = DA_MFMA(PAF(2), VFR(11), o[3]), c1, 6, nmh1, c1[4], c1[5], );        VRD(15); \
    GAPB(o[0] = DA_MFMA(PAF(3), VFR(12), o[0]), c1, 8, nmh1, c1[6], c1[7], pw2[0] = PKW(c1, 0); pw2[1] = PKW(c1, 2); DA_PIN(pw2));   KRD(GL, 0); \
    GAPB(o[1] = DA_MFMA(PAF(3), VFR(13), o[1]), c1, 10, nmh1, c1[8], c1[9], pw2[2] = PKW(c1, 4); pw2[3] = PKW(c1, 6); DA_PIN(pw2));  KRD(GL, 1); \
    GAPB(o[2] = DA_MFMA(PAF(3), VFR(14), o[2]), c1, 12, nmh1, c1[10], c1[11], );     KRD(GL, 2); \
    GAPB(o[3] = DA_MFMA(PAF(3), VFR(15), o[3]), c1, 14, nmh1, c1[12], c1[13], );     KRD(GL, 3); \
    sacc += c1[14]; sacc += c1[15]; l_reg += sacc; \
    pw3[0] = PKW(c1, 8); pw3[1] = PKW(c1, 10); pw3[2] = PKW(c1, 12); pw3[3] = PKW(c1, 14); DA_PIN(pw3); \
    } while (0)
#define ENDW(tt) do { if ((tt) + 4 < NT) { DA_WAIT_BAR(8); } else if ((tt) + 3 < NT) { DA_WAIT_BAR(6); } else if ((tt) + 2 < NT) { DA_WAIT_BAR(4); } else { DA_WAIT_BAR(0); } } while (0)
    int t = 1;
    for (; t + 4 < NT; ++t) {
        STEP(t, false, true, true, true); DA_WAIT_BAR(8); RESC();
    }
    for (; t + 1 < NT; ++t) {
        STEP(t, true, (t + 4 < NT), (t + 2 < NT), (t + 1 < NT)); ENDW(t); RESC();
    }
    STEP(NT - 1, true, false, false, false); RESC();
    { const lcp vp_ = vp0 + SL(NT - 1);
#define DRN(k, i) do { const s16x4 lo_ = vtr(vp_ + VOFF(i)), hh_ = vtr(vp_ + VOFF(i) + 512); \
        o[(i) & 3] = DA_MFMA(PAF(k), ((bf16x8){lo_[0], lo_[1], lo_[2], lo_[3], hh_[0], hh_[1], hh_[2], hh_[3]}), o[(i) & 3]); } while (0)
      DRN(0, 0); DRN(0, 1); DRN(0, 2); DRN(0, 3); DRN(1, 4); DRN(1, 5); DRN(1, 6); DRN(1, 7); DRN(2, 8); DRN(2, 9); DRN(2, 10); DRN(2, 11); DRN(3, 12); DRN(3, 13); DRN(3, 14); DRN(3, 15);
#undef DRN
    }
#undef DMA_K
#undef DMA_V
#undef SL
#undef EX
#undef RESC
#undef PKW
#undef PAF
#undef VFR
#undef VOFF
#undef VRD
#undef KRD
#undef GAPA
#undef GAPB
#undef STEP
#undef ENDW
    { auto rr = __builtin_amdgcn_permlane32_swap(__float_as_uint(l_reg), __float_as_uint(l_reg), false, false); l_reg = __uint_as_float(rr[0]) + __uint_as_float(rr[1]); }
    attn_epilogue_body(lds, o, l_reg, yb, subln_w, lam, rowb, q0, h, wave, lane);
}
}

namespace rw {
typedef short bf16x8 __attribute__((ext_vector_type(8)));
typedef float f32x2 __attribute__((ext_vector_type(2)));
typedef short s16x4 __attribute__((ext_vector_type(4)));
constexpr int CH = 32, ACT_PITCH = 528;
constexpr int OFF_HAT = 41472, HAT_PITCH = 144, HAT_SZ = 32 * HAT_PITCH, OFF_TIL = OFF_HAT + 4 * HAT_SZ, TIL_PITCH = 40, TIL_SZ = 64 * TIL_PITCH, OFF_GR = OFF_TIL + 4 * TIL_SZ, OFF_WC = OFF_GR + 10 * 1024;
constexpr int OFF_ACT = 0, OFF_RKV = 16896, OFF_VEC = 41472, OFF_G = 82432, OFF_Y = 90624, OFF_NRM = 98816, OFF_SCL = 99328, OFF_CT = 99840, OFF_SCP = 102400;
template <int CTRL> __device__ __forceinline__ float dppf(float x) { return __builtin_bit_cast(float, __builtin_amdgcn_mov_dpp(__builtin_bit_cast(int, x), CTRL, 0xf, 0xf, true)); }
__device__ __forceinline__ float row_allsum(float v) { v += dppf<0x128>(v); v += dppf<0x124>(v); v += dppf<0x122>(v); v += dppf<0x121>(v); return v; }
__device__ __forceinline__ void row_allsum4(float& a, float& b, float& c, float& d) {
#define RW_DPP4(n) "v_add_f32_dpp %0, %0, %0 row_ror:" #n " row_mask:0xf bank_mask:0xf\n\tv_add_f32_dpp %1, %1, %1 row_ror:" #n " row_mask:0xf bank_mask:0xf\n\t" \
                   "v_add_f32_dpp %2, %2, %2 row_ror:" #n " row_mask:0xf bank_mask:0xf\n\tv_add_f32_dpp %3, %3, %3 row_ror:" #n " row_mask:0xf bank_mask:0xf\n\t"
    asm volatile("s_nop 1\n\t" RW_DPP4(8) RW_DPP4(4) RW_DPP4(2) RW_DPP4(1) "s_nop 1" : "+v"(a), "+v"(b), "+v"(c), "+v"(d));
#undef RW_DPP4
}
__device__ __forceinline__ f32x4 ld4bf(const bf16_t* p) { const v2u w = *(const v2u*)p; return (f32x4){pg8::bflo(w.x), pg8::bfhi(w.x), pg8::bflo(w.y), pg8::bfhi(w.y)}; }
__device__ __forceinline__ float fsig(float x) { return __builtin_amdgcn_rcpf(1.f + __expf(-x)); }
__device__ __forceinline__ float ftanh(float x) { return 1.f - 2.f * __builtin_amdgcn_rcpf(1.f + __expf(2.f * x)); }
struct ZRow { v2u r, k, v, w, a; v4u g; };
__device__ __forceinline__ ZRow ldrow(const bf16_t* zr, int c4, int cg) {
    ZRow o; o.r = *(const v2u*)(zr + C_R + c4); o.k = *(const v2u*)(zr + C_K + c4); o.v = *(const v2u*)(zr + C_V + c4); o.w = *(const v2u*)(zr + C_WL + 4 * cg); o.a = *(const v2u*)(zr + C_AL + 4 * cg);
    o.g = *(const v4u*)(zr + C_GL + 8 * cg); return o;
}
__device__ __forceinline__ f32x4 up4(v2u w) { return (f32x4){pg8::bflo(w.x), pg8::bfhi(w.x), pg8::bflo(w.y), pg8::bfhi(w.y)}; }

struct ScanP { const float *mu, *w0, *w2, *a0, *a2, *g2, *k_k, *k_a, *r_k, *lnx_w, *lnx_b; };
__device__ __forceinline__ void scan_unit(LAS unsigned char* lds, const bf16_t* __restrict__ z, bf16_t* __restrict__ ya, const ScanP P, int b, int h, int tid, int wave, int lane) {
    asm volatile("" : "+v"(tid)); lane = tid & 63;
    const float* mu = P.mu; const float* w0 = P.w0; const float* w2 = P.w2; const float* a0 = P.a0; const float* a2 = P.a2; const float* g2 = P.g2;
    const float* k_k = P.k_k; const float* k_a = P.k_a; const float* r_k = P.r_k; const float* lnx_w = P.lnx_w; const float* lnx_b = P.lnx_b;
    const size_t rowb = (size_t)b * SEQ;
    const int tl = tid >> 4, cg = tid & 15;
    const int nt = wave & 3, rl = lane & 15, rg = lane >> 4;
    LAS float* rkv = (LAS float*)(lds + OFF_RKV); LAS float* vec = (LAS float*)(lds + OFF_VEC); LAS float* gbuf = (LAS float*)(lds + OFF_G);
    LAS float* ybuf = (LAS float*)(lds + OFF_Y); LAS float* nrm = (LAS float*)(lds + OFF_NRM); LAS float* scl = (LAS float*)(lds + OFF_SCL); LAS float* scp = (LAS float*)(lds + OFF_SCP);
    bf16x8 bfr[8];
    {
        const int col = h * 64 + 16 * nt + rl;
#pragma unroll
        for (int f = 0; f < 8; ++f) {
            const float* src = (f < 2) ? w2 : (f < 4) ? a2 : g2;
            const int kb = ((f < 4) ? 32 * (f & 1) : 32 * (f - 4)) + 8 * rg;
            float e[8];
#pragma unroll
            for (int j = 0; j < 8; ++j) e[j] = src[(size_t)(kb + j) * 512 + col];
            v4u p; p.x = pg8::cvt_pk_bf16(e[0], e[1]); p.y = pg8::cvt_pk_bf16(e[2], e[3]); p.z = pg8::cvt_pk_bf16(e[4], e[5]); p.w = pg8::cvt_pk_bf16(e[6], e[7]);
            bfr[f] = __builtin_bit_cast(bf16x8, p);
            __builtin_amdgcn_sched_barrier(0);
        }
    }
    const int mt = wave >> 2;
    const int hc = h * 64 + 16 * nt + rl;
    const float w0c = w0[hc], a0c = a0[hc], kkc = k_k[hc], kac = k_a[hc], rkc = r_k[hc];
    const int c4 = h * 64 + 4 * cg;
    f32x4 ST[4];
#pragma unroll
    for (int i = 0; i < 4; ++i) ST[i] = (f32x4){0.f, 0.f, 0.f, 0.f};
    LAS float* ctab = (LAS float*)(lds + OFF_CT);
    if (tl == 0) {
        LAS float* ct = ctab + cg * 36;
        *(LAS f32x4*)(ct + 0) = *(const f32x4*)(mu + C_R + c4); *(LAS f32x4*)(ct + 4) = *(const f32x4*)(mu + C_K + c4); *(LAS f32x4*)(ct + 8) = *(const f32x4*)(mu + C_V + c4);
        *(LAS f32x4*)(ct + 12) = *(const f32x4*)(mu + C_WL + 4 * cg); *(LAS f32x4*)(ct + 16) = *(const f32x4*)(mu + C_AL + 4 * cg);
        *(LAS f32x4*)(ct + 20) = *(const f32x4*)(mu + C_GL + 8 * cg); *(LAS f32x4*)(ct + 24) = *(const f32x4*)(mu + C_GL + 8 * cg + 4);
        *(LAS f32x4*)(ct + 28) = *(const f32x4*)(lnx_w + c4); *(LAS f32x4*)(ct + 32) = *(const f32x4*)(lnx_b + c4);
    }
    __syncthreads();
    const LAS float* myct = ctab + cg * 36;
    ZRow zc = ldrow(z + (rowb + tl) * NZ, c4, cg), zp;
    if (tl > 0) zp = ldrow(z + (rowb + tl - 1) * NZ, c4, cg); else { zp.r = zp.k = zp.v = zp.w = zp.a = (v2u){0u, 0u}; zp.g = (v4u){0u, 0u, 0u, 0u}; }
    for (int t0 = 0; t0 < SEQ; t0 += CH) {
        {
            const f32x4 cr = up4(zc.r), ck = up4(zc.k), cv = up4(zc.v), cw = up4(zc.w), ca = up4(zc.a);
            const f32x4 cg0 = (f32x4){pg8::bflo(zc.g.x), pg8::bfhi(zc.g.x), pg8::bflo(zc.g.y), pg8::bfhi(zc.g.y)}, cg1 = (f32x4){pg8::bflo(zc.g.z), pg8::bfhi(zc.g.z), pg8::bflo(zc.g.w), pg8::bfhi(zc.g.w)};
            const f32x4 pr = up4(zp.r), pk = up4(zp.k), pv = up4(zp.v), pw = up4(zp.w), pa = up4(zp.a);
            const f32x4 pg0 = (f32x4){pg8::bflo(zp.g.x), pg8::bfhi(zp.g.x), pg8::bflo(zp.g.y), pg8::bfhi(zp.g.y)}, pg1 = (f32x4){pg8::bflo(zp.g.z), pg8::bfhi(zp.g.z), pg8::bflo(zp.g.w), pg8::bfhi(zp.g.w)};
            if (t0 + CH < SEQ) { zc = ldrow(z + (rowb + t0 + CH + tl) * NZ, c4, cg); zp = ldrow(z + (rowb + t0 + CH + tl - 1) * NZ, c4, cg); }
            const f32x4 rs_ = cr + (pr - cr) * *(const LAS f32x4*)(myct + 0), ks_ = ck + (pk - ck) * *(const LAS f32x4*)(myct + 4), vs_ = cv + (pv - cv) * *(const LAS f32x4*)(myct + 8);
            const f32x4 ws_ = cw + (pw - cw) * *(const LAS f32x4*)(myct + 12), as_ = ca + (pa - ca) * *(const LAS f32x4*)(myct + 16);
            const f32x4 g0_ = cg0 + (pg0 - cg0) * *(const LAS f32x4*)(myct + 20), g1_ = cg1 + (pg1 - cg1) * *(const LAS f32x4*)(myct + 24);
            *(LAS f32x4*)(rkv + 0 * 2048 + tl * 64 + 4 * cg) = rs_; *(LAS f32x4*)(rkv + 1 * 2048 + tl * 64 + 4 * cg) = ks_; *(LAS f32x4*)(rkv + 2 * 2048 + tl * 64 + 4 * cg) = vs_;
            LAS unsigned char* ar = lds + OFF_ACT + tl * ACT_PITCH;
            v2u tw; tw.x = pg8::cvt_pk_bf16(ftanh(ws_[0]), ftanh(ws_[1])); tw.y = pg8::cvt_pk_bf16(ftanh(ws_[2]), ftanh(ws_[3]));
            *(LAS v2u*)(ar + 8 * cg) = tw;
            v2u aw; aw.x = pg8::cvt_pk_bf16(as_[0], as_[1]); aw.y = pg8::cvt_pk_bf16(as_[2], as_[3]);
            *(LAS v2u*)(ar + 128 + 8 * cg) = aw;
            v4u gw; gw.x = pg8::cvt_pk_bf16(fsig(g0_[0]), fsig(g0_[1])); gw.y = pg8::cvt_pk_bf16(fsig(g0_[2]), fsig(g0_[3]));
            gw.z = pg8::cvt_pk_bf16(fsig(g1_[0]), fsig(g1_[1])); gw.w = pg8::cvt_pk_bf16(fsig(g1_[2]), fsig(g1_[3]));
            *(LAS v4u*)(ar + 256 + 16 * cg) = gw;
        }
        __syncthreads();
        f32x4 accw = (f32x4){0.f, 0.f, 0.f, 0.f}, acca = accw, accg = accw;
        {
            const LAS unsigned char* ap = lds + OFF_ACT + (16 * mt + rl) * ACT_PITCH + 8 * rg * 2;
#pragma unroll
            for (int f = 0; f < 8; ++f) {
                const bf16x8 a = *(const LAS bf16x8*)(ap + f * 64);
                if (f < 2) accw = __builtin_amdgcn_mfma_f32_16x16x32_bf16(a, bfr[f], accw, 0, 0, 0);
                else if (f < 4) acca = __builtin_amdgcn_mfma_f32_16x16x32_bf16(a, bfr[f], acca, 0, 0, 0);
                else accg = __builtin_amdgcn_mfma_f32_16x16x32_bf16(a, bfr[f], accg, 0, 0, 0);
            }
        }
        float lw[4], av[4], kk[4];
        {
            const int c = 16 * nt + rl;
            float n2[4];
#pragma unroll
            for (int r = 0; r < 4; ++r) {
                const int tok = 16 * mt + 4 * rg + r;
                gbuf[tok * 64 + c] = accg[r];
                const float nx = -(w0c + accw[r]);
                const float sp = nx > 20.f ? nx : __logf(1.f + __expf(nx));
                lw[r] = -__expf(-sp - 0.5f);
                av[r] = fsig(a0c + acca[r]);
                kk[r] = rkv[1 * 2048 + tok * 64 + c] * kkc;
                n2[r] = kk[r] * kk[r];
            }
            row_allsum4(n2[0], n2[1], n2[2], n2[3]);
            if (rl == 0) {
#pragma unroll
                for (int r = 0; r < 4; ++r) nrm[(16 * mt + 4 * rg + r) * 4 + nt] = n2[r];
            }
        }
        __syncthreads();
        {
            const int c = 16 * nt + rl;
            const float p0 = lw[0], p1 = p0 + lw[1], p2 = p1 + lw[2], p3 = p2 + lw[3];
            const float t1 = __shfl(p3, (lane - 16) & 63), t2 = __shfl(p3, (lane - 32) & 63), t3 = __shfl(p3, (lane - 48) & 63);
            const float E = (rg >= 1 ? t1 : 0.f) + (rg >= 2 ? t2 : 0.f) + (rg >= 3 ? t3 : 0.f);
            const float Ltot = __shfl(E + p3, rl + 48);
            const float pin[4] = {p0, p1, p2, p3};
            float bt[4], kt[4];
#pragma unroll
            for (int r = 0; r < 4; ++r) {
                const int tok = 16 * mt + 4 * rg + r;
                const f32x4 n4 = *(const LAS f32x4*)(nrm + tok * 4);
                const float ksv = rkv[1 * 2048 + tok * 64 + c], rsv = rkv[0 * 2048 + tok * 64 + c];
                const float inv = fminf(__builtin_amdgcn_rsqf((n4[0] + n4[1]) + (n4[2] + n4[3])), 1e12f);
                const float kkn = kk[r] * inv, beta = kkn * av[r], kmod = ksv * (1.f + (av[r] - 1.f) * kac);
                const float L = E + pin[r], eL = __expf(L), ieL = __expf(-L), eLm = __expf(L - lw[r]), eT = __expf(Ltot - L);
                LAS unsigned char* hp = lds + OFF_HAT + tok * HAT_PITCH + c * 2;
                *(LAS bf16_t*)(hp) = f2bf(-kkn * eLm); *(LAS bf16_t*)(hp + HAT_SZ) = f2bf(beta * ieL); *(LAS bf16_t*)(hp + 2 * HAT_SZ) = f2bf(kmod * ieL); *(LAS bf16_t*)(hp + 3 * HAT_SZ) = f2bf(rsv * eL);
                bt[r] = beta * eT; kt[r] = kmod * eT;
                float pbr = beta * rsv, pkr = kmod * rsv, pbo = rsv * kmod * rkc, dum = 0.f;
                row_allsum4(pbr, pkr, pbo, dum);
                if (rl == 0) *(LAS f32x4*)(scp + (tok * 4 + nt) * 4) = (f32x4){pbr, pkr, pbo, 0.f};
            }
            LAS unsigned char* tp = lds + OFF_TIL + (2 * mt) * TIL_SZ + c * TIL_PITCH + 8 * rg;
            v2u w; w.x = pg8::cvt_pk_bf16(bt[0], bt[1]); w.y = pg8::cvt_pk_bf16(bt[2], bt[3]); *(LAS v2u*)(tp) = w;
            w.x = pg8::cvt_pk_bf16(kt[0], kt[1]); w.y = pg8::cvt_pk_bf16(kt[2], kt[3]); *(LAS v2u*)(tp + TIL_SZ) = w;
            if (rg == 0) ((LAS float*)(lds + OFF_WC))[mt * 64 + c] = __expf(Ltot);
        }
        __syncthreads();
        if (tid < CH) {
            const f32x4 p0 = *(const LAS f32x4*)(scp + tid * 16), p1 = *(const LAS f32x4*)(scp + tid * 16 + 4), p2 = *(const LAS f32x4*)(scp + tid * 16 + 8), p3 = *(const LAS f32x4*)(scp + tid * 16 + 12);
            *(LAS f32x4*)(scl + 4 * tid) = (p0 + p1) + (p2 + p3);
        }
        int lane_ = lane; asm volatile("" : "+v"(lane_));
        const int rl_ = lane_ & 15, rg_ = lane_ >> 4;
        {
            const int c = wave >> 2, g = wave & 3;
            const LAS unsigned char* pa = lds + OFF_HAT + ((g & 1) ? 2 : 1) * HAT_SZ + (16 * c + rl_) * HAT_PITCH + 16 * rg_;
            const LAS unsigned char* pb = lds + OFF_HAT + ((g < 2) ? 0 : 3) * HAT_SZ + (16 * c + rl_) * HAT_PITCH + 16 * rg_;
            f32x4 acc = (f32x4){0.f, 0.f, 0.f, 0.f};
            acc = __builtin_amdgcn_mfma_f32_16x16x32_bf16(*(const LAS bf16x8*)(pa), *(const LAS bf16x8*)(pb), acc, 0, 0, 0);
            acc = __builtin_amdgcn_mfma_f32_16x16x32_bf16(*(const LAS bf16x8*)(pa + 64), *(const LAS bf16x8*)(pb + 64), acc, 0, 0, 0);
#pragma unroll
            for (int e = 0; e < 4; ++e) { const int row = 4 * rg_ + e; const bool keep = (g < 2) ? (row < rl_) : (row <= rl_); if (!keep) acc[e] = 0.f; }
            *(LAS f32x4*)(lds + OFF_GR + (c * 5 + g) * 1024 + lane_ * 16) = acc;
            if (g == 0) {
                asm volatile("s_waitcnt lgkmcnt(0)" ::: "memory");
                if (lane_ < 16) {
                    const int sc = lane_;
                    const LAS float* tb = (const LAS float*)(lds + OFF_GR + (c * 5) * 1024);
                    float m[16], ps[16];
#pragma unroll
                    for (int r = 0; r < 16; ++r) ps[r] = 0.f;
#pragma unroll
                    for (int u = 15; u >= 0; --u) {
                        m[u] = (u == sc) ? 1.f : ((u < sc) ? ps[u] : 0.f);
#pragma unroll
                        for (int r = 0; r < u; ++r) ps[r] = __builtin_fmaf(tb[(u + 16 * (r >> 2)) * 4 + (r & 3)], m[u], ps[r]);
                    }
                    LAS f32x4* mt_ = (LAS f32x4*)(lds + OFF_GR + (c * 5 + 4) * 1024);
#pragma unroll
                    for (int q = 0; q < 4; ++q) mt_[sc + 16 * q] = (f32x4){m[4 * q], m[4 * q + 1], m[4 * q + 2], m[4 * q + 3]};
                }
            }
        }
        __syncthreads();
        if (wave < 4) {
            const int ib = wave;
#pragma unroll
            for (int c = 0; c < 2; ++c) {
                bf16x8 sb[2];
#pragma unroll
                for (int ks = 0; ks < 2; ++ks) {
                    v4u p; p.x = pg8::cvt_pk_bf16(ST[2 * ks][0], ST[2 * ks][1]); p.y = pg8::cvt_pk_bf16(ST[2 * ks][2], ST[2 * ks][3]);
                    p.z = pg8::cvt_pk_bf16(ST[2 * ks + 1][0], ST[2 * ks + 1][1]); p.w = pg8::cvt_pk_bf16(ST[2 * ks + 1][2], ST[2 * ks + 1][3]);
                    sb[ks] = __builtin_bit_cast(bf16x8, p);
                }
                const LAS unsigned char* ha = lds + OFF_HAT + (16 * c + rl_) * HAT_PITCH + 8 * rg_;
                f32x4 xt = (f32x4){0.f, 0.f, 0.f, 0.f}, yt = xt;
#pragma unroll
                for (int ks = 0; ks < 2; ++ks) {
                    v4u fa, fr; const v2u a0_ = *(const LAS v2u*)(ha + 64 * ks), a1_ = *(const LAS v2u*)(ha + 64 * ks + 32);
                    const v2u r0_ = *(const LAS v2u*)(ha + 3 * HAT_SZ + 64 * ks), r1_ = *(const LAS v2u*)(ha + 3 * HAT_SZ + 64 * ks + 32);
                    fa.x = a0_.x; fa.y = a0_.y; fa.z = a1_.x; fa.w = a1_.y; fr.x = r0_.x; fr.y = r0_.y; fr.z = r1_.x; fr.w = r1_.y;
                    xt = __builtin_amdgcn_mfma_f32_16x16x32_bf16(__builtin_bit_cast(bf16x8, fa), sb[ks], xt, 0, 0, 0);
                    yt = __builtin_amdgcn_mfma_f32_16x16x32_bf16(__builtin_bit_cast(bf16x8, fr), sb[ks], yt, 0, 0, 0);
                }
                const LAS float* vsrc = rkv + 2 * 2048 + (16 * c + 4 * rg_) * 64 + 16 * ib + rl_;
                v2u vb_; vb_.x = pg8::cvt_pk_bf16(vsrc[0], vsrc[64]); vb_.y = pg8::cvt_pk_bf16(vsrc[128], vsrc[192]);
                const s16x4 vb = __builtin_bit_cast(s16x4, vb_);
                const LAS unsigned char* gr = lds + OFF_GR + (c * 5) * 1024 + lane_ * 16;
#define RW_AFR(g_) ({ const f32x4 t_ = *(const LAS f32x4*)(gr + (g_) * 1024); v2u w_; w_.x = pg8::cvt_pk_bf16(t_[0], t_[1]); w_.y = pg8::cvt_pk_bf16(t_[2], t_[3]); __builtin_bit_cast(s16x4, w_); })
#define RW_PK4(x_) ({ v2u w_; w_.x = pg8::cvt_pk_bf16((x_)[0], (x_)[1]); w_.y = pg8::cvt_pk_bf16((x_)[2], (x_)[3]); __builtin_bit_cast(s16x4, w_); })
                const f32x4 zt = __builtin_amdgcn_mfma_f32_16x16x16bf16_1k(RW_AFR(1), vb, xt, 0, 0, 0);
                const f32x4 ut = __builtin_amdgcn_mfma_f32_16x16x16bf16_1k(RW_AFR(4), RW_PK4(zt), (f32x4){0.f, 0.f, 0.f, 0.f}, 0, 0, 0);
                const s16x4 ub = RW_PK4(ut);
                yt = __builtin_amdgcn_mfma_f32_16x16x16bf16_1k(RW_AFR(2), ub, yt, 0, 0, 0);
                yt = __builtin_amdgcn_mfma_f32_16x16x16bf16_1k(RW_AFR(3), vb, yt, 0, 0, 0);
#pragma unroll
                for (int e = 0; e < 4; ++e) ybuf[(16 * c + 4 * rg_ + e) * 64 + 16 * ib + rl_] = yt[e];
                const LAS unsigned char* tl_ = lds + OFF_TIL + (2 * c) * TIL_SZ + rl_ * TIL_PITCH + 8 * rg_;
                const LAS float* wc = (const LAS float*)(lds + OFF_WC) + c * 64 + 4 * rg_;
#pragma unroll
                for (int jt = 0; jt < 4; ++jt) {
                    f32x4 acc = ST[jt] * *(const LAS f32x4*)(wc + 16 * jt);
                    acc = __builtin_amdgcn_mfma_f32_16x16x16bf16_1k(*(const LAS s16x4*)(tl_ + TIL_SZ + 16 * jt * TIL_PITCH), vb, acc, 0, 0, 0);
                    acc = __builtin_amdgcn_mfma_f32_16x16x16bf16_1k(*(const LAS s16x4*)(tl_ + 16 * jt * TIL_PITCH), ub, acc, 0, 0, 0);
                    ST[jt] = acc;
                }
#undef RW_AFR
#undef RW_PK4
            }
        }
        __syncthreads();
        {
            const f32x4 y4 = *(const LAS f32x4*)(ybuf + tl * 64 + 4 * cg);
            const float mean = row_allsum((y4[0] + y4[1]) + (y4[2] + y4[3])) * (1.f / 64.f);
            const f32x4 dv = y4 - mean;
            const float var = row_allsum((dv[0] * dv[0] + dv[1] * dv[1]) + (dv[2] * dv[2] + dv[3] * dv[3])) * (1.f / 64.f);
            const float rs_ = rsqrtf(var + GN_EPS);
            const f32x4 yn = dv * rs_ * *(const LAS f32x4*)(myct + 28) + *(const LAS f32x4*)(myct + 32);
            const float bonus = scl[tl * 4 + 2];
            const f32x4 vs_ = *(const LAS f32x4*)(rkv + 2 * 2048 + tl * 64 + 4 * cg), g4 = *(const LAS f32x4*)(gbuf + tl * 64 + 4 * cg);
            const f32x4 o = (yn + vs_ * bonus) * g4;
            v2u w; w.x = pg8::cvt_pk_bf16(o[0], o[1]); w.y = pg8::cvt_pk_bf16(o[2], o[3]);
            *(v2u*)(ya + (rowb + t0 + tl) * 512 + c4) = w;
        }
        __syncthreads();
    }
}
}

typedef __bf16 bf16x2_t __attribute__((ext_vector_type(2)));
__device__ __forceinline__ float dot2bf(unsigned a, unsigned b, float c) { return __builtin_amdgcn_fdot2_f32_bf16(__builtin_bit_cast(bf16x2_t, a), __builtin_bit_cast(bf16x2_t, b), c, false); }
__device__ __forceinline__ unsigned f2ord(float f) { const unsigned u = __float_as_uint(f); return (u & 0x80000000u) ? ~u : (u | 0x80000000u); }
__device__ __forceinline__ float ord2f(unsigned o) { return __uint_as_float((o & 0x80000000u) ? (o ^ 0x80000000u) : ~o); }
__device__ __forceinline__ unsigned row_allmax_u32(unsigned v) {
    v = max(v, (unsigned)__builtin_amdgcn_update_dpp(0, (int)v, 0x128, 0xf, 0xf, false));
    v = max(v, (unsigned)__builtin_amdgcn_update_dpp(0, (int)v, 0x124, 0xf, 0xf, false));
    v = max(v, (unsigned)__builtin_amdgcn_update_dpp(0, (int)v, 0x122, 0xf, 0xf, false));
    v = max(v, (unsigned)__builtin_amdgcn_update_dpp(0, (int)v, 0x121, 0xf, 0xf, false));
    return v;
}

constexpr int TK_PITCH = 272, TK_HALF = 128 * TK_PITCH;
typedef short tk_bf16x8 __attribute__((ext_vector_type(8)));
__device__ __forceinline__ void topk_loadq(tk_bf16x8 (&qa)[8], const bf16_t* __restrict__ qb, int t0, int h, int lane) {
    const bf16_t* qp = qb + (size_t)(t0 + (lane & 15)) * 2048 + h * 256 + 8 * (lane >> 4);
#pragma unroll
    for (int i = 0; i < 8; ++i) qa[i] = *(const tk_bf16x8*)(qp + i * 32);
}
__device__ __forceinline__ void topk_item(const tk_bf16x8 (&qa)[8], const LAS unsigned char* klds, int* __restrict__ ids, float* __restrict__ gates, int t0, int h, int lane) {
    const int rl = lane & 15, rg = lane >> 4;
    unsigned top[2][4];
#pragma unroll
    for (int c = 0; c < 2; ++c) {
        f32x4 acc[8];
#pragma unroll
        for (int nt = 0; nt < 8; ++nt) acc[nt] = (f32x4){64.f, 64.f, 64.f, 64.f};
        const LAS unsigned char* kp = klds + c * TK_HALF + rl * TK_PITCH + 16 * rg;
#pragma unroll
        for (int ks = 0; ks < 4; ++ks) {
#pragma unroll
            for (int nt = 0; nt < 8; ++nt) { const tk_bf16x8 b = *(const LAS tk_bf16x8*)(kp + nt * 16 * TK_PITCH + ks * 64); acc[nt] = __builtin_amdgcn_mfma_f32_16x16x32_bf16(qa[c * 4 + ks], b, acc[nt], 0, 0, 0); }
            __builtin_amdgcn_sched_barrier(0);
        }
        unsigned k[4][8];
#pragma unroll
        for (int r = 0; r < 4; ++r) {
#pragma unroll
            for (int nt = 0; nt < 8; ++nt) k[r][nt] = (__float_as_uint(fmaxf(acc[nt][r], 1.f)) & ~127u) | (unsigned)(127 - (nt * 16 + rl));
#define TK_CE(i, j) do { const unsigned a_ = max(k[r][i], k[r][j]), b_ = min(k[r][i], k[r][j]); k[r][i] = a_; k[r][j] = b_; } while (0)
            TK_CE(0, 1); TK_CE(2, 3); TK_CE(4, 5); TK_CE(6, 7); TK_CE(0, 2); TK_CE(1, 3); TK_CE(4, 6); TK_CE(5, 7); TK_CE(1, 2); TK_CE(5, 6);
            TK_CE(0, 4); TK_CE(1, 5); TK_CE(2, 6); TK_CE(3, 7); TK_CE(2, 4); TK_CE(3, 5); TK_CE(1, 2); TK_CE(3, 4); TK_CE(5, 6);
#undef TK_CE
        }
        unsigned tp[4] = {0u, 0u, 0u, 0u};
        for (int round = 0; round < 16; ++round) {
#pragma unroll
            for (int r = 0; r < 4; ++r) {
                const unsigned m = row_allmax_u32(k[r][0]);
                tp[r] = (rl == round) ? m : tp[r];
                const bool win = (k[r][0] == m);
                k[r][0] = win ? k[r][1] : k[r][0]; k[r][1] = win ? k[r][2] : k[r][1]; k[r][2] = win ? k[r][3] : k[r][2]; k[r][3] = win ? k[r][4] : k[r][3];
                k[r][4] = win ? k[r][5] : k[r][4]; k[r][5] = win ? k[r][6] : k[r][5]; k[r][6] = win ? k[r][7] : k[r][6]; k[r][7] = win ? 0u : k[r][7];
            }
        }
#pragma unroll
        for (int r = 0; r < 4; ++r) top[c][r] = tp[r];
    }
    const int rowbase = lane & 48;
    float v1[4]; int n1[4], ptr[4], myid[4]; unsigned k2[4], myv[4];
#pragma unroll
    for (int r = 0; r < 4; ++r) { v1[r] = __uint_as_float(top[0][r] & ~127u); n1[r] = 127 - (int)(top[0][r] & 127u); ptr[r] = 0; k2[r] = (unsigned)__builtin_amdgcn_ds_bpermute(rowbase * 4, (int)top[1][r]); myid[r] = 0; myv[r] = 0u; }
    for (int round = 0; round < 16; ++round) {
#pragma unroll
        for (int r = 0; r < 4; ++r) {
            const float head = v1[r] + __uint_as_float(k2[r] & ~127u);
            const unsigned key = (ptr[r] < 16) ? ((__float_as_uint(head) & ~15u) | (unsigned)(15 - rl)) : 0u;
            const unsigned m = row_allmax_u32(key);
            const bool win = (key == m);
            const unsigned wid = row_allmax_u32(win ? (unsigned)(n1[r] * 128 + (127 - (int)(k2[r] & 127u))) + 1u : 0u);
            myid[r] = (rl == round) ? (int)wid - 1 : myid[r];
            myv[r] = (rl == round) ? m : myv[r];
            ptr[r] += win ? 1 : 0;
            k2[r] = (unsigned)__builtin_amdgcn_ds_bpermute((rowbase + (ptr[r] & 15)) * 4, (int)top[1][r]);
        }
    }
#pragma unroll
    for (int r = 0; r < 4; ++r) {
        const float val = __uint_as_float(myv[r] & ~15u);
        const float vmax = __uint_as_float((unsigned)__builtin_amdgcn_ds_bpermute(rowbase * 4, (int)__float_as_uint(val)));
        const float e = __expf(val - vmax);
        const float sum = rw::row_allsum(e);
        gates[(size_t)(t0 + 4 * rg + r) * 128 + h * 16 + rl] = e * __builtin_amdgcn_rcpf(sum); ids[(size_t)(t0 + 4 * rg + r) * 128 + h * 16 + rl] = myid[r];
    }
}

typedef float f32x2 __attribute__((ext_vector_type(2)));
__device__ __forceinline__ void peer_token(const bf16_t* __restrict__ x2b, const float* __restrict__ ssq2, const int* __restrict__ ids, const float* __restrict__ gates,
                                           const unsigned char* __restrict__ U8, const unsigned char* __restrict__ V8, const float* __restrict__ usc, const float* __restrict__ vsc,
                                           const float* __restrict__ fw, float* __restrict__ out, int t, int lane) {
    const int l16 = lane * 16;
    f32x2 hx[8];
    {
        const v4u h0 = *(const v4u*)(x2b + (size_t)t * DM + l16), h1 = *(const v4u*)(x2b + (size_t)t * DM + l16 + 8);
        const unsigned hw[8] = {h0.x, h0.y, h0.z, h0.w, h1.x, h1.y, h1.z, h1.w};
#pragma unroll
        for (int i = 0; i < 8; ++i) hx[i] = (f32x2){pg8::bflo(hw[i]), pg8::bfhi(hw[i])};
    }
    const int idA = ids[(size_t)t * 128 + lane], idB = ids[(size_t)t * 128 + 64 + lane];
    const float rs = rsqrtf(pg8::ssq_sum16(ssq2 + (size_t)t * 16) * (1.f / DM) + NORM_EPS);
    const float suA = rs * usc[idA], suB = rs * usc[idB];
    const float svA = gates[(size_t)t * 128 + lane] * vsc[idA], svB = gates[(size_t)t * 128 + 64 + lane] * vsc[idB];
    f32x2 y[8];
#pragma unroll
    for (int i = 0; i < 8; ++i) y[i] = (f32x2){0.f, 0.f};
    const int bit0 = lane & 1, bit1 = (lane >> 1) & 1, bit5 = lane >> 5;
    v3u_t uw[8], vw[8];
    const unsigned vo12 = (unsigned)lane * 12u;
#define PEER_LDU(g_) do { const int is_ = ((g_) < 8) ? idA : idB; const int lb_ = ((g_) * 8) & 63; _Pragma("unroll") for (int k = 0; k < 8; ++k) { const unsigned eo = (unsigned)__builtin_amdgcn_readlane(is_, lb_ + k) * 768u; \
        const unsigned char* rp_ = U8 + eo; uw[k] = *(const v3u_t*)(rp_ + vo12); } } while (0)
#define PEER_LDV(g_) do { const int is_ = ((g_) < 8) ? idA : idB; const int lb_ = ((g_) * 8) & 63; _Pragma("unroll") for (int k = 0; k < 8; ++k) { const unsigned eo = (unsigned)__builtin_amdgcn_readlane(is_, lb_ + k) * 768u; \
        const unsigned char* rp_ = V8 + eo; vw[k] = *(const v3u_t*)(rp_ + vo12); } } while (0)
    PEER_LDU(0); PEER_LDV(0);
    for (int g = 0; g < 16; ++g) {
        const float susel = (g < 8) ? suA : suB, svsel = (g < 8) ? svA : svB; const int lb = (g * 8) & 63;
        float d[8];
#pragma unroll
        for (int k = 0; k < 8; k += 2) {
            const v32f_t f = __builtin_amdgcn_cvt_scalef32_pk32_f32_fp6((v6u_t){uw[k][0], uw[k][1], uw[k][2], uw[k + 1][0], uw[k + 1][1], uw[k + 1][2]}, 1.0f);
            f32x2 a = (f32x2){0.f, 0.f}, b = a;
#pragma unroll
            for (int i = 0; i < 8; ++i) { a += (f32x2){f[2 * i], f[2 * i + 1]} * hx[i]; b += (f32x2){f[16 + 2 * i], f[17 + 2 * i]} * hx[i]; }
            d[k] = a[0] + a[1]; d[k + 1] = b[0] + b[1];
            __builtin_amdgcn_sched_barrier(0);
        }
        if (g + 1 < 16) PEER_LDU(g + 1);
        __builtin_amdgcn_sched_barrier(0);
#pragma unroll
        for (int k = 0; k < 8; ++k) d[k] *= __uint_as_float((unsigned)__builtin_amdgcn_readlane((int)__float_as_uint(susel), lb + k));
        float r4[4];
#pragma unroll
        for (int k = 0; k < 4; ++k) { const float send = bit0 ? d[k] : d[k + 4], keep = bit0 ? d[k + 4] : d[k]; r4[k] = keep + rw::dppf<0xB1>(send); }
        float r2[2];
#pragma unroll
        for (int k = 0; k < 2; ++k) { const float send = bit1 ? r4[k] : r4[k + 2], keep = bit1 ? r4[k + 2] : r4[k]; r2[k] = keep + rw::dppf<0x4E>(send); }
        float r1;
        { const float send = bit5 ? r2[0] : r2[1], keep = bit5 ? r2[1] : r2[0];
          auto rr = __builtin_amdgcn_permlane32_swap(__float_as_uint(send), __float_as_uint(send), false, false);
          r1 = keep + __uint_as_float(bit5 ? rr[0] : rr[1]); }
        r1 += rw::dppf<0x128>(r1); r1 += rw::dppf<0x124>(r1);
        r1 += __uint_as_float((unsigned)__builtin_amdgcn_ds_swizzle((int)__float_as_uint(r1), 0x401F));
        const float dd = r1;
        const float act = 0.5f * dd * (1.f + erff(dd * 0.70710678118654752f));
#pragma unroll
        for (int k = 0; k < 8; k += 2) {
#define PEER_LANE_OF(k_) ((((k_) >> 2) & 1) | ((((k_) >> 1) & 1) << 1) | (((k_) & 1) << 5))
            const float a = __uint_as_float((unsigned)__builtin_amdgcn_readlane((int)__float_as_uint(act), PEER_LANE_OF(k))) * __uint_as_float((unsigned)__builtin_amdgcn_readlane((int)__float_as_uint(svsel), lb + k));
            const float b = __uint_as_float((unsigned)__builtin_amdgcn_readlane((int)__float_as_uint(act), PEER_LANE_OF(k + 1))) * __uint_as_float((unsigned)__builtin_amdgcn_readlane((int)__float_as_uint(svsel), lb + k + 1));
#undef PEER_LANE_OF
            const f32x2 a2 = (f32x2){a, a}, b2 = (f32x2){b, b};
            const v32f_t f = __builtin_amdgcn_cvt_scalef32_pk32_f32_fp6((v6u_t){vw[k][0], vw[k][1], vw[k][2], vw[k + 1][0], vw[k + 1][1], vw[k + 1][2]}, 1.0f);
#pragma unroll
            for (int i = 0; i < 8; ++i) { y[i] += (f32x2){f[2 * i], f[2 * i + 1]} * a2; y[i] += (f32x2){f[16 + 2 * i], f[17 + 2 * i]} * b2; }
            __builtin_amdgcn_sched_barrier(0);
        }
        if (g + 1 < 16) PEER_LDV(g + 1);
        __builtin_amdgcn_sched_barrier(0);
    }
#undef PEER_LDU
#undef PEER_LDV
    float* orow = out + (size_t)t * DM + l16;
    float ss = 0.f;
    f32x4 o4[4];
#pragma unroll
    for (int i = 0; i < 4; ++i) { o4[i] = (f32x4){hx[2 * i][0] + y[2 * i][0], hx[2 * i][1] + y[2 * i][1], hx[2 * i + 1][0] + y[2 * i + 1][0], hx[2 * i + 1][1] + y[2 * i + 1][1]};
        ss += (o4[i][0] * o4[i][0] + o4[i][1] * o4[i][1]) + (o4[i][2] * o4[i][2] + o4[i][3] * o4[i][3]); }
    ss = wave_sum(ss);
    const float r = rsqrtf(ss * (1.f / DM) + NORM_EPS);
#pragma unroll
    for (int i = 0; i < 4; ++i) *(f32x4*)(orow + 4 * i) = o4[i] * r * *(const f32x4*)(fw + l16 + 4 * i);
}

__global__ void __launch_bounds__(NWAVES * 64, 2) mk_fwd(Args args) {
    extern __shared__ __attribute__((aligned(16))) unsigned char lds_raw[];
    LAS unsigned char* lds = (LAS unsigned char*)lds_raw;
    volatile LAS unsigned* MISC = (volatile LAS unsigned*)(lds + MISC_OFF);
    const int tid = threadIdx.x, lane = tid & 63, wave = __builtin_amdgcn_readfirstlane(tid >> 6);
    const int G = gridDim.x; const int bx = blockIdx.x; const int vcu = (G % 8 == 0) ? (bx % 8) * (G / 8) + bx / 8 : bx;
    unsigned char* ws = args.ws;
    unsigned* ctl = (unsigned*)(ws + WS_CTL);
    for (int u = tid; u < (LDS_BYTES - LDSCTL_OFF) / 4; u += NWAVES * 64) ((LAS unsigned*)(lds + LDSCTL_OFF))[u] = 0u;
    __syncthreads();
    XcdBarrier bar = xcd_barrier_post(ctl + CW_BAR + args.li * XCD_BAR_WORDS, MISC + 8);
    const int lo = args.ph_lo, hi = args.ph_hi;
#define IN(k) (lo <= (k) && (k) < hi)
#define BOTH(k) (IN(k) && IN((k) + 1))
    bf16_t* WinT = (bf16_t*)(ws + WS_WIN); bf16_t* PaT = (bf16_t*)(ws + WS_PA); bf16_t* PbT = (bf16_t*)(ws + WS_PB); bf16_t* WoT = (bf16_t*)(ws + WS_WO);
    bf16_t* WqT = (bf16_t*)(ws + WS_WQ); bf16_t* KeysB = (bf16_t*)(ws + WS_KEYS);
    float* rstd1 = (float*)(ws + WS_RSTD1); float* ssq2 = (float*)(ws + WS_RSTD2); float* scal = (float*)(ws + WS_SCAL);
    unsigned char* U8 = ws + WS_U; unsigned char* V8 = ws + WS_V; float* usc = (float*)(ws + WS_USC); float* vsc = (float*)(ws + WS_VSC);
    bf16_t* xb = (bf16_t*)(ws + WS_XB); bf16_t* ya = (bf16_t*)(ws + WS_YA); bf16_t* yb = (bf16_t*)(ws + WS_YB); bf16_t* x2b = (bf16_t*)(ws + WS_X2B);
    bf16_t* z = (bf16_t*)(ws + WS_Z); bf16_t* qb = (bf16_t*)(ws + WS_Q);
    bf16_t* merged = (bf16_t*)(ws + WS_MERGED);
    const int gw = vcu * NWAVES + wave, NGW = G * NWAVES;

    if (IN(0)) {
        LAS float* scr = (LAS float*)(lds + wave * 16384);
        constexpr int I_IN = (DM / 64) * (NZ / 32), I_PA = (512 / 64) * (DM / 32), I_WO = (DM / 64) * (DM / 32), I_WQ = (DM / 64) * (2048 / 32);
        constexpr int NITEMS = I_IN + 2 * I_PA + I_WO + I_WQ;
        for (int it = gw; it < NITEMS; it += NGW) {
            int r = it;
            if (r < I_IN) { p0_transpose_item(args.in[2], args.in[1], DM, NZ, WinT, scr, r, lane, ws + WS_WG8, C_GA); continue; } r -= I_IN;
            if (r < I_PA) { p0_transpose_item(args.in[19], nullptr, 512, DM, PaT, scr, r, lane); continue; } r -= I_PA;
            if (r < I_PA) { p0_transpose_item(args.in[20], nullptr, 512, DM, PbT, scr, r, lane); continue; } r -= I_PA;
            if (r < I_WO) { p0_transpose_item(args.in[21], nullptr, DM, DM, WoT, scr, r, lane); continue; } r -= I_WO;
            p0_transpose_item(args.in[23], args.in[22], DM, 2048, WqT, scr, r, lane);
        }
        p0_convert(args.in[24], nullptr, KeysB, (size_t)16 * 128 * 128, gw, NGW, lane);
        for (int e = gw; e < 2 * NEXP; e += NGW) {
            const bool isu = e < NEXP; const int row = isu ? e : e - NEXP;
            p0_row_fp6((isu ? args.in[25] : args.in[26]) + (size_t)row * DM, isu ? args.in[22] : nullptr, (isu ? U8 : V8) + (size_t)row * 768, (isu ? usc : vsc) + row, lane);
        }
        for (int m = gw; m < T_TOK; m += NGW) {
            const f32x4* xr = (const f32x4*)(args.in[0] + (size_t)m * DM) + lane;
            f32x4 v[4]; float s = 0.f;
#pragma unroll
            for (int j = 0; j < 4; ++j) { v[j] = xr[64 * j]; s += (v[j][0] * v[j][0] + v[j][1] * v[j][1]) + (v[j][2] * v[j][2] + v[j][3] * v[j][3]); }
            s = wave_sum(s);
            v2u* o8 = (v2u*)(xb + (size_t)m * DM) + lane;
#pragma unroll
            for (int j = 0; j < 4; ++j) { v2u w; w.x = pg8::cvt_pk_bf16(v[j][0], v[j][1]); w.y = pg8::cvt_pk_bf16(v[j][2], v[j][3]); o8[64 * j] = w;
                int p = 0; p = __builtin_amdgcn_cvt_pk_fp8_f32(v[j][0], v[j][1], p, false); p = __builtin_amdgcn_cvt_pk_fp8_f32(v[j][2], v[j][3], p, true);
                ((unsigned*)(ws + WS_XQ + (size_t)m * DM))[lane + 64 * j] = (unsigned)p; }
            if (lane == 0) rstd1[m] = rsqrtf(s * (1.f / DM) + NORM_EPS);
        }
        if (gw == 0) {
            const float a = wave_sum(args.in[14][lane] * args.in[15][lane]), b = wave_sum(args.in[16][lane] * args.in[17][lane]);
            if (lane == 0) scal[0] = __expf(a) - __expf(b) + LAM_INIT;
        }
        if (BOTH(0)) xcd_barrier(bar);
    }
    if (IN(1)) {
        {
            pg8::Gemm g{xb, WinT, DM, DM, DM}; pg8::StaticOrder S; S.init(T_TOK, C_GA, G, bx);
            pg8::EpiRowScale<false> E{z, NZ, rstd1};
            pg8::gemm_phase(lds, g, S, E);
        }
        {
            pg8::Gemm g{(const bf16_t*)(ws + WS_XQ), (const bf16_t*)(ws + WS_WG8), DM / 2, DM / 2, DM / 2}; pg8::StaticOrder S; S.init(T_TOK, NZ - C_GA, G, bx);
            pg8::EpiRowScale<false> E{z + C_GA, NZ, rstd1, 1.f / 32.f};
            pg8::gemm_phase<pg8::EpiRowScale<false>, pg8::StaticOrder, true>(lds, g, S, E);
        }
        if (BOTH(1)) xcd_barrier(bar);
    }
    if (IN(2)) {
        {
            const rw::ScanP P{args.in[3], args.in[4], args.in[5], args.in[6], args.in[7], args.in[8], args.in[9], args.in[10], args.in[11], args.in[12], args.in[13]};
            for (int rep = 0; rep < REPS(2); ++rep) for (int u = vcu; u < NB * 8; u += G) rw::scan_unit(lds, z, ya, P, u >> 3, u & 7, tid, wave, lane);
        }
        const float lam = scal[0];
        __syncthreads();
        for (int i = 0;; ++i) {
            int idx = vcu + i * G; if (idx >= 2048 * REPS(10)) break;
            idx &= 2047;
            const int slot = idx >> 8, v = idx & 255, bh = v >> 1, a = (v & 1) * 4 + (slot >> 1), qblk = (slot & 1) ? 15 - a : a;
            da::attn_unit(lds, z, yb, args.in[18], lam, bh >> 2, bh & 3, qblk, wave, lane);
        }
        if (BOTH(2)) xcd_barrier(bar);
    }
    if (IN(3)) {
        pg8::Gemm g{ya, PaT, 512, 512, 512}; pg8::StaticOrder S; S.init(T_TOK, DM, G, bx);
        pg8::EpiGate<false> E{merged, z, C_GA};
        pg8::gemm_phase(lds, g, S, E);
        if (BOTH(3)) xcd_barrier(bar);
    }
    if (IN(4)) {
        pg8::Gemm g{yb, PbT, 512, 512, 512}; pg8::StaticOrder S; S.init(T_TOK, DM, G, bx);
        pg8::EpiGate<true> E{merged, z, C_GB};
        pg8::gemm_phase(lds, g, S, E);
        if (BOTH(4)) xcd_barrier(bar);
    }
    if (IN(5)) {
        pg8::Gemm g{merged, WoT, DM, DM, DM}; pg8::StaticOrder S; S.init(T_TOK, DM, G, bx);
        pg8::EpiX2 E{args.in[0], args.out, x2b, ssq2};
        pg8::gemm_phase(lds, g, S, E);
        if (BOTH(5)) xcd_barrier(bar);
    }
    if (IN(6)) {
        pg8::Gemm g{x2b, WqT, DM, DM, DM}; pg8::StaticOrder S; S.init(T_TOK, 2048, G, bx);
        pg8::EpiRowScale<true> E{qb, 2048, ssq2};
        for (int rep = 0; rep < REPS(6); ++rep) pg8::gemm_phase(lds, g, S, E);
        if (BOTH(6)) xcd_barrier(bar);
    }
    if (IN(7)) {
        int* ids = (int*)(ws + WS_IDS); float* gates = (float*)(ws + WS_GATES);
        for (int rep = 0; rep < REPS(7); ++rep)
        for (int h = 0; h < 8; ++h) {
            __syncthreads();
            {
                const bf16_t* ksrc = KeysB + (size_t)h * 2 * 128 * 128;
#pragma unroll
                for (int i = 0; i < 8; ++i) { const int chunk = tid + i * 512, row = chunk >> 4, cc = chunk & 15;
                    *(LAS v4u*)(lds + (row >> 7) * TK_HALF + (row & 127) * TK_PITCH + cc * 16) = *(const v4u*)(ksrc + (size_t)row * 128 + cc * 8); }
            }
            __syncthreads();
            for (int tile = gw; tile < 4096; tile += NGW) {
                tk_bf16x8 qa[8];
                topk_loadq(qa, qb, tile * 16, h, lane);
                topk_item(qa, lds, ids, gates, tile * 16, h, lane);
            }
        }
        if (BOTH(7)) xcd_barrier(bar);
    }
    if (IN(8)) {
        const int* ids = (const int*)(ws + WS_IDS); const float* gates = (const float*)(ws + WS_GATES);
        for (int t = gw; t < T_TOK; t += NGW) peer_token(x2b, ssq2, ids, gates, U8, V8, usc, vsc, args.in[27], args.out, t, lane);
    }
#undef IN
#undef BOTH
}

extern "C" void kernel_launch(void* const* d_in, const int* in_sizes, int n_in, void* d_out, int out_size, void* d_ws, size_t ws_size, hipStream_t stream) {
    static int grid = 0;
    if (grid == 0) {
        if (n_in != 28 || in_sizes[0] != T_TOK * DM || out_size != T_TOK * DM || ws_size < WS_END) {
            fprintf(stderr, "kernel_launch: unexpected shapes / workspace (n_in %d, ws %zu < %zu)\n", n_in, ws_size, (size_t)WS_END); grid = -1; return; }
        int dev = 0, cus = 0;
        if (hipGetDevice(&dev) != hipSuccess || hipDeviceGetAttribute(&cus, hipDeviceAttributeMultiprocessorCount, dev) != hipSuccess) { grid = -1; return; }
        if (hipFuncSetAttribute((const void*)mk_fwd, hipFuncAttributeMaxDynamicSharedMemorySize, LDS_BYTES) != hipSuccess) { fprintf(stderr, "kernel_launch: hipFuncSetAttribute failed\n"); grid = -1; return; }
        grid = cus;
    }
    if (grid < 0) return;
    unsigned char* ws = (unsigned char*)d_ws;
    float* out = (float*)d_out;
    (void)hipMemsetAsync(ws + WS_CTL, 0, 1 * MiB, stream);
    Args a{};
    for (int i = 0; i < 28; ++i) a.in[i] = (const float*)d_in[i];
    a.out = out; a.ws = ws;
    a.ph_lo = 0; a.ph_hi = 9; a.li = 0;
    hipLaunchKernelGGL(mk_fwd, dim3(grid), dim3(NWAVES * 64), LDS_BYTES, stream, a);
}
```

```cpp
#include <hip/hip_runtime.h>
#include <stdint.h>
#include <cstdio>

typedef unsigned short bf16_t;
typedef unsigned int u32;

#ifndef PROBE_REP
#define PROBE_REP 0
#endif
#define REPS(k) (((PROBE_REP >> (k)) & 1) ? 2 : 1)
constexpr int T_TOK = 65536, DM = 1024, SEQ = 2048, NB = 32;
constexpr int NZ = 5376;
constexpr int C_R = 0, C_K = 512, C_V = 1024, C_WL = 1536, C_AL = 1600, C_GL = 1664, C_Q = 1792, C_ZK = 2304, C_ZV = 2816, C_GA = 3328, C_GB = 4352;
constexpr int NEXP = 16384;
constexpr float NORM_EPS = 1e-6f, GN_EPS = 64e-5f, SUBLN_EPS = 1e-5f;
constexpr float LAM_INIT = 0.2f;

constexpr size_t MiB = 1u << 20;
constexpr size_t WS_CTL = 0;
constexpr size_t WS_WIN = 1 * MiB;
constexpr size_t WS_PA = 12 * MiB;
constexpr size_t WS_PB = 13 * MiB;
constexpr size_t WS_WO = 14 * MiB;
constexpr size_t WS_WQ = 16 * MiB;
constexpr size_t WS_KEYS = 20 * MiB;
constexpr size_t WS_RSTD1 = 21 * MiB;
constexpr size_t WS_RSTD2 = 58 * MiB;
constexpr size_t WS_SCAL = 23 * MiB;
constexpr size_t WS_U = 24 * MiB;
constexpr size_t WS_V = 40 * MiB;
constexpr size_t WS_USC = 56 * MiB;
constexpr size_t WS_VSC = 57 * MiB;
constexpr size_t WS_XB = 88 * MiB;
constexpr int YAB_PITCH = 1024;
constexpr size_t WS_YA = WS_XB;
constexpr size_t WS_YB = WS_XB + 1024;
constexpr size_t WS_X2B = WS_XB;
constexpr size_t WS_Z = 216 * MiB;
constexpr size_t WS_Q = WS_Z;
constexpr size_t WS_IDS = WS_Z + 256 * MiB;
constexpr size_t WS_GATES = WS_Z + 288 * MiB;
constexpr size_t WS_MERGED = 888 * MiB;
constexpr size_t WS_XQ = WS_MERGED;
constexpr size_t WS_WG8 = WS_MERGED + 64 * MiB;
constexpr size_t WS_END = 1016 * MiB;

__device__ __forceinline__ float bf2f(bf16_t h) { return __uint_as_float(((u32)h) << 16); }
__device__ __forceinline__ bf16_t f2bf(float f) { u32 u = __float_as_uint(f); u += 0x7fffu + ((u >> 16) & 1u); return (bf16_t)(u >> 16); }
__device__ __forceinline__ float wave_sum(float v) {
#pragma unroll
    for (int o = 1; o < 64; o <<= 1) v += __shfl_xor(v, o);
    return v;
}
__device__ __forceinline__ float sigmoidf_(float x) { return __builtin_amdgcn_rcpf(1.f + __expf(-x)); }

namespace pg8 {
#define PG8_LAS __attribute__((address_space(3)))
typedef short bf16x8 __attribute__((ext_vector_type(8)));
typedef float f32x4 __attribute__((ext_vector_type(4)));
typedef unsigned u32x4 __attribute__((ext_vector_type(4)));
constexpr int BM = 256, BK = 64, HALF = 128, HTB = HALF * BK * 2  , STAGE_BYTES = 8 * HTB, NXCD = 8, WGM = 8;

__host__ __device__ __forceinline__ int lds_byte(int r, int c) { const int st = (r >> 4) * 2 + (c >> 5), rr = r & 15, cc = c & 31, ob = rr * 64 + cc * 2; return st * 1024 + (ob ^ (((ob >> 9) & 1) << 5)); }
__host__ __device__ __forceinline__ void stage_rc(int b, int& R, int& C) { const int st = b / 1024, sb = b % 1024, swz = sb ^ (((sb >> 9) & 1) << 5); R = (st >> 1) * 16 + swz / 64; C = (st & 1) * 32 + (swz % 64) / 2; }
__host__ __device__ __forceinline__ int perm32(int rho) { const int n = rho >> 4, i = rho & 15; return 8 * (i >> 2) + 4 * n + (i & 3); }

struct Unit { int pm, pn; };
struct Gemm { const bf16_t* A; const bf16_t* Bt; int lda, ldb, K; };

struct StaticOrder {
    int nM, nN, nwg, G, c;
    __host__ __device__ void init(int M, int N, int G_, int c_) { nM = M / BM; nN = N / BM; nwg = nM * nN; G = G_; c = c_; }
    __host__ __device__ bool next(int i, Unit& u) const {
        const long L = (long)i * G + c; if (L >= nwg) return false;
        int wgid = (int)L; { const int q = nwg / NXCD, r = nwg % NXCD, xcd = wgid % NXCD, off = wgid / NXCD; wgid = (xcd < r ? xcd * (q + 1) : r * (q + 1) + (xcd - r) * q) + off; }
        const int nig = WGM * nN, gid = wgid / nig, fm = gid * WGM, gsz = (nM - fm) < WGM ? (nM - fm) : WGM;
        u.pm = fm + ((wgid % nig) % gsz); u.pn = (wgid % nig) / gsz; return true;
    }
};
typedef float f32x2_c __attribute__((ext_vector_type(2))); typedef __bf16 bf16x2_c __attribute__((ext_vector_type(2)));
__device__ __forceinline__ unsigned cvt_pk_bf16(float lo, float hi) { const f32x2_c v = {lo, hi}; const bf16x2_c b = __builtin_convertvector(v, bf16x2_c); return __builtin_bit_cast(unsigned, b); }
__device__ __forceinline__ float bflo(unsigned w) { return __uint_as_float(w << 16); }
__device__ __forceinline__ float bfhi(unsigned w) { return __uint_as_float(w & 0xffff0000u); }

__device__ __forceinline__ float ssq_sum16(const float* p) {
    const f32x4 a = *(const f32x4*)p, b = *(const f32x4*)(p + 4), c = *(const f32x4*)(p + 8), d = *(const f32x4*)(p + 12);
    return (((a[0] + a[1]) + (a[2] + a[3])) + ((b[0] + b[1]) + (b[2] + b[3]))) + (((c[0] + c[1]) + (c[2] + c[3])) + ((d[0] + d[1]) + (d[2] + d[3])));
}
template <bool SSQ> struct EpiRowScale {
    static constexpr bool PERM = true, MID = false;
    bf16_t* O; int ldc; const float* rs; float mul = 1.f;
    __device__ __forceinline__ void operator()(const f32x4 (&acc)[2][2][4][2], const Unit& u, int wr, int wc, int fr, int fq) const {
        const int row0 = u.pm * BM + wr * 64 + fr, col0 = u.pn * BM + wc * 32 + 8 * fq;
#pragma unroll
        for (int ai = 0; ai < 2; ++ai)
#pragma unroll
            for (int m = 0; m < 4; ++m) {
                const int row = row0 + ai * HALF + m * 16;
                float s; if (SSQ) s = rsqrtf(ssq_sum16(rs + (size_t)row * 16) * (1.f / 1024.f) + NORM_EPS); else s = rs[row] * mul;
                bf16_t* rowp = O + (size_t)row * ldc + col0;
#pragma unroll
                for (int bj = 0; bj < 2; ++bj) {
                    const f32x4 v0 = acc[ai][bj][m][0] * s, v1 = acc[ai][bj][m][1] * s;
                    u32x4 w; w.x = cvt_pk_bf16(v0[0], v0[1]); w.y = cvt_pk_bf16(v0[2], v0[3]); w.z = cvt_pk_bf16(v1[0], v1[1]); w.w = cvt_pk_bf16(v1[2], v1[3]);
                    *(u32x4*)(rowp + bj * HALF) = w;
                }
            }
    }
};
template <bool ACCUM> struct EpiGate {
    static constexpr bool PERM = true, MID = false;
    bf16_t* mg; const bf16_t* z; int gcol;
    __device__ __forceinline__ void operator()(const f32x4 (&acc)[2][2][4][2], const Unit& u, int wr, int wc, int fr, int fq) const {
        const int row0 = u.pm * BM + wr * 64 + fr, col0 = u.pn * BM + wc * 32 + 8 * fq;
#pragma unroll
        for (int ai = 0; ai < 2; ++ai)
#pragma unroll
            for (int m = 0; m < 4; ++m) {
                const int row = row0 + ai * HALF + m * 16;
                const bf16_t* gp = z + (size_t)row * NZ + gcol + col0;
                bf16_t* rowp = mg + (size_t)row * DM + col0;
#pragma unroll
                for (int bj = 0; bj < 2; ++bj) {
                    const u32x4 g = *(const u32x4*)(gp + bj * HALF);
                    const f32x4 a0 = acc[ai][bj][m][0], a1 = acc[ai][bj][m][1];
                    float r[8];
                    r[0] = sigmoidf_(bflo(g.x)) * a0[0]; r[1] = sigmoidf_(bfhi(g.x)) * a0[1]; r[2] = sigmoidf_(bflo(g.y)) * a0[2]; r[3] = sigmoidf_(bfhi(g.y)) * a0[3];
                    r[4] = sigmoidf_(bflo(g.z)) * a1[0]; r[5] = sigmoidf_(bfhi(g.z)) * a1[1]; r[6] = sigmoidf_(bflo(g.w)) * a1[2]; r[7] = sigmoidf_(bfhi(g.w)) * a1[3];
                    if (ACCUM) { const u32x4 o = *(const u32x4*)(rowp + bj * HALF);
                        r[0] += bflo(o.x); r[1] += bfhi(o.x); r[2] += bflo(o.y); r[3] += bfhi(o.y); r[4] += bflo(o.z); r[5] += bfhi(o.z); r[6] += bflo(o.w); r[7] += bfhi(o.w); }
                    u32x4 w; w.x = cvt_pk_bf16(r[0], r[1]); w.y = cvt_pk_bf16(r[2], r[3]); w.z = cvt_pk_bf16(r[4], r[5]); w.w = cvt_pk_bf16(r[6], r[7]);
                    *(u32x4*)(rowp + bj * HALF) = w;
                }
            }
    }
};
struct EpiGate2 {
    static constexpr bool PERM = true, MID = true;
    bf16_t* mg; const bf16_t* z;
    __device__ __forceinline__ void mid(f32x4 (&acc)[2][2][4][2], const Unit& u, int wr, int wc, int fr, int fq) const {
        int row0 = u.pm * BM + wr * 64 + fr; const int col0 = u.pn * BM + wc * 32 + 8 * fq;
        asm volatile("" : "+v"(row0));
#pragma unroll
        for (int aq = 0; aq < 4; ++aq) {
            const int ai = aq >> 1, mb = (aq & 1) * 2;
            u32x4 ga[4][2], gb[4][2];
#pragma unroll
            for (int m = mb; m < mb + 2; ++m) {
                const bf16_t* gp = z + (size_t)(row0 + ai * HALF + m * 16) * NZ + col0;
                ga[m][0] = *(const u32x4*)(gp + C_GA); ga[m][1] = *(const u32x4*)(gp + C_GA + HALF); gb[m][0] = *(const u32x4*)(gp + C_GB); gb[m][1] = *(const u32x4*)(gp + C_GB + HALF);
            }
            __builtin_amdgcn_sched_barrier(0);
#pragma unroll
            for (int m = mb; m < mb + 2; ++m)
#pragma unroll
                for (int bj = 0; bj < 2; ++bj) {
                    const unsigned gaw[4] = {ga[m][bj].x, ga[m][bj].y, ga[m][bj].z, ga[m][bj].w}, gbw[4] = {gb[m][bj].x, gb[m][bj].y, gb[m][bj].z, gb[m][bj].w};
                    float r[8];
#pragma unroll
                    for (int i = 0; i < 4; ++i) {
                        r[2 * i] = (1.f + __expf(-fmaxf(bflo(gbw[i]), -30.f))) * __builtin_amdgcn_rcpf(1.f + __expf(-fmaxf(bflo(gaw[i]), -30.f)));
                        r[2 * i + 1] = (1.f + __expf(-fmaxf(bfhi(gbw[i]), -30.f))) * __builtin_amdgcn_rcpf(1.f + __expf(-fmaxf(bfhi(gaw[i]), -30.f)));
                    }
                    acc[ai][bj][m][0] = acc[ai][bj][m][0] * (f32x4){r[0], r[1], r[2], r[3]};
                    acc[ai][bj][m][1] = acc[ai][bj][m][1] * (f32x4){r[4], r[5], r[6], r[7]};
                }
        }
    }
    __device__ __forceinline__ void operator()(const f32x4 (&acc)[2][2][4][2], const Unit& u, int wr, int wc, int fr, int fq) const {
        int row0 = u.pm * BM + wr * 64 + fr; const int col0 = u.pn * BM + wc * 32 + 8 * fq;
        asm volatile("" : "+v"(row0));
#pragma unroll
        for (int ai = 0; ai < 2; ++ai)
#pragma unroll
            for (int m = 0; m < 4; ++m) {
                const int row = row0 + ai * HALF + m * 16;
                const bf16_t* gp = z + (size_t)row * NZ + C_GB + col0;
                bf16_t* rowp = mg + (size_t)row * DM + col0;
#pragma unroll
                for (int bj = 0; bj < 2; ++bj) {
                    const u32x4 g = *(const u32x4*)(gp + bj * HALF);
                    const unsigned gw[4] = {g.x, g.y, g.z, g.w};
                    const f32x4 a0 = acc[ai][bj][m][0], a1 = acc[ai][bj][m][1];
                    const float av[8] = {a0[0], a0[1], a0[2], a0[3], a1[0], a1[1], a1[2], a1[3]};
                    float r[8];
#pragma unroll
                    for (int i = 0; i < 4; ++i) {
                        r[2 * i] = av[2 * i] * __builtin_amdgcn_rcpf(1.f + __expf(-fmaxf(bflo(gw[i]), -30.f)));
                        r[2 * i + 1] = av[2 * i + 1] * __builtin_amdgcn_rcpf(1.f + __expf(-fmaxf(bfhi(gw[i]), -30.f)));
                    }
                    u32x4 w; w.x = cvt_pk_bf16(r[0], r[1]); w.y = cvt_pk_bf16(r[2], r[3]); w.z = cvt_pk_bf16(r[4], r[5]); w.w = cvt_pk_bf16(r[6], r[7]);
                    *(u32x4*)(rowp + bj * HALF) = w;
                }
            }
    }
};
struct EpiX2 {
    static constexpr bool PERM = true, MID = false;
    const float* x; float* x2; bf16_t* x2b; float* ssq;
    __device__ __forceinline__ void operator()(const f32x4 (&acc)[2][2][4][2], const Unit& u, int wr, int wc, int fr, int fq) const {
        const int row0 = u.pm * BM + wr * 64 + fr, col0 = u.pn * BM + wc * 32 + 8 * fq;
#pragma unroll
        for (int ai = 0; ai < 2; ++ai)
#pragma unroll
            for (int m = 0; m < 4; ++m) {
                const int row = row0 + ai * HALF + m * 16;
                const size_t off = (size_t)row * DM + col0;
                float ss = 0.f;
#pragma unroll
                for (int bj = 0; bj < 2; ++bj) {
                    const f32x4 x0 = *(const f32x4*)(x + off + bj * HALF), x1 = *(const f32x4*)(x + off + bj * HALF + 4);
                    const f32x4 o0 = x0 + acc[ai][bj][m][0], o1 = x1 + acc[ai][bj][m][1];
                    u32x4 w; w.x = cvt_pk_bf16(o0[0], o0[1]); w.y = cvt_pk_bf16(o0[2], o0[3]); w.z = cvt_pk_bf16(o1[0], o1[1]); w.w = cvt_pk_bf16(o1[2], o1[3]);
                    *(u32x4*)(x2b + off + bj * HALF) = w;
                    ss += (o0[0] * o0[0] + o0[1] * o0[1]) + (o0[2] * o0[2] + o0[3] * o0[3]) + (o1[0] * o1[0] + o1[1] * o1[1]) + (o1[2] * o1[2] + o1[3] * o1[3]);
                }
                ss += __shfl_xor(ss, 16); ss += __shfl_xor(ss, 32);
                if (fq == 0) ssq[(size_t)row * 16 + (u.pn & 3) * 4 + wc] = ss;
            }
    }
};

typedef int v8i_t __attribute__((ext_vector_type(8)));
template <class Epi, class Sched, bool F8 = false>
__device__ __forceinline__ void gemm_phase(PG8_LAS unsigned char* lds, const Gemm g, const Sched& S, const Epi& E) {
    const int tid = threadIdx.x, wid = __builtin_amdgcn_readfirstlane(tid >> 6), lane = tid & 63, wr = wid >> 2, wc = wid & 3, fr = lane & 15, fq = lane >> 4;
    const int K = g.K, nt = K / BK;
    unsigned voffA[2], voffB[2];
#pragma unroll
    for (int i = 0; i < 2; ++i) { int R, C; stage_rc(tid * 16 + i * 8192, R, C); const int Rb = Epi::PERM ? ((R & ~31) + perm32(R & 31)) : R;
        voffA[i] = (unsigned)(R * g.lda + C) * 2u; voffB[i] = (unsigned)(Rb * g.ldb + C) * 2u; }
    const size_t kstep = (size_t)(BK * 2);
    const size_t hstepA = (size_t)HALF * g.lda * 2, hstepB = (size_t)HALF * g.ldb * 2;
    const size_t tstepA = 2 * hstepA, tstepB = 2 * hstepB;
    const unsigned ldsw = (unsigned)wid * 1024u;
    const int aoff = lds_byte(wr * 64 + fr, fq * 8), boff = lds_byte(wc * 32 + fr, fq * 8);
    const int sub8 = (fq >> 1) * 1024 + fr * 64 + (((fq & 1) ^ (fr >> 3)) * 32);
    const int aoff8 = ((wr * 64) >> 4) * 2048 + sub8, boff8 = ((wc * 32) >> 4) * 2048 + sub8;
#define PG8_SA(b, h) (((b) * 2 + (h)) * HTB)
#define PG8_SB(b, h) ((4 + (b) * 2 + (h)) * HTB)
#define PG8_STAGE(bufoff, gbase, voff) do { _Pragma("unroll") for (int _i = 0; _i < 2; ++_i) \
        __builtin_amdgcn_global_load_lds((const unsigned*)((const char*)(gbase) + (voff)[_i]), (PG8_LAS unsigned*)(lds + (bufoff) + ldsw + _i * 8192), 16, 0, 0); } while (0)
#define PG8_LD8(p_) ({ typedef int i4_ __attribute__((ext_vector_type(4))); const i4_ lo_ = *(const PG8_LAS i4_*)(p_), hi_ = *(const PG8_LAS i4_*)((p_) + 16); __builtin_shufflevector(lo_, hi_, 0, 1, 2, 3, 4, 5, 6, 7); })
#define PG8_LDA(dst, b, h) do { if constexpr (F8) { _Pragma("unroll") for (int m = 0; m < 4; ++m) dst##8[m] = PG8_LD8(lds + PG8_SA(b, h) + aoff8 + m * 2048); } else { \
        _Pragma("unroll") for (int m = 0; m < 4; ++m) _Pragma("unroll") for (int k = 0; k < 2; ++k) dst[m][k] = *(const PG8_LAS bf16x8*)(lds + PG8_SA(b, h) + aoff + m * 2048 + k * 1024); } } while (0)
#define PG8_LDB(dst, b, h) do { if constexpr (F8) { _Pragma("unroll") for (int n = 0; n < 2; ++n) dst##8[n] = PG8_LD8(lds + PG8_SB(b, h) + boff8 + n * 2048); } else { \
        _Pragma("unroll") for (int n = 0; n < 2; ++n) _Pragma("unroll") for (int k = 0; k < 2; ++k) dst[n][k] = *(const PG8_LAS bf16x8*)(lds + PG8_SB(b, h) + boff + n * 2048 + k * 1024); } } while (0)
#define PG8_MMA(ai, bj, At, Bt) do { __builtin_amdgcn_s_setprio(1); if constexpr (F8) { _Pragma("unroll") for (int m = 0; m < 4; ++m) _Pragma("unroll") for (int n = 0; n < 2; ++n) \
        asm volatile("v_mfma_scale_f32_16x16x128_f8f6f4 %0, %1, %2, %0, %3, %3 op_sel_hi:[0,0,0]" : "+v"(acc[ai][bj][m][n]) : "v"(Bt##8[n]), "v"(At##8[m]), "v"(sc127)); } else { \
        _Pragma("unroll") for (int m = 0; m < 4; ++m) _Pragma("unroll") for (int n = 0; n < 2; ++n) _Pragma("unroll") for (int k = 0; k < 2; ++k) \
        acc[ai][bj][m][n] = __builtin_amdgcn_mfma_f32_16x16x32_bf16(Bt[n][k], At[m][k], acc[ai][bj][m][n], 0, 0, 0); } __builtin_amdgcn_s_setprio(0); } while (0)
#define PG8_WAIT_V(n) asm volatile("s_waitcnt vmcnt(" #n ")" ::: "memory")
#define PG8_WAIT_L(n) asm volatile("s_waitcnt lgkmcnt(" #n ")" ::: "memory")
#define PG8_BAR __builtin_amdgcn_s_barrier()
#define PG8_SCHED __builtin_amdgcn_sched_barrier(0)
#define PG8_KBODY(t) do { \
            const bool last = (t == nt - 2); \
            const char* a1 = cA + (size_t)(t + 1) * kstep; \
            const char* a2 = last ? nA : cA + (size_t)(t + 2) * kstep; const char* b2 = last ? nB : cB + (size_t)(t + 2) * kstep; \
            const char* a3 = a2 + kstep; const char* b3 = b2 + kstep; \
 \
            PG8_LDB(B0, 0, 0); PG8_LDB(B1, 0, 1); PG8_SCHED; PG8_LDA(At, 0, 0); PG8_STAGE(PG8_SA(1, 1), a1 + hstepA, voffA); \
            PG8_WAIT_V(8); PG8_WAIT_L(0); PG8_BAR; PG8_MMA(0, 0, At, B0); PG8_MMA(0, 1, At, B1); PG8_BAR; PG8_SCHED; \
 \
            PG8_LDA(At, 0, 1); PG8_STAGE(PG8_SB(0, 0), b2, voffB); PG8_STAGE(PG8_SB(0, 1), b2 + hstepB, voffB); PG8_STAGE(PG8_SA(0, 0), a2, voffA); \
            PG8_WAIT_V(8); PG8_WAIT_L(0); PG8_BAR; PG8_MMA(1, 0, At, B0); PG8_MMA(1, 1, At, B1); PG8_BAR; PG8_SCHED; \
 \
            PG8_LDB(B0, 1, 0); PG8_LDB(B1, 1, 1); PG8_SCHED; PG8_LDA(At, 1, 0); PG8_STAGE(PG8_SA(0, 1), a2 + hstepA, voffA); \
            PG8_WAIT_V(8); PG8_WAIT_L(0); PG8_BAR; PG8_MMA(0, 0, At, B0); PG8_MMA(0, 1, At, B1); PG8_BAR; PG8_SCHED; \
 \
            PG8_LDA(At, 1, 1); PG8_STAGE(PG8_SB(1, 0), b3, voffB); PG8_STAGE(PG8_SB(1, 1), b3 + hstepB, voffB); PG8_STAGE(PG8_SA(1, 0), a3, voffA); \
            PG8_WAIT_V(8); PG8_WAIT_L(0); PG8_BAR; PG8_MMA(1, 0, At, B0); PG8_MMA(1, 1, At, B1); PG8_BAR; PG8_SCHED; \
        } while (0)
    Unit cur, nxt; int ui = 0;
    if (!S.next(0, cur)) return;
    f32x4 acc[2][2][4][2];
#pragma unroll
    for (int a = 0; a < 2; ++a)
#pragma unroll
        for (int b = 0; b < 2; ++b)
#pragma unroll
            for (int m = 0; m < 4; ++m)
#pragma unroll
                for (int n = 0; n < 2; ++n) acc[a][b][m][n] = (f32x4){0.f, 0.f, 0.f, 0.f};
    bf16x8 At[4][2], B0[2][2], B1[2][2]; v8i_t At8[4], B08[2], B18[2];
    const int sc127 = 127;
    const char* cA = (const char*)g.A + (size_t)cur.pm * tstepA; const char* cB = (const char*)g.Bt + (size_t)cur.pn * tstepB;
    PG8_STAGE(PG8_SB(0, 0), cB, voffB); PG8_STAGE(PG8_SB(0, 1), cB + hstepB, voffB); PG8_STAGE(PG8_SA(0, 0), cA, voffA); PG8_STAGE(PG8_SA(0, 1), cA + hstepA, voffA);
    if (wr == 1) PG8_BAR;
    PG8_WAIT_V(2); PG8_BAR;
    PG8_STAGE(PG8_SB(1, 0), cB + kstep, voffB); PG8_STAGE(PG8_SA(1, 0), cA + kstep, voffA); PG8_STAGE(PG8_SB(1, 1), cB + hstepB + kstep, voffB);
    PG8_WAIT_V(6); PG8_BAR;
    for (;;) {
        const bool has_next = S.next(ui + 1, nxt);
        const char* nA = has_next ? (const char*)g.A + (size_t)nxt.pm * tstepA : cA; const char* nB = has_next ? (const char*)g.Bt + (size_t)nxt.pn * tstepB : cB;
        if constexpr (Epi::MID) {
#pragma nounroll
            for (int t = 0; t < (nt >> 1); t += 2) PG8_KBODY(t);
            E.mid(acc, cur, wr, wc, fr, fq);
#pragma nounroll
            for (int t = (nt >> 1); t < nt; t += 2) PG8_KBODY(t);
        } else {
#pragma nounroll
            for (int t = 0; t < nt; t += 2) PG8_KBODY(t);
        }
        if (wr == 0) PG8_BAR;
        if constexpr (F8) asm volatile("s_nop 15\n\ts_nop 15" ::: "memory");
        E(acc, cur, wr, wc, fr, fq);
        if (!has_next) break;
#pragma unroll
        for (int a = 0; a < 2; ++a)
#pragma unroll
            for (int b = 0; b < 2; ++b)
#pragma unroll
                for (int m = 0; m < 4; ++m)
#pragma unroll
                    for (int n = 0; n < 2; ++n) acc[a][b][m][n] = (f32x4){0.f, 0.f, 0.f, 0.f};
        cur = nxt; cA = nA; cB = nB; ++ui;
        if (wr == 1) PG8_BAR;
    }
    PG8_WAIT_V(0);
    PG8_BAR;
#undef PG8_SA
#undef PG8_SB
#undef PG8_STAGE
#undef PG8_LDA
#undef PG8_KBODY
#undef PG8_LD8
#undef PG8_LDB
#undef PG8_MMA
#undef PG8_WAIT_V
#undef PG8_WAIT_L
#undef PG8_BAR
#undef PG8_SCHED
}
}

constexpr int NWAVES = 8;
constexpr int LDS_RING_BYTES = 131072, LDSCTL_OFF = 143360, MISC_OFF = LDSCTL_OFF + 320, LDS_BYTES = 147456;
#define LAS __attribute__((address_space(3)))
#define GAS __attribute__((address_space(1)))
typedef float f32x4 __attribute__((ext_vector_type(4)));
typedef unsigned v4u __attribute__((ext_vector_type(4)));
typedef unsigned v2u __attribute__((ext_vector_type(2)));
#define LDS_WAIT() asm volatile("s_waitcnt lgkmcnt(0)" ::: "memory")

constexpr int CW_BAR = 4096;
#define XB_TMO      128
#define XB_XCNT(j)  (256  + 64 * (j))
#define XB_XSUB(j)  (1280 + 64 * (j))
#define XB_XGEN(j)  (2304 + 64 * (j))
#define XB_TOP      3328
#define XB_TOPGEN   3392
#define XCD_BAR_WORDS 3456
#define XB_SPIN_CAP (1u << 20)
__device__ __forceinline__ unsigned xb_ld(unsigned* p)              { return __hip_atomic_load(p, __ATOMIC_RELAXED, __HIP_MEMORY_SCOPE_AGENT); }
__device__ __forceinline__ unsigned xb_add(unsigned* p, unsigned v) { return __hip_atomic_fetch_add(p, v, __ATOMIC_RELAXED, __HIP_MEMORY_SCOPE_AGENT); }
__device__ __forceinline__ unsigned xb_xcc_id() { return (unsigned)__builtin_amdgcn_s_getreg((3 << 11) | 20) & 0xFu; }
#define XB_SPIN(cond, bar) do { unsigned _sp = 0; while (cond) { __builtin_amdgcn_s_sleep(1); \
    if ((++_sp & 255u) == 0u) { if (xb_ld(&(bar)[XB_TMO])) break; if (_sp > XB_SPIN_CAP) { atomicAdd(&(bar)[XB_TMO], 1u); break; } } } } while (0)
struct XcdBarrier { unsigned* bar; unsigned x; volatile LAS unsigned* st; };
__device__ __forceinline__ XcdBarrier xcd_barrier_post(unsigned* bar, volatile LAS unsigned* st) {
    XcdBarrier b; b.bar = bar; b.x = xb_xcc_id(); b.st = st;
    if (threadIdx.x == 0) (void)xb_add(&bar[XB_XCNT(b.x)], 1u);
    return b;
}
__device__ __forceinline__ void xcd_barrier_complete(unsigned* bar, unsigned x, unsigned& nloc, unsigned& nx) {
    const unsigned G = gridDim.x * gridDim.y * gridDim.z;
    unsigned sum, cnt, mine, sp = 0u;
    for (;;) {
        sum = 0u; cnt = 0u; mine = 0u;
#pragma unroll
        for (unsigned j = 0; j < 16; ++j) { const unsigned c = xb_ld(&bar[XB_XCNT(j)]); sum += c; cnt += (c > 0u) ? 1u : 0u; mine = (j == x) ? c : mine; }
        if (sum == G) break;
        __builtin_amdgcn_s_sleep(1);
        if ((++sp & 255u) == 0u) { if (xb_ld(&bar[XB_TMO])) break; if (sp > XB_SPIN_CAP) { atomicAdd(&bar[XB_TMO], 1u); break; } }
    }
    nloc = mine > 0u ? mine : 1u; nx = cnt > 0u ? cnt : 1u;
}
__device__ __forceinline__ void xcd_barrier(const XcdBarrier& b) {
    asm volatile("s_waitcnt vmcnt(0)" ::: "memory");
    __syncthreads();
    if (threadIdx.x == 0) {
        unsigned* bar = b.bar;
        __builtin_amdgcn_s_waitcnt(0);
        unsigned nloc = b.st[0], nx = b.st[1];
        if (nloc == 0u) { xcd_barrier_complete(bar, b.x, nloc, nx); b.st[0] = nloc; b.st[1] = nx; }
        const unsigned old = xb_add(&bar[XB_XSUB(b.x)], 1u);
        const unsigned gen = old / nloc;
        if (old + 1u == (gen + 1u) * nloc) {
            __builtin_amdgcn_fence(__ATOMIC_RELEASE, "agent");
            asm volatile("s_waitcnt vmcnt(0)" ::: "memory");
            const unsigned og = xb_add(&bar[XB_TOP], 1u);
            const unsigned tg = og / nx;
            if (og + 1u == (tg + 1u) * nx) xb_add(&bar[XB_TOPGEN], 1u);
            else XB_SPIN(xb_ld(&bar[XB_TOPGEN]) == tg, bar);
            __builtin_amdgcn_fence(__ATOMIC_ACQUIRE, "agent");
            xb_add(&bar[XB_XGEN(b.x)], 1u);
            asm volatile("s_waitcnt vmcnt(0)" ::: "memory");
        } else {
            XB_SPIN(xb_ld(&bar[XB_XGEN(b.x)]) == gen, bar);
            __builtin_amdgcn_fence(__ATOMIC_ACQUIRE, "agent");
            asm volatile("s_waitcnt vmcnt(0)" ::: "memory");
        }
    }
    __syncthreads();
}

struct Args { const float* in[28]; float* out; unsigned char* ws; int ph_lo, ph_hi, li, pad; };

__device__ __forceinline__ void p0_transpose_item(const float* W, const float* sc, int K, int N, bf16_t* WT, LAS float* scr, int item, int lane, unsigned char* W8 = nullptr, int n8 = 0, int ldw = 0, int koff = 0) {
    if (ldw == 0) ldw = K;
    const int nblk = N / 32, kb = item / nblk, nb = item % nblk, k0 = 64 * kb, n0 = 32 * nb;
#pragma unroll 8
    for (int i = 0; i < 32; ++i) { const int kk = 2 * i + (lane >> 5); const float s = sc ? sc[k0 + kk] : 1.f; scr[kk * 33 + (lane & 31)] = W[(size_t)(k0 + kk) * N + n0 + (lane & 31)] * s; }
    LDS_WAIT(); asm volatile("" ::: "memory");
    const int c = lane & 7;
#pragma unroll
    for (int j = 0; j < 4; ++j) { const int n = (lane >> 3) + 8 * j; const LAS float* s = scr + (8 * c) * 33 + n;
        v4u o; o.x = pg8::cvt_pk_bf16(s[0 * 33], s[1 * 33]); o.y = pg8::cvt_pk_bf16(s[2 * 33], s[3 * 33]); o.z = pg8::cvt_pk_bf16(s[4 * 33], s[5 * 33]); o.w = pg8::cvt_pk_bf16(s[6 * 33], s[7 * 33]);
        *(v4u*)(WT + (size_t)(n0 + n) * ldw + koff + k0 + 8 * c) = o;
        if (W8 && n0 + n >= n8) {
            int p0 = 0, p1 = 0;
            p0 = __builtin_amdgcn_cvt_pk_fp8_f32(s[0 * 33] * 32.f, s[1 * 33] * 32.f, p0, false); p0 = __builtin_amdgcn_cvt_pk_fp8_f32(s[2 * 33] * 32.f, s[3 * 33] * 32.f, p0, true);
            p1 = __builtin_amdgcn_cvt_pk_fp8_f32(s[4 * 33] * 32.f, s[5 * 33] * 32.f, p1, false); p1 = __builtin_amdgcn_cvt_pk_fp8_f32(s[6 * 33] * 32.f, s[7 * 33] * 32.f, p1, true);
            *(v2u*)(W8 + (size_t)(n0 + n - n8) * K + k0 + 8 * c) = (v2u){(unsigned)p0, (unsigned)p1};
        } }
    LDS_WAIT(); asm volatile("" ::: "memory");
}
typedef unsigned v6u_t __attribute__((ext_vector_type(6)));
typedef unsigned v3u_t __attribute__((ext_vector_type(3)));
typedef float v16f_t __attribute__((ext_vector_type(16)));
typedef float v32f_t __attribute__((ext_vector_type(32)));
__device__ __forceinline__ void p0_row_fp6(const float* in, const float* cs, unsigned char* out, float* sc, int lane) {
    f32x4 v[4]; float mx = 0.f;
#pragma unroll
    for (int i = 0; i < 4; ++i) { v[i] = *(const f32x4*)(in + lane * 16 + 4 * i); if (cs) v[i] = v[i] * *(const f32x4*)(cs + lane * 16 + 4 * i);
        mx = fmaxf(mx, fmaxf(fmaxf(fabsf(v[i][0]), fabsf(v[i][1])), fmaxf(fabsf(v[i][2]), fabsf(v[i][3])))); }
#pragma unroll
    for (int o = 1; o < 64; o <<= 1) mx = fmaxf(mx, __shfl_xor(mx, o));
    mx = fmaxf(mx, 1e-30f);
    const float q = 7.5f / mx;
    v16f_t a, b;
#pragma unroll
    for (int i = 0; i < 16; ++i) { a[i] = 0.f; b[i] = 0.f; }
#pragma unroll
    for (int i = 0; i < 8; ++i) { a[i] = v[(2 * i) >> 2][(2 * i) & 3] * q; b[i] = v[(2 * i + 1) >> 2][(2 * i + 1) & 3] * q; }
    const v6u_t p = __builtin_amdgcn_cvt_scalef32_2xpk16_fp6_f32(a, b, 1.0f);
    *(v3u_t*)(out + lane * 12) = (v3u_t){p[0], p[1], p[2]};
    if (lane == 0) *sc = mx * (1.f / 7.5f);
}
__device__ __forceinline__ void p0_convert(const float* in, const float* cs, bf16_t* out, size_t n, int gw, int NGW, int lane) {
    for (size_t i = ((size_t)gw * 64 + lane) * 8; i < n; i += (size_t)NGW * 512) {
        f32x4 a = *(const f32x4*)(in + i), b = *(const f32x4*)(in + i + 4);
        if (cs) { const int c = (int)(i & 1023); a = a * *(const f32x4*)(cs + c); b = b * *(const f32x4*)(cs + c + 4); }
        v4u o; o.x = pg8::cvt_pk_bf16(a[0], a[1]); o.y = pg8::cvt_pk_bf16(a[2], a[3]); o.z = pg8::cvt_pk_bf16(b[0], b[1]); o.w = pg8::cvt_pk_bf16(b[2], b[3]);
        *(v4u*)(out + i) = o;
    }
}

namespace da {
typedef short bf16x8 __attribute__((ext_vector_type(8)));
typedef short s16x4 __attribute__((ext_vector_type(4)));
typedef float f32x16 __attribute__((ext_vector_type(16)));
typedef const LAS unsigned char* lcp;
constexpr float LOG2E = 1.4426950408889634f, C2 = 0.125f * LOG2E, THR = 8.f;
constexpr int RSLOT = 16384, LDS_KR = 0, LDS_VR = 4 * RSLOT, SCR_OFF = 8 * RSLOT, COMB_OFF = 0;
#define DA_SBAR() __builtin_amdgcn_sched_barrier(0)
#define DA_PIN(x) asm volatile("" : "+v"(x))
#define DA_MFMA(a, b, c) __builtin_amdgcn_mfma_f32_32x32x16_bf16(a, b, c, 0, 0, 0)
#define DA_WAIT_BAR(N) asm volatile("s_waitcnt vmcnt(" #N ") lgkmcnt(0)\n\ts_barrier" ::: "memory")
#define DA_MX3(a, b, c) __builtin_fmaxf(__builtin_fmaxf((a), (b)), (c))
__device__ __forceinline__ int crow(int r, int hi) { return (r & 3) + 8 * (r >> 2) + 4 * hi; }
__device__ __forceinline__ s16x4 vtr(lcp p) { return __builtin_bit_cast(s16x4, __builtin_amdgcn_ds_read_tr16_b64_v4i16((LAS s16x4*)p)); }
__device__ __forceinline__ unsigned cvtpk(float lo, float hi) { unsigned r; asm("v_cvt_pk_bf16_f32 %0, %1, %2" : "=v"(r) : "v"(lo), "v"(hi)); return r; }
__device__ __forceinline__ void glds16(const void* g, unsigned lds_base) {
    unsigned sv; asm volatile("s_mov_b32 %0, m0\n\ts_mov_b32 m0, %2\n\ts_nop 0\n\tglobal_load_lds_dwordx4 %1, off\n\ts_mov_b32 m0, %0" : "=&s"(sv) : "v"(g), "s"(lds_base) : "memory"); }
__device__ __forceinline__ void glds16_o128(const void* g, unsigned lds_base) {
    unsigned sv; asm volatile("s_mov_b32 %0, m0\n\ts_mov_b32 m0, %2\n\ts_nop 0\n\tglobal_load_lds_dwordx4 %1, off offset:128\n\ts_mov_b32 m0, %0" : "=&s"(sv) : "v"(g), "s"(lds_base) : "memory"); }
__device__ __forceinline__ void kload2(bf16x8* kf, lcp kp, int d0) { kf[2 * d0] = *(const LAS bf16x8*)(kp + d0 * 2048); kf[2 * d0 + 1] = *(const LAS bf16x8*)(kp + d0 * 2048 + 512); }
__device__ __forceinline__ float max16(const f32x16& p) {
    float a = DA_MX3(p[0], p[1], p[2]), b = DA_MX3(p[3], p[4], p[5]); a = DA_MX3(a, p[6], p[7]); b = DA_MX3(b, p[8], p[9]); a = DA_MX3(a, p[10], p[11]); b = DA_MX3(b, p[12], p[13]);
    a = DA_MX3(a, p[14], p[15]); return __builtin_fmaxf(a, b); }
__device__ __forceinline__ float rowmax(const f32x16& p0, const f32x16& p1, float offA, float offB) {
    const float m = __builtin_fmaxf(__builtin_fmaf(max16(p0), C2, offA), __builtin_fmaf(max16(p1), C2, offB));
    auto rr = __builtin_amdgcn_permlane32_swap(__float_as_uint(m), __float_as_uint(m), false, false);
    return __builtin_fmaxf(__uint_as_float(rr[0]), __uint_as_float(rr[1])); }
__device__ __forceinline__ void cmask(f32x16& p0, f32x16& p1, int jb, int qrel, int hi) {
    const int kb = 64 * jb + 4 * hi;
#pragma unroll
    for (int r = 0; r < 16; ++r) { const int kv = kb + (r & 3) + 8 * (r >> 2); if (kv > qrel) p0[r] = -INFINITY; if (kv + 32 > qrel) p1[r] = -INFINITY; } }

__device__ __forceinline__ void attn_epilogue_body(LAS unsigned char* lds, f32x16 (&o)[4], float l_reg, bf16_t* __restrict__ yb, const float* __restrict__ subln_w, float lam,
                                                   size_t rowb, int q0, int h, int wave, int lane) {
    asm volatile("" : "+v"(lane));
    const int r32 = lane & 31, hi = lane >> 5, map = wave >> 2, qs = wave & 3;
    LAS float* wsf = (LAS float*)(lds + SCR_OFF) + wave * 64;
    if (hi == 0) wsf[r32] = __builtin_amdgcn_rcpf(l_reg);
    float il[16];
#pragma unroll
    for (int g = 0; g < 4; ++g) { const f32x4 t4 = *(const LAS f32x4*)(wsf + 8 * g + 4 * hi); il[4 * g] = t4[0]; il[4 * g + 1] = t4[1]; il[4 * g + 2] = t4[2]; il[4 * g + 3] = t4[3]; }
    __syncthreads();
    LAS float* comb = (LAS float*)(lds + COMB_OFF) + qs * 4096;
    if (map == 1) {
#pragma unroll
        for (int d = 0; d < 4; ++d)
#pragma unroll
            for (int r = 0; r < 16; ++r) comb[crow(r, hi) * 128 + 32 * d + r32] = o[d][r] * il[r];
    }
    __syncthreads();
    if (map == 0) {
        float sw[4];
#pragma unroll
        for (int d = 0; d < 4; ++d) sw[d] = subln_w[32 * d + r32] * (1.f - LAM_INIT);
#pragma unroll
        for (int r = 0; r < 16; ++r) {
            float v[4], ss = 0.f;
#pragma unroll
            for (int d = 0; d < 4; ++d) { v[d] = o[d][r] * il[r] - lam * comb[crow(r, hi) * 128 + 32 * d + r32]; ss += v[d] * v[d]; }
            ss += __shfl_xor(ss, 1); ss += __shfl_xor(ss, 2); ss += __shfl_xor(ss, 4); ss += __shfl_xor(ss, 8); ss += __shfl_xor(ss, 16);
            const float rs = rsqrtf(ss * (1.f / 128.f) + SUBLN_EPS);
            bf16_t* op = yb + (rowb + q0 + crow(r, hi)) * YAB_PITCH + h * 128 + r32;
#pragma unroll
            for (int d = 0; d < 4; ++d) op[32 * d] = f2bf(v[d] * rs * sw[d]);
        }
    }
    __syncthreads();
}
__device__ __forceinline__ void attn_unit(LAS unsigned char* lds, const bf16_t* __restrict__ z, bf16_t* __restrict__ yb, const float* __restrict__ subln_w, float lam,
                                          int b, int h, int qblk, int wave_, int lane) {
    const int wave = __builtin_amdgcn_readfirstlane(wave_);
    const int r32 = lane & 31, hi = lane >> 5, map = wave >> 2, qs = wave & 3;
    const int q0 = qblk * 128 + qs * 32, NT = 2 * qblk + 2, qrel = qs * 32 + r32;
    const size_t rowb = (size_t)b * SEQ;
    const float slope = exp2f(-2.f * (float)(h + 1)), slope2 = slope * LOG2E, s64 = 64.f * slope2, s32 = 32.f * slope2;
    const unsigned lds0 = (unsigned)(uintptr_t)lds;
    LAS float* wsf = (LAS float*)(lds + SCR_OFF) + wave * 64;
    const bf16_t* ksrc = z + (rowb + lane) * NZ + C_ZK + h * 128 + wave * 8;
    const int pc0 = 2 * wave;
    const bf16_t* vsrc0 = z + (rowb + 16 * (pc0 & 3) + (lane >> 2)) * NZ + C_ZV + h * 128 + 32 * (pc0 >> 2) + (lane & 3) * 8;
    const unsigned kdst = lds0 + LDS_KR + wave * 1024, vdst = lds0 + LDS_VR + pc0 * 1024;
#define DMA_K(t, slot) do { const bf16_t* k_ = ksrc + (size_t)(t) * 64 * NZ; const unsigned d_ = (unsigned)__builtin_amdgcn_readfirstlane(kdst + (slot)); glds16(k_, d_); glds16_o128(k_, d_ + 8192 - 128); } while (0)
#define DMA_V(t, slot) do { const size_t o_ = (size_t)(t) * 64 * NZ; const unsigned d_ = (unsigned)__builtin_amdgcn_readfirstlane(vdst + (slot)); glds16(vsrc0 + o_, d_); glds16(vsrc0 + o_ + 16 * NZ, d_ + 1024); } while (0)
    const lcp vp0 = lds + LDS_VR + ((lane >> 4) & 1) * 32 + (lane & 3) * 8 + (4 * hi + ((lane & 15) >> 2)) * 64;
    const lcp kp0 = lds + LDS_KR + map * 8192 + hi * 1024 + r32 * 16;
    DMA_K(0, 0); DMA_V(0, 0); DMA_K(1, RSLOT);
    bf16x8 qr[4];
    {
        const bf16_t* qp = z + (rowb + q0 + r32) * NZ + C_Q + h * 128 + map * 64 + hi * 8;
#pragma unroll
        for (int d0 = 0; d0 < 4; ++d0) qr[d0] = *(const bf16x8*)(qp + d0 * 16);
    }
    f32x16 bias16;
#pragma unroll
    for (int r = 0; r < 16; ++r) bias16[r] = (8.f * slope) * (float)((r & 3) + 8 * (r >> 2));
    DA_PIN(bias16);
    float mhat = 0.f, l_reg = 0.f, offA = slope2 * (float)(4 * hi);
    f32x16 o[4];
#pragma unroll
    for (int d = 0; d < 4; ++d) o[d] = (f32x16){};
    bool resc = false;
    f32x16 c0, c1; bf16x8 kf[8]; s16x4 vlo[4], vhi[4]; v4u pw0, pw1, pw2, pw3;
#define SL(t) ((((t)) & 3) * RSLOT)
#define EX(v, nm) __builtin_amdgcn_exp2f(__builtin_fmaf((v), C2, (nm)))
#define RESC() do { if (resc) { _Pragma("unroll") for (int d_ = 0; d_ < 4; ++d_) _Pragma("unroll") for (int r = 0; r < 16; ++r) o[d_][r] *= wsf[crow(r, hi)]; } } while (0)
#define PKW(P, i) pg8::cvt_pk_bf16(P[i], P[(i) + 1])
    DMA_K(2, 2 * RSLOT); DMA_K(3, 3 * RSLOT); DMA_V(1, RSLOT);
    DA_WAIT_BAR(10);
#pragma unroll
    for (int d0 = 0; d0 < 4; ++d0) kload2(kf, kp0, d0);
    c0 = DA_MFMA(kf[0], qr[0], bias16); c1 = DA_MFMA(kf[1], qr[0], bias16); c0 = DA_MFMA(kf[2], qr[1], c0); c1 = DA_MFMA(kf[3], qr[1], c1);
    c0 = DA_MFMA(kf[4], qr[2], c0); c1 = DA_MFMA(kf[5], qr[2], c1); c0 = DA_MFMA(kf[6], qr[3], c0); c1 = DA_MFMA(kf[7], qr[3], c1);
    if (NT == 2) cmask(c0, c1, 0, qrel, hi);
    { mhat = rowmax(c0, c1, offA, offA + s32); const float nmh0 = offA - mhat, nmh1 = nmh0 + s32; float sacc = 0.f;
#pragma unroll
      for (int r = 0; r < 16; ++r) { c0[r] = EX(c0[r], nmh0); c1[r] = EX(c1[r], nmh1); sacc += c0[r] + c1[r]; }
      l_reg = sacc; }
    pw0 = (v4u){PKW(c0, 0), PKW(c0, 2), PKW(c0, 4), PKW(c0, 6)}; pw1 = (v4u){PKW(c0, 8), PKW(c0, 10), PKW(c0, 12), PKW(c0, 14)};
    pw2 = (v4u){PKW(c1, 0), PKW(c1, 2), PKW(c1, 4), PKW(c1, 6)}; pw3 = (v4u){PKW(c1, 8), PKW(c1, 10), PKW(c1, 12), PKW(c1, 14)};
    DA_WAIT_BAR(6);
    DMA_K(4, 0); DMA_V(2, 2 * RSLOT);
#pragma unroll
    for (int d0 = 0; d0 < 4; ++d0) kload2(kf, kp0 + RSLOT, d0);
    if (NT == 2) { DA_WAIT_BAR(0); } else { DA_WAIT_BAR(8); }
#define PAF(k) __builtin_bit_cast(bf16x8, pw##k)
#define VFR(i) (bf16x8){vlo[(i) & 3][0], vlo[(i) & 3][1], vlo[(i) & 3][2], vlo[(i) & 3][3], vhi[(i) & 3][0], vhi[(i) & 3][1], vhi[(i) & 3][2], vhi[(i) & 3][3]}
#define VOFF(i) ((((i) & 3) * 4 + ((i) >> 2)) * 1024)
#define VRD(i) do { vlo[(i) & 3] = vtr(vp_ + VOFF(i)); vhi[(i) & 3] = vtr(vp_ + VOFF(i) + 512); DA_SBAR(); } while (0)
#define KRD(G, d0) do { if (G) { kload2(kf, kp0 + sl_next_, d0); DA_SBAR(); } } while (0)
#define GAPA(MF) do { MF; DA_SBAR(); } while (0)
#define GAPB(MF, X, i, nm, A0, A1, EXTRA) do { MF; X[i] = EX(X[i], nm); X[(i) + 1] = EX(X[(i) + 1], nm); sacc += A0; sacc += A1; EXTRA; DA_PIN(X); DA_PIN(sacc); DA_SBAR(); } while (0)
#define STEP(t, MASK, GK, GV, GL) do { DA_SBAR(); \
    const lcp vp_ = vp0 + SL((t) - 1); const int sl_next_ = SL((t) + 1); \
            GAPA(c0 = DA_MFMA(kf[0], qr[0], bias16)); GAPA(c1 = DA_MFMA(kf[1], qr[0], bias16)); GAPA(c0 = DA_MFMA(kf[2], qr[1], c0)); GAPA(c1 = DA_MFMA(kf[3], qr[1], c1)); \
    VRD(0); GAPA(c0 = DA_MFMA(kf[4], qr[2], c0)); VRD(1); GAPA(c1 = DA_MFMA(kf[5], qr[2], c1)); VRD(2); GAPA(c0 = DA_MFMA(kf[6], qr[3], c0)); VRD(3); GAPA(c1 = DA_MFMA(kf[7], qr[3], c1)); \
    offA += s64; \
    if (GK) DMA_K((t) + 4, SL(t)); if (GV) DMA_V((t) + 2, SL((t) + 2)); \
    if (MASK) cmask(c0, c1, (t) - (NT - 2), qrel, hi); \
    { const float rm = rowmax(c0, c1, offA, offA + s32) - mhat; resc = false; \
      if (__builtin_expect(__any(rm > THR), 0)) { const float dl = __builtin_fmaxf(rm, 0.f); mhat += dl; \
          const float f = __builtin_amdgcn_exp2f(-dl); l_reg *= f; if (hi == 0) wsf[r32] = f; resc = true; } } \
    const float nmh0 = offA - mhat, nmh1 = nmh0 + s32; float sacc = 0.f; DA_SBAR(); \
    GAPB(o[0] = DA_MFMA(PAF(0), VFR(0), o[0]), c0, 0, nmh0, 0.f, 0.f, );             VRD(4); \
    GAPB(o[1] = DA_MFMA(PAF(0), VFR(1), o[1]), c0, 2, nmh0, c0[0], c0[1], );         VRD(5); \
    GAPB(o[2] = DA_MFMA(PAF(0), VFR(2), o[2]), c0, 4, nmh0, c0[2], c0[3], );         VRD(6); \
    GAPB(o[3] = DA_MFMA(PAF(0), VFR(3), o[3]), c0, 6, nmh0, c0[4], c0[5], );         VRD(7); \
    GAPB(o[0] = DA_MFMA(PAF(1), VFR(4), o[0]), c0, 8, nmh0, c0[6], c0[7], pw0[0] = PKW(c0, 0); pw0[1] = PKW(c0, 2); DA_PIN(pw0));    VRD(8); \
    GAPB(o[1] = DA_MFMA(PAF(1), VFR(5), o[1]), c0, 10, nmh0, c0[8], c0[9], pw0[2] = PKW(c0, 4); pw0[3] = PKW(c0, 6); DA_PIN(pw0));   VRD(9); \
    GAPB(o[2] = DA_MFMA(PAF(1), VFR(6), o[2]), c0, 12, nmh0, c0[10], c0[11], );      VRD(10); \
    GAPB(o[3] = DA_MFMA(PAF(1), VFR(7), o[3]), c0, 14, nmh0, c0[12], c0[13], );      VRD(11); \
    GAPB(o[0] = DA_MFMA(PAF(2), VFR(8), o[0]), c1, 0, nmh1, c0[14], c0[15], pw1[0] = PKW(c0, 8); pw1[1] = PKW(c0, 10); DA_PIN(pw1));  VRD(12); \
    GAPB(o[1] = DA_MFMA(PAF(2), VFR(9), o[1]), c1, 2, nmh1, c1[0], c1[1], pw1[2] = PKW(c0, 12); pw1[3] = PKW(c0, 14); DA_PIN(pw1));   VRD(13); \
    GAPB(o[2] = DA_MFMA(PAF(2), VFR(10), o[2]), c1, 4, nmh1, c1[2], c1[3], );        VRD(14); \
    GAPB(o[3] = DA_MFMA(PAF(2), VFR(11), o[3]), c1, 6, nmh1, c1[4], c1[5], );        VRD(15); \
    GAPB(o[0] = DA_MFMA(PAF(3), VFR(12), o[0]), c1, 8, nmh1, c1[6], c1[7], pw2[0] = PKW(c1, 0); pw2[1] = PKW(c1, 2); DA_PIN(pw2));   KRD(GL, 0); \
    GAPB(o[1] = DA_MFMA(PAF(3), VFR(13), o[1]), c1, 10, nmh1, c1[8], c1[9], pw2[2] = PKW(c1, 4); pw2[3] = PKW(c1, 6); DA_PIN(pw2));  KRD(GL, 1); \
    GAPB(o[2] = DA_MFMA(PAF(3), VFR(14), o[2]), c1, 12, nmh1, c1[10], c1[11], );     KRD(GL, 2); \
    GAPB(o[3] = DA_MFMA(PAF(3), VFR(15), o[3]), c1, 14, nmh1, c1[12], c1[13], );     KRD(GL, 3); \
    sacc += c1[14]; sacc += c1[15]; l_reg += sacc; \
    pw3[0] = PKW(c1, 8); pw3[1] = PKW(c1, 10); pw3[2] = PKW(c1, 12); pw3[3] = PKW(c1, 14); DA_PIN(pw3); \
    } while (0)
#define ENDW(tt) do { if ((tt) + 4 < NT) { DA_WAIT_BAR(8); } else if ((tt) + 3 < NT) { DA_WAIT_BAR(6); } else if ((tt) + 2 < NT) { DA_WAIT_BAR(4); } else { DA_WAIT_BAR(0); } } while (0)
    int t = 1;
    for (; t + 4 < NT; ++t) {
        STEP(t, false, true, true, true); DA_WAIT_BAR(8); RESC();
    }
    for (; t + 1 < NT; ++t) {
        STEP(t, true, (t + 4 < NT), (t + 2 < NT), (t + 1 < NT)); ENDW(t); RESC();
    }
    STEP(NT - 1, true, false, false, false); RESC();
    { const lcp vp_ = vp0 + SL(NT - 1);
#define DRN(k, i) do { const s16x4 lo_ = vtr(vp_ + VOFF(i)), hh_ = vtr(vp_ + VOFF(i) + 512); \
        o[(i) & 3] = DA_MFMA(PAF(k), ((bf16x8){lo_[0], lo_[1], lo_[2], lo_[3], hh_[0], hh_[1], hh_[2], hh_[3]}), o[(i) & 3]); } while (0)
      DRN(0, 0); DRN(0, 1); DRN(0, 2); DRN(0, 3); DRN(1, 4); DRN(1, 5); DRN(1, 6); DRN(1, 7); DRN(2, 8); DRN(2, 9); DRN(2, 10); DRN(2, 11); DRN(3, 12); DRN(3, 13); DRN(3, 14); DRN(3, 15);
#undef DRN
    }
#undef DMA_K
#undef DMA_V
#undef SL
#undef EX
#undef RESC
#undef PKW
#undef PAF
#undef VFR
#undef VOFF
#undef VRD
#undef KRD
#undef GAPA
#undef GAPB
#undef STEP
#undef ENDW
    { auto rr = __builtin_amdgcn_permlane32_swap(__float_as_uint(l_reg), __float_as_uint(l_reg), false, false); l_reg = __uint_as_float(rr[0]) + __uint_as_float(rr[1]); }
    attn_epilogue_body(lds, o, l_reg, yb, subln_w, lam, rowb, q0, h, wave, lane);
}
}

namespace rw {
typedef short bf16x8 __attribute__((ext_vector_type(8)));
typedef float f32x2 __attribute__((ext_vector_type(2)));
typedef short s16x4 __attribute__((ext_vector_type(4)));
constexpr int CH = 32, ACT_PITCH = 528;
constexpr int OFF_HAT = 41472, HAT_PITCH = 144, HAT_SZ = 32 * HAT_PITCH, OFF_TIL = OFF_HAT + 4 * HAT_SZ, TIL_PITCH = 40, TIL_SZ = 64 * TIL_PITCH, OFF_GR = OFF_TIL + 4 * TIL_SZ, OFF_WC = OFF_GR + 10 * 1024;
constexpr int OFF_ACT = 0, OFF_RKV = 16896, OFF_VEC = 41472, OFF_G = 82432, OFF_Y = 90624, OFF_NRM = 98816, OFF_SCL = 99328, OFF_CT = 99840, OFF_SCP = 102400;
template <int CTRL> __device__ __forceinline__ float dppf(float x) { return __builtin_bit_cast(float, __builtin_amdgcn_mov_dpp(__builtin_bit_cast(int, x), CTRL, 0xf, 0xf, true)); }
__device__ __forceinline__ float row_allsum(float v) { v += dppf<0x128>(v); v += dppf<0x124>(v); v += dppf<0x122>(v); v += dppf<0x121>(v); return v; }
__device__ __forceinline__ void row_allsum4(float& a, float& b, float& c, float& d) {
#define RW_DPP4(n) "v_add_f32_dpp %0, %0, %0 row_ror:" #n " row_mask:0xf bank_mask:0xf\n\tv_add_f32_dpp %1, %1, %1 row_ror:" #n " row_mask:0xf bank_mask:0xf\n\t" \
                   "v_add_f32_dpp %2, %2, %2 row_ror:" #n " row_mask:0xf bank_mask:0xf\n\tv_add_f32_dpp %3, %3, %3 row_ror:" #n " row_mask:0xf bank_mask:0xf\n\t"
    asm volatile("s_nop 1\n\t" RW_DPP4(8) RW_DPP4(4) RW_DPP4(2) RW_DPP4(1) "s_nop 1" : "+v"(a), "+v"(b), "+v"(c), "+v"(d));
#undef RW_DPP4
}
__device__ __forceinline__ f32x4 ld4bf(const bf16_t* p) { const v2u w = *(const v2u*)p; return (f32x4){pg8::bflo(w.x), pg8::bfhi(w.x), pg8::bflo(w.y), pg8::bfhi(w.y)}; }
__device__ __forceinline__ float fsig(float x) { return __builtin_amdgcn_rcpf(1.f + __expf(-x)); }
__device__ __forceinline__ float ftanh(float x) { return 1.f - 2.f * __builtin_amdgcn_rcpf(1.f + __expf(2.f * x)); }
struct ZRow { v2u r, k, v, w, a; v4u g; };
__device__ __forceinline__ ZRow ldrow(const bf16_t* zr, int c4, int cg) {
    ZRow o; o.r = *(const v2u*)(zr + C_R + c4); o.k = *(const v2u*)(zr + C_K + c4); o.v = *(const v2u*)(zr + C_V + c4); o.w = *(const v2u*)(zr + C_WL + 4 * cg); o.a = *(const v2u*)(zr + C_AL + 4 * cg);
    o.g = *(const v4u*)(zr + C_GL + 8 * cg); return o;
}
__device__ __forceinline__ f32x4 up4(v2u w) { return (f32x4){pg8::bflo(w.x), pg8::bfhi(w.x), pg8::bflo(w.y), pg8::bfhi(w.y)}; }

struct ScanP { const float *mu, *w0, *w2, *a0, *a2, *g2, *k_k, *k_a, *r_k, *lnx_w, *lnx_b; };
__device__ __forceinline__ void scan_unit(LAS unsigned char* lds, const bf16_t* __restrict__ z, bf16_t* __restrict__ ya, const ScanP P, int b, int h, int tid, int wave, int lane) {
    asm volatile("" : "+v"(tid)); lane = tid & 63;
    const float* mu = P.mu; const float* w0 = P.w0; const float* w2 = P.w2; const float* a0 = P.a0; const float* a2 = P.a2; const float* g2 = P.g2;
    const float* k_k = P.k_k; const float* k_a = P.k_a; const float* r_k = P.r_k; const float* lnx_w = P.lnx_w; const float* lnx_b = P.lnx_b;
    const size_t rowb = (size_t)b * SEQ;
    const int tl = tid >> 4, cg = tid & 15;
    const int nt = wave & 3, rl = lane & 15, rg = lane >> 4;
    LAS float* rkv = (LAS float*)(lds + OFF_RKV); LAS float* vec = (LAS float*)(lds + OFF_VEC); LAS float* gbuf = (LAS float*)(lds + OFF_G);
    LAS float* ybuf = (LAS float*)(lds + OFF_Y); LAS float* nrm = (LAS float*)(lds + OFF_NRM); LAS float* scl = (LAS float*)(lds + OFF_SCL); LAS float* scp = (LAS float*)(lds + OFF_SCP);
    bf16x8 bfr[8];
    {
        const int col = h * 64 + 16 * nt + rl;
#pragma unroll
        for (int f = 0; f < 8; ++f) {
            const float* src = (f < 2) ? w2 : (f < 4) ? a2 : g2;
            const int kb = ((f < 4) ? 32 * (f & 1) : 32 * (f - 4)) + 8 * rg;
            float e[8];
#pragma unroll
            for (int j = 0; j < 8; ++j) e[j] = src[(size_t)(kb + j) * 512 + col];
            v4u p; p.x = pg8::cvt_pk_bf16(e[0], e[1]); p.y = pg8::cvt_pk_bf16(e[2], e[3]); p.z = pg8::cvt_pk_bf16(e[4], e[5]); p.w = pg8::cvt_pk_bf16(e[6], e[7]);
            bfr[f] = __builtin_bit_cast(bf16x8, p);
            __builtin_amdgcn_sched_barrier(0);
        }
    }
    const int mt = wave >> 2;
    const int hc = h * 64 + 16 * nt + rl;
    const float w0c = w0[hc], a0c = a0[hc], kkc = k_k[hc], kac = k_a[hc], rkc = r_k[hc];
    const int c4 = h * 64 + 4 * cg;
    f32x4 ST[4];
#pragma unroll
    for (int i = 0; i < 4; ++i) ST[i] = (f32x4){0.f, 0.f, 0.f, 0.f};
    LAS float* ctab = (LAS float*)(lds + OFF_CT);
    if (tl == 0) {
        LAS float* ct = ctab + cg * 36;
        *(LAS f32x4*)(ct + 0) = *(const f32x4*)(mu + C_R + c4); *(LAS f32x4*)(ct + 4) = *(const f32x4*)(mu + C_K + c4); *(LAS f32x4*)(ct + 8) = *(const f32x4*)(mu + C_V + c4);
        *(LAS f32x4*)(ct + 12) = *(const f32x4*)(mu + C_WL + 4 * cg); *(LAS f32x4*)(ct + 16) = *(const f32x4*)(mu + C_AL + 4 * cg);
        *(LAS f32x4*)(ct + 20) = *(const f32x4*)(mu + C_GL + 8 * cg); *(LAS f32x4*)(ct + 24) = *(const f32x4*)(mu + C_GL + 8 * cg + 4);
        *(LAS f32x4*)(ct + 28) = *(const f32x4*)(lnx_w + c4); *(LAS f32x4*)(ct + 32) = *(const f32x4*)(lnx_b + c4);
    }
    __syncthreads();
    const LAS float* myct = ctab + cg * 36;
    ZRow zc = ldrow(z + (rowb + tl) * NZ, c4, cg), zp;
    if (tl > 0) zp = ldrow(z + (rowb + tl - 1) * NZ, c4, cg); else { zp.r = zp.k = zp.v = zp.w = zp.a = (v2u){0u, 0u}; zp.g = (v4u){0u, 0u, 0u, 0u}; }
    for (int t0 = 0; t0 < SEQ; t0 += CH) {
        {
            const f32x4 cr = up4(zc.r), ck = up4(zc.k), cv = up4(zc.v), cw = up4(zc.w), ca = up4(zc.a);
            const f32x4 cg0 = (f32x4){pg8::bflo(zc.g.x), pg8::bfhi(zc.g.x), pg8::bflo(zc.g.y), pg8::bfhi(zc.g.y)}, cg1 = (f32x4){pg8::bflo(zc.g.z), pg8::bfhi(zc.g.z), pg8::bflo(zc.g.w), pg8::bfhi(zc.g.w)};
            const f32x4 pr = up4(zp.r), pk = up4(zp.k), pv = up4(zp.v), pw = up4(zp.w), pa = up4(zp.a);
            const f32x4 pg0 = (f32x4){pg8::bflo(zp.g.x), pg8::bfhi(zp.g.x), pg8::bflo(zp.g.y), pg8::bfhi(zp.g.y)}, pg1 = (f32x4){pg8::bflo(zp.g.z), pg8::bfhi(zp.g.z), pg8::bflo(zp.g.w), pg8::bfhi(zp.g.w)};
            if (t0 + CH < SEQ) { zc = ldrow(z + (rowb + t0 + CH + tl) * NZ, c4, cg); zp = ldrow(z + (rowb + t0 + CH + tl - 1) * NZ, c4, cg); }
            const f32x4 rs_ = cr + (pr - cr) * *(const LAS f32x4*)(myct + 0), ks_ = ck + (pk - ck) * *(const LAS f32x4*)(myct + 4), vs_ = cv + (pv - cv) * *(const LAS f32x4*)(myct + 8);
            const f32x4 ws_ = cw + (pw - cw) * *(const LAS f32x4*)(myct + 12), as_ = ca + (pa - ca) * *(const LAS f32x4*)(myct + 16);
            const f32x4 g0_ = cg0 + (pg0 - cg0) * *(const LAS f32x4*)(myct + 20), g1_ = cg1 + (pg1 - cg1) * *(const LAS f32x4*)(myct + 24);
            *(LAS f32x4*)(rkv + 0 * 2048 + tl * 64 + 4 * cg) = rs_; *(LAS f32x4*)(rkv + 1 * 2048 + tl * 64 + 4 * cg) = ks_; *(LAS f32x4*)(rkv + 2 * 2048 + tl * 64 + 4 * cg) = vs_;
            LAS unsigned char* ar = lds + OFF_ACT + tl * ACT_PITCH;
            v2u tw; tw.x = pg8::cvt_pk_bf16(ftanh(ws_[0]), ftanh(ws_[1])); tw.y = pg8::cvt_pk_bf16(ftanh(ws_[2]), ftanh(ws_[3]));
            *(LAS v2u*)(ar + 8 * cg) = tw;
            v2u aw; aw.x = pg8::cvt_pk_bf16(as_[0], as_[1]); aw.y = pg8::cvt_pk_bf16(as_[2], as_[3]);
            *(LAS v2u*)(ar + 128 + 8 * cg) = aw;
            v4u gw; gw.x = pg8::cvt_pk_bf16(fsig(g0_[0]), fsig(g0_[1])); gw.y = pg8::cvt_pk_bf16(fsig(g0_[2]), fsig(g0_[3]));
            gw.z = pg8::cvt_pk_bf16(fsig(g1_[0]), fsig(g1_[1])); gw.w = pg8::cvt_pk_bf16(fsig(g1_[2]), fsig(g1_[3]));
            *(LAS v4u*)(ar + 256 + 16 * cg) = gw;
        }
        __syncthreads();
        f32x4 accw = (f32x4){0.f, 0.f, 0.f, 0.f}, acca = accw, accg = accw;
        {
            const LAS unsigned char* ap = lds + OFF_ACT + (16 * mt + rl) * ACT_PITCH + 8 * rg * 2;
#pragma unroll
            for (int f = 0; f < 8; ++f) {
                const bf16x8 a = *(const LAS bf16x8*)(ap + f * 64);
                if (f < 2) accw = __builtin_amdgcn_mfma_f32_16x16x32_bf16(a, bfr[f], accw, 0, 0, 0);
                else if (f < 4) acca = __builtin_amdgcn_mfma_f32_16x16x32_bf16(a, bfr[f], acca, 0, 0, 0);
                else accg = __builtin_amdgcn_mfma_f32_16x16x32_bf16(a, bfr[f], accg, 0, 0, 0);
            }
        }
        float lw[4], av[4], kk[4];
        {
            const int c = 16 * nt + rl;
            float n2[4];
#pragma unroll
            for (int r = 0; r < 4; ++r) {
                const int tok = 16 * mt + 4 * rg + r;
                gbuf[tok * 64 + c] = accg[r];
                const float nx = -(w0c + accw[r]);
                const float sp = nx > 20.f ? nx : __logf(1.f + __expf(nx));
                lw[r] = -__expf(-sp - 0.5f);
                av[r] = fsig(a0c + acca[r]);
                kk[r] = rkv[1 * 2048 + tok * 64 + c] * kkc;
                n2[r] = kk[r] * kk[r];
            }
            row_allsum4(n2[0], n2[1], n2[2], n2[3]);
            if (rl == 0) {
#pragma unroll
                for (int r = 0; r < 4; ++r) nrm[(16 * mt + 4 * rg + r) * 4 + nt] = n2[r];
            }
        }
        __syncthreads();
        {
            const int c = 16 * nt + rl;
            const float p0 = lw[0], p1 = p0 + lw[1], p2 = p1 + lw[2], p3 = p2 + lw[3];
            const float t1 = __shfl(p3, (lane - 16) & 63), t2 = __shfl(p3, (lane - 32) & 63), t3 = __shfl(p3, (lane - 48) & 63);
            const float E = (rg >= 1 ? t1 : 0.f) + (rg >= 2 ? t2 : 0.f) + (rg >= 3 ? t3 : 0.f);
            const float Ltot = __shfl(E + p3, rl + 48);
            const float pin[4] = {p0, p1, p2, p3};
            float bt[4], kt[4];
#pragma unroll
            for (int r = 0; r < 4; ++r) {
                const int tok = 16 * mt + 4 * rg + r;
                const f32x4 n4 = *(const LAS f32x4*)(nrm + tok * 4);
                const float ksv = rkv[1 * 2048 + tok * 64 + c], rsv = rkv[0 * 2048 + tok * 64 + c];
                const float inv = fminf(__builtin_amdgcn_rsqf((n4[0] + n4[1]) + (n4[2] + n4[3])), 1e12f);
                const float kkn = kk[r] * inv, beta = kkn * av[r], kmod = ksv * (1.f + (av[r] - 1.f) * kac);
                const float L = E + pin[r], eL = __expf(L), ieL = __expf(-L), eLm = __expf(L - lw[r]), eT = __expf(Ltot - L);
                LAS unsigned char* hp = lds + OFF_HAT + tok * HAT_PITCH + c * 2;
                *(LAS bf16_t*)(hp) = f2bf(-kkn * eLm); *(LAS bf16_t*)(hp + HAT_SZ) = f2bf(beta * ieL); *(LAS bf16_t*)(hp + 2 * HAT_SZ) = f2bf(kmod * ieL); *(LAS bf16_t*)(hp + 3 * HAT_SZ) = f2bf(rsv * eL);
                bt[r] = beta * eT; kt[r] = kmod * eT;
                float pbr = beta * rsv, pkr = kmod * rsv, pbo = rsv * kmod * rkc, dum = 0.f;
                row_allsum4(pbr, pkr, pbo, dum);
                if (rl == 0) *(LAS f32x4*)(scp + (tok * 4 + nt) * 4) = (f32x4){pbr, pkr, pbo, 0.f};
            }
            LAS unsigned char* tp = lds + OFF_TIL + (2 * mt) * TIL_SZ + c * TIL_PITCH + 8 * rg;
            v2u w; w.x = pg8::cvt_pk_bf16(bt[0], bt[1]); w.y = pg8::cvt_pk_bf16(bt[2], bt[3]); *(LAS v2u*)(tp) = w;
            w.x = pg8::cvt_pk_bf16(kt[0], kt[1]); w.y = pg8::cvt_pk_bf16(kt[2], kt[3]); *(LAS v2u*)(tp + TIL_SZ) = w;
            if (rg == 0) ((LAS float*)(lds + OFF_WC))[mt * 64 + c] = __expf(Ltot);
        }
        __syncthreads();
        if (tid < CH) {
            const f32x4 p0 = *(const LAS f32x4*)(scp + tid * 16), p1 = *(const LAS f32x4*)(scp + tid * 16 + 4), p2 = *(const LAS f32x4*)(scp + tid * 16 + 8), p3 = *(const LAS f32x4*)(scp + tid * 16 + 12);
            *(LAS f32x4*)(scl + 4 * tid) = (p0 + p1) + (p2 + p3);
        }
        int lane_ = lane; asm volatile("" : "+v"(lane_));
        const int rl_ = lane_ & 15, rg_ = lane_ >> 4;
        {
            const int c = wave >> 2, g = wave & 3;
            const LAS unsigned char* pa = lds + OFF_HAT + ((g & 1) ? 2 : 1) * HAT_SZ + (16 * c + rl_) * HAT_PITCH + 16 * rg_;
            const LAS unsigned char* pb = lds + OFF_HAT + ((g < 2) ? 0 : 3) * HAT_SZ + (16 * c + rl_) * HAT_PITCH + 16 * rg_;
            f32x4 acc = (f32x4){0.f, 0.f, 0.f, 0.f};
            acc = __builtin_amdgcn_mfma_f32_16x16x32_bf16(*(const LAS bf16x8*)(pa), *(const LAS bf16x8*)(pb), acc, 0, 0, 0);
            acc = __builtin_amdgcn_mfma_f32_16x16x32_bf16(*(const LAS bf16x8*)(pa + 64), *(const LAS bf16x8*)(pb + 64), acc, 0, 0, 0);
#pragma unroll
            for (int e = 0; e < 4; ++e) { const int row = 4 * rg_ + e; const bool keep = (g < 2) ? (row < rl_) : (row <= rl_); if (!keep) acc[e] = 0.f; }
            *(LAS f32x4*)(lds + OFF_GR + (c * 5 + g) * 1024 + lane_ * 16) = acc;
            if (g == 0) {
                asm volatile("s_waitcnt lgkmcnt(0)" ::: "memory");
                if (lane_ < 16) {
                    const int sc = lane_;
                    const LAS float* tb = (const LAS float*)(lds + OFF_GR + (c * 5) * 1024);
                    float m[16], ps[16];
#pragma unroll
                    for (int r = 0; r < 16; ++r) ps[r] = 0.f;
#pragma unroll
                    for (int u = 15; u >= 0; --u) {
                        m[u] = (u == sc) ? 1.f : ((u < sc) ? ps[u] : 0.f);
#pragma unroll
                        for (int r = 0; r < u; ++r) ps[r] = __builtin_fmaf(tb[(u + 16 * (r >> 2)) * 4 + (r & 3)], m[u], ps[r]);
                    }
                    LAS f32x4* mt_ = (LAS f32x4*)(lds + OFF_GR + (c * 5 + 4) * 1024);
#pragma unroll
                    for (int q = 0; q < 4; ++q) mt_[sc + 16 * q] = (f32x4){m[4 * q], m[4 * q + 1], m[4 * q + 2], m[4 * q + 3]};
                }
            }
        }
        __syncthreads();
        if (wave < 4) {
            const int ib = wave;
#pragma unroll
            for (int c = 0; c < 2; ++c) {
                bf16x8 sb[2];
#pragma unroll
                for (int ks = 0; ks < 2; ++ks) {
                    v4u p; p.x = pg8::cvt_pk_bf16(ST[2 * ks][0], ST[2 * ks][1]); p.y = pg8::cvt_pk_bf16(ST[2 * ks][2], ST[2 * ks][3]);
                    p.z = pg8::cvt_pk_bf16(ST[2 * ks + 1][0], ST[2 * ks + 1][1]); p.w = pg8::cvt_pk_bf16(ST[2 * ks + 1][2], ST[2 * ks + 1][3]);
                    sb[ks] = __builtin_bit_cast(bf16x8, p);
                }
                const LAS unsigned char* ha = lds + OFF_HAT + (16 * c + rl_) * HAT_PITCH + 8 * rg_;
                f32x4 xt = (f32x4){0.f, 0.f, 0.f, 0.f}, yt = xt;
#pragma unroll
                for (int ks = 0; ks < 2; ++ks) {
                    v4u fa, fr; const v2u a0_ = *(const LAS v2u*)(ha + 64 * ks), a1_ = *(const LAS v2u*)(ha + 64 * ks + 32);
                    const v2u r0_ = *(const LAS v2u*)(ha + 3 * HAT_SZ + 64 * ks), r1_ = *(const LAS v2u*)(ha + 3 * HAT_SZ + 64 * ks + 32);
                    fa.x = a0_.x; fa.y = a0_.y; fa.z = a1_.x; fa.w = a1_.y; fr.x = r0_.x; fr.y = r0_.y; fr.z = r1_.x; fr.w = r1_.y;
                    xt = __builtin_amdgcn_mfma_f32_16x16x32_bf16(__builtin_bit_cast(bf16x8, fa), sb[ks], xt, 0, 0, 0);
                    yt = __builtin_amdgcn_mfma_f32_16x16x32_bf16(__builtin_bit_cast(bf16x8, fr), sb[ks], yt, 0, 0, 0);
                }
                const LAS float* vsrc = rkv + 2 * 2048 + (16 * c + 4 * rg_) * 64 + 16 * ib + rl_;
                v2u vb_; vb_.x = pg8::cvt_pk_bf16(vsrc[0], vsrc[64]); vb_.y = pg8::cvt_pk_bf16(vsrc[128], vsrc[192]);
                const s16x4 vb = __builtin_bit_cast(s16x4, vb_);
                const LAS unsigned char* gr = lds + OFF_GR + (c * 5) * 1024 + lane_ * 16;
#define RW_AFR(g_) ({ const f32x4 t_ = *(const LAS f32x4*)(gr + (g_) * 1024); v2u w_; w_.x = pg8::cvt_pk_bf16(t_[0], t_[1]); w_.y = pg8::cvt_pk_bf16(t_[2], t_[3]); __builtin_bit_cast(s16x4, w_); })
#define RW_PK4(x_) ({ v2u w_; w_.x = pg8::cvt_pk_bf16((x_)[0], (x_)[1]); w_.y = pg8::cvt_pk_bf16((x_)[2], (x_)[3]); __builtin_bit_cast(s16x4, w_); })
                const f32x4 zt = __builtin_amdgcn_mfma_f32_16x16x16bf16_1k(RW_AFR(1), vb, xt, 0, 0, 0);
                const f32x4 ut = __builtin_amdgcn_mfma_f32_16x16x16bf16_1k(RW_AFR(4), RW_PK4(zt), (f32x4){0.f, 0.f, 0.f, 0.f}, 0, 0, 0);
                const s16x4 ub = RW_PK4(ut);
                yt = __builtin_amdgcn_mfma_f32_16x16x16bf16_1k(RW_AFR(2), ub, yt, 0, 0, 0);
                yt = __builtin_amdgcn_mfma_f32_16x16x16bf16_1k(RW_AFR(3), vb, yt, 0, 0, 0);
#pragma unroll
                for (int e = 0; e < 4; ++e) ybuf[(16 * c + 4 * rg_ + e) * 64 + 16 * ib + rl_] = yt[e];
                const LAS unsigned char* tl_ = lds + OFF_TIL + (2 * c) * TIL_SZ + rl_ * TIL_PITCH + 8 * rg_;
                const LAS float* wc = (const LAS float*)(lds + OFF_WC) + c * 64 + 4 * rg_;
#pragma unroll
                for (int jt = 0; jt < 4; ++jt) {
                    f32x4 acc = ST[jt] * *(const LAS f32x4*)(wc + 16 * jt);
                    acc = __builtin_amdgcn_mfma_f32_16x16x16bf16_1k(*(const LAS s16x4*)(tl_ + TIL_SZ + 16 * jt * TIL_PITCH), vb, acc, 0, 0, 0);
                    acc = __builtin_amdgcn_mfma_f32_16x16x16bf16_1k(*(const LAS s16x4*)(tl_ + 16 * jt * TIL_PITCH), ub, acc, 0, 0, 0);
                    ST[jt] = acc;
                }
#undef RW_AFR
#undef RW_PK4
            }
        }
        __syncthreads();
        {
            const f32x4 y4 = *(const LAS f32x4*)(ybuf + tl * 64 + 4 * cg);
            const float mean = row_allsum((y4[0] + y4[1]) + (y4[2] + y4[3])) * (1.f / 64.f);
            const f32x4 dv = y4 - mean;
            const float var = row_allsum((dv[0] * dv[0] + dv[1] * dv[1]) + (dv[2] * dv[2] + dv[3] * dv[3])) * (1.f / 64.f);
            const float rs_ = rsqrtf(var + GN_EPS);
            const f32x4 yn = dv * rs_ * *(const LAS f32x4*)(myct + 28) + *(const LAS f32x4*)(myct + 32);
            const float bonus = scl[tl * 4 + 2];
            const f32x4 vs_ = *(const LAS f32x4*)(rkv + 2 * 2048 + tl * 64 + 4 * cg), g4 = *(const LAS f32x4*)(gbuf + tl * 64 + 4 * cg);
            const f32x4 o = (yn + vs_ * bonus) * g4;
            v2u w; w.x = pg8::cvt_pk_bf16(o[0], o[1]); w.y = pg8::cvt_pk_bf16(o[2], o[3]);
            *(v2u*)(ya + (rowb + t0 + tl) * YAB_PITCH + c4) = w;
        }
        __syncthreads();
    }
}
}

typedef __bf16 bf16x2_t __attribute__((ext_vector_type(2)));
__device__ __forceinline__ float dot2bf(unsigned a, unsigned b, float c) { return __builtin_amdgcn_fdot2_f32_bf16(__builtin_bit_cast(bf16x2_t, a), __builtin_bit_cast(bf16x2_t, b), c, false); }
__device__ __forceinline__ unsigned f2ord(float f) { const unsigned u = __float_as_uint(f); return (u & 0x80000000u) ? ~u : (u | 0x80000000u); }
__device__ __forceinline__ float ord2f(unsigned o) { return __uint_as_float((o & 0x80000000u) ? (o ^ 0x80000000u) : ~o); }
__device__ __forceinline__ unsigned row_allmax_u32(unsigned v) {
    v = max(v, (unsigned)__builtin_amdgcn_update_dpp(0, (int)v, 0x128, 0xf, 0xf, false));
    v = max(v, (unsigned)__builtin_amdgcn_update_dpp(0, (int)v, 0x124, 0xf, 0xf, false));
    v = max(v, (unsigned)__builtin_amdgcn_update_dpp(0, (int)v, 0x122, 0xf, 0xf, false));
    v = max(v, (unsigned)__builtin_amdgcn_update_dpp(0, (int)v, 0x121, 0xf, 0xf, false));
    return v;
}

constexpr int TK_PITCH = 272, TK_HALF = 128 * TK_PITCH;
typedef short tk_bf16x8 __attribute__((ext_vector_type(8)));
__device__ __forceinline__ void topk_loadq(tk_bf16x8 (&qa)[8], const bf16_t* __restrict__ qb, int t0, int h, int lane) {
    const bf16_t* qp = qb + (size_t)(t0 + (lane & 15)) * 2048 + h * 256 + 8 * (lane >> 4);
#pragma unroll
    for (int i = 0; i < 8; ++i) qa[i] = *(const tk_bf16x8*)(qp + i * 32);
}
__device__ __forceinline__ void topk_item(const tk_bf16x8 (&qa)[8], const LAS unsigned char* klds, int* __restrict__ ids, float* __restrict__ gates, int t0, int h, int lane) {
    const int rl = lane & 15, rg = lane >> 4;
    unsigned top[2][4];
#pragma unroll
    for (int c = 0; c < 2; ++c) {
        f32x4 acc[8];
#pragma unroll
        for (int nt = 0; nt < 8; ++nt) acc[nt] = (f32x4){64.f, 64.f, 64.f, 64.f};
        const LAS unsigned char* kp = klds + c * TK_HALF + rl * TK_PITCH + 16 * rg;
#pragma unroll
        for (int ks = 0; ks < 4; ++ks) {
#pragma unroll
            for (int nt = 0; nt < 8; ++nt) { const tk_bf16x8 b = *(const LAS tk_bf16x8*)(kp + nt * 16 * TK_PITCH + ks * 64); acc[nt] = __builtin_amdgcn_mfma_f32_16x16x32_bf16(qa[c * 4 + ks], b, acc[nt], 0, 0, 0); }
            __builtin_amdgcn_sched_barrier(0);
        }
        unsigned k[4][8];
#pragma unroll
        for (int r = 0; r < 4; ++r) {
#pragma unroll
            for (int nt = 0; nt < 8; ++nt) k[r][nt] = (__float_as_uint(fmaxf(acc[nt][r], 1.f)) & ~127u) | (unsigned)(127 - (nt * 16 + rl));
#define TK_CE(i, j) do { const unsigned a_ = max(k[r][i], k[r][j]), b_ = min(k[r][i], k[r][j]); k[r][i] = a_; k[r][j] = b_; } while (0)
            TK_CE(0, 1); TK_CE(2, 3); TK_CE(4, 5); TK_CE(6, 7); TK_CE(0, 2); TK_CE(1, 3); TK_CE(4, 6); TK_CE(5, 7); TK_CE(1, 2); TK_CE(5, 6);
            TK_CE(0, 4); TK_CE(1, 5); TK_CE(2, 6); TK_CE(3, 7); TK_CE(2, 4); TK_CE(3, 5); TK_CE(1, 2); TK_CE(3, 4); TK_CE(5, 6);
#undef TK_CE
        }
        unsigned tp[4] = {0u, 0u, 0u, 0u};
        for (int round = 0; round < 16; ++round) {
#pragma unroll
            for (int r = 0; r < 4; ++r) {
                const unsigned m = row_allmax_u32(k[r][0]);
                tp[r] = (rl == round) ? m : tp[r];
                const bool win = (k[r][0] == m);
                k[r][0] = win ? k[r][1] : k[r][0]; k[r][1] = win ? k[r][2] : k[r][1]; k[r][2] = win ? k[r][3] : k[r][2]; k[r][3] = win ? k[r][4] : k[r][3];
                k[r][4] = win ? k[r][5] : k[r][4]; k[r][5] = win ? k[r][6] : k[r][5]; k[r][6] = win ? k[r][7] : k[r][6]; k[r][7] = win ? 0u : k[r][7];
            }
        }
#pragma unroll
        for (int r = 0; r < 4; ++r) top[c][r] = tp[r];
    }
    const int rowbase = lane & 48;
    float v1[4]; int n1[4], ptr[4], myid[4]; unsigned k2[4], myv[4];
#pragma unroll
    for (int r = 0; r < 4; ++r) { v1[r] = __uint_as_float(top[0][r] & ~127u); n1[r] = 127 - (int)(top[0][r] & 127u); ptr[r] = 0; k2[r] = (unsigned)__builtin_amdgcn_ds_bpermute(rowbase * 4, (int)top[1][r]); myid[r] = 0; myv[r] = 0u; }
    for (int round = 0; round < 16; ++round) {
#pragma unroll
        for (int r = 0; r < 4; ++r) {
            const float head = v1[r] + __uint_as_float(k2[r] & ~127u);
            const unsigned key = (ptr[r] < 16) ? ((__float_as_uint(head) & ~15u) | (unsigned)(15 - rl)) : 0u;
            const unsigned m = row_allmax_u32(key);
            const bool win = (key == m);
            const unsigned wid = row_allmax_u32(win ? (unsigned)(n1[r] * 128 + (127 - (int)(k2[r] & 127u))) + 1u : 0u);
            myid[r] = (rl == round) ? (int)wid - 1 : myid[r];
            myv[r] = (rl == round) ? m : myv[r];
            ptr[r] += win ? 1 : 0;
            k2[r] = (unsigned)__builtin_amdgcn_ds_bpermute((rowbase + (ptr[r] & 15)) * 4, (int)top[1][r]);
        }
    }
#pragma unroll
    for (int r = 0; r < 4; ++r) {
        const float val = __uint_as_float(myv[r] & ~15u);
        const float vmax = __uint_as_float((unsigned)__builtin_amdgcn_ds_bpermute(rowbase * 4, (int)__float_as_uint(val)));
        const float e = __expf(val - vmax);
        const float sum = rw::row_allsum(e);
        gates[(size_t)(t0 + 4 * rg + r) * 128 + h * 16 + rl] = e * __builtin_amdgcn_rcpf(sum); ids[(size_t)(t0 + 4 * rg + r) * 128 + h * 16 + rl] = myid[r];
    }
}

typedef float f32x2 __attribute__((ext_vector_type(2)));
__device__ __forceinline__ void peer_token(const bf16_t* __restrict__ x2b, const float* __restrict__ ssq2, const int* __restrict__ ids, const float* __restrict__ gates,
                                           const unsigned char* __restrict__ U8, const unsigned char* __restrict__ V8, const float* __restrict__ usc, const float* __restrict__ vsc,
                                           const float* __restrict__ fw, float* __restrict__ out, int t, int lane) {
    const int l16 = lane * 16;
    f32x2 hx[8];
    {
        const v4u h0 = *(const v4u*)(x2b + (size_t)t * DM + l16), h1 = *(const v4u*)(x2b + (size_t)t * DM + l16 + 8);
        const unsigned hw[8] = {h0.x, h0.y, h0.z, h0.w, h1.x, h1.y, h1.z, h1.w};
#pragma unroll
        for (int i = 0; i < 8; ++i) hx[i] = (f32x2){pg8::bflo(hw[i]), pg8::bfhi(hw[i])};
    }
    const int idA = ids[(size_t)t * 128 + lane], idB = ids[(size_t)t * 128 + 64 + lane];
    const float rs = rsqrtf(pg8::ssq_sum16(ssq2 + (size_t)t * 16) * (1.f / DM) + NORM_EPS);
    const float suA = rs * usc[idA], suB = rs * usc[idB];
    const float svA = gates[(size_t)t * 128 + lane] * vsc[idA], svB = gates[(size_t)t * 128 + 64 + lane] * vsc[idB];
    f32x2 y[8];
#pragma unroll
    for (int i = 0; i < 8; ++i) y[i] = (f32x2){0.f, 0.f};
    const int bit0 = lane & 1, bit1 = (lane >> 1) & 1, bit5 = lane >> 5;
    v3u_t uw[8], vw[8];
    const unsigned vo12 = (unsigned)lane * 12u;
#define PEER_LDU(g_) do { const int is_ = ((g_) < 8) ? idA : idB; const int lb_ = ((g_) * 8) & 63; _Pragma("unroll") for (int k = 0; k < 8; ++k) { const unsigned eo = (unsigned)__builtin_amdgcn_readlane(is_, lb_ + k) * 768u; \
        const unsigned char* rp_ = U8 + eo; uw[k] = *(const v3u_t*)(rp_ + vo12); } } while (0)
#define PEER_LDV(g_) do { const int is_ = ((g_) < 8) ? idA : idB; const int lb_ = ((g_) * 8) & 63; _Pragma("unroll") for (int k = 0; k < 8; ++k) { const unsigned eo = (unsigned)__builtin_amdgcn_readlane(is_, lb_ + k) * 768u; \
        const unsigned char* rp_ = V8 + eo; vw[k] = *(const v3u_t*)(rp_ + vo12); } } while (0)
    PEER_LDU(0); PEER_LDV(0);
    for (int g = 0; g < 16; ++g) {
        const float susel = (g < 8) ? suA : suB, svsel = (g < 8) ? svA : svB; const int lb = (g * 8) & 63;
        float d[8];
#pragma unroll
        for (int k = 0; k < 8; k += 2) {
            const v32f_t f = __builtin_amdgcn_cvt_scalef32_pk32_f32_fp6((v6u_t){uw[k][0], uw[k][1], uw[k][2], uw[k + 1][0], uw[k + 1][1], uw[k + 1][2]}, 1.0f);
            f32x2 a = (f32x2){0.f, 0.f}, b = a;
#pragma unroll
            for (int i = 0; i < 8; ++i) { a += (f32x2){f[2 * i], f[2 * i + 1]} * hx[i]; b += (f32x2){f[16 + 2 * i], f[17 + 2 * i]} * hx[i]; }
            d[k] = a[0] + a[1]; d[k + 1] = b[0] + b[1];
            __builtin_amdgcn_sched_barrier(0);
        }
        if (g + 1 < 16) PEER_LDU(g + 1);
        __builtin_amdgcn_sched_barrier(0);
#pragma unroll
        for (int k = 0; k < 8; ++k) d[k] *= __uint_as_float((unsigned)__builtin_amdgcn_readlane((int)__float_as_uint(susel), lb + k));
        float r4[4];
#pragma unroll
        for (int k = 0; k < 4; ++k) { const float send = bit0 ? d[k] : d[k + 4], keep = bit0 ? d[k + 4] : d[k]; r4[k] = keep + rw::dppf<0xB1>(send); }
        float r2[2];
#pragma unroll
        for (int k = 0; k < 2; ++k) { const float send = bit1 ? r4[k] : r4[k + 2], keep = bit1 ? r4[k + 2] : r4[k]; r2[k] = keep + rw::dppf<0x4E>(send); }
        float r1;
        { const float send = bit5 ? r2[0] : r2[1], keep = bit5 ? r2[1] : r2[0];
          auto rr = __builtin_amdgcn_permlane32_swap(__float_as_uint(send), __float_as_uint(send), false, false);
          r1 = keep + __uint_as_float(bit5 ? rr[0] : rr[1]); }
        r1 += rw::dppf<0x128>(r1); r1 += rw::dppf<0x124>(r1);
        r1 += __uint_as_float((unsigned)__builtin_amdgcn_ds_swizzle((int)__float_as_uint(r1), 0x401F));
        const float dd = r1;
        const float act = 0.5f * dd * (1.f + erff(dd * 0.70710678118654752f));
#pragma unroll
        for (int k = 0; k < 8; k += 2) {
#define PEER_LANE_OF(k_) ((((k_) >> 2) & 1) | ((((k_) >> 1) & 1) << 1) | (((k_) & 1) << 5))
            const float a = __uint_as_float((unsigned)__builtin_amdgcn_readlane((int)__float_as_uint(act), PEER_LANE_OF(k))) * __uint_as_float((unsigned)__builtin_amdgcn_readlane((int)__float_as_uint(svsel), lb + k));
            const float b = __uint_as_float((unsigned)__builtin_amdgcn_readlane((int)__float_as_uint(act), PEER_LANE_OF(k + 1))) * __uint_as_float((unsigned)__builtin_amdgcn_readlane((int)__float_as_uint(svsel), lb + k + 1));
#undef PEER_LANE_OF
            const f32x2 a2 = (f32x2){a, a}, b2 = (f32x2){b, b};
            const v32f_t f = __builtin_amdgcn_cvt_scalef32_pk32_f32_fp6((v6u_t){vw[k][0], vw[k][1], vw[k][2], vw[k + 1][0], vw[k + 1][1], vw[k + 1][2]}, 1.0f);
#pragma unroll
            for (int i = 0; i < 8; ++i) { y[i] += (f32x2){f[2 * i], f[2 * i + 1]} * a2; y[i] += (f32x2){f[16 + 2 * i], f[17 + 2 * i]} * b2; }
            __builtin_amdgcn_sched_barrier(0);
        }
        if (g + 1 < 16) PEER_LDV(g + 1);
        __builtin_amdgcn_sched_barrier(0);
    }
#undef PEER_LDU
#undef PEER_LDV
    float* orow = out + (size_t)t * DM + l16;
    float ss = 0.f;
    f32x4 o4[4];
#pragma unroll
    for (int i = 0; i < 4; ++i) { o4[i] = (f32x4){hx[2 * i][0] + y[2 * i][0], hx[2 * i][1] + y[2 * i][1], hx[2 * i + 1][0] + y[2 * i + 1][0], hx[2 * i + 1][1] + y[2 * i + 1][1]};
        ss += (o4[i][0] * o4[i][0] + o4[i][1] * o4[i][1]) + (o4[i][2] * o4[i][2] + o4[i][3] * o4[i][3]); }
    ss = wave_sum(ss);
    const float r = rsqrtf(ss * (1.f / DM) + NORM_EPS);
#pragma unroll
    for (int i = 0; i < 4; ++i) *(f32x4*)(orow + 4 * i) = o4[i] * r * *(const f32x4*)(fw + l16 + 4 * i);
}

__global__ void __launch_bounds__(NWAVES * 64, 2) mk_fwd(Args args) {
    extern __shared__ __attribute__((aligned(16))) unsigned char lds_raw[];
    LAS unsigned char* lds = (LAS unsigned char*)lds_raw;
    volatile LAS unsigned* MISC = (volatile LAS unsigned*)(lds + MISC_OFF);
    const int tid = threadIdx.x, lane = tid & 63, wave = __builtin_amdgcn_readfirstlane(tid >> 6);
    const int G = gridDim.x; const int bx = blockIdx.x; const int vcu = (G % 8 == 0) ? (bx % 8) * (G / 8) + bx / 8 : bx;
    unsigned char* ws = args.ws;
    unsigned* ctl = (unsigned*)(ws + WS_CTL);
    for (int u = tid; u < (LDS_BYTES - LDSCTL_OFF) / 4; u += NWAVES * 64) ((LAS unsigned*)(lds + LDSCTL_OFF))[u] = 0u;
    __syncthreads();
    XcdBarrier bar = xcd_barrier_post(ctl + CW_BAR + args.li * XCD_BAR_WORDS, MISC + 8);
    const int lo = args.ph_lo, hi = args.ph_hi;
#define IN(k) (lo <= (k) && (k) < hi)
#define BOTH(k) (IN(k) && IN((k) + 1))
    bf16_t* WinT = (bf16_t*)(ws + WS_WIN); bf16_t* PaT = (bf16_t*)(ws + WS_PA); bf16_t* PbT = (bf16_t*)(ws + WS_PB); bf16_t* WoT = (bf16_t*)(ws + WS_WO);
    bf16_t* WqT = (bf16_t*)(ws + WS_WQ); bf16_t* KeysB = (bf16_t*)(ws + WS_KEYS);
    float* rstd1 = (float*)(ws + WS_RSTD1); float* ssq2 = (float*)(ws + WS_RSTD2); float* scal = (float*)(ws + WS_SCAL);
    unsigned char* U8 = ws + WS_U; unsigned char* V8 = ws + WS_V; float* usc = (float*)(ws + WS_USC); float* vsc = (float*)(ws + WS_VSC);
    bf16_t* xb = (bf16_t*)(ws + WS_XB); bf16_t* ya = (bf16_t*)(ws + WS_YA); bf16_t* yb = (bf16_t*)(ws + WS_YB); bf16_t* x2b = (bf16_t*)(ws + WS_X2B);
    bf16_t* z = (bf16_t*)(ws + WS_Z); bf16_t* qb = (bf16_t*)(ws + WS_Q);
    bf16_t* merged = (bf16_t*)(ws + WS_MERGED);
    const int gw = vcu * NWAVES + wave, NGW = G * NWAVES;

    if (IN(0)) {
        LAS float* scr = (LAS float*)(lds + wave * 16384);
        constexpr int I_IN = (DM / 64) * (NZ / 32), I_PA = (512 / 64) * (DM / 32), I_WO = (DM / 64) * (DM / 32), I_WQ = (DM / 64) * (2048 / 32);
        constexpr int NITEMS = I_IN + 2 * I_PA + I_WO + I_WQ;
        for (int it = gw; it < NITEMS; it += NGW) {
            int r = it;
            if (r < I_IN) { p0_transpose_item(args.in[2], args.in[1], DM, NZ, WinT, scr, r, lane, ws + WS_WG8, C_GA); continue; } r -= I_IN;
            if (r < I_PA) { p0_transpose_item(args.in[19], nullptr, 512, DM, PaT, scr, r, lane, nullptr, 0, DM, 0); continue; } r -= I_PA;
            if (r < I_PA) { p0_transpose_item(args.in[20], nullptr, 512, DM, PaT, scr, r, lane, nullptr, 0, DM, 512); continue; } r -= I_PA;
            if (r < I_WO) { p0_transpose_item(args.in[21], nullptr, DM, DM, WoT, scr, r, lane); continue; } r -= I_WO;
            p0_transpose_item(args.in[23], args.in[22], DM, 2048, WqT, scr, r, lane);
        }
        p0_convert(args.in[24], nullptr, KeysB, (size_t)16 * 128 * 128, gw, NGW, lane);
        for (int e = gw; e < 2 * NEXP; e += NGW) {
            const bool isu = e < NEXP; const int row = isu ? e : e - NEXP;
            p0_row_fp6((isu ? args.in[25] : args.in[26]) + (size_t)row * DM, isu ? args.in[22] : nullptr, (isu ? U8 : V8) + (size_t)row * 768, (isu ? usc : vsc) + row, lane);
        }
        for (int m = gw; m < T_TOK; m += NGW) {
            const f32x4* xr = (const f32x4*)(args.in[0] + (size_t)m * DM) + lane;
            f32x4 v[4]; float s = 0.f;
#pragma unroll
            for (int j = 0; j < 4; ++j) { v[j] = xr[64 * j]; s += (v[j][0] * v[j][0] + v[j][1] * v[j][1]) + (v[j][2] * v[j][2] + v[j][3] * v[j][3]); }
            s = wave_sum(s);
            v2u* o8 = (v2u*)(xb + (size_t)m * DM) + lane;
#pragma unroll
            for (int j = 0; j < 4; ++j) { v2u w; w.x = pg8::cvt_pk_bf16(v[j][0], v[j][1]); w.y = pg8::cvt_pk_bf16(v[j][2], v[j][3]); o8[64 * j] = w;
                int p = 0; p = __builtin_amdgcn_cvt_pk_fp8_f32(v[j][0], v[j][1], p, false); p = __builtin_amdgcn_cvt_pk_fp8_f32(v[j][2], v[j][3], p, true);
                ((unsigned*)(ws + WS_XQ + (size_t)m * DM))[lane + 64 * j] = (unsigned)p; }
            if (lane == 0) rstd1[m] = rsqrtf(s * (1.f / DM) + NORM_EPS);
        }
        if (gw == 0) {
            const float a = wave_sum(args.in[14][lane] * args.in[15][lane]), b = wave_sum(args.in[16][lane] * args.in[17][lane]);
            if (lane == 0) scal[0] = __expf(a) - __expf(b) + LAM_INIT;
        }
        if (BOTH(0)) xcd_barrier(bar);
    }
    if (IN(1)) {
        {
            pg8::Gemm g{xb, WinT, DM, DM, DM}; pg8::StaticOrder S; S.init(T_TOK, C_GA, G, bx);
            pg8::EpiRowScale<false> E{z, NZ, rstd1};
            pg8::gemm_phase(lds, g, S, E);
        }
        {
            pg8::Gemm g{(const bf16_t*)(ws + WS_XQ), (const bf16_t*)(ws + WS_WG8), DM / 2, DM / 2, DM / 2}; pg8::StaticOrder S; S.init(T_TOK, NZ - C_GA, G, bx);
            pg8::EpiRowScale<false> E{z + C_GA, NZ, rstd1, 1.f / 32.f};
            pg8::gemm_phase<pg8::EpiRowScale<false>, pg8::StaticOrder, true>(lds, g, S, E);
        }
        if (BOTH(1)) xcd_barrier(bar);
    }
    if (IN(2)) {
        {
            const rw::ScanP P{args.in[3], args.in[4], args.in[5], args.in[6], args.in[7], args.in[8], args.in[9], args.in[10], args.in[11], args.in[12], args.in[13]};
            for (int rep = 0; rep < REPS(2); ++rep) for (int u = vcu; u < NB * 8; u += G) rw::scan_unit(lds, z, ya, P, u >> 3, u & 7, tid, wave, lane);
        }
        const float lam = scal[0];
        __syncthreads();
        for (int i = 0;; ++i) {
            int idx = vcu + i * G; if (idx >= 2048 * REPS(10)) break;
            idx &= 2047;
            const int slot = idx >> 8, v = idx & 255, bh = v >> 1, a = (v & 1) * 4 + (slot >> 1), qblk = (slot & 1) ? 15 - a : a;
            da::attn_unit(lds, z, yb, args.in[18], lam, bh >> 2, bh & 3, qblk, wave, lane);
        }
        if (BOTH(2)) xcd_barrier(bar);
    }
    if (IN(3)) {
        pg8::Gemm g{ya, PaT, DM, DM, DM}; pg8::StaticOrder S; S.init(T_TOK, DM, G, bx);
        pg8::EpiGate2 E{merged, z};
        pg8::gemm_phase(lds, g, S, E);
        if (BOTH(3)) xcd_barrier(bar);
    }
    if (IN(5)) {
        pg8::Gemm g{merged, WoT, DM, DM, DM}; pg8::StaticOrder S; S.init(T_TOK, DM, G, bx);
        pg8::EpiX2 E{args.in[0], args.out, x2b, ssq2};
        pg8::gemm_phase(lds, g, S, E);
        if (BOTH(5)) xcd_barrier(bar);
    }
    if (IN(6)) {
        pg8::Gemm g{x2b, WqT, DM, DM, DM}; pg8::StaticOrder S; S.init(T_TOK, 2048, G, bx);
        pg8::EpiRowScale<true> E{qb, 2048, ssq2};
        for (int rep = 0; rep < REPS(6); ++rep) pg8::gemm_phase(lds, g, S, E);
        if (BOTH(6)) xcd_barrier(bar);
    }
    if (IN(7)) {
        int* ids = (int*)(ws + WS_IDS); float* gates = (float*)(ws + WS_GATES);
        for (int rep = 0; rep < REPS(7); ++rep)
        for (int h = 0; h < 8; ++h) {
            __syncthreads();
            {
                const bf16_t* ksrc = KeysB + (size_t)h * 2 * 128 * 128;
#pragma unroll
                for (int i = 0; i < 8; ++i) { const int chunk = tid + i * 512, row = chunk >> 4, cc = chunk & 15;
                    *(LAS v4u*)(lds + (row >> 7) * TK_HALF + (row & 127) * TK_PITCH + cc * 16) = *(const v4u*)(ksrc + (size_t)row * 128 + cc * 8); }
            }
            __syncthreads();
            for (int tile = gw; tile < 4096; tile += NGW) {
                tk_bf16x8 qa[8];
                topk_loadq(qa, qb, tile * 16, h, lane);
                topk_item(qa, lds, ids, gates, tile * 16, h, lane);
            }
        }
        if (BOTH(7)) xcd_barrier(bar);
    }
    if (IN(8)) {
        const int* ids = (const int*)(ws + WS_IDS); const float* gates = (const float*)(ws + WS_GATES);
        for (int t = gw; t < T_TOK; t += NGW) peer_token(x2b, ssq2, ids, gates, U8, V8, usc, vsc, args.in[27], args.out, t, lane);
    }
#undef IN
#undef BOTH
}

extern "C" void kernel_launch(void* const* d_in, const int* in_sizes, int n_in, void* d_out, int out_size, void* d_ws, size_t ws_size, hipStream_t stream) {
    static int grid = 0;
    if (grid == 0) {
        if (n_in != 28 || in_sizes[0] != T_TOK * DM || out_size != T_TOK * DM || ws_size < WS_END) {
            fprintf(stderr, "kernel_launch: unexpected shapes / workspace (n_in %d, ws %zu < %zu)\n", n_in, ws_size, (size_t)WS_END); grid = -1; return; }
        int dev = 0, cus = 0;
        if (hipGetDevice(&dev) != hipSuccess || hipDeviceGetAttribute(&cus, hipDeviceAttributeMultiprocessorCount, dev) != hipSuccess) { grid = -1; return; }
        if (hipFuncSetAttribute((const void*)mk_fwd, hipFuncAttributeMaxDynamicSharedMemorySize, LDS_BYTES) != hipSuccess) { fprintf(stderr, "kernel_launch: hipFuncSetAttribute failed\n"); grid = -1; return; }
        grid = cus;
    }
    if (grid < 0) return;
    unsigned char* ws = (unsigned char*)d_ws;
    float* out = (float*)d_out;
    (void)hipMemsetAsync(ws + WS_CTL, 0, 1 * MiB, stream);
    Args a{};
    for (int i = 0; i < 28; ++i) a.in[i] = (const float*)d_in[i];
    a.out = out; a.ws = ws;
    a.ph_lo = 0; a.ph_hi = 9; a.li = 0;
    hipLaunchKernelGGL(mk_fwd, dim3(grid), dim3(NWAVES * 64), LDS_BYTES, stream, a);
}
```

```cpp
#include <hip/hip_runtime.h>
#include <stdint.h>
#include <cstdio>

typedef unsigned short bf16_t;
typedef unsigned int u32;

#ifndef PROBE_REP
#define PROBE_REP 0
#endif
#define REPS(k) (((PROBE_REP >> (k)) & 1) ? 2 : 1)
constexpr int T_TOK = 65536, DM = 1024, SEQ = 2048, NB = 32;
constexpr int NZ = 5376;
constexpr int C_R = 0, C_K = 512, C_V = 1024, C_WL = 1536, C_AL = 1600, C_GL = 1664, C_Q = 1792, C_ZK = 2304, C_ZV = 2816, C_GA = 3328, C_GB = 4352;
constexpr int NEXP = 16384;
constexpr float NORM_EPS = 1e-6f, GN_EPS = 64e-5f, SUBLN_EPS = 1e-5f;
constexpr float LAM_INIT = 0.2f;

constexpr size_t MiB = 1u << 20;
constexpr size_t WS_CTL = 0;
constexpr size_t WS_WIN = 1 * MiB;
constexpr size_t WS_PA = 12 * MiB;
constexpr size_t WS_PB = 13 * MiB;
constexpr size_t WS_WO = 14 * MiB;
constexpr size_t WS_WQ = 16 * MiB;
constexpr size_t WS_KEYS = 20 * MiB;
constexpr size_t WS_RSTD1 = 21 * MiB;
constexpr size_t WS_RSTD2 = 58 * MiB;
constexpr size_t WS_SCAL = 23 * MiB;
constexpr size_t WS_U = 24 * MiB;
constexpr size_t WS_V = 40 * MiB;
constexpr size_t WS_USC = 56 * MiB;
constexpr size_t WS_VSC = 57 * MiB;
constexpr size_t WS_XB = 88 * MiB;
constexpr int YAB_PITCH = 1024;
constexpr size_t WS_YA = WS_XB;
constexpr size_t WS_YB = WS_XB + 1024;
constexpr size_t WS_X2B = WS_XB;
constexpr size_t WS_Z = 216 * MiB;
constexpr size_t WS_Q = WS_Z;
constexpr size_t WS_IDS = WS_Z + 256 * MiB;
constexpr size_t WS_GATES = WS_Z + 288 * MiB;
constexpr size_t WS_MERGED = 888 * MiB;
constexpr size_t WS_XQ = WS_MERGED;
constexpr size_t WS_WG8 = WS_MERGED + 64 * MiB;
constexpr size_t WS_END = 1016 * MiB;

__device__ __forceinline__ float bf2f(bf16_t h) { return __uint_as_float(((u32)h) << 16); }
__device__ __forceinline__ bf16_t f2bf(float f) { u32 u = __float_as_uint(f); u += 0x7fffu + ((u >> 16) & 1u); return (bf16_t)(u >> 16); }
__device__ __forceinline__ float wave_sum(float v) {
#pragma unroll
    for (int o = 1; o < 64; o <<= 1) v += __shfl_xor(v, o);
    return v;
}
__device__ __forceinline__ float sigmoidf_(float x) { return __builtin_amdgcn_rcpf(1.f + __expf(-x)); }

namespace pg8 {
#define PG8_LAS __attribute__((address_space(3)))
typedef short bf16x8 __attribute__((ext_vector_type(8)));
typedef float f32x4 __attribute__((ext_vector_type(4)));
typedef unsigned u32x4 __attribute__((ext_vector_type(4)));
constexpr int BM = 256, BK = 64, HALF = 128, HTB = HALF * BK * 2  , STAGE_BYTES = 8 * HTB, NXCD = 8, WGM = 8;

__host__ __device__ __forceinline__ int lds_byte(int r, int c) { const int st = (r >> 4) * 2 + (c >> 5), rr = r & 15, cc = c & 31, ob = rr * 64 + cc * 2; return st * 1024 + (ob ^ (((ob >> 9) & 1) << 5)); }
__host__ __device__ __forceinline__ void stage_rc(int b, int& R, int& C) { const int st = b / 1024, sb = b % 1024, swz = sb ^ (((sb >> 9) & 1) << 5); R = (st >> 1) * 16 + swz / 64; C = (st & 1) * 32 + (swz % 64) / 2; }
__host__ __device__ __forceinline__ int perm32(int rho) { const int n = rho >> 4, i = rho & 15; return 8 * (i >> 2) + 4 * n + (i & 3); }

struct Unit { int pm, pn; };
struct Gemm { const bf16_t* A; const bf16_t* Bt; int lda, ldb, K; };

struct StaticOrder {
    int nM, nN, nwg, G, c;
    __host__ __device__ void init(int M, int N, int G_, int c_) { nM = M / BM; nN = N / BM; nwg = nM * nN; G = G_; c = c_; }
    __host__ __device__ bool next(int i, Unit& u) const {
        const long L = (long)i * G + c; if (L >= nwg) return false;
        int wgid = (int)L; { const int q = nwg / NXCD, r = nwg % NXCD, xcd = wgid % NXCD, off = wgid / NXCD; wgid = (xcd < r ? xcd * (q + 1) : r * (q + 1) + (xcd - r) * q) + off; }
        const int nig = WGM * nN, gid = wgid / nig, fm = gid * WGM, gsz = (nM - fm) < WGM ? (nM - fm) : WGM;
        u.pm = fm + ((wgid % nig) % gsz); u.pn = (wgid % nig) / gsz; return true;
    }
};
typedef float f32x2_c __attribute__((ext_vector_type(2))); typedef __bf16 bf16x2_c __attribute__((ext_vector_type(2)));
__device__ __forceinline__ unsigned cvt_pk_bf16(float lo, float hi) { const f32x2_c v = {lo, hi}; const bf16x2_c b = __builtin_convertvector(v, bf16x2_c); return __builtin_bit_cast(unsigned, b); }
__device__ __forceinline__ float bflo(unsigned w) { return __uint_as_float(w << 16); }
__device__ __forceinline__ float bfhi(unsigned w) { return __uint_as_float(w & 0xffff0000u); }

__device__ __forceinline__ float ssq_sum16(const float* p) {
    const f32x4 a = *(const f32x4*)p, b = *(const f32x4*)(p + 4), c = *(const f32x4*)(p + 8), d = *(const f32x4*)(p + 12);
    return (((a[0] + a[1]) + (a[2] + a[3])) + ((b[0] + b[1]) + (b[2] + b[3]))) + (((c[0] + c[1]) + (c[2] + c[3])) + ((d[0] + d[1]) + (d[2] + d[3])));
}
template <bool SSQ> struct EpiRowScale {
    static constexpr bool PERM = true, MID = false;
    bf16_t* O; int ldc; const float* rs; float mul = 1.f;
    __device__ __forceinline__ void operator()(const f32x4 (&acc)[2][2][4][2], const Unit& u, int wr, int wc, int fr, int fq) const {
        const int row0 = u.pm * BM + wr * 64 + fr, col0 = u.pn * BM + wc * 32 + 8 * fq;
#pragma unroll
        for (int ai = 0; ai < 2; ++ai)
#pragma unroll
            for (int m = 0; m < 4; ++m) {
                const int row = row0 + ai * HALF + m * 16;
                float s; if (SSQ) s = rsqrtf(ssq_sum16(rs + (size_t)row * 16) * (1.f / 1024.f) + NORM_EPS); else s = rs[row] * mul;
                bf16_t* rowp = O + (size_t)row * ldc + col0;
#pragma unroll
                for (int bj = 0; bj < 2; ++bj) {
                    const f32x4 v0 = acc[ai][bj][m][0] * s, v1 = acc[ai][bj][m][1] * s;
                    u32x4 w; w.x = cvt_pk_bf16(v0[0], v0[1]); w.y = cvt_pk_bf16(v0[2], v0[3]); w.z = cvt_pk_bf16(v1[0], v1[1]); w.w = cvt_pk_bf16(v1[2], v1[3]);
                    *(u32x4*)(rowp + bj * HALF) = w;
                }
            }
    }
};
template <bool ACCUM> struct EpiGate {
    static constexpr bool PERM = true, MID = false;
    bf16_t* mg; const bf16_t* z; int gcol;
    __device__ __forceinline__ void operator()(const f32x4 (&acc)[2][2][4][2], const Unit& u, int wr, int wc, int fr, int fq) const {
        const int row0 = u.pm * BM + wr * 64 + fr, col0 = u.pn * BM + wc * 32 + 8 * fq;
#pragma unroll
        for (int ai = 0; ai < 2; ++ai)
#pragma unroll
            for (int m = 0; m < 4; ++m) {
                const int row = row0 + ai * HALF + m * 16;
                const bf16_t* gp = z + (size_t)row * NZ + gcol + col0;
                bf16_t* rowp = mg + (size_t)row * DM + col0;
#pragma unroll
                for (int bj = 0; bj < 2; ++bj) {
                    const u32x4 g = *(const u32x4*)(gp + bj * HALF);
                    const f32x4 a0 = acc[ai][bj][m][0], a1 = acc[ai][bj][m][1];
                    float r[8];
                    r[0] = sigmoidf_(bflo(g.x)) * a0[0]; r[1] = sigmoidf_(bfhi(g.x)) * a0[1]; r[2] = sigmoidf_(bflo(g.y)) * a0[2]; r[3] = sigmoidf_(bfhi(g.y)) * a0[3];
                    r[4] = sigmoidf_(bflo(g.z)) * a1[0]; r[5] = sigmoidf_(bfhi(g.z)) * a1[1]; r[6] = sigmoidf_(bflo(g.w)) * a1[2]; r[7] = sigmoidf_(bfhi(g.w)) * a1[3];
                    if (ACCUM) { const u32x4 o = *(const u32x4*)(rowp + bj * HALF);
                        r[0] += bflo(o.x); r[1] += bfhi(o.x); r[2] += bflo(o.y); r[3] += bfhi(o.y); r[4] += bflo(o.z); r[5] += bfhi(o.z); r[6] += bflo(o.w); r[7] += bfhi(o.w); }
                    u32x4 w; w.x = cvt_pk_bf16(r[0], r[1]); w.y = cvt_pk_bf16(r[2], r[3]); w.z = cvt_pk_bf16(r[4], r[5]); w.w = cvt_pk_bf16(r[6], r[7]);
                    *(u32x4*)(rowp + bj * HALF) = w;
                }
            }
    }
};
struct EpiGate2 {
    static constexpr bool PERM = true, MID = true;
    bf16_t* mg; const bf16_t* z;
    __device__ __forceinline__ void mid(f32x4 (&acc)[2][2][4][2], const Unit& u, int wr, int wc, int fr, int fq) const {
        int row0 = u.pm * BM + wr * 64 + fr; const int col0 = u.pn * BM + wc * 32 + 8 * fq;
        asm volatile("" : "+v"(row0));
        u32x4 gq[2][8];
#define EG2_LOAD(q_, buf_) do { _Pragma("unroll") for (int mm = 0; mm < 2; ++mm) { const bf16_t* gp = z + (size_t)(row0 + ((q_) >> 1) * HALF + (((q_) & 1) * 2 + mm) * 16) * NZ + col0; \
            gq[buf_][4 * mm] = *(const u32x4*)(gp + C_GA); gq[buf_][4 * mm + 1] = *(const u32x4*)(gp + C_GA + HALF); gq[buf_][4 * mm + 2] = *(const u32x4*)(gp + C_GB); gq[buf_][4 * mm + 3] = *(const u32x4*)(gp + C_GB + HALF); } } while (0)
        EG2_LOAD(0, 0);
#pragma unroll
        for (int q = 0; q < 4; ++q) {
            if (q + 1 < 4) EG2_LOAD(q + 1, (q + 1) & 1);
            __builtin_amdgcn_sched_barrier(0);
            const int ai = q >> 1;
#pragma unroll
            for (int mm = 0; mm < 2; ++mm) { const int m = (q & 1) * 2 + mm;
#pragma unroll
                for (int bj = 0; bj < 2; ++bj) {
                    const u32x4 ga = gq[q & 1][4 * mm + bj], gb = gq[q & 1][4 * mm + 2 + bj];
                    const unsigned gaw[4] = {ga.x, ga.y, ga.z, ga.w}, gbw[4] = {gb.x, gb.y, gb.z, gb.w};
                    float r[8];
#pragma unroll
                    for (int i = 0; i < 4; ++i) {
                        r[2 * i] = (1.f + __expf(-fmaxf(bflo(gbw[i]), -30.f))) * __builtin_amdgcn_rcpf(1.f + __expf(-fmaxf(bflo(gaw[i]), -30.f)));
                        r[2 * i + 1] = (1.f + __expf(-fmaxf(bfhi(gbw[i]), -30.f))) * __builtin_amdgcn_rcpf(1.f + __expf(-fmaxf(bfhi(gaw[i]), -30.f)));
                    }
                    acc[ai][bj][m][0] = acc[ai][bj][m][0] * (f32x4){r[0], r[1], r[2], r[3]};
                    acc[ai][bj][m][1] = acc[ai][bj][m][1] * (f32x4){r[4], r[5], r[6], r[7]};
                }
            }
            __builtin_amdgcn_sched_barrier(0);
        }
#undef EG2_LOAD
    }
    __device__ __forceinline__ void operator()(const f32x4 (&acc)[2][2][4][2], const Unit& u, int wr, int wc, int fr, int fq) const {
        int row0 = u.pm * BM + wr * 64 + fr; const int col0 = u.pn * BM + wc * 32 + 8 * fq;
        asm volatile("" : "+v"(row0));
#pragma unroll
        for (int ai = 0; ai < 2; ++ai)
#pragma unroll
            for (int m = 0; m < 4; ++m) {
                const int row = row0 + ai * HALF + m * 16;
                const bf16_t* gp = z + (size_t)row * NZ + C_GB + col0;
                bf16_t* rowp = mg + (size_t)row * DM + col0;
#pragma unroll
                for (int bj = 0; bj < 2; ++bj) {
                    const u32x4 g = *(const u32x4*)(gp + bj * HALF);
                    const unsigned gw[4] = {g.x, g.y, g.z, g.w};
                    const f32x4 a0 = acc[ai][bj][m][0], a1 = acc[ai][bj][m][1];
                    const float av[8] = {a0[0], a0[1], a0[2], a0[3], a1[0], a1[1], a1[2], a1[3]};
                    float r[8];
#pragma unroll
                    for (int i = 0; i < 4; ++i) {
                        r[2 * i] = av[2 * i] * __builtin_amdgcn_rcpf(1.f + __expf(-fmaxf(bflo(gw[i]), -30.f)));
                        r[2 * i + 1] = av[2 * i + 1] * __builtin_amdgcn_rcpf(1.f + __expf(-fmaxf(bfhi(gw[i]), -30.f)));
                    }
                    u32x4 w; w.x = cvt_pk_bf16(r[0], r[1]); w.y = cvt_pk_bf16(r[2], r[3]); w.z = cvt_pk_bf16(r[4], r[5]); w.w = cvt_pk_bf16(r[6], r[7]);
                    *(u32x4*)(rowp + bj * HALF) = w;
                }
            }
    }
};
struct EpiX2 {
    static constexpr bool PERM = true, MID = false;
    const float* x; float* x2; bf16_t* x2b; float* ssq;
    __device__ __forceinline__ void operator()(const f32x4 (&acc)[2][2][4][2], const Unit& u, int wr, int wc, int fr, int fq) const {
        const int row0 = u.pm * BM + wr * 64 + fr, col0 = u.pn * BM + wc * 32 + 8 * fq;
#pragma unroll
        for (int ai = 0; ai < 2; ++ai)
#pragma unroll
            for (int m = 0; m < 4; ++m) {
                const int row = row0 + ai * HALF + m * 16;
                const size_t off = (size_t)row * DM + col0;
                float ss = 0.f;
#pragma unroll
                for (int bj = 0; bj < 2; ++bj) {
                    const f32x4 x0 = *(const f32x4*)(x + off + bj * HALF), x1 = *(const f32x4*)(x + off + bj * HALF + 4);
                    const f32x4 o0 = x0 + acc[ai][bj][m][0], o1 = x1 + acc[ai][bj][m][1];
                    u32x4 w; w.x = cvt_pk_bf16(o0[0], o0[1]); w.y = cvt_pk_bf16(o0[2], o0[3]); w.z = cvt_pk_bf16(o1[0], o1[1]); w.w = cvt_pk_bf16(o1[2], o1[3]);
                    *(u32x4*)(x2b + off + bj * HALF) = w;
                    ss += (o0[0] * o0[0] + o0[1] * o0[1]) + (o0[2] * o0[2] + o0[3] * o0[3]) + (o1[0] * o1[0] + o1[1] * o1[1]) + (o1[2] * o1[2] + o1[3] * o1[3]);
                }
                ss += __shfl_xor(ss, 16); ss += __shfl_xor(ss, 32);
                if (fq == 0) ssq[(size_t)row * 16 + (u.pn & 3) * 4 + wc] = ss;
            }
    }
};

typedef int v8i_t __attribute__((ext_vector_type(8)));
template <class Epi, class Sched, bool F8 = false>
__device__ __forceinline__ void gemm_phase(PG8_LAS unsigned char* lds, const Gemm g, const Sched& S, const Epi& E) {
    const int tid = threadIdx.x, wid = __builtin_amdgcn_readfirstlane(tid >> 6), lane = tid & 63, wr = wid >> 2, wc = wid & 3, fr = lane & 15, fq = lane >> 4;
    const int K = g.K, nt = K / BK;
    unsigned voffA[2], voffB[2];
#pragma unroll
    for (int i = 0; i < 2; ++i) { int R, C; stage_rc(tid * 16 + i * 8192, R, C); const int Rb = Epi::PERM ? ((R & ~31) + perm32(R & 31)) : R;
        voffA[i] = (unsigned)(R * g.lda + C) * 2u; voffB[i] = (unsigned)(Rb * g.ldb + C) * 2u; }
    const size_t kstep = (size_t)(BK * 2);
    const size_t hstepA = (size_t)HALF * g.lda * 2, hstepB = (size_t)HALF * g.ldb * 2;
    const size_t tstepA = 2 * hstepA, tstepB = 2 * hstepB;
    const unsigned ldsw = (unsigned)wid * 1024u;
    const int aoff = lds_byte(wr * 64 + fr, fq * 8), boff = lds_byte(wc * 32 + fr, fq * 8);
    const int sub8 = (fq >> 1) * 1024 + fr * 64 + (((fq & 1) ^ (fr >> 3)) * 32);
    const int aoff8 = ((wr * 64) >> 4) * 2048 + sub8, boff8 = ((wc * 32) >> 4) * 2048 + sub8;
#define PG8_SA(b, h) (((b) * 2 + (h)) * HTB)
#define PG8_SB(b, h) ((4 + (b) * 2 + (h)) * HTB)
#define PG8_STAGE(bufoff, gbase, voff) do { _Pragma("unroll") for (int _i = 0; _i < 2; ++_i) \
        __builtin_amdgcn_global_load_lds((const unsigned*)((const char*)(gbase) + (voff)[_i]), (PG8_LAS unsigned*)(lds + (bufoff) + ldsw + _i * 8192), 16, 0, 0); } while (0)
#define PG8_LD8(p_) ({ typedef int i4_ __attribute__((ext_vector_type(4))); const i4_ lo_ = *(const PG8_LAS i4_*)(p_), hi_ = *(const PG8_LAS i4_*)((p_) + 16); __builtin_shufflevector(lo_, hi_, 0, 1, 2, 3, 4, 5, 6, 7); })
#define PG8_LDA(dst, b, h) do { if constexpr (F8) { _Pragma("unroll") for (int m = 0; m < 4; ++m) dst##8[m] = PG8_LD8(lds + PG8_SA(b, h) + aoff8 + m * 2048); } else { \
        _Pragma("unroll") for (int m = 0; m < 4; ++m) _Pragma("unroll") for (int k = 0; k < 2; ++k) dst[m][k] = *(const PG8_LAS bf16x8*)(lds + PG8_SA(b, h) + aoff + m * 2048 + k * 1024); } } while (0)
#define PG8_LDB(dst, b, h) do { if constexpr (F8) { _Pragma("unroll") for (int n = 0; n < 2; ++n) dst##8[n] = PG8_LD8(lds + PG8_SB(b, h) + boff8 + n * 2048); } else { \
        _Pragma("unroll") for (int n = 0; n < 2; ++n) _Pragma("unroll") for (int k = 0; k < 2; ++k) dst[n][k] = *(const PG8_LAS bf16x8*)(lds + PG8_SB(b, h) + boff + n * 2048 + k * 1024); } } while (0)
#define PG8_MMA(ai, bj, At, Bt) do { __builtin_amdgcn_s_setprio(1); if constexpr (F8) { _Pragma("unroll") for (int m = 0; m < 4; ++m) _Pragma("unroll") for (int n = 0; n < 2; ++n) \
        asm volatile("v_mfma_scale_f32_16x16x128_f8f6f4 %0, %1, %2, %0, %3, %3 op_sel_hi:[0,0,0]" : "+v"(acc[ai][bj][m][n]) : "v"(Bt##8[n]), "v"(At##8[m]), "v"(sc127)); } else { \
        _Pragma("unroll") for (int m = 0; m < 4; ++m) _Pragma("unroll") for (int n = 0; n < 2; ++n) _Pragma("unroll") for (int k = 0; k < 2; ++k) \
        acc[ai][bj][m][n] = __builtin_amdgcn_mfma_f32_16x16x32_bf16(Bt[n][k], At[m][k], acc[ai][bj][m][n], 0, 0, 0); } __builtin_amdgcn_s_setprio(0); } while (0)
#define PG8_WAIT_V(n) asm volatile("s_waitcnt vmcnt(" #n ")" ::: "memory")
#define PG8_WAIT_L(n) asm volatile("s_waitcnt lgkmcnt(" #n ")" ::: "memory")
#define PG8_BAR __builtin_amdgcn_s_barrier()
#define PG8_SCHED __builtin_amdgcn_sched_barrier(0)
#define PG8_KBODY(t) do { \
            const bool last = (t == nt - 2); \
            const char* a1 = cA + (size_t)(t + 1) * kstep; \
            const char* a2 = last ? nA : cA + (size_t)(t + 2) * kstep; const char* b2 = last ? nB : cB + (size_t)(t + 2) * kstep; \
            const char* a3 = a2 + kstep; const char* b3 = b2 + kstep; \
 \
            PG8_LDB(B0, 0, 0); PG8_LDB(B1, 0, 1); PG8_SCHED; PG8_LDA(At, 0, 0); PG8_STAGE(PG8_SA(1, 1), a1 + hstepA, voffA); \
            PG8_WAIT_V(8); PG8_WAIT_L(0); PG8_BAR; PG8_MMA(0, 0, At, B0); PG8_MMA(0, 1, At, B1); PG8_BAR; PG8_SCHED; \
 \
            PG8_LDA(At, 0, 1); PG8_STAGE(PG8_SB(0, 0), b2, voffB); PG8_STAGE(PG8_SB(0, 1), b2 + hstepB, voffB); PG8_STAGE(PG8_SA(0, 0), a2, voffA); \
            PG8_WAIT_V(8); PG8_WAIT_L(0); PG8_BAR; PG8_MMA(1, 0, At, B0); PG8_MMA(1, 1, At, B1); PG8_BAR; PG8_SCHED; \
 \
            PG8_LDB(B0, 1, 0); PG8_LDB(B1, 1, 1); PG8_SCHED; PG8_LDA(At, 1, 0); PG8_STAGE(PG8_SA(0, 1), a2 + hstepA, voffA); \
            PG8_WAIT_V(8); PG8_WAIT_L(0); PG8_BAR; PG8_MMA(0, 0, At, B0); PG8_MMA(0, 1, At, B1); PG8_BAR; PG8_SCHED; \
 \
            PG8_LDA(At, 1, 1); PG8_STAGE(PG8_SB(1, 0), b3, voffB); PG8_STAGE(PG8_SB(1, 1), b3 + hstepB, voffB); PG8_STAGE(PG8_SA(1, 0), a3, voffA); \
            PG8_WAIT_V(8); PG8_WAIT_L(0); PG8_BAR; PG8_MMA(1, 0, At, B0); PG8_MMA(1, 1, At, B1); PG8_BAR; PG8_SCHED; \
        } while (0)
    Unit cur, nxt; int ui = 0;
    if (!S.next(0, cur)) return;
    f32x4 acc[2][2][4][2];
#pragma unroll
    for (int a = 0; a < 2; ++a)
#pragma unroll
        for (int b = 0; b < 2; ++b)
#pragma unroll
            for (int m = 0; m < 4; ++m)
#pragma unroll
                for (int n = 0; n < 2; ++n) acc[a][b][m][n] = (f32x4){0.f, 0.f, 0.f, 0.f};
    bf16x8 At[4][2], B0[2][2], B1[2][2]; v8i_t At8[4], B08[2], B18[2];
    const int sc127 = 127;
    const char* cA = (const char*)g.A + (size_t)cur.pm * tstepA; const char* cB = (const char*)g.Bt + (size_t)cur.pn * tstepB;
    PG8_STAGE(PG8_SB(0, 0), cB, voffB); PG8_STAGE(PG8_SB(0, 1), cB + hstepB, voffB); PG8_STAGE(PG8_SA(0, 0), cA, voffA); PG8_STAGE(PG8_SA(0, 1), cA + hstepA, voffA);
    if (wr == 1) PG8_BAR;
    PG8_WAIT_V(2); PG8_BAR;
    PG8_STAGE(PG8_SB(1, 0), cB + kstep, voffB); PG8_STAGE(PG8_SA(1, 0), cA + kstep, voffA); PG8_STAGE(PG8_SB(1, 1), cB + hstepB + kstep, voffB);
    PG8_WAIT_V(6); PG8_BAR;
    for (;;) {
        const bool has_next = S.next(ui + 1, nxt);
        const char* nA = has_next ? (const char*)g.A + (size_t)nxt.pm * tstepA : cA; const char* nB = has_next ? (const char*)g.Bt + (size_t)nxt.pn * tstepB : cB;
        if constexpr (Epi::MID) {
#pragma nounroll
            for (int t = 0; t < (nt >> 1); t += 2) PG8_KBODY(t);
            E.mid(acc, cur, wr, wc, fr, fq);
#pragma nounroll
            for (int t = (nt >> 1); t < nt; t += 2) PG8_KBODY(t);
        } else {
#pragma nounroll
            for (int t = 0; t < nt; t += 2) PG8_KBODY(t);
        }
        if (wr == 0) PG8_BAR;
        if constexpr (F8) asm volatile("s_nop 15\n\ts_nop 15" ::: "memory");
        E(acc, cur, wr, wc, fr, fq);
        if (!has_next) break;
#pragma unroll
        for (int a = 0; a < 2; ++a)
#pragma unroll
            for (int b = 0; b < 2; ++b)
#pragma unroll
                for (int m = 0; m < 4; ++m)
#pragma unroll
                    for (int n = 0; n < 2; ++n) acc[a][b][m][n] = (f32x4){0.f, 0.f, 0.f, 0.f};
        cur = nxt; cA = nA; cB = nB; ++ui;
        if (wr == 1) PG8_BAR;
    }
    PG8_WAIT_V(0);
    PG8_BAR;
#undef PG8_SA
#undef PG8_SB
#undef PG8_STAGE
#undef PG8_LDA
#undef PG8_KBODY
#undef PG8_LD8
#undef PG8_LDB
#undef PG8_MMA
#undef PG8_WAIT_V
#undef PG8_WAIT_L
#undef PG8_BAR
#undef PG8_SCHED
}
}

constexpr int NWAVES = 8;
constexpr int LDS_RING_BYTES = 131072, LDSCTL_OFF = 143360, MISC_OFF = LDSCTL_OFF + 320, LDS_BYTES = 147456;
#define LAS __attribute__((address_space(3)))
#define GAS __attribute__((address_space(1)))
typedef float f32x4 __attribute__((ext_vector_type(4)));
typedef unsigned v4u __attribute__((ext_vector_type(4)));
typedef unsigned v2u __attribute__((ext_vector_type(2)));
#define LDS_WAIT() asm volatile("s_waitcnt lgkmcnt(0)" ::: "memory")

constexpr int CW_BAR = 4096;
#define XB_TMO      128
#define XB_XCNT(j)  (256  + 64 * (j))
#define XB_XSUB(j)  (1280 + 64 * (j))
#define XB_XGEN(j)  (2304 + 64 * (j))
#define XB_TOP      3328
#define XB_TOPGEN   3392
#define XCD_BAR_WORDS 3456
#define XB_SPIN_CAP (1u << 20)
__device__ __forceinline__ unsigned xb_ld(unsigned* p)              { return __hip_atomic_load(p, __ATOMIC_RELAXED, __HIP_MEMORY_SCOPE_AGENT); }
__device__ __forceinline__ unsigned xb_add(unsigned* p, unsigned v) { return __hip_atomic_fetch_add(p, v, __ATOMIC_RELAXED, __HIP_MEMORY_SCOPE_AGENT); }
__device__ __forceinline__ unsigned xb_xcc_id() { return (unsigned)__builtin_amdgcn_s_getreg((3 << 11) | 20) & 0xFu; }
#define XB_SPIN(cond, bar) do { unsigned _sp = 0; while (cond) { __builtin_amdgcn_s_sleep(1); \
    if ((++_sp & 255u) == 0u) { if (xb_ld(&(bar)[XB_TMO])) break; if (_sp > XB_SPIN_CAP) { atomicAdd(&(bar)[XB_TMO], 1u); break; } } } } while (0)
struct XcdBarrier { unsigned* bar; unsigned x; volatile LAS unsigned* st; };
__device__ __forceinline__ XcdBarrier xcd_barrier_post(unsigned* bar, volatile LAS unsigned* st) {
    XcdBarrier b; b.bar = bar; b.x = xb_xcc_id(); b.st = st;
    if (threadIdx.x == 0) (void)xb_add(&bar[XB_XCNT(b.x)], 1u);
    return b;
}
__device__ __forceinline__ void xcd_barrier_complete(unsigned* bar, unsigned x, unsigned& nloc, unsigned& nx) {
    const unsigned G = gridDim.x * gridDim.y * gridDim.z;
    unsigned sum, cnt, mine, sp = 0u;
    for (;;) {
        sum = 0u; cnt = 0u; mine = 0u;
#pragma unroll
        for (unsigned j = 0; j < 16; ++j) { const unsigned c = xb_ld(&bar[XB_XCNT(j)]); sum += c; cnt += (c > 0u) ? 1u : 0u; mine = (j == x) ? c : mine; }
        if (sum == G) break;
        __builtin_amdgcn_s_sleep(1);
        if ((++sp & 255u) == 0u) { if (xb_ld(&bar[XB_TMO])) break; if (sp > XB_SPIN_CAP) { atomicAdd(&bar[XB_TMO], 1u); break; } }
    }
    nloc = mine > 0u ? mine : 1u; nx = cnt > 0u ? cnt : 1u;
}
__device__ __forceinline__ void xcd_barrier(const XcdBarrier& b) {
    asm volatile("s_waitcnt vmcnt(0)" ::: "memory");
    __syncthreads();
    if (threadIdx.x == 0) {
        unsigned* bar = b.bar;
        __builtin_amdgcn_s_waitcnt(0);
        unsigned nloc = b.st[0], nx = b.st[1];
        if (nloc == 0u) { xcd_barrier_complete(bar, b.x, nloc, nx); b.st[0] = nloc; b.st[1] = nx; }
        const unsigned old = xb_add(&bar[XB_XSUB(b.x)], 1u);
        const unsigned gen = old / nloc;
        if (old + 1u == (gen + 1u) * nloc) {
            __builtin_amdgcn_fence(__ATOMIC_RELEASE, "agent");
            asm volatile("s_waitcnt vmcnt(0)" ::: "memory");
            const unsigned og = xb_add(&bar[XB_TOP], 1u);
            const unsigned tg = og / nx;
            if (og + 1u == (tg + 1u) * nx) xb_add(&bar[XB_TOPGEN], 1u);
            else XB_SPIN(xb_ld(&bar[XB_TOPGEN]) == tg, bar);
            __builtin_amdgcn_fence(__ATOMIC_ACQUIRE, "agent");
            xb_add(&bar[XB_XGEN(b.x)], 1u);
            asm volatile("s_waitcnt vmcnt(0)" ::: "memory");
        } else {
            XB_SPIN(xb_ld(&bar[XB_XGEN(b.x)]) == gen, bar);
            __builtin_amdgcn_fence(__ATOMIC_ACQUIRE, "agent");
            asm volatile("s_waitcnt vmcnt(0)" ::: "memory");
        }
    }
    __syncthreads();
}

struct Args { const float* in[28]; float* out; unsigned char* ws; int ph_lo, ph_hi, li, pad; };

__device__ __forceinline__ void p0_transpose_item(const float* W, const float* sc, int K, int N, bf16_t* WT, LAS float* scr, int item, int lane, unsigned char* W8 = nullptr, int n8 = 0, int ldw = 0, int koff = 0) {
    if (ldw == 0) ldw = K;
    const int nblk = N / 32, kb = item / nblk, nb = item % nblk, k0 = 64 * kb, n0 = 32 * nb;
#pragma unroll 8
    for (int i = 0; i < 32; ++i) { const int kk = 2 * i + (lane >> 5); const float s = sc ? sc[k0 + kk] : 1.f; scr[kk * 33 + (lane & 31)] = W[(size_t)(k0 + kk) * N + n0 + (lane & 31)] * s; }
    LDS_WAIT(); asm volatile("" ::: "memory");
    const int c = lane & 7;
#pragma unroll
    for (int j = 0; j < 4; ++j) { const int n = (lane >> 3) + 8 * j; const LAS float* s = scr + (8 * c) * 33 + n;
        v4u o; o.x = pg8::cvt_pk_bf16(s[0 * 33], s[1 * 33]); o.y = pg8::cvt_pk_bf16(s[2 * 33], s[3 * 33]); o.z = pg8::cvt_pk_bf16(s[4 * 33], s[5 * 33]); o.w = pg8::cvt_pk_bf16(s[6 * 33], s[7 * 33]);
        *(v4u*)(WT + (size_t)(n0 + n) * ldw + koff + k0 + 8 * c) = o;
        if (W8 && n0 + n >= n8) {
            int p0 = 0, p1 = 0;
            p0 = __builtin_amdgcn_cvt_pk_fp8_f32(s[0 * 33] * 32.f, s[1 * 33] * 32.f, p0, false); p0 = __builtin_amdgcn_cvt_pk_fp8_f32(s[2 * 33] * 32.f, s[3 * 33] * 32.f, p0, true);
            p1 = __builtin_amdgcn_cvt_pk_fp8_f32(s[4 * 33] * 32.f, s[5 * 33] * 32.f, p1, false); p1 = __builtin_amdgcn_cvt_pk_fp8_f32(s[6 * 33] * 32.f, s[7 * 33] * 32.f, p1, true);
            *(v2u*)(W8 + (size_t)(n0 + n - n8) * K + k0 + 8 * c) = (v2u){(unsigned)p0, (unsigned)p1};
        } }
    LDS_WAIT(); asm volatile("" ::: "memory");
}
typedef unsigned v6u_t __attribute__((ext_vector_type(6)));
typedef unsigned v3u_t __attribute__((ext_vector_type(3)));
typedef float v16f_t __attribute__((ext_vector_type(16)));
typedef float v32f_t __attribute__((ext_vector_type(32)));
__device__ __forceinline__ void p0_row_fp6(const float* in, const float* cs, unsigned char* out, float* sc, int lane) {
    f32x4 v[4]; float mx = 0.f;
#pragma unroll
    for (int i = 0; i < 4; ++i) { v[i] = *(const f32x4*)(in + lane * 16 + 4 * i); if (cs) v[i] = v[i] * *(const f32x4*)(cs + lane * 16 + 4 * i);
        mx = fmaxf(mx, fmaxf(fmaxf(fabsf(v[i][0]), fabsf(v[i][1])), fmaxf(fabsf(v[i][2]), fabsf(v[i][3])))); }
#pragma unroll
    for (int o = 1; o < 64; o <<= 1) mx = fmaxf(mx, __shfl_xor(mx, o));
    mx = fmaxf(mx, 1e-30f);
    const float q = 7.5f / mx;
    v16f_t a, b;
#pragma unroll
    for (int i = 0; i < 16; ++i) { a[i] = 0.f; b[i] = 0.f; }
#pragma unroll
    for (int i = 0; i < 8; ++i) { a[i] = v[(2 * i) >> 2][(2 * i) & 3] * q; b[i] = v[(2 * i + 1) >> 2][(2 * i + 1) & 3] * q; }
    const v6u_t p = __builtin_amdgcn_cvt_scalef32_2xpk16_fp6_f32(a, b, 1.0f);
    *(v3u_t*)(out + lane * 12) = (v3u_t){p[0], p[1], p[2]};
    if (lane == 0) *sc = mx * (1.f / 7.5f);
}
__device__ __forceinline__ void p0_convert(const float* in, const float* cs, bf16_t* out, size_t n, int gw, int NGW, int lane) {
    for (size_t i = ((size_t)gw * 64 + lane) * 8; i < n; i += (size_t)NGW * 512) {
        f32x4 a = *(const f32x4*)(in + i), b = *(const f32x4*)(in + i + 4);
        if (cs) { const int c = (int)(i & 1023); a = a * *(const f32x4*)(cs + c); b = b * *(const f32x4*)(cs + c + 4); }
        v4u o; o.x = pg8::cvt_pk_bf16(a[0], a[1]); o.y = pg8::cvt_pk_bf16(a[2], a[3]); o.z = pg8::cvt_pk_bf16(b[0], b[1]); o.w = pg8::cvt_pk_bf16(b[2], b[3]);
        *(v4u*)(out + i) = o;
    }
}

namespace da {
typedef short bf16x8 __attribute__((ext_vector_type(8)));
typedef short s16x4 __attribute__((ext_vector_type(4)));
typedef float f32x16 __attribute__((ext_vector_type(16)));
typedef const LAS unsigned char* lcp;
constexpr float LOG2E = 1.4426950408889634f, C2 = 0.125f * LOG2E, THR = 8.f;
constexpr int RSLOT = 16384, LDS_KR = 0, LDS_VR = 4 * RSLOT, SCR_OFF = 8 * RSLOT, COMB_OFF = 0;
#define DA_SBAR() __builtin_amdgcn_sched_barrier(0)
#define DA_PIN(x) asm volatile("" : "+v"(x))
#define DA_MFMA(a, b, c) __builtin_amdgcn_mfma_f32_32x32x16_bf16(a, b, c, 0, 0, 0)
#define DA_WAIT_BAR(N) asm volatile("s_waitcnt vmcnt(" #N ") lgkmcnt(0)\n\ts_barrier" ::: "memory")
#define DA_MX3(a, b, c) __builtin_fmaxf(__builtin_fmaxf((a), (b)), (c))
__device__ __forceinline__ int crow(int r, int hi) { return (r & 3) + 8 * (r >> 2) + 4 * hi; }
__device__ __forceinline__ s16x4 vtr(lcp p) { return __builtin_bit_cast(s16x4, __builtin_amdgcn_ds_read_tr16_b64_v4i16((LAS s16x4*)p)); }
__device__ __forceinline__ unsigned cvtpk(float lo, float hi) { unsigned r; asm("v_cvt_pk_bf16_f32 %0, %1, %2" : "=v"(r) : "v"(lo), "v"(hi)); return r; }
__device__ __forceinline__ void glds16(const void* g, unsigned lds_base) {
    unsigned sv; asm volatile("s_mov_b32 %0, m0\n\ts_mov_b32 m0, %2\n\ts_nop 0\n\tglobal_load_lds_dwordx4 %1, off\n\ts_mov_b32 m0, %0" : "=&s"(sv) : "v"(g), "s"(lds_base) : "memory"); }
__device__ __forceinline__ void glds16_o128(const void* g, unsigned lds_base) {
    unsigned sv; asm volatile("s_mov_b32 %0, m0\n\ts_mov_b32 m0, %2\n\ts_nop 0\n\tglobal_load_lds_dwordx4 %1, off offset:128\n\ts_mov_b32 m0, %0" : "=&s"(sv) : "v"(g), "s"(lds_base) : "memory"); }
__device__ __forceinline__ void kload2(bf16x8* kf, lcp kp, int d0) { kf[2 * d0] = *(const LAS bf16x8*)(kp + d0 * 2048); kf[2 * d0 + 1] = *(const LAS bf16x8*)(kp + d0 * 2048 + 512); }
__device__ __forceinline__ float max16(const f32x16& p) {
    float a = DA_MX3(p[0], p[1], p[2]), b = DA_MX3(p[3], p[4], p[5]); a = DA_MX3(a, p[6], p[7]); b = DA_MX3(b, p[8], p[9]); a = DA_MX3(a, p[10], p[11]); b = DA_MX3(b, p[12], p[13]);
    a = DA_MX3(a, p[14], p[15]); return __builtin_fmaxf(a, b); }
__device__ __forceinline__ float rowmax(const f32x16& p0, const f32x16& p1, float offA, float offB) {
    const float m = __builtin_fmaxf(__builtin_fmaf(max16(p0), C2, offA), __builtin_fmaf(max16(p1), C2, offB));
    auto rr = __builtin_amdgcn_permlane32_swap(__float_as_uint(m), __float_as_uint(m), false, false);
    return __builtin_fmaxf(__uint_as_float(rr[0]), __uint_as_float(rr[1])); }
__device__ __forceinline__ void cmask(f32x16& p0, f32x16& p1, int jb, int qrel, int hi) {
    const int kb = 64 * jb + 4 * hi;
#pragma unroll
    for (int r = 0; r < 16; ++r) { const int kv = kb + (r & 3) + 8 * (r >> 2); if (kv > qrel) p0[r] = -INFINITY; if (kv + 32 > qrel) p1[r] = -INFINITY; } }

__device__ __forceinline__ void attn_epilogue_body(LAS unsigned char* lds, f32x16 (&o)[4], float l_reg, bf16_t* __restrict__ yb, const float* __restrict__ subln_w, float lam,
                                                   size_t rowb, int q0, int h, int wave, int lane) {
    asm volatile("" : "+v"(lane));
    const int r32 = lane & 31, hi = lane >> 5, map = wave >> 2, qs = wave & 3;
    LAS float* wsf = (LAS float*)(lds + SCR_OFF) + wave * 64;
    if (hi == 0) wsf[r32] = __builtin_amdgcn_rcpf(l_reg);
    float il[16];
#pragma unroll
    for (int g = 0; g < 4; ++g) { const f32x4 t4 = *(const LAS f32x4*)(wsf + 8 * g + 4 * hi); il[4 * g] = t4[0]; il[4 * g + 1] = t4[1]; il[4 * g + 2] = t4[2]; il[4 * g + 3] = t4[3]; }
    __syncthreads();
    LAS float* comb = (LAS float*)(lds + COMB_OFF) + qs * 4096;
    if (map == 1) {
#pragma unroll
        for (int d = 0; d < 4; ++d)
#pragma unroll
            for (int r = 0; r < 16; ++r) comb[crow(r, hi) * 128 + 32 * d + r32] = o[d][r] * il[r];
    }
    __syncthreads();
    if (map == 0) {
        float sw[4];
#pragma unroll
        for (int d = 0; d < 4; ++d) sw[d] = subln_w[32 * d + r32] * (1.f - LAM_INIT);
#pragma unroll
        for (int r = 0; r < 16; ++r) {
            float v[4], ss = 0.f;
#pragma unroll
            for (int d = 0; d < 4; ++d) { v[d] = o[d][r] * il[r] - lam * comb[crow(r, hi) * 128 + 32 * d + r32]; ss += v[d] * v[d]; }
            ss += __shfl_xor(ss, 1); ss += __shfl_xor(ss, 2); ss += __shfl_xor(ss, 4); ss += __shfl_xor(ss, 8); ss += __shfl_xor(ss, 16);
            const float rs = rsqrtf(ss * (1.f / 128.f) + SUBLN_EPS);
            bf16_t* op = yb + (rowb + q0 + crow(r, hi)) * YAB_PITCH + h * 128 + r32;
#pragma unroll
            for (int d = 0; d < 4; ++d) op[32 * d] = f2bf(v[d] * rs * sw[d]);
        }
    }
    __syncthreads();
}
__device__ __forceinline__ void attn_unit(LAS unsigned char* lds, const bf16_t* __restrict__ z, bf16_t* __restrict__ yb, const float* __restrict__ subln_w, float lam,
                                          int b, int h, int qblk, int wave_, int lane) {
    const int wave = __builtin_amdgcn_readfirstlane(wave_);
    const int r32 = lane & 31, hi = lane >> 5, map = wave >> 2, qs = wave & 3;
    const int q0 = qblk * 128 + qs * 32, NT = 2 * qblk + 2, qrel = qs * 32 + r32;
    const size_t rowb = (size_t)b * SEQ;
    const float slope = exp2f(-2.f * (float)(h + 1)), slope2 = slope * LOG2E, s64 = 64.f * slope2, s32 = 32.f * slope2;
    const unsigned lds0 = (unsigned)(uintptr_t)lds;
    LAS float* wsf = (LAS float*)(lds + SCR_OFF) + wave * 64;
    const bf16_t* ksrc = z + (rowb + lane) * NZ + C_ZK + h * 128 + wave * 8;
    const int pc0 = 2 * wave;
    const bf16_t* vsrc0 = z + (rowb + 16 * (pc0 & 3) + (lane >> 2)) * NZ + C_ZV + h * 128 + 32 * (pc0 >> 2) + (lane & 3) * 8;
    const unsigned kdst = lds0 + LDS_KR + wave * 1024, vdst = lds0 + LDS_VR + pc0 * 1024;
#define DMA_K(t, slot) do { const bf16_t* k_ = ksrc + (size_t)(t) * 64 * NZ; const unsigned d_ = (unsigned)__builtin_amdgcn_readfirstlane(kdst + (slot)); glds16(k_, d_); glds16_o128(k_, d_ + 8192 - 128); } while (0)
#define DMA_V(t, slot) do { const size_t o_ = (size_t)(t) * 64 * NZ; const unsigned d_ = (unsigned)__builtin_amdgcn_readfirstlane(vdst + (slot)); glds16(vsrc0 + o_, d_); glds16(vsrc0 + o_ + 16 * NZ, d_ + 1024); } while (0)
    const lcp vp0 = lds + LDS_VR + ((lane >> 4) & 1) * 32 + (lane & 3) * 8 + (4 * hi + ((lane & 15) >> 2)) * 64;
    const lcp kp0 = lds + LDS_KR + map * 8192 + hi * 1024 + r32 * 16;
    DMA_K(0, 0); DMA_V(0, 0); DMA_K(1, RSLOT);
    bf16x8 qr[4];
    {
        const bf16_t* qp = z + (rowb + q0 + r32) * NZ + C_Q + h * 128 + map * 64 + hi * 8;
#pragma unroll
        for (int d0 = 0; d0 < 4; ++d0) qr[d0] = *(const bf16x8*)(qp + d0 * 16);
    }
    f32x16 bias16;
#pragma unroll
    for (int r = 0; r < 16; ++r) bias16[r] = (8.f * slope) * (float)((r & 3) + 8 * (r >> 2));
    DA_PIN(bias16);
    float mhat = 0.f, l_reg = 0.f, offA = slope2 * (float)(4 * hi);
    f32x16 o[4];
#pragma unroll
    for (int d = 0; d < 4; ++d) o[d] = (f32x16){};
    bool resc = false;
    f32x16 c0, c1; bf16x8 kf[8]; s16x4 vlo[4], vhi[4]; v4u pw0, pw1, pw2, pw3;
#define SL(t) ((((t)) & 3) * RSLOT)
#define EX(v, nm) __builtin_amdgcn_exp2f(__builtin_fmaf((v), C2, (nm)))
#define RESC() do { if (resc) { _Pragma("unroll") for (int d_ = 0; d_ < 4; ++d_) _Pragma("unroll") for (int r = 0; r < 16; ++r) o[d_][r] *= wsf[crow(r, hi)]; } } while (0)
#define PKW(P, i) pg8::cvt_pk_bf16(P[i], P[(i) + 1])
    DMA_K(2, 2 * RSLOT); DMA_K(3, 3 * RSLOT); DMA_V(1, RSLOT);
    DA_WAIT_BAR(10);
#pragma unroll
    for (int d0 = 0; d0 < 4; ++d0) kload2(kf, kp0, d0);
    c0 = DA_MFMA(kf[0], qr[0], bias16); c1 = DA_MFMA(kf[1], qr[0], bias16); c0 = DA_MFMA(kf[2], qr[1], c0); c1 = DA_MFMA(kf[3], qr[1], c1);
    c0 = DA_MFMA(kf[4], qr[2], c0); c1 = DA_MFMA(kf[5], qr[2], c1); c0 = DA_MFMA(kf[6], qr[3], c0); c1 = DA_MFMA(kf[7], qr[3], c1);
    if (NT == 2) cmask(c0, c1, 0, qrel, hi);
    { mhat = rowmax(c0, c1, offA, offA + s32); const float nmh0 = offA - mhat, nmh1 = nmh0 + s32; float sacc = 0.f;
#pragma unroll
      for (int r = 0; r < 16; ++r) { c0[r] = EX(c0[r], nmh0); c1[r] = EX(c1[r], nmh1); sacc += c0[r] + c1[r]; }
      l_reg = sacc; }
    pw0 = (v4u){PKW(c0, 0), PKW(c0, 2), PKW(c0, 4), PKW(c0, 6)}; pw1 = (v4u){PKW(c0, 8), PKW(c0, 10), PKW(c0, 12), PKW(c0, 14)};
    pw2 = (v4u){PKW(c1, 0), PKW(c1, 2), PKW(c1, 4), PKW(c1, 6)}; pw3 = (v4u){PKW(c1, 8), PKW(c1, 10), PKW(c1, 12), PKW(c1, 14)};
    DA_WAIT_BAR(6);
    DMA_K(4, 0); DMA_V(2, 2 * RSLOT);
#pragma unroll
    for (int d0 = 0; d0 < 4; ++d0) kload2(kf, kp0 + RSLOT, d0);
    if (NT == 2) { DA_WAIT_BAR(0); } else { DA_WAIT_BAR(8); }
#define PAF(k) __builtin_bit_cast(bf16x8, pw##k)
#define VFR(i) (bf16x8){vlo[(i) & 3][0], vlo[(i) & 3][1], vlo[(i) & 3][2], vlo[(i) & 3][3], vhi[(i) & 3][0], vhi[(i) & 3][1], vhi[(i) & 3][2], vhi[(i) & 3][3]}
#define VOFF(i) ((((i) & 3) * 4 + ((i) >> 2)) * 1024)
#define VRD(i) do { vlo[(i) & 3] = vtr(vp_ + VOFF(i)); vhi[(i) & 3] = vtr(vp_ + VOFF(i) + 512); DA_SBAR(); } while (0)
#define KRD(G, d0) do { if (G) { kload2(kf, kp0 + sl_next_, d0); DA_SBAR(); } } while (0)
#define GAPA(MF) do { MF; DA_SBAR(); } while (0)
#define GAPB(MF, X, i, nm, A0, A1, EXTRA) do { MF; X[i] = EX(X[i], nm); X[(i) + 1] = EX(X[(i) + 1], nm); sacc += A0; sacc += A1; EXTRA; DA_PIN(X); DA_PIN(sacc); DA_SBAR(); } while (0)
#define STEP(t, MASK, GK, GV, GL) do { DA_SBAR(); \
    const lcp vp_ = vp0 + SL((t) - 1); const int sl_next_ = SL((t) + 1); \
            GAPA(c0 = DA_MFMA(kf[0], qr[0], bias16)); GAPA(c1 = DA_MFMA(kf[1], qr[0], bias16)); GAPA(c0 = DA_MFMA(kf[2], qr[1], c0)); GAPA(c1 = DA_MFMA(kf[3], qr[1], c1)); \
    VRD(0); GAPA(c0 = DA_MFMA(kf[4], qr[2], c0)); VRD(1); GAPA(c1 = DA_MFMA(kf[5], qr[2], c1)); VRD(2); GAPA(c0 = DA_MFMA(kf[6], qr[3], c0)); VRD(3); GAPA(c1 = DA_MFMA(kf[7], qr[3], c1)); \
    offA += s64; \
    if (GK) DMA_K((t) + 4, SL(t)); if (GV) DMA_V((t) + 2, SL((t) + 2)); \
    if (MASK) cmask(c0, c1, (t) - (NT - 2), qrel, hi); \
    { const float rm = rowmax(c0, c1, offA, offA + s32) - mhat; resc = false; \
      if (__builtin_expect(__any(rm > THR), 0)) { const float dl = __builtin_fmaxf(rm, 0.f); mhat += dl; \
          const float f = __builtin_amdgcn_exp2f(-dl); l_reg *= f; if (hi == 0) wsf[r32] = f; resc = true; } } \
    const float nmh0 = offA - mhat, nmh1 = nmh0 + s32; float sacc = 0.f; DA_SBAR(); \
    GAPB(o[0] = DA_MFMA(PAF(0), VFR(0), o[0]), c0, 0, nmh0, 0.f, 0.f, );             VRD(4); \
    GAPB(o[1] = DA_MFMA(PAF(0), VFR(1), o[1]), c0, 2, nmh0, c0[0], c0[1], );         VRD(5); \
    GAPB(o[2] = DA_MFMA(PAF(0), VFR(2), o[2]), c0, 4, nmh0, c0[2], c0[3], );         VRD(6); \
    GAPB(o[3] = DA_MFMA(PAF(0), VFR(3), o[3]), c0, 6, nmh0, c0[4], c0[5], );         VRD(7); \
    GAPB(o[0] = DA_MFMA(PAF(1), VFR(4), o[0]), c0, 8, nmh0, c0[6], c0[7], pw0[0] = PKW(c0, 0); pw0[1] = PKW(c0, 2); DA_PIN(pw0));    VRD(8); \
    GAPB(o[1] = DA_MFMA(PAF(1), VFR(5), o[1]), c0, 10, nmh0, c0[8], c0[9], pw0[2] = PKW(c0, 4); pw0[3] = PKW(c0, 6); DA_PIN(pw0));   VRD(9); \
    GAPB(o[2] = DA_MFMA(PAF(1), VFR(6), o[2]), c0, 12, nmh0, c0[10], c0[11], );      VRD(10); \
    GAPB(o[3] = DA_MFMA(PAF(1), VFR(7), o[3]), c0, 14, nmh0, c0[12], c0[13], );      VRD(11); \
    GAPB(o[0] = DA_MFMA(PAF(2), VFR(8), o[0]), c1, 0, nmh1, c0[14], c0[15], pw1[0] = PKW(c0, 8); pw1[1] = PKW(c0, 10); DA_PIN(pw1));  VRD(12); \
    GAPB(o[1] = DA_MFMA(PAF(2), VFR(9), o[1]), c1, 2, nmh1, c1[0], c1[1], pw1[2] = PKW(c0, 12); pw1[3] = PKW(c0, 14); DA_PIN(pw1));   VRD(13); \
    GAPB(o[2] = DA_MFMA(PAF(2), VFR(10), o[2]), c1, 4, nmh1, c1[2], c1[3], );        VRD(14); \
    GAPB(o[3] = DA_MFMA(PAF(2), VFR(11), o[3]), c1, 6, nmh1, c1[4], c1[5], );        VRD(15); \
    GAPB(o[0] = DA_MFMA(PAF(3), VFR(12), o[0]), c1, 8, nmh1, c1[6], c1[7], pw2[0] = PKW(c1, 0); pw2[1] = PKW(c1, 2); DA_PIN(pw2));   KRD(GL, 0); \
    GAPB(o[1] = DA_MFMA(PAF(3), VFR(13), o[1]), c1, 10, nmh1, c1[8], c1[9], pw2[2] = PKW(c1, 4); pw2[3] = PKW(c1, 6); DA_PIN(pw2));  KRD(GL, 1); \
    GAPB(o[2] = DA_MFMA(PAF(3), VFR(14), o[2]), c1, 12, nmh1, c1[10], c1[11], );     KRD(GL, 2); \
    GAPB(o[3] = DA_MFMA(PAF(3), VFR(15), o[3]), c1, 14, nmh1, c1[12], c1[13], );     KRD(GL, 3); \
    sacc += c1[14]; sacc += c1[15]; l_reg += sacc; \
    pw3[0] = PKW(c1, 8); pw3[1] = PKW(c1, 10); pw3[2] = PKW(c1, 12); pw3[3] = PKW(c1, 14); DA_PIN(pw3); \
    } while (0)
#define ENDW(tt) do { if ((tt) + 4 < NT) { DA_WAIT_BAR(8); } else if ((tt) + 3 < NT) { DA_WAIT_BAR(6); } else if ((tt) + 2 < NT) { DA_WAIT_BAR(4); } else { DA_WAIT_BAR(0); } } while (0)
    int t = 1;
    for (; t + 4 < NT; ++t) {
        STEP(t, false, true, true, true); DA_WAIT_BAR(8); RESC();
    }
    for (; t + 1 < NT; ++t) {
        STEP(t, true, (t + 4 < NT), (t + 2 < NT), (t + 1 < NT)); ENDW(t); RESC();
    }
    STEP(NT - 1, true, false, false, false); RESC();
    { const lcp vp_ = vp0 + SL(NT - 1);
#define DRN(k, i) do { const s16x4 lo_ = vtr(vp_ + VOFF(i)), hh_ = vtr(vp_ + VOFF(i) + 512); \
        o[(i) & 3] = DA_MFMA(PAF(k), ((bf16x8){lo_[0], lo_[1], lo_[2], lo_[3], hh_[0], hh_[1], hh_[2], hh_[3]}), o[(i) & 3]); } while (0)
      DRN(0, 0); DRN(0, 1); DRN(0, 2); DRN(0, 3); DRN(1, 4); DRN(1, 5); DRN(1, 6); DRN(1, 7); DRN(2, 8); DRN(2, 9); DRN(2, 10); DRN(2, 11); DRN(3, 12); DRN(3, 13); DRN(3, 14); DRN(3, 15);
#undef DRN
    }
#undef DMA_K
#undef DMA_V
#undef SL
#undef EX
#undef RESC
#undef PKW
#undef PAF
#undef VFR
#undef VOFF
#undef VRD
#undef KRD
#undef GAPA
#undef GAPB
#undef STEP
#undef ENDW
    { auto rr = __builtin_amdgcn_permlane32_swap(__float_as_uint(l_reg), __float_as_uint(l_reg), false, false); l_reg = __uint_as_float(rr[0]) + __uint_as_float(rr[1]); }
    attn_epilogue_body(lds, o, l_reg, yb, subln_w, lam, rowb, q0, h, wave, lane);
}
}

namespace rw {
typedef short bf16x8 __attribute__((ext_vector_type(8)));
typedef float f32x2 __attribute__((ext_vector_type(2)));
typedef short s16x4 __attribute__((ext_vector_type(4)));
constexpr int CH = 32, ACT_PITCH = 528;
constexpr int OFF_HAT = 41472, HAT_PITCH = 144, HAT_SZ = 32 * HAT_PITCH, OFF_TIL = OFF_HAT + 4 * HAT_SZ, TIL_PITCH = 40, TIL_SZ = 64 * TIL_PITCH, OFF_GR = OFF_TIL + 4 * TIL_SZ, OFF_WC = OFF_GR + 10 * 1024;
constexpr int OFF_ACT = 0, OFF_RKV = 16896, OFF_VEC = 41472, OFF_G = 82432, OFF_Y = 90624, OFF_NRM = 98816, OFF_SCL = 99328, OFF_CT = 99840, OFF_SCP = 102400;
template <int CTRL> __device__ __forceinline__ float dppf(float x) { return __builtin_bit_cast(float, __builtin_amdgcn_mov_dpp(__builtin_bit_cast(int, x), CTRL, 0xf, 0xf, true)); }
__device__ __forceinline__ float row_allsum(float v) { v += dppf<0x128>(v); v += dppf<0x124>(v); v += dppf<0x122>(v); v += dppf<0x121>(v); return v; }
__device__ __forceinline__ void row_allsum4(float& a, float& b, float& c, float& d) {
#define RW_DPP4(n) "v_add_f32_dpp %0, %0, %0 row_ror:" #n " row_mask:0xf bank_mask:0xf\n\tv_add_f32_dpp %1, %1, %1 row_ror:" #n " row_mask:0xf bank_mask:0xf\n\t" \
                   "v_add_f32_dpp %2, %2, %2 row_ror:" #n " row_mask:0xf bank_mask:0xf\n\tv_add_f32_dpp %3, %3, %3 row_ror:" #n " row_mask:0xf bank_mask:0xf\n\t"
    asm volatile("s_nop 1\n\t" RW_DPP4(8) RW_DPP4(4) RW_DPP4(2) RW_DPP4(1) "s_nop 1" : "+v"(a), "+v"(b), "+v"(c), "+v"(d));
#undef RW_DPP4
}
__device__ __forceinline__ f32x4 ld4bf(const bf16_t* p) { const v2u w = *(const v2u*)p; return (f32x4){pg8::bflo(w.x), pg8::bfhi(w.x), pg8::bflo(w.y), pg8::bfhi(w.y)}; }
__device__ __forceinline__ float fsig(float x) { return __builtin_amdgcn_rcpf(1.f + __expf(-x)); }
__device__ __forceinline__ float ftanh(float x) { return 1.f - 2.f * __builtin_amdgcn_rcpf(1.f + __expf(2.f * x)); }
struct ZRow { v2u r, k, v, w, a; v4u g; };
__device__ __forceinline__ ZRow ldrow(const bf16_t* zr, int c4, int cg) {
    ZRow o; o.r = *(const v2u*)(zr + C_R + c4); o.k = *(const v2u*)(zr + C_K + c4); o.v = *(const v2u*)(zr + C_V + c4); o.w = *(const v2u*)(zr + C_WL + 4 * cg); o.a = *(const v2u*)(zr + C_AL + 4 * cg);
    o.g = *(const v4u*)(zr + C_GL + 8 * cg); return o;
}
__device__ __forceinline__ f32x4 up4(v2u w) { return (f32x4){pg8::bflo(w.x), pg8::bfhi(w.x), pg8::bflo(w.y), pg8::bfhi(w.y)}; }

struct ScanP { const float *mu, *w0, *w2, *a0, *a2, *g2, *k_k, *k_a, *r_k, *lnx_w, *lnx_b; };
__device__ __forceinline__ void scan_unit(LAS unsigned char* lds, const bf16_t* __restrict__ z, bf16_t* __restrict__ ya, const ScanP P, int b, int h, int tid, int wave, int lane) {
    asm volatile("" : "+v"(tid)); lane = tid & 63;
    const float* mu = P.mu; const float* w0 = P.w0; const float* w2 = P.w2; const float* a0 = P.a0; const float* a2 = P.a2; const float* g2 = P.g2;
    const float* k_k = P.k_k; const float* k_a = P.k_a; const float* r_k = P.r_k; const float* lnx_w = P.lnx_w; const float* lnx_b = P.lnx_b;
    const size_t rowb = (size_t)b * SEQ;
    const int tl = tid >> 4, cg = tid & 15;
    const int nt = wave & 3, rl = lane & 15, rg = lane >> 4;
    LAS float* rkv = (LAS float*)(lds + OFF_RKV); LAS float* vec = (LAS float*)(lds + OFF_VEC); LAS float* gbuf = (LAS float*)(lds + OFF_G);
    LAS float* ybuf = (LAS float*)(lds + OFF_Y); LAS float* nrm = (LAS float*)(lds + OFF_NRM); LAS float* scl = (LAS float*)(lds + OFF_SCL); LAS float* scp = (LAS float*)(lds + OFF_SCP);
    bf16x8 bfr[8];
    {
        const int col = h * 64 + 16 * nt + rl;
#pragma unroll
        for (int f = 0; f < 8; ++f) {
            const float* src = (f < 2) ? w2 : (f < 4) ? a2 : g2;
            const int kb = ((f < 4) ? 32 * (f & 1) : 32 * (f - 4)) + 8 * rg;
            float e[8];
#pragma unroll
            for (int j = 0; j < 8; ++j) e[j] = src[(size_t)(kb + j) * 512 + col];
            v4u p; p.x = pg8::cvt_pk_bf16(e[0], e[1]); p.y = pg8::cvt_pk_bf16(e[2], e[3]); p.z = pg8::cvt_pk_bf16(e[4], e[5]); p.w = pg8::cvt_pk_bf16(e[6], e[7]);
            bfr[f] = __builtin_bit_cast(bf16x8, p);
            __builtin_amdgcn_sched_barrier(0);
        }
    }
    const int mt = wave >> 2;
    const int hc = h * 64 + 16 * nt + rl;
    const float w0c = w0[hc], a0c = a0[hc], kkc = k_k[hc], kac = k_a[hc], rkc = r_k[hc];
    const int c4 = h * 64 + 4 * cg;
    f32x4 ST[4];
#pragma unroll
    for (int i = 0; i < 4; ++i) ST[i] = (f32x4){0.f, 0.f, 0.f, 0.f};
    LAS float* ctab = (LAS float*)(lds + OFF_CT);
    if (tl == 0) {
        LAS float* ct = ctab + cg * 36;
        *(LAS f32x4*)(ct + 0) = *(const f32x4*)(mu + C_R + c4); *(LAS f32x4*)(ct + 4) = *(const f32x4*)(mu + C_K + c4); *(LAS f32x4*)(ct + 8) = *(const f32x4*)(mu + C_V + c4);
        *(LAS f32x4*)(ct + 12) = *(const f32x4*)(mu + C_WL + 4 * cg); *(LAS f32x4*)(ct + 16) = *(const f32x4*)(mu + C_AL + 4 * cg);
        *(LAS f32x4*)(ct + 20) = *(const f32x4*)(mu + C_GL + 8 * cg); *(LAS f32x4*)(ct + 24) = *(const f32x4*)(mu + C_GL + 8 * cg + 4);
        *(LAS f32x4*)(ct + 28) = *(const f32x4*)(lnx_w + c4); *(LAS f32x4*)(ct + 32) = *(const f32x4*)(lnx_b + c4);
    }
    __syncthreads();
    const LAS float* myct = ctab + cg * 36;
    ZRow zc = ldrow(z + (rowb + tl) * NZ, c4, cg), zp;
    if (tl > 0) zp = ldrow(z + (rowb + tl - 1) * NZ, c4, cg); else { zp.r = zp.k = zp.v = zp.w = zp.a = (v2u){0u, 0u}; zp.g = (v4u){0u, 0u, 0u, 0u}; }
    for (int t0 = 0; t0 < SEQ; t0 += CH) {
        {
            const f32x4 cr = up4(zc.r), ck = up4(zc.k), cv = up4(zc.v), cw = up4(zc.w), ca = up4(zc.a);
            const f32x4 cg0 = (f32x4){pg8::bflo(zc.g.x), pg8::bfhi(zc.g.x), pg8::bflo(zc.g.y), pg8::bfhi(zc.g.y)}, cg1 = (f32x4){pg8::bflo(zc.g.z), pg8::bfhi(zc.g.z), pg8::bflo(zc.g.w), pg8::bfhi(zc.g.w)};
            const f32x4 pr = up4(zp.r), pk = up4(zp.k), pv = up4(zp.v), pw = up4(zp.w), pa = up4(zp.a);
            const f32x4 pg0 = (f32x4){pg8::bflo(zp.g.x), pg8::bfhi(zp.g.x), pg8::bflo(zp.g.y), pg8::bfhi(zp.g.y)}, pg1 = (f32x4){pg8::bflo(zp.g.z), pg8::bfhi(zp.g.z), pg8::bflo(zp.g.w), pg8::bfhi(zp.g.w)};
            if (t0 + CH < SEQ) { zc = ldrow(z + (rowb + t0 + CH + tl) * NZ, c4, cg); zp = ldrow(z + (rowb + t0 + CH + tl - 1) * NZ, c4, cg); }
            const f32x4 rs_ = cr + (pr - cr) * *(const LAS f32x4*)(myct + 0), ks_ = ck + (pk - ck) * *(const LAS f32x4*)(myct + 4), vs_ = cv + (pv - cv) * *(const LAS f32x4*)(myct + 8);
            const f32x4 ws_ = cw + (pw - cw) * *(const LAS f32x4*)(myct + 12), as_ = ca + (pa - ca) * *(const LAS f32x4*)(myct + 16);
            const f32x4 g0_ = cg0 + (pg0 - cg0) * *(const LAS f32x4*)(myct + 20), g1_ = cg1 + (pg1 - cg1) * *(const LAS f32x4*)(myct + 24);
            *(LAS f32x4*)(rkv + 0 * 2048 + tl * 64 + 4 * cg) = rs_; *(LAS f32x4*)(rkv + 1 * 2048 + tl * 64 + 4 * cg) = ks_; *(LAS f32x4*)(rkv + 2 * 2048 + tl * 64 + 4 * cg) = vs_;
            LAS unsigned char* ar = lds + OFF_ACT + tl * ACT_PITCH;
            v2u tw; tw.x = pg8::cvt_pk_bf16(ftanh(ws_[0]), ftanh(ws_[1])); tw.y = pg8::cvt_pk_bf16(ftanh(ws_[2]), ftanh(ws_[3]));
            *(LAS v2u*)(ar + 8 * cg) = tw;
            v2u aw; aw.x = pg8::cvt_pk_bf16(as_[0], as_[1]); aw.y = pg8::cvt_pk_bf16(as_[2], as_[3]);
            *(LAS v2u*)(ar + 128 + 8 * cg) = aw;
            v4u gw; gw.x = pg8::cvt_pk_bf16(fsig(g0_[0]), fsig(g0_[1])); gw.y = pg8::cvt_pk_bf16(fsig(g0_[2]), fsig(g0_[3]));
            gw.z = pg8::cvt_pk_bf16(fsig(g1_[0]), fsig(g1_[1])); gw.w = pg8::cvt_pk_bf16(fsig(g1_[2]), fsig(g1_[3]));
            *(LAS v4u*)(ar + 256 + 16 * cg) = gw;
        }
        __syncthreads();
        f32x4 accw = (f32x4){0.f, 0.f, 0.f, 0.f}, acca = accw, accg = accw;
        {
            const LAS unsigned char* ap = lds + OFF_ACT + (16 * mt + rl) * ACT_PITCH + 8 * rg * 2;
#pragma unroll
            for (int f = 0; f < 8; ++f) {
                const bf16x8 a = *(const LAS bf16x8*)(ap + f * 64);
                if (f < 2) accw = __builtin_amdgcn_mfma_f32_16x16x32_bf16(a, bfr[f], accw, 0, 0, 0);
                else if (f < 4) acca = __builtin_amdgcn_mfma_f32_16x16x32_bf16(a, bfr[f], acca, 0, 0, 0);
                else accg = __builtin_amdgcn_mfma_f32_16x16x32_bf16(a, bfr[f], accg, 0, 0, 0);
            }
        }
        float lw[4], av[4], kk[4];
        {
            const int c = 16 * nt + rl;
            float n2[4];
#pragma unroll
            for (int r = 0; r < 4; ++r) {
                const int tok = 16 * mt + 4 * rg + r;
                gbuf[tok * 64 + c] = accg[r];
                const float nx = -(w0c + accw[r]);
                const float sp = nx > 20.f ? nx : __logf(1.f + __expf(nx));
                lw[r] = -__expf(-sp - 0.5f);
                av[r] = fsig(a0c + acca[r]);
                kk[r] = rkv[1 * 2048 + tok * 64 + c] * kkc;
                n2[r] = kk[r] * kk[r];
            }
            row_allsum4(n2[0], n2[1], n2[2], n2[3]);
            if (rl == 0) {
#pragma unroll
                for (int r = 0; r < 4; ++r) nrm[(16 * mt + 4 * rg + r) * 4 + nt] = n2[r];
            }
        }
        __syncthreads();
        {
            const int c = 16 * nt + rl;
            const float p0 = lw[0], p1 = p0 + lw[1], p2 = p1 + lw[2], p3 = p2 + lw[3];
            const float t1 = __shfl(p3, (lane - 16) & 63), t2 = __shfl(p3, (lane - 32) & 63), t3 = __shfl(p3, (lane - 48) & 63);
            const float E = (rg >= 1 ? t1 : 0.f) + (rg >= 2 ? t2 : 0.f) + (rg >= 3 ? t3 : 0.f);
            const float Ltot = __shfl(E + p3, rl + 48);
            const float pin[4] = {p0, p1, p2, p3};
            float bt[4], kt[4];
#pragma unroll
            for (int r = 0; r < 4; ++r) {
                const int tok = 16 * mt + 4 * rg + r;
                const f32x4 n4 = *(const LAS f32x4*)(nrm + tok * 4);
                const float ksv = rkv[1 * 2048 + tok * 64 + c], rsv = rkv[0 * 2048 + tok * 64 + c];
                const float inv = fminf(__builtin_amdgcn_rsqf((n4[0] + n4[1]) + (n4[2] + n4[3])), 1e12f);
                const float kkn = kk[r] * inv, beta = kkn * av[r], kmod = ksv * (1.f + (av[r] - 1.f) * kac);
                const float L = E + pin[r], eL = __expf(L), ieL = __expf(-L), eLm = __expf(L - lw[r]), eT = __expf(Ltot - L);
                LAS unsigned char* hp = lds + OFF_HAT + tok * HAT_PITCH + c * 2;
                *(LAS bf16_t*)(hp) = f2bf(-kkn * eLm); *(LAS bf16_t*)(hp + HAT_SZ) = f2bf(beta * ieL); *(LAS bf16_t*)(hp + 2 * HAT_SZ) = f2bf(kmod * ieL); *(LAS bf16_t*)(hp + 3 * HAT_SZ) = f2bf(rsv * eL);
                bt[r] = beta * eT; kt[r] = kmod * eT;
                float pbr = beta * rsv, pkr = kmod * rsv, pbo = rsv * kmod * rkc, dum = 0.f;
                row_allsum4(pbr, pkr, pbo, dum);
                if (rl == 0) *(LAS f32x4*)(scp + (tok * 4 + nt) * 4) = (f32x4){pbr, pkr, pbo, 0.f};
            }
            LAS unsigned char* tp = lds + OFF_TIL + (2 * mt) * TIL_SZ + c * TIL_PITCH + 8 * rg;
            v2u w; w.x = pg8::cvt_pk_bf16(bt[0], bt[1]); w.y = pg8::cvt_pk_bf16(bt[2], bt[3]); *(LAS v2u*)(tp) = w;
            w.x = pg8::cvt_pk_bf16(kt[0], kt[1]); w.y = pg8::cvt_pk_bf16(kt[2], kt[3]); *(LAS v2u*)(tp + TIL_SZ) = w;
            if (rg == 0) ((LAS float*)(lds + OFF_WC))[mt * 64 + c] = __expf(Ltot);
        }
        __syncthreads();
        if (tid < CH) {
            const f32x4 p0 = *(const LAS f32x4*)(scp + tid * 16), p1 = *(const LAS f32x4*)(scp + tid * 16 + 4), p2 = *(const LAS f32x4*)(scp + tid * 16 + 8), p3 = *(const LAS f32x4*)(scp + tid * 16 + 12);
            *(LAS f32x4*)(scl + 4 * tid) = (p0 + p1) + (p2 + p3);
        }
        int lane_ = lane; asm volatile("" : "+v"(lane_));
        const int rl_ = lane_ & 15, rg_ = lane_ >> 4;
        {
            const int c = wave >> 2, g = wave & 3;
            const LAS unsigned char* pa = lds + OFF_HAT + ((g & 1) ? 2 : 1) * HAT_SZ + (16 * c + rl_) * HAT_PITCH + 16 * rg_;
            const LAS unsigned char* pb = lds + OFF_HAT + ((g < 2) ? 0 : 3) * HAT_SZ + (16 * c + rl_) * HAT_PITCH + 16 * rg_;
            f32x4 acc = (f32x4){0.f, 0.f, 0.f, 0.f};
            acc = __builtin_amdgcn_mfma_f32_16x16x32_bf16(*(const LAS bf16x8*)(pa), *(const LAS bf16x8*)(pb), acc, 0, 0, 0);
            acc = __builtin_amdgcn_mfma_f32_16x16x32_bf16(*(const LAS bf16x8*)(pa + 64), *(const LAS bf16x8*)(pb + 64), acc, 0, 0, 0);
#pragma unroll
            for (int e = 0; e < 4; ++e) { const int row = 4 * rg_ + e; const bool keep = (g < 2) ? (row < rl_) : (row <= rl_); if (!keep) acc[e] = 0.f; }
            *(LAS f32x4*)(lds + OFF_GR + (c * 5 + g) * 1024 + lane_ * 16) = acc;
            if (g == 0) {
                asm volatile("s_waitcnt lgkmcnt(0)" ::: "memory");
                if (lane_ < 16) {
                    const int sc = lane_;
                    const LAS float* tb = (const LAS float*)(lds + OFF_GR + (c * 5) * 1024);
                    float m[16], ps[16];
#pragma unroll
                    for (int r = 0; r < 16; ++r) ps[r] = 0.f;
#pragma unroll
                    for (int u = 15; u >= 0; --u) {
                        m[u] = (u == sc) ? 1.f : ((u < sc) ? ps[u] : 0.f);
#pragma unroll
                        for (int r = 0; r < u; ++r) ps[r] = __builtin_fmaf(tb[(u + 16 * (r >> 2)) * 4 + (r & 3)], m[u], ps[r]);
                    }
                    LAS f32x4* mt_ = (LAS f32x4*)(lds + OFF_GR + (c * 5 + 4) * 1024);
#pragma unroll
                    for (int q = 0; q < 4; ++q) mt_[sc + 16 * q] = (f32x4){m[4 * q], m[4 * q + 1], m[4 * q + 2], m[4 * q + 3]};
                }
            }
        }
        __syncthreads();
        if (wave < 4) {
            const int ib = wave;
#pragma unroll
            for (int c = 0; c < 2; ++c) {
                bf16x8 sb[2];
#pragma unroll
                for (int ks = 0; ks < 2; ++ks) {
                    v4u p; p.x = pg8::cvt_pk_bf16(ST[2 * ks][0], ST[2 * ks][1]); p.y = pg8::cvt_pk_bf16(ST[2 * ks][2], ST[2 * ks][3]);
                    p.z = pg8::cvt_pk_bf16(ST[2 * ks + 1][0], ST[2 * ks + 1][1]); p.w = pg8::cvt_pk_bf16(ST[2 * ks + 1][2], ST[2 * ks + 1][3]);
                    sb[ks] = __builtin_bit_cast(bf16x8, p);
                }
                const LAS unsigned char* ha = lds + OFF_HAT + (16 * c + rl_) * HAT_PITCH + 8 * rg_;
                f32x4 xt = (f32x4){0.f, 0.f, 0.f, 0.f}, yt = xt;
#pragma unroll
                for (int ks = 0; ks < 2; ++ks) {
                    v4u fa, fr; const v2u a0_ = *(const LAS v2u*)(ha + 64 * ks), a1_ = *(const LAS v2u*)(ha + 64 * ks + 32);
                    const v2u r0_ = *(const LAS v2u*)(ha + 3 * HAT_SZ + 64 * ks), r1_ = *(const LAS v2u*)(ha + 3 * HAT_SZ + 64 * ks + 32);
                    fa.x = a0_.x; fa.y = a0_.y; fa.z = a1_.x; fa.w = a1_.y; fr.x = r0_.x; fr.y = r0_.y; fr.z = r1_.x; fr.w = r1_.y;
                    xt = __builtin_amdgcn_mfma_f32_16x16x32_bf16(__builtin_bit_cast(bf16x8, fa), sb[ks], xt, 0, 0, 0);
                    yt = __builtin_amdgcn_mfma_f32_16x16x32_bf16(__builtin_bit_cast(bf16x8, fr), sb[ks], yt, 0, 0, 0);
                }
                const LAS float* vsrc = rkv + 2 * 2048 + (16 * c + 4 * rg_) * 64 + 16 * ib + rl_;
                v2u vb_; vb_.x = pg8::cvt_pk_bf16(vsrc[0], vsrc[64]); vb_.y = pg8::cvt_pk_bf16(vsrc[128], vsrc[192]);
                const s16x4 vb = __builtin_bit_cast(s16x4, vb_);
                const LAS unsigned char* gr = lds + OFF_GR + (c * 5) * 1024 + lane_ * 16;
#define RW_AFR(g_) ({ const f32x4 t_ = *(const LAS f32x4*)(gr + (g_) * 1024); v2u w_; w_.x = pg8::cvt_pk_bf16(t_[0], t_[1]); w_.y = pg8::cvt_pk_bf16(t_[2], t_[3]); __builtin_bit_cast(s16x4, w_); })
#define RW_PK4(x_) ({ v2u w_; w_.x = pg8::cvt_pk_bf16((x_)[0], (x_)[1]); w_.y = pg8::cvt_pk_bf16((x_)[2], (x_)[3]); __builtin_bit_cast(s16x4, w_); })
                const f32x4 zt = __builtin_amdgcn_mfma_f32_16x16x16bf16_1k(RW_AFR(1), vb, xt, 0, 0, 0);
                const f32x4 ut = __builtin_amdgcn_mfma_f32_16x16x16bf16_1k(RW_AFR(4), RW_PK4(zt), (f32x4){0.f, 0.f, 0.f, 0.f}, 0, 0, 0);
                const s16x4 ub = RW_PK4(ut);
                yt = __builtin_amdgcn_mfma_f32_16x16x16bf16_1k(RW_AFR(2), ub, yt, 0, 0, 0);
                yt = __builtin_amdgcn_mfma_f32_16x16x16bf16_1k(RW_AFR(3), vb, yt, 0, 0, 0);
#pragma unroll
                for (int e = 0; e < 4; ++e) ybuf[(16 * c + 4 * rg_ + e) * 64 + 16 * ib + rl_] = yt[e];
                const LAS unsigned char* tl_ = lds + OFF_TIL + (2 * c) * TIL_SZ + rl_ * TIL_PITCH + 8 * rg_;
                const LAS float* wc = (const LAS float*)(lds + OFF_WC) + c * 64 + 4 * rg_;
#pragma unroll
                for (int jt = 0; jt < 4; ++jt) {
                    f32x4 acc = ST[jt] * *(const LAS f32x4*)(wc + 16 * jt);
                    acc = __builtin_amdgcn_mfma_f32_16x16x16bf16_1k(*(const LAS s16x4*)(tl_ + TIL_SZ + 16 * jt * TIL_PITCH), vb, acc, 0, 0, 0);
                    acc = __builtin_amdgcn_mfma_f32_16x16x16bf16_1k(*(const LAS s16x4*)(tl_ + 16 * jt * TIL_PITCH), ub, acc, 0, 0, 0);
                    ST[jt] = acc;
                }
#undef RW_AFR
#undef RW_PK4
            }
        }
        __syncthreads();
        {
            const f32x4 y4 = *(const LAS f32x4*)(ybuf + tl * 64 + 4 * cg);
            const float mean = row_allsum((y4[0] + y4[1]) + (y4[2] + y4[3])) * (1.f / 64.f);
            const f32x4 dv = y4 - mean;
            const float var = row_allsum((dv[0] * dv[0] + dv[1] * dv[1]) + (dv[2] * dv[2] + dv[3] * dv[3])) * (1.f / 64.f);
            const float rs_ = rsqrtf(var + GN_EPS);
            const f32x4 yn = dv * rs_ * *(const LAS f32x4*)(myct + 28) + *(const LAS f32x4*)(myct + 32);
            const float bonus = scl[tl * 4 + 2];
            const f32x4 vs_ = *(const LAS f32x4*)(rkv + 2 * 2048 + tl * 64 + 4 * cg), g4 = *(const LAS f32x4*)(gbuf + tl * 64 + 4 * cg);
            const f32x4 o = (yn + vs_ * bonus) * g4;
            v2u w; w.x = pg8::cvt_pk_bf16(o[0], o[1]); w.y = pg8::cvt_pk_bf16(o[2], o[3]);
            *(v2u*)(ya + (rowb + t0 + tl) * YAB_PITCH + c4) = w;
        }
        __syncthreads();
    }
}
}

typedef __bf16 bf16x2_t __attribute__((ext_vector_type(2)));
__device__ __forceinline__ float dot2bf(unsigned a, unsigned b, float c) { return __builtin_amdgcn_fdot2_f32_bf16(__builtin_bit_cast(bf16x2_t, a), __builtin_bit_cast(bf16x2_t, b), c, false); }
__device__ __forceinline__ unsigned f2ord(float f) { const unsigned u = __float_as_uint(f); return (u & 0x80000000u) ? ~u : (u | 0x80000000u); }
__device__ __forceinline__ float ord2f(unsigned o) { return __uint_as_float((o & 0x80000000u) ? (o ^ 0x80000000u) : ~o); }
__device__ __forceinline__ unsigned row_allmax_u32(unsigned v) {
    v = max(v, (unsigned)__builtin_amdgcn_update_dpp(0, (int)v, 0x128, 0xf, 0xf, false));
    v = max(v, (unsigned)__builtin_amdgcn_update_dpp(0, (int)v, 0x124, 0xf, 0xf, false));
    v = max(v, (unsigned)__builtin_amdgcn_update_dpp(0, (int)v, 0x122, 0xf, 0xf, false));
    v = max(v, (unsigned)__builtin_amdgcn_update_dpp(0, (int)v, 0x121, 0xf, 0xf, false));
    return v;
}

constexpr int TK_PITCH = 272, TK_HALF = 128 * TK_PITCH;
typedef short tk_bf16x8 __attribute__((ext_vector_type(8)));
__device__ __forceinline__ void topk_loadq(tk_bf16x8 (&qa)[8], const bf16_t* __restrict__ qb, int t0, int h, int lane) {
    const bf16_t* qp = qb + (size_t)(t0 + (lane & 15)) * 2048 + h * 256 + 8 * (lane >> 4);
#pragma unroll
    for (int i = 0; i < 8; ++i) qa[i] = *(const tk_bf16x8*)(qp + i * 32);
}
__device__ __forceinline__ void topk_item(const tk_bf16x8 (&qa)[8], const LAS unsigned char* klds, int* __restrict__ ids, float* __restrict__ gates, int t0, int h, int lane) {
    const int rl = lane & 15, rg = lane >> 4;
    unsigned top[2][4];
#pragma unroll
    for (int c = 0; c < 2; ++c) {
        f32x4 acc[8];
#pragma unroll
        for (int nt = 0; nt < 8; ++nt) acc[nt] = (f32x4){64.f, 64.f, 64.f, 64.f};
        const LAS unsigned char* kp = klds + c * TK_HALF + rl * TK_PITCH + 16 * rg;
#pragma unroll
        for (int ks = 0; ks < 4; ++ks) {
#pragma unroll
            for (int nt = 0; nt < 8; ++nt) { const tk_bf16x8 b = *(const LAS tk_bf16x8*)(kp + nt * 16 * TK_PITCH + ks * 64); acc[nt] = __builtin_amdgcn_mfma_f32_16x16x32_bf16(qa[c * 4 + ks], b, acc[nt], 0, 0, 0); }
            __builtin_amdgcn_sched_barrier(0);
        }
        unsigned k[4][8];
#pragma unroll
        for (int r = 0; r < 4; ++r) {
#pragma unroll
            for (int nt = 0; nt < 8; ++nt) k[r][nt] = (__float_as_uint(fmaxf(acc[nt][r], 1.f)) & ~127u) | (unsigned)(127 - (nt * 16 + rl));
#define TK_CE(i, j) do { const unsigned a_ = max(k[r][i], k[r][j]), b_ = min(k[r][i], k[r][j]); k[r][i] = a_; k[r][j] = b_; } while (0)
            TK_CE(0, 1); TK_CE(2, 3); TK_CE(4, 5); TK_CE(6, 7); TK_CE(0, 2); TK_CE(1, 3); TK_CE(4, 6); TK_CE(5, 7); TK_CE(1, 2); TK_CE(5, 6);
            TK_CE(0, 4); TK_CE(1, 5); TK_CE(2, 6); TK_CE(3, 7); TK_CE(2, 4); TK_CE(3, 5); TK_CE(1, 2); TK_CE(3, 4); TK_CE(5, 6);
#undef TK_CE
        }
        unsigned tp[4] = {0u, 0u, 0u, 0u};
        for (int round = 0; round < 16; ++round) {
#pragma unroll
            for (int r = 0; r < 4; ++r) {
                const unsigned m = row_allmax_u32(k[r][0]);
                tp[r] = (rl == round) ? m : tp[r];
                const bool win = (k[r][0] == m);
                k[r][0] = win ? k[r][1] : k[r][0]; k[r][1] = win ? k[r][2] : k[r][1]; k[r][2] = win ? k[r][3] : k[r][2]; k[r][3] = win ? k[r][4] : k[r][3];
                k[r][4] = win ? k[r][5] : k[r][4]; k[r][5] = win ? k[r][6] : k[r][5]; k[r][6] = win ? k[r][7] : k[r][6]; k[r][7] = win ? 0u : k[r][7];
            }
        }
#pragma unroll
        for (int r = 0; r < 4; ++r) top[c][r] = tp[r];
    }
    const int rowbase = lane & 48;
    float v1[4]; int n1[4], ptr[4], myid[4]; unsigned k2[4], myv[4];
#pragma unroll
    for (int r = 0; r < 4; ++r) { v1[r] = __uint_as_float(top[0][r] & ~127u); n1[r] = 127 - (int)(top[0][r] & 127u); ptr[r] = 0; k2[r] = (unsigned)__builtin_amdgcn_ds_bpermute(rowbase * 4, (int)top[1][r]); myid[r] = 0; myv[r] = 0u; }
    for (int round = 0; round < 16; ++round) {
#pragma unroll
        for (int r = 0; r < 4; ++r) {
            const float head = v1[r] + __uint_as_float(k2[r] & ~127u);
            const unsigned key = (ptr[r] < 16) ? ((__float_as_uint(head) & ~15u) | (unsigned)(15 - rl)) : 0u;
            const unsigned m = row_allmax_u32(key);
            const bool win = (key == m);
            const unsigned wid = row_allmax_u32(win ? (unsigned)(n1[r] * 128 + (127 - (int)(k2[r] & 127u))) + 1u : 0u);
            myid[r] = (rl == round) ? (int)wid - 1 : myid[r];
            myv[r] = (rl == round) ? m : myv[r];
            ptr[r] += win ? 1 : 0;
            k2[r] = (unsigned)__builtin_amdgcn_ds_bpermute((rowbase + (ptr[r] & 15)) * 4, (int)top[1][r]);
        }
    }
#pragma unroll
    for (int r = 0; r < 4; ++r) {
        const float val = __uint_as_float(myv[r] & ~15u);
        const float vmax = __uint_as_float((unsigned)__builtin_amdgcn_ds_bpermute(rowbase * 4, (int)__float_as_uint(val)));
        const float e = __expf(val - vmax);
        const float sum = rw::row_allsum(e);
        gates[(size_t)(t0 + 4 * rg + r) * 128 + h * 16 + rl] = e * __builtin_amdgcn_rcpf(sum); ids[(size_t)(t0 + 4 * rg + r) * 128 + h * 16 + rl] = myid[r];
    }
}

typedef float f32x2 __attribute__((ext_vector_type(2)));
__device__ __forceinline__ void peer_token(const bf16_t* __restrict__ x2b, const float* __restrict__ ssq2, const int* __restrict__ ids, const float* __restrict__ gates,
                                           const unsigned char* __restrict__ U8, const unsigned char* __restrict__ V8, const float* __restrict__ usc, const float* __restrict__ vsc,
                                           const float* __restrict__ fw, float* __restrict__ out, int t, int lane) {
    const int l16 = lane * 16;
    f32x2 hx[8];
    {
        const v4u h0 = *(const v4u*)(x2b + (size_t)t * DM + l16), h1 = *(const v4u*)(x2b + (size_t)t * DM + l16 + 8);
        const unsigned hw[8] = {h0.x, h0.y, h0.z, h0.w, h1.x, h1.y, h1.z, h1.w};
#pragma unroll
        for (int i = 0; i < 8; ++i) hx[i] = (f32x2){pg8::bflo(hw[i]), pg8::bfhi(hw[i])};
    }
    const int idA = ids[(size_t)t * 128 + lane], idB = ids[(size_t)t * 128 + 64 + lane];
    const float rs = rsqrtf(pg8::ssq_sum16(ssq2 + (size_t)t * 16) * (1.f / DM) + NORM_EPS);
    const float suA = rs * usc[idA], suB = rs * usc[idB];
    const float svA = gates[(size_t)t * 128 + lane] * vsc[idA], svB = gates[(size_t)t * 128 + 64 + lane] * vsc[idB];
    f32x2 y[8];
#pragma unroll
    for (int i = 0; i < 8; ++i) y[i] = (f32x2){0.f, 0.f};
    const int bit0 = lane & 1, bit1 = (lane >> 1) & 1, bit5 = lane >> 5;
    v3u_t uw[8], vw[8];
    const unsigned vo12 = (unsigned)lane * 12u;
#define PEER_LDU(g_) do { const int is_ = ((g_) < 8) ? idA : idB; const int lb_ = ((g_) * 8) & 63; _Pragma("unroll") for (int k = 0; k < 8; ++k) { const unsigned eo = (unsigned)__builtin_amdgcn_readlane(is_, lb_ + k) * 768u; \
        const unsigned char* rp_ = U8 + eo; uw[k] = *(const v3u_t*)(rp_ + vo12); } } while (0)
#define PEER_LDV(g_) do { const int is_ = ((g_) < 8) ? idA : idB; const int lb_ = ((g_) * 8) & 63; _Pragma("unroll") for (int k = 0; k < 8; ++k) { const unsigned eo = (unsigned)__builtin_amdgcn_readlane(is_, lb_ + k) * 768u; \
        const unsigned char* rp_ = V8 + eo; vw[k] = *(const v3u_t*)(rp_ + vo12); } } while (0)
    PEER_LDU(0); PEER_LDV(0);
    for (int g = 0; g < 16; ++g) {
        const float susel = (g < 8) ? suA : suB, svsel = (g < 8) ? svA : svB; const int lb = (g * 8) & 63;
        float d[8];
#pragma unroll
        for (int k = 0; k < 8; k += 2) {
            const v32f_t f = __builtin_amdgcn_cvt_scalef32_pk32_f32_fp6((v6u_t){uw[k][0], uw[k][1], uw[k][2], uw[k + 1][0], uw[k + 1][1], uw[k + 1][2]}, 1.0f);
            f32x2 a = (f32x2){0.f, 0.f}, b = a;
#pragma unroll
            for (int i = 0; i < 8; ++i) { a += (f32x2){f[2 * i], f[2 * i + 1]} * hx[i]; b += (f32x2){f[16 + 2 * i], f[17 + 2 * i]} * hx[i]; }
            d[k] = a[0] + a[1]; d[k + 1] = b[0] + b[1];
            __builtin_amdgcn_sched_barrier(0);
        }
        if (g + 1 < 16) PEER_LDU(g + 1);
        __builtin_amdgcn_sched_barrier(0);
#pragma unroll
        for (int k = 0; k < 8; ++k) d[k] *= __uint_as_float((unsigned)__builtin_amdgcn_readlane((int)__float_as_uint(susel), lb + k));
        float r4[4];
#pragma unroll
        for (int k = 0; k < 4; ++k) { const float send = bit0 ? d[k] : d[k + 4], keep = bit0 ? d[k + 4] : d[k]; r4[k] = keep + rw::dppf<0xB1>(send); }
        float r2[2];
#pragma unroll
        for (int k = 0; k < 2; ++k) { const float send = bit1 ? r4[k] : r4[k + 2], keep = bit1 ? r4[k + 2] : r4[k]; r2[k] = keep + rw::dppf<0x4E>(send); }
        float r1;
        { const float send = bit5 ? r2[0] : r2[1], keep = bit5 ? r2[1] : r2[0];
          auto rr = __builtin_amdgcn_permlane32_swap(__float_as_uint(send), __float_as_uint(send), false, false);
          r1 = keep + __uint_as_float(bit5 ? rr[0] : rr[1]); }
        r1 += rw::dppf<0x128>(r1); r1 += rw::dppf<0x124>(r1);
        r1 += __uint_as_float((unsigned)__builtin_amdgcn_ds_swizzle((int)__float_as_uint(r1), 0x401F));
        const float dd = r1;
        const float act = 0.5f * dd * (1.f + erff(dd * 0.70710678118654752f));
#pragma unroll
        for (int k = 0; k < 8; k += 2) {
#define PEER_LANE_OF(k_) ((((k_) >> 2) & 1) | ((((k_) >> 1) & 1) << 1) | (((k_) & 1) << 5))
            const float a = __uint_as_float((unsigned)__builtin_amdgcn_readlane((int)__float_as_uint(act), PEER_LANE_OF(k))) * __uint_as_float((unsigned)__builtin_amdgcn_readlane((int)__float_as_uint(svsel), lb + k));
            const float b = __uint_as_float((unsigned)__builtin_amdgcn_readlane((int)__float_as_uint(act), PEER_LANE_OF(k + 1))) * __uint_as_float((unsigned)__builtin_amdgcn_readlane((int)__float_as_uint(svsel), lb + k + 1));
#undef PEER_LANE_OF
            const f32x2 a2 = (f32x2){a, a}, b2 = (f32x2){b, b};
            const v32f_t f = __builtin_amdgcn_cvt_scalef32_pk32_f32_fp6((v6u_t){vw[k][0], vw[k][1], vw[k][2], vw[k + 1][0], vw[k + 1][1], vw[k + 1][2]}, 1.0f);
#pragma unroll
            for (int i = 0; i < 8; ++i) { y[i] += (f32x2){f[2 * i], f[2 * i + 1]} * a2; y[i] += (f32x2){f[16 + 2 * i], f[17 + 2 * i]} * b2; }
            __builtin_amdgcn_sched_barrier(0);
        }
        if (g + 1 < 16) PEER_LDV(g + 1);
        __builtin_amdgcn_sched_barrier(0);
    }
#undef PEER_LDU
#undef PEER_LDV
    float* orow = out + (size_t)t * DM + l16;
    float ss = 0.f;
    f32x4 o4[4];
#pragma unroll
    for (int i = 0; i < 4; ++i) { o4[i] = (f32x4){hx[2 * i][0] + y[2 * i][0], hx[2 * i][1] + y[2 * i][1], hx[2 * i + 1][0] + y[2 * i + 1][0], hx[2 * i + 1][1] + y[2 * i + 1][1]};
        ss += (o4[i][0] * o4[i][0] + o4[i][1] * o4[i][1]) + (o4[i][2] * o4[i][2] + o4[i][3] * o4[i][3]); }
    ss = wave_sum(ss);
    const float r = rsqrtf(ss * (1.f / DM) + NORM_EPS);
#pragma unroll
    for (int i = 0; i < 4; ++i) *(f32x4*)(orow + 4 * i) = o4[i] * r * *(const f32x4*)(fw + l16 + 4 * i);
}

__global__ void __launch_bounds__(NWAVES * 64, 2) mk_fwd(Args args) {
    extern __shared__ __attribute__((aligned(16))) unsigned char lds_raw[];
    LAS unsigned char* lds = (LAS unsigned char*)lds_raw;
    volatile LAS unsigned* MISC = (volatile LAS unsigned*)(lds + MISC_OFF);
    const int tid = threadIdx.x, lane = tid & 63, wave = __builtin_amdgcn_readfirstlane(tid >> 6);
    const int G = gridDim.x; const int bx = blockIdx.x; const int vcu = (G % 8 == 0) ? (bx % 8) * (G / 8) + bx / 8 : bx;
    unsigned char* ws = args.ws;
    unsigned* ctl = (unsigned*)(ws + WS_CTL);
    for (int u = tid; u < (LDS_BYTES - LDSCTL_OFF) / 4; u += NWAVES * 64) ((LAS unsigned*)(lds + LDSCTL_OFF))[u] = 0u;
    __syncthreads();
    XcdBarrier bar = xcd_barrier_post(ctl + CW_BAR + args.li * XCD_BAR_WORDS, MISC + 8);
    const int lo = args.ph_lo, hi = args.ph_hi;
#define IN(k) (lo <= (k) && (k) < hi)
#define BOTH(k) (IN(k) && IN((k) + 1))
    bf16_t* WinT = (bf16_t*)(ws + WS_WIN); bf16_t* PaT = (bf16_t*)(ws + WS_PA); bf16_t* PbT = (bf16_t*)(ws + WS_PB); bf16_t* WoT = (bf16_t*)(ws + WS_WO);
    bf16_t* WqT = (bf16_t*)(ws + WS_WQ); bf16_t* KeysB = (bf16_t*)(ws + WS_KEYS);
    float* rstd1 = (float*)(ws + WS_RSTD1); float* ssq2 = (float*)(ws + WS_RSTD2); float* scal = (float*)(ws + WS_SCAL);
    unsigned char* U8 = ws + WS_U; unsigned char* V8 = ws + WS_V; float* usc = (float*)(ws + WS_USC); float* vsc = (float*)(ws + WS_VSC);
    bf16_t* xb = (bf16_t*)(ws + WS_XB); bf16_t* ya = (bf16_t*)(ws + WS_YA); bf16_t* yb = (bf16_t*)(ws + WS_YB); bf16_t* x2b = (bf16_t*)(ws + WS_X2B);
    bf16_t* z = (bf16_t*)(ws + WS_Z); bf16_t* qb = (bf16_t*)(ws + WS_Q);
    bf16_t* merged = (bf16_t*)(ws + WS_MERGED);
    const int gw = vcu * NWAVES + wave, NGW = G * NWAVES;

    if (IN(0)) {
        LAS float* scr = (LAS float*)(lds + wave * 16384);
        constexpr int I_IN = (DM / 64) * (NZ / 32), I_PA = (512 / 64) * (DM / 32), I_WO = (DM / 64) * (DM / 32), I_WQ = (DM / 64) * (2048 / 32);
        constexpr int NITEMS = I_IN + 2 * I_PA + I_WO + I_WQ;
        for (int it = gw; it < NITEMS; it += NGW) {
            int r = it;
            if (r < I_IN) { p0_transpose_item(args.in[2], args.in[1], DM, NZ, WinT, scr, r, lane, ws + WS_WG8, C_GA); continue; } r -= I_IN;
            if (r < I_PA) { p0_transpose_item(args.in[19], nullptr, 512, DM, PaT, scr, r, lane, nullptr, 0, DM, 0); continue; } r -= I_PA;
            if (r < I_PA) { p0_transpose_item(args.in[20], nullptr, 512, DM, PaT, scr, r, lane, nullptr, 0, DM, 512); continue; } r -= I_PA;
            if (r < I_WO) { p0_transpose_item(args.in[21], nullptr, DM, DM, WoT, scr, r, lane); continue; } r -= I_WO;
            p0_transpose_item(args.in[23], args.in[22], DM, 2048, WqT, scr, r, lane);
        }
        p0_convert(args.in[24], nullptr, KeysB, (size_t)16 * 128 * 128, gw, NGW, lane);
        for (int e = gw; e < 2 * NEXP; e += NGW) {
            const bool isu = e < NEXP; const int row = isu ? e : e - NEXP;
            p0_row_fp6((isu ? args.in[25] : args.in[26]) + (size_t)row * DM, isu ? args.in[22] : nullptr, (isu ? U8 : V8) + (size_t)row * 768, (isu ? usc : vsc) + row, lane);
        }
        for (int m = gw; m < T_TOK; m += NGW) {
            const f32x4* xr = (const f32x4*)(args.in[0] + (size_t)m * DM) + lane;
            f32x4 v[4]; float s = 0.f;
#pragma unroll
            for (int j = 0; j < 4; ++j) { v[j] = xr[64 * j]; s += (v[j][0] * v[j][0] + v[j][1] * v[j][1]) + (v[j][2] * v[j][2] + v[j][3] * v[j][3]); }
            s = wave_sum(s);
            v2u* o8 = (v2u*)(xb + (size_t)m * DM) + lane;
#pragma unroll
            for (int j = 0; j < 4; ++j) { v2u w; w.x = pg8::cvt_pk_bf16(v[j][0], v[j][1]); w.y = pg8::cvt_pk_bf16(v[j][2], v[j][3]); o8[64 * j] = w;
                int p = 0; p = __builtin_amdgcn_cvt_pk_fp8_f32(v[j][0], v[j][1], p, false); p = __builtin_amdgcn_cvt_pk_fp8_f32(v[j][2], v[j][3], p, true);
                ((unsigned*)(ws + WS_XQ + (size_t)m * DM))[lane + 64 * j] = (unsigned)p; }
            if (lane == 0) rstd1[m] = rsqrtf(s * (1.f / DM) + NORM_EPS);
        }
        if (gw == 0) {
            const float a = wave_sum(args.in[14][lane] * args.in[15][lane]), b = wave_sum(args.in[16][lane] * args.in[17][lane]);
            if (lane == 0) scal[0] = __expf(a) - __expf(b) + LAM_INIT;
        }
        if (BOTH(0)) xcd_barrier(bar);
    }
    if (IN(1)) {
        {
            pg8::Gemm g{xb, WinT, DM, DM, DM}; pg8::StaticOrder S; S.init(T_TOK, C_GA, G, bx);
            pg8::EpiRowScale<false> E{z, NZ, rstd1};
            pg8::gemm_phase(lds, g, S, E);
        }
        {
            pg8::Gemm g{(const bf16_t*)(ws + WS_XQ), (const bf16_t*)(ws + WS_WG8), DM / 2, DM / 2, DM / 2}; pg8::StaticOrder S; S.init(T_TOK, NZ - C_GA, G, bx);
            pg8::EpiRowScale<false> E{z + C_GA, NZ, rstd1, 1.f / 32.f};
            pg8::gemm_phase<pg8::EpiRowScale<false>, pg8::StaticOrder, true>(lds, g, S, E);
        }
        if (BOTH(1)) xcd_barrier(bar);
    }
    if (IN(2)) {
        {
            const rw::ScanP P{args.in[3], args.in[4], args.in[5], args.in[6], args.in[7], args.in[8], args.in[9], args.in[10], args.in[11], args.in[12], args.in[13]};
            for (int rep = 0; rep < REPS(2); ++rep) for (int u = vcu; u < NB * 8; u += G) rw::scan_unit(lds, z, ya, P, u >> 3, u & 7, tid, wave, lane);
        }
        const float lam = scal[0];
        __syncthreads();
        for (int i = 0;; ++i) {
            int idx = vcu + i * G; if (idx >= 2048 * REPS(10)) break;
            idx &= 2047;
            const int slot = idx >> 8, v = idx & 255, bh = v >> 1, a = (v & 1) * 4 + (slot >> 1), qblk = (slot & 1) ? 15 - a : a;
            da::attn_unit(lds, z, yb, args.in[18], lam, bh >> 2, bh & 3, qblk, wave, lane);
        }
        if (BOTH(2)) xcd_barrier(bar);
    }
    if (IN(3)) {
        pg8::Gemm g{ya, PaT, DM, DM, DM}; pg8::StaticOrder S; S.init(T_TOK, DM, G, bx);
        pg8::EpiGate2 E{merged, z};
        pg8::gemm_phase(lds, g, S, E);
        if (BOTH(3)) xcd_barrier(bar);
    }
    if (IN(5)) {
        pg8::Gemm g{merged, WoT, DM, DM, DM}; pg8::StaticOrder S; S.init(T_TOK, DM, G, bx);
        pg8::EpiX2 E{args.in[0], args.out, x2b, ssq2};
        pg8::gemm_phase(lds, g, S, E);
        if (BOTH(5)) xcd_barrier(bar);
    }
    if (IN(6)) {
        pg8::Gemm g{x2b, WqT, DM, DM, DM}; pg8::StaticOrder S; S.init(T_TOK, 2048, G, bx);
        pg8::EpiRowScale<true> E{qb, 2048, ssq2};
        for (int rep = 0; rep < REPS(6); ++rep) pg8::gemm_phase(lds, g, S, E);
        if (BOTH(6)) xcd_barrier(bar);
    }
    if (IN(7)) {
        int* ids = (int*)(ws + WS_IDS); float* gates = (float*)(ws + WS_GATES);
        for (int rep = 0; rep < REPS(7); ++rep)
        for (int h = 0; h < 8; ++h) {
            __syncthreads();
            {
                const bf16_t* ksrc = KeysB + (size_t)h * 2 * 128 * 128;
#pragma unroll
                for (int i = 0; i < 8; ++i) { const int chunk = tid + i * 512, row = chunk >> 4, cc = chunk & 15;
                    *(LAS v4u*)(lds + (row >> 7) * TK_HALF + (row & 127) * TK_PITCH + cc * 16) = *(const v4u*)(ksrc + (size_t)row * 128 + cc * 8); }
            }
            __syncthreads();
            for (int tile = gw; tile < 4096; tile += NGW) {
                tk_bf16x8 qa[8];
                topk_loadq(qa, qb, tile * 16, h, lane);
                topk_item(qa, lds, ids, gates, tile * 16, h, lane);
            }
        }
        if (BOTH(7)) xcd_barrier(bar);
    }
    if (IN(8)) {
        const int* ids = (const int*)(ws + WS_IDS); const float* gates = (const float*)(ws + WS_GATES);
        for (int t = gw; t < T_TOK; t += NGW) peer_token(x2b, ssq2, ids, gates, U8, V8, usc, vsc, args.in[27], args.out, t, lane);
    }
#undef IN
#undef BOTH
}

extern "C" void kernel_launch(void* const* d_in, const int* in_sizes, int n_in, void* d_out, int out_size, void* d_ws, size_t ws_size, hipStream_t stream) {
    static int grid = 0;
    if (grid == 0) {
        if (n_in != 28 || in_sizes[0] != T_TOK * DM || out_size != T_TOK * DM || ws_size < WS_END) {
            fprintf(stderr, "kernel_launch: unexpected shapes / workspace (n_in %d, ws %zu < %zu)\n", n_in, ws_size, (size_t)WS_END); grid = -1; return; }
        int dev = 0, cus = 0;
        if (hipGetDevice(&dev) != hipSuccess || hipDeviceGetAttribute(&cus, hipDeviceAttributeMultiprocessorCount, dev) != hipSuccess) { grid = -1; return; }
        if (hipFuncSetAttribute((const void*)mk_fwd, hipFuncAttributeMaxDynamicSharedMemorySize, LDS_BYTES) != hipSuccess) { fprintf(stderr, "kernel_launch: hipFuncSetAttribute failed\n"); grid = -1; return; }
        grid = cus;
    }
    if (grid < 0) return;
    unsigned char* ws = (unsigned char*)d_ws;
    float* out = (float*)d_out;
    (void)hipMemsetAsync(ws + WS_CTL, 0, 1 * MiB, stream);
    Args a{};
    for (int i = 0; i < 28; ++i) a.in[i] = (const float*)d_in[i];
    a.out = out; a.ws = ws;
    a.ph_lo = 0; a.ph_hi = 9; a.li = 0;
    hipLaunchKernelGGL(mk_fwd, dim3(grid), dim3(NWAVES * 64), LDS_BYTES, stream, a);
}
```

```cpp
#include <hip/hip_runtime.h>
#include <stdint.h>
#include <cstdio>

typedef unsigned short bf16_t;
typedef unsigned int u32;

#ifndef PROBE_REP
#define PROBE_REP 0
#endif
#define REPS(k) (((PROBE_REP >> (k)) & 1) ? 2 : 1)
constexpr int T_TOK = 65536, DM = 1024, SEQ = 2048, NB = 32;
constexpr int NZ = 5376;
constexpr int C_R = 0, C_K = 512, C_V = 1024, C_WL = 1536, C_AL = 1600, C_GL = 1664, C_Q = 1792, C_ZK = 2304, C_ZV = 2816, C_GA = 3328, C_GB = 4352;
constexpr int NEXP = 16384;
constexpr float NORM_EPS = 1e-6f, GN_EPS = 64e-5f, SUBLN_EPS = 1e-5f;
constexpr float LAM_INIT = 0.2f;

constexpr size_t MiB = 1u << 20;
constexpr size_t WS_CTL = 0;
constexpr size_t WS_WIN = 1 * MiB;
constexpr size_t WS_PA = 12 * MiB;
constexpr size_t WS_PB = 13 * MiB;
constexpr size_t WS_WO = 14 * MiB;
constexpr size_t WS_WQ = 16 * MiB;
constexpr size_t WS_KEYS = 20 * MiB;
constexpr size_t WS_RSTD1 = 21 * MiB;
constexpr size_t WS_RSTD2 = 58 * MiB;
constexpr size_t WS_SCAL = 23 * MiB;
constexpr size_t WS_U = 24 * MiB;
constexpr size_t WS_V = 40 * MiB;
constexpr size_t WS_USC = 56 * MiB;
constexpr size_t WS_VSC = 57 * MiB;
constexpr size_t WS_XB = 88 * MiB;
constexpr int YAB_PITCH = 1024;
constexpr size_t WS_YA = WS_XB;
constexpr size_t WS_YB = WS_XB + 1024;
constexpr size_t WS_X2B = WS_XB;
constexpr size_t WS_Z = 216 * MiB;
constexpr size_t WS_Q = WS_Z;
constexpr size_t WS_IDS = WS_Z + 256 * MiB;
constexpr size_t WS_GATES = WS_Z + 288 * MiB;
constexpr size_t WS_MERGED = 888 * MiB;
constexpr size_t WS_XQ = WS_MERGED;
constexpr size_t WS_WG8 = WS_MERGED + 64 * MiB;
constexpr size_t WS_END = 1016 * MiB;

__device__ __forceinline__ float bf2f(bf16_t h) { return __uint_as_float(((u32)h) << 16); }
__device__ __forceinline__ bf16_t f2bf(float f) { u32 u = __float_as_uint(f); u += 0x7fffu + ((u >> 16) & 1u); return (bf16_t)(u >> 16); }
__device__ __forceinline__ float wave_sum(float v) {
#pragma unroll
    for (int o = 1; o < 64; o <<= 1) v += __shfl_xor(v, o);
    return v;
}
__device__ __forceinline__ float sigmoidf_(float x) { return __builtin_amdgcn_rcpf(1.f + __expf(-x)); }

namespace pg8 {
#define PG8_LAS __attribute__((address_space(3)))
typedef short bf16x8 __attribute__((ext_vector_type(8)));
typedef float f32x4 __attribute__((ext_vector_type(4)));
typedef unsigned u32x4 __attribute__((ext_vector_type(4)));
constexpr int BM = 256, BK = 64, HALF = 128, HTB = HALF * BK * 2  , STAGE_BYTES = 8 * HTB, NXCD = 8, WGM = 8;

__host__ __device__ __forceinline__ int lds_byte(int r, int c) { const int st = (r >> 4) * 2 + (c >> 5), rr = r & 15, cc = c & 31, ob = rr * 64 + cc * 2; return st * 1024 + (ob ^ (((ob >> 9) & 1) << 5)); }
__host__ __device__ __forceinline__ void stage_rc(int b, int& R, int& C) { const int st = b / 1024, sb = b % 1024, swz = sb ^ (((sb >> 9) & 1) << 5); R = (st >> 1) * 16 + swz / 64; C = (st & 1) * 32 + (swz % 64) / 2; }
__host__ __device__ __forceinline__ int perm32(int rho) { const int n = rho >> 4, i = rho & 15; return 8 * (i >> 2) + 4 * n + (i & 3); }

struct Unit { int pm, pn; };
struct Gemm { const bf16_t* A; const bf16_t* Bt; int lda, ldb, K; };

struct StaticOrder {
    int nM, nN, nwg, G, c;
    __host__ __device__ void init(int M, int N, int G_, int c_) { nM = M / BM; nN = N / BM; nwg = nM * nN; G = G_; c = c_; }
    __host__ __device__ bool next(int i, Unit& u) const {
        const long L = (long)i * G + c; if (L >= nwg) return false;
        int wgid = (int)L; { const int q = nwg / NXCD, r = nwg % NXCD, xcd = wgid % NXCD, off = wgid / NXCD; wgid = (xcd < r ? xcd * (q + 1) : r * (q + 1) + (xcd - r) * q) + off; }
        const int nig = WGM * nN, gid = wgid / nig, fm = gid * WGM, gsz = (nM - fm) < WGM ? (nM - fm) : WGM;
        u.pm = fm + ((wgid % nig) % gsz); u.pn = (wgid % nig) / gsz; return true;
    }
};
typedef float f32x2_c __attribute__((ext_vector_type(2))); typedef __bf16 bf16x2_c __attribute__((ext_vector_type(2)));
__device__ __forceinline__ unsigned cvt_pk_bf16(float lo, float hi) { const f32x2_c v = {lo, hi}; const bf16x2_c b = __builtin_convertvector(v, bf16x2_c); return __builtin_bit_cast(unsigned, b); }
__device__ __forceinline__ float bflo(unsigned w) { return __uint_as_float(w << 16); }
__device__ __forceinline__ float bfhi(unsigned w) { return __uint_as_float(w & 0xffff0000u); }

__device__ __forceinline__ float ssq_sum16(const float* p) {
    const f32x4 a = *(const f32x4*)p, b = *(const f32x4*)(p + 4), c = *(const f32x4*)(p + 8), d = *(const f32x4*)(p + 12);
    return (((a[0] + a[1]) + (a[2] + a[3])) + ((b[0] + b[1]) + (b[2] + b[3]))) + (((c[0] + c[1]) + (c[2] + c[3])) + ((d[0] + d[1]) + (d[2] + d[3])));
}
template <bool SSQ> struct EpiRowScale {
    static constexpr bool PERM = true, MID = false;
    bf16_t* O; int ldc; const float* rs; float mul = 1.f;
    __device__ __forceinline__ void operator()(const f32x4 (&acc)[2][2][4][2], const Unit& u, int wr, int wc, int fr, int fq) const {
        const int row0 = u.pm * BM + wr * 64 + fr, col0 = u.pn * BM + wc * 32 + 8 * fq;
#pragma unroll
        for (int ai = 0; ai < 2; ++ai)
#pragma unroll
            for (int m = 0; m < 4; ++m) {
                const int row = row0 + ai * HALF + m * 16;
                float s; if (SSQ) s = rsqrtf(ssq_sum16(rs + (size_t)row * 16) * (1.f / 1024.f) + NORM_EPS); else s = rs[row] * mul;
                bf16_t* rowp = O + (size_t)row * ldc + col0;
#pragma unroll
                for (int bj = 0; bj < 2; ++bj) {
                    const f32x4 v0 = acc[ai][bj][m][0] * s, v1 = acc[ai][bj][m][1] * s;
                    u32x4 w; w.x = cvt_pk_bf16(v0[0], v0[1]); w.y = cvt_pk_bf16(v0[2], v0[3]); w.z = cvt_pk_bf16(v1[0], v1[1]); w.w = cvt_pk_bf16(v1[2], v1[3]);
                    *(u32x4*)(rowp + bj * HALF) = w;
                }
            }
    }
};
struct EpiRowScaleF8 {
    static constexpr bool PERM = true, MID = false;
    unsigned char* O; int ldc; const float* rs; float mul;
    __device__ __forceinline__ void operator()(const f32x4 (&acc)[2][2][4][2], const Unit& u, int wr, int wc, int fr, int fq) const {
        const int row0 = u.pm * BM + wr * 64 + fr, col0 = u.pn * BM + wc * 32 + 8 * fq;
#pragma unroll
        for (int ai = 0; ai < 2; ++ai)
#pragma unroll
            for (int m = 0; m < 4; ++m) {
                const int row = row0 + ai * HALF + m * 16;
                const float s = rs[row] * mul;
                unsigned char* rowp = O + (size_t)row * ldc + col0;
#pragma unroll
                for (int bj = 0; bj < 2; ++bj) {
                    const f32x4 v0 = acc[ai][bj][m][0] * s, v1 = acc[ai][bj][m][1] * s;
                    int p0 = 0, p1 = 0;
                    p0 = __builtin_amdgcn_cvt_pk_fp8_f32(v0[0], v0[1], p0, false); p0 = __builtin_amdgcn_cvt_pk_fp8_f32(v0[2], v0[3], p0, true);
                    p1 = __builtin_amdgcn_cvt_pk_fp8_f32(v1[0], v1[1], p1, false); p1 = __builtin_amdgcn_cvt_pk_fp8_f32(v1[2], v1[3], p1, true);
                    *(unsigned long long*)(rowp + bj * HALF) = ((unsigned long long)(unsigned)p1 << 32) | (unsigned)p0;
                }
            }
    }
};
template <bool ACCUM> struct EpiGate {
    static constexpr bool PERM = true, MID = false;
    bf16_t* mg; const bf16_t* z; int gcol;
    __device__ __forceinline__ void operator()(const f32x4 (&acc)[2][2][4][2], const Unit& u, int wr, int wc, int fr, int fq) const {
        const int row0 = u.pm * BM + wr * 64 + fr, col0 = u.pn * BM + wc * 32 + 8 * fq;
#pragma unroll
        for (int ai = 0; ai < 2; ++ai)
#pragma unroll
            for (int m = 0; m < 4; ++m) {
                const int row = row0 + ai * HALF + m * 16;
                const bf16_t* gp = z + (size_t)row * NZ + gcol + col0;
                bf16_t* rowp = mg + (size_t)row * DM + col0;
#pragma unroll
                for (int bj = 0; bj < 2; ++bj) {
                    const u32x4 g = *(const u32x4*)(gp + bj * HALF);
                    const f32x4 a0 = acc[ai][bj][m][0], a1 = acc[ai][bj][m][1];
                    float r[8];
                    r[0] = sigmoidf_(bflo(g.x)) * a0[0]; r[1] = sigmoidf_(bfhi(g.x)) * a0[1]; r[2] = sigmoidf_(bflo(g.y)) * a0[2]; r[3] = sigmoidf_(bfhi(g.y)) * a0[3];
                    r[4] = sigmoidf_(bflo(g.z)) * a1[0]; r[5] = sigmoidf_(bfhi(g.z)) * a1[1]; r[6] = sigmoidf_(bflo(g.w)) * a1[2]; r[7] = sigmoidf_(bfhi(g.w)) * a1[3];
                    if (ACCUM) { const u32x4 o = *(const u32x4*)(rowp + bj * HALF);
                        r[0] += bflo(o.x); r[1] += bfhi(o.x); r[2] += bflo(o.y); r[3] += bfhi(o.y); r[4] += bflo(o.z); r[5] += bfhi(o.z); r[6] += bflo(o.w); r[7] += bfhi(o.w); }
                    u32x4 w; w.x = cvt_pk_bf16(r[0], r[1]); w.y = cvt_pk_bf16(r[2], r[3]); w.z = cvt_pk_bf16(r[4], r[5]); w.w = cvt_pk_bf16(r[6], r[7]);
                    *(u32x4*)(rowp + bj * HALF) = w;
                }
            }
    }
};
struct EpiGate2 {
    static constexpr bool PERM = true, MID = true;
    bf16_t* mg; const unsigned char* g8;
    typedef float f2_ __attribute__((ext_vector_type(2)));
    static __device__ __forceinline__ void dec8(unsigned long long w, float (&o)[8]) {
        const int lo = (int)(unsigned)w, hi = (int)(unsigned)(w >> 32);
        const f2_ a = __builtin_amdgcn_cvt_pk_f32_fp8(lo, false), b = __builtin_amdgcn_cvt_pk_f32_fp8(lo, true), c = __builtin_amdgcn_cvt_pk_f32_fp8(hi, false), d = __builtin_amdgcn_cvt_pk_f32_fp8(hi, true);
        o[0] = a[0]; o[1] = a[1]; o[2] = b[0]; o[3] = b[1]; o[4] = c[0]; o[5] = c[1]; o[6] = d[0]; o[7] = d[1];
    }
    __device__ __forceinline__ void mid(f32x4 (&acc)[2][2][4][2], const Unit& u, int wr, int wc, int fr, int fq) const {
        int row0 = u.pm * BM + wr * 64 + fr; const int col0 = u.pn * BM + wc * 32 + 8 * fq;
        asm volatile("" : "+v"(row0));
        unsigned long long gq[2][8];
#define EG2_LOAD(q_, buf_) do { _Pragma("unroll") for (int mm = 0; mm < 2; ++mm) { const unsigned char* gp = g8 + (size_t)(row0 + ((q_) >> 1) * HALF + (((q_) & 1) * 2 + mm) * 16) * 2048 + col0; \
            gq[buf_][4 * mm] = *(const unsigned long long*)(gp); gq[buf_][4 * mm + 1] = *(const unsigned long long*)(gp + HALF); gq[buf_][4 * mm + 2] = *(const unsigned long long*)(gp + 1024); gq[buf_][4 * mm + 3] = *(const unsigned long long*)(gp + 1024 + HALF); } } while (0)
        EG2_LOAD(0, 0);
#pragma unroll
        for (int q = 0; q < 4; ++q) {
            if (q + 1 < 4) EG2_LOAD(q + 1, (q + 1) & 1);
            __builtin_amdgcn_sched_barrier(0);
            const int ai = q >> 1;
#pragma unroll
            for (int mm = 0; mm < 2; ++mm) { const int m = (q & 1) * 2 + mm;
#pragma unroll
                for (int bj = 0; bj < 2; ++bj) {
                    float ga[8], gb[8], r[8];
                    dec8(gq[q & 1][4 * mm + bj], ga); dec8(gq[q & 1][4 * mm + 2 + bj], gb);
#pragma unroll
                    for (int i = 0; i < 8; ++i) r[i] = (1.f + __expf(-fmaxf(gb[i], -30.f))) * __builtin_amdgcn_rcpf(1.f + __expf(-fmaxf(ga[i], -30.f)));
                    acc[ai][bj][m][0] = acc[ai][bj][m][0] * (f32x4){r[0], r[1], r[2], r[3]};
                    acc[ai][bj][m][1] = acc[ai][bj][m][1] * (f32x4){r[4], r[5], r[6], r[7]};
                }
            }
            __builtin_amdgcn_sched_barrier(0);
        }
#undef EG2_LOAD
    }
    __device__ __forceinline__ void operator()(const f32x4 (&acc)[2][2][4][2], const Unit& u, int wr, int wc, int fr, int fq) const {
        int row0 = u.pm * BM + wr * 64 + fr; const int col0 = u.pn * BM + wc * 32 + 8 * fq;
        asm volatile("" : "+v"(row0));
#pragma unroll
        for (int ai = 0; ai < 2; ++ai)
#pragma unroll
            for (int m = 0; m < 4; ++m) {
                const int row = row0 + ai * HALF + m * 16;
                const unsigned char* gp = g8 + (size_t)row * 2048 + 1024 + col0;
                bf16_t* rowp = mg + (size_t)row * DM + col0;
#pragma unroll
                for (int bj = 0; bj < 2; ++bj) {
                    float gb[8]; dec8(*(const unsigned long long*)(gp + bj * HALF), gb);
                    const f32x4 a0 = acc[ai][bj][m][0], a1 = acc[ai][bj][m][1];
                    const float av[8] = {a0[0], a0[1], a0[2], a0[3], a1[0], a1[1], a1[2], a1[3]};
                    float r[8];
#pragma unroll
                    for (int i = 0; i < 8; ++i) r[i] = av[i] * __builtin_amdgcn_rcpf(1.f + __expf(-fmaxf(gb[i], -30.f)));
                    u32x4 w; w.x = cvt_pk_bf16(r[0], r[1]); w.y = cvt_pk_bf16(r[2], r[3]); w.z = cvt_pk_bf16(r[4], r[5]); w.w = cvt_pk_bf16(r[6], r[7]);
                    *(u32x4*)(rowp + bj * HALF) = w;
                }
            }
    }
};
struct EpiX2 {
    static constexpr bool PERM = true, MID = false;
    const float* x; float* x2; bf16_t* x2b; float* ssq;
    __device__ __forceinline__ void operator()(const f32x4 (&acc)[2][2][4][2], const Unit& u, int wr, int wc, int fr, int fq) const {
        const int row0 = u.pm * BM + wr * 64 + fr, col0 = u.pn * BM + wc * 32 + 8 * fq;
#pragma unroll
        for (int ai = 0; ai < 2; ++ai)
#pragma unroll
            for (int m = 0; m < 4; ++m) {
                const int row = row0 + ai * HALF + m * 16;
                const size_t off = (size_t)row * DM + col0;
                float ss = 0.f;
#pragma unroll
                for (int bj = 0; bj < 2; ++bj) {
                    const f32x4 x0 = *(const f32x4*)(x + off + bj * HALF), x1 = *(const f32x4*)(x + off + bj * HALF + 4);
                    const f32x4 o0 = x0 + acc[ai][bj][m][0], o1 = x1 + acc[ai][bj][m][1];
                    u32x4 w; w.x = cvt_pk_bf16(o0[0], o0[1]); w.y = cvt_pk_bf16(o0[2], o0[3]); w.z = cvt_pk_bf16(o1[0], o1[1]); w.w = cvt_pk_bf16(o1[2], o1[3]);
                    *(u32x4*)(x2b + off + bj * HALF) = w;
                    ss += (o0[0] * o0[0] + o0[1] * o0[1]) + (o0[2] * o0[2] + o0[3] * o0[3]) + (o1[0] * o1[0] + o1[1] * o1[1]) + (o1[2] * o1[2] + o1[3] * o1[3]);
                }
                ss += __shfl_xor(ss, 16); ss += __shfl_xor(ss, 32);
                if (fq == 0) ssq[(size_t)row * 16 + (u.pn & 3) * 4 + wc] = ss;
            }
    }
};

typedef int v8i_t __attribute__((ext_vector_type(8)));
template <class Epi, class Sched, bool F8 = false>
__device__ __forceinline__ void gemm_phase(PG8_LAS unsigned char* lds, const Gemm g, const Sched& S, const Epi& E) {
    const int tid = threadIdx.x, wid = __builtin_amdgcn_readfirstlane(tid >> 6), lane = tid & 63, wr = wid >> 2, wc = wid & 3, fr = lane & 15, fq = lane >> 4;
    const int K = g.K, nt = K / BK;
    unsigned voffA[2], voffB[2];
#pragma unroll
    for (int i = 0; i < 2; ++i) { int R, C; stage_rc(tid * 16 + i * 8192, R, C); const int Rb = Epi::PERM ? ((R & ~31) + perm32(R & 31)) : R;
        voffA[i] = (unsigned)(R * g.lda + C) * 2u; voffB[i] = (unsigned)(Rb * g.ldb + C) * 2u; }
    const size_t kstep = (size_t)(BK * 2);
    const size_t hstepA = (size_t)HALF * g.lda * 2, hstepB = (size_t)HALF * g.ldb * 2;
    const size_t tstepA = 2 * hstepA, tstepB = 2 * hstepB;
    const unsigned ldsw = (unsigned)wid * 1024u;
    const int aoff = lds_byte(wr * 64 + fr, fq * 8), boff = lds_byte(wc * 32 + fr, fq * 8);
    const int sub8 = (fq >> 1) * 1024 + fr * 64 + (((fq & 1) ^ (fr >> 3)) * 32);
    const int aoff8 = ((wr * 64) >> 4) * 2048 + sub8, boff8 = ((wc * 32) >> 4) * 2048 + sub8;
#define PG8_SA(b, h) (((b) * 2 + (h)) * HTB)
#define PG8_SB(b, h) ((4 + (b) * 2 + (h)) * HTB)
#define PG8_STAGE(bufoff, gbase, voff) do { _Pragma("unroll") for (int _i = 0; _i < 2; ++_i) \
        __builtin_amdgcn_global_load_lds((const unsigned*)((const char*)(gbase) + (voff)[_i]), (PG8_LAS unsigned*)(lds + (bufoff) + ldsw + _i * 8192), 16, 0, 0); } while (0)
#define PG8_LD8(p_) ({ typedef int i4_ __attribute__((ext_vector_type(4))); const i4_ lo_ = *(const PG8_LAS i4_*)(p_), hi_ = *(const PG8_LAS i4_*)((p_) + 16); __builtin_shufflevector(lo_, hi_, 0, 1, 2, 3, 4, 5, 6, 7); })
#define PG8_LDA(dst, b, h) do { if constexpr (F8) { _Pragma("unroll") for (int m = 0; m < 4; ++m) dst##8[m] = PG8_LD8(lds + PG8_SA(b, h) + aoff8 + m * 2048); } else { \
        _Pragma("unroll") for (int m = 0; m < 4; ++m) _Pragma("unroll") for (int k = 0; k < 2; ++k) dst[m][k] = *(const PG8_LAS bf16x8*)(lds + PG8_SA(b, h) + aoff + m * 2048 + k * 1024); } } while (0)
#define PG8_LDB(dst, b, h) do { if constexpr (F8) { _Pragma("unroll") for (int n = 0; n < 2; ++n) dst##8[n] = PG8_LD8(lds + PG8_SB(b, h) + boff8 + n * 2048); } else { \
        _Pragma("unroll") for (int n = 0; n < 2; ++n) _Pragma("unroll") for (int k = 0; k < 2; ++k) dst[n][k] = *(const PG8_LAS bf16x8*)(lds + PG8_SB(b, h) + boff + n * 2048 + k * 1024); } } while (0)
#define PG8_MMA(ai, bj, At, Bt) do { __builtin_amdgcn_s_setprio(1); if constexpr (F8) { _Pragma("unroll") for (int m = 0; m < 4; ++m) _Pragma("unroll") for (int n = 0; n < 2; ++n) \
        asm volatile("v_mfma_scale_f32_16x16x128_f8f6f4 %0, %1, %2, %0, %3, %3 op_sel_hi:[0,0,0]" : "+v"(acc[ai][bj][m][n]) : "v"(Bt##8[n]), "v"(At##8[m]), "v"(sc127)); } else { \
        _Pragma("unroll") for (int m = 0; m < 4; ++m) _Pragma("unroll") for (int n = 0; n < 2; ++n) _Pragma("unroll") for (int k = 0; k < 2; ++k) \
        acc[ai][bj][m][n] = __builtin_amdgcn_mfma_f32_16x16x32_bf16(Bt[n][k], At[m][k], acc[ai][bj][m][n], 0, 0, 0); } __builtin_amdgcn_s_setprio(0); } while (0)
#define PG8_WAIT_V(n) asm volatile("s_waitcnt vmcnt(" #n ")" ::: "memory")
#define PG8_WAIT_L(n) asm volatile("s_waitcnt lgkmcnt(" #n ")" ::: "memory")
#define PG8_BAR __builtin_amdgcn_s_barrier()
#define PG8_SCHED __builtin_amdgcn_sched_barrier(0)
#define PG8_KBODY(t) do { \
            const bool last = (t == nt - 2); \
            const char* a1 = cA + (size_t)(t + 1) * kstep; \
            const char* a2 = last ? nA : cA + (size_t)(t + 2) * kstep; const char* b2 = last ? nB : cB + (size_t)(t + 2) * kstep; \
            const char* a3 = a2 + kstep; const char* b3 = b2 + kstep; \
 \
            PG8_LDB(B0, 0, 0); PG8_LDB(B1, 0, 1); PG8_SCHED; PG8_LDA(At, 0, 0); PG8_STAGE(PG8_SA(1, 1), a1 + hstepA, voffA); \
            PG8_WAIT_V(8); PG8_WAIT_L(0); PG8_BAR; PG8_MMA(0, 0, At, B0); PG8_MMA(0, 1, At, B1); PG8_BAR; PG8_SCHED; \
 \
            PG8_LDA(At, 0, 1); PG8_STAGE(PG8_SB(0, 0), b2, voffB); PG8_STAGE(PG8_SB(0, 1), b2 + hstepB, voffB); PG8_STAGE(PG8_SA(0, 0), a2, voffA); \
            PG8_WAIT_V(8); PG8_WAIT_L(0); PG8_BAR; PG8_MMA(1, 0, At, B0); PG8_MMA(1, 1, At, B1); PG8_BAR; PG8_SCHED; \
 \
            PG8_LDB(B0, 1, 0); PG8_LDB(B1, 1, 1); PG8_SCHED; PG8_LDA(At, 1, 0); PG8_STAGE(PG8_SA(0, 1), a2 + hstepA, voffA); \
            PG8_WAIT_V(8); PG8_WAIT_L(0); PG8_BAR; PG8_MMA(0, 0, At, B0); PG8_MMA(0, 1, At, B1); PG8_BAR; PG8_SCHED; \
 \
            PG8_LDA(At, 1, 1); PG8_STAGE(PG8_SB(1, 0), b3, voffB); PG8_STAGE(PG8_SB(1, 1), b3 + hstepB, voffB); PG8_STAGE(PG8_SA(1, 0), a3, voffA); \
            PG8_WAIT_V(8); PG8_WAIT_L(0); PG8_BAR; PG8_MMA(1, 0, At, B0); PG8_MMA(1, 1, At, B1); PG8_BAR; PG8_SCHED; \
        } while (0)
    Unit cur, nxt; int ui = 0;
    if (!S.next(0, cur)) return;
    f32x4 acc[2][2][4][2];
#pragma unroll
    for (int a = 0; a < 2; ++a)
#pragma unroll
        for (int b = 0; b < 2; ++b)
#pragma unroll
            for (int m = 0; m < 4; ++m)
#pragma unroll
                for (int n = 0; n < 2; ++n) acc[a][b][m][n] = (f32x4){0.f, 0.f, 0.f, 0.f};
    bf16x8 At[4][2], B0[2][2], B1[2][2]; v8i_t At8[4], B08[2], B18[2];
    const int sc127 = 127;
    const char* cA = (const char*)g.A + (size_t)cur.pm * tstepA; const char* cB = (const char*)g.Bt + (size_t)cur.pn * tstepB;
    PG8_STAGE(PG8_SB(0, 0), cB, voffB); PG8_STAGE(PG8_SB(0, 1), cB + hstepB, voffB); PG8_STAGE(PG8_SA(0, 0), cA, voffA); PG8_STAGE(PG8_SA(0, 1), cA + hstepA, voffA);
    if (wr == 1) PG8_BAR;
    PG8_WAIT_V(2); PG8_BAR;
    PG8_STAGE(PG8_SB(1, 0), cB + kstep, voffB); PG8_STAGE(PG8_SA(1, 0), cA + kstep, voffA); PG8_STAGE(PG8_SB(1, 1), cB + hstepB + kstep, voffB);
    PG8_WAIT_V(6); PG8_BAR;
    for (;;) {
        const bool has_next = S.next(ui + 1, nxt);
        const char* nA = has_next ? (const char*)g.A + (size_t)nxt.pm * tstepA : cA; const char* nB = has_next ? (const char*)g.Bt + (size_t)nxt.pn * tstepB : cB;
        if constexpr (Epi::MID) {
#pragma nounroll
            for (int t = 0; t < (nt >> 1); t += 2) PG8_KBODY(t);
            E.mid(acc, cur, wr, wc, fr, fq);
#pragma nounroll
            for (int t = (nt >> 1); t < nt; t += 2) PG8_KBODY(t);
        } else {
#pragma nounroll
            for (int t = 0; t < nt; t += 2) PG8_KBODY(t);
        }
        if (wr == 0) PG8_BAR;
        if constexpr (F8) asm volatile("s_nop 15\n\ts_nop 15" ::: "memory");
        E(acc, cur, wr, wc, fr, fq);
        if (!has_next) break;
#pragma unroll
        for (int a = 0; a < 2; ++a)
#pragma unroll
            for (int b = 0; b < 2; ++b)
#pragma unroll
                for (int m = 0; m < 4; ++m)
#pragma unroll
                    for (int n = 0; n < 2; ++n) acc[a][b][m][n] = (f32x4){0.f, 0.f, 0.f, 0.f};
        cur = nxt; cA = nA; cB = nB; ++ui;
        if (wr == 1) PG8_BAR;
    }
    PG8_WAIT_V(0);
    PG8_BAR;
#undef PG8_SA
#undef PG8_SB
#undef PG8_STAGE
#undef PG8_LDA
#undef PG8_KBODY
#undef PG8_LD8
#undef PG8_LDB
#undef PG8_MMA
#undef PG8_WAIT_V
#undef PG8_WAIT_L
#undef PG8_BAR
#undef PG8_SCHED
}
}

constexpr int NWAVES = 8;
constexpr int LDS_RING_BYTES = 131072, LDSCTL_OFF = 143360, MISC_OFF = LDSCTL_OFF + 320, LDS_BYTES = 147456;
#define LAS __attribute__((address_space(3)))
#define GAS __attribute__((address_space(1)))
typedef float f32x4 __attribute__((ext_vector_type(4)));
typedef unsigned v4u __attribute__((ext_vector_type(4)));
typedef unsigned v2u __attribute__((ext_vector_type(2)));
#define LDS_WAIT() asm volatile("s_waitcnt lgkmcnt(0)" ::: "memory")

constexpr int CW_BAR = 4096;
#define XB_TMO      128
#define XB_XCNT(j)  (256  + 64 * (j))
#define XB_XSUB(j)  (1280 + 64 * (j))
#define XB_XGEN(j)  (2304 + 64 * (j))
#define XB_TOP      3328
#define XB_TOPGEN   3392
#define XCD_BAR_WORDS 3456
#define XB_SPIN_CAP (1u << 20)
__device__ __forceinline__ unsigned xb_ld(unsigned* p)              { return __hip_atomic_load(p, __ATOMIC_RELAXED, __HIP_MEMORY_SCOPE_AGENT); }
__device__ __forceinline__ unsigned xb_add(unsigned* p, unsigned v) { return __hip_atomic_fetch_add(p, v, __ATOMIC_RELAXED, __HIP_MEMORY_SCOPE_AGENT); }
__device__ __forceinline__ unsigned xb_xcc_id() { return (unsigned)__builtin_amdgcn_s_getreg((3 << 11) | 20) & 0xFu; }
#define XB_SPIN(cond, bar) do { unsigned _sp = 0; while (cond) { __builtin_amdgcn_s_sleep(1); \
    if ((++_sp & 255u) == 0u) { if (xb_ld(&(bar)[XB_TMO])) break; if (_sp > XB_SPIN_CAP) { atomicAdd(&(bar)[XB_TMO], 1u); break; } } } } while (0)
struct XcdBarrier { unsigned* bar; unsigned x; volatile LAS unsigned* st; };
__device__ __forceinline__ XcdBarrier xcd_barrier_post(unsigned* bar, volatile LAS unsigned* st) {
    XcdBarrier b; b.bar = bar; b.x = xb_xcc_id(); b.st = st;
    if (threadIdx.x == 0) (void)xb_add(&bar[XB_XCNT(b.x)], 1u);
    return b;
}
__device__ __forceinline__ void xcd_barrier_complete(unsigned* bar, unsigned x, unsigned& nloc, unsigned& nx) {
    const unsigned G = gridDim.x * gridDim.y * gridDim.z;
    unsigned sum, cnt, mine, sp = 0u;
    for (;;) {
        sum = 0u; cnt = 0u; mine = 0u;
#pragma unroll
        for (unsigned j = 0; j < 16; ++j) { const unsigned c = xb_ld(&bar[XB_XCNT(j)]); sum += c; cnt += (c > 0u) ? 1u : 0u; mine = (j == x) ? c : mine; }
        if (sum == G) break;
        __builtin_amdgcn_s_sleep(1);
        if ((++sp & 255u) == 0u) { if (xb_ld(&bar[XB_TMO])) break; if (sp > XB_SPIN_CAP) { atomicAdd(&bar[XB_TMO], 1u); break; } }
    }
    nloc = mine > 0u ? mine : 1u; nx = cnt > 0u ? cnt : 1u;
}
__device__ __forceinline__ void xcd_barrier(const XcdBarrier& b) {
    asm volatile("s_waitcnt vmcnt(0)" ::: "memory");
    __syncthreads();
    if (threadIdx.x == 0) {
        unsigned* bar = b.bar;
        __builtin_amdgcn_s_waitcnt(0);
        unsigned nloc = b.st[0], nx = b.st[1];
        if (nloc == 0u) { xcd_barrier_complete(bar, b.x, nloc, nx); b.st[0] = nloc; b.st[1] = nx; }
        const unsigned old = xb_add(&bar[XB_XSUB(b.x)], 1u);
        const unsigned gen = old / nloc;
        if (old + 1u == (gen + 1u) * nloc) {
            __builtin_amdgcn_fence(__ATOMIC_RELEASE, "agent");
            asm volatile("s_waitcnt vmcnt(0)" ::: "memory");
            const unsigned og = xb_add(&bar[XB_TOP], 1u);
            const unsigned tg = og / nx;
            if (og + 1u == (tg + 1u) * nx) xb_add(&bar[XB_TOPGEN], 1u);
            else XB_SPIN(xb_ld(&bar[XB_TOPGEN]) == tg, bar);
            __builtin_amdgcn_fence(__ATOMIC_ACQUIRE, "agent");
            xb_add(&bar[XB_XGEN(b.x)], 1u);
            asm volatile("s_waitcnt vmcnt(0)" ::: "memory");
        } else {
            XB_SPIN(xb_ld(&bar[XB_XGEN(b.x)]) == gen, bar);
            __builtin_amdgcn_fence(__ATOMIC_ACQUIRE, "agent");
            asm volatile("s_waitcnt vmcnt(0)" ::: "memory");
        }
    }
    __syncthreads();
}

struct Args { const float* in[28]; float* out; unsigned char* ws; int ph_lo, ph_hi, li, pad; };

__device__ __forceinline__ void p0_transpose_item(const float* W, const float* sc, int K, int N, bf16_t* WT, LAS float* scr, int item, int lane, unsigned char* W8 = nullptr, int n8 = 0, int ldw = 0, int koff = 0) {
    if (ldw == 0) ldw = K;
    const int nblk = N / 32, kb = item / nblk, nb = item % nblk, k0 = 64 * kb, n0 = 32 * nb;
#pragma unroll 8
    for (int i = 0; i < 32; ++i) { const int kk = 2 * i + (lane >> 5); const float s = sc ? sc[k0 + kk] : 1.f; scr[kk * 33 + (lane & 31)] = W[(size_t)(k0 + kk) * N + n0 + (lane & 31)] * s; }
    LDS_WAIT(); asm volatile("" ::: "memory");
    const int c = lane & 7;
#pragma unroll
    for (int j = 0; j < 4; ++j) { const int n = (lane >> 3) + 8 * j; const LAS float* s = scr + (8 * c) * 33 + n;
        v4u o; o.x = pg8::cvt_pk_bf16(s[0 * 33], s[1 * 33]); o.y = pg8::cvt_pk_bf16(s[2 * 33], s[3 * 33]); o.z = pg8::cvt_pk_bf16(s[4 * 33], s[5 * 33]); o.w = pg8::cvt_pk_bf16(s[6 * 33], s[7 * 33]);
        *(v4u*)(WT + (size_t)(n0 + n) * ldw + koff + k0 + 8 * c) = o;
        if (W8 && n0 + n >= n8) {
            int p0 = 0, p1 = 0;
            p0 = __builtin_amdgcn_cvt_pk_fp8_f32(s[0 * 33] * 32.f, s[1 * 33] * 32.f, p0, false); p0 = __builtin_amdgcn_cvt_pk_fp8_f32(s[2 * 33] * 32.f, s[3 * 33] * 32.f, p0, true);
            p1 = __builtin_amdgcn_cvt_pk_fp8_f32(s[4 * 33] * 32.f, s[5 * 33] * 32.f, p1, false); p1 = __builtin_amdgcn_cvt_pk_fp8_f32(s[6 * 33] * 32.f, s[7 * 33] * 32.f, p1, true);
            *(v2u*)(W8 + (size_t)(n0 + n - n8) * K + k0 + 8 * c) = (v2u){(unsigned)p0, (unsigned)p1};
        } }
    LDS_WAIT(); asm volatile("" ::: "memory");
}
typedef unsigned v6u_t __attribute__((ext_vector_type(6)));
typedef unsigned v3u_t __attribute__((ext_vector_type(3)));
typedef float v16f_t __attribute__((ext_vector_type(16)));
typedef float v32f_t __attribute__((ext_vector_type(32)));
__device__ __forceinline__ void p0_row_fp6(const float* in, const float* cs, unsigned char* out, float* sc, int lane) {
    f32x4 v[4]; float mx = 0.f;
#pragma unroll
    for (int i = 0; i < 4; ++i) { v[i] = *(const f32x4*)(in + lane * 16 + 4 * i); if (cs) v[i] = v[i] * *(const f32x4*)(cs + lane * 16 + 4 * i);
        mx = fmaxf(mx, fmaxf(fmaxf(fabsf(v[i][0]), fabsf(v[i][1])), fmaxf(fabsf(v[i][2]), fabsf(v[i][3])))); }
#pragma unroll
    for (int o = 1; o < 64; o <<= 1) mx = fmaxf(mx, __shfl_xor(mx, o));
    mx = fmaxf(mx, 1e-30f);
    const float q = 7.5f / mx;
    v16f_t a, b;
#pragma unroll
    for (int i = 0; i < 16; ++i) { a[i] = 0.f; b[i] = 0.f; }
#pragma unroll
    for (int i = 0; i < 8; ++i) { a[i] = v[(2 * i) >> 2][(2 * i) & 3] * q; b[i] = v[(2 * i + 1) >> 2][(2 * i + 1) & 3] * q; }
    const v6u_t p = __builtin_amdgcn_cvt_scalef32_2xpk16_fp6_f32(a, b, 1.0f);
    *(v3u_t*)(out + lane * 12) = (v3u_t){p[0], p[1], p[2]};
    if (lane == 0) *sc = mx * (1.f / 7.5f);
}
__device__ __forceinline__ void p0_convert(const float* in, const float* cs, bf16_t* out, size_t n, int gw, int NGW, int lane) {
    for (size_t i = ((size_t)gw * 64 + lane) * 8; i < n; i += (size_t)NGW * 512) {
        f32x4 a = *(const f32x4*)(in + i), b = *(const f32x4*)(in + i + 4);
        if (cs) { const int c = (int)(i & 1023); a = a * *(const f32x4*)(cs + c); b = b * *(const f32x4*)(cs + c + 4); }
        v4u o; o.x = pg8::cvt_pk_bf16(a[0], a[1]); o.y = pg8::cvt_pk_bf16(a[2], a[3]); o.z = pg8::cvt_pk_bf16(b[0], b[1]); o.w = pg8::cvt_pk_bf16(b[2], b[3]);
        *(v4u*)(out + i) = o;
    }
}

namespace da {
typedef short bf16x8 __attribute__((ext_vector_type(8)));
typedef short s16x4 __attribute__((ext_vector_type(4)));
typedef float f32x16 __attribute__((ext_vector_type(16)));
typedef const LAS unsigned char* lcp;
constexpr float LOG2E = 1.4426950408889634f, C2 = 0.125f * LOG2E, THR = 8.f;
constexpr int RSLOT = 16384, LDS_KR = 0, LDS_VR = 4 * RSLOT, SCR_OFF = 8 * RSLOT, COMB_OFF = 0;
#define DA_SBAR() __builtin_amdgcn_sched_barrier(0)
#define DA_PIN(x) asm volatile("" : "+v"(x))
#define DA_MFMA(a, b, c) __builtin_amdgcn_mfma_f32_32x32x16_bf16(a, b, c, 0, 0, 0)
#define DA_WAIT_BAR(N) asm volatile("s_waitcnt vmcnt(" #N ") lgkmcnt(0)\n\ts_barrier" ::: "memory")
#define DA_MX3(a, b, c) __builtin_fmaxf(__builtin_fmaxf((a), (b)), (c))
__device__ __forceinline__ int crow(int r, int hi) { return (r & 3) + 8 * (r >> 2) + 4 * hi; }
__device__ __forceinline__ s16x4 vtr(lcp p) { return __builtin_bit_cast(s16x4, __builtin_amdgcn_ds_read_tr16_b64_v4i16((LAS s16x4*)p)); }
__device__ __forceinline__ unsigned cvtpk(float lo, float hi) { unsigned r; asm("v_cvt_pk_bf16_f32 %0, %1, %2" : "=v"(r) : "v"(lo), "v"(hi)); return r; }
__device__ __forceinline__ void glds16(const void* g, unsigned lds_base) {
    unsigned sv; asm volatile("s_mov_b32 %0, m0\n\ts_mov_b32 m0, %2\n\ts_nop 0\n\tglobal_load_lds_dwordx4 %1, off\n\ts_mov_b32 m0, %0" : "=&s"(sv) : "v"(g), "s"(lds_base) : "memory"); }
__device__ __forceinline__ void glds16_o128(const void* g, unsigned lds_base) {
    unsigned sv; asm volatile("s_mov_b32 %0, m0\n\ts_mov_b32 m0, %2\n\ts_nop 0\n\tglobal_load_lds_dwordx4 %1, off offset:128\n\ts_mov_b32 m0, %0" : "=&s"(sv) : "v"(g), "s"(lds_base) : "memory"); }
__device__ __forceinline__ void kload2(bf16x8* kf, lcp kp, int d0) { kf[2 * d0] = *(const LAS bf16x8*)(kp + d0 * 2048); kf[2 * d0 + 1] = *(const LAS bf16x8*)(kp + d0 * 2048 + 512); }
__device__ __forceinline__ float max16(const f32x16& p) {
    float a = DA_MX3(p[0], p[1], p[2]), b = DA_MX3(p[3], p[4], p[5]); a = DA_MX3(a, p[6], p[7]); b = DA_MX3(b, p[8], p[9]); a = DA_MX3(a, p[10], p[11]); b = DA_MX3(b, p[12], p[13]);
    a = DA_MX3(a, p[14], p[15]); return __builtin_fmaxf(a, b); }
__device__ __forceinline__ float rowmax(const f32x16& p0, const f32x16& p1, float offA, float offB) {
    const float m = __builtin_fmaxf(__builtin_fmaf(max16(p0), C2, offA), __builtin_fmaf(max16(p1), C2, offB));
    auto rr = __builtin_amdgcn_permlane32_swap(__float_as_uint(m), __float_as_uint(m), false, false);
    return __builtin_fmaxf(__uint_as_float(rr[0]), __uint_as_float(rr[1])); }
__device__ __forceinline__ void cmask(f32x16& p0, f32x16& p1, int jb, int qrel, int hi) {
    const int kb = 64 * jb + 4 * hi;
#pragma unroll
    for (int r = 0; r < 16; ++r) { const int kv = kb + (r & 3) + 8 * (r >> 2); if (kv > qrel) p0[r] = -INFINITY; if (kv + 32 > qrel) p1[r] = -INFINITY; } }

__device__ __forceinline__ void attn_epilogue_body(LAS unsigned char* lds, f32x16 (&o)[4], float l_reg, bf16_t* __restrict__ yb, const float* __restrict__ subln_w, float lam,
                                                   size_t rowb, int q0, int h, int wave, int lane) {
    asm volatile("" : "+v"(lane));
    const int r32 = lane & 31, hi = lane >> 5, map = wave >> 2, qs = wave & 3;
    LAS float* wsf = (LAS float*)(lds + SCR_OFF) + wave * 64;
    if (hi == 0) wsf[r32] = __builtin_amdgcn_rcpf(l_reg);
    float il[16];
#pragma unroll
    for (int g = 0; g < 4; ++g) { const f32x4 t4 = *(const LAS f32x4*)(wsf + 8 * g + 4 * hi); il[4 * g] = t4[0]; il[4 * g + 1] = t4[1]; il[4 * g + 2] = t4[2]; il[4 * g + 3] = t4[3]; }
    __syncthreads();
    LAS float* comb = (LAS float*)(lds + COMB_OFF) + qs * 4096;
    if (map == 1) {
#pragma unroll
        for (int d = 0; d < 4; ++d)
#pragma unroll
            for (int r = 0; r < 16; ++r) comb[crow(r, hi) * 128 + 32 * d + r32] = o[d][r] * il[r];
    }
    __syncthreads();
    if (map == 0) {
        float sw[4];
#pragma unroll
        for (int d = 0; d < 4; ++d) sw[d] = subln_w[32 * d + r32] * (1.f - LAM_INIT);
#pragma unroll
        for (int r = 0; r < 16; ++r) {
            float v[4], ss = 0.f;
#pragma unroll
            for (int d = 0; d < 4; ++d) { v[d] = o[d][r] * il[r] - lam * comb[crow(r, hi) * 128 + 32 * d + r32]; ss += v[d] * v[d]; }
            ss += __shfl_xor(ss, 1); ss += __shfl_xor(ss, 2); ss += __shfl_xor(ss, 4); ss += __shfl_xor(ss, 8); ss += __shfl_xor(ss, 16);
            const float rs = rsqrtf(ss * (1.f / 128.f) + SUBLN_EPS);
            bf16_t* op = yb + (rowb + q0 + crow(r, hi)) * YAB_PITCH + h * 128 + r32;
#pragma unroll
            for (int d = 0; d < 4; ++d) op[32 * d] = f2bf(v[d] * rs * sw[d]);
        }
    }
    __syncthreads();
}
__device__ __forceinline__ void attn_unit(LAS unsigned char* lds, const bf16_t* __restrict__ z, bf16_t* __restrict__ yb, const float* __restrict__ subln_w, float lam,
                                          int b, int h, int qblk, int wave_, int lane) {
    const int wave = __builtin_amdgcn_readfirstlane(wave_);
    const int r32 = lane & 31, hi = lane >> 5, map = wave >> 2, qs = wave & 3;
    const int q0 = qblk * 128 + qs * 32, NT = 2 * qblk + 2, qrel = qs * 32 + r32;
    const size_t rowb = (size_t)b * SEQ;
    const float slope = exp2f(-2.f * (float)(h + 1)), slope2 = slope * LOG2E, s64 = 64.f * slope2, s32 = 32.f * slope2;
    const unsigned lds0 = (unsigned)(uintptr_t)lds;
    LAS float* wsf = (LAS float*)(lds + SCR_OFF) + wave * 64;
    const bf16_t* ksrc = z + (rowb + lane) * NZ + C_ZK + h * 128 + wave * 8;
    const int pc0 = 2 * wave;
    const bf16_t* vsrc0 = z + (rowb + 16 * (pc0 & 3) + (lane >> 2)) * NZ + C_ZV + h * 128 + 32 * (pc0 >> 2) + (lane & 3) * 8;
    const unsigned kdst = lds0 + LDS_KR + wave * 1024, vdst = lds0 + LDS_VR + pc0 * 1024;
#define DMA_K(t, slot) do { const bf16_t* k_ = ksrc + (size_t)(t) * 64 * NZ; const unsigned d_ = (unsigned)__builtin_amdgcn_readfirstlane(kdst + (slot)); glds16(k_, d_); glds16_o128(k_, d_ + 8192 - 128); } while (0)
#define DMA_V(t, slot) do { const size_t o_ = (size_t)(t) * 64 * NZ; const unsigned d_ = (unsigned)__builtin_amdgcn_readfirstlane(vdst + (slot)); glds16(vsrc0 + o_, d_); glds16(vsrc0 + o_ + 16 * NZ, d_ + 1024); } while (0)
    const lcp vp0 = lds + LDS_VR + ((lane >> 4) & 1) * 32 + (lane & 3) * 8 + (4 * hi + ((lane & 15) >> 2)) * 64;
    const lcp kp0 = lds + LDS_KR + map * 8192 + hi * 1024 + r32 * 16;
    DMA_K(0, 0); DMA_V(0, 0); DMA_K(1, RSLOT);
    bf16x8 qr[4];
    {
        const bf16_t* qp = z + (rowb + q0 + r32) * NZ + C_Q + h * 128 + map * 64 + hi * 8;
#pragma unroll
        for (int d0 = 0; d0 < 4; ++d0) qr[d0] = *(const bf16x8*)(qp + d0 * 16);
    }
    f32x16 bias16;
#pragma unroll
    for (int r = 0; r < 16; ++r) bias16[r] = (8.f * slope) * (float)((r & 3) + 8 * (r >> 2));
    DA_PIN(bias16);
    float mhat = 0.f, l_reg = 0.f, offA = slope2 * (float)(4 * hi);
    f32x16 o[4];
#pragma unroll
    for (int d = 0; d < 4; ++d) o[d] = (f32x16){};
    bool resc = false;
    f32x16 c0, c1; bf16x8 kf[8]; s16x4 vlo[4], vhi[4]; v4u pw0, pw1, pw2, pw3;
#define SL(t) ((((t)) & 3) * RSLOT)
#define EX(v, nm) __builtin_amdgcn_exp2f(__builtin_fmaf((v), C2, (nm)))
#define RESC() do { if (resc) { _Pragma("unroll") for (int d_ = 0; d_ < 4; ++d_) _Pragma("unroll") for (int r = 0; r < 16; ++r) o[d_][r] *= wsf[crow(r, hi)]; } } while (0)
#define PKW(P, i) pg8::cvt_pk_bf16(P[i], P[(i) + 1])
    DMA_K(2, 2 * RSLOT); DMA_K(3, 3 * RSLOT); DMA_V(1, RSLOT);
    DA_WAIT_BAR(10);
#pragma unroll
    for (int d0 = 0; d0 < 4; ++d0) kload2(kf, kp0, d0);
    c0 = DA_MFMA(kf[0], qr[0], bias16); c1 = DA_MFMA(kf[1], qr[0], bias16); c0 = DA_MFMA(kf[2], qr[1], c0); c1 = DA_MFMA(kf[3], qr[1], c1);
    c0 = DA_MFMA(kf[4], qr[2], c0); c1 = DA_MFMA(kf[5], qr[2], c1); c0 = DA_MFMA(kf[6], qr[3], c0); c1 = DA_MFMA(kf[7], qr[3], c1);
    if (NT == 2) cmask(c0, c1, 0, qrel, hi);
    { mhat = rowmax(c0, c1, offA, offA + s32); const float nmh0 = offA - mhat, nmh1 = nmh0 + s32; float sacc = 0.f;
#pragma unroll
      for (int r = 0; r < 16; ++r) { c0[r] = EX(c0[r], nmh0); c1[r] = EX(c1[r], nmh1); sacc += c0[r] + c1[r]; }
      l_reg = sacc; }
    pw0 = (v4u){PKW(c0, 0), PKW(c0, 2), PKW(c0, 4), PKW(c0, 6)}; pw1 = (v4u){PKW(c0, 8), PKW(c0, 10), PKW(c0, 12), PKW(c0, 14)};
    pw2 = (v4u){PKW(c1, 0), PKW(c1, 2), PKW(c1, 4), PKW(c1, 6)}; pw3 = (v4u){PKW(c1, 8), PKW(c1, 10), PKW(c1, 12), PKW(c1, 14)};
    DA_WAIT_BAR(6);
    DMA_K(4, 0); DMA_V(2, 2 * RSLOT);
#pragma unroll
    for (int d0 = 0; d0 < 4; ++d0) kload2(kf, kp0 + RSLOT, d0);
    if (NT == 2) { DA_WAIT_BAR(0); } else { DA_WAIT_BAR(8); }
#define PAF(k) __builtin_bit_cast(bf16x8, pw##k)
#define VFR(i) (bf16x8){vlo[(i) & 3][0], vlo[(i) & 3][1], vlo[(i) & 3][2], vlo[(i) & 3][3], vhi[(i) & 3][0], vhi[(i) & 3][1], vhi[(i) & 3][2], vhi[(i) & 3][3]}
#define VOFF(i) ((((i) & 3) * 4 + ((i) >> 2)) * 1024)
#define VRD(i) do { vlo[(i) & 3] = vtr(vp_ + VOFF(i)); vhi[(i) & 3] = vtr(vp_ + VOFF(i) + 512); DA_SBAR(); } while (0)
#define KRD(G, d0) do { if (G) { kload2(kf, kp0 + sl_next_, d0); DA_SBAR(); } } while (0)
#define GAPA(MF) do { MF; DA_SBAR(); } while (0)
#define GAPB(MF, X, i, nm, A0, A1, EXTRA) do { MF; X[i] = EX(X[i], nm); X[(i) + 1] = EX(X[(i) + 1], nm); sacc += A0; sacc += A1; EXTRA; DA_PIN(X); DA_PIN(sacc); DA_SBAR(); } while (0)
#define STEP(t, MASK, GK, GV, GL) do { DA_SBAR(); \
    const lcp vp_ = vp0 + SL((t) - 1); const int sl_next_ = SL((t) + 1); \
            GAPA(c0 = DA_MFMA(kf[0], qr[0], bias16)); GAPA(c1 = DA_MFMA(kf[1], qr[0], bias16)); GAPA(c0 = DA_MFMA(kf[2], qr[1], c0)); GAPA(c1 = DA_MFMA(kf[3], qr[1], c1)); \
    VRD(0); GAPA(c0 = DA_MFMA(kf[4], qr[2], c0)); VRD(1); GAPA(c1 = DA_MFMA(kf[5], qr[2], c1)); VRD(2); GAPA(c0 = DA_MFMA(kf[6], qr[3], c0)); VRD(3); GAPA(c1 = DA_MFMA(kf[7], qr[3], c1)); \
    offA += s64; \
    if (GK) DMA_K((t) + 4, SL(t)); if (GV) DMA_V((t) + 2, SL((t) + 2)); \
    if (MASK) cmask(c0, c1, (t) - (NT - 2), qrel, hi); \
    { const float rm = rowmax(c0, c1, offA, offA + s32) - mhat; resc = false; \
      if (__builtin_expect(__any(rm > THR), 0)) { const float dl = __builtin_fmaxf(rm, 0.f); mhat += dl; \
          const float f = __builtin_amdgcn_exp2f(-dl); l_reg *= f; if (hi == 0) wsf[r32] = f; resc = true; } } \
    const float nmh0 = offA - mhat, nmh1 = nmh0 + s32; float sacc = 0.f; DA_SBAR(); \
    GAPB(o[0] = DA_MFMA(PAF(0), VFR(0), o[0]), c0, 0, nmh0, 0.f, 0.f, );             VRD(4); \
    GAPB(o[1] = DA_MFMA(PAF(0), VFR(1), o[1]), c0, 2, nmh0, c0[0], c0[1], );         VRD(5); \
    GAPB(o[2] = DA_MFMA(PAF(0), VFR(2), o[2]), c0, 4, nmh0, c0[2], c0[3], );         VRD(6); \
    GAPB(o[3] = DA_MFMA(PAF(0), VFR(3), o[3]), c0, 6, nmh0, c0[4], c0[5], );         VRD(7); \
    GAPB(o[0] = DA_MFMA(PAF(1), VFR(4), o[0]), c0, 8, nmh0, c0[6], c0[7], pw0[0] = PKW(c0, 0); pw0[1] = PKW(c0, 2); DA_PIN(pw0));    VRD(8); \
    GAPB(o[1] = DA_MFMA(PAF(1), VFR(5), o[1]), c0, 10, nmh0, c0[8], c0[9], pw0[2] = PKW(c0, 4); pw0[3] = PKW(c0, 6); DA_PIN(pw0));   VRD(9); \
    GAPB(o[2] = DA_MFMA(PAF(1), VFR(6), o[2]), c0, 12, nmh0, c0[10], c0[11], );      VRD(10); \
    GAPB(o[3] = DA_MFMA(PAF(1), VFR(7), o[3]), c0, 14, nmh0, c0[12], c0[13], );      VRD(11); \
    GAPB(o[0] = DA_MFMA(PAF(2), VFR(8), o[0]), c1, 0, nmh1, c0[14], c0[15], pw1[0] = PKW(c0, 8); pw1[1] = PKW(c0, 10); DA_PIN(pw1));  VRD(12); \
    GAPB(o[1] = DA_MFMA(PAF(2), VFR(9), o[1]), c1, 2, nmh1, c1[0], c1[1], pw1[2] = PKW(c0, 12); pw1[3] = PKW(c0, 14); DA_PIN(pw1));   VRD(13); \
    GAPB(o[2] = DA_MFMA(PAF(2), VFR(10), o[2]), c1, 4, nmh1, c1[2], c1[3], );        VRD(14); \
    GAPB(o[3] = DA_MFMA(PAF(2), VFR(11), o[3]), c1, 6, nmh1, c1[4], c1[5], );        VRD(15); \
    GAPB(o[0] = DA_MFMA(PAF(3), VFR(12), o[0]), c1, 8, nmh1, c1[6], c1[7], pw2[0] = PKW(c1, 0); pw2[1] = PKW(c1, 2); DA_PIN(pw2));   KRD(GL, 0); \
    GAPB(o[1] = DA_MFMA(PAF(3), VFR(13), o[1]), c1, 10, nmh1, c1[8], c1[9], pw2[2] = PKW(c1, 4); pw2[3] = PKW(c1, 6); DA_PIN(pw2));  KRD(GL, 1); \
    GAPB(o[2] = DA_MFMA(PAF(3), VFR(14), o[2]), c1, 12, nmh1, c1[10], c1[11], );     KRD(GL, 2); \
    GAPB(o[3] = DA_MFMA(PAF(3), VFR(15), o[3]), c1, 14, nmh1, c1[12], c1[13], );     KRD(GL, 3); \
    sacc += c1[14]; sacc += c1[15]; l_reg += sacc; \
    pw3[0] = PKW(c1, 8); pw3[1] = PKW(c1, 10); pw3[2] = PKW(c1, 12); pw3[3] = PKW(c1, 14); DA_PIN(pw3); \
    } while (0)
#define ENDW(tt) do { if ((tt) + 4 < NT) { DA_WAIT_BAR(8); } else if ((tt) + 3 < NT) { DA_WAIT_BAR(6); } else if ((tt) + 2 < NT) { DA_WAIT_BAR(4); } else { DA_WAIT_BAR(0); } } while (0)
    int t = 1;
    for (; t + 4 < NT; ++t) {
        STEP(t, false, true, true, true); DA_WAIT_BAR(8); RESC();
    }
    for (; t + 1 < NT; ++t) {
        STEP(t, true, (t + 4 < NT), (t + 2 < NT), (t + 1 < NT)); ENDW(t); RESC();
    }
    STEP(NT - 1, true, false, false, false); RESC();
    { const lcp vp_ = vp0 + SL(NT - 1);
#define DRN(k, i) do { const s16x4 lo_ = vtr(vp_ + VOFF(i)), hh_ = vtr(vp_ + VOFF(i) + 512); \
        o[(i) & 3] = DA_MFMA(PAF(k), ((bf16x8){lo_[0], lo_[1], lo_[2], lo_[3], hh_[0], hh_[1], hh_[2], hh_[3]}), o[(i) & 3]); } while (0)
      DRN(0, 0); DRN(0, 1); DRN(0, 2); DRN(0, 3); DRN(1, 4); DRN(1, 5); DRN(1, 6); DRN(1, 7); DRN(2, 8); DRN(2, 9); DRN(2, 10); DRN(2, 11); DRN(3, 12); DRN(3, 13); DRN(3, 14); DRN(3, 15);
#undef DRN
    }
#undef DMA_K
#undef DMA_V
#undef SL
#undef EX
#undef RESC
#undef PKW
#undef PAF
#undef VFR
#undef VOFF
#undef VRD
#undef KRD
#undef GAPA
#undef GAPB
#undef STEP
#undef ENDW
    { auto rr = __builtin_amdgcn_permlane32_swap(__float_as_uint(l_reg), __float_as_uint(l_reg), false, false); l_reg = __uint_as_float(rr[0]) + __uint_as_float(rr[1]); }
    attn_epilogue_body(lds, o, l_reg, yb, subln_w, lam, rowb, q0, h, wave, lane);
}
}

namespace rw {
typedef short bf16x8 __attribute__((ext_vector_type(8)));
typedef float f32x2 __attribute__((ext_vector_type(2)));
typedef short s16x4 __attribute__((ext_vector_type(4)));
constexpr int CH = 32, ACT_PITCH = 528;
constexpr int OFF_HAT = 41472, HAT_PITCH = 144, HAT_SZ = 32 * HAT_PITCH, OFF_TIL = OFF_HAT + 4 * HAT_SZ, TIL_PITCH = 40, TIL_SZ = 64 * TIL_PITCH, OFF_GR = OFF_TIL + 4 * TIL_SZ, OFF_WC = OFF_GR + 10 * 1024;
constexpr int OFF_ACT = 0, OFF_RKV = 16896, OFF_VEC = 41472, OFF_G = 82432, OFF_Y = 90624, OFF_NRM = 98816, OFF_SCL = 99328, OFF_CT = 99840, OFF_SCP = 102400;
template <int CTRL> __device__ __forceinline__ float dppf(float x) { return __builtin_bit_cast(float, __builtin_amdgcn_mov_dpp(__builtin_bit_cast(int, x), CTRL, 0xf, 0xf, true)); }
__device__ __forceinline__ float row_allsum(float v) { v += dppf<0x128>(v); v += dppf<0x124>(v); v += dppf<0x122>(v); v += dppf<0x121>(v); return v; }
__device__ __forceinline__ void row_allsum4(float& a, float& b, float& c, float& d) {
#define RW_DPP4(n) "v_add_f32_dpp %0, %0, %0 row_ror:" #n " row_mask:0xf bank_mask:0xf\n\tv_add_f32_dpp %1, %1, %1 row_ror:" #n " row_mask:0xf bank_mask:0xf\n\t" \
                   "v_add_f32_dpp %2, %2, %2 row_ror:" #n " row_mask:0xf bank_mask:0xf\n\tv_add_f32_dpp %3, %3, %3 row_ror:" #n " row_mask:0xf bank_mask:0xf\n\t"
    asm volatile("s_nop 1\n\t" RW_DPP4(8) RW_DPP4(4) RW_DPP4(2) RW_DPP4(1) "s_nop 1" : "+v"(a), "+v"(b), "+v"(c), "+v"(d));
#undef RW_DPP4
}
__device__ __forceinline__ f32x4 ld4bf(const bf16_t* p) { const v2u w = *(const v2u*)p; return (f32x4){pg8::bflo(w.x), pg8::bfhi(w.x), pg8::bflo(w.y), pg8::bfhi(w.y)}; }
__device__ __forceinline__ float fsig(float x) { return __builtin_amdgcn_rcpf(1.f + __expf(-x)); }
__device__ __forceinline__ float ftanh(float x) { return 1.f - 2.f * __builtin_amdgcn_rcpf(1.f + __expf(2.f * x)); }
struct ZRow { v2u r, k, v, w, a; v4u g; };
__device__ __forceinline__ ZRow ldrow(const bf16_t* zr, int c4, int cg) {
    ZRow o; o.r = *(const v2u*)(zr + C_R + c4); o.k = *(const v2u*)(zr + C_K + c4); o.v = *(const v2u*)(zr + C_V + c4); o.w = *(const v2u*)(zr + C_WL + 4 * cg); o.a = *(const v2u*)(zr + C_AL + 4 * cg);
    o.g = *(const v4u*)(zr + C_GL + 8 * cg); return o;
}
__device__ __forceinline__ f32x4 up4(v2u w) { return (f32x4){pg8::bflo(w.x), pg8::bfhi(w.x), pg8::bflo(w.y), pg8::bfhi(w.y)}; }

struct ScanP { const float *mu, *w0, *w2, *a0, *a2, *g2, *k_k, *k_a, *r_k, *lnx_w, *lnx_b; };
__device__ __forceinline__ void scan_unit(LAS unsigned char* lds, const bf16_t* __restrict__ z, bf16_t* __restrict__ ya, const ScanP P, int b, int h, int tid, int wave, int lane) {
    asm volatile("" : "+v"(tid)); lane = tid & 63;
    const float* mu = P.mu; const float* w0 = P.w0; const float* w2 = P.w2; const float* a0 = P.a0; const float* a2 = P.a2; const float* g2 = P.g2;
    const float* k_k = P.k_k; const float* k_a = P.k_a; const float* r_k = P.r_k; const float* lnx_w = P.lnx_w; const float* lnx_b = P.lnx_b;
    const size_t rowb = (size_t)b * SEQ;
    const int tl = tid >> 4, cg = tid & 15;
    const int nt = wave & 3, rl = lane & 15, rg = lane >> 4;
    LAS float* rkv = (LAS float*)(lds + OFF_RKV); LAS float* vec = (LAS float*)(lds + OFF_VEC); LAS float* gbuf = (LAS float*)(lds + OFF_G);
    LAS float* ybuf = (LAS float*)(lds + OFF_Y); LAS float* nrm = (LAS float*)(lds + OFF_NRM); LAS float* scl = (LAS float*)(lds + OFF_SCL); LAS float* scp = (LAS float*)(lds + OFF_SCP);
    bf16x8 bfr[8];
    {
        const int col = h * 64 + 16 * nt + rl;
#pragma unroll
        for (int f = 0; f < 8; ++f) {
            const float* src = (f < 2) ? w2 : (f < 4) ? a2 : g2;
            const int kb = ((f < 4) ? 32 * (f & 1) : 32 * (f - 4)) + 8 * rg;
            float e[8];
#pragma unroll
            for (int j = 0; j < 8; ++j) e[j] = src[(size_t)(kb + j) * 512 + col];
            v4u p; p.x = pg8::cvt_pk_bf16(e[0], e[1]); p.y = pg8::cvt_pk_bf16(e[2], e[3]); p.z = pg8::cvt_pk_bf16(e[4], e[5]); p.w = pg8::cvt_pk_bf16(e[6], e[7]);
            bfr[f] = __builtin_bit_cast(bf16x8, p);
            __builtin_amdgcn_sched_barrier(0);
        }
    }
    const int mt = wave >> 2;
    const int hc = h * 64 + 16 * nt + rl;
    const float w0c = w0[hc], a0c = a0[hc], kkc = k_k[hc], kac = k_a[hc], rkc = r_k[hc];
    const int c4 = h * 64 + 4 * cg;
    f32x4 ST[4];
#pragma unroll
    for (int i = 0; i < 4; ++i) ST[i] = (f32x4){0.f, 0.f, 0.f, 0.f};
    LAS float* ctab = (LAS float*)(lds + OFF_CT);
    if (tl == 0) {
        LAS float* ct = ctab + cg * 36;
        *(LAS f32x4*)(ct + 0) = *(const f32x4*)(mu + C_R + c4); *(LAS f32x4*)(ct + 4) = *(const f32x4*)(mu + C_K + c4); *(LAS f32x4*)(ct + 8) = *(const f32x4*)(mu + C_V + c4);
        *(LAS f32x4*)(ct + 12) = *(const f32x4*)(mu + C_WL + 4 * cg); *(LAS f32x4*)(ct + 16) = *(const f32x4*)(mu + C_AL + 4 * cg);
        *(LAS f32x4*)(ct + 20) = *(const f32x4*)(mu + C_GL + 8 * cg); *(LAS f32x4*)(ct + 24) = *(const f32x4*)(mu + C_GL + 8 * cg + 4);
        *(LAS f32x4*)(ct + 28) = *(const f32x4*)(lnx_w + c4); *(LAS f32x4*)(ct + 32) = *(const f32x4*)(lnx_b + c4);
    }
    __syncthreads();
    const LAS float* myct = ctab + cg * 36;
    ZRow zc = ldrow(z + (rowb + tl) * NZ, c4, cg), zp;
    if (tl > 0) zp = ldrow(z + (rowb + tl - 1) * NZ, c4, cg); else { zp.r = zp.k = zp.v = zp.w = zp.a = (v2u){0u, 0u}; zp.g = (v4u){0u, 0u, 0u, 0u}; }
    for (int t0 = 0; t0 < SEQ; t0 += CH) {
        {
            const f32x4 cr = up4(zc.r), ck = up4(zc.k), cv = up4(zc.v), cw = up4(zc.w), ca = up4(zc.a);
            const f32x4 cg0 = (f32x4){pg8::bflo(zc.g.x), pg8::bfhi(zc.g.x), pg8::bflo(zc.g.y), pg8::bfhi(zc.g.y)}, cg1 = (f32x4){pg8::bflo(zc.g.z), pg8::bfhi(zc.g.z), pg8::bflo(zc.g.w), pg8::bfhi(zc.g.w)};
            const f32x4 pr = up4(zp.r), pk = up4(zp.k), pv = up4(zp.v), pw = up4(zp.w), pa = up4(zp.a);
            const f32x4 pg0 = (f32x4){pg8::bflo(zp.g.x), pg8::bfhi(zp.g.x), pg8::bflo(zp.g.y), pg8::bfhi(zp.g.y)}, pg1 = (f32x4){pg8::bflo(zp.g.z), pg8::bfhi(zp.g.z), pg8::bflo(zp.g.w), pg8::bfhi(zp.g.w)};
            if (t0 + CH < SEQ) { zc = ldrow(z + (rowb + t0 + CH + tl) * NZ, c4, cg); zp = ldrow(z + (rowb + t0 + CH + tl - 1) * NZ, c4, cg); }
            const f32x4 rs_ = cr + (pr - cr) * *(const LAS f32x4*)(myct + 0), ks_ = ck + (pk - ck) * *(const LAS f32x4*)(myct + 4), vs_ = cv + (pv - cv) * *(const LAS f32x4*)(myct + 8);
            const f32x4 ws_ = cw + (pw - cw) * *(const LAS f32x4*)(myct + 12), as_ = ca + (pa - ca) * *(const LAS f32x4*)(myct + 16);
            const f32x4 g0_ = cg0 + (pg0 - cg0) * *(const LAS f32x4*)(myct + 20), g1_ = cg1 + (pg1 - cg1) * *(const LAS f32x4*)(myct + 24);
            *(LAS f32x4*)(rkv + 0 * 2048 + tl * 64 + 4 * cg) = rs_; *(LAS f32x4*)(rkv + 1 * 2048 + tl * 64 + 4 * cg) = ks_; *(LAS f32x4*)(rkv + 2 * 2048 + tl * 64 + 4 * cg) = vs_;
            LAS unsigned char* ar = lds + OFF_ACT + tl * ACT_PITCH;
            v2u tw; tw.x = pg8::cvt_pk_bf16(ftanh(ws_[0]), ftanh(ws_[1])); tw.y = pg8::cvt_pk_bf16(ftanh(ws_[2]), ftanh(ws_[3]));
            *(LAS v2u*)(ar + 8 * cg) = tw;
            v2u aw; aw.x = pg8::cvt_pk_bf16(as_[0], as_[1]); aw.y = pg8::cvt_pk_bf16(as_[2], as_[3]);
            *(LAS v2u*)(ar + 128 + 8 * cg) = aw;
            v4u gw; gw.x = pg8::cvt_pk_bf16(fsig(g0_[0]), fsig(g0_[1])); gw.y = pg8::cvt_pk_bf16(fsig(g0_[2]), fsig(g0_[3]));
            gw.z = pg8::cvt_pk_bf16(fsig(g1_[0]), fsig(g1_[1])); gw.w = pg8::cvt_pk_bf16(fsig(g1_[2]), fsig(g1_[3]));
            *(LAS v4u*)(ar + 256 + 16 * cg) = gw;
        }
        __syncthreads();
        f32x4 accw = (f32x4){0.f, 0.f, 0.f, 0.f}, acca = accw, accg = accw;
        {
            const LAS unsigned char* ap = lds + OFF_ACT + (16 * mt + rl) * ACT_PITCH + 8 * rg * 2;
#pragma unroll
            for (int f = 0; f < 8; ++f) {
                const bf16x8 a = *(const LAS bf16x8*)(ap + f * 64);
                if (f < 2) accw = __builtin_amdgcn_mfma_f32_16x16x32_bf16(a, bfr[f], accw, 0, 0, 0);
                else if (f < 4) acca = __builtin_amdgcn_mfma_f32_16x16x32_bf16(a, bfr[f], acca, 0, 0, 0);
                else accg = __builtin_amdgcn_mfma_f32_16x16x32_bf16(a, bfr[f], accg, 0, 0, 0);
            }
        }
        float lw[4], av[4], kk[4];
        {
            const int c = 16 * nt + rl;
            float n2[4];
#pragma unroll
            for (int r = 0; r < 4; ++r) {
                const int tok = 16 * mt + 4 * rg + r;
                gbuf[tok * 64 + c] = accg[r];
                const float nx = -(w0c + accw[r]);
                const float sp = nx > 20.f ? nx : __logf(1.f + __expf(nx));
                lw[r] = -__expf(-sp - 0.5f);
                av[r] = fsig(a0c + acca[r]);
                kk[r] = rkv[1 * 2048 + tok * 64 + c] * kkc;
                n2[r] = kk[r] * kk[r];
            }
            row_allsum4(n2[0], n2[1], n2[2], n2[3]);
            if (rl == 0) {
#pragma unroll
                for (int r = 0; r < 4; ++r) nrm[(16 * mt + 4 * rg + r) * 4 + nt] = n2[r];
            }
        }
        __syncthreads();
        {
            const int c = 16 * nt + rl;
            const float p0 = lw[0], p1 = p0 + lw[1], p2 = p1 + lw[2], p3 = p2 + lw[3];
            const float t1 = __shfl(p3, (lane - 16) & 63), t2 = __shfl(p3, (lane - 32) & 63), t3 = __shfl(p3, (lane - 48) & 63);
            const float E = (rg >= 1 ? t1 : 0.f) + (rg >= 2 ? t2 : 0.f) + (rg >= 3 ? t3 : 0.f);
            const float Ltot = __shfl(E + p3, rl + 48);
            const float pin[4] = {p0, p1, p2, p3};
            float bt[4], kt[4];
#pragma unroll
            for (int r = 0; r < 4; ++r) {
                const int tok = 16 * mt + 4 * rg + r;
                const f32x4 n4 = *(const LAS f32x4*)(nrm + tok * 4);
                const float ksv = rkv[1 * 2048 + tok * 64 + c], rsv = rkv[0 * 2048 + tok * 64 + c];
                const float inv = fminf(__builtin_amdgcn_rsqf((n4[0] + n4[1]) + (n4[2] + n4[3])), 1e12f);
                const float kkn = kk[r] * inv, beta = kkn * av[r], kmod = ksv * (1.f + (av[r] - 1.f) * kac);
                const float L = E + pin[r], eL = __expf(L), ieL = __expf(-L), eLm = __expf(L - lw[r]), eT = __expf(Ltot - L);
                LAS unsigned char* hp = lds + OFF_HAT + tok * HAT_PITCH + c * 2;
                *(LAS bf16_t*)(hp) = f2bf(-kkn * eLm); *(LAS bf16_t*)(hp + HAT_SZ) = f2bf(beta * ieL); *(LAS bf16_t*)(hp + 2 * HAT_SZ) = f2bf(kmod * ieL); *(LAS bf16_t*)(hp + 3 * HAT_SZ) = f2bf(rsv * eL);
                bt[r] = beta * eT; kt[r] = kmod * eT;
                float pbr = beta * rsv, pkr = kmod * rsv, pbo = rsv * kmod * rkc, dum = 0.f;
                row_allsum4(pbr, pkr, pbo, dum);
                if (rl == 0) *(LAS f32x4*)(scp + (tok * 4 + nt) * 4) = (f32x4){pbr, pkr, pbo, 0.f};
            }
            LAS unsigned char* tp = lds + OFF_TIL + (2 * mt) * TIL_SZ + c * TIL_PITCH + 8 * rg;
            v2u w; w.x = pg8::cvt_pk_bf16(bt[0], bt[1]); w.y = pg8::cvt_pk_bf16(bt[2], bt[3]); *(LAS v2u*)(tp) = w;
            w.x = pg8::cvt_pk_bf16(kt[0], kt[1]); w.y = pg8::cvt_pk_bf16(kt[2], kt[3]); *(LAS v2u*)(tp + TIL_SZ) = w;
            if (rg == 0) ((LAS float*)(lds + OFF_WC))[mt * 64 + c] = __expf(Ltot);
        }
        __syncthreads();
        if (tid < CH) {
            const f32x4 p0 = *(const LAS f32x4*)(scp + tid * 16), p1 = *(const LAS f32x4*)(scp + tid * 16 + 4), p2 = *(const LAS f32x4*)(scp + tid * 16 + 8), p3 = *(const LAS f32x4*)(scp + tid * 16 + 12);
            *(LAS f32x4*)(scl + 4 * tid) = (p0 + p1) + (p2 + p3);
        }
        int lane_ = lane; asm volatile("" : "+v"(lane_));
        const int rl_ = lane_ & 15, rg_ = lane_ >> 4;
        {
            const int c = wave >> 2, g = wave & 3;
            const LAS unsigned char* pa = lds + OFF_HAT + ((g & 1) ? 2 : 1) * HAT_SZ + (16 * c + rl_) * HAT_PITCH + 16 * rg_;
            const LAS unsigned char* pb = lds + OFF_HAT + ((g < 2) ? 0 : 3) * HAT_SZ + (16 * c + rl_) * HAT_PITCH + 16 * rg_;
            f32x4 acc = (f32x4){0.f, 0.f, 0.f, 0.f};
            acc = __builtin_amdgcn_mfma_f32_16x16x32_bf16(*(const LAS bf16x8*)(pa), *(const LAS bf16x8*)(pb), acc, 0, 0, 0);
            acc = __builtin_amdgcn_mfma_f32_16x16x32_bf16(*(const LAS bf16x8*)(pa + 64), *(const LAS bf16x8*)(pb + 64), acc, 0, 0, 0);
#pragma unroll
            for (int e = 0; e < 4; ++e) { const int row = 4 * rg_ + e; const bool keep = (g < 2) ? (row < rl_) : (row <= rl_); if (!keep) acc[e] = 0.f; }
            *(LAS f32x4*)(lds + OFF_GR + (c * 5 + g) * 1024 + lane_ * 16) = acc;
            if (g == 0) {
                asm volatile("s_waitcnt lgkmcnt(0)" ::: "memory");
                if (lane_ < 16) {
                    const int sc = lane_;
                    const LAS float* tb = (const LAS float*)(lds + OFF_GR + (c * 5) * 1024);
                    float m[16], ps[16];
#pragma unroll
                    for (int r = 0; r < 16; ++r) ps[r] = 0.f;
#pragma unroll
                    for (int u = 15; u >= 0; --u) {
                        m[u] = (u == sc) ? 1.f : ((u < sc) ? ps[u] : 0.f);
#pragma unroll
                        for (int r = 0; r < u; ++r) ps[r] = __builtin_fmaf(tb[(u + 16 * (r >> 2)) * 4 + (r & 3)], m[u], ps[r]);
                    }
                    LAS f32x4* mt_ = (LAS f32x4*)(lds + OFF_GR + (c * 5 + 4) * 1024);
#pragma unroll
                    for (int q = 0; q < 4; ++q) mt_[sc + 16 * q] = (f32x4){m[4 * q], m[4 * q + 1], m[4 * q + 2], m[4 * q + 3]};
                }
            }
        }
        __syncthreads();
        if (wave < 4) {
            const int ib = wave;
#pragma unroll
            for (int c = 0; c < 2; ++c) {
                bf16x8 sb[2];
#pragma unroll
                for (int ks = 0; ks < 2; ++ks) {
                    v4u p; p.x = pg8::cvt_pk_bf16(ST[2 * ks][0], ST[2 * ks][1]); p.y = pg8::cvt_pk_bf16(ST[2 * ks][2], ST[2 * ks][3]);
                    p.z = pg8::cvt_pk_bf16(ST[2 * ks + 1][0], ST[2 * ks + 1][1]); p.w = pg8::cvt_pk_bf16(ST[2 * ks + 1][2], ST[2 * ks + 1][3]);
                    sb[ks] = __builtin_bit_cast(bf16x8, p);
                }
                const LAS unsigned char* ha = lds + OFF_HAT + (16 * c + rl_) * HAT_PITCH + 8 * rg_;
                f32x4 xt = (f32x4){0.f, 0.f, 0.f, 0.f}, yt = xt;
#pragma unroll
                for (int ks = 0; ks < 2; ++ks) {
                    v4u fa, fr; const v2u a0_ = *(const LAS v2u*)(ha + 64 * ks), a1_ = *(const LAS v2u*)(ha + 64 * ks + 32);
                    const v2u r0_ = *(const LAS v2u*)(ha + 3 * HAT_SZ + 64 * ks), r1_ = *(const LAS v2u*)(ha + 3 * HAT_SZ + 64 * ks + 32);
                    fa.x = a0_.x; fa.y = a0_.y; fa.z = a1_.x; fa.w = a1_.y; fr.x = r0_.x; fr.y = r0_.y; fr.z = r1_.x; fr.w = r1_.y;
                    xt = __builtin_amdgcn_mfma_f32_16x16x32_bf16(__builtin_bit_cast(bf16x8, fa), sb[ks], xt, 0, 0, 0);
                    yt = __builtin_amdgcn_mfma_f32_16x16x32_bf16(__builtin_bit_cast(bf16x8, fr), sb[ks], yt, 0, 0, 0);
                }
                const LAS float* vsrc = rkv + 2 * 2048 + (16 * c + 4 * rg_) * 64 + 16 * ib + rl_;
                v2u vb_; vb_.x = pg8::cvt_pk_bf16(vsrc[0], vsrc[64]); vb_.y = pg8::cvt_pk_bf16(vsrc[128], vsrc[192]);
                const s16x4 vb = __builtin_bit_cast(s16x4, vb_);
                const LAS unsigned char* gr = lds + OFF_GR + (c * 5) * 1024 + lane_ * 16;
#define RW_AFR(g_) ({ const f32x4 t_ = *(const LAS f32x4*)(gr + (g_) * 1024); v2u w_; w_.x = pg8::cvt_pk_bf16(t_[0], t_[1]); w_.y = pg8::cvt_pk_bf16(t_[2], t_[3]); __builtin_bit_cast(s16x4, w_); })
#define RW_PK4(x_) ({ v2u w_; w_.x = pg8::cvt_pk_bf16((x_)[0], (x_)[1]); w_.y = pg8::cvt_pk_bf16((x_)[2], (x_)[3]); __builtin_bit_cast(s16x4, w_); })
                const f32x4 zt = __builtin_amdgcn_mfma_f32_16x16x16bf16_1k(RW_AFR(1), vb, xt, 0, 0, 0);
                const f32x4 ut = __builtin_amdgcn_mfma_f32_16x16x16bf16_1k(RW_AFR(4), RW_PK4(zt), (f32x4){0.f, 0.f, 0.f, 0.f}, 0, 0, 0);
                const s16x4 ub = RW_PK4(ut);
                yt = __builtin_amdgcn_mfma_f32_16x16x16bf16_1k(RW_AFR(2), ub, yt, 0, 0, 0);
                yt = __builtin_amdgcn_mfma_f32_16x16x16bf16_1k(RW_AFR(3), vb, yt, 0, 0, 0);
#pragma unroll
                for (int e = 0; e < 4; ++e) ybuf[(16 * c + 4 * rg_ + e) * 64 + 16 * ib + rl_] = yt[e];
                const LAS unsigned char* tl_ = lds + OFF_TIL + (2 * c) * TIL_SZ + rl_ * TIL_PITCH + 8 * rg_;
                const LAS float* wc = (const LAS float*)(lds + OFF_WC) + c * 64 + 4 * rg_;
#pragma unroll
                for (int jt = 0; jt < 4; ++jt) {
                    f32x4 acc = ST[jt] * *(const LAS f32x4*)(wc + 16 * jt);
                    acc = __builtin_amdgcn_mfma_f32_16x16x16bf16_1k(*(const LAS s16x4*)(tl_ + TIL_SZ + 16 * jt * TIL_PITCH), vb, acc, 0, 0, 0);
                    acc = __builtin_amdgcn_mfma_f32_16x16x16bf16_1k(*(const LAS s16x4*)(tl_ + 16 * jt * TIL_PITCH), ub, acc, 0, 0, 0);
                    ST[jt] = acc;
                }
#undef RW_AFR
#undef RW_PK4
            }
        }
        __syncthreads();
        {
            const f32x4 y4 = *(const LAS f32x4*)(ybuf + tl * 64 + 4 * cg);
            const float mean = row_allsum((y4[0] + y4[1]) + (y4[2] + y4[3])) * (1.f / 64.f);
            const f32x4 dv = y4 - mean;
            const float var = row_allsum((dv[0] * dv[0] + dv[1] * dv[1]) + (dv[2] * dv[2] + dv[3] * dv[3])) * (1.f / 64.f);
            const float rs_ = rsqrtf(var + GN_EPS);
            const f32x4 yn = dv * rs_ * *(const LAS f32x4*)(myct + 28) + *(const LAS f32x4*)(myct + 32);
            const float bonus = scl[tl * 4 + 2];
            const f32x4 vs_ = *(const LAS f32x4*)(rkv + 2 * 2048 + tl * 64 + 4 * cg), g4 = *(const LAS f32x4*)(gbuf + tl * 64 + 4 * cg);
            const f32x4 o = (yn + vs_ * bonus) * g4;
            v2u w; w.x = pg8::cvt_pk_bf16(o[0], o[1]); w.y = pg8::cvt_pk_bf16(o[2], o[3]);
            *(v2u*)(ya + (rowb + t0 + tl) * YAB_PITCH + c4) = w;
        }
        __syncthreads();
    }
}
}

typedef __bf16 bf16x2_t __attribute__((ext_vector_type(2)));
__device__ __forceinline__ float dot2bf(unsigned a, unsigned b, float c) { return __builtin_amdgcn_fdot2_f32_bf16(__builtin_bit_cast(bf16x2_t, a), __builtin_bit_cast(bf16x2_t, b), c, false); }
__device__ __forceinline__ unsigned f2ord(float f) { const unsigned u = __float_as_uint(f); return (u & 0x80000000u) ? ~u : (u | 0x80000000u); }
__device__ __forceinline__ float ord2f(unsigned o) { return __uint_as_float((o & 0x80000000u) ? (o ^ 0x80000000u) : ~o); }
__device__ __forceinline__ unsigned row_allmax_u32(unsigned v) {
    v = max(v, (unsigned)__builtin_amdgcn_update_dpp(0, (int)v, 0x128, 0xf, 0xf, false));
    v = max(v, (unsigned)__builtin_amdgcn_update_dpp(0, (int)v, 0x124, 0xf, 0xf, false));
    v = max(v, (unsigned)__builtin_amdgcn_update_dpp(0, (int)v, 0x122, 0xf, 0xf, false));
    v = max(v, (unsigned)__builtin_amdgcn_update_dpp(0, (int)v, 0x121, 0xf, 0xf, false));
    return v;
}

constexpr int TK_PITCH = 272, TK_HALF = 128 * TK_PITCH;
typedef short tk_bf16x8 __attribute__((ext_vector_type(8)));
__device__ __forceinline__ void topk_loadq(tk_bf16x8 (&qa)[8], const bf16_t* __restrict__ qb, int t0, int h, int lane) {
    const bf16_t* qp = qb + (size_t)(t0 + (lane & 15)) * 2048 + h * 256 + 8 * (lane >> 4);
#pragma unroll
    for (int i = 0; i < 8; ++i) qa[i] = *(const tk_bf16x8*)(qp + i * 32);
}
__device__ __forceinline__ void topk_item(const tk_bf16x8 (&qa)[8], const LAS unsigned char* klds, int* __restrict__ ids, float* __restrict__ gates, int t0, int h, int lane) {
    const int rl = lane & 15, rg = lane >> 4;
    unsigned top[2][4];
#pragma unroll
    for (int c = 0; c < 2; ++c) {
        f32x4 acc[8];
#pragma unroll
        for (int nt = 0; nt < 8; ++nt) acc[nt] = (f32x4){64.f, 64.f, 64.f, 64.f};
        const LAS unsigned char* kp = klds + c * TK_HALF + rl * TK_PITCH + 16 * rg;
#pragma unroll
        for (int ks = 0; ks < 4; ++ks) {
#pragma unroll
            for (int nt = 0; nt < 8; ++nt) { const tk_bf16x8 b = *(const LAS tk_bf16x8*)(kp + nt * 16 * TK_PITCH + ks * 64); acc[nt] = __builtin_amdgcn_mfma_f32_16x16x32_bf16(qa[c * 4 + ks], b, acc[nt], 0, 0, 0); }
            __builtin_amdgcn_sched_barrier(0);
        }
        unsigned k[4][8];
#pragma unroll
        for (int r = 0; r < 4; ++r) {
#pragma unroll
            for (int nt = 0; nt < 8; ++nt) k[r][nt] = (__float_as_uint(fmaxf(acc[nt][r], 1.f)) & ~127u) | (unsigned)(127 - (nt * 16 + rl));
#define TK_CE(i, j) do { const unsigned a_ = max(k[r][i], k[r][j]), b_ = min(k[r][i], k[r][j]); k[r][i] = a_; k[r][j] = b_; } while (0)
            TK_CE(0, 1); TK_CE(2, 3); TK_CE(4, 5); TK_CE(6, 7); TK_CE(0, 2); TK_CE(1, 3); TK_CE(4, 6); TK_CE(5, 7); TK_CE(1, 2); TK_CE(5, 6);
            TK_CE(0, 4); TK_CE(1, 5); TK_CE(2, 6); TK_CE(3, 7); TK_CE(2, 4); TK_CE(3, 5); TK_CE(1, 2); TK_CE(3, 4); TK_CE(5, 6);
#undef TK_CE
        }
        unsigned tp[4] = {0u, 0u, 0u, 0u};
        for (int round = 0; round < 16; ++round) {
#pragma unroll
            for (int r = 0; r < 4; ++r) {
                const unsigned m = row_allmax_u32(k[r][0]);
                tp[r] = (rl == round) ? m : tp[r];
                const bool win = (k[r][0] == m);
                k[r][0] = win ? k[r][1] : k[r][0]; k[r][1] = win ? k[r][2] : k[r][1]; k[r][2] = win ? k[r][3] : k[r][2]; k[r][3] = win ? k[r][4] : k[r][3];
                k[r][4] = win ? k[r][5] : k[r][4]; k[r][5] = win ? k[r][6] : k[r][5]; k[r][6] = win ? k[r][7] : k[r][6]; k[r][7] = win ? 0u : k[r][7];
            }
        }
#pragma unroll
        for (int r = 0; r < 4; ++r) top[c][r] = tp[r];
    }
    const int rowbase = lane & 48;
    float v1[4]; int n1[4], ptr[4], myid[4]; unsigned k2[4], myv[4];
#pragma unroll
    for (int r = 0; r < 4; ++r) { v1[r] = __uint_as_float(top[0][r] & ~127u); n1[r] = 127 - (int)(top[0][r] & 127u); ptr[r] = 0; k2[r] = (unsigned)__builtin_amdgcn_ds_bpermute(rowbase * 4, (int)top[1][r]); myid[r] = 0; myv[r] = 0u; }
    for (int round = 0; round < 16; ++round) {
#pragma unroll
        for (int r = 0; r < 4; ++r) {
            const float head = v1[r] + __uint_as_float(k2[r] & ~127u);
            const unsigned key = (ptr[r] < 16) ? ((__float_as_uint(head) & ~15u) | (unsigned)(15 - rl)) : 0u;
            const unsigned m = row_allmax_u32(key);
            const bool win = (key == m);
            const unsigned wid = row_allmax_u32(win ? (unsigned)(n1[r] * 128 + (127 - (int)(k2[r] & 127u))) + 1u : 0u);
            myid[r] = (rl == round) ? (int)wid - 1 : myid[r];
            myv[r] = (rl == round) ? m : myv[r];
            ptr[r] += win ? 1 : 0;
            k2[r] = (unsigned)__builtin_amdgcn_ds_bpermute((rowbase + (ptr[r] & 15)) * 4, (int)top[1][r]);
        }
    }
#pragma unroll
    for (int r = 0; r < 4; ++r) {
        const float val = __uint_as_float(myv[r] & ~15u);
        const float vmax = __uint_as_float((unsigned)__builtin_amdgcn_ds_bpermute(rowbase * 4, (int)__float_as_uint(val)));
        const float e = __expf(val - vmax);
        const float sum = rw::row_allsum(e);
        gates[(size_t)(t0 + 4 * rg + r) * 128 + h * 16 + rl] = e * __builtin_amdgcn_rcpf(sum); ids[(size_t)(t0 + 4 * rg + r) * 128 + h * 16 + rl] = myid[r];
    }
}

typedef float f32x2 __attribute__((ext_vector_type(2)));
__device__ __forceinline__ void peer_token(const bf16_t* __restrict__ x2b, const float* __restrict__ ssq2, const int* __restrict__ ids, const float* __restrict__ gates,
                                           const unsigned char* __restrict__ U8, const unsigned char* __restrict__ V8, const float* __restrict__ usc, const float* __restrict__ vsc,
                                           const float* __restrict__ fw, float* __restrict__ out, int t, int lane) {
    const int l16 = lane * 16;
    f32x2 hx[8];
    {
        const v4u h0 = *(const v4u*)(x2b + (size_t)t * DM + l16), h1 = *(const v4u*)(x2b + (size_t)t * DM + l16 + 8);
        const unsigned hw[8] = {h0.x, h0.y, h0.z, h0.w, h1.x, h1.y, h1.z, h1.w};
#pragma unroll
        for (int i = 0; i < 8; ++i) hx[i] = (f32x2){pg8::bflo(hw[i]), pg8::bfhi(hw[i])};
    }
    const int idA = ids[(size_t)t * 128 + lane], idB = ids[(size_t)t * 128 + 64 + lane];
    const float rs = rsqrtf(pg8::ssq_sum16(ssq2 + (size_t)t * 16) * (1.f / DM) + NORM_EPS);
    const float suA = rs * usc[idA], suB = rs * usc[idB];
    const float svA = gates[(size_t)t * 128 + lane] * vsc[idA], svB = gates[(size_t)t * 128 + 64 + lane] * vsc[idB];
    f32x2 y[8];
#pragma unroll
    for (int i = 0; i < 8; ++i) y[i] = (f32x2){0.f, 0.f};
    const int bit0 = lane & 1, bit1 = (lane >> 1) & 1, bit5 = lane >> 5;
    v3u_t uw[8], vw[8];
    const unsigned vo12 = (unsigned)lane * 12u;
#define PEER_LDU(g_) do { const int is_ = ((g_) < 8) ? idA : idB; const int lb_ = ((g_) * 8) & 63; _Pragma("unroll") for (int k = 0; k < 8; ++k) { const unsigned eo = (unsigned)__builtin_amdgcn_readlane(is_, lb_ + k) * 768u; \
        const unsigned char* rp_ = U8 + eo; uw[k] = *(const v3u_t*)(rp_ + vo12); } } while (0)
#define PEER_LDV(g_) do { const int is_ = ((g_) < 8) ? idA : idB; const int lb_ = ((g_) * 8) & 63; _Pragma("unroll") for (int k = 0; k < 8; ++k) { const unsigned eo = (unsigned)__builtin_amdgcn_readlane(is_, lb_ + k) * 768u; \
        const unsigned char* rp_ = V8 + eo; vw[k] = *(const v3u_t*)(rp_ + vo12); } } while (0)
    PEER_LDU(0); PEER_LDV(0);
    for (int g = 0; g < 16; ++g) {
        const float susel = (g < 8) ? suA : suB, svsel = (g < 8) ? svA : svB; const int lb = (g * 8) & 63;
        float d[8];
#pragma unroll
        for (int k = 0; k < 8; k += 2) {
            const v32f_t f = __builtin_amdgcn_cvt_scalef32_pk32_f32_fp6((v6u_t){uw[k][0], uw[k][1], uw[k][2], uw[k + 1][0], uw[k + 1][1], uw[k + 1][2]}, 1.0f);
            f32x2 a = (f32x2){0.f, 0.f}, b = a;
#pragma unroll
            for (int i = 0; i < 8; ++i) { a += (f32x2){f[2 * i], f[2 * i + 1]} * hx[i]; b += (f32x2){f[16 + 2 * i], f[17 + 2 * i]} * hx[i]; }
            d[k] = a[0] + a[1]; d[k + 1] = b[0] + b[1];
            __builtin_amdgcn_sched_barrier(0);
        }
        if (g + 1 < 16) PEER_LDU(g + 1);
        __builtin_amdgcn_sched_barrier(0);
#pragma unroll
        for (int k = 0; k < 8; ++k) d[k] *= __uint_as_float((unsigned)__builtin_amdgcn_readlane((int)__float_as_uint(susel), lb + k));
        float r4[4];
#pragma unroll
        for (int k = 0; k < 4; ++k) { const float send = bit0 ? d[k] : d[k + 4], keep = bit0 ? d[k + 4] : d[k]; r4[k] = keep + rw::dppf<0xB1>(send); }
        float r2[2];
#pragma unroll
        for (int k = 0; k < 2; ++k) { const float send = bit1 ? r4[k] : r4[k + 2], keep = bit1 ? r4[k + 2] : r4[k]; r2[k] = keep + rw::dppf<0x4E>(send); }
        float r1;
        { const float send = bit5 ? r2[0] : r2[1], keep = bit5 ? r2[1] : r2[0];
          auto rr = __builtin_amdgcn_permlane32_swap(__float_as_uint(send), __float_as_uint(send), false, false);
          r1 = keep + __uint_as_float(bit5 ? rr[0] : rr[1]); }
        r1 += rw::dppf<0x128>(r1); r1 += rw::dppf<0x124>(r1);
        r1 += __uint_as_float((unsigned)__builtin_amdgcn_ds_swizzle((int)__float_as_uint(r1), 0x401F));
        const float dd = r1;
        const float act = 0.5f * dd * (1.f + erff(dd * 0.70710678118654752f));
#pragma unroll
        for (int k = 0; k < 8; k += 2) {
#define PEER_LANE_OF(k_) ((((k_) >> 2) & 1) | ((((k_) >> 1) & 1) << 1) | (((k_) & 1) << 5))
            const float a = __uint_as_float((unsigned)__builtin_amdgcn_readlane((int)__float_as_uint(act), PEER_LANE_OF(k))) * __uint_as_float((unsigned)__builtin_amdgcn_readlane((int)__float_as_uint(svsel), lb + k));
            const float b = __uint_as_float((unsigned)__builtin_amdgcn_readlane((int)__float_as_uint(act), PEER_LANE_OF(k + 1))) * __uint_as_float((unsigned)__builtin_amdgcn_readlane((int)__float_as_uint(svsel), lb + k + 1));
#undef PEER_LANE_OF
            const f32x2 a2 = (f32x2){a, a}, b2 = (f32x2){b, b};
            const v32f_t f = __builtin_amdgcn_cvt_scalef32_pk32_f32_fp6((v6u_t){vw[k][0], vw[k][1], vw[k][2], vw[k + 1][0], vw[k + 1][1], vw[k + 1][2]}, 1.0f);
#pragma unroll
            for (int i = 0; i < 8; ++i) { y[i] += (f32x2){f[2 * i], f[2 * i + 1]} * a2; y[i] += (f32x2){f[16 + 2 * i], f[17 + 2 * i]} * b2; }
            __builtin_amdgcn_sched_barrier(0);
        }
        if (g + 1 < 16) PEER_LDV(g + 1);
        __builtin_amdgcn_sched_barrier(0);
    }
#undef PEER_LDU
#undef PEER_LDV
    float* orow = out + (size_t)t * DM + l16;
    float ss = 0.f;
    f32x4 o4[4];
#pragma unroll
    for (int i = 0; i < 4; ++i) { o4[i] = (f32x4){hx[2 * i][0] + y[2 * i][0], hx[2 * i][1] + y[2 * i][1], hx[2 * i + 1][0] + y[2 * i + 1][0], hx[2 * i + 1][1] + y[2 * i + 1][1]};
        ss += (o4[i][0] * o4[i][0] + o4[i][1] * o4[i][1]) + (o4[i][2] * o4[i][2] + o4[i][3] * o4[i][3]); }
    ss = wave_sum(ss);
    const float r = rsqrtf(ss * (1.f / DM) + NORM_EPS);
#pragma unroll
    for (int i = 0; i < 4; ++i) *(f32x4*)(orow + 4 * i) = o4[i] * r * *(const f32x4*)(fw + l16 + 4 * i);
}

__global__ void __launch_bounds__(NWAVES * 64, 2) mk_fwd(Args args) {
    extern __shared__ __attribute__((aligned(16))) unsigned char lds_raw[];
    LAS unsigned char* lds = (LAS unsigned char*)lds_raw;
    volatile LAS unsigned* MISC = (volatile LAS unsigned*)(lds + MISC_OFF);
    const int tid = threadIdx.x, lane = tid & 63, wave = __builtin_amdgcn_readfirstlane(tid >> 6);
    const int G = gridDim.x; const int bx = blockIdx.x; const int vcu = (G % 8 == 0) ? (bx % 8) * (G / 8) + bx / 8 : bx;
    unsigned char* ws = args.ws;
    unsigned* ctl = (unsigned*)(ws + WS_CTL);
    for (int u = tid; u < (LDS_BYTES - LDSCTL_OFF) / 4; u += NWAVES * 64) ((LAS unsigned*)(lds + LDSCTL_OFF))[u] = 0u;
    __syncthreads();
    XcdBarrier bar = xcd_barrier_post(ctl + CW_BAR + args.li * XCD_BAR_WORDS, MISC + 8);
    const int lo = args.ph_lo, hi = args.ph_hi;
#define IN(k) (lo <= (k) && (k) < hi)
#define BOTH(k) (IN(k) && IN((k) + 1))
    bf16_t* WinT = (bf16_t*)(ws + WS_WIN); bf16_t* PaT = (bf16_t*)(ws + WS_PA); bf16_t* PbT = (bf16_t*)(ws + WS_PB); bf16_t* WoT = (bf16_t*)(ws + WS_WO);
    bf16_t* WqT = (bf16_t*)(ws + WS_WQ); bf16_t* KeysB = (bf16_t*)(ws + WS_KEYS);
    float* rstd1 = (float*)(ws + WS_RSTD1); float* ssq2 = (float*)(ws + WS_RSTD2); float* scal = (float*)(ws + WS_SCAL);
    unsigned char* U8 = ws + WS_U; unsigned char* V8 = ws + WS_V; float* usc = (float*)(ws + WS_USC); float* vsc = (float*)(ws + WS_VSC);
    bf16_t* xb = (bf16_t*)(ws + WS_XB); bf16_t* ya = (bf16_t*)(ws + WS_YA); bf16_t* yb = (bf16_t*)(ws + WS_YB); bf16_t* x2b = (bf16_t*)(ws + WS_X2B);
    bf16_t* z = (bf16_t*)(ws + WS_Z); bf16_t* qb = (bf16_t*)(ws + WS_Q);
    bf16_t* merged = (bf16_t*)(ws + WS_MERGED);
    const int gw = vcu * NWAVES + wave, NGW = G * NWAVES;

    if (IN(0)) {
        LAS float* scr = (LAS float*)(lds + wave * 16384);
        constexpr int I_IN = (DM / 64) * (NZ / 32), I_PA = (512 / 64) * (DM / 32), I_WO = (DM / 64) * (DM / 32), I_WQ = (DM / 64) * (2048 / 32);
        constexpr int NITEMS = I_IN + 2 * I_PA + I_WO + I_WQ;
        for (int it = gw; it < NITEMS; it += NGW) {
            int r = it;
            if (r < I_IN) { p0_transpose_item(args.in[2], args.in[1], DM, NZ, WinT, scr, r, lane, ws + WS_WG8, C_GA); continue; } r -= I_IN;
            if (r < I_PA) { p0_transpose_item(args.in[19], nullptr, 512, DM, PaT, scr, r, lane, nullptr, 0, DM, 0); continue; } r -= I_PA;
            if (r < I_PA) { p0_transpose_item(args.in[20], nullptr, 512, DM, PaT, scr, r, lane, nullptr, 0, DM, 512); continue; } r -= I_PA;
            if (r < I_WO) { p0_transpose_item(args.in[21], nullptr, DM, DM, WoT, scr, r, lane); continue; } r -= I_WO;
            p0_transpose_item(args.in[23], args.in[22], DM, 2048, WqT, scr, r, lane);
        }
        p0_convert(args.in[24], nullptr, KeysB, (size_t)16 * 128 * 128, gw, NGW, lane);
        for (int e = gw; e < 2 * NEXP; e += NGW) {
            const bool isu = e < NEXP; const int row = isu ? e : e - NEXP;
            p0_row_fp6((isu ? args.in[25] : args.in[26]) + (size_t)row * DM, isu ? args.in[22] : nullptr, (isu ? U8 : V8) + (size_t)row * 768, (isu ? usc : vsc) + row, lane);
        }
        for (int m = gw; m < T_TOK; m += NGW) {
            const f32x4* xr = (const f32x4*)(args.in[0] + (size_t)m * DM) + lane;
            f32x4 v[4]; float s = 0.f;
#pragma unroll
            for (int j = 0; j < 4; ++j) { v[j] = xr[64 * j]; s += (v[j][0] * v[j][0] + v[j][1] * v[j][1]) + (v[j][2] * v[j][2] + v[j][3] * v[j][3]); }
            s = wave_sum(s);
            v2u* o8 = (v2u*)(xb + (size_t)m * DM) + lane;
#pragma unroll
            for (int j = 0; j < 4; ++j) { v2u w; w.x = pg8::cvt_pk_bf16(v[j][0], v[j][1]); w.y = pg8::cvt_pk_bf16(v[j][2], v[j][3]); o8[64 * j] = w;
                int p = 0; p = __builtin_amdgcn_cvt_pk_fp8_f32(v[j][0], v[j][1], p, false); p = __builtin_amdgcn_cvt_pk_fp8_f32(v[j][2], v[j][3], p, true);
                ((unsigned*)(ws + WS_XQ + (size_t)m * DM))[lane + 64 * j] = (unsigned)p; }
            if (lane == 0) rstd1[m] = rsqrtf(s * (1.f / DM) + NORM_EPS);
        }
        if (gw == 0) {
            const float a = wave_sum(args.in[14][lane] * args.in[15][lane]), b = wave_sum(args.in[16][lane] * args.in[17][lane]);
            if (lane == 0) scal[0] = __expf(a) - __expf(b) + LAM_INIT;
        }
        if (BOTH(0)) xcd_barrier(bar);
    }
    if (IN(1)) {
        {
            pg8::Gemm g{xb, WinT, DM, DM, DM}; pg8::StaticOrder S; S.init(T_TOK, C_GA, G, bx);
            pg8::EpiRowScale<false> E{z, NZ, rstd1};
            pg8::gemm_phase(lds, g, S, E);
        }
        {
            pg8::Gemm g{(const bf16_t*)(ws + WS_XQ), (const bf16_t*)(ws + WS_WG8), DM / 2, DM / 2, DM / 2}; pg8::StaticOrder S; S.init(T_TOK, NZ - C_GA, G, bx);
            pg8::EpiRowScaleF8 E{(unsigned char*)args.out, 2048, rstd1, 1.f / 32.f};
            pg8::gemm_phase<pg8::EpiRowScaleF8, pg8::StaticOrder, true>(lds, g, S, E);
        }
        if (BOTH(1)) xcd_barrier(bar);
    }
    if (IN(2)) {
        {
            const rw::ScanP P{args.in[3], args.in[4], args.in[5], args.in[6], args.in[7], args.in[8], args.in[9], args.in[10], args.in[11], args.in[12], args.in[13]};
            for (int rep = 0; rep < REPS(2); ++rep) for (int u = vcu; u < NB * 8; u += G) rw::scan_unit(lds, z, ya, P, u >> 3, u & 7, tid, wave, lane);
        }
        const float lam = scal[0];
        __syncthreads();
        for (int i = 0;; ++i) {
            int idx = vcu + i * G; if (idx >= 2048 * REPS(10)) break;
            idx &= 2047;
            const int slot = idx >> 8, v = idx & 255, bh = v >> 1, a = (v & 1) * 4 + (slot >> 1), qblk = (slot & 1) ? 15 - a : a;
            da::attn_unit(lds, z, yb, args.in[18], lam, bh >> 2, bh & 3, qblk, wave, lane);
        }
        if (BOTH(2)) xcd_barrier(bar);
    }
    if (IN(3)) {
        pg8::Gemm g{ya, PaT, DM, DM, DM}; pg8::StaticOrder S; S.init(T_TOK, DM, G, bx);
        pg8::EpiGate2 E{merged, (const unsigned char*)args.out};
        pg8::gemm_phase(lds, g, S, E);
        if (BOTH(3)) xcd_barrier(bar);
    }
    if (IN(5)) {
        pg8::Gemm g{merged, WoT, DM, DM, DM}; pg8::StaticOrder S; S.init(T_TOK, DM, G, bx);
        pg8::EpiX2 E{args.in[0], args.out, x2b, ssq2};
        pg8::gemm_phase(lds, g, S, E);
        if (BOTH(5)) xcd_barrier(bar);
    }
    if (IN(6)) {
        pg8::Gemm g{x2b, WqT, DM, DM, DM}; pg8::StaticOrder S; S.init(T_TOK, 2048, G, bx);
        pg8::EpiRowScale<true> E{qb, 2048, ssq2};
        for (int rep = 0; rep < REPS(6); ++rep) pg8::gemm_phase(lds, g, S, E);
        if (BOTH(6)) xcd_barrier(bar);
    }
    if (IN(7)) {
        int* ids = (int*)(ws + WS_IDS); float* gates = (float*)(ws + WS_GATES);
        for (int rep = 0; rep < REPS(7); ++rep)
        for (int h = 0; h < 8; ++h) {
            __syncthreads();
            {
                const bf16_t* ksrc = KeysB + (size_t)h * 2 * 128 * 128;
#pragma unroll
                for (int i = 0; i < 8; ++i) { const int chunk = tid + i * 512, row = chunk >> 4, cc = chunk & 15;
                    *(LAS v4u*)(lds + (row >> 7) * TK_HALF + (row & 127) * TK_PITCH + cc * 16) = *(const v4u*)(ksrc + (size_t)row * 128 + cc * 8); }
            }
            __syncthreads();
            for (int tile = gw; tile < 4096; tile += NGW) {
                tk_bf16x8 qa[8];
                topk_loadq(qa, qb, tile * 16, h, lane);
                topk_item(qa, lds, ids, gates, tile * 16, h, lane);
            }
        }
        if (BOTH(7)) xcd_barrier(bar);
    }
    if (IN(8)) {
        const int* ids = (const int*)(ws + WS_IDS); const float* gates = (const float*)(ws + WS_GATES);
        for (int t = gw; t < T_TOK; t += NGW) peer_token(x2b, ssq2, ids, gates, U8, V8, usc, vsc, args.in[27], args.out, t, lane);
    }
#undef IN
#undef BOTH
}

extern "C" void kernel_launch(void* const* d_in, const int* in_sizes, int n_in, void* d_out, int out_size, void* d_ws, size_t ws_size, hipStream_t stream) {
    static int grid = 0;
    if (grid == 0) {
        if (n_in != 28 || in_sizes[0] != T_TOK * DM || out_size != T_TOK * DM || ws_size < WS_END) {
            fprintf(stderr, "kernel_launch: unexpected shapes / workspace (n_in %d, ws %zu < %zu)\n", n_in, ws_size, (size_t)WS_END); grid = -1; return; }
        int dev = 0, cus = 0;
        if (hipGetDevice(&dev) != hipSuccess || hipDeviceGetAttribute(&cus, hipDeviceAttributeMultiprocessorCount, dev) != hipSuccess) { grid = -1; return; }
        if (hipFuncSetAttribute((const void*)mk_fwd, hipFuncAttributeMaxDynamicSharedMemorySize, LDS_BYTES) != hipSuccess) { fprintf(stderr, "kernel_launch: hipFuncSetAttribute failed\n"); grid = -1; return; }
        grid = cus;
    }
    if (grid < 0) return;
    unsigned char* ws = (unsigned char*)d_ws;
    float* out = (float*)d_out;
    (void)hipMemsetAsync(ws + WS_CTL, 0, 1 * MiB, stream);
    Args a{};
    for (int i = 0; i < 28; ++i) a.in[i] = (const float*)d_in[i];
    a.out = out; a.ws = ws;
    a.ph_lo = 0; a.ph_hi = 9; a.li = 0;
    hipLaunchKernelGGL(mk_fwd, dim3(grid), dim3(NWAVES * 64), LDS_BYTES, stream, a);
}
```

```cpp
#include <hip/hip_runtime.h>
#include <stdint.h>
#include <cstdio>

typedef unsigned short bf16_t;
typedef unsigned int u32;

#ifndef PROBE_REP
#define PROBE_REP 0
#endif
#define REPS(k) (((PROBE_REP >> (k)) & 1) ? 2 : 1)
constexpr int T_TOK = 65536, DM = 1024, SEQ = 2048, NB = 32;
constexpr int NZ = 5376;
constexpr int ZP = NZ;
constexpr int C_R = 0, C_K = 512, C_V = 1024, C_WL = 1536, C_AL = 1600, C_GL = 1664, C_Q = 1792, C_ZK = 2304, C_ZV = 2816, C_GA = 3328, C_GB = 4352;
constexpr int NEXP = 16384;
constexpr float NORM_EPS = 1e-6f, GN_EPS = 64e-5f, SUBLN_EPS = 1e-5f;
constexpr float LAM_INIT = 0.2f;

constexpr size_t MiB = 1u << 20;
constexpr size_t WS_CTL = 0;
constexpr size_t WS_WIN = 1 * MiB;
constexpr size_t WS_PA = 12 * MiB;
constexpr size_t WS_PB = 13 * MiB;
constexpr size_t WS_WO = 14 * MiB;
constexpr size_t WS_WQ = 16 * MiB;
constexpr size_t WS_KEYS = 20 * MiB;
constexpr size_t WS_RSTD1 = 21 * MiB;
constexpr size_t WS_RSTD2 = 58 * MiB;
constexpr size_t WS_SCAL = 23 * MiB;
constexpr size_t WS_U = 24 * MiB;
constexpr size_t WS_V = 40 * MiB;
constexpr size_t WS_USC = 56 * MiB;
constexpr size_t WS_VSC = 57 * MiB;
constexpr size_t WS_XB = 88 * MiB;
constexpr int YAB_PITCH = 1024;
constexpr size_t WS_YA = WS_XB;
constexpr size_t WS_YB = WS_XB + 1024;
constexpr size_t WS_X2B = WS_XB;
constexpr size_t WS_Z = 216 * MiB;
constexpr int IDP = 512;
constexpr size_t WS_MERGED = 888 * MiB;
constexpr size_t WS_IDS = WS_MERGED;
constexpr size_t WS_GATES = WS_MERGED + 512;
constexpr size_t WS_WG8 = 1016 * MiB;
constexpr size_t WS_END = 1018 * MiB;
constexpr int GP8 = 4096;

__device__ __forceinline__ float bf2f(bf16_t h) { return __uint_as_float(((u32)h) << 16); }
__device__ __forceinline__ bf16_t f2bf(float f) { u32 u = __float_as_uint(f); u += 0x7fffu + ((u >> 16) & 1u); return (bf16_t)(u >> 16); }
__device__ __forceinline__ float wave_sum(float v) {
#pragma unroll
    for (int o = 1; o < 64; o <<= 1) v += __shfl_xor(v, o);
    return v;
}
__device__ __forceinline__ float sigmoidf_(float x) { return __builtin_amdgcn_rcpf(1.f + __expf(-x)); }

namespace pg8 {
#define PG8_LAS __attribute__((address_space(3)))
typedef short bf16x8 __attribute__((ext_vector_type(8)));
typedef float f32x4 __attribute__((ext_vector_type(4)));
typedef unsigned u32x4 __attribute__((ext_vector_type(4)));
constexpr int BM = 256, BK = 64, HALF = 128, HTB = HALF * BK * 2  , STAGE_BYTES = 8 * HTB, NXCD = 8, WGM = 8;

__host__ __device__ __forceinline__ int lds_byte(int r, int c) { const int st = (r >> 4) * 2 + (c >> 5), rr = r & 15, cc = c & 31, ob = rr * 64 + cc * 2; return st * 1024 + (ob ^ (((ob >> 9) & 1) << 5)); }
__host__ __device__ __forceinline__ void stage_rc(int b, int& R, int& C) { const int st = b / 1024, sb = b % 1024, swz = sb ^ (((sb >> 9) & 1) << 5); R = (st >> 1) * 16 + swz / 64; C = (st & 1) * 32 + (swz % 64) / 2; }
__host__ __device__ __forceinline__ int perm32(int rho) { const int n = rho >> 4, i = rho & 15; return 8 * (i >> 2) + 4 * n + (i & 3); }

struct Unit { int pm, pn; };
struct Gemm { const bf16_t* A; const bf16_t* Bt; int lda, ldb, K; };

struct StaticOrder {
    int nM, nN, nwg, G, c;
    __host__ __device__ void init(int M, int N, int G_, int c_) { nM = M / BM; nN = N / BM; nwg = nM * nN; G = G_; c = c_; }
    __host__ __device__ bool next(int i, Unit& u) const {
        const long L = (long)i * G + c; if (L >= nwg) return false;
        int wgid = (int)L; { const int q = nwg / NXCD, r = nwg % NXCD, xcd = wgid % NXCD, off = wgid / NXCD; wgid = (xcd < r ? xcd * (q + 1) : r * (q + 1) + (xcd - r) * q) + off; }
        const int nig = WGM * nN, gid = wgid / nig, fm = gid * WGM, gsz = (nM - fm) < WGM ? (nM - fm) : WGM;
        u.pm = fm + ((wgid % nig) % gsz); u.pn = (wgid % nig) / gsz; return true;
    }
};
typedef float f32x2_c __attribute__((ext_vector_type(2))); typedef __bf16 bf16x2_c __attribute__((ext_vector_type(2)));
__device__ __forceinline__ unsigned cvt_pk_bf16(float lo, float hi) { const f32x2_c v = {lo, hi}; const bf16x2_c b = __builtin_convertvector(v, bf16x2_c); return __builtin_bit_cast(unsigned, b); }
__device__ __forceinline__ float bflo(unsigned w) { return __uint_as_float(w << 16); }
__device__ __forceinline__ float bfhi(unsigned w) { return __uint_as_float(w & 0xffff0000u); }

__device__ __forceinline__ float ssq_sum16(const float* p) {
    const f32x4 a = *(const f32x4*)p, b = *(const f32x4*)(p + 4), c = *(const f32x4*)(p + 8), d = *(const f32x4*)(p + 12);
    return (((a[0] + a[1]) + (a[2] + a[3])) + ((b[0] + b[1]) + (b[2] + b[3]))) + (((c[0] + c[1]) + (c[2] + c[3])) + ((d[0] + d[1]) + (d[2] + d[3])));
}
template <bool SSQ> struct EpiRowScale {
    static constexpr bool PERM = true, MID = false;
    bf16_t* O; int ldc; const float* rs; float mul = 1.f;
    __device__ __forceinline__ void operator()(const f32x4 (&acc)[2][2][4][2], const Unit& u, int wr, int wc, int fr, int fq) const {
        const int row0 = u.pm * BM + wr * 64 + fr, col0 = u.pn * BM + wc * 32 + 8 * fq;
#pragma unroll
        for (int ai = 0; ai < 2; ++ai)
#pragma unroll
            for (int m = 0; m < 4; ++m) {
                const int row = row0 + ai * HALF + m * 16;
                float s; if (SSQ) s = rsqrtf(ssq_sum16(rs + (size_t)row * 16) * (1.f / 1024.f) + NORM_EPS) * mul; else s = rs[row] * mul;
                bf16_t* rowp = O + (size_t)row * ldc + col0;
#pragma unroll
                for (int bj = 0; bj < 2; ++bj) {
                    const f32x4 v0 = acc[ai][bj][m][0] * s, v1 = acc[ai][bj][m][1] * s;
                    u32x4 w; w.x = cvt_pk_bf16(v0[0], v0[1]); w.y = cvt_pk_bf16(v0[2], v0[3]); w.z = cvt_pk_bf16(v1[0], v1[1]); w.w = cvt_pk_bf16(v1[2], v1[3]);
                    *(u32x4*)(rowp + bj * HALF) = w;
                }
            }
    }
};
struct EpiRowScaleF8 {
    static constexpr bool PERM = true, MID = false;
    unsigned char* O; int ldc; const float* rs; float mul;
    __device__ __forceinline__ void operator()(const f32x4 (&acc)[2][2][4][2], const Unit& u, int wr, int wc, int fr, int fq) const {
        const int row0 = u.pm * BM + wr * 64 + fr, colp = u.pn * BM + wc * 64 + fq * 16;
#pragma unroll
        for (int ai = 0; ai < 2; ++ai)
#pragma unroll
            for (int m = 0; m < 4; ++m) {
                const int row = row0 + ai * HALF + m * 16;
                const float s = rs[row] * mul;
                int p[4];
#pragma unroll
                for (int bj = 0; bj < 2; ++bj) {
                    const f32x4 v0 = acc[ai][bj][m][0] * s, v1 = acc[ai][bj][m][1] * s;
                    int p0 = 0, p1 = 0;
                    p0 = __builtin_amdgcn_cvt_pk_fp8_f32(v0[0], v0[1], p0, false); p0 = __builtin_amdgcn_cvt_pk_fp8_f32(v0[2], v0[3], p0, true);
                    p1 = __builtin_amdgcn_cvt_pk_fp8_f32(v1[0], v1[1], p1, false); p1 = __builtin_amdgcn_cvt_pk_fp8_f32(v1[2], v1[3], p1, true);
                    p[2 * bj] = p0; p[2 * bj + 1] = p1;
                }
                *(u32x4*)(O + (size_t)row * ldc + colp) = (u32x4){(unsigned)p[0], (unsigned)p[1], (unsigned)p[2], (unsigned)p[3]};
            }
    }
};
template <bool ACCUM> struct EpiGate {
    static constexpr bool PERM = true, MID = false;
    bf16_t* mg; const bf16_t* z; int gcol;
    __device__ __forceinline__ void operator()(const f32x4 (&acc)[2][2][4][2], const Unit& u, int wr, int wc, int fr, int fq) const {
        const int row0 = u.pm * BM + wr * 64 + fr, col0 = u.pn * BM + wc * 32 + 8 * fq;
#pragma unroll
        for (int ai = 0; ai < 2; ++ai)
#pragma unroll
            for (int m = 0; m < 4; ++m) {
                const int row = row0 + ai * HALF + m * 16;
                const bf16_t* gp = z + (size_t)row * NZ + gcol + col0;
                bf16_t* rowp = mg + (size_t)row * DM + col0;
#pragma unroll
                for (int bj = 0; bj < 2; ++bj) {
                    const u32x4 g = *(const u32x4*)(gp + bj * HALF);
                    const f32x4 a0 = acc[ai][bj][m][0], a1 = acc[ai][bj][m][1];
                    float r[8];
                    r[0] = sigmoidf_(bflo(g.x)) * a0[0]; r[1] = sigmoidf_(bfhi(g.x)) * a0[1]; r[2] = sigmoidf_(bflo(g.y)) * a0[2]; r[3] = sigmoidf_(bfhi(g.y)) * a0[3];
                    r[4] = sigmoidf_(bflo(g.z)) * a1[0]; r[5] = sigmoidf_(bfhi(g.z)) * a1[1]; r[6] = sigmoidf_(bflo(g.w)) * a1[2]; r[7] = sigmoidf_(bfhi(g.w)) * a1[3];
                    if (ACCUM) { const u32x4 o = *(const u32x4*)(rowp + bj * HALF);
                        r[0] += bflo(o.x); r[1] += bfhi(o.x); r[2] += bflo(o.y); r[3] += bfhi(o.y); r[4] += bflo(o.z); r[5] += bfhi(o.z); r[6] += bflo(o.w); r[7] += bfhi(o.w); }
                    u32x4 w; w.x = cvt_pk_bf16(r[0], r[1]); w.y = cvt_pk_bf16(r[2], r[3]); w.z = cvt_pk_bf16(r[4], r[5]); w.w = cvt_pk_bf16(r[6], r[7]);
                    *(u32x4*)(rowp + bj * HALF) = w;
                }
            }
    }
};
struct EpiGate2 {
    static constexpr bool PERM = true, MID = true;
    bf16_t* mg; const unsigned char* g8;
    typedef float f2_ __attribute__((ext_vector_type(2)));
    static __device__ __forceinline__ void dec8(unsigned lo_, unsigned hi_, float (&o)[8]) {
        const int lo = (int)lo_, hi = (int)hi_;
        const f2_ a = __builtin_amdgcn_cvt_pk_f32_fp8(lo, false), b = __builtin_amdgcn_cvt_pk_f32_fp8(lo, true), c = __builtin_amdgcn_cvt_pk_f32_fp8(hi, false), d = __builtin_amdgcn_cvt_pk_f32_fp8(hi, true);
        o[0] = a[0]; o[1] = a[1]; o[2] = b[0]; o[3] = b[1]; o[4] = c[0]; o[5] = c[1]; o[6] = d[0]; o[7] = d[1];
    }
    __device__ __forceinline__ void mid(f32x4 (&acc)[2][2][4][2], const Unit& u, int wr, int wc, int fr, int fq) const {
        int row0 = u.pm * BM + wr * 64 + fr; const int colp = u.pn * BM + wc * 64 + fq * 16;
        asm volatile("" : "+v"(row0));
        u32x4 gq[2][4];
#define EG2_LOAD(q_, buf_) do { _Pragma("unroll") for (int mm = 0; mm < 2; ++mm) { const unsigned char* gp = g8 + (size_t)(row0 + ((q_) >> 1) * HALF + (((q_) & 1) * 2 + mm) * 16) * GP8 + colp; \
            gq[buf_][2 * mm] = *(const u32x4*)(gp); gq[buf_][2 * mm + 1] = *(const u32x4*)(gp + 1024); } } while (0)
        EG2_LOAD(0, 0);
#pragma unroll
        for (int q = 0; q < 4; ++q) {
            if (q + 1 < 4) EG2_LOAD(q + 1, (q + 1) & 1);
            __builtin_amdgcn_sched_barrier(0);
            const int ai = q >> 1;
#pragma unroll
            for (int mm = 0; mm < 2; ++mm) { const int m = (q & 1) * 2 + mm;
                const u32x4 wa = gq[q & 1][2 * mm], wb = gq[q & 1][2 * mm + 1];
#pragma unroll
                for (int bj = 0; bj < 2; ++bj) {
                    float ga[8], gb[8], r[8];
                    dec8(bj ? wa.z : wa.x, bj ? wa.w : wa.y, ga); dec8(bj ? wb.z : wb.x, bj ? wb.w : wb.y, gb);
#pragma unroll
                    for (int i = 0; i < 8; ++i) r[i] = (1.f + __expf(-fmaxf(gb[i], -30.f))) * __builtin_amdgcn_rcpf(1.f + __expf(-fmaxf(ga[i], -30.f)));
                    acc[ai][bj][m][0] = acc[ai][bj][m][0] * (f32x4){r[0], r[1], r[2], r[3]};
                    acc[ai][bj][m][1] = acc[ai][bj][m][1] * (f32x4){r[4], r[5], r[6], r[7]};
                }
            }
            __builtin_amdgcn_sched_barrier(0);
        }
#undef EG2_LOAD
    }
    __device__ __forceinline__ void operator()(const f32x4 (&acc)[2][2][4][2], const Unit& u, int wr, int wc, int fr, int fq) const {
        int row0 = u.pm * BM + wr * 64 + fr; const int col0 = u.pn * BM + wc * 32 + 8 * fq, colp = u.pn * BM + wc * 64 + fq * 16;
        asm volatile("" : "+v"(row0));
#pragma unroll
        for (int ai = 0; ai < 2; ++ai)
#pragma unroll
            for (int m = 0; m < 4; ++m) {
                const int row = row0 + ai * HALF + m * 16;
                const u32x4 wb = *(const u32x4*)(g8 + (size_t)row * GP8 + 1024 + colp);
                bf16_t* rowp = mg + (size_t)row * DM + col0;
#pragma unroll
                for (int bj = 0; bj < 2; ++bj) {
                    float gb[8]; dec8(bj ? wb.z : wb.x, bj ? wb.w : wb.y, gb);
                    const f32x4 a0 = acc[ai][bj][m][0], a1 = acc[ai][bj][m][1];
                    const float av[8] = {a0[0], a0[1], a0[2], a0[3], a1[0], a1[1], a1[2], a1[3]};
                    float r[8];
#pragma unroll
                    for (int i = 0; i < 8; ++i) r[i] = av[i] * __builtin_amdgcn_rcpf(1.f + __expf(-fmaxf(gb[i], -30.f)));
                    u32x4 w; w.x = cvt_pk_bf16(r[0], r[1]); w.y = cvt_pk_bf16(r[2], r[3]); w.z = cvt_pk_bf16(r[4], r[5]); w.w = cvt_pk_bf16(r[6], r[7]);
                    *(u32x4*)(rowp + bj * HALF) = w;
                }
            }
    }
};
struct EpiX2 {
    static constexpr bool PERM = true, MID = false;
    const float* x; unsigned char* x2q; int ldq; bf16_t* x2b; float* ssq;
    __device__ __forceinline__ void operator()(const f32x4 (&acc)[2][2][4][2], const Unit& u, int wr, int wc, int fr, int fq) const {
        const int row0 = u.pm * BM + wr * 64 + fr, col0 = u.pn * BM + wc * 32 + 8 * fq, colp = u.pn * BM + wc * 64 + fq * 16;
#pragma unroll
        for (int ai = 0; ai < 2; ++ai)
#pragma unroll
            for (int m = 0; m < 4; ++m) {
                const int row = row0 + ai * HALF + m * 16;
                const size_t off = (size_t)row * DM + col0;
                float ss = 0.f; int p[4];
#pragma unroll
                for (int bj = 0; bj < 2; ++bj) {
                    const f32x4 x0 = *(const f32x4*)(x + off + bj * HALF), x1 = *(const f32x4*)(x + off + bj * HALF + 4);
                    const f32x4 o0 = x0 + acc[ai][bj][m][0], o1 = x1 + acc[ai][bj][m][1];
                    u32x4 w; w.x = cvt_pk_bf16(o0[0], o0[1]); w.y = cvt_pk_bf16(o0[2], o0[3]); w.z = cvt_pk_bf16(o1[0], o1[1]); w.w = cvt_pk_bf16(o1[2], o1[3]);
                    *(u32x4*)(x2b + off + bj * HALF) = w;
                    int p0 = 0, p1 = 0;
                    p0 = __builtin_amdgcn_cvt_pk_fp8_f32(o0[0], o0[1], p0, false); p0 = __builtin_amdgcn_cvt_pk_fp8_f32(o0[2], o0[3], p0, true);
                    p1 = __builtin_amdgcn_cvt_pk_fp8_f32(o1[0], o1[1], p1, false); p1 = __builtin_amdgcn_cvt_pk_fp8_f32(o1[2], o1[3], p1, true);
                    p[2 * bj] = p0; p[2 * bj + 1] = p1;
                    ss += (o0[0] * o0[0] + o0[1] * o0[1]) + (o0[2] * o0[2] + o0[3] * o0[3]) + (o1[0] * o1[0] + o1[1] * o1[1]) + (o1[2] * o1[2] + o1[3] * o1[3]);
                }
                *(u32x4*)(x2q + (size_t)row * ldq + colp) = (u32x4){(unsigned)p[0], (unsigned)p[1], (unsigned)p[2], (unsigned)p[3]};
                ss += __shfl_xor(ss, 16); ss += __shfl_xor(ss, 32);
                if (fq == 0) ssq[(size_t)row * 16 + (u.pn & 3) * 4 + wc] = ss;
            }
    }
};

typedef int v8i_t __attribute__((ext_vector_type(8)));
template <class Epi, class Sched, bool F8 = false>
__device__ __forceinline__ void gemm_phase(PG8_LAS unsigned char* lds, const Gemm g, const Sched& S, const Epi& E) {
    const int tid = threadIdx.x, wid = __builtin_amdgcn_readfirstlane(tid >> 6), lane = tid & 63, wr = wid >> 2, wc = wid & 3, fr = lane & 15, fq = lane >> 4;
    const int K = g.K, nt = K / BK;
    unsigned voffA[2], voffB[2];
#pragma unroll
    for (int i = 0; i < 2; ++i) { int R, C; stage_rc(tid * 16 + i * 8192, R, C); const int Rb = Epi::PERM ? ((R & ~31) + perm32(R & 31)) : R;
        voffA[i] = (unsigned)(R * g.lda + C) * 2u; voffB[i] = (unsigned)(Rb * g.ldb + C) * 2u; }
    const size_t kstep = (size_t)(BK * 2);
    const size_t hstepA = (size_t)HALF * g.lda * 2, hstepB = (size_t)HALF * g.ldb * 2;
    const size_t tstepA = 2 * hstepA, tstepB = 2 * hstepB;
    const unsigned ldsw = (unsigned)wid * 1024u;
    const int aoff = lds_byte(wr * 64 + fr, fq * 8), boff = lds_byte(wc * 32 + fr, fq * 8);
    const int sub8 = (fq >> 1) * 1024 + fr * 64 + (((fq & 1) ^ (fr >> 3)) * 32);
    const int aoff8 = ((wr * 64) >> 4) * 2048 + sub8, boff8 = ((wc * 32) >> 4) * 2048 + sub8;
#define PG8_SA(b, h) (((b) * 2 + (h)) * HTB)
#define PG8_SB(b, h) ((4 + (b) * 2 + (h)) * HTB)
#define PG8_STAGE(bufoff, gbase, voff) do { _Pragma("unroll") for (int _i = 0; _i < 2; ++_i) \
        __builtin_amdgcn_global_load_lds((const unsigned*)((const char*)(gbase) + (voff)[_i]), (PG8_LAS unsigned*)(lds + (bufoff) + ldsw + _i * 8192), 16, 0, 0); } while (0)
#define PG8_LD8(p_) ({ typedef int i4_ __attribute__((ext_vector_type(4))); const i4_ lo_ = *(const PG8_LAS i4_*)(p_), hi_ = *(const PG8_LAS i4_*)((p_) + 16); __builtin_shufflevector(lo_, hi_, 0, 1, 2, 3, 4, 5, 6, 7); })
#define PG8_LDA(dst, b, h) do { if constexpr (F8) { _Pragma("unroll") for (int m = 0; m < 4; ++m) dst##8[m] = PG8_LD8(lds + PG8_SA(b, h) + aoff8 + m * 2048); } else { \
        _Pragma("unroll") for (int m = 0; m < 4; ++m) _Pragma("unroll") for (int k = 0; k < 2; ++k) dst[m][k] = *(const PG8_LAS bf16x8*)(lds + PG8_SA(b, h) + aoff + m * 2048 + k * 1024); } } while (0)
#define PG8_LDB(dst, b, h) do { if constexpr (F8) { _Pragma("unroll") for (int n = 0; n < 2; ++n) dst##8[n] = PG8_LD8(lds + PG8_SB(b, h) + boff8 + n * 2048); } else { \
        _Pragma("unroll") for (int n = 0; n < 2; ++n) _Pragma("unroll") for (int k = 0; k < 2; ++k) dst[n][k] = *(const PG8_LAS bf16x8*)(lds + PG8_SB(b, h) + boff + n * 2048 + k * 1024); } } while (0)
#define PG8_MMA(ai, bj, At, Bt) do { __builtin_amdgcn_s_setprio(1); if constexpr (F8) { _Pragma("unroll") for (int m = 0; m < 4; ++m) _Pragma("unroll") for (int n = 0; n < 2; ++n) \
        asm volatile("v_mfma_scale_f32_16x16x128_f8f6f4 %0, %1, %2, %0, %3, %3 op_sel_hi:[0,0,0]" : "+v"(acc[ai][bj][m][n]) : "v"(Bt##8[n]), "v"(At##8[m]), "v"(sc127)); } else { \
        _Pragma("unroll") for (int m = 0; m < 4; ++m) _Pragma("unroll") for (int n = 0; n < 2; ++n) _Pragma("unroll") for (int k = 0; k < 2; ++k) \
        acc[ai][bj][m][n] = __builtin_amdgcn_mfma_f32_16x16x32_bf16(Bt[n][k], At[m][k], acc[ai][bj][m][n], 0, 0, 0); } __builtin_amdgcn_s_setprio(0); } while (0)
#define PG8_WAIT_V(n) asm volatile("s_waitcnt vmcnt(" #n ")" ::: "memory")
#define PG8_WAIT_L(n) asm volatile("s_waitcnt lgkmcnt(" #n ")" ::: "memory")
#define PG8_BAR __builtin_amdgcn_s_barrier()
#define PG8_SCHED __builtin_amdgcn_sched_barrier(0)
#define PG8_KBODY(t) do { \
            const bool last = (t == nt - 2); \
            const char* a1 = cA + (size_t)(t + 1) * kstep; \
            const char* a2 = last ? nA : cA + (size_t)(t + 2) * kstep; const char* b2 = last ? nB : cB + (size_t)(t + 2) * kstep; \
            const char* a3 = a2 + kstep; const char* b3 = b2 + kstep; \
 \
            PG8_LDB(B0, 0, 0); PG8_LDB(B1, 0, 1); PG8_SCHED; PG8_LDA(At, 0, 0); PG8_STAGE(PG8_SA(1, 1), a1 + hstepA, voffA); \
            PG8_WAIT_V(8); PG8_WAIT_L(0); PG8_BAR; PG8_MMA(0, 0, At, B0); PG8_MMA(0, 1, At, B1); PG8_BAR; PG8_SCHED; \
 \
            PG8_LDA(At, 0, 1); PG8_STAGE(PG8_SB(0, 0), b2, voffB); PG8_STAGE(PG8_SB(0, 1), b2 + hstepB, voffB); PG8_STAGE(PG8_SA(0, 0), a2, voffA); \
            PG8_WAIT_V(8); PG8_WAIT_L(0); PG8_BAR; PG8_MMA(1, 0, At, B0); PG8_MMA(1, 1, At, B1); PG8_BAR; PG8_SCHED; \
 \
            PG8_LDB(B0, 1, 0); PG8_LDB(B1, 1, 1); PG8_SCHED; PG8_LDA(At, 1, 0); PG8_STAGE(PG8_SA(0, 1), a2 + hstepA, voffA); \
            PG8_WAIT_V(8); PG8_WAIT_L(0); PG8_BAR; PG8_MMA(0, 0, At, B0); PG8_MMA(0, 1, At, B1); PG8_BAR; PG8_SCHED; \
 \
            PG8_LDA(At, 1, 1); PG8_STAGE(PG8_SB(1, 0), b3, voffB); PG8_STAGE(PG8_SB(1, 1), b3 + hstepB, voffB); PG8_STAGE(PG8_SA(1, 0), a3, voffA); \
            PG8_WAIT_V(8); PG8_WAIT_L(0); PG8_BAR; PG8_MMA(1, 0, At, B0); PG8_MMA(1, 1, At, B1); PG8_BAR; PG8_SCHED; \
        } while (0)
    Unit cur, nxt; int ui = 0;
    if (!S.next(0, cur)) return;
    f32x4 acc[2][2][4][2];
#pragma unroll
    for (int a = 0; a < 2; ++a)
#pragma unroll
        for (int b = 0; b < 2; ++b)
#pragma unroll
            for (int m = 0; m < 4; ++m)
#pragma unroll
                for (int n = 0; n < 2; ++n) acc[a][b][m][n] = (f32x4){0.f, 0.f, 0.f, 0.f};
    bf16x8 At[4][2], B0[2][2], B1[2][2]; v8i_t At8[4], B08[2], B18[2];
    const int sc127 = 127;
    const char* cA = (const char*)g.A + (size_t)cur.pm * tstepA; const char* cB = (const char*)g.Bt + (size_t)cur.pn * tstepB;
    PG8_STAGE(PG8_SB(0, 0), cB, voffB); PG8_STAGE(PG8_SB(0, 1), cB + hstepB, voffB); PG8_STAGE(PG8_SA(0, 0), cA, voffA); PG8_STAGE(PG8_SA(0, 1), cA + hstepA, voffA);
    if (wr == 1) PG8_BAR;
    PG8_WAIT_V(2); PG8_BAR;
    PG8_STAGE(PG8_SB(1, 0), cB + kstep, voffB); PG8_STAGE(PG8_SA(1, 0), cA + kstep, voffA); PG8_STAGE(PG8_SB(1, 1), cB + hstepB + kstep, voffB);
    PG8_WAIT_V(6); PG8_BAR;
    for (;;) {
        const bool has_next = S.next(ui + 1, nxt);
        const char* nA = has_next ? (const char*)g.A + (size_t)nxt.pm * tstepA : cA; const char* nB = has_next ? (const char*)g.Bt + (size_t)nxt.pn * tstepB : cB;
        if constexpr (Epi::MID) {
#pragma nounroll
            for (int t = 0; t < (nt >> 1); t += 2) PG8_KBODY(t);
            E.mid(acc, cur, wr, wc, fr, fq);
#pragma nounroll
            for (int t = (nt >> 1); t < nt; t += 2) PG8_KBODY(t);
        } else {
#pragma nounroll
            for (int t = 0; t < nt; t += 2) PG8_KBODY(t);
        }
        if (wr == 0) PG8_BAR;
        if constexpr (F8) asm volatile("s_nop 15\n\ts_nop 15" ::: "memory");
        E(acc, cur, wr, wc, fr, fq);
        if (!has_next) break;
#pragma unroll
        for (int a = 0; a < 2; ++a)
#pragma unroll
            for (int b = 0; b < 2; ++b)
#pragma unroll
                for (int m = 0; m < 4; ++m)
#pragma unroll
                    for (int n = 0; n < 2; ++n) acc[a][b][m][n] = (f32x4){0.f, 0.f, 0.f, 0.f};
        cur = nxt; cA = nA; cB = nB; ++ui;
        if (wr == 1) PG8_BAR;
    }
    PG8_WAIT_V(0);
    PG8_BAR;
#undef PG8_SA
#undef PG8_SB
#undef PG8_STAGE
#undef PG8_LDA
#undef PG8_KBODY
#undef PG8_LD8
#undef PG8_LDB
#undef PG8_MMA
#undef PG8_WAIT_V
#undef PG8_WAIT_L
#undef PG8_BAR
#undef PG8_SCHED
}
}

constexpr int NWAVES = 8;
constexpr int LDS_RING_BYTES = 131072, LDSCTL_OFF = 143360, MISC_OFF = LDSCTL_OFF + 320, LDS_BYTES = 147456;
#define LAS __attribute__((address_space(3)))
#define GAS __attribute__((address_space(1)))
typedef float f32x4 __attribute__((ext_vector_type(4)));
typedef unsigned v4u __attribute__((ext_vector_type(4)));
typedef unsigned v2u __attribute__((ext_vector_type(2)));
#define LDS_WAIT() asm volatile("s_waitcnt lgkmcnt(0)" ::: "memory")

constexpr int CW_BAR = 4096;
#define XB_TMO      128
#define XB_XCNT(j)  (256  + 64 * (j))
#define XB_XSUB(j)  (1280 + 64 * (j))
#define XB_XGEN(j)  (2304 + 64 * (j))
#define XB_TOP      3328
#define XB_TOPGEN   3392
#define XCD_BAR_WORDS 3456
#define XB_SPIN_CAP (1u << 20)
__device__ __forceinline__ unsigned xb_ld(unsigned* p)              { return __hip_atomic_load(p, __ATOMIC_RELAXED, __HIP_MEMORY_SCOPE_AGENT); }
__device__ __forceinline__ unsigned xb_add(unsigned* p, unsigned v) { return __hip_atomic_fetch_add(p, v, __ATOMIC_RELAXED, __HIP_MEMORY_SCOPE_AGENT); }
__device__ __forceinline__ unsigned xb_xcc_id() { return (unsigned)__builtin_amdgcn_s_getreg((3 << 11) | 20) & 0xFu; }
#define XB_SPIN(cond, bar) do { unsigned _sp = 0; while (cond) { __builtin_amdgcn_s_sleep(1); \
    if ((++_sp & 255u) == 0u) { if (xb_ld(&(bar)[XB_TMO])) break; if (_sp > XB_SPIN_CAP) { atomicAdd(&(bar)[XB_TMO], 1u); break; } } } } while (0)
struct XcdBarrier { unsigned* bar; unsigned x; volatile LAS unsigned* st; };
__device__ __forceinline__ XcdBarrier xcd_barrier_post(unsigned* bar, volatile LAS unsigned* st) {
    XcdBarrier b; b.bar = bar; b.x = xb_xcc_id(); b.st = st;
    if (threadIdx.x == 0) (void)xb_add(&bar[XB_XCNT(b.x)], 1u);
    return b;
}
__device__ __forceinline__ void xcd_barrier_complete(unsigned* bar, unsigned x, unsigned& nloc, unsigned& nx) {
    const unsigned G = gridDim.x * gridDim.y * gridDim.z;
    unsigned sum, cnt, mine, sp = 0u;
    for (;;) {
        sum = 0u; cnt = 0u; mine = 0u;
#pragma unroll
        for (unsigned j = 0; j < 16; ++j) { const unsigned c = xb_ld(&bar[XB_XCNT(j)]); sum += c; cnt += (c > 0u) ? 1u : 0u; mine = (j == x) ? c : mine; }
        if (sum == G) break;
        __builtin_amdgcn_s_sleep(1);
        if ((++sp & 255u) == 0u) { if (xb_ld(&bar[XB_TMO])) break; if (sp > XB_SPIN_CAP) { atomicAdd(&bar[XB_TMO], 1u); break; } }
    }
    nloc = mine > 0u ? mine : 1u; nx = cnt > 0u ? cnt : 1u;
}
__device__ __forceinline__ void xcd_barrier(const XcdBarrier& b) {
    asm volatile("s_waitcnt vmcnt(0)" ::: "memory");
    __syncthreads();
    if (threadIdx.x == 0) {
        unsigned* bar = b.bar;
        __builtin_amdgcn_s_waitcnt(0);
        unsigned nloc = b.st[0], nx = b.st[1];
        if (nloc == 0u) { xcd_barrier_complete(bar, b.x, nloc, nx); b.st[0] = nloc; b.st[1] = nx; }
        const unsigned old = xb_add(&bar[XB_XSUB(b.x)], 1u);
        const unsigned gen = old / nloc;
        if (old + 1u == (gen + 1u) * nloc) {
            __builtin_amdgcn_fence(__ATOMIC_RELEASE, "agent");
            asm volatile("s_waitcnt vmcnt(0)" ::: "memory");
            const unsigned og = xb_add(&bar[XB_TOP], 1u);
            const unsigned tg = og / nx;
            if (og + 1u == (tg + 1u) * nx) xb_add(&bar[XB_TOPGEN], 1u);
            else XB_SPIN(xb_ld(&bar[XB_TOPGEN]) == tg, bar);
            __builtin_amdgcn_fence(__ATOMIC_ACQUIRE, "agent");
            xb_add(&bar[XB_XGEN(b.x)], 1u);
            asm volatile("s_waitcnt vmcnt(0)" ::: "memory");
        } else {
            XB_SPIN(xb_ld(&bar[XB_XGEN(b.x)]) == gen, bar);
            __builtin_amdgcn_fence(__ATOMIC_ACQUIRE, "agent");
            asm volatile("s_waitcnt vmcnt(0)" ::: "memory");
        }
    }
    __syncthreads();
}

constexpr int CW_GRP = 16384;
__device__ __forceinline__ void group_barrier(unsigned* ctl, unsigned grp, unsigned nloc) {
    asm volatile("s_waitcnt vmcnt(0)" ::: "memory");
    __syncthreads();
    if (threadIdx.x == 0) {
        unsigned* cnt = ctl + CW_GRP + 64 * grp; unsigned* genw = ctl + CW_GRP + 1024 + 64 * grp; unsigned* tmo = ctl + CW_GRP + 2048;
        __builtin_amdgcn_fence(__ATOMIC_RELEASE, "agent");
        asm volatile("s_waitcnt vmcnt(0)" ::: "memory");
        const unsigned old = xb_add(cnt, 1u), gen = old / nloc;
        if (old + 1u == (gen + 1u) * nloc) xb_add(genw, 1u);
        else { unsigned sp = 0; while (xb_ld(genw) == gen) { __builtin_amdgcn_s_sleep(1); if ((++sp & 255u) == 0u) { if (xb_ld(tmo)) break; if (sp > XB_SPIN_CAP) { atomicAdd(tmo, 1u); break; } } } }
        __builtin_amdgcn_fence(__ATOMIC_ACQUIRE, "agent");
        asm volatile("s_waitcnt vmcnt(0)" ::: "memory");
    }
    __syncthreads();
}
struct Args { const float* in[28]; float* out; unsigned char* ws; int ph_lo, ph_hi, li, pad; };

__device__ __forceinline__ void p0_transpose_item(const float* W, const float* sc, int K, int N, bf16_t* WT, LAS float* scr, int item, int lane, unsigned char* W8 = nullptr, int n8 = 0, int ldw = 0, int koff = 0) {
    if (ldw == 0) ldw = K;
    const int nblk = N / 32, kb = item / nblk, nb = item % nblk, k0 = 64 * kb, n0 = 32 * nb;
#pragma unroll 8
    for (int i = 0; i < 32; ++i) { const int kk = 2 * i + (lane >> 5); const float s = sc ? sc[k0 + kk] : 1.f; scr[kk * 33 + (lane & 31)] = W[(size_t)(k0 + kk) * N + n0 + (lane & 31)] * s; }
    LDS_WAIT(); asm volatile("" ::: "memory");
    const int c = lane & 7;
#pragma unroll
    for (int j = 0; j < 4; ++j) { const int n = (lane >> 3) + 8 * j; const LAS float* s = scr + (8 * c) * 33 + n;
        v4u o; o.x = pg8::cvt_pk_bf16(s[0 * 33], s[1 * 33]); o.y = pg8::cvt_pk_bf16(s[2 * 33], s[3 * 33]); o.z = pg8::cvt_pk_bf16(s[4 * 33], s[5 * 33]); o.w = pg8::cvt_pk_bf16(s[6 * 33], s[7 * 33]);
        *(v4u*)(WT + (size_t)(n0 + n) * ldw + koff + k0 + 8 * c) = o;
        if (W8 && n0 + n >= n8) {
            int p0 = 0, p1 = 0;
            p0 = __builtin_amdgcn_cvt_pk_fp8_f32(s[0 * 33] * 32.f, s[1 * 33] * 32.f, p0, false); p0 = __builtin_amdgcn_cvt_pk_fp8_f32(s[2 * 33] * 32.f, s[3 * 33] * 32.f, p0, true);
            p1 = __builtin_amdgcn_cvt_pk_fp8_f32(s[4 * 33] * 32.f, s[5 * 33] * 32.f, p1, false); p1 = __builtin_amdgcn_cvt_pk_fp8_f32(s[6 * 33] * 32.f, s[7 * 33] * 32.f, p1, true);
            *(v2u*)(W8 + (size_t)(n0 + n - n8) * K + k0 + 8 * c) = (v2u){(unsigned)p0, (unsigned)p1};
        } }
    LDS_WAIT(); asm volatile("" ::: "memory");
}
__device__ __forceinline__ void p0_wk_item(const float* __restrict__ Wq, const float* __restrict__ sc, const float* __restrict__ keys, unsigned char* __restrict__ Wk8, int item, int lane) {
    typedef short b8_t __attribute__((ext_vector_type(8)));
    const int hc = item >> 6, kb = item & 63, fr = lane & 15, fq = lane >> 4, k = kb * 16 + fr;
    const int kp = (k & ~255) | (((k >> 5) & 3) << 6) | (((k >> 3) & 3) << 4) | (((k >> 7) & 1) << 3) | (k & 7);
    const float s = sc[k];
    b8_t bw[4];
#pragma unroll
    for (int ks = 0; ks < 4; ++ks) {
        const float* p = Wq + (size_t)k * 2048 + hc * 128 + 32 * ks + 8 * fq; const f32x4 a = *(const f32x4*)p * s, b = *(const f32x4*)(p + 4) * s;
        v4u w; w.x = pg8::cvt_pk_bf16(a[0], a[1]); w.y = pg8::cvt_pk_bf16(a[2], a[3]); w.z = pg8::cvt_pk_bf16(b[0], b[1]); w.w = pg8::cvt_pk_bf16(b[2], b[3]); bw[ks] = __builtin_bit_cast(b8_t, w);
    }
#pragma unroll
    for (int nt = 0; nt < 8; ++nt) {
        f32x4 acc = (f32x4){0.f, 0.f, 0.f, 0.f};
#pragma unroll
        for (int ks = 0; ks < 4; ++ks) {
            const float* p = keys + ((size_t)hc * 128 + 16 * nt + fr) * 128 + 32 * ks + 8 * fq; const f32x4 a = *(const f32x4*)p, b = *(const f32x4*)(p + 4);
            v4u w; w.x = pg8::cvt_pk_bf16(a[0], a[1]); w.y = pg8::cvt_pk_bf16(a[2], a[3]); w.z = pg8::cvt_pk_bf16(b[0], b[1]); w.w = pg8::cvt_pk_bf16(b[2], b[3]);
            acc = __builtin_amdgcn_mfma_f32_16x16x32_bf16(__builtin_bit_cast(b8_t, w), bw[ks], acc, 0, 0, 0);
        }
#pragma unroll
        for (int e = 0; e < 4; ++e) Wk8[(size_t)(hc * 128 + (4 * fq + e) * 8 + nt) * DM + kp] = (unsigned char)__builtin_amdgcn_cvt_pk_fp8_f32(acc[e] * 32.f, 0.f, 0, false);
    }
}
typedef unsigned v6u_t __attribute__((ext_vector_type(6)));
typedef unsigned v3u_t __attribute__((ext_vector_type(3)));
typedef float v16f_t __attribute__((ext_vector_type(16)));
typedef float v32f_t __attribute__((ext_vector_type(32)));
__device__ __forceinline__ void p0_row_fp6(const float* in, const float* cs, unsigned char* out, float* sc, int lane) {
    f32x4 v[4]; float mx = 0.f;
#pragma unroll
    for (int i = 0; i < 4; ++i) { v[i] = *(const f32x4*)(in + lane * 16 + 4 * i); if (cs) v[i] = v[i] * *(const f32x4*)(cs + lane * 16 + 4 * i);
        mx = fmaxf(mx, fmaxf(fmaxf(fabsf(v[i][0]), fabsf(v[i][1])), fmaxf(fabsf(v[i][2]), fabsf(v[i][3])))); }
#pragma unroll
    for (int o = 1; o < 64; o <<= 1) mx = fmaxf(mx, __shfl_xor(mx, o));
    mx = fmaxf(mx, 1e-30f);
    const float q = 7.5f / mx;
    v16f_t a, b;
#pragma unroll
    for (int i = 0; i < 16; ++i) { a[i] = 0.f; b[i] = 0.f; }
#pragma unroll
    for (int i = 0; i < 8; ++i) { a[i] = v[(2 * i) >> 2][(2 * i) & 3] * q; b[i] = v[(2 * i + 1) >> 2][(2 * i + 1) & 3] * q; }
    const v6u_t p = __builtin_amdgcn_cvt_scalef32_2xpk16_fp6_f32(a, b, 1.0f);
    *(v3u_t*)(out + lane * 12) = (v3u_t){p[0], p[1], p[2]};
    if (lane == 0) *sc = mx * (1.f / 7.5f);
}
__device__ __forceinline__ void p0_convert(const float* in, const float* cs, bf16_t* out, size_t n, int gw, int NGW, int lane) {
    for (size_t i = ((size_t)gw * 64 + lane) * 8; i < n; i += (size_t)NGW * 512) {
        f32x4 a = *(const f32x4*)(in + i), b = *(const f32x4*)(in + i + 4);
        if (cs) { const int c = (int)(i & 1023); a = a * *(const f32x4*)(cs + c); b = b * *(const f32x4*)(cs + c + 4); }
        v4u o; o.x = pg8::cvt_pk_bf16(a[0], a[1]); o.y = pg8::cvt_pk_bf16(a[2], a[3]); o.z = pg8::cvt_pk_bf16(b[0], b[1]); o.w = pg8::cvt_pk_bf16(b[2], b[3]);
        *(v4u*)(out + i) = o;
    }
}

namespace da {
typedef short bf16x8 __attribute__((ext_vector_type(8)));
typedef short s16x4 __attribute__((ext_vector_type(4)));
typedef float f32x16 __attribute__((ext_vector_type(16)));
typedef const LAS unsigned char* lcp;
constexpr float LOG2E = 1.4426950408889634f, C2 = 0.125f * LOG2E, THR = 8.f;
constexpr int RSLOT = 16384, LDS_KR = 0, LDS_VR = 4 * RSLOT, SCR_OFF = 8 * RSLOT, COMB_OFF = 0;
#define DA_SBAR() __builtin_amdgcn_sched_barrier(0)
#define DA_PIN(x) asm volatile("" : "+v"(x))
#define DA_MFMA(a, b, c) __builtin_amdgcn_mfma_f32_32x32x16_bf16(a, b, c, 0, 0, 0)
#define DA_WAIT_BAR(N) asm volatile("s_waitcnt vmcnt(" #N ") lgkmcnt(0)\n\ts_barrier" ::: "memory")
#define DA_MX3(a, b, c) __builtin_fmaxf(__builtin_fmaxf((a), (b)), (c))
__device__ __forceinline__ int crow(int r, int hi) { return (r & 3) + 8 * (r >> 2) + 4 * hi; }
__device__ __forceinline__ s16x4 vtr(lcp p) { return __builtin_bit_cast(s16x4, __builtin_amdgcn_ds_read_tr16_b64_v4i16((LAS s16x4*)p)); }
__device__ __forceinline__ unsigned cvtpk(float lo, float hi) { unsigned r; asm("v_cvt_pk_bf16_f32 %0, %1, %2" : "=v"(r) : "v"(lo), "v"(hi)); return r; }
__device__ __forceinline__ void glds16(const void* g, unsigned lds_base) {
    unsigned sv; asm volatile("s_mov_b32 %0, m0\n\ts_mov_b32 m0, %2\n\ts_nop 0\n\tglobal_load_lds_dwordx4 %1, off\n\ts_mov_b32 m0, %0" : "=&s"(sv) : "v"(g), "s"(lds_base) : "memory"); }
__device__ __forceinline__ void glds16_o128(const void* g, unsigned lds_base) {
    unsigned sv; asm volatile("s_mov_b32 %0, m0\n\ts_mov_b32 m0, %2\n\ts_nop 0\n\tglobal_load_lds_dwordx4 %1, off offset:128\n\ts_mov_b32 m0, %0" : "=&s"(sv) : "v"(g), "s"(lds_base) : "memory"); }
__device__ __forceinline__ void kload2(bf16x8* kf, lcp kp, int d0) { kf[2 * d0] = *(const LAS bf16x8*)(kp + d0 * 2048); kf[2 * d0 + 1] = *(const LAS bf16x8*)(kp + d0 * 2048 + 512); }
__device__ __forceinline__ float max16(const f32x16& p) {
    float a = DA_MX3(p[0], p[1], p[2]), b = DA_MX3(p[3], p[4], p[5]); a = DA_MX3(a, p[6], p[7]); b = DA_MX3(b, p[8], p[9]); a = DA_MX3(a, p[10], p[11]); b = DA_MX3(b, p[12], p[13]);
    a = DA_MX3(a, p[14], p[15]); return __builtin_fmaxf(a, b); }
__device__ __forceinline__ float rowmax(const f32x16& p0, const f32x16& p1, float offA, float offB) {
    const float m = __builtin_fmaxf(__builtin_fmaf(max16(p0), C2, offA), __builtin_fmaf(max16(p1), C2, offB));
    auto rr = __builtin_amdgcn_permlane32_swap(__float_as_uint(m), __float_as_uint(m), false, false);
    return __builtin_fmaxf(__uint_as_float(rr[0]), __uint_as_float(rr[1])); }
__device__ __forceinline__ void cmask(f32x16& p0, f32x16& p1, int jb, int qrel, int hi) {
    const int kb = 64 * jb + 4 * hi;
#pragma unroll
    for (int r = 0; r < 16; ++r) { const int kv = kb + (r & 3) + 8 * (r >> 2); if (kv > qrel) p0[r] = -INFINITY; if (kv + 32 > qrel) p1[r] = -INFINITY; } }

__device__ __forceinline__ void attn_epilogue_body(LAS unsigned char* lds, f32x16 (&o)[4], float l_reg, bf16_t* __restrict__ yb, const float* __restrict__ subln_w, float lam,
                                                   size_t rowb, int q0, int h, int wave, int lane) {
    asm volatile("" : "+v"(lane));
    const int r32 = lane & 31, hi = lane >> 5, map = wave >> 2, qs = wave & 3;
    LAS float* wsf = (LAS float*)(lds + SCR_OFF) + wave * 64;
    if (hi == 0) wsf[r32] = __builtin_amdgcn_rcpf(l_reg);
    float il[16];
#pragma unroll
    for (int g = 0; g < 4; ++g) { const f32x4 t4 = *(const LAS f32x4*)(wsf + 8 * g + 4 * hi); il[4 * g] = t4[0]; il[4 * g + 1] = t4[1]; il[4 * g + 2] = t4[2]; il[4 * g + 3] = t4[3]; }
    __syncthreads();
    LAS float* comb = (LAS float*)(lds + COMB_OFF) + qs * 4096;
    if (map == 1) {
#pragma unroll
        for (int d = 0; d < 4; ++d)
#pragma unroll
            for (int r = 0; r < 16; ++r) comb[crow(r, hi) * 128 + 32 * d + r32] = o[d][r] * il[r];
    }
    __syncthreads();
    if (map == 0) {
        float sw[4];
#pragma unroll
        for (int d = 0; d < 4; ++d) sw[d] = subln_w[32 * d + r32] * (1.f - LAM_INIT);
#pragma unroll
        for (int r = 0; r < 16; ++r) {
            float v[4], ss = 0.f;
#pragma unroll
            for (int d = 0; d < 4; ++d) { v[d] = o[d][r] * il[r] - lam * comb[crow(r, hi) * 128 + 32 * d + r32]; ss += v[d] * v[d]; }
            ss += __shfl_xor(ss, 1); ss += __shfl_xor(ss, 2); ss += __shfl_xor(ss, 4); ss += __shfl_xor(ss, 8); ss += __shfl_xor(ss, 16);
            const float rs = rsqrtf(ss * (1.f / 128.f) + SUBLN_EPS);
            bf16_t* op = yb + (rowb + q0 + crow(r, hi)) * YAB_PITCH + h * 128 + r32;
#pragma unroll
            for (int d = 0; d < 4; ++d) op[32 * d] = f2bf(v[d] * rs * sw[d]);
        }
    }
    __syncthreads();
}
__device__ __forceinline__ void attn_unit(LAS unsigned char* lds, const bf16_t* __restrict__ z, bf16_t* __restrict__ yb, const float* __restrict__ subln_w, float lam,
                                          int b, int h, int qblk, int wave_, int lane) {
    const int wave = __builtin_amdgcn_readfirstlane(wave_);
    const int r32 = lane & 31, hi = lane >> 5, map = wave >> 2, qs = wave & 3;
    const int q0 = qblk * 128 + qs * 32, NT = 2 * qblk + 2, qrel = qs * 32 + r32;
    const size_t rowb = (size_t)b * SEQ;
    const float slope = exp2f(-2.f * (float)(h + 1)), slope2 = slope * LOG2E, s64 = 64.f * slope2, s32 = 32.f * slope2;
    const unsigned lds0 = (unsigned)(uintptr_t)lds;
    LAS float* wsf = (LAS float*)(lds + SCR_OFF) + wave * 64;
    const bf16_t* ksrc = z + (rowb + lane) * ZP + C_ZK + h * 128 + wave * 8;
    const int pc0 = 2 * wave;
    const bf16_t* vsrc0 = z + (rowb + 16 * (pc0 & 3) + (lane >> 2)) * ZP + C_ZV + h * 128 + 32 * (pc0 >> 2) + (lane & 3) * 8;
    const unsigned kdst = lds0 + LDS_KR + wave * 1024, vdst = lds0 + LDS_VR + pc0 * 1024;
#define DMA_K(t, slot) do { const bf16_t* k_ = ksrc + (size_t)(t) * 64 * ZP; const unsigned d_ = (unsigned)__builtin_amdgcn_readfirstlane(kdst + (slot)); glds16(k_, d_); glds16_o128(k_, d_ + 8192 - 128); } while (0)
#define DMA_V(t, slot) do { const size_t o_ = (size_t)(t) * 64 * ZP; const unsigned d_ = (unsigned)__builtin_amdgcn_readfirstlane(vdst + (slot)); glds16(vsrc0 + o_, d_); glds16(vsrc0 + o_ + 16 * ZP, d_ + 1024); } while (0)
    const lcp vp0 = lds + LDS_VR + ((lane >> 4) & 1) * 32 + (lane & 3) * 8 + (4 * hi + ((lane & 15) >> 2)) * 64;
    const lcp kp0 = lds + LDS_KR + map * 8192 + hi * 1024 + r32 * 16;
    DMA_K(0, 0); DMA_V(0, 0); DMA_K(1, RSLOT);
    bf16x8 qr[4];
    {
        const bf16_t* qp = z + (rowb + q0 + r32) * ZP + C_Q + h * 128 + map * 64 + hi * 8;
#pragma unroll
        for (int d0 = 0; d0 < 4; ++d0) qr[d0] = *(const bf16x8*)(qp + d0 * 16);
    }
    f32x16 bias16;
#pragma unroll
    for (int r = 0; r < 16; ++r) bias16[r] = (8.f * slope) * (float)((r & 3) + 8 * (r >> 2));
    DA_PIN(bias16);
    float mhat = 0.f, l_reg = 0.f, offA = slope2 * (float)(4 * hi);
    f32x16 o[4];
#pragma unroll
    for (int d = 0; d < 4; ++d) o[d] = (f32x16){};
    bool resc = false;
    f32x16 c0, c1; bf16x8 kf[8]; s16x4 vlo[4], vhi[4]; v4u pw0, pw1, pw2, pw3;
#define SL(t) ((((t)) & 3) * RSLOT)
#define EX(v, nm) __builtin_amdgcn_exp2f(__builtin_fmaf((v), C2, (nm)))
#define RESC() do { if (resc) { _Pragma("unroll") for (int d_ = 0; d_ < 4; ++d_) _Pragma("unroll") for (int r = 0; r < 16; ++r) o[d_][r] *= wsf[crow(r, hi)]; } } while (0)
#define PKW(P, i) pg8::cvt_pk_bf16(P[i], P[(i) + 1])
    DMA_K(2, 2 * RSLOT); DMA_K(3, 3 * RSLOT); DMA_V(1, RSLOT);
    DA_WAIT_BAR(10);
#pragma unroll
    for (int d0 = 0; d0 < 4; ++d0) kload2(kf, kp0, d0);
    c0 = DA_MFMA(kf[0], qr[0], bias16); c1 = DA_MFMA(kf[1], qr[0], bias16); c0 = DA_MFMA(kf[2], qr[1], c0); c1 = DA_MFMA(kf[3], qr[1], c1);
    c0 = DA_MFMA(kf[4], qr[2], c0); c1 = DA_MFMA(kf[5], qr[2], c1); c0 = DA_MFMA(kf[6], qr[3], c0); c1 = DA_MFMA(kf[7], qr[3], c1);
    if (NT == 2) cmask(c0, c1, 0, qrel, hi);
    { mhat = rowmax(c0, c1, offA, offA + s32); const float nmh0 = offA - mhat, nmh1 = nmh0 + s32; float sacc = 0.f;
#pragma unroll
      for (int r = 0; r < 16; ++r) { c0[r] = EX(c0[r], nmh0); c1[r] = EX(c1[r], nmh1); sacc += c0[r] + c1[r]; }
      l_reg = sacc; }
    pw0 = (v4u){PKW(c0, 0), PKW(c0, 2), PKW(c0, 4), PKW(c0, 6)}; pw1 = (v4u){PKW(c0, 8), PKW(c0, 10), PKW(c0, 12), PKW(c0, 14)};
    pw2 = (v4u){PKW(c1, 0), PKW(c1, 2), PKW(c1, 4), PKW(c1, 6)}; pw3 = (v4u){PKW(c1, 8), PKW(c1, 10), PKW(c1, 12), PKW(c1, 14)};
    DA_WAIT_BAR(6);
    DMA_K(4, 0); DMA_V(2, 2 * RSLOT);
#pragma unroll
    for (int d0 = 0; d0 < 4; ++d0) kload2(kf, kp0 + RSLOT, d0);
    if (NT == 2) { DA_WAIT_BAR(0); } else { DA_WAIT_BAR(8); }
#define PAF(k) __builtin_bit_cast(bf16x8, pw##k)
#define VFR(i) (bf16x8){vlo[(i) & 3][0], vlo[(i) & 3][1], vlo[(i) & 3][2], vlo[(i) & 3][3], vhi[(i) & 3][0], vhi[(i) & 3][1], vhi[(i) & 3][2], vhi[(i) & 3][3]}
#define VOFF(i) ((((i) & 3) * 4 + ((i) >> 2)) * 1024)
#define VRD(i) do { vlo[(i) & 3] = vtr(vp_ + VOFF(i)); vhi[(i) & 3] = vtr(vp_ + VOFF(i) + 512); DA_SBAR(); } while (0)
#define KRD(G, d0) do { if (G) { kload2(kf, kp0 + sl_next_, d0); DA_SBAR(); } } while (0)
#define GAPA(MF) do { MF; DA_SBAR(); } while (0)
#define GAPB(MF, X, i, nm, A0, A1, EXTRA) do { MF; X[i] = EX(X[i], nm); X[(i) + 1] = EX(X[(i) + 1], nm); sacc += A0; sacc += A1; EXTRA; DA_PIN(X); DA_PIN(sacc); DA_SBAR(); } while (0)
#define STEP(t, MASK, GK, GV, GL) do { DA_SBAR(); \
    const lcp vp_ = vp0 + SL((t) - 1); const int sl_next_ = SL((t) + 1); \
            GAPA(c0 = DA_MFMA(kf[0], qr[0], bias16)); GAPA(c1 = DA_MFMA(kf[1], qr[0], bias16)); GAPA(c0 = DA_MFMA(kf[2], qr[1], c0)); GAPA(c1 = DA_MFMA(kf[3], qr[1], c1)); \
    VRD(0); GAPA(c0 = DA_MFMA(kf[4], qr[2], c0)); VRD(1); GAPA(c1 = DA_MFMA(kf[5], qr[2], c1)); VRD(2); GAPA(c0 = DA_MFMA(kf[6], qr[3], c0)); VRD(3); GAPA(c1 = DA_MFMA(kf[7], qr[3], c1)); \
    offA += s64; \
    if (GK) DMA_K((t) + 4, SL(t)); if (GV) DMA_V((t) + 2, SL((t) + 2)); \
    if (MASK) cmask(c0, c1, (t) - (NT - 2), qrel, hi); \
    { const float rm = rowmax(c0, c1, offA, offA + s32) - mhat; resc = false; \
      if (__builtin_expect(__any(rm > THR), 0)) { const float dl = __builtin_fmaxf(rm, 0.f); mhat += dl; \
          const float f = __builtin_amdgcn_exp2f(-dl); l_reg *= f; if (hi == 0) wsf[r32] = f; resc = true; } } \
    const float nmh0 = offA - mhat, nmh1 = nmh0 + s32; float sacc = 0.f; DA_SBAR(); \
    GAPB(o[0] = DA_MFMA(PAF(0), VFR(0), o[0]), c0, 0, nmh0, 0.f, 0.f, );             VRD(4); \
    GAPB(o[1] = DA_MFMA(PAF(0), VFR(1), o[1]), c0, 2, nmh0, c0[0], c0[1], );         VRD(5); \
    GAPB(o[2] = DA_MFMA(PAF(0), VFR(2), o[2]), c0, 4, nmh0, c0[2], c0[3], );         VRD(6); \
    GAPB(o[3] = DA_MFMA(PAF(0), VFR(3), o[3]), c0, 6, nmh0, c0[4], c0[5], );         VRD(7); \
    GAPB(o[0] = DA_MFMA(PAF(1), VFR(4), o[0]), c0, 8, nmh0, c0[6], c0[7], pw0[0] = PKW(c0, 0); pw0[1] = PKW(c0, 2); DA_PIN(pw0));    VRD(8); \
    GAPB(o[1] = DA_MFMA(PAF(1), VFR(5), o[1]), c0, 10, nmh0, c0[8], c0[9], pw0[2] = PKW(c0, 4); pw0[3] = PKW(c0, 6); DA_PIN(pw0));   VRD(9); \
    GAPB(o[2] = DA_MFMA(PAF(1), VFR(6), o[2]), c0, 12, nmh0, c0[10], c0[11], );      VRD(10); \
    GAPB(o[3] = DA_MFMA(PAF(1), VFR(7), o[3]), c0, 14, nmh0, c0[12], c0[13], );      VRD(11); \
    GAPB(o[0] = DA_MFMA(PAF(2), VFR(8), o[0]), c1, 0, nmh1, c0[14], c0[15], pw1[0] = PKW(c0, 8); pw1[1] = PKW(c0, 10); DA_PIN(pw1));  VRD(12); \
    GAPB(o[1] = DA_MFMA(PAF(2), VFR(9), o[1]), c1, 2, nmh1, c1[0], c1[1], pw1[2] = PKW(c0, 12); pw1[3] = PKW(c0, 14); DA_PIN(pw1));   VRD(13); \
    GAPB(o[2] = DA_MFMA(PAF(2), VFR(10), o[2]), c1, 4, nmh1, c1[2], c1[3], );        VRD(14); \
    GAPB(o[3] = DA_MFMA(PAF(2), VFR(11), o[3]), c1, 6, nmh1, c1[4], c1[5], );        VRD(15); \
    GAPB(o[0] = DA_MFMA(PAF(3), VFR(12), o[0]), c1, 8, nmh1, c1[6], c1[7], pw2[0] = PKW(c1, 0); pw2[1] = PKW(c1, 2); DA_PIN(pw2));   KRD(GL, 0); \
    GAPB(o[1] = DA_MFMA(PAF(3), VFR(13), o[1]), c1, 10, nmh1, c1[8], c1[9], pw2[2] = PKW(c1, 4); pw2[3] = PKW(c1, 6); DA_PIN(pw2));  KRD(GL, 1); \
    GAPB(o[2] = DA_MFMA(PAF(3), VFR(14), o[2]), c1, 12, nmh1, c1[10], c1[11], );     KRD(GL, 2); \
    GAPB(o[3] = DA_MFMA(PAF(3), VFR(15), o[3]), c1, 14, nmh1, c1[12], c1[13], );     KRD(GL, 3); \
    sacc += c1[14]; sacc += c1[15]; l_reg += sacc; \
    pw3[0] = PKW(c1, 8); pw3[1] = PKW(c1, 10); pw3[2] = PKW(c1, 12); pw3[3] = PKW(c1, 14); DA_PIN(pw3); \
    } while (0)
#define ENDW(tt) do { if ((tt) + 4 < NT) { DA_WAIT_BAR(8); } else if ((tt) + 3 < NT) { DA_WAIT_BAR(6); } else if ((tt) + 2 < NT) { DA_WAIT_BAR(4); } else { DA_WAIT_BAR(0); } } while (0)
    int t = 1;
    for (; t + 4 < NT; ++t) {
        STEP(t, false, true, true, true); DA_WAIT_BAR(8); RESC();
    }
    for (; t + 1 < NT; ++t) {
        STEP(t, true, (t + 4 < NT), (t + 2 < NT), (t + 1 < NT)); ENDW(t); RESC();
    }
    STEP(NT - 1, true, false, false, false); RESC();
    { const lcp vp_ = vp0 + SL(NT - 1);
#define DRN(k, i) do { const s16x4 lo_ = vtr(vp_ + VOFF(i)), hh_ = vtr(vp_ + VOFF(i) + 512); \
        o[(i) & 3] = DA_MFMA(PAF(k), ((bf16x8){lo_[0], lo_[1], lo_[2], lo_[3], hh_[0], hh_[1], hh_[2], hh_[3]}), o[(i) & 3]); } while (0)
      DRN(0, 0); DRN(0, 1); DRN(0, 2); DRN(0, 3); DRN(1, 4); DRN(1, 5); DRN(1, 6); DRN(1, 7); DRN(2, 8); DRN(2, 9); DRN(2, 10); DRN(2, 11); DRN(3, 12); DRN(3, 13); DRN(3, 14); DRN(3, 15);
#undef DRN
    }
#undef DMA_K
#undef DMA_V
#undef SL
#undef EX
#undef RESC
#undef PKW
#undef PAF
#undef VFR
#undef VOFF
#undef VRD
#undef KRD
#undef GAPA
#undef GAPB
#undef STEP
#undef ENDW
    { auto rr = __builtin_amdgcn_permlane32_swap(__float_as_uint(l_reg), __float_as_uint(l_reg), false, false); l_reg = __uint_as_float(rr[0]) + __uint_as_float(rr[1]); }
    attn_epilogue_body(lds, o, l_reg, yb, subln_w, lam, rowb, q0, h, wave, lane);
}
}

namespace rw {
typedef short bf16x8 __attribute__((ext_vector_type(8)));
typedef float f32x2 __attribute__((ext_vector_type(2)));
typedef short s16x4 __attribute__((ext_vector_type(4)));
constexpr int CH = 32, ACT_PITCH = 528;
constexpr int OFF_HAT = 41472, HAT_PITCH = 144, HAT_SZ = 32 * HAT_PITCH, OFF_TIL = OFF_HAT + 4 * HAT_SZ, TIL_PITCH = 40, TIL_SZ = 64 * TIL_PITCH, OFF_GR = OFF_TIL + 4 * TIL_SZ, OFF_WC = OFF_GR + 10 * 1024;
constexpr int OFF_ACT = 0, OFF_RKV = 16896, OFF_VEC = 41472, OFF_G = 82432, OFF_Y = 90624, OFF_NRM = 98816, OFF_SCL = 99328, OFF_CT = 99840, OFF_SCP = 102400;
template <int CTRL> __device__ __forceinline__ float dppf(float x) { return __builtin_bit_cast(float, __builtin_amdgcn_mov_dpp(__builtin_bit_cast(int, x), CTRL, 0xf, 0xf, true)); }
__device__ __forceinline__ float row_allsum(float v) { v += dppf<0x128>(v); v += dppf<0x124>(v); v += dppf<0x122>(v); v += dppf<0x121>(v); return v; }
__device__ __forceinline__ void row_allsum4(float& a, float& b, float& c, float& d) {
#define RW_DPP4(n) "v_add_f32_dpp %0, %0, %0 row_ror:" #n " row_mask:0xf bank_mask:0xf\n\tv_add_f32_dpp %1, %1, %1 row_ror:" #n " row_mask:0xf bank_mask:0xf\n\t" \
                   "v_add_f32_dpp %2, %2, %2 row_ror:" #n " row_mask:0xf bank_mask:0xf\n\tv_add_f32_dpp %3, %3, %3 row_ror:" #n " row_mask:0xf bank_mask:0xf\n\t"
    asm volatile("s_nop 1\n\t" RW_DPP4(8) RW_DPP4(4) RW_DPP4(2) RW_DPP4(1) "s_nop 1" : "+v"(a), "+v"(b), "+v"(c), "+v"(d));
#undef RW_DPP4
}
__device__ __forceinline__ f32x4 ld4bf(const bf16_t* p) { const v2u w = *(const v2u*)p; return (f32x4){pg8::bflo(w.x), pg8::bfhi(w.x), pg8::bflo(w.y), pg8::bfhi(w.y)}; }
__device__ __forceinline__ float fsig(float x) { return __builtin_amdgcn_rcpf(1.f + __expf(-x)); }
__device__ __forceinline__ float ftanh(float x) { return 1.f - 2.f * __builtin_amdgcn_rcpf(1.f + __expf(2.f * x)); }
struct ZRow { v2u r, k, v, w, a; v4u g; };
__device__ __forceinline__ ZRow ldrow(const bf16_t* zr, int c4, int cg) {
    ZRow o; o.r = *(const v2u*)(zr + C_R + c4); o.k = *(const v2u*)(zr + C_K + c4); o.v = *(const v2u*)(zr + C_V + c4); o.w = *(const v2u*)(zr + C_WL + 4 * cg); o.a = *(const v2u*)(zr + C_AL + 4 * cg);
    o.g = *(const v4u*)(zr + C_GL + 8 * cg); return o;
}
__device__ __forceinline__ f32x4 up4(v2u w) { return (f32x4){pg8::bflo(w.x), pg8::bfhi(w.x), pg8::bflo(w.y), pg8::bfhi(w.y)}; }

struct ScanP { const float *mu, *w0, *w2, *a0, *a2, *g2, *k_k, *k_a, *r_k, *lnx_w, *lnx_b; };
template <int U> __device__ __forceinline__ void inv_steps(float (&ps)[4], const LAS float* tb) {
    if constexpr (U >= 1) {
        const float mu = __int_as_float(__builtin_amdgcn_mov_dpp(__float_as_int(ps[U >> 2]), (U & 3) * 0x55, 0xf, 0xf, true));
#pragma unroll
        for (int i = 0; i <= ((U - 1) >> 2); ++i) ps[i] = __builtin_fmaf(tb[(U + 16 * i) * 4], mu, ps[i]);
        inv_steps<U - 1>(ps, tb);
    }
}
__device__ __forceinline__ void scan_unit(LAS unsigned char* lds, const bf16_t* __restrict__ z, bf16_t* __restrict__ ya, const ScanP P, int b, int h, int tid, int wave, int lane) {
    asm volatile("" : "+v"(tid)); lane = tid & 63;
    const float* mu = P.mu; const float* w0 = P.w0; const float* w2 = P.w2; const float* a0 = P.a0; const float* a2 = P.a2; const float* g2 = P.g2;
    const float* k_k = P.k_k; const float* k_a = P.k_a; const float* r_k = P.r_k; const float* lnx_w = P.lnx_w; const float* lnx_b = P.lnx_b;
    const size_t rowb = (size_t)b * SEQ;
    const int tl = tid >> 4, cg = tid & 15;
    const int nt = wave & 3, rl = lane & 15, rg = lane >> 4;
    LAS float* rkv = (LAS float*)(lds + OFF_RKV); LAS float* vec = (LAS float*)(lds + OFF_VEC); LAS float* gbuf = (LAS float*)(lds + OFF_G);
    LAS float* ybuf = (LAS float*)(lds + OFF_Y); LAS float* nrm = (LAS float*)(lds + OFF_NRM); LAS float* scl = (LAS float*)(lds + OFF_SCL); LAS float* scp = (LAS float*)(lds + OFF_SCP);
    bf16x8 bfr[8];
    {
        const int col = h * 64 + 16 * nt + rl;
#pragma unroll
        for (int f = 0; f < 8; ++f) {
            const float* src = (f < 2) ? w2 : (f < 4) ? a2 : g2;
            const int kb = ((f < 4) ? 32 * (f & 1) : 32 * (f - 4)) + 8 * rg;
            float e[8];
#pragma unroll
            for (int j = 0; j < 8; ++j) e[j] = src[(size_t)(kb + j) * 512 + col];
            v4u p; p.x = pg8::cvt_pk_bf16(e[0], e[1]); p.y = pg8::cvt_pk_bf16(e[2], e[3]); p.z = pg8::cvt_pk_bf16(e[4], e[5]); p.w = pg8::cvt_pk_bf16(e[6], e[7]);
            bfr[f] = __builtin_bit_cast(bf16x8, p);
            __builtin_amdgcn_sched_barrier(0);
        }
    }
    const int mt = wave >> 2;
    const int hc = h * 64 + 16 * nt + rl;
    const float w0c = w0[hc], a0c = a0[hc], kkc = k_k[hc], kac = k_a[hc], rkc = r_k[hc];
    const int c4 = h * 64 + 4 * cg;
    f32x4 ST[4];
#pragma unroll
    for (int i = 0; i < 4; ++i) ST[i] = (f32x4){0.f, 0.f, 0.f, 0.f};
    LAS float* ctab = (LAS float*)(lds + OFF_CT);
    if (tl == 0) {
        LAS float* ct = ctab + cg * 36;
        *(LAS f32x4*)(ct + 0) = *(const f32x4*)(mu + C_R + c4); *(LAS f32x4*)(ct + 4) = *(const f32x4*)(mu + C_K + c4); *(LAS f32x4*)(ct + 8) = *(const f32x4*)(mu + C_V + c4);
        *(LAS f32x4*)(ct + 12) = *(const f32x4*)(mu + C_WL + 4 * cg); *(LAS f32x4*)(ct + 16) = *(const f32x4*)(mu + C_AL + 4 * cg);
        *(LAS f32x4*)(ct + 20) = *(const f32x4*)(mu + C_GL + 8 * cg); *(LAS f32x4*)(ct + 24) = *(const f32x4*)(mu + C_GL + 8 * cg + 4);
        *(LAS f32x4*)(ct + 28) = *(const f32x4*)(lnx_w + c4); *(LAS f32x4*)(ct + 32) = *(const f32x4*)(lnx_b + c4);
    }
    __syncthreads();
    const LAS float* myct = ctab + cg * 36;
    ZRow zc = ldrow(z + (rowb + tl) * ZP, c4, cg), zp;
    if (tl > 0) zp = ldrow(z + (rowb + tl - 1) * ZP, c4, cg); else { zp.r = zp.k = zp.v = zp.w = zp.a = (v2u){0u, 0u}; zp.g = (v4u){0u, 0u, 0u, 0u}; }
    for (int t0 = 0; t0 < SEQ; t0 += CH) {
        {
            const f32x4 cr = up4(zc.r), ck = up4(zc.k), cv = up4(zc.v), cw = up4(zc.w), ca = up4(zc.a);
            const f32x4 cg0 = (f32x4){pg8::bflo(zc.g.x), pg8::bfhi(zc.g.x), pg8::bflo(zc.g.y), pg8::bfhi(zc.g.y)}, cg1 = (f32x4){pg8::bflo(zc.g.z), pg8::bfhi(zc.g.z), pg8::bflo(zc.g.w), pg8::bfhi(zc.g.w)};
            const f32x4 pr = up4(zp.r), pk = up4(zp.k), pv = up4(zp.v), pw = up4(zp.w), pa = up4(zp.a);
            const f32x4 pg0 = (f32x4){pg8::bflo(zp.g.x), pg8::bfhi(zp.g.x), pg8::bflo(zp.g.y), pg8::bfhi(zp.g.y)}, pg1 = (f32x4){pg8::bflo(zp.g.z), pg8::bfhi(zp.g.z), pg8::bflo(zp.g.w), pg8::bfhi(zp.g.w)};
            if (t0 + CH < SEQ) { zc = ldrow(z + (rowb + t0 + CH + tl) * ZP, c4, cg); zp = ldrow(z + (rowb + t0 + CH + tl - 1) * ZP, c4, cg); }
            const f32x4 rs_ = cr + (pr - cr) * *(const LAS f32x4*)(myct + 0), ks_ = ck + (pk - ck) * *(const LAS f32x4*)(myct + 4), vs_ = cv + (pv - cv) * *(const LAS f32x4*)(myct + 8);
            const f32x4 ws_ = cw + (pw - cw) * *(const LAS f32x4*)(myct + 12), as_ = ca + (pa - ca) * *(const LAS f32x4*)(myct + 16);
            const f32x4 g0_ = cg0 + (pg0 - cg0) * *(const LAS f32x4*)(myct + 20), g1_ = cg1 + (pg1 - cg1) * *(const LAS f32x4*)(myct + 24);
            *(LAS f32x4*)(rkv + 0 * 2048 + tl * 64 + 4 * cg) = rs_; *(LAS f32x4*)(rkv + 1 * 2048 + tl * 64 + 4 * cg) = ks_; *(LAS f32x4*)(rkv + 2 * 2048 + tl * 64 + 4 * cg) = vs_;
            LAS unsigned char* ar = lds + OFF_ACT + tl * ACT_PITCH;
            v2u tw; tw.x = pg8::cvt_pk_bf16(ftanh(ws_[0]), ftanh(ws_[1])); tw.y = pg8::cvt_pk_bf16(ftanh(ws_[2]), ftanh(ws_[3]));
            *(LAS v2u*)(ar + 8 * cg) = tw;
            v2u aw; aw.x = pg8::cvt_pk_bf16(as_[0], as_[1]); aw.y = pg8::cvt_pk_bf16(as_[2], as_[3]);
            *(LAS v2u*)(ar + 128 + 8 * cg) = aw;
            v4u gw; gw.x = pg8::cvt_pk_bf16(fsig(g0_[0]), fsig(g0_[1])); gw.y = pg8::cvt_pk_bf16(fsig(g0_[2]), fsig(g0_[3]));
            gw.z = pg8::cvt_pk_bf16(fsig(g1_[0]), fsig(g1_[1])); gw.w = pg8::cvt_pk_bf16(fsig(g1_[2]), fsig(g1_[3]));
            *(LAS v4u*)(ar + 256 + 16 * cg) = gw;
        }
        __syncthreads();
        f32x4 accw = (f32x4){0.f, 0.f, 0.f, 0.f}, acca = accw, accg = accw;
        {
            const LAS unsigned char* ap = lds + OFF_ACT + (16 * mt + rl) * ACT_PITCH + 8 * rg * 2;
#pragma unroll
            for (int f = 0; f < 8; ++f) {
                const bf16x8 a = *(const LAS bf16x8*)(ap + f * 64);
                if (f < 2) accw = __builtin_amdgcn_mfma_f32_16x16x32_bf16(a, bfr[f], accw, 0, 0, 0);
                else if (f < 4) acca = __builtin_amdgcn_mfma_f32_16x16x32_bf16(a, bfr[f], acca, 0, 0, 0);
                else accg = __builtin_amdgcn_mfma_f32_16x16x32_bf16(a, bfr[f], accg, 0, 0, 0);
            }
        }
        float lw[4], av[4], kk[4];
        {
            const int c = 16 * nt + rl;
            float n2[4];
#pragma unroll
            for (int r = 0; r < 4; ++r) {
                const int tok = 16 * mt + 4 * rg + r;
                gbuf[tok * 64 + c] = accg[r];
                const float nx = -(w0c + accw[r]);
                const float sp = nx > 20.f ? nx : __logf(1.f + __expf(nx));
                lw[r] = -__expf(-sp - 0.5f);
                av[r] = fsig(a0c + acca[r]);
                kk[r] = rkv[1 * 2048 + tok * 64 + c] * kkc;
                n2[r] = kk[r] * kk[r];
            }
            row_allsum4(n2[0], n2[1], n2[2], n2[3]);
            if (rl == 0) {
#pragma unroll
                for (int r = 0; r < 4; ++r) nrm[(16 * mt + 4 * rg + r) * 4 + nt] = n2[r];
            }
        }
        __syncthreads();
        {
            const int c = 16 * nt + rl;
            const float p0 = lw[0], p1 = p0 + lw[1], p2 = p1 + lw[2], p3 = p2 + lw[3];
            const float t1 = __shfl(p3, (lane - 16) & 63), t2 = __shfl(p3, (lane - 32) & 63), t3 = __shfl(p3, (lane - 48) & 63);
            const float E = (rg >= 1 ? t1 : 0.f) + (rg >= 2 ? t2 : 0.f) + (rg >= 3 ? t3 : 0.f);
            const float Ltot = __shfl(E + p3, rl + 48);
            const float pin[4] = {p0, p1, p2, p3};
            float bt[4], kt[4];
#pragma unroll
            for (int r = 0; r < 4; ++r) {
                const int tok = 16 * mt + 4 * rg + r;
                const f32x4 n4 = *(const LAS f32x4*)(nrm + tok * 4);
                const float ksv = rkv[1 * 2048 + tok * 64 + c], rsv = rkv[0 * 2048 + tok * 64 + c];
                const float inv = fminf(__builtin_amdgcn_rsqf((n4[0] + n4[1]) + (n4[2] + n4[3])), 1e12f);
                const float kkn = kk[r] * inv, beta = kkn * av[r], kmod = ksv * (1.f + (av[r] - 1.f) * kac);
                const float L = E + pin[r], eL = __expf(L), ieL = __expf(-L), eLm = __expf(L - lw[r]), eT = __expf(Ltot - L);
                LAS unsigned char* hp = lds + OFF_HAT + tok * HAT_PITCH + c * 2;
                *(LAS bf16_t*)(hp) = f2bf(-kkn * eLm); *(LAS bf16_t*)(hp + HAT_SZ) = f2bf(beta * ieL); *(LAS bf16_t*)(hp + 2 * HAT_SZ) = f2bf(kmod * ieL); *(LAS bf16_t*)(hp + 3 * HAT_SZ) = f2bf(rsv * eL);
                bt[r] = beta * eT; kt[r] = kmod * eT;
                float pbr = beta * rsv, pkr = kmod * rsv, pbo = rsv * kmod * rkc, dum = 0.f;
                row_allsum4(pbr, pkr, pbo, dum);
                if (rl == 0) *(LAS f32x4*)(scp + (tok * 4 + nt) * 4) = (f32x4){pbr, pkr, pbo, 0.f};
            }
            LAS unsigned char* tp = lds + OFF_TIL + (2 * mt) * TIL_SZ + c * TIL_PITCH + 8 * rg;
            v2u w; w.x = pg8::cvt_pk_bf16(bt[0], bt[1]); w.y = pg8::cvt_pk_bf16(bt[2], bt[3]); *(LAS v2u*)(tp) = w;
            w.x = pg8::cvt_pk_bf16(kt[0], kt[1]); w.y = pg8::cvt_pk_bf16(kt[2], kt[3]); *(LAS v2u*)(tp + TIL_SZ) = w;
            if (rg == 0) ((LAS float*)(lds + OFF_WC))[mt * 64 + c] = __expf(Ltot);
        }
        __syncthreads();
        if (tid < CH) {
            const f32x4 p0 = *(const LAS f32x4*)(scp + tid * 16), p1 = *(const LAS f32x4*)(scp + tid * 16 + 4), p2 = *(const LAS f32x4*)(scp + tid * 16 + 8), p3 = *(const LAS f32x4*)(scp + tid * 16 + 12);
            *(LAS f32x4*)(scl + 4 * tid) = (p0 + p1) + (p2 + p3);
        }
        int lane_ = lane; asm volatile("" : "+v"(lane_));
        const int rl_ = lane_ & 15, rg_ = lane_ >> 4;
        {
            const int c = wave >> 2, g = wave & 3;
            const LAS unsigned char* pa = lds + OFF_HAT + ((g & 1) ? 2 : 1) * HAT_SZ + (16 * c + rl_) * HAT_PITCH + 16 * rg_;
            const LAS unsigned char* pb = lds + OFF_HAT + ((g < 2) ? 0 : 3) * HAT_SZ + (16 * c + rl_) * HAT_PITCH + 16 * rg_;
            f32x4 acc = (f32x4){0.f, 0.f, 0.f, 0.f};
            acc = __builtin_amdgcn_mfma_f32_16x16x32_bf16(*(const LAS bf16x8*)(pa), *(const LAS bf16x8*)(pb), acc, 0, 0, 0);
            acc = __builtin_amdgcn_mfma_f32_16x16x32_bf16(*(const LAS bf16x8*)(pa + 64), *(const LAS bf16x8*)(pb + 64), acc, 0, 0, 0);
#pragma unroll
            for (int e = 0; e < 4; ++e) { const int row = 4 * rg_ + e; const bool keep = (g < 2) ? (row < rl_) : (row <= rl_); if (!keep) acc[e] = 0.f; }
            *(LAS f32x4*)(lds + OFF_GR + (c * 5 + g) * 1024 + lane_ * 16) = acc;
            if (g == 0) {
                asm volatile("s_waitcnt lgkmcnt(0)" ::: "memory");
                const int sc = lane_ >> 2, q = lane_ & 3;
                const LAS float* tb = (const LAS float*)(lds + OFF_GR + (c * 5) * 1024) + q;
                float ps[4];
#pragma unroll
                for (int i = 0; i < 4; ++i) ps[i] = (4 * i + q == sc) ? 1.f : 0.f;
                inv_steps<15>(ps, tb);
                LAS float* mt_ = (LAS float*)(lds + OFF_GR + (c * 5 + 4) * 1024);
#pragma unroll
                for (int i = 0; i < 4; ++i) mt_[(sc + 16 * i) * 4 + q] = ps[i];
            }
        }
        __syncthreads();
        if (wave < 4) {
            const int ib = wave;
#pragma unroll
            for (int c = 0; c < 2; ++c) {
                bf16x8 sb[2];
#pragma unroll
                for (int ks = 0; ks < 2; ++ks) {
                    v4u p; p.x = pg8::cvt_pk_bf16(ST[2 * ks][0], ST[2 * ks][1]); p.y = pg8::cvt_pk_bf16(ST[2 * ks][2], ST[2 * ks][3]);
                    p.z = pg8::cvt_pk_bf16(ST[2 * ks + 1][0], ST[2 * ks + 1][1]); p.w = pg8::cvt_pk_bf16(ST[2 * ks + 1][2], ST[2 * ks + 1][3]);
                    sb[ks] = __builtin_bit_cast(bf16x8, p);
                }
                const LAS unsigned char* ha = lds + OFF_HAT + (16 * c + rl_) * HAT_PITCH + 8 * rg_;
                f32x4 xt = (f32x4){0.f, 0.f, 0.f, 0.f}, yt = xt;
#pragma unroll
                for (int ks = 0; ks < 2; ++ks) {
                    v4u fa, fr; const v2u a0_ = *(const LAS v2u*)(ha + 64 * ks), a1_ = *(const LAS v2u*)(ha + 64 * ks + 32);
                    const v2u r0_ = *(const LAS v2u*)(ha + 3 * HAT_SZ + 64 * ks), r1_ = *(const LAS v2u*)(ha + 3 * HAT_SZ + 64 * ks + 32);
                    fa.x = a0_.x; fa.y = a0_.y; fa.z = a1_.x; fa.w = a1_.y; fr.x = r0_.x; fr.y = r0_.y; fr.z = r1_.x; fr.w = r1_.y;
                    xt = __builtin_amdgcn_mfma_f32_16x16x32_bf16(__builtin_bit_cast(bf16x8, fa), sb[ks], xt, 0, 0, 0);
                    yt = __builtin_amdgcn_mfma_f32_16x16x32_bf16(__builtin_bit_cast(bf16x8, fr), sb[ks], yt, 0, 0, 0);
                }
                const LAS float* vsrc = rkv + 2 * 2048 + (16 * c + 4 * rg_) * 64 + 16 * ib + rl_;
                v2u vb_; vb_.x = pg8::cvt_pk_bf16(vsrc[0], vsrc[64]); vb_.y = pg8::cvt_pk_bf16(vsrc[128], vsrc[192]);
                const s16x4 vb = __builtin_bit_cast(s16x4, vb_);
                const LAS unsigned char* gr = lds + OFF_GR + (c * 5) * 1024 + lane_ * 16;
#define RW_AFR(g_) ({ const f32x4 t_ = *(const LAS f32x4*)(gr + (g_) * 1024); v2u w_; w_.x = pg8::cvt_pk_bf16(t_[0], t_[1]); w_.y = pg8::cvt_pk_bf16(t_[2], t_[3]); __builtin_bit_cast(s16x4, w_); })
#define RW_PK4(x_) ({ v2u w_; w_.x = pg8::cvt_pk_bf16((x_)[0], (x_)[1]); w_.y = pg8::cvt_pk_bf16((x_)[2], (x_)[3]); __builtin_bit_cast(s16x4, w_); })
                const f32x4 zt = __builtin_amdgcn_mfma_f32_16x16x16bf16_1k(RW_AFR(1), vb, xt, 0, 0, 0);
                const f32x4 ut = __builtin_amdgcn_mfma_f32_16x16x16bf16_1k(RW_AFR(4), RW_PK4(zt), (f32x4){0.f, 0.f, 0.f, 0.f}, 0, 0, 0);
                const s16x4 ub = RW_PK4(ut);
                yt = __builtin_amdgcn_mfma_f32_16x16x16bf16_1k(RW_AFR(2), ub, yt, 0, 0, 0);
                yt = __builtin_amdgcn_mfma_f32_16x16x16bf16_1k(RW_AFR(3), vb, yt, 0, 0, 0);
#pragma unroll
                for (int e = 0; e < 4; ++e) ybuf[(16 * c + 4 * rg_ + e) * 64 + 16 * ib + rl_] = yt[e];
                const LAS unsigned char* tl_ = lds + OFF_TIL + (2 * c) * TIL_SZ + rl_ * TIL_PITCH + 8 * rg_;
                const LAS float* wc = (const LAS float*)(lds + OFF_WC) + c * 64 + 4 * rg_;
#pragma unroll
                for (int jt = 0; jt < 4; ++jt) {
                    f32x4 acc = ST[jt] * *(const LAS f32x4*)(wc + 16 * jt);
                    acc = __builtin_amdgcn_mfma_f32_16x16x16bf16_1k(*(const LAS s16x4*)(tl_ + TIL_SZ + 16 * jt * TIL_PITCH), vb, acc, 0, 0, 0);
                    acc = __builtin_amdgcn_mfma_f32_16x16x16bf16_1k(*(const LAS s16x4*)(tl_ + 16 * jt * TIL_PITCH), ub, acc, 0, 0, 0);
                    ST[jt] = acc;
                }
#undef RW_AFR
#undef RW_PK4
            }
        }
        __syncthreads();
        {
            const f32x4 y4 = *(const LAS f32x4*)(ybuf + tl * 64 + 4 * cg);
            const float mean = row_allsum((y4[0] + y4[1]) + (y4[2] + y4[3])) * (1.f / 64.f);
            const f32x4 dv = y4 - mean;
            const float var = row_allsum((dv[0] * dv[0] + dv[1] * dv[1]) + (dv[2] * dv[2] + dv[3] * dv[3])) * (1.f / 64.f);
            const float rs_ = rsqrtf(var + GN_EPS);
            const f32x4 yn = dv * rs_ * *(const LAS f32x4*)(myct + 28) + *(const LAS f32x4*)(myct + 32);
            const float bonus = scl[tl * 4 + 2];
            const f32x4 vs_ = *(const LAS f32x4*)(rkv + 2 * 2048 + tl * 64 + 4 * cg), g4 = *(const LAS f32x4*)(gbuf + tl * 64 + 4 * cg);
            const f32x4 o = (yn + vs_ * bonus) * g4;
            v2u w; w.x = pg8::cvt_pk_bf16(o[0], o[1]); w.y = pg8::cvt_pk_bf16(o[2], o[3]);
            *(v2u*)(ya + (rowb + t0 + tl) * YAB_PITCH + c4) = w;
        }
        __syncthreads();
    }
}
}

typedef __bf16 bf16x2_t __attribute__((ext_vector_type(2)));
__device__ __forceinline__ float dot2bf(unsigned a, unsigned b, float c) { return __builtin_amdgcn_fdot2_f32_bf16(__builtin_bit_cast(bf16x2_t, a), __builtin_bit_cast(bf16x2_t, b), c, false); }
__device__ __forceinline__ unsigned f2ord(float f) { const unsigned u = __float_as_uint(f); return (u & 0x80000000u) ? ~u : (u | 0x80000000u); }
__device__ __forceinline__ float ord2f(unsigned o) { return __uint_as_float((o & 0x80000000u) ? (o ^ 0x80000000u) : ~o); }
__device__ __forceinline__ unsigned row_allmax_u32(unsigned v) {
    v = max(v, (unsigned)__builtin_amdgcn_update_dpp(0, (int)v, 0x128, 0xf, 0xf, false));
    v = max(v, (unsigned)__builtin_amdgcn_update_dpp(0, (int)v, 0x124, 0xf, 0xf, false));
    v = max(v, (unsigned)__builtin_amdgcn_update_dpp(0, (int)v, 0x122, 0xf, 0xf, false));
    v = max(v, (unsigned)__builtin_amdgcn_update_dpp(0, (int)v, 0x121, 0xf, 0xf, false));
    return v;
}

constexpr int TK_PITCH = 272, TK_HALF = 128 * TK_PITCH;
typedef short tk_bf16x8 __attribute__((ext_vector_type(8)));
__device__ __forceinline__ void topk_loadq(tk_bf16x8 (&qa)[8], const bf16_t* __restrict__ qb, int t0, int h, int lane) {
    const bf16_t* qp = qb + (size_t)(t0 + (lane & 15)) * 2048 + h * 256 + 8 * (lane >> 4);
#pragma unroll
    for (int i = 0; i < 8; ++i) qa[i] = *(const tk_bf16x8*)(qp + i * 32);
}
__device__ __forceinline__ void topk_item(const bf16_t* __restrict__ sb, int* __restrict__ ids, float* __restrict__ gates, int t0, int h, int lane) {
    const int rl = lane & 15, rg = lane >> 4;
    unsigned top[2][4];
#pragma unroll
    for (int c = 0; c < 2; ++c) {
        f32x4 acc[8];
#pragma unroll
        for (int r = 0; r < 4; ++r) {
            const v4u w = *(const v4u*)(sb + (size_t)(t0 + 4 * rg + r) * 2048 + h * 256 + c * 128 + rl * 8);
            acc[0][r] = 64.f + pg8::bflo(w.x); acc[1][r] = 64.f + pg8::bfhi(w.x); acc[2][r] = 64.f + pg8::bflo(w.y); acc[3][r] = 64.f + pg8::bfhi(w.y);
            acc[4][r] = 64.f + pg8::bflo(w.z); acc[5][r] = 64.f + pg8::bfhi(w.z); acc[6][r] = 64.f + pg8::bflo(w.w); acc[7][r] = 64.f + pg8::bfhi(w.w);
        }
        unsigned k[4][8];
#pragma unroll
        for (int r = 0; r < 4; ++r) {
#pragma unroll
            for (int nt = 0; nt < 8; ++nt) k[r][nt] = (__float_as_uint(fmaxf(acc[nt][r], 1.f)) & ~127u) | (unsigned)(127 - (nt * 16 + rl));
#define TK_CE(i, j) do { const unsigned a_ = max(k[r][i], k[r][j]), b_ = min(k[r][i], k[r][j]); k[r][i] = a_; k[r][j] = b_; } while (0)
            TK_CE(0, 1); TK_CE(2, 3); TK_CE(4, 5); TK_CE(6, 7); TK_CE(0, 2); TK_CE(1, 3); TK_CE(4, 6); TK_CE(5, 7); TK_CE(1, 2); TK_CE(5, 6);
            TK_CE(0, 4); TK_CE(1, 5); TK_CE(2, 6); TK_CE(3, 7); TK_CE(2, 4); TK_CE(3, 5); TK_CE(1, 2); TK_CE(3, 4); TK_CE(5, 6);
#undef TK_CE
        }
        unsigned tp[4] = {0u, 0u, 0u, 0u};
        for (int round = 0; round < 16; ++round) {
#pragma unroll
            for (int r = 0; r < 4; ++r) {
                const unsigned m = row_allmax_u32(k[r][0]);
                tp[r] = (rl == round) ? m : tp[r];
                const bool win = (k[r][0] == m);
                k[r][0] = win ? k[r][1] : k[r][0]; k[r][1] = win ? k[r][2] : k[r][1]; k[r][2] = win ? k[r][3] : k[r][2]; k[r][3] = win ? k[r][4] : k[r][3];
                k[r][4] = win ? k[r][5] : k[r][4]; k[r][5] = win ? k[r][6] : k[r][5]; k[r][6] = win ? k[r][7] : k[r][6]; k[r][7] = win ? 0u : k[r][7];
            }
        }
#pragma unroll
        for (int r = 0; r < 4; ++r) top[c][r] = tp[r];
    }
    const int rowbase = lane & 48;
    float v1[4]; int n1[4], ptr[4], myid[4]; unsigned k2[4], myv[4];
#pragma unroll
    for (int r = 0; r < 4; ++r) { v1[r] = __uint_as_float(top[0][r] & ~127u); n1[r] = 127 - (int)(top[0][r] & 127u); ptr[r] = 0; k2[r] = (unsigned)__builtin_amdgcn_ds_bpermute(rowbase * 4, (int)top[1][r]); myid[r] = 0; myv[r] = 0u; }
    for (int round = 0; round < 16; ++round) {
#pragma unroll
        for (int r = 0; r < 4; ++r) {
            const float head = v1[r] + __uint_as_float(k2[r] & ~127u);
            const unsigned key = (ptr[r] < 16) ? ((__float_as_uint(head) & ~15u) | (unsigned)(15 - rl)) : 0u;
            const unsigned m = row_allmax_u32(key);
            const bool win = (key == m);
            const unsigned wid = row_allmax_u32(win ? (unsigned)(n1[r] * 128 + (127 - (int)(k2[r] & 127u))) + 1u : 0u);
            myid[r] = (rl == round) ? (int)wid - 1 : myid[r];
            myv[r] = (rl == round) ? m : myv[r];
            ptr[r] += win ? 1 : 0;
            k2[r] = (unsigned)__builtin_amdgcn_ds_bpermute((rowbase + (ptr[r] & 15)) * 4, (int)top[1][r]);
        }
    }
#pragma unroll
    for (int r = 0; r < 4; ++r) {
        const float val = __uint_as_float(myv[r] & ~15u);
        const float vmax = __uint_as_float((unsigned)__builtin_amdgcn_ds_bpermute(rowbase * 4, (int)__float_as_uint(val)));
        const float e = __expf(val - vmax);
        const float sum = rw::row_allsum(e);
        gates[(size_t)(t0 + 4 * rg + r) * IDP + h * 16 + rl] = e * __builtin_amdgcn_rcpf(sum); ids[(size_t)(t0 + 4 * rg + r) * IDP + h * 16 + rl] = myid[r];
    }
}

typedef float f32x2 __attribute__((ext_vector_type(2)));
typedef int v8i_t __attribute__((ext_vector_type(8)));
constexpr int PEER_PITCH = 1040, PEER_H6 = 16 * PEER_PITCH, PEER_WLDS = PEER_H6 + 1024;
template <int MODE>
__device__ __forceinline__ void peer_token(LAS unsigned char* wl, const bf16_t* __restrict__ x2b, const float* __restrict__ ssq2, const int* __restrict__ ids, const float* __restrict__ gates,
                                           const unsigned char* __restrict__ U8, const unsigned char* __restrict__ V8, const float* __restrict__ usc, const float* __restrict__ vsc,
                                           const float* __restrict__ fw, float* __restrict__ out, float* __restrict__ coef, int t, int lane) {
    asm volatile("" : "+v"(lane));
    const int l16 = lane * 16, fr = lane & 15, fq = lane >> 4;
    unsigned hw[8];
    if constexpr (MODE == 1) {
        const v4u h0 = *(const v4u*)(x2b + (size_t)t * DM + l16), h1 = *(const v4u*)(x2b + (size_t)t * DM + l16 + 8);
        hw[0] = h0.x; hw[1] = h0.y; hw[2] = h0.z; hw[3] = h0.w; hw[4] = h1.x; hw[5] = h1.y; hw[6] = h1.z; hw[7] = h1.w;
    }
    const int idA = ids[(size_t)t * IDP + lane], idB = ids[(size_t)t * IDP + 64 + lane];
    const unsigned vo12 = (unsigned)lane * 12u;
#define PEER_LD16(buf_, tab_, g_) do { const int is_ = ((g_) < 4) ? idA : idB; const int lb_ = ((g_) * 16) & 63; _Pragma("unroll") for (int k = 0; k < 16; ++k) { \
        const unsigned eo = (unsigned)__builtin_amdgcn_readlane(is_, lb_ + k) * 768u; const unsigned char* rp_ = tab_ + eo; buf_[k] = *(const v3u_t*)(rp_ + vo12); } } while (0)
#define PEER_DMA16(g_) do { const int is_ = ((g_) < 4) ? idA : idB; const int lb_ = ((g_) * 16) & 63; _Pragma("unroll") for (int k = 0; k < 16; ++k) { \
        const unsigned eo = (unsigned)__builtin_amdgcn_readlane(is_, lb_ + k) * 768u; const unsigned char* rp_ = U8 + eo; \
        __builtin_amdgcn_global_load_lds((const unsigned*)(rp_ + vo12), (LAS unsigned*)(wl + k * PEER_PITCH), 16, 0, 0); if (k & 1) __builtin_amdgcn_sched_barrier(0); } } while (0)
    if constexpr (MODE == 1) {
        v3u_t uwa[16], uwb[16];
        PEER_LD16(uwa, U8, 0);
        __builtin_amdgcn_sched_barrier(0);
        PEER_LD16(uwb, U8, 1);
        __builtin_amdgcn_sched_barrier(0);
        float mx = 0.f;
#pragma unroll
        for (int i = 0; i < 8; ++i) mx = fmaxf(mx, fmaxf(fabsf(pg8::bflo(hw[i])), fabsf(pg8::bfhi(hw[i]))));
#pragma unroll
        for (int o = 1; o < 64; o <<= 1) mx = fmaxf(mx, __shfl_xor(mx, o));
        mx = fmaxf(mx, 1e-30f);
        {
            const float q6 = 7.5f / mx;
            v16f_t a, b;
#pragma unroll
            for (int i = 0; i < 16; ++i) { a[i] = 0.f; b[i] = 0.f; }
#pragma unroll
            for (int i = 0; i < 8; ++i) { a[i] = pg8::bflo(hw[i]) * q6; b[i] = pg8::bfhi(hw[i]) * q6; }
            const v6u_t p = __builtin_amdgcn_cvt_scalef32_2xpk16_fp6_f32(a, b, 1.0f);
            LAS unsigned* hp = (LAS unsigned*)(wl + PEER_H6 + lane * 12); hp[0] = p[0]; hp[1] = p[1]; hp[2] = p[2];
        }
        const float rs = rsqrtf(pg8::ssq_sum16(ssq2 + (size_t)t * 16) * (1.f / DM) + NORM_EPS) * (mx * (1.f / 7.5f));
        const float suA = rs * usc[idA], suB = rs * usc[idB];
        const float svA = gates[(size_t)t * IDP + lane] * vsc[idA], svB = gates[(size_t)t * IDP + 64 + lane] * vsc[idB];
#define PEER_UGRP(uw, g_) do { \
            const float susel = ((g_) < 4) ? suA : suB, svsel = ((g_) < 4) ? svA : svB; const int lb = ((g_) * 16) & 63; \
            _Pragma("unroll") for (int k = 0; k < 16; ++k) *(LAS v3u_t*)(wl + k * PEER_PITCH + lane * 16) = uw[k]; \
            __builtin_amdgcn_sched_barrier(0); \
            if ((g_) + 2 < 8) PEER_LD16(uw, U8, (g_) + 2); \
            __builtin_amdgcn_sched_barrier(0); \
            f32x4 acc = (f32x4){0.f, 0.f, 0.f, 0.f}; \
            _Pragma("unroll") for (int b = 0; b < 8; ++b) { \
                const LAS v4u* ap = (const LAS v4u*)(wl + fr * PEER_PITCH + 32 * (4 * b + fq)); const v4u w0 = ap[0], w1 = ap[1]; \
                const v8i_t a = (v8i_t){(int)w0.x, (int)w0.y, (int)w0.z, (int)w1.x, (int)w1.y, (int)w1.z, 0, 0}; \
                const LAS v2u* hp = (const LAS v2u*)(wl + PEER_H6 + 96 * b + 24 * fq); const v2u h0_ = hp[0], h1_ = hp[1], h2_ = hp[2]; \
                const v8i_t bf = (v8i_t){(int)h0_.x, (int)h0_.y, (int)h1_.x, (int)h1_.y, (int)h2_.x, (int)h2_.y, 0, 0}; \
                acc = __builtin_amdgcn_mfma_scale_f32_16x16x128_f8f6f4(a, bf, acc, 2  , 2  , 0, 127, 0, 127); \
                if (b & 1) __builtin_amdgcn_sched_barrier(0); \
            } \
              \
            const int esel = fr & 3; \
            const float dot = (esel == 0) ? acc[0] : (esel == 1) ? acc[1] : (esel == 2) ? acc[2] : acc[3]; \
            const float suv = __shfl(susel, lb + 4 * fq + esel), svv = __shfl(svsel, lb + 4 * fq + esel); \
            const float dd = dot * suv; \
            const float act = 0.5f * dd * (1.f + erff(dd * 0.70710678118654752f)) * svv; \
            if (fr < 4) coef[(size_t)t * IDP + (g_) * 16 + 4 * fq + fr] = act; \
            __builtin_amdgcn_sched_barrier(0); \
        } while (0)
#pragma nounroll
        for (int g = 0; g < 8; g += 2) { PEER_UGRP(uwa, g); PEER_UGRP(uwb, g + 1); }
#undef PEER_UGRP
    } else {
        v3u_t vwa[16], vwb[16], vwc[16];
        PEER_LD16(vwa, V8, 0);
        const float cfA = coef[(size_t)t * IDP + lane], cfB = coef[(size_t)t * IDP + 64 + lane];
        f32x2 y[8];
#pragma unroll
        for (int i = 0; i < 8; ++i) y[i] = (f32x2){0.f, 0.f};
#define PEER_VACC(vw, g_) do { const float cs_ = ((g_) < 4) ? cfA : cfB; const int lb_ = ((g_) * 16) & 63; _Pragma("unroll") for (int k = 0; k < 16; k += 2) { \
            const float a = __uint_as_float((unsigned)__builtin_amdgcn_readlane((int)__float_as_uint(cs_), lb_ + k)); \
            const float b = __uint_as_float((unsigned)__builtin_amdgcn_readlane((int)__float_as_uint(cs_), lb_ + k + 1)); \
            const f32x2 a2 = (f32x2){a, a}, b2 = (f32x2){b, b}; \
            const v32f_t f = __builtin_amdgcn_cvt_scalef32_pk32_f32_fp6((v6u_t){vw[k][0], vw[k][1], vw[k][2], vw[k + 1][0], vw[k + 1][1], vw[k + 1][2]}, 1.0f); \
            _Pragma("unroll") for (int i = 0; i < 8; ++i) { y[i] += (f32x2){f[2 * i], f[2 * i + 1]} * a2; y[i] += (f32x2){f[16 + 2 * i], f[17 + 2 * i]} * b2; } \
            __builtin_amdgcn_sched_barrier(0); } } while (0)
#define PEER_SB() __builtin_amdgcn_sched_barrier(0)
        PEER_SB(); PEER_LD16(vwb, V8, 1); PEER_SB(); PEER_LD16(vwc, V8, 2); PEER_SB();
        PEER_VACC(vwa, 0); PEER_LD16(vwa, V8, 3); PEER_SB();
        PEER_VACC(vwb, 1); PEER_LD16(vwb, V8, 4); PEER_SB();
        PEER_VACC(vwc, 2); PEER_LD16(vwc, V8, 5); PEER_SB();
        PEER_VACC(vwa, 3); PEER_LD16(vwa, V8, 6); PEER_SB();
        PEER_VACC(vwb, 4); PEER_LD16(vwb, V8, 7); PEER_SB();
        PEER_VACC(vwc, 5);
        {
            const v4u h0 = *(const v4u*)(x2b + (size_t)t * DM + l16), h1 = *(const v4u*)(x2b + (size_t)t * DM + l16 + 8);
            hw[0] = h0.x; hw[1] = h0.y; hw[2] = h0.z; hw[3] = h0.w; hw[4] = h1.x; hw[5] = h1.y; hw[6] = h1.z; hw[7] = h1.w;
        }
        PEER_SB(); PEER_VACC(vwa, 6); PEER_VACC(vwb, 7);
#undef PEER_SB
#undef PEER_VACC
        float* orow = out + (size_t)t * DM + l16;
        float ss = 0.f;
        f32x4 o4[4];
#pragma unroll
        for (int i = 0; i < 4; ++i) { o4[i] = (f32x4){pg8::bflo(hw[2 * i]) + y[2 * i][0], pg8::bfhi(hw[2 * i]) + y[2 * i][1], pg8::bflo(hw[2 * i + 1]) + y[2 * i + 1][0], pg8::bfhi(hw[2 * i + 1]) + y[2 * i + 1][1]};
            ss += (o4[i][0] * o4[i][0] + o4[i][1] * o4[i][1]) + (o4[i][2] * o4[i][2] + o4[i][3] * o4[i][3]); }
        ss = wave_sum(ss);
        const float r = rsqrtf(ss * (1.f / DM) + NORM_EPS);
#pragma unroll
        for (int i = 0; i < 4; ++i) *(f32x4*)(orow + 4 * i) = o4[i] * r * *(const f32x4*)(fw + l16 + 4 * i);
    }
#undef PEER_LD16
#undef PEER_DMA16
}
__device__ __forceinline__ void peer_u_stream(LAS unsigned char* wl, const bf16_t* __restrict__ x2b, const float* __restrict__ ssq2, const int* __restrict__ ids, const float* __restrict__ gates,
                                              const unsigned char* __restrict__ U8, const float* __restrict__ usc, const float* __restrict__ vsc, float* __restrict__ coef, int t0, int lane) {
    asm volatile("" : "+v"(lane));
    const int l16 = lane * 16, fr = lane & 15, fq = lane >> 4;
    const unsigned vo12 = (unsigned)lane * 12u;
#define PUS_SB() __builtin_amdgcn_sched_barrier(0)
#define PUS_LD16(buf_, ia_, ib_, g_) do { const int is_ = ((g_) < 4) ? ia_ : ib_; const int lb_ = ((g_) * 16) & 63; _Pragma("unroll") for (int k = 0; k < 16; ++k) { \
        const unsigned eo = (unsigned)__builtin_amdgcn_readlane(is_, lb_ + k) * 768u; buf_[k] = *(const v3u_t*)(U8 + eo + vo12); } } while (0)
    int t = t0;
    int idA = ids[(size_t)t * IDP + lane], idB = ids[(size_t)t * IDP + 64 + lane];
    v4u h0 = *(const v4u*)(x2b + (size_t)t * DM + l16), h1 = *(const v4u*)(x2b + (size_t)t * DM + l16 + 8);
    v3u_t uwa[16], uwb[16];
    PUS_LD16(uwa, idA, idB, 0); PUS_SB(); PUS_LD16(uwb, idA, idB, 1); PUS_SB();
#pragma nounroll
    for (int i = 0; i < 16; ++i) {
        const int tn = t0 + ((i + 1 < 16) ? i + 1 : i);
        unsigned hw[8]; hw[0] = h0.x; hw[1] = h0.y; hw[2] = h0.z; hw[3] = h0.w; hw[4] = h1.x; hw[5] = h1.y; hw[6] = h1.z; hw[7] = h1.w;
        float mx = 0.f;
#pragma unroll
        for (int j = 0; j < 8; ++j) mx = fmaxf(mx, fmaxf(fabsf(pg8::bflo(hw[j])), fabsf(pg8::bfhi(hw[j]))));
#pragma unroll
        for (int o = 1; o < 64; o <<= 1) mx = fmaxf(mx, __shfl_xor(mx, o));
        mx = fmaxf(mx, 1e-30f);
        {
            const float q6 = 7.5f / mx;
            v16f_t a, b;
#pragma unroll
            for (int j = 0; j < 16; ++j) { a[j] = 0.f; b[j] = 0.f; }
#pragma unroll
            for (int j = 0; j < 8; ++j) { a[j] = pg8::bflo(hw[j]) * q6; b[j] = pg8::bfhi(hw[j]) * q6; }
            const v6u_t p = __builtin_amdgcn_cvt_scalef32_2xpk16_fp6_f32(a, b, 1.0f);
            LAS unsigned* hp = (LAS unsigned*)(wl + PEER_H6 + lane * 12); hp[0] = p[0]; hp[1] = p[1]; hp[2] = p[2];
        }
        PUS_SB();
        const int nA = ids[(size_t)tn * IDP + lane], nB = ids[(size_t)tn * IDP + 64 + lane];
        h0 = *(const v4u*)(x2b + (size_t)tn * DM + l16); h1 = *(const v4u*)(x2b + (size_t)tn * DM + l16 + 8);
        const float rs = rsqrtf(pg8::ssq_sum16(ssq2 + (size_t)t * 16) * (1.f / DM) + NORM_EPS) * (mx * (1.f / 7.5f));
        const float suA = rs * usc[idA], suB = rs * usc[idB];
        const float svA = gates[(size_t)t * IDP + lane] * vsc[idA], svB = gates[(size_t)t * IDP + 64 + lane] * vsc[idB];
        PUS_SB();
#define PUS_GRP(uw, g_, RA, RB, RG) do { \
            const float susel = ((g_) < 4) ? suA : suB, svsel = ((g_) < 4) ? svA : svB; const int lb = ((g_) * 16) & 63; \
            _Pragma("unroll") for (int k = 0; k < 16; ++k) *(LAS v3u_t*)(wl + k * PEER_PITCH + lane * 16) = uw[k]; \
            PUS_SB(); \
            PUS_LD16(uw, RA, RB, RG); \
            PUS_SB(); \
            f32x4 acc = (f32x4){0.f, 0.f, 0.f, 0.f}; \
            _Pragma("unroll") for (int b = 0; b < 8; ++b) { \
                const LAS v4u* ap = (const LAS v4u*)(wl + fr * PEER_PITCH + 32 * (4 * b + fq)); const v4u w0 = ap[0], w1 = ap[1]; \
                const v8i_t a = (v8i_t){(int)w0.x, (int)w0.y, (int)w0.z, (int)w1.x, (int)w1.y, (int)w1.z, 0, 0}; \
                const LAS v2u* hp = (const LAS v2u*)(wl + PEER_H6 + 96 * b + 24 * fq); const v2u h0_ = hp[0], h1_ = hp[1], h2_ = hp[2]; \
                const v8i_t bf = (v8i_t){(int)h0_.x, (int)h0_.y, (int)h1_.x, (int)h1_.y, (int)h2_.x, (int)h2_.y, 0, 0}; \
                acc = __builtin_amdgcn_mfma_scale_f32_16x16x128_f8f6f4(a, bf, acc, 2  , 2  , 0, 127, 0, 127); \
                if (b & 1) PUS_SB(); \
            } \
            const int esel = fr & 3; \
            const float dot = (esel == 0) ? acc[0] : (esel == 1) ? acc[1] : (esel == 2) ? acc[2] : acc[3]; \
            const float suv = __shfl(susel, lb + 4 * fq + esel), svv = __shfl(svsel, lb + 4 * fq + esel); \
            const float dd = dot * suv; \
            const float act = 0.5f * dd * (1.f + erff(dd * 0.70710678118654752f)) * svv; \
            if (fr < 4) coef[(size_t)t * IDP + (g_) * 16 + 4 * fq + fr] = act; \
            PUS_SB(); \
        } while (0)
        PUS_GRP(uwa, 0, idA, idB, 2); PUS_GRP(uwb, 1, idA, idB, 3); PUS_GRP(uwa, 2, idA, idB, 4); PUS_GRP(uwb, 3, idA, idB, 5);
        PUS_GRP(uwa, 4, idA, idB, 6); PUS_GRP(uwb, 5, idA, idB, 7); PUS_GRP(uwa, 6, nA, nB, 0); PUS_GRP(uwb, 7, nA, nB, 1);
#undef PUS_GRP
        t = tn; idA = nA; idB = nB;
    }
#undef PUS_LD16
#undef PUS_SB
}

__global__ void __launch_bounds__(NWAVES * 64, 2) mk_fwd(Args args) {
    extern __shared__ __attribute__((aligned(16))) unsigned char lds_raw[];
    LAS unsigned char* lds = (LAS unsigned char*)lds_raw;
    volatile LAS unsigned* MISC = (volatile LAS unsigned*)(lds + MISC_OFF);
    const int tid = threadIdx.x, lane = tid & 63, wave = __builtin_amdgcn_readfirstlane(tid >> 6);
    const int G = gridDim.x; const int bx = blockIdx.x; const int vcu = (G % 8 == 0) ? (bx % 8) * (G / 8) + bx / 8 : bx;
    unsigned char* ws = args.ws;
    unsigned* ctl = (unsigned*)(ws + WS_CTL);
    for (int u = tid; u < (LDS_BYTES - LDSCTL_OFF) / 4; u += NWAVES * 64) ((LAS unsigned*)(lds + LDSCTL_OFF))[u] = 0u;
    __syncthreads();
    XcdBarrier bar = xcd_barrier_post(ctl + CW_BAR + args.li * XCD_BAR_WORDS, MISC + 8);
    const int lo = args.ph_lo, hi = args.ph_hi;
    const bool grp_ok = (G == T_TOK / 256);
#define SEAM() do { if (grp_ok) group_barrier(ctl, (unsigned)(bx & 7), (unsigned)(G >> 3)); else xcd_barrier(bar); } while (0)
#define IN(k) (lo <= (k) && (k) < hi)
#define BOTH(k) (IN(k) && IN((k) + 1))
    bf16_t* WinT = (bf16_t*)(ws + WS_WIN); bf16_t* PaT = (bf16_t*)(ws + WS_PA); bf16_t* PbT = (bf16_t*)(ws + WS_PB); bf16_t* WoT = (bf16_t*)(ws + WS_WO);
    bf16_t* WqT = (bf16_t*)(ws + WS_WQ); bf16_t* KeysB = (bf16_t*)(ws + WS_KEYS);
    float* rstd1 = (float*)(ws + WS_RSTD1); float* ssq2 = (float*)(ws + WS_RSTD2); float* scal = (float*)(ws + WS_SCAL);
    unsigned char* U8 = ws + WS_U; unsigned char* V8 = ws + WS_V; float* usc = (float*)(ws + WS_USC); float* vsc = (float*)(ws + WS_VSC);
    bf16_t* xb = (bf16_t*)(ws + WS_XB); bf16_t* ya = (bf16_t*)(ws + WS_YA); bf16_t* yb = (bf16_t*)(ws + WS_YB); bf16_t* x2b = (bf16_t*)(ws + WS_X2B);
    bf16_t* z = (bf16_t*)(ws + WS_Z); bf16_t* qb = (bf16_t*)args.out;
    bf16_t* merged = (bf16_t*)(ws + WS_MERGED);
    const int gw = vcu * NWAVES + wave, NGW = G * NWAVES;

    if (IN(0)) {
        LAS float* scr = (LAS float*)(lds + wave * 16384);
        constexpr int I_IN = (DM / 64) * (NZ / 32), I_PA = (512 / 64) * (DM / 32), I_WO = (DM / 64) * (DM / 32), I_WK = 16 * (DM / 16);
        constexpr int NITEMS = I_IN + 2 * I_PA + I_WO + I_WK;
        for (int it = gw; it < NITEMS; it += NGW) {
            int r = it;
            if (r < I_IN) { p0_transpose_item(args.in[2], args.in[1], DM, NZ, WinT, scr, r, lane, ws + WS_WG8, C_GA); continue; } r -= I_IN;
            if (r < I_PA) { p0_transpose_item(args.in[19], nullptr, 512, DM, PaT, scr, r, lane, nullptr, 0, DM, 0); continue; } r -= I_PA;
            if (r < I_PA) { p0_transpose_item(args.in[20], nullptr, 512, DM, PaT, scr, r, lane, nullptr, 0, DM, 512); continue; } r -= I_PA;
            if (r < I_WO) { p0_transpose_item(args.in[21], nullptr, DM, DM, WoT, scr, r, lane); continue; } r -= I_WO;
            p0_wk_item(args.in[23], args.in[22], args.in[24], (unsigned char*)WqT, r, lane);
        }
        for (int e = gw; e < 2 * NEXP; e += NGW) {
            const bool isu = e < NEXP; const int row = isu ? e : e - NEXP;
            p0_row_fp6((isu ? args.in[25] : args.in[26]) + (size_t)row * DM, isu ? args.in[22] : nullptr, (isu ? U8 : V8) + (size_t)row * 768, (isu ? usc : vsc) + row, lane);
        }
        for (int m = gw; m < T_TOK; m += NGW) {
            const f32x4* xr = (const f32x4*)(args.in[0] + (size_t)m * DM) + lane;
            f32x4 v[4]; float s = 0.f;
#pragma unroll
            for (int j = 0; j < 4; ++j) { v[j] = xr[64 * j]; s += (v[j][0] * v[j][0] + v[j][1] * v[j][1]) + (v[j][2] * v[j][2] + v[j][3] * v[j][3]); }
            s = wave_sum(s);
            v2u* o8 = (v2u*)(xb + (size_t)m * DM) + lane;
#pragma unroll
            for (int j = 0; j < 4; ++j) { v2u w; w.x = pg8::cvt_pk_bf16(v[j][0], v[j][1]); w.y = pg8::cvt_pk_bf16(v[j][2], v[j][3]); o8[64 * j] = w;
                int p = 0; p = __builtin_amdgcn_cvt_pk_fp8_f32(v[j][0], v[j][1], p, false); p = __builtin_amdgcn_cvt_pk_fp8_f32(v[j][2], v[j][3], p, true);
                ((unsigned*)(z + (size_t)m * NZ + C_GA))[lane + 64 * j] = (unsigned)p; }
            if (lane == 0) rstd1[m] = rsqrtf(s * (1.f / DM) + NORM_EPS);
        }
        if (gw == 0) {
            const float a = wave_sum(args.in[14][lane] * args.in[15][lane]), b = wave_sum(args.in[16][lane] * args.in[17][lane]);
            if (lane == 0) scal[0] = __expf(a) - __expf(b) + LAM_INIT;
        }
        if (BOTH(0)) xcd_barrier(bar);
    }
    if (IN(1)) {
        {
            pg8::Gemm g{xb, WinT, DM, DM, DM}; pg8::StaticOrder S; S.init(T_TOK, C_GA, G, bx);
            pg8::EpiRowScale<false> E{z, ZP, rstd1};
            pg8::gemm_phase(lds, g, S, E);
        }
        {
            pg8::Gemm g{z + C_GA, (const bf16_t*)(ws + WS_WG8), NZ, DM / 2, DM / 2}; pg8::StaticOrder S; S.init(T_TOK, NZ - C_GA, G, bx);
            pg8::EpiRowScaleF8 E{(unsigned char*)args.out, GP8, rstd1, 1.f / 32.f};
            pg8::gemm_phase<pg8::EpiRowScaleF8, pg8::StaticOrder, true>(lds, g, S, E);
        }
        if (BOTH(1)) SEAM();
    }
    if (IN(2)) {
        {
            const rw::ScanP P{args.in[3], args.in[4], args.in[5], args.in[6], args.in[7], args.in[8], args.in[9], args.in[10], args.in[11], args.in[12], args.in[13]};
            for (int rep = 0; rep < REPS(2); ++rep) for (int u = vcu; u < NB * 8; u += G) rw::scan_unit(lds, z, ya, P, u >> 3, u & 7, tid, wave, lane);
        }
        const float lam = scal[0];
        __syncthreads();
        for (int i = 0;; ++i) {
            int idx = vcu + i * G; if (idx >= 2048 * REPS(10)) break;
            idx &= 2047;
            const int slot = idx >> 8, v = idx & 255, bh = v >> 1, a = (v & 1) * 4 + (slot >> 1), qblk = (slot & 1) ? 15 - a : a;
            da::attn_unit(lds, z, yb, args.in[18], lam, bh >> 2, bh & 3, qblk, wave, lane);
        }
        if (BOTH(2)) SEAM();
    }
    if (IN(3)) {
        pg8::Gemm g{ya, PaT, DM, DM, DM}; pg8::StaticOrder S; S.init(T_TOK, DM, G, bx);
        pg8::EpiGate2 E{merged, (const unsigned char*)args.out};
        pg8::gemm_phase(lds, g, S, E);
        if (BOTH(3)) SEAM();
    }
    if (IN(5)) {
        pg8::Gemm g{merged, WoT, DM, DM, DM}; pg8::StaticOrder S; S.init(T_TOK, DM, G, bx);
        pg8::EpiX2 E{args.in[0], (unsigned char*)(z + C_GA), NZ * 2, x2b, ssq2};
        pg8::gemm_phase(lds, g, S, E);
        if (BOTH(5)) SEAM();
    }
    if (IN(6)) {
        pg8::Gemm g{z + C_GA, WqT, NZ, DM / 2, DM / 2}; pg8::StaticOrder S; S.init(T_TOK, 2048, G, bx);
        pg8::EpiRowScale<true> E{qb, 2048, ssq2, 1.f / 32.f};
        for (int rep = 0; rep < REPS(6); ++rep) pg8::gemm_phase<pg8::EpiRowScale<true>, pg8::StaticOrder, true>(lds, g, S, E);
        if (BOTH(6)) SEAM();
    }
    if (IN(7)) {
        int* ids = (int*)(ws + WS_IDS); float* gates = (float*)(ws + WS_GATES);
        LAS unsigned char* wl = lds + wave * PEER_WLDS;
        float* coef = gates + 128;
        for (int ti = gw; ti < 4096; ti += NGW) {
            const int tile = grp_ok ? ((gw >> 8) * 512 + (gw & 255) + ((ti >= NGW) ? 256 : 0)) : ti;
            int l7 = (int)__builtin_amdgcn_mbcnt_hi(~0u, __builtin_amdgcn_mbcnt_lo(~0u, 0u)); asm volatile("" : "+v"(l7));
            for (int h = 0; h < 8; ++h) topk_item(qb, ids, gates, tile * 16, h, l7);
            __threadfence_block();
            peer_u_stream(wl, x2b, ssq2, ids, gates, U8, usc, vsc, coef, tile * 16, l7);
        }
        __threadfence_block();
        for (int ti = gw; ti < 4096; ti += NGW) {
            const int tile = grp_ok ? ((gw >> 8) * 512 + (gw & 255) + ((ti >= NGW) ? 256 : 0)) : ti;
            int l7 = (int)__builtin_amdgcn_mbcnt_hi(~0u, __builtin_amdgcn_mbcnt_lo(~0u, 0u)); asm volatile("" : "+v"(l7));
            for (int tk = 0; tk < 16; ++tk) peer_token<2>(wl, x2b, ssq2, ids, gates, U8, V8, usc, vsc, args.in[27], args.out, coef, tile * 16 + tk, l7);
        }
    }
#undef IN
#undef BOTH
#undef SEAM
}

extern "C" void kernel_launch(void* const* d_in, const int* in_sizes, int n_in, void* d_out, int out_size, void* d_ws, size_t ws_size, hipStream_t stream) {
    static int grid = 0;
    if (grid == 0) {
        if (n_in != 28 || in_sizes[0] != T_TOK * DM || out_size != T_TOK * DM || ws_size < WS_END) {
            fprintf(stderr, "kernel_launch: unexpected shapes / workspace (n_in %d, ws %zu < %zu)\n", n_in, ws_size, (size_t)WS_END); grid = -1; return; }
        int dev = 0, cus = 0;
        if (hipGetDevice(&dev) != hipSuccess || hipDeviceGetAttribute(&cus, hipDeviceAttributeMultiprocessorCount, dev) != hipSuccess) { grid = -1; return; }
        if (hipFuncSetAttribute((const void*)mk_fwd, hipFuncAttributeMaxDynamicSharedMemorySize, LDS_BYTES) != hipSuccess) { fprintf(stderr, "kernel_launch: hipFuncSetAttribute failed\n"); grid = -1; return; }
        grid = cus;
    }
    if (grid < 0) return;
    unsigned char* ws = (unsigned char*)d_ws;
    float* out = (float*)d_out;
    (void)hipMemsetAsync(ws + WS_CTL, 0, 1 * MiB, stream);
    Args a{};
    for (int i = 0; i < 28; ++i) a.in[i] = (const float*)d_in[i];
    a.out = out; a.ws = ws;
    a.ph_lo = 0; a.ph_hi = 9; a.li = 0;
    hipLaunchKernelGGL(mk_fwd, dim3(grid), dim3(NWAVES * 64), LDS_BYTES, stream, a);
}
```
